# Optimizing an MI355X kernel written in HIP

```python
import jax, jax.numpy as jnp
from jax import lax
import numpy as np

D_MODEL = 1024
BATCH = 2
SEQ = 16384
DEPTH = 2

N_MIXERS = 2
N_GLA = (DEPTH + 1) // N_MIXERS
N_RWKV = DEPTH // N_MIXERS

GLA_HEADS = 4
GLA_KEY_WIDTH = D_MODEL // 2
GLA_VAL_WIDTH = D_MODEL
GLA_DK = GLA_KEY_WIDTH // GLA_HEADS
GLA_DV = GLA_VAL_WIDTH // GLA_HEADS
GLA_GATE_RANK = 16
GLA_GATE_NORMALIZER = 16.0
GLA_CHUNK = 64
GLA_IN = 2 * GLA_KEY_WIDTH + 2 * GLA_VAL_WIDTH + GLA_GATE_RANK

RWKV_HEAD = 64
RWKV_WIDTH = D_MODEL
RWKV_HEADS = RWKV_WIDTH // RWKV_HEAD
RWKV_DECAY_RANK = 64
RWKV_ICLR_RANK = 64
RWKV_IN = 4 * RWKV_WIDTH + RWKV_DECAY_RANK + RWKV_ICLR_RANK

RMS_EPS = 1e-6
GN_EPS = 64e-5

kernel_name = "hybrid_gla_rwkv7_interleaved"


def rmsnorm(x, g):
    xf = x.astype(jnp.float32)
    y = xf * lax.rsqrt(jnp.mean(xf * xf, axis=-1, keepdims=True) + RMS_EPS)
    return (y * g.astype(jnp.float32)).astype(x.dtype)


def gla_mixer(h, w_in, w_alpha_up, b_alpha, g_head, w_out):
    B, T, _ = h.shape
    nc = T // GLA_CHUNK
    p = h @ w_in
    q, k, v, gate, ad = jnp.split(p, [GLA_KEY_WIDTH, 2 * GLA_KEY_WIDTH,
                                       2 * GLA_KEY_WIDTH + GLA_VAL_WIDTH,
                                       2 * GLA_KEY_WIDTH + 2 * GLA_VAL_WIDTH], axis=-1)
    f32 = jnp.float32
    log_alpha = jax.nn.log_sigmoid((ad.astype(f32) @ w_alpha_up.astype(f32)
                                    + b_alpha.astype(f32))) / GLA_GATE_NORMALIZER

    def heads(z, d):
        return z.astype(f32).reshape(B, nc, GLA_CHUNK, GLA_HEADS, d).transpose(0, 3, 1, 2, 4)

    q = heads(q, GLA_DK) * (GLA_DK ** -0.5)
    k = heads(k, GLA_DK)
    v = heads(v, GLA_DV)
    bcum = jnp.cumsum(heads(log_alpha, GLA_DK), axis=3)
    b_last = bcum[:, :, :, -1, :]
    q_dec = q * jnp.exp(bcum)
    k_dec = k * jnp.exp(-bcum)
    k_to_end = k * jnp.exp(b_last[:, :, :, None, :] - bcum)

    mask = jnp.tril(jnp.ones((GLA_CHUNK, GLA_CHUNK), dtype=bool))
    att = jnp.where(mask, jnp.einsum('bhncd,bhnsd->bhncs', q_dec, k_dec), 0.0)
    o_intra = jnp.einsum('bhncs,bhnsv->bhncv', att, v)

    def step(S, inp):
        qd, kt, vv, dl = inp
        o = jnp.einsum('bhcd,bhdv->bhcv', qd, S)
        S = S * jnp.exp(dl)[..., None] + jnp.einsum('bhcd,bhcv->bhdv', kt, vv)
        return S, o

    S0 = jnp.zeros((B, GLA_HEADS, GLA_DK, GLA_DV), f32)
    xs = (jnp.moveaxis(q_dec, 2, 0), jnp.moveaxis(k_to_end, 2, 0),
          jnp.moveaxis(v, 2, 0), jnp.moveaxis(b_last, 2, 0))
    _, o_inter = lax.scan(step, S0, xs)
    o = o_intra + jnp.moveaxis(o_inter, 0, 2)

    o = o * lax.rsqrt(jnp.mean(o * o, axis=-1, keepdims=True) + RMS_EPS) * g_head.astype(f32)
    o = o.transpose(0, 2, 3, 1, 4).reshape(B, T, GLA_VAL_WIDTH)
    o = o * jax.nn.silu(gate.astype(f32))
    return o.astype(h.dtype) @ w_out


def token_shift(p):
    return jnp.pad(p, ((0, 0), (1, 0), (0, 0)))[:, :-1]


def rwkv7_mixer(h, w_in, mu, w0, w_decay_up, a0, w_iclr_up, k_k, k_a, r_k, ln_w, ln_b, w_out):
    B, T, _ = h.shape
    f32 = jnp.float32
    p = h @ w_in
    p = p + mu * (token_shift(p) - p)
    r, k, v, gate, wd, ad = jnp.split(p, [RWKV_WIDTH, 2 * RWKV_WIDTH, 3 * RWKV_WIDTH,
                                           4 * RWKV_WIDTH, 4 * RWKV_WIDTH + RWKV_DECAY_RANK], axis=-1)
    r, k, v, gate, wd, ad = (z.astype(f32) for z in (r, k, v, gate, wd, ad))

    w_log = -jax.nn.softplus(-(w0.astype(f32) + jnp.tanh(wd) @ w_decay_up.astype(f32))) - 0.5
    decay = jnp.exp(-jnp.exp(w_log))
    a = jax.nn.sigmoid(a0.astype(f32) + ad @ w_iclr_up.astype(f32))

    def heads(z):
        return z.reshape(B, T, RWKV_HEADS, RWKV_HEAD)

    kk = heads(k * k_k.astype(f32))
    kk = kk / jnp.maximum(jnp.sqrt(jnp.sum(kk * kk, axis=-1, keepdims=True)), 1e-12)
    k = k * (1.0 + (a - 1.0) * k_a.astype(f32))
    r, decay, k, v, a = heads(r), heads(decay), heads(k), heads(v), heads(a)

    def step(S, inp):
        r_t, w_t, k_t, v_t, kk_t, a_t = inp
        sa = jnp.einsum('bhvk,bhk->bhv', S, -kk_t)
        S = (S * w_t[:, :, None, :] + sa[..., None] * (kk_t * a_t)[:, :, None, :]
             + v_t[..., None] * k_t[:, :, None, :])
        y = jnp.einsum('bhvk,bhk->bhv', S, r_t)
        return S, y

    S0 = jnp.zeros((B, RWKV_HEADS, RWKV_HEAD, RWKV_HEAD), f32)
    xs = tuple(jnp.moveaxis(z, 1, 0) for z in (r, decay, k, v, kk, a))
    _, y = lax.scan(step, S0, xs)
    y = jnp.moveaxis(y, 0, 1)

    mean = jnp.mean(y, axis=-1, keepdims=True)
    var = jnp.mean(jnp.square(y - mean), axis=-1, keepdims=True)
    y = ((y - mean) * lax.rsqrt(var + GN_EPS)).reshape(B, T, RWKV_WIDTH)
    y = y * ln_w.astype(f32) + ln_b.astype(f32)
    bonus = jnp.sum(r * k * r_k.astype(f32), axis=-1, keepdims=True) * v
    y = y + bonus.reshape(B, T, RWKV_WIDTH)
    y = y * jax.nn.silu(gate)
    return y.astype(h.dtype) @ w_out


def setup_inputs(seed: int = 0) -> dict:
    key = jax.random.key(seed)
    ks = jax.random.split(key, 24)
    nrm = jax.random.normal
    f32 = jnp.float32
    D = D_MODEL
    x = nrm(ks[0], (BATCH, SEQ, D), f32)
    gla_pre_norm = 1.0 + 0.02 * nrm(ks[1], (N_GLA, D), f32)
    gla_w_in = nrm(ks[2], (N_GLA, D, GLA_IN), f32) * D ** -0.5
    gla_w_alpha_up = nrm(ks[3], (N_GLA, GLA_GATE_RANK, GLA_KEY_WIDTH), f32) * GLA_GATE_RANK ** -0.5
    gla_b_alpha = 0.1 * nrm(ks[4], (N_GLA, GLA_KEY_WIDTH), f32)
    gla_head_norm = 1.0 + 0.02 * nrm(ks[5], (N_GLA, GLA_DV), f32)
    gla_w_out = nrm(ks[6], (N_GLA, GLA_VAL_WIDTH, D), f32) * GLA_VAL_WIDTH ** -0.5
    gla_post_norm = 1.0 + 0.02 * nrm(ks[7], (N_GLA, D), f32)
    rwkv_pre_norm = 1.0 + 0.02 * nrm(ks[8], (N_RWKV, D), f32)
    rwkv_w_in = nrm(ks[9], (N_RWKV, D, RWKV_IN), f32) * D ** -0.5
    rwkv_mu = jax.random.uniform(ks[10], (N_RWKV, RWKV_IN), f32)
    rwkv_w0 = -1.0 + 0.5 * nrm(ks[11], (N_RWKV, RWKV_WIDTH), f32)
    rwkv_w_decay_up = 0.1 * nrm(ks[12], (N_RWKV, RWKV_DECAY_RANK, RWKV_WIDTH), f32)
    rwkv_a0 = 0.1 * nrm(ks[13], (N_RWKV, RWKV_WIDTH), f32)
    rwkv_w_iclr_up = 0.1 * nrm(ks[14], (N_RWKV, RWKV_ICLR_RANK, RWKV_WIDTH), f32)
    rwkv_k_k = 0.85 + 0.05 * nrm(ks[15], (N_RWKV, RWKV_WIDTH), f32)
    rwkv_k_a = 1.0 + 0.05 * nrm(ks[16], (N_RWKV, RWKV_WIDTH), f32)
    rwkv_r_k = 0.1 * nrm(ks[17], (N_RWKV, RWKV_HEADS, RWKV_HEAD), f32)
    rwkv_ln_w = 1.0 + 0.02 * nrm(ks[18], (N_RWKV, RWKV_WIDTH), f32)
    rwkv_ln_b = 0.02 * nrm(ks[19], (N_RWKV, RWKV_WIDTH), f32)
    rwkv_w_out = nrm(ks[20], (N_RWKV, RWKV_WIDTH, D), f32) * RWKV_WIDTH ** -0.5
    rwkv_post_norm = 1.0 + 0.02 * nrm(ks[21], (N_RWKV, D), f32)
    return {"x": x,
            "gla_pre_norm": gla_pre_norm, "gla_w_in": gla_w_in, "gla_w_alpha_up": gla_w_alpha_up,
            "gla_b_alpha": gla_b_alpha, "gla_head_norm": gla_head_norm, "gla_w_out": gla_w_out,
            "gla_post_norm": gla_post_norm,
            "rwkv_pre_norm": rwkv_pre_norm, "rwkv_w_in": rwkv_w_in, "rwkv_mu": rwkv_mu,
            "rwkv_w0": rwkv_w0, "rwkv_w_decay_up": rwkv_w_decay_up, "rwkv_a0": rwkv_a0,
            "rwkv_w_iclr_up": rwkv_w_iclr_up, "rwkv_k_k": rwkv_k_k, "rwkv_k_a": rwkv_k_a,
            "rwkv_r_k": rwkv_r_k, "rwkv_ln_w": rwkv_ln_w, "rwkv_ln_b": rwkv_ln_b,
            "rwkv_w_out": rwkv_w_out, "rwkv_post_norm": rwkv_post_norm}


def reference(x, gla_pre_norm, gla_w_in, gla_w_alpha_up, gla_b_alpha, gla_head_norm, gla_w_out,
              gla_post_norm, rwkv_pre_norm, rwkv_w_in, rwkv_mu, rwkv_w0, rwkv_w_decay_up, rwkv_a0,
              rwkv_w_iclr_up, rwkv_k_k, rwkv_k_a, rwkv_r_k, rwkv_ln_w, rwkv_ln_b, rwkv_w_out,
              rwkv_post_norm):
    for i in range(DEPTH):
        j = i // N_MIXERS
        if i % N_MIXERS == 0:
            h = rmsnorm(x, gla_pre_norm[j])
            y = gla_mixer(h, gla_w_in[j], gla_w_alpha_up[j], gla_b_alpha[j], gla_head_norm[j],
                          gla_w_out[j])
            x = x + rmsnorm(y, gla_post_norm[j])
        else:
            h = rmsnorm(x, rwkv_pre_norm[j])
            y = rwkv7_mixer(h, rwkv_w_in[j], rwkv_mu[j], rwkv_w0[j], rwkv_w_decay_up[j], rwkv_a0[j],
                            rwkv_w_iclr_up[j], rwkv_k_k[j], rwkv_k_a[j], rwkv_r_k[j], rwkv_ln_w[j],
                            rwkv_ln_b[j], rwkv_w_out[j])
            x = x + rmsnorm(y, rwkv_post_norm[j])
    return x
```

```cpp
#include <hip/hip_runtime.h>
#include <hip/hip_cooperative_groups.h>
#include <cstdio>
namespace cg = cooperative_groups;
#define N_LAUNCH_MODE 1
namespace pg8 {
#define PG8_LAS __attribute__((address_space(3)))
typedef unsigned short bf16_t;
typedef short bf16x8 __attribute__((ext_vector_type(8)));
typedef float f32x4 __attribute__((ext_vector_type(4)));
typedef unsigned u32x4 __attribute__((ext_vector_type(4)));
constexpr int BM = 256, BK = 64, HALF = 128, HTB = HALF * BK * 2  , STAGE_BYTES = 8 * HTB, NXCD = 8, WGM = 8;

__host__ __device__ __forceinline__ int lds_byte(int r, int c) { const int st = (r >> 4) * 2 + (c >> 5), rr = r & 15, cc = c & 31, ob = rr * 64 + cc * 2; return st * 1024 + (ob ^ (((ob >> 9) & 1) << 5)); }
__host__ __device__ __forceinline__ void stage_rc(int b, int& R, int& C) { const int st = b / 1024, sb = b % 1024, swz = sb ^ (((sb >> 9) & 1) << 5); R = (st >> 1) * 16 + swz / 64; C = (st & 1) * 32 + (swz % 64) / 2; }
__host__ __device__ __forceinline__ int perm32(int rho) { const int n = rho >> 4, i = rho & 15; return 8 * (i >> 2) + 4 * n + (i & 3); }

struct Unit { int pm, pn; };
struct Gemm { const bf16_t* A; const bf16_t* Bt; int M, N, K; };

struct StaticOrder {
    int nM, nN, nwg, G, c;
    __host__ __device__ void init(int M, int N, int G_, int c_) { nM = M / BM; nN = N / BM; nwg = nM * nN; G = G_; c = c_; }
    __host__ __device__ bool next(int i, Unit& u) const {
        const long L = (long)i * G + c; if (L >= nwg) return false;
        int wgid = (int)L; { const int q = nwg / NXCD, r = nwg % NXCD, xcd = wgid % NXCD, off = wgid / NXCD; wgid = (xcd < r ? xcd * (q + 1) : r * (q + 1) + (xcd - r) * q) + off; }
        const int nig = WGM * nN, gid = wgid / nig, fm = gid * WGM, gsz = (nM - fm) < WGM ? (nM - fm) : WGM;
        u.pm = fm + ((wgid % nig) % gsz); u.pn = (wgid % nig) / gsz; return true;
    }
    __device__ __forceinline__ void a_ready(const Unit&) const {}
    __device__ __forceinline__ void done(const Unit&) const {}
};

__device__ __forceinline__ unsigned cvt_pk_bf16(float lo, float hi) { unsigned r; asm volatile("v_cvt_pk_bf16_f32 %0, %1, %2" : "=v"(r) : "v"(lo), "v"(hi)); return r; }
typedef float f32x2 __attribute__((ext_vector_type(2)));
struct EpiF32 {
    static constexpr bool PERM = false, AFTER_DRAIN = false;
    float* C; int ldc; const float* bias;
    __device__ __forceinline__ void operator()(const f32x4 (&acc)[2][2][4][2], const Unit& u, int wr, int wc, int fr, int fq) const {
        const int row0 = u.pm * BM + wr * 64 + fr, col0 = u.pn * BM + wc * 32 + 4 * fq;
        f32x4 bv[2][2];
#pragma unroll
        for (int bj = 0; bj < 2; ++bj)
#pragma unroll
            for (int n = 0; n < 2; ++n) bv[bj][n] = bias ? *(const f32x4*)(bias + col0 + bj * HALF + n * 16) : (f32x4){0.f, 0.f, 0.f, 0.f};
#pragma unroll
        for (int ai = 0; ai < 2; ++ai)
#pragma unroll
            for (int m = 0; m < 4; ++m) { float* rowp = C + (size_t)(row0 + ai * HALF + m * 16) * ldc + col0;
#pragma unroll
                for (int bj = 0; bj < 2; ++bj)
#pragma unroll
                    for (int n = 0; n < 2; ++n) *(f32x4*)(rowp + bj * HALF + n * 16) = acc[ai][bj][m][n] + bv[bj][n]; }
    }
};
template <int ACT  > struct EpiBf16 {
    static constexpr bool PERM = true, AFTER_DRAIN = false;
    bf16_t* O; int ldc; const float* bias; int split_cols; size_t split_stride;
    __device__ __forceinline__ void operator()(const f32x4 (&acc)[2][2][4][2], const Unit& u, int wr, int wc, int fr, int fq) const {
        const int row0 = u.pm * BM + wr * 64 + fr; int colt = u.pn * BM; bf16_t* base = O;
        if (split_cols) { const int t = colt / split_cols; base += (size_t)t * split_stride; colt -= t * split_cols; }
        const int col0 = colt + wc * 32 + 8 * fq, bcol0 = u.pn * BM + wc * 32 + 8 * fq;
        f32x4 bv[2][2];
#pragma unroll
        for (int bj = 0; bj < 2; ++bj)
#pragma unroll
            for (int n = 0; n < 2; ++n) bv[bj][n] = bias ? *(const f32x4*)(bias + bcol0 + bj * HALF + 4 * n) : (f32x4){0.f, 0.f, 0.f, 0.f};
#pragma unroll
        for (int ai = 0; ai < 2; ++ai)
#pragma unroll
            for (int m = 0; m < 4; ++m) { bf16_t* rowp = base + (size_t)(row0 + ai * HALF + m * 16) * ldc + col0;
#pragma unroll
                for (int bj = 0; bj < 2; ++bj) { f32x4 v0 = acc[ai][bj][m][0] + bv[bj][0], v1 = acc[ai][bj][m][1] + bv[bj][1];
                    u32x4 w; w.x = cvt_pk_bf16(v0[0], v0[1]); w.y = cvt_pk_bf16(v0[2], v0[3]); w.z = cvt_pk_bf16(v1[0], v1[1]); w.w = cvt_pk_bf16(v1[2], v1[3]);
                    *(u32x4*)(rowp + bj * HALF) = w; } }
    }
};

template <class Epi, class Sched>
__device__ __forceinline__ void gemm_phase(PG8_LAS unsigned char* lds, const Gemm g, const Sched& S, const Epi& E) {
    const int tid = threadIdx.x, wid = __builtin_amdgcn_readfirstlane(tid >> 6), lane = tid & 63, wr = wid >> 2, wc = wid & 3, fr = lane & 15, fq = lane >> 4;
    const int K = g.K, nt = K / BK;
    unsigned voffA[2], voffB[2];
#pragma unroll
    for (int i = 0; i < 2; ++i) { int R, C; stage_rc(tid * 16 + i * 8192, R, C); const int Rb = Epi::PERM ? ((R & ~31) + perm32(R & 31)) : R;
        voffA[i] = (unsigned)(R * K + C) * 2u; voffB[i] = (unsigned)(Rb * K + C) * 2u; }
    const size_t kstep = (size_t)(BK * 2);
    const size_t hstep = (size_t)HALF * K * 2;
    const size_t tstep = 2 * hstep;
    const unsigned ldsw = (unsigned)wid * 1024u;
    const int aoff = lds_byte(wr * 64 + fr, fq * 8), boff = lds_byte(wc * 32 + fr, fq * 8);
#define PG8_SA(b, h) (((b) * 2 + (h)) * HTB)
#define PG8_SB(b, h) ((4 + (b) * 2 + (h)) * HTB)
#define PG8_STAGE(bufoff, gbase, voff) do { _Pragma("unroll") for (int _i = 0; _i < 2; ++_i) \
        __builtin_amdgcn_global_load_lds((const unsigned*)((const char*)(gbase) + (voff)[_i]), (PG8_LAS unsigned*)(lds + (bufoff) + ldsw + _i * 8192), 16, 0, 0); } while (0)
#define PG8_LDA(dst, b, h) do { _Pragma("unroll") for (int m = 0; m < 4; ++m) _Pragma("unroll") for (int k = 0; k < 2; ++k) dst[m][k] = *(const PG8_LAS bf16x8*)(lds + PG8_SA(b, h) + aoff + m * 2048 + k * 1024); } while (0)
#define PG8_LDB(dst, b, h) do { _Pragma("unroll") for (int n = 0; n < 2; ++n) _Pragma("unroll") for (int k = 0; k < 2; ++k) dst[n][k] = *(const PG8_LAS bf16x8*)(lds + PG8_SB(b, h) + boff + n * 2048 + k * 1024); } while (0)
#define PG8_MMA(ai, bj, At, Bt) do { __builtin_amdgcn_s_setprio(1); _Pragma("unroll") for (int m = 0; m < 4; ++m) _Pragma("unroll") for (int n = 0; n < 2; ++n) _Pragma("unroll") for (int k = 0; k < 2; ++k) \
        acc[ai][bj][m][n] = __builtin_amdgcn_mfma_f32_16x16x32_bf16(Bt[n][k], At[m][k], acc[ai][bj][m][n], 0, 0, 0); __builtin_amdgcn_s_setprio(0); } while (0)
#define PG8_WAIT_V(n) asm volatile("s_waitcnt vmcnt(" #n ")" ::: "memory")
#define PG8_WAIT_L(n) asm volatile("s_waitcnt lgkmcnt(" #n ")" ::: "memory")
#define PG8_BAR __builtin_amdgcn_s_barrier()
#define PG8_SCHED __builtin_amdgcn_sched_barrier(0)
    Unit cur, nxt; int ui = 0;
    if (!S.next(0, cur)) return;
    f32x4 acc[2][2][4][2];
#pragma unroll
    for (int a = 0; a < 2; ++a)
#pragma unroll
        for (int b = 0; b < 2; ++b)
#pragma unroll
            for (int m = 0; m < 4; ++m)
#pragma unroll
                for (int n = 0; n < 2; ++n) acc[a][b][m][n] = (f32x4){0.f, 0.f, 0.f, 0.f};
    bf16x8 At[4][2], B0[2][2], B1[2][2];
    const char* cA = (const char*)g.A + (size_t)cur.pm * tstep; const char* cB = (const char*)g.Bt + (size_t)cur.pn * tstep;
    S.a_ready(cur);
    PG8_STAGE(PG8_SB(0, 0), cB, voffB); PG8_STAGE(PG8_SA(0, 0), cA, voffA); PG8_STAGE(PG8_SB(0, 1), cB + hstep, voffB); PG8_STAGE(PG8_SA(0, 1), cA + hstep, voffA);
    if (wr == 1) PG8_BAR;
    PG8_WAIT_V(4); PG8_BAR;
    PG8_STAGE(PG8_SB(1, 0), cB + kstep, voffB); PG8_STAGE(PG8_SA(1, 0), cA + kstep, voffA); PG8_STAGE(PG8_SB(1, 1), cB + hstep + kstep, voffB);
    PG8_WAIT_V(6); PG8_BAR;
    for (;;) {
        const bool has_next = S.next(ui + 1, nxt);
        const char* nA = has_next ? (const char*)g.A + (size_t)nxt.pm * tstep : cA; const char* nB = has_next ? (const char*)g.Bt + (size_t)nxt.pn * tstep : cB;
        for (int t = 0; t < nt; t += 2) {
            const bool last = (t == nt - 2);
            const char* a1 = cA + (size_t)(t + 1) * kstep;
            const char* a2 = last ? nA : cA + (size_t)(t + 2) * kstep; const char* b2 = last ? nB : cB + (size_t)(t + 2) * kstep;
            const char* a3 = a2 + kstep; const char* b3 = b2 + kstep;
            if (last && has_next) S.a_ready(nxt);
            PG8_LDB(B0, 0, 0); PG8_SCHED; PG8_LDA(At, 0, 0); PG8_STAGE(PG8_SA(1, 1), a1 + hstep, voffA);
            PG8_WAIT_L(8); PG8_BAR; PG8_WAIT_L(0); PG8_MMA(0, 0, At, B0); PG8_BAR; PG8_SCHED;
            PG8_LDB(B1, 0, 1); PG8_STAGE(PG8_SB(0, 0), b2, voffB);
            PG8_BAR; PG8_WAIT_L(0); PG8_MMA(0, 1, At, B1); PG8_BAR;
            PG8_LDA(At, 0, 1); PG8_STAGE(PG8_SA(0, 0), a2, voffA);
            PG8_BAR; PG8_WAIT_L(0); PG8_MMA(1, 0, At, B0); PG8_BAR; PG8_SCHED;
            PG8_STAGE(PG8_SB(0, 1), b2 + hstep, voffB);
            PG8_WAIT_V(6); PG8_BAR; PG8_MMA(1, 1, At, B1); PG8_BAR;
            PG8_LDB(B0, 1, 0); PG8_SCHED; PG8_LDA(At, 1, 0); PG8_STAGE(PG8_SA(0, 1), a2 + hstep, voffA);
            PG8_WAIT_L(8); PG8_BAR; PG8_WAIT_L(0); PG8_MMA(0, 0, At, B0); PG8_BAR; PG8_SCHED;
            PG8_LDB(B1, 1, 1); PG8_STAGE(PG8_SB(1, 0), b3, voffB);
            PG8_BAR; PG8_WAIT_L(0); PG8_MMA(0, 1, At, B1); PG8_BAR;
            PG8_LDA(At, 1, 1); PG8_STAGE(PG8_SA(1, 0), a3, voffA);
            PG8_BAR; PG8_WAIT_L(0); PG8_MMA(1, 0, At, B0); PG8_BAR; PG8_SCHED;
            PG8_STAGE(PG8_SB(1, 1), b3 + hstep, voffB);
            PG8_WAIT_V(6); PG8_BAR; PG8_MMA(1, 1, At, B1); PG8_BAR;
        }
        if constexpr (!Epi::AFTER_DRAIN) { E(acc, cur, wr, wc, fr, fq); S.done(cur); }
        if (!has_next) break;
#pragma unroll
        for (int a = 0; a < 2; ++a)
#pragma unroll
            for (int b = 0; b < 2; ++b)
#pragma unroll
                for (int m = 0; m < 4; ++m)
#pragma unroll
                    for (int n = 0; n < 2; ++n) acc[a][b][m][n] = (f32x4){0.f, 0.f, 0.f, 0.f};
        cur = nxt; cA = nA; cB = nB; ++ui;
    }
    PG8_WAIT_V(0);
    if (wr == 0) PG8_BAR;
    PG8_BAR;
    if constexpr (Epi::AFTER_DRAIN) { E.fused(acc, cur, wr, wc, fr, fq, lds, wid, lane); S.done(cur); }
#undef PG8_SA
#undef PG8_SB
#undef PG8_STAGE
#undef PG8_LDA
#undef PG8_LDB
#undef PG8_MMA
#undef PG8_WAIT_V
#undef PG8_WAIT_L
#undef PG8_BAR
#undef PG8_SCHED
}
}


typedef unsigned short bf16_t;
typedef short bf16x8 __attribute__((ext_vector_type(8)));
typedef float f32x4 __attribute__((ext_vector_type(4)));
typedef unsigned u32x4 __attribute__((ext_vector_type(4)));
typedef unsigned u32x2 __attribute__((ext_vector_type(2)));

constexpr int MTOK = 32768, DM = 1024, SEQ = 16384, NTH = 512;
constexpr int GIN = 3088, GIN_P = 3328, RIN = 4224, RIN_P = 4352;
constexpr int LDS_BYTES = 131072;

constexpr size_t WS_WGIN  = 0;
constexpr size_t WS_WGOUT = WS_WGIN  + (size_t)GIN_P * DM * 2;
constexpr size_t WS_WRIN  = WS_WGOUT + (size_t)DM * DM * 2;
constexpr size_t WS_WROUT = WS_WRIN  + (size_t)RIN_P * DM * 2;
constexpr size_t WS_A     = WS_WROUT + (size_t)DM * DM * 2;
constexpr size_t WS_Y     = WS_A     + (size_t)MTOK * DM * 2;
constexpr size_t WS_GS    = WS_Y     + (size_t)MTOK * DM * 2;
constexpr size_t WS_GD    = WS_GS    + (size_t)8 * 32 * 128 * 256 * 4;
constexpr size_t WS_P     = WS_GD    + (size_t)8 * 32 * 128 * 4;
constexpr size_t WS_END   = WS_P     + (size_t)MTOK * RIN_P * 2;

struct Params { const float* in[22]; float* out; unsigned char* ws; int ph_lo, ph_hi; };

__device__ __forceinline__ float bf2f(unsigned b) { return __uint_as_float(b << 16); }
__device__ __forceinline__ bf16_t f2bf(float f) { unsigned u = __float_as_uint(f); u += 0x7FFFu + ((u >> 16) & 1u); return (bf16_t)(u >> 16); }
__device__ __forceinline__ unsigned pk2(float lo, float hi) { return pg8::cvt_pk_bf16(lo, hi); }
__device__ __forceinline__ float wave_sum(float x) {
#pragma unroll
    for (int off = 32; off >= 1; off >>= 1) x += __shfl_xor(x, off);
    return x;
}
__device__ __forceinline__ f32x4 mfma16(bf16x8 a, bf16x8 b, f32x4 c) { return __builtin_amdgcn_mfma_f32_16x16x32_bf16(a, b, c, 0, 0, 0); }
__device__ __forceinline__ bf16x8 as_bf16x8(u32x4 v) { union { u32x4 u; bf16x8 b; } x; x.u = v; return x.b; }
__device__ __forceinline__ float log_sigmoid(float z) { return fminf(z, 0.f) - log1pf(__expf(-fabsf(z))); }
__device__ __forceinline__ float softplus(float z) { return fmaxf(z, 0.f) + log1pf(__expf(-fabsf(z))); }

__device__ void prep_weight(const float* __restrict__ W, int N, const float* __restrict__ gain, bf16_t* __restrict__ Wt, int NP, float* tile) {
    const int tid = threadIdx.x;
    const int nu = (NP / 64) * 16;
    for (int u = blockIdx.x; u < nu; u += gridDim.x) {
        const int n0 = (u >> 4) * 64, k0 = (u & 15) * 64;
        {
            const int j = tid & 63, i0 = tid >> 6;
#pragma unroll
            for (int r = 0; r < 8; ++r) {
                const int i = i0 + 8 * r, k = k0 + i, n = n0 + j;
                float v = 0.f;
                if (n < N) { v = W[(size_t)k * N + n]; if (gain) v *= gain[k]; }
                tile[i * 65 + j] = v;
            }
        }
        __syncthreads();
        {
            const int i = tid & 63, j0 = tid >> 6;
#pragma unroll
            for (int r = 0; r < 8; ++r) {
                const int j = j0 + 8 * r;
                Wt[(size_t)(n0 + j) * DM + k0 + i] = f2bf(tile[i * 65 + j]);
            }
        }
        __syncthreads();
    }
}

__device__ void phase_norm0(const Params& p) {
    const int tid = threadIdx.x, lane = tid & 63, w = tid >> 6;
    const float* x = p.in[0];
    bf16_t* A = (bf16_t*)(p.ws + WS_A);
    for (int row = blockIdx.x * 8 + w; row < MTOK; row += gridDim.x * 8) {
        const float4* xr = (const float4*)(x + (size_t)row * DM);
        float4 v[4];
#pragma unroll
        for (int i = 0; i < 4; ++i) v[i] = xr[lane + 64 * i];
        float ss = 0.f;
#pragma unroll
        for (int i = 0; i < 4; ++i) ss += v[i].x * v[i].x + v[i].y * v[i].y + v[i].z * v[i].z + v[i].w * v[i].w;
        ss = wave_sum(ss);
        const float rstd = rsqrtf(ss * (1.0f / DM) + 1e-6f);
#pragma unroll
        for (int i = 0; i < 4; ++i) {
            u32x2 o; o.x = pk2(v[i].x * rstd, v[i].y * rstd); o.y = pk2(v[i].z * rstd, v[i].w * rstd);
            *(u32x2*)(A + (size_t)row * DM + 4 * (lane + 64 * i)) = o;
        }
    }
}

__device__ void phase_norm1(const Params& p) {
    const int tid = threadIdx.x, lane = tid & 63, w = tid >> 6;
    const float* x = p.in[0];
    const float* gpost = p.in[7];
    const bf16_t* Y = (const bf16_t*)(p.ws + WS_Y);
    bf16_t* A = (bf16_t*)(p.ws + WS_A);
    float4 gp[4];
#pragma unroll
    for (int i = 0; i < 4; ++i) gp[i] = ((const float4*)gpost)[lane + 64 * i];
    for (int row = blockIdx.x * 8 + w; row < MTOK; row += gridDim.x * 8) {
        const float4* xr = (const float4*)(x + (size_t)row * DM);
        float4 v[4]; u32x2 yv[4];
#pragma unroll
        for (int i = 0; i < 4; ++i) { v[i] = xr[lane + 64 * i]; yv[i] = *(const u32x2*)(Y + (size_t)row * DM + 4 * (lane + 64 * i)); }
        float4 y[4];
        float ss = 0.f;
#pragma unroll
        for (int i = 0; i < 4; ++i) {
            y[i].x = bf2f(yv[i].x & 0xffffu); y[i].y = bf2f(yv[i].x >> 16); y[i].z = bf2f(yv[i].y & 0xffffu); y[i].w = bf2f(yv[i].y >> 16);
            ss += y[i].x * y[i].x + y[i].y * y[i].y + y[i].z * y[i].z + y[i].w * y[i].w;
        }
        ss = wave_sum(ss);
        const float rstdy = rsqrtf(ss * (1.0f / DM) + 1e-6f);
        float s1 = 0.f;
#pragma unroll
        for (int i = 0; i < 4; ++i) {
            v[i].x += y[i].x * rstdy * gp[i].x; v[i].y += y[i].y * rstdy * gp[i].y; v[i].z += y[i].z * rstdy * gp[i].z; v[i].w += y[i].w * rstdy * gp[i].w;
            s1 += v[i].x * v[i].x + v[i].y * v[i].y + v[i].z * v[i].z + v[i].w * v[i].w;
            ((float4*)(p.out + (size_t)row * DM))[lane + 64 * i] = v[i];
        }
        s1 = wave_sum(s1);
        const float rstd = rsqrtf(s1 * (1.0f / DM) + 1e-6f);
#pragma unroll
        for (int i = 0; i < 4; ++i) {
            u32x2 o; o.x = pk2(v[i].x * rstd, v[i].y * rstd); o.y = pk2(v[i].z * rstd, v[i].w * rstd);
            *(u32x2*)(A + (size_t)row * DM + 4 * (lane + 64 * i)) = o;
        }
    }
}

__device__ void phase_final(const Params& p) {
    const int tid = threadIdx.x, lane = tid & 63, w = tid >> 6;
    const float* gpost = p.in[21];
    const bf16_t* Y = (const bf16_t*)(p.ws + WS_Y);
    float4 gp[4];
#pragma unroll
    for (int i = 0; i < 4; ++i) gp[i] = ((const float4*)gpost)[lane + 64 * i];
    for (int row = blockIdx.x * 8 + w; row < MTOK; row += gridDim.x * 8) {
        float4* xr = (float4*)(p.out + (size_t)row * DM);
        float4 v[4]; u32x2 yv[4];
#pragma unroll
        for (int i = 0; i < 4; ++i) { v[i] = xr[lane + 64 * i]; yv[i] = *(const u32x2*)(Y + (size_t)row * DM + 4 * (lane + 64 * i)); }
        float4 y[4];
        float ss = 0.f;
#pragma unroll
        for (int i = 0; i < 4; ++i) {
            y[i].x = bf2f(yv[i].x & 0xffffu); y[i].y = bf2f(yv[i].x >> 16); y[i].z = bf2f(yv[i].y & 0xffffu); y[i].w = bf2f(yv[i].y >> 16);
            ss += y[i].x * y[i].x + y[i].y * y[i].y + y[i].z * y[i].z + y[i].w * y[i].w;
        }
        ss = wave_sum(ss);
        const float rstdy = rsqrtf(ss * (1.0f / DM) + 1e-6f);
#pragma unroll
        for (int i = 0; i < 4; ++i) {
            v[i].x += y[i].x * rstdy * gp[i].x; v[i].y += y[i].y * rstdy * gp[i].y; v[i].z += y[i].z * rstdy * gp[i].z; v[i].w += y[i].w * rstdy * gp[i].w;
            xr[lane + 64 * i] = v[i];
        }
    }
}

constexpr int L_AD = 0, L_TOT = 4096, L_DEC = 6144, L_SSQ = 6656, L_QD = 8704, L_KD = L_QD + 64 * 136 * 2, L_KT = L_KD + 64 * 136 * 2, L_VT = L_KT + 128 * 72 * 2,
              L_ATT = L_VT + 256 * 72 * 2, L_GLA_END = L_ATT + 64 * 72 * 2;
static_assert(L_GLA_END <= LDS_BYTES, "GLA LDS");

template <bool OUT>
__device__ void gla_pass(const Params& p, unsigned char* lds) {
    const int tid = threadIdx.x, lane = tid & 63, w = tid >> 6, l15 = lane & 15, g = lane >> 4;
    const bf16_t* P = (const bf16_t*)(p.ws + WS_P);
    float* GS = (float*)(p.ws + WS_GS);
    float* GD = (float*)(p.ws + WS_GD);
    bf16_t* Aout = (bf16_t*)(p.ws + WS_A);
    float* ADs = (float*)(lds + L_AD); float* TOT = (float*)(lds + L_TOT); float* DEC = (float*)(lds + L_DEC); float* SSQ = (float*)(lds + L_SSQ);
    bf16_t* QD = (bf16_t*)(lds + L_QD); bf16_t* KD = (bf16_t*)(lds + L_KD); bf16_t* KT = (bf16_t*)(lds + L_KT); bf16_t* VT = (bf16_t*)(lds + L_VT); bf16_t* ATT = (bf16_t*)(lds + L_ATT);
    const float* w_up = p.in[3]; const float* b_al = p.in[4]; const float* g_head = p.in[5];
    const int d = tid & 127, rg = tid >> 7;

    for (int unit = blockIdx.x; unit < 256; unit += gridDim.x) {
        const int bh = unit >> 5, m = unit & 31, b = bh >> 2, h = bh & 3;
        const int tokbase = b * SEQ + m * 512;
        float wup[16];
#pragma unroll
        for (int j = 0; j < 16; ++j) wup[j] = w_up[j * 512 + h * 128 + d];
        const float bA = b_al[h * 128 + d];
        float gh[2];
#pragma unroll
        for (int vt = 0; vt < 2; ++vt) gh[vt] = g_head[32 * w + 16 * vt + l15];
        float logD = 0.f;
        f32x4 S[8][2];
#pragma unroll
        for (int mt = 0; mt < 8; ++mt)
#pragma unroll
            for (int vt = 0; vt < 2; ++vt) {
                if (OUT) {
#pragma unroll
                    for (int r = 0; r < 4; ++r) S[mt][vt][r] = GS[((size_t)(bh * 32 + m) * 128 + 16 * mt + 4 * g + r) * 256 + 32 * w + 16 * vt + l15];
                } else S[mt][vt] = (f32x4){0.f, 0.f, 0.f, 0.f};
            }

        for (int ch = 0; ch < 8; ++ch) {
            const int tok0 = tokbase + ch * 64;
            {
                const int idx = tid * 2, c = idx >> 4, j = idx & 15;
                const unsigned v = *(const unsigned*)(P + (size_t)(tok0 + c) * GIN_P + 3072 + j);
                ADs[idx] = bf2f(v & 0xffffu); ADs[idx + 1] = bf2f(v >> 16);
            }
            __syncthreads();
            float cs[16]; float run = 0.f;
#pragma unroll
            for (int i = 0; i < 16; ++i) {
                const float4* ar = (const float4*)(ADs + (16 * rg + i) * 16);
                float z = bA;
#pragma unroll
                for (int q = 0; q < 4; ++q) { const float4 a = ar[q]; z += a.x * wup[4 * q] + a.y * wup[4 * q + 1] + a.z * wup[4 * q + 2] + a.w * wup[4 * q + 3]; }
                run += log_sigmoid(z) * (1.0f / 16.0f);
                cs[i] = run;
            }
            TOT[rg * 128 + d] = run;
            __syncthreads();
            float off = 0.f, blast = 0.f;
#pragma unroll
            for (int r = 0; r < 4; ++r) { const float t = TOT[r * 128 + d]; blast += t; if (r < rg) off += t; }
            {
                unsigned kt[8];
#pragma unroll
                for (int i = 0; i < 16; i += 2) {
                    float kv[2];
#pragma unroll
                    for (int e = 0; e < 2; ++e) {
                        const int c = 16 * rg + i + e;
                        const float bb = cs[i + e] + off;
                        const bf16_t* row = P + (size_t)(tok0 + c) * GIN_P + h * 128 + d;
                        const float kx = bf2f(row[512]);
                        kv[e] = kx * __expf(blast - bb);
                        if (OUT) {
                            const float qx = bf2f(row[0]);
                            QD[c * 136 + d] = f2bf(qx * 0.08838834764831845f * __expf(bb));
                            KD[c * 136 + d] = f2bf(kx * __expf(-bb));
                        }
                    }
                    kt[i >> 1] = pk2(kv[0], kv[1]);
                }
                u32x4* dst = (u32x4*)(KT + d * 72 + 16 * rg);
                dst[0] = (u32x4){kt[0], kt[1], kt[2], kt[3]};
                dst[1] = (u32x4){kt[4], kt[5], kt[6], kt[7]};
            }
            if (rg == 0) { DEC[d] = __expf(blast); logD += blast; }
            {
                const int v = tid & 255, chh = tid >> 8;
                const bf16_t* vp = P + (size_t)(tok0 + 32 * chh) * GIN_P + 1024 + h * 256 + v;
#pragma unroll
                for (int q4 = 0; q4 < 4; ++q4) {
                    unsigned e[8];
#pragma unroll
                    for (int i = 0; i < 8; ++i) e[i] = vp[(size_t)(q4 * 8 + i) * GIN_P];
                    *(u32x4*)(VT + v * 72 + 32 * chh + 8 * q4) = (u32x4){e[0] | (e[1] << 16), e[2] | (e[3] << 16), e[4] | (e[5] << 16), e[6] | (e[7] << 16)};
                }
            }
            __syncthreads();

            f32x4 o[4][2];
            if (OUT) {
#pragma unroll
                for (int t2 = 0; t2 < 2; ++t2) {
                    const int tl = 2 * w + t2, ct = tl >> 2, st = tl & 3;
                    f32x4 acc = (f32x4){0.f, 0.f, 0.f, 0.f};
                    if (st <= ct) {
#pragma unroll
                        for (int kk = 0; kk < 4; ++kk) {
                            const bf16x8 a = *(const bf16x8*)(KD + (16 * st + l15) * 136 + 32 * kk + 8 * g);
                            const bf16x8 bq = *(const bf16x8*)(QD + (16 * ct + l15) * 136 + 32 * kk + 8 * g);
                            acc = mfma16(a, bq, acc);
                        }
#pragma unroll
                        for (int r = 0; r < 4; ++r) if (16 * st + 4 * g + r > 16 * ct + l15) acc[r] = 0.f;
                    }
                    u32x2 pk; pk.x = pk2(acc[0], acc[1]); pk.y = pk2(acc[2], acc[3]);
                    *(u32x2*)(ATT + (16 * ct + l15) * 72 + 16 * st + 4 * g) = pk;
                }
                __syncthreads();
#pragma unroll
                for (int ct = 0; ct < 4; ++ct)
#pragma unroll
                    for (int vt = 0; vt < 2; ++vt) o[ct][vt] = (f32x4){0.f, 0.f, 0.f, 0.f};
#pragma unroll
                for (int kk = 0; kk < 4; ++kk) {
                    bf16x8 sb[2];
#pragma unroll
                    for (int vt = 0; vt < 2; ++vt)
                        sb[vt] = as_bf16x8((u32x4){pk2(S[2 * kk][vt][0], S[2 * kk][vt][1]), pk2(S[2 * kk][vt][2], S[2 * kk][vt][3]),
                                                   pk2(S[2 * kk + 1][vt][0], S[2 * kk + 1][vt][1]), pk2(S[2 * kk + 1][vt][2], S[2 * kk + 1][vt][3])});
#pragma unroll
                    for (int ct = 0; ct < 4; ++ct) {
                        const bf16_t* qr = QD + (16 * ct + l15) * 136 + 32 * kk + 4 * g;
                        const u32x2 lo = *(const u32x2*)qr, hi = *(const u32x2*)(qr + 16);
                        const bf16x8 a = as_bf16x8((u32x4){lo.x, lo.y, hi.x, hi.y});
#pragma unroll
                        for (int vt = 0; vt < 2; ++vt) o[ct][vt] = mfma16(a, sb[vt], o[ct][vt]);
                    }
                }
            }
            bf16x8 bv[2][2];
#pragma unroll
            for (int vt = 0; vt < 2; ++vt)
#pragma unroll
                for (int kk = 0; kk < 2; ++kk) bv[vt][kk] = *(const bf16x8*)(VT + (32 * w + 16 * vt + l15) * 72 + 32 * kk + 8 * g);
            if (OUT) {
#pragma unroll
                for (int ct = 0; ct < 4; ++ct)
#pragma unroll
                    for (int kk = 0; kk < 2; ++kk) {
                        if (32 * kk <= 16 * ct + 15) {
                            const bf16x8 a = *(const bf16x8*)(ATT + (16 * ct + l15) * 72 + 32 * kk + 8 * g);
#pragma unroll
                            for (int vt = 0; vt < 2; ++vt) o[ct][vt] = mfma16(a, bv[vt][kk], o[ct][vt]);
                        }
                    }
            }
#pragma unroll
            for (int mt = 0; mt < 8; ++mt) {
                const f32x4 dv = *(const f32x4*)(DEC + 16 * mt + 4 * g);
#pragma unroll
                for (int vt = 0; vt < 2; ++vt) S[mt][vt] *= dv;
#pragma unroll
                for (int kk = 0; kk < 2; ++kk) {
                    const bf16x8 a = *(const bf16x8*)(KT + (16 * mt + l15) * 72 + 32 * kk + 8 * g);
#pragma unroll
                    for (int vt = 0; vt < 2; ++vt) S[mt][vt] = mfma16(a, bv[vt][kk], S[mt][vt]);
                }
            }
            if (OUT) {
                float ss[4][4];
#pragma unroll
                for (int ct = 0; ct < 4; ++ct)
#pragma unroll
                    for (int r = 0; r < 4; ++r) {
                        float s = o[ct][0][r] * o[ct][0][r] + o[ct][1][r] * o[ct][1][r];
                        s += __shfl_xor(s, 1); s += __shfl_xor(s, 2); s += __shfl_xor(s, 4); s += __shfl_xor(s, 8);
                        ss[ct][r] = s;
                    }
                if (l15 == 0) {
#pragma unroll
                    for (int ct = 0; ct < 4; ++ct)
#pragma unroll
                        for (int r = 0; r < 4; ++r) SSQ[(16 * ct + 4 * g + r) * 8 + w] = ss[ct][r];
                }
                __syncthreads();
#pragma unroll
                for (int ct = 0; ct < 4; ++ct)
#pragma unroll
                    for (int r = 0; r < 4; ++r) {
                        const int c = 16 * ct + 4 * g + r;
                        const float4 s0 = *(const float4*)(SSQ + c * 8), s1 = *(const float4*)(SSQ + c * 8 + 4);
                        const float tot = (s0.x + s0.y) + (s0.z + s0.w) + (s1.x + s1.y) + (s1.z + s1.w);
                        const float rstd = rsqrtf(tot * (1.0f / 256.0f) + 1e-6f);
#pragma unroll
                        for (int vt = 0; vt < 2; ++vt) {
                            const int v = 32 * w + 16 * vt + l15;
                            const float gt = bf2f(P[(size_t)(tok0 + c) * GIN_P + 2048 + h * 256 + v]);
                            const float val = o[ct][vt][r] * rstd * gh[vt] * gt / (1.0f + __expf(-gt));
                            Aout[(size_t)(tok0 + c) * DM + h * 256 + v] = f2bf(val);
                        }
                    }
            }
        }
        if (!OUT) {
#pragma unroll
            for (int mt = 0; mt < 8; ++mt)
#pragma unroll
                for (int vt = 0; vt < 2; ++vt)
#pragma unroll
                    for (int r = 0; r < 4; ++r) GS[((size_t)(bh * 32 + m) * 128 + 16 * mt + 4 * g + r) * 256 + 32 * w + 16 * vt + l15] = S[mt][vt][r];
            if (rg == 0) GD[(bh * 32 + m) * 128 + d] = __expf(logD);
        }
        __syncthreads();
    }
}

__device__ void gla_scan(const Params& p) {
    float* GS = (float*)(p.ws + WS_GS);
    const float* GD = (const float*)(p.ws + WS_GD);
    for (int idx = blockIdx.x * NTH + threadIdx.x; idx < 8 * 32768; idx += gridDim.x * NTH) {
        const int bh = idx >> 15, e = idx & 32767, d = e >> 8;
        float S = 0.f;
        for (int m0 = 0; m0 < 32; m0 += 16) {
            float t[16], dd[16];
#pragma unroll
            for (int m = 0; m < 16; ++m) { t[m] = GS[(size_t)(bh * 32 + m0 + m) * 32768 + e]; dd[m] = GD[(bh * 32 + m0 + m) * 128 + d]; }
#pragma unroll
            for (int m = 0; m < 16; ++m) { GS[(size_t)(bh * 32 + m0 + m) * 32768 + e] = S; S = S * dd[m] + t[m]; }
        }
    }
}

constexpr int RW_TB = 32;
__device__ void rwkv_naive(const Params& p, unsigned char* lds) {
    if (blockIdx.x >= 32) return;
    const int tid = threadIdx.x, lane = tid & 63, w = tid >> 6;
    const int bh = blockIdx.x, b = bh >> 4, h = bh & 15, c = h * 64 + lane;
    float* WD = (float*)lds; float* WI = WD + 4096; float* VEC = WI + 4096; float* YB = VEC + RW_TB * 7 * 64; float* SCR = YB + RW_TB * 64;
    const bf16_t* P = (const bf16_t*)(p.ws + WS_P);
    bf16_t* Aout = (bf16_t*)(p.ws + WS_A);
    const float* mu = p.in[10];
#pragma unroll
    for (int i = 0; i < 8; ++i) { const int idx = tid + NTH * i, j = idx >> 6, l = idx & 63; WD[idx] = p.in[12][j * 1024 + h * 64 + l]; WI[idx] = p.in[14][j * 1024 + h * 64 + l]; }
    const float mu_r = mu[c], mu_k = mu[1024 + c], mu_v = mu[2048 + c], mu_g = mu[3072 + c], mu_wd = mu[4096 + lane], mu_ad = mu[4160 + lane];
    const float w0 = p.in[11][c], a0 = p.in[13][c], k_k = p.in[15][c], k_a = p.in[16][c], r_k = p.in[17][c], ln_w = p.in[18][c], ln_b = p.in[19][c];
    float S[64];
#pragma unroll
    for (int k = 0; k < 64; ++k) S[k] = 0.f;
    __syncthreads();
    float* scr = SCR + w * 128;
    for (int blk = 0; blk < SEQ / RW_TB; ++blk) {
#pragma unroll
        for (int s4 = 0; s4 < 4; ++s4) {
            const int s = 4 * w + s4;
            float* V = VEC + s * 448;
            if (blk > 0) {
                const int t = (blk - 1) * RW_TB + s;
                const float y = YB[s * 64 + lane];
                const float mean = wave_sum(y) * (1.0f / 64.0f);
                const float dd = y - mean;
                const float var = wave_sum(dd * dd) * (1.0f / 64.0f);
                const float yn = dd * rsqrtf(var + 64e-5f) * ln_w + ln_b;
                const float rr = V[lane], k2 = V[128 + lane], vv = V[192 + lane], gg = V[384 + lane];
                const float bonus = wave_sum(rr * k2 * r_k) * vv;
                Aout[(size_t)(b * SEQ + t) * DM + c] = f2bf((yn + bonus) * gg / (1.0f + __expf(-gg)));
            }
            {
                const int t = blk * RW_TB + s;
                const bf16_t* pr = P + (size_t)(b * SEQ + t) * RIN_P;
                float r = bf2f(pr[c]), k = bf2f(pr[1024 + c]), v = bf2f(pr[2048 + c]), gt = bf2f(pr[3072 + c]), wd = bf2f(pr[4096 + lane]), ad = bf2f(pr[4160 + lane]);
                float r0 = 0.f, k0 = 0.f, v0 = 0.f, g0 = 0.f, wd0 = 0.f, ad0 = 0.f;
                if (t > 0) { const bf16_t* pp = pr - RIN_P; r0 = bf2f(pp[c]); k0 = bf2f(pp[1024 + c]); v0 = bf2f(pp[2048 + c]); g0 = bf2f(pp[3072 + c]); wd0 = bf2f(pp[4096 + lane]); ad0 = bf2f(pp[4160 + lane]); }
                r += mu_r * (r0 - r); k += mu_k * (k0 - k); v += mu_v * (v0 - v); gt += mu_g * (g0 - gt); wd += mu_wd * (wd0 - wd); ad += mu_ad * (ad0 - ad);
                scr[lane] = tanhf(wd); scr[64 + lane] = ad;
                float dw = 0.f, da = 0.f;
#pragma unroll
                for (int j4 = 0; j4 < 16; ++j4) {
                    const float4 tw = *(const float4*)(scr + 4 * j4), aa = *(const float4*)(scr + 64 + 4 * j4);
                    dw += tw.x * WD[(4 * j4) * 64 + lane] + tw.y * WD[(4 * j4 + 1) * 64 + lane] + tw.z * WD[(4 * j4 + 2) * 64 + lane] + tw.w * WD[(4 * j4 + 3) * 64 + lane];
                    da += aa.x * WI[(4 * j4) * 64 + lane] + aa.y * WI[(4 * j4 + 1) * 64 + lane] + aa.z * WI[(4 * j4 + 2) * 64 + lane] + aa.w * WI[(4 * j4 + 3) * 64 + lane];
                }
                const float wl = -softplus(-(w0 + dw)) - 0.5f;
                const float wdec = __expf(-__expf(wl));
                const float a = 1.0f / (1.0f + __expf(-(a0 + da)));
                float kk = k * k_k;
                const float n2 = wave_sum(kk * kk);
                kk = kk / fmaxf(sqrtf(n2), 1e-12f);
                const float k2 = k * (1.0f + (a - 1.0f) * k_a);
                V[lane] = r; V[64 + lane] = wdec; V[128 + lane] = k2; V[192 + lane] = v; V[256 + lane] = kk; V[320 + lane] = kk * a; V[384 + lane] = gt;
            }
        }
        __syncthreads();
        if (w == 0) {
            for (int s = 0; s < RW_TB; ++s) {
                const float* V = VEC + s * 448;
                const float vv = V[192 + lane];
                float sa0 = 0.f, sa1 = 0.f, sa2 = 0.f, sa3 = 0.f;
#pragma unroll
                for (int k4 = 0; k4 < 16; ++k4) { const float4 q = *(const float4*)(V + 256 + 4 * k4); sa0 += S[4 * k4] * q.x; sa1 += S[4 * k4 + 1] * q.y; sa2 += S[4 * k4 + 2] * q.z; sa3 += S[4 * k4 + 3] * q.w; }
                const float sa = -((sa0 + sa1) + (sa2 + sa3));
                float y0 = 0.f, y1 = 0.f, y2 = 0.f, y3 = 0.f;
#pragma unroll
                for (int k4 = 0; k4 < 16; ++k4) {
                    const float4 wq = *(const float4*)(V + 64 + 4 * k4), bq = *(const float4*)(V + 320 + 4 * k4), kq = *(const float4*)(V + 128 + 4 * k4), rq = *(const float4*)(V + 4 * k4);
                    S[4 * k4] = S[4 * k4] * wq.x + sa * bq.x + vv * kq.x; y0 += S[4 * k4] * rq.x;
                    S[4 * k4 + 1] = S[4 * k4 + 1] * wq.y + sa * bq.y + vv * kq.y; y1 += S[4 * k4 + 1] * rq.y;
                    S[4 * k4 + 2] = S[4 * k4 + 2] * wq.z + sa * bq.z + vv * kq.z; y2 += S[4 * k4 + 2] * rq.z;
                    S[4 * k4 + 3] = S[4 * k4 + 3] * wq.w + sa * bq.w + vv * kq.w; y3 += S[4 * k4 + 3] * rq.w;
                }
                YB[s * 64 + lane] = (y0 + y1) + (y2 + y3);
            }
        }
        __syncthreads();
    }
#pragma unroll
    for (int s4 = 0; s4 < 4; ++s4) {
        const int s = 4 * w + s4;
        const float* V = VEC + s * 448;
        const int t = (SEQ / RW_TB - 1) * RW_TB + s;
        const float y = YB[s * 64 + lane];
        const float mean = wave_sum(y) * (1.0f / 64.0f);
        const float dd = y - mean;
        const float var = wave_sum(dd * dd) * (1.0f / 64.0f);
        const float yn = dd * rsqrtf(var + 64e-5f) * ln_w + ln_b;
        const float rr = V[lane], k2 = V[128 + lane], vv = V[192 + lane], gg = V[384 + lane];
        const float bonus = wave_sum(rr * k2 * r_k) * vv;
        Aout[(size_t)(b * SEQ + t) * DM + c] = f2bf((yn + bonus) * gg / (1.0f + __expf(-gg)));
    }
}

#ifndef N_LAUNCH_MODE
#define N_LAUNCH_MODE 1
#endif
constexpr int N_PHASES = 11;

__global__ void __launch_bounds__(NTH, 2) fwd_kernel(Params p) {
    extern __shared__ __attribute__((aligned(16))) unsigned char lds[];
    cg::grid_group grid = cg::this_grid();
    const int lo = p.ph_lo, hi = p.ph_hi;
    unsigned char* ws = p.ws;
#define IN(k) (lo <= (k) && (k) < hi)
#define SEAM(k) do { if ((k) + 1 < hi) grid.sync(); } while (0)
    if (IN(0)) {
        prep_weight(p.in[2], GIN, p.in[1], (bf16_t*)(ws + WS_WGIN), GIN_P, (float*)lds);
        prep_weight(p.in[6], DM, nullptr, (bf16_t*)(ws + WS_WGOUT), DM, (float*)lds);
        prep_weight(p.in[9], RIN, p.in[8], (bf16_t*)(ws + WS_WRIN), RIN_P, (float*)lds);
        prep_weight(p.in[20], DM, nullptr, (bf16_t*)(ws + WS_WROUT), DM, (float*)lds);
        phase_norm0(p);
        SEAM(0);
    }
    if (IN(1)) {
        pg8::Gemm g{(const bf16_t*)(ws + WS_A), (const bf16_t*)(ws + WS_WGIN), MTOK, GIN_P, DM}; pg8::StaticOrder S; S.init(MTOK, GIN_P, gridDim.x, blockIdx.x);
        pg8::EpiBf16<0> E{(bf16_t*)(ws + WS_P), GIN_P, nullptr, 0, 0};
        pg8::gemm_phase<pg8::EpiBf16<0>, pg8::StaticOrder>((PG8_LAS unsigned char*)lds, g, S, E);
        SEAM(1);
    }
    if (IN(2)) { gla_pass<false>(p, lds); SEAM(2); }
    if (IN(3)) { gla_scan(p); SEAM(3); }
    if (IN(4)) { gla_pass<true>(p, lds); SEAM(4); }
    if (IN(5)) {
        pg8::Gemm g{(const bf16_t*)(ws + WS_A), (const bf16_t*)(ws + WS_WGOUT), MTOK, DM, DM}; pg8::StaticOrder S; S.init(MTOK, DM, gridDim.x, blockIdx.x);
        pg8::EpiBf16<0> E{(bf16_t*)(ws + WS_Y), DM, nullptr, 0, 0};
        pg8::gemm_phase<pg8::EpiBf16<0>, pg8::StaticOrder>((PG8_LAS unsigned char*)lds, g, S, E);
        SEAM(5);
    }
    if (IN(6)) { phase_norm1(p); SEAM(6); }
    if (IN(7)) {
        pg8::Gemm g{(const bf16_t*)(ws + WS_A), (const bf16_t*)(ws + WS_WRIN), MTOK, RIN_P, DM}; pg8::StaticOrder S; S.init(MTOK, RIN_P, gridDim.x, blockIdx.x);
        pg8::EpiBf16<0> E{(bf16_t*)(ws + WS_P), RIN_P, nullptr, 0, 0};
        pg8::gemm_phase<pg8::EpiBf16<0>, pg8::StaticOrder>((PG8_LAS unsigned char*)lds, g, S, E);
        SEAM(7);
    }
    if (IN(8)) { rwkv_naive(p, lds); SEAM(8); }
    if (IN(9)) {
        pg8::Gemm g{(const bf16_t*)(ws + WS_A), (const bf16_t*)(ws + WS_WROUT), MTOK, DM, DM}; pg8::StaticOrder S; S.init(MTOK, DM, gridDim.x, blockIdx.x);
        pg8::EpiBf16<0> E{(bf16_t*)(ws + WS_Y), DM, nullptr, 0, 0};
        pg8::gemm_phase<pg8::EpiBf16<0>, pg8::StaticOrder>((PG8_LAS unsigned char*)lds, g, S, E);
        SEAM(9);
    }
    if (IN(10)) { phase_final(p); }
#undef IN
#undef SEAM
}

extern "C" void kernel_launch(void* const* d_in, const int* in_sizes, int n_in, void* d_out, int out_size, void* d_ws, size_t ws_size, hipStream_t stream) {
    static int grid = 0;
    if (grid == 0) {
        int dev = 0, cus = 0, per_cu = 0;
        hipGetDevice(&dev);
        hipDeviceGetAttribute(&cus, hipDeviceAttributeMultiprocessorCount, dev);
        hipFuncSetAttribute((const void*)fwd_kernel, hipFuncAttributeMaxDynamicSharedMemorySize, LDS_BYTES);
        hipOccupancyMaxActiveBlocksPerMultiprocessor(&per_cu, (const void*)fwd_kernel, NTH, LDS_BYTES);
        if (per_cu < 1) { fprintf(stderr, "kernel_launch: occupancy query says %d blocks per CU\n", per_cu); per_cu = 1; }
        grid = cus;
        if (n_in != 22 || ws_size < WS_END) fprintf(stderr, "kernel_launch: unexpected n_in %d or workspace %zu < %zu\n", n_in, ws_size, (size_t)WS_END);
        (void)hipGetLastError();
    }
    Params p{};
    for (int i = 0; i < 22; ++i) p.in[i] = (const float*)d_in[i];
    p.out = (float*)d_out; p.ws = (unsigned char*)d_ws;
#if N_LAUNCH_MODE == 1
    p.ph_lo = 0; p.ph_hi = N_PHASES;
    void* args[] = {&p};
    hipError_t e = hipLaunchCooperativeKernel((const void*)fwd_kernel, dim3(grid), dim3(NTH), args, LDS_BYTES, stream);
    if (e != hipSuccess) fprintf(stderr, "cooperative launch failed: %s (grid %d)\n", hipGetErrorString(e), grid);
#else
    for (int k = 0; k < 11; ++k) {
        p.ph_lo = k; p.ph_hi = k + 1;
        hipLaunchKernelGGL(fwd_kernel, dim3(grid), dim3(NTH), LDS_BYTES, stream, p);
    }
#endif
}
```

```cpp
#include <hip/hip_runtime.h>
#include <hip/hip_cooperative_groups.h>
#include <cstdio>
namespace cg = cooperative_groups;
#define N_LAUNCH_MODE 1
namespace pg8 {
#define PG8_LAS __attribute__((address_space(3)))
typedef unsigned short bf16_t;
typedef short bf16x8 __attribute__((ext_vector_type(8)));
typedef float f32x4 __attribute__((ext_vector_type(4)));
typedef unsigned u32x4 __attribute__((ext_vector_type(4)));
constexpr int BM = 256, BK = 64, HALF = 128, HTB = HALF * BK * 2  , STAGE_BYTES = 8 * HTB, NXCD = 8, WGM = 8;

__host__ __device__ __forceinline__ int lds_byte(int r, int c) { const int st = (r >> 4) * 2 + (c >> 5), rr = r & 15, cc = c & 31, ob = rr * 64 + cc * 2; return st * 1024 + (ob ^ (((ob >> 9) & 1) << 5)); }
__host__ __device__ __forceinline__ void stage_rc(int b, int& R, int& C) { const int st = b / 1024, sb = b % 1024, swz = sb ^ (((sb >> 9) & 1) << 5); R = (st >> 1) * 16 + swz / 64; C = (st & 1) * 32 + (swz % 64) / 2; }
__host__ __device__ __forceinline__ int perm32(int rho) { const int n = rho >> 4, i = rho & 15; return 8 * (i >> 2) + 4 * n + (i & 3); }

struct Unit { int pm, pn; };
struct Gemm { const bf16_t* A; const bf16_t* Bt; int M, N, K; };

struct StaticOrder {
    int nM, nN, nwg, G, c;
    __host__ __device__ void init(int M, int N, int G_, int c_) { nM = M / BM; nN = N / BM; nwg = nM * nN; G = G_; c = c_; }
    __host__ __device__ bool next(int i, Unit& u) const {
        const long L = (long)i * G + c; if (L >= nwg) return false;
        int wgid = (int)L; { const int q = nwg / NXCD, r = nwg % NXCD, xcd = wgid % NXCD, off = wgid / NXCD; wgid = (xcd < r ? xcd * (q + 1) : r * (q + 1) + (xcd - r) * q) + off; }
        const int nig = WGM * nN, gid = wgid / nig, fm = gid * WGM, gsz = (nM - fm) < WGM ? (nM - fm) : WGM;
        u.pm = fm + ((wgid % nig) % gsz); u.pn = (wgid % nig) / gsz; return true;
    }
    __device__ __forceinline__ void a_ready(const Unit&) const {}
    __device__ __forceinline__ void done(const Unit&) const {}
};

typedef float cvt_f32x2 __attribute__((ext_vector_type(2)));
typedef __bf16 cvt_bf16x2 __attribute__((ext_vector_type(2)));
__device__ __forceinline__ unsigned cvt_pk_bf16(float lo, float hi) { const cvt_f32x2 v = {lo, hi}; union { cvt_bf16x2 b; unsigned u; } x; x.b = __builtin_convertvector(v, cvt_bf16x2); return x.u; }
typedef float f32x2 __attribute__((ext_vector_type(2)));
struct EpiF32 {
    static constexpr bool PERM = false, AFTER_DRAIN = false;
    float* C; int ldc; const float* bias;
    __device__ __forceinline__ void operator()(const f32x4 (&acc)[2][2][4][2], const Unit& u, int wr, int wc, int fr, int fq) const {
        const int row0 = u.pm * BM + wr * 64 + fr, col0 = u.pn * BM + wc * 32 + 4 * fq;
        f32x4 bv[2][2];
#pragma unroll
        for (int bj = 0; bj < 2; ++bj)
#pragma unroll
            for (int n = 0; n < 2; ++n) bv[bj][n] = bias ? *(const f32x4*)(bias + col0 + bj * HALF + n * 16) : (f32x4){0.f, 0.f, 0.f, 0.f};
#pragma unroll
        for (int ai = 0; ai < 2; ++ai)
#pragma unroll
            for (int m = 0; m < 4; ++m) { float* rowp = C + (size_t)(row0 + ai * HALF + m * 16) * ldc + col0;
#pragma unroll
                for (int bj = 0; bj < 2; ++bj)
#pragma unroll
                    for (int n = 0; n < 2; ++n) *(f32x4*)(rowp + bj * HALF + n * 16) = acc[ai][bj][m][n] + bv[bj][n]; }
    }
};
template <int ACT  > struct EpiBf16 {
    static constexpr bool PERM = true, AFTER_DRAIN = false;
    bf16_t* O; int ldc; const float* bias; int split_cols; size_t split_stride;
    __device__ __forceinline__ void operator()(const f32x4 (&acc)[2][2][4][2], const Unit& u, int wr, int wc, int fr, int fq) const {
        const int row0 = u.pm * BM + wr * 64 + fr; int colt = u.pn * BM; bf16_t* base = O;
        if (split_cols) { const int t = colt / split_cols; base += (size_t)t * split_stride; colt -= t * split_cols; }
        const int col0 = colt + wc * 32 + 8 * fq, bcol0 = u.pn * BM + wc * 32 + 8 * fq;
        f32x4 bv[2][2];
#pragma unroll
        for (int bj = 0; bj < 2; ++bj)
#pragma unroll
            for (int n = 0; n < 2; ++n) bv[bj][n] = bias ? *(const f32x4*)(bias + bcol0 + bj * HALF + 4 * n) : (f32x4){0.f, 0.f, 0.f, 0.f};
#pragma unroll
        for (int ai = 0; ai < 2; ++ai)
#pragma unroll
            for (int m = 0; m < 4; ++m) { bf16_t* rowp = base + (size_t)(row0 + ai * HALF + m * 16) * ldc + col0;
#pragma unroll
                for (int bj = 0; bj < 2; ++bj) { f32x4 v0 = acc[ai][bj][m][0] + bv[bj][0], v1 = acc[ai][bj][m][1] + bv[bj][1];
                    u32x4 w; w.x = cvt_pk_bf16(v0[0], v0[1]); w.y = cvt_pk_bf16(v0[2], v0[3]); w.z = cvt_pk_bf16(v1[0], v1[1]); w.w = cvt_pk_bf16(v1[2], v1[3]);
                    *(u32x4*)(rowp + bj * HALF) = w; } }
    }
};

template <class Epi, class Sched>
__device__ __forceinline__ void gemm_phase(PG8_LAS unsigned char* lds, const Gemm g, const Sched& S, const Epi& E) {
    const int tid = threadIdx.x, wid = __builtin_amdgcn_readfirstlane(tid >> 6), lane = tid & 63, wr = wid >> 2, wc = wid & 3, fr = lane & 15, fq = lane >> 4;
    const int K = g.K, nt = K / BK;
    unsigned voffA[2], voffB[2];
#pragma unroll
    for (int i = 0; i < 2; ++i) { int R, C; stage_rc(tid * 16 + i * 8192, R, C); const int Rb = Epi::PERM ? ((R & ~31) + perm32(R & 31)) : R;
        voffA[i] = (unsigned)(R * K + C) * 2u; voffB[i] = (unsigned)(Rb * K + C) * 2u; }
    const size_t kstep = (size_t)(BK * 2);
    const size_t hstep = (size_t)HALF * K * 2;
    const size_t tstep = 2 * hstep;
    const unsigned ldsw = (unsigned)wid * 1024u;
    const int aoff = lds_byte(wr * 64 + fr, fq * 8), boff = lds_byte(wc * 32 + fr, fq * 8);
#define PG8_SA(b, h) (((b) * 2 + (h)) * HTB)
#define PG8_SB(b, h) ((4 + (b) * 2 + (h)) * HTB)
#define PG8_STAGE(bufoff, gbase, voff) do { _Pragma("unroll") for (int _i = 0; _i < 2; ++_i) \
        __builtin_amdgcn_global_load_lds((const unsigned*)((const char*)(gbase) + (voff)[_i]), (PG8_LAS unsigned*)(lds + (bufoff) + ldsw + _i * 8192), 16, 0, 0); } while (0)
#define PG8_LDA(dst, b, h) do { _Pragma("unroll") for (int m = 0; m < 4; ++m) _Pragma("unroll") for (int k = 0; k < 2; ++k) dst[m][k] = *(const PG8_LAS bf16x8*)(lds + PG8_SA(b, h) + aoff + m * 2048 + k * 1024); } while (0)
#define PG8_LDB(dst, b, h) do { _Pragma("unroll") for (int n = 0; n < 2; ++n) _Pragma("unroll") for (int k = 0; k < 2; ++k) dst[n][k] = *(const PG8_LAS bf16x8*)(lds + PG8_SB(b, h) + boff + n * 2048 + k * 1024); } while (0)
#define PG8_MMA(ai, bj, At, Bt) do { __builtin_amdgcn_s_setprio(1); _Pragma("unroll") for (int m = 0; m < 4; ++m) _Pragma("unroll") for (int n = 0; n < 2; ++n) _Pragma("unroll") for (int k = 0; k < 2; ++k) \
        acc[ai][bj][m][n] = __builtin_amdgcn_mfma_f32_16x16x32_bf16(Bt[n][k], At[m][k], acc[ai][bj][m][n], 0, 0, 0); __builtin_amdgcn_s_setprio(0); } while (0)
#define PG8_WAIT_V(n) asm volatile("s_waitcnt vmcnt(" #n ")" ::: "memory")
#define PG8_WAIT_L(n) asm volatile("s_waitcnt lgkmcnt(" #n ")" ::: "memory")
#define PG8_BAR __builtin_amdgcn_s_barrier()
#define PG8_SCHED __builtin_amdgcn_sched_barrier(0)
    Unit cur, nxt; int ui = 0;
    if (!S.next(0, cur)) return;
    f32x4 acc[2][2][4][2];
#pragma unroll
    for (int a = 0; a < 2; ++a)
#pragma unroll
        for (int b = 0; b < 2; ++b)
#pragma unroll
            for (int m = 0; m < 4; ++m)
#pragma unroll
                for (int n = 0; n < 2; ++n) acc[a][b][m][n] = (f32x4){0.f, 0.f, 0.f, 0.f};
    bf16x8 At[4][2], B0[2][2], B1[2][2];
    const char* cA = (const char*)g.A + (size_t)cur.pm * tstep; const char* cB = (const char*)g.Bt + (size_t)cur.pn * tstep;
    S.a_ready(cur);
    PG8_STAGE(PG8_SB(0, 0), cB, voffB); PG8_STAGE(PG8_SA(0, 0), cA, voffA); PG8_STAGE(PG8_SB(0, 1), cB + hstep, voffB); PG8_STAGE(PG8_SA(0, 1), cA + hstep, voffA);
    if (wr == 1) PG8_BAR;
    PG8_WAIT_V(4); PG8_BAR;
    PG8_STAGE(PG8_SB(1, 0), cB + kstep, voffB); PG8_STAGE(PG8_SA(1, 0), cA + kstep, voffA); PG8_STAGE(PG8_SB(1, 1), cB + hstep + kstep, voffB);
    PG8_WAIT_V(6); PG8_BAR;
    for (;;) {
        const bool has_next = S.next(ui + 1, nxt);
        const char* nA = has_next ? (const char*)g.A + (size_t)nxt.pm * tstep : cA; const char* nB = has_next ? (const char*)g.Bt + (size_t)nxt.pn * tstep : cB;
        for (int t = 0; t < nt; t += 2) {
            const bool last = (t == nt - 2);
            const char* a1 = cA + (size_t)(t + 1) * kstep;
            const char* a2 = last ? nA : cA + (size_t)(t + 2) * kstep; const char* b2 = last ? nB : cB + (size_t)(t + 2) * kstep;
            const char* a3 = a2 + kstep; const char* b3 = b2 + kstep;
            if (last && has_next) S.a_ready(nxt);
            PG8_LDB(B0, 0, 0); PG8_SCHED; PG8_LDA(At, 0, 0); PG8_STAGE(PG8_SA(1, 1), a1 + hstep, voffA);
            PG8_WAIT_L(8); PG8_BAR; PG8_WAIT_L(0); PG8_MMA(0, 0, At, B0); PG8_BAR; PG8_SCHED;
            PG8_LDB(B1, 0, 1); PG8_STAGE(PG8_SB(0, 0), b2, voffB);
            PG8_BAR; PG8_WAIT_L(0); PG8_MMA(0, 1, At, B1); PG8_BAR;
            PG8_LDA(At, 0, 1); PG8_STAGE(PG8_SA(0, 0), a2, voffA);
            PG8_BAR; PG8_WAIT_L(0); PG8_MMA(1, 0, At, B0); PG8_BAR; PG8_SCHED;
            PG8_STAGE(PG8_SB(0, 1), b2 + hstep, voffB);
            PG8_WAIT_V(6); PG8_BAR; PG8_MMA(1, 1, At, B1); PG8_BAR;
            PG8_LDB(B0, 1, 0); PG8_SCHED; PG8_LDA(At, 1, 0); PG8_STAGE(PG8_SA(0, 1), a2 + hstep, voffA);
            PG8_WAIT_L(8); PG8_BAR; PG8_WAIT_L(0); PG8_MMA(0, 0, At, B0); PG8_BAR; PG8_SCHED;
            PG8_LDB(B1, 1, 1); PG8_STAGE(PG8_SB(1, 0), b3, voffB);
            PG8_BAR; PG8_WAIT_L(0); PG8_MMA(0, 1, At, B1); PG8_BAR;
            PG8_LDA(At, 1, 1); PG8_STAGE(PG8_SA(1, 0), a3, voffA);
            PG8_BAR; PG8_WAIT_L(0); PG8_MMA(1, 0, At, B0); PG8_BAR; PG8_SCHED;
            PG8_STAGE(PG8_SB(1, 1), b3 + hstep, voffB);
            PG8_WAIT_V(6); PG8_BAR; PG8_MMA(1, 1, At, B1); PG8_BAR;
        }
        if constexpr (!Epi::AFTER_DRAIN) { E(acc, cur, wr, wc, fr, fq); S.done(cur); }
        if (!has_next) break;
#pragma unroll
        for (int a = 0; a < 2; ++a)
#pragma unroll
            for (int b = 0; b < 2; ++b)
#pragma unroll
                for (int m = 0; m < 4; ++m)
#pragma unroll
                    for (int n = 0; n < 2; ++n) acc[a][b][m][n] = (f32x4){0.f, 0.f, 0.f, 0.f};
        cur = nxt; cA = nA; cB = nB; ++ui;
    }
    PG8_WAIT_V(0);
    if (wr == 0) PG8_BAR;
    PG8_BAR;
    if constexpr (Epi::AFTER_DRAIN) { E.fused(acc, cur, wr, wc, fr, fq, lds, wid, lane); S.done(cur); }
#undef PG8_SA
#undef PG8_SB
#undef PG8_STAGE
#undef PG8_LDA
#undef PG8_LDB
#undef PG8_MMA
#undef PG8_WAIT_V
#undef PG8_WAIT_L
#undef PG8_BAR
#undef PG8_SCHED
}
}


typedef unsigned short bf16_t;
typedef short bf16x8 __attribute__((ext_vector_type(8)));
typedef float f32x4 __attribute__((ext_vector_type(4)));
typedef unsigned u32x4 __attribute__((ext_vector_type(4)));
typedef unsigned u32x2 __attribute__((ext_vector_type(2)));

constexpr int MTOK = 32768, DM = 1024, SEQ = 16384, NTH = 512;
constexpr int GIN = 3088, GIN_P = 3328, RIN = 4224, RIN_P = 4352;
constexpr int LDS_BYTES = 131072;

constexpr size_t WS_WGIN  = 0;
constexpr size_t WS_WGOUT = WS_WGIN  + (size_t)GIN_P * DM * 2;
constexpr size_t WS_WRIN  = WS_WGOUT + (size_t)DM * DM * 2;
constexpr size_t WS_WROUT = WS_WRIN  + (size_t)RIN_P * DM * 2;
constexpr size_t WS_WDUT  = WS_WROUT + (size_t)DM * DM * 2;
constexpr size_t WS_WIUT  = WS_WDUT  + (size_t)DM * 64 * 2;
constexpr size_t WS_A     = WS_WIUT  + (size_t)DM * 64 * 2;
constexpr size_t WS_Y     = WS_A     + (size_t)MTOK * DM * 2;
constexpr size_t WS_GS    = WS_Y     + (size_t)MTOK * DM * 2;
constexpr size_t WS_GD    = WS_GS    + (size_t)8 * 32 * 128 * 256 * 4;
constexpr size_t WS_P     = WS_GD    + (size_t)8 * 32 * 128 * 4;
constexpr size_t WS_END   = WS_P     + (size_t)MTOK * RIN_P * 2;

struct Params { const float* in[22]; float* out; unsigned char* ws; int ph_lo, ph_hi; };

__device__ __forceinline__ float bf2f(unsigned b) { return __uint_as_float(b << 16); }
__device__ __forceinline__ bf16_t f2bf(float f) { unsigned u = __float_as_uint(f); u += 0x7FFFu + ((u >> 16) & 1u); return (bf16_t)(u >> 16); }
__device__ __forceinline__ unsigned pk2(float lo, float hi) { return pg8::cvt_pk_bf16(lo, hi); }
__device__ __forceinline__ float wave_sum(float x) {
#pragma unroll
    for (int off = 32; off >= 1; off >>= 1) x += __shfl_xor(x, off);
    return x;
}
__device__ __forceinline__ f32x4 mfma16(bf16x8 a, bf16x8 b, f32x4 c) { return __builtin_amdgcn_mfma_f32_16x16x32_bf16(a, b, c, 0, 0, 0); }
__device__ __forceinline__ bf16x8 as_bf16x8(u32x4 v) { union { u32x4 u; bf16x8 b; } x; x.u = v; return x.b; }
__device__ __forceinline__ float log_sigmoid(float z) { return fminf(z, 0.f) - log1pf(__expf(-fabsf(z))); }
__device__ __forceinline__ float softplus(float z) { return fmaxf(z, 0.f) + log1pf(__expf(-fabsf(z))); }

__device__ void prep_weight(const float* __restrict__ W, int N, const float* __restrict__ gain, bf16_t* __restrict__ Wt, int NP, float* tile) {
    const int tid = threadIdx.x;
    const int nu = (NP / 64) * 16;
    for (int u = blockIdx.x; u < nu; u += gridDim.x) {
        const int n0 = (u >> 4) * 64, k0 = (u & 15) * 64;
        {
            const int j = tid & 63, i0 = tid >> 6;
#pragma unroll
            for (int r = 0; r < 8; ++r) {
                const int i = i0 + 8 * r, k = k0 + i, n = n0 + j;
                float v = 0.f;
                if (n < N) { v = W[(size_t)k * N + n]; if (gain) v *= gain[k]; }
                tile[i * 65 + j] = v;
            }
        }
        __syncthreads();
        {
            const int i = tid & 63, j0 = tid >> 6;
#pragma unroll
            for (int r = 0; r < 8; ++r) {
                const int j = j0 + 8 * r;
                Wt[(size_t)(n0 + j) * DM + k0 + i] = f2bf(tile[i * 65 + j]);
            }
        }
        __syncthreads();
    }
}

__device__ void prep_lowrank(const float* __restrict__ src, bf16_t* __restrict__ dst) {
    for (int idx = blockIdx.x * NTH + threadIdx.x; idx < 65536; idx += gridDim.x * NTH) dst[idx] = f2bf(src[(idx & 63) * 1024 + (idx >> 6)]);
}

struct EpiBf16Bnd {
    static constexpr bool PERM = true, AFTER_DRAIN = false;
    bf16_t* O; int ldc; bf16_t* bnd;
    __device__ __forceinline__ void operator()(const f32x4 (&acc)[2][2][4][2], const pg8::Unit& u, int wr, int wc, int fr, int fq) const {
        const int row0 = u.pm * pg8::BM + wr * 64 + fr, col0 = u.pn * pg8::BM + wc * 32 + 8 * fq;
#pragma unroll
        for (int ai = 0; ai < 2; ++ai)
#pragma unroll
            for (int m = 0; m < 4; ++m) {
                const int row = row0 + ai * pg8::HALF + m * 16;
                bf16_t* rowp = O + (size_t)row * ldc + col0;
#pragma unroll
                for (int bj = 0; bj < 2; ++bj) {
                    const f32x4 v0 = acc[ai][bj][m][0], v1 = acc[ai][bj][m][1];
                    u32x4 wv; wv.x = pk2(v0[0], v0[1]); wv.y = pk2(v0[2], v0[3]); wv.z = pk2(v1[0], v1[1]); wv.w = pk2(v1[2], v1[3]);
                    *(u32x4*)(rowp + bj * pg8::HALF) = wv;
                    if (m == 3 && fr == 15) *(u32x4*)(bnd + (size_t)((row >> 6) + 1) * ldc + col0 + bj * pg8::HALF) = wv;
                }
            }
    }
};

__device__ void phase_norm0(const Params& p) {
    const int tid = threadIdx.x, lane = tid & 63, w = tid >> 6;
    const float* x = p.in[0];
    bf16_t* A = (bf16_t*)(p.ws + WS_A);
    for (int row = blockIdx.x * 8 + w; row < MTOK; row += gridDim.x * 8) {
        const float4* xr = (const float4*)(x + (size_t)row * DM);
        float4 v[4];
#pragma unroll
        for (int i = 0; i < 4; ++i) v[i] = xr[lane + 64 * i];
        float ss = 0.f;
#pragma unroll
        for (int i = 0; i < 4; ++i) ss += v[i].x * v[i].x + v[i].y * v[i].y + v[i].z * v[i].z + v[i].w * v[i].w;
        ss = wave_sum(ss);
        const float rstd = rsqrtf(ss * (1.0f / DM) + 1e-6f);
#pragma unroll
        for (int i = 0; i < 4; ++i) {
            u32x2 o; o.x = pk2(v[i].x * rstd, v[i].y * rstd); o.y = pk2(v[i].z * rstd, v[i].w * rstd);
            *(u32x2*)(A + (size_t)row * DM + 4 * (lane + 64 * i)) = o;
        }
    }
}

__device__ void phase_norm1(const Params& p) {
    const int tid = threadIdx.x, lane = tid & 63, w = tid >> 6;
    const float* x = p.in[0];
    const float* gpost = p.in[7];
    const bf16_t* Y = (const bf16_t*)(p.ws + WS_Y);
    bf16_t* A = (bf16_t*)(p.ws + WS_A);
    float4 gp[4];
#pragma unroll
    for (int i = 0; i < 4; ++i) gp[i] = ((const float4*)gpost)[lane + 64 * i];
    for (int row = blockIdx.x * 8 + w; row < MTOK; row += gridDim.x * 8) {
        const float4* xr = (const float4*)(x + (size_t)row * DM);
        float4 v[4]; u32x2 yv[4];
#pragma unroll
        for (int i = 0; i < 4; ++i) { v[i] = xr[lane + 64 * i]; yv[i] = *(const u32x2*)(Y + (size_t)row * DM + 4 * (lane + 64 * i)); }
        float4 y[4];
        float ss = 0.f;
#pragma unroll
        for (int i = 0; i < 4; ++i) {
            y[i].x = bf2f(yv[i].x & 0xffffu); y[i].y = bf2f(yv[i].x >> 16); y[i].z = bf2f(yv[i].y & 0xffffu); y[i].w = bf2f(yv[i].y >> 16);
            ss += y[i].x * y[i].x + y[i].y * y[i].y + y[i].z * y[i].z + y[i].w * y[i].w;
        }
        ss = wave_sum(ss);
        const float rstdy = rsqrtf(ss * (1.0f / DM) + 1e-6f);
        float s1 = 0.f;
#pragma unroll
        for (int i = 0; i < 4; ++i) {
            v[i].x += y[i].x * rstdy * gp[i].x; v[i].y += y[i].y * rstdy * gp[i].y; v[i].z += y[i].z * rstdy * gp[i].z; v[i].w += y[i].w * rstdy * gp[i].w;
            s1 += v[i].x * v[i].x + v[i].y * v[i].y + v[i].z * v[i].z + v[i].w * v[i].w;
            ((float4*)(p.out + (size_t)row * DM))[lane + 64 * i] = v[i];
        }
        s1 = wave_sum(s1);
        const float rstd = rsqrtf(s1 * (1.0f / DM) + 1e-6f);
#pragma unroll
        for (int i = 0; i < 4; ++i) {
            u32x2 o; o.x = pk2(v[i].x * rstd, v[i].y * rstd); o.y = pk2(v[i].z * rstd, v[i].w * rstd);
            *(u32x2*)(A + (size_t)row * DM + 4 * (lane + 64 * i)) = o;
        }
    }
}

__device__ void phase_final(const Params& p) {
    const int tid = threadIdx.x, lane = tid & 63, w = tid >> 6;
    const float* gpost = p.in[21];
    const bf16_t* Y = (const bf16_t*)(p.ws + WS_Y);
    float4 gp[4];
#pragma unroll
    for (int i = 0; i < 4; ++i) gp[i] = ((const float4*)gpost)[lane + 64 * i];
    for (int row = blockIdx.x * 8 + w; row < MTOK; row += gridDim.x * 8) {
        float4* xr = (float4*)(p.out + (size_t)row * DM);
        float4 v[4]; u32x2 yv[4];
#pragma unroll
        for (int i = 0; i < 4; ++i) { v[i] = xr[lane + 64 * i]; yv[i] = *(const u32x2*)(Y + (size_t)row * DM + 4 * (lane + 64 * i)); }
        float4 y[4];
        float ss = 0.f;
#pragma unroll
        for (int i = 0; i < 4; ++i) {
            y[i].x = bf2f(yv[i].x & 0xffffu); y[i].y = bf2f(yv[i].x >> 16); y[i].z = bf2f(yv[i].y & 0xffffu); y[i].w = bf2f(yv[i].y >> 16);
            ss += y[i].x * y[i].x + y[i].y * y[i].y + y[i].z * y[i].z + y[i].w * y[i].w;
        }
        ss = wave_sum(ss);
        const float rstdy = rsqrtf(ss * (1.0f / DM) + 1e-6f);
#pragma unroll
        for (int i = 0; i < 4; ++i) {
            v[i].x += y[i].x * rstdy * gp[i].x; v[i].y += y[i].y * rstdy * gp[i].y; v[i].z += y[i].z * rstdy * gp[i].z; v[i].w += y[i].w * rstdy * gp[i].w;
            xr[lane + 64 * i] = v[i];
        }
    }
}

constexpr int L_AD = 0, L_TOT = 4096, L_DEC = 6144, L_SSQ = 6656, L_QD = 8704, L_KD = L_QD + 64 * 136 * 2, L_KT = L_KD + 64 * 136 * 2, L_VT = L_KT + 128 * 72 * 2,
              L_ATT = L_VT + 256 * 72 * 2, L_GLA_END = L_ATT + 64 * 72 * 2;
static_assert(L_GLA_END <= LDS_BYTES, "GLA LDS");

template <bool OUT>
__device__ void gla_pass(const Params& p, unsigned char* lds) {
    const int tid = threadIdx.x, lane = tid & 63, w = tid >> 6, l15 = lane & 15, g = lane >> 4;
    const bf16_t* P = (const bf16_t*)(p.ws + WS_P);
    float* GS = (float*)(p.ws + WS_GS);
    float* GD = (float*)(p.ws + WS_GD);
    bf16_t* Aout = (bf16_t*)(p.ws + WS_A);
    float* ADs = (float*)(lds + L_AD); float* TOT = (float*)(lds + L_TOT); float* DEC = (float*)(lds + L_DEC); float* SSQ = (float*)(lds + L_SSQ);
    bf16_t* QD = (bf16_t*)(lds + L_QD); bf16_t* KD = (bf16_t*)(lds + L_KD); bf16_t* KT = (bf16_t*)(lds + L_KT); bf16_t* VT = (bf16_t*)(lds + L_VT); bf16_t* ATT = (bf16_t*)(lds + L_ATT);
    const float* w_up = p.in[3]; const float* b_al = p.in[4]; const float* g_head = p.in[5];
    const int d = tid & 127, rg = tid >> 7;

    for (int unit = blockIdx.x; unit < 256; unit += gridDim.x) {
        const int bh = unit >> 5, m = unit & 31, b = bh >> 2, h = bh & 3;
        const int tokbase = b * SEQ + m * 512;
        float wup[16];
#pragma unroll
        for (int j = 0; j < 16; ++j) wup[j] = w_up[j * 512 + h * 128 + d];
        const float bA = b_al[h * 128 + d];
        float gh[2];
#pragma unroll
        for (int vt = 0; vt < 2; ++vt) gh[vt] = g_head[32 * w + 16 * vt + l15];
        float logD = 0.f;
        f32x4 S[8][2];
#pragma unroll
        for (int mt = 0; mt < 8; ++mt)
#pragma unroll
            for (int vt = 0; vt < 2; ++vt) {
                if (OUT) {
#pragma unroll
                    for (int r = 0; r < 4; ++r) S[mt][vt][r] = GS[((size_t)(bh * 32 + m) * 128 + 16 * mt + 4 * g + r) * 256 + 32 * w + 16 * vt + l15];
                } else S[mt][vt] = (f32x4){0.f, 0.f, 0.f, 0.f};
            }

        for (int ch = 0; ch < 8; ++ch) {
            const int tok0 = tokbase + ch * 64;
            {
                const int idx = tid * 2, c = idx >> 4, j = idx & 15;
                const unsigned v = *(const unsigned*)(P + (size_t)(tok0 + c) * GIN_P + 3072 + j);
                ADs[idx] = bf2f(v & 0xffffu); ADs[idx + 1] = bf2f(v >> 16);
            }
            __syncthreads();
            float cs[16]; float run = 0.f;
#pragma unroll
            for (int i = 0; i < 16; ++i) {
                const float4* ar = (const float4*)(ADs + (16 * rg + i) * 16);
                float z = bA;
#pragma unroll
                for (int q = 0; q < 4; ++q) { const float4 a = ar[q]; z += a.x * wup[4 * q] + a.y * wup[4 * q + 1] + a.z * wup[4 * q + 2] + a.w * wup[4 * q + 3]; }
                run += log_sigmoid(z) * (1.0f / 16.0f);
                cs[i] = run;
            }
            TOT[rg * 128 + d] = run;
            __syncthreads();
            float off = 0.f, blast = 0.f;
#pragma unroll
            for (int r = 0; r < 4; ++r) { const float t = TOT[r * 128 + d]; blast += t; if (r < rg) off += t; }
            {
                unsigned kt[8];
#pragma unroll
                for (int i = 0; i < 16; i += 2) {
                    float kv[2];
#pragma unroll
                    for (int e = 0; e < 2; ++e) {
                        const int c = 16 * rg + i + e;
                        const float bb = cs[i + e] + off;
                        const bf16_t* row = P + (size_t)(tok0 + c) * GIN_P + h * 128 + d;
                        const float kx = bf2f(row[512]);
                        kv[e] = kx * __expf(blast - bb);
                        if (OUT) {
                            const float qx = bf2f(row[0]);
                            QD[c * 136 + d] = f2bf(qx * 0.08838834764831845f * __expf(bb));
                            KD[c * 136 + d] = f2bf(kx * __expf(-bb));
                        }
                    }
                    kt[i >> 1] = pk2(kv[0], kv[1]);
                }
                u32x4* dst = (u32x4*)(KT + d * 72 + 16 * rg);
                dst[0] = (u32x4){kt[0], kt[1], kt[2], kt[3]};
                dst[1] = (u32x4){kt[4], kt[5], kt[6], kt[7]};
            }
            if (rg == 0) { DEC[d] = __expf(blast); logD += blast; }
            {
                const int v = tid & 255, chh = tid >> 8;
                const bf16_t* vp = P + (size_t)(tok0 + 32 * chh) * GIN_P + 1024 + h * 256 + v;
#pragma unroll
                for (int q4 = 0; q4 < 4; ++q4) {
                    unsigned e[8];
#pragma unroll
                    for (int i = 0; i < 8; ++i) e[i] = vp[(size_t)(q4 * 8 + i) * GIN_P];
                    *(u32x4*)(VT + v * 72 + 32 * chh + 8 * q4) = (u32x4){e[0] | (e[1] << 16), e[2] | (e[3] << 16), e[4] | (e[5] << 16), e[6] | (e[7] << 16)};
                }
            }
            __syncthreads();

            f32x4 o[4][2];
            if (OUT) {
#pragma unroll
                for (int t2 = 0; t2 < 2; ++t2) {
                    const int tl = 2 * w + t2, ct = tl >> 2, st = tl & 3;
                    f32x4 acc = (f32x4){0.f, 0.f, 0.f, 0.f};
                    if (st <= ct) {
#pragma unroll
                        for (int kk = 0; kk < 4; ++kk) {
                            const bf16x8 a = *(const bf16x8*)(KD + (16 * st + l15) * 136 + 32 * kk + 8 * g);
                            const bf16x8 bq = *(const bf16x8*)(QD + (16 * ct + l15) * 136 + 32 * kk + 8 * g);
                            acc = mfma16(a, bq, acc);
                        }
#pragma unroll
                        for (int r = 0; r < 4; ++r) if (16 * st + 4 * g + r > 16 * ct + l15) acc[r] = 0.f;
                    }
                    u32x2 pk; pk.x = pk2(acc[0], acc[1]); pk.y = pk2(acc[2], acc[3]);
                    *(u32x2*)(ATT + (16 * ct + l15) * 72 + 16 * st + 4 * g) = pk;
                }
                __syncthreads();
#pragma unroll
                for (int ct = 0; ct < 4; ++ct)
#pragma unroll
                    for (int vt = 0; vt < 2; ++vt) o[ct][vt] = (f32x4){0.f, 0.f, 0.f, 0.f};
#pragma unroll
                for (int kk = 0; kk < 4; ++kk) {
                    bf16x8 sb[2];
#pragma unroll
                    for (int vt = 0; vt < 2; ++vt)
                        sb[vt] = as_bf16x8((u32x4){pk2(S[2 * kk][vt][0], S[2 * kk][vt][1]), pk2(S[2 * kk][vt][2], S[2 * kk][vt][3]),
                                                   pk2(S[2 * kk + 1][vt][0], S[2 * kk + 1][vt][1]), pk2(S[2 * kk + 1][vt][2], S[2 * kk + 1][vt][3])});
#pragma unroll
                    for (int ct = 0; ct < 4; ++ct) {
                        const bf16_t* qr = QD + (16 * ct + l15) * 136 + 32 * kk + 4 * g;
                        const u32x2 lo = *(const u32x2*)qr, hi = *(const u32x2*)(qr + 16);
                        const bf16x8 a = as_bf16x8((u32x4){lo.x, lo.y, hi.x, hi.y});
#pragma unroll
                        for (int vt = 0; vt < 2; ++vt) o[ct][vt] = mfma16(a, sb[vt], o[ct][vt]);
                    }
                }
            }
            bf16x8 bv[2][2];
#pragma unroll
            for (int vt = 0; vt < 2; ++vt)
#pragma unroll
                for (int kk = 0; kk < 2; ++kk) bv[vt][kk] = *(const bf16x8*)(VT + (32 * w + 16 * vt + l15) * 72 + 32 * kk + 8 * g);
            if (OUT) {
#pragma unroll
                for (int ct = 0; ct < 4; ++ct)
#pragma unroll
                    for (int kk = 0; kk < 2; ++kk) {
                        if (32 * kk <= 16 * ct + 15) {
                            const bf16x8 a = *(const bf16x8*)(ATT + (16 * ct + l15) * 72 + 32 * kk + 8 * g);
#pragma unroll
                            for (int vt = 0; vt < 2; ++vt) o[ct][vt] = mfma16(a, bv[vt][kk], o[ct][vt]);
                        }
                    }
            }
#pragma unroll
            for (int mt = 0; mt < 8; ++mt) {
                const f32x4 dv = *(const f32x4*)(DEC + 16 * mt + 4 * g);
#pragma unroll
                for (int vt = 0; vt < 2; ++vt) S[mt][vt] *= dv;
#pragma unroll
                for (int kk = 0; kk < 2; ++kk) {
                    const bf16x8 a = *(const bf16x8*)(KT + (16 * mt + l15) * 72 + 32 * kk + 8 * g);
#pragma unroll
                    for (int vt = 0; vt < 2; ++vt) S[mt][vt] = mfma16(a, bv[vt][kk], S[mt][vt]);
                }
            }
            if (OUT) {
                float ss[4][4];
#pragma unroll
                for (int ct = 0; ct < 4; ++ct)
#pragma unroll
                    for (int r = 0; r < 4; ++r) {
                        float s = o[ct][0][r] * o[ct][0][r] + o[ct][1][r] * o[ct][1][r];
                        s += __shfl_xor(s, 1); s += __shfl_xor(s, 2); s += __shfl_xor(s, 4); s += __shfl_xor(s, 8);
                        ss[ct][r] = s;
                    }
                if (l15 == 0) {
#pragma unroll
                    for (int ct = 0; ct < 4; ++ct)
#pragma unroll
                        for (int r = 0; r < 4; ++r) SSQ[(16 * ct + 4 * g + r) * 8 + w] = ss[ct][r];
                }
                __syncthreads();
#pragma unroll
                for (int ct = 0; ct < 4; ++ct)
#pragma unroll
                    for (int r = 0; r < 4; ++r) {
                        const int c = 16 * ct + 4 * g + r;
                        const float4 s0 = *(const float4*)(SSQ + c * 8), s1 = *(const float4*)(SSQ + c * 8 + 4);
                        const float tot = (s0.x + s0.y) + (s0.z + s0.w) + (s1.x + s1.y) + (s1.z + s1.w);
                        const float rstd = rsqrtf(tot * (1.0f / 256.0f) + 1e-6f);
#pragma unroll
                        for (int vt = 0; vt < 2; ++vt) {
                            const int v = 32 * w + 16 * vt + l15;
                            const float gt = bf2f(P[(size_t)(tok0 + c) * GIN_P + 2048 + h * 256 + v]);
                            const float val = o[ct][vt][r] * rstd * gh[vt] * gt / (1.0f + __expf(-gt));
                            Aout[(size_t)(tok0 + c) * DM + h * 256 + v] = f2bf(val);
                        }
                    }
            }
        }
        if (!OUT) {
#pragma unroll
            for (int mt = 0; mt < 8; ++mt)
#pragma unroll
                for (int vt = 0; vt < 2; ++vt)
#pragma unroll
                    for (int r = 0; r < 4; ++r) GS[((size_t)(bh * 32 + m) * 128 + 16 * mt + 4 * g + r) * 256 + 32 * w + 16 * vt + l15] = S[mt][vt][r];
            if (rg == 0) GD[(bh * 32 + m) * 128 + d] = __expf(logD);
        }
        __syncthreads();
    }
}

__device__ void gla_scan(const Params& p) {
    float* GS = (float*)(p.ws + WS_GS);
    const float* GD = (const float*)(p.ws + WS_GD);
    for (int idx = blockIdx.x * NTH + threadIdx.x; idx < 8 * 32768; idx += gridDim.x * NTH) {
        const int bh = idx >> 15, e = idx & 32767, d = e >> 8;
        float S = 0.f;
        for (int m0 = 0; m0 < 32; m0 += 16) {
            float t[16], dd[16];
#pragma unroll
            for (int m = 0; m < 16; ++m) { t[m] = GS[(size_t)(bh * 32 + m0 + m) * 32768 + e]; dd[m] = GD[(bh * 32 + m0 + m) * 128 + d]; }
#pragma unroll
            for (int m = 0; m < 16; ++m) { GS[(size_t)(bh * 32 + m0 + m) * 32768 + e] = S; S = S * dd[m] + t[m]; }
        }
    }
}

constexpr int PP = RIN_P;
constexpr size_t WS_RK  = WS_GS;
constexpr size_t WS_BND = WS_GS + (size_t)MTOK * 16 * 4;
static_assert(WS_BND + (size_t)513 * PP * 2 <= WS_GD, "RWKV side buffers must fit the GLA state region");
constexpr int IMG = 64 * 72 * 2;
constexpr int R_ALB = 0, R_BH = IMG, R_KH = 2 * IMG, R_RB = 3 * IMG, R_BTT = 4 * IMG, R_KTT = 5 * IMG, R_VT = 6 * IMG, R_AAB = 7 * IMG, R_AAK = 8 * IMG, R_ARB = 9 * IMG, R_ARK = 10 * IMG,
              R_DWT = R_AAB, R_DAT = R_AAB + 64 * 68 * 4, R_BT = 11 * IMG, R_TW = R_BT, R_ADI = R_BT + IMG, R_TD = R_BT + 2 * IMG, R_TD16 = R_TD + 4096, R_CS = R_TD16 + 2048, R_GC = R_CS + 2048,
              R_END = R_GC + 256;
static_assert(R_DAT + 64 * 68 * 4 <= R_BT && R_END <= LDS_BYTES, "R1 LDS");

__device__ __forceinline__ bf16x8 ldfrag(const bf16_t* img, int row, int koff) { return *(const bf16x8*)(img + row * 72 + koff); }
__device__ __forceinline__ u32x2 pk4(f32x4 v) { u32x2 r; r.x = pk2(v[0], v[1]); r.y = pk2(v[2], v[3]); return r; }
__device__ __forceinline__ f32x4 unpk4(u32x2 v) { return (f32x4){bf2f(v.x & 0xffffu), bf2f(v.x >> 16), bf2f(v.y & 0xffffu), bf2f(v.y >> 16)}; }

__device__ void rwkv_r1(const Params& p, unsigned char* lds) {
    const int tid = threadIdx.x, lane = tid & 63, w = tid >> 6, l15 = lane & 15, g = lane >> 4;
    bf16_t* P = (bf16_t*)(p.ws + WS_P);
    bf16_t* Abuf = (bf16_t*)(p.ws + WS_A);
    bf16_t* Ybuf = (bf16_t*)(p.ws + WS_Y);
    float* RK = (float*)(p.ws + WS_RK);
    const bf16_t* BND = (const bf16_t*)(p.ws + WS_BND);
    const bf16_t* WduT = (const bf16_t*)(p.ws + WS_WDUT);
    const bf16_t* WiuT = (const bf16_t*)(p.ws + WS_WIUT);
    bf16_t* ALB = (bf16_t*)(lds + R_ALB); bf16_t* BH = (bf16_t*)(lds + R_BH); bf16_t* KH = (bf16_t*)(lds + R_KH); bf16_t* RB = (bf16_t*)(lds + R_RB);
    bf16_t* BTT = (bf16_t*)(lds + R_BTT); bf16_t* KTT = (bf16_t*)(lds + R_KTT); bf16_t* VT = (bf16_t*)(lds + R_VT);
    bf16_t* AAB = (bf16_t*)(lds + R_AAB); bf16_t* AAK = (bf16_t*)(lds + R_AAK); bf16_t* ARB = (bf16_t*)(lds + R_ARB); bf16_t* ARK = (bf16_t*)(lds + R_ARK);
    float* DWT = (float*)(lds + R_DWT); float* DAT = (float*)(lds + R_DAT);
    bf16_t* BT = (bf16_t*)(lds + R_BT); bf16_t* TW = (bf16_t*)(lds + R_TW); bf16_t* ADI = (bf16_t*)(lds + R_ADI);
    float* TD = (float*)(lds + R_TD); bf16_t* TD16 = (bf16_t*)(lds + R_TD16); float* CS = (float*)(lds + R_CS); float* GCs = (float*)(lds + R_GC);
    const float* mu = p.in[10];
    const int c = lane, tg = w;
    const float mu_wd = mu[4096 + c], mu_ad = mu[4160 + c];

    for (int unit = blockIdx.x; unit < 8192; unit += gridDim.x) {
        const int bn = unit >> 4, h = unit & 15, n = bn & 255;
        const size_t R0 = (size_t)bn * 64;
        const int ch = h * 64 + c;
        const float mu_r = mu[ch], mu_k = mu[1024 + ch], mu_v = mu[2048 + ch];
        const float w0 = p.in[11][ch], a0 = p.in[13][ch], k_k = p.in[15][ch], k_a = p.in[16][ch], r_k = p.in[17][ch];
        float rv[8], kv[8], vv[8];
        {
            float rr[9], kr[9], vr[9], wr_[9], ar[9];
#pragma unroll
            for (int i = 0; i < 9; ++i) {
                const int t = 8 * tg + i - 1;
                const bf16_t* row = (t >= 0) ? (P + (R0 + t) * PP) : (BND + (size_t)bn * PP);
                const bool z = (t < 0 && n == 0);
                rr[i] = z ? 0.f : bf2f(row[ch]); kr[i] = z ? 0.f : bf2f(row[1024 + ch]); vr[i] = z ? 0.f : bf2f(row[2048 + ch]);
                wr_[i] = z ? 0.f : bf2f(row[4096 + c]); ar[i] = z ? 0.f : bf2f(row[4160 + c]);
            }
#pragma unroll
            for (int i = 0; i < 8; ++i) {
                const int t = 8 * tg + i;
                rv[i] = rr[i + 1] + mu_r * (rr[i] - rr[i + 1]); kv[i] = kr[i + 1] + mu_k * (kr[i] - kr[i + 1]); vv[i] = vr[i + 1] + mu_v * (vr[i] - vr[i + 1]);
                const float wd = wr_[i + 1] + mu_wd * (wr_[i] - wr_[i + 1]), ad = ar[i + 1] + mu_ad * (ar[i] - ar[i + 1]);
                TW[t * 72 + c] = f2bf(tanhf(wd)); ADI[t * 72 + c] = f2bf(ad);
            }
        }
        __syncthreads();
        {
            const int tt = w & 3;
#pragma unroll
            for (int q = 0; q < 2; ++q) {
                const int ct = 2 * (w >> 2) + q;
                f32x4 aw = (f32x4){0.f, 0.f, 0.f, 0.f}, aa = aw;
#pragma unroll
                for (int kk = 0; kk < 2; ++kk) {
                    const bf16x8 fa = ldfrag(TW, 16 * tt + l15, 32 * kk + 8 * g), fb = ldfrag(ADI, 16 * tt + l15, 32 * kk + 8 * g);
                    const bf16x8 wa = *(const bf16x8*)(WduT + (size_t)(h * 64 + 16 * ct + l15) * 64 + 32 * kk + 8 * g);
                    const bf16x8 wb = *(const bf16x8*)(WiuT + (size_t)(h * 64 + 16 * ct + l15) * 64 + 32 * kk + 8 * g);
                    aw = mfma16(fa, wa, aw); aa = mfma16(fb, wb, aa);
                }
                *(f32x4*)(DWT + (16 * ct + l15) * 68 + 16 * tt + 4 * g) = aw;
                *(f32x4*)(DAT + (16 * ct + l15) * 68 + 16 * tt + 4 * g) = aa;
            }
        }
        __syncthreads();
        float lw[8], av[8], kkv[8], k2v[8];
        {
            const f32x4 d0 = *(const f32x4*)(DWT + c * 68 + 8 * tg), d1 = *(const f32x4*)(DWT + c * 68 + 8 * tg + 4);
            const f32x4 e0 = *(const f32x4*)(DAT + c * 68 + 8 * tg), e1 = *(const f32x4*)(DAT + c * 68 + 8 * tg + 4);
#pragma unroll
            for (int i = 0; i < 8; ++i) {
                const float dw = i < 4 ? d0[i & 3] : d1[i & 3], da = i < 4 ? e0[i & 3] : e1[i & 3];
                lw[i] = -__expf(-softplus(-(w0 + dw)) - 0.5f);
                av[i] = 1.0f / (1.0f + __expf(-(a0 + da)));
                kkv[i] = kv[i] * k_k;
                k2v[i] = kv[i] * (1.0f + (av[i] - 1.0f) * k_a);
            }
            float n2[8], rk[8];
#pragma unroll
            for (int i = 0; i < 8; ++i) { n2[i] = kkv[i] * kkv[i]; rk[i] = rv[i] * k2v[i] * r_k; }
#pragma unroll
            for (int off = 32; off >= 1; off >>= 1) {
#pragma unroll
                for (int i = 0; i < 8; ++i) { n2[i] += __shfl_xor(n2[i], off); rk[i] += __shfl_xor(rk[i], off); }
            }
#pragma unroll
            for (int i = 0; i < 8; ++i) kkv[i] = kkv[i] / fmaxf(sqrtf(n2[i]), 1e-12f);
            if (lane < 8) {
                float sel = rk[0];
#pragma unroll
                for (int i = 1; i < 8; ++i) sel = (lane == i) ? rk[i] : sel;
                RK[(R0 + 8 * tg + lane) * 16 + h] = sel;
            }
        }
        float G[9];
        {
            float run = 0.f;
#pragma unroll
            for (int i = 0; i < 8; ++i) { run += lw[i]; G[i + 1] = run; }
            CS[tg * 64 + c] = run;
        }
        __syncthreads();
        float GC = 0.f;
        {
            float off = 0.f;
#pragma unroll
            for (int q = 0; q < 8; ++q) { const float t = CS[q * 64 + c]; GC += t; if (q < tg) off += t; }
            G[0] = off;
#pragma unroll
            for (int i = 1; i < 9; ++i) G[i] += off;
        }
        {
            unsigned tA[4], tB[4], tK[4], tV[4];
#pragma unroll
            for (int i = 0; i < 8; i += 2) {
                float xa[2], xb[2], xk[2];
#pragma unroll
                for (int e = 0; e < 2; ++e) {
                    const int t = 8 * tg + i + e;
                    const float em = __expf(G[i + e]), ep = __expf(G[i + e + 1]), en = __expf(-G[i + e + 1]), ec = __expf(GC - G[i + e + 1]);
                    const float al = -kkv[i + e] * em, be = kkv[i + e] * av[i + e];
                    ALB[t * 72 + c] = f2bf(al);
                    BH[t * 72 + c] = f2bf(be * en);
                    KH[t * 72 + c] = f2bf(k2v[i + e] * en);
                    RB[t * 72 + c] = f2bf(rv[i + e] * ep);
                    Ybuf[(R0 + t) * DM + ch] = f2bf(vv[i + e]);
                    xa[e] = al; xb[e] = be * ec; xk[e] = k2v[i + e] * ec;
                }
                tA[i >> 1] = pk2(xa[0], xa[1]); tB[i >> 1] = pk2(xb[0], xb[1]); tK[i >> 1] = pk2(xk[0], xk[1]); tV[i >> 1] = pk2(vv[i], vv[i + 1]);
            }
            *(u32x4*)(BT + c * 72 + 8 * tg) = (u32x4){tA[0], tA[1], tA[2], tA[3]};
            *(u32x4*)(BTT + c * 72 + 8 * tg) = (u32x4){tB[0], tB[1], tB[2], tB[3]};
            *(u32x4*)(KTT + c * 72 + 8 * tg) = (u32x4){tK[0], tK[1], tK[2], tK[3]};
            *(u32x4*)(VT + c * 72 + 8 * tg) = (u32x4){tV[0], tV[1], tV[2], tV[3]};
            if (tg == 0) GCs[c] = __expf(GC);
        }
        __syncthreads();
#pragma unroll
        for (int q = 0; q < 2; ++q) {
            const int pos = 2 * w + q, tt = pos >> 2, st = pos & 3;
            f32x4 cab = (f32x4){0.f, 0.f, 0.f, 0.f}, cak = cab, crb = cab, crk = cab;
            if (st <= tt) {
#pragma unroll
                for (int kk = 0; kk < 2; ++kk) {
                    const bf16x8 fb = ldfrag(BH, 16 * st + l15, 32 * kk + 8 * g), fk = ldfrag(KH, 16 * st + l15, 32 * kk + 8 * g);
                    const bf16x8 fa = ldfrag(ALB, 16 * tt + l15, 32 * kk + 8 * g), fr = ldfrag(RB, 16 * tt + l15, 32 * kk + 8 * g);
                    cab = mfma16(fb, fa, cab); cak = mfma16(fk, fa, cak); crb = mfma16(fb, fr, crb); crk = mfma16(fk, fr, crk);
                }
#pragma unroll
                for (int r = 0; r < 4; ++r) {
                    const int s = 16 * st + 4 * g + r, t = 16 * tt + l15;
                    if (s >= t) { cab[r] = 0.f; cak[r] = 0.f; }
                    if (s > t) { crb[r] = 0.f; crk[r] = 0.f; }
                }
                if (st == tt) *(f32x4*)(TD + st * 256 + l15 * 16 + 4 * g) = cab;
            }
            const int o = (16 * tt + l15) * 72 + 16 * st + 4 * g;
            *(u32x2*)(AAB + o) = pk4(cab); *(u32x2*)(AAK + o) = pk4(cak); *(u32x2*)(ARB + o) = pk4(crb); *(u32x2*)(ARK + o) = pk4(crk);
        }
        __syncthreads();
        if (w == 0) {
            const float* Nb = TD + g * 256;
            float tr[16];
#pragma unroll
            for (int r = 0; r < 16; ++r) {
                float acc = (l15 == r) ? 1.f : 0.f;
#pragma unroll
                for (int j4 = 0; j4 < 4; ++j4) {
                    if (4 * j4 < r) {
                        const f32x4 nv = *(const f32x4*)(Nb + r * 16 + 4 * j4);
#pragma unroll
                        for (int e = 0; e < 4; ++e) if (4 * j4 + e < r) acc += nv[e] * tr[4 * j4 + e];
                    }
                }
                tr[r] = acc;
                TD16[g * 256 + r * 16 + l15] = f2bf(acc);
            }
        } else {
            for (int tl = w - 1; tl < 16; tl += 7) {
                const int tt = tl >> 2, vt = tl & 3;
                f32x4 acc = (f32x4){0.f, 0.f, 0.f, 0.f};
#pragma unroll
                for (int kk = 0; kk < 2; ++kk) {
                    if (32 * kk <= 16 * tt + 15) acc = mfma16(ldfrag(AAK, 16 * tt + l15, 32 * kk + 8 * g), ldfrag(VT, 16 * vt + l15, 32 * kk + 8 * g), acc);
                }
                *(u32x2*)(BT + (64 + 16 * vt + l15) * 72 + 16 * tt + 4 * g) = pk4(acc);
            }
        }
        __syncthreads();
        {
            u32x2 xb[4];
            const int col = 16 * w + l15;
#pragma unroll
            for (int i = 0; i < 4; ++i) {
                f32x4 z = unpk4(*(const u32x2*)(BT + col * 72 + 16 * i + 4 * g));
                if (i >= 1) {
                    const bf16_t* ar = AAB + (16 * i + l15) * 72 + 4 * g;
                    const u32x2 a0 = *(const u32x2*)ar;
                    u32x2 a1 = (u32x2){0u, 0u}, b1 = (u32x2){0u, 0u};
                    if (i >= 2) { a1 = *(const u32x2*)(ar + 16); b1 = xb[1]; }
                    z = mfma16(as_bf16x8((u32x4){a0.x, a0.y, a1.x, a1.y}), as_bf16x8((u32x4){xb[0].x, xb[0].y, b1.x, b1.y}), z);
                    if (i == 3) {
                        const u32x2 a2 = *(const u32x2*)(ar + 32);
                        z = mfma16(as_bf16x8((u32x4){a2.x, a2.y, 0u, 0u}), as_bf16x8((u32x4){xb[2].x, xb[2].y, 0u, 0u}), z);
                    }
                }
                const u32x2 tq = *(const u32x2*)(TD16 + i * 256 + l15 * 16 + 4 * g);
                const u32x2 zq = pk4(z);
                const f32x4 x = mfma16(as_bf16x8((u32x4){tq.x, tq.y, 0u, 0u}), as_bf16x8((u32x4){zq.x, zq.y, 0u, 0u}), (f32x4){0.f, 0.f, 0.f, 0.f});
                xb[i] = pk4(x);
                *(u32x2*)(BT + col * 72 + 16 * i + 4 * g) = xb[i];
            }
        }
        __syncthreads();
        {
            const int rt_ = w & 3;
#pragma unroll
            for (int q = 0; q < 2; ++q) {
                const int ctile = 2 * (w >> 2) + q;
                {
                    f32x4 acc = (f32x4){0.f, 0.f, 0.f, 0.f};
#pragma unroll
                    for (int kk = 0; kk < 2; ++kk) acc = mfma16(ldfrag(BT, 16 * rt_ + l15, 32 * kk + 8 * g), ldfrag(BTT, 16 * ctile + l15, 32 * kk + 8 * g), acc);
                    const int dcol = 16 * ctile + l15;
                    if (rt_ == ctile) {
                        const float gc = GCs[dcol];
#pragma unroll
                        for (int r = 0; r < 4; ++r) if (4 * g + r == l15) acc[r] += gc;
                    }
                    *(u32x2*)(P + (R0 + dcol) * PP + h * 64 + 32 * (rt_ >> 1) + 8 * g + 4 * (rt_ & 1)) = pk4(acc);
                }
                {
                    f32x4 acc = unpk4(*(const u32x2*)(RB + (16 * ctile + l15) * 72 + 16 * rt_ + 4 * g));
#pragma unroll
                    for (int kk = 0; kk < 2; ++kk) {
                        if (32 * kk <= 16 * ctile + 15) acc = mfma16(ldfrag(BT, 16 * rt_ + l15, 32 * kk + 8 * g), ldfrag(ARB, 16 * ctile + l15, 32 * kk + 8 * g), acc);
                    }
                    *(u32x2*)(P + (R0 + 16 * ctile + l15) * PP + 1024 + h * 64 + 16 * rt_ + 4 * g) = pk4(acc);
                }
                {
                    f32x4 acc = (f32x4){0.f, 0.f, 0.f, 0.f};
#pragma unroll
                    for (int kk = 0; kk < 2; ++kk) {
                        acc = mfma16(ldfrag(BTT, 16 * rt_ + l15, 32 * kk + 8 * g), ldfrag(BT, 64 + 16 * ctile + l15, 32 * kk + 8 * g), acc);
                        acc = mfma16(ldfrag(KTT, 16 * rt_ + l15, 32 * kk + 8 * g), ldfrag(VT, 16 * ctile + l15, 32 * kk + 8 * g), acc);
                    }
                    *(u32x2*)(P + (R0 + 16 * ctile + l15) * PP + 2048 + h * 64 + 16 * rt_ + 4 * g) = pk4(acc);
                }
                {
                    f32x4 acc = (f32x4){0.f, 0.f, 0.f, 0.f};
#pragma unroll
                    for (int kk = 0; kk < 2; ++kk) {
                        if (32 * kk <= 16 * rt_ + 15) {
                            acc = mfma16(ldfrag(ARB, 16 * rt_ + l15, 32 * kk + 8 * g), ldfrag(BT, 64 + 16 * ctile + l15, 32 * kk + 8 * g), acc);
                            acc = mfma16(ldfrag(ARK, 16 * rt_ + l15, 32 * kk + 8 * g), ldfrag(VT, 16 * ctile + l15, 32 * kk + 8 * g), acc);
                        }
                    }
                    *(u32x2*)(Abuf + (R0 + 16 * ctile + l15) * DM + h * 64 + 16 * rt_ + 4 * g) = pk4(acc);
                }
            }
        }
        __syncthreads();
    }
}

constexpr int SC_SLOT = 2 * IMG;
__device__ void rwkv_scan(const Params& p, unsigned char* lds) {
    if (blockIdx.x >= 32) return;
    const int tid = threadIdx.x, lane = tid & 63, w = __builtin_amdgcn_readfirstlane(tid >> 6), l15 = lane & 15, g = lane >> 4;
    const int bh = blockIdx.x, b = bh >> 4, h = bh & 15;
    bf16_t* P = (bf16_t*)(p.ws + WS_P);
    const size_t Rb = (size_t)b * SEQ;
    if (w >= 4) {
        const int lj = w - 4;
        const unsigned goff = (unsigned)(((lane >> 3) * PP + (lane & 7) * 8) * 2);
        const unsigned loff = (unsigned)((lane >> 3) * 144 + (lane & 7) * 16);
        const char* gbase = (const char*)P + (Rb * PP + h * 64) * 2;
        u32x4 ld0[16], ld1[16];
#define SC_ISSUE(dst, chunk) do { const char* cb = gbase + (size_t)(chunk) * 64 * PP * 2; _Pragma("unroll") for (int q = 0; q < 16; ++q) \
        dst[q] = *(const u32x4*)(cb + (size_t)(((q & 7) * 8 * PP + (q >> 3) * 2048) * 2) + goff); } while (0)
#define SC_RETIRE(src, chunk) do { unsigned char* sb = lds + ((chunk) & 1) * SC_SLOT + loff; _Pragma("unroll") for (int q = 0; q < 16; ++q) \
        *(u32x4*)(sb + (q >> 3) * IMG + (q & 7) * 8 * 144) = src[q]; } while (0)
        SC_ISSUE(ld0, lj); SC_ISSUE(ld1, lj + 4);
        for (int i0 = 0; i0 <= 256; i0 += 8) {
#pragma unroll
            for (int ii = 0; ii < 8; ++ii) {
                const int i = i0 + ii;
                if (i <= 256) {
                    if (i < 256 && (ii & 3) == lj) {
                        if (ii < 4) { SC_RETIRE(ld0, i); if (i + 8 < 256) SC_ISSUE(ld0, i + 8); }
                        else        { SC_RETIRE(ld1, i); if (i + 8 < 256) SC_ISSUE(ld1, i + 8); }
                    }
                    __syncthreads();
                }
            }
        }
#undef SC_ISSUE
#undef SC_RETIRE
    } else {
        f32x4 H[4];
#pragma unroll
        for (int mt = 0; mt < 4; ++mt) H[mt] = (f32x4){0.f, 0.f, 0.f, 0.f};
        for (int i = 0; i <= 256; ++i) {
            if (i >= 1) {
                const int n = i - 1;
                const unsigned char* sb = lds + (n & 1) * SC_SLOT;
                const bf16_t* MT = (const bf16_t*)sb; const bf16_t* NT = (const bf16_t*)(sb + IMG);
                u32x2 hp[4];
#pragma unroll
                for (int mt = 0; mt < 4; ++mt) {
                    hp[mt] = pk4(H[mt]);
                    *(u32x2*)(P + (Rb + (size_t)n * 64 + 16 * w + l15) * PP + 2048 + h * 64 + 16 * mt + 4 * g) = hp[mt];
                }
                bf16x8 hb[2];
                hb[0] = as_bf16x8((u32x4){hp[0].x, hp[0].y, hp[1].x, hp[1].y});
                hb[1] = as_bf16x8((u32x4){hp[2].x, hp[2].y, hp[3].x, hp[3].y});
#pragma unroll
                for (int mt = 0; mt < 4; ++mt) {
                    f32x4 acc = unpk4(*(const u32x2*)(NT + (16 * w + l15) * 72 + 16 * mt + 4 * g));
#pragma unroll
                    for (int kk = 0; kk < 2; ++kk) acc = mfma16(ldfrag(MT, 16 * mt + l15, 32 * kk + 8 * g), hb[kk], acc);
                    H[mt] = acc;
                }
            }
            __syncthreads();
        }
    }
}

__device__ void rwkv_post(const Params& p, unsigned char* lds) {
    const int tid = threadIdx.x, lane = tid & 63, w = tid >> 6, l15 = lane & 15, g = lane >> 4;
    const bf16_t* P = (const bf16_t*)(p.ws + WS_P);
    bf16_t* Abuf = (bf16_t*)(p.ws + WS_A);
    const bf16_t* Ybuf = (const bf16_t*)(p.ws + WS_Y);
    const float* RK = (const float*)(p.ws + WS_RK);
    const bf16_t* BND = (const bf16_t*)(p.ws + WS_BND);
    float* RED = (float*)lds;
    const int tt = w & 3, vh = w >> 2;
    for (int unit = blockIdx.x; unit < 8192; unit += gridDim.x) {
        const int bn = unit >> 4, h = unit & 15, n = bn & 255;
        const size_t R0 = (size_t)bn * 64;
        f32x4 y[2];
#pragma unroll
        for (int j = 0; j < 2; ++j) {
            const int v = 16 * (2 * vh + j) + l15;
            f32x4 acc = unpk4(*(const u32x2*)(Abuf + (R0 + v) * DM + h * 64 + 16 * tt + 4 * g));
#pragma unroll
            for (int kk = 0; kk < 2; ++kk) {
                const bf16x8 fa = *(const bf16x8*)(P + (R0 + 16 * tt + l15) * PP + 1024 + h * 64 + 32 * kk + 8 * g);
                const bf16x8 fb = *(const bf16x8*)(P + (R0 + v) * PP + 2048 + h * 64 + 32 * kk + 8 * g);
                acc = mfma16(fa, fb, acc);
            }
            y[j] = acc;
        }
        float s1[4], s2[4];
#pragma unroll
        for (int r = 0; r < 4; ++r) {
            float a = y[0][r] + y[1][r], q = y[0][r] * y[0][r] + y[1][r] * y[1][r];
            a += __shfl_xor(a, 1); q += __shfl_xor(q, 1); a += __shfl_xor(a, 2); q += __shfl_xor(q, 2); a += __shfl_xor(a, 4); q += __shfl_xor(q, 4); a += __shfl_xor(a, 8); q += __shfl_xor(q, 8);
            s1[r] = a; s2[r] = q;
        }
        if (l15 == 0) {
#pragma unroll
            for (int r = 0; r < 4; ++r) { RED[(vh * 64 + 16 * tt + 4 * g + r) * 2] = s1[r]; RED[(vh * 64 + 16 * tt + 4 * g + r) * 2 + 1] = s2[r]; }
        }
        __syncthreads();
#pragma unroll
        for (int r = 0; r < 4; ++r) {
            const int t = 16 * tt + 4 * g + r;
            const float a = RED[t * 2] + RED[(64 + t) * 2], q = RED[t * 2 + 1] + RED[(64 + t) * 2 + 1];
            const float mean = a * (1.0f / 64.0f);
            const float var = fmaxf(q * (1.0f / 64.0f) - mean * mean, 0.f);
            const float rstd = rsqrtf(var + 64e-5f);
            const float rk = RK[(R0 + t) * 16 + h];
            const bf16_t* grow = P + (R0 + t) * PP + 3072 + h * 64;
            const bf16_t* gprev = (t > 0) ? (grow - PP) : (BND + (size_t)bn * PP + 3072 + h * 64);
            const bool zprev = (t == 0 && n == 0);
#pragma unroll
            for (int j = 0; j < 2; ++j) {
                const int v = 16 * (2 * vh + j) + l15, ch = h * 64 + v;
                const float yn = (y[j][r] - mean) * rstd * p.in[18][ch] + p.in[19][ch];
                const float vp = bf2f(Ybuf[(R0 + t) * DM + ch]);
                const float g1 = bf2f(grow[v]), g0 = zprev ? 0.f : bf2f(gprev[v]);
                const float gt = g1 + p.in[10][3072 + ch] * (g0 - g1);
                Abuf[(R0 + t) * DM + ch] = f2bf((yn + rk * vp) * gt / (1.0f + __expf(-gt)));
            }
        }
        __syncthreads();
    }
}

#ifndef N_LAUNCH_MODE
#define N_LAUNCH_MODE 1
#endif
constexpr int N_PHASES = 13;

__global__ void __launch_bounds__(NTH, 2) fwd_kernel(Params p) {
    extern __shared__ __attribute__((aligned(16))) unsigned char lds[];
    cg::grid_group grid = cg::this_grid();
    const int lo = p.ph_lo, hi = p.ph_hi;
    unsigned char* ws = p.ws;
#define IN(k) (lo <= (k) && (k) < hi)
#define SEAM(k) do { if ((k) + 1 < hi) grid.sync(); } while (0)
    if (IN(0)) {
        prep_weight(p.in[2], GIN, p.in[1], (bf16_t*)(ws + WS_WGIN), GIN_P, (float*)lds);
        prep_weight(p.in[6], DM, nullptr, (bf16_t*)(ws + WS_WGOUT), DM, (float*)lds);
        prep_weight(p.in[9], RIN, p.in[8], (bf16_t*)(ws + WS_WRIN), RIN_P, (float*)lds);
        prep_weight(p.in[20], DM, nullptr, (bf16_t*)(ws + WS_WROUT), DM, (float*)lds);
        prep_lowrank(p.in[12], (bf16_t*)(ws + WS_WDUT));
        prep_lowrank(p.in[14], (bf16_t*)(ws + WS_WIUT));
        phase_norm0(p);
        SEAM(0);
    }
    if (IN(1)) {
        pg8::Gemm g{(const bf16_t*)(ws + WS_A), (const bf16_t*)(ws + WS_WGIN), MTOK, GIN_P, DM}; pg8::StaticOrder S; S.init(MTOK, GIN_P, gridDim.x, blockIdx.x);
        pg8::EpiBf16<0> E{(bf16_t*)(ws + WS_P), GIN_P, nullptr, 0, 0};
        pg8::gemm_phase<pg8::EpiBf16<0>, pg8::StaticOrder>((PG8_LAS unsigned char*)lds, g, S, E);
        SEAM(1);
    }
    if (IN(2)) { gla_pass<false>(p, lds); SEAM(2); }
    if (IN(3)) { gla_scan(p); SEAM(3); }
    if (IN(4)) { gla_pass<true>(p, lds); SEAM(4); }
    if (IN(5)) {
        pg8::Gemm g{(const bf16_t*)(ws + WS_A), (const bf16_t*)(ws + WS_WGOUT), MTOK, DM, DM}; pg8::StaticOrder S; S.init(MTOK, DM, gridDim.x, blockIdx.x);
        pg8::EpiBf16<0> E{(bf16_t*)(ws + WS_Y), DM, nullptr, 0, 0};
        pg8::gemm_phase<pg8::EpiBf16<0>, pg8::StaticOrder>((PG8_LAS unsigned char*)lds, g, S, E);
        SEAM(5);
    }
    if (IN(6)) { phase_norm1(p); SEAM(6); }
    if (IN(7)) {
        pg8::Gemm g{(const bf16_t*)(ws + WS_A), (const bf16_t*)(ws + WS_WRIN), MTOK, RIN_P, DM}; pg8::StaticOrder S; S.init(MTOK, RIN_P, gridDim.x, blockIdx.x);
        EpiBf16Bnd E{(bf16_t*)(ws + WS_P), RIN_P, (bf16_t*)(ws + WS_BND)};
        pg8::gemm_phase<EpiBf16Bnd, pg8::StaticOrder>((PG8_LAS unsigned char*)lds, g, S, E);
        SEAM(7);
    }
    if (IN(8)) { rwkv_r1(p, lds); SEAM(8); }
    if (IN(9)) { rwkv_scan(p, lds); SEAM(9); }
    if (IN(10)) { rwkv_post(p, lds); SEAM(10); }
    if (IN(11)) {
        pg8::Gemm g{(const bf16_t*)(ws + WS_A), (const bf16_t*)(ws + WS_WROUT), MTOK, DM, DM}; pg8::StaticOrder S; S.init(MTOK, DM, gridDim.x, blockIdx.x);
        pg8::EpiBf16<0> E{(bf16_t*)(ws + WS_Y), DM, nullptr, 0, 0};
        pg8::gemm_phase<pg8::EpiBf16<0>, pg8::StaticOrder>((PG8_LAS unsigned char*)lds, g, S, E);
        SEAM(11);
    }
    if (IN(12)) { phase_final(p); }
#undef IN
#undef SEAM
}

extern "C" void kernel_launch(void* const* d_in, const int* in_sizes, int n_in, void* d_out, int out_size, void* d_ws, size_t ws_size, hipStream_t stream) {
    static int grid = 0;
    if (grid == 0) {
        int dev = 0, cus = 0, per_cu = 0;
        hipGetDevice(&dev);
        hipDeviceGetAttribute(&cus, hipDeviceAttributeMultiprocessorCount, dev);
        hipFuncSetAttribute((const void*)fwd_kernel, hipFuncAttributeMaxDynamicSharedMemorySize, LDS_BYTES);
        hipOccupancyMaxActiveBlocksPerMultiprocessor(&per_cu, (const void*)fwd_kernel, NTH, LDS_BYTES);
        if (per_cu < 1) { fprintf(stderr, "kernel_launch: occupancy query says %d blocks per CU\n", per_cu); per_cu = 1; }
        grid = cus;
        if (n_in != 22 || ws_size < WS_END) fprintf(stderr, "kernel_launch: unexpected n_in %d or workspace %zu < %zu\n", n_in, ws_size, (size_t)WS_END);
        (void)hipGetLastError();
    }
    Params p{};
    for (int i = 0; i < 22; ++i) p.in[i] = (const float*)d_in[i];
    p.out = (float*)d_out; p.ws = (unsigned char*)d_ws;
#if N_LAUNCH_MODE == 1
    p.ph_lo = 0; p.ph_hi = N_PHASES;
    void* args[] = {&p};
    hipError_t e = hipLaunchCooperativeKernel((const void*)fwd_kernel, dim3(grid), dim3(NTH), args, LDS_BYTES, stream);
    if (e != hipSuccess) fprintf(stderr, "cooperative launch failed: %s (grid %d)\n", hipGetErrorString(e), grid);
#else
    for (int k = 0; k < N_PHASES; ++k) {
        p.ph_lo = k; p.ph_hi = k + 1;
        hipLaunchKernelGGL(fwd_kernel, dim3(grid), dim3(NTH), LDS_BYTES, stream, p);
    }
#endif
}
```

```cpp
#include <hip/hip_runtime.h>
#include <hip/hip_cooperative_groups.h>
#include <cstdio>
namespace cg = cooperative_groups;
#define PROBE_ID 0
#define N_LAUNCH_MODE 1
namespace pg8 {
#define PG8_LAS __attribute__((address_space(3)))
typedef unsigned short bf16_t;
typedef short bf16x8 __attribute__((ext_vector_type(8)));
typedef float f32x4 __attribute__((ext_vector_type(4)));
typedef unsigned u32x4 __attribute__((ext_vector_type(4)));
constexpr int BM = 256, BK = 64, HALF = 128, HTB = HALF * BK * 2  , STAGE_BYTES = 8 * HTB, NXCD = 8, WGM = 8;

__host__ __device__ __forceinline__ int lds_byte(int r, int c) { const int st = (r >> 4) * 2 + (c >> 5), rr = r & 15, cc = c & 31, ob = rr * 64 + cc * 2; return st * 1024 + (ob ^ (((ob >> 9) & 1) << 5)); }
__host__ __device__ __forceinline__ void stage_rc(int b, int& R, int& C) { const int st = b / 1024, sb = b % 1024, swz = sb ^ (((sb >> 9) & 1) << 5); R = (st >> 1) * 16 + swz / 64; C = (st & 1) * 32 + (swz % 64) / 2; }
__host__ __device__ __forceinline__ int perm32(int rho) { const int n = rho >> 4, i = rho & 15; return 8 * (i >> 2) + 4 * n + (i & 3); }

struct Unit { int pm, pn; };
struct Gemm { const bf16_t* A; const bf16_t* Bt; int M, N, K; };

struct StaticOrder {
    int nM, nN, nwg, G, c;
    __host__ __device__ void init(int M, int N, int G_, int c_) { nM = M / BM; nN = N / BM; nwg = nM * nN; G = G_; c = c_; }
    __host__ __device__ bool next(int i, Unit& u) const {
        const long L = (long)i * G + c; if (L >= nwg) return false;
        int wgid = (int)L; { const int q = nwg / NXCD, r = nwg % NXCD, xcd = wgid % NXCD, off = wgid / NXCD; wgid = (xcd < r ? xcd * (q + 1) : r * (q + 1) + (xcd - r) * q) + off; }
        const int nig = WGM * nN, gid = wgid / nig, fm = gid * WGM, gsz = (nM - fm) < WGM ? (nM - fm) : WGM;
        u.pm = fm + ((wgid % nig) % gsz); u.pn = (wgid % nig) / gsz; return true;
    }
    __device__ __forceinline__ void a_ready(const Unit&) const {}
    __device__ __forceinline__ void done(const Unit&) const {}
};

typedef float cvt_f32x2 __attribute__((ext_vector_type(2)));
typedef __bf16 cvt_bf16x2 __attribute__((ext_vector_type(2)));
__device__ __forceinline__ unsigned cvt_pk_bf16(float lo, float hi) { const cvt_f32x2 v = {lo, hi}; union { cvt_bf16x2 b; unsigned u; } x; x.b = __builtin_convertvector(v, cvt_bf16x2); return x.u; }
typedef float f32x2 __attribute__((ext_vector_type(2)));
struct EpiF32 {
    static constexpr bool PERM = false, AFTER_DRAIN = false;
    float* C; int ldc; const float* bias;
    __device__ __forceinline__ void operator()(const f32x4 (&acc)[2][2][4][2], const Unit& u, int wr, int wc, int fr, int fq) const {
        const int row0 = u.pm * BM + wr * 64 + fr, col0 = u.pn * BM + wc * 32 + 4 * fq;
        f32x4 bv[2][2];
#pragma unroll
        for (int bj = 0; bj < 2; ++bj)
#pragma unroll
            for (int n = 0; n < 2; ++n) bv[bj][n] = bias ? *(const f32x4*)(bias + col0 + bj * HALF + n * 16) : (f32x4){0.f, 0.f, 0.f, 0.f};
#pragma unroll
        for (int ai = 0; ai < 2; ++ai)
#pragma unroll
            for (int m = 0; m < 4; ++m) { float* rowp = C + (size_t)(row0 + ai * HALF + m * 16) * ldc + col0;
#pragma unroll
                for (int bj = 0; bj < 2; ++bj)
#pragma unroll
                    for (int n = 0; n < 2; ++n) *(f32x4*)(rowp + bj * HALF + n * 16) = acc[ai][bj][m][n] + bv[bj][n]; }
    }
};
template <int ACT  > struct EpiBf16 {
    static constexpr bool PERM = true, AFTER_DRAIN = false;
    bf16_t* O; int ldc; const float* bias; int split_cols; size_t split_stride;
    __device__ __forceinline__ void operator()(const f32x4 (&acc)[2][2][4][2], const Unit& u, int wr, int wc, int fr, int fq) const {
        const int row0 = u.pm * BM + wr * 64 + fr; int colt = u.pn * BM; bf16_t* base = O;
        if (split_cols) { const int t = colt / split_cols; base += (size_t)t * split_stride; colt -= t * split_cols; }
        const int col0 = colt + wc * 32 + 8 * fq, bcol0 = u.pn * BM + wc * 32 + 8 * fq;
        f32x4 bv[2][2];
#pragma unroll
        for (int bj = 0; bj < 2; ++bj)
#pragma unroll
            for (int n = 0; n < 2; ++n) bv[bj][n] = bias ? *(const f32x4*)(bias + bcol0 + bj * HALF + 4 * n) : (f32x4){0.f, 0.f, 0.f, 0.f};
#pragma unroll
        for (int ai = 0; ai < 2; ++ai)
#pragma unroll
            for (int m = 0; m < 4; ++m) { bf16_t* rowp = base + (size_t)(row0 + ai * HALF + m * 16) * ldc + col0;
#pragma unroll
                for (int bj = 0; bj < 2; ++bj) { f32x4 v0 = acc[ai][bj][m][0] + bv[bj][0], v1 = acc[ai][bj][m][1] + bv[bj][1];
                    u32x4 w; w.x = cvt_pk_bf16(v0[0], v0[1]); w.y = cvt_pk_bf16(v0[2], v0[3]); w.z = cvt_pk_bf16(v1[0], v1[1]); w.w = cvt_pk_bf16(v1[2], v1[3]);
                    *(u32x4*)(rowp + bj * HALF) = w; } }
    }
};

template <class Epi, class Sched>
__device__ __forceinline__ void gemm_phase(PG8_LAS unsigned char* lds, const Gemm g, const Sched& S, const Epi& E) {
    const int tid = threadIdx.x, wid = __builtin_amdgcn_readfirstlane(tid >> 6), lane = tid & 63, wr = wid >> 2, wc = wid & 3, fr = lane & 15, fq = lane >> 4;
    const int K = g.K, nt = K / BK;
    unsigned voffA[2], voffB[2];
#pragma unroll
    for (int i = 0; i < 2; ++i) { int R, C; stage_rc(tid * 16 + i * 8192, R, C); const int Rb = Epi::PERM ? ((R & ~31) + perm32(R & 31)) : R;
        voffA[i] = (unsigned)(R * K + C) * 2u; voffB[i] = (unsigned)(Rb * K + C) * 2u; }
    const size_t kstep = (size_t)(BK * 2);
    const size_t hstep = (size_t)HALF * K * 2;
    const size_t tstep = 2 * hstep;
    const unsigned ldsw = (unsigned)wid * 1024u;
    const int aoff = lds_byte(wr * 64 + fr, fq * 8), boff = lds_byte(wc * 32 + fr, fq * 8);
#define PG8_SA(b, h) (((b) * 2 + (h)) * HTB)
#define PG8_SB(b, h) ((4 + (b) * 2 + (h)) * HTB)
#define PG8_STAGE(bufoff, gbase, voff) do { _Pragma("unroll") for (int _i = 0; _i < 2; ++_i) \
        __builtin_amdgcn_global_load_lds((const unsigned*)((const char*)(gbase) + (voff)[_i]), (PG8_LAS unsigned*)(lds + (bufoff) + ldsw + _i * 8192), 16, 0, 0); } while (0)
#define PG8_LDA(dst, b, h) do { _Pragma("unroll") for (int m = 0; m < 4; ++m) _Pragma("unroll") for (int k = 0; k < 2; ++k) dst[m][k] = *(const PG8_LAS bf16x8*)(lds + PG8_SA(b, h) + aoff + m * 2048 + k * 1024); } while (0)
#define PG8_LDB(dst, b, h) do { _Pragma("unroll") for (int n = 0; n < 2; ++n) _Pragma("unroll") for (int k = 0; k < 2; ++k) dst[n][k] = *(const PG8_LAS bf16x8*)(lds + PG8_SB(b, h) + boff + n * 2048 + k * 1024); } while (0)
#define PG8_MMA(ai, bj, At, Bt) do { __builtin_amdgcn_s_setprio(1); _Pragma("unroll") for (int m = 0; m < 4; ++m) _Pragma("unroll") for (int n = 0; n < 2; ++n) _Pragma("unroll") for (int k = 0; k < 2; ++k) \
        acc[ai][bj][m][n] = __builtin_amdgcn_mfma_f32_16x16x32_bf16(Bt[n][k], At[m][k], acc[ai][bj][m][n], 0, 0, 0); __builtin_amdgcn_s_setprio(0); } while (0)
#define PG8_WAIT_V(n) asm volatile("s_waitcnt vmcnt(" #n ")" ::: "memory")
#define PG8_WAIT_L(n) asm volatile("s_waitcnt lgkmcnt(" #n ")" ::: "memory")
#define PG8_BAR __builtin_amdgcn_s_barrier()
#define PG8_SCHED __builtin_amdgcn_sched_barrier(0)
    Unit cur, nxt; int ui = 0;
    if (!S.next(0, cur)) return;
    f32x4 acc[2][2][4][2];
#pragma unroll
    for (int a = 0; a < 2; ++a)
#pragma unroll
        for (int b = 0; b < 2; ++b)
#pragma unroll
            for (int m = 0; m < 4; ++m)
#pragma unroll
                for (int n = 0; n < 2; ++n) acc[a][b][m][n] = (f32x4){0.f, 0.f, 0.f, 0.f};
    bf16x8 At[4][2], B0[2][2], B1[2][2];
    const char* cA = (const char*)g.A + (size_t)cur.pm * tstep; const char* cB = (const char*)g.Bt + (size_t)cur.pn * tstep;
    S.a_ready(cur);
    PG8_STAGE(PG8_SB(0, 0), cB, voffB); PG8_STAGE(PG8_SA(0, 0), cA, voffA); PG8_STAGE(PG8_SB(0, 1), cB + hstep, voffB); PG8_STAGE(PG8_SA(0, 1), cA + hstep, voffA);
    if (wr == 1) PG8_BAR;
    PG8_WAIT_V(4); PG8_BAR;
    PG8_STAGE(PG8_SB(1, 0), cB + kstep, voffB); PG8_STAGE(PG8_SA(1, 0), cA + kstep, voffA); PG8_STAGE(PG8_SB(1, 1), cB + hstep + kstep, voffB);
    PG8_WAIT_V(6); PG8_BAR;
    for (;;) {
        const bool has_next = S.next(ui + 1, nxt);
        const char* nA = has_next ? (const char*)g.A + (size_t)nxt.pm * tstep : cA; const char* nB = has_next ? (const char*)g.Bt + (size_t)nxt.pn * tstep : cB;
        for (int t = 0; t < nt; t += 2) {
            const bool last = (t == nt - 2);
            const char* a1 = cA + (size_t)(t + 1) * kstep;
            const char* a2 = last ? nA : cA + (size_t)(t + 2) * kstep; const char* b2 = last ? nB : cB + (size_t)(t + 2) * kstep;
            const char* a3 = a2 + kstep; const char* b3 = b2 + kstep;
            if (last && has_next) S.a_ready(nxt);
            PG8_LDB(B0, 0, 0); PG8_SCHED; PG8_LDA(At, 0, 0); PG8_STAGE(PG8_SA(1, 1), a1 + hstep, voffA);
            PG8_WAIT_L(8); PG8_BAR; PG8_WAIT_L(0); PG8_MMA(0, 0, At, B0); PG8_BAR; PG8_SCHED;
            PG8_LDB(B1, 0, 1); PG8_STAGE(PG8_SB(0, 0), b2, voffB);
            PG8_BAR; PG8_WAIT_L(0); PG8_MMA(0, 1, At, B1); PG8_BAR;
            PG8_LDA(At, 0, 1); PG8_STAGE(PG8_SA(0, 0), a2, voffA);
            PG8_BAR; PG8_WAIT_L(0); PG8_MMA(1, 0, At, B0); PG8_BAR; PG8_SCHED;
            PG8_STAGE(PG8_SB(0, 1), b2 + hstep, voffB);
            PG8_WAIT_V(6); PG8_BAR; PG8_MMA(1, 1, At, B1); PG8_BAR;
            PG8_LDB(B0, 1, 0); PG8_SCHED; PG8_LDA(At, 1, 0); PG8_STAGE(PG8_SA(0, 1), a2 + hstep, voffA);
            PG8_WAIT_L(8); PG8_BAR; PG8_WAIT_L(0); PG8_MMA(0, 0, At, B0); PG8_BAR; PG8_SCHED;
            PG8_LDB(B1, 1, 1); PG8_STAGE(PG8_SB(1, 0), b3, voffB);
            PG8_BAR; PG8_WAIT_L(0); PG8_MMA(0, 1, At, B1); PG8_BAR;
            PG8_LDA(At, 1, 1); PG8_STAGE(PG8_SA(1, 0), a3, voffA);
            PG8_BAR; PG8_WAIT_L(0); PG8_MMA(1, 0, At, B0); PG8_BAR; PG8_SCHED;
            PG8_STAGE(PG8_SB(1, 1), b3 + hstep, voffB);
            PG8_WAIT_V(6); PG8_BAR; PG8_MMA(1, 1, At, B1); PG8_BAR;
        }
        if constexpr (!Epi::AFTER_DRAIN) { E(acc, cur, wr, wc, fr, fq); S.done(cur); }
        if (!has_next) break;
#pragma unroll
        for (int a = 0; a < 2; ++a)
#pragma unroll
            for (int b = 0; b < 2; ++b)
#pragma unroll
                for (int m = 0; m < 4; ++m)
#pragma unroll
                    for (int n = 0; n < 2; ++n) acc[a][b][m][n] = (f32x4){0.f, 0.f, 0.f, 0.f};
        cur = nxt; cA = nA; cB = nB; ++ui;
    }
    PG8_WAIT_V(0);
    if (wr == 0) PG8_BAR;
    PG8_BAR;
    if constexpr (Epi::AFTER_DRAIN) { E.fused(acc, cur, wr, wc, fr, fq, lds, wid, lane); S.done(cur); }
#undef PG8_SA
#undef PG8_SB
#undef PG8_STAGE
#undef PG8_LDA
#undef PG8_LDB
#undef PG8_MMA
#undef PG8_WAIT_V
#undef PG8_WAIT_L
#undef PG8_BAR
#undef PG8_SCHED
}
}


typedef unsigned short bf16_t;
typedef short bf16x8 __attribute__((ext_vector_type(8)));
typedef float f32x4 __attribute__((ext_vector_type(4)));
typedef unsigned u32x4 __attribute__((ext_vector_type(4)));
typedef unsigned u32x2 __attribute__((ext_vector_type(2)));

constexpr int MTOK = 32768, DM = 1024, SEQ = 16384, NTH = 512;
constexpr int GIN = 3088, GIN_P = 3328, RIN = 4224, RIN_P = 4352;
constexpr int LDS_BYTES = 131072;

constexpr size_t WS_WGIN  = 0;
constexpr size_t WS_WGOUT = WS_WGIN  + (size_t)GIN_P * DM * 2;
constexpr size_t WS_WRIN  = WS_WGOUT + (size_t)DM * DM * 2;
constexpr size_t WS_WROUT = WS_WRIN  + (size_t)RIN_P * DM * 2;
constexpr size_t WS_WDUT  = WS_WROUT + (size_t)DM * DM * 2;
constexpr size_t WS_WIUT  = WS_WDUT  + (size_t)DM * 64 * 2;
constexpr size_t WS_A     = WS_WIUT  + (size_t)DM * 64 * 2;
constexpr size_t WS_Y     = WS_A     + (size_t)MTOK * DM * 2;
constexpr size_t WS_GS    = WS_Y     + (size_t)MTOK * DM * 2;
constexpr size_t WS_GD    = WS_GS    + (size_t)8 * 32 * 128 * 256 * 4;
constexpr size_t WS_P     = WS_GD    + (size_t)8 * 32 * 128 * 4;
constexpr size_t WS_BAR   = WS_P     + (size_t)MTOK * RIN_P * 2;
constexpr size_t WS_END   = WS_BAR   + 16384;

struct Params { const float* in[22]; float* out; unsigned char* ws; int ph_lo, ph_hi; };

__device__ __forceinline__ float bf2f(unsigned b) { return __uint_as_float(b << 16); }
__device__ __forceinline__ bf16_t f2bf(float f) { unsigned u = __float_as_uint(f); u += 0x7FFFu + ((u >> 16) & 1u); return (bf16_t)(u >> 16); }
__device__ __forceinline__ unsigned pk2(float lo, float hi) { return pg8::cvt_pk_bf16(lo, hi); }
__device__ __forceinline__ float wave_sum(float x) {
#pragma unroll
    for (int off = 32; off >= 1; off >>= 1) x += __shfl_xor(x, off);
    return x;
}
__device__ __forceinline__ f32x4 mfma16(bf16x8 a, bf16x8 b, f32x4 c) { return __builtin_amdgcn_mfma_f32_16x16x32_bf16(a, b, c, 0, 0, 0); }
__device__ __forceinline__ bf16x8 as_bf16x8(u32x4 v) { union { u32x4 u; bf16x8 b; } x; x.u = v; return x.b; }
__device__ __forceinline__ float log_sigmoid(float z) { return fminf(z, 0.f) - log1pf(__expf(-fabsf(z))); }
__device__ __forceinline__ float softplus(float z) { return fmaxf(z, 0.f) + log1pf(__expf(-fabsf(z))); }

__device__ void prep_weight(const float* __restrict__ W, int N, const float* __restrict__ gain, bf16_t* __restrict__ Wt, int NP, float* tile) {
    const int tid = threadIdx.x;
    const int nu = (NP / 64) * 16;
    for (int u = blockIdx.x; u < nu; u += gridDim.x) {
        const int n0 = (u >> 4) * 64, k0 = (u & 15) * 64;
        {
            const int j = tid & 63, i0 = tid >> 6;
#pragma unroll
            for (int r = 0; r < 8; ++r) {
                const int i = i0 + 8 * r, k = k0 + i, n = n0 + j;
                float v = 0.f;
                if (n < N) { v = W[(size_t)k * N + n]; if (gain) v *= gain[k]; }
                tile[i * 65 + j] = v;
            }
        }
        __syncthreads();
        {
            const int i = tid & 63, j0 = tid >> 6;
#pragma unroll
            for (int r = 0; r < 8; ++r) {
                const int j = j0 + 8 * r;
                Wt[(size_t)(n0 + j) * DM + k0 + i] = f2bf(tile[i * 65 + j]);
            }
        }
        __syncthreads();
    }
}

__device__ void prep_lowrank(const float* __restrict__ src, bf16_t* __restrict__ dst) {
    for (int idx = blockIdx.x * NTH + threadIdx.x; idx < 65536; idx += gridDim.x * NTH) dst[idx] = f2bf(src[(idx & 63) * 1024 + (idx >> 6)]);
}

struct EpiBf16Bnd {
    static constexpr bool PERM = true, AFTER_DRAIN = false;
    bf16_t* O; int ldc; bf16_t* bnd;
    __device__ __forceinline__ void operator()(const f32x4 (&acc)[2][2][4][2], const pg8::Unit& u, int wr, int wc, int fr, int fq) const {
        const int row0 = u.pm * pg8::BM + wr * 64 + fr, col0 = u.pn * pg8::BM + wc * 32 + 8 * fq;
#pragma unroll
        for (int ai = 0; ai < 2; ++ai)
#pragma unroll
            for (int m = 0; m < 4; ++m) {
                const int row = row0 + ai * pg8::HALF + m * 16;
                bf16_t* rowp = O + (size_t)row * ldc + col0;
#pragma unroll
                for (int bj = 0; bj < 2; ++bj) {
                    const f32x4 v0 = acc[ai][bj][m][0], v1 = acc[ai][bj][m][1];
                    u32x4 wv; wv.x = pk2(v0[0], v0[1]); wv.y = pk2(v0[2], v0[3]); wv.z = pk2(v1[0], v1[1]); wv.w = pk2(v1[2], v1[3]);
                    *(u32x4*)(rowp + bj * pg8::HALF) = wv;
                    if (m == 3 && fr == 15) *(u32x4*)(bnd + (size_t)((row >> 6) + 1) * ldc + col0 + bj * pg8::HALF) = wv;
                }
            }
    }
};

__device__ void phase_norm0(const Params& p) {
    const int tid = threadIdx.x, lane = tid & 63, w = tid >> 6;
    const float* x = p.in[0];
    bf16_t* A = (bf16_t*)(p.ws + WS_A);
    for (int row = blockIdx.x * 8 + w; row < MTOK; row += gridDim.x * 8) {
        const float4* xr = (const float4*)(x + (size_t)row * DM);
        float4 v[4];
#pragma unroll
        for (int i = 0; i < 4; ++i) v[i] = xr[lane + 64 * i];
        float ss = 0.f;
#pragma unroll
        for (int i = 0; i < 4; ++i) ss += v[i].x * v[i].x + v[i].y * v[i].y + v[i].z * v[i].z + v[i].w * v[i].w;
        ss = wave_sum(ss);
        const float rstd = rsqrtf(ss * (1.0f / DM) + 1e-6f);
#pragma unroll
        for (int i = 0; i < 4; ++i) {
            u32x2 o; o.x = pk2(v[i].x * rstd, v[i].y * rstd); o.y = pk2(v[i].z * rstd, v[i].w * rstd);
            *(u32x2*)(A + (size_t)row * DM + 4 * (lane + 64 * i)) = o;
        }
    }
}

__device__ void phase_norm1(const Params& p) {
    const int tid = threadIdx.x, lane = tid & 63, w = tid >> 6;
    const float* x = p.in[0];
    const float* gpost = p.in[7];
    const bf16_t* Y = (const bf16_t*)(p.ws + WS_Y);
    bf16_t* A = (bf16_t*)(p.ws + WS_A);
    float4 gp[4];
#pragma unroll
    for (int i = 0; i < 4; ++i) gp[i] = ((const float4*)gpost)[lane + 64 * i];
    for (int row = blockIdx.x * 8 + w; row < MTOK; row += gridDim.x * 8) {
        const float4* xr = (const float4*)(x + (size_t)row * DM);
        float4 v[4]; u32x2 yv[4];
#pragma unroll
        for (int i = 0; i < 4; ++i) { v[i] = xr[lane + 64 * i]; yv[i] = *(const u32x2*)(Y + (size_t)row * DM + 4 * (lane + 64 * i)); }
        float4 y[4];
        float ss = 0.f;
#pragma unroll
        for (int i = 0; i < 4; ++i) {
            y[i].x = bf2f(yv[i].x & 0xffffu); y[i].y = bf2f(yv[i].x >> 16); y[i].z = bf2f(yv[i].y & 0xffffu); y[i].w = bf2f(yv[i].y >> 16);
            ss += y[i].x * y[i].x + y[i].y * y[i].y + y[i].z * y[i].z + y[i].w * y[i].w;
        }
        ss = wave_sum(ss);
        const float rstdy = rsqrtf(ss * (1.0f / DM) + 1e-6f);
        float s1 = 0.f;
#pragma unroll
        for (int i = 0; i < 4; ++i) {
            v[i].x += y[i].x * rstdy * gp[i].x; v[i].y += y[i].y * rstdy * gp[i].y; v[i].z += y[i].z * rstdy * gp[i].z; v[i].w += y[i].w * rstdy * gp[i].w;
            s1 += v[i].x * v[i].x + v[i].y * v[i].y + v[i].z * v[i].z + v[i].w * v[i].w;
            ((float4*)(p.out + (size_t)row * DM))[lane + 64 * i] = v[i];
        }
        s1 = wave_sum(s1);
        const float rstd = rsqrtf(s1 * (1.0f / DM) + 1e-6f);
#pragma unroll
        for (int i = 0; i < 4; ++i) {
            u32x2 o; o.x = pk2(v[i].x * rstd, v[i].y * rstd); o.y = pk2(v[i].z * rstd, v[i].w * rstd);
            *(u32x2*)(A + (size_t)row * DM + 4 * (lane + 64 * i)) = o;
        }
    }
}

__device__ void phase_final(const Params& p) {
    const int tid = threadIdx.x, lane = tid & 63, w = tid >> 6;
    const float* gpost = p.in[21];
    const bf16_t* Y = (const bf16_t*)(p.ws + WS_Y);
    float4 gp[4];
#pragma unroll
    for (int i = 0; i < 4; ++i) gp[i] = ((const float4*)gpost)[lane + 64 * i];
    for (int row = blockIdx.x * 8 + w; row < MTOK; row += gridDim.x * 8) {
        float4* xr = (float4*)(p.out + (size_t)row * DM);
        float4 v[4]; u32x2 yv[4];
#pragma unroll
        for (int i = 0; i < 4; ++i) { v[i] = xr[lane + 64 * i]; yv[i] = *(const u32x2*)(Y + (size_t)row * DM + 4 * (lane + 64 * i)); }
        float4 y[4];
        float ss = 0.f;
#pragma unroll
        for (int i = 0; i < 4; ++i) {
            y[i].x = bf2f(yv[i].x & 0xffffu); y[i].y = bf2f(yv[i].x >> 16); y[i].z = bf2f(yv[i].y & 0xffffu); y[i].w = bf2f(yv[i].y >> 16);
            ss += y[i].x * y[i].x + y[i].y * y[i].y + y[i].z * y[i].z + y[i].w * y[i].w;
        }
        ss = wave_sum(ss);
        const float rstdy = rsqrtf(ss * (1.0f / DM) + 1e-6f);
#pragma unroll
        for (int i = 0; i < 4; ++i) {
            v[i].x += y[i].x * rstdy * gp[i].x; v[i].y += y[i].y * rstdy * gp[i].y; v[i].z += y[i].z * rstdy * gp[i].z; v[i].w += y[i].w * rstdy * gp[i].w;
            xr[lane + 64 * i] = v[i];
        }
    }
}

constexpr int L_AD = 0, L_TOT = 4096, L_DEC = 6144, L_SSQ = 6656, L_QD = 8704, L_KD = L_QD + 64 * 136 * 2, L_KT = L_KD + 64 * 136 * 2, L_VT = L_KT + 128 * 72 * 2,
              L_ATT = L_VT + 256 * 72 * 2, L_GLA_END = L_ATT + 64 * 72 * 2;
static_assert(L_GLA_END <= LDS_BYTES, "GLA LDS");

template <bool OUT>
__device__ void gla_pass(const Params& p, unsigned char* lds) {
    const int tid = threadIdx.x, lane = tid & 63, w = tid >> 6, l15 = lane & 15, g = lane >> 4;
    const bf16_t* P = (const bf16_t*)(p.ws + WS_P);
    float* GS = (float*)(p.ws + WS_GS);
    float* GD = (float*)(p.ws + WS_GD);
    bf16_t* Aout = (bf16_t*)(p.ws + WS_A);
    float* ADs = (float*)(lds + L_AD); float* TOT = (float*)(lds + L_TOT); float* DEC = (float*)(lds + L_DEC); float* SSQ = (float*)(lds + L_SSQ);
    bf16_t* QD = (bf16_t*)(lds + L_QD); bf16_t* KD = (bf16_t*)(lds + L_KD); bf16_t* KT = (bf16_t*)(lds + L_KT); bf16_t* VT = (bf16_t*)(lds + L_VT); bf16_t* ATT = (bf16_t*)(lds + L_ATT);
    const float* w_up = p.in[3]; const float* b_al = p.in[4]; const float* g_head = p.in[5];
    const int d = tid & 127, rg = tid >> 7;

    for (int unit = blockIdx.x; unit < 256; unit += gridDim.x) {
        const int bh = unit >> 5, m = unit & 31, b = bh >> 2, h = bh & 3;
        const int tokbase = b * SEQ + m * 512;
        float wup[16];
#pragma unroll
        for (int j = 0; j < 16; ++j) wup[j] = w_up[j * 512 + h * 128 + d];
        const float bA = b_al[h * 128 + d];
        float gh[2];
#pragma unroll
        for (int vt = 0; vt < 2; ++vt) gh[vt] = g_head[32 * w + 16 * vt + l15];
        float logD = 0.f;
        f32x4 S[8][2];
#pragma unroll
        for (int mt = 0; mt < 8; ++mt)
#pragma unroll
            for (int vt = 0; vt < 2; ++vt) {
                if (OUT) {
#pragma unroll
                    for (int r = 0; r < 4; ++r) S[mt][vt][r] = GS[((size_t)(bh * 32 + m) * 128 + 16 * mt + 4 * g + r) * 256 + 32 * w + 16 * vt + l15];
                } else S[mt][vt] = (f32x4){0.f, 0.f, 0.f, 0.f};
            }

        for (int ch = 0; ch < 8; ++ch) {
            const int tok0 = tokbase + ch * 64;
            {
                const int idx = tid * 2, c = idx >> 4, j = idx & 15;
                const unsigned v = *(const unsigned*)(P + (size_t)(tok0 + c) * GIN_P + 3072 + j);
                ADs[idx] = bf2f(v & 0xffffu); ADs[idx + 1] = bf2f(v >> 16);
            }
            __syncthreads();
            float cs[16]; float run = 0.f;
#pragma unroll
            for (int i = 0; i < 16; ++i) {
                const float4* ar = (const float4*)(ADs + (16 * rg + i) * 16);
                float z = bA;
#pragma unroll
                for (int q = 0; q < 4; ++q) { const float4 a = ar[q]; z += a.x * wup[4 * q] + a.y * wup[4 * q + 1] + a.z * wup[4 * q + 2] + a.w * wup[4 * q + 3]; }
                run += log_sigmoid(z) * (1.0f / 16.0f);
                cs[i] = run;
            }
            TOT[rg * 128 + d] = run;
            __syncthreads();
            float off = 0.f, blast = 0.f;
#pragma unroll
            for (int r = 0; r < 4; ++r) { const float t = TOT[r * 128 + d]; blast += t; if (r < rg) off += t; }
            {
                unsigned kt[8];
#pragma unroll
                for (int i = 0; i < 16; i += 2) {
                    float kv[2];
#pragma unroll
                    for (int e = 0; e < 2; ++e) {
                        const int c = 16 * rg + i + e;
                        const float bb = cs[i + e] + off;
                        const bf16_t* row = P + (size_t)(tok0 + c) * GIN_P + h * 128 + d;
                        const float kx = bf2f(row[512]);
                        kv[e] = kx * __expf(blast - bb);
                        if (OUT) {
                            const float qx = bf2f(row[0]);
                            QD[c * 136 + d] = f2bf(qx * 0.08838834764831845f * __expf(bb));
                            KD[c * 136 + d] = f2bf(kx * __expf(-bb));
                        }
                    }
                    kt[i >> 1] = pk2(kv[0], kv[1]);
                }
                u32x4* dst = (u32x4*)(KT + d * 72 + 16 * rg);
                dst[0] = (u32x4){kt[0], kt[1], kt[2], kt[3]};
                dst[1] = (u32x4){kt[4], kt[5], kt[6], kt[7]};
            }
            if (rg == 0) { DEC[d] = __expf(blast); logD += blast; }
            {
                const int v = tid & 255, chh = tid >> 8;
                const bf16_t* vp = P + (size_t)(tok0 + 32 * chh) * GIN_P + 1024 + h * 256 + v;
#pragma unroll
                for (int q4 = 0; q4 < 4; ++q4) {
                    unsigned e[8];
#pragma unroll
                    for (int i = 0; i < 8; ++i) e[i] = vp[(size_t)(q4 * 8 + i) * GIN_P];
                    *(u32x4*)(VT + v * 72 + 32 * chh + 8 * q4) = (u32x4){e[0] | (e[1] << 16), e[2] | (e[3] << 16), e[4] | (e[5] << 16), e[6] | (e[7] << 16)};
                }
            }
            __syncthreads();

            f32x4 o[4][2];
            if (OUT) {
#pragma unroll
                for (int t2 = 0; t2 < 2; ++t2) {
                    const int tl = 2 * w + t2, ct = tl >> 2, st = tl & 3;
                    f32x4 acc = (f32x4){0.f, 0.f, 0.f, 0.f};
                    if (st <= ct) {
#pragma unroll
                        for (int kk = 0; kk < 4; ++kk) {
                            const bf16x8 a = *(const bf16x8*)(KD + (16 * st + l15) * 136 + 32 * kk + 8 * g);
                            const bf16x8 bq = *(const bf16x8*)(QD + (16 * ct + l15) * 136 + 32 * kk + 8 * g);
                            acc = mfma16(a, bq, acc);
                        }
#pragma unroll
                        for (int r = 0; r < 4; ++r) if (16 * st + 4 * g + r > 16 * ct + l15) acc[r] = 0.f;
                    }
                    u32x2 pk; pk.x = pk2(acc[0], acc[1]); pk.y = pk2(acc[2], acc[3]);
                    *(u32x2*)(ATT + (16 * ct + l15) * 72 + 16 * st + 4 * g) = pk;
                }
                __syncthreads();
#pragma unroll
                for (int ct = 0; ct < 4; ++ct)
#pragma unroll
                    for (int vt = 0; vt < 2; ++vt) o[ct][vt] = (f32x4){0.f, 0.f, 0.f, 0.f};
#pragma unroll
                for (int kk = 0; kk < 4; ++kk) {
                    bf16x8 sb[2];
#pragma unroll
                    for (int vt = 0; vt < 2; ++vt)
                        sb[vt] = as_bf16x8((u32x4){pk2(S[2 * kk][vt][0], S[2 * kk][vt][1]), pk2(S[2 * kk][vt][2], S[2 * kk][vt][3]),
                                                   pk2(S[2 * kk + 1][vt][0], S[2 * kk + 1][vt][1]), pk2(S[2 * kk + 1][vt][2], S[2 * kk + 1][vt][3])});
#pragma unroll
                    for (int ct = 0; ct < 4; ++ct) {
                        const bf16_t* qr = QD + (16 * ct + l15) * 136 + 32 * kk + 4 * g;
                        const u32x2 lo = *(const u32x2*)qr, hi = *(const u32x2*)(qr + 16);
                        const bf16x8 a = as_bf16x8((u32x4){lo.x, lo.y, hi.x, hi.y});
#pragma unroll
                        for (int vt = 0; vt < 2; ++vt) o[ct][vt] = mfma16(a, sb[vt], o[ct][vt]);
                    }
                }
            }
            bf16x8 bv[2][2];
#pragma unroll
            for (int vt = 0; vt < 2; ++vt)
#pragma unroll
                for (int kk = 0; kk < 2; ++kk) bv[vt][kk] = *(const bf16x8*)(VT + (32 * w + 16 * vt + l15) * 72 + 32 * kk + 8 * g);
            if (OUT) {
#pragma unroll
                for (int ct = 0; ct < 4; ++ct)
#pragma unroll
                    for (int kk = 0; kk < 2; ++kk) {
                        if (32 * kk <= 16 * ct + 15) {
                            const bf16x8 a = *(const bf16x8*)(ATT + (16 * ct + l15) * 72 + 32 * kk + 8 * g);
#pragma unroll
                            for (int vt = 0; vt < 2; ++vt) o[ct][vt] = mfma16(a, bv[vt][kk], o[ct][vt]);
                        }
                    }
            }
#pragma unroll
            for (int mt = 0; mt < 8; ++mt) {
                const f32x4 dv = *(const f32x4*)(DEC + 16 * mt + 4 * g);
#pragma unroll
                for (int vt = 0; vt < 2; ++vt) S[mt][vt] *= dv;
#pragma unroll
                for (int kk = 0; kk < 2; ++kk) {
                    const bf16x8 a = *(const bf16x8*)(KT + (16 * mt + l15) * 72 + 32 * kk + 8 * g);
#pragma unroll
                    for (int vt = 0; vt < 2; ++vt) S[mt][vt] = mfma16(a, bv[vt][kk], S[mt][vt]);
                }
            }
            if (OUT) {
                float ss[4][4];
#pragma unroll
                for (int ct = 0; ct < 4; ++ct)
#pragma unroll
                    for (int r = 0; r < 4; ++r) {
                        float s = o[ct][0][r] * o[ct][0][r] + o[ct][1][r] * o[ct][1][r];
                        s += __shfl_xor(s, 1); s += __shfl_xor(s, 2); s += __shfl_xor(s, 4); s += __shfl_xor(s, 8);
                        ss[ct][r] = s;
                    }
                if (l15 == 0) {
#pragma unroll
                    for (int ct = 0; ct < 4; ++ct)
#pragma unroll
                        for (int r = 0; r < 4; ++r) SSQ[(16 * ct + 4 * g + r) * 8 + w] = ss[ct][r];
                }
                __syncthreads();
#pragma unroll
                for (int ct = 0; ct < 4; ++ct)
#pragma unroll
                    for (int r = 0; r < 4; ++r) {
                        const int c = 16 * ct + 4 * g + r;
                        const float4 s0 = *(const float4*)(SSQ + c * 8), s1 = *(const float4*)(SSQ + c * 8 + 4);
                        const float tot = (s0.x + s0.y) + (s0.z + s0.w) + (s1.x + s1.y) + (s1.z + s1.w);
                        const float rstd = rsqrtf(tot * (1.0f / 256.0f) + 1e-6f);
#pragma unroll
                        for (int vt = 0; vt < 2; ++vt) {
                            const int v = 32 * w + 16 * vt + l15;
                            const float gt = bf2f(P[(size_t)(tok0 + c) * GIN_P + 2048 + h * 256 + v]);
                            const float val = o[ct][vt][r] * rstd * gh[vt] * gt / (1.0f + __expf(-gt));
                            Aout[(size_t)(tok0 + c) * DM + h * 256 + v] = f2bf(val);
                        }
                    }
            }
        }
        if (!OUT) {
#pragma unroll
            for (int mt = 0; mt < 8; ++mt)
#pragma unroll
                for (int vt = 0; vt < 2; ++vt)
#pragma unroll
                    for (int r = 0; r < 4; ++r) GS[((size_t)(bh * 32 + m) * 128 + 16 * mt + 4 * g + r) * 256 + 32 * w + 16 * vt + l15] = S[mt][vt][r];
            if (rg == 0) GD[(bh * 32 + m) * 128 + d] = __expf(logD);
        }
        __syncthreads();
    }
}

__device__ void gla_scan(const Params& p) {
    float* GS = (float*)(p.ws + WS_GS);
    const float* GD = (const float*)(p.ws + WS_GD);
    for (int idx = blockIdx.x * NTH + threadIdx.x; idx < 8 * 32768; idx += gridDim.x * NTH) {
        const int bh = idx >> 15, e = idx & 32767, d = e >> 8;
        float S = 0.f;
        for (int m0 = 0; m0 < 32; m0 += 16) {
            float t[16], dd[16];
#pragma unroll
            for (int m = 0; m < 16; ++m) { t[m] = GS[(size_t)(bh * 32 + m0 + m) * 32768 + e]; dd[m] = GD[(bh * 32 + m0 + m) * 128 + d]; }
#pragma unroll
            for (int m = 0; m < 16; ++m) { GS[(size_t)(bh * 32 + m0 + m) * 32768 + e] = S; S = S * dd[m] + t[m]; }
        }
    }
}

constexpr int PP = RIN_P;
constexpr size_t WS_RK  = WS_GS;
constexpr size_t WS_BND = WS_GS + (size_t)MTOK * 16 * 4;
static_assert(WS_BND + (size_t)513 * PP * 2 <= WS_GD, "RWKV side buffers must fit the GLA state region");
constexpr int IMG = 64 * 72 * 2;
constexpr int R_ALB = 0, R_BH = IMG, R_KH = 2 * IMG, R_RB = 3 * IMG, R_BTL = 4 * IMG, R_KTL = 5 * IMG, R_VI = 6 * IMG, R_AAB = 7 * IMG, R_AAK = 8 * IMG, R_ARB = 9 * IMG, R_ARK = 10 * IMG,
              R_DW = R_AAB, R_DA = R_AAB + 64 * 68 * 4, R_XT = 11 * IMG, R_TW = R_XT, R_ADI = R_XT + IMG, R_TDF = R_XT + 2 * IMG, R_CS = R_TDF + 2048, R_GC = R_CS + 2048, R_CONST = R_GC + 256,
              R_END = R_CONST + 2560;
static_assert(R_DA + 64 * 68 * 4 <= R_XT && R_END <= LDS_BYTES, "R1 LDS");
#define LDS_BARRIER() do { asm volatile("s_waitcnt lgkmcnt(0)" ::: "memory"); __builtin_amdgcn_s_barrier(); asm volatile("" ::: "memory"); } while (0)

typedef short s16x4 __attribute__((ext_vector_type(4)));
__device__ __forceinline__ bf16x8 ldfrag(const bf16_t* img, int row, int koff) { return *(const bf16x8*)(img + row * 72 + koff); }
__device__ __forceinline__ u32x2 pk4(f32x4 v) { u32x2 r; r.x = pk2(v[0], v[1]); r.y = pk2(v[2], v[3]); return r; }
__device__ __forceinline__ f32x4 unpk4(u32x2 v) { return (f32x4){bf2f(v.x & 0xffffu), bf2f(v.x >> 16), bf2f(v.y & 0xffffu), bf2f(v.y >> 16)}; }
__device__ __forceinline__ u32x2 trread(const bf16_t* p) {
    union { s16x4 s; u32x2 u; } x; x.s = __builtin_amdgcn_ds_read_tr16_b64_v4i16((__attribute__((address_space(3))) s16x4*)p); return x.u;
}
__device__ __forceinline__ bf16x8 trfrag(const bf16_t* img, int k0, int c0, int g, int q, int pq) {
    const bf16_t* a = img + (k0 + 8 * g + q) * 72 + c0 + 4 * pq;
    const u32x2 lo = trread(a), hi = trread(a + 4 * 72);
    return as_bf16x8((u32x4){lo.x, lo.y, hi.x, hi.y});
}
__device__ __forceinline__ f32x4 lo4(u32x4 v) { return (f32x4){bf2f(v.x & 0xffffu), bf2f(v.x >> 16), bf2f(v.y & 0xffffu), bf2f(v.y >> 16)}; }
__device__ __forceinline__ f32x4 hi4(u32x4 v) { return (f32x4){bf2f(v.z & 0xffffu), bf2f(v.z >> 16), bf2f(v.w & 0xffffu), bf2f(v.w >> 16)}; }
__device__ __forceinline__ u32x4 pk8(f32x4 a, f32x4 b) { return (u32x4){pk2(a[0], a[1]), pk2(a[2], a[3]), pk2(b[0], b[1]), pk2(b[2], b[3])}; }
__device__ __forceinline__ float fast_rcp(float x) { return __builtin_amdgcn_rcpf(x); }
__device__ __forceinline__ f32x4 mm16(f32x4 xa, f32x4 yb, f32x4 c) {
    const u32x2 a = pk4(xa), b = pk4(yb);
    return mfma16(as_bf16x8((u32x4){a.x, a.y, 0u, 0u}), as_bf16x8((u32x4){b.x, b.y, 0u, 0u}), c);
}

struct R1Raw { u32x4 r0, r1, k0, k1, v0, v1, w0, w1, a0, a1; };
__device__ __forceinline__ void r1_issue(R1Raw& x, const bf16_t* P, const bf16_t* BND, int unit, int t, int cs) {
    const int bn = unit >> 4, h = unit & 15;
    const bf16_t* cur = P + ((size_t)bn * 64 + t) * PP;
    const bf16_t* prv = (t > 0) ? (cur - PP) : (BND + (size_t)bn * PP);
    const int ch = h * 64 + 8 * cs;
    x.r0 = *(const u32x4*)(cur + ch); x.k0 = *(const u32x4*)(cur + 1024 + ch); x.v0 = *(const u32x4*)(cur + 2048 + ch); x.w0 = *(const u32x4*)(cur + 4096 + 8 * cs); x.a0 = *(const u32x4*)(cur + 4160 + 8 * cs);
    x.r1 = *(const u32x4*)(prv + ch); x.k1 = *(const u32x4*)(prv + 1024 + ch); x.v1 = *(const u32x4*)(prv + 2048 + ch); x.w1 = *(const u32x4*)(prv + 4096 + 8 * cs); x.a1 = *(const u32x4*)(prv + 4160 + 8 * cs);
}
__device__ __forceinline__ void lerp8(u32x4 c, u32x4 pv, bool zprev, const float* mu8, f32x4& o0, f32x4& o1) {
    const f32x4 c0 = lo4(c), c1 = hi4(c);
    f32x4 p0 = lo4(pv), p1 = hi4(pv);
    if (zprev) { p0 = (f32x4){0.f, 0.f, 0.f, 0.f}; p1 = p0; }
    const f32x4 m0 = *(const f32x4*)mu8, m1 = *(const f32x4*)(mu8 + 4);
    o0 = c0 + m0 * (p0 - c0); o1 = c1 + m1 * (p1 - c1);
}

__device__ void rwkv_r1(const Params& p, unsigned char* lds) {
    const int tid = threadIdx.x, lane = tid & 63, w = tid >> 6, l15 = lane & 15, g = lane >> 4, q4 = l15 >> 2, p4 = l15 & 3;
    bf16_t* P = (bf16_t*)(p.ws + WS_P);
    bf16_t* Abuf = (bf16_t*)(p.ws + WS_A);
    bf16_t* Ybuf = (bf16_t*)(p.ws + WS_Y);
    float* RK = (float*)(p.ws + WS_RK);
    const bf16_t* BND = (const bf16_t*)(p.ws + WS_BND);
    const bf16_t* WduT = (const bf16_t*)(p.ws + WS_WDUT);
    const bf16_t* WiuT = (const bf16_t*)(p.ws + WS_WIUT);
    bf16_t* ALB = (bf16_t*)(lds + R_ALB); bf16_t* BH = (bf16_t*)(lds + R_BH); bf16_t* KH = (bf16_t*)(lds + R_KH); bf16_t* RB = (bf16_t*)(lds + R_RB);
    bf16_t* BTL = (bf16_t*)(lds + R_BTL); bf16_t* KTL = (bf16_t*)(lds + R_KTL); bf16_t* VI = (bf16_t*)(lds + R_VI);
    bf16_t* AAB = (bf16_t*)(lds + R_AAB); bf16_t* AAK = (bf16_t*)(lds + R_AAK); bf16_t* ARB = (bf16_t*)(lds + R_ARB); bf16_t* ARK = (bf16_t*)(lds + R_ARK);
    float* DW = (float*)(lds + R_DW); float* DA = (float*)(lds + R_DA);
    bf16_t* XT = (bf16_t*)(lds + R_XT); bf16_t* TW = (bf16_t*)(lds + R_TW); bf16_t* ADI = (bf16_t*)(lds + R_ADI);
    u32x2* TDF = (u32x2*)(lds + R_TDF); float* CS = (float*)(lds + R_CS); float* GCs = (float*)(lds + R_GC); float* CONST = (float*)(lds + R_CONST);
    const int t = tid >> 3, cs = tid & 7, tl = lane >> 3;
    int hprev = -1;
    R1Raw raw;
    if (blockIdx.x < 8192) r1_issue(raw, P, BND, blockIdx.x, t, cs);

    for (int unit = blockIdx.x; unit < 8192; unit += gridDim.x) {
        const int bn = unit >> 4, h = unit & 15, n = bn & 255;
        const size_t R0 = (size_t)bn * 64;
        if (h != hprev) {
            LDS_BARRIER();
            if (tid < 64) {
                const int ch = h * 64 + tid;
                CONST[tid] = p.in[10][ch]; CONST[64 + tid] = p.in[10][1024 + ch]; CONST[128 + tid] = p.in[10][2048 + ch];
                CONST[192 + tid] = p.in[11][ch]; CONST[256 + tid] = p.in[13][ch]; CONST[320 + tid] = p.in[15][ch]; CONST[384 + tid] = p.in[16][ch]; CONST[448 + tid] = p.in[17][ch];
                CONST[512 + tid] = p.in[10][4096 + tid]; CONST[576 + tid] = p.in[10][4160 + tid];
            }
            hprev = h;
            LDS_BARRIER();
        }
        bf16x8 fwd[2][2], fwi[2][2];
#pragma unroll
        for (int q = 0; q < 2; ++q)
#pragma unroll
            for (int kk = 0; kk < 2; ++kk) {
                const size_t o = (size_t)(h * 64 + 16 * (2 * (w >> 2) + q) + l15) * 64 + 32 * kk + 8 * g;
                fwd[q][kk] = *(const bf16x8*)(WduT + o); fwi[q][kk] = *(const bf16x8*)(WiuT + o);
            }
        f32x4 r0, r1, k0, k1, v0, v1;
        {
            const bool zp = (t == 0 && n == 0);
            f32x4 wd0, wd1, ad0, ad1;
            lerp8(raw.r0, raw.r1, zp, CONST + 8 * cs, r0, r1);
            lerp8(raw.k0, raw.k1, zp, CONST + 64 + 8 * cs, k0, k1);
            lerp8(raw.v0, raw.v1, zp, CONST + 128 + 8 * cs, v0, v1);
            lerp8(raw.w0, raw.w1, zp, CONST + 512 + 8 * cs, wd0, wd1);
            lerp8(raw.a0, raw.a1, zp, CONST + 576 + 8 * cs, ad0, ad1);
#pragma unroll
            for (int j = 0; j < 4; ++j) {
                const float e0 = __expf(-2.f * fabsf(wd0[j])), e1 = __expf(-2.f * fabsf(wd1[j]));
                wd0[j] = copysignf((1.f - e0) * fast_rcp(1.f + e0), wd0[j]); wd1[j] = copysignf((1.f - e1) * fast_rcp(1.f + e1), wd1[j]);
            }
            *(u32x4*)(TW + t * 72 + 8 * cs) = pk8(wd0, wd1);
            *(u32x4*)(ADI + t * 72 + 8 * cs) = pk8(ad0, ad1);
        }
        if (unit + (int)gridDim.x < 8192) r1_issue(raw, P, BND, unit + gridDim.x, t, cs);
        LDS_BARRIER();
        {
            const int tt = w & 3;
            bf16x8 ft[2], fa[2];
#pragma unroll
            for (int kk = 0; kk < 2; ++kk) { ft[kk] = ldfrag(TW, 16 * tt + l15, 32 * kk + 8 * g); fa[kk] = ldfrag(ADI, 16 * tt + l15, 32 * kk + 8 * g); }
#pragma unroll
            for (int q = 0; q < 2; ++q) {
                const int ct = 2 * (w >> 2) + q;
                f32x4 aw = (f32x4){0.f, 0.f, 0.f, 0.f}, aa = aw;
#pragma unroll
                for (int kk = 0; kk < 2; ++kk) { aw = mfma16(fwd[q][kk], ft[kk], aw); aa = mfma16(fwi[q][kk], fa[kk], aa); }
                *(f32x4*)(DW + (16 * tt + l15) * 68 + 16 * ct + 4 * g) = aw;
                *(f32x4*)(DA + (16 * tt + l15) * 68 + 16 * ct + 4 * g) = aa;
            }
        }
        LDS_BARRIER();
        f32x4 lw[2], av[2], kk[2], k2[2], G[2];
        {
            const f32x4 cw0[2] = {*(const f32x4*)(CONST + 192 + 8 * cs), *(const f32x4*)(CONST + 196 + 8 * cs)};
            const f32x4 ca0[2] = {*(const f32x4*)(CONST + 256 + 8 * cs), *(const f32x4*)(CONST + 260 + 8 * cs)};
            const f32x4 ckk[2] = {*(const f32x4*)(CONST + 320 + 8 * cs), *(const f32x4*)(CONST + 324 + 8 * cs)};
            const f32x4 cka[2] = {*(const f32x4*)(CONST + 384 + 8 * cs), *(const f32x4*)(CONST + 388 + 8 * cs)};
            const f32x4 crk[2] = {*(const f32x4*)(CONST + 448 + 8 * cs), *(const f32x4*)(CONST + 452 + 8 * cs)};
            const f32x4 dwv[2] = {*(const f32x4*)(DW + t * 68 + 8 * cs), *(const f32x4*)(DW + t * 68 + 8 * cs + 4)};
            const f32x4 dav[2] = {*(const f32x4*)(DA + t * 68 + 8 * cs), *(const f32x4*)(DA + t * 68 + 8 * cs + 4)};
            const f32x4 kin[2] = {k0, k1}, rin[2] = {r0, r1};
            float n2 = 0.f, rk = 0.f;
#pragma unroll
            for (int hf = 0; hf < 2; ++hf)
#pragma unroll
                for (int j = 0; j < 4; ++j) {
                    const float z = -(cw0[hf][j] + dwv[hf][j]);
                    const float sp = fmaxf(z, 0.f) + __logf(1.f + __expf(-fabsf(z)));
                    lw[hf][j] = -__expf(-sp - 0.5f);
                    av[hf][j] = fast_rcp(1.f + __expf(-(ca0[hf][j] + dav[hf][j])));
                    kk[hf][j] = kin[hf][j] * ckk[hf][j];
                    k2[hf][j] = kin[hf][j] * (1.f + (av[hf][j] - 1.f) * cka[hf][j]);
                    n2 += kk[hf][j] * kk[hf][j]; rk += rin[hf][j] * k2[hf][j] * crk[hf][j];
                }
            n2 += __shfl_xor(n2, 1); rk += __shfl_xor(rk, 1); n2 += __shfl_xor(n2, 2); rk += __shfl_xor(rk, 2); n2 += __shfl_xor(n2, 4); rk += __shfl_xor(rk, 4);
            const float inv = 1.0f / fmaxf(sqrtf(n2), 1e-12f);
            kk[0] *= inv; kk[1] *= inv;
            if (cs == 0) RK[(R0 + t) * 16 + h] = rk;
            G[0] = lw[0]; G[1] = lw[1];
#pragma unroll
            for (int d = 1; d < 8; d <<= 1)
#pragma unroll
                for (int hf = 0; hf < 2; ++hf)
#pragma unroll
                    for (int j = 0; j < 4; ++j) { const float y = __shfl_up(G[hf][j], 8 * d); if (tl >= d) G[hf][j] += y; }
            if (tl == 7) { *(f32x4*)(CS + w * 64 + 8 * cs) = G[0]; *(f32x4*)(CS + w * 64 + 8 * cs + 4) = G[1]; }
        }
        LDS_BARRIER();
        {
            f32x4 off[2] = {(f32x4){0.f, 0.f, 0.f, 0.f}, (f32x4){0.f, 0.f, 0.f, 0.f}}, gc[2] = {off[0], off[0]};
#pragma unroll
            for (int q = 0; q < 8; ++q) {
                const f32x4 c0 = *(const f32x4*)(CS + q * 64 + 8 * cs), c1 = *(const f32x4*)(CS + q * 64 + 8 * cs + 4);
                gc[0] += c0; gc[1] += c1;
                if (q < w) { off[0] += c0; off[1] += c1; }
            }
            f32x4 al[2], bh[2], kh[2], rb[2], bt[2], kt[2];
            const f32x4 rin[2] = {r0, r1};
#pragma unroll
            for (int hf = 0; hf < 2; ++hf)
#pragma unroll
                for (int j = 0; j < 4; ++j) {
                    const float Gi = G[hf][j] + off[hf][j];
                    const float eG = __expf(Gi), eGm = __expf(Gi - lw[hf][j]), enG = fast_rcp(eG), eC = __expf(gc[hf][j] - Gi);
                    const float be = kk[hf][j] * av[hf][j];
                    al[hf][j] = -kk[hf][j] * eGm; bh[hf][j] = be * enG; kh[hf][j] = k2[hf][j] * enG; rb[hf][j] = rin[hf][j] * eG; bt[hf][j] = be * eC; kt[hf][j] = k2[hf][j] * eC;
                }
            const int o = t * 72 + 8 * cs;
            *(u32x4*)(ALB + o) = pk8(al[0], al[1]); *(u32x4*)(BH + o) = pk8(bh[0], bh[1]); *(u32x4*)(KH + o) = pk8(kh[0], kh[1]); *(u32x4*)(RB + o) = pk8(rb[0], rb[1]);
            *(u32x4*)(BTL + o) = pk8(bt[0], bt[1]); *(u32x4*)(KTL + o) = pk8(kt[0], kt[1]);
            const u32x4 vpk = pk8(v0, v1);
            *(u32x4*)(VI + o) = vpk;
            *(u32x4*)(Ybuf + (R0 + t) * DM + h * 64 + 8 * cs) = vpk;
            if (w == 0 && tl == 0) { f32x4 e0, e1;
#pragma unroll
                for (int j = 0; j < 4; ++j) { e0[j] = __expf(gc[0][j]); e1[j] = __expf(gc[1][j]); }
                *(f32x4*)(GCs + 8 * cs) = e0; *(f32x4*)(GCs + 8 * cs + 4) = e1; }
        }
        LDS_BARRIER();
        {
            int ntile = 1, tta = 0, sta = 0, ttb = 0, stb = 0;
            if (w == 0) { tta = 0; sta = 0; } else if (w == 2) { tta = 1; sta = 1; } else if (w == 5) { tta = 2; sta = 2; } else if (w == 7) { tta = 3; sta = 3; }
            else if (w == 1) { ntile = 2; tta = 1; sta = 0; ttb = 2; stb = 0; } else if (w == 3) { ntile = 2; tta = 2; sta = 1; ttb = 3; stb = 0; }
            else if (w == 4) { tta = 3; sta = 1; } else { tta = 3; sta = 2; }
            for (int it = 0; it < ntile; ++it) {
                const int tt = it ? ttb : tta, st = it ? stb : sta;
                f32x4 cab = (f32x4){0.f, 0.f, 0.f, 0.f}, cak = cab, crb = cab, crk = cab, nab = cab;
#pragma unroll
                for (int kq = 0; kq < 2; ++kq) {
                    const bf16x8 fb = ldfrag(BH, 16 * st + l15, 32 * kq + 8 * g), fk = ldfrag(KH, 16 * st + l15, 32 * kq + 8 * g);
                    const bf16x8 fa = ldfrag(ALB, 16 * tt + l15, 32 * kq + 8 * g), fr = ldfrag(RB, 16 * tt + l15, 32 * kq + 8 * g);
                    cab = mfma16(fb, fa, cab); cak = mfma16(fk, fa, cak); crb = mfma16(fb, fr, crb); crk = mfma16(fk, fr, crk);
                    if (tt == st) nab = mfma16(fa, fb, nab);
                }
                if (tt == st) {
#pragma unroll
                    for (int r = 0; r < 4; ++r) {
                        const int s = 4 * g + r, tq = l15;
                        if (s >= tq) { cab[r] = 0.f; cak[r] = 0.f; }
                        if (s > tq) { crb[r] = 0.f; crk[r] = 0.f; }
                        if (l15 >= 4 * g + r) nab[r] = 0.f;
                    }
                }
                const int o = (16 * tt + l15) * 72 + 16 * st + 4 * g;
                *(u32x2*)(AAB + o) = pk4(cab); *(u32x2*)(AAK + o) = pk4(cak); *(u32x2*)(ARB + o) = pk4(crb); *(u32x2*)(ARK + o) = pk4(crk);
                if (tt == st) {
                    const f32x4 z = (f32x4){0.f, 0.f, 0.f, 0.f};
                    const f32x4 Q1 = cab, N1 = nab;
                    const f32x4 Q2 = mm16(N1, Q1, z), N2 = mm16(Q1, N1, z);
                    f32x4 Pm = Q1;
#pragma unroll
                    for (int r = 0; r < 4; ++r) if (4 * g + r == l15) Pm[r] += 1.f;
                    Pm = mm16(N2, Pm, Pm);
                    const f32x4 Q4 = mm16(N2, Q2, z), N4 = mm16(Q2, N2, z);
                    Pm = mm16(N4, Pm, Pm);
                    const f32x4 N8 = mm16(Q4, N4, z);
                    Pm = mm16(N8, Pm, Pm);
                    TDF[tt * 64 + lane] = pk4(Pm);
                }
            }
            if (w == 4 || w == 6) {
                const int tt = (w == 4) ? 0 : 2, st = tt + 1;
                const int o = (16 * tt + l15) * 72 + 16 * st + 4 * g;
                const u32x2 zz = (u32x2){0u, 0u};
                *(u32x2*)(AAK + o) = zz; *(u32x2*)(ARB + o) = zz; *(u32x2*)(ARK + o) = zz;
            }
        }
        LDS_BARRIER();
        {
            u32x2 xb[4];
            const int col = 16 * w + l15;
            bf16x8 vfr[2];
            if (w >= 4) { vfr[0] = trfrag(VI, 0, 16 * (w - 4), g, q4, p4); vfr[1] = trfrag(VI, 32, 16 * (w - 4), g, q4, p4); }
#pragma unroll
            for (int i = 0; i < 4; ++i) {
                f32x4 z;
                if (w < 4) z = unpk4(trread(ALB + (16 * i + 4 * g + q4) * 72 + 16 * w + 4 * p4));
                else {
                    z = mfma16(ldfrag(AAK, 16 * i + l15, 8 * g), vfr[0], (f32x4){0.f, 0.f, 0.f, 0.f});
                    if (i >= 2) z = mfma16(ldfrag(AAK, 16 * i + l15, 32 + 8 * g), vfr[1], z);
                }
                if (i >= 1) {
                    const bf16_t* ar = AAB + (16 * i + l15) * 72 + 4 * g;
                    const u32x2 a0 = *(const u32x2*)ar;
                    u32x2 a1 = (u32x2){0u, 0u}, b1 = (u32x2){0u, 0u};
                    if (i >= 2) { a1 = *(const u32x2*)(ar + 16); b1 = xb[1]; }
                    z = mfma16(as_bf16x8((u32x4){a0.x, a0.y, a1.x, a1.y}), as_bf16x8((u32x4){xb[0].x, xb[0].y, b1.x, b1.y}), z);
                    if (i == 3) {
                        const u32x2 a2 = *(const u32x2*)(ar + 32);
                        z = mfma16(as_bf16x8((u32x4){a2.x, a2.y, 0u, 0u}), as_bf16x8((u32x4){xb[2].x, xb[2].y, 0u, 0u}), z);
                    }
                }
                const u32x2 tq = TDF[i * 64 + lane];
                const u32x2 zq = pk4(z);
                const f32x4 x = mfma16(as_bf16x8((u32x4){tq.x, tq.y, 0u, 0u}), as_bf16x8((u32x4){zq.x, zq.y, 0u, 0u}), (f32x4){0.f, 0.f, 0.f, 0.f});
                xb[i] = pk4(x);
                *(u32x2*)(XT + col * 72 + 16 * i + 4 * g) = xb[i];
            }
        }
        LDS_BARRIER();
        {
            const int rt_ = w & 3;
            bf16x8 xw[2], xu[2], fbt[2], fkt[2], fvr[2];
#pragma unroll
            for (int kq = 0; kq < 2; ++kq) {
                xw[kq] = ldfrag(XT, 16 * rt_ + l15, 32 * kq + 8 * g);
                xu[kq] = ldfrag(XT, 64 + 16 * rt_ + l15, 32 * kq + 8 * g);
                fbt[kq] = trfrag(BTL, 32 * kq, 16 * rt_, g, q4, p4);
                fkt[kq] = trfrag(KTL, 32 * kq, 16 * rt_, g, q4, p4);
                fvr[kq] = trfrag(VI, 32 * kq, 16 * rt_, g, q4, p4);
            }
#pragma unroll
            for (int q = 0; q < 2; ++q) {
                const int ctile = 2 * (w >> 2) + q;
                {
                    f32x4 acc = (f32x4){0.f, 0.f, 0.f, 0.f};
#pragma unroll
                    for (int kq = 0; kq < 2; ++kq) acc = mfma16(xw[kq], trfrag(BTL, 32 * kq, 16 * ctile, g, q4, p4), acc);
                    const int dcol = 16 * ctile + l15;
                    if (rt_ == ctile) {
                        const float gc = GCs[dcol];
#pragma unroll
                        for (int r = 0; r < 4; ++r) if (4 * g + r == l15) acc[r] += gc;
                    }
                    *(u32x2*)(P + (R0 + dcol) * PP + h * 64 + 32 * (rt_ >> 1) + 8 * g + 4 * (rt_ & 1)) = pk4(acc);
                }
                {
                    f32x4 acc = unpk4(*(const u32x2*)(RB + (16 * ctile + l15) * 72 + 16 * rt_ + 4 * g));
#pragma unroll
                    for (int kq = 0; kq < 2; ++kq) {
                        if (32 * kq <= 16 * ctile + 15) acc = mfma16(xw[kq], ldfrag(ARB, 16 * ctile + l15, 32 * kq + 8 * g), acc);
                    }
                    *(u32x2*)(P + (R0 + 16 * ctile + l15) * PP + 1024 + h * 64 + 16 * rt_ + 4 * g) = pk4(acc);
                }
                {
                    f32x4 acc = (f32x4){0.f, 0.f, 0.f, 0.f};
#pragma unroll
                    for (int kq = 0; kq < 2; ++kq) {
                        acc = mfma16(fbt[kq], ldfrag(XT, 64 + 16 * ctile + l15, 32 * kq + 8 * g), acc);
                        acc = mfma16(fkt[kq], trfrag(VI, 32 * kq, 16 * ctile, g, q4, p4), acc);
                    }
                    *(u32x2*)(P + (R0 + 16 * ctile + l15) * PP + 2048 + h * 64 + 16 * rt_ + 4 * g) = pk4(acc);
                }
                {
                    f32x4 acc = (f32x4){0.f, 0.f, 0.f, 0.f};
#pragma unroll
                    for (int kq = 0; kq < 2; ++kq) {
                        if (32 * kq <= 16 * ctile + 15) {
                            acc = mfma16(xu[kq], ldfrag(ARB, 16 * ctile + l15, 32 * kq + 8 * g), acc);
                            acc = mfma16(fvr[kq], ldfrag(ARK, 16 * ctile + l15, 32 * kq + 8 * g), acc);
                        }
                    }
                    *(u32x2*)(Abuf + (R0 + 16 * ctile + l15) * DM + h * 64 + 16 * rt_ + 4 * g) = pk4(acc);
                }
            }
        }
        LDS_BARRIER();
    }
}

constexpr int SC_SLOT = 2 * IMG;
__device__ void rwkv_scan(const Params& p, unsigned char* lds) {
    if (blockIdx.x >= 32) return;
    const int tid = threadIdx.x, lane = tid & 63, w = __builtin_amdgcn_readfirstlane(tid >> 6), l15 = lane & 15, g = lane >> 4;
    const int bh = blockIdx.x, b = bh >> 4, h = bh & 15;
    bf16_t* P = (bf16_t*)(p.ws + WS_P);
    const size_t Rb = (size_t)b * SEQ;
    if (w >= 4) {
        const int lj = w - 4;
        const unsigned goff = (unsigned)(((lane >> 3) * PP + (lane & 7) * 8) * 2);
        const unsigned loff = (unsigned)((lane >> 3) * 144 + (lane & 7) * 16);
        const char* gbase = (const char*)P + (Rb * PP + h * 64) * 2;
        u32x4 ld0[16], ld1[16];
#define SC_ISSUE(dst, chunk) do { const char* cb = gbase + (size_t)(chunk) * 64 * PP * 2; _Pragma("unroll") for (int q = 0; q < 16; ++q) \
        dst[q] = *(const u32x4*)(cb + (size_t)(((q & 7) * 8 * PP + (q >> 3) * 2048) * 2) + goff); } while (0)
#define SC_RETIRE(src, chunk) do { unsigned char* sb = lds + ((chunk) & 1) * SC_SLOT + loff; _Pragma("unroll") for (int q = 0; q < 16; ++q) \
        *(u32x4*)(sb + (q >> 3) * IMG + (q & 7) * 8 * 144) = src[q]; } while (0)
        SC_ISSUE(ld0, lj); SC_ISSUE(ld1, lj + 4);
        for (int it = 0; it < 32; ++it) {
            const int c0 = lj + 8 * it;
            for (int k = 0; k < lj; ++k) LDS_BARRIER();
            SC_RETIRE(ld0, c0); SC_ISSUE(ld0, (c0 + 8 < 256 ? c0 + 8 : 255));
            for (int k = 0; k < 4; ++k) LDS_BARRIER();
            SC_RETIRE(ld1, c0 + 4); SC_ISSUE(ld1, (c0 + 12 < 256 ? c0 + 12 : 255));
            for (int k = 0; k < 4 - lj; ++k) LDS_BARRIER();
        }
        LDS_BARRIER();
#undef SC_ISSUE
#undef SC_RETIRE
    } else {
        f32x4 H[4];
#pragma unroll
        for (int mt = 0; mt < 4; ++mt) H[mt] = (f32x4){0.f, 0.f, 0.f, 0.f};
        for (int i = 0; i <= 256; ++i) {
            if (i >= 1) {
                const int n = i - 1;
                const unsigned char* sb = lds + (n & 1) * SC_SLOT;
                const bf16_t* MT = (const bf16_t*)sb; const bf16_t* NT = (const bf16_t*)(sb + IMG);
                u32x2 hp[4];
#pragma unroll
                for (int mt = 0; mt < 4; ++mt) {
                    hp[mt] = pk4(H[mt]);
                    *(u32x2*)(P + (Rb + (size_t)n * 64 + 16 * w + l15) * PP + 2048 + h * 64 + 16 * mt + 4 * g) = hp[mt];
                }
                bf16x8 hb[2];
                hb[0] = as_bf16x8((u32x4){hp[0].x, hp[0].y, hp[1].x, hp[1].y});
                hb[1] = as_bf16x8((u32x4){hp[2].x, hp[2].y, hp[3].x, hp[3].y});
#pragma unroll
                for (int mt = 0; mt < 4; ++mt) {
                    f32x4 acc = unpk4(*(const u32x2*)(NT + (16 * w + l15) * 72 + 16 * mt + 4 * g));
#pragma unroll
                    for (int kk = 0; kk < 2; ++kk) acc = mfma16(ldfrag(MT, 16 * mt + l15, 32 * kk + 8 * g), hb[kk], acc);
                    H[mt] = acc;
                }
            }
            LDS_BARRIER();
        }
    }
}

__device__ void rwkv_post(const Params& p) {
    const int tid = threadIdx.x, lane = tid & 63, w = tid >> 6, l15 = lane & 15, g = lane >> 4;
    const bf16_t* P = (const bf16_t*)(p.ws + WS_P);
    bf16_t* Abuf = (bf16_t*)(p.ws + WS_A);
    const bf16_t* Ybuf = (const bf16_t*)(p.ws + WS_Y);
    const float* RK = (const float*)(p.ws + WS_RK);
    const bf16_t* BND = (const bf16_t*)(p.ws + WS_BND);
    for (int hu = blockIdx.x * 8 + w; hu < 16384; hu += gridDim.x * 8) {
        const int unit = hu >> 1, t0 = (hu & 1) * 32;
        const int bn = unit >> 4, h = unit & 15, n = bn & 255;
        const size_t R0 = (size_t)bn * 64;
        bf16x8 fh[4][2], fr[2][2];
#pragma unroll
        for (int kk = 0; kk < 2; ++kk) {
#pragma unroll
            for (int q = 0; q < 4; ++q) fh[q][kk] = *(const bf16x8*)(P + (R0 + 16 * q + l15) * PP + 2048 + h * 64 + 32 * kk + 8 * g);
#pragma unroll
            for (int q = 0; q < 2; ++q) fr[q][kk] = *(const bf16x8*)(P + (R0 + t0 + 16 * q + l15) * PP + 1024 + h * 64 + 32 * kk + 8 * g);
        }
        f32x4 y[4][2];
#pragma unroll
        for (int vt = 0; vt < 4; ++vt)
#pragma unroll
            for (int tt = 0; tt < 2; ++tt) y[vt][tt] = unpk4(*(const u32x2*)(Abuf + (R0 + t0 + 16 * tt + l15) * DM + h * 64 + 16 * vt + 4 * g));
#pragma unroll
        for (int vt = 0; vt < 4; ++vt)
#pragma unroll
            for (int tt = 0; tt < 2; ++tt)
#pragma unroll
                for (int kk = 0; kk < 2; ++kk) y[vt][tt] = mfma16(fh[vt][kk], fr[tt][kk], y[vt][tt]);
        f32x4 lnw[4], lnb[4], mug[4];
#pragma unroll
        for (int vt = 0; vt < 4; ++vt) {
            const int ch = h * 64 + 16 * vt + 4 * g;
            lnw[vt] = *(const f32x4*)(p.in[18] + ch); lnb[vt] = *(const f32x4*)(p.in[19] + ch); mug[vt] = *(const f32x4*)(p.in[10] + 3072 + ch);
        }
#pragma unroll
        for (int tt = 0; tt < 2; ++tt) {
            const int t = t0 + 16 * tt + l15;
            float s1 = 0.f, s2 = 0.f;
#pragma unroll
            for (int vt = 0; vt < 4; ++vt)
#pragma unroll
                for (int r = 0; r < 4; ++r) { s1 += y[vt][tt][r]; s2 += y[vt][tt][r] * y[vt][tt][r]; }
            s1 += __shfl_xor(s1, 16); s2 += __shfl_xor(s2, 16); s1 += __shfl_xor(s1, 32); s2 += __shfl_xor(s2, 32);
            const float mean = s1 * (1.0f / 64.0f);
            const float rstd = rsqrtf(fmaxf(s2 * (1.0f / 64.0f) - mean * mean, 0.f) + 64e-5f);
            const float rk = RK[(R0 + t) * 16 + h];
            const bf16_t* grow = P + (R0 + t) * PP + 3072 + h * 64;
            const bf16_t* gprev = (t > 0) ? (grow - PP) : (BND + (size_t)bn * PP + 3072 + h * 64);
            const bool zprev = (t == 0 && n == 0);
#pragma unroll
            for (int vt = 0; vt < 4; ++vt) {
                const int v = 16 * vt + 4 * g;
                const f32x4 g1 = unpk4(*(const u32x2*)(grow + v));
                f32x4 g0 = unpk4(*(const u32x2*)(gprev + v));
                if (zprev) g0 = (f32x4){0.f, 0.f, 0.f, 0.f};
                const f32x4 vp = unpk4(*(const u32x2*)(Ybuf + (R0 + t) * DM + h * 64 + v));
                f32x4 o;
#pragma unroll
                for (int r = 0; r < 4; ++r) {
                    const float yn = (y[vt][tt][r] - mean) * rstd * lnw[vt][r] + lnb[vt][r];
                    const float gt = g1[r] + mug[vt][r] * (g0[r] - g1[r]);
                    o[r] = (yn + rk * vp[r]) * gt / (1.0f + __expf(-gt));
                }
                *(u32x2*)(Abuf + (R0 + t) * DM + h * 64 + v) = pk4(o);
            }
        }
    }
}
#define XB_TMO      128
#define XB_XCNT(j)  (256  + 64 * (j))
#define XB_XSUB(j)  (1280 + 64 * (j))
#define XB_XGEN(j)  (2304 + 64 * (j))
#define XB_TOP      3328
#define XB_TOPGEN   3392
#define XCD_BAR_WORDS 3456
#define XB_SPIN_CAP (1u << 18)
#define LAS __attribute__((address_space(3)))

__device__ __forceinline__ unsigned xb_ld(unsigned* p)              { return __hip_atomic_load(p, __ATOMIC_RELAXED, __HIP_MEMORY_SCOPE_AGENT); }
__device__ __forceinline__ unsigned xb_add(unsigned* p, unsigned v) { return __hip_atomic_fetch_add(p, v, __ATOMIC_RELAXED, __HIP_MEMORY_SCOPE_AGENT); }
__device__ __forceinline__ unsigned xb_xcc_id() { return (unsigned)__builtin_amdgcn_s_getreg((3 << 11) | 20) & 0xFu; }
#define XB_SPIN(cond, bar) do { unsigned _sp = 0; while (cond) { __builtin_amdgcn_s_sleep(1); \
    if ((++_sp & 255u) == 0u) { if (xb_ld(&(bar)[XB_TMO])) break; if (_sp > XB_SPIN_CAP) { atomicAdd(&(bar)[XB_TMO], 1u); break; } } } } while (0)

struct XcdBarrier {
    unsigned* bar; unsigned x;
    volatile LAS unsigned* st;
};

__device__ __forceinline__ XcdBarrier xcd_barrier_post(unsigned* bar, volatile LAS unsigned* st) {
    XcdBarrier b; b.bar = bar; b.x = xb_xcc_id(); b.st = st;
    if (threadIdx.x == 0) (void)xb_add(&bar[XB_XCNT(b.x)], 1u);
    return b;
}
__device__ __forceinline__ void xcd_barrier_complete(unsigned* bar, unsigned x, unsigned& nloc, unsigned& nx) {
    const unsigned G = gridDim.x * gridDim.y * gridDim.z;
    unsigned sum, cnt, mine, sp = 0u;
    for (;;) {
        sum = 0u; cnt = 0u; mine = 0u;
#pragma unroll
        for (unsigned j = 0; j < 16; ++j) { const unsigned c = xb_ld(&bar[XB_XCNT(j)]); sum += c; cnt += (c > 0u) ? 1u : 0u; mine = (j == x) ? c : mine; }
        if (sum == G) break;
        __builtin_amdgcn_s_sleep(1);
        if ((++sp & 255u) == 0u) { if (xb_ld(&bar[XB_TMO])) break; if (sp > XB_SPIN_CAP) { atomicAdd(&bar[XB_TMO], 1u); break; } }
    }
    nloc = mine > 0u ? mine : 1u; nx = cnt > 0u ? cnt : 1u;
}

__device__ __forceinline__ void xcd_barrier(const XcdBarrier& b) {
    asm volatile("s_waitcnt vmcnt(0)" ::: "memory");
    __syncthreads();
    if (threadIdx.x == 0) {
        unsigned* bar = b.bar;
        __builtin_amdgcn_s_waitcnt(0);
        unsigned nloc = b.st[0], nx = b.st[1];
        if (nloc == 0u) { xcd_barrier_complete(bar, b.x, nloc, nx); b.st[0] = nloc; b.st[1] = nx; }
        const unsigned old = xb_add(&bar[XB_XSUB(b.x)], 1u);
        const unsigned gen = old / nloc;
        if (old + 1u == (gen + 1u) * nloc) {
            __builtin_amdgcn_fence(__ATOMIC_RELEASE, "agent");
            asm volatile("s_waitcnt vmcnt(0)" ::: "memory");
            const unsigned og = xb_add(&bar[XB_TOP], 1u);
            const unsigned tg = og / nx;
            if (og + 1u == (tg + 1u) * nx) xb_add(&bar[XB_TOPGEN], 1u);
            else XB_SPIN(xb_ld(&bar[XB_TOPGEN]) == tg, bar);
            __builtin_amdgcn_fence(__ATOMIC_ACQUIRE, "agent");
            xb_add(&bar[XB_XGEN(b.x)], 1u);
            asm volatile("s_waitcnt vmcnt(0)" ::: "memory");
        } else {
            XB_SPIN(xb_ld(&bar[XB_XGEN(b.x)]) == gen, bar);
            __builtin_amdgcn_fence(__ATOMIC_ACQUIRE, "agent");
            asm volatile("s_waitcnt vmcnt(0)" ::: "memory");
        }
    }
    __syncthreads();
}


#ifndef PROBE_ID
#define PROBE_ID 0
#endif
#ifndef N_LAUNCH_MODE
#define N_LAUNCH_MODE 1
#endif
constexpr int N_PHASES = 13;

__global__ void __launch_bounds__(NTH, 2) fwd_kernel(Params p) {
    extern __shared__ __attribute__((aligned(16))) unsigned char lds[];
    const int lo = p.ph_lo, hi = p.ph_hi;
    volatile LAS unsigned* xst = (volatile LAS unsigned*)(lds + LDS_BYTES);
    if (threadIdx.x < 4) xst[threadIdx.x] = 0u;
    __syncthreads();
    const XcdBarrier xbar = xcd_barrier_post((unsigned*)(p.ws + WS_BAR), xst);
    unsigned char* ws = p.ws;
#define IN(k) (lo <= (k) && (k) < hi)
#define SEAM(k) do { if ((k) + 1 < hi) xcd_barrier(xbar); } while (0)
    if (IN(0)) {
        prep_weight(p.in[2], GIN, p.in[1], (bf16_t*)(ws + WS_WGIN), GIN_P, (float*)lds);
        prep_weight(p.in[6], DM, nullptr, (bf16_t*)(ws + WS_WGOUT), DM, (float*)lds);
        prep_weight(p.in[9], RIN, p.in[8], (bf16_t*)(ws + WS_WRIN), RIN_P, (float*)lds);
        prep_weight(p.in[20], DM, nullptr, (bf16_t*)(ws + WS_WROUT), DM, (float*)lds);
        prep_lowrank(p.in[12], (bf16_t*)(ws + WS_WDUT));
        prep_lowrank(p.in[14], (bf16_t*)(ws + WS_WIUT));
        phase_norm0(p);
        SEAM(0);
    }
    if (IN(1)) {
        pg8::Gemm g{(const bf16_t*)(ws + WS_A), (const bf16_t*)(ws + WS_WGIN), MTOK, GIN_P, DM}; pg8::StaticOrder S; S.init(MTOK, GIN_P, gridDim.x, blockIdx.x);
        pg8::EpiBf16<0> E{(bf16_t*)(ws + WS_P), GIN_P, nullptr, 0, 0};
        pg8::gemm_phase<pg8::EpiBf16<0>, pg8::StaticOrder>((PG8_LAS unsigned char*)lds, g, S, E);
        SEAM(1);
    }
    if (IN(2)) { gla_pass<false>(p, lds); SEAM(2); }
    if (IN(3)) { gla_scan(p); SEAM(3); }
    if (IN(4)) { gla_pass<true>(p, lds); SEAM(4); }
    if (IN(5)) {
        pg8::Gemm g{(const bf16_t*)(ws + WS_A), (const bf16_t*)(ws + WS_WGOUT), MTOK, DM, DM}; pg8::StaticOrder S; S.init(MTOK, DM, gridDim.x, blockIdx.x);
        pg8::EpiBf16<0> E{(bf16_t*)(ws + WS_Y), DM, nullptr, 0, 0};
        pg8::gemm_phase<pg8::EpiBf16<0>, pg8::StaticOrder>((PG8_LAS unsigned char*)lds, g, S, E);
        SEAM(5);
    }
    if (IN(6)) { phase_norm1(p); SEAM(6); }
    if (IN(7)) {
        pg8::Gemm g{(const bf16_t*)(ws + WS_A), (const bf16_t*)(ws + WS_WRIN), MTOK, RIN_P, DM}; pg8::StaticOrder S; S.init(MTOK, RIN_P, gridDim.x, blockIdx.x);
        EpiBf16Bnd E{(bf16_t*)(ws + WS_P), RIN_P, (bf16_t*)(ws + WS_BND)};
        pg8::gemm_phase<EpiBf16Bnd, pg8::StaticOrder>((PG8_LAS unsigned char*)lds, g, S, E);
        SEAM(7);
    }
    if (IN(8)) { rwkv_r1(p, lds); SEAM(8); }
    if (IN(9)) { rwkv_scan(p, lds); SEAM(9); }
    if (IN(10)) { rwkv_post(p); SEAM(10); }
    if (IN(11)) {
        pg8::Gemm g{(const bf16_t*)(ws + WS_A), (const bf16_t*)(ws + WS_WROUT), MTOK, DM, DM}; pg8::StaticOrder S; S.init(MTOK, DM, gridDim.x, blockIdx.x);
        pg8::EpiBf16<0> E{(bf16_t*)(ws + WS_Y), DM, nullptr, 0, 0};
        pg8::gemm_phase<pg8::EpiBf16<0>, pg8::StaticOrder>((PG8_LAS unsigned char*)lds, g, S, E);
        SEAM(11);
    }
    if (IN(12)) { phase_final(p); }
#undef IN
#undef SEAM
}

extern "C" void kernel_launch(void* const* d_in, const int* in_sizes, int n_in, void* d_out, int out_size, void* d_ws, size_t ws_size, hipStream_t stream) {
    static int grid = 0;
    if (grid == 0) {
        int dev = 0, cus = 0, per_cu = 0;
        hipGetDevice(&dev);
        hipDeviceGetAttribute(&cus, hipDeviceAttributeMultiprocessorCount, dev);
        hipFuncSetAttribute((const void*)fwd_kernel, hipFuncAttributeMaxDynamicSharedMemorySize, LDS_BYTES + 16);
        hipOccupancyMaxActiveBlocksPerMultiprocessor(&per_cu, (const void*)fwd_kernel, NTH, LDS_BYTES + 16);
        if (per_cu < 1) { fprintf(stderr, "kernel_launch: occupancy query says %d blocks per CU\n", per_cu); per_cu = 1; }
        grid = cus;
        if (n_in != 22 || ws_size < WS_END) fprintf(stderr, "kernel_launch: unexpected n_in %d or workspace %zu < %zu\n", n_in, ws_size, (size_t)WS_END);
        (void)hipGetLastError();
    }
    if (hipMemsetAsync((char*)d_ws + WS_BAR, 0, XCD_BAR_WORDS * 4, stream) != hipSuccess) fprintf(stderr, "kernel_launch: memset of the barrier words failed\n");
    Params p{};
    for (int i = 0; i < 22; ++i) p.in[i] = (const float*)d_in[i];
    p.out = (float*)d_out; p.ws = (unsigned char*)d_ws;
#if N_LAUNCH_MODE == 1
    void* args[] = {&p};
#if PROBE_ID > 0
    p.ph_lo = 0; p.ph_hi = PROBE_ID;
    (void)hipLaunchCooperativeKernel((const void*)fwd_kernel, dim3(grid), dim3(NTH), args, LDS_BYTES + 16, stream);
    (void)hipMemsetAsync((char*)d_ws + WS_BAR, 0, XCD_BAR_WORDS * 4, stream);
#endif
    p.ph_lo = 0; p.ph_hi = N_PHASES;
    hipError_t e = hipLaunchCooperativeKernel((const void*)fwd_kernel, dim3(grid), dim3(NTH), args, LDS_BYTES + 16, stream);
    if (e != hipSuccess) fprintf(stderr, "cooperative launch failed: %s (grid %d)\n", hipGetErrorString(e), grid);
#else
    for (int k = 0; k < N_PHASES; ++k) {
        p.ph_lo = k; p.ph_hi = k + 1;
        hipLaunchKernelGGL(fwd_kernel, dim3(grid), dim3(NTH), LDS_BYTES + 16, stream, p);
    }
#endif
}
```

```cpp
#include <hip/hip_runtime.h>
#include <hip/hip_cooperative_groups.h>
#include <cstdio>
namespace cg = cooperative_groups;
#define PROBE_ID 0
#define N_LAUNCH_MODE 1
namespace pg8 {
#define PG8_LAS __attribute__((address_space(3)))
typedef unsigned short bf16_t;
typedef short bf16x8 __attribute__((ext_vector_type(8)));
typedef float f32x4 __attribute__((ext_vector_type(4)));
typedef unsigned u32x4 __attribute__((ext_vector_type(4)));
constexpr int BM = 256, BK = 64, HALF = 128, HTB = HALF * BK * 2  , STAGE_BYTES = 8 * HTB, NXCD = 8, WGM = 8;

__host__ __device__ __forceinline__ int lds_byte(int r, int c) { const int st = (r >> 4) * 2 + (c >> 5), rr = r & 15, cc = c & 31, ob = rr * 64 + cc * 2; return st * 1024 + (ob ^ (((ob >> 9) & 1) << 5)); }
__host__ __device__ __forceinline__ void stage_rc(int b, int& R, int& C) { const int st = b / 1024, sb = b % 1024, swz = sb ^ (((sb >> 9) & 1) << 5); R = (st >> 1) * 16 + swz / 64; C = (st & 1) * 32 + (swz % 64) / 2; }
__host__ __device__ __forceinline__ int perm32(int rho) { const int n = rho >> 4, i = rho & 15; return 8 * (i >> 2) + 4 * n + (i & 3); }

struct Unit { int pm, pn; };
struct Gemm { const bf16_t* A; const bf16_t* Bt; int M, N, K; };

struct StaticOrder {
    int nM, nN, nwg, G, c;
    __host__ __device__ void init(int M, int N, int G_, int c_) { nM = M / BM; nN = N / BM; nwg = nM * nN; G = G_; c = c_; }
    __host__ __device__ bool next(int i, Unit& u) const {
        const long L = (long)i * G + c; if (L >= nwg) return false;
        int wgid = (int)L; { const int q = nwg / NXCD, r = nwg % NXCD, xcd = wgid % NXCD, off = wgid / NXCD; wgid = (xcd < r ? xcd * (q + 1) : r * (q + 1) + (xcd - r) * q) + off; }
        const int nig = WGM * nN, gid = wgid / nig, fm = gid * WGM, gsz = (nM - fm) < WGM ? (nM - fm) : WGM;
        u.pm = fm + ((wgid % nig) % gsz); u.pn = (wgid % nig) / gsz; return true;
    }
    __device__ __forceinline__ void a_ready(const Unit&) const {}
    __device__ __forceinline__ void done(const Unit&) const {}
};

typedef float cvt_f32x2 __attribute__((ext_vector_type(2)));
typedef __bf16 cvt_bf16x2 __attribute__((ext_vector_type(2)));
__device__ __forceinline__ unsigned cvt_pk_bf16(float lo, float hi) { const cvt_f32x2 v = {lo, hi}; union { cvt_bf16x2 b; unsigned u; } x; x.b = __builtin_convertvector(v, cvt_bf16x2); return x.u; }
typedef float f32x2 __attribute__((ext_vector_type(2)));
struct EpiF32 {
    static constexpr bool PERM = false, AFTER_DRAIN = false;
    float* C; int ldc; const float* bias;
    __device__ __forceinline__ void operator()(const f32x4 (&acc)[2][2][4][2], const Unit& u, int wr, int wc, int fr, int fq) const {
        const int row0 = u.pm * BM + wr * 64 + fr, col0 = u.pn * BM + wc * 32 + 4 * fq;
        f32x4 bv[2][2];
#pragma unroll
        for (int bj = 0; bj < 2; ++bj)
#pragma unroll
            for (int n = 0; n < 2; ++n) bv[bj][n] = bias ? *(const f32x4*)(bias + col0 + bj * HALF + n * 16) : (f32x4){0.f, 0.f, 0.f, 0.f};
#pragma unroll
        for (int ai = 0; ai < 2; ++ai)
#pragma unroll
            for (int m = 0; m < 4; ++m) { float* rowp = C + (size_t)(row0 + ai * HALF + m * 16) * ldc + col0;
#pragma unroll
                for (int bj = 0; bj < 2; ++bj)
#pragma unroll
                    for (int n = 0; n < 2; ++n) *(f32x4*)(rowp + bj * HALF + n * 16) = acc[ai][bj][m][n] + bv[bj][n]; }
    }
};
template <int ACT  > struct EpiBf16 {
    static constexpr bool PERM = true, AFTER_DRAIN = false;
    bf16_t* O; int ldc; const float* bias; int split_cols; size_t split_stride;
    __device__ __forceinline__ void operator()(const f32x4 (&acc)[2][2][4][2], const Unit& u, int wr, int wc, int fr, int fq) const {
        const int row0 = u.pm * BM + wr * 64 + fr; int colt = u.pn * BM; bf16_t* base = O;
        if (split_cols) { const int t = colt / split_cols; base += (size_t)t * split_stride; colt -= t * split_cols; }
        const int col0 = colt + wc * 32 + 8 * fq, bcol0 = u.pn * BM + wc * 32 + 8 * fq;
        f32x4 bv[2][2];
#pragma unroll
        for (int bj = 0; bj < 2; ++bj)
#pragma unroll
            for (int n = 0; n < 2; ++n) bv[bj][n] = bias ? *(const f32x4*)(bias + bcol0 + bj * HALF + 4 * n) : (f32x4){0.f, 0.f, 0.f, 0.f};
#pragma unroll
        for (int ai = 0; ai < 2; ++ai)
#pragma unroll
            for (int m = 0; m < 4; ++m) { bf16_t* rowp = base + (size_t)(row0 + ai * HALF + m * 16) * ldc + col0;
#pragma unroll
                for (int bj = 0; bj < 2; ++bj) { f32x4 v0 = acc[ai][bj][m][0] + bv[bj][0], v1 = acc[ai][bj][m][1] + bv[bj][1];
                    u32x4 w; w.x = cvt_pk_bf16(v0[0], v0[1]); w.y = cvt_pk_bf16(v0[2], v0[3]); w.z = cvt_pk_bf16(v1[0], v1[1]); w.w = cvt_pk_bf16(v1[2], v1[3]);
                    *(u32x4*)(rowp + bj * HALF) = w; } }
    }
};

template <class Epi, class Sched>
__device__ __forceinline__ void gemm_phase(PG8_LAS unsigned char* lds, const Gemm g, const Sched& S, const Epi& E) {
    const int tid = threadIdx.x, wid = __builtin_amdgcn_readfirstlane(tid >> 6), lane = tid & 63, wr = wid >> 2, wc = wid & 3, fr = lane & 15, fq = lane >> 4;
    const int K = g.K, nt = K / BK;
    unsigned voffA[2], voffB[2];
#pragma unroll
    for (int i = 0; i < 2; ++i) { int R, C; stage_rc(tid * 16 + i * 8192, R, C); const int Rb = Epi::PERM ? ((R & ~31) + perm32(R & 31)) : R;
        voffA[i] = (unsigned)(R * K + C) * 2u; voffB[i] = (unsigned)(Rb * K + C) * 2u; }
    const size_t kstep = (size_t)(BK * 2);
    const size_t hstep = (size_t)HALF * K * 2;
    const size_t tstep = 2 * hstep;
    const unsigned ldsw = (unsigned)wid * 1024u;
    const int aoff = lds_byte(wr * 64 + fr, fq * 8), boff = lds_byte(wc * 32 + fr, fq * 8);
#define PG8_SA(b, h) (((b) * 2 + (h)) * HTB)
#define PG8_SB(b, h) ((4 + (b) * 2 + (h)) * HTB)
#define PG8_STAGE(bufoff, gbase, voff) do { _Pragma("unroll") for (int _i = 0; _i < 2; ++_i) \
        __builtin_amdgcn_global_load_lds((const unsigned*)((const char*)(gbase) + (voff)[_i]), (PG8_LAS unsigned*)(lds + (bufoff) + ldsw + _i * 8192), 16, 0, 0); } while (0)
#define PG8_LDA(dst, b, h) do { _Pragma("unroll") for (int m = 0; m < 4; ++m) _Pragma("unroll") for (int k = 0; k < 2; ++k) dst[m][k] = *(const PG8_LAS bf16x8*)(lds + PG8_SA(b, h) + aoff + m * 2048 + k * 1024); } while (0)
#define PG8_LDB(dst, b, h) do { _Pragma("unroll") for (int n = 0; n < 2; ++n) _Pragma("unroll") for (int k = 0; k < 2; ++k) dst[n][k] = *(const PG8_LAS bf16x8*)(lds + PG8_SB(b, h) + boff + n * 2048 + k * 1024); } while (0)
#define PG8_MMA(ai, bj, At, Bt) do { __builtin_amdgcn_s_setprio(1); _Pragma("unroll") for (int m = 0; m < 4; ++m) _Pragma("unroll") for (int n = 0; n < 2; ++n) _Pragma("unroll") for (int k = 0; k < 2; ++k) \
        acc[ai][bj][m][n] = __builtin_amdgcn_mfma_f32_16x16x32_bf16(Bt[n][k], At[m][k], acc[ai][bj][m][n], 0, 0, 0); __builtin_amdgcn_s_setprio(0); } while (0)
#define PG8_WAIT_V(n) asm volatile("s_waitcnt vmcnt(" #n ")" ::: "memory")
#define PG8_WAIT_L(n) asm volatile("s_waitcnt lgkmcnt(" #n ")" ::: "memory")
#define PG8_BAR __builtin_amdgcn_s_barrier()
#define PG8_SCHED __builtin_amdgcn_sched_barrier(0)
    Unit cur, nxt; int ui = 0;
    if (!S.next(0, cur)) return;
    f32x4 acc[2][2][4][2];
#pragma unroll
    for (int a = 0; a < 2; ++a)
#pragma unroll
        for (int b = 0; b < 2; ++b)
#pragma unroll
            for (int m = 0; m < 4; ++m)
#pragma unroll
                for (int n = 0; n < 2; ++n) acc[a][b][m][n] = (f32x4){0.f, 0.f, 0.f, 0.f};
    bf16x8 At[4][2], B0[2][2], B1[2][2];
    const char* cA = (const char*)g.A + (size_t)cur.pm * tstep; const char* cB = (const char*)g.Bt + (size_t)cur.pn * tstep;
    S.a_ready(cur);
    PG8_STAGE(PG8_SB(0, 0), cB, voffB); PG8_STAGE(PG8_SA(0, 0), cA, voffA); PG8_STAGE(PG8_SB(0, 1), cB + hstep, voffB); PG8_STAGE(PG8_SA(0, 1), cA + hstep, voffA);
    if (wr == 1) PG8_BAR;
    PG8_WAIT_V(4); PG8_BAR;
    PG8_STAGE(PG8_SB(1, 0), cB + kstep, voffB); PG8_STAGE(PG8_SA(1, 0), cA + kstep, voffA); PG8_STAGE(PG8_SB(1, 1), cB + hstep + kstep, voffB);
    PG8_WAIT_V(6); PG8_BAR;
    for (;;) {
        const bool has_next = S.next(ui + 1, nxt);
        const char* nA = has_next ? (const char*)g.A + (size_t)nxt.pm * tstep : cA; const char* nB = has_next ? (const char*)g.Bt + (size_t)nxt.pn * tstep : cB;
        for (int t = 0; t < nt; t += 2) {
            const bool last = (t == nt - 2);
            const char* a1 = cA + (size_t)(t + 1) * kstep;
            const char* a2 = last ? nA : cA + (size_t)(t + 2) * kstep; const char* b2 = last ? nB : cB + (size_t)(t + 2) * kstep;
            const char* a3 = a2 + kstep; const char* b3 = b2 + kstep;
            if (last && has_next) S.a_ready(nxt);
            PG8_LDB(B0, 0, 0); PG8_SCHED; PG8_LDA(At, 0, 0); PG8_STAGE(PG8_SA(1, 1), a1 + hstep, voffA);
            PG8_WAIT_L(8); PG8_BAR; PG8_WAIT_L(0); PG8_MMA(0, 0, At, B0); PG8_BAR; PG8_SCHED;
            PG8_LDB(B1, 0, 1); PG8_STAGE(PG8_SB(0, 0), b2, voffB);
            PG8_BAR; PG8_WAIT_L(0); PG8_MMA(0, 1, At, B1); PG8_BAR;
            PG8_LDA(At, 0, 1); PG8_STAGE(PG8_SA(0, 0), a2, voffA);
            PG8_BAR; PG8_WAIT_L(0); PG8_MMA(1, 0, At, B0); PG8_BAR; PG8_SCHED;
            PG8_STAGE(PG8_SB(0, 1), b2 + hstep, voffB);
            PG8_WAIT_V(6); PG8_BAR; PG8_MMA(1, 1, At, B1); PG8_BAR;
            PG8_LDB(B0, 1, 0); PG8_SCHED; PG8_LDA(At, 1, 0); PG8_STAGE(PG8_SA(0, 1), a2 + hstep, voffA);
            PG8_WAIT_L(8); PG8_BAR; PG8_WAIT_L(0); PG8_MMA(0, 0, At, B0); PG8_BAR; PG8_SCHED;
            PG8_LDB(B1, 1, 1); PG8_STAGE(PG8_SB(1, 0), b3, voffB);
            PG8_BAR; PG8_WAIT_L(0); PG8_MMA(0, 1, At, B1); PG8_BAR;
            PG8_LDA(At, 1, 1); PG8_STAGE(PG8_SA(1, 0), a3, voffA);
            PG8_BAR; PG8_WAIT_L(0); PG8_MMA(1, 0, At, B0); PG8_BAR; PG8_SCHED;
            PG8_STAGE(PG8_SB(1, 1), b3 + hstep, voffB);
            PG8_WAIT_V(6); PG8_BAR; PG8_MMA(1, 1, At, B1); PG8_BAR;
        }
        if constexpr (!Epi::AFTER_DRAIN) { E(acc, cur, wr, wc, fr, fq); S.done(cur); }
        if (!has_next) break;
#pragma unroll
        for (int a = 0; a < 2; ++a)
#pragma unroll
            for (int b = 0; b < 2; ++b)
#pragma unroll
                for (int m = 0; m < 4; ++m)
#pragma unroll
                    for (int n = 0; n < 2; ++n) acc[a][b][m][n] = (f32x4){0.f, 0.f, 0.f, 0.f};
        cur = nxt; cA = nA; cB = nB; ++ui;
    }
    PG8_WAIT_V(0);
    if (wr == 0) PG8_BAR;
    PG8_BAR;
    if constexpr (Epi::AFTER_DRAIN) { E.fused(acc, cur, wr, wc, fr, fq, lds, wid, lane); S.done(cur); }
#undef PG8_SA
#undef PG8_SB
#undef PG8_STAGE
#undef PG8_LDA
#undef PG8_LDB
#undef PG8_MMA
#undef PG8_WAIT_V
#undef PG8_WAIT_L
#undef PG8_BAR
#undef PG8_SCHED
}
}


typedef unsigned short bf16_t;
typedef short bf16x8 __attribute__((ext_vector_type(8)));
typedef float f32x4 __attribute__((ext_vector_type(4)));
typedef unsigned u32x4 __attribute__((ext_vector_type(4)));
typedef unsigned u32x2 __attribute__((ext_vector_type(2)));

constexpr int MTOK = 32768, DM = 1024, SEQ = 16384, NTH = 512;
constexpr int GIN = 3088, GIN_P = 3328, RIN = 4224, RIN_P = 4352;
constexpr int LDS_BYTES = 131072;

constexpr size_t WS_WGIN  = 0;
constexpr size_t WS_WGOUT = WS_WGIN  + (size_t)GIN_P * DM * 2;
constexpr size_t WS_WRIN  = WS_WGOUT + (size_t)DM * DM * 2;
constexpr size_t WS_WROUT = WS_WRIN  + (size_t)RIN_P * DM * 2;
constexpr size_t WS_WDUT  = WS_WROUT + (size_t)DM * DM * 2;
constexpr size_t WS_WIUT  = WS_WDUT  + (size_t)DM * 64 * 2;
constexpr size_t WS_WUPT  = WS_WIUT  + (size_t)DM * 64 * 2;
constexpr size_t WS_A     = WS_WUPT  + (size_t)512 * 16 * 2;
constexpr size_t WS_Y     = WS_A     + (size_t)MTOK * DM * 2;
constexpr size_t WS_GS    = WS_Y     + (size_t)MTOK * DM * 2;
constexpr size_t WS_GD    = WS_GS    + (size_t)8 * 32 * 128 * 256 * 4;
constexpr size_t WS_P     = WS_GD    + (size_t)8 * 32 * 128 * 4;
constexpr size_t WS_BAR   = WS_P     + (size_t)MTOK * RIN_P * 2;
constexpr size_t WS_END   = WS_BAR   + 16384;

struct Params { const float* in[22]; float* out; unsigned char* ws; int ph_lo, ph_hi; };

__device__ __forceinline__ float bf2f(unsigned b) { return __uint_as_float(b << 16); }
__device__ __forceinline__ bf16_t f2bf(float f) { unsigned u = __float_as_uint(f); u += 0x7FFFu + ((u >> 16) & 1u); return (bf16_t)(u >> 16); }
__device__ __forceinline__ unsigned pk2(float lo, float hi) { return pg8::cvt_pk_bf16(lo, hi); }
__device__ __forceinline__ float wave_sum(float x) {
#pragma unroll
    for (int off = 32; off >= 1; off >>= 1) x += __shfl_xor(x, off);
    return x;
}
__device__ __forceinline__ f32x4 mfma16(bf16x8 a, bf16x8 b, f32x4 c) { return __builtin_amdgcn_mfma_f32_16x16x32_bf16(a, b, c, 0, 0, 0); }
__device__ __forceinline__ bf16x8 as_bf16x8(u32x4 v) { union { u32x4 u; bf16x8 b; } x; x.u = v; return x.b; }
__device__ __forceinline__ float log_sigmoid(float z) { return fminf(z, 0.f) - log1pf(__expf(-fabsf(z))); }
__device__ __forceinline__ float softplus(float z) { return fmaxf(z, 0.f) + log1pf(__expf(-fabsf(z))); }

__device__ void prep_weight(const float* __restrict__ W, int N, const float* __restrict__ gain, bf16_t* __restrict__ Wt, int NP, float* tile) {
    const int tid = threadIdx.x;
    const int nu = (NP / 64) * 16;
    for (int u = blockIdx.x; u < nu; u += gridDim.x) {
        const int n0 = (u >> 4) * 64, k0 = (u & 15) * 64;
        {
            const int j = tid & 63, i0 = tid >> 6;
#pragma unroll
            for (int r = 0; r < 8; ++r) {
                const int i = i0 + 8 * r, k = k0 + i, n = n0 + j;
                float v = 0.f;
                if (n < N) { v = W[(size_t)k * N + n]; if (gain) v *= gain[k]; }
                tile[i * 65 + j] = v;
            }
        }
        __syncthreads();
        {
            const int i = tid & 63, j0 = tid >> 6;
#pragma unroll
            for (int r = 0; r < 8; ++r) {
                const int j = j0 + 8 * r;
                Wt[(size_t)(n0 + j) * DM + k0 + i] = f2bf(tile[i * 65 + j]);
            }
        }
        __syncthreads();
    }
}

__device__ void prep_lowrank(const float* __restrict__ src, bf16_t* __restrict__ dst) {
    for (int idx = blockIdx.x * NTH + threadIdx.x; idx < 65536; idx += gridDim.x * NTH) dst[idx] = f2bf(src[(idx & 63) * 1024 + (idx >> 6)]);
}

__device__ void prep_wup(const float* __restrict__ src, bf16_t* __restrict__ dst) {
    for (int idx = blockIdx.x * NTH + threadIdx.x; idx < 8192; idx += gridDim.x * NTH) dst[idx] = f2bf(src[(idx & 15) * 512 + (idx >> 4)]);
}

struct EpiBf16Bnd {
    static constexpr bool PERM = true, AFTER_DRAIN = false;
    bf16_t* O; int ldc; bf16_t* bnd;
    __device__ __forceinline__ void operator()(const f32x4 (&acc)[2][2][4][2], const pg8::Unit& u, int wr, int wc, int fr, int fq) const {
        const int row0 = u.pm * pg8::BM + wr * 64 + fr, col0 = u.pn * pg8::BM + wc * 32 + 8 * fq;
#pragma unroll
        for (int ai = 0; ai < 2; ++ai)
#pragma unroll
            for (int m = 0; m < 4; ++m) {
                const int row = row0 + ai * pg8::HALF + m * 16;
                bf16_t* rowp = O + (size_t)row * ldc + col0;
#pragma unroll
                for (int bj = 0; bj < 2; ++bj) {
                    const f32x4 v0 = acc[ai][bj][m][0], v1 = acc[ai][bj][m][1];
                    u32x4 wv; wv.x = pk2(v0[0], v0[1]); wv.y = pk2(v0[2], v0[3]); wv.z = pk2(v1[0], v1[1]); wv.w = pk2(v1[2], v1[3]);
                    *(u32x4*)(rowp + bj * pg8::HALF) = wv;
                    if (m == 3 && fr == 15) *(u32x4*)(bnd + (size_t)((row >> 6) + 1) * ldc + col0 + bj * pg8::HALF) = wv;
                }
            }
    }
};

__device__ void phase_norm0(const Params& p) {
    const int tid = threadIdx.x, lane = tid & 63, w = tid >> 6;
    const float* x = p.in[0];
    bf16_t* A = (bf16_t*)(p.ws + WS_A);
    for (int row = blockIdx.x * 8 + w; row < MTOK; row += gridDim.x * 8) {
        const float4* xr = (const float4*)(x + (size_t)row * DM);
        float4 v[4];
#pragma unroll
        for (int i = 0; i < 4; ++i) v[i] = xr[lane + 64 * i];
        float ss = 0.f;
#pragma unroll
        for (int i = 0; i < 4; ++i) ss += v[i].x * v[i].x + v[i].y * v[i].y + v[i].z * v[i].z + v[i].w * v[i].w;
        ss = wave_sum(ss);
        const float rstd = rsqrtf(ss * (1.0f / DM) + 1e-6f);
#pragma unroll
        for (int i = 0; i < 4; ++i) {
            u32x2 o; o.x = pk2(v[i].x * rstd, v[i].y * rstd); o.y = pk2(v[i].z * rstd, v[i].w * rstd);
            *(u32x2*)(A + (size_t)row * DM + 4 * (lane + 64 * i)) = o;
        }
    }
}

__device__ void phase_norm1(const Params& p) {
    const int tid = threadIdx.x, lane = tid & 63, w = tid >> 6;
    const float* x = p.in[0];
    const float* gpost = p.in[7];
    const bf16_t* Y = (const bf16_t*)(p.ws + WS_Y);
    bf16_t* A = (bf16_t*)(p.ws + WS_A);
    float4 gp[4];
#pragma unroll
    for (int i = 0; i < 4; ++i) gp[i] = ((const float4*)gpost)[lane + 64 * i];
    for (int row = blockIdx.x * 8 + w; row < MTOK; row += gridDim.x * 8) {
        const float4* xr = (const float4*)(x + (size_t)row * DM);
        float4 v[4]; u32x2 yv[4];
#pragma unroll
        for (int i = 0; i < 4; ++i) { v[i] = xr[lane + 64 * i]; yv[i] = *(const u32x2*)(Y + (size_t)row * DM + 4 * (lane + 64 * i)); }
        float4 y[4];
        float ss = 0.f;
#pragma unroll
        for (int i = 0; i < 4; ++i) {
            y[i].x = bf2f(yv[i].x & 0xffffu); y[i].y = bf2f(yv[i].x >> 16); y[i].z = bf2f(yv[i].y & 0xffffu); y[i].w = bf2f(yv[i].y >> 16);
            ss += y[i].x * y[i].x + y[i].y * y[i].y + y[i].z * y[i].z + y[i].w * y[i].w;
        }
        ss = wave_sum(ss);
        const float rstdy = rsqrtf(ss * (1.0f / DM) + 1e-6f);
        float s1 = 0.f;
#pragma unroll
        for (int i = 0; i < 4; ++i) {
            v[i].x += y[i].x * rstdy * gp[i].x; v[i].y += y[i].y * rstdy * gp[i].y; v[i].z += y[i].z * rstdy * gp[i].z; v[i].w += y[i].w * rstdy * gp[i].w;
            s1 += v[i].x * v[i].x + v[i].y * v[i].y + v[i].z * v[i].z + v[i].w * v[i].w;
            ((float4*)(p.out + (size_t)row * DM))[lane + 64 * i] = v[i];
        }
        s1 = wave_sum(s1);
        const float rstd = rsqrtf(s1 * (1.0f / DM) + 1e-6f);
#pragma unroll
        for (int i = 0; i < 4; ++i) {
            u32x2 o; o.x = pk2(v[i].x * rstd, v[i].y * rstd); o.y = pk2(v[i].z * rstd, v[i].w * rstd);
            *(u32x2*)(A + (size_t)row * DM + 4 * (lane + 64 * i)) = o;
        }
    }
}

__device__ void phase_final(const Params& p) {
    const int tid = threadIdx.x, lane = tid & 63, w = tid >> 6;
    const float* gpost = p.in[21];
    const bf16_t* Y = (const bf16_t*)(p.ws + WS_Y);
    float4 gp[4];
#pragma unroll
    for (int i = 0; i < 4; ++i) gp[i] = ((const float4*)gpost)[lane + 64 * i];
    for (int row = blockIdx.x * 8 + w; row < MTOK; row += gridDim.x * 8) {
        float4* xr = (float4*)(p.out + (size_t)row * DM);
        float4 v[4]; u32x2 yv[4];
#pragma unroll
        for (int i = 0; i < 4; ++i) { v[i] = xr[lane + 64 * i]; yv[i] = *(const u32x2*)(Y + (size_t)row * DM + 4 * (lane + 64 * i)); }
        float4 y[4];
        float ss = 0.f;
#pragma unroll
        for (int i = 0; i < 4; ++i) {
            y[i].x = bf2f(yv[i].x & 0xffffu); y[i].y = bf2f(yv[i].x >> 16); y[i].z = bf2f(yv[i].y & 0xffffu); y[i].w = bf2f(yv[i].y >> 16);
            ss += y[i].x * y[i].x + y[i].y * y[i].y + y[i].z * y[i].z + y[i].w * y[i].w;
        }
        ss = wave_sum(ss);
        const float rstdy = rsqrtf(ss * (1.0f / DM) + 1e-6f);
#pragma unroll
        for (int i = 0; i < 4; ++i) {
            v[i].x += y[i].x * rstdy * gp[i].x; v[i].y += y[i].y * rstdy * gp[i].y; v[i].z += y[i].z * rstdy * gp[i].z; v[i].w += y[i].w * rstdy * gp[i].w;
            xr[lane + 64 * i] = v[i];
        }
    }
}

constexpr int L_BC = 0, L_ATT = 0, L_QD = 33792, L_KD = L_QD + 64 * 136 * 2, L_KTE = L_KD + 64 * 136 * 2, L_VI = L_KTE + 64 * 144 * 2, L_SSQ = L_VI + 64 * 272 * 2, L_BL = L_SSQ + 2048, L_DEC = L_BL + 512, L_ADL = L_DEC + 512,
              L_GLA_END = L_ADL + 2048;
static_assert(L_GLA_END <= LDS_BYTES, "GLA LDS");
#define GLA_BARRIER() do { asm volatile("s_waitcnt lgkmcnt(0)" ::: "memory"); __builtin_amdgcn_s_barrier(); asm volatile("" ::: "memory"); } while (0)
typedef short gs16x4 __attribute__((ext_vector_type(4)));
__device__ __forceinline__ u32x2 g_trread(const bf16_t* p) { union { gs16x4 s; u32x2 u; } x; x.s = __builtin_amdgcn_ds_read_tr16_b64_v4i16((__attribute__((address_space(3))) gs16x4*)p); return x.u; }
template <int PITCH> __device__ __forceinline__ bf16x8 g_trfrag(const bf16_t* img, int k0, int c0, int g, int q, int pq) {
    const bf16_t* a = img + (k0 + 8 * g + q) * PITCH + c0 + 4 * pq;
    const u32x2 lo = g_trread(a), hi = g_trread(a + 4 * PITCH);
    return as_bf16x8((u32x4){lo.x, lo.y, hi.x, hi.y});
}
__device__ __forceinline__ f32x4 g_lo4(u32x4 v) { return (f32x4){bf2f(v.x & 0xffffu), bf2f(v.x >> 16), bf2f(v.y & 0xffffu), bf2f(v.y >> 16)}; }
__device__ __forceinline__ f32x4 g_hi4(u32x4 v) { return (f32x4){bf2f(v.z & 0xffffu), bf2f(v.z >> 16), bf2f(v.w & 0xffffu), bf2f(v.w >> 16)}; }
__device__ __forceinline__ u32x2 g_pk4(f32x4 v) { u32x2 r; r.x = pk2(v[0], v[1]); r.y = pk2(v[2], v[3]); return r; }
__device__ __forceinline__ f32x4 g_unpk4(u32x2 v) { return (f32x4){bf2f(v.x & 0xffffu), bf2f(v.x >> 16), bf2f(v.y & 0xffffu), bf2f(v.y >> 16)}; }

template <bool OUT> struct GlaRaw { u32x4 q[2], k[2], v[4]; };
template <bool OUT> __device__ __forceinline__ void gla_issue(GlaRaw<OUT>& x, const char* cb  , unsigned offQ, unsigned offV) {
    if (OUT) { x.q[0] = *(const u32x4*)(cb + offQ); x.q[1] = *(const u32x4*)(cb + offQ + 16); }
    x.k[0] = *(const u32x4*)(cb + offQ + 1024); x.k[1] = *(const u32x4*)(cb + offQ + 1040);
#pragma unroll
    for (int i = 0; i < 4; ++i) x.v[i] = *(const u32x4*)(cb + offV + 16 * i);
}

template <bool OUT>
__device__ void gla_pass(const Params& p, unsigned char* lds) {
    const int tid = threadIdx.x, lane = tid & 63, w = __builtin_amdgcn_readfirstlane(tid >> 6), l15 = lane & 15, g = lane >> 4, q4 = l15 >> 2, p4 = l15 & 3;
    const bf16_t* P = (const bf16_t*)(p.ws + WS_P);
    float* GS = (float*)(p.ws + WS_GS);
    float* GD = (float*)(p.ws + WS_GD);
    bf16_t* Aout = (bf16_t*)(p.ws + WS_A);
    const bf16_t* WupT = (const bf16_t*)(p.ws + WS_WUPT);
    float* BC = (float*)(lds + L_BC); bf16_t* ATT = (bf16_t*)(lds + L_ATT); bf16_t* QD = (bf16_t*)(lds + L_QD); bf16_t* KD = (bf16_t*)(lds + L_KD); bf16_t* KTE = (bf16_t*)(lds + L_KTE);
    bf16_t* VI = (bf16_t*)(lds + L_VI); float* SSQ = (float*)(lds + L_SSQ); float* BL = (float*)(lds + L_BL); float* DEC = (float*)(lds + L_DEC); bf16_t* ADL = (bf16_t*)(lds + L_ADL);
    const float* b_al = p.in[4]; const float* g_head = p.in[5];
    const int c = tid >> 3, seg = tid & 7;

    for (int unit = blockIdx.x; unit < 256; unit += gridDim.x) {
        const int bh = unit >> 5, m = unit & 31, b = bh >> 2, h = bh & 3;
        const int tokbase = b * SEQ + m * 512;
        u32x4 wupq = *(const u32x4*)(WupT + (size_t)(h * 128 + 16 * w + l15) * 16 + 8 * (g & 1));
        if (g >= 2) wupq = (u32x4){0u, 0u, 0u, 0u};
        const bf16x8 wupf = as_bf16x8(wupq);
        const float bA = b_al[h * 128 + 16 * w + l15];
        float logD = 0.f;
        f32x4 S[8][2];
#pragma unroll
        for (int mt = 0; mt < 8; ++mt)
#pragma unroll
            for (int vt = 0; vt < 2; ++vt) {
                if (OUT) {
#pragma unroll
                    for (int r = 0; r < 4; ++r) S[mt][vt][r] = GS[((size_t)(bh * 32 + m) * 128 + 16 * mt + 4 * g + r) * 256 + 32 * w + 16 * vt + l15];
                } else S[mt][vt] = (f32x4){0.f, 0.f, 0.f, 0.f};
            }
        const unsigned offQ = (unsigned)((c * GIN_P + h * 128 + 16 * seg) * 2), offV = (unsigned)((c * GIN_P + 1024 + h * 256 + 32 * seg) * 2), offAD = (unsigned)(((tid >> 1) * GIN_P + 3072 + 8 * (tid & 1)) * 2);
        const unsigned offG = (unsigned)((l15 * GIN_P + 2048 + h * 256 + 32 * w + 4 * g) * 2), offO = (unsigned)((l15 * DM + h * 256 + 32 * w + 4 * g) * 2);
        GlaRaw<OUT> raw;
        gla_issue<OUT>(raw, (const char*)P + (size_t)tokbase * GIN_P * 2, offQ, offV);
        if (tid < 128) *(u32x4*)(ADL + tid * 8) = *(const u32x4*)((const char*)P + (size_t)tokbase * GIN_P * 2 + offAD);
        GLA_BARRIER();

        for (int ch = 0; ch < 8; ++ch) {
            const int tok0 = tokbase + ch * 64;
            u32x4 adn = (u32x4){0u, 0u, 0u, 0u};
            {
                float run = 0.f;
                if (ch < 7 && tid < 128) adn = *(const u32x4*)((const char*)P + (size_t)(tok0 + 64) * GIN_P * 2 + offAD);
#pragma unroll
                for (int ct = 0; ct < 4; ++ct) {
                    u32x4 aq = *(const u32x4*)(ADL + (16 * ct + l15) * 16 + 8 * (g & 1));
                    if (g >= 2) aq = (u32x4){0u, 0u, 0u, 0u};
                    const f32x4 z = mfma16(as_bf16x8(aq), wupf, (f32x4){bA, bA, bA, bA});
                    f32x4 sc;
                    float acc = 0.f;
#pragma unroll
                    for (int r = 0; r < 4; ++r) { acc += (fminf(z[r], 0.f) - __logf(1.f + __expf(-fabsf(z[r])))) * (1.0f / 16.0f); sc[r] = acc; }
                    float x = acc;
                    float y = __shfl_up(x, 16); if (g >= 1) x += y;
                    y = __shfl_up(x, 32); if (g >= 2) x += y;
                    const float base = run + (x - acc);
                    run += __shfl(x, 48 + l15);
#pragma unroll
                    for (int r = 0; r < 4; ++r) BC[(16 * ct + 4 * g + r) * 132 + 16 * w + l15] = base + sc[r];
                }
                if (g == 0) { BL[16 * w + l15] = run; DEC[16 * w + l15] = __expf(run); }
                if (!OUT) logD += run;
            }
            GLA_BARRIER();
            u32x2 gate[2][4];
            {
#pragma unroll
                for (int hh = 0; hh < 2; ++hh) {
                    const int o8 = 16 * seg + 8 * hh;
                    const f32x4 bb[2] = {*(const f32x4*)(BC + c * 132 + o8), *(const f32x4*)(BC + c * 132 + o8 + 4)};
                    const f32x4 dc[2] = {*(const f32x4*)(DEC + o8), *(const f32x4*)(DEC + o8 + 4)};
                    const f32x4 kx[2] = {g_lo4(raw.k[hh]), g_hi4(raw.k[hh])};
                    f32x4 qx[2];
                    if (OUT) { qx[0] = g_lo4(raw.q[hh]); qx[1] = g_hi4(raw.q[hh]); }
                    f32x4 kd[2], kt[2], qd[2];
#pragma unroll
                    for (int i = 0; i < 2; ++i)
#pragma unroll
                        for (int j = 0; j < 4; ++j) {
                            const float eB = __expf(bb[i][j]), enB = __builtin_amdgcn_rcpf(eB);
                            kd[i][j] = kx[i][j] * enB; kt[i][j] = kd[i][j] * dc[i][j];
                            if (OUT) qd[i][j] = qx[i][j] * 0.08838834764831845f * eB;
                        }
                    *(u32x4*)(KTE + c * 144 + o8) = (u32x4){pk2(kt[0][0], kt[0][1]), pk2(kt[0][2], kt[0][3]), pk2(kt[1][0], kt[1][1]), pk2(kt[1][2], kt[1][3])};
                    if (OUT) {
                        *(u32x4*)(KD + c * 136 + o8) = (u32x4){pk2(kd[0][0], kd[0][1]), pk2(kd[0][2], kd[0][3]), pk2(kd[1][0], kd[1][1]), pk2(kd[1][2], kd[1][3])};
                        *(u32x4*)(QD + c * 136 + o8) = (u32x4){pk2(qd[0][0], qd[0][1]), pk2(qd[0][2], qd[0][3]), pk2(qd[1][0], qd[1][1]), pk2(qd[1][2], qd[1][3])};
                    }
                }
#pragma unroll
                for (int i = 0; i < 4; ++i) *(u32x4*)(VI + c * 272 + 32 * seg + 8 * i) = raw.v[i];
                if (OUT) {
#pragma unroll
                    for (int vt = 0; vt < 2; ++vt)
#pragma unroll
                        for (int ct = 0; ct < 4; ++ct) gate[vt][ct] = *(const u32x2*)((const char*)P + (size_t)(tok0 + 16 * ct) * GIN_P * 2 + offG + 32 * vt);
                }
                if (ch < 7) gla_issue<OUT>(raw, (const char*)P + (size_t)(tok0 + 64) * GIN_P * 2, offQ, offV);
                if (ch < 7 && tid < 128) *(u32x4*)(ADL + tid * 8) = adn;
            }
            GLA_BARRIER();
            f32x4 o[2][4];
            if (OUT) {
#pragma unroll
                for (int t2 = 0; t2 < 2; ++t2) {
                    const int tl = 2 * w + t2, ct = tl >> 2, st = tl & 3;
                    f32x4 acc = (f32x4){0.f, 0.f, 0.f, 0.f};
                    if (st <= ct) {
#pragma unroll
                        for (int kk = 0; kk < 4; ++kk) {
                            const bf16x8 a = *(const bf16x8*)(KD + (16 * st + l15) * 136 + 32 * kk + 8 * g);
                            const bf16x8 bq = *(const bf16x8*)(QD + (16 * ct + l15) * 136 + 32 * kk + 8 * g);
                            acc = mfma16(a, bq, acc);
                        }
#pragma unroll
                        for (int r = 0; r < 4; ++r) if (16 * st + 4 * g + r > 16 * ct + l15) acc[r] = 0.f;
                    }
                    *(u32x2*)(ATT + (16 * ct + l15) * 72 + 16 * st + 4 * g) = g_pk4(acc);
                }
                GLA_BARRIER();
#pragma unroll
                for (int vt = 0; vt < 2; ++vt)
#pragma unroll
                    for (int ct = 0; ct < 4; ++ct) o[vt][ct] = (f32x4){0.f, 0.f, 0.f, 0.f};
#pragma unroll
                for (int kk = 0; kk < 4; ++kk) {
                    bf16x8 sa[2];
#pragma unroll
                    for (int vt = 0; vt < 2; ++vt) { const u32x2 s0 = g_pk4(S[2 * kk][vt]), s1 = g_pk4(S[2 * kk + 1][vt]); sa[vt] = as_bf16x8((u32x4){s0.x, s0.y, s1.x, s1.y}); }
#pragma unroll
                    for (int ct = 0; ct < 4; ++ct) {
                        const bf16_t* qr = QD + (16 * ct + l15) * 136 + 32 * kk + 4 * g;
                        const u32x2 lo = *(const u32x2*)qr, hi = *(const u32x2*)(qr + 16);
                        const bf16x8 bq = as_bf16x8((u32x4){lo.x, lo.y, hi.x, hi.y});
#pragma unroll
                        for (int vt = 0; vt < 2; ++vt) o[vt][ct] = mfma16(sa[vt], bq, o[vt][ct]);
                    }
                }
            }
            bf16x8 bv[2][2];
#pragma unroll
            for (int vt = 0; vt < 2; ++vt)
#pragma unroll
                for (int kk = 0; kk < 2; ++kk) bv[vt][kk] = g_trfrag<272>(VI, 32 * kk, 32 * w + 16 * vt, g, q4, p4);
            if (OUT) {
#pragma unroll
                for (int ct = 0; ct < 4; ++ct)
#pragma unroll
                    for (int kk = 0; kk < 2; ++kk) {
                        if (32 * kk <= 16 * ct + 15) {
                            const bf16x8 bq = *(const bf16x8*)(ATT + (16 * ct + l15) * 72 + 32 * kk + 8 * g);
#pragma unroll
                            for (int vt = 0; vt < 2; ++vt) o[vt][ct] = mfma16(bv[vt][kk], bq, o[vt][ct]);
                        }
                    }
            }
#pragma unroll
            for (int mt = 0; mt < 8; ++mt) {
                const f32x4 dv = *(const f32x4*)(DEC + 16 * mt + 4 * g);
#pragma unroll
                for (int vt = 0; vt < 2; ++vt) S[mt][vt] *= dv;
#pragma unroll
                for (int kk = 0; kk < 2; ++kk) {
                    const bf16x8 a = g_trfrag<144>(KTE, 32 * kk, 16 * mt, g, q4, p4);
#pragma unroll
                    for (int vt = 0; vt < 2; ++vt) S[mt][vt] = mfma16(a, bv[vt][kk], S[mt][vt]);
                }
            }
            if (OUT) {
                float ss[4];
#pragma unroll
                for (int ct = 0; ct < 4; ++ct) {
                    float s = 0.f;
#pragma unroll
                    for (int vt = 0; vt < 2; ++vt)
#pragma unroll
                        for (int r = 0; r < 4; ++r) s += o[vt][ct][r] * o[vt][ct][r];
                    s += __shfl_xor(s, 16); s += __shfl_xor(s, 32);
                    ss[ct] = s;
                }
                if (g == 0) {
#pragma unroll
                    for (int ct = 0; ct < 4; ++ct) SSQ[(16 * ct + l15) * 8 + w] = ss[ct];
                }
                f32x4 gh[2];
#pragma unroll
                for (int vt = 0; vt < 2; ++vt) gh[vt] = *(const f32x4*)(g_head + 32 * w + 16 * vt + 4 * g);
                GLA_BARRIER();
#pragma unroll
                for (int ct = 0; ct < 4; ++ct) {
                    const int cc = 16 * ct + l15;
                    const float4 s0 = *(const float4*)(SSQ + cc * 8), s1 = *(const float4*)(SSQ + cc * 8 + 4);
                    const float tot = (s0.x + s0.y) + (s0.z + s0.w) + (s1.x + s1.y) + (s1.z + s1.w);
                    const float rstd = rsqrtf(tot * (1.0f / 256.0f) + 1e-6f);
#pragma unroll
                    for (int vt = 0; vt < 2; ++vt) {
                        const f32x4 gt = g_unpk4(gate[vt][ct]);
                        f32x4 val;
#pragma unroll
                        for (int r = 0; r < 4; ++r) val[r] = o[vt][ct][r] * rstd * gh[vt][r] * gt[r] * __builtin_amdgcn_rcpf(1.0f + __expf(-gt[r]));
                        *(u32x2*)((char*)Aout + (size_t)(tok0 + 16 * ct) * DM * 2 + offO + 32 * vt) = g_pk4(val);
                    }
                }
            } else {
                GLA_BARRIER();
            }
        }
        if (!OUT) {
#pragma unroll
            for (int mt = 0; mt < 8; ++mt)
#pragma unroll
                for (int vt = 0; vt < 2; ++vt)
#pragma unroll
                    for (int r = 0; r < 4; ++r) GS[((size_t)(bh * 32 + m) * 128 + 16 * mt + 4 * g + r) * 256 + 32 * w + 16 * vt + l15] = S[mt][vt][r];
            if (g == 0) GD[(bh * 32 + m) * 128 + 16 * w + l15] = __expf(logD);
        }
        GLA_BARRIER();
    }
}

__device__ void gla_scan(const Params& p) {
    float* GS = (float*)(p.ws + WS_GS);
    const float* GD = (const float*)(p.ws + WS_GD);
    for (int idx = blockIdx.x * NTH + threadIdx.x; idx < 8 * 32768; idx += gridDim.x * NTH) {
        const int bh = idx >> 15, e = idx & 32767, d = e >> 8;
        float S = 0.f;
        for (int m0 = 0; m0 < 32; m0 += 16) {
            float t[16], dd[16];
#pragma unroll
            for (int m = 0; m < 16; ++m) { t[m] = GS[(size_t)(bh * 32 + m0 + m) * 32768 + e]; dd[m] = GD[(bh * 32 + m0 + m) * 128 + d]; }
#pragma unroll
            for (int m = 0; m < 16; ++m) { GS[(size_t)(bh * 32 + m0 + m) * 32768 + e] = S; S = S * dd[m] + t[m]; }
        }
    }
}

constexpr int PP = RIN_P;
constexpr size_t WS_RK  = WS_GS;
constexpr size_t WS_BND = WS_GS + (size_t)MTOK * 16 * 4;
static_assert(WS_BND + (size_t)513 * PP * 2 <= WS_GD, "RWKV side buffers must fit the GLA state region");
constexpr int IMG = 64 * 72 * 2;
constexpr int R_ALB = 0, R_BH = IMG, R_KH = 2 * IMG, R_RB = 3 * IMG, R_BTL = 4 * IMG, R_KTL = 5 * IMG, R_VI = 6 * IMG, R_AAB = 7 * IMG, R_AAK = 8 * IMG, R_ARB = 9 * IMG, R_ARK = 10 * IMG,
              R_DW = R_AAB, R_DA = R_AAB + 64 * 68 * 4, R_XT = 11 * IMG, R_TW = R_XT, R_ADI = R_XT + IMG, R_TDF = R_XT + 2 * IMG, R_CS = R_TDF + 2048, R_GC = R_CS + 2048, R_CONST = R_GC + 256,
              R_END = R_CONST + 2560;
static_assert(R_DA + 64 * 68 * 4 <= R_XT && R_END <= LDS_BYTES, "R1 LDS");
#define LDS_BARRIER() do { asm volatile("s_waitcnt lgkmcnt(0)" ::: "memory"); __builtin_amdgcn_s_barrier(); asm volatile("" ::: "memory"); } while (0)

typedef short s16x4 __attribute__((ext_vector_type(4)));
__device__ __forceinline__ bf16x8 ldfrag(const bf16_t* img, int row, int koff) { return *(const bf16x8*)(img + row * 72 + koff); }
__device__ __forceinline__ u32x2 pk4(f32x4 v) { u32x2 r; r.x = pk2(v[0], v[1]); r.y = pk2(v[2], v[3]); return r; }
__device__ __forceinline__ f32x4 unpk4(u32x2 v) { return (f32x4){bf2f(v.x & 0xffffu), bf2f(v.x >> 16), bf2f(v.y & 0xffffu), bf2f(v.y >> 16)}; }
__device__ __forceinline__ u32x2 trread(const bf16_t* p) {
    union { s16x4 s; u32x2 u; } x; x.s = __builtin_amdgcn_ds_read_tr16_b64_v4i16((__attribute__((address_space(3))) s16x4*)p); return x.u;
}
__device__ __forceinline__ bf16x8 trfrag(const bf16_t* img, int k0, int c0, int g, int q, int pq) {
    const bf16_t* a = img + (k0 + 8 * g + q) * 72 + c0 + 4 * pq;
    const u32x2 lo = trread(a), hi = trread(a + 4 * 72);
    return as_bf16x8((u32x4){lo.x, lo.y, hi.x, hi.y});
}
__device__ __forceinline__ f32x4 lo4(u32x4 v) { return (f32x4){bf2f(v.x & 0xffffu), bf2f(v.x >> 16), bf2f(v.y & 0xffffu), bf2f(v.y >> 16)}; }
__device__ __forceinline__ f32x4 hi4(u32x4 v) { return (f32x4){bf2f(v.z & 0xffffu), bf2f(v.z >> 16), bf2f(v.w & 0xffffu), bf2f(v.w >> 16)}; }
__device__ __forceinline__ u32x4 pk8(f32x4 a, f32x4 b) { return (u32x4){pk2(a[0], a[1]), pk2(a[2], a[3]), pk2(b[0], b[1]), pk2(b[2], b[3])}; }
__device__ __forceinline__ float fast_rcp(float x) { return __builtin_amdgcn_rcpf(x); }
__device__ __forceinline__ f32x4 mm16(f32x4 xa, f32x4 yb, f32x4 c) {
    const u32x2 a = pk4(xa), b = pk4(yb);
    return mfma16(as_bf16x8((u32x4){a.x, a.y, 0u, 0u}), as_bf16x8((u32x4){b.x, b.y, 0u, 0u}), c);
}

struct R1Raw { u32x4 r0, r1, k0, k1, v0, v1, w0, w1, a0, a1; };
__device__ __forceinline__ void r1_issue(R1Raw& x, const bf16_t* P, const bf16_t* BND, int unit, int t, int cs) {
    const int bn = unit >> 4, h = unit & 15;
    const bf16_t* cur = P + ((size_t)bn * 64 + t) * PP;
    const bf16_t* prv = (t > 0) ? (cur - PP) : (BND + (size_t)bn * PP);
    const int ch = h * 64 + 8 * cs;
    x.r0 = *(const u32x4*)(cur + ch); x.k0 = *(const u32x4*)(cur + 1024 + ch); x.v0 = *(const u32x4*)(cur + 2048 + ch); x.w0 = *(const u32x4*)(cur + 4096 + 8 * cs); x.a0 = *(const u32x4*)(cur + 4160 + 8 * cs);
    x.r1 = *(const u32x4*)(prv + ch); x.k1 = *(const u32x4*)(prv + 1024 + ch); x.v1 = *(const u32x4*)(prv + 2048 + ch); x.w1 = *(const u32x4*)(prv + 4096 + 8 * cs); x.a1 = *(const u32x4*)(prv + 4160 + 8 * cs);
}
__device__ __forceinline__ void lerp8(u32x4 c, u32x4 pv, bool zprev, const float* mu8, f32x4& o0, f32x4& o1) {
    const f32x4 c0 = lo4(c), c1 = hi4(c);
    f32x4 p0 = lo4(pv), p1 = hi4(pv);
    if (zprev) { p0 = (f32x4){0.f, 0.f, 0.f, 0.f}; p1 = p0; }
    const f32x4 m0 = *(const f32x4*)mu8, m1 = *(const f32x4*)(mu8 + 4);
    o0 = c0 + m0 * (p0 - c0); o1 = c1 + m1 * (p1 - c1);
}

__device__ void rwkv_r1(const Params& p, unsigned char* lds) {
    const int tid = threadIdx.x, lane = tid & 63, w = tid >> 6, l15 = lane & 15, g = lane >> 4, q4 = l15 >> 2, p4 = l15 & 3;
    bf16_t* P = (bf16_t*)(p.ws + WS_P);
    bf16_t* Abuf = (bf16_t*)(p.ws + WS_A);
    bf16_t* Ybuf = (bf16_t*)(p.ws + WS_Y);
    float* RK = (float*)(p.ws + WS_RK);
    const bf16_t* BND = (const bf16_t*)(p.ws + WS_BND);
    const bf16_t* WduT = (const bf16_t*)(p.ws + WS_WDUT);
    const bf16_t* WiuT = (const bf16_t*)(p.ws + WS_WIUT);
    bf16_t* ALB = (bf16_t*)(lds + R_ALB); bf16_t* BH = (bf16_t*)(lds + R_BH); bf16_t* KH = (bf16_t*)(lds + R_KH); bf16_t* RB = (bf16_t*)(lds + R_RB);
    bf16_t* BTL = (bf16_t*)(lds + R_BTL); bf16_t* KTL = (bf16_t*)(lds + R_KTL); bf16_t* VI = (bf16_t*)(lds + R_VI);
    bf16_t* AAB = (bf16_t*)(lds + R_AAB); bf16_t* AAK = (bf16_t*)(lds + R_AAK); bf16_t* ARB = (bf16_t*)(lds + R_ARB); bf16_t* ARK = (bf16_t*)(lds + R_ARK);
    float* DW = (float*)(lds + R_DW); float* DA = (float*)(lds + R_DA);
    bf16_t* XT = (bf16_t*)(lds + R_XT); bf16_t* TW = (bf16_t*)(lds + R_TW); bf16_t* ADI = (bf16_t*)(lds + R_ADI);
    u32x2* TDF = (u32x2*)(lds + R_TDF); float* CS = (float*)(lds + R_CS); float* GCs = (float*)(lds + R_GC); float* CONST = (float*)(lds + R_CONST);
    const int t = tid >> 3, cs = tid & 7, tl = lane >> 3;
    int hprev = -1;
    R1Raw raw;
    if (blockIdx.x < 8192) r1_issue(raw, P, BND, blockIdx.x, t, cs);

    for (int unit = blockIdx.x; unit < 8192; unit += gridDim.x) {
        const int bn = unit >> 4, h = unit & 15, n = bn & 255;
        const size_t R0 = (size_t)bn * 64;
        if (h != hprev) {
            LDS_BARRIER();
            if (tid < 64) {
                const int ch = h * 64 + tid;
                CONST[tid] = p.in[10][ch]; CONST[64 + tid] = p.in[10][1024 + ch]; CONST[128 + tid] = p.in[10][2048 + ch];
                CONST[192 + tid] = p.in[11][ch]; CONST[256 + tid] = p.in[13][ch]; CONST[320 + tid] = p.in[15][ch]; CONST[384 + tid] = p.in[16][ch]; CONST[448 + tid] = p.in[17][ch];
                CONST[512 + tid] = p.in[10][4096 + tid]; CONST[576 + tid] = p.in[10][4160 + tid];
            }
            hprev = h;
            LDS_BARRIER();
        }
        bf16x8 fwd[2][2], fwi[2][2];
#pragma unroll
        for (int q = 0; q < 2; ++q)
#pragma unroll
            for (int kk = 0; kk < 2; ++kk) {
                const size_t o = (size_t)(h * 64 + 16 * (2 * (w >> 2) + q) + l15) * 64 + 32 * kk + 8 * g;
                fwd[q][kk] = *(const bf16x8*)(WduT + o); fwi[q][kk] = *(const bf16x8*)(WiuT + o);
            }
        f32x4 r0, r1, k0, k1, v0, v1;
        {
            const bool zp = (t == 0 && n == 0);
            f32x4 wd0, wd1, ad0, ad1;
            lerp8(raw.r0, raw.r1, zp, CONST + 8 * cs, r0, r1);
            lerp8(raw.k0, raw.k1, zp, CONST + 64 + 8 * cs, k0, k1);
            lerp8(raw.v0, raw.v1, zp, CONST + 128 + 8 * cs, v0, v1);
            lerp8(raw.w0, raw.w1, zp, CONST + 512 + 8 * cs, wd0, wd1);
            lerp8(raw.a0, raw.a1, zp, CONST + 576 + 8 * cs, ad0, ad1);
#pragma unroll
            for (int j = 0; j < 4; ++j) {
                const float e0 = __expf(-2.f * fabsf(wd0[j])), e1 = __expf(-2.f * fabsf(wd1[j]));
                wd0[j] = copysignf((1.f - e0) * fast_rcp(1.f + e0), wd0[j]); wd1[j] = copysignf((1.f - e1) * fast_rcp(1.f + e1), wd1[j]);
            }
            *(u32x4*)(TW + t * 72 + 8 * cs) = pk8(wd0, wd1);
            *(u32x4*)(ADI + t * 72 + 8 * cs) = pk8(ad0, ad1);
        }
        if (unit + (int)gridDim.x < 8192) r1_issue(raw, P, BND, unit + gridDim.x, t, cs);
        LDS_BARRIER();
        {
            const int tt = w & 3;
            bf16x8 ft[2], fa[2];
#pragma unroll
            for (int kk = 0; kk < 2; ++kk) { ft[kk] = ldfrag(TW, 16 * tt + l15, 32 * kk + 8 * g); fa[kk] = ldfrag(ADI, 16 * tt + l15, 32 * kk + 8 * g); }
#pragma unroll
            for (int q = 0; q < 2; ++q) {
                const int ct = 2 * (w >> 2) + q;
                f32x4 aw = (f32x4){0.f, 0.f, 0.f, 0.f}, aa = aw;
#pragma unroll
                for (int kk = 0; kk < 2; ++kk) { aw = mfma16(fwd[q][kk], ft[kk], aw); aa = mfma16(fwi[q][kk], fa[kk], aa); }
                *(f32x4*)(DW + (16 * tt + l15) * 68 + 16 * ct + 4 * g) = aw;
                *(f32x4*)(DA + (16 * tt + l15) * 68 + 16 * ct + 4 * g) = aa;
            }
        }
        LDS_BARRIER();
        f32x4 lw[2], av[2], kk[2], k2[2], G[2];
        {
            const f32x4 cw0[2] = {*(const f32x4*)(CONST + 192 + 8 * cs), *(const f32x4*)(CONST + 196 + 8 * cs)};
            const f32x4 ca0[2] = {*(const f32x4*)(CONST + 256 + 8 * cs), *(const f32x4*)(CONST + 260 + 8 * cs)};
            const f32x4 ckk[2] = {*(const f32x4*)(CONST + 320 + 8 * cs), *(const f32x4*)(CONST + 324 + 8 * cs)};
            const f32x4 cka[2] = {*(const f32x4*)(CONST + 384 + 8 * cs), *(const f32x4*)(CONST + 388 + 8 * cs)};
            const f32x4 crk[2] = {*(const f32x4*)(CONST + 448 + 8 * cs), *(const f32x4*)(CONST + 452 + 8 * cs)};
            const f32x4 dwv[2] = {*(const f32x4*)(DW + t * 68 + 8 * cs), *(const f32x4*)(DW + t * 68 + 8 * cs + 4)};
            const f32x4 dav[2] = {*(const f32x4*)(DA + t * 68 + 8 * cs), *(const f32x4*)(DA + t * 68 + 8 * cs + 4)};
            const f32x4 kin[2] = {k0, k1}, rin[2] = {r0, r1};
            float n2 = 0.f, rk = 0.f;
#pragma unroll
            for (int hf = 0; hf < 2; ++hf)
#pragma unroll
                for (int j = 0; j < 4; ++j) {
                    const float z = -(cw0[hf][j] + dwv[hf][j]);
                    const float sp = fmaxf(z, 0.f) + __logf(1.f + __expf(-fabsf(z)));
                    lw[hf][j] = -__expf(-sp - 0.5f);
                    av[hf][j] = fast_rcp(1.f + __expf(-(ca0[hf][j] + dav[hf][j])));
                    kk[hf][j] = kin[hf][j] * ckk[hf][j];
                    k2[hf][j] = kin[hf][j] * (1.f + (av[hf][j] - 1.f) * cka[hf][j]);
                    n2 += kk[hf][j] * kk[hf][j]; rk += rin[hf][j] * k2[hf][j] * crk[hf][j];
                }
            n2 += __shfl_xor(n2, 1); rk += __shfl_xor(rk, 1); n2 += __shfl_xor(n2, 2); rk += __shfl_xor(rk, 2); n2 += __shfl_xor(n2, 4); rk += __shfl_xor(rk, 4);
            const float inv = 1.0f / fmaxf(sqrtf(n2), 1e-12f);
            kk[0] *= inv; kk[1] *= inv;
            if (cs == 0) RK[(R0 + t) * 16 + h] = rk;
            G[0] = lw[0]; G[1] = lw[1];
#pragma unroll
            for (int d = 1; d < 8; d <<= 1)
#pragma unroll
                for (int hf = 0; hf < 2; ++hf)
#pragma unroll
                    for (int j = 0; j < 4; ++j) { const float y = __shfl_up(G[hf][j], 8 * d); if (tl >= d) G[hf][j] += y; }
            if (tl == 7) { *(f32x4*)(CS + w * 64 + 8 * cs) = G[0]; *(f32x4*)(CS + w * 64 + 8 * cs + 4) = G[1]; }
        }
        LDS_BARRIER();
        {
            f32x4 off[2] = {(f32x4){0.f, 0.f, 0.f, 0.f}, (f32x4){0.f, 0.f, 0.f, 0.f}}, gc[2] = {off[0], off[0]};
#pragma unroll
            for (int q = 0; q < 8; ++q) {
                const f32x4 c0 = *(const f32x4*)(CS + q * 64 + 8 * cs), c1 = *(const f32x4*)(CS + q * 64 + 8 * cs + 4);
                gc[0] += c0; gc[1] += c1;
                if (q < w) { off[0] += c0; off[1] += c1; }
            }
            f32x4 al[2], bh[2], kh[2], rb[2], bt[2], kt[2];
            const f32x4 rin[2] = {r0, r1};
#pragma unroll
            for (int hf = 0; hf < 2; ++hf)
#pragma unroll
                for (int j = 0; j < 4; ++j) {
                    const float Gi = G[hf][j] + off[hf][j];
                    const float eG = __expf(Gi), eGm = __expf(Gi - lw[hf][j]), enG = fast_rcp(eG), eC = __expf(gc[hf][j] - Gi);
                    const float be = kk[hf][j] * av[hf][j];
                    al[hf][j] = -kk[hf][j] * eGm; bh[hf][j] = be * enG; kh[hf][j] = k2[hf][j] * enG; rb[hf][j] = rin[hf][j] * eG; bt[hf][j] = be * eC; kt[hf][j] = k2[hf][j] * eC;
                }
            const int o = t * 72 + 8 * cs;
            *(u32x4*)(ALB + o) = pk8(al[0], al[1]); *(u32x4*)(BH + o) = pk8(bh[0], bh[1]); *(u32x4*)(KH + o) = pk8(kh[0], kh[1]); *(u32x4*)(RB + o) = pk8(rb[0], rb[1]);
            *(u32x4*)(BTL + o) = pk8(bt[0], bt[1]); *(u32x4*)(KTL + o) = pk8(kt[0], kt[1]);
            const u32x4 vpk = pk8(v0, v1);
            *(u32x4*)(VI + o) = vpk;
            *(u32x4*)(Ybuf + (R0 + t) * DM + h * 64 + 8 * cs) = vpk;
            if (w == 0 && tl == 0) { f32x4 e0, e1;
#pragma unroll
                for (int j = 0; j < 4; ++j) { e0[j] = __expf(gc[0][j]); e1[j] = __expf(gc[1][j]); }
                *(f32x4*)(GCs + 8 * cs) = e0; *(f32x4*)(GCs + 8 * cs + 4) = e1; }
        }
        LDS_BARRIER();
        {
            int ntile = 1, tta = 0, sta = 0, ttb = 0, stb = 0;
            if (w == 0) { tta = 0; sta = 0; } else if (w == 2) { tta = 1; sta = 1; } else if (w == 5) { tta = 2; sta = 2; } else if (w == 7) { tta = 3; sta = 3; }
            else if (w == 1) { ntile = 2; tta = 1; sta = 0; ttb = 2; stb = 0; } else if (w == 3) { ntile = 2; tta = 2; sta = 1; ttb = 3; stb = 0; }
            else if (w == 4) { tta = 3; sta = 1; } else { tta = 3; sta = 2; }
            for (int it = 0; it < ntile; ++it) {
                const int tt = it ? ttb : tta, st = it ? stb : sta;
                f32x4 cab = (f32x4){0.f, 0.f, 0.f, 0.f}, cak = cab, crb = cab, crk = cab, nab = cab;
#pragma unroll
                for (int kq = 0; kq < 2; ++kq) {
                    const bf16x8 fb = ldfrag(BH, 16 * st + l15, 32 * kq + 8 * g), fk = ldfrag(KH, 16 * st + l15, 32 * kq + 8 * g);
                    const bf16x8 fa = ldfrag(ALB, 16 * tt + l15, 32 * kq + 8 * g), fr = ldfrag(RB, 16 * tt + l15, 32 * kq + 8 * g);
                    cab = mfma16(fb, fa, cab); cak = mfma16(fk, fa, cak); crb = mfma16(fb, fr, crb); crk = mfma16(fk, fr, crk);
                    if (tt == st) nab = mfma16(fa, fb, nab);
                }
                if (tt == st) {
#pragma unroll
                    for (int r = 0; r < 4; ++r) {
                        const int s = 4 * g + r, tq = l15;
                        if (s >= tq) { cab[r] = 0.f; cak[r] = 0.f; }
                        if (s > tq) { crb[r] = 0.f; crk[r] = 0.f; }
                        if (l15 >= 4 * g + r) nab[r] = 0.f;
                    }
                }
                const int o = (16 * tt + l15) * 72 + 16 * st + 4 * g;
                *(u32x2*)(AAB + o) = pk4(cab); *(u32x2*)(AAK + o) = pk4(cak); *(u32x2*)(ARB + o) = pk4(crb); *(u32x2*)(ARK + o) = pk4(crk);
                if (tt == st) {
                    const f32x4 z = (f32x4){0.f, 0.f, 0.f, 0.f};
                    const f32x4 Q1 = cab, N1 = nab;
                    const f32x4 Q2 = mm16(N1, Q1, z), N2 = mm16(Q1, N1, z);
                    f32x4 Pm = Q1;
#pragma unroll
                    for (int r = 0; r < 4; ++r) if (4 * g + r == l15) Pm[r] += 1.f;
                    Pm = mm16(N2, Pm, Pm);
                    const f32x4 Q4 = mm16(N2, Q2, z), N4 = mm16(Q2, N2, z);
                    Pm = mm16(N4, Pm, Pm);
                    const f32x4 N8 = mm16(Q4, N4, z);
                    Pm = mm16(N8, Pm, Pm);
                    TDF[tt * 64 + lane] = pk4(Pm);
                }
            }
            if (w == 4 || w == 6) {
                const int tt = (w == 4) ? 0 : 2, st = tt + 1;
                const int o = (16 * tt + l15) * 72 + 16 * st + 4 * g;
                const u32x2 zz = (u32x2){0u, 0u};
                *(u32x2*)(AAK + o) = zz; *(u32x2*)(ARB + o) = zz; *(u32x2*)(ARK + o) = zz;
            }
        }
        LDS_BARRIER();
        {
            u32x2 xb[4];
            const int col = 16 * w + l15;
            bf16x8 vfr[2];
            if (w >= 4) { vfr[0] = trfrag(VI, 0, 16 * (w - 4), g, q4, p4); vfr[1] = trfrag(VI, 32, 16 * (w - 4), g, q4, p4); }
#pragma unroll
            for (int i = 0; i < 4; ++i) {
                f32x4 z;
                if (w < 4) z = unpk4(trread(ALB + (16 * i + 4 * g + q4) * 72 + 16 * w + 4 * p4));
                else {
                    z = mfma16(ldfrag(AAK, 16 * i + l15, 8 * g), vfr[0], (f32x4){0.f, 0.f, 0.f, 0.f});
                    if (i >= 2) z = mfma16(ldfrag(AAK, 16 * i + l15, 32 + 8 * g), vfr[1], z);
                }
                if (i >= 1) {
                    const bf16_t* ar = AAB + (16 * i + l15) * 72 + 4 * g;
                    const u32x2 a0 = *(const u32x2*)ar;
                    u32x2 a1 = (u32x2){0u, 0u}, b1 = (u32x2){0u, 0u};
                    if (i >= 2) { a1 = *(const u32x2*)(ar + 16); b1 = xb[1]; }
                    z = mfma16(as_bf16x8((u32x4){a0.x, a0.y, a1.x, a1.y}), as_bf16x8((u32x4){xb[0].x, xb[0].y, b1.x, b1.y}), z);
                    if (i == 3) {
                        const u32x2 a2 = *(const u32x2*)(ar + 32);
                        z = mfma16(as_bf16x8((u32x4){a2.x, a2.y, 0u, 0u}), as_bf16x8((u32x4){xb[2].x, xb[2].y, 0u, 0u}), z);
                    }
                }
                const u32x2 tq = TDF[i * 64 + lane];
                const u32x2 zq = pk4(z);
                const f32x4 x = mfma16(as_bf16x8((u32x4){tq.x, tq.y, 0u, 0u}), as_bf16x8((u32x4){zq.x, zq.y, 0u, 0u}), (f32x4){0.f, 0.f, 0.f, 0.f});
                xb[i] = pk4(x);
                *(u32x2*)(XT + col * 72 + 16 * i + 4 * g) = xb[i];
            }
        }
        LDS_BARRIER();
        {
            const int rt_ = w & 3;
            bf16x8 xw[2], xu[2], fbt[2], fkt[2], fvr[2];
#pragma unroll
            for (int kq = 0; kq < 2; ++kq) {
                xw[kq] = ldfrag(XT, 16 * rt_ + l15, 32 * kq + 8 * g);
                xu[kq] = ldfrag(XT, 64 + 16 * rt_ + l15, 32 * kq + 8 * g);
                fbt[kq] = trfrag(BTL, 32 * kq, 16 * rt_, g, q4, p4);
                fkt[kq] = trfrag(KTL, 32 * kq, 16 * rt_, g, q4, p4);
                fvr[kq] = trfrag(VI, 32 * kq, 16 * rt_, g, q4, p4);
            }
#pragma unroll
            for (int q = 0; q < 2; ++q) {
                const int ctile = 2 * (w >> 2) + q;
                {
                    f32x4 acc = (f32x4){0.f, 0.f, 0.f, 0.f};
#pragma unroll
                    for (int kq = 0; kq < 2; ++kq) acc = mfma16(xw[kq], trfrag(BTL, 32 * kq, 16 * ctile, g, q4, p4), acc);
                    const int dcol = 16 * ctile + l15;
                    if (rt_ == ctile) {
                        const float gc = GCs[dcol];
#pragma unroll
                        for (int r = 0; r < 4; ++r) if (4 * g + r == l15) acc[r] += gc;
                    }
                    *(u32x2*)(P + (R0 + dcol) * PP + h * 64 + 32 * (rt_ >> 1) + 8 * g + 4 * (rt_ & 1)) = pk4(acc);
                }
                {
                    f32x4 acc = unpk4(*(const u32x2*)(RB + (16 * ctile + l15) * 72 + 16 * rt_ + 4 * g));
#pragma unroll
                    for (int kq = 0; kq < 2; ++kq) {
                        if (32 * kq <= 16 * ctile + 15) acc = mfma16(xw[kq], ldfrag(ARB, 16 * ctile + l15, 32 * kq + 8 * g), acc);
                    }
                    *(u32x2*)(P + (R0 + 16 * ctile + l15) * PP + 1024 + h * 64 + 16 * rt_ + 4 * g) = pk4(acc);
                }
                {
                    f32x4 acc = (f32x4){0.f, 0.f, 0.f, 0.f};
#pragma unroll
                    for (int kq = 0; kq < 2; ++kq) {
                        acc = mfma16(fbt[kq], ldfrag(XT, 64 + 16 * ctile + l15, 32 * kq + 8 * g), acc);
                        acc = mfma16(fkt[kq], trfrag(VI, 32 * kq, 16 * ctile, g, q4, p4), acc);
                    }
                    *(u32x2*)(P + (R0 + 16 * ctile + l15) * PP + 2048 + h * 64 + 16 * rt_ + 4 * g) = pk4(acc);
                }
                {
                    f32x4 acc = (f32x4){0.f, 0.f, 0.f, 0.f};
#pragma unroll
                    for (int kq = 0; kq < 2; ++kq) {
                        if (32 * kq <= 16 * ctile + 15) {
                            acc = mfma16(xu[kq], ldfrag(ARB, 16 * ctile + l15, 32 * kq + 8 * g), acc);
                            acc = mfma16(fvr[kq], ldfrag(ARK, 16 * ctile + l15, 32 * kq + 8 * g), acc);
                        }
                    }
                    *(u32x2*)(Abuf + (R0 + 16 * ctile + l15) * DM + h * 64 + 16 * rt_ + 4 * g) = pk4(acc);
                }
            }
        }
        LDS_BARRIER();
    }
}

constexpr int SC_SLOT = 2 * IMG;
__device__ void rwkv_scan(const Params& p, unsigned char* lds) {
    if (blockIdx.x >= 32) return;
    const int tid = threadIdx.x, lane = tid & 63, w = __builtin_amdgcn_readfirstlane(tid >> 6), l15 = lane & 15, g = lane >> 4;
    const int bh = blockIdx.x, b = bh >> 4, h = bh & 15;
    bf16_t* P = (bf16_t*)(p.ws + WS_P);
    const size_t Rb = (size_t)b * SEQ;
    if (w >= 4) {
        const int lj = w - 4;
        const unsigned goff = (unsigned)(((lane >> 3) * PP + (lane & 7) * 8) * 2);
        const unsigned loff = (unsigned)((lane >> 3) * 144 + (lane & 7) * 16);
        const char* gbase = (const char*)P + (Rb * PP + h * 64) * 2;
        u32x4 ld0[16], ld1[16];
#define SC_ISSUE(dst, chunk) do { const char* cb = gbase + (size_t)(chunk) * 64 * PP * 2; _Pragma("unroll") for (int q = 0; q < 16; ++q) \
        dst[q] = *(const u32x4*)(cb + (size_t)(((q & 7) * 8 * PP + (q >> 3) * 2048) * 2) + goff); } while (0)
#define SC_RETIRE(src, chunk) do { unsigned char* sb = lds + ((chunk) & 1) * SC_SLOT + loff; _Pragma("unroll") for (int q = 0; q < 16; ++q) \
        *(u32x4*)(sb + (q >> 3) * IMG + (q & 7) * 8 * 144) = src[q]; } while (0)
        SC_ISSUE(ld0, lj); SC_ISSUE(ld1, lj + 4);
        for (int it = 0; it < 32; ++it) {
            const int c0 = lj + 8 * it;
            for (int k = 0; k < lj; ++k) LDS_BARRIER();
            SC_RETIRE(ld0, c0); SC_ISSUE(ld0, (c0 + 8 < 256 ? c0 + 8 : 255));
            for (int k = 0; k < 4; ++k) LDS_BARRIER();
            SC_RETIRE(ld1, c0 + 4); SC_ISSUE(ld1, (c0 + 12 < 256 ? c0 + 12 : 255));
            for (int k = 0; k < 4 - lj; ++k) LDS_BARRIER();
        }
        LDS_BARRIER();
#undef SC_ISSUE
#undef SC_RETIRE
    } else {
        f32x4 H[4];
#pragma unroll
        for (int mt = 0; mt < 4; ++mt) H[mt] = (f32x4){0.f, 0.f, 0.f, 0.f};
        for (int i = 0; i <= 256; ++i) {
            if (i >= 1) {
                const int n = i - 1;
                const unsigned char* sb = lds + (n & 1) * SC_SLOT;
                const bf16_t* MT = (const bf16_t*)sb; const bf16_t* NT = (const bf16_t*)(sb + IMG);
                u32x2 hp[4];
#pragma unroll
                for (int mt = 0; mt < 4; ++mt) {
                    hp[mt] = pk4(H[mt]);
                    *(u32x2*)(P + (Rb + (size_t)n * 64 + 16 * w + l15) * PP + 2048 + h * 64 + 16 * mt + 4 * g) = hp[mt];
                }
                bf16x8 hb[2];
                hb[0] = as_bf16x8((u32x4){hp[0].x, hp[0].y, hp[1].x, hp[1].y});
                hb[1] = as_bf16x8((u32x4){hp[2].x, hp[2].y, hp[3].x, hp[3].y});
#pragma unroll
                for (int mt = 0; mt < 4; ++mt) {
                    f32x4 acc = unpk4(*(const u32x2*)(NT + (16 * w + l15) * 72 + 16 * mt + 4 * g));
#pragma unroll
                    for (int kk = 0; kk < 2; ++kk) acc = mfma16(ldfrag(MT, 16 * mt + l15, 32 * kk + 8 * g), hb[kk], acc);
                    H[mt] = acc;
                }
            }
            LDS_BARRIER();
        }
    }
}

__device__ void rwkv_post(const Params& p) {
    const int tid = threadIdx.x, lane = tid & 63, w = tid >> 6, l15 = lane & 15, g = lane >> 4;
    const bf16_t* P = (const bf16_t*)(p.ws + WS_P);
    bf16_t* Abuf = (bf16_t*)(p.ws + WS_A);
    const bf16_t* Ybuf = (const bf16_t*)(p.ws + WS_Y);
    const float* RK = (const float*)(p.ws + WS_RK);
    const bf16_t* BND = (const bf16_t*)(p.ws + WS_BND);
    for (int hu = blockIdx.x * 8 + w; hu < 16384; hu += gridDim.x * 8) {
        const int unit = hu >> 1, t0 = (hu & 1) * 32;
        const int bn = unit >> 4, h = unit & 15, n = bn & 255;
        const size_t R0 = (size_t)bn * 64;
        bf16x8 fh[4][2], fr[2][2];
#pragma unroll
        for (int kk = 0; kk < 2; ++kk) {
#pragma unroll
            for (int q = 0; q < 4; ++q) fh[q][kk] = *(const bf16x8*)(P + (R0 + 16 * q + l15) * PP + 2048 + h * 64 + 32 * kk + 8 * g);
#pragma unroll
            for (int q = 0; q < 2; ++q) fr[q][kk] = *(const bf16x8*)(P + (R0 + t0 + 16 * q + l15) * PP + 1024 + h * 64 + 32 * kk + 8 * g);
        }
        f32x4 y[4][2];
#pragma unroll
        for (int vt = 0; vt < 4; ++vt)
#pragma unroll
            for (int tt = 0; tt < 2; ++tt) y[vt][tt] = unpk4(*(const u32x2*)(Abuf + (R0 + t0 + 16 * tt + l15) * DM + h * 64 + 16 * vt + 4 * g));
#pragma unroll
        for (int vt = 0; vt < 4; ++vt)
#pragma unroll
            for (int tt = 0; tt < 2; ++tt)
#pragma unroll
                for (int kk = 0; kk < 2; ++kk) y[vt][tt] = mfma16(fh[vt][kk], fr[tt][kk], y[vt][tt]);
        f32x4 lnw[4], lnb[4], mug[4];
#pragma unroll
        for (int vt = 0; vt < 4; ++vt) {
            const int ch = h * 64 + 16 * vt + 4 * g;
            lnw[vt] = *(const f32x4*)(p.in[18] + ch); lnb[vt] = *(const f32x4*)(p.in[19] + ch); mug[vt] = *(const f32x4*)(p.in[10] + 3072 + ch);
        }
#pragma unroll
        for (int tt = 0; tt < 2; ++tt) {
            const int t = t0 + 16 * tt + l15;
            float s1 = 0.f, s2 = 0.f;
#pragma unroll
            for (int vt = 0; vt < 4; ++vt)
#pragma unroll
                for (int r = 0; r < 4; ++r) { s1 += y[vt][tt][r]; s2 += y[vt][tt][r] * y[vt][tt][r]; }
            s1 += __shfl_xor(s1, 16); s2 += __shfl_xor(s2, 16); s1 += __shfl_xor(s1, 32); s2 += __shfl_xor(s2, 32);
            const float mean = s1 * (1.0f / 64.0f);
            const float rstd = rsqrtf(fmaxf(s2 * (1.0f / 64.0f) - mean * mean, 0.f) + 64e-5f);
            const float rk = RK[(R0 + t) * 16 + h];
            const bf16_t* grow = P + (R0 + t) * PP + 3072 + h * 64;
            const bf16_t* gprev = (t > 0) ? (grow - PP) : (BND + (size_t)bn * PP + 3072 + h * 64);
            const bool zprev = (t == 0 && n == 0);
#pragma unroll
            for (int vt = 0; vt < 4; ++vt) {
                const int v = 16 * vt + 4 * g;
                const f32x4 g1 = unpk4(*(const u32x2*)(grow + v));
                f32x4 g0 = unpk4(*(const u32x2*)(gprev + v));
                if (zprev) g0 = (f32x4){0.f, 0.f, 0.f, 0.f};
                const f32x4 vp = unpk4(*(const u32x2*)(Ybuf + (R0 + t) * DM + h * 64 + v));
                f32x4 o;
#pragma unroll
                for (int r = 0; r < 4; ++r) {
                    const float yn = (y[vt][tt][r] - mean) * rstd * lnw[vt][r] + lnb[vt][r];
                    const float gt = g1[r] + mug[vt][r] * (g0[r] - g1[r]);
                    o[r] = (yn + rk * vp[r]) * gt / (1.0f + __expf(-gt));
                }
                *(u32x2*)(Abuf + (R0 + t) * DM + h * 64 + v) = pk4(o);
            }
        }
    }
}
#define XB_TMO      128
#define XB_XCNT(j)  (256  + 64 * (j))
#define XB_XSUB(j)  (1280 + 64 * (j))
#define XB_XGEN(j)  (2304 + 64 * (j))
#define XB_TOP      3328
#define XB_TOPGEN   3392
#define XCD_BAR_WORDS 3456
#define XB_SPIN_CAP (1u << 18)
#define LAS __attribute__((address_space(3)))

__device__ __forceinline__ unsigned xb_ld(unsigned* p)              { return __hip_atomic_load(p, __ATOMIC_RELAXED, __HIP_MEMORY_SCOPE_AGENT); }
__device__ __forceinline__ unsigned xb_add(unsigned* p, unsigned v) { return __hip_atomic_fetch_add(p, v, __ATOMIC_RELAXED, __HIP_MEMORY_SCOPE_AGENT); }
__device__ __forceinline__ unsigned xb_xcc_id() { return (unsigned)__builtin_amdgcn_s_getreg((3 << 11) | 20) & 0xFu; }
#define XB_SPIN(cond, bar) do { unsigned _sp = 0; while (cond) { __builtin_amdgcn_s_sleep(1); \
    if ((++_sp & 255u) == 0u) { if (xb_ld(&(bar)[XB_TMO])) break; if (_sp > XB_SPIN_CAP) { atomicAdd(&(bar)[XB_TMO], 1u); break; } } } } while (0)

struct XcdBarrier {
    unsigned* bar; unsigned x;
    volatile LAS unsigned* st;
};

__device__ __forceinline__ XcdBarrier xcd_barrier_post(unsigned* bar, volatile LAS unsigned* st) {
    XcdBarrier b; b.bar = bar; b.x = xb_xcc_id(); b.st = st;
    if (threadIdx.x == 0) (void)xb_add(&bar[XB_XCNT(b.x)], 1u);
    return b;
}
__device__ __forceinline__ void xcd_barrier_complete(unsigned* bar, unsigned x, unsigned& nloc, unsigned& nx) {
    const unsigned G = gridDim.x * gridDim.y * gridDim.z;
    unsigned sum, cnt, mine, sp = 0u;
    for (;;) {
        sum = 0u; cnt = 0u; mine = 0u;
#pragma unroll
        for (unsigned j = 0; j < 16; ++j) { const unsigned c = xb_ld(&bar[XB_XCNT(j)]); sum += c; cnt += (c > 0u) ? 1u : 0u; mine = (j == x) ? c : mine; }
        if (sum == G) break;
        __builtin_amdgcn_s_sleep(1);
        if ((++sp & 255u) == 0u) { if (xb_ld(&bar[XB_TMO])) break; if (sp > XB_SPIN_CAP) { atomicAdd(&bar[XB_TMO], 1u); break; } }
    }
    nloc = mine > 0u ? mine : 1u; nx = cnt > 0u ? cnt : 1u;
}

__device__ __forceinline__ void xcd_barrier(const XcdBarrier& b) {
    asm volatile("s_waitcnt vmcnt(0)" ::: "memory");
    __syncthreads();
    if (threadIdx.x == 0) {
        unsigned* bar = b.bar;
        __builtin_amdgcn_s_waitcnt(0);
        unsigned nloc = b.st[0], nx = b.st[1];
        if (nloc == 0u) { xcd_barrier_complete(bar, b.x, nloc, nx); b.st[0] = nloc; b.st[1] = nx; }
        const unsigned old = xb_add(&bar[XB_XSUB(b.x)], 1u);
        const unsigned gen = old / nloc;
        if (old + 1u == (gen + 1u) * nloc) {
            __builtin_amdgcn_fence(__ATOMIC_RELEASE, "agent");
            asm volatile("s_waitcnt vmcnt(0)" ::: "memory");
            const unsigned og = xb_add(&bar[XB_TOP], 1u);
            const unsigned tg = og / nx;
            if (og + 1u == (tg + 1u) * nx) xb_add(&bar[XB_TOPGEN], 1u);
            else XB_SPIN(xb_ld(&bar[XB_TOPGEN]) == tg, bar);
            __builtin_amdgcn_fence(__ATOMIC_ACQUIRE, "agent");
            xb_add(&bar[XB_XGEN(b.x)], 1u);
            asm volatile("s_waitcnt vmcnt(0)" ::: "memory");
        } else {
            XB_SPIN(xb_ld(&bar[XB_XGEN(b.x)]) == gen, bar);
            __builtin_amdgcn_fence(__ATOMIC_ACQUIRE, "agent");
            asm volatile("s_waitcnt vmcnt(0)" ::: "memory");
        }
    }
    __syncthreads();
}


#ifndef PROBE_ID
#define PROBE_ID 0
#endif
#ifndef N_LAUNCH_MODE
#define N_LAUNCH_MODE 1
#endif
constexpr int N_PHASES = 13;

__global__ void __launch_bounds__(NTH, 2) fwd_kernel(Params p) {
    extern __shared__ __attribute__((aligned(16))) unsigned char lds[];
    const int lo = p.ph_lo, hi = p.ph_hi;
    volatile LAS unsigned* xst = (volatile LAS unsigned*)(lds + LDS_BYTES);
    if (threadIdx.x < 4) xst[threadIdx.x] = 0u;
    __syncthreads();
    const XcdBarrier xbar = xcd_barrier_post((unsigned*)(p.ws + WS_BAR), xst);
    unsigned char* ws = p.ws;
#define IN(k) (lo <= (k) && (k) < hi)
#define SEAM(k) do { if ((k) + 1 < hi) xcd_barrier(xbar); } while (0)
    if (IN(0)) {
        prep_weight(p.in[2], GIN, p.in[1], (bf16_t*)(ws + WS_WGIN), GIN_P, (float*)lds);
        prep_weight(p.in[6], DM, nullptr, (bf16_t*)(ws + WS_WGOUT), DM, (float*)lds);
        prep_weight(p.in[9], RIN, p.in[8], (bf16_t*)(ws + WS_WRIN), RIN_P, (float*)lds);
        prep_weight(p.in[20], DM, nullptr, (bf16_t*)(ws + WS_WROUT), DM, (float*)lds);
        prep_lowrank(p.in[12], (bf16_t*)(ws + WS_WDUT));
        prep_lowrank(p.in[14], (bf16_t*)(ws + WS_WIUT));
        prep_wup(p.in[3], (bf16_t*)(ws + WS_WUPT));
        phase_norm0(p);
        SEAM(0);
    }
    if (IN(1)) {
        pg8::Gemm g{(const bf16_t*)(ws + WS_A), (const bf16_t*)(ws + WS_WGIN), MTOK, GIN_P, DM}; pg8::StaticOrder S; S.init(MTOK, GIN_P, gridDim.x, blockIdx.x);
        pg8::EpiBf16<0> E{(bf16_t*)(ws + WS_P), GIN_P, nullptr, 0, 0};
        pg8::gemm_phase<pg8::EpiBf16<0>, pg8::StaticOrder>((PG8_LAS unsigned char*)lds, g, S, E);
        SEAM(1);
    }
    if (IN(2)) { gla_pass<false>(p, lds); SEAM(2); }
    if (IN(3)) { gla_scan(p); SEAM(3); }
    if (IN(4)) { gla_pass<true>(p, lds); SEAM(4); }
    if (IN(5)) {
        pg8::Gemm g{(const bf16_t*)(ws + WS_A), (const bf16_t*)(ws + WS_WGOUT), MTOK, DM, DM}; pg8::StaticOrder S; S.init(MTOK, DM, gridDim.x, blockIdx.x);
        pg8::EpiBf16<0> E{(bf16_t*)(ws + WS_Y), DM, nullptr, 0, 0};
        pg8::gemm_phase<pg8::EpiBf16<0>, pg8::StaticOrder>((PG8_LAS unsigned char*)lds, g, S, E);
        SEAM(5);
    }
    if (IN(6)) { phase_norm1(p); SEAM(6); }
    if (IN(7)) {
        pg8::Gemm g{(const bf16_t*)(ws + WS_A), (const bf16_t*)(ws + WS_WRIN), MTOK, RIN_P, DM}; pg8::StaticOrder S; S.init(MTOK, RIN_P, gridDim.x, blockIdx.x);
        EpiBf16Bnd E{(bf16_t*)(ws + WS_P), RIN_P, (bf16_t*)(ws + WS_BND)};
        pg8::gemm_phase<EpiBf16Bnd, pg8::StaticOrder>((PG8_LAS unsigned char*)lds, g, S, E);
        SEAM(7);
    }
    if (IN(8)) { rwkv_r1(p, lds); SEAM(8); }
    if (IN(9)) { rwkv_scan(p, lds); SEAM(9); }
    if (IN(10)) { rwkv_post(p); SEAM(10); }
    if (IN(11)) {
        pg8::Gemm g{(const bf16_t*)(ws + WS_A), (const bf16_t*)(ws + WS_WROUT), MTOK, DM, DM}; pg8::StaticOrder S; S.init(MTOK, DM, gridDim.x, blockIdx.x);
        pg8::EpiBf16<0> E{(bf16_t*)(ws + WS_Y), DM, nullptr, 0, 0};
        pg8::gemm_phase<pg8::EpiBf16<0>, pg8::StaticOrder>((PG8_LAS unsigned char*)lds, g, S, E);
        SEAM(11);
    }
    if (IN(12)) { phase_final(p); }
#undef IN
#undef SEAM
}

extern "C" void kernel_launch(void* const* d_in, const int* in_sizes, int n_in, void* d_out, int out_size, void* d_ws, size_t ws_size, hipStream_t stream) {
    static int grid = 0;
    if (grid == 0) {
        int dev = 0, cus = 0, per_cu = 0;
        hipGetDevice(&dev);
        hipDeviceGetAttribute(&cus, hipDeviceAttributeMultiprocessorCount, dev);
        hipFuncSetAttribute((const void*)fwd_kernel, hipFuncAttributeMaxDynamicSharedMemorySize, LDS_BYTES + 16);
        hipOccupancyMaxActiveBlocksPerMultiprocessor(&per_cu, (const void*)fwd_kernel, NTH, LDS_BYTES + 16);
        if (per_cu < 1) { fprintf(stderr, "kernel_launch: occupancy query says %d blocks per CU\n", per_cu); per_cu = 1; }
        grid = cus;
        if (n_in != 22 || ws_size < WS_END) fprintf(stderr, "kernel_launch: unexpected n_in %d or workspace %zu < %zu\n", n_in, ws_size, (size_t)WS_END);
        (void)hipGetLastError();
    }
    if (hipMemsetAsync((char*)d_ws + WS_BAR, 0, XCD_BAR_WORDS * 4, stream) != hipSuccess) fprintf(stderr, "kernel_launch: memset of the barrier words failed\n");
    Params p{};
    for (int i = 0; i < 22; ++i) p.in[i] = (const float*)d_in[i];
    p.out = (float*)d_out; p.ws = (unsigned char*)d_ws;
#if N_LAUNCH_MODE == 1
    void* args[] = {&p};
#if PROBE_ID > 0
    p.ph_lo = 0; p.ph_hi = PROBE_ID;
    (void)hipLaunchCooperativeKernel((const void*)fwd_kernel, dim3(grid), dim3(NTH), args, LDS_BYTES + 16, stream);
    (void)hipMemsetAsync((char*)d_ws + WS_BAR, 0, XCD_BAR_WORDS * 4, stream);
#endif
    p.ph_lo = 0; p.ph_hi = N_PHASES;
    hipError_t e = hipLaunchCooperativeKernel((const void*)fwd_kernel, dim3(grid), dim3(NTH), args, LDS_BYTES + 16, stream);
    if (e != hipSuccess) fprintf(stderr, "cooperative launch failed: %s (grid %d)\n", hipGetErrorString(e), grid);
#else
    for (int k = 0; k < N_PHASES; ++k) {
        p.ph_lo = k; p.ph_hi = k + 1;
        hipLaunchKernelGGL(fwd_kernel, dim3(grid), dim3(NTH), LDS_BYTES + 16, stream, p);
    }
#endif
}
```

```cpp
#include <hip/hip_runtime.h>
#include <hip/hip_cooperative_groups.h>
#include <cstdio>
namespace cg = cooperative_groups;
#define PROBE_ID 0
#define N_LAUNCH_MODE 1
namespace pg8 {
#define PG8_LAS __attribute__((address_space(3)))
typedef unsigned short bf16_t;
typedef short bf16x8 __attribute__((ext_vector_type(8)));
typedef float f32x4 __attribute__((ext_vector_type(4)));
typedef unsigned u32x4 __attribute__((ext_vector_type(4)));
constexpr int BM = 256, BK = 64, HALF = 128, HTB = HALF * BK * 2  , STAGE_BYTES = 8 * HTB, NXCD = 8, WGM = 8;

__host__ __device__ __forceinline__ int lds_byte(int r, int c) { const int st = (r >> 4) * 2 + (c >> 5), rr = r & 15, cc = c & 31, ob = rr * 64 + cc * 2; return st * 1024 + (ob ^ (((ob >> 9) & 1) << 5)); }
__host__ __device__ __forceinline__ void stage_rc(int b, int& R, int& C) { const int st = b / 1024, sb = b % 1024, swz = sb ^ (((sb >> 9) & 1) << 5); R = (st >> 1) * 16 + swz / 64; C = (st & 1) * 32 + (swz % 64) / 2; }
__host__ __device__ __forceinline__ int perm32(int rho) { const int n = rho >> 4, i = rho & 15; return 8 * (i >> 2) + 4 * n + (i & 3); }

struct Unit { int pm, pn; };
struct Gemm { const bf16_t* A; const bf16_t* Bt; int M, N, K; };

struct StaticOrder {
    int nM, nN, nwg, G, c;
    __host__ __device__ void init(int M, int N, int G_, int c_) { nM = M / BM; nN = N / BM; nwg = nM * nN; G = G_; c = c_; }
    __host__ __device__ bool next(int i, Unit& u) const {
        const long L = (long)i * G + c; if (L >= nwg) return false;
        int wgid = (int)L; { const int q = nwg / NXCD, r = nwg % NXCD, xcd = wgid % NXCD, off = wgid / NXCD; wgid = (xcd < r ? xcd * (q + 1) : r * (q + 1) + (xcd - r) * q) + off; }
        const int nig = WGM * nN, gid = wgid / nig, fm = gid * WGM, gsz = (nM - fm) < WGM ? (nM - fm) : WGM;
        u.pm = fm + ((wgid % nig) % gsz); u.pn = (wgid % nig) / gsz; return true;
    }
    __device__ __forceinline__ void a_ready(const Unit&) const {}
    __device__ __forceinline__ void done(const Unit&) const {}
};

typedef float cvt_f32x2 __attribute__((ext_vector_type(2)));
typedef __bf16 cvt_bf16x2 __attribute__((ext_vector_type(2)));
__device__ __forceinline__ unsigned cvt_pk_bf16(float lo, float hi) { const cvt_f32x2 v = {lo, hi}; union { cvt_bf16x2 b; unsigned u; } x; x.b = __builtin_convertvector(v, cvt_bf16x2); return x.u; }
typedef float f32x2 __attribute__((ext_vector_type(2)));
struct EpiF32 {
    static constexpr bool PERM = false, AFTER_DRAIN = false;
    float* C; int ldc; const float* bias;
    __device__ __forceinline__ void operator()(const f32x4 (&acc)[2][2][4][2], const Unit& u, int wr, int wc, int fr, int fq) const {
        const int row0 = u.pm * BM + wr * 64 + fr, col0 = u.pn * BM + wc * 32 + 4 * fq;
        f32x4 bv[2][2];
#pragma unroll
        for (int bj = 0; bj < 2; ++bj)
#pragma unroll
            for (int n = 0; n < 2; ++n) bv[bj][n] = bias ? *(const f32x4*)(bias + col0 + bj * HALF + n * 16) : (f32x4){0.f, 0.f, 0.f, 0.f};
#pragma unroll
        for (int ai = 0; ai < 2; ++ai)
#pragma unroll
            for (int m = 0; m < 4; ++m) { float* rowp = C + (size_t)(row0 + ai * HALF + m * 16) * ldc + col0;
#pragma unroll
                for (int bj = 0; bj < 2; ++bj)
#pragma unroll
                    for (int n = 0; n < 2; ++n) *(f32x4*)(rowp + bj * HALF + n * 16) = acc[ai][bj][m][n] + bv[bj][n]; }
    }
};
template <int ACT  > struct EpiBf16 {
    static constexpr bool PERM = true, AFTER_DRAIN = false;
    bf16_t* O; int ldc; const float* bias; int split_cols; size_t split_stride;
    __device__ __forceinline__ void operator()(const f32x4 (&acc)[2][2][4][2], const Unit& u, int wr, int wc, int fr, int fq) const {
        const int row0 = u.pm * BM + wr * 64 + fr; int colt = u.pn * BM; bf16_t* base = O;
        if (split_cols) { const int t = colt / split_cols; base += (size_t)t * split_stride; colt -= t * split_cols; }
        const int col0 = colt + wc * 32 + 8 * fq, bcol0 = u.pn * BM + wc * 32 + 8 * fq;
        f32x4 bv[2][2];
#pragma unroll
        for (int bj = 0; bj < 2; ++bj)
#pragma unroll
            for (int n = 0; n < 2; ++n) bv[bj][n] = bias ? *(const f32x4*)(bias + bcol0 + bj * HALF + 4 * n) : (f32x4){0.f, 0.f, 0.f, 0.f};
#pragma unroll
        for (int ai = 0; ai < 2; ++ai)
#pragma unroll
            for (int m = 0; m < 4; ++m) { bf16_t* rowp = base + (size_t)(row0 + ai * HALF + m * 16) * ldc + col0;
#pragma unroll
                for (int bj = 0; bj < 2; ++bj) { f32x4 v0 = acc[ai][bj][m][0] + bv[bj][0], v1 = acc[ai][bj][m][1] + bv[bj][1];
                    u32x4 w; w.x = cvt_pk_bf16(v0[0], v0[1]); w.y = cvt_pk_bf16(v0[2], v0[3]); w.z = cvt_pk_bf16(v1[0], v1[1]); w.w = cvt_pk_bf16(v1[2], v1[3]);
                    *(u32x4*)(rowp + bj * HALF) = w; } }
    }
};

template <class Epi, class Sched>
__device__ __forceinline__ void gemm_phase(PG8_LAS unsigned char* lds, const Gemm g, const Sched& S, const Epi& E) {
    const int tid = threadIdx.x, wid = __builtin_amdgcn_readfirstlane(tid >> 6), lane = tid & 63, wr = wid >> 2, wc = wid & 3, fr = lane & 15, fq = lane >> 4;
    const int K = g.K, nt = K / BK;
    unsigned voffA[2], voffB[2];
#pragma unroll
    for (int i = 0; i < 2; ++i) { int R, C; stage_rc(tid * 16 + i * 8192, R, C); const int Rb = Epi::PERM ? ((R & ~31) + perm32(R & 31)) : R;
        voffA[i] = (unsigned)(R * K + C) * 2u; voffB[i] = (unsigned)(Rb * K + C) * 2u; }
    const size_t kstep = (size_t)(BK * 2);
    const size_t hstep = (size_t)HALF * K * 2;
    const size_t tstep = 2 * hstep;
    const unsigned ldsw = (unsigned)wid * 1024u;
    const int aoff = lds_byte(wr * 64 + fr, fq * 8), boff = lds_byte(wc * 32 + fr, fq * 8);
#define PG8_SA(b, h) (((b) * 2 + (h)) * HTB)
#define PG8_SB(b, h) ((4 + (b) * 2 + (h)) * HTB)
#define PG8_STAGE(bufoff, gbase, voff) do { _Pragma("unroll") for (int _i = 0; _i < 2; ++_i) \
        __builtin_amdgcn_global_load_lds((const unsigned*)((const char*)(gbase) + (voff)[_i]), (PG8_LAS unsigned*)(lds + (bufoff) + ldsw + _i * 8192), 16, 0, 0); } while (0)
#define PG8_LDA(dst, b, h) do { _Pragma("unroll") for (int m = 0; m < 4; ++m) _Pragma("unroll") for (int k = 0; k < 2; ++k) dst[m][k] = *(const PG8_LAS bf16x8*)(lds + PG8_SA(b, h) + aoff + m * 2048 + k * 1024); } while (0)
#define PG8_LDB(dst, b, h) do { _Pragma("unroll") for (int n = 0; n < 2; ++n) _Pragma("unroll") for (int k = 0; k < 2; ++k) dst[n][k] = *(const PG8_LAS bf16x8*)(lds + PG8_SB(b, h) + boff + n * 2048 + k * 1024); } while (0)
#define PG8_MMA(ai, bj, At, Bt) do { __builtin_amdgcn_s_setprio(1); _Pragma("unroll") for (int m = 0; m < 4; ++m) _Pragma("unroll") for (int n = 0; n < 2; ++n) _Pragma("unroll") for (int k = 0; k < 2; ++k) \
        acc[ai][bj][m][n] = __builtin_amdgcn_mfma_f32_16x16x32_bf16(Bt[n][k], At[m][k], acc[ai][bj][m][n], 0, 0, 0); __builtin_amdgcn_s_setprio(0); } while (0)
#define PG8_WAIT_V(n) asm volatile("s_waitcnt vmcnt(" #n ")" ::: "memory")
#define PG8_WAIT_L(n) asm volatile("s_waitcnt lgkmcnt(" #n ")" ::: "memory")
#define PG8_BAR __builtin_amdgcn_s_barrier()
#define PG8_SCHED __builtin_amdgcn_sched_barrier(0)
    Unit cur, nxt; int ui = 0;
    if (!S.next(0, cur)) return;
    f32x4 acc[2][2][4][2];
#pragma unroll
    for (int a = 0; a < 2; ++a)
#pragma unroll
        for (int b = 0; b < 2; ++b)
#pragma unroll
            for (int m = 0; m < 4; ++m)
#pragma unroll
                for (int n = 0; n < 2; ++n) acc[a][b][m][n] = (f32x4){0.f, 0.f, 0.f, 0.f};
    bf16x8 At[4][2], B0[2][2], B1[2][2];
    const char* cA = (const char*)g.A + (size_t)cur.pm * tstep; const char* cB = (const char*)g.Bt + (size_t)cur.pn * tstep;
    S.a_ready(cur);
    PG8_STAGE(PG8_SB(0, 0), cB, voffB); PG8_STAGE(PG8_SA(0, 0), cA, voffA); PG8_STAGE(PG8_SB(0, 1), cB + hstep, voffB); PG8_STAGE(PG8_SA(0, 1), cA + hstep, voffA);
    if (wr == 1) PG8_BAR;
    PG8_WAIT_V(4); PG8_BAR;
    PG8_STAGE(PG8_SB(1, 0), cB + kstep, voffB); PG8_STAGE(PG8_SA(1, 0), cA + kstep, voffA); PG8_STAGE(PG8_SB(1, 1), cB + hstep + kstep, voffB);
    PG8_WAIT_V(6); PG8_BAR;
    for (;;) {
        const bool has_next = S.next(ui + 1, nxt);
        const char* nA = has_next ? (const char*)g.A + (size_t)nxt.pm * tstep : cA; const char* nB = has_next ? (const char*)g.Bt + (size_t)nxt.pn * tstep : cB;
        for (int t = 0; t < nt; t += 2) {
            const bool last = (t == nt - 2);
            const char* a1 = cA + (size_t)(t + 1) * kstep;
            const char* a2 = last ? nA : cA + (size_t)(t + 2) * kstep; const char* b2 = last ? nB : cB + (size_t)(t + 2) * kstep;
            const char* a3 = a2 + kstep; const char* b3 = b2 + kstep;
            if (last && has_next) S.a_ready(nxt);
            PG8_LDB(B0, 0, 0); PG8_SCHED; PG8_LDA(At, 0, 0); PG8_STAGE(PG8_SA(1, 1), a1 + hstep, voffA);
            PG8_WAIT_L(8); PG8_BAR; PG8_WAIT_L(0); PG8_MMA(0, 0, At, B0); PG8_BAR; PG8_SCHED;
            PG8_LDB(B1, 0, 1); PG8_STAGE(PG8_SB(0, 0), b2, voffB);
            PG8_BAR; PG8_WAIT_L(0); PG8_MMA(0, 1, At, B1); PG8_BAR;
            PG8_LDA(At, 0, 1); PG8_STAGE(PG8_SA(0, 0), a2, voffA);
            PG8_BAR; PG8_WAIT_L(0); PG8_MMA(1, 0, At, B0); PG8_BAR; PG8_SCHED;
            PG8_STAGE(PG8_SB(0, 1), b2 + hstep, voffB);
            PG8_WAIT_V(6); PG8_BAR; PG8_MMA(1, 1, At, B1); PG8_BAR;
            PG8_LDB(B0, 1, 0); PG8_SCHED; PG8_LDA(At, 1, 0); PG8_STAGE(PG8_SA(0, 1), a2 + hstep, voffA);
            PG8_WAIT_L(8); PG8_BAR; PG8_WAIT_L(0); PG8_MMA(0, 0, At, B0); PG8_BAR; PG8_SCHED;
            PG8_LDB(B1, 1, 1); PG8_STAGE(PG8_SB(1, 0), b3, voffB);
            PG8_BAR; PG8_WAIT_L(0); PG8_MMA(0, 1, At, B1); PG8_BAR;
            PG8_LDA(At, 1, 1); PG8_STAGE(PG8_SA(1, 0), a3, voffA);
            PG8_BAR; PG8_WAIT_L(0); PG8_MMA(1, 0, At, B0); PG8_BAR; PG8_SCHED;
            PG8_STAGE(PG8_SB(1, 1), b3 + hstep, voffB);
            PG8_WAIT_V(6); PG8_BAR; PG8_MMA(1, 1, At, B1); PG8_BAR;
        }
        if constexpr (!Epi::AFTER_DRAIN) { E(acc, cur, wr, wc, fr, fq); S.done(cur); }
        if (!has_next) break;
#pragma unroll
        for (int a = 0; a < 2; ++a)
#pragma unroll
            for (int b = 0; b < 2; ++b)
#pragma unroll
                for (int m = 0; m < 4; ++m)
#pragma unroll
                    for (int n = 0; n < 2; ++n) acc[a][b][m][n] = (f32x4){0.f, 0.f, 0.f, 0.f};
        cur = nxt; cA = nA; cB = nB; ++ui;
    }
    PG8_WAIT_V(0);
    if (wr == 0) PG8_BAR;
    PG8_BAR;
    if constexpr (Epi::AFTER_DRAIN) { E.fused(acc, cur, wr, wc, fr, fq, lds, wid, lane); S.done(cur); }
#undef PG8_SA
#undef PG8_SB
#undef PG8_STAGE
#undef PG8_LDA
#undef PG8_LDB
#undef PG8_MMA
#undef PG8_WAIT_V
#undef PG8_WAIT_L
#undef PG8_BAR
#undef PG8_SCHED
}
}


typedef unsigned short bf16_t;
typedef short bf16x8 __attribute__((ext_vector_type(8)));
typedef float f32x4 __attribute__((ext_vector_type(4)));
typedef unsigned u32x4 __attribute__((ext_vector_type(4)));
typedef unsigned u32x2 __attribute__((ext_vector_type(2)));

constexpr int MTOK = 32768, DM = 1024, SEQ = 16384, NTH = 512;
constexpr int GIN = 3088, GIN_P = 3072, RIN = 4224, RIN_P = 4352;
constexpr int LDS_BYTES = 131072;

constexpr size_t WS_WGIN  = 0;
constexpr size_t WS_WGOUT = WS_WGIN  + (size_t)GIN_P * DM * 2;
constexpr size_t WS_WRIN  = WS_WGOUT + (size_t)DM * DM * 2;
constexpr size_t WS_WROUT = WS_WRIN  + (size_t)RIN_P * DM * 2;
constexpr size_t WS_WDUT  = WS_WROUT + (size_t)DM * DM * 2;
constexpr size_t WS_WIUT  = WS_WDUT  + (size_t)DM * 64 * 2;
constexpr size_t WS_WUPT  = WS_WIUT  + (size_t)DM * 64 * 2;
constexpr size_t WS_A     = WS_WUPT  + (size_t)512 * 16 * 2;
constexpr size_t WS_Y     = WS_A     + (size_t)MTOK * DM * 2;
constexpr size_t WS_GS    = WS_Y     + (size_t)MTOK * DM * 2;
constexpr size_t WS_GD    = WS_GS    + (size_t)8 * 32 * 128 * 256 * 4;
constexpr size_t WS_P     = WS_GD    + (size_t)8 * 32 * 128 * 4;
constexpr size_t WS_BAR   = WS_P     + (size_t)MTOK * RIN_P * 2;
constexpr size_t WS_AD    = WS_BAR   + 16384;
constexpr size_t WS_END   = WS_AD    + (size_t)MTOK * 16 * 2;

struct Params { const float* in[22]; float* out; unsigned char* ws; int ph_lo, ph_hi; };

__device__ __forceinline__ float bf2f(unsigned b) { return __uint_as_float(b << 16); }
__device__ __forceinline__ bf16_t f2bf(float f) { unsigned u = __float_as_uint(f); u += 0x7FFFu + ((u >> 16) & 1u); return (bf16_t)(u >> 16); }
__device__ __forceinline__ unsigned pk2(float lo, float hi) { return pg8::cvt_pk_bf16(lo, hi); }
__device__ __forceinline__ float wave_sum(float x) {
#pragma unroll
    for (int off = 32; off >= 1; off >>= 1) x += __shfl_xor(x, off);
    return x;
}
__device__ __forceinline__ f32x4 mfma16(bf16x8 a, bf16x8 b, f32x4 c) { return __builtin_amdgcn_mfma_f32_16x16x32_bf16(a, b, c, 0, 0, 0); }
__device__ __forceinline__ bf16x8 as_bf16x8(u32x4 v) { union { u32x4 u; bf16x8 b; } x; x.u = v; return x.b; }
__device__ __forceinline__ float log_sigmoid(float z) { return fminf(z, 0.f) - log1pf(__expf(-fabsf(z))); }
__device__ __forceinline__ float softplus(float z) { return fmaxf(z, 0.f) + log1pf(__expf(-fabsf(z))); }

__device__ void prep_weight(const float* __restrict__ W, int N, const float* __restrict__ gain, bf16_t* __restrict__ Wt, int NP, float* tile) {
    const int tid = threadIdx.x;
    const int nu = (NP / 64) * 16;
    for (int u = blockIdx.x; u < nu; u += gridDim.x) {
        const int n0 = (u >> 4) * 64, k0 = (u & 15) * 64;
        {
            const int j = tid & 63, i0 = tid >> 6;
#pragma unroll
            for (int r = 0; r < 8; ++r) {
                const int i = i0 + 8 * r, k = k0 + i, n = n0 + j;
                float v = 0.f;
                if (n < N) { v = W[(size_t)k * N + n]; if (gain) v *= gain[k]; }
                tile[i * 65 + j] = v;
            }
        }
        __syncthreads();
        {
            const int i = tid & 63, j0 = tid >> 6;
#pragma unroll
            for (int r = 0; r < 8; ++r) {
                const int j = j0 + 8 * r;
                Wt[(size_t)(n0 + j) * DM + k0 + i] = f2bf(tile[i * 65 + j]);
            }
        }
        __syncthreads();
    }
}

__device__ void prep_lowrank(const float* __restrict__ src, bf16_t* __restrict__ dst) {
    for (int idx = blockIdx.x * NTH + threadIdx.x; idx < 65536; idx += gridDim.x * NTH) dst[idx] = f2bf(src[(idx & 63) * 1024 + (idx >> 6)]);
}

__device__ void prep_wup(const float* __restrict__ src, bf16_t* __restrict__ dst) {
    for (int idx = blockIdx.x * NTH + threadIdx.x; idx < 8192; idx += gridDim.x * NTH) dst[idx] = f2bf(src[(idx & 15) * 512 + (idx >> 4)]);
}

struct EpiBf16Bnd {
    static constexpr bool PERM = true, AFTER_DRAIN = false;
    bf16_t* O; int ldc; bf16_t* bnd;
    __device__ __forceinline__ void operator()(const f32x4 (&acc)[2][2][4][2], const pg8::Unit& u, int wr, int wc, int fr, int fq) const {
        const int row0 = u.pm * pg8::BM + wr * 64 + fr, col0 = u.pn * pg8::BM + wc * 32 + 8 * fq;
#pragma unroll
        for (int ai = 0; ai < 2; ++ai)
#pragma unroll
            for (int m = 0; m < 4; ++m) {
                const int row = row0 + ai * pg8::HALF + m * 16;
                bf16_t* rowp = O + (size_t)row * ldc + col0;
#pragma unroll
                for (int bj = 0; bj < 2; ++bj) {
                    const f32x4 v0 = acc[ai][bj][m][0], v1 = acc[ai][bj][m][1];
                    u32x4 wv; wv.x = pk2(v0[0], v0[1]); wv.y = pk2(v0[2], v0[3]); wv.z = pk2(v1[0], v1[1]); wv.w = pk2(v1[2], v1[3]);
                    *(u32x4*)(rowp + bj * pg8::HALF) = wv;
                    if (m == 3 && fr == 15) *(u32x4*)(bnd + (size_t)((row >> 6) + 1) * ldc + col0 + bj * pg8::HALF) = wv;
                }
            }
    }
};

__device__ void phase_norm0(const Params& p, unsigned char* lds) {
    const int tid = threadIdx.x, lane = tid & 63, w = tid >> 6, l15 = lane & 15, g = lane >> 4;
    const float* x = p.in[0];
    bf16_t* A = (bf16_t*)(p.ws + WS_A);
    bf16_t* AD = (bf16_t*)(p.ws + WS_AD);
    bf16_t* WAD = (bf16_t*)lds;
    float* PSS = (float*)(lds + 33024);
    float* PAD = (float*)(lds + 33024 + 512);
    for (int e = tid; e < 16384; e += NTH) { const int k = e >> 4, j = e & 15; WAD[j * 1032 + k] = f2bf(p.in[2][(size_t)k * GIN + 3072 + j] * p.in[1][k]); }
    __syncthreads();
    bf16x8 wf[4];
#pragma unroll
    for (int kk = 0; kk < 4; ++kk) wf[kk] = *(const bf16x8*)(WAD + l15 * 1032 + 128 * w + 32 * kk + 8 * g);
    float4 xa[4][2];
    int tile = blockIdx.x;
    if (tile < MTOK / 16) {
#pragma unroll
        for (int kk = 0; kk < 4; ++kk) { const float4* s = (const float4*)(x + (size_t)(16 * tile + l15) * DM + 128 * w + 32 * kk + 8 * g); xa[kk][0] = s[0]; xa[kk][1] = s[1]; }
    }
    for (; tile < MTOK / 16; tile += gridDim.x) {
        float4 xv[4][2];
#pragma unroll
        for (int kk = 0; kk < 4; ++kk) { xv[kk][0] = xa[kk][0]; xv[kk][1] = xa[kk][1]; }
        if (tile + (int)gridDim.x < MTOK / 16) {
#pragma unroll
            for (int kk = 0; kk < 4; ++kk) { const float4* s = (const float4*)(x + (size_t)(16 * (tile + gridDim.x) + l15) * DM + 128 * w + 32 * kk + 8 * g); xa[kk][0] = s[0]; xa[kk][1] = s[1]; }
        }
        float ss = 0.f;
        f32x4 acc = (f32x4){0.f, 0.f, 0.f, 0.f};
#pragma unroll
        for (int kk = 0; kk < 4; ++kk) {
            const float4 a = xv[kk][0], b = xv[kk][1];
            ss += a.x * a.x + a.y * a.y + a.z * a.z + a.w * a.w + b.x * b.x + b.y * b.y + b.z * b.z + b.w * b.w;
            acc = mfma16(as_bf16x8((u32x4){pk2(a.x, a.y), pk2(a.z, a.w), pk2(b.x, b.y), pk2(b.z, b.w)}), wf[kk], acc);
        }
        ss += __shfl_xor(ss, 16); ss += __shfl_xor(ss, 32);
        if (g == 0) PSS[w * 16 + l15] = ss;
        *(f32x4*)(PAD + (w * 64 + lane) * 4) = acc;
        __syncthreads();
        float tot = 0.f;
#pragma unroll
        for (int q = 0; q < 8; ++q) tot += PSS[q * 16 + l15];
        const float rstd = rsqrtf(tot * (1.0f / DM) + 1e-6f);
#pragma unroll
        for (int kk = 0; kk < 4; ++kk) {
            const float4 a = xv[kk][0], b = xv[kk][1];
            *(u32x4*)(A + (size_t)(16 * tile + l15) * DM + 128 * w + 32 * kk + 8 * g) = (u32x4){pk2(a.x * rstd, a.y * rstd), pk2(a.z * rstd, a.w * rstd), pk2(b.x * rstd, b.y * rstd), pk2(b.z * rstd, b.w * rstd)};
        }
        if (w == 0) {
            f32x4 s = (f32x4){0.f, 0.f, 0.f, 0.f};
#pragma unroll
            for (int q = 0; q < 8; ++q) s += *(const f32x4*)(PAD + (q * 64 + lane) * 4);
#pragma unroll
            for (int r = 0; r < 4; ++r) AD[(size_t)(16 * tile + 4 * g + r) * 16 + l15] = f2bf(s[r] * __shfl(rstd, 4 * g + r));
        }
        __syncthreads();
    }
}

__device__ void phase_norm1(const Params& p) {
    const int tid = threadIdx.x, lane = tid & 63, w = tid >> 6;
    const float* x = p.in[0];
    const float* gpost = p.in[7];
    const bf16_t* Y = (const bf16_t*)(p.ws + WS_Y);
    bf16_t* A = (bf16_t*)(p.ws + WS_A);
    float4 gp[4];
#pragma unroll
    for (int i = 0; i < 4; ++i) gp[i] = ((const float4*)gpost)[lane + 64 * i];
    for (int row = blockIdx.x * 8 + w; row < MTOK; row += gridDim.x * 8) {
        const float4* xr = (const float4*)(x + (size_t)row * DM);
        float4 v[4]; u32x2 yv[4];
#pragma unroll
        for (int i = 0; i < 4; ++i) { v[i] = xr[lane + 64 * i]; yv[i] = *(const u32x2*)(Y + (size_t)row * DM + 4 * (lane + 64 * i)); }
        float4 y[4];
        float ss = 0.f;
#pragma unroll
        for (int i = 0; i < 4; ++i) {
            y[i].x = bf2f(yv[i].x & 0xffffu); y[i].y = bf2f(yv[i].x >> 16); y[i].z = bf2f(yv[i].y & 0xffffu); y[i].w = bf2f(yv[i].y >> 16);
            ss += y[i].x * y[i].x + y[i].y * y[i].y + y[i].z * y[i].z + y[i].w * y[i].w;
        }
        ss = wave_sum(ss);
        const float rstdy = rsqrtf(ss * (1.0f / DM) + 1e-6f);
        float s1 = 0.f;
#pragma unroll
        for (int i = 0; i < 4; ++i) {
            v[i].x += y[i].x * rstdy * gp[i].x; v[i].y += y[i].y * rstdy * gp[i].y; v[i].z += y[i].z * rstdy * gp[i].z; v[i].w += y[i].w * rstdy * gp[i].w;
            s1 += v[i].x * v[i].x + v[i].y * v[i].y + v[i].z * v[i].z + v[i].w * v[i].w;
            ((float4*)(p.out + (size_t)row * DM))[lane + 64 * i] = v[i];
        }
        s1 = wave_sum(s1);
        const float rstd = rsqrtf(s1 * (1.0f / DM) + 1e-6f);
#pragma unroll
        for (int i = 0; i < 4; ++i) {
            u32x2 o; o.x = pk2(v[i].x * rstd, v[i].y * rstd); o.y = pk2(v[i].z * rstd, v[i].w * rstd);
            *(u32x2*)(A + (size_t)row * DM + 4 * (lane + 64 * i)) = o;
        }
    }
}

__device__ void phase_final(const Params& p) {
    const int tid = threadIdx.x, lane = tid & 63, w = tid >> 6;
    const float* gpost = p.in[21];
    const bf16_t* Y = (const bf16_t*)(p.ws + WS_Y);
    float4 gp[4];
#pragma unroll
    for (int i = 0; i < 4; ++i) gp[i] = ((const float4*)gpost)[lane + 64 * i];
    for (int row = blockIdx.x * 8 + w; row < MTOK; row += gridDim.x * 8) {
        float4* xr = (float4*)(p.out + (size_t)row * DM);
        float4 v[4]; u32x2 yv[4];
#pragma unroll
        for (int i = 0; i < 4; ++i) { v[i] = xr[lane + 64 * i]; yv[i] = *(const u32x2*)(Y + (size_t)row * DM + 4 * (lane + 64 * i)); }
        float4 y[4];
        float ss = 0.f;
#pragma unroll
        for (int i = 0; i < 4; ++i) {
            y[i].x = bf2f(yv[i].x & 0xffffu); y[i].y = bf2f(yv[i].x >> 16); y[i].z = bf2f(yv[i].y & 0xffffu); y[i].w = bf2f(yv[i].y >> 16);
            ss += y[i].x * y[i].x + y[i].y * y[i].y + y[i].z * y[i].z + y[i].w * y[i].w;
        }
        ss = wave_sum(ss);
        const float rstdy = rsqrtf(ss * (1.0f / DM) + 1e-6f);
#pragma unroll
        for (int i = 0; i < 4; ++i) {
            v[i].x += y[i].x * rstdy * gp[i].x; v[i].y += y[i].y * rstdy * gp[i].y; v[i].z += y[i].z * rstdy * gp[i].z; v[i].w += y[i].w * rstdy * gp[i].w;
            xr[lane + 64 * i] = v[i];
        }
    }
}

constexpr int L_BC = 0, L_ATT = 0, L_QD = 33792, L_KD = L_QD + 64 * 136 * 2, L_KTE = L_KD + 64 * 136 * 2, L_VI = L_KTE + 64 * 144 * 2, L_SSQ = L_VI + 64 * 272 * 2, L_BL = L_SSQ + 2048, L_DEC = L_BL + 512, L_ADL = L_DEC + 512,
              L_GLA_END = L_ADL + 2048;
static_assert(L_GLA_END <= LDS_BYTES, "GLA LDS");
#define GLA_BARRIER() do { asm volatile("s_waitcnt lgkmcnt(0)" ::: "memory"); __builtin_amdgcn_s_barrier(); asm volatile("" ::: "memory"); } while (0)
typedef short gs16x4 __attribute__((ext_vector_type(4)));
__device__ __forceinline__ u32x2 g_trread(const bf16_t* p) { union { gs16x4 s; u32x2 u; } x; x.s = __builtin_amdgcn_ds_read_tr16_b64_v4i16((__attribute__((address_space(3))) gs16x4*)p); return x.u; }
template <int PITCH> __device__ __forceinline__ bf16x8 g_trfrag(const bf16_t* img, int k0, int c0, int g, int q, int pq) {
    const bf16_t* a = img + (k0 + 8 * g + q) * PITCH + c0 + 4 * pq;
    const u32x2 lo = g_trread(a), hi = g_trread(a + 4 * PITCH);
    return as_bf16x8((u32x4){lo.x, lo.y, hi.x, hi.y});
}
__device__ __forceinline__ f32x4 g_lo4(u32x4 v) { return (f32x4){bf2f(v.x & 0xffffu), bf2f(v.x >> 16), bf2f(v.y & 0xffffu), bf2f(v.y >> 16)}; }
__device__ __forceinline__ f32x4 g_hi4(u32x4 v) { return (f32x4){bf2f(v.z & 0xffffu), bf2f(v.z >> 16), bf2f(v.w & 0xffffu), bf2f(v.w >> 16)}; }
__device__ __forceinline__ u32x2 g_pk4(f32x4 v) { u32x2 r; r.x = pk2(v[0], v[1]); r.y = pk2(v[2], v[3]); return r; }
__device__ __forceinline__ f32x4 g_unpk4(u32x2 v) { return (f32x4){bf2f(v.x & 0xffffu), bf2f(v.x >> 16), bf2f(v.y & 0xffffu), bf2f(v.y >> 16)}; }

template <bool OUT> struct GlaRaw { u32x4 q[2], k[2], v[4]; };
template <bool OUT> __device__ __forceinline__ void gla_issue(GlaRaw<OUT>& x, const char* cb  , unsigned offQ, unsigned offV) {
    if (OUT) { x.q[0] = *(const u32x4*)(cb + offQ); x.q[1] = *(const u32x4*)(cb + offQ + 16); }
    x.k[0] = *(const u32x4*)(cb + offQ + 1024); x.k[1] = *(const u32x4*)(cb + offQ + 1040);
#pragma unroll
    for (int i = 0; i < 4; ++i) x.v[i] = *(const u32x4*)(cb + offV + 16 * i);
}

template <bool OUT>
__device__ void gla_pass(const Params& p, unsigned char* lds) {
    const int tid = threadIdx.x, lane = tid & 63, w = __builtin_amdgcn_readfirstlane(tid >> 6), l15 = lane & 15, g = lane >> 4, q4 = l15 >> 2, p4 = l15 & 3;
    const bf16_t* P = (const bf16_t*)(p.ws + WS_P);
    float* GS = (float*)(p.ws + WS_GS);
    float* GD = (float*)(p.ws + WS_GD);
    bf16_t* Aout = (bf16_t*)(p.ws + WS_A);
    const bf16_t* WupT = (const bf16_t*)(p.ws + WS_WUPT);
    const bf16_t* ADG = (const bf16_t*)(p.ws + WS_AD);
    float* BC = (float*)(lds + L_BC); bf16_t* ATT = (bf16_t*)(lds + L_ATT); bf16_t* QD = (bf16_t*)(lds + L_QD); bf16_t* KD = (bf16_t*)(lds + L_KD); bf16_t* KTE = (bf16_t*)(lds + L_KTE);
    bf16_t* VI = (bf16_t*)(lds + L_VI); float* SSQ = (float*)(lds + L_SSQ); float* BL = (float*)(lds + L_BL); float* DEC = (float*)(lds + L_DEC); bf16_t* ADL = (bf16_t*)(lds + L_ADL);
    const float* b_al = p.in[4]; const float* g_head = p.in[5];
    const int c = tid >> 3, seg = tid & 7;

    for (int unit = blockIdx.x; unit < 256; unit += gridDim.x) {
        const int bh = unit >> 5, m = unit & 31, b = bh >> 2, h = bh & 3;
        const int tokbase = b * SEQ + m * 512;
        u32x4 wupq = *(const u32x4*)(WupT + (size_t)(h * 128 + 16 * w + l15) * 16 + 8 * (g & 1));
        if (g >= 2) wupq = (u32x4){0u, 0u, 0u, 0u};
        const bf16x8 wupf = as_bf16x8(wupq);
        const float bA = b_al[h * 128 + 16 * w + l15];
        float logD = 0.f;
        f32x4 S[8][2];
#pragma unroll
        for (int mt = 0; mt < 8; ++mt)
#pragma unroll
            for (int vt = 0; vt < 2; ++vt) {
                if (OUT) {
#pragma unroll
                    for (int r = 0; r < 4; ++r) S[mt][vt][r] = GS[((size_t)(bh * 32 + m) * 128 + 16 * mt + 4 * g + r) * 256 + 32 * w + 16 * vt + l15];
                } else S[mt][vt] = (f32x4){0.f, 0.f, 0.f, 0.f};
            }
        const unsigned offQ = (unsigned)((c * GIN_P + h * 128 + 16 * seg) * 2), offV = (unsigned)((c * GIN_P + 1024 + h * 256 + 32 * seg) * 2), offAD = (unsigned)(tid * 16);
        const unsigned offG = (unsigned)((l15 * GIN_P + 2048 + h * 256 + 32 * w + 4 * g) * 2), offO = (unsigned)((l15 * DM + h * 256 + 32 * w + 4 * g) * 2);
        GlaRaw<OUT> raw;
        gla_issue<OUT>(raw, (const char*)P + (size_t)tokbase * GIN_P * 2, offQ, offV);
        if (tid < 128) *(u32x4*)(ADL + tid * 8) = *(const u32x4*)((const char*)ADG + (size_t)tokbase * 32 + offAD);
        GLA_BARRIER();

        for (int ch = 0; ch < 8; ++ch) {
            const int tok0 = tokbase + ch * 64;
            u32x4 adn = (u32x4){0u, 0u, 0u, 0u};
            {
                float run = 0.f;
                if (ch < 7 && tid < 128) adn = *(const u32x4*)((const char*)ADG + (size_t)(tok0 + 64) * 32 + offAD);
#pragma unroll
                for (int ct = 0; ct < 4; ++ct) {
                    u32x4 aq = *(const u32x4*)(ADL + (16 * ct + l15) * 16 + 8 * (g & 1));
                    if (g >= 2) aq = (u32x4){0u, 0u, 0u, 0u};
                    const f32x4 z = mfma16(as_bf16x8(aq), wupf, (f32x4){bA, bA, bA, bA});
                    f32x4 sc;
                    float acc = 0.f;
#pragma unroll
                    for (int r = 0; r < 4; ++r) { acc += (fminf(z[r], 0.f) - __logf(1.f + __expf(-fabsf(z[r])))) * (1.0f / 16.0f); sc[r] = acc; }
                    float x = acc;
                    float y = __shfl_up(x, 16); if (g >= 1) x += y;
                    y = __shfl_up(x, 32); if (g >= 2) x += y;
                    const float base = run + (x - acc);
                    run += __shfl(x, 48 + l15);
#pragma unroll
                    for (int r = 0; r < 4; ++r) BC[(16 * ct + 4 * g + r) * 132 + 16 * w + l15] = base + sc[r];
                }
                if (g == 0) { BL[16 * w + l15] = run; DEC[16 * w + l15] = __expf(run); }
                if (!OUT) logD += run;
            }
            GLA_BARRIER();
            u32x2 gate[2][4];
            {
#pragma unroll
                for (int hh = 0; hh < 2; ++hh) {
                    const int o8 = 16 * seg + 8 * hh;
                    const f32x4 bb[2] = {*(const f32x4*)(BC + c * 132 + o8), *(const f32x4*)(BC + c * 132 + o8 + 4)};
                    const f32x4 dc[2] = {*(const f32x4*)(DEC + o8), *(const f32x4*)(DEC + o8 + 4)};
                    const f32x4 kx[2] = {g_lo4(raw.k[hh]), g_hi4(raw.k[hh])};
                    f32x4 qx[2];
                    if (OUT) { qx[0] = g_lo4(raw.q[hh]); qx[1] = g_hi4(raw.q[hh]); }
                    f32x4 kd[2], kt[2], qd[2];
#pragma unroll
                    for (int i = 0; i < 2; ++i)
#pragma unroll
                        for (int j = 0; j < 4; ++j) {
                            const float eB = __expf(bb[i][j]), enB = __builtin_amdgcn_rcpf(eB);
                            kd[i][j] = kx[i][j] * enB; kt[i][j] = kd[i][j] * dc[i][j];
                            if (OUT) qd[i][j] = qx[i][j] * 0.08838834764831845f * eB;
                        }
                    *(u32x4*)(KTE + c * 144 + o8) = (u32x4){pk2(kt[0][0], kt[0][1]), pk2(kt[0][2], kt[0][3]), pk2(kt[1][0], kt[1][1]), pk2(kt[1][2], kt[1][3])};
                    if (OUT) {
                        *(u32x4*)(KD + c * 136 + o8) = (u32x4){pk2(kd[0][0], kd[0][1]), pk2(kd[0][2], kd[0][3]), pk2(kd[1][0], kd[1][1]), pk2(kd[1][2], kd[1][3])};
                        *(u32x4*)(QD + c * 136 + o8) = (u32x4){pk2(qd[0][0], qd[0][1]), pk2(qd[0][2], qd[0][3]), pk2(qd[1][0], qd[1][1]), pk2(qd[1][2], qd[1][3])};
                    }
                }
#pragma unroll
                for (int i = 0; i < 4; ++i) *(u32x4*)(VI + c * 272 + 32 * seg + 8 * i) = raw.v[i];
                if (OUT) {
#pragma unroll
                    for (int vt = 0; vt < 2; ++vt)
#pragma unroll
                        for (int ct = 0; ct < 4; ++ct) gate[vt][ct] = *(const u32x2*)((const char*)P + (size_t)(tok0 + 16 * ct) * GIN_P * 2 + offG + 32 * vt);
                }
                if (ch < 7) gla_issue<OUT>(raw, (const char*)P + (size_t)(tok0 + 64) * GIN_P * 2, offQ, offV);
                if (ch < 7 && tid < 128) *(u32x4*)(ADL + tid * 8) = adn;
            }
            GLA_BARRIER();
            f32x4 o[2][4];
            if (OUT) {
#pragma unroll
                for (int t2 = 0; t2 < 2; ++t2) {
                    const int tl = 2 * w + t2, ct = tl >> 2, st = tl & 3;
                    f32x4 acc = (f32x4){0.f, 0.f, 0.f, 0.f};
                    if (st <= ct) {
#pragma unroll
                        for (int kk = 0; kk < 4; ++kk) {
                            const bf16x8 a = *(const bf16x8*)(KD + (16 * st + l15) * 136 + 32 * kk + 8 * g);
                            const bf16x8 bq = *(const bf16x8*)(QD + (16 * ct + l15) * 136 + 32 * kk + 8 * g);
                            acc = mfma16(a, bq, acc);
                        }
#pragma unroll
                        for (int r = 0; r < 4; ++r) if (16 * st + 4 * g + r > 16 * ct + l15) acc[r] = 0.f;
                    }
                    *(u32x2*)(ATT + (16 * ct + l15) * 72 + 16 * st + 4 * g) = g_pk4(acc);
                }
                GLA_BARRIER();
#pragma unroll
                for (int vt = 0; vt < 2; ++vt)
#pragma unroll
                    for (int ct = 0; ct < 4; ++ct) o[vt][ct] = (f32x4){0.f, 0.f, 0.f, 0.f};
#pragma unroll
                for (int kk = 0; kk < 4; ++kk) {
                    bf16x8 sa[2];
#pragma unroll
                    for (int vt = 0; vt < 2; ++vt) { const u32x2 s0 = g_pk4(S[2 * kk][vt]), s1 = g_pk4(S[2 * kk + 1][vt]); sa[vt] = as_bf16x8((u32x4){s0.x, s0.y, s1.x, s1.y}); }
#pragma unroll
                    for (int ct = 0; ct < 4; ++ct) {
                        const bf16_t* qr = QD + (16 * ct + l15) * 136 + 32 * kk + 4 * g;
                        const u32x2 lo = *(const u32x2*)qr, hi = *(const u32x2*)(qr + 16);
                        const bf16x8 bq = as_bf16x8((u32x4){lo.x, lo.y, hi.x, hi.y});
#pragma unroll
                        for (int vt = 0; vt < 2; ++vt) o[vt][ct] = mfma16(sa[vt], bq, o[vt][ct]);
                    }
                }
            }
            bf16x8 bv[2][2];
#pragma unroll
            for (int vt = 0; vt < 2; ++vt)
#pragma unroll
                for (int kk = 0; kk < 2; ++kk) bv[vt][kk] = g_trfrag<272>(VI, 32 * kk, 32 * w + 16 * vt, g, q4, p4);
            if (OUT) {
#pragma unroll
                for (int ct = 0; ct < 4; ++ct)
#pragma unroll
                    for (int kk = 0; kk < 2; ++kk) {
                        if (32 * kk <= 16 * ct + 15) {
                            const bf16x8 bq = *(const bf16x8*)(ATT + (16 * ct + l15) * 72 + 32 * kk + 8 * g);
#pragma unroll
                            for (int vt = 0; vt < 2; ++vt) o[vt][ct] = mfma16(bv[vt][kk], bq, o[vt][ct]);
                        }
                    }
            }
#pragma unroll
            for (int mt = 0; mt < 8; ++mt) {
                const f32x4 dv = *(const f32x4*)(DEC + 16 * mt + 4 * g);
#pragma unroll
                for (int vt = 0; vt < 2; ++vt) S[mt][vt] *= dv;
#pragma unroll
                for (int kk = 0; kk < 2; ++kk) {
                    const bf16x8 a = g_trfrag<144>(KTE, 32 * kk, 16 * mt, g, q4, p4);
#pragma unroll
                    for (int vt = 0; vt < 2; ++vt) S[mt][vt] = mfma16(a, bv[vt][kk], S[mt][vt]);
                }
            }
            if (OUT) {
                float ss[4];
#pragma unroll
                for (int ct = 0; ct < 4; ++ct) {
                    float s = 0.f;
#pragma unroll
                    for (int vt = 0; vt < 2; ++vt)
#pragma unroll
                        for (int r = 0; r < 4; ++r) s += o[vt][ct][r] * o[vt][ct][r];
                    s += __shfl_xor(s, 16); s += __shfl_xor(s, 32);
                    ss[ct] = s;
                }
                if (g == 0) {
#pragma unroll
                    for (int ct = 0; ct < 4; ++ct) SSQ[(16 * ct + l15) * 8 + w] = ss[ct];
                }
                f32x4 gh[2];
#pragma unroll
                for (int vt = 0; vt < 2; ++vt) gh[vt] = *(const f32x4*)(g_head + 32 * w + 16 * vt + 4 * g);
                GLA_BARRIER();
#pragma unroll
                for (int ct = 0; ct < 4; ++ct) {
                    const int cc = 16 * ct + l15;
                    const float4 s0 = *(const float4*)(SSQ + cc * 8), s1 = *(const float4*)(SSQ + cc * 8 + 4);
                    const float tot = (s0.x + s0.y) + (s0.z + s0.w) + (s1.x + s1.y) + (s1.z + s1.w);
                    const float rstd = rsqrtf(tot * (1.0f / 256.0f) + 1e-6f);
#pragma unroll
                    for (int vt = 0; vt < 2; ++vt) {
                        const f32x4 gt = g_unpk4(gate[vt][ct]);
                        f32x4 val;
#pragma unroll
                        for (int r = 0; r < 4; ++r) val[r] = o[vt][ct][r] * rstd * gh[vt][r] * gt[r] * __builtin_amdgcn_rcpf(1.0f + __expf(-gt[r]));
                        *(u32x2*)((char*)Aout + (size_t)(tok0 + 16 * ct) * DM * 2 + offO + 32 * vt) = g_pk4(val);
                    }
                }
            } else {
                GLA_BARRIER();
            }
        }
        if (!OUT) {
#pragma unroll
            for (int mt = 0; mt < 8; ++mt)
#pragma unroll
                for (int vt = 0; vt < 2; ++vt)
#pragma unroll
                    for (int r = 0; r < 4; ++r) GS[((size_t)(bh * 32 + m) * 128 + 16 * mt + 4 * g + r) * 256 + 32 * w + 16 * vt + l15] = S[mt][vt][r];
            if (g == 0) GD[(bh * 32 + m) * 128 + 16 * w + l15] = __expf(logD);
        }
        GLA_BARRIER();
    }
}

__device__ void gla_scan(const Params& p) {
    float* GS = (float*)(p.ws + WS_GS);
    const float* GD = (const float*)(p.ws + WS_GD);
    for (int idx = blockIdx.x * NTH + threadIdx.x; idx < 8 * 32768; idx += gridDim.x * NTH) {
        const int bh = idx >> 15, e = idx & 32767, d = e >> 8;
        float S = 0.f;
        for (int m0 = 0; m0 < 32; m0 += 16) {
            float t[16], dd[16];
#pragma unroll
            for (int m = 0; m < 16; ++m) { t[m] = GS[(size_t)(bh * 32 + m0 + m) * 32768 + e]; dd[m] = GD[(bh * 32 + m0 + m) * 128 + d]; }
#pragma unroll
            for (int m = 0; m < 16; ++m) { GS[(size_t)(bh * 32 + m0 + m) * 32768 + e] = S; S = S * dd[m] + t[m]; }
        }
    }
}

constexpr int PP = RIN_P;
constexpr size_t WS_RK  = WS_GS;
constexpr size_t WS_BND = WS_GS + (size_t)MTOK * 16 * 4;
static_assert(WS_BND + (size_t)513 * PP * 2 <= WS_GD, "RWKV side buffers must fit the GLA state region");
constexpr int IMG = 64 * 72 * 2;
constexpr int R_ALB = 0, R_BH = IMG, R_KH = 2 * IMG, R_RB = 3 * IMG, R_BTL = 4 * IMG, R_KTL = 5 * IMG, R_VI = 6 * IMG, R_AAB = 7 * IMG, R_AAK = 8 * IMG, R_ARB = 9 * IMG, R_ARK = 10 * IMG,
              R_DW = R_AAB, R_DA = R_AAB + 64 * 68 * 4, R_XT = 11 * IMG, R_TW = R_XT, R_ADI = R_XT + IMG, R_TDF = R_XT + 2 * IMG, R_CS = R_TDF + 2048, R_GC = R_CS + 2048, R_CONST = R_GC + 256,
              R_END = R_CONST + 2560;
static_assert(R_DA + 64 * 68 * 4 <= R_XT && R_END <= LDS_BYTES, "R1 LDS");
#define LDS_BARRIER() do { asm volatile("s_waitcnt lgkmcnt(0)" ::: "memory"); __builtin_amdgcn_s_barrier(); asm volatile("" ::: "memory"); } while (0)

typedef short s16x4 __attribute__((ext_vector_type(4)));
__device__ __forceinline__ bf16x8 ldfrag(const bf16_t* img, int row, int koff) { return *(const bf16x8*)(img + row * 72 + koff); }
__device__ __forceinline__ u32x2 pk4(f32x4 v) { u32x2 r; r.x = pk2(v[0], v[1]); r.y = pk2(v[2], v[3]); return r; }
__device__ __forceinline__ f32x4 unpk4(u32x2 v) { return (f32x4){bf2f(v.x & 0xffffu), bf2f(v.x >> 16), bf2f(v.y & 0xffffu), bf2f(v.y >> 16)}; }
__device__ __forceinline__ u32x2 trread(const bf16_t* p) {
    union { s16x4 s; u32x2 u; } x; x.s = __builtin_amdgcn_ds_read_tr16_b64_v4i16((__attribute__((address_space(3))) s16x4*)p); return x.u;
}
__device__ __forceinline__ bf16x8 trfrag(const bf16_t* img, int k0, int c0, int g, int q, int pq) {
    const bf16_t* a = img + (k0 + 8 * g + q) * 72 + c0 + 4 * pq;
    const u32x2 lo = trread(a), hi = trread(a + 4 * 72);
    return as_bf16x8((u32x4){lo.x, lo.y, hi.x, hi.y});
}
__device__ __forceinline__ f32x4 lo4(u32x4 v) { return (f32x4){bf2f(v.x & 0xffffu), bf2f(v.x >> 16), bf2f(v.y & 0xffffu), bf2f(v.y >> 16)}; }
__device__ __forceinline__ f32x4 hi4(u32x4 v) { return (f32x4){bf2f(v.z & 0xffffu), bf2f(v.z >> 16), bf2f(v.w & 0xffffu), bf2f(v.w >> 16)}; }
__device__ __forceinline__ u32x4 pk8(f32x4 a, f32x4 b) { return (u32x4){pk2(a[0], a[1]), pk2(a[2], a[3]), pk2(b[0], b[1]), pk2(b[2], b[3])}; }
__device__ __forceinline__ float fast_rcp(float x) { return __builtin_amdgcn_rcpf(x); }
__device__ __forceinline__ f32x4 mm16(f32x4 xa, f32x4 yb, f32x4 c) {
    const u32x2 a = pk4(xa), b = pk4(yb);
    return mfma16(as_bf16x8((u32x4){a.x, a.y, 0u, 0u}), as_bf16x8((u32x4){b.x, b.y, 0u, 0u}), c);
}

struct R1Raw { u32x4 r0, r1, k0, k1, v0, v1, w0, w1, a0, a1; };
__device__ __forceinline__ void r1_issue(R1Raw& x, const bf16_t* P, const bf16_t* BND, int unit, int t, int cs) {
    const int bn = unit >> 4, h = unit & 15;
    const bf16_t* cur = P + ((size_t)bn * 64 + t) * PP;
    const bf16_t* prv = (t > 0) ? (cur - PP) : (BND + (size_t)bn * PP);
    const int ch = h * 64 + 8 * cs;
    x.r0 = *(const u32x4*)(cur + ch); x.k0 = *(const u32x4*)(cur + 1024 + ch); x.v0 = *(const u32x4*)(cur + 2048 + ch); x.w0 = *(const u32x4*)(cur + 4096 + 8 * cs); x.a0 = *(const u32x4*)(cur + 4160 + 8 * cs);
    x.r1 = *(const u32x4*)(prv + ch); x.k1 = *(const u32x4*)(prv + 1024 + ch); x.v1 = *(const u32x4*)(prv + 2048 + ch); x.w1 = *(const u32x4*)(prv + 4096 + 8 * cs); x.a1 = *(const u32x4*)(prv + 4160 + 8 * cs);
}
__device__ __forceinline__ void lerp8(u32x4 c, u32x4 pv, bool zprev, const float* mu8, f32x4& o0, f32x4& o1) {
    const f32x4 c0 = lo4(c), c1 = hi4(c);
    f32x4 p0 = lo4(pv), p1 = hi4(pv);
    if (zprev) { p0 = (f32x4){0.f, 0.f, 0.f, 0.f}; p1 = p0; }
    const f32x4 m0 = *(const f32x4*)mu8, m1 = *(const f32x4*)(mu8 + 4);
    o0 = c0 + m0 * (p0 - c0); o1 = c1 + m1 * (p1 - c1);
}

__device__ void rwkv_r1(const Params& p, unsigned char* lds) {
    const int tid = threadIdx.x, lane = tid & 63, w = tid >> 6, l15 = lane & 15, g = lane >> 4, q4 = l15 >> 2, p4 = l15 & 3;
    bf16_t* P = (bf16_t*)(p.ws + WS_P);
    bf16_t* Abuf = (bf16_t*)(p.ws + WS_A);
    bf16_t* Ybuf = (bf16_t*)(p.ws + WS_Y);
    float* RK = (float*)(p.ws + WS_RK);
    const bf16_t* BND = (const bf16_t*)(p.ws + WS_BND);
    const bf16_t* WduT = (const bf16_t*)(p.ws + WS_WDUT);
    const bf16_t* WiuT = (const bf16_t*)(p.ws + WS_WIUT);
    bf16_t* ALB = (bf16_t*)(lds + R_ALB); bf16_t* BH = (bf16_t*)(lds + R_BH); bf16_t* KH = (bf16_t*)(lds + R_KH); bf16_t* RB = (bf16_t*)(lds + R_RB);
    bf16_t* BTL = (bf16_t*)(lds + R_BTL); bf16_t* KTL = (bf16_t*)(lds + R_KTL); bf16_t* VI = (bf16_t*)(lds + R_VI);
    bf16_t* AAB = (bf16_t*)(lds + R_AAB); bf16_t* AAK = (bf16_t*)(lds + R_AAK); bf16_t* ARB = (bf16_t*)(lds + R_ARB); bf16_t* ARK = (bf16_t*)(lds + R_ARK);
    float* DW = (float*)(lds + R_DW); float* DA = (float*)(lds + R_DA);
    bf16_t* XT = (bf16_t*)(lds + R_XT); bf16_t* TW = (bf16_t*)(lds + R_TW); bf16_t* ADI = (bf16_t*)(lds + R_ADI);
    u32x2* TDF = (u32x2*)(lds + R_TDF); float* CS = (float*)(lds + R_CS); float* GCs = (float*)(lds + R_GC); float* CONST = (float*)(lds + R_CONST);
    const int t = tid >> 3, cs = tid & 7, tl = lane >> 3;
    int hprev = -1;
    R1Raw raw;
    if (blockIdx.x < 8192) r1_issue(raw, P, BND, blockIdx.x, t, cs);

    for (int unit = blockIdx.x; unit < 8192; unit += gridDim.x) {
        const int bn = unit >> 4, h = unit & 15, n = bn & 255;
        const size_t R0 = (size_t)bn * 64;
        if (h != hprev) {
            LDS_BARRIER();
            if (tid < 64) {
                const int ch = h * 64 + tid;
                CONST[tid] = p.in[10][ch]; CONST[64 + tid] = p.in[10][1024 + ch]; CONST[128 + tid] = p.in[10][2048 + ch];
                CONST[192 + tid] = p.in[11][ch]; CONST[256 + tid] = p.in[13][ch]; CONST[320 + tid] = p.in[15][ch]; CONST[384 + tid] = p.in[16][ch]; CONST[448 + tid] = p.in[17][ch];
                CONST[512 + tid] = p.in[10][4096 + tid]; CONST[576 + tid] = p.in[10][4160 + tid];
            }
            hprev = h;
            LDS_BARRIER();
        }
        bf16x8 fwd[2][2], fwi[2][2];
#pragma unroll
        for (int q = 0; q < 2; ++q)
#pragma unroll
            for (int kk = 0; kk < 2; ++kk) {
                const size_t o = (size_t)(h * 64 + 16 * (2 * (w >> 2) + q) + l15) * 64 + 32 * kk + 8 * g;
                fwd[q][kk] = *(const bf16x8*)(WduT + o); fwi[q][kk] = *(const bf16x8*)(WiuT + o);
            }
        f32x4 r0, r1, k0, k1, v0, v1;
        {
            const bool zp = (t == 0 && n == 0);
            f32x4 wd0, wd1, ad0, ad1;
            lerp8(raw.r0, raw.r1, zp, CONST + 8 * cs, r0, r1);
            lerp8(raw.k0, raw.k1, zp, CONST + 64 + 8 * cs, k0, k1);
            lerp8(raw.v0, raw.v1, zp, CONST + 128 + 8 * cs, v0, v1);
            lerp8(raw.w0, raw.w1, zp, CONST + 512 + 8 * cs, wd0, wd1);
            lerp8(raw.a0, raw.a1, zp, CONST + 576 + 8 * cs, ad0, ad1);
#pragma unroll
            for (int j = 0; j < 4; ++j) {
                const float e0 = __expf(-2.f * fabsf(wd0[j])), e1 = __expf(-2.f * fabsf(wd1[j]));
                wd0[j] = copysignf((1.f - e0) * fast_rcp(1.f + e0), wd0[j]); wd1[j] = copysignf((1.f - e1) * fast_rcp(1.f + e1), wd1[j]);
            }
            *(u32x4*)(TW + t * 72 + 8 * cs) = pk8(wd0, wd1);
            *(u32x4*)(ADI + t * 72 + 8 * cs) = pk8(ad0, ad1);
        }
        if (unit + (int)gridDim.x < 8192) r1_issue(raw, P, BND, unit + gridDim.x, t, cs);
        LDS_BARRIER();
        {
            const int tt = w & 3;
            bf16x8 ft[2], fa[2];
#pragma unroll
            for (int kk = 0; kk < 2; ++kk) { ft[kk] = ldfrag(TW, 16 * tt + l15, 32 * kk + 8 * g); fa[kk] = ldfrag(ADI, 16 * tt + l15, 32 * kk + 8 * g); }
#pragma unroll
            for (int q = 0; q < 2; ++q) {
                const int ct = 2 * (w >> 2) + q;
                f32x4 aw = (f32x4){0.f, 0.f, 0.f, 0.f}, aa = aw;
#pragma unroll
                for (int kk = 0; kk < 2; ++kk) { aw = mfma16(fwd[q][kk], ft[kk], aw); aa = mfma16(fwi[q][kk], fa[kk], aa); }
                *(f32x4*)(DW + (16 * tt + l15) * 68 + 16 * ct + 4 * g) = aw;
                *(f32x4*)(DA + (16 * tt + l15) * 68 + 16 * ct + 4 * g) = aa;
            }
        }
        LDS_BARRIER();
        f32x4 lw[2], av[2], kk[2], k2[2], G[2];
        {
            const f32x4 cw0[2] = {*(const f32x4*)(CONST + 192 + 8 * cs), *(const f32x4*)(CONST + 196 + 8 * cs)};
            const f32x4 ca0[2] = {*(const f32x4*)(CONST + 256 + 8 * cs), *(const f32x4*)(CONST + 260 + 8 * cs)};
            const f32x4 ckk[2] = {*(const f32x4*)(CONST + 320 + 8 * cs), *(const f32x4*)(CONST + 324 + 8 * cs)};
            const f32x4 cka[2] = {*(const f32x4*)(CONST + 384 + 8 * cs), *(const f32x4*)(CONST + 388 + 8 * cs)};
            const f32x4 crk[2] = {*(const f32x4*)(CONST + 448 + 8 * cs), *(const f32x4*)(CONST + 452 + 8 * cs)};
            const f32x4 dwv[2] = {*(const f32x4*)(DW + t * 68 + 8 * cs), *(const f32x4*)(DW + t * 68 + 8 * cs + 4)};
            const f32x4 dav[2] = {*(const f32x4*)(DA + t * 68 + 8 * cs), *(const f32x4*)(DA + t * 68 + 8 * cs + 4)};
            const f32x4 kin[2] = {k0, k1}, rin[2] = {r0, r1};
            float n2 = 0.f, rk = 0.f;
#pragma unroll
            for (int hf = 0; hf < 2; ++hf)
#pragma unroll
                for (int j = 0; j < 4; ++j) {
                    const float z = -(cw0[hf][j] + dwv[hf][j]);
                    const float sp = fmaxf(z, 0.f) + __logf(1.f + __expf(-fabsf(z)));
                    lw[hf][j] = -__expf(-sp - 0.5f);
                    av[hf][j] = fast_rcp(1.f + __expf(-(ca0[hf][j] + dav[hf][j])));
                    kk[hf][j] = kin[hf][j] * ckk[hf][j];
                    k2[hf][j] = kin[hf][j] * (1.f + (av[hf][j] - 1.f) * cka[hf][j]);
                    n2 += kk[hf][j] * kk[hf][j]; rk += rin[hf][j] * k2[hf][j] * crk[hf][j];
                }
            n2 += __shfl_xor(n2, 1); rk += __shfl_xor(rk, 1); n2 += __shfl_xor(n2, 2); rk += __shfl_xor(rk, 2); n2 += __shfl_xor(n2, 4); rk += __shfl_xor(rk, 4);
            const float inv = 1.0f / fmaxf(sqrtf(n2), 1e-12f);
            kk[0] *= inv; kk[1] *= inv;
            if (cs == 0) RK[(R0 + t) * 16 + h] = rk;
            G[0] = lw[0]; G[1] = lw[1];
#pragma unroll
            for (int d = 1; d < 8; d <<= 1)
#pragma unroll
                for (int hf = 0; hf < 2; ++hf)
#pragma unroll
                    for (int j = 0; j < 4; ++j) { const float y = __shfl_up(G[hf][j], 8 * d); if (tl >= d) G[hf][j] += y; }
            if (tl == 7) { *(f32x4*)(CS + w * 64 + 8 * cs) = G[0]; *(f32x4*)(CS + w * 64 + 8 * cs + 4) = G[1]; }
        }
        LDS_BARRIER();
        {
            f32x4 off[2] = {(f32x4){0.f, 0.f, 0.f, 0.f}, (f32x4){0.f, 0.f, 0.f, 0.f}}, gc[2] = {off[0], off[0]};
#pragma unroll
            for (int q = 0; q < 8; ++q) {
                const f32x4 c0 = *(const f32x4*)(CS + q * 64 + 8 * cs), c1 = *(const f32x4*)(CS + q * 64 + 8 * cs + 4);
                gc[0] += c0; gc[1] += c1;
                if (q < w) { off[0] += c0; off[1] += c1; }
            }
            f32x4 al[2], bh[2], kh[2], rb[2], bt[2], kt[2];
            const f32x4 rin[2] = {r0, r1};
#pragma unroll
            for (int hf = 0; hf < 2; ++hf)
#pragma unroll
                for (int j = 0; j < 4; ++j) {
                    const float Gi = G[hf][j] + off[hf][j];
                    const float eG = __expf(Gi), eGm = __expf(Gi - lw[hf][j]), enG = fast_rcp(eG), eC = __expf(gc[hf][j] - Gi);
                    const float be = kk[hf][j] * av[hf][j];
                    al[hf][j] = -kk[hf][j] * eGm; bh[hf][j] = be * enG; kh[hf][j] = k2[hf][j] * enG; rb[hf][j] = rin[hf][j] * eG; bt[hf][j] = be * eC; kt[hf][j] = k2[hf][j] * eC;
                }
            const int o = t * 72 + 8 * cs;
            *(u32x4*)(ALB + o) = pk8(al[0], al[1]); *(u32x4*)(BH + o) = pk8(bh[0], bh[1]); *(u32x4*)(KH + o) = pk8(kh[0], kh[1]); *(u32x4*)(RB + o) = pk8(rb[0], rb[1]);
            *(u32x4*)(BTL + o) = pk8(bt[0], bt[1]); *(u32x4*)(KTL + o) = pk8(kt[0], kt[1]);
            const u32x4 vpk = pk8(v0, v1);
            *(u32x4*)(VI + o) = vpk;
            *(u32x4*)(Ybuf + (R0 + t) * DM + h * 64 + 8 * cs) = vpk;
            if (w == 0 && tl == 0) { f32x4 e0, e1;
#pragma unroll
                for (int j = 0; j < 4; ++j) { e0[j] = __expf(gc[0][j]); e1[j] = __expf(gc[1][j]); }
                *(f32x4*)(GCs + 8 * cs) = e0; *(f32x4*)(GCs + 8 * cs + 4) = e1; }
        }
        LDS_BARRIER();
        {
            int ntile = 1, tta = 0, sta = 0, ttb = 0, stb = 0;
            if (w == 0) { tta = 0; sta = 0; } else if (w == 2) { tta = 1; sta = 1; } else if (w == 5) { tta = 2; sta = 2; } else if (w == 7) { tta = 3; sta = 3; }
            else if (w == 1) { ntile = 2; tta = 1; sta = 0; ttb = 2; stb = 0; } else if (w == 3) { ntile = 2; tta = 2; sta = 1; ttb = 3; stb = 0; }
            else if (w == 4) { tta = 3; sta = 1; } else { tta = 3; sta = 2; }
            for (int it = 0; it < ntile; ++it) {
                const int tt = it ? ttb : tta, st = it ? stb : sta;
                f32x4 cab = (f32x4){0.f, 0.f, 0.f, 0.f}, cak = cab, crb = cab, crk = cab, nab = cab;
#pragma unroll
                for (int kq = 0; kq < 2; ++kq) {
                    const bf16x8 fb = ldfrag(BH, 16 * st + l15, 32 * kq + 8 * g), fk = ldfrag(KH, 16 * st + l15, 32 * kq + 8 * g);
                    const bf16x8 fa = ldfrag(ALB, 16 * tt + l15, 32 * kq + 8 * g), fr = ldfrag(RB, 16 * tt + l15, 32 * kq + 8 * g);
                    cab = mfma16(fb, fa, cab); cak = mfma16(fk, fa, cak); crb = mfma16(fb, fr, crb); crk = mfma16(fk, fr, crk);
                    if (tt == st) nab = mfma16(fa, fb, nab);
                }
                if (tt == st) {
#pragma unroll
                    for (int r = 0; r < 4; ++r) {
                        const int s = 4 * g + r, tq = l15;
                        if (s >= tq) { cab[r] = 0.f; cak[r] = 0.f; }
                        if (s > tq) { crb[r] = 0.f; crk[r] = 0.f; }
                        if (l15 >= 4 * g + r) nab[r] = 0.f;
                    }
                }
                const int o = (16 * tt + l15) * 72 + 16 * st + 4 * g;
                *(u32x2*)(AAB + o) = pk4(cab); *(u32x2*)(AAK + o) = pk4(cak); *(u32x2*)(ARB + o) = pk4(crb); *(u32x2*)(ARK + o) = pk4(crk);
                if (tt == st) {
                    const f32x4 z = (f32x4){0.f, 0.f, 0.f, 0.f};
                    const f32x4 Q1 = cab, N1 = nab;
                    const f32x4 Q2 = mm16(N1, Q1, z), N2 = mm16(Q1, N1, z);
                    f32x4 Pm = Q1;
#pragma unroll
                    for (int r = 0; r < 4; ++r) if (4 * g + r == l15) Pm[r] += 1.f;
                    Pm = mm16(N2, Pm, Pm);
                    const f32x4 Q4 = mm16(N2, Q2, z), N4 = mm16(Q2, N2, z);
                    Pm = mm16(N4, Pm, Pm);
                    const f32x4 N8 = mm16(Q4, N4, z);
                    Pm = mm16(N8, Pm, Pm);
                    TDF[tt * 64 + lane] = pk4(Pm);
                }
            }
            if (w == 4 || w == 6) {
                const int tt = (w == 4) ? 0 : 2, st = tt + 1;
                const int o = (16 * tt + l15) * 72 + 16 * st + 4 * g;
                const u32x2 zz = (u32x2){0u, 0u};
                *(u32x2*)(AAK + o) = zz; *(u32x2*)(ARB + o) = zz; *(u32x2*)(ARK + o) = zz;
            }
        }
        LDS_BARRIER();
        {
            u32x2 xb[4];
            const int col = 16 * w + l15;
            bf16x8 vfr[2];
            if (w >= 4) { vfr[0] = trfrag(VI, 0, 16 * (w - 4), g, q4, p4); vfr[1] = trfrag(VI, 32, 16 * (w - 4), g, q4, p4); }
#pragma unroll
            for (int i = 0; i < 4; ++i) {
                f32x4 z;
                if (w < 4) z = unpk4(trread(ALB + (16 * i + 4 * g + q4) * 72 + 16 * w + 4 * p4));
                else {
                    z = mfma16(ldfrag(AAK, 16 * i + l15, 8 * g), vfr[0], (f32x4){0.f, 0.f, 0.f, 0.f});
                    if (i >= 2) z = mfma16(ldfrag(AAK, 16 * i + l15, 32 + 8 * g), vfr[1], z);
                }
                if (i >= 1) {
                    const bf16_t* ar = AAB + (16 * i + l15) * 72 + 4 * g;
                    const u32x2 a0 = *(const u32x2*)ar;
                    u32x2 a1 = (u32x2){0u, 0u}, b1 = (u32x2){0u, 0u};
                    if (i >= 2) { a1 = *(const u32x2*)(ar + 16); b1 = xb[1]; }
                    z = mfma16(as_bf16x8((u32x4){a0.x, a0.y, a1.x, a1.y}), as_bf16x8((u32x4){xb[0].x, xb[0].y, b1.x, b1.y}), z);
                    if (i == 3) {
                        const u32x2 a2 = *(const u32x2*)(ar + 32);
                        z = mfma16(as_bf16x8((u32x4){a2.x, a2.y, 0u, 0u}), as_bf16x8((u32x4){xb[2].x, xb[2].y, 0u, 0u}), z);
                    }
                }
                const u32x2 tq = TDF[i * 64 + lane];
                const u32x2 zq = pk4(z);
                const f32x4 x = mfma16(as_bf16x8((u32x4){tq.x, tq.y, 0u, 0u}), as_bf16x8((u32x4){zq.x, zq.y, 0u, 0u}), (f32x4){0.f, 0.f, 0.f, 0.f});
                xb[i] = pk4(x);
                *(u32x2*)(XT + col * 72 + 16 * i + 4 * g) = xb[i];
            }
        }
        LDS_BARRIER();
        {
            const int rt_ = w & 3;
            bf16x8 xw[2], xu[2], fbt[2], fkt[2], fvr[2];
#pragma unroll
            for (int kq = 0; kq < 2; ++kq) {
                xw[kq] = ldfrag(XT, 16 * rt_ + l15, 32 * kq + 8 * g);
                xu[kq] = ldfrag(XT, 64 + 16 * rt_ + l15, 32 * kq + 8 * g);
                fbt[kq] = trfrag(BTL, 32 * kq, 16 * rt_, g, q4, p4);
                fkt[kq] = trfrag(KTL, 32 * kq, 16 * rt_, g, q4, p4);
                fvr[kq] = trfrag(VI, 32 * kq, 16 * rt_, g, q4, p4);
            }
#pragma unroll
            for (int q = 0; q < 2; ++q) {
                const int ctile = 2 * (w >> 2) + q;
                {
                    f32x4 acc = (f32x4){0.f, 0.f, 0.f, 0.f};
#pragma unroll
                    for (int kq = 0; kq < 2; ++kq) acc = mfma16(xw[kq], trfrag(BTL, 32 * kq, 16 * ctile, g, q4, p4), acc);
                    const int dcol = 16 * ctile + l15;
                    if (rt_ == ctile) {
                        const float gc = GCs[dcol];
#pragma unroll
                        for (int r = 0; r < 4; ++r) if (4 * g + r == l15) acc[r] += gc;
                    }
                    *(u32x2*)(P + (R0 + dcol) * PP + h * 64 + 32 * (rt_ >> 1) + 8 * g + 4 * (rt_ & 1)) = pk4(acc);
                }
                {
                    f32x4 acc = unpk4(*(const u32x2*)(RB + (16 * ctile + l15) * 72 + 16 * rt_ + 4 * g));
#pragma unroll
                    for (int kq = 0; kq < 2; ++kq) {
                        if (32 * kq <= 16 * ctile + 15) acc = mfma16(xw[kq], ldfrag(ARB, 16 * ctile + l15, 32 * kq + 8 * g), acc);
                    }
                    *(u32x2*)(P + (R0 + 16 * ctile + l15) * PP + 1024 + h * 64 + 16 * rt_ + 4 * g) = pk4(acc);
                }
                {
                    f32x4 acc = (f32x4){0.f, 0.f, 0.f, 0.f};
#pragma unroll
                    for (int kq = 0; kq < 2; ++kq) {
                        acc = mfma16(fbt[kq], ldfrag(XT, 64 + 16 * ctile + l15, 32 * kq + 8 * g), acc);
                        acc = mfma16(fkt[kq], trfrag(VI, 32 * kq, 16 * ctile, g, q4, p4), acc);
                    }
                    *(u32x2*)(P + (R0 + 16 * ctile + l15) * PP + 2048 + h * 64 + 16 * rt_ + 4 * g) = pk4(acc);
                }
                {
                    f32x4 acc = (f32x4){0.f, 0.f, 0.f, 0.f};
#pragma unroll
                    for (int kq = 0; kq < 2; ++kq) {
                        if (32 * kq <= 16 * ctile + 15) {
                            acc = mfma16(xu[kq], ldfrag(ARB, 16 * ctile + l15, 32 * kq + 8 * g), acc);
                            acc = mfma16(fvr[kq], ldfrag(ARK, 16 * ctile + l15, 32 * kq + 8 * g), acc);
                        }
                    }
                    *(u32x2*)(Abuf + (R0 + 16 * ctile + l15) * DM + h * 64 + 16 * rt_ + 4 * g) = pk4(acc);
                }
            }
        }
        LDS_BARRIER();
    }
}

constexpr int SC_SLOT = 2 * IMG;
constexpr size_t WS_MG = (WS_BND + (size_t)513 * PP * 2 + 255) & ~(size_t)255;
constexpr size_t WS_NG = WS_MG + (size_t)1024 * 4096 * 2;
constexpr size_t WS_HG = WS_NG + (size_t)1024 * 4096 * 2;
static_assert(WS_HG + (size_t)1024 * 4096 * 2 <= WS_GD, "scan buffers must fit the GLA state region");

template <int MODE>
__device__ void rwkv_scan2(const Params& p, unsigned char* lds) {
    constexpr int SPU = (MODE == 2) ? 32 : 8;
    constexpr int NU = (MODE == 2) ? 32 : 1024;
    const int tid = threadIdx.x, lane = tid & 63, w = __builtin_amdgcn_readfirstlane(tid >> 6), l15 = lane & 15, g = lane >> 4;
    bf16_t* P = (bf16_t*)(p.ws + WS_P);
    bf16_t* MG = (bf16_t*)(p.ws + WS_MG); bf16_t* NG = (bf16_t*)(p.ws + WS_NG); bf16_t* HG = (bf16_t*)(p.ws + WS_HG);
    const int G = gridDim.x;
    const int nun = ((int)blockIdx.x < NU) ? (NU - 1 - (int)blockIdx.x) / G + 1 : 0;
    const int T = nun * SPU;
    if (T == 0) return;
#define SC_SRC(s, p0, p1, pitchb) \
    const int u_ = (int)blockIdx.x + G * ((s) / SPU), j_ = (s) % SPU; \
    const char* p0; const char* p1; unsigned pitchb; \
    if (MODE == 2) { p0 = (const char*)(MG + (size_t)(u_ * 32 + j_) * 4096); p1 = (const char*)(NG + (size_t)(u_ * 32 + j_) * 4096); pitchb = 128u; } \
    else { const int bh_ = u_ >> 5, n_ = 8 * (u_ & 31) + j_; p0 = (const char*)(P + ((size_t)(bh_ >> 4) * SEQ + (size_t)n_ * 64) * PP + (bh_ & 15) * 64); p1 = p0 + 4096; pitchb = (unsigned)(PP * 2); }
    if (w >= 4) {
        const int lj = w - 4;
        const unsigned loff = (unsigned)((lane >> 3) * 144 + (lane & 7) * 16);
        u32x4 ld0[16], ld1[16];
#define SC_ISSUE(dst, s) do { const int sc_ = ((s) < T) ? (s) : T - 1; SC_SRC(sc_, q0_, q1_, pb_) const unsigned go_ = (unsigned)(lane >> 3) * pb_ + (unsigned)(lane & 7) * 16u; \
        _Pragma("unroll") for (int q = 0; q < 16; ++q) dst[q] = *(const u32x4*)(((q >> 3) ? q1_ : q0_) + (size_t)((q & 7) * 8) * pb_ + go_); } while (0)
#define SC_RETIRE(src, s) do { unsigned char* sb = lds + ((s) & 1) * SC_SLOT + loff; _Pragma("unroll") for (int q = 0; q < 16; ++q) \
        *(u32x4*)(sb + (q >> 3) * IMG + (q & 7) * 8 * 144) = src[q]; } while (0)
        SC_ISSUE(ld0, lj); SC_ISSUE(ld1, lj + 4);
        for (int it = 0; it < T / 8; ++it) {
            const int c0 = lj + 8 * it;
            for (int k = 0; k < lj; ++k) LDS_BARRIER();
            SC_RETIRE(ld0, c0); SC_ISSUE(ld0, c0 + 8);
            for (int k = 0; k < 4; ++k) LDS_BARRIER();
            SC_RETIRE(ld1, c0 + 4); SC_ISSUE(ld1, c0 + 12);
            for (int k = 0; k < 4 - lj; ++k) LDS_BARRIER();
        }
        LDS_BARRIER();
#undef SC_ISSUE
#undef SC_RETIRE
    } else {
        f32x4 H[4], Mg[4];
        for (int i = 0; i <= T; ++i) {
            if (i >= 1) {
                const int s = i - 1, u = (int)blockIdx.x + G * (s / SPU), j = s % SPU;
                const unsigned char* sb = lds + (s & 1) * SC_SLOT;
                const bf16_t* MT = (const bf16_t*)sb; const bf16_t* NT = (const bf16_t*)(sb + IMG);
                if (j == 0) {
                    if (MODE == 3) {
#pragma unroll
                        for (int mt = 0; mt < 4; ++mt) H[mt] = unpk4(*(const u32x2*)(HG + (size_t)u * 4096 + (16 * w + l15) * 64 + 16 * mt + 4 * g));
                    } else {
#pragma unroll
                        for (int mt = 0; mt < 4; ++mt) H[mt] = (f32x4){0.f, 0.f, 0.f, 0.f};
                    }
                    if (MODE == 1) {
#pragma unroll
                        for (int mt = 0; mt < 4; ++mt)
#pragma unroll
                            for (int r = 0; r < 4; ++r) Mg[mt][r] = (16 * mt + 4 * g + r == 16 * w + l15) ? 1.f : 0.f;
                    }
                }
                u32x2 hp[4];
#pragma unroll
                for (int mt = 0; mt < 4; ++mt) hp[mt] = pk4(H[mt]);
                if (MODE == 2) {
#pragma unroll
                    for (int mt = 0; mt < 4; ++mt) *(u32x2*)(HG + (size_t)(u * 32 + j) * 4096 + (16 * w + l15) * 64 + 16 * mt + 4 * g) = hp[mt];
                }
                if (MODE == 3) {
                    const int bh = u >> 5, n = 8 * (u & 31) + j;
#pragma unroll
                    for (int mt = 0; mt < 4; ++mt) *(u32x2*)(P + ((size_t)(bh >> 4) * SEQ + (size_t)n * 64 + 16 * w + l15) * PP + 2048 + (bh & 15) * 64 + 16 * mt + 4 * g) = hp[mt];
                }
                bf16x8 hb[2], mb[2];
                hb[0] = as_bf16x8((u32x4){hp[0].x, hp[0].y, hp[1].x, hp[1].y});
                hb[1] = as_bf16x8((u32x4){hp[2].x, hp[2].y, hp[3].x, hp[3].y});
                if (MODE == 1) {
                    const u32x2 m0 = pk4(Mg[0]), m1 = pk4(Mg[1]), m2 = pk4(Mg[2]), m3 = pk4(Mg[3]);
                    mb[0] = as_bf16x8((u32x4){m0.x, m0.y, m1.x, m1.y}); mb[1] = as_bf16x8((u32x4){m2.x, m2.y, m3.x, m3.y});
                }
#pragma unroll
                for (int mt = 0; mt < 4; ++mt) {
                    const bf16x8 a0 = ldfrag(MT, 16 * mt + l15, 8 * g), a1 = ldfrag(MT, 16 * mt + l15, 32 + 8 * g);
                    f32x4 acc = unpk4(*(const u32x2*)(NT + (16 * w + l15) * 72 + 16 * mt + 4 * g));
                    acc = mfma16(a0, hb[0], acc); acc = mfma16(a1, hb[1], acc);
                    H[mt] = acc;
                    if (MODE == 1) { f32x4 am = mfma16(a0, mb[0], (f32x4){0.f, 0.f, 0.f, 0.f}); am = mfma16(a1, mb[1], am); Mg[mt] = am; }
                }
                if (MODE == 1 && j == SPU - 1) {
                    const int pc = 32 * (w >> 1) + 8 * (l15 >> 2) + 4 * (w & 1) + (l15 & 3);
#pragma unroll
                    for (int mt = 0; mt < 4; ++mt) {
                        *(u32x2*)(NG + (size_t)u * 4096 + (16 * w + l15) * 64 + 16 * mt + 4 * g) = pk4(H[mt]);
#pragma unroll
                        for (int r = 0; r < 4; ++r) MG[(size_t)u * 4096 + (16 * mt + 4 * g + r) * 64 + pc] = f2bf(Mg[mt][r]);
                    }
                }
            }
            LDS_BARRIER();
        }
    }
#undef SC_SRC
}

__device__ void rwkv_post(const Params& p) {
    const int tid = threadIdx.x, lane = tid & 63, w = tid >> 6, l15 = lane & 15, g = lane >> 4;
    const bf16_t* P = (const bf16_t*)(p.ws + WS_P);
    bf16_t* Abuf = (bf16_t*)(p.ws + WS_A);
    const bf16_t* Ybuf = (const bf16_t*)(p.ws + WS_Y);
    const float* RK = (const float*)(p.ws + WS_RK);
    const bf16_t* BND = (const bf16_t*)(p.ws + WS_BND);
    for (int hu = blockIdx.x * 8 + w; hu < 16384; hu += gridDim.x * 8) {
        const int unit = hu >> 1, t0 = (hu & 1) * 32;
        const int bn = unit >> 4, h = unit & 15, n = bn & 255;
        const size_t R0 = (size_t)bn * 64;
        bf16x8 fh[4][2], fr[2][2];
#pragma unroll
        for (int kk = 0; kk < 2; ++kk) {
#pragma unroll
            for (int q = 0; q < 4; ++q) fh[q][kk] = *(const bf16x8*)(P + (R0 + 16 * q + l15) * PP + 2048 + h * 64 + 32 * kk + 8 * g);
#pragma unroll
            for (int q = 0; q < 2; ++q) fr[q][kk] = *(const bf16x8*)(P + (R0 + t0 + 16 * q + l15) * PP + 1024 + h * 64 + 32 * kk + 8 * g);
        }
        f32x4 y[4][2];
#pragma unroll
        for (int vt = 0; vt < 4; ++vt)
#pragma unroll
            for (int tt = 0; tt < 2; ++tt) y[vt][tt] = unpk4(*(const u32x2*)(Abuf + (R0 + t0 + 16 * tt + l15) * DM + h * 64 + 16 * vt + 4 * g));
#pragma unroll
        for (int vt = 0; vt < 4; ++vt)
#pragma unroll
            for (int tt = 0; tt < 2; ++tt)
#pragma unroll
                for (int kk = 0; kk < 2; ++kk) y[vt][tt] = mfma16(fh[vt][kk], fr[tt][kk], y[vt][tt]);
        f32x4 lnw[4], lnb[4], mug[4];
#pragma unroll
        for (int vt = 0; vt < 4; ++vt) {
            const int ch = h * 64 + 16 * vt + 4 * g;
            lnw[vt] = *(const f32x4*)(p.in[18] + ch); lnb[vt] = *(const f32x4*)(p.in[19] + ch); mug[vt] = *(const f32x4*)(p.in[10] + 3072 + ch);
        }
#pragma unroll
        for (int tt = 0; tt < 2; ++tt) {
            const int t = t0 + 16 * tt + l15;
            float s1 = 0.f, s2 = 0.f;
#pragma unroll
            for (int vt = 0; vt < 4; ++vt)
#pragma unroll
                for (int r = 0; r < 4; ++r) { s1 += y[vt][tt][r]; s2 += y[vt][tt][r] * y[vt][tt][r]; }
            s1 += __shfl_xor(s1, 16); s2 += __shfl_xor(s2, 16); s1 += __shfl_xor(s1, 32); s2 += __shfl_xor(s2, 32);
            const float mean = s1 * (1.0f / 64.0f);
            const float rstd = rsqrtf(fmaxf(s2 * (1.0f / 64.0f) - mean * mean, 0.f) + 64e-5f);
            const float rk = RK[(R0 + t) * 16 + h];
            const bf16_t* grow = P + (R0 + t) * PP + 3072 + h * 64;
            const bf16_t* gprev = (t > 0) ? (grow - PP) : (BND + (size_t)bn * PP + 3072 + h * 64);
            const bool zprev = (t == 0 && n == 0);
#pragma unroll
            for (int vt = 0; vt < 4; ++vt) {
                const int v = 16 * vt + 4 * g;
                const f32x4 g1 = unpk4(*(const u32x2*)(grow + v));
                f32x4 g0 = unpk4(*(const u32x2*)(gprev + v));
                if (zprev) g0 = (f32x4){0.f, 0.f, 0.f, 0.f};
                const f32x4 vp = unpk4(*(const u32x2*)(Ybuf + (R0 + t) * DM + h * 64 + v));
                f32x4 o;
#pragma unroll
                for (int r = 0; r < 4; ++r) {
                    const float yn = (y[vt][tt][r] - mean) * rstd * lnw[vt][r] + lnb[vt][r];
                    const float gt = g1[r] + mug[vt][r] * (g0[r] - g1[r]);
                    o[r] = (yn + rk * vp[r]) * gt / (1.0f + __expf(-gt));
                }
                *(u32x2*)(Abuf + (R0 + t) * DM + h * 64 + v) = pk4(o);
            }
        }
    }
}
#define XB_TMO      128
#define XB_XCNT(j)  (256  + 64 * (j))
#define XB_XSUB(j)  (1280 + 64 * (j))
#define XB_XGEN(j)  (2304 + 64 * (j))
#define XB_TOP      3328
#define XB_TOPGEN   3392
#define XCD_BAR_WORDS 3456
#define XB_SPIN_CAP (1u << 18)
#define LAS __attribute__((address_space(3)))

__device__ __forceinline__ unsigned xb_ld(unsigned* p)              { return __hip_atomic_load(p, __ATOMIC_RELAXED, __HIP_MEMORY_SCOPE_AGENT); }
__device__ __forceinline__ unsigned xb_add(unsigned* p, unsigned v) { return __hip_atomic_fetch_add(p, v, __ATOMIC_RELAXED, __HIP_MEMORY_SCOPE_AGENT); }
__device__ __forceinline__ unsigned xb_xcc_id() { return (unsigned)__builtin_amdgcn_s_getreg((3 << 11) | 20) & 0xFu; }
#define XB_SPIN(cond, bar) do { unsigned _sp = 0; while (cond) { __builtin_amdgcn_s_sleep(1); \
    if ((++_sp & 255u) == 0u) { if (xb_ld(&(bar)[XB_TMO])) break; if (_sp > XB_SPIN_CAP) { atomicAdd(&(bar)[XB_TMO], 1u); break; } } } } while (0)

struct XcdBarrier {
    unsigned* bar; unsigned x;
    volatile LAS unsigned* st;
};

__device__ __forceinline__ XcdBarrier xcd_barrier_post(unsigned* bar, volatile LAS unsigned* st) {
    XcdBarrier b; b.bar = bar; b.x = xb_xcc_id(); b.st = st;
    if (threadIdx.x == 0) (void)xb_add(&bar[XB_XCNT(b.x)], 1u);
    return b;
}
__device__ __forceinline__ void xcd_barrier_complete(unsigned* bar, unsigned x, unsigned& nloc, unsigned& nx) {
    const unsigned G = gridDim.x * gridDim.y * gridDim.z;
    unsigned sum, cnt, mine, sp = 0u;
    for (;;) {
        sum = 0u; cnt = 0u; mine = 0u;
#pragma unroll
        for (unsigned j = 0; j < 16; ++j) { const unsigned c = xb_ld(&bar[XB_XCNT(j)]); sum += c; cnt += (c > 0u) ? 1u : 0u; mine = (j == x) ? c : mine; }
        if (sum == G) break;
        __builtin_amdgcn_s_sleep(1);
        if ((++sp & 255u) == 0u) { if (xb_ld(&bar[XB_TMO])) break; if (sp > XB_SPIN_CAP) { atomicAdd(&bar[XB_TMO], 1u); break; } }
    }
    nloc = mine > 0u ? mine : 1u; nx = cnt > 0u ? cnt : 1u;
}

__device__ __forceinline__ void xcd_barrier(const XcdBarrier& b) {
    asm volatile("s_waitcnt vmcnt(0)" ::: "memory");
    __syncthreads();
    if (threadIdx.x == 0) {
        unsigned* bar = b.bar;
        __builtin_amdgcn_s_waitcnt(0);
        unsigned nloc = b.st[0], nx = b.st[1];
        if (nloc == 0u) { xcd_barrier_complete(bar, b.x, nloc, nx); b.st[0] = nloc; b.st[1] = nx; }
        const unsigned old = xb_add(&bar[XB_XSUB(b.x)], 1u);
        const unsigned gen = old / nloc;
        if (old + 1u == (gen + 1u) * nloc) {
            __builtin_amdgcn_fence(__ATOMIC_RELEASE, "agent");
            asm volatile("s_waitcnt vmcnt(0)" ::: "memory");
            const unsigned og = xb_add(&bar[XB_TOP], 1u);
            const unsigned tg = og / nx;
            if (og + 1u == (tg + 1u) * nx) xb_add(&bar[XB_TOPGEN], 1u);
            else XB_SPIN(xb_ld(&bar[XB_TOPGEN]) == tg, bar);
            __builtin_amdgcn_fence(__ATOMIC_ACQUIRE, "agent");
            xb_add(&bar[XB_XGEN(b.x)], 1u);
            asm volatile("s_waitcnt vmcnt(0)" ::: "memory");
        } else {
            XB_SPIN(xb_ld(&bar[XB_XGEN(b.x)]) == gen, bar);
            __builtin_amdgcn_fence(__ATOMIC_ACQUIRE, "agent");
            asm volatile("s_waitcnt vmcnt(0)" ::: "memory");
        }
    }
    __syncthreads();
}


#ifndef PROBE_ID
#define PROBE_ID 0
#endif
#ifndef N_LAUNCH_MODE
#define N_LAUNCH_MODE 1
#endif
constexpr int N_PHASES = 15;

__global__ void __launch_bounds__(NTH, 2) fwd_kernel(Params p) {
    extern __shared__ __attribute__((aligned(16))) unsigned char lds[];
    const int lo = p.ph_lo, hi = p.ph_hi;
    volatile LAS unsigned* xst = (volatile LAS unsigned*)(lds + LDS_BYTES);
    if (threadIdx.x < 4) xst[threadIdx.x] = 0u;
    __syncthreads();
    const XcdBarrier xbar = xcd_barrier_post((unsigned*)(p.ws + WS_BAR), xst);
    unsigned char* ws = p.ws;
#define IN(k) (lo <= (k) && (k) < hi)
#define SEAM(k) do { if ((k) + 1 < hi) xcd_barrier(xbar); } while (0)
    if (IN(0)) {
        prep_weight(p.in[2], GIN, p.in[1], (bf16_t*)(ws + WS_WGIN), GIN_P, (float*)lds);
        prep_weight(p.in[6], DM, nullptr, (bf16_t*)(ws + WS_WGOUT), DM, (float*)lds);
        prep_weight(p.in[9], RIN, p.in[8], (bf16_t*)(ws + WS_WRIN), RIN_P, (float*)lds);
        prep_weight(p.in[20], DM, nullptr, (bf16_t*)(ws + WS_WROUT), DM, (float*)lds);
        prep_lowrank(p.in[12], (bf16_t*)(ws + WS_WDUT));
        prep_lowrank(p.in[14], (bf16_t*)(ws + WS_WIUT));
        prep_wup(p.in[3], (bf16_t*)(ws + WS_WUPT));
        __syncthreads();
        phase_norm0(p, lds);
        SEAM(0);
    }
    if (IN(1)) {
        pg8::Gemm g{(const bf16_t*)(ws + WS_A), (const bf16_t*)(ws + WS_WGIN), MTOK, GIN_P, DM}; pg8::StaticOrder S; S.init(MTOK, GIN_P, gridDim.x, blockIdx.x);
        pg8::EpiBf16<0> E{(bf16_t*)(ws + WS_P), GIN_P, nullptr, 0, 0};
        pg8::gemm_phase<pg8::EpiBf16<0>, pg8::StaticOrder>((PG8_LAS unsigned char*)lds, g, S, E);
        SEAM(1);
    }
    if (IN(2)) { gla_pass<false>(p, lds); SEAM(2); }
    if (IN(3)) { gla_scan(p); SEAM(3); }
    if (IN(4)) { gla_pass<true>(p, lds); SEAM(4); }
    if (IN(5)) {
        pg8::Gemm g{(const bf16_t*)(ws + WS_A), (const bf16_t*)(ws + WS_WGOUT), MTOK, DM, DM}; pg8::StaticOrder S; S.init(MTOK, DM, gridDim.x, blockIdx.x);
        pg8::EpiBf16<0> E{(bf16_t*)(ws + WS_Y), DM, nullptr, 0, 0};
        pg8::gemm_phase<pg8::EpiBf16<0>, pg8::StaticOrder>((PG8_LAS unsigned char*)lds, g, S, E);
        SEAM(5);
    }
    if (IN(6)) { phase_norm1(p); SEAM(6); }
    if (IN(7)) {
        pg8::Gemm g{(const bf16_t*)(ws + WS_A), (const bf16_t*)(ws + WS_WRIN), MTOK, RIN_P, DM}; pg8::StaticOrder S; S.init(MTOK, RIN_P, gridDim.x, blockIdx.x);
        EpiBf16Bnd E{(bf16_t*)(ws + WS_P), RIN_P, (bf16_t*)(ws + WS_BND)};
        pg8::gemm_phase<EpiBf16Bnd, pg8::StaticOrder>((PG8_LAS unsigned char*)lds, g, S, E);
        SEAM(7);
    }
    if (IN(8)) { rwkv_r1(p, lds); SEAM(8); }
    if (IN(9)) { rwkv_scan2<1>(p, lds); SEAM(9); }
    if (IN(10)) { rwkv_scan2<2>(p, lds); SEAM(10); }
    if (IN(11)) { rwkv_scan2<3>(p, lds); SEAM(11); }
    if (IN(12)) { rwkv_post(p); SEAM(12); }
    if (IN(13)) {
        pg8::Gemm g{(const bf16_t*)(ws + WS_A), (const bf16_t*)(ws + WS_WROUT), MTOK, DM, DM}; pg8::StaticOrder S; S.init(MTOK, DM, gridDim.x, blockIdx.x);
        pg8::EpiBf16<0> E{(bf16_t*)(ws + WS_Y), DM, nullptr, 0, 0};
        pg8::gemm_phase<pg8::EpiBf16<0>, pg8::StaticOrder>((PG8_LAS unsigned char*)lds, g, S, E);
        SEAM(13);
    }
    if (IN(14)) { phase_final(p); }
#undef IN
#undef SEAM
}

extern "C" void kernel_launch(void* const* d_in, const int* in_sizes, int n_in, void* d_out, int out_size, void* d_ws, size_t ws_size, hipStream_t stream) {
    static int grid = 0;
    if (grid == 0) {
        int dev = 0, cus = 0, per_cu = 0;
        hipGetDevice(&dev);
        hipDeviceGetAttribute(&cus, hipDeviceAttributeMultiprocessorCount, dev);
        hipFuncSetAttribute((const void*)fwd_kernel, hipFuncAttributeMaxDynamicSharedMemorySize, LDS_BYTES + 16);
        hipOccupancyMaxActiveBlocksPerMultiprocessor(&per_cu, (const void*)fwd_kernel, NTH, LDS_BYTES + 16);
        if (per_cu < 1) { fprintf(stderr, "kernel_launch: occupancy query says %d blocks per CU\n", per_cu); per_cu = 1; }
        grid = cus;
        if (n_in != 22 || ws_size < WS_END) fprintf(stderr, "kernel_launch: unexpected n_in %d or workspace %zu < %zu\n", n_in, ws_size, (size_t)WS_END);
        (void)hipGetLastError();
    }
    if (hipMemsetAsync((char*)d_ws + WS_BAR, 0, XCD_BAR_WORDS * 4, stream) != hipSuccess) fprintf(stderr, "kernel_launch: memset of the barrier words failed\n");
    Params p{};
    for (int i = 0; i < 22; ++i) p.in[i] = (const float*)d_in[i];
    p.out = (float*)d_out; p.ws = (unsigned char*)d_ws;
#if N_LAUNCH_MODE == 1
    void* args[] = {&p};
#if PROBE_ID > 0
    p.ph_lo = 0; p.ph_hi = PROBE_ID;
    (void)hipLaunchCooperativeKernel((const void*)fwd_kernel, dim3(grid), dim3(NTH), args, LDS_BYTES + 16, stream);
    (void)hipMemsetAsync((char*)d_ws + WS_BAR, 0, XCD_BAR_WORDS * 4, stream);
#endif
    p.ph_lo = 0; p.ph_hi = N_PHASES;
    hipError_t e = hipLaunchCooperativeKernel((const void*)fwd_kernel, dim3(grid), dim3(NTH), args, LDS_BYTES + 16, stream);
    if (e != hipSuccess) fprintf(stderr, "cooperative launch failed: %s (grid %d)\n", hipGetErrorString(e), grid);
#else
    for (int k = 0; k < N_PHASES; ++k) {
        p.ph_lo = k; p.ph_hi = k + 1;
        hipLaunchKernelGGL(fwd_kernel, dim3(grid), dim3(NTH), LDS_BYTES + 16, stream, p);
    }
#endif
}
```

```cpp
#include <hip/hip_runtime.h>
#include <hip/hip_cooperative_groups.h>
#include <cstdio>
namespace cg = cooperative_groups;
#define PROBE_ID 0
#define N_LAUNCH_MODE 1
namespace pg8 {
#define PG8_LAS __attribute__((address_space(3)))
typedef unsigned short bf16_t;
typedef short bf16x8 __attribute__((ext_vector_type(8)));
typedef float f32x4 __attribute__((ext_vector_type(4)));
typedef unsigned u32x4 __attribute__((ext_vector_type(4)));
constexpr int BM = 256, BK = 64, HALF = 128, HTB = HALF * BK * 2  , STAGE_BYTES = 8 * HTB, NXCD = 8, WGM = 8;

__host__ __device__ __forceinline__ int lds_byte(int r, int c) { const int st = (r >> 4) * 2 + (c >> 5), rr = r & 15, cc = c & 31, ob = rr * 64 + cc * 2; return st * 1024 + (ob ^ (((ob >> 9) & 1) << 5)); }
__host__ __device__ __forceinline__ void stage_rc(int b, int& R, int& C) { const int st = b / 1024, sb = b % 1024, swz = sb ^ (((sb >> 9) & 1) << 5); R = (st >> 1) * 16 + swz / 64; C = (st & 1) * 32 + (swz % 64) / 2; }
__host__ __device__ __forceinline__ int perm32(int rho) { const int n = rho >> 4, i = rho & 15; return 8 * (i >> 2) + 4 * n + (i & 3); }

struct Unit { int pm, pn; };
struct Gemm { const bf16_t* A; const bf16_t* Bt; int M, N, K; };

struct StaticOrder {
    int nM, nN, nwg, G, c;
    __host__ __device__ void init(int M, int N, int G_, int c_) { nM = M / BM; nN = N / BM; nwg = nM * nN; G = G_; c = c_; }
    __host__ __device__ bool next(int i, Unit& u) const {
        const long L = (long)i * G + c; if (L >= nwg) return false;
        int wgid = (int)L; { const int q = nwg / NXCD, r = nwg % NXCD, xcd = wgid % NXCD, off = wgid / NXCD; wgid = (xcd < r ? xcd * (q + 1) : r * (q + 1) + (xcd - r) * q) + off; }
        const int nig = WGM * nN, gid = wgid / nig, fm = gid * WGM, gsz = (nM - fm) < WGM ? (nM - fm) : WGM;
        u.pm = fm + ((wgid % nig) % gsz); u.pn = (wgid % nig) / gsz; return true;
    }
    __device__ __forceinline__ void a_ready(const Unit&) const {}
    __device__ __forceinline__ void done(const Unit&) const {}
};

typedef float cvt_f32x2 __attribute__((ext_vector_type(2)));
typedef __bf16 cvt_bf16x2 __attribute__((ext_vector_type(2)));
__device__ __forceinline__ unsigned cvt_pk_bf16(float lo, float hi) { const cvt_f32x2 v = {lo, hi}; union { cvt_bf16x2 b; unsigned u; } x; x.b = __builtin_convertvector(v, cvt_bf16x2); return x.u; }
typedef float f32x2 __attribute__((ext_vector_type(2)));
struct EpiF32 {
    static constexpr bool PERM = false, AFTER_DRAIN = false;
    float* C; int ldc; const float* bias;
    __device__ __forceinline__ void operator()(const f32x4 (&acc)[2][2][4][2], const Unit& u, int wr, int wc, int fr, int fq) const {
        const int row0 = u.pm * BM + wr * 64 + fr, col0 = u.pn * BM + wc * 32 + 4 * fq;
        f32x4 bv[2][2];
#pragma unroll
        for (int bj = 0; bj < 2; ++bj)
#pragma unroll
            for (int n = 0; n < 2; ++n) bv[bj][n] = bias ? *(const f32x4*)(bias + col0 + bj * HALF + n * 16) : (f32x4){0.f, 0.f, 0.f, 0.f};
#pragma unroll
        for (int ai = 0; ai < 2; ++ai)
#pragma unroll
            for (int m = 0; m < 4; ++m) { float* rowp = C + (size_t)(row0 + ai * HALF + m * 16) * ldc + col0;
#pragma unroll
                for (int bj = 0; bj < 2; ++bj)
#pragma unroll
                    for (int n = 0; n < 2; ++n) *(f32x4*)(rowp + bj * HALF + n * 16) = acc[ai][bj][m][n] + bv[bj][n]; }
    }
};
template <int ACT  > struct EpiBf16 {
    static constexpr bool PERM = true, AFTER_DRAIN = false;
    bf16_t* O; int ldc; const float* bias; int split_cols; size_t split_stride;
    __device__ __forceinline__ void operator()(const f32x4 (&acc)[2][2][4][2], const Unit& u, int wr, int wc, int fr, int fq) const {
        const int row0 = u.pm * BM + wr * 64 + fr; int colt = u.pn * BM; bf16_t* base = O;
        if (split_cols) { const int t = colt / split_cols; base += (size_t)t * split_stride; colt -= t * split_cols; }
        const int col0 = colt + wc * 32 + 8 * fq, bcol0 = u.pn * BM + wc * 32 + 8 * fq;
        f32x4 bv[2][2];
#pragma unroll
        for (int bj = 0; bj < 2; ++bj)
#pragma unroll
            for (int n = 0; n < 2; ++n) bv[bj][n] = bias ? *(const f32x4*)(bias + bcol0 + bj * HALF + 4 * n) : (f32x4){0.f, 0.f, 0.f, 0.f};
#pragma unroll
        for (int ai = 0; ai < 2; ++ai)
#pragma unroll
            for (int m = 0; m < 4; ++m) { bf16_t* rowp = base + (size_t)(row0 + ai * HALF + m * 16) * ldc + col0;
#pragma unroll
                for (int bj = 0; bj < 2; ++bj) { f32x4 v0 = acc[ai][bj][m][0] + bv[bj][0], v1 = acc[ai][bj][m][1] + bv[bj][1];
                    u32x4 w; w.x = cvt_pk_bf16(v0[0], v0[1]); w.y = cvt_pk_bf16(v0[2], v0[3]); w.z = cvt_pk_bf16(v1[0], v1[1]); w.w = cvt_pk_bf16(v1[2], v1[3]);
                    *(u32x4*)(rowp + bj * HALF) = w; } }
    }
};

template <class Epi, class Sched>
__device__ __forceinline__ void gemm_phase(PG8_LAS unsigned char* lds, const Gemm g, const Sched& S, const Epi& E) {
    const int tid = threadIdx.x, wid = __builtin_amdgcn_readfirstlane(tid >> 6), lane = tid & 63, wr = wid >> 2, wc = wid & 3, fr = lane & 15, fq = lane >> 4;
    const int K = g.K, nt = K / BK;
    unsigned voffA[2], voffB[2];
#pragma unroll
    for (int i = 0; i < 2; ++i) { int R, C; stage_rc(tid * 16 + i * 8192, R, C); const int Rb = Epi::PERM ? ((R & ~31) + perm32(R & 31)) : R;
        voffA[i] = (unsigned)(R * K + C) * 2u; voffB[i] = (unsigned)(Rb * K + C) * 2u; }
    const size_t kstep = (size_t)(BK * 2);
    const size_t hstep = (size_t)HALF * K * 2;
    const size_t tstep = 2 * hstep;
    const unsigned ldsw = (unsigned)wid * 1024u;
    const int aoff = lds_byte(wr * 64 + fr, fq * 8), boff = lds_byte(wc * 32 + fr, fq * 8);
#define PG8_SA(b, h) (((b) * 2 + (h)) * HTB)
#define PG8_SB(b, h) ((4 + (b) * 2 + (h)) * HTB)
#define PG8_STAGE(bufoff, gbase, voff) do { _Pragma("unroll") for (int _i = 0; _i < 2; ++_i) \
        __builtin_amdgcn_global_load_lds((const unsigned*)((const char*)(gbase) + (voff)[_i]), (PG8_LAS unsigned*)(lds + (bufoff) + ldsw + _i * 8192), 16, 0, 0); } while (0)
#define PG8_LDA(dst, b, h) do { _Pragma("unroll") for (int m = 0; m < 4; ++m) _Pragma("unroll") for (int k = 0; k < 2; ++k) dst[m][k] = *(const PG8_LAS bf16x8*)(lds + PG8_SA(b, h) + aoff + m * 2048 + k * 1024); } while (0)
#define PG8_LDB(dst, b, h) do { _Pragma("unroll") for (int n = 0; n < 2; ++n) _Pragma("unroll") for (int k = 0; k < 2; ++k) dst[n][k] = *(const PG8_LAS bf16x8*)(lds + PG8_SB(b, h) + boff + n * 2048 + k * 1024); } while (0)
#define PG8_MMA(ai, bj, At, Bt) do { __builtin_amdgcn_s_setprio(1); _Pragma("unroll") for (int m = 0; m < 4; ++m) _Pragma("unroll") for (int n = 0; n < 2; ++n) _Pragma("unroll") for (int k = 0; k < 2; ++k) \
        acc[ai][bj][m][n] = __builtin_amdgcn_mfma_f32_16x16x32_bf16(Bt[n][k], At[m][k], acc[ai][bj][m][n], 0, 0, 0); __builtin_amdgcn_s_setprio(0); } while (0)
#define PG8_WAIT_V(n) asm volatile("s_waitcnt vmcnt(" #n ")" ::: "memory")
#define PG8_WAIT_L(n) asm volatile("s_waitcnt lgkmcnt(" #n ")" ::: "memory")
#define PG8_BAR __builtin_amdgcn_s_barrier()
#define PG8_SCHED __builtin_amdgcn_sched_barrier(0)
    Unit cur, nxt; int ui = 0;
    if (!S.next(0, cur)) return;
    f32x4 acc[2][2][4][2];
#pragma unroll
    for (int a = 0; a < 2; ++a)
#pragma unroll
        for (int b = 0; b < 2; ++b)
#pragma unroll
            for (int m = 0; m < 4; ++m)
#pragma unroll
                for (int n = 0; n < 2; ++n) acc[a][b][m][n] = (f32x4){0.f, 0.f, 0.f, 0.f};
    bf16x8 At[4][2], B0[2][2], B1[2][2];
    const char* cA = (const char*)g.A + (size_t)cur.pm * tstep; const char* cB = (const char*)g.Bt + (size_t)cur.pn * tstep;
    S.a_ready(cur);
    PG8_STAGE(PG8_SB(0, 0), cB, voffB); PG8_STAGE(PG8_SA(0, 0), cA, voffA); PG8_STAGE(PG8_SB(0, 1), cB + hstep, voffB); PG8_STAGE(PG8_SA(0, 1), cA + hstep, voffA);
    if (wr == 1) PG8_BAR;
    PG8_WAIT_V(4); PG8_BAR;
    PG8_STAGE(PG8_SB(1, 0), cB + kstep, voffB); PG8_STAGE(PG8_SA(1, 0), cA + kstep, voffA); PG8_STAGE(PG8_SB(1, 1), cB + hstep + kstep, voffB);
    PG8_WAIT_V(6); PG8_BAR;
    for (;;) {
        const bool has_next = S.next(ui + 1, nxt);
        const char* nA = has_next ? (const char*)g.A + (size_t)nxt.pm * tstep : cA; const char* nB = has_next ? (const char*)g.Bt + (size_t)nxt.pn * tstep : cB;
        for (int t = 0; t < nt; t += 2) {
            const bool last = (t == nt - 2);
            const char* a1 = cA + (size_t)(t + 1) * kstep;
            const char* a2 = last ? nA : cA + (size_t)(t + 2) * kstep; const char* b2 = last ? nB : cB + (size_t)(t + 2) * kstep;
            const char* a3 = a2 + kstep; const char* b3 = b2 + kstep;
            if (last && has_next) S.a_ready(nxt);
            PG8_LDB(B0, 0, 0); PG8_SCHED; PG8_LDA(At, 0, 0); PG8_STAGE(PG8_SA(1, 1), a1 + hstep, voffA);
            PG8_WAIT_L(8); PG8_BAR; PG8_WAIT_L(0); PG8_MMA(0, 0, At, B0); PG8_BAR; PG8_SCHED;
            PG8_LDB(B1, 0, 1); PG8_STAGE(PG8_SB(0, 0), b2, voffB);
            PG8_BAR; PG8_WAIT_L(0); PG8_MMA(0, 1, At, B1); PG8_BAR;
            PG8_LDA(At, 0, 1); PG8_STAGE(PG8_SA(0, 0), a2, voffA);
            PG8_BAR; PG8_WAIT_L(0); PG8_MMA(1, 0, At, B0); PG8_BAR; PG8_SCHED;
            PG8_STAGE(PG8_SB(0, 1), b2 + hstep, voffB);
            PG8_WAIT_V(6); PG8_BAR; PG8_MMA(1, 1, At, B1); PG8_BAR;
            PG8_LDB(B0, 1, 0); PG8_SCHED; PG8_LDA(At, 1, 0); PG8_STAGE(PG8_SA(0, 1), a2 + hstep, voffA);
            PG8_WAIT_L(8); PG8_BAR; PG8_WAIT_L(0); PG8_MMA(0, 0, At, B0); PG8_BAR; PG8_SCHED;
            PG8_LDB(B1, 1, 1); PG8_STAGE(PG8_SB(1, 0), b3, voffB);
            PG8_BAR; PG8_WAIT_L(0); PG8_MMA(0, 1, At, B1); PG8_BAR;
            PG8_LDA(At, 1, 1); PG8_STAGE(PG8_SA(1, 0), a3, voffA);
            PG8_BAR; PG8_WAIT_L(0); PG8_MMA(1, 0, At, B0); PG8_BAR; PG8_SCHED;
            PG8_STAGE(PG8_SB(1, 1), b3 + hstep, voffB);
            PG8_WAIT_V(6); PG8_BAR; PG8_MMA(1, 1, At, B1); PG8_BAR;
        }
        if constexpr (!Epi::AFTER_DRAIN) { E(acc, cur, wr, wc, fr, fq); S.done(cur); }
        if (!has_next) break;
#pragma unroll
        for (int a = 0; a < 2; ++a)
#pragma unroll
            for (int b = 0; b < 2; ++b)
#pragma unroll
                for (int m = 0; m < 4; ++m)
#pragma unroll
                    for (int n = 0; n < 2; ++n) acc[a][b][m][n] = (f32x4){0.f, 0.f, 0.f, 0.f};
        cur = nxt; cA = nA; cB = nB; ++ui;
    }
    PG8_WAIT_V(0);
    if (wr == 0) PG8_BAR;
    PG8_BAR;
    if constexpr (Epi::AFTER_DRAIN) { E.fused(acc, cur, wr, wc, fr, fq, lds, wid, lane); S.done(cur); }
#undef PG8_SA
#undef PG8_SB
#undef PG8_STAGE
#undef PG8_LDA
#undef PG8_LDB
#undef PG8_MMA
#undef PG8_WAIT_V
#undef PG8_WAIT_L
#undef PG8_BAR
#undef PG8_SCHED
}
}


typedef unsigned short bf16_t;
typedef short bf16x8 __attribute__((ext_vector_type(8)));
typedef float f32x4 __attribute__((ext_vector_type(4)));
typedef unsigned u32x4 __attribute__((ext_vector_type(4)));
typedef unsigned u32x2 __attribute__((ext_vector_type(2)));

constexpr int MTOK = 32768, DM = 1024, SEQ = 16384, NTH = 512;
constexpr int GIN = 3088, GIN_P = 3072, RIN = 4224, RIN_P = 4352;
constexpr int LDS_BYTES = 131072;

constexpr size_t WS_WGIN  = 0;
constexpr size_t WS_WGOUT = WS_WGIN  + (size_t)GIN_P * DM * 2;
constexpr size_t WS_WRIN  = WS_WGOUT + (size_t)DM * DM * 2;
constexpr size_t WS_WROUT = WS_WRIN  + (size_t)RIN_P * DM * 2;
constexpr size_t WS_WDUT  = WS_WROUT + (size_t)DM * DM * 2;
constexpr size_t WS_WIUT  = WS_WDUT  + (size_t)DM * 64 * 2;
constexpr size_t WS_WUPT  = WS_WIUT  + (size_t)DM * 64 * 2;
constexpr size_t WS_A     = WS_WUPT  + (size_t)512 * 16 * 2;
constexpr size_t WS_Y     = WS_A     + (size_t)MTOK * DM * 2;
constexpr size_t WS_GS    = WS_Y     + (size_t)MTOK * DM * 2;
constexpr size_t WS_GD    = WS_GS    + (size_t)8 * 32 * 128 * 256 * 4;
constexpr size_t WS_P     = WS_GD    + (size_t)8 * 32 * 128 * 4;
constexpr size_t WS_BAR   = WS_P     + (size_t)MTOK * RIN_P * 2;
constexpr size_t WS_AD    = WS_BAR   + 16384;
constexpr size_t WS_END   = WS_AD    + (size_t)MTOK * 16 * 2;

struct Params { const float* in[22]; float* out; unsigned char* ws; int ph_lo, ph_hi; };

__device__ __forceinline__ float bf2f(unsigned b) { return __uint_as_float(b << 16); }
__device__ __forceinline__ bf16_t f2bf(float f) { unsigned u = __float_as_uint(f); u += 0x7FFFu + ((u >> 16) & 1u); return (bf16_t)(u >> 16); }
__device__ __forceinline__ unsigned pk2(float lo, float hi) { return pg8::cvt_pk_bf16(lo, hi); }
__device__ __forceinline__ float wave_sum(float x) {
#pragma unroll
    for (int off = 32; off >= 1; off >>= 1) x += __shfl_xor(x, off);
    return x;
}
__device__ __forceinline__ f32x4 mfma16(bf16x8 a, bf16x8 b, f32x4 c) { return __builtin_amdgcn_mfma_f32_16x16x32_bf16(a, b, c, 0, 0, 0); }
__device__ __forceinline__ bf16x8 as_bf16x8(u32x4 v) { union { u32x4 u; bf16x8 b; } x; x.u = v; return x.b; }
__device__ __forceinline__ float log_sigmoid(float z) { return fminf(z, 0.f) - log1pf(__expf(-fabsf(z))); }
__device__ __forceinline__ float softplus(float z) { return fmaxf(z, 0.f) + log1pf(__expf(-fabsf(z))); }

__device__ void prep_weight(const float* __restrict__ W, int N, const float* __restrict__ gain, bf16_t* __restrict__ Wt, int NP, float* tile) {
    const int tid = threadIdx.x;
    const int nu = (NP / 64) * 16;
    for (int u = blockIdx.x; u < nu; u += gridDim.x) {
        const int n0 = (u >> 4) * 64, k0 = (u & 15) * 64;
        {
            const int j = tid & 63, i0 = tid >> 6;
#pragma unroll
            for (int r = 0; r < 8; ++r) {
                const int i = i0 + 8 * r, k = k0 + i, n = n0 + j;
                float v = 0.f;
                if (n < N) { v = W[(size_t)k * N + n]; if (gain) v *= gain[k]; }
                tile[i * 65 + j] = v;
            }
        }
        __syncthreads();
        {
            const int i = tid & 63, j0 = tid >> 6;
#pragma unroll
            for (int r = 0; r < 8; ++r) {
                const int j = j0 + 8 * r;
                Wt[(size_t)(n0 + j) * DM + k0 + i] = f2bf(tile[i * 65 + j]);
            }
        }
        __syncthreads();
    }
}

__device__ void prep_lowrank(const float* __restrict__ src, bf16_t* __restrict__ dst) {
    for (int idx = blockIdx.x * NTH + threadIdx.x; idx < 65536; idx += gridDim.x * NTH) dst[idx] = f2bf(src[(idx & 63) * 1024 + (idx >> 6)]);
}

__device__ void prep_wup(const float* __restrict__ src, bf16_t* __restrict__ dst) {
    for (int idx = blockIdx.x * NTH + threadIdx.x; idx < 8192; idx += gridDim.x * NTH) dst[idx] = f2bf(src[(idx & 15) * 512 + (idx >> 4)]);
}

struct EpiBf16Bnd {
    static constexpr bool PERM = true, AFTER_DRAIN = false;
    bf16_t* O; int ldc; bf16_t* bnd;
    __device__ __forceinline__ void operator()(const f32x4 (&acc)[2][2][4][2], const pg8::Unit& u, int wr, int wc, int fr, int fq) const {
        const int row0 = u.pm * pg8::BM + wr * 64 + fr, col0 = u.pn * pg8::BM + wc * 32 + 8 * fq;
#pragma unroll
        for (int ai = 0; ai < 2; ++ai)
#pragma unroll
            for (int m = 0; m < 4; ++m) {
                const int row = row0 + ai * pg8::HALF + m * 16;
                bf16_t* rowp = O + (size_t)row * ldc + col0;
#pragma unroll
                for (int bj = 0; bj < 2; ++bj) {
                    const f32x4 v0 = acc[ai][bj][m][0], v1 = acc[ai][bj][m][1];
                    u32x4 wv; wv.x = pk2(v0[0], v0[1]); wv.y = pk2(v0[2], v0[3]); wv.z = pk2(v1[0], v1[1]); wv.w = pk2(v1[2], v1[3]);
                    *(u32x4*)(rowp + bj * pg8::HALF) = wv;
                    if (m == 3 && fr == 15) *(u32x4*)(bnd + (size_t)((row >> 6) + 1) * ldc + col0 + bj * pg8::HALF) = wv;
                }
            }
    }
};

__device__ void phase_norm0(const Params& p, unsigned char* lds) {
    const int tid = threadIdx.x, lane = tid & 63, w = tid >> 6, l15 = lane & 15, g = lane >> 4;
    const float* x = p.in[0];
    bf16_t* A = (bf16_t*)(p.ws + WS_A);
    bf16_t* AD = (bf16_t*)(p.ws + WS_AD);
    bf16_t* WAD = (bf16_t*)lds;
    float* PSS = (float*)(lds + 33024);
    float* PAD = (float*)(lds + 33024 + 512);
    for (int e = tid; e < 16384; e += NTH) { const int k = e >> 4, j = e & 15; WAD[j * 1032 + k] = f2bf(p.in[2][(size_t)k * GIN + 3072 + j] * p.in[1][k]); }
    __syncthreads();
    bf16x8 wf[4];
#pragma unroll
    for (int kk = 0; kk < 4; ++kk) wf[kk] = *(const bf16x8*)(WAD + l15 * 1032 + 128 * w + 32 * kk + 8 * g);
    float4 xa[4][2];
    int tile = blockIdx.x;
    if (tile < MTOK / 16) {
#pragma unroll
        for (int kk = 0; kk < 4; ++kk) { const float4* s = (const float4*)(x + (size_t)(16 * tile + l15) * DM + 128 * w + 32 * kk + 8 * g); xa[kk][0] = s[0]; xa[kk][1] = s[1]; }
    }
    for (; tile < MTOK / 16; tile += gridDim.x) {
        float4 xv[4][2];
#pragma unroll
        for (int kk = 0; kk < 4; ++kk) { xv[kk][0] = xa[kk][0]; xv[kk][1] = xa[kk][1]; }
        if (tile + (int)gridDim.x < MTOK / 16) {
#pragma unroll
            for (int kk = 0; kk < 4; ++kk) { const float4* s = (const float4*)(x + (size_t)(16 * (tile + gridDim.x) + l15) * DM + 128 * w + 32 * kk + 8 * g); xa[kk][0] = s[0]; xa[kk][1] = s[1]; }
        }
        float ss = 0.f;
        f32x4 acc = (f32x4){0.f, 0.f, 0.f, 0.f};
#pragma unroll
        for (int kk = 0; kk < 4; ++kk) {
            const float4 a = xv[kk][0], b = xv[kk][1];
            ss += a.x * a.x + a.y * a.y + a.z * a.z + a.w * a.w + b.x * b.x + b.y * b.y + b.z * b.z + b.w * b.w;
            acc = mfma16(as_bf16x8((u32x4){pk2(a.x, a.y), pk2(a.z, a.w), pk2(b.x, b.y), pk2(b.z, b.w)}), wf[kk], acc);
        }
        ss += __shfl_xor(ss, 16); ss += __shfl_xor(ss, 32);
        if (g == 0) PSS[w * 16 + l15] = ss;
        *(f32x4*)(PAD + (w * 64 + lane) * 4) = acc;
        __syncthreads();
        float tot = 0.f;
#pragma unroll
        for (int q = 0; q < 8; ++q) tot += PSS[q * 16 + l15];
        const float rstd = rsqrtf(tot * (1.0f / DM) + 1e-6f);
#pragma unroll
        for (int kk = 0; kk < 4; ++kk) {
            const float4 a = xv[kk][0], b = xv[kk][1];
            *(u32x4*)(A + (size_t)(16 * tile + l15) * DM + 128 * w + 32 * kk + 8 * g) = (u32x4){pk2(a.x * rstd, a.y * rstd), pk2(a.z * rstd, a.w * rstd), pk2(b.x * rstd, b.y * rstd), pk2(b.z * rstd, b.w * rstd)};
        }
        if (w == 0) {
            f32x4 s = (f32x4){0.f, 0.f, 0.f, 0.f};
#pragma unroll
            for (int q = 0; q < 8; ++q) s += *(const f32x4*)(PAD + (q * 64 + lane) * 4);
#pragma unroll
            for (int r = 0; r < 4; ++r) AD[(size_t)(16 * tile + 4 * g + r) * 16 + l15] = f2bf(s[r] * __shfl(rstd, 4 * g + r));
        }
        __syncthreads();
    }
}

__device__ void phase_norm1(const Params& p) {
    const int tid = threadIdx.x, lane = tid & 63, w = tid >> 6;
    const float* x = p.in[0];
    const float* gpost = p.in[7];
    const bf16_t* Y = (const bf16_t*)(p.ws + WS_Y);
    bf16_t* A = (bf16_t*)(p.ws + WS_A);
    float4 gp[4];
#pragma unroll
    for (int i = 0; i < 4; ++i) gp[i] = ((const float4*)gpost)[lane + 64 * i];
    for (int row = blockIdx.x * 8 + w; row < MTOK; row += gridDim.x * 8) {
        const float4* xr = (const float4*)(x + (size_t)row * DM);
        float4 v[4]; u32x2 yv[4];
#pragma unroll
        for (int i = 0; i < 4; ++i) { v[i] = xr[lane + 64 * i]; yv[i] = *(const u32x2*)(Y + (size_t)row * DM + 4 * (lane + 64 * i)); }
        float4 y[4];
        float ss = 0.f;
#pragma unroll
        for (int i = 0; i < 4; ++i) {
            y[i].x = bf2f(yv[i].x & 0xffffu); y[i].y = bf2f(yv[i].x >> 16); y[i].z = bf2f(yv[i].y & 0xffffu); y[i].w = bf2f(yv[i].y >> 16);
            ss += y[i].x * y[i].x + y[i].y * y[i].y + y[i].z * y[i].z + y[i].w * y[i].w;
        }
        ss = wave_sum(ss);
        const float rstdy = rsqrtf(ss * (1.0f / DM) + 1e-6f);
        float s1 = 0.f;
#pragma unroll
        for (int i = 0; i < 4; ++i) {
            v[i].x += y[i].x * rstdy * gp[i].x; v[i].y += y[i].y * rstdy * gp[i].y; v[i].z += y[i].z * rstdy * gp[i].z; v[i].w += y[i].w * rstdy * gp[i].w;
            s1 += v[i].x * v[i].x + v[i].y * v[i].y + v[i].z * v[i].z + v[i].w * v[i].w;
            ((float4*)(p.out + (size_t)row * DM))[lane + 64 * i] = v[i];
        }
        s1 = wave_sum(s1);
        const float rstd = rsqrtf(s1 * (1.0f / DM) + 1e-6f);
#pragma unroll
        for (int i = 0; i < 4; ++i) {
            u32x2 o; o.x = pk2(v[i].x * rstd, v[i].y * rstd); o.y = pk2(v[i].z * rstd, v[i].w * rstd);
            *(u32x2*)(A + (size_t)row * DM + 4 * (lane + 64 * i)) = o;
        }
    }
}

__device__ void phase_final(const Params& p) {
    const int tid = threadIdx.x, lane = tid & 63, w = tid >> 6;
    const float* gpost = p.in[21];
    const bf16_t* Y = (const bf16_t*)(p.ws + WS_Y);
    float4 gp[4];
#pragma unroll
    for (int i = 0; i < 4; ++i) gp[i] = ((const float4*)gpost)[lane + 64 * i];
    for (int row = blockIdx.x * 8 + w; row < MTOK; row += gridDim.x * 8) {
        float4* xr = (float4*)(p.out + (size_t)row * DM);
        float4 v[4]; u32x2 yv[4];
#pragma unroll
        for (int i = 0; i < 4; ++i) { v[i] = xr[lane + 64 * i]; yv[i] = *(const u32x2*)(Y + (size_t)row * DM + 4 * (lane + 64 * i)); }
        float4 y[4];
        float ss = 0.f;
#pragma unroll
        for (int i = 0; i < 4; ++i) {
            y[i].x = bf2f(yv[i].x & 0xffffu); y[i].y = bf2f(yv[i].x >> 16); y[i].z = bf2f(yv[i].y & 0xffffu); y[i].w = bf2f(yv[i].y >> 16);
            ss += y[i].x * y[i].x + y[i].y * y[i].y + y[i].z * y[i].z + y[i].w * y[i].w;
        }
        ss = wave_sum(ss);
        const float rstdy = rsqrtf(ss * (1.0f / DM) + 1e-6f);
#pragma unroll
        for (int i = 0; i < 4; ++i) {
            v[i].x += y[i].x * rstdy * gp[i].x; v[i].y += y[i].y * rstdy * gp[i].y; v[i].z += y[i].z * rstdy * gp[i].z; v[i].w += y[i].w * rstdy * gp[i].w;
            xr[lane + 64 * i] = v[i];
        }
    }
}

constexpr int L_BC = 0, L_ATT = 0, L_QD = 33792, L_KD = L_QD + 64 * 136 * 2, L_KTE = L_KD + 64 * 136 * 2, L_VI = L_KTE + 64 * 144 * 2, L_SSQ = L_VI + 64 * 272 * 2, L_BL = L_SSQ + 2048, L_DEC = L_BL + 512, L_ADL = L_DEC + 512,
              L_GLA_END = L_ADL + 2048;
static_assert(L_GLA_END <= LDS_BYTES, "GLA LDS");
#define GLA_BARRIER() do { asm volatile("s_waitcnt lgkmcnt(0)" ::: "memory"); __builtin_amdgcn_s_barrier(); asm volatile("" ::: "memory"); } while (0)
typedef short gs16x4 __attribute__((ext_vector_type(4)));
__device__ __forceinline__ u32x2 g_trread(const bf16_t* p) { union { gs16x4 s; u32x2 u; } x; x.s = __builtin_amdgcn_ds_read_tr16_b64_v4i16((__attribute__((address_space(3))) gs16x4*)p); return x.u; }
template <int PITCH> __device__ __forceinline__ bf16x8 g_trfrag(const bf16_t* img, int k0, int c0, int g, int q, int pq) {
    const bf16_t* a = img + (k0 + 8 * g + q) * PITCH + c0 + 4 * pq;
    const u32x2 lo = g_trread(a), hi = g_trread(a + 4 * PITCH);
    return as_bf16x8((u32x4){lo.x, lo.y, hi.x, hi.y});
}
__device__ __forceinline__ f32x4 g_lo4(u32x4 v) { return (f32x4){bf2f(v.x & 0xffffu), bf2f(v.x >> 16), bf2f(v.y & 0xffffu), bf2f(v.y >> 16)}; }
__device__ __forceinline__ f32x4 g_hi4(u32x4 v) { return (f32x4){bf2f(v.z & 0xffffu), bf2f(v.z >> 16), bf2f(v.w & 0xffffu), bf2f(v.w >> 16)}; }
__device__ __forceinline__ u32x2 g_pk4(f32x4 v) { u32x2 r; r.x = pk2(v[0], v[1]); r.y = pk2(v[2], v[3]); return r; }
__device__ __forceinline__ f32x4 g_unpk4(u32x2 v) { return (f32x4){bf2f(v.x & 0xffffu), bf2f(v.x >> 16), bf2f(v.y & 0xffffu), bf2f(v.y >> 16)}; }

template <bool OUT> struct GlaRaw { u32x4 q[2], k[2], v[4]; };
template <bool OUT> __device__ __forceinline__ void gla_issue(GlaRaw<OUT>& x, const char* cb  , unsigned offQ, unsigned offV) {
    if (OUT) { x.q[0] = *(const u32x4*)(cb + offQ); x.q[1] = *(const u32x4*)(cb + offQ + 16); }
    x.k[0] = *(const u32x4*)(cb + offQ + 1024); x.k[1] = *(const u32x4*)(cb + offQ + 1040);
#pragma unroll
    for (int i = 0; i < 4; ++i) x.v[i] = *(const u32x4*)(cb + offV + 16 * i);
}

template <bool OUT>
__device__ void gla_pass(const Params& p, unsigned char* lds) {
    const int tid = threadIdx.x, lane = tid & 63, w = __builtin_amdgcn_readfirstlane(tid >> 6), l15 = lane & 15, g = lane >> 4, q4 = l15 >> 2, p4 = l15 & 3;
    const bf16_t* P = (const bf16_t*)(p.ws + WS_P);
    float* GS = (float*)(p.ws + WS_GS);
    float* GD = (float*)(p.ws + WS_GD);
    bf16_t* Aout = (bf16_t*)(p.ws + WS_A);
    const bf16_t* WupT = (const bf16_t*)(p.ws + WS_WUPT);
    const bf16_t* ADG = (const bf16_t*)(p.ws + WS_AD);
    float* BC = (float*)(lds + L_BC); bf16_t* ATT = (bf16_t*)(lds + L_ATT); bf16_t* QD = (bf16_t*)(lds + L_QD); bf16_t* KD = (bf16_t*)(lds + L_KD); bf16_t* KTE = (bf16_t*)(lds + L_KTE);
    bf16_t* VI = (bf16_t*)(lds + L_VI); float* SSQ = (float*)(lds + L_SSQ); float* BL = (float*)(lds + L_BL); float* DEC = (float*)(lds + L_DEC); bf16_t* ADL = (bf16_t*)(lds + L_ADL);
    const float* b_al = p.in[4]; const float* g_head = p.in[5];
    const int c = tid >> 3, seg = tid & 7;

    for (int unit = blockIdx.x; unit < 256; unit += gridDim.x) {
        const int bh = unit >> 5, m = unit & 31, b = bh >> 2, h = bh & 3;
        const int tokbase = b * SEQ + m * 512;
        u32x4 wupq = *(const u32x4*)(WupT + (size_t)(h * 128 + 16 * w + l15) * 16 + 8 * (g & 1));
        if (g >= 2) wupq = (u32x4){0u, 0u, 0u, 0u};
        const bf16x8 wupf = as_bf16x8(wupq);
        const float bA = b_al[h * 128 + 16 * w + l15];
        float logD = 0.f;
        f32x4 S[8][2];
#pragma unroll
        for (int mt = 0; mt < 8; ++mt)
#pragma unroll
            for (int vt = 0; vt < 2; ++vt) {
                if (OUT) {
#pragma unroll
                    for (int r = 0; r < 4; ++r) S[mt][vt][r] = GS[((size_t)(bh * 32 + m) * 128 + 16 * mt + 4 * g + r) * 256 + 32 * w + 16 * vt + l15];
                } else S[mt][vt] = (f32x4){0.f, 0.f, 0.f, 0.f};
            }
        const unsigned offQ = (unsigned)((c * GIN_P + h * 128 + 16 * seg) * 2), offV = (unsigned)((c * GIN_P + 1024 + h * 256 + 32 * seg) * 2), offAD = (unsigned)(tid * 16);
        const unsigned offG = (unsigned)((l15 * GIN_P + 2048 + h * 256 + 32 * w + 4 * g) * 2), offO = (unsigned)((l15 * DM + h * 256 + 32 * w + 4 * g) * 2);
        GlaRaw<OUT> raw;
        gla_issue<OUT>(raw, (const char*)P + (size_t)tokbase * GIN_P * 2, offQ, offV);
        if (tid < 128) *(u32x4*)(ADL + tid * 8) = *(const u32x4*)((const char*)ADG + (size_t)tokbase * 32 + offAD);
        GLA_BARRIER();

        for (int ch = 0; ch < 8; ++ch) {
            const int tok0 = tokbase + ch * 64;
            u32x4 adn = (u32x4){0u, 0u, 0u, 0u};
            {
                float run = 0.f;
                if (ch < 7 && tid < 128) adn = *(const u32x4*)((const char*)ADG + (size_t)(tok0 + 64) * 32 + offAD);
#pragma unroll
                for (int ct = 0; ct < 4; ++ct) {
                    u32x4 aq = *(const u32x4*)(ADL + (16 * ct + l15) * 16 + 8 * (g & 1));
                    if (g >= 2) aq = (u32x4){0u, 0u, 0u, 0u};
                    const f32x4 z = mfma16(as_bf16x8(aq), wupf, (f32x4){bA, bA, bA, bA});
                    f32x4 sc;
                    float acc = 0.f;
#pragma unroll
                    for (int r = 0; r < 4; ++r) { acc += (fminf(z[r], 0.f) - __logf(1.f + __expf(-fabsf(z[r])))) * (1.0f / 16.0f); sc[r] = acc; }
                    float x = acc;
                    float y = __shfl_up(x, 16); if (g >= 1) x += y;
                    y = __shfl_up(x, 32); if (g >= 2) x += y;
                    const float base = run + (x - acc);
                    run += __shfl(x, 48 + l15);
#pragma unroll
                    for (int r = 0; r < 4; ++r) BC[(16 * ct + 4 * g + r) * 132 + 16 * w + l15] = base + sc[r];
                }
                if (g == 0) { BL[16 * w + l15] = run; DEC[16 * w + l15] = __expf(run); }
                if (!OUT) logD += run;
            }
            GLA_BARRIER();
            u32x2 gate[2][4];
            {
#pragma unroll
                for (int hh = 0; hh < 2; ++hh) {
                    const int o8 = 16 * seg + 8 * hh;
                    const f32x4 bb[2] = {*(const f32x4*)(BC + c * 132 + o8), *(const f32x4*)(BC + c * 132 + o8 + 4)};
                    const f32x4 dc[2] = {*(const f32x4*)(DEC + o8), *(const f32x4*)(DEC + o8 + 4)};
                    const f32x4 kx[2] = {g_lo4(raw.k[hh]), g_hi4(raw.k[hh])};
                    f32x4 qx[2];
                    if (OUT) { qx[0] = g_lo4(raw.q[hh]); qx[1] = g_hi4(raw.q[hh]); }
                    f32x4 kd[2], kt[2], qd[2];
#pragma unroll
                    for (int i = 0; i < 2; ++i)
#pragma unroll
                        for (int j = 0; j < 4; ++j) {
                            const float eB = __expf(bb[i][j]), enB = __builtin_amdgcn_rcpf(eB);
                            kd[i][j] = kx[i][j] * enB; kt[i][j] = kd[i][j] * dc[i][j];
                            if (OUT) qd[i][j] = qx[i][j] * 0.08838834764831845f * eB;
                        }
                    *(u32x4*)(KTE + c * 144 + o8) = (u32x4){pk2(kt[0][0], kt[0][1]), pk2(kt[0][2], kt[0][3]), pk2(kt[1][0], kt[1][1]), pk2(kt[1][2], kt[1][3])};
                    if (OUT) {
                        *(u32x4*)(KD + c * 136 + o8) = (u32x4){pk2(kd[0][0], kd[0][1]), pk2(kd[0][2], kd[0][3]), pk2(kd[1][0], kd[1][1]), pk2(kd[1][2], kd[1][3])};
                        *(u32x4*)(QD + c * 136 + o8) = (u32x4){pk2(qd[0][0], qd[0][1]), pk2(qd[0][2], qd[0][3]), pk2(qd[1][0], qd[1][1]), pk2(qd[1][2], qd[1][3])};
                    }
                }
#pragma unroll
                for (int i = 0; i < 4; ++i) *(u32x4*)(VI + c * 272 + 32 * seg + 8 * i) = raw.v[i];
                if (OUT) {
#pragma unroll
                    for (int vt = 0; vt < 2; ++vt)
#pragma unroll
                        for (int ct = 0; ct < 4; ++ct) gate[vt][ct] = *(const u32x2*)((const char*)P + (size_t)(tok0 + 16 * ct) * GIN_P * 2 + offG + 32 * vt);
                }
                if (ch < 7) gla_issue<OUT>(raw, (const char*)P + (size_t)(tok0 + 64) * GIN_P * 2, offQ, offV);
                if (ch < 7 && tid < 128) *(u32x4*)(ADL + tid * 8) = adn;
            }
            GLA_BARRIER();
            f32x4 o[2][4];
            if (OUT) {
#pragma unroll
                for (int t2 = 0; t2 < 2; ++t2) {
                    const int tl = 2 * w + t2, ct = tl >> 2, st = tl & 3;
                    f32x4 acc = (f32x4){0.f, 0.f, 0.f, 0.f};
                    if (st <= ct) {
#pragma unroll
                        for (int kk = 0; kk < 4; ++kk) {
                            const bf16x8 a = *(const bf16x8*)(KD + (16 * st + l15) * 136 + 32 * kk + 8 * g);
                            const bf16x8 bq = *(const bf16x8*)(QD + (16 * ct + l15) * 136 + 32 * kk + 8 * g);
                            acc = mfma16(a, bq, acc);
                        }
#pragma unroll
                        for (int r = 0; r < 4; ++r) if (16 * st + 4 * g + r > 16 * ct + l15) acc[r] = 0.f;
                    }
                    *(u32x2*)(ATT + (16 * ct + l15) * 72 + 16 * st + 4 * g) = g_pk4(acc);
                }
                GLA_BARRIER();
#pragma unroll
                for (int vt = 0; vt < 2; ++vt)
#pragma unroll
                    for (int ct = 0; ct < 4; ++ct) o[vt][ct] = (f32x4){0.f, 0.f, 0.f, 0.f};
#pragma unroll
                for (int kk = 0; kk < 4; ++kk) {
                    bf16x8 sa[2];
#pragma unroll
                    for (int vt = 0; vt < 2; ++vt) { const u32x2 s0 = g_pk4(S[2 * kk][vt]), s1 = g_pk4(S[2 * kk + 1][vt]); sa[vt] = as_bf16x8((u32x4){s0.x, s0.y, s1.x, s1.y}); }
#pragma unroll
                    for (int ct = 0; ct < 4; ++ct) {
                        const bf16_t* qr = QD + (16 * ct + l15) * 136 + 32 * kk + 4 * g;
                        const u32x2 lo = *(const u32x2*)qr, hi = *(const u32x2*)(qr + 16);
                        const bf16x8 bq = as_bf16x8((u32x4){lo.x, lo.y, hi.x, hi.y});
#pragma unroll
                        for (int vt = 0; vt < 2; ++vt) o[vt][ct] = mfma16(sa[vt], bq, o[vt][ct]);
                    }
                }
            }
            bf16x8 bv[2][2];
#pragma unroll
            for (int vt = 0; vt < 2; ++vt)
#pragma unroll
                for (int kk = 0; kk < 2; ++kk) bv[vt][kk] = g_trfrag<272>(VI, 32 * kk, 32 * w + 16 * vt, g, q4, p4);
            if (OUT) {
#pragma unroll
                for (int ct = 0; ct < 4; ++ct)
#pragma unroll
                    for (int kk = 0; kk < 2; ++kk) {
                        if (32 * kk <= 16 * ct + 15) {
                            const bf16x8 bq = *(const bf16x8*)(ATT + (16 * ct + l15) * 72 + 32 * kk + 8 * g);
#pragma unroll
                            for (int vt = 0; vt < 2; ++vt) o[vt][ct] = mfma16(bv[vt][kk], bq, o[vt][ct]);
                        }
                    }
            }
#pragma unroll
            for (int mt = 0; mt < 8; ++mt) {
                const f32x4 dv = *(const f32x4*)(DEC + 16 * mt + 4 * g);
#pragma unroll
                for (int vt = 0; vt < 2; ++vt) S[mt][vt] *= dv;
#pragma unroll
                for (int kk = 0; kk < 2; ++kk) {
                    const bf16x8 a = g_trfrag<144>(KTE, 32 * kk, 16 * mt, g, q4, p4);
#pragma unroll
                    for (int vt = 0; vt < 2; ++vt) S[mt][vt] = mfma16(a, bv[vt][kk], S[mt][vt]);
                }
            }
            if (OUT) {
                float ss[4];
#pragma unroll
                for (int ct = 0; ct < 4; ++ct) {
                    float s = 0.f;
#pragma unroll
                    for (int vt = 0; vt < 2; ++vt)
#pragma unroll
                        for (int r = 0; r < 4; ++r) s += o[vt][ct][r] * o[vt][ct][r];
                    s += __shfl_xor(s, 16); s += __shfl_xor(s, 32);
                    ss[ct] = s;
                }
                if (g == 0) {
#pragma unroll
                    for (int ct = 0; ct < 4; ++ct) SSQ[(16 * ct + l15) * 8 + w] = ss[ct];
                }
                f32x4 gh[2];
#pragma unroll
                for (int vt = 0; vt < 2; ++vt) gh[vt] = *(const f32x4*)(g_head + 32 * w + 16 * vt + 4 * g);
                GLA_BARRIER();
#pragma unroll
                for (int ct = 0; ct < 4; ++ct) {
                    const int cc = 16 * ct + l15;
                    const float4 s0 = *(const float4*)(SSQ + cc * 8), s1 = *(const float4*)(SSQ + cc * 8 + 4);
                    const float tot = (s0.x + s0.y) + (s0.z + s0.w) + (s1.x + s1.y) + (s1.z + s1.w);
                    const float rstd = rsqrtf(tot * (1.0f / 256.0f) + 1e-6f);
#pragma unroll
                    for (int vt = 0; vt < 2; ++vt) {
                        const f32x4 gt = g_unpk4(gate[vt][ct]);
                        f32x4 val;
#pragma unroll
                        for (int r = 0; r < 4; ++r) val[r] = o[vt][ct][r] * rstd * gh[vt][r] * gt[r] * __builtin_amdgcn_rcpf(1.0f + __expf(-gt[r]));
                        *(u32x2*)((char*)Aout + (size_t)(tok0 + 16 * ct) * DM * 2 + offO + 32 * vt) = g_pk4(val);
                    }
                }
            } else {
                GLA_BARRIER();
            }
        }
        if (!OUT) {
#pragma unroll
            for (int mt = 0; mt < 8; ++mt)
#pragma unroll
                for (int vt = 0; vt < 2; ++vt)
#pragma unroll
                    for (int r = 0; r < 4; ++r) GS[((size_t)(bh * 32 + m) * 128 + 16 * mt + 4 * g + r) * 256 + 32 * w + 16 * vt + l15] = S[mt][vt][r];
            if (g == 0) GD[(bh * 32 + m) * 128 + 16 * w + l15] = __expf(logD);
        }
        GLA_BARRIER();
    }
}

__device__ void gla_scan(const Params& p) {
    float* GS = (float*)(p.ws + WS_GS);
    const float* GD = (const float*)(p.ws + WS_GD);
    for (int idx = blockIdx.x * NTH + threadIdx.x; idx < 8 * 32768; idx += gridDim.x * NTH) {
        const int bh = idx >> 15, e = idx & 32767, d = e >> 8;
        float S = 0.f;
        for (int m0 = 0; m0 < 32; m0 += 16) {
            float t[16], dd[16];
#pragma unroll
            for (int m = 0; m < 16; ++m) { t[m] = GS[(size_t)(bh * 32 + m0 + m) * 32768 + e]; dd[m] = GD[(bh * 32 + m0 + m) * 128 + d]; }
#pragma unroll
            for (int m = 0; m < 16; ++m) { GS[(size_t)(bh * 32 + m0 + m) * 32768 + e] = S; S = S * dd[m] + t[m]; }
        }
    }
}

constexpr int PP = RIN_P;
constexpr size_t WS_RK  = WS_GS;
constexpr size_t WS_BND = WS_GS + (size_t)MTOK * 16 * 4;
static_assert(WS_BND + (size_t)513 * PP * 2 <= WS_GD, "RWKV side buffers must fit the GLA state region");
constexpr int IMG = 64 * 72 * 2;
constexpr int R_ALB = 0, R_BH = IMG, R_KH = 2 * IMG, R_RB = 3 * IMG, R_BTL = 4 * IMG, R_KTL = 5 * IMG, R_VI = 6 * IMG, R_AAB = 7 * IMG, R_AAK = 8 * IMG, R_ARB = 9 * IMG, R_ARK = 10 * IMG,
              R_DW = R_AAB, R_DA = R_AAB + 64 * 68 * 4, R_XT = 11 * IMG, R_TW = R_XT, R_ADI = R_XT + IMG, R_TDF = R_XT + 2 * IMG, R_CS = R_TDF + 2048, R_GC = R_CS + 2048, R_CONST = R_GC + 256,
              R_END = R_CONST + 2560;
static_assert(R_DA + 64 * 68 * 4 <= R_XT && R_END <= LDS_BYTES, "R1 LDS");
#define LDS_BARRIER() do { asm volatile("s_waitcnt lgkmcnt(0)" ::: "memory"); __builtin_amdgcn_s_barrier(); asm volatile("" ::: "memory"); } while (0)

typedef short s16x4 __attribute__((ext_vector_type(4)));
__device__ __forceinline__ bf16x8 ldfrag(const bf16_t* img, int row, int koff) { return *(const bf16x8*)(img + row * 72 + koff); }
__device__ __forceinline__ u32x2 pk4(f32x4 v) { u32x2 r; r.x = pk2(v[0], v[1]); r.y = pk2(v[2], v[3]); return r; }
__device__ __forceinline__ f32x4 unpk4(u32x2 v) { return (f32x4){bf2f(v.x & 0xffffu), bf2f(v.x >> 16), bf2f(v.y & 0xffffu), bf2f(v.y >> 16)}; }
__device__ __forceinline__ u32x2 trread(const bf16_t* p) {
    union { s16x4 s; u32x2 u; } x; x.s = __builtin_amdgcn_ds_read_tr16_b64_v4i16((__attribute__((address_space(3))) s16x4*)p); return x.u;
}
__device__ __forceinline__ bf16x8 trfrag(const bf16_t* img, int k0, int c0, int g, int q, int pq) {
    const bf16_t* a = img + (k0 + 8 * g + q) * 72 + c0 + 4 * pq;
    const u32x2 lo = trread(a), hi = trread(a + 4 * 72);
    return as_bf16x8((u32x4){lo.x, lo.y, hi.x, hi.y});
}
__device__ __forceinline__ f32x4 lo4(u32x4 v) { return (f32x4){bf2f(v.x & 0xffffu), bf2f(v.x >> 16), bf2f(v.y & 0xffffu), bf2f(v.y >> 16)}; }
__device__ __forceinline__ f32x4 hi4(u32x4 v) { return (f32x4){bf2f(v.z & 0xffffu), bf2f(v.z >> 16), bf2f(v.w & 0xffffu), bf2f(v.w >> 16)}; }
__device__ __forceinline__ u32x4 pk8(f32x4 a, f32x4 b) { return (u32x4){pk2(a[0], a[1]), pk2(a[2], a[3]), pk2(b[0], b[1]), pk2(b[2], b[3])}; }
__device__ __forceinline__ float fast_rcp(float x) { return __builtin_amdgcn_rcpf(x); }
__device__ __forceinline__ f32x4 mm16(f32x4 xa, f32x4 yb, f32x4 c) {
    const u32x2 a = pk4(xa), b = pk4(yb);
    return mfma16(as_bf16x8((u32x4){a.x, a.y, 0u, 0u}), as_bf16x8((u32x4){b.x, b.y, 0u, 0u}), c);
}

struct R1Raw { u32x4 r0, r1, k0, k1, v0, v1, w0, w1, a0, a1; };
__device__ __forceinline__ void r1_issue(R1Raw& x, const bf16_t* P, const bf16_t* BND, int unit, int t, int cs) {
    const int bn = unit >> 4, h = unit & 15;
    const bf16_t* cur = P + ((size_t)bn * 64 + t) * PP;
    const bf16_t* prv = (t > 0) ? (cur - PP) : (BND + (size_t)bn * PP);
    const int ch = h * 64 + 8 * cs;
    x.r0 = *(const u32x4*)(cur + ch); x.k0 = *(const u32x4*)(cur + 1024 + ch); x.v0 = *(const u32x4*)(cur + 2048 + ch); x.w0 = *(const u32x4*)(cur + 4096 + 8 * cs); x.a0 = *(const u32x4*)(cur + 4160 + 8 * cs);
    x.r1 = *(const u32x4*)(prv + ch); x.k1 = *(const u32x4*)(prv + 1024 + ch); x.v1 = *(const u32x4*)(prv + 2048 + ch); x.w1 = *(const u32x4*)(prv + 4096 + 8 * cs); x.a1 = *(const u32x4*)(prv + 4160 + 8 * cs);
}
__device__ __forceinline__ void lerp8(u32x4 c, u32x4 pv, bool zprev, const float* mu8, f32x4& o0, f32x4& o1) {
    const f32x4 c0 = lo4(c), c1 = hi4(c);
    f32x4 p0 = lo4(pv), p1 = hi4(pv);
    if (zprev) { p0 = (f32x4){0.f, 0.f, 0.f, 0.f}; p1 = p0; }
    const f32x4 m0 = *(const f32x4*)mu8, m1 = *(const f32x4*)(mu8 + 4);
    o0 = c0 + m0 * (p0 - c0); o1 = c1 + m1 * (p1 - c1);
}

__device__ void rwkv_r1(const Params& p, unsigned char* lds) {
    const int tid = threadIdx.x, lane = tid & 63, w = __builtin_amdgcn_readfirstlane(tid >> 6), l15 = lane & 15, g = lane >> 4, q4 = l15 >> 2, p4 = l15 & 3;
    bf16_t* P = (bf16_t*)(p.ws + WS_P);
    bf16_t* Abuf = (bf16_t*)(p.ws + WS_A);
    bf16_t* Ybuf = (bf16_t*)(p.ws + WS_Y);
    float* RK = (float*)(p.ws + WS_RK);
    const bf16_t* BND = (const bf16_t*)(p.ws + WS_BND);
    const bf16_t* WduT = (const bf16_t*)(p.ws + WS_WDUT);
    const bf16_t* WiuT = (const bf16_t*)(p.ws + WS_WIUT);
    bf16_t* ALB = (bf16_t*)(lds + R_ALB); bf16_t* BH = (bf16_t*)(lds + R_BH); bf16_t* KH = (bf16_t*)(lds + R_KH); bf16_t* RB = (bf16_t*)(lds + R_RB);
    bf16_t* BTL = (bf16_t*)(lds + R_BTL); bf16_t* KTL = (bf16_t*)(lds + R_KTL); bf16_t* VI = (bf16_t*)(lds + R_VI);
    bf16_t* AAB = (bf16_t*)(lds + R_AAB); bf16_t* AAK = (bf16_t*)(lds + R_AAK); bf16_t* ARB = (bf16_t*)(lds + R_ARB); bf16_t* ARK = (bf16_t*)(lds + R_ARK);
    float* DW = (float*)(lds + R_DW); float* DA = (float*)(lds + R_DA);
    bf16_t* XT = (bf16_t*)(lds + R_XT); bf16_t* TW = (bf16_t*)(lds + R_TW); bf16_t* ADI = (bf16_t*)(lds + R_ADI);
    u32x2* TDF = (u32x2*)(lds + R_TDF); float* CS = (float*)(lds + R_CS); float* GCs = (float*)(lds + R_GC); float* CONST = (float*)(lds + R_CONST);
    const int t = tid >> 3, cs = tid & 7, tl = lane >> 3;
    int hprev = -1;
    R1Raw raw;
    if (blockIdx.x < 8192) r1_issue(raw, P, BND, blockIdx.x, t, cs);

    for (int unit = blockIdx.x; unit < 8192; unit += gridDim.x) {
        const int bn = unit >> 4, h = unit & 15, n = bn & 255;
        const size_t R0 = (size_t)bn * 64;
        if (h != hprev) {
            LDS_BARRIER();
            if (tid < 64) {
                const int ch = h * 64 + tid;
                CONST[tid] = p.in[10][ch]; CONST[64 + tid] = p.in[10][1024 + ch]; CONST[128 + tid] = p.in[10][2048 + ch];
                CONST[192 + tid] = p.in[11][ch]; CONST[256 + tid] = p.in[13][ch]; CONST[320 + tid] = p.in[15][ch]; CONST[384 + tid] = p.in[16][ch]; CONST[448 + tid] = p.in[17][ch];
                CONST[512 + tid] = p.in[10][4096 + tid]; CONST[576 + tid] = p.in[10][4160 + tid];
            }
            hprev = h;
            LDS_BARRIER();
        }
        bf16x8 fwd[2][2], fwi[2][2];
#pragma unroll
        for (int q = 0; q < 2; ++q)
#pragma unroll
            for (int kk = 0; kk < 2; ++kk) {
                const size_t o = (size_t)(h * 64 + 16 * (2 * (w >> 2) + q) + l15) * 64 + 32 * kk + 8 * g;
                fwd[q][kk] = *(const bf16x8*)(WduT + o); fwi[q][kk] = *(const bf16x8*)(WiuT + o);
            }
        f32x4 r0, r1, k0, k1, v0, v1;
        {
            const bool zp = (t == 0 && n == 0);
            f32x4 wd0, wd1, ad0, ad1;
            lerp8(raw.r0, raw.r1, zp, CONST + 8 * cs, r0, r1);
            lerp8(raw.k0, raw.k1, zp, CONST + 64 + 8 * cs, k0, k1);
            lerp8(raw.v0, raw.v1, zp, CONST + 128 + 8 * cs, v0, v1);
            lerp8(raw.w0, raw.w1, zp, CONST + 512 + 8 * cs, wd0, wd1);
            lerp8(raw.a0, raw.a1, zp, CONST + 576 + 8 * cs, ad0, ad1);
#pragma unroll
            for (int j = 0; j < 4; ++j) {
                const float e0 = __expf(-2.f * fabsf(wd0[j])), e1 = __expf(-2.f * fabsf(wd1[j]));
                wd0[j] = copysignf((1.f - e0) * fast_rcp(1.f + e0), wd0[j]); wd1[j] = copysignf((1.f - e1) * fast_rcp(1.f + e1), wd1[j]);
            }
            *(u32x4*)(TW + t * 72 + 8 * cs) = pk8(wd0, wd1);
            *(u32x4*)(ADI + t * 72 + 8 * cs) = pk8(ad0, ad1);
        }
        if (unit + (int)gridDim.x < 8192) r1_issue(raw, P, BND, unit + gridDim.x, t, cs);
        LDS_BARRIER();
        {
            const int tt = w & 3;
            bf16x8 ft[2], fa[2];
#pragma unroll
            for (int kk = 0; kk < 2; ++kk) { ft[kk] = ldfrag(TW, 16 * tt + l15, 32 * kk + 8 * g); fa[kk] = ldfrag(ADI, 16 * tt + l15, 32 * kk + 8 * g); }
#pragma unroll
            for (int q = 0; q < 2; ++q) {
                const int ct = 2 * (w >> 2) + q;
                f32x4 aw = (f32x4){0.f, 0.f, 0.f, 0.f}, aa = aw;
#pragma unroll
                for (int kk = 0; kk < 2; ++kk) { aw = mfma16(fwd[q][kk], ft[kk], aw); aa = mfma16(fwi[q][kk], fa[kk], aa); }
                *(f32x4*)(DW + (16 * tt + l15) * 68 + 16 * ct + 4 * g) = aw;
                *(f32x4*)(DA + (16 * tt + l15) * 68 + 16 * ct + 4 * g) = aa;
            }
        }
        LDS_BARRIER();
        f32x4 lw[2], av[2], kk[2], k2[2], G[2];
        {
            const f32x4 cw0[2] = {*(const f32x4*)(CONST + 192 + 8 * cs), *(const f32x4*)(CONST + 196 + 8 * cs)};
            const f32x4 ca0[2] = {*(const f32x4*)(CONST + 256 + 8 * cs), *(const f32x4*)(CONST + 260 + 8 * cs)};
            const f32x4 ckk[2] = {*(const f32x4*)(CONST + 320 + 8 * cs), *(const f32x4*)(CONST + 324 + 8 * cs)};
            const f32x4 cka[2] = {*(const f32x4*)(CONST + 384 + 8 * cs), *(const f32x4*)(CONST + 388 + 8 * cs)};
            const f32x4 crk[2] = {*(const f32x4*)(CONST + 448 + 8 * cs), *(const f32x4*)(CONST + 452 + 8 * cs)};
            const f32x4 dwv[2] = {*(const f32x4*)(DW + t * 68 + 8 * cs), *(const f32x4*)(DW + t * 68 + 8 * cs + 4)};
            const f32x4 dav[2] = {*(const f32x4*)(DA + t * 68 + 8 * cs), *(const f32x4*)(DA + t * 68 + 8 * cs + 4)};
            const f32x4 kin[2] = {k0, k1}, rin[2] = {r0, r1};
            float n2 = 0.f, rk = 0.f;
#pragma unroll
            for (int hf = 0; hf < 2; ++hf)
#pragma unroll
                for (int j = 0; j < 4; ++j) {
                    const float z = -(cw0[hf][j] + dwv[hf][j]);
                    const float sp = fmaxf(z, 0.f) + __logf(1.f + __expf(-fabsf(z)));
                    lw[hf][j] = -__expf(-sp - 0.5f);
                    av[hf][j] = fast_rcp(1.f + __expf(-(ca0[hf][j] + dav[hf][j])));
                    kk[hf][j] = kin[hf][j] * ckk[hf][j];
                    k2[hf][j] = kin[hf][j] * (1.f + (av[hf][j] - 1.f) * cka[hf][j]);
                    n2 += kk[hf][j] * kk[hf][j]; rk += rin[hf][j] * k2[hf][j] * crk[hf][j];
                }
            n2 += __shfl_xor(n2, 1); rk += __shfl_xor(rk, 1); n2 += __shfl_xor(n2, 2); rk += __shfl_xor(rk, 2); n2 += __shfl_xor(n2, 4); rk += __shfl_xor(rk, 4);
            const float inv = 1.0f / fmaxf(sqrtf(n2), 1e-12f);
            kk[0] *= inv; kk[1] *= inv;
            if (cs == 0) RK[(R0 + t) * 16 + h] = rk;
            G[0] = lw[0]; G[1] = lw[1];
#pragma unroll
            for (int d = 1; d < 8; d <<= 1)
#pragma unroll
                for (int hf = 0; hf < 2; ++hf)
#pragma unroll
                    for (int j = 0; j < 4; ++j) { const float y = __shfl_up(G[hf][j], 8 * d); if (tl >= d) G[hf][j] += y; }
            if (tl == 7) { *(f32x4*)(CS + w * 64 + 8 * cs) = G[0]; *(f32x4*)(CS + w * 64 + 8 * cs + 4) = G[1]; }
        }
        LDS_BARRIER();
        {
            f32x4 off[2] = {(f32x4){0.f, 0.f, 0.f, 0.f}, (f32x4){0.f, 0.f, 0.f, 0.f}}, gc[2] = {off[0], off[0]};
#pragma unroll
            for (int q = 0; q < 8; ++q) {
                const f32x4 c0 = *(const f32x4*)(CS + q * 64 + 8 * cs), c1 = *(const f32x4*)(CS + q * 64 + 8 * cs + 4);
                gc[0] += c0; gc[1] += c1;
                if (q < w) { off[0] += c0; off[1] += c1; }
            }
            f32x4 al[2], bh[2], kh[2], rb[2], bt[2], kt[2];
            const f32x4 rin[2] = {r0, r1};
#pragma unroll
            for (int hf = 0; hf < 2; ++hf)
#pragma unroll
                for (int j = 0; j < 4; ++j) {
                    const float Gi = G[hf][j] + off[hf][j];
                    const float eG = __expf(Gi), eGm = __expf(Gi - lw[hf][j]), enG = fast_rcp(eG), eC = __expf(gc[hf][j] - Gi);
                    const float be = kk[hf][j] * av[hf][j];
                    al[hf][j] = -kk[hf][j] * eGm; bh[hf][j] = be * enG; kh[hf][j] = k2[hf][j] * enG; rb[hf][j] = rin[hf][j] * eG; bt[hf][j] = be * eC; kt[hf][j] = k2[hf][j] * eC;
                }
            const int o = t * 72 + 8 * cs;
            *(u32x4*)(ALB + o) = pk8(al[0], al[1]); *(u32x4*)(BH + o) = pk8(bh[0], bh[1]); *(u32x4*)(KH + o) = pk8(kh[0], kh[1]); *(u32x4*)(RB + o) = pk8(rb[0], rb[1]);
            *(u32x4*)(BTL + o) = pk8(bt[0], bt[1]); *(u32x4*)(KTL + o) = pk8(kt[0], kt[1]);
            const u32x4 vpk = pk8(v0, v1);
            *(u32x4*)(VI + o) = vpk;
            *(u32x4*)(Ybuf + (R0 + t) * DM + h * 64 + 8 * cs) = vpk;
            if (w == 0 && tl == 0) { f32x4 e0, e1;
#pragma unroll
                for (int j = 0; j < 4; ++j) { e0[j] = __expf(gc[0][j]); e1[j] = __expf(gc[1][j]); }
                *(f32x4*)(GCs + 8 * cs) = e0; *(f32x4*)(GCs + 8 * cs + 4) = e1; }
        }
        LDS_BARRIER();
        {
            int ntile = 1, tta = 0, sta = 0, ttb = 0, stb = 0;
            if (w == 0) { tta = 0; sta = 0; } else if (w == 2) { tta = 1; sta = 1; } else if (w == 5) { tta = 2; sta = 2; } else if (w == 7) { tta = 3; sta = 3; }
            else if (w == 1) { ntile = 2; tta = 1; sta = 0; ttb = 2; stb = 0; } else if (w == 3) { ntile = 2; tta = 2; sta = 1; ttb = 3; stb = 0; }
            else if (w == 4) { tta = 3; sta = 1; } else { tta = 3; sta = 2; }
            for (int it = 0; it < ntile; ++it) {
                const int tt = it ? ttb : tta, st = it ? stb : sta;
                f32x4 cab = (f32x4){0.f, 0.f, 0.f, 0.f}, cak = cab, crb = cab, crk = cab, nab = cab;
#pragma unroll
                for (int kq = 0; kq < 2; ++kq) {
                    const bf16x8 fb = ldfrag(BH, 16 * st + l15, 32 * kq + 8 * g), fk = ldfrag(KH, 16 * st + l15, 32 * kq + 8 * g);
                    const bf16x8 fa = ldfrag(ALB, 16 * tt + l15, 32 * kq + 8 * g), fr = ldfrag(RB, 16 * tt + l15, 32 * kq + 8 * g);
                    cab = mfma16(fb, fa, cab); cak = mfma16(fk, fa, cak); crb = mfma16(fb, fr, crb); crk = mfma16(fk, fr, crk);
                    if (tt == st) nab = mfma16(fa, fb, nab);
                }
                if (tt == st) {
#pragma unroll
                    for (int r = 0; r < 4; ++r) {
                        const int s = 4 * g + r, tq = l15;
                        if (s >= tq) { cab[r] = 0.f; cak[r] = 0.f; }
                        if (s > tq) { crb[r] = 0.f; crk[r] = 0.f; }
                        if (l15 >= 4 * g + r) nab[r] = 0.f;
                    }
                }
                const int o = (16 * tt + l15) * 72 + 16 * st + 4 * g;
                *(u32x2*)(AAB + o) = pk4(cab); *(u32x2*)(AAK + o) = pk4(cak); *(u32x2*)(ARB + o) = pk4(crb); *(u32x2*)(ARK + o) = pk4(crk);
                if (tt == st) {
                    const f32x4 z = (f32x4){0.f, 0.f, 0.f, 0.f};
                    const f32x4 Q1 = cab, N1 = nab;
                    const f32x4 Q2 = mm16(N1, Q1, z), N2 = mm16(Q1, N1, z);
                    f32x4 Pm = Q1;
#pragma unroll
                    for (int r = 0; r < 4; ++r) if (4 * g + r == l15) Pm[r] += 1.f;
                    Pm = mm16(N2, Pm, Pm);
                    const f32x4 Q4 = mm16(N2, Q2, z), N4 = mm16(Q2, N2, z);
                    Pm = mm16(N4, Pm, Pm);
                    const f32x4 N8 = mm16(Q4, N4, z);
                    Pm = mm16(N8, Pm, Pm);
                    TDF[tt * 64 + lane] = pk4(Pm);
                }
            }
            if (w == 4 || w == 6) {
                const int tt = (w == 4) ? 0 : 2, st = tt + 1;
                const int o = (16 * tt + l15) * 72 + 16 * st + 4 * g;
                const u32x2 zz = (u32x2){0u, 0u};
                *(u32x2*)(AAK + o) = zz; *(u32x2*)(ARB + o) = zz; *(u32x2*)(ARK + o) = zz;
            }
        }
        LDS_BARRIER();
        {
            u32x2 xb[4];
            const int col = 16 * w + l15;
            bf16x8 vfr[2];
            if (w >= 4) { vfr[0] = trfrag(VI, 0, 16 * (w - 4), g, q4, p4); vfr[1] = trfrag(VI, 32, 16 * (w - 4), g, q4, p4); }
#pragma unroll
            for (int i = 0; i < 4; ++i) {
                f32x4 z;
                if (w < 4) z = unpk4(trread(ALB + (16 * i + 4 * g + q4) * 72 + 16 * w + 4 * p4));
                else {
                    z = mfma16(ldfrag(AAK, 16 * i + l15, 8 * g), vfr[0], (f32x4){0.f, 0.f, 0.f, 0.f});
                    if (i >= 2) z = mfma16(ldfrag(AAK, 16 * i + l15, 32 + 8 * g), vfr[1], z);
                }
                if (i >= 1) {
                    const bf16_t* ar = AAB + (16 * i + l15) * 72 + 4 * g;
                    const u32x2 a0 = *(const u32x2*)ar;
                    u32x2 a1 = (u32x2){0u, 0u}, b1 = (u32x2){0u, 0u};
                    if (i >= 2) { a1 = *(const u32x2*)(ar + 16); b1 = xb[1]; }
                    z = mfma16(as_bf16x8((u32x4){a0.x, a0.y, a1.x, a1.y}), as_bf16x8((u32x4){xb[0].x, xb[0].y, b1.x, b1.y}), z);
                    if (i == 3) {
                        const u32x2 a2 = *(const u32x2*)(ar + 32);
                        z = mfma16(as_bf16x8((u32x4){a2.x, a2.y, 0u, 0u}), as_bf16x8((u32x4){xb[2].x, xb[2].y, 0u, 0u}), z);
                    }
                }
                const u32x2 tq = TDF[i * 64 + lane];
                const u32x2 zq = pk4(z);
                const f32x4 x = mfma16(as_bf16x8((u32x4){tq.x, tq.y, 0u, 0u}), as_bf16x8((u32x4){zq.x, zq.y, 0u, 0u}), (f32x4){0.f, 0.f, 0.f, 0.f});
                xb[i] = pk4(x);
                *(u32x2*)(XT + col * 72 + 16 * i + 4 * g) = xb[i];
            }
        }
        LDS_BARRIER();
        {
            const int rt_ = w & 3, c0 = 2 * (w >> 2);
            bf16x8 xw[2], xu[2], fbt[2], fkt[2], fvr[2];
#pragma unroll
            for (int kq = 0; kq < 2; ++kq) {
                xw[kq] = ldfrag(XT, 16 * rt_ + l15, 32 * kq + 8 * g);
                xu[kq] = ldfrag(XT, 64 + 16 * rt_ + l15, 32 * kq + 8 * g);
                fbt[kq] = trfrag(BTL, 32 * kq, 16 * rt_, g, q4, p4);
                fkt[kq] = trfrag(KTL, 32 * kq, 16 * rt_, g, q4, p4);
                fvr[kq] = trfrag(VI, 32 * kq, 16 * rt_, g, q4, p4);
            }
            const float gcd0 = GCs[16 * c0 + l15], gcd1 = GCs[16 * c0 + 16 + l15];
#pragma unroll
            for (int q = 0; q < 2; ++q) {
                bf16x8 gbt[2], garb[2], gxu[2], gvi[2], gark[2];
#pragma unroll
                for (int kq = 0; kq < 2; ++kq) {
                    gbt[kq] = trfrag(BTL, 32 * kq, 16 * (c0 + q), g, q4, p4);
                    garb[kq] = ldfrag(ARB, 16 * (c0 + q) + l15, 32 * kq + 8 * g);
                    gxu[kq] = ldfrag(XT, 64 + 16 * (c0 + q) + l15, 32 * kq + 8 * g);
                    gvi[kq] = trfrag(VI, 32 * kq, 16 * (c0 + q), g, q4, p4);
                    gark[kq] = ldfrag(ARK, 16 * (c0 + q) + l15, 32 * kq + 8 * g);
                }
                const u32x2 rbi = *(const u32x2*)(RB + (16 * (c0 + q) + l15) * 72 + 16 * rt_ + 4 * g);
                __builtin_amdgcn_sched_barrier(0);
                const int ctile = c0 + q;
                {
                    f32x4 acc = (f32x4){0.f, 0.f, 0.f, 0.f};
#pragma unroll
                    for (int kq = 0; kq < 2; ++kq) acc = mfma16(xw[kq], gbt[kq], acc);
                    const int dcol = 16 * ctile + l15;
                    if (rt_ == ctile) {
                        const float gc = q ? gcd1 : gcd0;
#pragma unroll
                        for (int r = 0; r < 4; ++r) if (4 * g + r == l15) acc[r] += gc;
                    }
                    *(u32x2*)(ALB + dcol * 72 + 32 * (rt_ >> 1) + 8 * g + 4 * (rt_ & 1)) = pk4(acc);
                }
                {
                    f32x4 acc = unpk4(rbi);
#pragma unroll
                    for (int kq = 0; kq < 2; ++kq) {
                        if (32 * kq <= 16 * ctile + 15) acc = mfma16(xw[kq], garb[kq], acc);
                    }
                    *(u32x2*)(BH + (16 * ctile + l15) * 72 + 16 * rt_ + 4 * g) = pk4(acc);
                }
                {
                    f32x4 acc = (f32x4){0.f, 0.f, 0.f, 0.f};
#pragma unroll
                    for (int kq = 0; kq < 2; ++kq) { acc = mfma16(fbt[kq], gxu[kq], acc); acc = mfma16(fkt[kq], gvi[kq], acc); }
                    *(u32x2*)(KH + (16 * ctile + l15) * 72 + 16 * rt_ + 4 * g) = pk4(acc);
                }
                {
                    f32x4 acc = (f32x4){0.f, 0.f, 0.f, 0.f};
#pragma unroll
                    for (int kq = 0; kq < 2; ++kq) {
                        if (32 * kq <= 16 * ctile + 15) { acc = mfma16(xu[kq], garb[kq], acc); acc = mfma16(fvr[kq], gark[kq], acc); }
                    }
                    *(u32x2*)(AAB + (16 * ctile + l15) * 72 + 16 * rt_ + 4 * g) = pk4(acc);
                }
            }
        }
        LDS_BARRIER();
        {
            const int o = t * 72 + 8 * cs;
            *(u32x4*)(P + (R0 + t) * PP + h * 64 + 8 * cs) = *(const u32x4*)(ALB + o);
            *(u32x4*)(P + (R0 + t) * PP + 1024 + h * 64 + 8 * cs) = *(const u32x4*)(BH + o);
            *(u32x4*)(P + (R0 + t) * PP + 2048 + h * 64 + 8 * cs) = *(const u32x4*)(KH + o);
            *(u32x4*)(Abuf + (R0 + t) * DM + h * 64 + 8 * cs) = *(const u32x4*)(AAB + o);
        }
    }
}

constexpr int SC_SLOT = 2 * IMG;
constexpr size_t WS_MG = (WS_BND + (size_t)513 * PP * 2 + 255) & ~(size_t)255;
constexpr size_t WS_NG = WS_MG + (size_t)1024 * 4096 * 2;
constexpr size_t WS_HG = WS_NG + (size_t)1024 * 4096 * 2;
static_assert(WS_HG + (size_t)1024 * 4096 * 2 <= WS_GD, "scan buffers must fit the GLA state region");

template <int MODE>
__device__ void rwkv_scan2(const Params& p, unsigned char* lds) {
    constexpr int SPU = (MODE == 2) ? 32 : 8;
    constexpr int NU = (MODE == 2) ? 32 : 1024;
    const int tid = threadIdx.x, lane = tid & 63, w = __builtin_amdgcn_readfirstlane(tid >> 6), l15 = lane & 15, g = lane >> 4;
    bf16_t* P = (bf16_t*)(p.ws + WS_P);
    bf16_t* MG = (bf16_t*)(p.ws + WS_MG); bf16_t* NG = (bf16_t*)(p.ws + WS_NG); bf16_t* HG = (bf16_t*)(p.ws + WS_HG);
    const int G = gridDim.x;
    const int nun = ((int)blockIdx.x < NU) ? (NU - 1 - (int)blockIdx.x) / G + 1 : 0;
    const int T = nun * SPU;
    if (T == 0) return;
#define SC_SRC(s, p0, p1, pitchb) \
    const int u_ = (int)blockIdx.x + G * ((s) / SPU), j_ = (s) % SPU; \
    const char* p0; const char* p1; unsigned pitchb; \
    if (MODE == 2) { p0 = (const char*)(MG + (size_t)(u_ * 32 + j_) * 4096); p1 = (const char*)(NG + (size_t)(u_ * 32 + j_) * 4096); pitchb = 128u; } \
    else { const int bh_ = u_ >> 5, n_ = 8 * (u_ & 31) + j_; p0 = (const char*)(P + ((size_t)(bh_ >> 4) * SEQ + (size_t)n_ * 64) * PP + (bh_ & 15) * 64); p1 = p0 + 4096; pitchb = (unsigned)(PP * 2); }
    if (w >= 4) {
        const int lj = w - 4;
        const unsigned loff = (unsigned)((lane >> 3) * 144 + (lane & 7) * 16);
        u32x4 ld0[16], ld1[16];
#define SC_ISSUE(dst, s) do { const int sc_ = ((s) < T) ? (s) : T - 1; SC_SRC(sc_, q0_, q1_, pb_) const unsigned go_ = (unsigned)(lane >> 3) * pb_ + (unsigned)(lane & 7) * 16u; \
        _Pragma("unroll") for (int q = 0; q < 16; ++q) dst[q] = *(const u32x4*)(((q >> 3) ? q1_ : q0_) + (size_t)((q & 7) * 8) * pb_ + go_); } while (0)
#define SC_RETIRE(src, s) do { unsigned char* sb = lds + ((s) & 1) * SC_SLOT + loff; _Pragma("unroll") for (int q = 0; q < 16; ++q) \
        *(u32x4*)(sb + (q >> 3) * IMG + (q & 7) * 8 * 144) = src[q]; } while (0)
        SC_ISSUE(ld0, lj); SC_ISSUE(ld1, lj + 4);
        for (int it = 0; it < T / 8; ++it) {
            const int c0 = lj + 8 * it;
            for (int k = 0; k < lj; ++k) LDS_BARRIER();
            SC_RETIRE(ld0, c0); SC_ISSUE(ld0, c0 + 8);
            for (int k = 0; k < 4; ++k) LDS_BARRIER();
            SC_RETIRE(ld1, c0 + 4); SC_ISSUE(ld1, c0 + 12);
            for (int k = 0; k < 4 - lj; ++k) LDS_BARRIER();
        }
        LDS_BARRIER();
#undef SC_ISSUE
#undef SC_RETIRE
    } else {
        f32x4 H[4], Mg[4];
        for (int i = 0; i <= T; ++i) {
            if (i >= 1) {
                const int s = i - 1, u = (int)blockIdx.x + G * (s / SPU), j = s % SPU;
                const unsigned char* sb = lds + (s & 1) * SC_SLOT;
                const bf16_t* MT = (const bf16_t*)sb; const bf16_t* NT = (const bf16_t*)(sb + IMG);
                if (j == 0) {
                    if (MODE == 3) {
#pragma unroll
                        for (int mt = 0; mt < 4; ++mt) H[mt] = unpk4(*(const u32x2*)(HG + (size_t)u * 4096 + (16 * w + l15) * 64 + 16 * mt + 4 * g));
                    } else {
#pragma unroll
                        for (int mt = 0; mt < 4; ++mt) H[mt] = (f32x4){0.f, 0.f, 0.f, 0.f};
                    }
                    if (MODE == 1) {
#pragma unroll
                        for (int mt = 0; mt < 4; ++mt)
#pragma unroll
                            for (int r = 0; r < 4; ++r) Mg[mt][r] = (16 * mt + 4 * g + r == 16 * w + l15) ? 1.f : 0.f;
                    }
                }
                u32x2 hp[4];
#pragma unroll
                for (int mt = 0; mt < 4; ++mt) hp[mt] = pk4(H[mt]);
                if (MODE == 2) {
#pragma unroll
                    for (int mt = 0; mt < 4; ++mt) *(u32x2*)(HG + (size_t)(u * 32 + j) * 4096 + (16 * w + l15) * 64 + 16 * mt + 4 * g) = hp[mt];
                }
                if (MODE == 3) {
                    const int bh = u >> 5, n = 8 * (u & 31) + j;
#pragma unroll
                    for (int mt = 0; mt < 4; ++mt) *(u32x2*)(P + ((size_t)(bh >> 4) * SEQ + (size_t)n * 64 + 16 * w + l15) * PP + 2048 + (bh & 15) * 64 + 16 * mt + 4 * g) = hp[mt];
                }
                bf16x8 hb[2], mb[2];
                hb[0] = as_bf16x8((u32x4){hp[0].x, hp[0].y, hp[1].x, hp[1].y});
                hb[1] = as_bf16x8((u32x4){hp[2].x, hp[2].y, hp[3].x, hp[3].y});
                if (MODE == 1) {
                    const u32x2 m0 = pk4(Mg[0]), m1 = pk4(Mg[1]), m2 = pk4(Mg[2]), m3 = pk4(Mg[3]);
                    mb[0] = as_bf16x8((u32x4){m0.x, m0.y, m1.x, m1.y}); mb[1] = as_bf16x8((u32x4){m2.x, m2.y, m3.x, m3.y});
                }
#pragma unroll
                for (int mt = 0; mt < 4; ++mt) {
                    const bf16x8 a0 = ldfrag(MT, 16 * mt + l15, 8 * g), a1 = ldfrag(MT, 16 * mt + l15, 32 + 8 * g);
                    f32x4 acc = unpk4(*(const u32x2*)(NT + (16 * w + l15) * 72 + 16 * mt + 4 * g));
                    acc = mfma16(a0, hb[0], acc); acc = mfma16(a1, hb[1], acc);
                    H[mt] = acc;
                    if (MODE == 1) { f32x4 am = mfma16(a0, mb[0], (f32x4){0.f, 0.f, 0.f, 0.f}); am = mfma16(a1, mb[1], am); Mg[mt] = am; }
                }
                if (MODE == 1 && j == SPU - 1) {
                    const int pc = 32 * (w >> 1) + 8 * (l15 >> 2) + 4 * (w & 1) + (l15 & 3);
#pragma unroll
                    for (int mt = 0; mt < 4; ++mt) {
                        *(u32x2*)(NG + (size_t)u * 4096 + (16 * w + l15) * 64 + 16 * mt + 4 * g) = pk4(H[mt]);
#pragma unroll
                        for (int r = 0; r < 4; ++r) MG[(size_t)u * 4096 + (16 * mt + 4 * g + r) * 64 + pc] = f2bf(Mg[mt][r]);
                    }
                }
            }
            LDS_BARRIER();
        }
    }
#undef SC_SRC
}

__device__ void rwkv_post(const Params& p, unsigned char* lds) {
    const int tid = threadIdx.x, lane = tid & 63, w = __builtin_amdgcn_readfirstlane(tid >> 6), l15 = lane & 15, g = lane >> 4;
    const bf16_t* P = (const bf16_t*)(p.ws + WS_P);
    bf16_t* Abuf = (bf16_t*)(p.ws + WS_A);
    const bf16_t* Ybuf = (const bf16_t*)(p.ws + WS_Y);
    const float* RK = (const float*)(p.ws + WS_RK);
    const bf16_t* BND = (const bf16_t*)(p.ws + WS_BND);
    float* L = (float*)(lds + w * 8704);
    const int tr = lane >> 3, seg = lane & 7;
    for (int hu = blockIdx.x * 8 + w; hu < 16384; hu += gridDim.x * 8) {
        const int unit = hu >> 1, t0 = (hu & 1) * 32;
        const int bn = unit >> 4, h = unit & 15, n = bn & 255;
        const size_t R0 = (size_t)bn * 64;
        bf16x8 fh[4][2], fr[2][2];
#pragma unroll
        for (int kk = 0; kk < 2; ++kk) {
#pragma unroll
            for (int q = 0; q < 4; ++q) fh[q][kk] = *(const bf16x8*)(P + (R0 + 16 * q + l15) * PP + 2048 + h * 64 + 32 * kk + 8 * g);
#pragma unroll
            for (int q = 0; q < 2; ++q) fr[q][kk] = *(const bf16x8*)(P + (R0 + t0 + 16 * q + l15) * PP + 1024 + h * 64 + 32 * kk + 8 * g);
        }
        u32x4 y0r[4], g1r[4], g0r[4], vpr[4];
        float rkv[4];
#pragma unroll
        for (int i = 0; i < 4; ++i) {
            const int t = t0 + tr + 8 * i;
            y0r[i] = *(const u32x4*)(Abuf + (R0 + t) * DM + h * 64 + 8 * seg);
            const bf16_t* grow = P + (R0 + t) * PP + 3072 + h * 64 + 8 * seg;
            g1r[i] = *(const u32x4*)grow;
            g0r[i] = *(const u32x4*)((t > 0) ? (grow - PP) : (BND + (size_t)bn * PP + 3072 + h * 64 + 8 * seg));
            vpr[i] = *(const u32x4*)(Ybuf + (R0 + t) * DM + h * 64 + 8 * seg);
            rkv[i] = RK[(R0 + t) * 16 + h];
        }
#pragma unroll
        for (int i = 0; i < 4; ++i) { *(f32x4*)(L + (tr + 8 * i) * 68 + 8 * seg) = lo4(y0r[i]); *(f32x4*)(L + (tr + 8 * i) * 68 + 8 * seg + 4) = hi4(y0r[i]); }
        f32x4 y[4][2];
#pragma unroll
        for (int vt = 0; vt < 4; ++vt)
#pragma unroll
            for (int tt = 0; tt < 2; ++tt) y[vt][tt] = *(const f32x4*)(L + (16 * tt + l15) * 68 + 16 * vt + 4 * g);
#pragma unroll
        for (int vt = 0; vt < 4; ++vt)
#pragma unroll
            for (int tt = 0; tt < 2; ++tt)
#pragma unroll
                for (int kk = 0; kk < 2; ++kk) y[vt][tt] = mfma16(fh[vt][kk], fr[tt][kk], y[vt][tt]);
#pragma unroll
        for (int tt = 0; tt < 2; ++tt) {
            float s1 = 0.f, s2 = 0.f;
#pragma unroll
            for (int vt = 0; vt < 4; ++vt)
#pragma unroll
                for (int r = 0; r < 4; ++r) { s1 += y[vt][tt][r]; s2 += y[vt][tt][r] * y[vt][tt][r]; }
            s1 += __shfl_xor(s1, 16); s2 += __shfl_xor(s2, 16); s1 += __shfl_xor(s1, 32); s2 += __shfl_xor(s2, 32);
            const float mean = s1 * (1.0f / 64.0f);
            const float rstd = rsqrtf(fmaxf(s2 * (1.0f / 64.0f) - mean * mean, 0.f) + 64e-5f);
#pragma unroll
            for (int vt = 0; vt < 4; ++vt) *(f32x4*)(L + (16 * tt + l15) * 68 + 16 * vt + 4 * g) = (y[vt][tt] - mean) * rstd;
        }
        const int ch = h * 64 + 8 * seg;
        const f32x4 lw0 = *(const f32x4*)(p.in[18] + ch), lw1 = *(const f32x4*)(p.in[18] + ch + 4), lb0 = *(const f32x4*)(p.in[19] + ch), lb1 = *(const f32x4*)(p.in[19] + ch + 4);
        const f32x4 mg0 = *(const f32x4*)(p.in[10] + 3072 + ch), mg1 = *(const f32x4*)(p.in[10] + 3072 + ch + 4);
#pragma unroll
        for (int i = 0; i < 4; ++i) {
            const int t = t0 + tr + 8 * i;
            const f32x4 n0 = *(const f32x4*)(L + (tr + 8 * i) * 68 + 8 * seg), n1 = *(const f32x4*)(L + (tr + 8 * i) * 68 + 8 * seg + 4);
            const f32x4 ga0 = lo4(g1r[i]), ga1 = hi4(g1r[i]);
            f32x4 gb0 = lo4(g0r[i]), gb1 = hi4(g0r[i]);
            if (t == 0 && n == 0) { gb0 = (f32x4){0.f, 0.f, 0.f, 0.f}; gb1 = gb0; }
            const f32x4 gt0 = ga0 + mg0 * (gb0 - ga0), gt1 = ga1 + mg1 * (gb1 - ga1);
            const f32x4 v0 = lo4(vpr[i]), v1 = hi4(vpr[i]);
            f32x4 o0 = n0 * lw0 + lb0 + rkv[i] * v0, o1 = n1 * lw1 + lb1 + rkv[i] * v1;
#pragma unroll
            for (int j = 0; j < 4; ++j) { o0[j] *= gt0[j] * __builtin_amdgcn_rcpf(1.0f + __expf(-gt0[j])); o1[j] *= gt1[j] * __builtin_amdgcn_rcpf(1.0f + __expf(-gt1[j])); }
            *(u32x4*)(Abuf + (R0 + t) * DM + h * 64 + 8 * seg) = pk8(o0, o1);
        }
    }
}
#define XB_TMO      128
#define XB_XCNT(j)  (256  + 64 * (j))
#define XB_XSUB(j)  (1280 + 64 * (j))
#define XB_XGEN(j)  (2304 + 64 * (j))
#define XB_TOP      3328
#define XB_TOPGEN   3392
#define XCD_BAR_WORDS 3456
#define XB_SPIN_CAP (1u << 18)
#define LAS __attribute__((address_space(3)))

__device__ __forceinline__ unsigned xb_ld(unsigned* p)              { return __hip_atomic_load(p, __ATOMIC_RELAXED, __HIP_MEMORY_SCOPE_AGENT); }
__device__ __forceinline__ unsigned xb_add(unsigned* p, unsigned v) { return __hip_atomic_fetch_add(p, v, __ATOMIC_RELAXED, __HIP_MEMORY_SCOPE_AGENT); }
__device__ __forceinline__ unsigned xb_xcc_id() { return (unsigned)__builtin_amdgcn_s_getreg((3 << 11) | 20) & 0xFu; }
#define XB_SPIN(cond, bar) do { unsigned _sp = 0; while (cond) { __builtin_amdgcn_s_sleep(1); \
    if ((++_sp & 255u) == 0u) { if (xb_ld(&(bar)[XB_TMO])) break; if (_sp > XB_SPIN_CAP) { atomicAdd(&(bar)[XB_TMO], 1u); break; } } } } while (0)

struct XcdBarrier {
    unsigned* bar; unsigned x;
    volatile LAS unsigned* st;
};

__device__ __forceinline__ XcdBarrier xcd_barrier_post(unsigned* bar, volatile LAS unsigned* st) {
    XcdBarrier b; b.bar = bar; b.x = xb_xcc_id(); b.st = st;
    if (threadIdx.x == 0) (void)xb_add(&bar[XB_XCNT(b.x)], 1u);
    return b;
}
__device__ __forceinline__ void xcd_barrier_complete(unsigned* bar, unsigned x, unsigned& nloc, unsigned& nx) {
    const unsigned G = gridDim.x * gridDim.y * gridDim.z;
    unsigned sum, cnt, mine, sp = 0u;
    for (;;) {
        sum = 0u; cnt = 0u; mine = 0u;
#pragma unroll
        for (unsigned j = 0; j < 16; ++j) { const unsigned c = xb_ld(&bar[XB_XCNT(j)]); sum += c; cnt += (c > 0u) ? 1u : 0u; mine = (j == x) ? c : mine; }
        if (sum == G) break;
        __builtin_amdgcn_s_sleep(1);
        if ((++sp & 255u) == 0u) { if (xb_ld(&bar[XB_TMO])) break; if (sp > XB_SPIN_CAP) { atomicAdd(&bar[XB_TMO], 1u); break; } }
    }
    nloc = mine > 0u ? mine : 1u; nx = cnt > 0u ? cnt : 1u;
}

__device__ __forceinline__ void xcd_barrier(const XcdBarrier& b) {
    asm volatile("s_waitcnt vmcnt(0)" ::: "memory");
    __syncthreads();
    if (threadIdx.x == 0) {
        unsigned* bar = b.bar;
        __builtin_amdgcn_s_waitcnt(0);
        unsigned nloc = b.st[0], nx = b.st[1];
        if (nloc == 0u) { xcd_barrier_complete(bar, b.x, nloc, nx); b.st[0] = nloc; b.st[1] = nx; }
        const unsigned old = xb_add(&bar[XB_XSUB(b.x)], 1u);
        const unsigned gen = old / nloc;
        if (old + 1u == (gen + 1u) * nloc) {
            __builtin_amdgcn_fence(__ATOMIC_RELEASE, "agent");
            asm volatile("s_waitcnt vmcnt(0)" ::: "memory");
            const unsigned og = xb_add(&bar[XB_TOP], 1u);
            const unsigned tg = og / nx;
            if (og + 1u == (tg + 1u) * nx) xb_add(&bar[XB_TOPGEN], 1u);
            else XB_SPIN(xb_ld(&bar[XB_TOPGEN]) == tg, bar);
            __builtin_amdgcn_fence(__ATOMIC_ACQUIRE, "agent");
            xb_add(&bar[XB_XGEN(b.x)], 1u);
            asm volatile("s_waitcnt vmcnt(0)" ::: "memory");
        } else {
            XB_SPIN(xb_ld(&bar[XB_XGEN(b.x)]) == gen, bar);
            __builtin_amdgcn_fence(__ATOMIC_ACQUIRE, "agent");
            asm volatile("s_waitcnt vmcnt(0)" ::: "memory");
        }
    }
    __syncthreads();
}


#ifndef PROBE_ID
#define PROBE_ID 0
#endif
#ifndef N_LAUNCH_MODE
#define N_LAUNCH_MODE 1
#endif
constexpr int N_PHASES = 15;

__global__ void __launch_bounds__(NTH, 2) fwd_kernel(Params p) {
    extern __shared__ __attribute__((aligned(16))) unsigned char lds[];
    const int lo = p.ph_lo, hi = p.ph_hi;
    volatile LAS unsigned* xst = (volatile LAS unsigned*)(lds + LDS_BYTES);
    if (threadIdx.x < 4) xst[threadIdx.x] = 0u;
    __syncthreads();
    const XcdBarrier xbar = xcd_barrier_post((unsigned*)(p.ws + WS_BAR), xst);
    unsigned char* ws = p.ws;
#define IN(k) (lo <= (k) && (k) < hi)
#define SEAM(k) do { if ((k) + 1 < hi) xcd_barrier(xbar); } while (0)
    if (IN(0)) {
        prep_weight(p.in[2], GIN, p.in[1], (bf16_t*)(ws + WS_WGIN), GIN_P, (float*)lds);
        prep_weight(p.in[6], DM, nullptr, (bf16_t*)(ws + WS_WGOUT), DM, (float*)lds);
        prep_weight(p.in[9], RIN, p.in[8], (bf16_t*)(ws + WS_WRIN), RIN_P, (float*)lds);
        prep_weight(p.in[20], DM, nullptr, (bf16_t*)(ws + WS_WROUT), DM, (float*)lds);
        prep_lowrank(p.in[12], (bf16_t*)(ws + WS_WDUT));
        prep_lowrank(p.in[14], (bf16_t*)(ws + WS_WIUT));
        prep_wup(p.in[3], (bf16_t*)(ws + WS_WUPT));
        __syncthreads();
        phase_norm0(p, lds);
        SEAM(0);
    }
    if (IN(1)) {
        pg8::Gemm g{(const bf16_t*)(ws + WS_A), (const bf16_t*)(ws + WS_WGIN), MTOK, GIN_P, DM}; pg8::StaticOrder S; S.init(MTOK, GIN_P, gridDim.x, blockIdx.x);
        pg8::EpiBf16<0> E{(bf16_t*)(ws + WS_P), GIN_P, nullptr, 0, 0};
        pg8::gemm_phase<pg8::EpiBf16<0>, pg8::StaticOrder>((PG8_LAS unsigned char*)lds, g, S, E);
        SEAM(1);
    }
    if (IN(2)) { gla_pass<false>(p, lds); SEAM(2); }
    if (IN(3)) { gla_scan(p); SEAM(3); }
    if (IN(4)) { gla_pass<true>(p, lds); SEAM(4); }
    if (IN(5)) {
        pg8::Gemm g{(const bf16_t*)(ws + WS_A), (const bf16_t*)(ws + WS_WGOUT), MTOK, DM, DM}; pg8::StaticOrder S; S.init(MTOK, DM, gridDim.x, blockIdx.x);
        pg8::EpiBf16<0> E{(bf16_t*)(ws + WS_Y), DM, nullptr, 0, 0};
        pg8::gemm_phase<pg8::EpiBf16<0>, pg8::StaticOrder>((PG8_LAS unsigned char*)lds, g, S, E);
        SEAM(5);
    }
    if (IN(6)) { phase_norm1(p); SEAM(6); }
    if (IN(7)) {
        pg8::Gemm g{(const bf16_t*)(ws + WS_A), (const bf16_t*)(ws + WS_WRIN), MTOK, RIN_P, DM}; pg8::StaticOrder S; S.init(MTOK, RIN_P, gridDim.x, blockIdx.x);
        EpiBf16Bnd E{(bf16_t*)(ws + WS_P), RIN_P, (bf16_t*)(ws + WS_BND)};
        pg8::gemm_phase<EpiBf16Bnd, pg8::StaticOrder>((PG8_LAS unsigned char*)lds, g, S, E);
        SEAM(7);
    }
    if (IN(8)) { rwkv_r1(p, lds); SEAM(8); }
    if (IN(9)) { rwkv_scan2<1>(p, lds); SEAM(9); }
    if (IN(10)) { rwkv_scan2<2>(p, lds); SEAM(10); }
    if (IN(11)) { rwkv_scan2<3>(p, lds); SEAM(11); }
    if (IN(12)) { rwkv_post(p, lds); SEAM(12); }
    if (IN(13)) {
        pg8::Gemm g{(const bf16_t*)(ws + WS_A), (const bf16_t*)(ws + WS_WROUT), MTOK, DM, DM}; pg8::StaticOrder S; S.init(MTOK, DM, gridDim.x, blockIdx.x);
        pg8::EpiBf16<0> E{(bf16_t*)(ws + WS_Y), DM, nullptr, 0, 0};
        pg8::gemm_phase<pg8::EpiBf16<0>, pg8::StaticOrder>((PG8_LAS unsigned char*)lds, g, S, E);
        SEAM(13);
    }
    if (IN(14)) { phase_final(p); }
#undef IN
#undef SEAM
}

extern "C" void kernel_launch(void* const* d_in, const int* in_sizes, int n_in, void* d_out, int out_size, void* d_ws, size_t ws_size, hipStream_t stream) {
    static int grid = 0;
    if (grid == 0) {
        int dev = 0, cus = 0, per_cu = 0;
        hipGetDevice(&dev);
        hipDeviceGetAttribute(&cus, hipDeviceAttributeMultiprocessorCount, dev);
        hipFuncSetAttribute((const void*)fwd_kernel, hipFuncAttributeMaxDynamicSharedMemorySize, LDS_BYTES + 16);
        hipOccupancyMaxActiveBlocksPerMultiprocessor(&per_cu, (const void*)fwd_kernel, NTH, LDS_BYTES + 16);
        if (per_cu < 1) { fprintf(stderr, "kernel_launch: occupancy query says %d blocks per CU\n", per_cu); per_cu = 1; }
        grid = cus;
        if (n_in != 22 || ws_size < WS_END) fprintf(stderr, "kernel_launch: unexpected n_in %d or workspace %zu < %zu\n", n_in, ws_size, (size_t)WS_END);
        (void)hipGetLastError();
    }
    if (hipMemsetAsync((char*)d_ws + WS_BAR, 0, XCD_BAR_WORDS * 4, stream) != hipSuccess) fprintf(stderr, "kernel_launch: memset of the barrier words failed\n");
    Params p{};
    for (int i = 0; i < 22; ++i) p.in[i] = (const float*)d_in[i];
    p.out = (float*)d_out; p.ws = (unsigned char*)d_ws;
#if N_LAUNCH_MODE == 1
    void* args[] = {&p};
#if PROBE_ID > 0
    p.ph_lo = 0; p.ph_hi = PROBE_ID;
    (void)hipLaunchCooperativeKernel((const void*)fwd_kernel, dim3(grid), dim3(NTH), args, LDS_BYTES + 16, stream);
    (void)hipMemsetAsync((char*)d_ws + WS_BAR, 0, XCD_BAR_WORDS * 4, stream);
#endif
    p.ph_lo = 0; p.ph_hi = N_PHASES;
    hipError_t e = hipLaunchCooperativeKernel((const void*)fwd_kernel, dim3(grid), dim3(NTH), args, LDS_BYTES + 16, stream);
    if (e != hipSuccess) fprintf(stderr, "cooperative launch failed: %s (grid %d)\n", hipGetErrorString(e), grid);
#else
    for (int k = 0; k < N_PHASES; ++k) {
        p.ph_lo = k; p.ph_hi = k + 1;
        hipLaunchKernelGGL(fwd_kernel, dim3(grid), dim3(NTH), LDS_BYTES + 16, stream, p);
    }
#endif
}
```

```cpp
#include <hip/hip_runtime.h>
#include <hip/hip_cooperative_groups.h>
#include <cstdio>
namespace cg = cooperative_groups;
#define PROBE_ID 0
#define N_LAUNCH_MODE 1
namespace pg8 {
#define PG8_LAS __attribute__((address_space(3)))
typedef unsigned short bf16_t;
typedef short bf16x8 __attribute__((ext_vector_type(8)));
typedef float f32x4 __attribute__((ext_vector_type(4)));
typedef unsigned u32x4 __attribute__((ext_vector_type(4)));
constexpr int BM = 256, BK = 64, HALF = 128, HTB = HALF * BK * 2  , STAGE_BYTES = 8 * HTB, NXCD = 8, WGM = 8;

__host__ __device__ __forceinline__ int lds_byte(int r, int c) { const int st = (r >> 4) * 2 + (c >> 5), rr = r & 15, cc = c & 31, ob = rr * 64 + cc * 2; return st * 1024 + (ob ^ (((ob >> 9) & 1) << 5)); }
__host__ __device__ __forceinline__ void stage_rc(int b, int& R, int& C) { const int st = b / 1024, sb = b % 1024, swz = sb ^ (((sb >> 9) & 1) << 5); R = (st >> 1) * 16 + swz / 64; C = (st & 1) * 32 + (swz % 64) / 2; }
__host__ __device__ __forceinline__ int perm32(int rho) { const int n = rho >> 4, i = rho & 15; return 8 * (i >> 2) + 4 * n + (i & 3); }

struct Unit { int pm, pn; };
struct Gemm { const bf16_t* A; const bf16_t* Bt; int M, N, K; };

struct StaticOrder {
    int nM, nN, nwg, G, c;
    __host__ __device__ void init(int M, int N, int G_, int c_) { nM = M / BM; nN = N / BM; nwg = nM * nN; G = G_; c = c_; }
    __host__ __device__ bool next(int i, Unit& u) const {
        const long L = (long)i * G + c; if (L >= nwg) return false;
        int wgid = (int)L; { const int q = nwg / NXCD, r = nwg % NXCD, xcd = wgid % NXCD, off = wgid / NXCD; wgid = (xcd < r ? xcd * (q + 1) : r * (q + 1) + (xcd - r) * q) + off; }
        const int nig = WGM * nN, gid = wgid / nig, fm = gid * WGM, gsz = (nM - fm) < WGM ? (nM - fm) : WGM;
        u.pm = fm + ((wgid % nig) % gsz); u.pn = (wgid % nig) / gsz; return true;
    }
    __device__ __forceinline__ void a_ready(const Unit&) const {}
    __device__ __forceinline__ void done(const Unit&) const {}
};

typedef float cvt_f32x2 __attribute__((ext_vector_type(2)));
typedef __bf16 cvt_bf16x2 __attribute__((ext_vector_type(2)));
__device__ __forceinline__ unsigned cvt_pk_bf16(float lo, float hi) { const cvt_f32x2 v = {lo, hi}; union { cvt_bf16x2 b; unsigned u; } x; x.b = __builtin_convertvector(v, cvt_bf16x2); return x.u; }
typedef float f32x2 __attribute__((ext_vector_type(2)));
struct EpiF32 {
    static constexpr bool PERM = false, AFTER_DRAIN = false;
    float* C; int ldc; const float* bias;
    __device__ __forceinline__ void operator()(const f32x4 (&acc)[2][2][4][2], const Unit& u, int wr, int wc, int fr, int fq) const {
        const int row0 = u.pm * BM + wr * 64 + fr, col0 = u.pn * BM + wc * 32 + 4 * fq;
        f32x4 bv[2][2];
#pragma unroll
        for (int bj = 0; bj < 2; ++bj)
#pragma unroll
            for (int n = 0; n < 2; ++n) bv[bj][n] = bias ? *(const f32x4*)(bias + col0 + bj * HALF + n * 16) : (f32x4){0.f, 0.f, 0.f, 0.f};
#pragma unroll
        for (int ai = 0; ai < 2; ++ai)
#pragma unroll
            for (int m = 0; m < 4; ++m) { float* rowp = C + (size_t)(row0 + ai * HALF + m * 16) * ldc + col0;
#pragma unroll
                for (int bj = 0; bj < 2; ++bj)
#pragma unroll
                    for (int n = 0; n < 2; ++n) *(f32x4*)(rowp + bj * HALF + n * 16) = acc[ai][bj][m][n] + bv[bj][n]; }
    }
};
template <int ACT  > struct EpiBf16 {
    static constexpr bool PERM = true, AFTER_DRAIN = false;
    bf16_t* O; int ldc; const float* bias; int split_cols; size_t split_stride;
    __device__ __forceinline__ void operator()(const f32x4 (&acc)[2][2][4][2], const Unit& u, int wr, int wc, int fr, int fq) const {
        const int row0 = u.pm * BM + wr * 64 + fr; int colt = u.pn * BM; bf16_t* base = O;
        if (split_cols) { const int t = colt / split_cols; base += (size_t)t * split_stride; colt -= t * split_cols; }
        const int col0 = colt + wc * 32 + 8 * fq, bcol0 = u.pn * BM + wc * 32 + 8 * fq;
        f32x4 bv[2][2];
#pragma unroll
        for (int bj = 0; bj < 2; ++bj)
#pragma unroll
            for (int n = 0; n < 2; ++n) bv[bj][n] = bias ? *(const f32x4*)(bias + bcol0 + bj * HALF + 4 * n) : (f32x4){0.f, 0.f, 0.f, 0.f};
#pragma unroll
        for (int ai = 0; ai < 2; ++ai)
#pragma unroll
            for (int m = 0; m < 4; ++m) { bf16_t* rowp = base + (size_t)(row0 + ai * HALF + m * 16) * ldc + col0;
#pragma unroll
                for (int bj = 0; bj < 2; ++bj) { f32x4 v0 = acc[ai][bj][m][0] + bv[bj][0], v1 = acc[ai][bj][m][1] + bv[bj][1];
                    u32x4 w; w.x = cvt_pk_bf16(v0[0], v0[1]); w.y = cvt_pk_bf16(v0[2], v0[3]); w.z = cvt_pk_bf16(v1[0], v1[1]); w.w = cvt_pk_bf16(v1[2], v1[3]);
                    *(u32x4*)(rowp + bj * HALF) = w; } }
    }
};

template <class Epi, class Sched>
__device__ __forceinline__ void gemm_phase(PG8_LAS unsigned char* lds, const Gemm g, const Sched& S, const Epi& E) {
    const int tid = threadIdx.x, wid = __builtin_amdgcn_readfirstlane(tid >> 6), lane = tid & 63, wr = wid >> 2, wc = wid & 3, fr = lane & 15, fq = lane >> 4;
    const int K = g.K, nt = K / BK;
    unsigned voffA[2], voffB[2];
#pragma unroll
    for (int i = 0; i < 2; ++i) { int R, C; stage_rc(tid * 16 + i * 8192, R, C); const int Rb = Epi::PERM ? ((R & ~31) + perm32(R & 31)) : R;
        voffA[i] = (unsigned)(R * K + C) * 2u; voffB[i] = (unsigned)(Rb * K + C) * 2u; }
    const size_t kstep = (size_t)(BK * 2);
    const size_t hstep = (size_t)HALF * K * 2;
    const size_t tstep = 2 * hstep;
    const unsigned ldsw = (unsigned)wid * 1024u;
    const int aoff = lds_byte(wr * 64 + fr, fq * 8), boff = lds_byte(wc * 32 + fr, fq * 8);
#define PG8_SA(b, h) (((b) * 2 + (h)) * HTB)
#define PG8_SB(b, h) ((4 + (b) * 2 + (h)) * HTB)
#define PG8_STAGE(bufoff, gbase, voff) do { _Pragma("unroll") for (int _i = 0; _i < 2; ++_i) \
        __builtin_amdgcn_global_load_lds((const unsigned*)((const char*)(gbase) + (voff)[_i]), (PG8_LAS unsigned*)(lds + (bufoff) + ldsw + _i * 8192), 16, 0, 0); } while (0)
#define PG8_LDA(dst, b, h) do { _Pragma("unroll") for (int m = 0; m < 4; ++m) _Pragma("unroll") for (int k = 0; k < 2; ++k) dst[m][k] = *(const PG8_LAS bf16x8*)(lds + PG8_SA(b, h) + aoff + m * 2048 + k * 1024); } while (0)
#define PG8_LDB(dst, b, h) do { _Pragma("unroll") for (int n = 0; n < 2; ++n) _Pragma("unroll") for (int k = 0; k < 2; ++k) dst[n][k] = *(const PG8_LAS bf16x8*)(lds + PG8_SB(b, h) + boff + n * 2048 + k * 1024); } while (0)
#define PG8_MMA(ai, bj, At, Bt) do { __builtin_amdgcn_s_setprio(1); _Pragma("unroll") for (int m = 0; m < 4; ++m) _Pragma("unroll") for (int n = 0; n < 2; ++n) _Pragma("unroll") for (int k = 0; k < 2; ++k) \
        acc[ai][bj][m][n] = __builtin_amdgcn_mfma_f32_16x16x32_bf16(Bt[n][k], At[m][k], acc[ai][bj][m][n], 0, 0, 0); __builtin_amdgcn_s_setprio(0); } while (0)
#define PG8_WAIT_V(n) asm volatile("s_waitcnt vmcnt(" #n ")" ::: "memory")
#define PG8_WAIT_L(n) asm volatile("s_waitcnt lgkmcnt(" #n ")" ::: "memory")
#define PG8_BAR __builtin_amdgcn_s_barrier()
#define PG8_SCHED __builtin_amdgcn_sched_barrier(0)
    Unit cur, nxt; int ui = 0;
    if (!S.next(0, cur)) return;
    f32x4 acc[2][2][4][2];
#pragma unroll
    for (int a = 0; a < 2; ++a)
#pragma unroll
        for (int b = 0; b < 2; ++b)
#pragma unroll
            for (int m = 0; m < 4; ++m)
#pragma unroll
                for (int n = 0; n < 2; ++n) acc[a][b][m][n] = (f32x4){0.f, 0.f, 0.f, 0.f};
    bf16x8 At[4][2], B0[2][2], B1[2][2];
    const char* cA = (const char*)g.A + (size_t)cur.pm * tstep; const char* cB = (const char*)g.Bt + (size_t)cur.pn * tstep;
    S.a_ready(cur);
    PG8_STAGE(PG8_SB(0, 0), cB, voffB); PG8_STAGE(PG8_SA(0, 0), cA, voffA); PG8_STAGE(PG8_SB(0, 1), cB + hstep, voffB); PG8_STAGE(PG8_SA(0, 1), cA + hstep, voffA);
    if (wr == 1) PG8_BAR;
    PG8_WAIT_V(4); PG8_BAR;
    PG8_STAGE(PG8_SB(1, 0), cB + kstep, voffB); PG8_STAGE(PG8_SA(1, 0), cA + kstep, voffA); PG8_STAGE(PG8_SB(1, 1), cB + hstep + kstep, voffB);
    PG8_WAIT_V(6); PG8_BAR;
    for (;;) {
        const bool has_next = S.next(ui + 1, nxt);
        const char* nA = has_next ? (const char*)g.A + (size_t)nxt.pm * tstep : cA; const char* nB = has_next ? (const char*)g.Bt + (size_t)nxt.pn * tstep : cB;
        for (int t = 0; t < nt; t += 2) {
            const bool last = (t == nt - 2);
            const char* a1 = cA + (size_t)(t + 1) * kstep;
            const char* a2 = last ? nA : cA + (size_t)(t + 2) * kstep; const char* b2 = last ? nB : cB + (size_t)(t + 2) * kstep;
            const char* a3 = a2 + kstep; const char* b3 = b2 + kstep;
            if (last && has_next) S.a_ready(nxt);
            PG8_LDB(B0, 0, 0); PG8_SCHED; PG8_LDA(At, 0, 0); PG8_STAGE(PG8_SA(1, 1), a1 + hstep, voffA);
            PG8_WAIT_L(8); PG8_BAR; PG8_WAIT_L(0); PG8_MMA(0, 0, At, B0); PG8_BAR; PG8_SCHED;
            PG8_LDB(B1, 0, 1); PG8_STAGE(PG8_SB(0, 0), b2, voffB);
            PG8_BAR; PG8_WAIT_L(0); PG8_MMA(0, 1, At, B1); PG8_BAR;
            PG8_LDA(At, 0, 1); PG8_STAGE(PG8_SA(0, 0), a2, voffA);
            PG8_BAR; PG8_WAIT_L(0); PG8_MMA(1, 0, At, B0); PG8_BAR; PG8_SCHED;
            PG8_STAGE(PG8_SB(0, 1), b2 + hstep, voffB);
            PG8_WAIT_V(6); PG8_BAR; PG8_MMA(1, 1, At, B1); PG8_BAR;
            PG8_LDB(B0, 1, 0); PG8_SCHED; PG8_LDA(At, 1, 0); PG8_STAGE(PG8_SA(0, 1), a2 + hstep, voffA);
            PG8_WAIT_L(8); PG8_BAR; PG8_WAIT_L(0); PG8_MMA(0, 0, At, B0); PG8_BAR; PG8_SCHED;
            PG8_LDB(B1, 1, 1); PG8_STAGE(PG8_SB(1, 0), b3, voffB);
            PG8_BAR; PG8_WAIT_L(0); PG8_MMA(0, 1, At, B1); PG8_BAR;
            PG8_LDA(At, 1, 1); PG8_STAGE(PG8_SA(1, 0), a3, voffA);
            PG8_BAR; PG8_WAIT_L(0); PG8_MMA(1, 0, At, B0); PG8_BAR; PG8_SCHED;
            PG8_STAGE(PG8_SB(1, 1), b3 + hstep, voffB);
            PG8_WAIT_V(6); PG8_BAR; PG8_MMA(1, 1, At, B1); PG8_BAR;
        }
        if constexpr (!Epi::AFTER_DRAIN) { E(acc, cur, wr, wc, fr, fq); S.done(cur); }
        if (!has_next) break;
#pragma unroll
        for (int a = 0; a < 2; ++a)
#pragma unroll
            for (int b = 0; b < 2; ++b)
#pragma unroll
                for (int m = 0; m < 4; ++m)
#pragma unroll
                    for (int n = 0; n < 2; ++n) acc[a][b][m][n] = (f32x4){0.f, 0.f, 0.f, 0.f};
        cur = nxt; cA = nA; cB = nB; ++ui;
    }
    PG8_WAIT_V(0);
    if (wr == 0) PG8_BAR;
    PG8_BAR;
    if constexpr (Epi::AFTER_DRAIN) { E.fused(acc, cur, wr, wc, fr, fq, lds, wid, lane); S.done(cur); }
#undef PG8_SA
#undef PG8_SB
#undef PG8_STAGE
#undef PG8_LDA
#undef PG8_LDB
#undef PG8_MMA
#undef PG8_WAIT_V
#undef PG8_WAIT_L
#undef PG8_BAR
#undef PG8_SCHED
}
}


typedef unsigned short bf16_t;
typedef short bf16x8 __attribute__((ext_vector_type(8)));
typedef float f32x4 __attribute__((ext_vector_type(4)));
typedef unsigned u32x4 __attribute__((ext_vector_type(4)));
typedef unsigned u32x2 __attribute__((ext_vector_type(2)));

constexpr int MTOK = 32768, DM = 1024, SEQ = 16384, NTH = 512;
constexpr int GIN = 3088, GIN_P = 3072, RIN = 4224, RIN_P = 4352;
constexpr int LDS_BYTES = 131072;

constexpr size_t WS_WGIN  = 0;
constexpr size_t WS_WGOUT = WS_WGIN  + (size_t)GIN_P * DM * 2;
constexpr size_t WS_WRIN  = WS_WGOUT + (size_t)DM * DM * 2;
constexpr size_t WS_WROUT = WS_WRIN  + (size_t)RIN_P * DM * 2;
constexpr size_t WS_WDUT  = WS_WROUT + (size_t)DM * DM * 2;
constexpr size_t WS_WIUT  = WS_WDUT  + (size_t)DM * 64 * 2;
constexpr size_t WS_WUPT  = WS_WIUT  + (size_t)DM * 64 * 2;
constexpr size_t WS_A     = WS_WUPT  + (size_t)512 * 16 * 2;
constexpr size_t WS_Y     = WS_A     + (size_t)MTOK * DM * 2;
constexpr size_t WS_GS    = WS_Y     + (size_t)MTOK * DM * 2;
constexpr size_t WS_GD    = WS_GS    + (size_t)24 * 1024 * 1024;
constexpr size_t WS_P     = WS_GD    + (size_t)8 * 32 * 128 * 4;
constexpr size_t WS_BAR   = WS_P     + (size_t)MTOK * RIN_P * 2;
constexpr size_t WS_AD    = WS_BAR   + 16384;
constexpr size_t WS_X1    = WS_AD    + (size_t)MTOK * 16 * 2;
constexpr size_t WS_END   = WS_X1    + (size_t)MTOK * DM * 2;
static_assert(WS_END <= (size_t)512 * 1024 * 1024, "workspace budget (4 x the largest tensor)");

struct Params { const float* in[22]; float* out; unsigned char* ws; int ph_lo, ph_hi; };

__device__ __forceinline__ float bf2f(unsigned b) { return __uint_as_float(b << 16); }
__device__ __forceinline__ bf16_t f2bf(float f) { unsigned u = __float_as_uint(f); u += 0x7FFFu + ((u >> 16) & 1u); return (bf16_t)(u >> 16); }
__device__ __forceinline__ unsigned pk2(float lo, float hi) { return pg8::cvt_pk_bf16(lo, hi); }
__device__ __forceinline__ float wave_sum(float x) {
#pragma unroll
    for (int off = 32; off >= 1; off >>= 1) x += __shfl_xor(x, off);
    return x;
}
__device__ __forceinline__ f32x4 mfma16(bf16x8 a, bf16x8 b, f32x4 c) { return __builtin_amdgcn_mfma_f32_16x16x32_bf16(a, b, c, 0, 0, 0); }
__device__ __forceinline__ bf16x8 as_bf16x8(u32x4 v) { union { u32x4 u; bf16x8 b; } x; x.u = v; return x.b; }
__device__ __forceinline__ float fexp(float x) { return __builtin_amdgcn_exp2f(x * 1.4426950408889634f); }
__device__ __forceinline__ float flog(float x) { return __builtin_amdgcn_logf(x) * 0.6931471805599453f; }
__device__ __forceinline__ float log_sigmoid(float z) { return fminf(z, 0.f) - log1pf(fexp(-fabsf(z))); }
__device__ __forceinline__ float softplus(float z) { return fmaxf(z, 0.f) + log1pf(fexp(-fabsf(z))); }

__device__ void prep_weight(const float* __restrict__ W, int N, const float* __restrict__ gain, bf16_t* __restrict__ Wt, int NP, float* tile) {
    const int tid = threadIdx.x;
    const int nu = (NP / 64) * 16;
    for (int u = blockIdx.x; u < nu; u += gridDim.x) {
        const int n0 = (u >> 4) * 64, k0 = (u & 15) * 64;
        {
            const int j = tid & 63, i0 = tid >> 6;
#pragma unroll
            for (int r = 0; r < 8; ++r) {
                const int i = i0 + 8 * r, k = k0 + i, n = n0 + j;
                float v = 0.f;
                if (n < N) { v = W[(size_t)k * N + n]; if (gain) v *= gain[k]; }
                tile[i * 65 + j] = v;
            }
        }
        __syncthreads();
        {
            const int i = tid & 63, j0 = tid >> 6;
#pragma unroll
            for (int r = 0; r < 8; ++r) {
                const int j = j0 + 8 * r;
                Wt[(size_t)(n0 + j) * DM + k0 + i] = f2bf(tile[i * 65 + j]);
            }
        }
        __syncthreads();
    }
}

__device__ void prep_lowrank(const float* __restrict__ src, bf16_t* __restrict__ dst) {
    for (int idx = blockIdx.x * NTH + threadIdx.x; idx < 65536; idx += gridDim.x * NTH) dst[idx] = f2bf(src[(idx & 63) * 1024 + (idx >> 6)]);
}

__device__ void zero_bnd_row(bf16_t* bnd) {
    if (blockIdx.x == 0) for (int i = threadIdx.x; i < RIN_P / 2; i += NTH) ((unsigned*)bnd)[i] = 0u;
}

__device__ void prep_wup(const float* __restrict__ src, bf16_t* __restrict__ dst) {
    for (int idx = blockIdx.x * NTH + threadIdx.x; idx < 8192; idx += gridDim.x * NTH) dst[idx] = f2bf(src[(idx & 15) * 512 + (idx >> 4)]);
}

struct EpiBf16Bnd {
    static constexpr bool PERM = true, AFTER_DRAIN = false;
    bf16_t* O; int ldc; bf16_t* bnd;
    __device__ __forceinline__ void operator()(const f32x4 (&acc)[2][2][4][2], const pg8::Unit& u, int wr, int wc, int fr, int fq) const {
        const int row0 = u.pm * pg8::BM + wr * 64 + fr, col0 = u.pn * pg8::BM + wc * 32 + 8 * fq;
#pragma unroll
        for (int ai = 0; ai < 2; ++ai)
#pragma unroll
            for (int m = 0; m < 4; ++m) {
                const int row = row0 + ai * pg8::HALF + m * 16;
                bf16_t* rowp = O + (size_t)row * ldc + col0;
#pragma unroll
                for (int bj = 0; bj < 2; ++bj) {
                    const f32x4 v0 = acc[ai][bj][m][0], v1 = acc[ai][bj][m][1];
                    u32x4 wv; wv.x = pk2(v0[0], v0[1]); wv.y = pk2(v0[2], v0[3]); wv.z = pk2(v1[0], v1[1]); wv.w = pk2(v1[2], v1[3]);
                    *(u32x4*)(rowp + bj * pg8::HALF) = wv;
                    if (m == 3 && fr == 15) *(u32x4*)(bnd + (size_t)((row >> 6) + 1) * ldc + col0 + bj * pg8::HALF) = wv;
                }
            }
    }
};

__device__ void phase_norm0(const Params& p, unsigned char* lds) {
    const int tid = threadIdx.x, lane = tid & 63, w = tid >> 6, l15 = lane & 15, g = lane >> 4;
    const float* x = p.in[0];
    bf16_t* A = (bf16_t*)(p.ws + WS_A);
    bf16_t* AD = (bf16_t*)(p.ws + WS_AD);
    bf16_t* WAD = (bf16_t*)lds;
    float* PSS = (float*)(lds + 33024);
    float* PAD = (float*)(lds + 33024 + 512);
    for (int e = tid; e < 16384; e += NTH) { const int k = e >> 4, j = e & 15; WAD[j * 1032 + k] = f2bf(p.in[2][(size_t)k * GIN + 3072 + j] * p.in[1][k]); }
    __syncthreads();
    bf16x8 wf[4];
#pragma unroll
    for (int kk = 0; kk < 4; ++kk) wf[kk] = *(const bf16x8*)(WAD + l15 * 1032 + 128 * w + 32 * kk + 8 * g);
    float4 xa[4][2];
    int tile = blockIdx.x;
    if (tile < MTOK / 16) {
#pragma unroll
        for (int kk = 0; kk < 4; ++kk) { const float4* s = (const float4*)(x + (size_t)(16 * tile + l15) * DM + 128 * w + 32 * kk + 8 * g); xa[kk][0] = s[0]; xa[kk][1] = s[1]; }
    }
    for (; tile < MTOK / 16; tile += gridDim.x) {
        float4 xv[4][2];
#pragma unroll
        for (int kk = 0; kk < 4; ++kk) { xv[kk][0] = xa[kk][0]; xv[kk][1] = xa[kk][1]; }
        if (tile + (int)gridDim.x < MTOK / 16) {
#pragma unroll
            for (int kk = 0; kk < 4; ++kk) { const float4* s = (const float4*)(x + (size_t)(16 * (tile + gridDim.x) + l15) * DM + 128 * w + 32 * kk + 8 * g); xa[kk][0] = s[0]; xa[kk][1] = s[1]; }
        }
        float ss = 0.f;
        f32x4 acc = (f32x4){0.f, 0.f, 0.f, 0.f};
#pragma unroll
        for (int kk = 0; kk < 4; ++kk) {
            const float4 a = xv[kk][0], b = xv[kk][1];
            ss += a.x * a.x + a.y * a.y + a.z * a.z + a.w * a.w + b.x * b.x + b.y * b.y + b.z * b.z + b.w * b.w;
            acc = mfma16(as_bf16x8((u32x4){pk2(a.x, a.y), pk2(a.z, a.w), pk2(b.x, b.y), pk2(b.z, b.w)}), wf[kk], acc);
        }
        ss += __shfl_xor(ss, 16); ss += __shfl_xor(ss, 32);
        if (g == 0) PSS[w * 16 + l15] = ss;
        *(f32x4*)(PAD + (w * 64 + lane) * 4) = acc;
        __syncthreads();
        float tot = 0.f;
#pragma unroll
        for (int q = 0; q < 8; ++q) tot += PSS[q * 16 + l15];
        const float rstd = rsqrtf(tot * (1.0f / DM) + 1e-6f);
#pragma unroll
        for (int kk = 0; kk < 4; ++kk) {
            const float4 a = xv[kk][0], b = xv[kk][1];
            *(u32x4*)(A + (size_t)(16 * tile + l15) * DM + 128 * w + 32 * kk + 8 * g) = (u32x4){pk2(a.x * rstd, a.y * rstd), pk2(a.z * rstd, a.w * rstd), pk2(b.x * rstd, b.y * rstd), pk2(b.z * rstd, b.w * rstd)};
        }
        if (w == 0) {
            f32x4 s = (f32x4){0.f, 0.f, 0.f, 0.f};
#pragma unroll
            for (int q = 0; q < 8; ++q) s += *(const f32x4*)(PAD + (q * 64 + lane) * 4);
#pragma unroll
            for (int r = 0; r < 4; ++r) AD[(size_t)(16 * tile + 4 * g + r) * 16 + l15] = f2bf(s[r] * __shfl(rstd, 4 * g + r));
        }
        __syncthreads();
    }
}

__device__ void phase_norm1(const Params& p) {
    const int tid = threadIdx.x, lane = tid & 63, w = tid >> 6;
    const float* x = p.in[0];
    const float* gpost = p.in[7];
    const bf16_t* Y = (const bf16_t*)(p.ws + WS_Y);
    bf16_t* A = (bf16_t*)(p.ws + WS_A);
    bf16_t* X1 = (bf16_t*)(p.ws + WS_X1);
    float4 gp[4];
#pragma unroll
    for (int i = 0; i < 4; ++i) gp[i] = ((const float4*)gpost)[lane + 64 * i];
    const int stride = gridDim.x * 8;
    float4 vn[4]; u32x2 yn[4];
    {
        const int row = blockIdx.x * 8 + w;
#pragma unroll
        for (int i = 0; i < 4; ++i) { vn[i] = ((const float4*)(x + (size_t)row * DM))[lane + 64 * i]; yn[i] = *(const u32x2*)(Y + (size_t)row * DM + 4 * (lane + 64 * i)); }
    }
    for (int row = blockIdx.x * 8 + w; row < MTOK; row += stride) {
        float4 v[4]; u32x2 yv[4];
#pragma unroll
        for (int i = 0; i < 4; ++i) { v[i] = vn[i]; yv[i] = yn[i]; }
        if (row + stride < MTOK) {
#pragma unroll
            for (int i = 0; i < 4; ++i) { vn[i] = ((const float4*)(x + (size_t)(row + stride) * DM))[lane + 64 * i]; yn[i] = *(const u32x2*)(Y + (size_t)(row + stride) * DM + 4 * (lane + 64 * i)); }
        }
        float4 y[4];
        float ss = 0.f;
#pragma unroll
        for (int i = 0; i < 4; ++i) {
            y[i].x = bf2f(yv[i].x & 0xffffu); y[i].y = bf2f(yv[i].x >> 16); y[i].z = bf2f(yv[i].y & 0xffffu); y[i].w = bf2f(yv[i].y >> 16);
            ss += y[i].x * y[i].x + y[i].y * y[i].y + y[i].z * y[i].z + y[i].w * y[i].w;
        }
        ss = wave_sum(ss);
        const float rstdy = rsqrtf(ss * (1.0f / DM) + 1e-6f);
        float s1 = 0.f;
#pragma unroll
        for (int i = 0; i < 4; ++i) {
            v[i].x += y[i].x * rstdy * gp[i].x; v[i].y += y[i].y * rstdy * gp[i].y; v[i].z += y[i].z * rstdy * gp[i].z; v[i].w += y[i].w * rstdy * gp[i].w;
            s1 += v[i].x * v[i].x + v[i].y * v[i].y + v[i].z * v[i].z + v[i].w * v[i].w;
            u32x2 xo; xo.x = pk2(v[i].x, v[i].y); xo.y = pk2(v[i].z, v[i].w);
            *(u32x2*)(X1 + (size_t)row * DM + 4 * (lane + 64 * i)) = xo;
        }
        s1 = wave_sum(s1);
        const float rstd = rsqrtf(s1 * (1.0f / DM) + 1e-6f);
#pragma unroll
        for (int i = 0; i < 4; ++i) {
            u32x2 o; o.x = pk2(v[i].x * rstd, v[i].y * rstd); o.y = pk2(v[i].z * rstd, v[i].w * rstd);
            *(u32x2*)(A + (size_t)row * DM + 4 * (lane + 64 * i)) = o;
        }
    }
}

__device__ void phase_final(const Params& p) {
    const int tid = threadIdx.x, lane = tid & 63, w = tid >> 6;
    const float* gpost = p.in[21];
    const bf16_t* Y = (const bf16_t*)(p.ws + WS_Y);
    const bf16_t* X1 = (const bf16_t*)(p.ws + WS_X1);
    float4 gp[4];
#pragma unroll
    for (int i = 0; i < 4; ++i) gp[i] = ((const float4*)gpost)[lane + 64 * i];
    const int stride = gridDim.x * 8;
    u32x2 xn[4], yn[4];
    {
        const int row = blockIdx.x * 8 + w;
#pragma unroll
        for (int i = 0; i < 4; ++i) { xn[i] = *(const u32x2*)(X1 + (size_t)row * DM + 4 * (lane + 64 * i)); yn[i] = *(const u32x2*)(Y + (size_t)row * DM + 4 * (lane + 64 * i)); }
    }
    for (int row = blockIdx.x * 8 + w; row < MTOK; row += stride) {
        u32x2 xv[4], yv[4];
#pragma unroll
        for (int i = 0; i < 4; ++i) { xv[i] = xn[i]; yv[i] = yn[i]; }
        if (row + stride < MTOK) {
#pragma unroll
            for (int i = 0; i < 4; ++i) { xn[i] = *(const u32x2*)(X1 + (size_t)(row + stride) * DM + 4 * (lane + 64 * i)); yn[i] = *(const u32x2*)(Y + (size_t)(row + stride) * DM + 4 * (lane + 64 * i)); }
        }
        float4 y[4];
        float ss = 0.f;
#pragma unroll
        for (int i = 0; i < 4; ++i) {
            y[i].x = bf2f(yv[i].x & 0xffffu); y[i].y = bf2f(yv[i].x >> 16); y[i].z = bf2f(yv[i].y & 0xffffu); y[i].w = bf2f(yv[i].y >> 16);
            ss += y[i].x * y[i].x + y[i].y * y[i].y + y[i].z * y[i].z + y[i].w * y[i].w;
        }
        ss = wave_sum(ss);
        const float rstdy = rsqrtf(ss * (1.0f / DM) + 1e-6f);
#pragma unroll
        for (int i = 0; i < 4; ++i) {
            float4 v;
            v.x = bf2f(xv[i].x & 0xffffu) + y[i].x * rstdy * gp[i].x; v.y = bf2f(xv[i].x >> 16) + y[i].y * rstdy * gp[i].y;
            v.z = bf2f(xv[i].y & 0xffffu) + y[i].z * rstdy * gp[i].z; v.w = bf2f(xv[i].y >> 16) + y[i].w * rstdy * gp[i].w;
            ((float4*)(p.out + (size_t)row * DM))[lane + 64 * i] = v;
        }
    }
}

constexpr int L_BC = 0, L_ATT = 0, L_QD = 33792, L_KD = L_QD + 64 * 136 * 2, L_KTE = L_KD + 64 * 136 * 2, L_VI = L_KTE + 64 * 144 * 2, L_SSQ = L_VI + 64 * 272 * 2, L_BL = L_SSQ + 2048, L_DEC = L_BL + 512, L_ADL = L_DEC + 512,
              L_GLA_END = L_ADL + 2048;
static_assert(L_GLA_END <= LDS_BYTES, "GLA LDS");
#define GLA_BARRIER() do { asm volatile("s_waitcnt lgkmcnt(0)" ::: "memory"); __builtin_amdgcn_s_barrier(); asm volatile("" ::: "memory"); } while (0)
typedef short gs16x4 __attribute__((ext_vector_type(4)));
__device__ __forceinline__ u32x2 g_trread(const bf16_t* p) { union { gs16x4 s; u32x2 u; } x; x.s = __builtin_amdgcn_ds_read_tr16_b64_v4i16((__attribute__((address_space(3))) gs16x4*)p); return x.u; }
template <int PITCH> __device__ __forceinline__ bf16x8 g_trfrag(const bf16_t* img, int k0, int c0, int g, int q, int pq) {
    const bf16_t* a = img + (k0 + 8 * g + q) * PITCH + c0 + 4 * pq;
    const u32x2 lo = g_trread(a), hi = g_trread(a + 4 * PITCH);
    return as_bf16x8((u32x4){lo.x, lo.y, hi.x, hi.y});
}
__device__ __forceinline__ f32x4 g_lo4(u32x4 v) { return (f32x4){bf2f(v.x & 0xffffu), bf2f(v.x >> 16), bf2f(v.y & 0xffffu), bf2f(v.y >> 16)}; }
__device__ __forceinline__ f32x4 g_hi4(u32x4 v) { return (f32x4){bf2f(v.z & 0xffffu), bf2f(v.z >> 16), bf2f(v.w & 0xffffu), bf2f(v.w >> 16)}; }
__device__ __forceinline__ u32x2 g_pk4(f32x4 v) { u32x2 r; r.x = pk2(v[0], v[1]); r.y = pk2(v[2], v[3]); return r; }
__device__ __forceinline__ f32x4 g_unpk4(u32x2 v) { return (f32x4){bf2f(v.x & 0xffffu), bf2f(v.x >> 16), bf2f(v.y & 0xffffu), bf2f(v.y >> 16)}; }

template <bool OUT> struct GlaRaw { u32x4 q[2], k[2], v[4]; };
template <bool OUT> __device__ __forceinline__ void gla_issue(GlaRaw<OUT>& x, const char* cb  , unsigned offQ, unsigned offV) {
    if (OUT) { x.q[0] = *(const u32x4*)(cb + offQ); x.q[1] = *(const u32x4*)(cb + offQ + 16); }
    x.k[0] = *(const u32x4*)(cb + offQ + 1024); x.k[1] = *(const u32x4*)(cb + offQ + 1040);
#pragma unroll
    for (int i = 0; i < 4; ++i) x.v[i] = *(const u32x4*)(cb + offV + 16 * i);
}

template <bool OUT>
__device__ void gla_pass(const Params& p, unsigned char* lds) {
    const int tid = threadIdx.x, w = __builtin_amdgcn_readfirstlane(tid >> 6);
    const bf16_t* P = (const bf16_t*)(p.ws + WS_P);
    bf16_t* GS = (bf16_t*)(p.ws + WS_GS);
    float* GD = (float*)(p.ws + WS_GD);
    bf16_t* Aout = (bf16_t*)(p.ws + WS_A);
    const bf16_t* WupT = (const bf16_t*)(p.ws + WS_WUPT);
    const bf16_t* ADG = (const bf16_t*)(p.ws + WS_AD);
    float* BC = (float*)(lds + L_BC); bf16_t* ATT = (bf16_t*)(lds + L_ATT); bf16_t* QD = (bf16_t*)(lds + L_QD); bf16_t* KD = (bf16_t*)(lds + L_KD); bf16_t* KTE = (bf16_t*)(lds + L_KTE);
    bf16_t* VI = (bf16_t*)(lds + L_VI); float* SSQ = (float*)(lds + L_SSQ); float* BL = (float*)(lds + L_BL); float* DEC = (float*)(lds + L_DEC); bf16_t* ADL = (bf16_t*)(lds + L_ADL);
    const float* b_al = p.in[4]; const float* g_head = p.in[5];

    for (int unit = blockIdx.x; unit < 256; unit += gridDim.x) {
        const int bh = unit >> 5, m = unit & 31, b = bh >> 2, h = bh & 3;
        int tidv = tid; asm volatile("" : "+v"(tidv));
        const int lane = tidv & 63, l15 = lane & 15, g = lane >> 4, q4 = l15 >> 2, p4 = l15 & 3;
        const int c = tidv >> 3, seg = tidv & 7;
        const int tokbase = b * SEQ + m * 512;
        u32x4 wupq = *(const u32x4*)(WupT + (size_t)(h * 128 + 16 * w + l15) * 16 + 8 * (g & 1));
        if (g >= 2) wupq = (u32x4){0u, 0u, 0u, 0u};
        const bf16x8 wupf = as_bf16x8(wupq);
        const float bA = b_al[h * 128 + 16 * w + l15];
        float logD = 0.f;
        f32x4 S[8][2];
#pragma unroll
        for (int mt = 0; mt < 8; ++mt)
#pragma unroll
            for (int vt = 0; vt < 2; ++vt) {
                if (OUT) S[mt][vt] = g_unpk4(*(const u32x2*)(GS + ((size_t)(bh * 32 + m) * 256 + 32 * w + 16 * vt + l15) * 128 + 16 * mt + 4 * g));
                else S[mt][vt] = (f32x4){0.f, 0.f, 0.f, 0.f};
            }
        const unsigned offQ = (unsigned)((c * GIN_P + h * 128 + 16 * seg) * 2), offV = (unsigned)((c * GIN_P + 1024 + h * 256 + 32 * seg) * 2), offAD = (unsigned)(tid * 16);
        const unsigned offG = (unsigned)((l15 * GIN_P + 2048 + h * 256 + 32 * w + 4 * g) * 2), offO = (unsigned)((l15 * DM + h * 256 + 32 * w + 4 * g) * 2);
        GlaRaw<OUT> raw;
        gla_issue<OUT>(raw, (const char*)P + (size_t)tokbase * GIN_P * 2, offQ, offV);
        if (tid < 128) *(u32x4*)(ADL + tid * 8) = *(const u32x4*)((const char*)ADG + (size_t)tokbase * 32 + offAD);
        GLA_BARRIER();

        for (int ch = 0; ch < 8; ++ch) {
            const int tok0 = tokbase + ch * 64;
            u32x4 adn = (u32x4){0u, 0u, 0u, 0u};
            {
                float run = 0.f;
                if (ch < 7 && tid < 128) adn = *(const u32x4*)((const char*)ADG + (size_t)(tok0 + 64) * 32 + offAD);
#pragma unroll
                for (int ct = 0; ct < 4; ++ct) {
                    u32x4 aq = *(const u32x4*)(ADL + (16 * ct + l15) * 16 + 8 * (g & 1));
                    if (g >= 2) aq = (u32x4){0u, 0u, 0u, 0u};
                    const f32x4 z = mfma16(as_bf16x8(aq), wupf, (f32x4){bA, bA, bA, bA});
                    f32x4 sc;
                    float acc = 0.f;
#pragma unroll
                    for (int r = 0; r < 4; ++r) { acc += (fminf(z[r], 0.f) - flog(1.f + fexp(-fabsf(z[r])))) * (1.0f / 16.0f); sc[r] = acc; }
                    float x = acc;
                    float y = __shfl_up(x, 16); if (g >= 1) x += y;
                    y = __shfl_up(x, 32); if (g >= 2) x += y;
                    const float base = run + (x - acc);
                    run += __shfl(x, 48 + l15);
#pragma unroll
                    for (int r = 0; r < 4; ++r) BC[(16 * ct + 4 * g + r) * 132 + 16 * w + l15] = base + sc[r];
                }
                if (g == 0) { BL[16 * w + l15] = run; DEC[16 * w + l15] = fexp(run); }
                if (!OUT) logD += run;
            }
            GLA_BARRIER();
            u32x2 gate[2][4];
            {
#pragma unroll
                for (int hh = 0; hh < 2; ++hh) {
                    const int o8 = 16 * seg + 8 * hh;
                    const f32x4 bb[2] = {*(const f32x4*)(BC + c * 132 + o8), *(const f32x4*)(BC + c * 132 + o8 + 4)};
                    const f32x4 dc[2] = {*(const f32x4*)(DEC + o8), *(const f32x4*)(DEC + o8 + 4)};
                    const f32x4 kx[2] = {g_lo4(raw.k[hh]), g_hi4(raw.k[hh])};
                    f32x4 qx[2];
                    if (OUT) { qx[0] = g_lo4(raw.q[hh]); qx[1] = g_hi4(raw.q[hh]); }
                    f32x4 kd[2], kt[2], qd[2];
#pragma unroll
                    for (int i = 0; i < 2; ++i)
#pragma unroll
                        for (int j = 0; j < 4; ++j) {
                            const float eB = fexp(bb[i][j]), enB = __builtin_amdgcn_rcpf(eB);
                            kd[i][j] = kx[i][j] * enB; kt[i][j] = kd[i][j] * dc[i][j];
                            if (OUT) qd[i][j] = qx[i][j] * 0.08838834764831845f * eB;
                        }
                    *(u32x4*)(KTE + c * 144 + o8) = (u32x4){pk2(kt[0][0], kt[0][1]), pk2(kt[0][2], kt[0][3]), pk2(kt[1][0], kt[1][1]), pk2(kt[1][2], kt[1][3])};
                    if (OUT) {
                        *(u32x4*)(KD + c * 136 + o8) = (u32x4){pk2(kd[0][0], kd[0][1]), pk2(kd[0][2], kd[0][3]), pk2(kd[1][0], kd[1][1]), pk2(kd[1][2], kd[1][3])};
                        *(u32x4*)(QD + c * 136 + o8) = (u32x4){pk2(qd[0][0], qd[0][1]), pk2(qd[0][2], qd[0][3]), pk2(qd[1][0], qd[1][1]), pk2(qd[1][2], qd[1][3])};
                    }
                }
#pragma unroll
                for (int i = 0; i < 4; ++i) *(u32x4*)(VI + c * 272 + 32 * seg + 8 * i) = raw.v[i];
                if (OUT) {
#pragma unroll
                    for (int vt = 0; vt < 2; ++vt)
#pragma unroll
                        for (int ct = 0; ct < 4; ++ct) gate[vt][ct] = *(const u32x2*)((const char*)P + (size_t)(tok0 + 16 * ct) * GIN_P * 2 + offG + 32 * vt);
                }
                if (ch < 7) gla_issue<OUT>(raw, (const char*)P + (size_t)(tok0 + 64) * GIN_P * 2, offQ, offV);
                if (ch < 7 && tid < 128) *(u32x4*)(ADL + tid * 8) = adn;
            }
            GLA_BARRIER();
            f32x4 o[2][4];
            if (OUT) {
#pragma unroll
                for (int t2 = 0; t2 < 2; ++t2) {
                    const int tl = 2 * w + t2, ct = tl >> 2, st = tl & 3;
                    f32x4 acc = (f32x4){0.f, 0.f, 0.f, 0.f};
                    if (st <= ct) {
#pragma unroll
                        for (int kk = 0; kk < 4; ++kk) {
                            const bf16x8 a = *(const bf16x8*)(KD + (16 * st + l15) * 136 + 32 * kk + 8 * g);
                            const bf16x8 bq = *(const bf16x8*)(QD + (16 * ct + l15) * 136 + 32 * kk + 8 * g);
                            acc = mfma16(a, bq, acc);
                        }
#pragma unroll
                        for (int r = 0; r < 4; ++r) if (16 * st + 4 * g + r > 16 * ct + l15) acc[r] = 0.f;
                    }
                    *(u32x2*)(ATT + (16 * ct + l15) * 72 + 16 * st + 4 * g) = g_pk4(acc);
                }
                GLA_BARRIER();
#pragma unroll
                for (int vt = 0; vt < 2; ++vt)
#pragma unroll
                    for (int ct = 0; ct < 4; ++ct) o[vt][ct] = (f32x4){0.f, 0.f, 0.f, 0.f};
#pragma unroll
                for (int kk = 0; kk < 4; ++kk) {
                    bf16x8 sa[2];
#pragma unroll
                    for (int vt = 0; vt < 2; ++vt) { const u32x2 s0 = g_pk4(S[2 * kk][vt]), s1 = g_pk4(S[2 * kk + 1][vt]); sa[vt] = as_bf16x8((u32x4){s0.x, s0.y, s1.x, s1.y}); }
#pragma unroll
                    for (int ct = 0; ct < 4; ++ct) {
                        const bf16_t* qr = QD + (16 * ct + l15) * 136 + 32 * kk + 4 * g;
                        const u32x2 lo = *(const u32x2*)qr, hi = *(const u32x2*)(qr + 16);
                        const bf16x8 bq = as_bf16x8((u32x4){lo.x, lo.y, hi.x, hi.y});
#pragma unroll
                        for (int vt = 0; vt < 2; ++vt) o[vt][ct] = mfma16(sa[vt], bq, o[vt][ct]);
                    }
                }
            }
            bf16x8 bv[2][2];
#pragma unroll
            for (int vt = 0; vt < 2; ++vt)
#pragma unroll
                for (int kk = 0; kk < 2; ++kk) bv[vt][kk] = g_trfrag<272>(VI, 32 * kk, 32 * w + 16 * vt, g, q4, p4);
            if (OUT) {
#pragma unroll
                for (int ct = 0; ct < 4; ++ct)
#pragma unroll
                    for (int kk = 0; kk < 2; ++kk) {
                        if (32 * kk <= 16 * ct + 15) {
                            const bf16x8 bq = *(const bf16x8*)(ATT + (16 * ct + l15) * 72 + 32 * kk + 8 * g);
#pragma unroll
                            for (int vt = 0; vt < 2; ++vt) o[vt][ct] = mfma16(bv[vt][kk], bq, o[vt][ct]);
                        }
                    }
            }
#pragma unroll
            for (int mt = 0; mt < 8; ++mt) {
                const f32x4 dv = *(const f32x4*)(DEC + 16 * mt + 4 * g);
#pragma unroll
                for (int vt = 0; vt < 2; ++vt) S[mt][vt] *= dv;
#pragma unroll
                for (int kk = 0; kk < 2; ++kk) {
                    const bf16x8 a = g_trfrag<144>(KTE, 32 * kk, 16 * mt, g, q4, p4);
#pragma unroll
                    for (int vt = 0; vt < 2; ++vt) S[mt][vt] = mfma16(a, bv[vt][kk], S[mt][vt]);
                }
            }
            if (OUT) {
                float ss[4];
#pragma unroll
                for (int ct = 0; ct < 4; ++ct) {
                    float s = 0.f;
#pragma unroll
                    for (int vt = 0; vt < 2; ++vt)
#pragma unroll
                        for (int r = 0; r < 4; ++r) s += o[vt][ct][r] * o[vt][ct][r];
                    s += __shfl_xor(s, 16); s += __shfl_xor(s, 32);
                    ss[ct] = s;
                }
                if (g == 0) {
#pragma unroll
                    for (int ct = 0; ct < 4; ++ct) SSQ[(16 * ct + l15) * 8 + w] = ss[ct];
                }
                f32x4 gh[2];
#pragma unroll
                for (int vt = 0; vt < 2; ++vt) gh[vt] = *(const f32x4*)(g_head + 32 * w + 16 * vt + 4 * g);
                GLA_BARRIER();
#pragma unroll
                for (int ct = 0; ct < 4; ++ct) {
                    const int cc = 16 * ct + l15;
                    const float4 s0 = *(const float4*)(SSQ + cc * 8), s1 = *(const float4*)(SSQ + cc * 8 + 4);
                    const float tot = (s0.x + s0.y) + (s0.z + s0.w) + (s1.x + s1.y) + (s1.z + s1.w);
                    const float rstd = rsqrtf(tot * (1.0f / 256.0f) + 1e-6f);
#pragma unroll
                    for (int vt = 0; vt < 2; ++vt) {
                        const f32x4 gt = g_unpk4(gate[vt][ct]);
                        f32x4 val;
#pragma unroll
                        for (int r = 0; r < 4; ++r) val[r] = o[vt][ct][r] * rstd * gh[vt][r] * gt[r] * __builtin_amdgcn_rcpf(1.0f + fexp(-gt[r]));
                        *(u32x2*)((char*)Aout + (size_t)(tok0 + 16 * ct) * DM * 2 + offO + 32 * vt) = g_pk4(val);
                    }
                }
            } else {
                GLA_BARRIER();
            }
        }
        if (!OUT) {
#pragma unroll
            for (int mt = 0; mt < 8; ++mt)
#pragma unroll
                for (int vt = 0; vt < 2; ++vt) *(u32x2*)(GS + ((size_t)(bh * 32 + m) * 256 + 32 * w + 16 * vt + l15) * 128 + 16 * mt + 4 * g) = g_pk4(S[mt][vt]);
            if (g == 0) GD[(bh * 32 + m) * 128 + 16 * w + l15] = fexp(logD);
        }
        GLA_BARRIER();
    }
}

__device__ void gla_scan(const Params& p) {
    bf16_t* GS = (bf16_t*)(p.ws + WS_GS);
    const float* GD = (const float*)(p.ws + WS_GD);
    for (int idx = blockIdx.x * NTH + threadIdx.x; idx < 8 * 8192; idx += gridDim.x * NTH) {
        const int bh = idx >> 13, e = (idx & 8191) * 4, d = e & 127;
        f32x4 S = (f32x4){0.f, 0.f, 0.f, 0.f};
        for (int m0 = 0; m0 < 32; m0 += 8) {
            u32x2 t[8]; f32x4 dd[8];
#pragma unroll
            for (int m = 0; m < 8; ++m) { t[m] = *(const u32x2*)(GS + (size_t)(bh * 32 + m0 + m) * 32768 + e); dd[m] = *(const f32x4*)(GD + (bh * 32 + m0 + m) * 128 + d); }
#pragma unroll
            for (int m = 0; m < 8; ++m) { *(u32x2*)(GS + (size_t)(bh * 32 + m0 + m) * 32768 + e) = g_pk4(S); S = S * dd[m] + g_unpk4(t[m]); }
        }
    }
}

constexpr int PP = RIN_P;
constexpr size_t WS_RK  = WS_GS;
constexpr size_t WS_BND = WS_GS + (size_t)MTOK * 16 * 4;
static_assert(WS_BND + (size_t)513 * PP * 2 <= WS_GD, "RWKV side buffers must fit the GLA state region");
constexpr int IMG = 64 * 72 * 2;
constexpr int R_ALB = 0, R_BH = IMG, R_KH = 2 * IMG, R_RB = 3 * IMG, R_BTL = 4 * IMG, R_KTL = 5 * IMG, R_VI = 6 * IMG, R_AAB = 7 * IMG, R_AAK = 8 * IMG, R_ARB = 9 * IMG, R_ARK = 10 * IMG,
              R_DW = R_AAB, R_DA = R_AAB + 64 * 68 * 4, R_XT = 11 * IMG, R_TW = R_XT, R_ADI = R_XT + IMG, R_TDF = R_XT + 2 * IMG, R_CS = R_TDF + 2048, R_GC = R_CS + 2048, R_CONST = R_GC + 256,
              R_END = R_CONST + 2560;
static_assert(R_DA + 64 * 68 * 4 <= R_XT && R_END <= LDS_BYTES, "R1 LDS");
#define LDS_BARRIER() do { asm volatile("s_waitcnt lgkmcnt(0)" ::: "memory"); __builtin_amdgcn_s_barrier(); asm volatile("" ::: "memory"); } while (0)

typedef short s16x4 __attribute__((ext_vector_type(4)));
__device__ __forceinline__ bf16x8 ldfrag(const bf16_t* img, int row, int koff) { return *(const bf16x8*)(img + row * 72 + koff); }
__device__ __forceinline__ u32x2 pk4(f32x4 v) { u32x2 r; r.x = pk2(v[0], v[1]); r.y = pk2(v[2], v[3]); return r; }
__device__ __forceinline__ f32x4 unpk4(u32x2 v) { return (f32x4){bf2f(v.x & 0xffffu), bf2f(v.x >> 16), bf2f(v.y & 0xffffu), bf2f(v.y >> 16)}; }
__device__ __forceinline__ u32x2 trread(const bf16_t* p) {
    union { s16x4 s; u32x2 u; } x; x.s = __builtin_amdgcn_ds_read_tr16_b64_v4i16((__attribute__((address_space(3))) s16x4*)p); return x.u;
}
__device__ __forceinline__ bf16x8 trfrag(const bf16_t* img, int k0, int c0, int g, int q, int pq) {
    const bf16_t* a = img + (k0 + 8 * g + q) * 72 + c0 + 4 * pq;
    const u32x2 lo = trread(a), hi = trread(a + 4 * 72);
    return as_bf16x8((u32x4){lo.x, lo.y, hi.x, hi.y});
}
__device__ __forceinline__ f32x4 lo4(u32x4 v) { return (f32x4){bf2f(v.x & 0xffffu), bf2f(v.x >> 16), bf2f(v.y & 0xffffu), bf2f(v.y >> 16)}; }
__device__ __forceinline__ f32x4 hi4(u32x4 v) { return (f32x4){bf2f(v.z & 0xffffu), bf2f(v.z >> 16), bf2f(v.w & 0xffffu), bf2f(v.w >> 16)}; }
__device__ __forceinline__ u32x4 pk8(f32x4 a, f32x4 b) { return (u32x4){pk2(a[0], a[1]), pk2(a[2], a[3]), pk2(b[0], b[1]), pk2(b[2], b[3])}; }
__device__ __forceinline__ float fast_rcp(float x) { return __builtin_amdgcn_rcpf(x); }
__device__ __forceinline__ f32x4 mm16(f32x4 xa, f32x4 yb, f32x4 c) {
    const u32x2 a = pk4(xa), b = pk4(yb);
    return mfma16(as_bf16x8((u32x4){a.x, a.y, 0u, 0u}), as_bf16x8((u32x4){b.x, b.y, 0u, 0u}), c);
}

struct R1Raw { u32x4 r0, r1, k0, k1, v0, v1, w0, w1, a0, a1; };
__device__ __forceinline__ void r1_issue(R1Raw& x, const bf16_t* P, const bf16_t* BND, int unit, int t, int cs) {
    const int bn = unit >> 4, h = unit & 15, n = bn & 255;
    const bf16_t* cur = P + ((size_t)bn * 64 + t) * PP;
    const bf16_t* prv = (t > 0) ? (cur - PP) : (BND + (size_t)(n == 0 ? 0 : bn) * PP);
    const int ch = h * 64 + 8 * cs;
    x.r0 = *(const u32x4*)(cur + ch); x.k0 = *(const u32x4*)(cur + 1024 + ch); x.v0 = *(const u32x4*)(cur + 2048 + ch); x.w0 = *(const u32x4*)(cur + 4096 + 8 * cs); x.a0 = *(const u32x4*)(cur + 4160 + 8 * cs);
    x.r1 = *(const u32x4*)(prv + ch); x.k1 = *(const u32x4*)(prv + 1024 + ch); x.v1 = *(const u32x4*)(prv + 2048 + ch); x.w1 = *(const u32x4*)(prv + 4096 + 8 * cs); x.a1 = *(const u32x4*)(prv + 4160 + 8 * cs);
}
__device__ __forceinline__ void lerp8(u32x4 c, u32x4 pv, const float* mu8, f32x4& o0, f32x4& o1) {
    const f32x4 c0 = lo4(c), c1 = hi4(c), p0 = lo4(pv), p1 = hi4(pv);
    const f32x4 m0 = *(const f32x4*)mu8, m1 = *(const f32x4*)(mu8 + 4);
    o0 = c0 + m0 * (p0 - c0); o1 = c1 + m1 * (p1 - c1);
}

__device__ void rwkv_r1(const Params& p, unsigned char* lds) {
    const int tid = threadIdx.x, w = __builtin_amdgcn_readfirstlane(tid >> 6);
    bf16_t* P = (bf16_t*)(p.ws + WS_P);
    bf16_t* Abuf = (bf16_t*)(p.ws + WS_A);
    bf16_t* Ybuf = (bf16_t*)(p.ws + WS_Y);
    float* RK = (float*)(p.ws + WS_RK);
    const bf16_t* BND = (const bf16_t*)(p.ws + WS_BND);
    const bf16_t* WduT = (const bf16_t*)(p.ws + WS_WDUT);
    const bf16_t* WiuT = (const bf16_t*)(p.ws + WS_WIUT);
    bf16_t* ALB = (bf16_t*)(lds + R_ALB); bf16_t* BH = (bf16_t*)(lds + R_BH); bf16_t* KH = (bf16_t*)(lds + R_KH); bf16_t* RB = (bf16_t*)(lds + R_RB);
    bf16_t* BTL = (bf16_t*)(lds + R_BTL); bf16_t* KTL = (bf16_t*)(lds + R_KTL); bf16_t* VI = (bf16_t*)(lds + R_VI);
    bf16_t* AAB = (bf16_t*)(lds + R_AAB); bf16_t* AAK = (bf16_t*)(lds + R_AAK); bf16_t* ARB = (bf16_t*)(lds + R_ARB); bf16_t* ARK = (bf16_t*)(lds + R_ARK);
    float* DW = (float*)(lds + R_DW); float* DA = (float*)(lds + R_DA);
    bf16_t* XT = (bf16_t*)(lds + R_XT); bf16_t* TW = (bf16_t*)(lds + R_TW); bf16_t* ADI = (bf16_t*)(lds + R_ADI);
    u32x2* TDF = (u32x2*)(lds + R_TDF); float* CS = (float*)(lds + R_CS); float* GCs = (float*)(lds + R_GC); float* CONST = (float*)(lds + R_CONST);
    const int t0_ = tid >> 3, cs0_ = tid & 7;
    int hprev = -1;
    R1Raw raw;
    if (blockIdx.x < 8192) r1_issue(raw, P, BND, blockIdx.x, t0_, cs0_);

    for (int unit = blockIdx.x; unit < 8192; unit += gridDim.x) {
        const int bn = unit >> 4, h = unit & 15, n = bn & 255;
        const size_t R0 = (size_t)bn * 64;
        int tidv = tid; asm volatile("" : "+v"(tidv));
        const int lane = tidv & 63, l15 = lane & 15, g = lane >> 4, q4 = l15 >> 2, p4 = l15 & 3, t = tidv >> 3, cs = tidv & 7, tl = lane >> 3;
        if (h != hprev) {
            LDS_BARRIER();
            if (tid < 64) {
                const int ch = h * 64 + tid;
                CONST[tid] = p.in[10][ch]; CONST[64 + tid] = p.in[10][1024 + ch]; CONST[128 + tid] = p.in[10][2048 + ch];
                CONST[192 + tid] = p.in[11][ch]; CONST[256 + tid] = p.in[13][ch]; CONST[320 + tid] = p.in[15][ch]; CONST[384 + tid] = p.in[16][ch]; CONST[448 + tid] = p.in[17][ch];
                CONST[512 + tid] = p.in[10][4096 + tid]; CONST[576 + tid] = p.in[10][4160 + tid];
            }
            hprev = h;
            LDS_BARRIER();
        }
        bf16x8 fwd[2][2], fwi[2][2];
#pragma unroll
        for (int q = 0; q < 2; ++q)
#pragma unroll
            for (int kk = 0; kk < 2; ++kk) {
                const size_t o = (size_t)(h * 64 + 16 * (2 * (w >> 2) + q) + l15) * 64 + 32 * kk + 8 * g;
                fwd[q][kk] = *(const bf16x8*)(WduT + o); fwi[q][kk] = *(const bf16x8*)(WiuT + o);
            }
        f32x4 r0, r1, k0, k1, v0, v1;
        {
            f32x4 wd0, wd1, ad0, ad1;
            lerp8(raw.r0, raw.r1, CONST + 8 * cs, r0, r1);
            lerp8(raw.k0, raw.k1, CONST + 64 + 8 * cs, k0, k1);
            lerp8(raw.v0, raw.v1, CONST + 128 + 8 * cs, v0, v1);
            lerp8(raw.w0, raw.w1, CONST + 512 + 8 * cs, wd0, wd1);
            lerp8(raw.a0, raw.a1, CONST + 576 + 8 * cs, ad0, ad1);
#pragma unroll
            for (int j = 0; j < 4; ++j) {
                const float e0 = fexp(-2.f * fabsf(wd0[j])), e1 = fexp(-2.f * fabsf(wd1[j]));
                wd0[j] = copysignf((1.f - e0) * fast_rcp(1.f + e0), wd0[j]); wd1[j] = copysignf((1.f - e1) * fast_rcp(1.f + e1), wd1[j]);
            }
            *(u32x4*)(TW + t * 72 + 8 * cs) = pk8(wd0, wd1);
            *(u32x4*)(ADI + t * 72 + 8 * cs) = pk8(ad0, ad1);
        }
        if (unit + (int)gridDim.x < 8192) r1_issue(raw, P, BND, unit + gridDim.x, t, cs);
        LDS_BARRIER();
        {
            const int tt = w & 3;
            bf16x8 ft[2], fa[2];
#pragma unroll
            for (int kk = 0; kk < 2; ++kk) { ft[kk] = ldfrag(TW, 16 * tt + l15, 32 * kk + 8 * g); fa[kk] = ldfrag(ADI, 16 * tt + l15, 32 * kk + 8 * g); }
#pragma unroll
            for (int q = 0; q < 2; ++q) {
                const int ct = 2 * (w >> 2) + q;
                f32x4 aw = (f32x4){0.f, 0.f, 0.f, 0.f}, aa = aw;
#pragma unroll
                for (int kk = 0; kk < 2; ++kk) { aw = mfma16(fwd[q][kk], ft[kk], aw); aa = mfma16(fwi[q][kk], fa[kk], aa); }
                *(f32x4*)(DW + (16 * tt + l15) * 68 + 16 * ct + 4 * g) = aw;
                *(f32x4*)(DA + (16 * tt + l15) * 68 + 16 * ct + 4 * g) = aa;
            }
        }
        LDS_BARRIER();
        f32x4 lw[2], av[2], kk[2], k2[2], G[2];
        {
            const f32x4 cw0[2] = {*(const f32x4*)(CONST + 192 + 8 * cs), *(const f32x4*)(CONST + 196 + 8 * cs)};
            const f32x4 ca0[2] = {*(const f32x4*)(CONST + 256 + 8 * cs), *(const f32x4*)(CONST + 260 + 8 * cs)};
            const f32x4 ckk[2] = {*(const f32x4*)(CONST + 320 + 8 * cs), *(const f32x4*)(CONST + 324 + 8 * cs)};
            const f32x4 cka[2] = {*(const f32x4*)(CONST + 384 + 8 * cs), *(const f32x4*)(CONST + 388 + 8 * cs)};
            const f32x4 crk[2] = {*(const f32x4*)(CONST + 448 + 8 * cs), *(const f32x4*)(CONST + 452 + 8 * cs)};
            const f32x4 dwv[2] = {*(const f32x4*)(DW + t * 68 + 8 * cs), *(const f32x4*)(DW + t * 68 + 8 * cs + 4)};
            const f32x4 dav[2] = {*(const f32x4*)(DA + t * 68 + 8 * cs), *(const f32x4*)(DA + t * 68 + 8 * cs + 4)};
            const f32x4 kin[2] = {k0, k1}, rin[2] = {r0, r1};
            float n2 = 0.f, rk = 0.f;
#pragma unroll
            for (int hf = 0; hf < 2; ++hf)
#pragma unroll
                for (int j = 0; j < 4; ++j) {
                    const float z = -(cw0[hf][j] + dwv[hf][j]);
                    const float sp = fmaxf(z, 0.f) + flog(1.f + fexp(-fabsf(z)));
                    lw[hf][j] = -fexp(-sp - 0.5f);
                    av[hf][j] = fast_rcp(1.f + fexp(-(ca0[hf][j] + dav[hf][j])));
                    kk[hf][j] = kin[hf][j] * ckk[hf][j];
                    k2[hf][j] = kin[hf][j] * (1.f + (av[hf][j] - 1.f) * cka[hf][j]);
                    n2 += kk[hf][j] * kk[hf][j]; rk += rin[hf][j] * k2[hf][j] * crk[hf][j];
                }
            n2 += __shfl_xor(n2, 1); rk += __shfl_xor(rk, 1); n2 += __shfl_xor(n2, 2); rk += __shfl_xor(rk, 2); n2 += __shfl_xor(n2, 4); rk += __shfl_xor(rk, 4);
            const float inv = 1.0f / fmaxf(sqrtf(n2), 1e-12f);
            kk[0] *= inv; kk[1] *= inv;
            if (cs == 0) RK[(R0 + t) * 16 + h] = rk;
            G[0] = lw[0]; G[1] = lw[1];
#pragma unroll
            for (int d = 1; d < 8; d <<= 1)
#pragma unroll
                for (int hf = 0; hf < 2; ++hf)
#pragma unroll
                    for (int j = 0; j < 4; ++j) { const float y = __shfl_up(G[hf][j], 8 * d); if (tl >= d) G[hf][j] += y; }
            if (tl == 7) { *(f32x4*)(CS + w * 64 + 8 * cs) = G[0]; *(f32x4*)(CS + w * 64 + 8 * cs + 4) = G[1]; }
        }
        LDS_BARRIER();
        {
            f32x4 off[2] = {(f32x4){0.f, 0.f, 0.f, 0.f}, (f32x4){0.f, 0.f, 0.f, 0.f}}, gc[2] = {off[0], off[0]};
#pragma unroll
            for (int q = 0; q < 8; ++q) {
                const f32x4 c0 = *(const f32x4*)(CS + q * 64 + 8 * cs), c1 = *(const f32x4*)(CS + q * 64 + 8 * cs + 4);
                const float mk = (q < w) ? 1.f : 0.f;
                gc[0] += c0; gc[1] += c1; off[0] += c0 * mk; off[1] += c1 * mk;
            }
            f32x4 al[2], bh[2], kh[2], rb[2];
            const f32x4 rin[2] = {r0, r1};
#pragma unroll
            for (int hf = 0; hf < 2; ++hf)
#pragma unroll
                for (int j = 0; j < 4; ++j) {
                    const float Gi = G[hf][j] + off[hf][j];
                    const float eG = fexp(Gi), eGm = fexp(Gi - lw[hf][j]), enG = fast_rcp(eG);
                    const float be = kk[hf][j] * av[hf][j];
                    al[hf][j] = -kk[hf][j] * eGm; bh[hf][j] = be * enG; kh[hf][j] = k2[hf][j] * enG; rb[hf][j] = rin[hf][j] * eG;
                }
            const int o = t * 72 + 8 * cs;
            *(u32x4*)(ALB + o) = pk8(al[0], al[1]); *(u32x4*)(BH + o) = pk8(bh[0], bh[1]); *(u32x4*)(KH + o) = pk8(kh[0], kh[1]); *(u32x4*)(RB + o) = pk8(rb[0], rb[1]);
            const u32x4 vpk = pk8(v0, v1);
            *(u32x4*)(VI + o) = vpk;
            *(u32x4*)(Ybuf + (R0 + t) * DM + h * 64 + 8 * cs) = vpk;
            if (w == 0 && tl == 0) { f32x4 e0, e1;
#pragma unroll
                for (int j = 0; j < 4; ++j) { e0[j] = fexp(gc[0][j]); e1[j] = fexp(gc[1][j]); }
                *(f32x4*)(GCs + 8 * cs) = e0; *(f32x4*)(GCs + 8 * cs + 4) = e1; }
        }
        LDS_BARRIER();
        {
            int ntile = 1, tta = 0, sta = 0, ttb = 0, stb = 0;
            if (w == 0) { tta = 0; sta = 0; } else if (w == 2) { tta = 1; sta = 1; } else if (w == 5) { tta = 2; sta = 2; } else if (w == 7) { tta = 3; sta = 3; }
            else if (w == 1) { ntile = 2; tta = 1; sta = 0; ttb = 2; stb = 0; } else if (w == 3) { ntile = 2; tta = 2; sta = 1; ttb = 3; stb = 0; }
            else if (w == 4) { tta = 3; sta = 1; } else { tta = 3; sta = 2; }
            for (int it = 0; it < ntile; ++it) {
                const int tt = it ? ttb : tta, st = it ? stb : sta;
                f32x4 cab = (f32x4){0.f, 0.f, 0.f, 0.f}, cak = cab, crb = cab, crk = cab, nab = cab;
#pragma unroll
                for (int kq = 0; kq < 2; ++kq) {
                    const bf16x8 fb = ldfrag(BH, 16 * st + l15, 32 * kq + 8 * g), fk = ldfrag(KH, 16 * st + l15, 32 * kq + 8 * g);
                    const bf16x8 fa = ldfrag(ALB, 16 * tt + l15, 32 * kq + 8 * g), fr = ldfrag(RB, 16 * tt + l15, 32 * kq + 8 * g);
                    cab = mfma16(fb, fa, cab); cak = mfma16(fk, fa, cak); crb = mfma16(fb, fr, crb); crk = mfma16(fk, fr, crk);
                    if (tt == st) nab = mfma16(fa, fb, nab);
                }
                if (tt == st) {
#pragma unroll
                    for (int r = 0; r < 4; ++r) {
                        const int s = 4 * g + r, tq = l15;
                        if (s >= tq) { cab[r] = 0.f; cak[r] = 0.f; }
                        if (s > tq) { crb[r] = 0.f; crk[r] = 0.f; }
                        if (l15 >= 4 * g + r) nab[r] = 0.f;
                    }
                }
                const int o = (16 * tt + l15) * 72 + 16 * st + 4 * g;
                *(u32x2*)(AAB + o) = pk4(cab); *(u32x2*)(AAK + o) = pk4(cak); *(u32x2*)(ARB + o) = pk4(crb); *(u32x2*)(ARK + o) = pk4(crk);
                if (tt == st) {
                    const f32x4 z = (f32x4){0.f, 0.f, 0.f, 0.f};
                    const f32x4 Q1 = cab, N1 = nab;
                    const f32x4 Q2 = mm16(N1, Q1, z), N2 = mm16(Q1, N1, z);
                    f32x4 Pm = Q1;
#pragma unroll
                    for (int r = 0; r < 4; ++r) if (4 * g + r == l15) Pm[r] += 1.f;
                    Pm = mm16(N2, Pm, Pm);
                    const f32x4 Q4 = mm16(N2, Q2, z), N4 = mm16(Q2, N2, z);
                    Pm = mm16(N4, Pm, Pm);
                    const f32x4 N8 = mm16(Q4, N4, z);
                    Pm = mm16(N8, Pm, Pm);
                    TDF[tt * 64 + lane] = pk4(Pm);
                }
            }
            if (w == 4 || w == 6) {
                const int tt = (w == 4) ? 0 : 2, st = tt + 1;
                const int o = (16 * tt + l15) * 72 + 16 * st + 4 * g;
                const u32x2 zz = (u32x2){0u, 0u};
                *(u32x2*)(AAK + o) = zz; *(u32x2*)(ARB + o) = zz; *(u32x2*)(ARK + o) = zz;
            }
        }
        LDS_BARRIER();
        {
            u32x2 xb[4];
            const int col = 16 * w + l15;
            bf16x8 vfr[2];
            if (w >= 4) { vfr[0] = trfrag(VI, 0, 16 * (w - 4), g, q4, p4); vfr[1] = trfrag(VI, 32, 16 * (w - 4), g, q4, p4); }
#pragma unroll
            for (int i = 0; i < 4; ++i) {
                f32x4 z;
                if (w < 4) z = unpk4(trread(ALB + (16 * i + 4 * g + q4) * 72 + 16 * w + 4 * p4));
                else {
                    z = mfma16(ldfrag(AAK, 16 * i + l15, 8 * g), vfr[0], (f32x4){0.f, 0.f, 0.f, 0.f});
                    if (i >= 2) z = mfma16(ldfrag(AAK, 16 * i + l15, 32 + 8 * g), vfr[1], z);
                }
                if (i >= 1) {
                    const bf16_t* ar = AAB + (16 * i + l15) * 72 + 4 * g;
                    const u32x2 a0 = *(const u32x2*)ar;
                    u32x2 a1 = (u32x2){0u, 0u}, b1 = (u32x2){0u, 0u};
                    if (i >= 2) { a1 = *(const u32x2*)(ar + 16); b1 = xb[1]; }
                    z = mfma16(as_bf16x8((u32x4){a0.x, a0.y, a1.x, a1.y}), as_bf16x8((u32x4){xb[0].x, xb[0].y, b1.x, b1.y}), z);
                    if (i == 3) {
                        const u32x2 a2 = *(const u32x2*)(ar + 32);
                        z = mfma16(as_bf16x8((u32x4){a2.x, a2.y, 0u, 0u}), as_bf16x8((u32x4){xb[2].x, xb[2].y, 0u, 0u}), z);
                    }
                }
                const u32x2 tq = TDF[i * 64 + lane];
                const u32x2 zq = pk4(z);
                const f32x4 x = mfma16(as_bf16x8((u32x4){tq.x, tq.y, 0u, 0u}), as_bf16x8((u32x4){zq.x, zq.y, 0u, 0u}), (f32x4){0.f, 0.f, 0.f, 0.f});
                xb[i] = pk4(x);
                *(u32x2*)(XT + col * 72 + 16 * i + 4 * g) = xb[i];
            }
        }
        LDS_BARRIER();
        {
            const int rt_ = w & 3, c0 = 2 * (w >> 2);
            bf16x8 xw[2], xu[2], fbt[2], fkt[2], fvr[2];
#pragma unroll
            for (int kq = 0; kq < 2; ++kq) {
                xw[kq] = ldfrag(XT, 16 * rt_ + l15, 32 * kq + 8 * g);
                xu[kq] = ldfrag(XT, 64 + 16 * rt_ + l15, 32 * kq + 8 * g);
                fbt[kq] = trfrag(BH, 32 * kq, 16 * rt_, g, q4, p4);
                fkt[kq] = trfrag(KH, 32 * kq, 16 * rt_, g, q4, p4);
                fvr[kq] = trfrag(VI, 32 * kq, 16 * rt_, g, q4, p4);
            }
            const float gcd0 = GCs[16 * c0 + l15], gcd1 = GCs[16 * c0 + 16 + l15];
            const f32x4 gcr = *(const f32x4*)(GCs + 16 * rt_ + 4 * g);
#pragma unroll
            for (int q = 0; q < 2; ++q) {
                bf16x8 gbt[2], garb[2], gxu[2], gvi[2], gark[2];
#pragma unroll
                for (int kq = 0; kq < 2; ++kq) {
                    gbt[kq] = trfrag(BH, 32 * kq, 16 * (c0 + q), g, q4, p4);
                    garb[kq] = ldfrag(ARB, 16 * (c0 + q) + l15, 32 * kq + 8 * g);
                    gxu[kq] = ldfrag(XT, 64 + 16 * (c0 + q) + l15, 32 * kq + 8 * g);
                    gvi[kq] = trfrag(VI, 32 * kq, 16 * (c0 + q), g, q4, p4);
                    gark[kq] = ldfrag(ARK, 16 * (c0 + q) + l15, 32 * kq + 8 * g);
                }
                const u32x2 rbi = *(const u32x2*)(RB + (16 * (c0 + q) + l15) * 72 + 16 * rt_ + 4 * g);
                __builtin_amdgcn_sched_barrier(0);
                const int ctile = c0 + q;
                {
                    f32x4 acc = (f32x4){0.f, 0.f, 0.f, 0.f};
#pragma unroll
                    for (int kq = 0; kq < 2; ++kq) acc = mfma16(xw[kq], gbt[kq], acc);
                    const int dcol = 16 * ctile + l15;
                    if (rt_ == ctile) {
#pragma unroll
                        for (int r = 0; r < 4; ++r) if (4 * g + r == l15) acc[r] += 1.f;
                    }
                    acc *= (q ? gcd1 : gcd0);
                    *(u32x2*)(ALB + dcol * 72 + 32 * (rt_ >> 1) + 8 * g + 4 * (rt_ & 1)) = pk4(acc);
                }
                {
                    f32x4 acc = unpk4(rbi);
#pragma unroll
                    for (int kq = 0; kq < 2; ++kq) {
                        if (32 * kq <= 16 * ctile + 15) acc = mfma16(xw[kq], garb[kq], acc);
                    }
                    *(u32x2*)(BTL + (16 * ctile + l15) * 72 + 16 * rt_ + 4 * g) = pk4(acc);
                }
                {
                    f32x4 acc = (f32x4){0.f, 0.f, 0.f, 0.f};
#pragma unroll
                    for (int kq = 0; kq < 2; ++kq) { acc = mfma16(fbt[kq], gxu[kq], acc); acc = mfma16(fkt[kq], gvi[kq], acc); }
                    *(u32x2*)(KTL + (16 * ctile + l15) * 72 + 16 * rt_ + 4 * g) = pk4(acc * gcr);
                }
                {
                    f32x4 acc = (f32x4){0.f, 0.f, 0.f, 0.f};
#pragma unroll
                    for (int kq = 0; kq < 2; ++kq) {
                        if (32 * kq <= 16 * ctile + 15) { acc = mfma16(xu[kq], garb[kq], acc); acc = mfma16(fvr[kq], gark[kq], acc); }
                    }
                    *(u32x2*)(AAB + (16 * ctile + l15) * 72 + 16 * rt_ + 4 * g) = pk4(acc);
                }
            }
        }
        LDS_BARRIER();
        {
            const int o = t * 72 + 8 * cs;
            *(u32x4*)(P + (R0 + t) * PP + h * 64 + 8 * cs) = *(const u32x4*)(ALB + o);
            *(u32x4*)(P + (R0 + t) * PP + 1024 + h * 64 + 8 * cs) = *(const u32x4*)(BTL + o);
            *(u32x4*)(P + (R0 + t) * PP + 2048 + h * 64 + 8 * cs) = *(const u32x4*)(KTL + o);
            *(u32x4*)(Abuf + (R0 + t) * DM + h * 64 + 8 * cs) = *(const u32x4*)(AAB + o);
        }
    }
}

constexpr int SC_SLOT = 2 * IMG;
constexpr size_t WS_MG = (WS_BND + (size_t)513 * PP * 2 + 255) & ~(size_t)255;
constexpr size_t WS_NG = WS_MG + (size_t)1024 * 4096 * 2;
static_assert(WS_NG + (size_t)1024 * 4096 * 2 <= WS_GD, "scan buffers must fit the GLA state region");

template <int MODE>
__device__ void rwkv_scan2(const Params& p, unsigned char* lds) {
    constexpr int SPU = (MODE == 2) ? 32 : 8;
    constexpr int NU = (MODE == 2) ? 32 : 1024;
    const int tid = threadIdx.x, lane = tid & 63, w = __builtin_amdgcn_readfirstlane(tid >> 6), l15 = lane & 15, g = lane >> 4;
    bf16_t* P = (bf16_t*)(p.ws + WS_P);
    bf16_t* MG = (bf16_t*)(p.ws + WS_MG); bf16_t* NG = (bf16_t*)(p.ws + WS_NG); bf16_t* HG = NG;
    const int G = gridDim.x;
    const int nun = ((int)blockIdx.x < NU) ? (NU - 1 - (int)blockIdx.x) / G + 1 : 0;
    const int T = nun * SPU;
    if (T == 0) return;
#define SC_SRC(s, p0, p1, pitchb) \
    const int u_ = (int)blockIdx.x + G * ((s) / SPU), j_ = (s) % SPU; \
    const char* p0; const char* p1; unsigned pitchb; \
    if (MODE == 2) { p0 = (const char*)(MG + (size_t)(u_ * 32 + j_) * 4096); p1 = (const char*)(NG + (size_t)(u_ * 32 + j_) * 4096); pitchb = 128u; } \
    else { const int bh_ = u_ >> 5, n_ = 8 * (u_ & 31) + j_; p0 = (const char*)(P + ((size_t)(bh_ >> 4) * SEQ + (size_t)n_ * 64) * PP + (bh_ & 15) * 64); p1 = p0 + 4096; pitchb = (unsigned)(PP * 2); }
    if (w >= 4) {
        const int lj = w - 4;
        const unsigned loff = (unsigned)((lane >> 3) * 144 + (lane & 7) * 16);
        u32x4 ld0[16], ld1[16];
#define SC_ISSUE(dst, s) do { const int sc_ = ((s) < T) ? (s) : T - 1; SC_SRC(sc_, q0_, q1_, pb_) const unsigned go_ = (unsigned)(lane >> 3) * pb_ + (unsigned)(lane & 7) * 16u; \
        _Pragma("unroll") for (int q = 0; q < 16; ++q) dst[q] = *(const u32x4*)(((q >> 3) ? q1_ : q0_) + (size_t)((q & 7) * 8) * pb_ + go_); } while (0)
#define SC_RETIRE(src, s) do { unsigned char* sb = lds + ((s) & 1) * SC_SLOT + loff; _Pragma("unroll") for (int q = 0; q < 16; ++q) \
        *(u32x4*)(sb + (q >> 3) * IMG + (q & 7) * 8 * 144) = src[q]; } while (0)
        SC_ISSUE(ld0, lj); SC_ISSUE(ld1, lj + 4);
        for (int it = 0; it < T / 8; ++it) {
            const int c0 = lj + 8 * it;
            for (int k = 0; k < lj; ++k) LDS_BARRIER();
            SC_RETIRE(ld0, c0); SC_ISSUE(ld0, c0 + 8);
            for (int k = 0; k < 4; ++k) LDS_BARRIER();
            SC_RETIRE(ld1, c0 + 4); SC_ISSUE(ld1, c0 + 12);
            for (int k = 0; k < 4 - lj; ++k) LDS_BARRIER();
        }
        LDS_BARRIER();
#undef SC_ISSUE
#undef SC_RETIRE
    } else {
        f32x4 H[4], Mg[4];
        for (int i = 0; i <= T; ++i) {
            if (i >= 1) {
                const int s = i - 1, u = (int)blockIdx.x + G * (s / SPU), j = s % SPU;
                const unsigned char* sb = lds + (s & 1) * SC_SLOT;
                const bf16_t* MT = (const bf16_t*)sb; const bf16_t* NT = (const bf16_t*)(sb + IMG);
                if (j == 0) {
                    if (MODE == 3) {
#pragma unroll
                        for (int mt = 0; mt < 4; ++mt) H[mt] = unpk4(*(const u32x2*)(HG + (size_t)u * 4096 + (16 * w + l15) * 64 + 16 * mt + 4 * g));
                    } else {
#pragma unroll
                        for (int mt = 0; mt < 4; ++mt) H[mt] = (f32x4){0.f, 0.f, 0.f, 0.f};
                    }
                    if (MODE == 1) {
#pragma unroll
                        for (int mt = 0; mt < 4; ++mt)
#pragma unroll
                            for (int r = 0; r < 4; ++r) Mg[mt][r] = (16 * mt + 4 * g + r == 16 * w + l15) ? 1.f : 0.f;
                    }
                }
                u32x2 hp[4];
#pragma unroll
                for (int mt = 0; mt < 4; ++mt) hp[mt] = pk4(H[mt]);
                if (MODE == 2) {
#pragma unroll
                    for (int mt = 0; mt < 4; ++mt) *(u32x2*)(HG + (size_t)(u * 32 + j) * 4096 + (16 * w + l15) * 64 + 16 * mt + 4 * g) = hp[mt];
                }
                if (MODE == 3) {
                    const int bh = u >> 5, n = 8 * (u & 31) + j;
#pragma unroll
                    for (int mt = 0; mt < 4; ++mt) *(u32x2*)(P + ((size_t)(bh >> 4) * SEQ + (size_t)n * 64 + 16 * w + l15) * PP + 2048 + (bh & 15) * 64 + 16 * mt + 4 * g) = hp[mt];
                }
                bf16x8 hb[2], mb[2];
                hb[0] = as_bf16x8((u32x4){hp[0].x, hp[0].y, hp[1].x, hp[1].y});
                hb[1] = as_bf16x8((u32x4){hp[2].x, hp[2].y, hp[3].x, hp[3].y});
                if (MODE == 1) {
                    const u32x2 m0 = pk4(Mg[0]), m1 = pk4(Mg[1]), m2 = pk4(Mg[2]), m3 = pk4(Mg[3]);
                    mb[0] = as_bf16x8((u32x4){m0.x, m0.y, m1.x, m1.y}); mb[1] = as_bf16x8((u32x4){m2.x, m2.y, m3.x, m3.y});
                }
#pragma unroll
                for (int mt = 0; mt < 4; ++mt) {
                    const bf16x8 a0 = ldfrag(MT, 16 * mt + l15, 8 * g), a1 = ldfrag(MT, 16 * mt + l15, 32 + 8 * g);
                    f32x4 acc = unpk4(*(const u32x2*)(NT + (16 * w + l15) * 72 + 16 * mt + 4 * g));
                    acc = mfma16(a0, hb[0], acc); acc = mfma16(a1, hb[1], acc);
                    H[mt] = acc;
                    if (MODE == 1) { f32x4 am = mfma16(a0, mb[0], (f32x4){0.f, 0.f, 0.f, 0.f}); am = mfma16(a1, mb[1], am); Mg[mt] = am; }
                }
                if (MODE == 1 && j == SPU - 1) {
                    const int pc = 32 * (w >> 1) + 8 * (l15 >> 2) + 4 * (w & 1) + (l15 & 3);
#pragma unroll
                    for (int mt = 0; mt < 4; ++mt) {
                        *(u32x2*)(NG + (size_t)u * 4096 + (16 * w + l15) * 64 + 16 * mt + 4 * g) = pk4(H[mt]);
#pragma unroll
                        for (int r = 0; r < 4; ++r) MG[(size_t)u * 4096 + (16 * mt + 4 * g + r) * 64 + pc] = f2bf(Mg[mt][r]);
                    }
                }
            }
            LDS_BARRIER();
        }
    }
#undef SC_SRC
}

__device__ void rwkv_post(const Params& p, unsigned char* lds) {
    const int tid = threadIdx.x, lane = tid & 63, w = __builtin_amdgcn_readfirstlane(tid >> 6), l15 = lane & 15, g = lane >> 4;
    const bf16_t* P = (const bf16_t*)(p.ws + WS_P);
    bf16_t* Abuf = (bf16_t*)(p.ws + WS_A);
    const bf16_t* Ybuf = (const bf16_t*)(p.ws + WS_Y);
    const float* RK = (const float*)(p.ws + WS_RK);
    const bf16_t* BND = (const bf16_t*)(p.ws + WS_BND);
    float* L = (float*)(lds + w * 8704);
    const int tr = lane >> 3, seg = lane & 7;
    for (int hu = blockIdx.x * 8 + w; hu < 16384; hu += gridDim.x * 8) {
        const int unit = hu >> 1, t0 = (hu & 1) * 32;
        const int bn = unit >> 4, h = unit & 15, n = bn & 255;
        const size_t R0 = (size_t)bn * 64;
        bf16x8 fh[4][2], fr[2][2];
#pragma unroll
        for (int kk = 0; kk < 2; ++kk) {
#pragma unroll
            for (int q = 0; q < 4; ++q) fh[q][kk] = *(const bf16x8*)(P + (R0 + 16 * q + l15) * PP + 2048 + h * 64 + 32 * kk + 8 * g);
#pragma unroll
            for (int q = 0; q < 2; ++q) fr[q][kk] = *(const bf16x8*)(P + (R0 + t0 + 16 * q + l15) * PP + 1024 + h * 64 + 32 * kk + 8 * g);
        }
        u32x4 y0r[4], g1r[4], g0r[4], vpr[4];
        float rkv[4];
#pragma unroll
        for (int i = 0; i < 4; ++i) {
            const int t = t0 + tr + 8 * i;
            y0r[i] = *(const u32x4*)(Abuf + (R0 + t) * DM + h * 64 + 8 * seg);
            const bf16_t* grow = P + (R0 + t) * PP + 3072 + h * 64 + 8 * seg;
            g1r[i] = *(const u32x4*)grow;
            g0r[i] = *(const u32x4*)((t > 0) ? (grow - PP) : (BND + (size_t)(n == 0 ? 0 : bn) * PP + 3072 + h * 64 + 8 * seg));
            vpr[i] = *(const u32x4*)(Ybuf + (R0 + t) * DM + h * 64 + 8 * seg);
            rkv[i] = RK[(R0 + t) * 16 + h];
        }
#pragma unroll
        for (int i = 0; i < 4; ++i) { *(f32x4*)(L + (tr + 8 * i) * 68 + 8 * seg) = lo4(y0r[i]); *(f32x4*)(L + (tr + 8 * i) * 68 + 8 * seg + 4) = hi4(y0r[i]); }
        f32x4 y[4][2];
#pragma unroll
        for (int vt = 0; vt < 4; ++vt)
#pragma unroll
            for (int tt = 0; tt < 2; ++tt) y[vt][tt] = *(const f32x4*)(L + (16 * tt + l15) * 68 + 16 * vt + 4 * g);
#pragma unroll
        for (int vt = 0; vt < 4; ++vt)
#pragma unroll
            for (int tt = 0; tt < 2; ++tt)
#pragma unroll
                for (int kk = 0; kk < 2; ++kk) y[vt][tt] = mfma16(fh[vt][kk], fr[tt][kk], y[vt][tt]);
#pragma unroll
        for (int tt = 0; tt < 2; ++tt) {
            float s1 = 0.f, s2 = 0.f;
#pragma unroll
            for (int vt = 0; vt < 4; ++vt)
#pragma unroll
                for (int r = 0; r < 4; ++r) { s1 += y[vt][tt][r]; s2 += y[vt][tt][r] * y[vt][tt][r]; }
            s1 += __shfl_xor(s1, 16); s2 += __shfl_xor(s2, 16); s1 += __shfl_xor(s1, 32); s2 += __shfl_xor(s2, 32);
            const float mean = s1 * (1.0f / 64.0f);
            const float rstd = rsqrtf(fmaxf(s2 * (1.0f / 64.0f) - mean * mean, 0.f) + 64e-5f);
#pragma unroll
            for (int vt = 0; vt < 4; ++vt) *(f32x4*)(L + (16 * tt + l15) * 68 + 16 * vt + 4 * g) = (y[vt][tt] - mean) * rstd;
        }
        const int ch = h * 64 + 8 * seg;
        const f32x4 lw0 = *(const f32x4*)(p.in[18] + ch), lw1 = *(const f32x4*)(p.in[18] + ch + 4), lb0 = *(const f32x4*)(p.in[19] + ch), lb1 = *(const f32x4*)(p.in[19] + ch + 4);
        const f32x4 mg0 = *(const f32x4*)(p.in[10] + 3072 + ch), mg1 = *(const f32x4*)(p.in[10] + 3072 + ch + 4);
#pragma unroll
        for (int i = 0; i < 4; ++i) {
            const int t = t0 + tr + 8 * i;
            const f32x4 n0 = *(const f32x4*)(L + (tr + 8 * i) * 68 + 8 * seg), n1 = *(const f32x4*)(L + (tr + 8 * i) * 68 + 8 * seg + 4);
            const f32x4 ga0 = lo4(g1r[i]), ga1 = hi4(g1r[i]);
            const f32x4 gb0 = lo4(g0r[i]), gb1 = hi4(g0r[i]);
            const f32x4 gt0 = ga0 + mg0 * (gb0 - ga0), gt1 = ga1 + mg1 * (gb1 - ga1);
            const f32x4 v0 = lo4(vpr[i]), v1 = hi4(vpr[i]);
            f32x4 o0 = n0 * lw0 + lb0 + rkv[i] * v0, o1 = n1 * lw1 + lb1 + rkv[i] * v1;
#pragma unroll
            for (int j = 0; j < 4; ++j) { o0[j] *= gt0[j] * __builtin_amdgcn_rcpf(1.0f + fexp(-gt0[j])); o1[j] *= gt1[j] * __builtin_amdgcn_rcpf(1.0f + fexp(-gt1[j])); }
            *(u32x4*)(Abuf + (R0 + t) * DM + h * 64 + 8 * seg) = pk8(o0, o1);
        }
    }
}
#define XB_TMO      128
#define XB_XCNT(j)  (256  + 64 * (j))
#define XB_XSUB(j)  (1280 + 64 * (j))
#define XB_XGEN(j)  (2304 + 64 * (j))
#define XB_TOP      3328
#define XB_TOPGEN   3392
#define XCD_BAR_WORDS 3456
#define XB_SPIN_CAP (1u << 18)
#define LAS __attribute__((address_space(3)))

__device__ __forceinline__ unsigned xb_ld(unsigned* p)              { return __hip_atomic_load(p, __ATOMIC_RELAXED, __HIP_MEMORY_SCOPE_AGENT); }
__device__ __forceinline__ unsigned xb_add(unsigned* p, unsigned v) { return __hip_atomic_fetch_add(p, v, __ATOMIC_RELAXED, __HIP_MEMORY_SCOPE_AGENT); }
__device__ __forceinline__ unsigned xb_xcc_id() { return (unsigned)__builtin_amdgcn_s_getreg((3 << 11) | 20) & 0xFu; }
#define XB_SPIN(cond, bar) do { unsigned _sp = 0; while (cond) { __builtin_amdgcn_s_sleep(1); \
    if ((++_sp & 255u) == 0u) { if (xb_ld(&(bar)[XB_TMO])) break; if (_sp > XB_SPIN_CAP) { atomicAdd(&(bar)[XB_TMO], 1u); break; } } } } while (0)

struct XcdBarrier {
    unsigned* bar; unsigned x;
    volatile LAS unsigned* st;
};

__device__ __forceinline__ XcdBarrier xcd_barrier_post(unsigned* bar, volatile LAS unsigned* st) {
    XcdBarrier b; b.bar = bar; b.x = xb_xcc_id(); b.st = st;
    if (threadIdx.x == 0) (void)xb_add(&bar[XB_XCNT(b.x)], 1u);
    return b;
}
__device__ __forceinline__ void xcd_barrier_complete(unsigned* bar, unsigned x, unsigned& nloc, unsigned& nx) {
    const unsigned G = gridDim.x * gridDim.y * gridDim.z;
    unsigned sum, cnt, mine, sp = 0u;
    for (;;) {
        sum = 0u; cnt = 0u; mine = 0u;
#pragma unroll
        for (unsigned j = 0; j < 16; ++j) { const unsigned c = xb_ld(&bar[XB_XCNT(j)]); sum += c; cnt += (c > 0u) ? 1u : 0u; mine = (j == x) ? c : mine; }
        if (sum == G) break;
        __builtin_amdgcn_s_sleep(1);
        if ((++sp & 255u) == 0u) { if (xb_ld(&bar[XB_TMO])) break; if (sp > XB_SPIN_CAP) { atomicAdd(&bar[XB_TMO], 1u); break; } }
    }
    nloc = mine > 0u ? mine : 1u; nx = cnt > 0u ? cnt : 1u;
}

__device__ __forceinline__ void xcd_barrier(const XcdBarrier& b) {
    asm volatile("s_waitcnt vmcnt(0)" ::: "memory");
    __syncthreads();
    if (threadIdx.x == 0) {
        unsigned* bar = b.bar;
        __builtin_amdgcn_s_waitcnt(0);
        unsigned nloc = b.st[0], nx = b.st[1];
        if (nloc == 0u) { xcd_barrier_complete(bar, b.x, nloc, nx); b.st[0] = nloc; b.st[1] = nx; }
        const unsigned old = xb_add(&bar[XB_XSUB(b.x)], 1u);
        const unsigned gen = old / nloc;
        if (old + 1u == (gen + 1u) * nloc) {
            __builtin_amdgcn_fence(__ATOMIC_RELEASE, "agent");
            asm volatile("s_waitcnt vmcnt(0)" ::: "memory");
            const unsigned og = xb_add(&bar[XB_TOP], 1u);
            const unsigned tg = og / nx;
            if (og + 1u == (tg + 1u) * nx) xb_add(&bar[XB_TOPGEN], 1u);
            else XB_SPIN(xb_ld(&bar[XB_TOPGEN]) == tg, bar);
            __builtin_amdgcn_fence(__ATOMIC_ACQUIRE, "agent");
            xb_add(&bar[XB_XGEN(b.x)], 1u);
            asm volatile("s_waitcnt vmcnt(0)" ::: "memory");
        } else {
            XB_SPIN(xb_ld(&bar[XB_XGEN(b.x)]) == gen, bar);
            __builtin_amdgcn_fence(__ATOMIC_ACQUIRE, "agent");
            asm volatile("s_waitcnt vmcnt(0)" ::: "memory");
        }
    }
    __syncthreads();
}


#ifndef PROBE_ID
#define PROBE_ID 0
#endif
#ifndef N_LAUNCH_MODE
#define N_LAUNCH_MODE 1
#endif
constexpr int N_PHASES = 15;

__global__ void __launch_bounds__(NTH, 2) fwd_kernel(Params p) {
    extern __shared__ __attribute__((aligned(16))) unsigned char lds[];
    const int lo = p.ph_lo, hi = p.ph_hi;
    volatile LAS unsigned* xst = (volatile LAS unsigned*)(lds + LDS_BYTES);
    if (threadIdx.x < 4) xst[threadIdx.x] = 0u;
    __syncthreads();
    const XcdBarrier xbar = xcd_barrier_post((unsigned*)(p.ws + WS_BAR), xst);
    unsigned char* ws = p.ws;
#define IN(k) (lo <= (k) && (k) < hi)
#define SEAM(k) do { if ((k) + 1 < hi) xcd_barrier(xbar); } while (0)
    if (IN(0)) {
        prep_weight(p.in[2], GIN, p.in[1], (bf16_t*)(ws + WS_WGIN), GIN_P, (float*)lds);
        prep_weight(p.in[6], DM, nullptr, (bf16_t*)(ws + WS_WGOUT), DM, (float*)lds);
        prep_wup(p.in[3], (bf16_t*)(ws + WS_WUPT));
        __syncthreads();
        phase_norm0(p, lds);
        SEAM(0);
    }
    if (IN(1)) {
        pg8::Gemm g{(const bf16_t*)(ws + WS_A), (const bf16_t*)(ws + WS_WGIN), MTOK, GIN_P, DM}; pg8::StaticOrder S; S.init(MTOK, GIN_P, gridDim.x, blockIdx.x);
        pg8::EpiBf16<0> E{(bf16_t*)(ws + WS_P), GIN_P, nullptr, 0, 0};
        pg8::gemm_phase<pg8::EpiBf16<0>, pg8::StaticOrder>((PG8_LAS unsigned char*)lds, g, S, E);
        SEAM(1);
    }
    if (IN(2)) { gla_pass<false>(p, lds); SEAM(2); }
    if (IN(3)) {
        gla_scan(p);
        prep_weight(p.in[9], RIN, p.in[8], (bf16_t*)(ws + WS_WRIN), RIN_P, (float*)lds);
        prep_weight(p.in[20], DM, nullptr, (bf16_t*)(ws + WS_WROUT), DM, (float*)lds);
        prep_lowrank(p.in[12], (bf16_t*)(ws + WS_WDUT));
        prep_lowrank(p.in[14], (bf16_t*)(ws + WS_WIUT));
        SEAM(3);
    }
    if (IN(4)) { gla_pass<true>(p, lds); SEAM(4); }
    if (IN(5)) {
        pg8::Gemm g{(const bf16_t*)(ws + WS_A), (const bf16_t*)(ws + WS_WGOUT), MTOK, DM, DM}; pg8::StaticOrder S; S.init(MTOK, DM, gridDim.x, blockIdx.x);
        pg8::EpiBf16<0> E{(bf16_t*)(ws + WS_Y), DM, nullptr, 0, 0};
        pg8::gemm_phase<pg8::EpiBf16<0>, pg8::StaticOrder>((PG8_LAS unsigned char*)lds, g, S, E);
        SEAM(5);
    }
    if (IN(6)) { phase_norm1(p); zero_bnd_row((bf16_t*)(ws + WS_BND)); SEAM(6); }
    if (IN(7)) {
        pg8::Gemm g{(const bf16_t*)(ws + WS_A), (const bf16_t*)(ws + WS_WRIN), MTOK, RIN_P, DM}; pg8::StaticOrder S; S.init(MTOK, RIN_P, gridDim.x, blockIdx.x);
        EpiBf16Bnd E{(bf16_t*)(ws + WS_P), RIN_P, (bf16_t*)(ws + WS_BND)};
        pg8::gemm_phase<EpiBf16Bnd, pg8::StaticOrder>((PG8_LAS unsigned char*)lds, g, S, E);
        SEAM(7);
    }
    if (IN(8)) { rwkv_r1(p, lds); SEAM(8); }
    if (IN(9)) { rwkv_scan2<1>(p, lds); SEAM(9); }
    if (IN(10)) { rwkv_scan2<2>(p, lds); SEAM(10); }
    if (IN(11)) { rwkv_scan2<3>(p, lds); SEAM(11); }
    if (IN(12)) { rwkv_post(p, lds); SEAM(12); }
    if (IN(13)) {
        pg8::Gemm g{(const bf16_t*)(ws + WS_A), (const bf16_t*)(ws + WS_WROUT), MTOK, DM, DM}; pg8::StaticOrder S; S.init(MTOK, DM, gridDim.x, blockIdx.x);
        pg8::EpiBf16<0> E{(bf16_t*)(ws + WS_Y), DM, nullptr, 0, 0};
        pg8::gemm_phase<pg8::EpiBf16<0>, pg8::StaticOrder>((PG8_LAS unsigned char*)lds, g, S, E);
        SEAM(13);
    }
    if (IN(14)) { phase_final(p); }
#undef IN
#undef SEAM
}

extern "C" void kernel_launch(void* const* d_in, const int* in_sizes, int n_in, void* d_out, int out_size, void* d_ws, size_t ws_size, hipStream_t stream) {
    static int grid = 0;
    if (grid == 0) {
        int dev = 0, cus = 0, per_cu = 0;
        hipGetDevice(&dev);
        hipDeviceGetAttribute(&cus, hipDeviceAttributeMultiprocessorCount, dev);
        hipFuncSetAttribute((const void*)fwd_kernel, hipFuncAttributeMaxDynamicSharedMemorySize, LDS_BYTES + 16);
        hipOccupancyMaxActiveBlocksPerMultiprocessor(&per_cu, (const void*)fwd_kernel, NTH, LDS_BYTES + 16);
        if (per_cu < 1) { fprintf(stderr, "kernel_launch: occupancy query says %d blocks per CU\n", per_cu); per_cu = 1; }
        grid = cus;
        if (n_in != 22 || ws_size < WS_END) fprintf(stderr, "kernel_launch: unexpected n_in %d or workspace %zu < %zu\n", n_in, ws_size, (size_t)WS_END);
        (void)hipGetLastError();
    }
    if (hipMemsetAsync((char*)d_ws + WS_BAR, 0, XCD_BAR_WORDS * 4, stream) != hipSuccess) fprintf(stderr, "kernel_launch: memset of the barrier words failed\n");
    Params p{};
    for (int i = 0; i < 22; ++i) p.in[i] = (const float*)d_in[i];
    p.out = (float*)d_out; p.ws = (unsigned char*)d_ws;
#if N_LAUNCH_MODE == 1
    void* args[] = {&p};
#if PROBE_ID > 0
    p.ph_lo = 0; p.ph_hi = PROBE_ID;
    (void)hipLaunchCooperativeKernel((const void*)fwd_kernel, dim3(grid), dim3(NTH), args, LDS_BYTES + 16, stream);
    (void)hipMemsetAsync((char*)d_ws + WS_BAR, 0, XCD_BAR_WORDS * 4, stream);
#endif
    p.ph_lo = 0; p.ph_hi = N_PHASES;
    hipError_t e = hipLaunchCooperativeKernel((const void*)fwd_kernel, dim3(grid), dim3(NTH), args, LDS_BYTES + 16, stream);
    if (e != hipSuccess) fprintf(stderr, "cooperative launch failed: %s (grid %d)\n", hipGetErrorString(e), grid);
#else
    for (int k = 0; k < N_PHASES; ++k) {
        p.ph_lo = k; p.ph_hi = k + 1;
        hipLaunchKernelGGL(fwd_kernel, dim3(grid), dim3(NTH), LDS_BYTES + 16, stream, p);
    }
#endif
}
```

```cpp
#include <hip/hip_runtime.h>
#include <hip/hip_cooperative_groups.h>
#include <cstdio>
namespace cg = cooperative_groups;
#define PROBE_ID 0
#define N_LAUNCH_MODE 1
namespace pg8 {
#define PG8_LAS __attribute__((address_space(3)))
typedef unsigned short bf16_t;
typedef short bf16x8 __attribute__((ext_vector_type(8)));
typedef float f32x4 __attribute__((ext_vector_type(4)));
typedef unsigned u32x4 __attribute__((ext_vector_type(4)));
constexpr int BM = 256, BK = 64, HALF = 128, HTB = HALF * BK * 2  , STAGE_BYTES = 8 * HTB, NXCD = 8, WGM = 8;

__host__ __device__ __forceinline__ int lds_byte(int r, int c) { const int st = (r >> 4) * 2 + (c >> 5), rr = r & 15, cc = c & 31, ob = rr * 64 + cc * 2; return st * 1024 + (ob ^ (((ob >> 9) & 1) << 5)); }
__host__ __device__ __forceinline__ void stage_rc(int b, int& R, int& C) { const int st = b / 1024, sb = b % 1024, swz = sb ^ (((sb >> 9) & 1) << 5); R = (st >> 1) * 16 + swz / 64; C = (st & 1) * 32 + (swz % 64) / 2; }
__host__ __device__ __forceinline__ int perm32(int rho) { const int n = rho >> 4, i = rho & 15; return 8 * (i >> 2) + 4 * n + (i & 3); }

struct Unit { int pm, pn; };
struct Gemm { const bf16_t* A; const bf16_t* Bt; int M, N, K; };

struct StaticOrder {
    int nM, nN, nwg, G, c;
    __host__ __device__ void init(int M, int N, int G_, int c_) { nM = M / BM; nN = N / BM; nwg = nM * nN; G = G_; c = c_; }
    __host__ __device__ bool next(int i, Unit& u) const {
        const long L = (long)i * G + c; if (L >= nwg) return false;
        int wgid = (int)L; { const int q = nwg / NXCD, r = nwg % NXCD, xcd = wgid % NXCD, off = wgid / NXCD; wgid = (xcd < r ? xcd * (q + 1) : r * (q + 1) + (xcd - r) * q) + off; }
        const int nig = WGM * nN, gid = wgid / nig, fm = gid * WGM, gsz = (nM - fm) < WGM ? (nM - fm) : WGM;
        u.pm = fm + ((wgid % nig) % gsz); u.pn = (wgid % nig) / gsz; return true;
    }
    __device__ __forceinline__ void a_ready(const Unit&) const {}
    __device__ __forceinline__ void done(const Unit&) const {}
};

typedef float cvt_f32x2 __attribute__((ext_vector_type(2)));
typedef __bf16 cvt_bf16x2 __attribute__((ext_vector_type(2)));
__device__ __forceinline__ unsigned cvt_pk_bf16(float lo, float hi) { const cvt_f32x2 v = {lo, hi}; union { cvt_bf16x2 b; unsigned u; } x; x.b = __builtin_convertvector(v, cvt_bf16x2); return x.u; }
typedef float f32x2 __attribute__((ext_vector_type(2)));
struct EpiF32 {
    static constexpr bool PERM = false, AFTER_DRAIN = false;
    float* C; int ldc; const float* bias;
    __device__ __forceinline__ void operator()(const f32x4 (&acc)[2][2][4][2], const Unit& u, int wr, int wc, int fr, int fq) const {
        const int row0 = u.pm * BM + wr * 64 + fr, col0 = u.pn * BM + wc * 32 + 4 * fq;
        f32x4 bv[2][2];
#pragma unroll
        for (int bj = 0; bj < 2; ++bj)
#pragma unroll
            for (int n = 0; n < 2; ++n) bv[bj][n] = bias ? *(const f32x4*)(bias + col0 + bj * HALF + n * 16) : (f32x4){0.f, 0.f, 0.f, 0.f};
#pragma unroll
        for (int ai = 0; ai < 2; ++ai)
#pragma unroll
            for (int m = 0; m < 4; ++m) { float* rowp = C + (size_t)(row0 + ai * HALF + m * 16) * ldc + col0;
#pragma unroll
                for (int bj = 0; bj < 2; ++bj)
#pragma unroll
                    for (int n = 0; n < 2; ++n) *(f32x4*)(rowp + bj * HALF + n * 16) = acc[ai][bj][m][n] + bv[bj][n]; }
    }
};
template <int ACT  > struct EpiBf16 {
    static constexpr bool PERM = true, AFTER_DRAIN = false;
    bf16_t* O; int ldc; const float* bias; int split_cols; size_t split_stride;
    __device__ __forceinline__ void operator()(const f32x4 (&acc)[2][2][4][2], const Unit& u, int wr, int wc, int fr, int fq) const {
        const int row0 = u.pm * BM + wr * 64 + fr; int colt = u.pn * BM; bf16_t* base = O;
        if (split_cols) { const int t = colt / split_cols; base += (size_t)t * split_stride; colt -= t * split_cols; }
        const int col0 = colt + wc * 32 + 8 * fq, bcol0 = u.pn * BM + wc * 32 + 8 * fq;
        f32x4 bv[2][2];
#pragma unroll
        for (int bj = 0; bj < 2; ++bj)
#pragma unroll
            for (int n = 0; n < 2; ++n) bv[bj][n] = bias ? *(const f32x4*)(bias + bcol0 + bj * HALF + 4 * n) : (f32x4){0.f, 0.f, 0.f, 0.f};
#pragma unroll
        for (int ai = 0; ai < 2; ++ai)
#pragma unroll
            for (int m = 0; m < 4; ++m) { bf16_t* rowp = base + (size_t)(row0 + ai * HALF + m * 16) * ldc + col0;
#pragma unroll
                for (int bj = 0; bj < 2; ++bj) { f32x4 v0 = acc[ai][bj][m][0] + bv[bj][0], v1 = acc[ai][bj][m][1] + bv[bj][1];
                    u32x4 w; w.x = cvt_pk_bf16(v0[0], v0[1]); w.y = cvt_pk_bf16(v0[2], v0[3]); w.z = cvt_pk_bf16(v1[0], v1[1]); w.w = cvt_pk_bf16(v1[2], v1[3]);
                    *(u32x4*)(rowp + bj * HALF) = w; } }
    }
};

template <class Epi, class Sched>
__device__ __forceinline__ void gemm_phase(PG8_LAS unsigned char* lds, const Gemm g, const Sched& S, const Epi& E) {
    const int tid = threadIdx.x, wid = __builtin_amdgcn_readfirstlane(tid >> 6), lane = tid & 63, wr = wid >> 2, wc = wid & 3, fr = lane & 15, fq = lane >> 4;
    const int K = g.K, nt = K / BK;
    unsigned voffA[2], voffB[2];
#pragma unroll
    for (int i = 0; i < 2; ++i) { int R, C; stage_rc(tid * 16 + i * 8192, R, C); const int Rb = Epi::PERM ? ((R & ~31) + perm32(R & 31)) : R;
        voffA[i] = (unsigned)(R * K + C) * 2u; voffB[i] = (unsigned)(Rb * K + C) * 2u; }
    const size_t kstep = (size_t)(BK * 2);
    const size_t hstep = (size_t)HALF * K * 2;
    const size_t tstep = 2 * hstep;
    const unsigned ldsw = (unsigned)wid * 1024u;
    const int aoff = lds_byte(wr * 64 + fr, fq * 8), boff = lds_byte(wc * 32 + fr, fq * 8);
#define PG8_SA(b, h) (((b) * 2 + (h)) * HTB)
#define PG8_SB(b, h) ((4 + (b) * 2 + (h)) * HTB)
#define PG8_STAGE(bufoff, gbase, voff) do { _Pragma("unroll") for (int _i = 0; _i < 2; ++_i) \
        __builtin_amdgcn_global_load_lds((const unsigned*)((const char*)(gbase) + (voff)[_i]), (PG8_LAS unsigned*)(lds + (bufoff) + ldsw + _i * 8192), 16, 0, 0); } while (0)
#define PG8_LDA(dst, b, h) do { _Pragma("unroll") for (int m = 0; m < 4; ++m) _Pragma("unroll") for (int k = 0; k < 2; ++k) dst[m][k] = *(const PG8_LAS bf16x8*)(lds + PG8_SA(b, h) + aoff + m * 2048 + k * 1024); } while (0)
#define PG8_LDB(dst, b, h) do { _Pragma("unroll") for (int n = 0; n < 2; ++n) _Pragma("unroll") for (int k = 0; k < 2; ++k) dst[n][k] = *(const PG8_LAS bf16x8*)(lds + PG8_SB(b, h) + boff + n * 2048 + k * 1024); } while (0)
#define PG8_MMA(ai, bj, At, Bt) do { __builtin_amdgcn_s_setprio(1); _Pragma("unroll") for (int m = 0; m < 4; ++m) _Pragma("unroll") for (int n = 0; n < 2; ++n) _Pragma("unroll") for (int k = 0; k < 2; ++k) \
        acc[ai][bj][m][n] = __builtin_amdgcn_mfma_f32_16x16x32_bf16(Bt[n][k], At[m][k], acc[ai][bj][m][n], 0, 0, 0); __builtin_amdgcn_s_setprio(0); } while (0)
#define PG8_WAIT_V(n) asm volatile("s_waitcnt vmcnt(" #n ")" ::: "memory")
#define PG8_WAIT_L(n) asm volatile("s_waitcnt lgkmcnt(" #n ")" ::: "memory")
#define PG8_BAR __builtin_amdgcn_s_barrier()
#define PG8_SCHED __builtin_amdgcn_sched_barrier(0)
    Unit cur, nxt; int ui = 0;
    if (!S.next(0, cur)) return;
    f32x4 acc[2][2][4][2];
#pragma unroll
    for (int a = 0; a < 2; ++a)
#pragma unroll
        for (int b = 0; b < 2; ++b)
#pragma unroll
            for (int m = 0; m < 4; ++m)
#pragma unroll
                for (int n = 0; n < 2; ++n) acc[a][b][m][n] = (f32x4){0.f, 0.f, 0.f, 0.f};
    bf16x8 At[4][2], B0[2][2], B1[2][2];
    const char* cA = (const char*)g.A + (size_t)cur.pm * tstep; const char* cB = (const char*)g.Bt + (size_t)cur.pn * tstep;
    S.a_ready(cur);
    PG8_STAGE(PG8_SB(0, 0), cB, voffB); PG8_STAGE(PG8_SA(0, 0), cA, voffA); PG8_STAGE(PG8_SB(0, 1), cB + hstep, voffB); PG8_STAGE(PG8_SA(0, 1), cA + hstep, voffA);
    if (wr == 1) PG8_BAR;
    PG8_WAIT_V(4); PG8_BAR;
    PG8_STAGE(PG8_SB(1, 0), cB + kstep, voffB); PG8_STAGE(PG8_SA(1, 0), cA + kstep, voffA); PG8_STAGE(PG8_SB(1, 1), cB + hstep + kstep, voffB);
    PG8_WAIT_V(6); PG8_BAR;
    for (;;) {
        const bool has_next = S.next(ui + 1, nxt);
        const char* nA = has_next ? (const char*)g.A + (size_t)nxt.pm * tstep : cA; const char* nB = has_next ? (const char*)g.Bt + (size_t)nxt.pn * tstep : cB;
        for (int t = 0; t < nt; t += 2) {
            const bool last = (t == nt - 2);
            const char* a1 = cA + (size_t)(t + 1) * kstep;
            const char* a2 = last ? nA : cA + (size_t)(t + 2) * kstep; const char* b2 = last ? nB : cB + (size_t)(t + 2) * kstep;
            const char* a3 = a2 + kstep; const char* b3 = b2 + kstep;
            if (last && has_next) S.a_ready(nxt);
            PG8_LDB(B0, 0, 0); PG8_SCHED; PG8_LDA(At, 0, 0); PG8_STAGE(PG8_SA(1, 1), a1 + hstep, voffA);
            PG8_WAIT_L(8); PG8_BAR; PG8_WAIT_L(0); PG8_MMA(0, 0, At, B0); PG8_BAR; PG8_SCHED;
            PG8_LDB(B1, 0, 1); PG8_STAGE(PG8_SB(0, 0), b2, voffB);
            PG8_BAR; PG8_WAIT_L(0); PG8_MMA(0, 1, At, B1); PG8_BAR;
            PG8_LDA(At, 0, 1); PG8_STAGE(PG8_SA(0, 0), a2, voffA);
            PG8_BAR; PG8_WAIT_L(0); PG8_MMA(1, 0, At, B0); PG8_BAR; PG8_SCHED;
            PG8_STAGE(PG8_SB(0, 1), b2 + hstep, voffB);
            PG8_WAIT_V(6); PG8_BAR; PG8_MMA(1, 1, At, B1); PG8_BAR;
            PG8_LDB(B0, 1, 0); PG8_SCHED; PG8_LDA(At, 1, 0); PG8_STAGE(PG8_SA(0, 1), a2 + hstep, voffA);
            PG8_WAIT_L(8); PG8_BAR; PG8_WAIT_L(0); PG8_MMA(0, 0, At, B0); PG8_BAR; PG8_SCHED;
            PG8_LDB(B1, 1, 1); PG8_STAGE(PG8_SB(1, 0), b3, voffB);
            PG8_BAR; PG8_WAIT_L(0); PG8_MMA(0, 1, At, B1); PG8_BAR;
            PG8_LDA(At, 1, 1); PG8_STAGE(PG8_SA(1, 0), a3, voffA);
            PG8_BAR; PG8_WAIT_L(0); PG8_MMA(1, 0, At, B0); PG8_BAR; PG8_SCHED;
            PG8_STAGE(PG8_SB(1, 1), b3 + hstep, voffB);
            PG8_WAIT_V(6); PG8_BAR; PG8_MMA(1, 1, At, B1); PG8_BAR;
        }
        if constexpr (!Epi::AFTER_DRAIN) { E(acc, cur, wr, wc, fr, fq); S.done(cur); }
        if (!has_next) break;
#pragma unroll
        for (int a = 0; a < 2; ++a)
#pragma unroll
            for (int b = 0; b < 2; ++b)
#pragma unroll
                for (int m = 0; m < 4; ++m)
#pragma unroll
                    for (int n = 0; n < 2; ++n) acc[a][b][m][n] = (f32x4){0.f, 0.f, 0.f, 0.f};
        cur = nxt; cA = nA; cB = nB; ++ui;
    }
    PG8_WAIT_V(0);
    if (wr == 0) PG8_BAR;
    PG8_BAR;
    if constexpr (Epi::AFTER_DRAIN) { E.fused(acc, cur, wr, wc, fr, fq, lds, wid, lane); S.done(cur); }
#undef PG8_SA
#undef PG8_SB
#undef PG8_STAGE
#undef PG8_LDA
#undef PG8_LDB
#undef PG8_MMA
#undef PG8_WAIT_V
#undef PG8_WAIT_L
#undef PG8_BAR
#undef PG8_SCHED
}
}


typedef unsigned short bf16_t;
typedef short bf16x8 __attribute__((ext_vector_type(8)));
typedef float f32x4 __attribute__((ext_vector_type(4)));
typedef unsigned u32x4 __attribute__((ext_vector_type(4)));
typedef unsigned u32x2 __attribute__((ext_vector_type(2)));

constexpr int MTOK = 32768, DM = 1024, SEQ = 16384, NTH = 512;
constexpr int GIN = 3088, GIN_P = 3072, RIN = 4224, RIN_P = 4352;
constexpr int LDS_BYTES = 147456;

constexpr size_t WS_WGIN  = 0;
constexpr size_t WS_WGOUT = WS_WGIN  + (size_t)GIN_P * DM * 2;
constexpr size_t WS_WRIN  = WS_WGOUT + (size_t)DM * DM * 2;
constexpr size_t WS_WROUT = WS_WRIN  + (size_t)RIN_P * DM * 2;
constexpr size_t WS_WDUT  = WS_WROUT + (size_t)DM * DM * 2;
constexpr size_t WS_WIUT  = WS_WDUT  + (size_t)DM * 64 * 2;
constexpr size_t WS_WUPT  = WS_WIUT  + (size_t)DM * 64 * 2;
constexpr size_t WS_A     = WS_WUPT  + (size_t)512 * 16 * 2;
constexpr size_t WS_Y     = WS_A     + (size_t)MTOK * DM * 2;
constexpr size_t WS_GS    = WS_Y     + (size_t)MTOK * DM * 2;
constexpr size_t WS_GD    = WS_GS    + (size_t)24 * 1024 * 1024;
constexpr size_t WS_P     = WS_GD    + (size_t)8 * 32 * 128 * 4;
constexpr size_t WS_BAR   = WS_P     + (size_t)MTOK * RIN_P * 2;
constexpr size_t WS_AD    = WS_BAR   + 16384;
constexpr size_t WS_X1    = WS_AD    + (size_t)MTOK * 16 * 2;
constexpr size_t WS_END   = WS_X1    + (size_t)MTOK * DM * 2;
static_assert(WS_END <= (size_t)512 * 1024 * 1024, "workspace budget (4 x the largest tensor)");

struct Params { const float* in[22]; float* out; unsigned char* ws; int ph_lo, ph_hi; };

__device__ __forceinline__ float bf2f(unsigned b) { return __uint_as_float(b << 16); }
__device__ __forceinline__ bf16_t f2bf(float f) { unsigned u = __float_as_uint(f); u += 0x7FFFu + ((u >> 16) & 1u); return (bf16_t)(u >> 16); }
__device__ __forceinline__ unsigned pk2(float lo, float hi) { return pg8::cvt_pk_bf16(lo, hi); }
__device__ __forceinline__ float wave_sum(float x) {
#pragma unroll
    for (int off = 32; off >= 1; off >>= 1) x += __shfl_xor(x, off);
    return x;
}
__device__ __forceinline__ f32x4 mfma16(bf16x8 a, bf16x8 b, f32x4 c) { return __builtin_amdgcn_mfma_f32_16x16x32_bf16(a, b, c, 0, 0, 0); }
__device__ __forceinline__ bf16x8 as_bf16x8(u32x4 v) { union { u32x4 u; bf16x8 b; } x; x.u = v; return x.b; }
__device__ __forceinline__ float fexp(float x) { return __builtin_amdgcn_exp2f(x * 1.4426950408889634f); }
__device__ __forceinline__ float flog(float x) { return __builtin_amdgcn_logf(x) * 0.6931471805599453f; }
__device__ __forceinline__ float log_sigmoid(float z) { return fminf(z, 0.f) - log1pf(fexp(-fabsf(z))); }
__device__ __forceinline__ float softplus(float z) { return fmaxf(z, 0.f) + log1pf(fexp(-fabsf(z))); }

__device__ void prep_weight(const float* __restrict__ W, int N, const float* __restrict__ gain, bf16_t* __restrict__ Wt, int NP, float* tile) {
    const int tid = threadIdx.x;
    const int nu = (NP / 64) * 16;
    for (int u = blockIdx.x; u < nu; u += gridDim.x) {
        const int n0 = (u >> 4) * 64, k0 = (u & 15) * 64;
        {
            const int j = tid & 63, i0 = tid >> 6;
#pragma unroll
            for (int r = 0; r < 8; ++r) {
                const int i = i0 + 8 * r, k = k0 + i, n = n0 + j;
                float v = 0.f;
                if (n < N) { v = W[(size_t)k * N + n]; if (gain) v *= gain[k]; }
                tile[i * 65 + j] = v;
            }
        }
        __syncthreads();
        {
            const int i = tid & 63, j0 = tid >> 6;
#pragma unroll
            for (int r = 0; r < 8; ++r) {
                const int j = j0 + 8 * r;
                Wt[(size_t)(n0 + j) * DM + k0 + i] = f2bf(tile[i * 65 + j]);
            }
        }
        __syncthreads();
    }
}

__device__ void prep_lowrank(const float* __restrict__ src, bf16_t* __restrict__ dst) {
    for (int idx = blockIdx.x * NTH + threadIdx.x; idx < 65536; idx += gridDim.x * NTH) dst[idx] = f2bf(src[(idx & 63) * 1024 + (idx >> 6)]);
}

__device__ void zero_bnd_row(bf16_t* bnd) {
    if (blockIdx.x == 0) for (int i = threadIdx.x; i < RIN_P / 2; i += NTH) ((unsigned*)bnd)[i] = 0u;
}

__device__ void prep_wup(const float* __restrict__ src, bf16_t* __restrict__ dst) {
    for (int idx = blockIdx.x * NTH + threadIdx.x; idx < 8192; idx += gridDim.x * NTH) dst[idx] = f2bf(src[(idx & 15) * 512 + (idx >> 4)]);
}

struct EpiBf16Bnd {
    static constexpr bool PERM = true, AFTER_DRAIN = false;
    bf16_t* O; int ldc; bf16_t* bnd;
    __device__ __forceinline__ void operator()(const f32x4 (&acc)[2][2][4][2], const pg8::Unit& u, int wr, int wc, int fr, int fq) const {
        const int row0 = u.pm * pg8::BM + wr * 64 + fr, col0 = u.pn * pg8::BM + wc * 32 + 8 * fq;
#pragma unroll
        for (int ai = 0; ai < 2; ++ai)
#pragma unroll
            for (int m = 0; m < 4; ++m) {
                const int row = row0 + ai * pg8::HALF + m * 16;
                bf16_t* rowp = O + (size_t)row * ldc + col0;
#pragma unroll
                for (int bj = 0; bj < 2; ++bj) {
                    const f32x4 v0 = acc[ai][bj][m][0], v1 = acc[ai][bj][m][1];
                    u32x4 wv; wv.x = pk2(v0[0], v0[1]); wv.y = pk2(v0[2], v0[3]); wv.z = pk2(v1[0], v1[1]); wv.w = pk2(v1[2], v1[3]);
                    *(u32x4*)(rowp + bj * pg8::HALF) = wv;
                    if (m == 3 && fr == 15) *(u32x4*)(bnd + (size_t)((row >> 6) + 1) * ldc + col0 + bj * pg8::HALF) = wv;
                }
            }
    }
};

__device__ void phase_norm0(const Params& p, unsigned char* lds) {
    const int tid = threadIdx.x, lane = tid & 63, w = tid >> 6, l15 = lane & 15, g = lane >> 4;
    const float* x = p.in[0];
    bf16_t* A = (bf16_t*)(p.ws + WS_A);
    bf16_t* AD = (bf16_t*)(p.ws + WS_AD);
    bf16_t* WAD = (bf16_t*)lds;
    float* PSS = (float*)(lds + 33024);
    float* PAD = (float*)(lds + 33024 + 512);
    for (int e = tid; e < 16384; e += NTH) { const int k = e >> 4, j = e & 15; WAD[j * 1032 + k] = f2bf(p.in[2][(size_t)k * GIN + 3072 + j] * p.in[1][k]); }
    __syncthreads();
    bf16x8 wf[4];
#pragma unroll
    for (int kk = 0; kk < 4; ++kk) wf[kk] = *(const bf16x8*)(WAD + l15 * 1032 + 128 * w + 32 * kk + 8 * g);
    float4 xa[4][2];
    int tile = blockIdx.x;
    if (tile < MTOK / 16) {
#pragma unroll
        for (int kk = 0; kk < 4; ++kk) { const float4* s = (const float4*)(x + (size_t)(16 * tile + l15) * DM + 128 * w + 32 * kk + 8 * g); xa[kk][0] = s[0]; xa[kk][1] = s[1]; }
    }
    for (; tile < MTOK / 16; tile += gridDim.x) {
        float4 xv[4][2];
#pragma unroll
        for (int kk = 0; kk < 4; ++kk) { xv[kk][0] = xa[kk][0]; xv[kk][1] = xa[kk][1]; }
        if (tile + (int)gridDim.x < MTOK / 16) {
#pragma unroll
            for (int kk = 0; kk < 4; ++kk) { const float4* s = (const float4*)(x + (size_t)(16 * (tile + gridDim.x) + l15) * DM + 128 * w + 32 * kk + 8 * g); xa[kk][0] = s[0]; xa[kk][1] = s[1]; }
        }
        float ss = 0.f;
        f32x4 acc = (f32x4){0.f, 0.f, 0.f, 0.f};
#pragma unroll
        for (int kk = 0; kk < 4; ++kk) {
            const float4 a = xv[kk][0], b = xv[kk][1];
            ss += a.x * a.x + a.y * a.y + a.z * a.z + a.w * a.w + b.x * b.x + b.y * b.y + b.z * b.z + b.w * b.w;
            acc = mfma16(as_bf16x8((u32x4){pk2(a.x, a.y), pk2(a.z, a.w), pk2(b.x, b.y), pk2(b.z, b.w)}), wf[kk], acc);
        }
        ss += __shfl_xor(ss, 16); ss += __shfl_xor(ss, 32);
        if (g == 0) PSS[w * 16 + l15] = ss;
        *(f32x4*)(PAD + (w * 64 + lane) * 4) = acc;
        __syncthreads();
        float tot = 0.f;
#pragma unroll
        for (int q = 0; q < 8; ++q) tot += PSS[q * 16 + l15];
        const float rstd = rsqrtf(tot * (1.0f / DM) + 1e-6f);
#pragma unroll
        for (int kk = 0; kk < 4; ++kk) {
            const float4 a = xv[kk][0], b = xv[kk][1];
            *(u32x4*)(A + (size_t)(16 * tile + l15) * DM + 128 * w + 32 * kk + 8 * g) = (u32x4){pk2(a.x * rstd, a.y * rstd), pk2(a.z * rstd, a.w * rstd), pk2(b.x * rstd, b.y * rstd), pk2(b.z * rstd, b.w * rstd)};
        }
        if (w == 0) {
            f32x4 s = (f32x4){0.f, 0.f, 0.f, 0.f};
#pragma unroll
            for (int q = 0; q < 8; ++q) s += *(const f32x4*)(PAD + (q * 64 + lane) * 4);
#pragma unroll
            for (int r = 0; r < 4; ++r) AD[(size_t)(16 * tile + 4 * g + r) * 16 + l15] = f2bf(s[r] * __shfl(rstd, 4 * g + r));
        }
        __syncthreads();
    }
}

__device__ void phase_norm1(const Params& p) {
    const int tid = threadIdx.x, lane = tid & 63, w = tid >> 6;
    const float* x = p.in[0];
    const float* gpost = p.in[7];
    const bf16_t* Y = (const bf16_t*)(p.ws + WS_Y);
    bf16_t* A = (bf16_t*)(p.ws + WS_A);
    bf16_t* X1 = (bf16_t*)(p.ws + WS_X1);
    float4 gp[4];
#pragma unroll
    for (int i = 0; i < 4; ++i) gp[i] = ((const float4*)gpost)[lane + 64 * i];
    const int stride = gridDim.x * 8;
    float4 vn[4]; u32x2 yn[4];
    {
        const int row = blockIdx.x * 8 + w;
#pragma unroll
        for (int i = 0; i < 4; ++i) { vn[i] = ((const float4*)(x + (size_t)row * DM))[lane + 64 * i]; yn[i] = *(const u32x2*)(Y + (size_t)row * DM + 4 * (lane + 64 * i)); }
    }
    for (int row = blockIdx.x * 8 + w; row < MTOK; row += stride) {
        float4 v[4]; u32x2 yv[4];
#pragma unroll
        for (int i = 0; i < 4; ++i) { v[i] = vn[i]; yv[i] = yn[i]; }
        if (row + stride < MTOK) {
#pragma unroll
            for (int i = 0; i < 4; ++i) { vn[i] = ((const float4*)(x + (size_t)(row + stride) * DM))[lane + 64 * i]; yn[i] = *(const u32x2*)(Y + (size_t)(row + stride) * DM + 4 * (lane + 64 * i)); }
        }
        float4 y[4];
        float ss = 0.f;
#pragma unroll
        for (int i = 0; i < 4; ++i) {
            y[i].x = bf2f(yv[i].x & 0xffffu); y[i].y = bf2f(yv[i].x >> 16); y[i].z = bf2f(yv[i].y & 0xffffu); y[i].w = bf2f(yv[i].y >> 16);
            ss += y[i].x * y[i].x + y[i].y * y[i].y + y[i].z * y[i].z + y[i].w * y[i].w;
        }
        ss = wave_sum(ss);
        const float rstdy = rsqrtf(ss * (1.0f / DM) + 1e-6f);
        float s1 = 0.f;
#pragma unroll
        for (int i = 0; i < 4; ++i) {
            v[i].x += y[i].x * rstdy * gp[i].x; v[i].y += y[i].y * rstdy * gp[i].y; v[i].z += y[i].z * rstdy * gp[i].z; v[i].w += y[i].w * rstdy * gp[i].w;
            s1 += v[i].x * v[i].x + v[i].y * v[i].y + v[i].z * v[i].z + v[i].w * v[i].w;
            u32x2 xo; xo.x = pk2(v[i].x, v[i].y); xo.y = pk2(v[i].z, v[i].w);
            *(u32x2*)(X1 + (size_t)row * DM + 4 * (lane + 64 * i)) = xo;
        }
        s1 = wave_sum(s1);
        const float rstd = rsqrtf(s1 * (1.0f / DM) + 1e-6f);
#pragma unroll
        for (int i = 0; i < 4; ++i) {
            u32x2 o; o.x = pk2(v[i].x * rstd, v[i].y * rstd); o.y = pk2(v[i].z * rstd, v[i].w * rstd);
            *(u32x2*)(A + (size_t)row * DM + 4 * (lane + 64 * i)) = o;
        }
    }
}

__device__ void phase_final(const Params& p) {
    const int tid = threadIdx.x, lane = tid & 63, w = tid >> 6;
    const float* gpost = p.in[21];
    const bf16_t* Y = (const bf16_t*)(p.ws + WS_Y);
    const bf16_t* X1 = (const bf16_t*)(p.ws + WS_X1);
    float4 gp[4];
#pragma unroll
    for (int i = 0; i < 4; ++i) gp[i] = ((const float4*)gpost)[lane + 64 * i];
    const int stride = gridDim.x * 8;
    u32x2 xn[4], yn[4];
    {
        const int row = blockIdx.x * 8 + w;
#pragma unroll
        for (int i = 0; i < 4; ++i) { xn[i] = *(const u32x2*)(X1 + (size_t)row * DM + 4 * (lane + 64 * i)); yn[i] = *(const u32x2*)(Y + (size_t)row * DM + 4 * (lane + 64 * i)); }
    }
    for (int row = blockIdx.x * 8 + w; row < MTOK; row += stride) {
        u32x2 xv[4], yv[4];
#pragma unroll
        for (int i = 0; i < 4; ++i) { xv[i] = xn[i]; yv[i] = yn[i]; }
        if (row + stride < MTOK) {
#pragma unroll
            for (int i = 0; i < 4; ++i) { xn[i] = *(const u32x2*)(X1 + (size_t)(row + stride) * DM + 4 * (lane + 64 * i)); yn[i] = *(const u32x2*)(Y + (size_t)(row + stride) * DM + 4 * (lane + 64 * i)); }
        }
        float4 y[4];
        float ss = 0.f;
#pragma unroll
        for (int i = 0; i < 4; ++i) {
            y[i].x = bf2f(yv[i].x & 0xffffu); y[i].y = bf2f(yv[i].x >> 16); y[i].z = bf2f(yv[i].y & 0xffffu); y[i].w = bf2f(yv[i].y >> 16);
            ss += y[i].x * y[i].x + y[i].y * y[i].y + y[i].z * y[i].z + y[i].w * y[i].w;
        }
        ss = wave_sum(ss);
        const float rstdy = rsqrtf(ss * (1.0f / DM) + 1e-6f);
#pragma unroll
        for (int i = 0; i < 4; ++i) {
            float4 v;
            v.x = bf2f(xv[i].x & 0xffffu) + y[i].x * rstdy * gp[i].x; v.y = bf2f(xv[i].x >> 16) + y[i].y * rstdy * gp[i].y;
            v.z = bf2f(xv[i].y & 0xffffu) + y[i].z * rstdy * gp[i].z; v.w = bf2f(xv[i].y >> 16) + y[i].w * rstdy * gp[i].w;
            ((float4*)(p.out + (size_t)row * DM))[lane + 64 * i] = v;
        }
    }
}

constexpr int L_BC = 0, L_ATT = 0, L_QD = 33792, L_KD = L_QD + 64 * 136 * 2, L_KTE = L_KD + 64 * 136 * 2, L_VI = L_KTE + 64 * 144 * 2, L_SSQ = L_VI + 64 * 272 * 2, L_BL = L_SSQ + 2048, L_DEC = L_BL + 512, L_ADL = L_DEC + 512,
              L_GLA_END = L_ADL + 2048;
static_assert(L_GLA_END <= LDS_BYTES, "GLA LDS");
#define GLA_BARRIER() do { asm volatile("s_waitcnt lgkmcnt(0)" ::: "memory"); __builtin_amdgcn_s_barrier(); asm volatile("" ::: "memory"); } while (0)
typedef short gs16x4 __attribute__((ext_vector_type(4)));
__device__ __forceinline__ u32x2 g_trread(const bf16_t* p) { union { gs16x4 s; u32x2 u; } x; x.s = __builtin_amdgcn_ds_read_tr16_b64_v4i16((__attribute__((address_space(3))) gs16x4*)p); return x.u; }
template <int PITCH> __device__ __forceinline__ bf16x8 g_trfrag(const bf16_t* img, int k0, int c0, int g, int q, int pq) {
    const bf16_t* a = img + (k0 + 8 * g + q) * PITCH + c0 + 4 * pq;
    const u32x2 lo = g_trread(a), hi = g_trread(a + 4 * PITCH);
    return as_bf16x8((u32x4){lo.x, lo.y, hi.x, hi.y});
}
__device__ __forceinline__ f32x4 g_lo4(u32x4 v) { return (f32x4){bf2f(v.x & 0xffffu), bf2f(v.x >> 16), bf2f(v.y & 0xffffu), bf2f(v.y >> 16)}; }
__device__ __forceinline__ f32x4 g_hi4(u32x4 v) { return (f32x4){bf2f(v.z & 0xffffu), bf2f(v.z >> 16), bf2f(v.w & 0xffffu), bf2f(v.w >> 16)}; }
__device__ __forceinline__ u32x2 g_pk4(f32x4 v) { u32x2 r; r.x = pk2(v[0], v[1]); r.y = pk2(v[2], v[3]); return r; }
__device__ __forceinline__ f32x4 g_unpk4(u32x2 v) { return (f32x4){bf2f(v.x & 0xffffu), bf2f(v.x >> 16), bf2f(v.y & 0xffffu), bf2f(v.y >> 16)}; }

template <bool OUT> struct GlaRaw { u32x4 q[2], k[2], v[4]; };
template <bool OUT> __device__ __forceinline__ void gla_issue(GlaRaw<OUT>& x, const char* cb  , unsigned offQ, unsigned offV) {
    if (OUT) { x.q[0] = *(const u32x4*)(cb + offQ); x.q[1] = *(const u32x4*)(cb + offQ + 16); }
    x.k[0] = *(const u32x4*)(cb + offQ + 1024); x.k[1] = *(const u32x4*)(cb + offQ + 1040);
#pragma unroll
    for (int i = 0; i < 4; ++i) x.v[i] = *(const u32x4*)(cb + offV + 16 * i);
}

template <bool OUT>
__device__ void gla_pass(const Params& p, unsigned char* lds) {
    const int tid = threadIdx.x, w = __builtin_amdgcn_readfirstlane(tid >> 6);
    const bf16_t* P = (const bf16_t*)(p.ws + WS_P);
    bf16_t* GS = (bf16_t*)(p.ws + WS_GS);
    float* GD = (float*)(p.ws + WS_GD);
    bf16_t* Aout = (bf16_t*)(p.ws + WS_A);
    const bf16_t* WupT = (const bf16_t*)(p.ws + WS_WUPT);
    const bf16_t* ADG = (const bf16_t*)(p.ws + WS_AD);
    float* BC = (float*)(lds + L_BC); bf16_t* ATT = (bf16_t*)(lds + L_ATT); bf16_t* QD = (bf16_t*)(lds + L_QD); bf16_t* KD = (bf16_t*)(lds + L_KD); bf16_t* KTE = (bf16_t*)(lds + L_KTE);
    bf16_t* VI = (bf16_t*)(lds + L_VI); float* SSQ = (float*)(lds + L_SSQ); float* BL = (float*)(lds + L_BL); float* DEC = (float*)(lds + L_DEC); bf16_t* ADL = (bf16_t*)(lds + L_ADL);
    const float* b_al = p.in[4]; const float* g_head = p.in[5];

    for (int unit = blockIdx.x; unit < 256; unit += gridDim.x) {
        const int bh = unit >> 5, m = unit & 31, b = bh >> 2, h = bh & 3;
        int tidv = tid; asm volatile("" : "+v"(tidv));
        const int lane = tidv & 63, l15 = lane & 15, g = lane >> 4, q4 = l15 >> 2, p4 = l15 & 3;
        const int c = tidv >> 3, seg = tidv & 7;
        const int tokbase = b * SEQ + m * 512;
        u32x4 wupq = *(const u32x4*)(WupT + (size_t)(h * 128 + 16 * w + l15) * 16 + 8 * (g & 1));
        if (g >= 2) wupq = (u32x4){0u, 0u, 0u, 0u};
        const bf16x8 wupf = as_bf16x8(wupq);
        const float bA = b_al[h * 128 + 16 * w + l15];
        f32x4 gh[2];
#pragma unroll
        for (int vt = 0; vt < 2; ++vt) gh[vt] = *(const f32x4*)(g_head + 32 * w + 16 * vt + 4 * g);
        float logD = 0.f;
        f32x4 S[8][2];
#pragma unroll
        for (int mt = 0; mt < 8; ++mt)
#pragma unroll
            for (int vt = 0; vt < 2; ++vt) {
                if (OUT) S[mt][vt] = g_unpk4(*(const u32x2*)(GS + ((size_t)(bh * 32 + m) * 256 + 32 * w + 16 * vt + l15) * 128 + 16 * mt + 4 * g));
                else S[mt][vt] = (f32x4){0.f, 0.f, 0.f, 0.f};
            }
        const unsigned offQ = (unsigned)((c * GIN_P + h * 128 + 16 * seg) * 2), offV = (unsigned)((c * GIN_P + 1024 + h * 256 + 32 * seg) * 2), offAD = (unsigned)(tid * 16);
        const unsigned offG = (unsigned)((l15 * GIN_P + 2048 + h * 256 + 32 * w + 4 * g) * 2), offO = (unsigned)((l15 * DM + h * 256 + 32 * w + 4 * g) * 2);
        GlaRaw<OUT> raw;
        gla_issue<OUT>(raw, (const char*)P + (size_t)tokbase * GIN_P * 2, offQ, offV);
        if (tid < 128) *(u32x4*)(ADL + tid * 8) = *(const u32x4*)((const char*)ADG + (size_t)tokbase * 32 + offAD);
        GLA_BARRIER();

        for (int ch = 0; ch < 8; ++ch) {
            const int tok0 = tokbase + ch * 64;
            u32x4 adn = (u32x4){0u, 0u, 0u, 0u};
            {
                if (ch < 7 && tid < 128) adn = *(const u32x4*)((const char*)ADG + (size_t)(tok0 + 64) * 32 + offAD);
                f32x4 sc[4]; float xinc[4], tot[4];
#pragma unroll
                for (int ct = 0; ct < 4; ++ct) {
                    u32x4 aq = *(const u32x4*)(ADL + (16 * ct + l15) * 16 + 8 * (g & 1));
                    if (g >= 2) aq = (u32x4){0u, 0u, 0u, 0u};
                    const f32x4 z = mfma16(as_bf16x8(aq), wupf, (f32x4){bA, bA, bA, bA});
                    float acc = 0.f;
#pragma unroll
                    for (int r = 0; r < 4; ++r) { acc += (fminf(z[r], 0.f) - flog(1.f + fexp(-fabsf(z[r])))) * (1.0f / 16.0f); sc[ct][r] = acc; }
                    xinc[ct] = acc;
                }
#pragma unroll
                for (int ct = 0; ct < 4; ++ct) { const float y = __shfl_up(xinc[ct], 16); if (g >= 1) xinc[ct] += y; }
#pragma unroll
                for (int ct = 0; ct < 4; ++ct) { const float y = __shfl_up(xinc[ct], 32); if (g >= 2) xinc[ct] += y; }
#pragma unroll
                for (int ct = 0; ct < 4; ++ct) tot[ct] = __shfl(xinc[ct], 48 + l15);
                float run = 0.f;
#pragma unroll
                for (int ct = 0; ct < 4; ++ct) {
                    const float base = run + (xinc[ct] - sc[ct][3]);
                    run += tot[ct];
#pragma unroll
                    for (int r = 0; r < 4; ++r) BC[(16 * ct + 4 * g + r) * 132 + 16 * w + l15] = base + sc[ct][r];
                }
                if (g == 0) { BL[16 * w + l15] = run; DEC[16 * w + l15] = fexp(run); }
                if (!OUT) logD += run;
            }
            GLA_BARRIER();
            u32x2 gate[2][4];
            {
#pragma unroll
                for (int hh = 0; hh < 2; ++hh) {
                    const int o8 = 16 * seg + 8 * hh;
                    const f32x4 bb[2] = {*(const f32x4*)(BC + c * 132 + o8), *(const f32x4*)(BC + c * 132 + o8 + 4)};
                    const f32x4 dc[2] = {*(const f32x4*)(DEC + o8), *(const f32x4*)(DEC + o8 + 4)};
                    const f32x4 kx[2] = {g_lo4(raw.k[hh]), g_hi4(raw.k[hh])};
                    f32x4 qx[2];
                    if (OUT) { qx[0] = g_lo4(raw.q[hh]); qx[1] = g_hi4(raw.q[hh]); }
                    f32x4 kd[2], kt[2], qd[2];
#pragma unroll
                    for (int i = 0; i < 2; ++i)
#pragma unroll
                        for (int j = 0; j < 4; ++j) {
                            const float eB = fexp(bb[i][j]), enB = __builtin_amdgcn_rcpf(eB);
                            kd[i][j] = kx[i][j] * enB; kt[i][j] = kd[i][j] * dc[i][j];
                            if (OUT) qd[i][j] = qx[i][j] * 0.08838834764831845f * eB;
                        }
                    *(u32x4*)(KTE + c * 144 + o8) = (u32x4){pk2(kt[0][0], kt[0][1]), pk2(kt[0][2], kt[0][3]), pk2(kt[1][0], kt[1][1]), pk2(kt[1][2], kt[1][3])};
                    if (OUT) {
                        *(u32x4*)(KD + c * 136 + o8) = (u32x4){pk2(kd[0][0], kd[0][1]), pk2(kd[0][2], kd[0][3]), pk2(kd[1][0], kd[1][1]), pk2(kd[1][2], kd[1][3])};
                        *(u32x4*)(QD + c * 136 + o8) = (u32x4){pk2(qd[0][0], qd[0][1]), pk2(qd[0][2], qd[0][3]), pk2(qd[1][0], qd[1][1]), pk2(qd[1][2], qd[1][3])};
                    }
                }
#pragma unroll
                for (int i = 0; i < 4; ++i) *(u32x4*)(VI + c * 272 + 32 * seg + 8 * i) = raw.v[i];
                if (OUT) {
#pragma unroll
                    for (int vt = 0; vt < 2; ++vt)
#pragma unroll
                        for (int ct = 0; ct < 4; ++ct) gate[vt][ct] = *(const u32x2*)((const char*)P + (size_t)(tok0 + 16 * ct) * GIN_P * 2 + offG + 32 * vt);
                }
                if (ch < 7) gla_issue<OUT>(raw, (const char*)P + (size_t)(tok0 + 64) * GIN_P * 2, offQ, offV);
                if (ch < 7 && tid < 128) *(u32x4*)(ADL + tid * 8) = adn;
            }
            GLA_BARRIER();
            f32x4 o[2][4];
            if (OUT) {
#pragma unroll
                for (int t2 = 0; t2 < 2; ++t2) {
                    const int tl = 2 * w + t2, ct = tl >> 2, st = tl & 3;
                    f32x4 acc = (f32x4){0.f, 0.f, 0.f, 0.f};
                    if (st <= ct) {
#pragma unroll
                        for (int kk = 0; kk < 4; ++kk) {
                            const bf16x8 a = *(const bf16x8*)(KD + (16 * st + l15) * 136 + 32 * kk + 8 * g);
                            const bf16x8 bq = *(const bf16x8*)(QD + (16 * ct + l15) * 136 + 32 * kk + 8 * g);
                            acc = mfma16(a, bq, acc);
                        }
#pragma unroll
                        for (int r = 0; r < 4; ++r) if (16 * st + 4 * g + r > 16 * ct + l15) acc[r] = 0.f;
                    }
                    *(u32x2*)(ATT + (16 * ct + l15) * 72 + 16 * st + 4 * g) = g_pk4(acc);
                }
                GLA_BARRIER();
#pragma unroll
                for (int vt = 0; vt < 2; ++vt)
#pragma unroll
                    for (int ct = 0; ct < 4; ++ct) o[vt][ct] = (f32x4){0.f, 0.f, 0.f, 0.f};
#pragma unroll
                for (int kk = 0; kk < 4; ++kk) {
                    bf16x8 sa[2];
#pragma unroll
                    for (int vt = 0; vt < 2; ++vt) { const u32x2 s0 = g_pk4(S[2 * kk][vt]), s1 = g_pk4(S[2 * kk + 1][vt]); sa[vt] = as_bf16x8((u32x4){s0.x, s0.y, s1.x, s1.y}); }
#pragma unroll
                    for (int ct = 0; ct < 4; ++ct) {
                        const bf16_t* qr = QD + (16 * ct + l15) * 136 + 32 * kk + 4 * g;
                        const u32x2 lo = *(const u32x2*)qr, hi = *(const u32x2*)(qr + 16);
                        const bf16x8 bq = as_bf16x8((u32x4){lo.x, lo.y, hi.x, hi.y});
#pragma unroll
                        for (int vt = 0; vt < 2; ++vt) o[vt][ct] = mfma16(sa[vt], bq, o[vt][ct]);
                    }
                }
            }
            bf16x8 bv[2][2];
#pragma unroll
            for (int vt = 0; vt < 2; ++vt)
#pragma unroll
                for (int kk = 0; kk < 2; ++kk) bv[vt][kk] = g_trfrag<272>(VI, 32 * kk, 32 * w + 16 * vt, g, q4, p4);
            if (OUT) {
#pragma unroll
                for (int ct = 0; ct < 4; ++ct)
#pragma unroll
                    for (int kk = 0; kk < 2; ++kk) {
                        if (32 * kk <= 16 * ct + 15) {
                            const bf16x8 bq = *(const bf16x8*)(ATT + (16 * ct + l15) * 72 + 32 * kk + 8 * g);
#pragma unroll
                            for (int vt = 0; vt < 2; ++vt) o[vt][ct] = mfma16(bv[vt][kk], bq, o[vt][ct]);
                        }
                    }
            }
#pragma unroll
            for (int mt = 0; mt < 8; ++mt) {
                const f32x4 dv = *(const f32x4*)(DEC + 16 * mt + 4 * g);
#pragma unroll
                for (int vt = 0; vt < 2; ++vt) S[mt][vt] *= dv;
#pragma unroll
                for (int kk = 0; kk < 2; ++kk) {
                    const bf16x8 a = g_trfrag<144>(KTE, 32 * kk, 16 * mt, g, q4, p4);
#pragma unroll
                    for (int vt = 0; vt < 2; ++vt) S[mt][vt] = mfma16(a, bv[vt][kk], S[mt][vt]);
                }
            }
            if (OUT) {
                float ss[4];
#pragma unroll
                for (int ct = 0; ct < 4; ++ct) {
                    float s = 0.f;
#pragma unroll
                    for (int vt = 0; vt < 2; ++vt)
#pragma unroll
                        for (int r = 0; r < 4; ++r) s += o[vt][ct][r] * o[vt][ct][r];
                    s += __shfl_xor(s, 16); s += __shfl_xor(s, 32);
                    ss[ct] = s;
                }
                if (g == 0) {
#pragma unroll
                    for (int ct = 0; ct < 4; ++ct) SSQ[(16 * ct + l15) * 8 + w] = ss[ct];
                }
                GLA_BARRIER();
#pragma unroll
                for (int ct = 0; ct < 4; ++ct) {
                    const int cc = 16 * ct + l15;
                    const float4 s0 = *(const float4*)(SSQ + cc * 8), s1 = *(const float4*)(SSQ + cc * 8 + 4);
                    const float tot = (s0.x + s0.y) + (s0.z + s0.w) + (s1.x + s1.y) + (s1.z + s1.w);
                    const float rstd = rsqrtf(tot * (1.0f / 256.0f) + 1e-6f);
#pragma unroll
                    for (int vt = 0; vt < 2; ++vt) {
                        const f32x4 gt = g_unpk4(gate[vt][ct]);
                        f32x4 val;
#pragma unroll
                        for (int r = 0; r < 4; ++r) val[r] = o[vt][ct][r] * rstd * gh[vt][r] * gt[r] * __builtin_amdgcn_rcpf(1.0f + fexp(-gt[r]));
                        *(u32x2*)((char*)Aout + (size_t)(tok0 + 16 * ct) * DM * 2 + offO + 32 * vt) = g_pk4(val);
                    }
                }
            } else {
                GLA_BARRIER();
            }
        }
        if (!OUT) {
#pragma unroll
            for (int mt = 0; mt < 8; ++mt)
#pragma unroll
                for (int vt = 0; vt < 2; ++vt) *(u32x2*)(GS + ((size_t)(bh * 32 + m) * 256 + 32 * w + 16 * vt + l15) * 128 + 16 * mt + 4 * g) = g_pk4(S[mt][vt]);
            if (g == 0) GD[(bh * 32 + m) * 128 + 16 * w + l15] = fexp(logD);
        }
        GLA_BARRIER();
    }
}

__device__ void gla_scan(const Params& p) {
    bf16_t* GS = (bf16_t*)(p.ws + WS_GS);
    const float* GD = (const float*)(p.ws + WS_GD);
    for (int idx = blockIdx.x * NTH + threadIdx.x; idx < 8 * 8192; idx += gridDim.x * NTH) {
        const int bh = idx >> 13, e = (idx & 8191) * 4, d = e & 127;
        f32x4 S = (f32x4){0.f, 0.f, 0.f, 0.f};
        for (int m0 = 0; m0 < 32; m0 += 8) {
            u32x2 t[8]; f32x4 dd[8];
#pragma unroll
            for (int m = 0; m < 8; ++m) { t[m] = *(const u32x2*)(GS + (size_t)(bh * 32 + m0 + m) * 32768 + e); dd[m] = *(const f32x4*)(GD + (bh * 32 + m0 + m) * 128 + d); }
#pragma unroll
            for (int m = 0; m < 8; ++m) { *(u32x2*)(GS + (size_t)(bh * 32 + m0 + m) * 32768 + e) = g_pk4(S); S = S * dd[m] + g_unpk4(t[m]); }
        }
    }
}

constexpr int PP = RIN_P;
constexpr size_t WS_RK  = WS_GS;
constexpr size_t WS_BND = WS_GS + (size_t)MTOK * 16 * 4;
static_assert(WS_BND + (size_t)513 * PP * 2 <= WS_GD, "RWKV side buffers must fit the GLA state region");
constexpr int IMG = 64 * 72 * 2;
constexpr int R_ALB = 0, R_BH = IMG, R_KH = 2 * IMG, R_RB = 3 * IMG, R_BTL = 4 * IMG, R_KTL = 5 * IMG, R_VI = 6 * IMG, R_AAB = 7 * IMG, R_AAK = 8 * IMG, R_ARB = 9 * IMG, R_ARK = 10 * IMG,
              R_DW = R_AAB, R_DA = R_AAB + 64 * 68 * 4, R_XT = 11 * IMG, R_TW = R_XT, R_ADI = R_XT + IMG, R_TDF = R_XT + 2 * IMG, R_CS = R_TDF + 2048, R_GC = R_CS + 2048, R_CONST = R_GC + 256, R_WDL = R_CONST + 2560, R_WIL = R_WDL + IMG,
              R_END = R_WIL + IMG;
static_assert(R_DA + 64 * 68 * 4 <= R_XT && R_END <= LDS_BYTES, "R1 LDS");
#define LDS_BARRIER() do { asm volatile("s_waitcnt lgkmcnt(0)" ::: "memory"); __builtin_amdgcn_s_barrier(); asm volatile("" ::: "memory"); } while (0)

typedef short s16x4 __attribute__((ext_vector_type(4)));
__device__ __forceinline__ bf16x8 ldfrag(const bf16_t* img, int row, int koff) { return *(const bf16x8*)(img + row * 72 + koff); }
__device__ __forceinline__ u32x2 pk4(f32x4 v) { u32x2 r; r.x = pk2(v[0], v[1]); r.y = pk2(v[2], v[3]); return r; }
__device__ __forceinline__ f32x4 unpk4(u32x2 v) { return (f32x4){bf2f(v.x & 0xffffu), bf2f(v.x >> 16), bf2f(v.y & 0xffffu), bf2f(v.y >> 16)}; }
__device__ __forceinline__ u32x2 trread(const bf16_t* p) {
    union { s16x4 s; u32x2 u; } x; x.s = __builtin_amdgcn_ds_read_tr16_b64_v4i16((__attribute__((address_space(3))) s16x4*)p); return x.u;
}
__device__ __forceinline__ bf16x8 trfrag(const bf16_t* img, int k0, int c0, int g, int q, int pq) {
    const bf16_t* a = img + (k0 + 8 * g + q) * 72 + c0 + 4 * pq;
    const u32x2 lo = trread(a), hi = trread(a + 4 * 72);
    return as_bf16x8((u32x4){lo.x, lo.y, hi.x, hi.y});
}
__device__ __forceinline__ f32x4 lo4(u32x4 v) { return (f32x4){bf2f(v.x & 0xffffu), bf2f(v.x >> 16), bf2f(v.y & 0xffffu), bf2f(v.y >> 16)}; }
__device__ __forceinline__ f32x4 hi4(u32x4 v) { return (f32x4){bf2f(v.z & 0xffffu), bf2f(v.z >> 16), bf2f(v.w & 0xffffu), bf2f(v.w >> 16)}; }
__device__ __forceinline__ u32x4 pk8(f32x4 a, f32x4 b) { return (u32x4){pk2(a[0], a[1]), pk2(a[2], a[3]), pk2(b[0], b[1]), pk2(b[2], b[3])}; }
__device__ __forceinline__ float fast_rcp(float x) { return __builtin_amdgcn_rcpf(x); }
__device__ __forceinline__ f32x4 mm16(f32x4 xa, f32x4 yb, f32x4 c) {
    const u32x2 a = pk4(xa), b = pk4(yb);
    return mfma16(as_bf16x8((u32x4){a.x, a.y, 0u, 0u}), as_bf16x8((u32x4){b.x, b.y, 0u, 0u}), c);
}

struct R1Raw { u32x4 r0, r1, k0, k1, v0, v1, w0, w1, a0, a1; };
__device__ __forceinline__ void r1_issue(R1Raw& x, const bf16_t* P, const bf16_t* BND, int unit, int t, int cs) {
    const int bn = unit >> 4, h = unit & 15, n = bn & 255;
    const bf16_t* cur = P + ((size_t)bn * 64 + t) * PP;
    const bf16_t* prv = (t > 0) ? (cur - PP) : (BND + (size_t)(n == 0 ? 0 : bn) * PP);
    const int ch = h * 64 + 8 * cs;
    x.r0 = *(const u32x4*)(cur + ch); x.k0 = *(const u32x4*)(cur + 1024 + ch); x.v0 = *(const u32x4*)(cur + 2048 + ch); x.w0 = *(const u32x4*)(cur + 4096 + 8 * cs); x.a0 = *(const u32x4*)(cur + 4160 + 8 * cs);
    x.r1 = *(const u32x4*)(prv + ch); x.k1 = *(const u32x4*)(prv + 1024 + ch); x.v1 = *(const u32x4*)(prv + 2048 + ch); x.w1 = *(const u32x4*)(prv + 4096 + 8 * cs); x.a1 = *(const u32x4*)(prv + 4160 + 8 * cs);
}
__device__ __forceinline__ void lerp8(u32x4 c, u32x4 pv, const float* mu8, f32x4& o0, f32x4& o1) {
    const f32x4 c0 = lo4(c), c1 = hi4(c), p0 = lo4(pv), p1 = hi4(pv);
    const f32x4 m0 = *(const f32x4*)mu8, m1 = *(const f32x4*)(mu8 + 4);
    o0 = c0 + m0 * (p0 - c0); o1 = c1 + m1 * (p1 - c1);
}

__device__ void rwkv_r1(const Params& p, unsigned char* lds) {
    const int tid = threadIdx.x, w = __builtin_amdgcn_readfirstlane(tid >> 6);
    bf16_t* P = (bf16_t*)(p.ws + WS_P);
    bf16_t* Abuf = (bf16_t*)(p.ws + WS_A);
    bf16_t* Ybuf = (bf16_t*)(p.ws + WS_Y);
    float* RK = (float*)(p.ws + WS_RK);
    const bf16_t* BND = (const bf16_t*)(p.ws + WS_BND);
    const bf16_t* WduT = (const bf16_t*)(p.ws + WS_WDUT);
    const bf16_t* WiuT = (const bf16_t*)(p.ws + WS_WIUT);
    bf16_t* ALB = (bf16_t*)(lds + R_ALB); bf16_t* BH = (bf16_t*)(lds + R_BH); bf16_t* KH = (bf16_t*)(lds + R_KH); bf16_t* RB = (bf16_t*)(lds + R_RB);
    bf16_t* BTL = (bf16_t*)(lds + R_BTL); bf16_t* KTL = (bf16_t*)(lds + R_KTL); bf16_t* VI = (bf16_t*)(lds + R_VI);
    bf16_t* AAB = (bf16_t*)(lds + R_AAB); bf16_t* AAK = (bf16_t*)(lds + R_AAK); bf16_t* ARB = (bf16_t*)(lds + R_ARB); bf16_t* ARK = (bf16_t*)(lds + R_ARK);
    float* DW = (float*)(lds + R_DW); float* DA = (float*)(lds + R_DA);
    bf16_t* XT = (bf16_t*)(lds + R_XT); bf16_t* TW = (bf16_t*)(lds + R_TW); bf16_t* ADI = (bf16_t*)(lds + R_ADI);
    u32x2* TDF = (u32x2*)(lds + R_TDF); float* CS = (float*)(lds + R_CS); float* GCs = (float*)(lds + R_GC); float* CONST = (float*)(lds + R_CONST); bf16_t* WDL = (bf16_t*)(lds + R_WDL); bf16_t* WIL = (bf16_t*)(lds + R_WIL);
    const int t0_ = tid >> 3, cs0_ = tid & 7;
    int hprev = -1;
    R1Raw raw;
    if (blockIdx.x < 8192) r1_issue(raw, P, BND, blockIdx.x, t0_, cs0_);

    for (int unit = blockIdx.x; unit < 8192; unit += gridDim.x) {
        const int bn = unit >> 4, h = unit & 15, n = bn & 255;
        const size_t R0 = (size_t)bn * 64;
        int tidv = tid; asm volatile("" : "+v"(tidv));
        const int lane = tidv & 63, l15 = lane & 15, g = lane >> 4, q4 = l15 >> 2, p4 = l15 & 3, t = tidv >> 3, cs = tidv & 7, tl = lane >> 3;
        if (h != hprev) {
            LDS_BARRIER();
            if (tid < 64) {
                const int ch = h * 64 + tid;
                CONST[tid] = p.in[10][ch]; CONST[64 + tid] = p.in[10][1024 + ch]; CONST[128 + tid] = p.in[10][2048 + ch];
                CONST[192 + tid] = p.in[11][ch]; CONST[256 + tid] = p.in[13][ch]; CONST[320 + tid] = p.in[15][ch]; CONST[384 + tid] = p.in[16][ch]; CONST[448 + tid] = p.in[17][ch];
                CONST[512 + tid] = p.in[10][4096 + tid]; CONST[576 + tid] = p.in[10][4160 + tid];
            }
            {
                const int rr = tid >> 3, sg = tid & 7;
                *(u32x4*)(WDL + rr * 72 + 8 * sg) = *(const u32x4*)(WduT + (size_t)(h * 64 + rr) * 64 + 8 * sg);
                *(u32x4*)(WIL + rr * 72 + 8 * sg) = *(const u32x4*)(WiuT + (size_t)(h * 64 + rr) * 64 + 8 * sg);
            }
            hprev = h;
            LDS_BARRIER();
        }
        f32x4 r0, r1, k0, k1, v0, v1;
        {
            f32x4 wd0, wd1, ad0, ad1;
            lerp8(raw.r0, raw.r1, CONST + 8 * cs, r0, r1);
            lerp8(raw.k0, raw.k1, CONST + 64 + 8 * cs, k0, k1);
            lerp8(raw.v0, raw.v1, CONST + 128 + 8 * cs, v0, v1);
            lerp8(raw.w0, raw.w1, CONST + 512 + 8 * cs, wd0, wd1);
            lerp8(raw.a0, raw.a1, CONST + 576 + 8 * cs, ad0, ad1);
#pragma unroll
            for (int j = 0; j < 4; ++j) {
                const float e0 = fexp(-2.f * fabsf(wd0[j])), e1 = fexp(-2.f * fabsf(wd1[j]));
                wd0[j] = copysignf((1.f - e0) * fast_rcp(1.f + e0), wd0[j]); wd1[j] = copysignf((1.f - e1) * fast_rcp(1.f + e1), wd1[j]);
            }
            *(u32x4*)(TW + t * 72 + 8 * cs) = pk8(wd0, wd1);
            *(u32x4*)(ADI + t * 72 + 8 * cs) = pk8(ad0, ad1);
        }
        if (unit + (int)gridDim.x < 8192) r1_issue(raw, P, BND, unit + gridDim.x, t, cs);
        LDS_BARRIER();
        {
            const int tt = w & 3;
            bf16x8 ft[2], fa[2];
#pragma unroll
            for (int kk = 0; kk < 2; ++kk) { ft[kk] = ldfrag(TW, 16 * tt + l15, 32 * kk + 8 * g); fa[kk] = ldfrag(ADI, 16 * tt + l15, 32 * kk + 8 * g); }
#pragma unroll
            for (int q = 0; q < 2; ++q) {
                const int ct = 2 * (w >> 2) + q;
                f32x4 aw = (f32x4){0.f, 0.f, 0.f, 0.f}, aa = aw;
#pragma unroll
                for (int kk = 0; kk < 2; ++kk) { aw = mfma16(ldfrag(WDL, 16 * ct + l15, 32 * kk + 8 * g), ft[kk], aw); aa = mfma16(ldfrag(WIL, 16 * ct + l15, 32 * kk + 8 * g), fa[kk], aa); }
                *(f32x4*)(DW + (16 * tt + l15) * 68 + 16 * ct + 4 * g) = aw;
                *(f32x4*)(DA + (16 * tt + l15) * 68 + 16 * ct + 4 * g) = aa;
            }
        }
        LDS_BARRIER();
        f32x4 lw[2], av[2], kk[2], k2[2], G[2];
        {
            const f32x4 cw0[2] = {*(const f32x4*)(CONST + 192 + 8 * cs), *(const f32x4*)(CONST + 196 + 8 * cs)};
            const f32x4 ca0[2] = {*(const f32x4*)(CONST + 256 + 8 * cs), *(const f32x4*)(CONST + 260 + 8 * cs)};
            const f32x4 ckk[2] = {*(const f32x4*)(CONST + 320 + 8 * cs), *(const f32x4*)(CONST + 324 + 8 * cs)};
            const f32x4 cka[2] = {*(const f32x4*)(CONST + 384 + 8 * cs), *(const f32x4*)(CONST + 388 + 8 * cs)};
            const f32x4 crk[2] = {*(const f32x4*)(CONST + 448 + 8 * cs), *(const f32x4*)(CONST + 452 + 8 * cs)};
            const f32x4 dwv[2] = {*(const f32x4*)(DW + t * 68 + 8 * cs), *(const f32x4*)(DW + t * 68 + 8 * cs + 4)};
            const f32x4 dav[2] = {*(const f32x4*)(DA + t * 68 + 8 * cs), *(const f32x4*)(DA + t * 68 + 8 * cs + 4)};
            const f32x4 kin[2] = {k0, k1}, rin[2] = {r0, r1};
            float n2 = 0.f, rk = 0.f;
#pragma unroll
            for (int hf = 0; hf < 2; ++hf)
#pragma unroll
                for (int j = 0; j < 4; ++j) {
                    const float z = -(cw0[hf][j] + dwv[hf][j]);
                    const float sp = fmaxf(z, 0.f) + flog(1.f + fexp(-fabsf(z)));
                    lw[hf][j] = -fexp(-sp - 0.5f);
                    av[hf][j] = fast_rcp(1.f + fexp(-(ca0[hf][j] + dav[hf][j])));
                    kk[hf][j] = kin[hf][j] * ckk[hf][j];
                    k2[hf][j] = kin[hf][j] * (1.f + (av[hf][j] - 1.f) * cka[hf][j]);
                    n2 += kk[hf][j] * kk[hf][j]; rk += rin[hf][j] * k2[hf][j] * crk[hf][j];
                }
            n2 += __shfl_xor(n2, 1); rk += __shfl_xor(rk, 1); n2 += __shfl_xor(n2, 2); rk += __shfl_xor(rk, 2); n2 += __shfl_xor(n2, 4); rk += __shfl_xor(rk, 4);
            const float inv = 1.0f / fmaxf(sqrtf(n2), 1e-12f);
            kk[0] *= inv; kk[1] *= inv;
            if (cs == 0) RK[(R0 + t) * 16 + h] = rk;
            G[0] = lw[0]; G[1] = lw[1];
#pragma unroll
            for (int d = 1; d < 8; d <<= 1)
#pragma unroll
                for (int hf = 0; hf < 2; ++hf)
#pragma unroll
                    for (int j = 0; j < 4; ++j) { const float y = __shfl_up(G[hf][j], 8 * d); if (tl >= d) G[hf][j] += y; }
            if (tl == 7) { *(f32x4*)(CS + w * 64 + 8 * cs) = G[0]; *(f32x4*)(CS + w * 64 + 8 * cs + 4) = G[1]; }
        }
        LDS_BARRIER();
        {
            f32x4 off[2] = {(f32x4){0.f, 0.f, 0.f, 0.f}, (f32x4){0.f, 0.f, 0.f, 0.f}}, gc[2] = {off[0], off[0]};
#pragma unroll
            for (int q = 0; q < 8; ++q) {
                const f32x4 c0 = *(const f32x4*)(CS + q * 64 + 8 * cs), c1 = *(const f32x4*)(CS + q * 64 + 8 * cs + 4);
                const float mk = (q < w) ? 1.f : 0.f;
                gc[0] += c0; gc[1] += c1; off[0] += c0 * mk; off[1] += c1 * mk;
            }
            f32x4 al[2], bh[2], kh[2], rb[2];
            const f32x4 rin[2] = {r0, r1};
#pragma unroll
            for (int hf = 0; hf < 2; ++hf)
#pragma unroll
                for (int j = 0; j < 4; ++j) {
                    const float Gi = G[hf][j] + off[hf][j];
                    const float eG = fexp(Gi), eGm = fexp(Gi - lw[hf][j]), enG = fast_rcp(eG);
                    const float be = kk[hf][j] * av[hf][j];
                    al[hf][j] = -kk[hf][j] * eGm; bh[hf][j] = be * enG; kh[hf][j] = k2[hf][j] * enG; rb[hf][j] = rin[hf][j] * eG;
                }
            const int o = t * 72 + 8 * cs;
            *(u32x4*)(ALB + o) = pk8(al[0], al[1]); *(u32x4*)(BH + o) = pk8(bh[0], bh[1]); *(u32x4*)(KH + o) = pk8(kh[0], kh[1]); *(u32x4*)(RB + o) = pk8(rb[0], rb[1]);
            const u32x4 vpk = pk8(v0, v1);
            *(u32x4*)(VI + o) = vpk;
            *(u32x4*)(Ybuf + (R0 + t) * DM + h * 64 + 8 * cs) = vpk;
            if (w == 0 && tl == 0) { f32x4 e0, e1;
#pragma unroll
                for (int j = 0; j < 4; ++j) { e0[j] = fexp(gc[0][j]); e1[j] = fexp(gc[1][j]); }
                *(f32x4*)(GCs + 8 * cs) = e0; *(f32x4*)(GCs + 8 * cs + 4) = e1; }
        }
        LDS_BARRIER();
        {
            int ntile = 1, tta = 0, sta = 0, ttb = 0, stb = 0;
            if (w == 0) { tta = 0; sta = 0; } else if (w == 2) { tta = 1; sta = 1; } else if (w == 5) { tta = 2; sta = 2; } else if (w == 7) { tta = 3; sta = 3; }
            else if (w == 1) { ntile = 2; tta = 1; sta = 0; ttb = 2; stb = 0; } else if (w == 3) { ntile = 2; tta = 2; sta = 1; ttb = 3; stb = 0; }
            else if (w == 4) { tta = 3; sta = 1; } else { tta = 3; sta = 2; }
            for (int it = 0; it < ntile; ++it) {
                const int tt = it ? ttb : tta, st = it ? stb : sta;
                f32x4 cab = (f32x4){0.f, 0.f, 0.f, 0.f}, cak = cab, crb = cab, crk = cab, nab = cab;
#pragma unroll
                for (int kq = 0; kq < 2; ++kq) {
                    const bf16x8 fb = ldfrag(BH, 16 * st + l15, 32 * kq + 8 * g), fk = ldfrag(KH, 16 * st + l15, 32 * kq + 8 * g);
                    const bf16x8 fa = ldfrag(ALB, 16 * tt + l15, 32 * kq + 8 * g), fr = ldfrag(RB, 16 * tt + l15, 32 * kq + 8 * g);
                    cab = mfma16(fb, fa, cab); cak = mfma16(fk, fa, cak); crb = mfma16(fb, fr, crb); crk = mfma16(fk, fr, crk);
                    if (tt == st) nab = mfma16(fa, fb, nab);
                }
                if (tt == st) {
#pragma unroll
                    for (int r = 0; r < 4; ++r) {
                        const int s = 4 * g + r, tq = l15;
                        if (s >= tq) { cab[r] = 0.f; cak[r] = 0.f; }
                        if (s > tq) { crb[r] = 0.f; crk[r] = 0.f; }
                        if (l15 >= 4 * g + r) nab[r] = 0.f;
                    }
                }
                const int o = (16 * tt + l15) * 72 + 16 * st + 4 * g;
                *(u32x2*)(AAB + o) = pk4(cab); *(u32x2*)(AAK + o) = pk4(cak); *(u32x2*)(ARB + o) = pk4(crb); *(u32x2*)(ARK + o) = pk4(crk);
                if (tt == st) {
                    const f32x4 z = (f32x4){0.f, 0.f, 0.f, 0.f};
                    const f32x4 Q1 = cab, N1 = nab;
                    const f32x4 Q2 = mm16(N1, Q1, z), N2 = mm16(Q1, N1, z);
                    f32x4 Pm = Q1;
#pragma unroll
                    for (int r = 0; r < 4; ++r) if (4 * g + r == l15) Pm[r] += 1.f;
                    Pm = mm16(N2, Pm, Pm);
                    const f32x4 Q4 = mm16(N2, Q2, z), N4 = mm16(Q2, N2, z);
                    Pm = mm16(N4, Pm, Pm);
                    const f32x4 N8 = mm16(Q4, N4, z);
                    Pm = mm16(N8, Pm, Pm);
                    TDF[tt * 64 + lane] = pk4(Pm);
                }
            }
            if (w == 4 || w == 6) {
                const int tt = (w == 4) ? 0 : 2, st = tt + 1;
                const int o = (16 * tt + l15) * 72 + 16 * st + 4 * g;
                const u32x2 zz = (u32x2){0u, 0u};
                *(u32x2*)(AAK + o) = zz; *(u32x2*)(ARB + o) = zz; *(u32x2*)(ARK + o) = zz;
            }
        }
        LDS_BARRIER();
        {
            u32x2 xb[4];
            const int col = 16 * w + l15;
            bf16x8 vfr[2];
            if (w >= 4) { vfr[0] = trfrag(VI, 0, 16 * (w - 4), g, q4, p4); vfr[1] = trfrag(VI, 32, 16 * (w - 4), g, q4, p4); }
#pragma unroll
            for (int i = 0; i < 4; ++i) {
                f32x4 z;
                if (w < 4) z = unpk4(trread(ALB + (16 * i + 4 * g + q4) * 72 + 16 * w + 4 * p4));
                else {
                    z = mfma16(ldfrag(AAK, 16 * i + l15, 8 * g), vfr[0], (f32x4){0.f, 0.f, 0.f, 0.f});
                    if (i >= 2) z = mfma16(ldfrag(AAK, 16 * i + l15, 32 + 8 * g), vfr[1], z);
                }
                if (i >= 1) {
                    const bf16_t* ar = AAB + (16 * i + l15) * 72 + 4 * g;
                    const u32x2 a0 = *(const u32x2*)ar;
                    u32x2 a1 = (u32x2){0u, 0u}, b1 = (u32x2){0u, 0u};
                    if (i >= 2) { a1 = *(const u32x2*)(ar + 16); b1 = xb[1]; }
                    z = mfma16(as_bf16x8((u32x4){a0.x, a0.y, a1.x, a1.y}), as_bf16x8((u32x4){xb[0].x, xb[0].y, b1.x, b1.y}), z);
                    if (i == 3) {
                        const u32x2 a2 = *(const u32x2*)(ar + 32);
                        z = mfma16(as_bf16x8((u32x4){a2.x, a2.y, 0u, 0u}), as_bf16x8((u32x4){xb[2].x, xb[2].y, 0u, 0u}), z);
                    }
                }
                const u32x2 tq = TDF[i * 64 + lane];
                const u32x2 zq = pk4(z);
                const f32x4 x = mfma16(as_bf16x8((u32x4){tq.x, tq.y, 0u, 0u}), as_bf16x8((u32x4){zq.x, zq.y, 0u, 0u}), (f32x4){0.f, 0.f, 0.f, 0.f});
                xb[i] = pk4(x);
                *(u32x2*)(XT + col * 72 + 16 * i + 4 * g) = xb[i];
            }
        }
        LDS_BARRIER();
        {
            const int rt_ = w & 3, c0 = 2 * (w >> 2);
            bf16x8 xw[2], xu[2], fbt[2], fkt[2], fvr[2];
#pragma unroll
            for (int kq = 0; kq < 2; ++kq) {
                xw[kq] = ldfrag(XT, 16 * rt_ + l15, 32 * kq + 8 * g);
                xu[kq] = ldfrag(XT, 64 + 16 * rt_ + l15, 32 * kq + 8 * g);
                fbt[kq] = trfrag(BH, 32 * kq, 16 * rt_, g, q4, p4);
                fkt[kq] = trfrag(KH, 32 * kq, 16 * rt_, g, q4, p4);
                fvr[kq] = trfrag(VI, 32 * kq, 16 * rt_, g, q4, p4);
            }
            const float gcd0 = GCs[16 * c0 + l15], gcd1 = GCs[16 * c0 + 16 + l15];
            const f32x4 gcr = *(const f32x4*)(GCs + 16 * rt_ + 4 * g);
#pragma unroll
            for (int q = 0; q < 2; ++q) {
                bf16x8 gbt[2], garb[2], gxu[2], gvi[2], gark[2];
#pragma unroll
                for (int kq = 0; kq < 2; ++kq) {
                    gbt[kq] = trfrag(BH, 32 * kq, 16 * (c0 + q), g, q4, p4);
                    garb[kq] = ldfrag(ARB, 16 * (c0 + q) + l15, 32 * kq + 8 * g);
                    gxu[kq] = ldfrag(XT, 64 + 16 * (c0 + q) + l15, 32 * kq + 8 * g);
                    gvi[kq] = trfrag(VI, 32 * kq, 16 * (c0 + q), g, q4, p4);
                    gark[kq] = ldfrag(ARK, 16 * (c0 + q) + l15, 32 * kq + 8 * g);
                }
                const u32x2 rbi = *(const u32x2*)(RB + (16 * (c0 + q) + l15) * 72 + 16 * rt_ + 4 * g);
                __builtin_amdgcn_sched_barrier(0);
                const int ctile = c0 + q;
                {
                    f32x4 acc = (f32x4){0.f, 0.f, 0.f, 0.f};
#pragma unroll
                    for (int kq = 0; kq < 2; ++kq) acc = mfma16(xw[kq], gbt[kq], acc);
                    const int dcol = 16 * ctile + l15;
                    if (rt_ == ctile) {
#pragma unroll
                        for (int r = 0; r < 4; ++r) if (4 * g + r == l15) acc[r] += 1.f;
                    }
                    acc *= (q ? gcd1 : gcd0);
                    *(u32x2*)(ALB + dcol * 72 + 32 * (rt_ >> 1) + 8 * g + 4 * (rt_ & 1)) = pk4(acc);
                }
                {
                    f32x4 acc = unpk4(rbi);
#pragma unroll
                    for (int kq = 0; kq < 2; ++kq) {
                        if (32 * kq <= 16 * ctile + 15) acc = mfma16(xw[kq], garb[kq], acc);
                    }
                    *(u32x2*)(BTL + (16 * ctile + l15) * 72 + 16 * rt_ + 4 * g) = pk4(acc);
                }
                {
                    f32x4 acc = (f32x4){0.f, 0.f, 0.f, 0.f};
#pragma unroll
                    for (int kq = 0; kq < 2; ++kq) { acc = mfma16(fbt[kq], gxu[kq], acc); acc = mfma16(fkt[kq], gvi[kq], acc); }
                    *(u32x2*)(KTL + (16 * ctile + l15) * 72 + 16 * rt_ + 4 * g) = pk4(acc * gcr);
                }
                {
                    f32x4 acc = (f32x4){0.f, 0.f, 0.f, 0.f};
#pragma unroll
                    for (int kq = 0; kq < 2; ++kq) {
                        if (32 * kq <= 16 * ctile + 15) { acc = mfma16(xu[kq], garb[kq], acc); acc = mfma16(fvr[kq], gark[kq], acc); }
                    }
                    *(u32x2*)(AAB + (16 * ctile + l15) * 72 + 16 * rt_ + 4 * g) = pk4(acc);
                }
            }
        }
        LDS_BARRIER();
        {
            const int o = t * 72 + 8 * cs;
            *(u32x4*)(P + (R0 + t) * PP + h * 64 + 8 * cs) = *(const u32x4*)(ALB + o);
            *(u32x4*)(P + (R0 + t) * PP + 1024 + h * 64 + 8 * cs) = *(const u32x4*)(BTL + o);
            *(u32x4*)(P + (R0 + t) * PP + 2048 + h * 64 + 8 * cs) = *(const u32x4*)(KTL + o);
            *(u32x4*)(Abuf + (R0 + t) * DM + h * 64 + 8 * cs) = *(const u32x4*)(AAB + o);
        }
    }
}

constexpr int SC_SLOT = 2 * IMG;
constexpr size_t WS_MG = (WS_BND + (size_t)513 * PP * 2 + 255) & ~(size_t)255;
constexpr size_t WS_NG = WS_MG + (size_t)1024 * 4096 * 2;
static_assert(WS_NG + (size_t)1024 * 4096 * 2 <= WS_GD, "scan buffers must fit the GLA state region");

template <int MODE>
__device__ void rwkv_scan2(const Params& p, unsigned char* lds) {
    constexpr int GSZ = 32, NGRP = 256 / GSZ, LG = 3;
    constexpr int SPU = (MODE == 2) ? NGRP : GSZ;
    constexpr int NU = (MODE == 2) ? 32 : 32 * NGRP;
    const int tid = threadIdx.x, lane = tid & 63, w = __builtin_amdgcn_readfirstlane(tid >> 6), l15 = lane & 15, g = lane >> 4;
    bf16_t* P = (bf16_t*)(p.ws + WS_P);
    bf16_t* MG = (bf16_t*)(p.ws + WS_MG); bf16_t* NG = (bf16_t*)(p.ws + WS_NG); bf16_t* HG = NG;
    const int G = gridDim.x;
    const int nun = ((int)blockIdx.x < NU) ? (NU - 1 - (int)blockIdx.x) / G + 1 : 0;
    const int T = nun * SPU;
    if (T == 0) return;
#define SC_SRC(s, p0, p1, pitchb) \
    const int u_ = (int)blockIdx.x + G * ((s) / SPU), j_ = (s) % SPU; \
    const char* p0; const char* p1; unsigned pitchb; \
    if (MODE == 2) { p0 = (const char*)(MG + (size_t)(u_ * NGRP + j_) * 4096); p1 = (const char*)(NG + (size_t)(u_ * NGRP + j_) * 4096); pitchb = 128u; } \
    else { const int bh_ = u_ >> LG, n_ = GSZ * (u_ & (NGRP - 1)) + j_; p0 = (const char*)(P + ((size_t)(bh_ >> 4) * SEQ + (size_t)n_ * 64) * PP + (bh_ & 15) * 64); p1 = p0 + 4096; pitchb = (unsigned)(PP * 2); }
    if (w >= 4) {
        const int lj = w - 4;
        const unsigned loff = (unsigned)((lane >> 3) * 144 + (lane & 7) * 16);
        u32x4 ld0[16], ld1[16];
#define SC_ISSUE(dst, s) do { const int sc_ = ((s) < T) ? (s) : T - 1; SC_SRC(sc_, q0_, q1_, pb_) const unsigned go_ = (unsigned)(lane >> 3) * pb_ + (unsigned)(lane & 7) * 16u; \
        _Pragma("unroll") for (int q = 0; q < 16; ++q) dst[q] = *(const u32x4*)(((q >> 3) ? q1_ : q0_) + (size_t)((q & 7) * 8) * pb_ + go_); } while (0)
#define SC_RETIRE(src, s) do { unsigned char* sb = lds + ((s) & 1) * SC_SLOT + loff; _Pragma("unroll") for (int q = 0; q < 16; ++q) \
        *(u32x4*)(sb + (q >> 3) * IMG + (q & 7) * 8 * 144) = src[q]; } while (0)
        SC_ISSUE(ld0, lj); SC_ISSUE(ld1, lj + 4);
        for (int it = 0; it < T / 8; ++it) {
            const int c0 = lj + 8 * it;
            for (int k = 0; k < lj; ++k) LDS_BARRIER();
            SC_RETIRE(ld0, c0); SC_ISSUE(ld0, c0 + 8);
            for (int k = 0; k < 4; ++k) LDS_BARRIER();
            SC_RETIRE(ld1, c0 + 4); SC_ISSUE(ld1, c0 + 12);
            for (int k = 0; k < 4 - lj; ++k) LDS_BARRIER();
        }
        LDS_BARRIER();
#undef SC_ISSUE
#undef SC_RETIRE
    } else {
        f32x4 H[4], Mg[4];
        for (int i = 0; i <= T; ++i) {
            if (i >= 1) {
                const int s = i - 1, u = (int)blockIdx.x + G * (s / SPU), j = s % SPU;
                const unsigned char* sb = lds + (s & 1) * SC_SLOT;
                const bf16_t* MT = (const bf16_t*)sb; const bf16_t* NT = (const bf16_t*)(sb + IMG);
                if (j == 0) {
                    if (MODE == 3) {
#pragma unroll
                        for (int mt = 0; mt < 4; ++mt) H[mt] = unpk4(*(const u32x2*)(HG + (size_t)u * 4096 + (16 * w + l15) * 64 + 16 * mt + 4 * g));
                    } else {
#pragma unroll
                        for (int mt = 0; mt < 4; ++mt) H[mt] = (f32x4){0.f, 0.f, 0.f, 0.f};
                    }
                    if (MODE == 1) {
#pragma unroll
                        for (int mt = 0; mt < 4; ++mt)
#pragma unroll
                            for (int r = 0; r < 4; ++r) Mg[mt][r] = (16 * mt + 4 * g + r == 16 * w + l15) ? 1.f : 0.f;
                    }
                }
                u32x2 hp[4];
#pragma unroll
                for (int mt = 0; mt < 4; ++mt) hp[mt] = pk4(H[mt]);
                if (MODE == 2) {
#pragma unroll
                    for (int mt = 0; mt < 4; ++mt) *(u32x2*)(HG + (size_t)(u * NGRP + j) * 4096 + (16 * w + l15) * 64 + 16 * mt + 4 * g) = hp[mt];
                }
                if (MODE == 3) {
                    const int bh = u >> LG, n = GSZ * (u & (NGRP - 1)) + j;
#pragma unroll
                    for (int mt = 0; mt < 4; ++mt) *(u32x2*)(P + ((size_t)(bh >> 4) * SEQ + (size_t)n * 64 + 16 * w + l15) * PP + 2048 + (bh & 15) * 64 + 16 * mt + 4 * g) = hp[mt];
                }
                bf16x8 hb[2], mb[2];
                hb[0] = as_bf16x8((u32x4){hp[0].x, hp[0].y, hp[1].x, hp[1].y});
                hb[1] = as_bf16x8((u32x4){hp[2].x, hp[2].y, hp[3].x, hp[3].y});
                if (MODE == 1) {
                    const u32x2 m0 = pk4(Mg[0]), m1 = pk4(Mg[1]), m2 = pk4(Mg[2]), m3 = pk4(Mg[3]);
                    mb[0] = as_bf16x8((u32x4){m0.x, m0.y, m1.x, m1.y}); mb[1] = as_bf16x8((u32x4){m2.x, m2.y, m3.x, m3.y});
                }
#pragma unroll
                for (int mt = 0; mt < 4; ++mt) {
                    const bf16x8 a0 = ldfrag(MT, 16 * mt + l15, 8 * g), a1 = ldfrag(MT, 16 * mt + l15, 32 + 8 * g);
                    f32x4 acc = unpk4(*(const u32x2*)(NT + (16 * w + l15) * 72 + 16 * mt + 4 * g));
                    acc = mfma16(a0, hb[0], acc); acc = mfma16(a1, hb[1], acc);
                    H[mt] = acc;
                    if (MODE == 1) { f32x4 am = mfma16(a0, mb[0], (f32x4){0.f, 0.f, 0.f, 0.f}); am = mfma16(a1, mb[1], am); Mg[mt] = am; }
                }
                if (MODE == 1 && j == SPU - 1) {
                    const int pc = 32 * (w >> 1) + 8 * (l15 >> 2) + 4 * (w & 1) + (l15 & 3);
#pragma unroll
                    for (int mt = 0; mt < 4; ++mt) {
                        *(u32x2*)(NG + (size_t)u * 4096 + (16 * w + l15) * 64 + 16 * mt + 4 * g) = pk4(H[mt]);
#pragma unroll
                        for (int r = 0; r < 4; ++r) MG[(size_t)u * 4096 + (16 * mt + 4 * g + r) * 64 + pc] = f2bf(Mg[mt][r]);
                    }
                }
            }
            LDS_BARRIER();
        }
    }
#undef SC_SRC
}

__device__ void rwkv_post(const Params& p, unsigned char* lds) {
    const int tid = threadIdx.x, lane = tid & 63, w = __builtin_amdgcn_readfirstlane(tid >> 6), l15 = lane & 15, g = lane >> 4;
    const bf16_t* P = (const bf16_t*)(p.ws + WS_P);
    bf16_t* Abuf = (bf16_t*)(p.ws + WS_A);
    const bf16_t* Ybuf = (const bf16_t*)(p.ws + WS_Y);
    const float* RK = (const float*)(p.ws + WS_RK);
    const bf16_t* BND = (const bf16_t*)(p.ws + WS_BND);
    float* L = (float*)(lds + w * 8704);
    const int tr = lane >> 3, seg = lane & 7;
    for (int hu = blockIdx.x * 8 + w; hu < 16384; hu += gridDim.x * 8) {
        const int unit = hu >> 1, t0 = (hu & 1) * 32;
        const int bn = unit >> 4, h = unit & 15, n = bn & 255;
        const size_t R0 = (size_t)bn * 64;
        bf16x8 fh[4][2], fr[2][2];
#pragma unroll
        for (int kk = 0; kk < 2; ++kk) {
#pragma unroll
            for (int q = 0; q < 4; ++q) fh[q][kk] = *(const bf16x8*)(P + (R0 + 16 * q + l15) * PP + 2048 + h * 64 + 32 * kk + 8 * g);
#pragma unroll
            for (int q = 0; q < 2; ++q) fr[q][kk] = *(const bf16x8*)(P + (R0 + t0 + 16 * q + l15) * PP + 1024 + h * 64 + 32 * kk + 8 * g);
        }
        u32x4 y0r[4], g1r[4], g0r[4], vpr[4];
        float rkv[4];
#pragma unroll
        for (int i = 0; i < 4; ++i) {
            const int t = t0 + tr + 8 * i;
            y0r[i] = *(const u32x4*)(Abuf + (R0 + t) * DM + h * 64 + 8 * seg);
            const bf16_t* grow = P + (R0 + t) * PP + 3072 + h * 64 + 8 * seg;
            g1r[i] = *(const u32x4*)grow;
            g0r[i] = *(const u32x4*)((t > 0) ? (grow - PP) : (BND + (size_t)(n == 0 ? 0 : bn) * PP + 3072 + h * 64 + 8 * seg));
            vpr[i] = *(const u32x4*)(Ybuf + (R0 + t) * DM + h * 64 + 8 * seg);
            rkv[i] = RK[(R0 + t) * 16 + h];
        }
#pragma unroll
        for (int i = 0; i < 4; ++i) { *(f32x4*)(L + (tr + 8 * i) * 68 + 8 * seg) = lo4(y0r[i]); *(f32x4*)(L + (tr + 8 * i) * 68 + 8 * seg + 4) = hi4(y0r[i]); }
        f32x4 y[4][2];
#pragma unroll
        for (int vt = 0; vt < 4; ++vt)
#pragma unroll
            for (int tt = 0; tt < 2; ++tt) y[vt][tt] = *(const f32x4*)(L + (16 * tt + l15) * 68 + 16 * vt + 4 * g);
#pragma unroll
        for (int vt = 0; vt < 4; ++vt)
#pragma unroll
            for (int tt = 0; tt < 2; ++tt)
#pragma unroll
                for (int kk = 0; kk < 2; ++kk) y[vt][tt] = mfma16(fh[vt][kk], fr[tt][kk], y[vt][tt]);
#pragma unroll
        for (int tt = 0; tt < 2; ++tt) {
            float s1 = 0.f, s2 = 0.f;
#pragma unroll
            for (int vt = 0; vt < 4; ++vt)
#pragma unroll
                for (int r = 0; r < 4; ++r) { s1 += y[vt][tt][r]; s2 += y[vt][tt][r] * y[vt][tt][r]; }
            s1 += __shfl_xor(s1, 16); s2 += __shfl_xor(s2, 16); s1 += __shfl_xor(s1, 32); s2 += __shfl_xor(s2, 32);
            const float mean = s1 * (1.0f / 64.0f);
            const float rstd = rsqrtf(fmaxf(s2 * (1.0f / 64.0f) - mean * mean, 0.f) + 64e-5f);
#pragma unroll
            for (int vt = 0; vt < 4; ++vt) *(f32x4*)(L + (16 * tt + l15) * 68 + 16 * vt + 4 * g) = (y[vt][tt] - mean) * rstd;
        }
        const int ch = h * 64 + 8 * seg;
        const f32x4 lw0 = *(const f32x4*)(p.in[18] + ch), lw1 = *(const f32x4*)(p.in[18] + ch + 4), lb0 = *(const f32x4*)(p.in[19] + ch), lb1 = *(const f32x4*)(p.in[19] + ch + 4);
        const f32x4 mg0 = *(const f32x4*)(p.in[10] + 3072 + ch), mg1 = *(const f32x4*)(p.in[10] + 3072 + ch + 4);
#pragma unroll
        for (int i = 0; i < 4; ++i) {
            const int t = t0 + tr + 8 * i;
            const f32x4 n0 = *(const f32x4*)(L + (tr + 8 * i) * 68 + 8 * seg), n1 = *(const f32x4*)(L + (tr + 8 * i) * 68 + 8 * seg + 4);
            const f32x4 ga0 = lo4(g1r[i]), ga1 = hi4(g1r[i]);
            const f32x4 gb0 = lo4(g0r[i]), gb1 = hi4(g0r[i]);
            const f32x4 gt0 = ga0 + mg0 * (gb0 - ga0), gt1 = ga1 + mg1 * (gb1 - ga1);
            const f32x4 v0 = lo4(vpr[i]), v1 = hi4(vpr[i]);
            f32x4 o0 = n0 * lw0 + lb0 + rkv[i] * v0, o1 = n1 * lw1 + lb1 + rkv[i] * v1;
#pragma unroll
            for (int j = 0; j < 4; ++j) { o0[j] *= gt0[j] * __builtin_amdgcn_rcpf(1.0f + fexp(-gt0[j])); o1[j] *= gt1[j] * __builtin_amdgcn_rcpf(1.0f + fexp(-gt1[j])); }
            *(u32x4*)(Abuf + (R0 + t) * DM + h * 64 + 8 * seg) = pk8(o0, o1);
        }
    }
}
#define XB_TMO      128
#define XB_XCNT(j)  (256  + 64 * (j))
#define XB_XSUB(j)  (1280 + 64 * (j))
#define XB_XGEN(j)  (2304 + 64 * (j))
#define XB_TOP      3328
#define XB_TOPGEN   3392
#define XCD_BAR_WORDS 3456
#define XB_SPIN_CAP (1u << 18)
#define LAS __attribute__((address_space(3)))

__device__ __forceinline__ unsigned xb_ld(unsigned* p)              { return __hip_atomic_load(p, __ATOMIC_RELAXED, __HIP_MEMORY_SCOPE_AGENT); }
__device__ __forceinline__ unsigned xb_add(unsigned* p, unsigned v) { return __hip_atomic_fetch_add(p, v, __ATOMIC_RELAXED, __HIP_MEMORY_SCOPE_AGENT); }
__device__ __forceinline__ unsigned xb_xcc_id() { return (unsigned)__builtin_amdgcn_s_getreg((3 << 11) | 20) & 0xFu; }
#define XB_SPIN(cond, bar) do { unsigned _sp = 0; while (cond) { __builtin_amdgcn_s_sleep(1); \
    if ((++_sp & 255u) == 0u) { if (xb_ld(&(bar)[XB_TMO])) break; if (_sp > XB_SPIN_CAP) { atomicAdd(&(bar)[XB_TMO], 1u); break; } } } } while (0)

struct XcdBarrier {
    unsigned* bar; unsigned x;
    volatile LAS unsigned* st;
};

__device__ __forceinline__ XcdBarrier xcd_barrier_post(unsigned* bar, volatile LAS unsigned* st) {
    XcdBarrier b; b.bar = bar; b.x = xb_xcc_id(); b.st = st;
    if (threadIdx.x == 0) (void)xb_add(&bar[XB_XCNT(b.x)], 1u);
    return b;
}
__device__ __forceinline__ void xcd_barrier_complete(unsigned* bar, unsigned x, unsigned& nloc, unsigned& nx) {
    const unsigned G = gridDim.x * gridDim.y * gridDim.z;
    unsigned sum, cnt, mine, sp = 0u;
    for (;;) {
        sum = 0u; cnt = 0u; mine = 0u;
#pragma unroll
        for (unsigned j = 0; j < 16; ++j) { const unsigned c = xb_ld(&bar[XB_XCNT(j)]); sum += c; cnt += (c > 0u) ? 1u : 0u; mine = (j == x) ? c : mine; }
        if (sum == G) break;
        __builtin_amdgcn_s_sleep(1);
        if ((++sp & 255u) == 0u) { if (xb_ld(&bar[XB_TMO])) break; if (sp > XB_SPIN_CAP) { atomicAdd(&bar[XB_TMO], 1u); break; } }
    }
    nloc = mine > 0u ? mine : 1u; nx = cnt > 0u ? cnt : 1u;
}

__device__ __forceinline__ void xcd_barrier(const XcdBarrier& b) {
    asm volatile("s_waitcnt vmcnt(0)" ::: "memory");
    __syncthreads();
    if (threadIdx.x == 0) {
        unsigned* bar = b.bar;
        __builtin_amdgcn_s_waitcnt(0);
        unsigned nloc = b.st[0], nx = b.st[1];
        if (nloc == 0u) { xcd_barrier_complete(bar, b.x, nloc, nx); b.st[0] = nloc; b.st[1] = nx; }
        const unsigned old = xb_add(&bar[XB_XSUB(b.x)], 1u);
        const unsigned gen = old / nloc;
        if (old + 1u == (gen + 1u) * nloc) {
            __builtin_amdgcn_fence(__ATOMIC_RELEASE, "agent");
            asm volatile("s_waitcnt vmcnt(0)" ::: "memory");
            const unsigned og = xb_add(&bar[XB_TOP], 1u);
            const unsigned tg = og / nx;
            if (og + 1u == (tg + 1u) * nx) xb_add(&bar[XB_TOPGEN], 1u);
            else XB_SPIN(xb_ld(&bar[XB_TOPGEN]) == tg, bar);
            __builtin_amdgcn_fence(__ATOMIC_ACQUIRE, "agent");
            xb_add(&bar[XB_XGEN(b.x)], 1u);
            asm volatile("s_waitcnt vmcnt(0)" ::: "memory");
        } else {
            XB_SPIN(xb_ld(&bar[XB_XGEN(b.x)]) == gen, bar);
            __builtin_amdgcn_fence(__ATOMIC_ACQUIRE, "agent");
            asm volatile("s_waitcnt vmcnt(0)" ::: "memory");
        }
    }
    __syncthreads();
}


#ifndef PROBE_ID
#define PROBE_ID 0
#endif
#ifndef N_LAUNCH_MODE
#define N_LAUNCH_MODE 1
#endif
constexpr int N_PHASES = 15;

__global__ void __launch_bounds__(NTH, 2) fwd_kernel(Params p) {
    extern __shared__ __attribute__((aligned(16))) unsigned char lds[];
    const int lo = p.ph_lo, hi = p.ph_hi;
    volatile LAS unsigned* xst = (volatile LAS unsigned*)(lds + LDS_BYTES);
    if (threadIdx.x < 4) xst[threadIdx.x] = 0u;
    __syncthreads();
    const XcdBarrier xbar = xcd_barrier_post((unsigned*)(p.ws + WS_BAR), xst);
    unsigned char* ws = p.ws;
#define IN(k) (lo <= (k) && (k) < hi)
#define SEAM(k) do { if ((k) + 1 < hi) xcd_barrier(xbar); } while (0)
    if (IN(0)) {
        prep_weight(p.in[2], GIN, p.in[1], (bf16_t*)(ws + WS_WGIN), GIN_P, (float*)lds);
        prep_weight(p.in[6], DM, nullptr, (bf16_t*)(ws + WS_WGOUT), DM, (float*)lds);
        prep_wup(p.in[3], (bf16_t*)(ws + WS_WUPT));
        __syncthreads();
        phase_norm0(p, lds);
        SEAM(0);
    }
    if (IN(1)) {
        pg8::Gemm g{(const bf16_t*)(ws + WS_A), (const bf16_t*)(ws + WS_WGIN), MTOK, GIN_P, DM}; pg8::StaticOrder S; S.init(MTOK, GIN_P, gridDim.x, blockIdx.x);
        pg8::EpiBf16<0> E{(bf16_t*)(ws + WS_P), GIN_P, nullptr, 0, 0};
        pg8::gemm_phase<pg8::EpiBf16<0>, pg8::StaticOrder>((PG8_LAS unsigned char*)lds, g, S, E);
        SEAM(1);
    }
    if (IN(2)) { gla_pass<false>(p, lds); SEAM(2); }
    if (IN(3)) {
        gla_scan(p);
        prep_weight(p.in[9], RIN, p.in[8], (bf16_t*)(ws + WS_WRIN), RIN_P, (float*)lds);
        prep_weight(p.in[20], DM, nullptr, (bf16_t*)(ws + WS_WROUT), DM, (float*)lds);
        prep_lowrank(p.in[12], (bf16_t*)(ws + WS_WDUT));
        prep_lowrank(p.in[14], (bf16_t*)(ws + WS_WIUT));
        SEAM(3);
    }
    if (IN(4)) { gla_pass<true>(p, lds); SEAM(4); }
    if (IN(5)) {
        pg8::Gemm g{(const bf16_t*)(ws + WS_A), (const bf16_t*)(ws + WS_WGOUT), MTOK, DM, DM}; pg8::StaticOrder S; S.init(MTOK, DM, gridDim.x, blockIdx.x);
        pg8::EpiBf16<0> E{(bf16_t*)(ws + WS_Y), DM, nullptr, 0, 0};
        pg8::gemm_phase<pg8::EpiBf16<0>, pg8::StaticOrder>((PG8_LAS unsigned char*)lds, g, S, E);
        SEAM(5);
    }
    if (IN(6)) { phase_norm1(p); zero_bnd_row((bf16_t*)(ws + WS_BND)); SEAM(6); }
    if (IN(7)) {
        pg8::Gemm g{(const bf16_t*)(ws + WS_A), (const bf16_t*)(ws + WS_WRIN), MTOK, RIN_P, DM}; pg8::StaticOrder S; S.init(MTOK, RIN_P, gridDim.x, blockIdx.x);
        EpiBf16Bnd E{(bf16_t*)(ws + WS_P), RIN_P, (bf16_t*)(ws + WS_BND)};
        pg8::gemm_phase<EpiBf16Bnd, pg8::StaticOrder>((PG8_LAS unsigned char*)lds, g, S, E);
        SEAM(7);
    }
    if (IN(8)) { rwkv_r1(p, lds); SEAM(8); }
    if (IN(9)) { rwkv_scan2<1>(p, lds); SEAM(9); }
    if (IN(10)) { rwkv_scan2<2>(p, lds); SEAM(10); }
    if (IN(11)) { rwkv_scan2<3>(p, lds); SEAM(11); }
    if (IN(12)) { rwkv_post(p, lds); SEAM(12); }
    if (IN(13)) {
        pg8::Gemm g{(const bf16_t*)(ws + WS_A), (const bf16_t*)(ws + WS_WROUT), MTOK, DM, DM}; pg8::StaticOrder S; S.init(MTOK, DM, gridDim.x, blockIdx.x);
        pg8::EpiBf16<0> E{(bf16_t*)(ws + WS_Y), DM, nullptr, 0, 0};
        pg8::gemm_phase<pg8::EpiBf16<0>, pg8::StaticOrder>((PG8_LAS unsigned char*)lds, g, S, E);
        SEAM(13);
    }
    if (IN(14)) { phase_final(p); }
#undef IN
#undef SEAM
}

extern "C" void kernel_launch(void* const* d_in, const int* in_sizes, int n_in, void* d_out, int out_size, void* d_ws, size_t ws_size, hipStream_t stream) {
    static int grid = 0;
    if (grid == 0) {
        int dev = 0, cus = 0, per_cu = 0;
        hipGetDevice(&dev);
        hipDeviceGetAttribute(&cus, hipDeviceAttributeMultiprocessorCount, dev);
        hipFuncSetAttribute((const void*)fwd_kernel, hipFuncAttributeMaxDynamicSharedMemorySize, LDS_BYTES + 16);
        hipOccupancyMaxActiveBlocksPerMultiprocessor(&per_cu, (const void*)fwd_kernel, NTH, LDS_BYTES + 16);
        if (per_cu < 1) { fprintf(stderr, "kernel_launch: occupancy query says %d blocks per CU\n", per_cu); per_cu = 1; }
        grid = cus;
        if (n_in != 22 || ws_size < WS_END) fprintf(stderr, "kernel_launch: unexpected n_in %d or workspace %zu < %zu\n", n_in, ws_size, (size_t)WS_END);
        (void)hipGetLastError();
    }
    if (hipMemsetAsync((char*)d_ws + WS_BAR, 0, XCD_BAR_WORDS * 4, stream) != hipSuccess) fprintf(stderr, "kernel_launch: memset of the barrier words failed\n");
    Params p{};
    for (int i = 0; i < 22; ++i) p.in[i] = (const float*)d_in[i];
    p.out = (float*)d_out; p.ws = (unsigned char*)d_ws;
#if N_LAUNCH_MODE == 1
    void* args[] = {&p};
#if PROBE_ID > 0
    p.ph_lo = 0; p.ph_hi = PROBE_ID;
    (void)hipLaunchCooperativeKernel((const void*)fwd_kernel, dim3(grid), dim3(NTH), args, LDS_BYTES + 16, stream);
    (void)hipMemsetAsync((char*)d_ws + WS_BAR, 0, XCD_BAR_WORDS * 4, stream);
#endif
    p.ph_lo = 0; p.ph_hi = N_PHASES;
    hipError_t e = hipLaunchCooperativeKernel((const void*)fwd_kernel, dim3(grid), dim3(NTH), args, LDS_BYTES + 16, stream);
    if (e != hipSuccess) fprintf(stderr, "cooperative launch failed: %s (grid %d)\n", hipGetErrorString(e), grid);
#else
    for (int k = 0; k < N_PHASES; ++k) {
        p.ph_lo = k; p.ph_hi = k + 1;
        hipLaunchKernelGGL(fwd_kernel, dim3(grid), dim3(NTH), LDS_BYTES + 16, stream, p);
    }
#endif
}
```

```cpp
#include <hip/hip_runtime.h>
#include <hip/hip_cooperative_groups.h>
#include <cstdio>
namespace cg = cooperative_groups;
#define PROBE_ID 0
#define N_LAUNCH_MODE 1
namespace pg8 {
#define PG8_LAS __attribute__((address_space(3)))
typedef unsigned short bf16_t;
typedef short bf16x8 __attribute__((ext_vector_type(8)));
typedef float f32x4 __attribute__((ext_vector_type(4)));
typedef unsigned u32x4 __attribute__((ext_vector_type(4)));
constexpr int BM = 256, BK = 64, HALF = 128, HTB = HALF * BK * 2  , STAGE_BYTES = 8 * HTB, NXCD = 8, WGM = 8;

__host__ __device__ __forceinline__ int lds_byte(int r, int c) { const int st = (r >> 4) * 2 + (c >> 5), rr = r & 15, cc = c & 31, ob = rr * 64 + cc * 2; return st * 1024 + (ob ^ (((ob >> 9) & 1) << 5)); }
__host__ __device__ __forceinline__ void stage_rc(int b, int& R, int& C) { const int st = b / 1024, sb = b % 1024, swz = sb ^ (((sb >> 9) & 1) << 5); R = (st >> 1) * 16 + swz / 64; C = (st & 1) * 32 + (swz % 64) / 2; }
__host__ __device__ __forceinline__ int perm32(int rho) { const int n = rho >> 4, i = rho & 15; return 8 * (i >> 2) + 4 * n + (i & 3); }

struct Unit { int pm, pn; };
struct Gemm { const bf16_t* A; const bf16_t* Bt; int M, N, K; };

struct StaticOrder {
    int nM, nN, nwg, G, c;
    __host__ __device__ void init(int M, int N, int G_, int c_) { nM = M / BM; nN = N / BM; nwg = nM * nN; G = G_; c = c_; }
    __host__ __device__ bool next(int i, Unit& u) const {
        const long L = (long)i * G + c; if (L >= nwg) return false;
        int wgid = (int)L; { const int q = nwg / NXCD, r = nwg % NXCD, xcd = wgid % NXCD, off = wgid / NXCD; wgid = (xcd < r ? xcd * (q + 1) : r * (q + 1) + (xcd - r) * q) + off; }
        const int nig = WGM * nN, gid = wgid / nig, fm = gid * WGM, gsz = (nM - fm) < WGM ? (nM - fm) : WGM;
        u.pm = fm + ((wgid % nig) % gsz); u.pn = (wgid % nig) / gsz; return true;
    }
    __device__ __forceinline__ void a_ready(const Unit&) const {}
    __device__ __forceinline__ void done(const Unit&) const {}
};

typedef float cvt_f32x2 __attribute__((ext_vector_type(2)));
typedef __bf16 cvt_bf16x2 __attribute__((ext_vector_type(2)));
__device__ __forceinline__ unsigned cvt_pk_bf16(float lo, float hi) { const cvt_f32x2 v = {lo, hi}; union { cvt_bf16x2 b; unsigned u; } x; x.b = __builtin_convertvector(v, cvt_bf16x2); return x.u; }
typedef float f32x2 __attribute__((ext_vector_type(2)));
struct EpiF32 {
    static constexpr bool PERM = false, AFTER_DRAIN = false;
    float* C; int ldc; const float* bias;
    __device__ __forceinline__ void operator()(const f32x4 (&acc)[2][2][4][2], const Unit& u, int wr, int wc, int fr, int fq) const {
        const int row0 = u.pm * BM + wr * 64 + fr, col0 = u.pn * BM + wc * 32 + 4 * fq;
        f32x4 bv[2][2];
#pragma unroll
        for (int bj = 0; bj < 2; ++bj)
#pragma unroll
            for (int n = 0; n < 2; ++n) bv[bj][n] = bias ? *(const f32x4*)(bias + col0 + bj * HALF + n * 16) : (f32x4){0.f, 0.f, 0.f, 0.f};
#pragma unroll
        for (int ai = 0; ai < 2; ++ai)
#pragma unroll
            for (int m = 0; m < 4; ++m) { float* rowp = C + (size_t)(row0 + ai * HALF + m * 16) * ldc + col0;
#pragma unroll
                for (int bj = 0; bj < 2; ++bj)
#pragma unroll
                    for (int n = 0; n < 2; ++n) *(f32x4*)(rowp + bj * HALF + n * 16) = acc[ai][bj][m][n] + bv[bj][n]; }
    }
};
template <int ACT  > struct EpiBf16 {
    static constexpr bool PERM = true, AFTER_DRAIN = false;
    bf16_t* O; int ldc; const float* bias; int split_cols; size_t split_stride;
    __device__ __forceinline__ void operator()(const f32x4 (&acc)[2][2][4][2], const Unit& u, int wr, int wc, int fr, int fq) const {
        const int row0 = u.pm * BM + wr * 64 + fr; int colt = u.pn * BM; bf16_t* base = O;
        if (split_cols) { const int t = colt / split_cols; base += (size_t)t * split_stride; colt -= t * split_cols; }
        const int col0 = colt + wc * 32 + 8 * fq, bcol0 = u.pn * BM + wc * 32 + 8 * fq;
        f32x4 bv[2][2];
#pragma unroll
        for (int bj = 0; bj < 2; ++bj)
#pragma unroll
            for (int n = 0; n < 2; ++n) bv[bj][n] = bias ? *(const f32x4*)(bias + bcol0 + bj * HALF + 4 * n) : (f32x4){0.f, 0.f, 0.f, 0.f};
#pragma unroll
        for (int ai = 0; ai < 2; ++ai)
#pragma unroll
            for (int m = 0; m < 4; ++m) { bf16_t* rowp = base + (size_t)(row0 + ai * HALF + m * 16) * ldc + col0;
#pragma unroll
                for (int bj = 0; bj < 2; ++bj) { f32x4 v0 = acc[ai][bj][m][0] + bv[bj][0], v1 = acc[ai][bj][m][1] + bv[bj][1];
                    u32x4 w; w.x = cvt_pk_bf16(v0[0], v0[1]); w.y = cvt_pk_bf16(v0[2], v0[3]); w.z = cvt_pk_bf16(v1[0], v1[1]); w.w = cvt_pk_bf16(v1[2], v1[3]);
                    *(u32x4*)(rowp + bj * HALF) = w; } }
    }
};

template <class Epi, class Sched>
__device__ __forceinline__ void gemm_phase(PG8_LAS unsigned char* lds, const Gemm g, const Sched& S, const Epi& E) {
    const int tid = threadIdx.x, wid = __builtin_amdgcn_readfirstlane(tid >> 6), lane = tid & 63, wr = wid >> 2, wc = wid & 3, fr = lane & 15, fq = lane >> 4;
    const int K = g.K, nt = K / BK;
    unsigned voffA[2], voffB[2];
#pragma unroll
    for (int i = 0; i < 2; ++i) { int R, C; stage_rc(tid * 16 + i * 8192, R, C); const int Rb = Epi::PERM ? ((R & ~31) + perm32(R & 31)) : R;
        voffA[i] = (unsigned)(R * K + C) * 2u; voffB[i] = (unsigned)(Rb * K + C) * 2u; }
    const size_t kstep = (size_t)(BK * 2);
    const size_t hstep = (size_t)HALF * K * 2;
    const size_t tstep = 2 * hstep;
    const unsigned ldsw = (unsigned)wid * 1024u;
    const int aoff = lds_byte(wr * 64 + fr, fq * 8), boff = lds_byte(wc * 32 + fr, fq * 8);
#define PG8_SA(b, h) (((b) * 2 + (h)) * HTB)
#define PG8_SB(b, h) ((4 + (b) * 2 + (h)) * HTB)
#define PG8_STAGE(bufoff, gbase, voff) do { _Pragma("unroll") for (int _i = 0; _i < 2; ++_i) \
        __builtin_amdgcn_global_load_lds((const unsigned*)((const char*)(gbase) + (voff)[_i]), (PG8_LAS unsigned*)(lds + (bufoff) + ldsw + _i * 8192), 16, 0, 0); } while (0)
#define PG8_LDA(dst, b, h) do { _Pragma("unroll") for (int m = 0; m < 4; ++m) _Pragma("unroll") for (int k = 0; k < 2; ++k) dst[m][k] = *(const PG8_LAS bf16x8*)(lds + PG8_SA(b, h) + aoff + m * 2048 + k * 1024); } while (0)
#define PG8_LDB(dst, b, h) do { _Pragma("unroll") for (int n = 0; n < 2; ++n) _Pragma("unroll") for (int k = 0; k < 2; ++k) dst[n][k] = *(const PG8_LAS bf16x8*)(lds + PG8_SB(b, h) + boff + n * 2048 + k * 1024); } while (0)
#define PG8_MMA(ai, bj, At, Bt) do { __builtin_amdgcn_s_setprio(1); _Pragma("unroll") for (int m = 0; m < 4; ++m) _Pragma("unroll") for (int n = 0; n < 2; ++n) _Pragma("unroll") for (int k = 0; k < 2; ++k) \
        acc[ai][bj][m][n] = __builtin_amdgcn_mfma_f32_16x16x32_bf16(Bt[n][k], At[m][k], acc[ai][bj][m][n], 0, 0, 0); __builtin_amdgcn_s_setprio(0); } while (0)
#define PG8_WAIT_V(n) asm volatile("s_waitcnt vmcnt(" #n ")" ::: "memory")
#define PG8_WAIT_L(n) asm volatile("s_waitcnt lgkmcnt(" #n ")" ::: "memory")
#define PG8_BAR __builtin_amdgcn_s_barrier()
#define PG8_SCHED __builtin_amdgcn_sched_barrier(0)
    Unit cur, nxt; int ui = 0;
    if (!S.next(0, cur)) return;
    f32x4 acc[2][2][4][2];
#pragma unroll
    for (int a = 0; a < 2; ++a)
#pragma unroll
        for (int b = 0; b < 2; ++b)
#pragma unroll
            for (int m = 0; m < 4; ++m)
#pragma unroll
                for (int n = 0; n < 2; ++n) acc[a][b][m][n] = (f32x4){0.f, 0.f, 0.f, 0.f};
    bf16x8 At[4][2], B0[2][2], B1[2][2];
    const char* cA = (const char*)g.A + (size_t)cur.pm * tstep; const char* cB = (const char*)g.Bt + (size_t)cur.pn * tstep;
    S.a_ready(cur);
    PG8_STAGE(PG8_SB(0, 0), cB, voffB); PG8_STAGE(PG8_SA(0, 0), cA, voffA); PG8_STAGE(PG8_SB(0, 1), cB + hstep, voffB); PG8_STAGE(PG8_SA(0, 1), cA + hstep, voffA);
    if (wr == 1) PG8_BAR;
    PG8_WAIT_V(4); PG8_BAR;
    PG8_STAGE(PG8_SB(1, 0), cB + kstep, voffB); PG8_STAGE(PG8_SA(1, 0), cA + kstep, voffA); PG8_STAGE(PG8_SB(1, 1), cB + hstep + kstep, voffB);
    PG8_WAIT_V(6); PG8_BAR;
    for (;;) {
        const bool has_next = S.next(ui + 1, nxt);
        const char* nA = has_next ? (const char*)g.A + (size_t)nxt.pm * tstep : cA; const char* nB = has_next ? (const char*)g.Bt + (size_t)nxt.pn * tstep : cB;
        for (int t = 0; t < nt; t += 2) {
            const bool last = (t == nt - 2);
            const char* a1 = cA + (size_t)(t + 1) * kstep;
            const char* a2 = last ? nA : cA + (size_t)(t + 2) * kstep; const char* b2 = last ? nB : cB + (size_t)(t + 2) * kstep;
            const char* a3 = a2 + kstep; const char* b3 = b2 + kstep;
            if (last && has_next) S.a_ready(nxt);
            PG8_LDB(B0, 0, 0); PG8_SCHED; PG8_LDA(At, 0, 0); PG8_STAGE(PG8_SA(1, 1), a1 + hstep, voffA);
            PG8_WAIT_L(8); PG8_BAR; PG8_WAIT_L(0); PG8_MMA(0, 0, At, B0); PG8_BAR; PG8_SCHED;
            PG8_LDB(B1, 0, 1); PG8_STAGE(PG8_SB(0, 0), b2, voffB);
            PG8_BAR; PG8_WAIT_L(0); PG8_MMA(0, 1, At, B1); PG8_BAR;
            PG8_LDA(At, 0, 1); PG8_STAGE(PG8_SA(0, 0), a2, voffA);
            PG8_BAR; PG8_WAIT_L(0); PG8_MMA(1, 0, At, B0); PG8_BAR; PG8_SCHED;
            PG8_STAGE(PG8_SB(0, 1), b2 + hstep, voffB);
            PG8_WAIT_V(6); PG8_BAR; PG8_MMA(1, 1, At, B1); PG8_BAR;
            PG8_LDB(B0, 1, 0); PG8_SCHED; PG8_LDA(At, 1, 0); PG8_STAGE(PG8_SA(0, 1), a2 + hstep, voffA);
            PG8_WAIT_L(8); PG8_BAR; PG8_WAIT_L(0); PG8_MMA(0, 0, At, B0); PG8_BAR; PG8_SCHED;
            PG8_LDB(B1, 1, 1); PG8_STAGE(PG8_SB(1, 0), b3, voffB);
            PG8_BAR; PG8_WAIT_L(0); PG8_MMA(0, 1, At, B1); PG8_BAR;
            PG8_LDA(At, 1, 1); PG8_STAGE(PG8_SA(1, 0), a3, voffA);
            PG8_BAR; PG8_WAIT_L(0); PG8_MMA(1, 0, At, B0); PG8_BAR; PG8_SCHED;
            PG8_STAGE(PG8_SB(1, 1), b3 + hstep, voffB);
            PG8_WAIT_V(6); PG8_BAR; PG8_MMA(1, 1, At, B1); PG8_BAR;
        }
        if constexpr (!Epi::AFTER_DRAIN) { E(acc, cur, wr, wc, fr, fq); S.done(cur); }
        if (!has_next) break;
#pragma unroll
        for (int a = 0; a < 2; ++a)
#pragma unroll
            for (int b = 0; b < 2; ++b)
#pragma unroll
                for (int m = 0; m < 4; ++m)
#pragma unroll
                    for (int n = 0; n < 2; ++n) acc[a][b][m][n] = (f32x4){0.f, 0.f, 0.f, 0.f};
        cur = nxt; cA = nA; cB = nB; ++ui;
    }
    PG8_WAIT_V(0);
    if (wr == 0) PG8_BAR;
    PG8_BAR;
    if constexpr (Epi::AFTER_DRAIN) { E.fused(acc, cur, wr, wc, fr, fq, lds, wid, lane); S.done(cur); }
#undef PG8_SA
#undef PG8_SB
#undef PG8_STAGE
#undef PG8_LDA
#undef PG8_LDB
#undef PG8_MMA
#undef PG8_WAIT_V
#undef PG8_WAIT_L
#undef PG8_BAR
#undef PG8_SCHED
}
}


typedef unsigned short bf16_t;
typedef short bf16x8 __attribute__((ext_vector_type(8)));
typedef float f32x4 __attribute__((ext_vector_type(4)));
typedef unsigned u32x4 __attribute__((ext_vector_type(4)));
typedef unsigned u32x2 __attribute__((ext_vector_type(2)));

constexpr int MTOK = 32768, DM = 1024, SEQ = 16384, NTH = 512;
constexpr int GIN = 3088, GIN_P = 3072, RIN = 4224, RIN_P = 4352;
constexpr int LDS_BYTES = 147456;

constexpr size_t WS_WGIN  = 0;
constexpr size_t WS_WGOUT = WS_WGIN  + (size_t)GIN_P * DM * 2;
constexpr size_t WS_WRIN  = WS_WGOUT + (size_t)DM * DM * 2;
constexpr size_t WS_WROUT = WS_WRIN  + (size_t)RIN_P * DM * 2;
constexpr size_t WS_WDUT  = WS_WROUT + (size_t)DM * DM * 2;
constexpr size_t WS_WIUT  = WS_WDUT  + (size_t)DM * 64 * 2;
constexpr size_t WS_WUPT  = WS_WIUT  + (size_t)DM * 64 * 2;
constexpr size_t WS_A     = WS_WUPT  + (size_t)512 * 16 * 2;
constexpr size_t WS_Y     = WS_A     + (size_t)MTOK * DM * 2;
constexpr size_t WS_GS    = WS_Y     + (size_t)MTOK * DM * 2;
constexpr size_t WS_GD    = WS_GS    + (size_t)24 * 1024 * 1024;
constexpr size_t WS_P     = WS_GD    + (size_t)8 * 32 * 128 * 4;
constexpr size_t WS_BAR   = WS_P     + (size_t)MTOK * RIN_P * 2;
constexpr size_t WS_AD    = WS_BAR   + 16384;
constexpr size_t WS_X1    = WS_AD    + (size_t)MTOK * 16 * 2;
constexpr size_t WS_END   = WS_X1    + (size_t)MTOK * DM * 2;
static_assert(WS_END <= (size_t)512 * 1024 * 1024, "workspace budget (4 x the largest tensor)");

struct Params { const float* in[22]; float* out; unsigned char* ws; int ph_lo, ph_hi; };

__device__ __forceinline__ float bf2f(unsigned b) { return __uint_as_float(b << 16); }
__device__ __forceinline__ bf16_t f2bf(float f) { unsigned u = __float_as_uint(f); u += 0x7FFFu + ((u >> 16) & 1u); return (bf16_t)(u >> 16); }
__device__ __forceinline__ unsigned pk2(float lo, float hi) { return pg8::cvt_pk_bf16(lo, hi); }
__device__ __forceinline__ float wave_sum(float x) {
#pragma unroll
    for (int off = 32; off >= 1; off >>= 1) x += __shfl_xor(x, off);
    return x;
}
__device__ __forceinline__ f32x4 mfma16(bf16x8 a, bf16x8 b, f32x4 c) { return __builtin_amdgcn_mfma_f32_16x16x32_bf16(a, b, c, 0, 0, 0); }
__device__ __forceinline__ bf16x8 as_bf16x8(u32x4 v) { union { u32x4 u; bf16x8 b; } x; x.u = v; return x.b; }
__device__ __forceinline__ float fexp(float x) { return __builtin_amdgcn_exp2f(x * 1.4426950408889634f); }
__device__ __forceinline__ float flog(float x) { return __builtin_amdgcn_logf(x) * 0.6931471805599453f; }
__device__ __forceinline__ float log_sigmoid(float z) { return fminf(z, 0.f) - log1pf(fexp(-fabsf(z))); }
__device__ __forceinline__ float softplus(float z) { return fmaxf(z, 0.f) + log1pf(fexp(-fabsf(z))); }

__device__ void prep_weight(const float* __restrict__ W, int N, const float* __restrict__ gain, bf16_t* __restrict__ Wt, int NP, float* tile) {
    const int tid = threadIdx.x;
    const int nu = (NP / 64) * 16;
    const int lk = tid >> 4, lq = tid & 15;
    const int sn = tid >> 3, ss = tid & 7;
    float4 v[2];
#define PW_LOAD(u_) do { const int n0_ = ((u_) >> 4) * 64, k0_ = ((u_) & 15) * 64; _Pragma("unroll") for (int r = 0; r < 2; ++r) { const int k = k0_ + lk + 32 * r, n = n0_ + 4 * lq; \
        float4 x_ = make_float4(0.f, 0.f, 0.f, 0.f); if (n < N) { x_ = *(const float4*)(W + (size_t)k * N + n); if (gain) { const float g_ = gain[k]; x_.x *= g_; x_.y *= g_; x_.z *= g_; x_.w *= g_; } } v[r] = x_; } } while (0)
    int u = blockIdx.x;
    if (u < nu) PW_LOAD(u);
    for (; u < nu; u += gridDim.x) {
        const int n0 = (u >> 4) * 64, k0 = (u & 15) * 64;
#pragma unroll
        for (int r = 0; r < 2; ++r) *(float4*)(tile + (lk + 32 * r) * 68 + 4 * lq) = v[r];
        if (u + (int)gridDim.x < nu) PW_LOAD(u + gridDim.x);
        __syncthreads();
        {
            float e[8];
#pragma unroll
            for (int q = 0; q < 8; ++q) e[q] = tile[(8 * ss + q) * 68 + sn];
            *(u32x4*)(Wt + (size_t)(n0 + sn) * DM + k0 + 8 * ss) = (u32x4){pk2(e[0], e[1]), pk2(e[2], e[3]), pk2(e[4], e[5]), pk2(e[6], e[7])};
        }
        __syncthreads();
    }
#undef PW_LOAD
}

__device__ void prep_lowrank(const float* __restrict__ src, bf16_t* __restrict__ dst) {
    for (int idx = blockIdx.x * NTH + threadIdx.x; idx < 65536; idx += gridDim.x * NTH) dst[idx] = f2bf(src[(idx & 63) * 1024 + (idx >> 6)]);
}

__device__ void zero_bnd_row(bf16_t* bnd) {
    if (blockIdx.x == 0) for (int i = threadIdx.x; i < RIN_P / 2; i += NTH) ((unsigned*)bnd)[i] = 0u;
}

__device__ void prep_wup(const float* __restrict__ src, bf16_t* __restrict__ dst) {
    for (int idx = blockIdx.x * NTH + threadIdx.x; idx < 8192; idx += gridDim.x * NTH) dst[idx] = f2bf(src[(idx & 15) * 512 + (idx >> 4)]);
}

struct EpiBf16Bnd {
    static constexpr bool PERM = true, AFTER_DRAIN = false;
    bf16_t* O; int ldc; bf16_t* bnd;
    __device__ __forceinline__ void operator()(const f32x4 (&acc)[2][2][4][2], const pg8::Unit& u, int wr, int wc, int fr, int fq) const {
        const int row0 = u.pm * pg8::BM + wr * 64 + fr, col0 = u.pn * pg8::BM + wc * 32 + 8 * fq;
#pragma unroll
        for (int ai = 0; ai < 2; ++ai)
#pragma unroll
            for (int m = 0; m < 4; ++m) {
                const int row = row0 + ai * pg8::HALF + m * 16;
                bf16_t* rowp = O + (size_t)row * ldc + col0;
#pragma unroll
                for (int bj = 0; bj < 2; ++bj) {
                    const f32x4 v0 = acc[ai][bj][m][0], v1 = acc[ai][bj][m][1];
                    u32x4 wv; wv.x = pk2(v0[0], v0[1]); wv.y = pk2(v0[2], v0[3]); wv.z = pk2(v1[0], v1[1]); wv.w = pk2(v1[2], v1[3]);
                    *(u32x4*)(rowp + bj * pg8::HALF) = wv;
                    if (m == 3 && fr == 15) *(u32x4*)(bnd + (size_t)((row >> 6) + 1) * ldc + col0 + bj * pg8::HALF) = wv;
                }
            }
    }
};

__device__ void phase_norm0(const Params& p, unsigned char* lds) {
    const int tid = threadIdx.x, lane = tid & 63, w = tid >> 6, l15 = lane & 15, g = lane >> 4;
    const float* x = p.in[0];
    bf16_t* A = (bf16_t*)(p.ws + WS_A);
    bf16_t* AD = (bf16_t*)(p.ws + WS_AD);
    bf16_t* WAD = (bf16_t*)lds;
    float* PSS = (float*)(lds + 33024);
    float* PAD = (float*)(lds + 33024 + 512);
    for (int e = tid; e < 16384; e += NTH) { const int k = e >> 4, j = e & 15; WAD[j * 1032 + k] = f2bf(p.in[2][(size_t)k * GIN + 3072 + j] * p.in[1][k]); }
    __syncthreads();
    bf16x8 wf[4];
#pragma unroll
    for (int kk = 0; kk < 4; ++kk) wf[kk] = *(const bf16x8*)(WAD + l15 * 1032 + 128 * w + 32 * kk + 8 * g);
    float4 xa[4][2];
    int tile = blockIdx.x;
    if (tile < MTOK / 16) {
#pragma unroll
        for (int kk = 0; kk < 4; ++kk) { const float4* s = (const float4*)(x + (size_t)(16 * tile + l15) * DM + 128 * w + 32 * kk + 8 * g); xa[kk][0] = s[0]; xa[kk][1] = s[1]; }
    }
    for (; tile < MTOK / 16; tile += gridDim.x) {
        float4 xv[4][2];
#pragma unroll
        for (int kk = 0; kk < 4; ++kk) { xv[kk][0] = xa[kk][0]; xv[kk][1] = xa[kk][1]; }
        if (tile + (int)gridDim.x < MTOK / 16) {
#pragma unroll
            for (int kk = 0; kk < 4; ++kk) { const float4* s = (const float4*)(x + (size_t)(16 * (tile + gridDim.x) + l15) * DM + 128 * w + 32 * kk + 8 * g); xa[kk][0] = s[0]; xa[kk][1] = s[1]; }
        }
        float ss = 0.f;
        f32x4 acc = (f32x4){0.f, 0.f, 0.f, 0.f};
#pragma unroll
        for (int kk = 0; kk < 4; ++kk) {
            const float4 a = xv[kk][0], b = xv[kk][1];
            ss += a.x * a.x + a.y * a.y + a.z * a.z + a.w * a.w + b.x * b.x + b.y * b.y + b.z * b.z + b.w * b.w;
            acc = mfma16(as_bf16x8((u32x4){pk2(a.x, a.y), pk2(a.z, a.w), pk2(b.x, b.y), pk2(b.z, b.w)}), wf[kk], acc);
        }
        ss += __shfl_xor(ss, 16); ss += __shfl_xor(ss, 32);
        if (g == 0) PSS[w * 16 + l15] = ss;
        *(f32x4*)(PAD + (w * 64 + lane) * 4) = acc;
        __syncthreads();
        float tot = 0.f;
#pragma unroll
        for (int q = 0; q < 8; ++q) tot += PSS[q * 16 + l15];
        const float rstd = rsqrtf(tot * (1.0f / DM) + 1e-6f);
#pragma unroll
        for (int kk = 0; kk < 4; ++kk) {
            const float4 a = xv[kk][0], b = xv[kk][1];
            *(u32x4*)(A + (size_t)(16 * tile + l15) * DM + 128 * w + 32 * kk + 8 * g) = (u32x4){pk2(a.x * rstd, a.y * rstd), pk2(a.z * rstd, a.w * rstd), pk2(b.x * rstd, b.y * rstd), pk2(b.z * rstd, b.w * rstd)};
        }
        if (w == 0) {
            f32x4 s = (f32x4){0.f, 0.f, 0.f, 0.f};
#pragma unroll
            for (int q = 0; q < 8; ++q) s += *(const f32x4*)(PAD + (q * 64 + lane) * 4);
#pragma unroll
            for (int r = 0; r < 4; ++r) AD[(size_t)(16 * tile + 4 * g + r) * 16 + l15] = f2bf(s[r] * __shfl(rstd, 4 * g + r));
        }
        __syncthreads();
    }
}

__device__ void phase_norm1(const Params& p) {
    const int tid = threadIdx.x, lane = tid & 63, w = tid >> 6;
    const float* x = p.in[0];
    const float* gpost = p.in[7];
    const bf16_t* Y = (const bf16_t*)(p.ws + WS_Y);
    bf16_t* A = (bf16_t*)(p.ws + WS_A);
    bf16_t* X1 = (bf16_t*)(p.ws + WS_X1);
    float4 gp[4];
#pragma unroll
    for (int i = 0; i < 4; ++i) gp[i] = ((const float4*)gpost)[lane + 64 * i];
    const int stride = gridDim.x * 8;
    float4 vn[4]; u32x2 yn[4];
    {
        const int row = blockIdx.x * 8 + w;
#pragma unroll
        for (int i = 0; i < 4; ++i) { vn[i] = ((const float4*)(x + (size_t)row * DM))[lane + 64 * i]; yn[i] = *(const u32x2*)(Y + (size_t)row * DM + 4 * (lane + 64 * i)); }
    }
    for (int row = blockIdx.x * 8 + w; row < MTOK; row += stride) {
        float4 v[4]; u32x2 yv[4];
#pragma unroll
        for (int i = 0; i < 4; ++i) { v[i] = vn[i]; yv[i] = yn[i]; }
        if (row + stride < MTOK) {
#pragma unroll
            for (int i = 0; i < 4; ++i) { vn[i] = ((const float4*)(x + (size_t)(row + stride) * DM))[lane + 64 * i]; yn[i] = *(const u32x2*)(Y + (size_t)(row + stride) * DM + 4 * (lane + 64 * i)); }
        }
        float4 y[4];
        float ss = 0.f;
#pragma unroll
        for (int i = 0; i < 4; ++i) {
            y[i].x = bf2f(yv[i].x & 0xffffu); y[i].y = bf2f(yv[i].x >> 16); y[i].z = bf2f(yv[i].y & 0xffffu); y[i].w = bf2f(yv[i].y >> 16);
            ss += y[i].x * y[i].x + y[i].y * y[i].y + y[i].z * y[i].z + y[i].w * y[i].w;
        }
        ss = wave_sum(ss);
        const float rstdy = rsqrtf(ss * (1.0f / DM) + 1e-6f);
        float s1 = 0.f;
#pragma unroll
        for (int i = 0; i < 4; ++i) {
            v[i].x += y[i].x * rstdy * gp[i].x; v[i].y += y[i].y * rstdy * gp[i].y; v[i].z += y[i].z * rstdy * gp[i].z; v[i].w += y[i].w * rstdy * gp[i].w;
            s1 += v[i].x * v[i].x + v[i].y * v[i].y + v[i].z * v[i].z + v[i].w * v[i].w;
            u32x2 xo; xo.x = pk2(v[i].x, v[i].y); xo.y = pk2(v[i].z, v[i].w);
            *(u32x2*)(X1 + (size_t)row * DM + 4 * (lane + 64 * i)) = xo;
        }
        s1 = wave_sum(s1);
        const float rstd = rsqrtf(s1 * (1.0f / DM) + 1e-6f);
#pragma unroll
        for (int i = 0; i < 4; ++i) {
            u32x2 o; o.x = pk2(v[i].x * rstd, v[i].y * rstd); o.y = pk2(v[i].z * rstd, v[i].w * rstd);
            *(u32x2*)(A + (size_t)row * DM + 4 * (lane + 64 * i)) = o;
        }
    }
}

__device__ void phase_final(const Params& p) {
    const int tid = threadIdx.x, lane = tid & 63, w = tid >> 6;
    const float* gpost = p.in[21];
    const bf16_t* Y = (const bf16_t*)(p.ws + WS_Y);
    const bf16_t* X1 = (const bf16_t*)(p.ws + WS_X1);
    float4 gp[4];
#pragma unroll
    for (int i = 0; i < 4; ++i) gp[i] = ((const float4*)gpost)[lane + 64 * i];
    const int stride = gridDim.x * 8;
    u32x2 xn[4], yn[4];
    {
        const int row = blockIdx.x * 8 + w;
#pragma unroll
        for (int i = 0; i < 4; ++i) { xn[i] = *(const u32x2*)(X1 + (size_t)row * DM + 4 * (lane + 64 * i)); yn[i] = *(const u32x2*)(Y + (size_t)row * DM + 4 * (lane + 64 * i)); }
    }
    for (int row = blockIdx.x * 8 + w; row < MTOK; row += stride) {
        u32x2 xv[4], yv[4];
#pragma unroll
        for (int i = 0; i < 4; ++i) { xv[i] = xn[i]; yv[i] = yn[i]; }
        if (row + stride < MTOK) {
#pragma unroll
            for (int i = 0; i < 4; ++i) { xn[i] = *(const u32x2*)(X1 + (size_t)(row + stride) * DM + 4 * (lane + 64 * i)); yn[i] = *(const u32x2*)(Y + (size_t)(row + stride) * DM + 4 * (lane + 64 * i)); }
        }
        float4 y[4];
        float ss = 0.f;
#pragma unroll
        for (int i = 0; i < 4; ++i) {
            y[i].x = bf2f(yv[i].x & 0xffffu); y[i].y = bf2f(yv[i].x >> 16); y[i].z = bf2f(yv[i].y & 0xffffu); y[i].w = bf2f(yv[i].y >> 16);
            ss += y[i].x * y[i].x + y[i].y * y[i].y + y[i].z * y[i].z + y[i].w * y[i].w;
        }
        ss = wave_sum(ss);
        const float rstdy = rsqrtf(ss * (1.0f / DM) + 1e-6f);
#pragma unroll
        for (int i = 0; i < 4; ++i) {
            float4 v;
            v.x = bf2f(xv[i].x & 0xffffu) + y[i].x * rstdy * gp[i].x; v.y = bf2f(xv[i].x >> 16) + y[i].y * rstdy * gp[i].y;
            v.z = bf2f(xv[i].y & 0xffffu) + y[i].z * rstdy * gp[i].z; v.w = bf2f(xv[i].y >> 16) + y[i].w * rstdy * gp[i].w;
            ((float4*)(p.out + (size_t)row * DM))[lane + 64 * i] = v;
        }
    }
}

constexpr int L_BC = 0, L_ATT = 0, L_QD = 33792, L_KD = L_QD + 64 * 136 * 2, L_KTE = L_KD + 64 * 136 * 2, L_VI = L_KTE + 64 * 144 * 2, L_SSQ = L_VI + 64 * 272 * 2, L_BL = L_SSQ + 2048, L_DEC = L_BL + 512, L_ADL = L_DEC + 512,
              L_GLA_END = L_ADL + 2048;
static_assert(L_GLA_END <= LDS_BYTES, "GLA LDS");
#define GLA_BARRIER() do { asm volatile("s_waitcnt lgkmcnt(0)" ::: "memory"); __builtin_amdgcn_s_barrier(); asm volatile("" ::: "memory"); } while (0)
typedef short gs16x4 __attribute__((ext_vector_type(4)));
__device__ __forceinline__ u32x2 g_trread(const bf16_t* p) { union { gs16x4 s; u32x2 u; } x; x.s = __builtin_amdgcn_ds_read_tr16_b64_v4i16((__attribute__((address_space(3))) gs16x4*)p); return x.u; }
template <int PITCH> __device__ __forceinline__ bf16x8 g_trfrag(const bf16_t* img, int k0, int c0, int g, int q, int pq) {
    const bf16_t* a = img + (k0 + 8 * g + q) * PITCH + c0 + 4 * pq;
    const u32x2 lo = g_trread(a), hi = g_trread(a + 4 * PITCH);
    return as_bf16x8((u32x4){lo.x, lo.y, hi.x, hi.y});
}
__device__ __forceinline__ f32x4 g_lo4(u32x4 v) { return (f32x4){bf2f(v.x & 0xffffu), bf2f(v.x >> 16), bf2f(v.y & 0xffffu), bf2f(v.y >> 16)}; }
__device__ __forceinline__ f32x4 g_hi4(u32x4 v) { return (f32x4){bf2f(v.z & 0xffffu), bf2f(v.z >> 16), bf2f(v.w & 0xffffu), bf2f(v.w >> 16)}; }
__device__ __forceinline__ u32x2 g_pk4(f32x4 v) { u32x2 r; r.x = pk2(v[0], v[1]); r.y = pk2(v[2], v[3]); return r; }
__device__ __forceinline__ f32x4 g_unpk4(u32x2 v) { return (f32x4){bf2f(v.x & 0xffffu), bf2f(v.x >> 16), bf2f(v.y & 0xffffu), bf2f(v.y >> 16)}; }

template <bool OUT> struct GlaRaw { u32x4 q[2], k[2], v[4]; };
template <bool OUT> __device__ __forceinline__ void gla_issue(GlaRaw<OUT>& x, const char* cb  , unsigned offQ, unsigned offV) {
    if (OUT) { x.q[0] = *(const u32x4*)(cb + offQ); x.q[1] = *(const u32x4*)(cb + offQ + 16); }
    x.k[0] = *(const u32x4*)(cb + offQ + 1024); x.k[1] = *(const u32x4*)(cb + offQ + 1040);
#pragma unroll
    for (int i = 0; i < 4; ++i) x.v[i] = *(const u32x4*)(cb + offV + 16 * i);
}

template <bool OUT>
__device__ void gla_pass(const Params& p, unsigned char* lds) {
    const int tid = threadIdx.x, w = __builtin_amdgcn_readfirstlane(tid >> 6);
    const bf16_t* P = (const bf16_t*)(p.ws + WS_P);
    bf16_t* GS = (bf16_t*)(p.ws + WS_GS);
    float* GD = (float*)(p.ws + WS_GD);
    bf16_t* Aout = (bf16_t*)(p.ws + WS_A);
    const bf16_t* WupT = (const bf16_t*)(p.ws + WS_WUPT);
    const bf16_t* ADG = (const bf16_t*)(p.ws + WS_AD);
    float* BC = (float*)(lds + L_BC); bf16_t* ATT = (bf16_t*)(lds + L_ATT); bf16_t* QD = (bf16_t*)(lds + L_QD); bf16_t* KD = (bf16_t*)(lds + L_KD); bf16_t* KTE = (bf16_t*)(lds + L_KTE);
    bf16_t* VI = (bf16_t*)(lds + L_VI); float* SSQ = (float*)(lds + L_SSQ); float* BL = (float*)(lds + L_BL); float* DEC = (float*)(lds + L_DEC); bf16_t* ADL = (bf16_t*)(lds + L_ADL);
    const float* b_al = p.in[4]; const float* g_head = p.in[5];

    for (int unit = blockIdx.x; unit < 256; unit += gridDim.x) {
        const int bh = unit >> 5, m = unit & 31, b = bh >> 2, h = bh & 3;
        int tidv = tid; asm volatile("" : "+v"(tidv));
        const int lane = tidv & 63, l15 = lane & 15, g = lane >> 4, q4 = l15 >> 2, p4 = l15 & 3;
        const int c = tidv >> 3, seg = tidv & 7;
        const int tokbase = b * SEQ + m * 512;
        u32x4 wupq = *(const u32x4*)(WupT + (size_t)(h * 128 + 16 * w + l15) * 16 + 8 * (g & 1));
        if (g >= 2) wupq = (u32x4){0u, 0u, 0u, 0u};
        const bf16x8 wupf = as_bf16x8(wupq);
        const float bA = b_al[h * 128 + 16 * w + l15];
        f32x4 gh[2];
#pragma unroll
        for (int vt = 0; vt < 2; ++vt) gh[vt] = *(const f32x4*)(g_head + 32 * w + 16 * vt + 4 * g);
        float logD = 0.f;
        f32x4 S[8][2];
#pragma unroll
        for (int mt = 0; mt < 8; ++mt)
#pragma unroll
            for (int vt = 0; vt < 2; ++vt) {
                if (OUT) S[mt][vt] = g_unpk4(*(const u32x2*)(GS + ((size_t)(bh * 32 + m) * 256 + 32 * w + 16 * vt + l15) * 128 + 16 * mt + 4 * g));
                else S[mt][vt] = (f32x4){0.f, 0.f, 0.f, 0.f};
            }
        const unsigned offQ = (unsigned)((c * GIN_P + h * 128 + 16 * seg) * 2), offV = (unsigned)((c * GIN_P + 1024 + h * 256 + 32 * seg) * 2), offAD = (unsigned)(tid * 16);
        const unsigned offG = (unsigned)((l15 * GIN_P + 2048 + h * 256 + 32 * w + 4 * g) * 2), offO = (unsigned)((l15 * DM + h * 256 + 32 * w + 4 * g) * 2);
        GlaRaw<OUT> raw;
        gla_issue<OUT>(raw, (const char*)P + (size_t)tokbase * GIN_P * 2, offQ, offV);
        if (tid < 128) *(u32x4*)(ADL + tid * 8) = *(const u32x4*)((const char*)ADG + (size_t)tokbase * 32 + offAD);
        GLA_BARRIER();

        for (int ch = 0; ch < 8; ++ch) {
            const int tok0 = tokbase + ch * 64;
            u32x4 adn = (u32x4){0u, 0u, 0u, 0u};
            {
                if (ch < 7 && tid < 128) adn = *(const u32x4*)((const char*)ADG + (size_t)(tok0 + 64) * 32 + offAD);
                f32x4 sc[4]; float xinc[4], tot[4];
#pragma unroll
                for (int ct = 0; ct < 4; ++ct) {
                    u32x4 aq = *(const u32x4*)(ADL + (16 * ct + l15) * 16 + 8 * (g & 1));
                    if (g >= 2) aq = (u32x4){0u, 0u, 0u, 0u};
                    const f32x4 z = mfma16(as_bf16x8(aq), wupf, (f32x4){bA, bA, bA, bA});
                    float acc = 0.f;
#pragma unroll
                    for (int r = 0; r < 4; ++r) { acc += (fminf(z[r], 0.f) - flog(1.f + fexp(-fabsf(z[r])))) * (1.0f / 16.0f); sc[ct][r] = acc; }
                    xinc[ct] = acc;
                }
#pragma unroll
                for (int ct = 0; ct < 4; ++ct) { const float y = __shfl_up(xinc[ct], 16); if (g >= 1) xinc[ct] += y; }
#pragma unroll
                for (int ct = 0; ct < 4; ++ct) { const float y = __shfl_up(xinc[ct], 32); if (g >= 2) xinc[ct] += y; }
#pragma unroll
                for (int ct = 0; ct < 4; ++ct) tot[ct] = __shfl(xinc[ct], 48 + l15);
                float run = 0.f;
#pragma unroll
                for (int ct = 0; ct < 4; ++ct) {
                    const float base = run + (xinc[ct] - sc[ct][3]);
                    run += tot[ct];
#pragma unroll
                    for (int r = 0; r < 4; ++r) BC[(16 * ct + 4 * g + r) * 132 + 16 * w + l15] = base + sc[ct][r];
                }
                if (g == 0) { BL[16 * w + l15] = run; DEC[16 * w + l15] = fexp(run); }
                if (!OUT) logD += run;
            }
            GLA_BARRIER();
            u32x2 gate[2][4];
            {
#pragma unroll
                for (int hh = 0; hh < 2; ++hh) {
                    const int o8 = 16 * seg + 8 * hh;
                    const f32x4 bb[2] = {*(const f32x4*)(BC + c * 132 + o8), *(const f32x4*)(BC + c * 132 + o8 + 4)};
                    const f32x4 dc[2] = {*(const f32x4*)(DEC + o8), *(const f32x4*)(DEC + o8 + 4)};
                    const f32x4 kx[2] = {g_lo4(raw.k[hh]), g_hi4(raw.k[hh])};
                    f32x4 qx[2];
                    if (OUT) { qx[0] = g_lo4(raw.q[hh]); qx[1] = g_hi4(raw.q[hh]); }
                    f32x4 kd[2], kt[2], qd[2];
#pragma unroll
                    for (int i = 0; i < 2; ++i)
#pragma unroll
                        for (int j = 0; j < 4; ++j) {
                            const float eB = fexp(bb[i][j]), enB = __builtin_amdgcn_rcpf(eB);
                            kd[i][j] = kx[i][j] * enB; kt[i][j] = kd[i][j] * dc[i][j];
                            if (OUT) qd[i][j] = qx[i][j] * 0.08838834764831845f * eB;
                        }
                    *(u32x4*)(KTE + c * 144 + o8) = (u32x4){pk2(kt[0][0], kt[0][1]), pk2(kt[0][2], kt[0][3]), pk2(kt[1][0], kt[1][1]), pk2(kt[1][2], kt[1][3])};
                    if (OUT) {
                        *(u32x4*)(KD + c * 136 + o8) = (u32x4){pk2(kd[0][0], kd[0][1]), pk2(kd[0][2], kd[0][3]), pk2(kd[1][0], kd[1][1]), pk2(kd[1][2], kd[1][3])};
                        *(u32x4*)(QD + c * 136 + o8) = (u32x4){pk2(qd[0][0], qd[0][1]), pk2(qd[0][2], qd[0][3]), pk2(qd[1][0], qd[1][1]), pk2(qd[1][2], qd[1][3])};
                    }
                }
#pragma unroll
                for (int i = 0; i < 4; ++i) *(u32x4*)(VI + c * 272 + 32 * seg + 8 * i) = raw.v[i];
                if (OUT) {
#pragma unroll
                    for (int vt = 0; vt < 2; ++vt)
#pragma unroll
                        for (int ct = 0; ct < 4; ++ct) gate[vt][ct] = *(const u32x2*)((const char*)P + (size_t)(tok0 + 16 * ct) * GIN_P * 2 + offG + 32 * vt);
                }
                if (ch < 7) gla_issue<OUT>(raw, (const char*)P + (size_t)(tok0 + 64) * GIN_P * 2, offQ, offV);
                if (ch < 7 && tid < 128) *(u32x4*)(ADL + tid * 8) = adn;
            }
            GLA_BARRIER();
            f32x4 o[2][4];
            if (OUT) {
#pragma unroll
                for (int t2 = 0; t2 < 2; ++t2) {
                    const int tl = 2 * w + t2, ct = tl >> 2, st = tl & 3;
                    f32x4 acc = (f32x4){0.f, 0.f, 0.f, 0.f};
                    if (st <= ct) {
#pragma unroll
                        for (int kk = 0; kk < 4; ++kk) {
                            const bf16x8 a = *(const bf16x8*)(KD + (16 * st + l15) * 136 + 32 * kk + 8 * g);
                            const bf16x8 bq = *(const bf16x8*)(QD + (16 * ct + l15) * 136 + 32 * kk + 8 * g);
                            acc = mfma16(a, bq, acc);
                        }
#pragma unroll
                        for (int r = 0; r < 4; ++r) if (16 * st + 4 * g + r > 16 * ct + l15) acc[r] = 0.f;
                    }
                    *(u32x2*)(ATT + (16 * ct + l15) * 72 + 16 * st + 4 * g) = g_pk4(acc);
                }
                GLA_BARRIER();
#pragma unroll
                for (int vt = 0; vt < 2; ++vt)
#pragma unroll
                    for (int ct = 0; ct < 4; ++ct) o[vt][ct] = (f32x4){0.f, 0.f, 0.f, 0.f};
#pragma unroll
                for (int kk = 0; kk < 4; ++kk) {
                    bf16x8 sa[2];
#pragma unroll
                    for (int vt = 0; vt < 2; ++vt) { const u32x2 s0 = g_pk4(S[2 * kk][vt]), s1 = g_pk4(S[2 * kk + 1][vt]); sa[vt] = as_bf16x8((u32x4){s0.x, s0.y, s1.x, s1.y}); }
#pragma unroll
                    for (int ct = 0; ct < 4; ++ct) {
                        const bf16_t* qr = QD + (16 * ct + l15) * 136 + 32 * kk + 4 * g;
                        const u32x2 lo = *(const u32x2*)qr, hi = *(const u32x2*)(qr + 16);
                        const bf16x8 bq = as_bf16x8((u32x4){lo.x, lo.y, hi.x, hi.y});
#pragma unroll
                        for (int vt = 0; vt < 2; ++vt) o[vt][ct] = mfma16(sa[vt], bq, o[vt][ct]);
                    }
                }
            }
            bf16x8 bv[2][2];
#pragma unroll
            for (int vt = 0; vt < 2; ++vt)
#pragma unroll
                for (int kk = 0; kk < 2; ++kk) bv[vt][kk] = g_trfrag<272>(VI, 32 * kk, 32 * w + 16 * vt, g, q4, p4);
            if (OUT) {
#pragma unroll
                for (int ct = 0; ct < 4; ++ct)
#pragma unroll
                    for (int kk = 0; kk < 2; ++kk) {
                        if (32 * kk <= 16 * ct + 15) {
                            const bf16x8 bq = *(const bf16x8*)(ATT + (16 * ct + l15) * 72 + 32 * kk + 8 * g);
#pragma unroll
                            for (int vt = 0; vt < 2; ++vt) o[vt][ct] = mfma16(bv[vt][kk], bq, o[vt][ct]);
                        }
                    }
            }
#pragma unroll
            for (int mt = 0; mt < 8; ++mt) {
                const f32x4 dv = *(const f32x4*)(DEC + 16 * mt + 4 * g);
#pragma unroll
                for (int vt = 0; vt < 2; ++vt) S[mt][vt] *= dv;
#pragma unroll
                for (int kk = 0; kk < 2; ++kk) {
                    const bf16x8 a = g_trfrag<144>(KTE, 32 * kk, 16 * mt, g, q4, p4);
#pragma unroll
                    for (int vt = 0; vt < 2; ++vt) S[mt][vt] = mfma16(a, bv[vt][kk], S[mt][vt]);
                }
            }
            if (OUT) {
                float ss[4];
#pragma unroll
                for (int ct = 0; ct < 4; ++ct) {
                    float s = 0.f;
#pragma unroll
                    for (int vt = 0; vt < 2; ++vt)
#pragma unroll
                        for (int r = 0; r < 4; ++r) s += o[vt][ct][r] * o[vt][ct][r];
                    s += __shfl_xor(s, 16); s += __shfl_xor(s, 32);
                    ss[ct] = s;
                }
                if (g == 0) {
#pragma unroll
                    for (int ct = 0; ct < 4; ++ct) SSQ[(16 * ct + l15) * 8 + w] = ss[ct];
                }
                GLA_BARRIER();
#pragma unroll
                for (int ct = 0; ct < 4; ++ct) {
                    const int cc = 16 * ct + l15;
                    const float4 s0 = *(const float4*)(SSQ + cc * 8), s1 = *(const float4*)(SSQ + cc * 8 + 4);
                    const float tot = (s0.x + s0.y) + (s0.z + s0.w) + (s1.x + s1.y) + (s1.z + s1.w);
                    const float rstd = rsqrtf(tot * (1.0f / 256.0f) + 1e-6f);
#pragma unroll
                    for (int vt = 0; vt < 2; ++vt) {
                        const f32x4 gt = g_unpk4(gate[vt][ct]);
                        f32x4 val;
#pragma unroll
                        for (int r = 0; r < 4; ++r) val[r] = o[vt][ct][r] * rstd * gh[vt][r] * gt[r] * __builtin_amdgcn_rcpf(1.0f + fexp(-gt[r]));
                        *(u32x2*)((char*)Aout + (size_t)(tok0 + 16 * ct) * DM * 2 + offO + 32 * vt) = g_pk4(val);
                    }
                }
            } else {
                GLA_BARRIER();
            }
        }
        if (!OUT) {
#pragma unroll
            for (int mt = 0; mt < 8; ++mt)
#pragma unroll
                for (int vt = 0; vt < 2; ++vt) *(u32x2*)(GS + ((size_t)(bh * 32 + m) * 256 + 32 * w + 16 * vt + l15) * 128 + 16 * mt + 4 * g) = g_pk4(S[mt][vt]);
            if (g == 0) GD[(bh * 32 + m) * 128 + 16 * w + l15] = fexp(logD);
        }
        GLA_BARRIER();
    }
}

__device__ void gla_scan(const Params& p) {
    bf16_t* GS = (bf16_t*)(p.ws + WS_GS);
    const float* GD = (const float*)(p.ws + WS_GD);
    for (int idx = blockIdx.x * NTH + threadIdx.x; idx < 8 * 8192; idx += gridDim.x * NTH) {
        const int bh = idx >> 13, e = (idx & 8191) * 4, d = e & 127;
        f32x4 S = (f32x4){0.f, 0.f, 0.f, 0.f};
        for (int m0 = 0; m0 < 32; m0 += 8) {
            u32x2 t[8]; f32x4 dd[8];
#pragma unroll
            for (int m = 0; m < 8; ++m) { t[m] = *(const u32x2*)(GS + (size_t)(bh * 32 + m0 + m) * 32768 + e); dd[m] = *(const f32x4*)(GD + (bh * 32 + m0 + m) * 128 + d); }
#pragma unroll
            for (int m = 0; m < 8; ++m) { *(u32x2*)(GS + (size_t)(bh * 32 + m0 + m) * 32768 + e) = g_pk4(S); S = S * dd[m] + g_unpk4(t[m]); }
        }
    }
}

constexpr int PP = RIN_P;
constexpr size_t WS_RK  = WS_GS;
constexpr size_t WS_BND = WS_GS + (size_t)MTOK * 16 * 4;
static_assert(WS_BND + (size_t)513 * PP * 2 <= WS_GD, "RWKV side buffers must fit the GLA state region");
constexpr int IMG = 64 * 72 * 2;
constexpr int R_ALB = 0, R_BH = IMG, R_KH = 2 * IMG, R_RB = 3 * IMG, R_BTL = 4 * IMG, R_KTL = 5 * IMG, R_VI = 6 * IMG, R_AAB = 7 * IMG, R_AAK = 8 * IMG, R_ARB = 9 * IMG, R_ARK = 10 * IMG,
              R_DW = R_AAB, R_DA = R_AAB + 64 * 68 * 4, R_XT = 11 * IMG, R_TW = R_XT, R_ADI = R_XT + IMG, R_TDF = R_XT + 2 * IMG, R_CS = R_TDF + 2048, R_GC = R_CS + 2048, R_CONST = R_GC + 256, R_WDL = R_CONST + 2560, R_WIL = R_WDL + IMG,
              R_END = R_WIL + IMG;
static_assert(R_DA + 64 * 68 * 4 <= R_XT && R_END <= LDS_BYTES, "R1 LDS");
#define LDS_BARRIER() do { asm volatile("s_waitcnt lgkmcnt(0)" ::: "memory"); __builtin_amdgcn_s_barrier(); asm volatile("" ::: "memory"); } while (0)

typedef short s16x4 __attribute__((ext_vector_type(4)));
__device__ __forceinline__ bf16x8 ldfrag(const bf16_t* img, int row, int koff) { return *(const bf16x8*)(img + row * 72 + koff); }
__device__ __forceinline__ u32x2 pk4(f32x4 v) { u32x2 r; r.x = pk2(v[0], v[1]); r.y = pk2(v[2], v[3]); return r; }
__device__ __forceinline__ f32x4 unpk4(u32x2 v) { return (f32x4){bf2f(v.x & 0xffffu), bf2f(v.x >> 16), bf2f(v.y & 0xffffu), bf2f(v.y >> 16)}; }
__device__ __forceinline__ u32x2 trread(const bf16_t* p) {
    union { s16x4 s; u32x2 u; } x; x.s = __builtin_amdgcn_ds_read_tr16_b64_v4i16((__attribute__((address_space(3))) s16x4*)p); return x.u;
}
__device__ __forceinline__ bf16x8 trfrag(const bf16_t* img, int k0, int c0, int g, int q, int pq) {
    const bf16_t* a = img + (k0 + 8 * g + q) * 72 + c0 + 4 * pq;
    const u32x2 lo = trread(a), hi = trread(a + 4 * 72);
    return as_bf16x8((u32x4){lo.x, lo.y, hi.x, hi.y});
}
__device__ __forceinline__ f32x4 lo4(u32x4 v) { return (f32x4){bf2f(v.x & 0xffffu), bf2f(v.x >> 16), bf2f(v.y & 0xffffu), bf2f(v.y >> 16)}; }
__device__ __forceinline__ f32x4 hi4(u32x4 v) { return (f32x4){bf2f(v.z & 0xffffu), bf2f(v.z >> 16), bf2f(v.w & 0xffffu), bf2f(v.w >> 16)}; }
__device__ __forceinline__ u32x4 pk8(f32x4 a, f32x4 b) { return (u32x4){pk2(a[0], a[1]), pk2(a[2], a[3]), pk2(b[0], b[1]), pk2(b[2], b[3])}; }
__device__ __forceinline__ float fast_rcp(float x) { return __builtin_amdgcn_rcpf(x); }
__device__ __forceinline__ f32x4 mm16(f32x4 xa, f32x4 yb, f32x4 c) {
    const u32x2 a = pk4(xa), b = pk4(yb);
    return mfma16(as_bf16x8((u32x4){a.x, a.y, 0u, 0u}), as_bf16x8((u32x4){b.x, b.y, 0u, 0u}), c);
}

struct R1Raw { u32x4 r0, r1, k0, k1, v0, v1, w0, w1, a0, a1; };
__device__ __forceinline__ void r1_issue(R1Raw& x, const bf16_t* P, const bf16_t* BND, int unit, int t, int cs) {
    const int bn = unit >> 4, h = unit & 15, n = bn & 255;
    const bf16_t* cur = P + ((size_t)bn * 64 + t) * PP;
    const bf16_t* prv = (t > 0) ? (cur - PP) : (BND + (size_t)(n == 0 ? 0 : bn) * PP);
    const int ch = h * 64 + 8 * cs;
    x.r0 = *(const u32x4*)(cur + ch); x.k0 = *(const u32x4*)(cur + 1024 + ch); x.v0 = *(const u32x4*)(cur + 2048 + ch); x.w0 = *(const u32x4*)(cur + 4096 + 8 * cs); x.a0 = *(const u32x4*)(cur + 4160 + 8 * cs);
    x.r1 = *(const u32x4*)(prv + ch); x.k1 = *(const u32x4*)(prv + 1024 + ch); x.v1 = *(const u32x4*)(prv + 2048 + ch); x.w1 = *(const u32x4*)(prv + 4096 + 8 * cs); x.a1 = *(const u32x4*)(prv + 4160 + 8 * cs);
}
__device__ __forceinline__ void lerp8(u32x4 c, u32x4 pv, const float* mu8, f32x4& o0, f32x4& o1) {
    const f32x4 c0 = lo4(c), c1 = hi4(c), p0 = lo4(pv), p1 = hi4(pv);
    const f32x4 m0 = *(const f32x4*)mu8, m1 = *(const f32x4*)(mu8 + 4);
    o0 = c0 + m0 * (p0 - c0); o1 = c1 + m1 * (p1 - c1);
}

__device__ void rwkv_r1(const Params& p, unsigned char* lds) {
    const int tid = threadIdx.x, w = __builtin_amdgcn_readfirstlane(tid >> 6);
    bf16_t* P = (bf16_t*)(p.ws + WS_P);
    bf16_t* Abuf = (bf16_t*)(p.ws + WS_A);
    bf16_t* Ybuf = (bf16_t*)(p.ws + WS_Y);
    float* RK = (float*)(p.ws + WS_RK);
    const bf16_t* BND = (const bf16_t*)(p.ws + WS_BND);
    const bf16_t* WduT = (const bf16_t*)(p.ws + WS_WDUT);
    const bf16_t* WiuT = (const bf16_t*)(p.ws + WS_WIUT);
    bf16_t* ALB = (bf16_t*)(lds + R_ALB); bf16_t* BH = (bf16_t*)(lds + R_BH); bf16_t* KH = (bf16_t*)(lds + R_KH); bf16_t* RB = (bf16_t*)(lds + R_RB);
    bf16_t* BTL = (bf16_t*)(lds + R_BTL); bf16_t* KTL = (bf16_t*)(lds + R_KTL); bf16_t* VI = (bf16_t*)(lds + R_VI);
    bf16_t* AAB = (bf16_t*)(lds + R_AAB); bf16_t* AAK = (bf16_t*)(lds + R_AAK); bf16_t* ARB = (bf16_t*)(lds + R_ARB); bf16_t* ARK = (bf16_t*)(lds + R_ARK);
    float* DW = (float*)(lds + R_DW); float* DA = (float*)(lds + R_DA);
    bf16_t* XT = (bf16_t*)(lds + R_XT); bf16_t* TW = (bf16_t*)(lds + R_TW); bf16_t* ADI = (bf16_t*)(lds + R_ADI);
    u32x2* TDF = (u32x2*)(lds + R_TDF); float* CS = (float*)(lds + R_CS); float* GCs = (float*)(lds + R_GC); float* CONST = (float*)(lds + R_CONST); bf16_t* WDL = (bf16_t*)(lds + R_WDL); bf16_t* WIL = (bf16_t*)(lds + R_WIL);
    const int t0_ = tid >> 3, cs0_ = tid & 7;
    int hprev = -1;
    R1Raw raw;
    if (blockIdx.x < 8192) r1_issue(raw, P, BND, blockIdx.x, t0_, cs0_);

    for (int unit = blockIdx.x; unit < 8192; unit += gridDim.x) {
        const int bn = unit >> 4, h = unit & 15, n = bn & 255;
        const size_t R0 = (size_t)bn * 64;
        int tidv = tid; asm volatile("" : "+v"(tidv));
        const int lane = tidv & 63, l15 = lane & 15, g = lane >> 4, q4 = l15 >> 2, p4 = l15 & 3, t = tidv >> 3, cs = tidv & 7, tl = lane >> 3;
        if (h != hprev) {
            LDS_BARRIER();
            if (tid < 64) {
                const int ch = h * 64 + tid;
                CONST[tid] = p.in[10][ch]; CONST[64 + tid] = p.in[10][1024 + ch]; CONST[128 + tid] = p.in[10][2048 + ch];
                CONST[192 + tid] = p.in[11][ch]; CONST[256 + tid] = p.in[13][ch]; CONST[320 + tid] = p.in[15][ch]; CONST[384 + tid] = p.in[16][ch]; CONST[448 + tid] = p.in[17][ch];
                CONST[512 + tid] = p.in[10][4096 + tid]; CONST[576 + tid] = p.in[10][4160 + tid];
            }
            {
                const int rr = tid >> 3, sg = tid & 7;
                *(u32x4*)(WDL + rr * 72 + 8 * sg) = *(const u32x4*)(WduT + (size_t)(h * 64 + rr) * 64 + 8 * sg);
                *(u32x4*)(WIL + rr * 72 + 8 * sg) = *(const u32x4*)(WiuT + (size_t)(h * 64 + rr) * 64 + 8 * sg);
            }
            hprev = h;
            LDS_BARRIER();
        }
        f32x4 r0, r1, k0, k1, v0, v1;
        {
            f32x4 wd0, wd1, ad0, ad1;
            lerp8(raw.r0, raw.r1, CONST + 8 * cs, r0, r1);
            lerp8(raw.k0, raw.k1, CONST + 64 + 8 * cs, k0, k1);
            lerp8(raw.v0, raw.v1, CONST + 128 + 8 * cs, v0, v1);
            lerp8(raw.w0, raw.w1, CONST + 512 + 8 * cs, wd0, wd1);
            lerp8(raw.a0, raw.a1, CONST + 576 + 8 * cs, ad0, ad1);
#pragma unroll
            for (int j = 0; j < 4; ++j) {
                const float e0 = fexp(-2.f * fabsf(wd0[j])), e1 = fexp(-2.f * fabsf(wd1[j]));
                wd0[j] = copysignf((1.f - e0) * fast_rcp(1.f + e0), wd0[j]); wd1[j] = copysignf((1.f - e1) * fast_rcp(1.f + e1), wd1[j]);
            }
            *(u32x4*)(TW + t * 72 + 8 * cs) = pk8(wd0, wd1);
            *(u32x4*)(ADI + t * 72 + 8 * cs) = pk8(ad0, ad1);
        }
        if (unit + (int)gridDim.x < 8192) r1_issue(raw, P, BND, unit + gridDim.x, t, cs);
        LDS_BARRIER();
        {
            const int tt = w & 3;
            bf16x8 ft[2], fa[2];
#pragma unroll
            for (int kk = 0; kk < 2; ++kk) { ft[kk] = ldfrag(TW, 16 * tt + l15, 32 * kk + 8 * g); fa[kk] = ldfrag(ADI, 16 * tt + l15, 32 * kk + 8 * g); }
#pragma unroll
            for (int q = 0; q < 2; ++q) {
                const int ct = 2 * (w >> 2) + q;
                f32x4 aw = (f32x4){0.f, 0.f, 0.f, 0.f}, aa = aw;
#pragma unroll
                for (int kk = 0; kk < 2; ++kk) { aw = mfma16(ldfrag(WDL, 16 * ct + l15, 32 * kk + 8 * g), ft[kk], aw); aa = mfma16(ldfrag(WIL, 16 * ct + l15, 32 * kk + 8 * g), fa[kk], aa); }
                *(f32x4*)(DW + (16 * tt + l15) * 68 + 16 * ct + 4 * g) = aw;
                *(f32x4*)(DA + (16 * tt + l15) * 68 + 16 * ct + 4 * g) = aa;
            }
        }
        LDS_BARRIER();
        f32x4 lw[2], av[2], kk[2], k2[2], G[2];
        {
            const f32x4 cw0[2] = {*(const f32x4*)(CONST + 192 + 8 * cs), *(const f32x4*)(CONST + 196 + 8 * cs)};
            const f32x4 ca0[2] = {*(const f32x4*)(CONST + 256 + 8 * cs), *(const f32x4*)(CONST + 260 + 8 * cs)};
            const f32x4 ckk[2] = {*(const f32x4*)(CONST + 320 + 8 * cs), *(const f32x4*)(CONST + 324 + 8 * cs)};
            const f32x4 cka[2] = {*(const f32x4*)(CONST + 384 + 8 * cs), *(const f32x4*)(CONST + 388 + 8 * cs)};
            const f32x4 crk[2] = {*(const f32x4*)(CONST + 448 + 8 * cs), *(const f32x4*)(CONST + 452 + 8 * cs)};
            const f32x4 dwv[2] = {*(const f32x4*)(DW + t * 68 + 8 * cs), *(const f32x4*)(DW + t * 68 + 8 * cs + 4)};
            const f32x4 dav[2] = {*(const f32x4*)(DA + t * 68 + 8 * cs), *(const f32x4*)(DA + t * 68 + 8 * cs + 4)};
            const f32x4 kin[2] = {k0, k1}, rin[2] = {r0, r1};
            float n2 = 0.f, rk = 0.f;
#pragma unroll
            for (int hf = 0; hf < 2; ++hf)
#pragma unroll
                for (int j = 0; j < 4; ++j) {
                    const float z = -(cw0[hf][j] + dwv[hf][j]);
                    const float sp = fmaxf(z, 0.f) + flog(1.f + fexp(-fabsf(z)));
                    lw[hf][j] = -fexp(-sp - 0.5f);
                    av[hf][j] = fast_rcp(1.f + fexp(-(ca0[hf][j] + dav[hf][j])));
                    kk[hf][j] = kin[hf][j] * ckk[hf][j];
                    k2[hf][j] = kin[hf][j] * (1.f + (av[hf][j] - 1.f) * cka[hf][j]);
                    n2 += kk[hf][j] * kk[hf][j]; rk += rin[hf][j] * k2[hf][j] * crk[hf][j];
                }
            n2 += __shfl_xor(n2, 1); rk += __shfl_xor(rk, 1); n2 += __shfl_xor(n2, 2); rk += __shfl_xor(rk, 2); n2 += __shfl_xor(n2, 4); rk += __shfl_xor(rk, 4);
            const float inv = 1.0f / fmaxf(sqrtf(n2), 1e-12f);
            kk[0] *= inv; kk[1] *= inv;
            if (cs == 0) RK[(R0 + t) * 16 + h] = rk;
            G[0] = lw[0]; G[1] = lw[1];
#pragma unroll
            for (int d = 1; d < 8; d <<= 1)
#pragma unroll
                for (int hf = 0; hf < 2; ++hf)
#pragma unroll
                    for (int j = 0; j < 4; ++j) { const float y = __shfl_up(G[hf][j], 8 * d); if (tl >= d) G[hf][j] += y; }
            if (tl == 7) { *(f32x4*)(CS + w * 64 + 8 * cs) = G[0]; *(f32x4*)(CS + w * 64 + 8 * cs + 4) = G[1]; }
        }
        LDS_BARRIER();
        {
            f32x4 off[2] = {(f32x4){0.f, 0.f, 0.f, 0.f}, (f32x4){0.f, 0.f, 0.f, 0.f}}, gc[2] = {off[0], off[0]};
#pragma unroll
            for (int q = 0; q < 8; ++q) {
                const f32x4 c0 = *(const f32x4*)(CS + q * 64 + 8 * cs), c1 = *(const f32x4*)(CS + q * 64 + 8 * cs + 4);
                const float mk = (q < w) ? 1.f : 0.f;
                gc[0] += c0; gc[1] += c1; off[0] += c0 * mk; off[1] += c1 * mk;
            }
            f32x4 al[2], bh[2], kh[2], rb[2];
            const f32x4 rin[2] = {r0, r1};
#pragma unroll
            for (int hf = 0; hf < 2; ++hf)
#pragma unroll
                for (int j = 0; j < 4; ++j) {
                    const float Gi = G[hf][j] + off[hf][j];
                    const float eG = fexp(Gi), eGm = fexp(Gi - lw[hf][j]), enG = fast_rcp(eG);
                    const float be = kk[hf][j] * av[hf][j];
                    al[hf][j] = -kk[hf][j] * eGm; bh[hf][j] = be * enG; kh[hf][j] = k2[hf][j] * enG; rb[hf][j] = rin[hf][j] * eG;
                }
            const int o = t * 72 + 8 * cs;
            *(u32x4*)(ALB + o) = pk8(al[0], al[1]); *(u32x4*)(BH + o) = pk8(bh[0], bh[1]); *(u32x4*)(KH + o) = pk8(kh[0], kh[1]); *(u32x4*)(RB + o) = pk8(rb[0], rb[1]);
            const u32x4 vpk = pk8(v0, v1);
            *(u32x4*)(VI + o) = vpk;
            *(u32x4*)(Ybuf + (R0 + t) * DM + h * 64 + 8 * cs) = vpk;
            if (w == 0 && tl == 0) { f32x4 e0, e1;
#pragma unroll
                for (int j = 0; j < 4; ++j) { e0[j] = fexp(gc[0][j]); e1[j] = fexp(gc[1][j]); }
                *(f32x4*)(GCs + 8 * cs) = e0; *(f32x4*)(GCs + 8 * cs + 4) = e1; }
        }
        LDS_BARRIER();
        {
            int ntile = 1, tta = 0, sta = 0, ttb = 0, stb = 0;
            if (w == 0) { tta = 0; sta = 0; } else if (w == 2) { tta = 1; sta = 1; } else if (w == 5) { tta = 2; sta = 2; } else if (w == 7) { tta = 3; sta = 3; }
            else if (w == 1) { ntile = 2; tta = 1; sta = 0; ttb = 2; stb = 0; } else if (w == 3) { ntile = 2; tta = 2; sta = 1; ttb = 3; stb = 0; }
            else if (w == 4) { tta = 3; sta = 1; } else { tta = 3; sta = 2; }
            for (int it = 0; it < ntile; ++it) {
                const int tt = it ? ttb : tta, st = it ? stb : sta;
                f32x4 cab = (f32x4){0.f, 0.f, 0.f, 0.f}, cak = cab, crb = cab, crk = cab, nab = cab;
#pragma unroll
                for (int kq = 0; kq < 2; ++kq) {
                    const bf16x8 fb = ldfrag(BH, 16 * st + l15, 32 * kq + 8 * g), fk = ldfrag(KH, 16 * st + l15, 32 * kq + 8 * g);
                    const bf16x8 fa = ldfrag(ALB, 16 * tt + l15, 32 * kq + 8 * g), fr = ldfrag(RB, 16 * tt + l15, 32 * kq + 8 * g);
                    cab = mfma16(fb, fa, cab); cak = mfma16(fk, fa, cak); crb = mfma16(fb, fr, crb); crk = mfma16(fk, fr, crk);
                    if (tt == st) nab = mfma16(fa, fb, nab);
                }
                if (tt == st) {
#pragma unroll
                    for (int r = 0; r < 4; ++r) {
                        const int s = 4 * g + r, tq = l15;
                        if (s >= tq) { cab[r] = 0.f; cak[r] = 0.f; }
                        if (s > tq) { crb[r] = 0.f; crk[r] = 0.f; }
                        if (l15 >= 4 * g + r) nab[r] = 0.f;
                    }
                }
                const int o = (16 * tt + l15) * 72 + 16 * st + 4 * g;
                *(u32x2*)(AAB + o) = pk4(cab); *(u32x2*)(AAK + o) = pk4(cak); *(u32x2*)(ARB + o) = pk4(crb); *(u32x2*)(ARK + o) = pk4(crk);
                if (tt == st) {
                    const f32x4 z = (f32x4){0.f, 0.f, 0.f, 0.f};
                    const f32x4 Q1 = cab, N1 = nab;
                    const f32x4 Q2 = mm16(N1, Q1, z), N2 = mm16(Q1, N1, z);
                    f32x4 Pm = Q1;
#pragma unroll
                    for (int r = 0; r < 4; ++r) if (4 * g + r == l15) Pm[r] += 1.f;
                    Pm = mm16(N2, Pm, Pm);
                    const f32x4 Q4 = mm16(N2, Q2, z), N4 = mm16(Q2, N2, z);
                    Pm = mm16(N4, Pm, Pm);
                    const f32x4 N8 = mm16(Q4, N4, z);
                    Pm = mm16(N8, Pm, Pm);
                    TDF[tt * 64 + lane] = pk4(Pm);
                }
            }
            if (w == 4 || w == 6) {
                const int tt = (w == 4) ? 0 : 2, st = tt + 1;
                const int o = (16 * tt + l15) * 72 + 16 * st + 4 * g;
                const u32x2 zz = (u32x2){0u, 0u};
                *(u32x2*)(AAK + o) = zz; *(u32x2*)(ARB + o) = zz; *(u32x2*)(ARK + o) = zz;
            }
        }
        LDS_BARRIER();
        {
            u32x2 xb[4];
            const int col = 16 * w + l15;
            bf16x8 vfr[2];
            if (w >= 4) { vfr[0] = trfrag(VI, 0, 16 * (w - 4), g, q4, p4); vfr[1] = trfrag(VI, 32, 16 * (w - 4), g, q4, p4); }
#pragma unroll
            for (int i = 0; i < 4; ++i) {
                f32x4 z;
                if (w < 4) z = unpk4(trread(ALB + (16 * i + 4 * g + q4) * 72 + 16 * w + 4 * p4));
                else {
                    z = mfma16(ldfrag(AAK, 16 * i + l15, 8 * g), vfr[0], (f32x4){0.f, 0.f, 0.f, 0.f});
                    if (i >= 2) z = mfma16(ldfrag(AAK, 16 * i + l15, 32 + 8 * g), vfr[1], z);
                }
                if (i >= 1) {
                    const bf16_t* ar = AAB + (16 * i + l15) * 72 + 4 * g;
                    const u32x2 a0 = *(const u32x2*)ar;
                    u32x2 a1 = (u32x2){0u, 0u}, b1 = (u32x2){0u, 0u};
                    if (i >= 2) { a1 = *(const u32x2*)(ar + 16); b1 = xb[1]; }
                    z = mfma16(as_bf16x8((u32x4){a0.x, a0.y, a1.x, a1.y}), as_bf16x8((u32x4){xb[0].x, xb[0].y, b1.x, b1.y}), z);
                    if (i == 3) {
                        const u32x2 a2 = *(const u32x2*)(ar + 32);
                        z = mfma16(as_bf16x8((u32x4){a2.x, a2.y, 0u, 0u}), as_bf16x8((u32x4){xb[2].x, xb[2].y, 0u, 0u}), z);
                    }
                }
                const u32x2 tq = TDF[i * 64 + lane];
                const u32x2 zq = pk4(z);
                const f32x4 x = mfma16(as_bf16x8((u32x4){tq.x, tq.y, 0u, 0u}), as_bf16x8((u32x4){zq.x, zq.y, 0u, 0u}), (f32x4){0.f, 0.f, 0.f, 0.f});
                xb[i] = pk4(x);
                *(u32x2*)(XT + col * 72 + 16 * i + 4 * g) = xb[i];
            }
        }
        LDS_BARRIER();
        {
            const int rt_ = w & 3, c0 = 2 * (w >> 2);
            bf16x8 xw[2], xu[2], fbt[2], fkt[2], fvr[2];
#pragma unroll
            for (int kq = 0; kq < 2; ++kq) {
                xw[kq] = ldfrag(XT, 16 * rt_ + l15, 32 * kq + 8 * g);
                xu[kq] = ldfrag(XT, 64 + 16 * rt_ + l15, 32 * kq + 8 * g);
                fbt[kq] = trfrag(BH, 32 * kq, 16 * rt_, g, q4, p4);
                fkt[kq] = trfrag(KH, 32 * kq, 16 * rt_, g, q4, p4);
                fvr[kq] = trfrag(VI, 32 * kq, 16 * rt_, g, q4, p4);
            }
            const float gcd0 = GCs[16 * c0 + l15], gcd1 = GCs[16 * c0 + 16 + l15];
            const f32x4 gcr = *(const f32x4*)(GCs + 16 * rt_ + 4 * g);
#pragma unroll
            for (int q = 0; q < 2; ++q) {
                bf16x8 gbt[2], garb[2], gxu[2], gvi[2], gark[2];
#pragma unroll
                for (int kq = 0; kq < 2; ++kq) {
                    gbt[kq] = trfrag(BH, 32 * kq, 16 * (c0 + q), g, q4, p4);
                    garb[kq] = ldfrag(ARB, 16 * (c0 + q) + l15, 32 * kq + 8 * g);
                    gxu[kq] = ldfrag(XT, 64 + 16 * (c0 + q) + l15, 32 * kq + 8 * g);
                    gvi[kq] = trfrag(VI, 32 * kq, 16 * (c0 + q), g, q4, p4);
                    gark[kq] = ldfrag(ARK, 16 * (c0 + q) + l15, 32 * kq + 8 * g);
                }
                const u32x2 rbi = *(const u32x2*)(RB + (16 * (c0 + q) + l15) * 72 + 16 * rt_ + 4 * g);
                __builtin_amdgcn_sched_barrier(0);
                const int ctile = c0 + q;
                {
                    f32x4 acc = (f32x4){0.f, 0.f, 0.f, 0.f};
#pragma unroll
                    for (int kq = 0; kq < 2; ++kq) acc = mfma16(xw[kq], gbt[kq], acc);
                    const int dcol = 16 * ctile + l15;
                    if (rt_ == ctile) {
#pragma unroll
                        for (int r = 0; r < 4; ++r) if (4 * g + r == l15) acc[r] += 1.f;
                    }
                    acc *= (q ? gcd1 : gcd0);
                    *(u32x2*)(ALB + dcol * 72 + 32 * (rt_ >> 1) + 8 * g + 4 * (rt_ & 1)) = pk4(acc);
                }
                {
                    f32x4 acc = unpk4(rbi);
#pragma unroll
                    for (int kq = 0; kq < 2; ++kq) {
                        if (32 * kq <= 16 * ctile + 15) acc = mfma16(xw[kq], garb[kq], acc);
                    }
                    *(u32x2*)(BTL + (16 * ctile + l15) * 72 + 16 * rt_ + 4 * g) = pk4(acc);
                }
                {
                    f32x4 acc = (f32x4){0.f, 0.f, 0.f, 0.f};
#pragma unroll
                    for (int kq = 0; kq < 2; ++kq) { acc = mfma16(fbt[kq], gxu[kq], acc); acc = mfma16(fkt[kq], gvi[kq], acc); }
                    *(u32x2*)(KTL + (16 * ctile + l15) * 72 + 16 * rt_ + 4 * g) = pk4(acc * gcr);
                }
                {
                    f32x4 acc = (f32x4){0.f, 0.f, 0.f, 0.f};
#pragma unroll
                    for (int kq = 0; kq < 2; ++kq) {
                        if (32 * kq <= 16 * ctile + 15) { acc = mfma16(xu[kq], garb[kq], acc); acc = mfma16(fvr[kq], gark[kq], acc); }
                    }
                    *(u32x2*)(AAB + (16 * ctile + l15) * 72 + 16 * rt_ + 4 * g) = pk4(acc);
                }
            }
        }
        LDS_BARRIER();
        {
            const int o = t * 72 + 8 * cs;
            *(u32x4*)(P + (R0 + t) * PP + h * 64 + 8 * cs) = *(const u32x4*)(ALB + o);
            *(u32x4*)(P + (R0 + t) * PP + 1024 + h * 64 + 8 * cs) = *(const u32x4*)(BTL + o);
            *(u32x4*)(P + (R0 + t) * PP + 2048 + h * 64 + 8 * cs) = *(const u32x4*)(KTL + o);
            *(u32x4*)(Abuf + (R0 + t) * DM + h * 64 + 8 * cs) = *(const u32x4*)(AAB + o);
        }
    }
}

constexpr int SC_SLOT = 2 * IMG;
constexpr size_t WS_MG = (WS_BND + (size_t)513 * PP * 2 + 255) & ~(size_t)255;
constexpr size_t WS_NG = WS_MG + (size_t)1024 * 4096 * 2;
static_assert(WS_NG + (size_t)1024 * 4096 * 2 <= WS_GD, "scan buffers must fit the GLA state region");

template <int MODE>
__device__ void rwkv_scan2(const Params& p, unsigned char* lds) {
    constexpr int GSZ = 32, NGRP = 256 / GSZ, LG = 3;
    constexpr int SPU = (MODE == 2) ? NGRP : GSZ;
    constexpr int NU = (MODE == 2) ? 32 : 32 * NGRP;
    const int tid = threadIdx.x, lane = tid & 63, w = __builtin_amdgcn_readfirstlane(tid >> 6), l15 = lane & 15, g = lane >> 4;
    bf16_t* P = (bf16_t*)(p.ws + WS_P);
    bf16_t* MG = (bf16_t*)(p.ws + WS_MG); bf16_t* NG = (bf16_t*)(p.ws + WS_NG); bf16_t* HG = NG;
    const int G = gridDim.x;
    const int nun = ((int)blockIdx.x < NU) ? (NU - 1 - (int)blockIdx.x) / G + 1 : 0;
    const int T = nun * SPU;
    if (T == 0) return;
#define SC_SRC(s, p0, p1, pitchb) \
    const int u_ = (int)blockIdx.x + G * ((s) / SPU), j_ = (s) % SPU; \
    const char* p0; const char* p1; unsigned pitchb; \
    if (MODE == 2) { p0 = (const char*)(MG + (size_t)(u_ * NGRP + j_) * 4096); p1 = (const char*)(NG + (size_t)(u_ * NGRP + j_) * 4096); pitchb = 128u; } \
    else { const int bh_ = u_ >> LG, n_ = GSZ * (u_ & (NGRP - 1)) + j_; p0 = (const char*)(P + ((size_t)(bh_ >> 4) * SEQ + (size_t)n_ * 64) * PP + (bh_ & 15) * 64); p1 = p0 + 4096; pitchb = (unsigned)(PP * 2); }
    if (w >= 4) {
        const int lj = w - 4;
        const unsigned loff = (unsigned)((lane >> 3) * 144 + (lane & 7) * 16);
        u32x4 ld0[16], ld1[16];
#define SC_ISSUE(dst, s) do { const int sc_ = ((s) < T) ? (s) : T - 1; SC_SRC(sc_, q0_, q1_, pb_) const unsigned go_ = (unsigned)(lane >> 3) * pb_ + (unsigned)(lane & 7) * 16u; \
        _Pragma("unroll") for (int q = 0; q < 16; ++q) dst[q] = *(const u32x4*)(((q >> 3) ? q1_ : q0_) + (size_t)((q & 7) * 8) * pb_ + go_); } while (0)
#define SC_RETIRE(src, s) do { unsigned char* sb = lds + ((s) & 1) * SC_SLOT + loff; _Pragma("unroll") for (int q = 0; q < 16; ++q) \
        *(u32x4*)(sb + (q >> 3) * IMG + (q & 7) * 8 * 144) = src[q]; } while (0)
        SC_ISSUE(ld0, lj); SC_ISSUE(ld1, lj + 4);
        for (int it = 0; it < T / 8; ++it) {
            const int c0 = lj + 8 * it;
            for (int k = 0; k < lj; ++k) LDS_BARRIER();
            SC_RETIRE(ld0, c0); SC_ISSUE(ld0, c0 + 8);
            for (int k = 0; k < 4; ++k) LDS_BARRIER();
            SC_RETIRE(ld1, c0 + 4); SC_ISSUE(ld1, c0 + 12);
            for (int k = 0; k < 4 - lj; ++k) LDS_BARRIER();
        }
        LDS_BARRIER();
#undef SC_ISSUE
#undef SC_RETIRE
    } else {
        f32x4 H[4], Mg[4];
        for (int i = 0; i <= T; ++i) {
            if (i >= 1) {
                const int s = i - 1, u = (int)blockIdx.x + G * (s / SPU), j = s % SPU;
                const unsigned char* sb = lds + (s & 1) * SC_SLOT;
                const bf16_t* MT = (const bf16_t*)sb; const bf16_t* NT = (const bf16_t*)(sb + IMG);
                if (j == 0) {
                    if (MODE == 3) {
#pragma unroll
                        for (int mt = 0; mt < 4; ++mt) H[mt] = unpk4(*(const u32x2*)(HG + (size_t)u * 4096 + (16 * w + l15) * 64 + 16 * mt + 4 * g));
                    } else {
#pragma unroll
                        for (int mt = 0; mt < 4; ++mt) H[mt] = (f32x4){0.f, 0.f, 0.f, 0.f};
                    }
                    if (MODE == 1) {
#pragma unroll
                        for (int mt = 0; mt < 4; ++mt)
#pragma unroll
                            for (int r = 0; r < 4; ++r) Mg[mt][r] = (16 * mt + 4 * g + r == 16 * w + l15) ? 1.f : 0.f;
                    }
                }
                u32x2 hp[4];
#pragma unroll
                for (int mt = 0; mt < 4; ++mt) hp[mt] = pk4(H[mt]);
                if (MODE == 2) {
#pragma unroll
                    for (int mt = 0; mt < 4; ++mt) *(u32x2*)(HG + (size_t)(u * NGRP + j) * 4096 + (16 * w + l15) * 64 + 16 * mt + 4 * g) = hp[mt];
                }
                if (MODE == 3) {
                    const int bh = u >> LG, n = GSZ * (u & (NGRP - 1)) + j;
#pragma unroll
                    for (int mt = 0; mt < 4; ++mt) *(u32x2*)(P + ((size_t)(bh >> 4) * SEQ + (size_t)n * 64 + 16 * w + l15) * PP + 2048 + (bh & 15) * 64 + 16 * mt + 4 * g) = hp[mt];
                }
                bf16x8 hb[2], mb[2];
                hb[0] = as_bf16x8((u32x4){hp[0].x, hp[0].y, hp[1].x, hp[1].y});
                hb[1] = as_bf16x8((u32x4){hp[2].x, hp[2].y, hp[3].x, hp[3].y});
                if (MODE == 1) {
                    const u32x2 m0 = pk4(Mg[0]), m1 = pk4(Mg[1]), m2 = pk4(Mg[2]), m3 = pk4(Mg[3]);
                    mb[0] = as_bf16x8((u32x4){m0.x, m0.y, m1.x, m1.y}); mb[1] = as_bf16x8((u32x4){m2.x, m2.y, m3.x, m3.y});
                }
#pragma unroll
                for (int mt = 0; mt < 4; ++mt) {
                    const bf16x8 a0 = ldfrag(MT, 16 * mt + l15, 8 * g), a1 = ldfrag(MT, 16 * mt + l15, 32 + 8 * g);
                    f32x4 acc = unpk4(*(const u32x2*)(NT + (16 * w + l15) * 72 + 16 * mt + 4 * g));
                    acc = mfma16(a0, hb[0], acc); acc = mfma16(a1, hb[1], acc);
                    H[mt] = acc;
                    if (MODE == 1) { f32x4 am = mfma16(a0, mb[0], (f32x4){0.f, 0.f, 0.f, 0.f}); am = mfma16(a1, mb[1], am); Mg[mt] = am; }
                }
                if (MODE == 1 && j == SPU - 1) {
                    const int pc = 32 * (w >> 1) + 8 * (l15 >> 2) + 4 * (w & 1) + (l15 & 3);
#pragma unroll
                    for (int mt = 0; mt < 4; ++mt) {
                        *(u32x2*)(NG + (size_t)u * 4096 + (16 * w + l15) * 64 + 16 * mt + 4 * g) = pk4(H[mt]);
#pragma unroll
                        for (int r = 0; r < 4; ++r) MG[(size_t)u * 4096 + (16 * mt + 4 * g + r) * 64 + pc] = f2bf(Mg[mt][r]);
                    }
                }
            }
            LDS_BARRIER();
        }
    }
#undef SC_SRC
}

__device__ void rwkv_post(const Params& p, unsigned char* lds) {
    const int tid = threadIdx.x, lane = tid & 63, w = __builtin_amdgcn_readfirstlane(tid >> 6), l15 = lane & 15, g = lane >> 4;
    const bf16_t* P = (const bf16_t*)(p.ws + WS_P);
    bf16_t* Abuf = (bf16_t*)(p.ws + WS_A);
    const bf16_t* Ybuf = (const bf16_t*)(p.ws + WS_Y);
    const float* RK = (const float*)(p.ws + WS_RK);
    const bf16_t* BND = (const bf16_t*)(p.ws + WS_BND);
    float* L = (float*)(lds + w * 8704);
    const int tr = lane >> 3, seg = lane & 7;
    for (int hu = blockIdx.x * 8 + w; hu < 16384; hu += gridDim.x * 8) {
        const int unit = hu >> 1, t0 = (hu & 1) * 32;
        const int bn = unit >> 4, h = unit & 15, n = bn & 255;
        const size_t R0 = (size_t)bn * 64;
        bf16x8 fh[4][2], fr[2][2];
#pragma unroll
        for (int kk = 0; kk < 2; ++kk) {
#pragma unroll
            for (int q = 0; q < 4; ++q) fh[q][kk] = *(const bf16x8*)(P + (R0 + 16 * q + l15) * PP + 2048 + h * 64 + 32 * kk + 8 * g);
#pragma unroll
            for (int q = 0; q < 2; ++q) fr[q][kk] = *(const bf16x8*)(P + (R0 + t0 + 16 * q + l15) * PP + 1024 + h * 64 + 32 * kk + 8 * g);
        }
        u32x4 y0r[4], g1r[4], g0r[4], vpr[4];
        float rkv[4];
#pragma unroll
        for (int i = 0; i < 4; ++i) {
            const int t = t0 + tr + 8 * i;
            y0r[i] = *(const u32x4*)(Abuf + (R0 + t) * DM + h * 64 + 8 * seg);
            const bf16_t* grow = P + (R0 + t) * PP + 3072 + h * 64 + 8 * seg;
            g1r[i] = *(const u32x4*)grow;
            g0r[i] = *(const u32x4*)((t > 0) ? (grow - PP) : (BND + (size_t)(n == 0 ? 0 : bn) * PP + 3072 + h * 64 + 8 * seg));
            vpr[i] = *(const u32x4*)(Ybuf + (R0 + t) * DM + h * 64 + 8 * seg);
            rkv[i] = RK[(R0 + t) * 16 + h];
        }
#pragma unroll
        for (int i = 0; i < 4; ++i) { *(f32x4*)(L + (tr + 8 * i) * 68 + 8 * seg) = lo4(y0r[i]); *(f32x4*)(L + (tr + 8 * i) * 68 + 8 * seg + 4) = hi4(y0r[i]); }
        f32x4 y[4][2];
#pragma unroll
        for (int vt = 0; vt < 4; ++vt)
#pragma unroll
            for (int tt = 0; tt < 2; ++tt) y[vt][tt] = *(const f32x4*)(L + (16 * tt + l15) * 68 + 16 * vt + 4 * g);
#pragma unroll
        for (int vt = 0; vt < 4; ++vt)
#pragma unroll
            for (int tt = 0; tt < 2; ++tt)
#pragma unroll
                for (int kk = 0; kk < 2; ++kk) y[vt][tt] = mfma16(fh[vt][kk], fr[tt][kk], y[vt][tt]);
#pragma unroll
        for (int tt = 0; tt < 2; ++tt) {
            float s1 = 0.f, s2 = 0.f;
#pragma unroll
            for (int vt = 0; vt < 4; ++vt)
#pragma unroll
                for (int r = 0; r < 4; ++r) { s1 += y[vt][tt][r]; s2 += y[vt][tt][r] * y[vt][tt][r]; }
            s1 += __shfl_xor(s1, 16); s2 += __shfl_xor(s2, 16); s1 += __shfl_xor(s1, 32); s2 += __shfl_xor(s2, 32);
            const float mean = s1 * (1.0f / 64.0f);
            const float rstd = rsqrtf(fmaxf(s2 * (1.0f / 64.0f) - mean * mean, 0.f) + 64e-5f);
#pragma unroll
            for (int vt = 0; vt < 4; ++vt) *(f32x4*)(L + (16 * tt + l15) * 68 + 16 * vt + 4 * g) = (y[vt][tt] - mean) * rstd;
        }
        const int ch = h * 64 + 8 * seg;
        const f32x4 lw0 = *(const f32x4*)(p.in[18] + ch), lw1 = *(const f32x4*)(p.in[18] + ch + 4), lb0 = *(const f32x4*)(p.in[19] + ch), lb1 = *(const f32x4*)(p.in[19] + ch + 4);
        const f32x4 mg0 = *(const f32x4*)(p.in[10] + 3072 + ch), mg1 = *(const f32x4*)(p.in[10] + 3072 + ch + 4);
#pragma unroll
        for (int i = 0; i < 4; ++i) {
            const int t = t0 + tr + 8 * i;
            const f32x4 n0 = *(const f32x4*)(L + (tr + 8 * i) * 68 + 8 * seg), n1 = *(const f32x4*)(L + (tr + 8 * i) * 68 + 8 * seg + 4);
            const f32x4 ga0 = lo4(g1r[i]), ga1 = hi4(g1r[i]);
            const f32x4 gb0 = lo4(g0r[i]), gb1 = hi4(g0r[i]);
            const f32x4 gt0 = ga0 + mg0 * (gb0 - ga0), gt1 = ga1 + mg1 * (gb1 - ga1);
            const f32x4 v0 = lo4(vpr[i]), v1 = hi4(vpr[i]);
            f32x4 o0 = n0 * lw0 + lb0 + rkv[i] * v0, o1 = n1 * lw1 + lb1 + rkv[i] * v1;
#pragma unroll
            for (int j = 0; j < 4; ++j) { o0[j] *= gt0[j] * __builtin_amdgcn_rcpf(1.0f + fexp(-gt0[j])); o1[j] *= gt1[j] * __builtin_amdgcn_rcpf(1.0f + fexp(-gt1[j])); }
            *(u32x4*)(Abuf + (R0 + t) * DM + h * 64 + 8 * seg) = pk8(o0, o1);
        }
    }
}
#define XB_TMO      128
#define XB_XCNT(j)  (256  + 64 * (j))
#define XB_XSUB(j)  (1280 + 64 * (j))
#define XB_XGEN(j)  (2304 + 64 * (j))
#define XB_TOP      3328
#define XB_TOPGEN   3392
#define XCD_BAR_WORDS 3456
#define XB_SPIN_CAP (1u << 18)
#define LAS __attribute__((address_space(3)))

__device__ __forceinline__ unsigned xb_ld(unsigned* p)              { return __hip_atomic_load(p, __ATOMIC_RELAXED, __HIP_MEMORY_SCOPE_AGENT); }
__device__ __forceinline__ unsigned xb_add(unsigned* p, unsigned v) { return __hip_atomic_fetch_add(p, v, __ATOMIC_RELAXED, __HIP_MEMORY_SCOPE_AGENT); }
__device__ __forceinline__ unsigned xb_xcc_id() { return (unsigned)__builtin_amdgcn_s_getreg((3 << 11) | 20) & 0xFu; }
#define XB_SPIN(cond, bar) do { unsigned _sp = 0; while (cond) { __builtin_amdgcn_s_sleep(1); \
    if ((++_sp & 255u) == 0u) { if (xb_ld(&(bar)[XB_TMO])) break; if (_sp > XB_SPIN_CAP) { atomicAdd(&(bar)[XB_TMO], 1u); break; } } } } while (0)

struct XcdBarrier {
    unsigned* bar; unsigned x;
    volatile LAS unsigned* st;
};

__device__ __forceinline__ XcdBarrier xcd_barrier_post(unsigned* bar, volatile LAS unsigned* st) {
    XcdBarrier b; b.bar = bar; b.x = xb_xcc_id(); b.st = st;
    if (threadIdx.x == 0) (void)xb_add(&bar[XB_XCNT(b.x)], 1u);
    return b;
}
__device__ __forceinline__ void xcd_barrier_complete(unsigned* bar, unsigned x, unsigned& nloc, unsigned& nx) {
    const unsigned G = gridDim.x * gridDim.y * gridDim.z;
    unsigned sum, cnt, mine, sp = 0u;
    for (;;) {
        sum = 0u; cnt = 0u; mine = 0u;
#pragma unroll
        for (unsigned j = 0; j < 16; ++j) { const unsigned c = xb_ld(&bar[XB_XCNT(j)]); sum += c; cnt += (c > 0u) ? 1u : 0u; mine = (j == x) ? c : mine; }
        if (sum == G) break;
        __builtin_amdgcn_s_sleep(1);
        if ((++sp & 255u) == 0u) { if (xb_ld(&bar[XB_TMO])) break; if (sp > XB_SPIN_CAP) { atomicAdd(&bar[XB_TMO], 1u); break; } }
    }
    nloc = mine > 0u ? mine : 1u; nx = cnt > 0u ? cnt : 1u;
}

__device__ __forceinline__ void xcd_barrier(const XcdBarrier& b) {
    asm volatile("s_waitcnt vmcnt(0)" ::: "memory");
    __syncthreads();
    if (threadIdx.x == 0) {
        unsigned* bar = b.bar;
        __builtin_amdgcn_s_waitcnt(0);
        unsigned nloc = b.st[0], nx = b.st[1];
        if (nloc == 0u) { xcd_barrier_complete(bar, b.x, nloc, nx); b.st[0] = nloc; b.st[1] = nx; }
        const unsigned old = xb_add(&bar[XB_XSUB(b.x)], 1u);
        const unsigned gen = old / nloc;
        if (old + 1u == (gen + 1u) * nloc) {
            __builtin_amdgcn_fence(__ATOMIC_RELEASE, "agent");
            asm volatile("s_waitcnt vmcnt(0)" ::: "memory");
            const unsigned og = xb_add(&bar[XB_TOP], 1u);
            const unsigned tg = og / nx;
            if (og + 1u == (tg + 1u) * nx) xb_add(&bar[XB_TOPGEN], 1u);
            else XB_SPIN(xb_ld(&bar[XB_TOPGEN]) == tg, bar);
            __builtin_amdgcn_fence(__ATOMIC_ACQUIRE, "agent");
            xb_add(&bar[XB_XGEN(b.x)], 1u);
            asm volatile("s_waitcnt vmcnt(0)" ::: "memory");
        } else {
            XB_SPIN(xb_ld(&bar[XB_XGEN(b.x)]) == gen, bar);
            __builtin_amdgcn_fence(__ATOMIC_ACQUIRE, "agent");
            asm volatile("s_waitcnt vmcnt(0)" ::: "memory");
        }
    }
    __syncthreads();
}


#ifndef PROBE_ID
#define PROBE_ID 0
#endif
#ifndef N_LAUNCH_MODE
#define N_LAUNCH_MODE 1
#endif
constexpr int N_PHASES = 15;

__global__ void __launch_bounds__(NTH, 2) fwd_kernel(Params p) {
    extern __shared__ __attribute__((aligned(16))) unsigned char lds[];
    const int lo = p.ph_lo, hi = p.ph_hi;
    volatile LAS unsigned* xst = (volatile LAS unsigned*)(lds + LDS_BYTES);
    if (threadIdx.x < 4) xst[threadIdx.x] = 0u;
    __syncthreads();
    const XcdBarrier xbar = xcd_barrier_post((unsigned*)(p.ws + WS_BAR), xst);
    unsigned char* ws = p.ws;
#define IN(k) (lo <= (k) && (k) < hi)
#define SEAM(k) do { if ((k) + 1 < hi) xcd_barrier(xbar); } while (0)
    if (IN(0)) {
        prep_weight(p.in[2], GIN, p.in[1], (bf16_t*)(ws + WS_WGIN), GIN_P, (float*)lds);
        prep_weight(p.in[6], DM, nullptr, (bf16_t*)(ws + WS_WGOUT), DM, (float*)lds);
        prep_wup(p.in[3], (bf16_t*)(ws + WS_WUPT));
        __syncthreads();
        phase_norm0(p, lds);
        SEAM(0);
    }
    if (IN(1)) {
        pg8::Gemm g{(const bf16_t*)(ws + WS_A), (const bf16_t*)(ws + WS_WGIN), MTOK, GIN_P, DM}; pg8::StaticOrder S; S.init(MTOK, GIN_P, gridDim.x, blockIdx.x);
        pg8::EpiBf16<0> E{(bf16_t*)(ws + WS_P), GIN_P, nullptr, 0, 0};
        pg8::gemm_phase<pg8::EpiBf16<0>, pg8::StaticOrder>((PG8_LAS unsigned char*)lds, g, S, E);
        SEAM(1);
    }
    if (IN(2)) { gla_pass<false>(p, lds); SEAM(2); }
    if (IN(3)) {
        gla_scan(p);
        prep_weight(p.in[9], RIN, p.in[8], (bf16_t*)(ws + WS_WRIN), RIN_P, (float*)lds);
        prep_weight(p.in[20], DM, nullptr, (bf16_t*)(ws + WS_WROUT), DM, (float*)lds);
        prep_lowrank(p.in[12], (bf16_t*)(ws + WS_WDUT));
        prep_lowrank(p.in[14], (bf16_t*)(ws + WS_WIUT));
        SEAM(3);
    }
    if (IN(4)) { gla_pass<true>(p, lds); SEAM(4); }
    if (IN(5)) {
        pg8::Gemm g{(const bf16_t*)(ws + WS_A), (const bf16_t*)(ws + WS_WGOUT), MTOK, DM, DM}; pg8::StaticOrder S; S.init(MTOK, DM, gridDim.x, blockIdx.x);
        pg8::EpiBf16<0> E{(bf16_t*)(ws + WS_Y), DM, nullptr, 0, 0};
        pg8::gemm_phase<pg8::EpiBf16<0>, pg8::StaticOrder>((PG8_LAS unsigned char*)lds, g, S, E);
        SEAM(5);
    }
    if (IN(6)) { phase_norm1(p); zero_bnd_row((bf16_t*)(ws + WS_BND)); SEAM(6); }
    if (IN(7)) {
        pg8::Gemm g{(const bf16_t*)(ws + WS_A), (const bf16_t*)(ws + WS_WRIN), MTOK, RIN_P, DM}; pg8::StaticOrder S; S.init(MTOK, RIN_P, gridDim.x, blockIdx.x);
        EpiBf16Bnd E{(bf16_t*)(ws + WS_P), RIN_P, (bf16_t*)(ws + WS_BND)};
        pg8::gemm_phase<EpiBf16Bnd, pg8::StaticOrder>((PG8_LAS unsigned char*)lds, g, S, E);
        SEAM(7);
    }
    if (IN(8)) { rwkv_r1(p, lds); SEAM(8); }
    if (IN(9)) { rwkv_scan2<1>(p, lds); SEAM(9); }
    if (IN(10)) { rwkv_scan2<2>(p, lds); SEAM(10); }
    if (IN(11)) { rwkv_scan2<3>(p, lds); SEAM(11); }
    if (IN(12)) { rwkv_post(p, lds); SEAM(12); }
    if (IN(13)) {
        pg8::Gemm g{(const bf16_t*)(ws + WS_A), (const bf16_t*)(ws + WS_WROUT), MTOK, DM, DM}; pg8::StaticOrder S; S.init(MTOK, DM, gridDim.x, blockIdx.x);
        pg8::EpiBf16<0> E{(bf16_t*)(ws + WS_Y), DM, nullptr, 0, 0};
        pg8::gemm_phase<pg8::EpiBf16<0>, pg8::StaticOrder>((PG8_LAS unsigned char*)lds, g, S, E);
        SEAM(13);
    }
    if (IN(14)) { phase_final(p); }
#undef IN
#undef SEAM
}

extern "C" void kernel_launch(void* const* d_in, const int* in_sizes, int n_in, void* d_out, int out_size, void* d_ws, size_t ws_size, hipStream_t stream) {
    static int grid = 0;
    if (grid == 0) {
        int dev = 0, cus = 0, per_cu = 0;
        hipGetDevice(&dev);
        hipDeviceGetAttribute(&cus, hipDeviceAttributeMultiprocessorCount, dev);
        hipFuncSetAttribute((const void*)fwd_kernel, hipFuncAttributeMaxDynamicSharedMemorySize, LDS_BYTES + 16);
        hipOccupancyMaxActiveBlocksPerMultiprocessor(&per_cu, (const void*)fwd_kernel, NTH, LDS_BYTES + 16);
        if (per_cu < 1) { fprintf(stderr, "kernel_launch: occupancy query says %d blocks per CU\n", per_cu); per_cu = 1; }
        grid = cus;
        if (n_in != 22 || ws_size < WS_END) fprintf(stderr, "kernel_launch: unexpected n_in %d or workspace %zu < %zu\n", n_in, ws_size, (size_t)WS_END);
        (void)hipGetLastError();
    }
    if (hipMemsetAsync((char*)d_ws + WS_BAR, 0, XCD_BAR_WORDS * 4, stream) != hipSuccess) fprintf(stderr, "kernel_launch: memset of the barrier words failed\n");
    Params p{};
    for (int i = 0; i < 22; ++i) p.in[i] = (const float*)d_in[i];
    p.out = (float*)d_out; p.ws = (unsigned char*)d_ws;
#if N_LAUNCH_MODE == 1
    void* args[] = {&p};
#if PROBE_ID > 0
    p.ph_lo = 0; p.ph_hi = PROBE_ID;
    (void)hipLaunchCooperativeKernel((const void*)fwd_kernel, dim3(grid), dim3(NTH), args, LDS_BYTES + 16, stream);
    (void)hipMemsetAsync((char*)d_ws + WS_BAR, 0, XCD_BAR_WORDS * 4, stream);
#endif
    p.ph_lo = 0; p.ph_hi = N_PHASES;
    hipError_t e = hipLaunchCooperativeKernel((const void*)fwd_kernel, dim3(grid), dim3(NTH), args, LDS_BYTES + 16, stream);
    if (e != hipSuccess) fprintf(stderr, "cooperative launch failed: %s (grid %d)\n", hipGetErrorString(e), grid);
#else
    for (int k = 0; k < N_PHASES; ++k) {
        p.ph_lo = k; p.ph_hi = k + 1;
        hipLaunchKernelGGL(fwd_kernel, dim3(grid), dim3(NTH), LDS_BYTES + 16, stream, p);
    }
#endif
}
```

```cpp
#include <hip/hip_runtime.h>
#include <hip/hip_cooperative_groups.h>
#include <cstdio>
namespace cg = cooperative_groups;
#define PROBE_ID 0
#define N_LAUNCH_MODE 1
namespace pg8 {
#define PG8_LAS __attribute__((address_space(3)))
typedef unsigned short bf16_t;
typedef short bf16x8 __attribute__((ext_vector_type(8)));
typedef float f32x4 __attribute__((ext_vector_type(4)));
typedef unsigned u32x4 __attribute__((ext_vector_type(4)));
constexpr int BM = 256, BK = 64, HALF = 128, HTB = HALF * BK * 2  , STAGE_BYTES = 8 * HTB, NXCD = 8, WGM = 8;

__host__ __device__ __forceinline__ int lds_byte(int r, int c) { const int st = (r >> 4) * 2 + (c >> 5), rr = r & 15, cc = c & 31, ob = rr * 64 + cc * 2; return st * 1024 + (ob ^ (((ob >> 9) & 1) << 5)); }
__host__ __device__ __forceinline__ void stage_rc(int b, int& R, int& C) { const int st = b / 1024, sb = b % 1024, swz = sb ^ (((sb >> 9) & 1) << 5); R = (st >> 1) * 16 + swz / 64; C = (st & 1) * 32 + (swz % 64) / 2; }
__host__ __device__ __forceinline__ int perm32(int rho) { const int n = rho >> 4, i = rho & 15; return 8 * (i >> 2) + 4 * n + (i & 3); }

struct Unit { int pm, pn; };
struct Gemm { const bf16_t* A; const bf16_t* Bt; int M, N, K; };

struct StaticOrder {
    int nM, nN, nwg, G, c;
    __host__ __device__ void init(int M, int N, int G_, int c_) { nM = M / BM; nN = N / BM; nwg = nM * nN; G = G_; c = c_; }
    __host__ __device__ bool next(int i, Unit& u) const {
        const long L = (long)i * G + c; if (L >= nwg) return false;
        int wgid = (int)L; { const int q = nwg / NXCD, r = nwg % NXCD, xcd = wgid % NXCD, off = wgid / NXCD; wgid = (xcd < r ? xcd * (q + 1) : r * (q + 1) + (xcd - r) * q) + off; }
        const int nig = WGM * nN, gid = wgid / nig, fm = gid * WGM, gsz = (nM - fm) < WGM ? (nM - fm) : WGM;
        u.pm = fm + ((wgid % nig) % gsz); u.pn = (wgid % nig) / gsz; return true;
    }
    __device__ __forceinline__ void a_ready(const Unit&) const {}
    __device__ __forceinline__ void done(const Unit&) const {}
};

typedef float cvt_f32x2 __attribute__((ext_vector_type(2)));
typedef __bf16 cvt_bf16x2 __attribute__((ext_vector_type(2)));
__device__ __forceinline__ unsigned cvt_pk_bf16(float lo, float hi) { const cvt_f32x2 v = {lo, hi}; union { cvt_bf16x2 b; unsigned u; } x; x.b = __builtin_convertvector(v, cvt_bf16x2); return x.u; }
typedef float f32x2 __attribute__((ext_vector_type(2)));
struct EpiF32 {
    static constexpr bool PERM = false, AFTER_DRAIN = false;
    float* C; int ldc; const float* bias;
    __device__ __forceinline__ void operator()(const f32x4 (&acc)[2][2][4][2], const Unit& u, int wr, int wc, int fr, int fq) const {
        const int row0 = u.pm * BM + wr * 64 + fr, col0 = u.pn * BM + wc * 32 + 4 * fq;
        f32x4 bv[2][2];
#pragma unroll
        for (int bj = 0; bj < 2; ++bj)
#pragma unroll
            for (int n = 0; n < 2; ++n) bv[bj][n] = bias ? *(const f32x4*)(bias + col0 + bj * HALF + n * 16) : (f32x4){0.f, 0.f, 0.f, 0.f};
#pragma unroll
        for (int ai = 0; ai < 2; ++ai)
#pragma unroll
            for (int m = 0; m < 4; ++m) { float* rowp = C + (size_t)(row0 + ai * HALF + m * 16) * ldc + col0;
#pragma unroll
                for (int bj = 0; bj < 2; ++bj)
#pragma unroll
                    for (int n = 0; n < 2; ++n) *(f32x4*)(rowp + bj * HALF + n * 16) = acc[ai][bj][m][n] + bv[bj][n]; }
    }
};
template <int ACT  > struct EpiBf16 {
    static constexpr bool PERM = true, AFTER_DRAIN = false;
    bf16_t* O; int ldc; const float* bias; int split_cols; size_t split_stride;
    __device__ __forceinline__ void operator()(const f32x4 (&acc)[2][2][4][2], const Unit& u, int wr, int wc, int fr, int fq) const {
        const int row0 = u.pm * BM + wr * 64 + fr; int colt = u.pn * BM; bf16_t* base = O;
        if (split_cols) { const int t = colt / split_cols; base += (size_t)t * split_stride; colt -= t * split_cols; }
        const int col0 = colt + wc * 32 + 8 * fq, bcol0 = u.pn * BM + wc * 32 + 8 * fq;
        f32x4 bv[2][2];
#pragma unroll
        for (int bj = 0; bj < 2; ++bj)
#pragma unroll
            for (int n = 0; n < 2; ++n) bv[bj][n] = bias ? *(const f32x4*)(bias + bcol0 + bj * HALF + 4 * n) : (f32x4){0.f, 0.f, 0.f, 0.f};
#pragma unroll
        for (int ai = 0; ai < 2; ++ai)
#pragma unroll
            for (int m = 0; m < 4; ++m) { bf16_t* rowp = base + (size_t)(row0 + ai * HALF + m * 16) * ldc + col0;
#pragma unroll
                for (int bj = 0; bj < 2; ++bj) { f32x4 v0 = acc[ai][bj][m][0] + bv[bj][0], v1 = acc[ai][bj][m][1] + bv[bj][1];
                    u32x4 w; w.x = cvt_pk_bf16(v0[0], v0[1]); w.y = cvt_pk_bf16(v0[2], v0[3]); w.z = cvt_pk_bf16(v1[0], v1[1]); w.w = cvt_pk_bf16(v1[2], v1[3]);
                    *(u32x4*)(rowp + bj * HALF) = w; } }
    }
};

template <class Epi, class Sched>
__device__ __forceinline__ void gemm_phase(PG8_LAS unsigned char* lds, const Gemm g, const Sched& S, const Epi& E) {
    const int tid = threadIdx.x, wid = __builtin_amdgcn_readfirstlane(tid >> 6), lane = tid & 63, wr = wid >> 2, wc = wid & 3, fr = lane & 15, fq = lane >> 4;
    const int K = g.K, nt = K / BK;
    unsigned voffA[2], voffB[2];
#pragma unroll
    for (int i = 0; i < 2; ++i) { int R, C; stage_rc(tid * 16 + i * 8192, R, C); const int Rb = Epi::PERM ? ((R & ~31) + perm32(R & 31)) : R;
        voffA[i] = (unsigned)(R * K + C) * 2u; voffB[i] = (unsigned)(Rb * K + C) * 2u; }
    const size_t kstep = (size_t)(BK * 2);
    const size_t hstep = (size_t)HALF * K * 2;
    const size_t tstep = 2 * hstep;
    const unsigned ldsw = (unsigned)wid * 1024u;
    const int aoff = lds_byte(wr * 64 + fr, fq * 8), boff = lds_byte(wc * 32 + fr, fq * 8);
#define PG8_SA(b, h) (((b) * 2 + (h)) * HTB)
#define PG8_SB(b, h) ((4 + (b) * 2 + (h)) * HTB)
#define PG8_STAGE(bufoff, gbase, voff) do { _Pragma("unroll") for (int _i = 0; _i < 2; ++_i) \
        __builtin_amdgcn_global_load_lds((const unsigned*)((const char*)(gbase) + (voff)[_i]), (PG8_LAS unsigned*)(lds + (bufoff) + ldsw + _i * 8192), 16, 0, 0); } while (0)
#define PG8_LDA(dst, b, h) do { _Pragma("unroll") for (int m = 0; m < 4; ++m) _Pragma("unroll") for (int k = 0; k < 2; ++k) dst[m][k] = *(const PG8_LAS bf16x8*)(lds + PG8_SA(b, h) + aoff + m * 2048 + k * 1024); } while (0)
#define PG8_LDB(dst, b, h) do { _Pragma("unroll") for (int n = 0; n < 2; ++n) _Pragma("unroll") for (int k = 0; k < 2; ++k) dst[n][k] = *(const PG8_LAS bf16x8*)(lds + PG8_SB(b, h) + boff + n * 2048 + k * 1024); } while (0)
#define PG8_MMA(ai, bj, At, Bt) do { __builtin_amdgcn_s_setprio(1); _Pragma("unroll") for (int m = 0; m < 4; ++m) _Pragma("unroll") for (int n = 0; n < 2; ++n) _Pragma("unroll") for (int k = 0; k < 2; ++k) \
        acc[ai][bj][m][n] = __builtin_amdgcn_mfma_f32_16x16x32_bf16(Bt[n][k], At[m][k], acc[ai][bj][m][n], 0, 0, 0); __builtin_amdgcn_s_setprio(0); } while (0)
#define PG8_WAIT_V(n) asm volatile("s_waitcnt vmcnt(" #n ")" ::: "memory")
#define PG8_WAIT_L(n) asm volatile("s_waitcnt lgkmcnt(" #n ")" ::: "memory")
#define PG8_BAR __builtin_amdgcn_s_barrier()
#define PG8_SCHED __builtin_amdgcn_sched_barrier(0)
    Unit cur, nxt; int ui = 0;
    if (!S.next(0, cur)) return;
    f32x4 acc[2][2][4][2];
#pragma unroll
    for (int a = 0; a < 2; ++a)
#pragma unroll
        for (int b = 0; b < 2; ++b)
#pragma unroll
            for (int m = 0; m < 4; ++m)
#pragma unroll
                for (int n = 0; n < 2; ++n) acc[a][b][m][n] = (f32x4){0.f, 0.f, 0.f, 0.f};
    bf16x8 At[4][2], B0[2][2], B1[2][2];
    const char* cA = (const char*)g.A + (size_t)cur.pm * tstep; const char* cB = (const char*)g.Bt + (size_t)cur.pn * tstep;
    S.a_ready(cur);
    PG8_STAGE(PG8_SB(0, 0), cB, voffB); PG8_STAGE(PG8_SA(0, 0), cA, voffA); PG8_STAGE(PG8_SB(0, 1), cB + hstep, voffB); PG8_STAGE(PG8_SA(0, 1), cA + hstep, voffA);
    if (wr == 1) PG8_BAR;
    PG8_WAIT_V(4); PG8_BAR;
    PG8_STAGE(PG8_SB(1, 0), cB + kstep, voffB); PG8_STAGE(PG8_SA(1, 0), cA + kstep, voffA); PG8_STAGE(PG8_SB(1, 1), cB + hstep + kstep, voffB);
    PG8_WAIT_V(6); PG8_BAR;
    for (;;) {
        const bool has_next = S.next(ui + 1, nxt);
        const char* nA = has_next ? (const char*)g.A + (size_t)nxt.pm * tstep : cA; const char* nB = has_next ? (const char*)g.Bt + (size_t)nxt.pn * tstep : cB;
        for (int t = 0; t < nt; t += 2) {
            const bool last = (t == nt - 2);
            const char* a1 = cA + (size_t)(t + 1) * kstep;
            const char* a2 = last ? nA : cA + (size_t)(t + 2) * kstep; const char* b2 = last ? nB : cB + (size_t)(t + 2) * kstep;
            const char* a3 = a2 + kstep; const char* b3 = b2 + kstep;
            if (last && has_next) S.a_ready(nxt);
            PG8_LDB(B0, 0, 0); PG8_SCHED; PG8_LDA(At, 0, 0); PG8_STAGE(PG8_SA(1, 1), a1 + hstep, voffA);
            PG8_WAIT_L(8); PG8_BAR; PG8_WAIT_L(0); PG8_MMA(0, 0, At, B0); PG8_BAR; PG8_SCHED;
            PG8_LDB(B1, 0, 1); PG8_STAGE(PG8_SB(0, 0), b2, voffB);
            PG8_BAR; PG8_WAIT_L(0); PG8_MMA(0, 1, At, B1); PG8_BAR;
            PG8_LDA(At, 0, 1); PG8_STAGE(PG8_SA(0, 0), a2, voffA);
            PG8_BAR; PG8_WAIT_L(0); PG8_MMA(1, 0, At, B0); PG8_BAR; PG8_SCHED;
            PG8_STAGE(PG8_SB(0, 1), b2 + hstep, voffB);
            PG8_WAIT_V(6); PG8_BAR; PG8_MMA(1, 1, At, B1); PG8_BAR;
            PG8_LDB(B0, 1, 0); PG8_SCHED; PG8_LDA(At, 1, 0); PG8_STAGE(PG8_SA(0, 1), a2 + hstep, voffA);
            PG8_WAIT_L(8); PG8_BAR; PG8_WAIT_L(0); PG8_MMA(0, 0, At, B0); PG8_BAR; PG8_SCHED;
            PG8_LDB(B1, 1, 1); PG8_STAGE(PG8_SB(1, 0), b3, voffB);
            PG8_BAR; PG8_WAIT_L(0); PG8_MMA(0, 1, At, B1); PG8_BAR;
            PG8_LDA(At, 1, 1); PG8_STAGE(PG8_SA(1, 0), a3, voffA);
            PG8_BAR; PG8_WAIT_L(0); PG8_MMA(1, 0, At, B0); PG8_BAR; PG8_SCHED;
            PG8_STAGE(PG8_SB(1, 1), b3 + hstep, voffB);
            PG8_WAIT_V(6); PG8_BAR; PG8_MMA(1, 1, At, B1); PG8_BAR;
        }
        if constexpr (!Epi::AFTER_DRAIN) { E(acc, cur, wr, wc, fr, fq); S.done(cur); }
        if (!has_next) break;
#pragma unroll
        for (int a = 0; a < 2; ++a)
#pragma unroll
            for (int b = 0; b < 2; ++b)
#pragma unroll
                for (int m = 0; m < 4; ++m)
#pragma unroll
                    for (int n = 0; n < 2; ++n) acc[a][b][m][n] = (f32x4){0.f, 0.f, 0.f, 0.f};
        cur = nxt; cA = nA; cB = nB; ++ui;
    }
    PG8_WAIT_V(0);
    if (wr == 0) PG8_BAR;
    PG8_BAR;
    if constexpr (Epi::AFTER_DRAIN) { E.fused(acc, cur, wr, wc, fr, fq, lds, wid, lane); S.done(cur); }
#undef PG8_SA
#undef PG8_SB
#undef PG8_STAGE
#undef PG8_LDA
#undef PG8_LDB
#undef PG8_MMA
#undef PG8_WAIT_V
#undef PG8_WAIT_L
#undef PG8_BAR
#undef PG8_SCHED
}
}


typedef unsigned short bf16_t;
typedef short bf16x8 __attribute__((ext_vector_type(8)));
typedef float f32x4 __attribute__((ext_vector_type(4)));
typedef unsigned u32x4 __attribute__((ext_vector_type(4)));
typedef unsigned u32x2 __attribute__((ext_vector_type(2)));

constexpr int MTOK = 32768, DM = 1024, SEQ = 16384, NTH = 512;
constexpr int GIN = 3088, GIN_P = 3072, RIN = 4224, RIN_P = 4352;
constexpr int LDS_BYTES = 147456;

constexpr size_t WS_WGIN  = 0;
constexpr size_t WS_WGOUT = WS_WGIN  + (size_t)GIN_P * DM * 2;
constexpr size_t WS_WRIN  = WS_WGOUT + (size_t)DM * DM * 2;
constexpr size_t WS_WROUT = WS_WRIN  + (size_t)RIN_P * DM * 2;
constexpr size_t WS_WDUT  = WS_WROUT + (size_t)DM * DM * 2;
constexpr size_t WS_WIUT  = WS_WDUT  + (size_t)DM * 64 * 2;
constexpr size_t WS_WUPT  = WS_WIUT  + (size_t)DM * 64 * 2;
constexpr size_t WS_A     = WS_WUPT  + (size_t)512 * 16 * 2;
constexpr size_t WS_Y     = WS_A     + (size_t)MTOK * DM * 2;
constexpr size_t WS_GS    = WS_Y     + (size_t)MTOK * DM * 2;
constexpr size_t WS_GD    = WS_GS    + (size_t)24 * 1024 * 1024;
constexpr size_t WS_P     = WS_GD    + (size_t)8 * 32 * 128 * 4;
constexpr size_t WS_BAR   = WS_P     + (size_t)MTOK * RIN_P * 2;
constexpr size_t WS_AD    = WS_BAR   + 16384;
constexpr size_t WS_X1    = WS_AD    + (size_t)MTOK * 16 * 2;
constexpr size_t WS_END   = WS_X1    + (size_t)MTOK * DM * 2;
static_assert(WS_END <= (size_t)512 * 1024 * 1024, "workspace budget (4 x the largest tensor)");

struct Params { const float* in[22]; float* out; unsigned char* ws; int ph_lo, ph_hi; };

__device__ __forceinline__ float bf2f(unsigned b) { return __uint_as_float(b << 16); }
__device__ __forceinline__ bf16_t f2bf(float f) { unsigned u = __float_as_uint(f); u += 0x7FFFu + ((u >> 16) & 1u); return (bf16_t)(u >> 16); }
__device__ __forceinline__ unsigned pk2(float lo, float hi) { return pg8::cvt_pk_bf16(lo, hi); }
__device__ __forceinline__ float wave_sum(float x) {
#pragma unroll
    for (int off = 32; off >= 1; off >>= 1) x += __shfl_xor(x, off);
    return x;
}
__device__ __forceinline__ f32x4 mfma16(bf16x8 a, bf16x8 b, f32x4 c) { return __builtin_amdgcn_mfma_f32_16x16x32_bf16(a, b, c, 0, 0, 0); }
__device__ __forceinline__ bf16x8 as_bf16x8(u32x4 v) { union { u32x4 u; bf16x8 b; } x; x.u = v; return x.b; }
__device__ __forceinline__ float fexp(float x) { return __builtin_amdgcn_exp2f(x * 1.4426950408889634f); }
__device__ __forceinline__ float flog(float x) { return __builtin_amdgcn_logf(x) * 0.6931471805599453f; }
__device__ __forceinline__ float log_sigmoid(float z) { return fminf(z, 0.f) - log1pf(fexp(-fabsf(z))); }
__device__ __forceinline__ float softplus(float z) { return fmaxf(z, 0.f) + log1pf(fexp(-fabsf(z))); }

__device__ void prep_weight(const float* __restrict__ W, int N, const float* __restrict__ gain, bf16_t* __restrict__ Wt, int NP, float* tile) {
    const int tid = threadIdx.x;
    const int nu = (NP / 64) * 16;
    const int lk = tid >> 4, lq = tid & 15;
    const int sn = tid >> 3, ss = tid & 7;
    float4 v[2];
#define PW_LOAD(u_) do { const int n0_ = ((u_) >> 4) * 64, k0_ = ((u_) & 15) * 64; _Pragma("unroll") for (int r = 0; r < 2; ++r) { const int k = k0_ + lk + 32 * r, n = n0_ + 4 * lq; \
        float4 x_ = make_float4(0.f, 0.f, 0.f, 0.f); if (n < N) { x_ = *(const float4*)(W + (size_t)k * N + n); if (gain) { const float g_ = gain[k]; x_.x *= g_; x_.y *= g_; x_.z *= g_; x_.w *= g_; } } v[r] = x_; } } while (0)
    int u = blockIdx.x;
    if (u < nu) PW_LOAD(u);
    for (; u < nu; u += gridDim.x) {
        const int n0 = (u >> 4) * 64, k0 = (u & 15) * 64;
#pragma unroll
        for (int r = 0; r < 2; ++r) *(float4*)(tile + (lk + 32 * r) * 68 + 4 * lq) = v[r];
        if (u + (int)gridDim.x < nu) PW_LOAD(u + gridDim.x);
        __syncthreads();
        {
            float e[8];
#pragma unroll
            for (int q = 0; q < 8; ++q) e[q] = tile[(8 * ss + q) * 68 + sn];
            *(u32x4*)(Wt + (size_t)(n0 + sn) * DM + k0 + 8 * ss) = (u32x4){pk2(e[0], e[1]), pk2(e[2], e[3]), pk2(e[4], e[5]), pk2(e[6], e[7])};
        }
        __syncthreads();
    }
#undef PW_LOAD
}

__device__ void prep_lowrank(const float* __restrict__ src, bf16_t* __restrict__ dst) {
    for (int idx = blockIdx.x * NTH + threadIdx.x; idx < 65536; idx += gridDim.x * NTH) dst[idx] = f2bf(src[(idx & 63) * 1024 + (idx >> 6)]);
}

__device__ void zero_bnd_row(bf16_t* bnd) {
    if (blockIdx.x == 0) for (int i = threadIdx.x; i < RIN_P / 2; i += NTH) ((unsigned*)bnd)[i] = 0u;
}

__device__ void prep_wup(const float* __restrict__ src, bf16_t* __restrict__ dst) {
    for (int idx = blockIdx.x * NTH + threadIdx.x; idx < 8192; idx += gridDim.x * NTH) dst[idx] = f2bf(src[(idx & 15) * 512 + (idx >> 4)]);
}

struct EpiBf16Bnd {
    static constexpr bool PERM = true, AFTER_DRAIN = false;
    bf16_t* O; int ldc; bf16_t* bnd;
    __device__ __forceinline__ void operator()(const f32x4 (&acc)[2][2][4][2], const pg8::Unit& u, int wr, int wc, int fr, int fq) const {
        const int row0 = u.pm * pg8::BM + wr * 64 + fr, col0 = u.pn * pg8::BM + wc * 32 + 8 * fq;
#pragma unroll
        for (int ai = 0; ai < 2; ++ai)
#pragma unroll
            for (int m = 0; m < 4; ++m) {
                const int row = row0 + ai * pg8::HALF + m * 16;
                bf16_t* rowp = O + (size_t)row * ldc + col0;
#pragma unroll
                for (int bj = 0; bj < 2; ++bj) {
                    const f32x4 v0 = acc[ai][bj][m][0], v1 = acc[ai][bj][m][1];
                    u32x4 wv; wv.x = pk2(v0[0], v0[1]); wv.y = pk2(v0[2], v0[3]); wv.z = pk2(v1[0], v1[1]); wv.w = pk2(v1[2], v1[3]);
                    *(u32x4*)(rowp + bj * pg8::HALF) = wv;
                    if (m == 3 && fr == 15) *(u32x4*)(bnd + (size_t)((row >> 6) + 1) * ldc + col0 + bj * pg8::HALF) = wv;
                }
            }
    }
};

__device__ void phase_norm0(const Params& p, unsigned char* lds) {
    const int tid = threadIdx.x, lane = tid & 63, w = tid >> 6, l15 = lane & 15, g = lane >> 4;
    const float* x = p.in[0];
    bf16_t* A = (bf16_t*)(p.ws + WS_A);
    bf16_t* AD = (bf16_t*)(p.ws + WS_AD);
    bf16_t* WAD = (bf16_t*)lds;
    float* PSS = (float*)(lds + 33024);
    float* PAD = (float*)(lds + 33024 + 512);
    for (int e = tid; e < 16384; e += NTH) { const int k = e >> 4, j = e & 15; WAD[j * 1032 + k] = f2bf(p.in[2][(size_t)k * GIN + 3072 + j] * p.in[1][k]); }
    __syncthreads();
    bf16x8 wf[4];
#pragma unroll
    for (int kk = 0; kk < 4; ++kk) wf[kk] = *(const bf16x8*)(WAD + l15 * 1032 + 128 * w + 32 * kk + 8 * g);
    float4 xa[4][2];
    int tile = blockIdx.x;
    if (tile < MTOK / 16) {
#pragma unroll
        for (int kk = 0; kk < 4; ++kk) { const float4* s = (const float4*)(x + (size_t)(16 * tile + l15) * DM + 128 * w + 32 * kk + 8 * g); xa[kk][0] = s[0]; xa[kk][1] = s[1]; }
    }
    for (; tile < MTOK / 16; tile += gridDim.x) {
        float4 xv[4][2];
#pragma unroll
        for (int kk = 0; kk < 4; ++kk) { xv[kk][0] = xa[kk][0]; xv[kk][1] = xa[kk][1]; }
        if (tile + (int)gridDim.x < MTOK / 16) {
#pragma unroll
            for (int kk = 0; kk < 4; ++kk) { const float4* s = (const float4*)(x + (size_t)(16 * (tile + gridDim.x) + l15) * DM + 128 * w + 32 * kk + 8 * g); xa[kk][0] = s[0]; xa[kk][1] = s[1]; }
        }
        float ss = 0.f;
        f32x4 acc = (f32x4){0.f, 0.f, 0.f, 0.f};
#pragma unroll
        for (int kk = 0; kk < 4; ++kk) {
            const float4 a = xv[kk][0], b = xv[kk][1];
            ss += a.x * a.x + a.y * a.y + a.z * a.z + a.w * a.w + b.x * b.x + b.y * b.y + b.z * b.z + b.w * b.w;
            acc = mfma16(as_bf16x8((u32x4){pk2(a.x, a.y), pk2(a.z, a.w), pk2(b.x, b.y), pk2(b.z, b.w)}), wf[kk], acc);
        }
        ss += __shfl_xor(ss, 16); ss += __shfl_xor(ss, 32);
        if (g == 0) PSS[w * 16 + l15] = ss;
        *(f32x4*)(PAD + (w * 64 + lane) * 4) = acc;
        __syncthreads();
        float tot = 0.f;
#pragma unroll
        for (int q = 0; q < 8; ++q) tot += PSS[q * 16 + l15];
        const float rstd = rsqrtf(tot * (1.0f / DM) + 1e-6f);
#pragma unroll
        for (int kk = 0; kk < 4; ++kk) {
            const float4 a = xv[kk][0], b = xv[kk][1];
            *(u32x4*)(A + (size_t)(16 * tile + l15) * DM + 128 * w + 32 * kk + 8 * g) = (u32x4){pk2(a.x * rstd, a.y * rstd), pk2(a.z * rstd, a.w * rstd), pk2(b.x * rstd, b.y * rstd), pk2(b.z * rstd, b.w * rstd)};
        }
        if (w == 0) {
            f32x4 s = (f32x4){0.f, 0.f, 0.f, 0.f};
#pragma unroll
            for (int q = 0; q < 8; ++q) s += *(const f32x4*)(PAD + (q * 64 + lane) * 4);
#pragma unroll
            for (int r = 0; r < 4; ++r) AD[(size_t)(16 * tile + 4 * g + r) * 16 + l15] = f2bf(s[r] * __shfl(rstd, 4 * g + r));
        }
        __syncthreads();
    }
}

__device__ void phase_norm1(const Params& p) {
    const int tid = threadIdx.x, lane = tid & 63, w = tid >> 6;
    const float* x = p.in[0];
    const float* gpost = p.in[7];
    const bf16_t* Y = (const bf16_t*)(p.ws + WS_Y);
    bf16_t* A = (bf16_t*)(p.ws + WS_A);
    bf16_t* X1 = (bf16_t*)(p.ws + WS_X1);
    float4 gp[4];
#pragma unroll
    for (int i = 0; i < 4; ++i) gp[i] = ((const float4*)gpost)[lane + 64 * i];
    const int stride = gridDim.x * 8;
    float4 vn[4]; u32x2 yn[4];
    {
        const int row = blockIdx.x * 8 + w;
#pragma unroll
        for (int i = 0; i < 4; ++i) { vn[i] = ((const float4*)(x + (size_t)row * DM))[lane + 64 * i]; yn[i] = *(const u32x2*)(Y + (size_t)row * DM + 4 * (lane + 64 * i)); }
    }
    for (int row = blockIdx.x * 8 + w; row < MTOK; row += stride) {
        float4 v[4]; u32x2 yv[4];
#pragma unroll
        for (int i = 0; i < 4; ++i) { v[i] = vn[i]; yv[i] = yn[i]; }
        if (row + stride < MTOK) {
#pragma unroll
            for (int i = 0; i < 4; ++i) { vn[i] = ((const float4*)(x + (size_t)(row + stride) * DM))[lane + 64 * i]; yn[i] = *(const u32x2*)(Y + (size_t)(row + stride) * DM + 4 * (lane + 64 * i)); }
        }
        float4 y[4];
        float ss = 0.f;
#pragma unroll
        for (int i = 0; i < 4; ++i) {
            y[i].x = bf2f(yv[i].x & 0xffffu); y[i].y = bf2f(yv[i].x >> 16); y[i].z = bf2f(yv[i].y & 0xffffu); y[i].w = bf2f(yv[i].y >> 16);
            ss += y[i].x * y[i].x + y[i].y * y[i].y + y[i].z * y[i].z + y[i].w * y[i].w;
        }
        ss = wave_sum(ss);
        const float rstdy = rsqrtf(ss * (1.0f / DM) + 1e-6f);
        float s1 = 0.f;
#pragma unroll
        for (int i = 0; i < 4; ++i) {
            v[i].x += y[i].x * rstdy * gp[i].x; v[i].y += y[i].y * rstdy * gp[i].y; v[i].z += y[i].z * rstdy * gp[i].z; v[i].w += y[i].w * rstdy * gp[i].w;
            s1 += v[i].x * v[i].x + v[i].y * v[i].y + v[i].z * v[i].z + v[i].w * v[i].w;
            u32x2 xo; xo.x = pk2(v[i].x, v[i].y); xo.y = pk2(v[i].z, v[i].w);
            *(u32x2*)(X1 + (size_t)row * DM + 4 * (lane + 64 * i)) = xo;
        }
        s1 = wave_sum(s1);
        const float rstd = rsqrtf(s1 * (1.0f / DM) + 1e-6f);
#pragma unroll
        for (int i = 0; i < 4; ++i) {
            u32x2 o; o.x = pk2(v[i].x * rstd, v[i].y * rstd); o.y = pk2(v[i].z * rstd, v[i].w * rstd);
            *(u32x2*)(A + (size_t)row * DM + 4 * (lane + 64 * i)) = o;
        }
    }
}

__device__ void phase_final(const Params& p) {
    const int tid = threadIdx.x, lane = tid & 63, w = tid >> 6;
    const float* gpost = p.in[21];
    const bf16_t* Y = (const bf16_t*)(p.ws + WS_Y);
    const bf16_t* X1 = (const bf16_t*)(p.ws + WS_X1);
    float4 gp[4];
#pragma unroll
    for (int i = 0; i < 4; ++i) gp[i] = ((const float4*)gpost)[lane + 64 * i];
    const int stride = gridDim.x * 8;
    u32x2 xn[4], yn[4];
    {
        const int row = blockIdx.x * 8 + w;
#pragma unroll
        for (int i = 0; i < 4; ++i) { xn[i] = *(const u32x2*)(X1 + (size_t)row * DM + 4 * (lane + 64 * i)); yn[i] = *(const u32x2*)(Y + (size_t)row * DM + 4 * (lane + 64 * i)); }
    }
    for (int row = blockIdx.x * 8 + w; row < MTOK; row += stride) {
        u32x2 xv[4], yv[4];
#pragma unroll
        for (int i = 0; i < 4; ++i) { xv[i] = xn[i]; yv[i] = yn[i]; }
        if (row + stride < MTOK) {
#pragma unroll
            for (int i = 0; i < 4; ++i) { xn[i] = *(const u32x2*)(X1 + (size_t)(row + stride) * DM + 4 * (lane + 64 * i)); yn[i] = *(const u32x2*)(Y + (size_t)(row + stride) * DM + 4 * (lane + 64 * i)); }
        }
        float4 y[4];
        float ss = 0.f;
#pragma unroll
        for (int i = 0; i < 4; ++i) {
            y[i].x = bf2f(yv[i].x & 0xffffu); y[i].y = bf2f(yv[i].x >> 16); y[i].z = bf2f(yv[i].y & 0xffffu); y[i].w = bf2f(yv[i].y >> 16);
            ss += y[i].x * y[i].x + y[i].y * y[i].y + y[i].z * y[i].z + y[i].w * y[i].w;
        }
        ss = wave_sum(ss);
        const float rstdy = rsqrtf(ss * (1.0f / DM) + 1e-6f);
#pragma unroll
        for (int i = 0; i < 4; ++i) {
            float4 v;
            v.x = bf2f(xv[i].x & 0xffffu) + y[i].x * rstdy * gp[i].x; v.y = bf2f(xv[i].x >> 16) + y[i].y * rstdy * gp[i].y;
            v.z = bf2f(xv[i].y & 0xffffu) + y[i].z * rstdy * gp[i].z; v.w = bf2f(xv[i].y >> 16) + y[i].w * rstdy * gp[i].w;
            ((float4*)(p.out + (size_t)row * DM))[lane + 64 * i] = v;
        }
    }
}

constexpr int L_BC = 0, L_ATT = 0, L_QD = 33792, L_KD = L_QD + 64 * 136 * 2, L_KTE = L_KD + 64 * 136 * 2, L_VI = L_KTE + 64 * 152 * 2, L_SSQ = L_VI + 64 * 280 * 2, L_BL = L_SSQ + 2048, L_DEC = L_BL + 512, L_ADL = L_DEC + 512,
              L_GLA_END = L_ADL + 2048;
static_assert(L_GLA_END <= LDS_BYTES, "GLA LDS");
#define GLA_BARRIER() do { asm volatile("s_waitcnt lgkmcnt(0)" ::: "memory"); __builtin_amdgcn_s_barrier(); asm volatile("" ::: "memory"); } while (0)
typedef short gs16x4 __attribute__((ext_vector_type(4)));
__device__ __forceinline__ u32x2 g_trread(const bf16_t* p) { union { gs16x4 s; u32x2 u; } x; x.s = __builtin_amdgcn_ds_read_tr16_b64_v4i16((__attribute__((address_space(3))) gs16x4*)p); return x.u; }
template <int PITCH> __device__ __forceinline__ bf16x8 g_trfrag(const bf16_t* img, int k0, int c0, int g, int q, int pq) {
    const bf16_t* a = img + (k0 + 8 * g + q) * PITCH + c0 + 4 * pq;
    const u32x2 lo = g_trread(a), hi = g_trread(a + 4 * PITCH);
    return as_bf16x8((u32x4){lo.x, lo.y, hi.x, hi.y});
}
__device__ __forceinline__ f32x4 g_lo4(u32x4 v) { return (f32x4){bf2f(v.x & 0xffffu), bf2f(v.x >> 16), bf2f(v.y & 0xffffu), bf2f(v.y >> 16)}; }
__device__ __forceinline__ f32x4 g_hi4(u32x4 v) { return (f32x4){bf2f(v.z & 0xffffu), bf2f(v.z >> 16), bf2f(v.w & 0xffffu), bf2f(v.w >> 16)}; }
__device__ __forceinline__ u32x2 g_pk4(f32x4 v) { u32x2 r; r.x = pk2(v[0], v[1]); r.y = pk2(v[2], v[3]); return r; }
__device__ __forceinline__ f32x4 g_unpk4(u32x2 v) { return (f32x4){bf2f(v.x & 0xffffu), bf2f(v.x >> 16), bf2f(v.y & 0xffffu), bf2f(v.y >> 16)}; }

template <bool OUT> struct GlaRaw { u32x4 q[2], k[2], v[4]; };
template <bool OUT> __device__ __forceinline__ void gla_issue(GlaRaw<OUT>& x, const char* cb  , unsigned offQ, unsigned offV) {
    if (OUT) { x.q[0] = *(const u32x4*)(cb + offQ); x.q[1] = *(const u32x4*)(cb + offQ + 16); }
    x.k[0] = *(const u32x4*)(cb + offQ + 1024); x.k[1] = *(const u32x4*)(cb + offQ + 1040);
#pragma unroll
    for (int i = 0; i < 4; ++i) x.v[i] = *(const u32x4*)(cb + offV + 16 * i);
}

template <bool OUT>
__device__ void gla_pass(const Params& p, unsigned char* lds) {
    const int tid = threadIdx.x, w = __builtin_amdgcn_readfirstlane(tid >> 6);
    const bf16_t* P = (const bf16_t*)(p.ws + WS_P);
    bf16_t* GS = (bf16_t*)(p.ws + WS_GS);
    float* GD = (float*)(p.ws + WS_GD);
    bf16_t* Aout = (bf16_t*)(p.ws + WS_A);
    const bf16_t* WupT = (const bf16_t*)(p.ws + WS_WUPT);
    const bf16_t* ADG = (const bf16_t*)(p.ws + WS_AD);
    float* BC = (float*)(lds + L_BC); bf16_t* ATT = (bf16_t*)(lds + L_ATT); bf16_t* QD = (bf16_t*)(lds + L_QD); bf16_t* KD = (bf16_t*)(lds + L_KD); bf16_t* KTE = (bf16_t*)(lds + L_KTE);
    bf16_t* VI = (bf16_t*)(lds + L_VI); float* SSQ = (float*)(lds + L_SSQ); float* BL = (float*)(lds + L_BL); float* DEC = (float*)(lds + L_DEC); bf16_t* ADL = (bf16_t*)(lds + L_ADL);
    const float* b_al = p.in[4]; const float* g_head = p.in[5];

    for (int unit = blockIdx.x; unit < 256; unit += gridDim.x) {
        const int bh = unit >> 5, m = unit & 31, b = bh >> 2, h = bh & 3;
        int tidv = tid; asm volatile("" : "+v"(tidv));
        const int lane = tidv & 63, l15 = lane & 15, g = lane >> 4, q4 = l15 >> 2, p4 = l15 & 3;
        const int c = tidv >> 3, seg = tidv & 7;
        const int tokbase = b * SEQ + m * 512;
        u32x4 wupq = *(const u32x4*)(WupT + (size_t)(h * 128 + 16 * w + l15) * 16 + 8 * (g & 1));
        if (g >= 2) wupq = (u32x4){0u, 0u, 0u, 0u};
        const bf16x8 wupf = as_bf16x8(wupq);
        const float bA = b_al[h * 128 + 16 * w + l15];
        f32x4 gh[2];
#pragma unroll
        for (int vt = 0; vt < 2; ++vt) gh[vt] = *(const f32x4*)(g_head + 32 * w + 16 * vt + 4 * g);
        float logD = 0.f;
        f32x4 S[8][2];
#pragma unroll
        for (int mt = 0; mt < 8; ++mt)
#pragma unroll
            for (int vt = 0; vt < 2; ++vt) {
                if (OUT) S[mt][vt] = g_unpk4(*(const u32x2*)(GS + ((size_t)(bh * 32 + m) * 256 + 32 * w + 16 * vt + l15) * 128 + 16 * mt + 4 * g));
                else S[mt][vt] = (f32x4){0.f, 0.f, 0.f, 0.f};
            }
        const unsigned offQ = (unsigned)((c * GIN_P + h * 128 + 16 * seg) * 2), offV = (unsigned)((c * GIN_P + 1024 + h * 256 + 32 * seg) * 2), offAD = (unsigned)(tid * 16);
        const unsigned offG = (unsigned)((l15 * GIN_P + 2048 + h * 256 + 32 * w + 4 * g) * 2), offO = (unsigned)((l15 * DM + h * 256 + 32 * w + 4 * g) * 2);
        GlaRaw<OUT> raw;
        gla_issue<OUT>(raw, (const char*)P + (size_t)tokbase * GIN_P * 2, offQ, offV);
        if (tid < 128) *(u32x4*)(ADL + tid * 8) = *(const u32x4*)((const char*)ADG + (size_t)tokbase * 32 + offAD);
        GLA_BARRIER();

        for (int ch = 0; ch < 8; ++ch) {
            const int tok0 = tokbase + ch * 64;
            u32x4 adn = (u32x4){0u, 0u, 0u, 0u};
            {
                if (ch < 7 && tid < 128) adn = *(const u32x4*)((const char*)ADG + (size_t)(tok0 + 64) * 32 + offAD);
                f32x4 sc[4]; float xinc[4], tot[4];
#pragma unroll
                for (int ct = 0; ct < 4; ++ct) {
                    u32x4 aq = *(const u32x4*)(ADL + (16 * ct + l15) * 16 + 8 * (g & 1));
                    if (g >= 2) aq = (u32x4){0u, 0u, 0u, 0u};
                    const f32x4 z = mfma16(as_bf16x8(aq), wupf, (f32x4){bA, bA, bA, bA});
                    float acc = 0.f;
#pragma unroll
                    for (int r = 0; r < 4; ++r) { acc += (fminf(z[r], 0.f) - flog(1.f + fexp(-fabsf(z[r])))) * (1.0f / 16.0f); sc[ct][r] = acc; }
                    xinc[ct] = acc;
                }
#pragma unroll
                for (int ct = 0; ct < 4; ++ct) { const float y = __shfl_up(xinc[ct], 16); if (g >= 1) xinc[ct] += y; }
#pragma unroll
                for (int ct = 0; ct < 4; ++ct) { const float y = __shfl_up(xinc[ct], 32); if (g >= 2) xinc[ct] += y; }
#pragma unroll
                for (int ct = 0; ct < 4; ++ct) tot[ct] = __shfl(xinc[ct], 48 + l15);
                float run = 0.f;
#pragma unroll
                for (int ct = 0; ct < 4; ++ct) {
                    const float base = run + (xinc[ct] - sc[ct][3]);
                    run += tot[ct];
#pragma unroll
                    for (int r = 0; r < 4; ++r) BC[(16 * ct + 4 * g + r) * 132 + 16 * w + l15] = base + sc[ct][r];
                }
                if (g == 0) { BL[16 * w + l15] = run; DEC[16 * w + l15] = fexp(run); }
                if (!OUT) logD += run;
            }
            GLA_BARRIER();
            u32x2 gate[2][4];
            {
#pragma unroll
                for (int hh = 0; hh < 2; ++hh) {
                    const int o8 = 16 * seg + 8 * hh;
                    const f32x4 bb[2] = {*(const f32x4*)(BC + c * 132 + o8), *(const f32x4*)(BC + c * 132 + o8 + 4)};
                    const f32x4 dc[2] = {*(const f32x4*)(DEC + o8), *(const f32x4*)(DEC + o8 + 4)};
                    const f32x4 kx[2] = {g_lo4(raw.k[hh]), g_hi4(raw.k[hh])};
                    f32x4 qx[2];
                    if (OUT) { qx[0] = g_lo4(raw.q[hh]); qx[1] = g_hi4(raw.q[hh]); }
                    f32x4 kd[2], kt[2], qd[2];
#pragma unroll
                    for (int i = 0; i < 2; ++i)
#pragma unroll
                        for (int j = 0; j < 4; ++j) {
                            const float eB = fexp(bb[i][j]), enB = __builtin_amdgcn_rcpf(eB);
                            kd[i][j] = kx[i][j] * enB; kt[i][j] = kd[i][j] * dc[i][j];
                            if (OUT) qd[i][j] = qx[i][j] * 0.08838834764831845f * eB;
                        }
                    *(u32x4*)(KTE + c * 152 + o8) = (u32x4){pk2(kt[0][0], kt[0][1]), pk2(kt[0][2], kt[0][3]), pk2(kt[1][0], kt[1][1]), pk2(kt[1][2], kt[1][3])};
                    if (OUT) {
                        *(u32x4*)(KD + c * 136 + o8) = (u32x4){pk2(kd[0][0], kd[0][1]), pk2(kd[0][2], kd[0][3]), pk2(kd[1][0], kd[1][1]), pk2(kd[1][2], kd[1][3])};
                        *(u32x4*)(QD + c * 136 + o8) = (u32x4){pk2(qd[0][0], qd[0][1]), pk2(qd[0][2], qd[0][3]), pk2(qd[1][0], qd[1][1]), pk2(qd[1][2], qd[1][3])};
                    }
                }
#pragma unroll
                for (int i = 0; i < 4; ++i) *(u32x4*)(VI + c * 280 + 32 * seg + 8 * i) = raw.v[i];
                if (OUT) {
#pragma unroll
                    for (int vt = 0; vt < 2; ++vt)
#pragma unroll
                        for (int ct = 0; ct < 4; ++ct) gate[vt][ct] = *(const u32x2*)((const char*)P + (size_t)(tok0 + 16 * ct) * GIN_P * 2 + offG + 32 * vt);
                }
                if (ch < 7) gla_issue<OUT>(raw, (const char*)P + (size_t)(tok0 + 64) * GIN_P * 2, offQ, offV);
                if (ch < 7 && tid < 128) *(u32x4*)(ADL + tid * 8) = adn;
            }
            GLA_BARRIER();
            f32x4 o[2][4];
            if (OUT) {
#pragma unroll
                for (int t2 = 0; t2 < 2; ++t2) {
                    const int tl = 2 * w + t2, ct = tl >> 2, st = tl & 3;
                    f32x4 acc = (f32x4){0.f, 0.f, 0.f, 0.f};
                    if (st <= ct) {
#pragma unroll
                        for (int kk = 0; kk < 4; ++kk) {
                            const bf16x8 a = *(const bf16x8*)(KD + (16 * st + l15) * 136 + 32 * kk + 8 * g);
                            const bf16x8 bq = *(const bf16x8*)(QD + (16 * ct + l15) * 136 + 32 * kk + 8 * g);
                            acc = mfma16(a, bq, acc);
                        }
#pragma unroll
                        for (int r = 0; r < 4; ++r) if (16 * st + 4 * g + r > 16 * ct + l15) acc[r] = 0.f;
                    }
                    *(u32x2*)(ATT + (16 * ct + l15) * 72 + 16 * st + 4 * g) = g_pk4(acc);
                }
                GLA_BARRIER();
#pragma unroll
                for (int vt = 0; vt < 2; ++vt)
#pragma unroll
                    for (int ct = 0; ct < 4; ++ct) o[vt][ct] = (f32x4){0.f, 0.f, 0.f, 0.f};
#pragma unroll
                for (int kk = 0; kk < 4; ++kk) {
                    bf16x8 sa[2];
#pragma unroll
                    for (int vt = 0; vt < 2; ++vt) { const u32x2 s0 = g_pk4(S[2 * kk][vt]), s1 = g_pk4(S[2 * kk + 1][vt]); sa[vt] = as_bf16x8((u32x4){s0.x, s0.y, s1.x, s1.y}); }
#pragma unroll
                    for (int ct = 0; ct < 4; ++ct) {
                        const bf16_t* qr = QD + (16 * ct + l15) * 136 + 32 * kk + 4 * g;
                        const u32x2 lo = *(const u32x2*)qr, hi = *(const u32x2*)(qr + 16);
                        const bf16x8 bq = as_bf16x8((u32x4){lo.x, lo.y, hi.x, hi.y});
#pragma unroll
                        for (int vt = 0; vt < 2; ++vt) o[vt][ct] = mfma16(sa[vt], bq, o[vt][ct]);
                    }
                }
            }
            bf16x8 bv[2][2];
#pragma unroll
            for (int vt = 0; vt < 2; ++vt)
#pragma unroll
                for (int kk = 0; kk < 2; ++kk) bv[vt][kk] = g_trfrag<280>(VI, 32 * kk, 32 * w + 16 * vt, g, q4, p4);
            if (OUT) {
#pragma unroll
                for (int ct = 0; ct < 4; ++ct)
#pragma unroll
                    for (int kk = 0; kk < 2; ++kk) {
                        if (32 * kk <= 16 * ct + 15) {
                            const bf16x8 bq = *(const bf16x8*)(ATT + (16 * ct + l15) * 72 + 32 * kk + 8 * g);
#pragma unroll
                            for (int vt = 0; vt < 2; ++vt) o[vt][ct] = mfma16(bv[vt][kk], bq, o[vt][ct]);
                        }
                    }
            }
#pragma unroll
            for (int mt = 0; mt < 8; ++mt) {
                const f32x4 dv = *(const f32x4*)(DEC + 16 * mt + 4 * g);
#pragma unroll
                for (int vt = 0; vt < 2; ++vt) S[mt][vt] *= dv;
#pragma unroll
                for (int kk = 0; kk < 2; ++kk) {
                    const bf16x8 a = g_trfrag<152>(KTE, 32 * kk, 16 * mt, g, q4, p4);
#pragma unroll
                    for (int vt = 0; vt < 2; ++vt) S[mt][vt] = mfma16(a, bv[vt][kk], S[mt][vt]);
                }
            }
            if (OUT) {
                float ss[4];
#pragma unroll
                for (int ct = 0; ct < 4; ++ct) {
                    float s = 0.f;
#pragma unroll
                    for (int vt = 0; vt < 2; ++vt)
#pragma unroll
                        for (int r = 0; r < 4; ++r) s += o[vt][ct][r] * o[vt][ct][r];
                    s += __shfl_xor(s, 16); s += __shfl_xor(s, 32);
                    ss[ct] = s;
                }
                if (g == 0) {
#pragma unroll
                    for (int ct = 0; ct < 4; ++ct) SSQ[(16 * ct + l15) * 8 + w] = ss[ct];
                }
                GLA_BARRIER();
#pragma unroll
                for (int ct = 0; ct < 4; ++ct) {
                    const int cc = 16 * ct + l15;
                    const float4 s0 = *(const float4*)(SSQ + cc * 8), s1 = *(const float4*)(SSQ + cc * 8 + 4);
                    const float tot = (s0.x + s0.y) + (s0.z + s0.w) + (s1.x + s1.y) + (s1.z + s1.w);
                    const float rstd = rsqrtf(tot * (1.0f / 256.0f) + 1e-6f);
#pragma unroll
                    for (int vt = 0; vt < 2; ++vt) {
                        const f32x4 gt = g_unpk4(gate[vt][ct]);
                        f32x4 val;
#pragma unroll
                        for (int r = 0; r < 4; ++r) val[r] = o[vt][ct][r] * rstd * gh[vt][r] * gt[r] * __builtin_amdgcn_rcpf(1.0f + fexp(-gt[r]));
                        *(u32x2*)((char*)Aout + (size_t)(tok0 + 16 * ct) * DM * 2 + offO + 32 * vt) = g_pk4(val);
                    }
                }
            } else {
                GLA_BARRIER();
            }
        }
        if (!OUT) {
#pragma unroll
            for (int mt = 0; mt < 8; ++mt)
#pragma unroll
                for (int vt = 0; vt < 2; ++vt) *(u32x2*)(GS + ((size_t)(bh * 32 + m) * 256 + 32 * w + 16 * vt + l15) * 128 + 16 * mt + 4 * g) = g_pk4(S[mt][vt]);
            if (g == 0) GD[(bh * 32 + m) * 128 + 16 * w + l15] = fexp(logD);
        }
        GLA_BARRIER();
    }
}

__device__ void gla_scan(const Params& p) {
    bf16_t* GS = (bf16_t*)(p.ws + WS_GS);
    const float* GD = (const float*)(p.ws + WS_GD);
    for (int idx = blockIdx.x * NTH + threadIdx.x; idx < 8 * 8192; idx += gridDim.x * NTH) {
        const int bh = idx >> 13, e = (idx & 8191) * 4, d = e & 127;
        f32x4 S = (f32x4){0.f, 0.f, 0.f, 0.f};
        for (int m0 = 0; m0 < 32; m0 += 8) {
            u32x2 t[8]; f32x4 dd[8];
#pragma unroll
            for (int m = 0; m < 8; ++m) { t[m] = *(const u32x2*)(GS + (size_t)(bh * 32 + m0 + m) * 32768 + e); dd[m] = *(const f32x4*)(GD + (bh * 32 + m0 + m) * 128 + d); }
#pragma unroll
            for (int m = 0; m < 8; ++m) { *(u32x2*)(GS + (size_t)(bh * 32 + m0 + m) * 32768 + e) = g_pk4(S); S = S * dd[m] + g_unpk4(t[m]); }
        }
    }
}

constexpr int PP = RIN_P;
constexpr size_t WS_RK  = WS_GS;
constexpr size_t WS_BND = WS_GS + (size_t)MTOK * 16 * 4;
static_assert(WS_BND + (size_t)513 * PP * 2 <= WS_GD, "RWKV side buffers must fit the GLA state region");
constexpr int IMG = 64 * 72 * 2;
constexpr int R_ALB = 0, R_BH = IMG, R_KH = 2 * IMG, R_RB = 3 * IMG, R_BTL = 4 * IMG, R_KTL = 5 * IMG, R_VI = 6 * IMG, R_AAB = 7 * IMG, R_AAK = 8 * IMG, R_ARB = 9 * IMG, R_ARK = 10 * IMG,
              R_DW = R_AAB, R_DA = R_AAB + 64 * 68 * 4, R_XT = 11 * IMG, R_TW = R_XT, R_ADI = R_XT + IMG, R_TDF = R_XT + 2 * IMG, R_CS = R_TDF + 2048, R_GC = R_CS + 2048, R_CONST = R_GC + 256, R_WDL = R_CONST + 2560, R_WIL = R_WDL + IMG,
              R_END = R_WIL + IMG;
static_assert(R_DA + 64 * 68 * 4 <= R_XT && R_END <= LDS_BYTES, "R1 LDS");
#define LDS_BARRIER() do { asm volatile("s_waitcnt lgkmcnt(0)" ::: "memory"); __builtin_amdgcn_s_barrier(); asm volatile("" ::: "memory"); } while (0)

typedef short s16x4 __attribute__((ext_vector_type(4)));
__device__ __forceinline__ bf16x8 ldfrag(const bf16_t* img, int row, int koff) { return *(const bf16x8*)(img + row * 72 + koff); }
__device__ __forceinline__ u32x2 pk4(f32x4 v) { u32x2 r; r.x = pk2(v[0], v[1]); r.y = pk2(v[2], v[3]); return r; }
__device__ __forceinline__ f32x4 unpk4(u32x2 v) { return (f32x4){bf2f(v.x & 0xffffu), bf2f(v.x >> 16), bf2f(v.y & 0xffffu), bf2f(v.y >> 16)}; }
__device__ __forceinline__ u32x2 trread(const bf16_t* p) {
    union { s16x4 s; u32x2 u; } x; x.s = __builtin_amdgcn_ds_read_tr16_b64_v4i16((__attribute__((address_space(3))) s16x4*)p); return x.u;
}
__device__ __forceinline__ bf16x8 trfrag(const bf16_t* img, int k0, int c0, int g, int q, int pq) {
    const bf16_t* a = img + (k0 + 8 * g + q) * 72 + c0 + 4 * pq;
    const u32x2 lo = trread(a), hi = trread(a + 4 * 72);
    return as_bf16x8((u32x4){lo.x, lo.y, hi.x, hi.y});
}
__device__ __forceinline__ f32x4 lo4(u32x4 v) { return (f32x4){bf2f(v.x & 0xffffu), bf2f(v.x >> 16), bf2f(v.y & 0xffffu), bf2f(v.y >> 16)}; }
__device__ __forceinline__ f32x4 hi4(u32x4 v) { return (f32x4){bf2f(v.z & 0xffffu), bf2f(v.z >> 16), bf2f(v.w & 0xffffu), bf2f(v.w >> 16)}; }
__device__ __forceinline__ u32x4 pk8(f32x4 a, f32x4 b) { return (u32x4){pk2(a[0], a[1]), pk2(a[2], a[3]), pk2(b[0], b[1]), pk2(b[2], b[3])}; }
__device__ __forceinline__ float fast_rcp(float x) { return __builtin_amdgcn_rcpf(x); }
__device__ __forceinline__ f32x4 mm16(f32x4 xa, f32x4 yb, f32x4 c) {
    const u32x2 a = pk4(xa), b = pk4(yb);
    return mfma16(as_bf16x8((u32x4){a.x, a.y, 0u, 0u}), as_bf16x8((u32x4){b.x, b.y, 0u, 0u}), c);
}

struct R1Raw { u32x4 r0, r1, k0, k1, v0, v1, w0, w1, a0, a1; };
__device__ __forceinline__ void r1_issue(R1Raw& x, const bf16_t* P, const bf16_t* BND, int unit, int t, int cs) {
    const int bn = unit >> 4, h = unit & 15, n = bn & 255;
    const bf16_t* cur = P + ((size_t)bn * 64 + t) * PP;
    const bf16_t* prv = (t > 0) ? (cur - PP) : (BND + (size_t)(n == 0 ? 0 : bn) * PP);
    const int ch = h * 64 + 8 * cs;
    x.r0 = *(const u32x4*)(cur + ch); x.k0 = *(const u32x4*)(cur + 1024 + ch); x.v0 = *(const u32x4*)(cur + 2048 + ch); x.w0 = *(const u32x4*)(cur + 4096 + 8 * cs); x.a0 = *(const u32x4*)(cur + 4160 + 8 * cs);
    x.r1 = *(const u32x4*)(prv + ch); x.k1 = *(const u32x4*)(prv + 1024 + ch); x.v1 = *(const u32x4*)(prv + 2048 + ch); x.w1 = *(const u32x4*)(prv + 4096 + 8 * cs); x.a1 = *(const u32x4*)(prv + 4160 + 8 * cs);
}
__device__ __forceinline__ void lerp8(u32x4 c, u32x4 pv, const float* mu8, f32x4& o0, f32x4& o1) {
    const f32x4 c0 = lo4(c), c1 = hi4(c), p0 = lo4(pv), p1 = hi4(pv);
    const f32x4 m0 = *(const f32x4*)mu8, m1 = *(const f32x4*)(mu8 + 4);
    o0 = c0 + m0 * (p0 - c0); o1 = c1 + m1 * (p1 - c1);
}

__device__ void rwkv_r1(const Params& p, unsigned char* lds) {
    const int tid = threadIdx.x, w = __builtin_amdgcn_readfirstlane(tid >> 6);
    bf16_t* P = (bf16_t*)(p.ws + WS_P);
    bf16_t* Abuf = (bf16_t*)(p.ws + WS_A);
    bf16_t* Ybuf = (bf16_t*)(p.ws + WS_Y);
    float* RK = (float*)(p.ws + WS_RK);
    const bf16_t* BND = (const bf16_t*)(p.ws + WS_BND);
    const bf16_t* WduT = (const bf16_t*)(p.ws + WS_WDUT);
    const bf16_t* WiuT = (const bf16_t*)(p.ws + WS_WIUT);
    bf16_t* ALB = (bf16_t*)(lds + R_ALB); bf16_t* BH = (bf16_t*)(lds + R_BH); bf16_t* KH = (bf16_t*)(lds + R_KH); bf16_t* RB = (bf16_t*)(lds + R_RB);
    bf16_t* BTL = (bf16_t*)(lds + R_BTL); bf16_t* KTL = (bf16_t*)(lds + R_KTL); bf16_t* VI = (bf16_t*)(lds + R_VI);
    bf16_t* AAB = (bf16_t*)(lds + R_AAB); bf16_t* AAK = (bf16_t*)(lds + R_AAK); bf16_t* ARB = (bf16_t*)(lds + R_ARB); bf16_t* ARK = (bf16_t*)(lds + R_ARK);
    float* DW = (float*)(lds + R_DW); float* DA = (float*)(lds + R_DA);
    bf16_t* XT = (bf16_t*)(lds + R_XT); bf16_t* TW = (bf16_t*)(lds + R_TW); bf16_t* ADI = (bf16_t*)(lds + R_ADI);
    u32x2* TDF = (u32x2*)(lds + R_TDF); float* CS = (float*)(lds + R_CS); float* GCs = (float*)(lds + R_GC); float* CONST = (float*)(lds + R_CONST); bf16_t* WDL = (bf16_t*)(lds + R_WDL); bf16_t* WIL = (bf16_t*)(lds + R_WIL);
    const int t0_ = tid >> 3, cs0_ = tid & 7;
    int hprev = -1;
    R1Raw raw;
    if (blockIdx.x < 8192) r1_issue(raw, P, BND, blockIdx.x, t0_, cs0_);

    for (int unit = blockIdx.x; unit < 8192; unit += gridDim.x) {
        const int bn = unit >> 4, h = unit & 15, n = bn & 255;
        const size_t R0 = (size_t)bn * 64;
        int tidv = tid; asm volatile("" : "+v"(tidv));
        const int lane = tidv & 63, l15 = lane & 15, g = lane >> 4, q4 = l15 >> 2, p4 = l15 & 3, t = tidv >> 3, cs = tidv & 7, tl = lane >> 3;
        if (h != hprev) {
            LDS_BARRIER();
            if (tid < 64) {
                const int ch = h * 64 + tid;
                CONST[tid] = p.in[10][ch]; CONST[64 + tid] = p.in[10][1024 + ch]; CONST[128 + tid] = p.in[10][2048 + ch];
                CONST[192 + tid] = p.in[11][ch]; CONST[256 + tid] = p.in[13][ch]; CONST[320 + tid] = p.in[15][ch]; CONST[384 + tid] = p.in[16][ch]; CONST[448 + tid] = p.in[17][ch];
                CONST[512 + tid] = p.in[10][4096 + tid]; CONST[576 + tid] = p.in[10][4160 + tid];
            }
            {
                const int rr = tid >> 3, sg = tid & 7;
                *(u32x4*)(WDL + rr * 72 + 8 * sg) = *(const u32x4*)(WduT + (size_t)(h * 64 + rr) * 64 + 8 * sg);
                *(u32x4*)(WIL + rr * 72 + 8 * sg) = *(const u32x4*)(WiuT + (size_t)(h * 64 + rr) * 64 + 8 * sg);
            }
            hprev = h;
            LDS_BARRIER();
        }
        f32x4 r0, r1, k0, k1, v0, v1;
        {
            f32x4 wd0, wd1, ad0, ad1;
            lerp8(raw.r0, raw.r1, CONST + 8 * cs, r0, r1);
            lerp8(raw.k0, raw.k1, CONST + 64 + 8 * cs, k0, k1);
            lerp8(raw.v0, raw.v1, CONST + 128 + 8 * cs, v0, v1);
            lerp8(raw.w0, raw.w1, CONST + 512 + 8 * cs, wd0, wd1);
            lerp8(raw.a0, raw.a1, CONST + 576 + 8 * cs, ad0, ad1);
#pragma unroll
            for (int j = 0; j < 4; ++j) {
                const float e0 = fexp(-2.f * fabsf(wd0[j])), e1 = fexp(-2.f * fabsf(wd1[j]));
                wd0[j] = copysignf((1.f - e0) * fast_rcp(1.f + e0), wd0[j]); wd1[j] = copysignf((1.f - e1) * fast_rcp(1.f + e1), wd1[j]);
            }
            *(u32x4*)(TW + t * 72 + 8 * cs) = pk8(wd0, wd1);
            *(u32x4*)(ADI + t * 72 + 8 * cs) = pk8(ad0, ad1);
        }
        if (unit + (int)gridDim.x < 8192) r1_issue(raw, P, BND, unit + gridDim.x, t, cs);
        LDS_BARRIER();
        {
            const int tt = w & 3;
            bf16x8 ft[2], fa[2];
#pragma unroll
            for (int kk = 0; kk < 2; ++kk) { ft[kk] = ldfrag(TW, 16 * tt + l15, 32 * kk + 8 * g); fa[kk] = ldfrag(ADI, 16 * tt + l15, 32 * kk + 8 * g); }
#pragma unroll
            for (int q = 0; q < 2; ++q) {
                const int ct = 2 * (w >> 2) + q;
                f32x4 aw = (f32x4){0.f, 0.f, 0.f, 0.f}, aa = aw;
#pragma unroll
                for (int kk = 0; kk < 2; ++kk) { aw = mfma16(ldfrag(WDL, 16 * ct + l15, 32 * kk + 8 * g), ft[kk], aw); aa = mfma16(ldfrag(WIL, 16 * ct + l15, 32 * kk + 8 * g), fa[kk], aa); }
                *(f32x4*)(DW + (16 * tt + l15) * 68 + 16 * ct + 4 * g) = aw;
                *(f32x4*)(DA + (16 * tt + l15) * 68 + 16 * ct + 4 * g) = aa;
            }
        }
        LDS_BARRIER();
        f32x4 lw[2], av[2], kk[2], k2[2], G[2];
        {
            const f32x4 cw0[2] = {*(const f32x4*)(CONST + 192 + 8 * cs), *(const f32x4*)(CONST + 196 + 8 * cs)};
            const f32x4 ca0[2] = {*(const f32x4*)(CONST + 256 + 8 * cs), *(const f32x4*)(CONST + 260 + 8 * cs)};
            const f32x4 ckk[2] = {*(const f32x4*)(CONST + 320 + 8 * cs), *(const f32x4*)(CONST + 324 + 8 * cs)};
            const f32x4 cka[2] = {*(const f32x4*)(CONST + 384 + 8 * cs), *(const f32x4*)(CONST + 388 + 8 * cs)};
            const f32x4 crk[2] = {*(const f32x4*)(CONST + 448 + 8 * cs), *(const f32x4*)(CONST + 452 + 8 * cs)};
            const f32x4 dwv[2] = {*(const f32x4*)(DW + t * 68 + 8 * cs), *(const f32x4*)(DW + t * 68 + 8 * cs + 4)};
            const f32x4 dav[2] = {*(const f32x4*)(DA + t * 68 + 8 * cs), *(const f32x4*)(DA + t * 68 + 8 * cs + 4)};
            const f32x4 kin[2] = {k0, k1}, rin[2] = {r0, r1};
            float n2 = 0.f, rk = 0.f;
#pragma unroll
            for (int hf = 0; hf < 2; ++hf)
#pragma unroll
                for (int j = 0; j < 4; ++j) {
                    const float z = -(cw0[hf][j] + dwv[hf][j]);
                    const float sp = fmaxf(z, 0.f) + flog(1.f + fexp(-fabsf(z)));
                    lw[hf][j] = -fexp(-sp - 0.5f);
                    av[hf][j] = fast_rcp(1.f + fexp(-(ca0[hf][j] + dav[hf][j])));
                    kk[hf][j] = kin[hf][j] * ckk[hf][j];
                    k2[hf][j] = kin[hf][j] * (1.f + (av[hf][j] - 1.f) * cka[hf][j]);
                    n2 += kk[hf][j] * kk[hf][j]; rk += rin[hf][j] * k2[hf][j] * crk[hf][j];
                }
            n2 += __shfl_xor(n2, 1); rk += __shfl_xor(rk, 1); n2 += __shfl_xor(n2, 2); rk += __shfl_xor(rk, 2); n2 += __shfl_xor(n2, 4); rk += __shfl_xor(rk, 4);
            const float inv = 1.0f / fmaxf(sqrtf(n2), 1e-12f);
            kk[0] *= inv; kk[1] *= inv;
            if (cs == 0) RK[(R0 + t) * 16 + h] = rk;
            G[0] = lw[0]; G[1] = lw[1];
#pragma unroll
            for (int d = 1; d < 8; d <<= 1)
#pragma unroll
                for (int hf = 0; hf < 2; ++hf)
#pragma unroll
                    for (int j = 0; j < 4; ++j) { const float y = __shfl_up(G[hf][j], 8 * d); if (tl >= d) G[hf][j] += y; }
            if (tl == 7) { *(f32x4*)(CS + w * 64 + 8 * cs) = G[0]; *(f32x4*)(CS + w * 64 + 8 * cs + 4) = G[1]; }
        }
        LDS_BARRIER();
        {
            f32x4 off[2] = {(f32x4){0.f, 0.f, 0.f, 0.f}, (f32x4){0.f, 0.f, 0.f, 0.f}}, gc[2] = {off[0], off[0]};
#pragma unroll
            for (int q = 0; q < 8; ++q) {
                const f32x4 c0 = *(const f32x4*)(CS + q * 64 + 8 * cs), c1 = *(const f32x4*)(CS + q * 64 + 8 * cs + 4);
                const float mk = (q < w) ? 1.f : 0.f;
                gc[0] += c0; gc[1] += c1; off[0] += c0 * mk; off[1] += c1 * mk;
            }
            f32x4 al[2], bh[2], kh[2], rb[2];
            const f32x4 rin[2] = {r0, r1};
#pragma unroll
            for (int hf = 0; hf < 2; ++hf)
#pragma unroll
                for (int j = 0; j < 4; ++j) {
                    const float Gi = G[hf][j] + off[hf][j];
                    const float eG = fexp(Gi), eGm = fexp(Gi - lw[hf][j]), enG = fast_rcp(eG);
                    const float be = kk[hf][j] * av[hf][j];
                    al[hf][j] = -kk[hf][j] * eGm; bh[hf][j] = be * enG; kh[hf][j] = k2[hf][j] * enG; rb[hf][j] = rin[hf][j] * eG;
                }
            const int o = t * 72 + 8 * cs;
            *(u32x4*)(ALB + o) = pk8(al[0], al[1]); *(u32x4*)(BH + o) = pk8(bh[0], bh[1]); *(u32x4*)(KH + o) = pk8(kh[0], kh[1]); *(u32x4*)(RB + o) = pk8(rb[0], rb[1]);
            const u32x4 vpk = pk8(v0, v1);
            *(u32x4*)(VI + o) = vpk;
            *(u32x4*)(Ybuf + (R0 + t) * DM + h * 64 + 8 * cs) = vpk;
            if (w == 0 && tl == 0) { f32x4 e0, e1;
#pragma unroll
                for (int j = 0; j < 4; ++j) { e0[j] = fexp(gc[0][j]); e1[j] = fexp(gc[1][j]); }
                *(f32x4*)(GCs + 8 * cs) = e0; *(f32x4*)(GCs + 8 * cs + 4) = e1; }
        }
        LDS_BARRIER();
        {
            int ntile = 1, tta = 0, sta = 0, ttb = 0, stb = 0;
            if (w == 0) { tta = 0; sta = 0; } else if (w == 2) { tta = 1; sta = 1; } else if (w == 5) { tta = 2; sta = 2; } else if (w == 7) { tta = 3; sta = 3; }
            else if (w == 1) { ntile = 2; tta = 1; sta = 0; ttb = 2; stb = 0; } else if (w == 3) { ntile = 2; tta = 2; sta = 1; ttb = 3; stb = 0; }
            else if (w == 4) { tta = 3; sta = 1; } else { tta = 3; sta = 2; }
            for (int it = 0; it < ntile; ++it) {
                const int tt = it ? ttb : tta, st = it ? stb : sta;
                f32x4 cab = (f32x4){0.f, 0.f, 0.f, 0.f}, cak = cab, crb = cab, crk = cab, nab = cab;
#pragma unroll
                for (int kq = 0; kq < 2; ++kq) {
                    const bf16x8 fb = ldfrag(BH, 16 * st + l15, 32 * kq + 8 * g), fk = ldfrag(KH, 16 * st + l15, 32 * kq + 8 * g);
                    const bf16x8 fa = ldfrag(ALB, 16 * tt + l15, 32 * kq + 8 * g), fr = ldfrag(RB, 16 * tt + l15, 32 * kq + 8 * g);
                    cab = mfma16(fb, fa, cab); cak = mfma16(fk, fa, cak); crb = mfma16(fb, fr, crb); crk = mfma16(fk, fr, crk);
                    if (tt == st) nab = mfma16(fa, fb, nab);
                }
                if (tt == st) {
#pragma unroll
                    for (int r = 0; r < 4; ++r) {
                        const int s = 4 * g + r, tq = l15;
                        if (s >= tq) { cab[r] = 0.f; cak[r] = 0.f; }
                        if (s > tq) { crb[r] = 0.f; crk[r] = 0.f; }
                        if (l15 >= 4 * g + r) nab[r] = 0.f;
                    }
                }
                const int o = (16 * tt + l15) * 72 + 16 * st + 4 * g;
                *(u32x2*)(AAB + o) = pk4(cab); *(u32x2*)(AAK + o) = pk4(cak); *(u32x2*)(ARB + o) = pk4(crb); *(u32x2*)(ARK + o) = pk4(crk);
                if (tt == st) {
                    const f32x4 z = (f32x4){0.f, 0.f, 0.f, 0.f};
                    const f32x4 Q1 = cab, N1 = nab;
                    const f32x4 Q2 = mm16(N1, Q1, z), N2 = mm16(Q1, N1, z);
                    f32x4 Pm = Q1;
#pragma unroll
                    for (int r = 0; r < 4; ++r) if (4 * g + r == l15) Pm[r] += 1.f;
                    Pm = mm16(N2, Pm, Pm);
                    const f32x4 Q4 = mm16(N2, Q2, z), N4 = mm16(Q2, N2, z);
                    Pm = mm16(N4, Pm, Pm);
                    const f32x4 N8 = mm16(Q4, N4, z);
                    Pm = mm16(N8, Pm, Pm);
                    TDF[tt * 64 + lane] = pk4(Pm);
                }
            }
            if (w == 4 || w == 6) {
                const int tt = (w == 4) ? 0 : 2, st = tt + 1;
                const int o = (16 * tt + l15) * 72 + 16 * st + 4 * g;
                const u32x2 zz = (u32x2){0u, 0u};
                *(u32x2*)(AAK + o) = zz; *(u32x2*)(ARB + o) = zz; *(u32x2*)(ARK + o) = zz;
            }
        }
        LDS_BARRIER();
        {
            u32x2 xb[4];
            const int col = 16 * w + l15;
            bf16x8 vfr[2];
            if (w >= 4) { vfr[0] = trfrag(VI, 0, 16 * (w - 4), g, q4, p4); vfr[1] = trfrag(VI, 32, 16 * (w - 4), g, q4, p4); }
#pragma unroll
            for (int i = 0; i < 4; ++i) {
                f32x4 z;
                if (w < 4) z = unpk4(trread(ALB + (16 * i + 4 * g + q4) * 72 + 16 * w + 4 * p4));
                else {
                    z = mfma16(ldfrag(AAK, 16 * i + l15, 8 * g), vfr[0], (f32x4){0.f, 0.f, 0.f, 0.f});
                    if (i >= 2) z = mfma16(ldfrag(AAK, 16 * i + l15, 32 + 8 * g), vfr[1], z);
                }
                if (i >= 1) {
                    const bf16_t* ar = AAB + (16 * i + l15) * 72 + 4 * g;
                    const u32x2 a0 = *(const u32x2*)ar;
                    u32x2 a1 = (u32x2){0u, 0u}, b1 = (u32x2){0u, 0u};
                    if (i >= 2) { a1 = *(const u32x2*)(ar + 16); b1 = xb[1]; }
                    z = mfma16(as_bf16x8((u32x4){a0.x, a0.y, a1.x, a1.y}), as_bf16x8((u32x4){xb[0].x, xb[0].y, b1.x, b1.y}), z);
                    if (i == 3) {
                        const u32x2 a2 = *(const u32x2*)(ar + 32);
                        z = mfma16(as_bf16x8((u32x4){a2.x, a2.y, 0u, 0u}), as_bf16x8((u32x4){xb[2].x, xb[2].y, 0u, 0u}), z);
                    }
                }
                const u32x2 tq = TDF[i * 64 + lane];
                const u32x2 zq = pk4(z);
                const f32x4 x = mfma16(as_bf16x8((u32x4){tq.x, tq.y, 0u, 0u}), as_bf16x8((u32x4){zq.x, zq.y, 0u, 0u}), (f32x4){0.f, 0.f, 0.f, 0.f});
                xb[i] = pk4(x);
                *(u32x2*)(XT + col * 72 + 16 * i + 4 * g) = xb[i];
            }
        }
        LDS_BARRIER();
        {
            const int rt_ = w & 3, c0 = 2 * (w >> 2);
            bf16x8 xw[2], xu[2], fbt[2], fkt[2], fvr[2];
#pragma unroll
            for (int kq = 0; kq < 2; ++kq) {
                xw[kq] = ldfrag(XT, 16 * rt_ + l15, 32 * kq + 8 * g);
                xu[kq] = ldfrag(XT, 64 + 16 * rt_ + l15, 32 * kq + 8 * g);
                fbt[kq] = trfrag(BH, 32 * kq, 16 * rt_, g, q4, p4);
                fkt[kq] = trfrag(KH, 32 * kq, 16 * rt_, g, q4, p4);
                fvr[kq] = trfrag(VI, 32 * kq, 16 * rt_, g, q4, p4);
            }
            const float gcd0 = GCs[16 * c0 + l15], gcd1 = GCs[16 * c0 + 16 + l15];
            const f32x4 gcr = *(const f32x4*)(GCs + 16 * rt_ + 4 * g);
#pragma unroll
            for (int q = 0; q < 2; ++q) {
                bf16x8 gbt[2], garb[2], gxu[2], gvi[2], gark[2];
#pragma unroll
                for (int kq = 0; kq < 2; ++kq) {
                    gbt[kq] = trfrag(BH, 32 * kq, 16 * (c0 + q), g, q4, p4);
                    garb[kq] = ldfrag(ARB, 16 * (c0 + q) + l15, 32 * kq + 8 * g);
                    gxu[kq] = ldfrag(XT, 64 + 16 * (c0 + q) + l15, 32 * kq + 8 * g);
                    gvi[kq] = trfrag(VI, 32 * kq, 16 * (c0 + q), g, q4, p4);
                    gark[kq] = ldfrag(ARK, 16 * (c0 + q) + l15, 32 * kq + 8 * g);
                }
                const u32x2 rbi = *(const u32x2*)(RB + (16 * (c0 + q) + l15) * 72 + 16 * rt_ + 4 * g);
                __builtin_amdgcn_sched_barrier(0);
                const int ctile = c0 + q;
                {
                    f32x4 acc = (f32x4){0.f, 0.f, 0.f, 0.f};
#pragma unroll
                    for (int kq = 0; kq < 2; ++kq) acc = mfma16(xw[kq], gbt[kq], acc);
                    const int dcol = 16 * ctile + l15;
                    if (rt_ == ctile) {
#pragma unroll
                        for (int r = 0; r < 4; ++r) if (4 * g + r == l15) acc[r] += 1.f;
                    }
                    acc *= (q ? gcd1 : gcd0);
                    *(u32x2*)(ALB + dcol * 72 + 32 * (rt_ >> 1) + 8 * g + 4 * (rt_ & 1)) = pk4(acc);
                }
                {
                    f32x4 acc = unpk4(rbi);
#pragma unroll
                    for (int kq = 0; kq < 2; ++kq) {
                        if (32 * kq <= 16 * ctile + 15) acc = mfma16(xw[kq], garb[kq], acc);
                    }
                    *(u32x2*)(BTL + (16 * ctile + l15) * 72 + 16 * rt_ + 4 * g) = pk4(acc);
                }
                {
                    f32x4 acc = (f32x4){0.f, 0.f, 0.f, 0.f};
#pragma unroll
                    for (int kq = 0; kq < 2; ++kq) { acc = mfma16(fbt[kq], gxu[kq], acc); acc = mfma16(fkt[kq], gvi[kq], acc); }
                    *(u32x2*)(KTL + (16 * ctile + l15) * 72 + 16 * rt_ + 4 * g) = pk4(acc * gcr);
                }
                {
                    f32x4 acc = (f32x4){0.f, 0.f, 0.f, 0.f};
#pragma unroll
                    for (int kq = 0; kq < 2; ++kq) {
                        if (32 * kq <= 16 * ctile + 15) { acc = mfma16(xu[kq], garb[kq], acc); acc = mfma16(fvr[kq], gark[kq], acc); }
                    }
                    *(u32x2*)(AAB + (16 * ctile + l15) * 72 + 16 * rt_ + 4 * g) = pk4(acc);
                }
            }
        }
        LDS_BARRIER();
        {
            const int o = t * 72 + 8 * cs;
            *(u32x4*)(P + (R0 + t) * PP + h * 64 + 8 * cs) = *(const u32x4*)(ALB + o);
            *(u32x4*)(P + (R0 + t) * PP + 1024 + h * 64 + 8 * cs) = *(const u32x4*)(BTL + o);
            *(u32x4*)(P + (R0 + t) * PP + 2048 + h * 64 + 8 * cs) = *(const u32x4*)(KTL + o);
            *(u32x4*)(Abuf + (R0 + t) * DM + h * 64 + 8 * cs) = *(const u32x4*)(AAB + o);
        }
    }
}

constexpr int SC_SLOT = 2 * IMG;
constexpr size_t WS_MG = (WS_BND + (size_t)513 * PP * 2 + 255) & ~(size_t)255;
constexpr size_t WS_NG = WS_MG + (size_t)1024 * 4096 * 2;
static_assert(WS_NG + (size_t)1024 * 4096 * 2 <= WS_GD, "scan buffers must fit the GLA state region");

template <int MODE>
__device__ void rwkv_scan2(const Params& p, unsigned char* lds) {
    constexpr int GSZ = 32, NGRP = 256 / GSZ, LG = 3;
    constexpr int SPU = (MODE == 2) ? NGRP : GSZ;
    constexpr int NU = (MODE == 2) ? 32 : 32 * NGRP;
    const int tid = threadIdx.x, lane = tid & 63, w = __builtin_amdgcn_readfirstlane(tid >> 6), l15 = lane & 15, g = lane >> 4;
    bf16_t* P = (bf16_t*)(p.ws + WS_P);
    bf16_t* MG = (bf16_t*)(p.ws + WS_MG); bf16_t* NG = (bf16_t*)(p.ws + WS_NG); bf16_t* HG = NG;
    const int G = gridDim.x;
    const int nun = ((int)blockIdx.x < NU) ? (NU - 1 - (int)blockIdx.x) / G + 1 : 0;
    const int T = nun * SPU;
    if (T == 0) return;
#define SC_SRC(s, p0, p1, pitchb) \
    const int u_ = (int)blockIdx.x + G * ((s) / SPU), j_ = (s) % SPU; \
    const char* p0; const char* p1; unsigned pitchb; \
    if (MODE == 2) { p0 = (const char*)(MG + (size_t)(u_ * NGRP + j_) * 4096); p1 = (const char*)(NG + (size_t)(u_ * NGRP + j_) * 4096); pitchb = 128u; } \
    else { const int bh_ = u_ >> LG, n_ = GSZ * (u_ & (NGRP - 1)) + j_; p0 = (const char*)(P + ((size_t)(bh_ >> 4) * SEQ + (size_t)n_ * 64) * PP + (bh_ & 15) * 64); p1 = p0 + 4096; pitchb = (unsigned)(PP * 2); }
    if (w >= 4) {
        const int lj = w - 4;
        const unsigned loff = (unsigned)((lane >> 3) * 144 + (lane & 7) * 16);
        u32x4 ld0[16], ld1[16];
#define SC_ISSUE(dst, s) do { const int sc_ = ((s) < T) ? (s) : T - 1; SC_SRC(sc_, q0_, q1_, pb_) const unsigned go_ = (unsigned)(lane >> 3) * pb_ + (unsigned)(lane & 7) * 16u; \
        _Pragma("unroll") for (int q = 0; q < 16; ++q) dst[q] = *(const u32x4*)(((q >> 3) ? q1_ : q0_) + (size_t)((q & 7) * 8) * pb_ + go_); } while (0)
#define SC_RETIRE(src, s) do { unsigned char* sb = lds + ((s) & 1) * SC_SLOT + loff; _Pragma("unroll") for (int q = 0; q < 16; ++q) \
        *(u32x4*)(sb + (q >> 3) * IMG + (q & 7) * 8 * 144) = src[q]; } while (0)
        SC_ISSUE(ld0, lj); SC_ISSUE(ld1, lj + 4);
        for (int it = 0; it < T / 8; ++it) {
            const int c0 = lj + 8 * it;
            for (int k = 0; k < lj; ++k) LDS_BARRIER();
            SC_RETIRE(ld0, c0); SC_ISSUE(ld0, c0 + 8);
            for (int k = 0; k < 4; ++k) LDS_BARRIER();
            SC_RETIRE(ld1, c0 + 4); SC_ISSUE(ld1, c0 + 12);
            for (int k = 0; k < 4 - lj; ++k) LDS_BARRIER();
        }
        LDS_BARRIER();
#undef SC_ISSUE
#undef SC_RETIRE
    } else {
        f32x4 H[4], Mg[4];
        for (int i = 0; i <= T; ++i) {
            if (i >= 1) {
                const int s = i - 1, u = (int)blockIdx.x + G * (s / SPU), j = s % SPU;
                const unsigned char* sb = lds + (s & 1) * SC_SLOT;
                const bf16_t* MT = (const bf16_t*)sb; const bf16_t* NT = (const bf16_t*)(sb + IMG);
                if (j == 0) {
                    if (MODE == 3) {
#pragma unroll
                        for (int mt = 0; mt < 4; ++mt) H[mt] = unpk4(*(const u32x2*)(HG + (size_t)u * 4096 + (16 * w + l15) * 64 + 16 * mt + 4 * g));
                    } else {
#pragma unroll
                        for (int mt = 0; mt < 4; ++mt) H[mt] = (f32x4){0.f, 0.f, 0.f, 0.f};
                    }
                    if (MODE == 1) {
#pragma unroll
                        for (int mt = 0; mt < 4; ++mt)
#pragma unroll
                            for (int r = 0; r < 4; ++r) Mg[mt][r] = (16 * mt + 4 * g + r == 16 * w + l15) ? 1.f : 0.f;
                    }
                }
                u32x2 hp[4];
#pragma unroll
                for (int mt = 0; mt < 4; ++mt) hp[mt] = pk4(H[mt]);
                if (MODE == 2) {
#pragma unroll
                    for (int mt = 0; mt < 4; ++mt) *(u32x2*)(HG + (size_t)(u * NGRP + j) * 4096 + (16 * w + l15) * 64 + 16 * mt + 4 * g) = hp[mt];
                }
                if (MODE == 3) {
                    const int bh = u >> LG, n = GSZ * (u & (NGRP - 1)) + j;
#pragma unroll
                    for (int mt = 0; mt < 4; ++mt) *(u32x2*)(P + ((size_t)(bh >> 4) * SEQ + (size_t)n * 64 + 16 * w + l15) * PP + 2048 + (bh & 15) * 64 + 16 * mt + 4 * g) = hp[mt];
                }
                bf16x8 hb[2], mb[2];
                hb[0] = as_bf16x8((u32x4){hp[0].x, hp[0].y, hp[1].x, hp[1].y});
                hb[1] = as_bf16x8((u32x4){hp[2].x, hp[2].y, hp[3].x, hp[3].y});
                if (MODE == 1) {
                    const u32x2 m0 = pk4(Mg[0]), m1 = pk4(Mg[1]), m2 = pk4(Mg[2]), m3 = pk4(Mg[3]);
                    mb[0] = as_bf16x8((u32x4){m0.x, m0.y, m1.x, m1.y}); mb[1] = as_bf16x8((u32x4){m2.x, m2.y, m3.x, m3.y});
                }
#pragma unroll
                for (int mt = 0; mt < 4; ++mt) {
                    const bf16x8 a0 = ldfrag(MT, 16 * mt + l15, 8 * g), a1 = ldfrag(MT, 16 * mt + l15, 32 + 8 * g);
                    f32x4 acc = unpk4(*(const u32x2*)(NT + (16 * w + l15) * 72 + 16 * mt + 4 * g));
                    acc = mfma16(a0, hb[0], acc); acc = mfma16(a1, hb[1], acc);
                    H[mt] = acc;
                    if (MODE == 1) { f32x4 am = mfma16(a0, mb[0], (f32x4){0.f, 0.f, 0.f, 0.f}); am = mfma16(a1, mb[1], am); Mg[mt] = am; }
                }
                if (MODE == 1 && j == SPU - 1) {
                    const int pc = 32 * (w >> 1) + 8 * (l15 >> 2) + 4 * (w & 1) + (l15 & 3);
#pragma unroll
                    for (int mt = 0; mt < 4; ++mt) {
                        *(u32x2*)(NG + (size_t)u * 4096 + (16 * w + l15) * 64 + 16 * mt + 4 * g) = pk4(H[mt]);
#pragma unroll
                        for (int r = 0; r < 4; ++r) MG[(size_t)u * 4096 + (16 * mt + 4 * g + r) * 64 + pc] = f2bf(Mg[mt][r]);
                    }
                }
            }
            LDS_BARRIER();
        }
    }
#undef SC_SRC
}

__device__ void rwkv_post(const Params& p, unsigned char* lds) {
    const int tid = threadIdx.x, lane = tid & 63, w = __builtin_amdgcn_readfirstlane(tid >> 6), l15 = lane & 15, g = lane >> 4;
    const bf16_t* P = (const bf16_t*)(p.ws + WS_P);
    bf16_t* Abuf = (bf16_t*)(p.ws + WS_A);
    const bf16_t* Ybuf = (const bf16_t*)(p.ws + WS_Y);
    const float* RK = (const float*)(p.ws + WS_RK);
    const bf16_t* BND = (const bf16_t*)(p.ws + WS_BND);
    float* L = (float*)(lds + w * 8704);
    const int tr = lane >> 3, seg = lane & 7;
    for (int hu = blockIdx.x * 8 + w; hu < 16384; hu += gridDim.x * 8) {
        const int unit = hu >> 1, t0 = (hu & 1) * 32;
        const int bn = unit >> 4, h = unit & 15, n = bn & 255;
        const size_t R0 = (size_t)bn * 64;
        bf16x8 fh[4][2], fr[2][2];
#pragma unroll
        for (int kk = 0; kk < 2; ++kk) {
#pragma unroll
            for (int q = 0; q < 4; ++q) fh[q][kk] = *(const bf16x8*)(P + (R0 + 16 * q + l15) * PP + 2048 + h * 64 + 32 * kk + 8 * g);
#pragma unroll
            for (int q = 0; q < 2; ++q) fr[q][kk] = *(const bf16x8*)(P + (R0 + t0 + 16 * q + l15) * PP + 1024 + h * 64 + 32 * kk + 8 * g);
        }
        u32x4 y0r[4], g1r[4], g0r[4], vpr[4];
        float rkv[4];
#pragma unroll
        for (int i = 0; i < 4; ++i) {
            const int t = t0 + tr + 8 * i;
            y0r[i] = *(const u32x4*)(Abuf + (R0 + t) * DM + h * 64 + 8 * seg);
            const bf16_t* grow = P + (R0 + t) * PP + 3072 + h * 64 + 8 * seg;
            g1r[i] = *(const u32x4*)grow;
            g0r[i] = *(const u32x4*)((t > 0) ? (grow - PP) : (BND + (size_t)(n == 0 ? 0 : bn) * PP + 3072 + h * 64 + 8 * seg));
            vpr[i] = *(const u32x4*)(Ybuf + (R0 + t) * DM + h * 64 + 8 * seg);
            rkv[i] = RK[(R0 + t) * 16 + h];
        }
#pragma unroll
        for (int i = 0; i < 4; ++i) { *(f32x4*)(L + (tr + 8 * i) * 68 + 8 * seg) = lo4(y0r[i]); *(f32x4*)(L + (tr + 8 * i) * 68 + 8 * seg + 4) = hi4(y0r[i]); }
        f32x4 y[4][2];
#pragma unroll
        for (int vt = 0; vt < 4; ++vt)
#pragma unroll
            for (int tt = 0; tt < 2; ++tt) y[vt][tt] = *(const f32x4*)(L + (16 * tt + l15) * 68 + 16 * vt + 4 * g);
#pragma unroll
        for (int vt = 0; vt < 4; ++vt)
#pragma unroll
            for (int tt = 0; tt < 2; ++tt)
#pragma unroll
                for (int kk = 0; kk < 2; ++kk) y[vt][tt] = mfma16(fh[vt][kk], fr[tt][kk], y[vt][tt]);
#pragma unroll
        for (int tt = 0; tt < 2; ++tt) {
            float s1 = 0.f, s2 = 0.f;
#pragma unroll
            for (int vt = 0; vt < 4; ++vt)
#pragma unroll
                for (int r = 0; r < 4; ++r) { s1 += y[vt][tt][r]; s2 += y[vt][tt][r] * y[vt][tt][r]; }
            s1 += __shfl_xor(s1, 16); s2 += __shfl_xor(s2, 16); s1 += __shfl_xor(s1, 32); s2 += __shfl_xor(s2, 32);
            const float mean = s1 * (1.0f / 64.0f);
            const float rstd = rsqrtf(fmaxf(s2 * (1.0f / 64.0f) - mean * mean, 0.f) + 64e-5f);
#pragma unroll
            for (int vt = 0; vt < 4; ++vt) *(f32x4*)(L + (16 * tt + l15) * 68 + 16 * vt + 4 * g) = (y[vt][tt] - mean) * rstd;
        }
        const int ch = h * 64 + 8 * seg;
        const f32x4 lw0 = *(const f32x4*)(p.in[18] + ch), lw1 = *(const f32x4*)(p.in[18] + ch + 4), lb0 = *(const f32x4*)(p.in[19] + ch), lb1 = *(const f32x4*)(p.in[19] + ch + 4);
        const f32x4 mg0 = *(const f32x4*)(p.in[10] + 3072 + ch), mg1 = *(const f32x4*)(p.in[10] + 3072 + ch + 4);
#pragma unroll
        for (int i = 0; i < 4; ++i) {
            const int t = t0 + tr + 8 * i;
            const f32x4 n0 = *(const f32x4*)(L + (tr + 8 * i) * 68 + 8 * seg), n1 = *(const f32x4*)(L + (tr + 8 * i) * 68 + 8 * seg + 4);
            const f32x4 ga0 = lo4(g1r[i]), ga1 = hi4(g1r[i]);
            const f32x4 gb0 = lo4(g0r[i]), gb1 = hi4(g0r[i]);
            const f32x4 gt0 = ga0 + mg0 * (gb0 - ga0), gt1 = ga1 + mg1 * (gb1 - ga1);
            const f32x4 v0 = lo4(vpr[i]), v1 = hi4(vpr[i]);
            f32x4 o0 = n0 * lw0 + lb0 + rkv[i] * v0, o1 = n1 * lw1 + lb1 + rkv[i] * v1;
#pragma unroll
            for (int j = 0; j < 4; ++j) { o0[j] *= gt0[j] * __builtin_amdgcn_rcpf(1.0f + fexp(-gt0[j])); o1[j] *= gt1[j] * __builtin_amdgcn_rcpf(1.0f + fexp(-gt1[j])); }
            *(u32x4*)(Abuf + (R0 + t) * DM + h * 64 + 8 * seg) = pk8(o0, o1);
        }
    }
}
#define XB_TMO      128
#define XB_XCNT(j)  (256  + 64 * (j))
#define XB_XSUB(j)  (1280 + 64 * (j))
#define XB_XGEN(j)  (2304 + 64 * (j))
#define XB_TOP      3328
#define XB_TOPGEN   3392
#define XCD_BAR_WORDS 3456
#define XB_SPIN_CAP (1u << 18)
#define LAS __attribute__((address_space(3)))

__device__ __forceinline__ unsigned xb_ld(unsigned* p)              { return __hip_atomic_load(p, __ATOMIC_RELAXED, __HIP_MEMORY_SCOPE_AGENT); }
__device__ __forceinline__ unsigned xb_add(unsigned* p, unsigned v) { return __hip_atomic_fetch_add(p, v, __ATOMIC_RELAXED, __HIP_MEMORY_SCOPE_AGENT); }
__device__ __forceinline__ unsigned xb_xcc_id() { return (unsigned)__builtin_amdgcn_s_getreg((3 << 11) | 20) & 0xFu; }
#define XB_SPIN(cond, bar) do { unsigned _sp = 0; while (cond) { __builtin_amdgcn_s_sleep(1); \
    if ((++_sp & 255u) == 0u) { if (xb_ld(&(bar)[XB_TMO])) break; if (_sp > XB_SPIN_CAP) { atomicAdd(&(bar)[XB_TMO], 1u); break; } } } } while (0)

struct XcdBarrier {
    unsigned* bar; unsigned x;
    volatile LAS unsigned* st;
};

__device__ __forceinline__ XcdBarrier xcd_barrier_post(unsigned* bar, volatile LAS unsigned* st) {
    XcdBarrier b; b.bar = bar; b.x = xb_xcc_id(); b.st = st;
    if (threadIdx.x == 0) (void)xb_add(&bar[XB_XCNT(b.x)], 1u);
    return b;
}
__device__ __forceinline__ void xcd_barrier_complete(unsigned* bar, unsigned x, unsigned& nloc, unsigned& nx) {
    const unsigned G = gridDim.x * gridDim.y * gridDim.z;
    unsigned sum, cnt, mine, sp = 0u;
    for (;;) {
        sum = 0u; cnt = 0u; mine = 0u;
#pragma unroll
        for (unsigned j = 0; j < 16; ++j) { const unsigned c = xb_ld(&bar[XB_XCNT(j)]); sum += c; cnt += (c > 0u) ? 1u : 0u; mine = (j == x) ? c : mine; }
        if (sum == G) break;
        __builtin_amdgcn_s_sleep(1);
        if ((++sp & 255u) == 0u) { if (xb_ld(&bar[XB_TMO])) break; if (sp > XB_SPIN_CAP) { atomicAdd(&bar[XB_TMO], 1u); break; } }
    }
    nloc = mine > 0u ? mine : 1u; nx = cnt > 0u ? cnt : 1u;
}

__device__ __forceinline__ void xcd_barrier(const XcdBarrier& b) {
    asm volatile("s_waitcnt vmcnt(0)" ::: "memory");
    __syncthreads();
    if (threadIdx.x == 0) {
        unsigned* bar = b.bar;
        __builtin_amdgcn_s_waitcnt(0);
        unsigned nloc = b.st[0], nx = b.st[1];
        if (nloc == 0u) { xcd_barrier_complete(bar, b.x, nloc, nx); b.st[0] = nloc; b.st[1] = nx; }
        const unsigned old = xb_add(&bar[XB_XSUB(b.x)], 1u);
        const unsigned gen = old / nloc;
        if (old + 1u == (gen + 1u) * nloc) {
            __builtin_amdgcn_fence(__ATOMIC_RELEASE, "agent");
            asm volatile("s_waitcnt vmcnt(0)" ::: "memory");
            const unsigned og = xb_add(&bar[XB_TOP], 1u);
            const unsigned tg = og / nx;
            if (og + 1u == (tg + 1u) * nx) xb_add(&bar[XB_TOPGEN], 1u);
            else XB_SPIN(xb_ld(&bar[XB_TOPGEN]) == tg, bar);
            __builtin_amdgcn_fence(__ATOMIC_ACQUIRE, "agent");
            xb_add(&bar[XB_XGEN(b.x)], 1u);
            asm volatile("s_waitcnt vmcnt(0)" ::: "memory");
        } else {
            XB_SPIN(xb_ld(&bar[XB_XGEN(b.x)]) == gen, bar);
            __builtin_amdgcn_fence(__ATOMIC_ACQUIRE, "agent");
            asm volatile("s_waitcnt vmcnt(0)" ::: "memory");
        }
    }
    __syncthreads();
}


#ifndef PROBE_ID
#define PROBE_ID 0
#endif
#ifndef N_LAUNCH_MODE
#define N_LAUNCH_MODE 1
#endif
constexpr int N_PHASES = 15;

__global__ void __launch_bounds__(NTH, 2) fwd_kernel(Params p) {
    extern __shared__ __attribute__((aligned(16))) unsigned char lds[];
    const int lo = p.ph_lo, hi = p.ph_hi;
    volatile LAS unsigned* xst = (volatile LAS unsigned*)(lds + LDS_BYTES);
    if (threadIdx.x < 4) xst[threadIdx.x] = 0u;
    __syncthreads();
    const XcdBarrier xbar = xcd_barrier_post((unsigned*)(p.ws + WS_BAR), xst);
    unsigned char* ws = p.ws;
#define IN(k) (lo <= (k) && (k) < hi)
#define SEAM(k) do { if ((k) + 1 < hi) xcd_barrier(xbar); } while (0)
    if (IN(0)) {
        prep_weight(p.in[2], GIN, p.in[1], (bf16_t*)(ws + WS_WGIN), GIN_P, (float*)lds);
        prep_weight(p.in[6], DM, nullptr, (bf16_t*)(ws + WS_WGOUT), DM, (float*)lds);
        prep_wup(p.in[3], (bf16_t*)(ws + WS_WUPT));
        __syncthreads();
        phase_norm0(p, lds);
        SEAM(0);
    }
    if (IN(1)) {
        pg8::Gemm g{(const bf16_t*)(ws + WS_A), (const bf16_t*)(ws + WS_WGIN), MTOK, GIN_P, DM}; pg8::StaticOrder S; S.init(MTOK, GIN_P, gridDim.x, blockIdx.x);
        pg8::EpiBf16<0> E{(bf16_t*)(ws + WS_P), GIN_P, nullptr, 0, 0};
        pg8::gemm_phase<pg8::EpiBf16<0>, pg8::StaticOrder>((PG8_LAS unsigned char*)lds, g, S, E);
        SEAM(1);
    }
    if (IN(2)) { gla_pass<false>(p, lds); SEAM(2); }
    if (IN(3)) {
        gla_scan(p);
        prep_weight(p.in[9], RIN, p.in[8], (bf16_t*)(ws + WS_WRIN), RIN_P, (float*)lds);
        prep_weight(p.in[20], DM, nullptr, (bf16_t*)(ws + WS_WROUT), DM, (float*)lds);
        prep_lowrank(p.in[12], (bf16_t*)(ws + WS_WDUT));
        prep_lowrank(p.in[14], (bf16_t*)(ws + WS_WIUT));
        SEAM(3);
    }
    if (IN(4)) { gla_pass<true>(p, lds); SEAM(4); }
    if (IN(5)) {
        pg8::Gemm g{(const bf16_t*)(ws + WS_A), (const bf16_t*)(ws + WS_WGOUT), MTOK, DM, DM}; pg8::StaticOrder S; S.init(MTOK, DM, gridDim.x, blockIdx.x);
        pg8::EpiBf16<0> E{(bf16_t*)(ws + WS_Y), DM, nullptr, 0, 0};
        pg8::gemm_phase<pg8::EpiBf16<0>, pg8::StaticOrder>((PG8_LAS unsigned char*)lds, g, S, E);
        SEAM(5);
    }
    if (IN(6)) { phase_norm1(p); zero_bnd_row((bf16_t*)(ws + WS_BND)); SEAM(6); }
    if (IN(7)) {
        pg8::Gemm g{(const bf16_t*)(ws + WS_A), (const bf16_t*)(ws + WS_WRIN), MTOK, RIN_P, DM}; pg8::StaticOrder S; S.init(MTOK, RIN_P, gridDim.x, blockIdx.x);
        EpiBf16Bnd E{(bf16_t*)(ws + WS_P), RIN_P, (bf16_t*)(ws + WS_BND)};
        pg8::gemm_phase<EpiBf16Bnd, pg8::StaticOrder>((PG8_LAS unsigned char*)lds, g, S, E);
        SEAM(7);
    }
    if (IN(8)) { rwkv_r1(p, lds); SEAM(8); }
    if (IN(9)) { rwkv_scan2<1>(p, lds); SEAM(9); }
    if (IN(10)) { rwkv_scan2<2>(p, lds); SEAM(10); }
    if (IN(11)) { rwkv_scan2<3>(p, lds); SEAM(11); }
    if (IN(12)) { rwkv_post(p, lds); SEAM(12); }
    if (IN(13)) {
        pg8::Gemm g{(const bf16_t*)(ws + WS_A), (const bf16_t*)(ws + WS_WROUT), MTOK, DM, DM}; pg8::StaticOrder S; S.init(MTOK, DM, gridDim.x, blockIdx.x);
        pg8::EpiBf16<0> E{(bf16_t*)(ws + WS_Y), DM, nullptr, 0, 0};
        pg8::gemm_phase<pg8::EpiBf16<0>, pg8::StaticOrder>((PG8_LAS unsigned char*)lds, g, S, E);
        SEAM(13);
    }
    if (IN(14)) { phase_final(p); }
#undef IN
#undef SEAM
}

extern "C" void kernel_launch(void* const* d_in, const int* in_sizes, int n_in, void* d_out, int out_size, void* d_ws, size_t ws_size, hipStream_t stream) {
    static int grid = 0;
    if (grid == 0) {
        int dev = 0, cus = 0, per_cu = 0;
        hipGetDevice(&dev);
        hipDeviceGetAttribute(&cus, hipDeviceAttributeMultiprocessorCount, dev);
        hipFuncSetAttribute((const void*)fwd_kernel, hipFuncAttributeMaxDynamicSharedMemorySize, LDS_BYTES + 16);
        hipOccupancyMaxActiveBlocksPerMultiprocessor(&per_cu, (const void*)fwd_kernel, NTH, LDS_BYTES + 16);
        if (per_cu < 1) { fprintf(stderr, "kernel_launch: occupancy query says %d blocks per CU\n", per_cu); per_cu = 1; }
        grid = cus;
        if (n_in != 22 || ws_size < WS_END) fprintf(stderr, "kernel_launch: unexpected n_in %d or workspace %zu < %zu\n", n_in, ws_size, (size_t)WS_END);
        (void)hipGetLastError();
    }
    if (hipMemsetAsync((char*)d_ws + WS_BAR, 0, XCD_BAR_WORDS * 4, stream) != hipSuccess) fprintf(stderr, "kernel_launch: memset of the barrier words failed\n");
    Params p{};
    for (int i = 0; i < 22; ++i) p.in[i] = (const float*)d_in[i];
    p.out = (float*)d_out; p.ws = (unsigned char*)d_ws;
#if N_LAUNCH_MODE == 1
    void* args[] = {&p};
#if PROBE_ID > 0
    p.ph_lo = 0; p.ph_hi = PROBE_ID;
    (void)hipLaunchCooperativeKernel((const void*)fwd_kernel, dim3(grid), dim3(NTH), args, LDS_BYTES + 16, stream);
    (void)hipMemsetAsync((char*)d_ws + WS_BAR, 0, XCD_BAR_WORDS * 4, stream);
#endif
    p.ph_lo = 0; p.ph_hi = N_PHASES;
    hipError_t e = hipLaunchCooperativeKernel((const void*)fwd_kernel, dim3(grid), dim3(NTH), args, LDS_BYTES + 16, stream);
    if (e != hipSuccess) fprintf(stderr, "cooperative launch failed: %s (grid %d)\n", hipGetErrorString(e), grid);
#else
    for (int k = 0; k < N_PHASES; ++k) {
        p.ph_lo = k; p.ph_hi = k + 1;
        hipLaunchKernelGGL(fwd_kernel, dim3(grid), dim3(NTH), LDS_BYTES + 16, stream, p);
    }
#endif
}
```

```cpp
#include <hip/hip_runtime.h>
#include <hip/hip_cooperative_groups.h>
#include <cstdio>
namespace cg = cooperative_groups;
#define PROBE_ID 0
#define N_LAUNCH_MODE 1
namespace pg8 {
#define PG8_LAS __attribute__((address_space(3)))
typedef unsigned short bf16_t;
typedef short bf16x8 __attribute__((ext_vector_type(8)));
typedef float f32x4 __attribute__((ext_vector_type(4)));
typedef unsigned u32x4 __attribute__((ext_vector_type(4)));
constexpr int BM = 256, BK = 64, HALF = 128, HTB = HALF * BK * 2  , STAGE_BYTES = 8 * HTB, NXCD = 8, WGM = 8;

__host__ __device__ __forceinline__ int lds_byte(int r, int c) { const int st = (r >> 4) * 2 + (c >> 5), rr = r & 15, cc = c & 31, ob = rr * 64 + cc * 2; return st * 1024 + (ob ^ (((ob >> 9) & 1) << 5)); }
__host__ __device__ __forceinline__ void stage_rc(int b, int& R, int& C) { const int st = b / 1024, sb = b % 1024, swz = sb ^ (((sb >> 9) & 1) << 5); R = (st >> 1) * 16 + swz / 64; C = (st & 1) * 32 + (swz % 64) / 2; }
__host__ __device__ __forceinline__ int perm32(int rho) { const int n = rho >> 4, i = rho & 15; return 8 * (i >> 2) + 4 * n + (i & 3); }

struct Unit { int pm, pn; };
struct Gemm { const bf16_t* A; const bf16_t* Bt; int M, N, K; };

struct StaticOrder {
    int nM, nN, nwg, G, c;
    __host__ __device__ void init(int M, int N, int G_, int c_) { nM = M / BM; nN = N / BM; nwg = nM * nN; G = G_; c = c_; }
    __host__ __device__ bool next(int i, Unit& u) const {
        const long L = (long)i * G + c; if (L >= nwg) return false;
        int wgid = (int)L; { const int q = nwg / NXCD, r = nwg % NXCD, xcd = wgid % NXCD, off = wgid / NXCD; wgid = (xcd < r ? xcd * (q + 1) : r * (q + 1) + (xcd - r) * q) + off; }
        const int nig = WGM * nN, gid = wgid / nig, fm = gid * WGM, gsz = (nM - fm) < WGM ? (nM - fm) : WGM;
        u.pm = fm + ((wgid % nig) % gsz); u.pn = (wgid % nig) / gsz; return true;
    }
    __device__ __forceinline__ void a_ready(const Unit&) const {}
    __device__ __forceinline__ void done(const Unit&) const {}
};

typedef float cvt_f32x2 __attribute__((ext_vector_type(2)));
typedef __bf16 cvt_bf16x2 __attribute__((ext_vector_type(2)));
__device__ __forceinline__ unsigned cvt_pk_bf16(float lo, float hi) { const cvt_f32x2 v = {lo, hi}; union { cvt_bf16x2 b; unsigned u; } x; x.b = __builtin_convertvector(v, cvt_bf16x2); return x.u; }
typedef float f32x2 __attribute__((ext_vector_type(2)));
struct EpiF32 {
    static constexpr bool PERM = false, AFTER_DRAIN = false;
    float* C; int ldc; const float* bias;
    __device__ __forceinline__ void operator()(const f32x4 (&acc)[2][2][4][2], const Unit& u, int wr, int wc, int fr, int fq) const {
        const int row0 = u.pm * BM + wr * 64 + fr, col0 = u.pn * BM + wc * 32 + 4 * fq;
        f32x4 bv[2][2];
#pragma unroll
        for (int bj = 0; bj < 2; ++bj)
#pragma unroll
            for (int n = 0; n < 2; ++n) bv[bj][n] = bias ? *(const f32x4*)(bias + col0 + bj * HALF + n * 16) : (f32x4){0.f, 0.f, 0.f, 0.f};
#pragma unroll
        for (int ai = 0; ai < 2; ++ai)
#pragma unroll
            for (int m = 0; m < 4; ++m) { float* rowp = C + (size_t)(row0 + ai * HALF + m * 16) * ldc + col0;
#pragma unroll
                for (int bj = 0; bj < 2; ++bj)
#pragma unroll
                    for (int n = 0; n < 2; ++n) *(f32x4*)(rowp + bj * HALF + n * 16) = acc[ai][bj][m][n] + bv[bj][n]; }
    }
};
template <int ACT  > struct EpiBf16 {
    static constexpr bool PERM = true, AFTER_DRAIN = false;
    bf16_t* O; int ldc; const float* bias; int split_cols; size_t split_stride;
    __device__ __forceinline__ void operator()(const f32x4 (&acc)[2][2][4][2], const Unit& u, int wr, int wc, int fr, int fq) const {
        const int row0 = u.pm * BM + wr * 64 + fr; int colt = u.pn * BM; bf16_t* base = O;
        if (split_cols) { const int t = colt / split_cols; base += (size_t)t * split_stride; colt -= t * split_cols; }
        const int col0 = colt + wc * 32 + 8 * fq, bcol0 = u.pn * BM + wc * 32 + 8 * fq;
        f32x4 bv[2][2];
#pragma unroll
        for (int bj = 0; bj < 2; ++bj)
#pragma unroll
            for (int n = 0; n < 2; ++n) bv[bj][n] = bias ? *(const f32x4*)(bias + bcol0 + bj * HALF + 4 * n) : (f32x4){0.f, 0.f, 0.f, 0.f};
#pragma unroll
        for (int ai = 0; ai < 2; ++ai)
#pragma unroll
            for (int m = 0; m < 4; ++m) { bf16_t* rowp = base + (size_t)(row0 + ai * HALF + m * 16) * ldc + col0;
#pragma unroll
                for (int bj = 0; bj < 2; ++bj) { f32x4 v0 = acc[ai][bj][m][0] + bv[bj][0], v1 = acc[ai][bj][m][1] + bv[bj][1];
                    u32x4 w; w.x = cvt_pk_bf16(v0[0], v0[1]); w.y = cvt_pk_bf16(v0[2], v0[3]); w.z = cvt_pk_bf16(v1[0], v1[1]); w.w = cvt_pk_bf16(v1[2], v1[3]);
                    *(u32x4*)(rowp + bj * HALF) = w; } }
    }
};

template <class Epi, class Sched>
__device__ __forceinline__ void gemm_phase(PG8_LAS unsigned char* lds, const Gemm g, const Sched& S, const Epi& E) {
    const int tid = threadIdx.x, wid = __builtin_amdgcn_readfirstlane(tid >> 6), lane = tid & 63, wr = wid >> 2, wc = wid & 3, fr = lane & 15, fq = lane >> 4;
    const int K = g.K, nt = K / BK;
    unsigned voffA[2], voffB[2];
#pragma unroll
    for (int i = 0; i < 2; ++i) { int R, C; stage_rc(tid * 16 + i * 8192, R, C); const int Rb = Epi::PERM ? ((R & ~31) + perm32(R & 31)) : R;
        voffA[i] = (unsigned)(R * K + C) * 2u; voffB[i] = (unsigned)(Rb * K + C) * 2u; }
    const size_t kstep = (size_t)(BK * 2);
    const size_t hstep = (size_t)HALF * K * 2;
    const size_t tstep = 2 * hstep;
    const unsigned ldsw = (unsigned)wid * 1024u;
    const int aoff = lds_byte(wr * 64 + fr, fq * 8), boff = lds_byte(wc * 32 + fr, fq * 8);
#define PG8_SA(b, h) (((b) * 2 + (h)) * HTB)
#define PG8_SB(b, h) ((4 + (b) * 2 + (h)) * HTB)
#define PG8_STAGE(bufoff, gbase, voff) do { _Pragma("unroll") for (int _i = 0; _i < 2; ++_i) \
        __builtin_amdgcn_global_load_lds((const unsigned*)((const char*)(gbase) + (voff)[_i]), (PG8_LAS unsigned*)(lds + (bufoff) + ldsw + _i * 8192), 16, 0, 0); } while (0)
#define PG8_LDA(dst, b, h) do { _Pragma("unroll") for (int m = 0; m < 4; ++m) _Pragma("unroll") for (int k = 0; k < 2; ++k) dst[m][k] = *(const PG8_LAS bf16x8*)(lds + PG8_SA(b, h) + aoff + m * 2048 + k * 1024); } while (0)
#define PG8_LDB(dst, b, h) do { _Pragma("unroll") for (int n = 0; n < 2; ++n) _Pragma("unroll") for (int k = 0; k < 2; ++k) dst[n][k] = *(const PG8_LAS bf16x8*)(lds + PG8_SB(b, h) + boff + n * 2048 + k * 1024); } while (0)
#define PG8_MMA(ai, bj, At, Bt) do { __builtin_amdgcn_s_setprio(1); _Pragma("unroll") for (int m = 0; m < 4; ++m) _Pragma("unroll") for (int n = 0; n < 2; ++n) _Pragma("unroll") for (int k = 0; k < 2; ++k) \
        acc[ai][bj][m][n] = __builtin_amdgcn_mfma_f32_16x16x32_bf16(Bt[n][k], At[m][k], acc[ai][bj][m][n], 0, 0, 0); __builtin_amdgcn_s_setprio(0); } while (0)
#define PG8_WAIT_V(n) asm volatile("s_waitcnt vmcnt(" #n ")" ::: "memory")
#define PG8_WAIT_L(n) asm volatile("s_waitcnt lgkmcnt(" #n ")" ::: "memory")
#define PG8_BAR __builtin_amdgcn_s_barrier()
#define PG8_SCHED __builtin_amdgcn_sched_barrier(0)
    Unit cur, nxt; int ui = 0;
    if (!S.next(0, cur)) return;
    f32x4 acc[2][2][4][2];
#pragma unroll
    for (int a = 0; a < 2; ++a)
#pragma unroll
        for (int b = 0; b < 2; ++b)
#pragma unroll
            for (int m = 0; m < 4; ++m)
#pragma unroll
                for (int n = 0; n < 2; ++n) acc[a][b][m][n] = (f32x4){0.f, 0.f, 0.f, 0.f};
    bf16x8 At[4][2], B0[2][2], B1[2][2];
    const char* cA = (const char*)g.A + (size_t)cur.pm * tstep; const char* cB = (const char*)g.Bt + (size_t)cur.pn * tstep;
    S.a_ready(cur);
    PG8_STAGE(PG8_SB(0, 0), cB, voffB); PG8_STAGE(PG8_SA(0, 0), cA, voffA); PG8_STAGE(PG8_SB(0, 1), cB + hstep, voffB); PG8_STAGE(PG8_SA(0, 1), cA + hstep, voffA);
    if (wr == 1) PG8_BAR;
    PG8_WAIT_V(4); PG8_BAR;
    PG8_STAGE(PG8_SB(1, 0), cB + kstep, voffB); PG8_STAGE(PG8_SA(1, 0), cA + kstep, voffA); PG8_STAGE(PG8_SB(1, 1), cB + hstep + kstep, voffB);
    PG8_WAIT_V(6); PG8_BAR;
    for (;;) {
        const bool has_next = S.next(ui + 1, nxt);
        const char* nA = has_next ? (const char*)g.A + (size_t)nxt.pm * tstep : cA; const char* nB = has_next ? (const char*)g.Bt + (size_t)nxt.pn * tstep : cB;
        for (int t = 0; t < nt; t += 2) {
            const bool last = (t == nt - 2);
            const char* a1 = cA + (size_t)(t + 1) * kstep;
            const char* a2 = last ? nA : cA + (size_t)(t + 2) * kstep; const char* b2 = last ? nB : cB + (size_t)(t + 2) * kstep;
            const char* a3 = a2 + kstep; const char* b3 = b2 + kstep;
            if (last && has_next) S.a_ready(nxt);
            PG8_LDB(B0, 0, 0); PG8_SCHED; PG8_LDA(At, 0, 0); PG8_STAGE(PG8_SA(1, 1), a1 + hstep, voffA);
            PG8_WAIT_L(8); PG8_BAR; PG8_WAIT_L(0); PG8_MMA(0, 0, At, B0); PG8_BAR; PG8_SCHED;
            PG8_LDB(B1, 0, 1); PG8_STAGE(PG8_SB(0, 0), b2, voffB);
            PG8_BAR; PG8_WAIT_L(0); PG8_MMA(0, 1, At, B1); PG8_BAR;
            PG8_LDA(At, 0, 1); PG8_STAGE(PG8_SA(0, 0), a2, voffA);
            PG8_BAR; PG8_WAIT_L(0); PG8_MMA(1, 0, At, B0); PG8_BAR; PG8_SCHED;
            PG8_STAGE(PG8_SB(0, 1), b2 + hstep, voffB);
            PG8_WAIT_V(6); PG8_BAR; PG8_MMA(1, 1, At, B1); PG8_BAR;
            PG8_LDB(B0, 1, 0); PG8_SCHED; PG8_LDA(At, 1, 0); PG8_STAGE(PG8_SA(0, 1), a2 + hstep, voffA);
            PG8_WAIT_L(8); PG8_BAR; PG8_WAIT_L(0); PG8_MMA(0, 0, At, B0); PG8_BAR; PG8_SCHED;
            PG8_LDB(B1, 1, 1); PG8_STAGE(PG8_SB(1, 0), b3, voffB);
            PG8_BAR; PG8_WAIT_L(0); PG8_MMA(0, 1, At, B1); PG8_BAR;
            PG8_LDA(At, 1, 1); PG8_STAGE(PG8_SA(1, 0), a3, voffA);
            PG8_BAR; PG8_WAIT_L(0); PG8_MMA(1, 0, At, B0); PG8_BAR; PG8_SCHED;
            PG8_STAGE(PG8_SB(1, 1), b3 + hstep, voffB);
            PG8_WAIT_V(6); PG8_BAR; PG8_MMA(1, 1, At, B1); PG8_BAR;
        }
        if constexpr (!Epi::AFTER_DRAIN) { E(acc, cur, wr, wc, fr, fq); S.done(cur); }
        if (!has_next) break;
#pragma unroll
        for (int a = 0; a < 2; ++a)
#pragma unroll
            for (int b = 0; b < 2; ++b)
#pragma unroll
                for (int m = 0; m < 4; ++m)
#pragma unroll
                    for (int n = 0; n < 2; ++n) acc[a][b][m][n] = (f32x4){0.f, 0.f, 0.f, 0.f};
        cur = nxt; cA = nA; cB = nB; ++ui;
    }
    PG8_WAIT_V(0);
    if (wr == 0) PG8_BAR;
    PG8_BAR;
    if constexpr (Epi::AFTER_DRAIN) { E.fused(acc, cur, wr, wc, fr, fq, lds, wid, lane); S.done(cur); }
#undef PG8_SA
#undef PG8_SB
#undef PG8_STAGE
#undef PG8_LDA
#undef PG8_LDB
#undef PG8_MMA
#undef PG8_WAIT_V
#undef PG8_WAIT_L
#undef PG8_BAR
#undef PG8_SCHED
}
}


typedef unsigned short bf16_t;
typedef short bf16x8 __attribute__((ext_vector_type(8)));
typedef float f32x4 __attribute__((ext_vector_type(4)));
typedef unsigned u32x4 __attribute__((ext_vector_type(4)));
typedef unsigned u32x2 __attribute__((ext_vector_type(2)));

constexpr int MTOK = 32768, DM = 1024, SEQ = 16384, NTH = 512;
constexpr int GIN = 3088, GIN_P = 3072, RIN = 4224, RIN_P = 4352;
constexpr int LDS_BYTES = 147456;

constexpr size_t WS_WGIN  = 0;
constexpr size_t WS_WGOUT = WS_WGIN  + (size_t)GIN_P * DM * 2;
constexpr size_t WS_WRIN  = WS_WGOUT + (size_t)DM * DM * 2;
constexpr size_t WS_WROUT = WS_WRIN  + (size_t)RIN_P * DM * 2;
constexpr size_t WS_WDUT  = WS_WROUT + (size_t)DM * DM * 2;
constexpr size_t WS_WIUT  = WS_WDUT  + (size_t)DM * 64 * 2;
constexpr size_t WS_WUPT  = WS_WIUT  + (size_t)DM * 64 * 2;
constexpr size_t WS_A     = WS_WUPT  + (size_t)512 * 16 * 2;
constexpr size_t WS_Y     = WS_A     + (size_t)MTOK * DM * 2;
constexpr size_t WS_GS    = WS_Y     + (size_t)MTOK * DM * 2;
constexpr size_t WS_GD    = WS_GS    + (size_t)24 * 1024 * 1024;
constexpr size_t WS_P     = WS_GD    + (size_t)8 * 32 * 128 * 4;
constexpr size_t WS_BAR   = WS_P     + (size_t)MTOK * RIN_P * 2;
constexpr size_t WS_AD    = WS_BAR   + 16384;
constexpr size_t WS_X1    = WS_AD    + (size_t)MTOK * 16 * 2;
constexpr size_t WS_END   = WS_X1    + (size_t)MTOK * DM * 2;
static_assert(WS_END <= (size_t)512 * 1024 * 1024, "workspace budget (4 x the largest tensor)");

struct Params { const float* in[22]; float* out; unsigned char* ws; int ph_lo, ph_hi; };

__device__ __forceinline__ float bf2f(unsigned b) { return __uint_as_float(b << 16); }
__device__ __forceinline__ bf16_t f2bf(float f) { unsigned u = __float_as_uint(f); u += 0x7FFFu + ((u >> 16) & 1u); return (bf16_t)(u >> 16); }
__device__ __forceinline__ unsigned pk2(float lo, float hi) { return pg8::cvt_pk_bf16(lo, hi); }
__device__ __forceinline__ float wave_sum(float x) {
#pragma unroll
    for (int off = 32; off >= 1; off >>= 1) x += __shfl_xor(x, off);
    return x;
}
__device__ __forceinline__ f32x4 mfma16(bf16x8 a, bf16x8 b, f32x4 c) { return __builtin_amdgcn_mfma_f32_16x16x32_bf16(a, b, c, 0, 0, 0); }
__device__ __forceinline__ bf16x8 as_bf16x8(u32x4 v) { union { u32x4 u; bf16x8 b; } x; x.u = v; return x.b; }
__device__ __forceinline__ float fexp(float x) { return __builtin_amdgcn_exp2f(x * 1.4426950408889634f); }
__device__ __forceinline__ float flog(float x) { return __builtin_amdgcn_logf(x) * 0.6931471805599453f; }
__device__ __forceinline__ float log_sigmoid(float z) { return fminf(z, 0.f) - log1pf(fexp(-fabsf(z))); }
__device__ __forceinline__ float softplus(float z) { return fmaxf(z, 0.f) + log1pf(fexp(-fabsf(z))); }

__device__ void prep_weight(const float* __restrict__ W, int N, const float* __restrict__ gain, bf16_t* __restrict__ Wt, int NP, float* tile) {
    const int tid = threadIdx.x;
    const int nu = (NP / 64) * 16;
    const int lk = tid >> 4, lq = tid & 15;
    const int sn = tid >> 3, ss = tid & 7;
    float4 v[2];
#define PW_LOAD(u_) do { const int n0_ = ((u_) >> 4) * 64, k0_ = ((u_) & 15) * 64; _Pragma("unroll") for (int r = 0; r < 2; ++r) { const int k = k0_ + lk + 32 * r, n = n0_ + 4 * lq; \
        float4 x_ = make_float4(0.f, 0.f, 0.f, 0.f); if (n < N) { x_ = *(const float4*)(W + (size_t)k * N + n); if (gain) { const float g_ = gain[k]; x_.x *= g_; x_.y *= g_; x_.z *= g_; x_.w *= g_; } } v[r] = x_; } } while (0)
    int u = blockIdx.x;
    if (u < nu) PW_LOAD(u);
    for (; u < nu; u += gridDim.x) {
        const int n0 = (u >> 4) * 64, k0 = (u & 15) * 64;
#pragma unroll
        for (int r = 0; r < 2; ++r) *(float4*)(tile + (lk + 32 * r) * 68 + 4 * lq) = v[r];
        if (u + (int)gridDim.x < nu) PW_LOAD(u + gridDim.x);
        __syncthreads();
        {
            float e[8];
#pragma unroll
            for (int q = 0; q < 8; ++q) e[q] = tile[(8 * ss + q) * 68 + sn];
            *(u32x4*)(Wt + (size_t)(n0 + sn) * DM + k0 + 8 * ss) = (u32x4){pk2(e[0], e[1]), pk2(e[2], e[3]), pk2(e[4], e[5]), pk2(e[6], e[7])};
        }
        __syncthreads();
    }
#undef PW_LOAD
}

__device__ void prep_lowrank(const float* __restrict__ src, bf16_t* __restrict__ dst) {
    for (int idx = blockIdx.x * NTH + threadIdx.x; idx < 65536; idx += gridDim.x * NTH) dst[idx] = f2bf(src[(idx & 63) * 1024 + (idx >> 6)]);
}

__device__ void zero_bnd_row(bf16_t* bnd) {
    if (blockIdx.x == 0) for (int i = threadIdx.x; i < RIN_P / 2; i += NTH) ((unsigned*)bnd)[i] = 0u;
}

__device__ void prep_wup(const float* __restrict__ src, bf16_t* __restrict__ dst) {
    for (int idx = blockIdx.x * NTH + threadIdx.x; idx < 8192; idx += gridDim.x * NTH) dst[idx] = f2bf(src[(idx & 15) * 512 + (idx >> 4)]);
}

struct EpiBf16GateSilu {
    static constexpr bool PERM = true, AFTER_DRAIN = false;
    bf16_t* O; int ldc;
    __device__ __forceinline__ void operator()(const f32x4 (&acc)[2][2][4][2], const pg8::Unit& u, int wr, int wc, int fr, int fq) const {
        const int row0 = u.pm * pg8::BM + wr * 64 + fr, col0 = u.pn * pg8::BM + wc * 32 + 8 * fq;
        const bool act = u.pn >= 8;
#pragma unroll
        for (int ai = 0; ai < 2; ++ai)
#pragma unroll
            for (int m = 0; m < 4; ++m) {
                bf16_t* rowp = O + (size_t)(row0 + ai * pg8::HALF + m * 16) * ldc + col0;
#pragma unroll
                for (int bj = 0; bj < 2; ++bj) {
                    f32x4 v0 = acc[ai][bj][m][0], v1 = acc[ai][bj][m][1];
                    if (act) {
#pragma unroll
                        for (int j = 0; j < 4; ++j) { v0[j] *= __builtin_amdgcn_rcpf(1.0f + fexp(-v0[j])); v1[j] *= __builtin_amdgcn_rcpf(1.0f + fexp(-v1[j])); }
                    }
                    u32x4 wv; wv.x = pk2(v0[0], v0[1]); wv.y = pk2(v0[2], v0[3]); wv.z = pk2(v1[0], v1[1]); wv.w = pk2(v1[2], v1[3]);
                    *(u32x4*)(rowp + bj * pg8::HALF) = wv;
                }
            }
    }
};

struct EpiBf16Bnd {
    static constexpr bool PERM = true, AFTER_DRAIN = false;
    bf16_t* O; int ldc; bf16_t* bnd;
    __device__ __forceinline__ void operator()(const f32x4 (&acc)[2][2][4][2], const pg8::Unit& u, int wr, int wc, int fr, int fq) const {
        const int row0 = u.pm * pg8::BM + wr * 64 + fr, col0 = u.pn * pg8::BM + wc * 32 + 8 * fq;
#pragma unroll
        for (int ai = 0; ai < 2; ++ai)
#pragma unroll
            for (int m = 0; m < 4; ++m) {
                const int row = row0 + ai * pg8::HALF + m * 16;
                bf16_t* rowp = O + (size_t)row * ldc + col0;
#pragma unroll
                for (int bj = 0; bj < 2; ++bj) {
                    const f32x4 v0 = acc[ai][bj][m][0], v1 = acc[ai][bj][m][1];
                    u32x4 wv; wv.x = pk2(v0[0], v0[1]); wv.y = pk2(v0[2], v0[3]); wv.z = pk2(v1[0], v1[1]); wv.w = pk2(v1[2], v1[3]);
                    *(u32x4*)(rowp + bj * pg8::HALF) = wv;
                    if (m == 3 && fr == 15) *(u32x4*)(bnd + (size_t)((row >> 6) + 1) * ldc + col0 + bj * pg8::HALF) = wv;
                }
            }
    }
};

__device__ void phase_norm0(const Params& p, unsigned char* lds) {
    const int tid = threadIdx.x, lane = tid & 63, w = tid >> 6, l15 = lane & 15, g = lane >> 4;
    const float* x = p.in[0];
    bf16_t* A = (bf16_t*)(p.ws + WS_A);
    bf16_t* AD = (bf16_t*)(p.ws + WS_AD);
    bf16_t* WAD = (bf16_t*)lds;
    float* PSS = (float*)(lds + 33024);
    float* PAD = (float*)(lds + 33024 + 512);
    for (int e = tid; e < 16384; e += NTH) { const int k = e >> 4, j = e & 15; WAD[j * 1032 + k] = f2bf(p.in[2][(size_t)k * GIN + 3072 + j] * p.in[1][k]); }
    __syncthreads();
    bf16x8 wf[4];
#pragma unroll
    for (int kk = 0; kk < 4; ++kk) wf[kk] = *(const bf16x8*)(WAD + l15 * 1032 + 128 * w + 32 * kk + 8 * g);
    float4 xa[4][2];
    int tile = blockIdx.x;
    if (tile < MTOK / 16) {
#pragma unroll
        for (int kk = 0; kk < 4; ++kk) { const float4* s = (const float4*)(x + (size_t)(16 * tile + l15) * DM + 128 * w + 32 * kk + 8 * g); xa[kk][0] = s[0]; xa[kk][1] = s[1]; }
    }
    for (; tile < MTOK / 16; tile += gridDim.x) {
        float4 xv[4][2];
#pragma unroll
        for (int kk = 0; kk < 4; ++kk) { xv[kk][0] = xa[kk][0]; xv[kk][1] = xa[kk][1]; }
        if (tile + (int)gridDim.x < MTOK / 16) {
#pragma unroll
            for (int kk = 0; kk < 4; ++kk) { const float4* s = (const float4*)(x + (size_t)(16 * (tile + gridDim.x) + l15) * DM + 128 * w + 32 * kk + 8 * g); xa[kk][0] = s[0]; xa[kk][1] = s[1]; }
        }
        float ss = 0.f;
        f32x4 acc = (f32x4){0.f, 0.f, 0.f, 0.f};
#pragma unroll
        for (int kk = 0; kk < 4; ++kk) {
            const float4 a = xv[kk][0], b = xv[kk][1];
            ss += a.x * a.x + a.y * a.y + a.z * a.z + a.w * a.w + b.x * b.x + b.y * b.y + b.z * b.z + b.w * b.w;
            acc = mfma16(as_bf16x8((u32x4){pk2(a.x, a.y), pk2(a.z, a.w), pk2(b.x, b.y), pk2(b.z, b.w)}), wf[kk], acc);
        }
        ss += __shfl_xor(ss, 16); ss += __shfl_xor(ss, 32);
        if (g == 0) PSS[w * 16 + l15] = ss;
        *(f32x4*)(PAD + (w * 64 + lane) * 4) = acc;
        __syncthreads();
        float tot = 0.f;
#pragma unroll
        for (int q = 0; q < 8; ++q) tot += PSS[q * 16 + l15];
        const float rstd = rsqrtf(tot * (1.0f / DM) + 1e-6f);
#pragma unroll
        for (int kk = 0; kk < 4; ++kk) {
            const float4 a = xv[kk][0], b = xv[kk][1];
            *(u32x4*)(A + (size_t)(16 * tile + l15) * DM + 128 * w + 32 * kk + 8 * g) = (u32x4){pk2(a.x * rstd, a.y * rstd), pk2(a.z * rstd, a.w * rstd), pk2(b.x * rstd, b.y * rstd), pk2(b.z * rstd, b.w * rstd)};
        }
        if (w == 0) {
            f32x4 s = (f32x4){0.f, 0.f, 0.f, 0.f};
#pragma unroll
            for (int q = 0; q < 8; ++q) s += *(const f32x4*)(PAD + (q * 64 + lane) * 4);
#pragma unroll
            for (int r = 0; r < 4; ++r) AD[(size_t)(16 * tile + 4 * g + r) * 16 + l15] = f2bf(s[r] * __shfl(rstd, 4 * g + r));
        }
        __syncthreads();
    }
}

__device__ void phase_norm1(const Params& p) {
    const int tid = threadIdx.x, lane = tid & 63, w = tid >> 6;
    const float* x = p.in[0];
    const float* gpost = p.in[7];
    const bf16_t* Y = (const bf16_t*)(p.ws + WS_Y);
    bf16_t* A = (bf16_t*)(p.ws + WS_A);
    bf16_t* X1 = (bf16_t*)(p.ws + WS_X1);
    float4 gp[4];
#pragma unroll
    for (int i = 0; i < 4; ++i) gp[i] = ((const float4*)gpost)[lane + 64 * i];
    const int stride = gridDim.x * 8;
    float4 vn[4]; u32x2 yn[4];
    {
        const int row = blockIdx.x * 8 + w;
#pragma unroll
        for (int i = 0; i < 4; ++i) { vn[i] = ((const float4*)(x + (size_t)row * DM))[lane + 64 * i]; yn[i] = *(const u32x2*)(Y + (size_t)row * DM + 4 * (lane + 64 * i)); }
    }
    for (int row = blockIdx.x * 8 + w; row < MTOK; row += stride) {
        float4 v[4]; u32x2 yv[4];
#pragma unroll
        for (int i = 0; i < 4; ++i) { v[i] = vn[i]; yv[i] = yn[i]; }
        if (row + stride < MTOK) {
#pragma unroll
            for (int i = 0; i < 4; ++i) { vn[i] = ((const float4*)(x + (size_t)(row + stride) * DM))[lane + 64 * i]; yn[i] = *(const u32x2*)(Y + (size_t)(row + stride) * DM + 4 * (lane + 64 * i)); }
        }
        float4 y[4];
        float ss = 0.f;
#pragma unroll
        for (int i = 0; i < 4; ++i) {
            y[i].x = bf2f(yv[i].x & 0xffffu); y[i].y = bf2f(yv[i].x >> 16); y[i].z = bf2f(yv[i].y & 0xffffu); y[i].w = bf2f(yv[i].y >> 16);
            ss += y[i].x * y[i].x + y[i].y * y[i].y + y[i].z * y[i].z + y[i].w * y[i].w;
        }
        ss = wave_sum(ss);
        const float rstdy = rsqrtf(ss * (1.0f / DM) + 1e-6f);
        float s1 = 0.f;
#pragma unroll
        for (int i = 0; i < 4; ++i) {
            v[i].x += y[i].x * rstdy * gp[i].x; v[i].y += y[i].y * rstdy * gp[i].y; v[i].z += y[i].z * rstdy * gp[i].z; v[i].w += y[i].w * rstdy * gp[i].w;
            s1 += v[i].x * v[i].x + v[i].y * v[i].y + v[i].z * v[i].z + v[i].w * v[i].w;
            u32x2 xo; xo.x = pk2(v[i].x, v[i].y); xo.y = pk2(v[i].z, v[i].w);
            *(u32x2*)(X1 + (size_t)row * DM + 4 * (lane + 64 * i)) = xo;
        }
        s1 = wave_sum(s1);
        const float rstd = rsqrtf(s1 * (1.0f / DM) + 1e-6f);
#pragma unroll
        for (int i = 0; i < 4; ++i) {
            u32x2 o; o.x = pk2(v[i].x * rstd, v[i].y * rstd); o.y = pk2(v[i].z * rstd, v[i].w * rstd);
            *(u32x2*)(A + (size_t)row * DM + 4 * (lane + 64 * i)) = o;
        }
    }
}

__device__ void phase_final(const Params& p) {
    const int tid = threadIdx.x, lane = tid & 63, w = tid >> 6;
    const float* gpost = p.in[21];
    const bf16_t* Y = (const bf16_t*)(p.ws + WS_Y);
    const bf16_t* X1 = (const bf16_t*)(p.ws + WS_X1);
    float4 gp[4];
#pragma unroll
    for (int i = 0; i < 4; ++i) gp[i] = ((const float4*)gpost)[lane + 64 * i];
    const int stride = gridDim.x * 8;
    u32x2 xn[4], yn[4];
    {
        const int row = blockIdx.x * 8 + w;
#pragma unroll
        for (int i = 0; i < 4; ++i) { xn[i] = *(const u32x2*)(X1 + (size_t)row * DM + 4 * (lane + 64 * i)); yn[i] = *(const u32x2*)(Y + (size_t)row * DM + 4 * (lane + 64 * i)); }
    }
    for (int row = blockIdx.x * 8 + w; row < MTOK; row += stride) {
        u32x2 xv[4], yv[4];
#pragma unroll
        for (int i = 0; i < 4; ++i) { xv[i] = xn[i]; yv[i] = yn[i]; }
        if (row + stride < MTOK) {
#pragma unroll
            for (int i = 0; i < 4; ++i) { xn[i] = *(const u32x2*)(X1 + (size_t)(row + stride) * DM + 4 * (lane + 64 * i)); yn[i] = *(const u32x2*)(Y + (size_t)(row + stride) * DM + 4 * (lane + 64 * i)); }
        }
        float4 y[4];
        float ss = 0.f;
#pragma unroll
        for (int i = 0; i < 4; ++i) {
            y[i].x = bf2f(yv[i].x & 0xffffu); y[i].y = bf2f(yv[i].x >> 16); y[i].z = bf2f(yv[i].y & 0xffffu); y[i].w = bf2f(yv[i].y >> 16);
            ss += y[i].x * y[i].x + y[i].y * y[i].y + y[i].z * y[i].z + y[i].w * y[i].w;
        }
        ss = wave_sum(ss);
        const float rstdy = rsqrtf(ss * (1.0f / DM) + 1e-6f);
#pragma unroll
        for (int i = 0; i < 4; ++i) {
            float4 v;
            v.x = bf2f(xv[i].x & 0xffffu) + y[i].x * rstdy * gp[i].x; v.y = bf2f(xv[i].x >> 16) + y[i].y * rstdy * gp[i].y;
            v.z = bf2f(xv[i].y & 0xffffu) + y[i].z * rstdy * gp[i].z; v.w = bf2f(xv[i].y >> 16) + y[i].w * rstdy * gp[i].w;
            ((float4*)(p.out + (size_t)row * DM))[lane + 64 * i] = v;
        }
    }
}

constexpr int L_BC = 0, L_ATT = 0, L_QD = 33792, L_KD = L_QD + 64 * 136 * 2, L_KTE = L_KD + 64 * 136 * 2, L_VI = L_KTE + 64 * 152 * 2, L_SSQ = L_VI + 64 * 280 * 2, L_BL = L_SSQ + 2048, L_DEC = L_BL + 512, L_ADL = L_DEC + 512,
              L_GLA_END = L_ADL + 2048;
static_assert(L_GLA_END <= LDS_BYTES, "GLA LDS");
#define GLA_BARRIER() do { asm volatile("s_waitcnt lgkmcnt(0)" ::: "memory"); __builtin_amdgcn_s_barrier(); asm volatile("" ::: "memory"); } while (0)
typedef short gs16x4 __attribute__((ext_vector_type(4)));
__device__ __forceinline__ u32x2 g_trread(const bf16_t* p) { union { gs16x4 s; u32x2 u; } x; x.s = __builtin_amdgcn_ds_read_tr16_b64_v4i16((__attribute__((address_space(3))) gs16x4*)p); return x.u; }
template <int PITCH> __device__ __forceinline__ bf16x8 g_trfrag(const bf16_t* img, int k0, int c0, int g, int q, int pq) {
    const bf16_t* a = img + (k0 + 8 * g + q) * PITCH + c0 + 4 * pq;
    const u32x2 lo = g_trread(a), hi = g_trread(a + 4 * PITCH);
    return as_bf16x8((u32x4){lo.x, lo.y, hi.x, hi.y});
}
__device__ __forceinline__ f32x4 g_lo4(u32x4 v) { return (f32x4){bf2f(v.x & 0xffffu), bf2f(v.x >> 16), bf2f(v.y & 0xffffu), bf2f(v.y >> 16)}; }
__device__ __forceinline__ f32x4 g_hi4(u32x4 v) { return (f32x4){bf2f(v.z & 0xffffu), bf2f(v.z >> 16), bf2f(v.w & 0xffffu), bf2f(v.w >> 16)}; }
__device__ __forceinline__ u32x2 g_pk4(f32x4 v) { u32x2 r; r.x = pk2(v[0], v[1]); r.y = pk2(v[2], v[3]); return r; }
__device__ __forceinline__ f32x4 g_unpk4(u32x2 v) { return (f32x4){bf2f(v.x & 0xffffu), bf2f(v.x >> 16), bf2f(v.y & 0xffffu), bf2f(v.y >> 16)}; }

template <bool OUT> struct GlaRaw { u32x4 q[2], k[2], v[4]; };
template <bool OUT> __device__ __forceinline__ void gla_issue(GlaRaw<OUT>& x, const char* cb  , unsigned offQ, unsigned offV) {
    if (OUT) { x.q[0] = *(const u32x4*)(cb + offQ); x.q[1] = *(const u32x4*)(cb + offQ + 16); }
    x.k[0] = *(const u32x4*)(cb + offQ + 1024); x.k[1] = *(const u32x4*)(cb + offQ + 1040);
#pragma unroll
    for (int i = 0; i < 4; ++i) x.v[i] = *(const u32x4*)(cb + offV + 16 * i);
}

template <bool OUT>
__device__ void gla_pass(const Params& p, unsigned char* lds) {
    const int tid = threadIdx.x, w = __builtin_amdgcn_readfirstlane(tid >> 6);
    const bf16_t* P = (const bf16_t*)(p.ws + WS_P);
    bf16_t* GS = (bf16_t*)(p.ws + WS_GS);
    float* GD = (float*)(p.ws + WS_GD);
    bf16_t* Aout = (bf16_t*)(p.ws + WS_A);
    const bf16_t* WupT = (const bf16_t*)(p.ws + WS_WUPT);
    const bf16_t* ADG = (const bf16_t*)(p.ws + WS_AD);
    float* BC = (float*)(lds + L_BC); bf16_t* ATT = (bf16_t*)(lds + L_ATT); bf16_t* QD = (bf16_t*)(lds + L_QD); bf16_t* KD = (bf16_t*)(lds + L_KD); bf16_t* KTE = (bf16_t*)(lds + L_KTE);
    bf16_t* VI = (bf16_t*)(lds + L_VI); float* SSQ = (float*)(lds + L_SSQ); float* BL = (float*)(lds + L_BL); float* DEC = (float*)(lds + L_DEC); bf16_t* ADL = (bf16_t*)(lds + L_ADL);
    const float* b_al = p.in[4]; const float* g_head = p.in[5];

    for (int unit = blockIdx.x; unit < 256; unit += gridDim.x) {
        const int bh = unit >> 5, m = unit & 31, b = bh >> 2, h = bh & 3;
        int tidv = tid; asm volatile("" : "+v"(tidv));
        const int lane = tidv & 63, l15 = lane & 15, g = lane >> 4, q4 = l15 >> 2, p4 = l15 & 3;
        const int c = tidv >> 3, seg = tidv & 7;
        const int tokbase = b * SEQ + m * 512;
        u32x4 wupq = *(const u32x4*)(WupT + (size_t)(h * 128 + 16 * w + l15) * 16 + 8 * (g & 1));
        if (g >= 2) wupq = (u32x4){0u, 0u, 0u, 0u};
        const bf16x8 wupf = as_bf16x8(wupq);
        const float bA = b_al[h * 128 + 16 * w + l15];
        f32x4 gh[2];
#pragma unroll
        for (int vt = 0; vt < 2; ++vt) gh[vt] = *(const f32x4*)(g_head + 32 * w + 16 * vt + 4 * g);
        float logD = 0.f;
        f32x4 S[8][2];
#pragma unroll
        for (int mt = 0; mt < 8; ++mt)
#pragma unroll
            for (int vt = 0; vt < 2; ++vt) {
                if (OUT) S[mt][vt] = g_unpk4(*(const u32x2*)(GS + ((size_t)(bh * 32 + m) * 256 + 32 * w + 16 * vt + l15) * 128 + 16 * mt + 4 * g));
                else S[mt][vt] = (f32x4){0.f, 0.f, 0.f, 0.f};
            }
        const unsigned offQ = (unsigned)((c * GIN_P + h * 128 + 16 * seg) * 2), offV = (unsigned)((c * GIN_P + 1024 + h * 256 + 32 * seg) * 2), offAD = (unsigned)(tid * 16);
        const unsigned offG = (unsigned)((l15 * GIN_P + 2048 + h * 256 + 32 * w + 4 * g) * 2), offO = (unsigned)((l15 * DM + h * 256 + 32 * w + 4 * g) * 2);
        GlaRaw<OUT> raw;
        gla_issue<OUT>(raw, (const char*)P + (size_t)tokbase * GIN_P * 2, offQ, offV);
        if (tid < 128) *(u32x4*)(ADL + tid * 8) = *(const u32x4*)((const char*)ADG + (size_t)tokbase * 32 + offAD);
        GLA_BARRIER();

        for (int ch = 0; ch < 8; ++ch) {
            const int tok0 = tokbase + ch * 64;
            u32x4 adn = (u32x4){0u, 0u, 0u, 0u};
            {
                if (ch < 7 && tid < 128) adn = *(const u32x4*)((const char*)ADG + (size_t)(tok0 + 64) * 32 + offAD);
                f32x4 sc[4]; float xinc[4], tot[4];
#pragma unroll
                for (int ct = 0; ct < 4; ++ct) {
                    u32x4 aq = *(const u32x4*)(ADL + (16 * ct + l15) * 16 + 8 * (g & 1));
                    if (g >= 2) aq = (u32x4){0u, 0u, 0u, 0u};
                    const f32x4 z = mfma16(as_bf16x8(aq), wupf, (f32x4){bA, bA, bA, bA});
                    float acc = 0.f;
#pragma unroll
                    for (int r = 0; r < 4; ++r) { acc += (fminf(z[r], 0.f) - flog(1.f + fexp(-fabsf(z[r])))) * (1.0f / 16.0f); sc[ct][r] = acc; }
                    xinc[ct] = acc;
                }
#pragma unroll
                for (int ct = 0; ct < 4; ++ct) { const float y = __shfl_up(xinc[ct], 16); if (g >= 1) xinc[ct] += y; }
#pragma unroll
                for (int ct = 0; ct < 4; ++ct) { const float y = __shfl_up(xinc[ct], 32); if (g >= 2) xinc[ct] += y; }
#pragma unroll
                for (int ct = 0; ct < 4; ++ct) tot[ct] = __shfl(xinc[ct], 48 + l15);
                float run = 0.f;
#pragma unroll
                for (int ct = 0; ct < 4; ++ct) {
                    const float base = run + (xinc[ct] - sc[ct][3]);
                    run += tot[ct];
#pragma unroll
                    for (int r = 0; r < 4; ++r) BC[(16 * ct + 4 * g + r) * 132 + 16 * w + l15] = base + sc[ct][r];
                }
                if (g == 0) { BL[16 * w + l15] = run; DEC[16 * w + l15] = fexp(run); }
                if (!OUT) logD += run;
            }
            GLA_BARRIER();
            u32x2 gate[2][4];
            {
#pragma unroll
                for (int hh = 0; hh < 2; ++hh) {
                    const int o8 = 16 * seg + 8 * hh;
                    const f32x4 bb[2] = {*(const f32x4*)(BC + c * 132 + o8), *(const f32x4*)(BC + c * 132 + o8 + 4)};
                    const f32x4 dc[2] = {*(const f32x4*)(DEC + o8), *(const f32x4*)(DEC + o8 + 4)};
                    const f32x4 kx[2] = {g_lo4(raw.k[hh]), g_hi4(raw.k[hh])};
                    f32x4 qx[2];
                    if (OUT) { qx[0] = g_lo4(raw.q[hh]); qx[1] = g_hi4(raw.q[hh]); }
                    f32x4 kd[2], kt[2], qd[2];
#pragma unroll
                    for (int i = 0; i < 2; ++i)
#pragma unroll
                        for (int j = 0; j < 4; ++j) {
                            const float eB = fexp(bb[i][j]), enB = __builtin_amdgcn_rcpf(eB);
                            kd[i][j] = kx[i][j] * enB; kt[i][j] = kd[i][j] * dc[i][j];
                            if (OUT) qd[i][j] = qx[i][j] * 0.08838834764831845f * eB;
                        }
                    *(u32x4*)(KTE + c * 152 + o8) = (u32x4){pk2(kt[0][0], kt[0][1]), pk2(kt[0][2], kt[0][3]), pk2(kt[1][0], kt[1][1]), pk2(kt[1][2], kt[1][3])};
                    if (OUT) {
                        *(u32x4*)(KD + c * 136 + o8) = (u32x4){pk2(kd[0][0], kd[0][1]), pk2(kd[0][2], kd[0][3]), pk2(kd[1][0], kd[1][1]), pk2(kd[1][2], kd[1][3])};
                        *(u32x4*)(QD + c * 136 + o8) = (u32x4){pk2(qd[0][0], qd[0][1]), pk2(qd[0][2], qd[0][3]), pk2(qd[1][0], qd[1][1]), pk2(qd[1][2], qd[1][3])};
                    }
                }
#pragma unroll
                for (int i = 0; i < 4; ++i) *(u32x4*)(VI + c * 280 + 32 * seg + 8 * i) = raw.v[i];
                if (OUT) {
#pragma unroll
                    for (int vt = 0; vt < 2; ++vt)
#pragma unroll
                        for (int ct = 0; ct < 4; ++ct) gate[vt][ct] = *(const u32x2*)((const char*)P + (size_t)(tok0 + 16 * ct) * GIN_P * 2 + offG + 32 * vt);
                }
                if (ch < 7) gla_issue<OUT>(raw, (const char*)P + (size_t)(tok0 + 64) * GIN_P * 2, offQ, offV);
                if (ch < 7 && tid < 128) *(u32x4*)(ADL + tid * 8) = adn;
            }
            GLA_BARRIER();
            f32x4 o[2][4];
            if (OUT) {
#pragma unroll
                for (int t2 = 0; t2 < 2; ++t2) {
                    const int tl = 2 * w + t2, ct = tl >> 2, st = tl & 3;
                    f32x4 acc = (f32x4){0.f, 0.f, 0.f, 0.f};
                    if (st <= ct) {
#pragma unroll
                        for (int kk = 0; kk < 4; ++kk) {
                            const bf16x8 a = *(const bf16x8*)(KD + (16 * st + l15) * 136 + 32 * kk + 8 * g);
                            const bf16x8 bq = *(const bf16x8*)(QD + (16 * ct + l15) * 136 + 32 * kk + 8 * g);
                            acc = mfma16(a, bq, acc);
                        }
#pragma unroll
                        for (int r = 0; r < 4; ++r) if (16 * st + 4 * g + r > 16 * ct + l15) acc[r] = 0.f;
                    }
                    *(u32x2*)(ATT + (16 * ct + l15) * 72 + 16 * st + 4 * g) = g_pk4(acc);
                }
                GLA_BARRIER();
#pragma unroll
                for (int vt = 0; vt < 2; ++vt)
#pragma unroll
                    for (int ct = 0; ct < 4; ++ct) o[vt][ct] = (f32x4){0.f, 0.f, 0.f, 0.f};
#pragma unroll
                for (int kk = 0; kk < 4; ++kk) {
                    bf16x8 sa[2];
#pragma unroll
                    for (int vt = 0; vt < 2; ++vt) { const u32x2 s0 = g_pk4(S[2 * kk][vt]), s1 = g_pk4(S[2 * kk + 1][vt]); sa[vt] = as_bf16x8((u32x4){s0.x, s0.y, s1.x, s1.y}); }
#pragma unroll
                    for (int ct = 0; ct < 4; ++ct) {
                        const bf16_t* qr = QD + (16 * ct + l15) * 136 + 32 * kk + 4 * g;
                        const u32x2 lo = *(const u32x2*)qr, hi = *(const u32x2*)(qr + 16);
                        const bf16x8 bq = as_bf16x8((u32x4){lo.x, lo.y, hi.x, hi.y});
#pragma unroll
                        for (int vt = 0; vt < 2; ++vt) o[vt][ct] = mfma16(sa[vt], bq, o[vt][ct]);
                    }
                }
            }
            bf16x8 bv[2][2];
#pragma unroll
            for (int vt = 0; vt < 2; ++vt)
#pragma unroll
                for (int kk = 0; kk < 2; ++kk) bv[vt][kk] = g_trfrag<280>(VI, 32 * kk, 32 * w + 16 * vt, g, q4, p4);
            if (OUT) {
#pragma unroll
                for (int ct = 0; ct < 4; ++ct)
#pragma unroll
                    for (int kk = 0; kk < 2; ++kk) {
                        if (32 * kk <= 16 * ct + 15) {
                            const bf16x8 bq = *(const bf16x8*)(ATT + (16 * ct + l15) * 72 + 32 * kk + 8 * g);
#pragma unroll
                            for (int vt = 0; vt < 2; ++vt) o[vt][ct] = mfma16(bv[vt][kk], bq, o[vt][ct]);
                        }
                    }
            }
#pragma unroll
            for (int mt = 0; mt < 8; ++mt) {
                const f32x4 dv = *(const f32x4*)(DEC + 16 * mt + 4 * g);
#pragma unroll
                for (int vt = 0; vt < 2; ++vt) S[mt][vt] *= dv;
#pragma unroll
                for (int kk = 0; kk < 2; ++kk) {
                    const bf16x8 a = g_trfrag<152>(KTE, 32 * kk, 16 * mt, g, q4, p4);
#pragma unroll
                    for (int vt = 0; vt < 2; ++vt) S[mt][vt] = mfma16(a, bv[vt][kk], S[mt][vt]);
                }
            }
            if (OUT) {
                float ss[4];
#pragma unroll
                for (int ct = 0; ct < 4; ++ct) {
                    float s = 0.f;
#pragma unroll
                    for (int vt = 0; vt < 2; ++vt)
#pragma unroll
                        for (int r = 0; r < 4; ++r) s += o[vt][ct][r] * o[vt][ct][r];
                    s += __shfl_xor(s, 16); s += __shfl_xor(s, 32);
                    ss[ct] = s;
                }
                if (g == 0) {
#pragma unroll
                    for (int ct = 0; ct < 4; ++ct) SSQ[(16 * ct + l15) * 8 + w] = ss[ct];
                }
                GLA_BARRIER();
#pragma unroll
                for (int ct = 0; ct < 4; ++ct) {
                    const int cc = 16 * ct + l15;
                    const float4 s0 = *(const float4*)(SSQ + cc * 8), s1 = *(const float4*)(SSQ + cc * 8 + 4);
                    const float tot = (s0.x + s0.y) + (s0.z + s0.w) + (s1.x + s1.y) + (s1.z + s1.w);
                    const float rstd = rsqrtf(tot * (1.0f / 256.0f) + 1e-6f);
#pragma unroll
                    for (int vt = 0; vt < 2; ++vt) {
                        const f32x4 gt = g_unpk4(gate[vt][ct]);
                        f32x4 val;
#pragma unroll
                        for (int r = 0; r < 4; ++r) val[r] = o[vt][ct][r] * rstd * gh[vt][r] * gt[r];
                        *(u32x2*)((char*)Aout + (size_t)(tok0 + 16 * ct) * DM * 2 + offO + 32 * vt) = g_pk4(val);
                    }
                }
            } else {
                GLA_BARRIER();
            }
        }
        if (!OUT) {
#pragma unroll
            for (int mt = 0; mt < 8; ++mt)
#pragma unroll
                for (int vt = 0; vt < 2; ++vt) *(u32x2*)(GS + ((size_t)(bh * 32 + m) * 256 + 32 * w + 16 * vt + l15) * 128 + 16 * mt + 4 * g) = g_pk4(S[mt][vt]);
            if (g == 0) GD[(bh * 32 + m) * 128 + 16 * w + l15] = fexp(logD);
        }
        GLA_BARRIER();
    }
}

__device__ void gla_scan(const Params& p) {
    bf16_t* GS = (bf16_t*)(p.ws + WS_GS);
    const float* GD = (const float*)(p.ws + WS_GD);
    for (int idx = blockIdx.x * NTH + threadIdx.x; idx < 8 * 8192; idx += gridDim.x * NTH) {
        const int bh = idx >> 13, e = (idx & 8191) * 4, d = e & 127;
        f32x4 S = (f32x4){0.f, 0.f, 0.f, 0.f};
        for (int m0 = 0; m0 < 32; m0 += 8) {
            u32x2 t[8]; f32x4 dd[8];
#pragma unroll
            for (int m = 0; m < 8; ++m) { t[m] = *(const u32x2*)(GS + (size_t)(bh * 32 + m0 + m) * 32768 + e); dd[m] = *(const f32x4*)(GD + (bh * 32 + m0 + m) * 128 + d); }
#pragma unroll
            for (int m = 0; m < 8; ++m) { *(u32x2*)(GS + (size_t)(bh * 32 + m0 + m) * 32768 + e) = g_pk4(S); S = S * dd[m] + g_unpk4(t[m]); }
        }
    }
}

constexpr int PP = RIN_P;
constexpr size_t WS_RK  = WS_GS;
constexpr size_t WS_BND = WS_GS + (size_t)MTOK * 16 * 4;
static_assert(WS_BND + (size_t)513 * PP * 2 <= WS_GD, "RWKV side buffers must fit the GLA state region");
constexpr int IMG = 64 * 72 * 2;
constexpr int R_ALB = 0, R_BH = IMG, R_KH = 2 * IMG, R_RB = 3 * IMG, R_BTL = 4 * IMG, R_KTL = 5 * IMG, R_VI = 6 * IMG, R_AAB = 7 * IMG, R_AAK = 8 * IMG, R_ARB = 9 * IMG, R_ARK = 10 * IMG,
              R_DW = R_AAB, R_DA = R_AAB + 64 * 68 * 4, R_XT = 11 * IMG, R_TW = R_XT, R_ADI = R_XT + IMG, R_TDF = R_XT + 2 * IMG, R_CS = R_TDF + 2048, R_GC = R_CS + 2048, R_CONST = R_GC + 256, R_WDL = R_CONST + 2560, R_WIL = R_WDL + IMG,
              R_END = R_WIL + IMG;
static_assert(R_DA + 64 * 68 * 4 <= R_XT && R_END <= LDS_BYTES, "R1 LDS");
#define LDS_BARRIER() do { asm volatile("s_waitcnt lgkmcnt(0)" ::: "memory"); __builtin_amdgcn_s_barrier(); asm volatile("" ::: "memory"); } while (0)

typedef short s16x4 __attribute__((ext_vector_type(4)));
__device__ __forceinline__ bf16x8 ldfrag(const bf16_t* img, int row, int koff) { return *(const bf16x8*)(img + row * 72 + koff); }
__device__ __forceinline__ u32x2 pk4(f32x4 v) { u32x2 r; r.x = pk2(v[0], v[1]); r.y = pk2(v[2], v[3]); return r; }
__device__ __forceinline__ f32x4 unpk4(u32x2 v) { return (f32x4){bf2f(v.x & 0xffffu), bf2f(v.x >> 16), bf2f(v.y & 0xffffu), bf2f(v.y >> 16)}; }
__device__ __forceinline__ u32x2 trread(const bf16_t* p) {
    union { s16x4 s; u32x2 u; } x; x.s = __builtin_amdgcn_ds_read_tr16_b64_v4i16((__attribute__((address_space(3))) s16x4*)p); return x.u;
}
__device__ __forceinline__ bf16x8 trfrag(const bf16_t* img, int k0, int c0, int g, int q, int pq) {
    const bf16_t* a = img + (k0 + 8 * g + q) * 72 + c0 + 4 * pq;
    const u32x2 lo = trread(a), hi = trread(a + 4 * 72);
    return as_bf16x8((u32x4){lo.x, lo.y, hi.x, hi.y});
}
__device__ __forceinline__ f32x4 lo4(u32x4 v) { return (f32x4){bf2f(v.x & 0xffffu), bf2f(v.x >> 16), bf2f(v.y & 0xffffu), bf2f(v.y >> 16)}; }
__device__ __forceinline__ f32x4 hi4(u32x4 v) { return (f32x4){bf2f(v.z & 0xffffu), bf2f(v.z >> 16), bf2f(v.w & 0xffffu), bf2f(v.w >> 16)}; }
__device__ __forceinline__ u32x4 pk8(f32x4 a, f32x4 b) { return (u32x4){pk2(a[0], a[1]), pk2(a[2], a[3]), pk2(b[0], b[1]), pk2(b[2], b[3])}; }
__device__ __forceinline__ float fast_rcp(float x) { return __builtin_amdgcn_rcpf(x); }
__device__ __forceinline__ f32x4 mm16(f32x4 xa, f32x4 yb, f32x4 c) {
    const u32x2 a = pk4(xa), b = pk4(yb);
    return mfma16(as_bf16x8((u32x4){a.x, a.y, 0u, 0u}), as_bf16x8((u32x4){b.x, b.y, 0u, 0u}), c);
}

struct R1Raw { u32x4 r0, r1, k0, k1, v0, v1, w0, w1, a0, a1; };
__device__ __forceinline__ void r1_issue(R1Raw& x, const bf16_t* P, const bf16_t* BND, int unit, int t, int cs) {
    const int bn = unit >> 4, h = unit & 15, n = bn & 255;
    const bf16_t* cur = P + ((size_t)bn * 64 + t) * PP;
    const bf16_t* prv = (t > 0) ? (cur - PP) : (BND + (size_t)(n == 0 ? 0 : bn) * PP);
    const int ch = h * 64 + 8 * cs;
    x.r0 = *(const u32x4*)(cur + ch); x.k0 = *(const u32x4*)(cur + 1024 + ch); x.v0 = *(const u32x4*)(cur + 2048 + ch); x.w0 = *(const u32x4*)(cur + 4096 + 8 * cs); x.a0 = *(const u32x4*)(cur + 4160 + 8 * cs);
    x.r1 = *(const u32x4*)(prv + ch); x.k1 = *(const u32x4*)(prv + 1024 + ch); x.v1 = *(const u32x4*)(prv + 2048 + ch); x.w1 = *(const u32x4*)(prv + 4096 + 8 * cs); x.a1 = *(const u32x4*)(prv + 4160 + 8 * cs);
}
__device__ __forceinline__ void lerp8(u32x4 c, u32x4 pv, const float* mu8, f32x4& o0, f32x4& o1) {
    const f32x4 c0 = lo4(c), c1 = hi4(c), p0 = lo4(pv), p1 = hi4(pv);
    const f32x4 m0 = *(const f32x4*)mu8, m1 = *(const f32x4*)(mu8 + 4);
    o0 = c0 + m0 * (p0 - c0); o1 = c1 + m1 * (p1 - c1);
}

__device__ void rwkv_r1(const Params& p, unsigned char* lds) {
    const int tid = threadIdx.x, w = __builtin_amdgcn_readfirstlane(tid >> 6);
    bf16_t* P = (bf16_t*)(p.ws + WS_P);
    bf16_t* Abuf = (bf16_t*)(p.ws + WS_A);
    bf16_t* Ybuf = (bf16_t*)(p.ws + WS_Y);
    float* RK = (float*)(p.ws + WS_RK);
    const bf16_t* BND = (const bf16_t*)(p.ws + WS_BND);
    const bf16_t* WduT = (const bf16_t*)(p.ws + WS_WDUT);
    const bf16_t* WiuT = (const bf16_t*)(p.ws + WS_WIUT);
    bf16_t* ALB = (bf16_t*)(lds + R_ALB); bf16_t* BH = (bf16_t*)(lds + R_BH); bf16_t* KH = (bf16_t*)(lds + R_KH); bf16_t* RB = (bf16_t*)(lds + R_RB);
    bf16_t* BTL = (bf16_t*)(lds + R_BTL); bf16_t* KTL = (bf16_t*)(lds + R_KTL); bf16_t* VI = (bf16_t*)(lds + R_VI);
    bf16_t* AAB = (bf16_t*)(lds + R_AAB); bf16_t* AAK = (bf16_t*)(lds + R_AAK); bf16_t* ARB = (bf16_t*)(lds + R_ARB); bf16_t* ARK = (bf16_t*)(lds + R_ARK);
    float* DW = (float*)(lds + R_DW); float* DA = (float*)(lds + R_DA);
    bf16_t* XT = (bf16_t*)(lds + R_XT); bf16_t* TW = (bf16_t*)(lds + R_TW); bf16_t* ADI = (bf16_t*)(lds + R_ADI);
    u32x2* TDF = (u32x2*)(lds + R_TDF); float* CS = (float*)(lds + R_CS); float* GCs = (float*)(lds + R_GC); float* CONST = (float*)(lds + R_CONST); bf16_t* WDL = (bf16_t*)(lds + R_WDL); bf16_t* WIL = (bf16_t*)(lds + R_WIL);
    const int t0_ = tid >> 3, cs0_ = tid & 7;
    int hprev = -1;
    R1Raw raw;
    if (blockIdx.x < 8192) r1_issue(raw, P, BND, blockIdx.x, t0_, cs0_);

    for (int unit = blockIdx.x; unit < 8192; unit += gridDim.x) {
        const int bn = unit >> 4, h = unit & 15, n = bn & 255;
        const size_t R0 = (size_t)bn * 64;
        int tidv = tid; asm volatile("" : "+v"(tidv));
        const int lane = tidv & 63, l15 = lane & 15, g = lane >> 4, q4 = l15 >> 2, p4 = l15 & 3, t = tidv >> 3, cs = tidv & 7, tl = lane >> 3;
        if (h != hprev) {
            LDS_BARRIER();
            if (tid < 64) {
                const int ch = h * 64 + tid;
                CONST[tid] = p.in[10][ch]; CONST[64 + tid] = p.in[10][1024 + ch]; CONST[128 + tid] = p.in[10][2048 + ch];
                CONST[192 + tid] = p.in[11][ch]; CONST[256 + tid] = p.in[13][ch]; CONST[320 + tid] = p.in[15][ch]; CONST[384 + tid] = p.in[16][ch]; CONST[448 + tid] = p.in[17][ch];
                CONST[512 + tid] = p.in[10][4096 + tid]; CONST[576 + tid] = p.in[10][4160 + tid];
            }
            {
                const int rr = tid >> 3, sg = tid & 7;
                *(u32x4*)(WDL + rr * 72 + 8 * sg) = *(const u32x4*)(WduT + (size_t)(h * 64 + rr) * 64 + 8 * sg);
                *(u32x4*)(WIL + rr * 72 + 8 * sg) = *(const u32x4*)(WiuT + (size_t)(h * 64 + rr) * 64 + 8 * sg);
            }
            hprev = h;
            LDS_BARRIER();
        }
        f32x4 r0, r1, k0, k1, v0, v1;
        {
            f32x4 wd0, wd1, ad0, ad1;
            lerp8(raw.r0, raw.r1, CONST + 8 * cs, r0, r1);
            lerp8(raw.k0, raw.k1, CONST + 64 + 8 * cs, k0, k1);
            lerp8(raw.v0, raw.v1, CONST + 128 + 8 * cs, v0, v1);
            lerp8(raw.w0, raw.w1, CONST + 512 + 8 * cs, wd0, wd1);
            lerp8(raw.a0, raw.a1, CONST + 576 + 8 * cs, ad0, ad1);
#pragma unroll
            for (int j = 0; j < 4; ++j) {
                const float e0 = fexp(-2.f * fabsf(wd0[j])), e1 = fexp(-2.f * fabsf(wd1[j]));
                wd0[j] = copysignf((1.f - e0) * fast_rcp(1.f + e0), wd0[j]); wd1[j] = copysignf((1.f - e1) * fast_rcp(1.f + e1), wd1[j]);
            }
            *(u32x4*)(TW + t * 72 + 8 * cs) = pk8(wd0, wd1);
            *(u32x4*)(ADI + t * 72 + 8 * cs) = pk8(ad0, ad1);
        }
        if (unit + (int)gridDim.x < 8192) r1_issue(raw, P, BND, unit + gridDim.x, t, cs);
        LDS_BARRIER();
        {
            const int tt = w & 3;
            bf16x8 ft[2], fa[2];
#pragma unroll
            for (int kk = 0; kk < 2; ++kk) { ft[kk] = ldfrag(TW, 16 * tt + l15, 32 * kk + 8 * g); fa[kk] = ldfrag(ADI, 16 * tt + l15, 32 * kk + 8 * g); }
#pragma unroll
            for (int q = 0; q < 2; ++q) {
                const int ct = 2 * (w >> 2) + q;
                f32x4 aw = (f32x4){0.f, 0.f, 0.f, 0.f}, aa = aw;
#pragma unroll
                for (int kk = 0; kk < 2; ++kk) { aw = mfma16(ldfrag(WDL, 16 * ct + l15, 32 * kk + 8 * g), ft[kk], aw); aa = mfma16(ldfrag(WIL, 16 * ct + l15, 32 * kk + 8 * g), fa[kk], aa); }
                *(f32x4*)(DW + (16 * tt + l15) * 68 + 16 * ct + 4 * g) = aw;
                *(f32x4*)(DA + (16 * tt + l15) * 68 + 16 * ct + 4 * g) = aa;
            }
        }
        LDS_BARRIER();
        f32x4 lw[2], av[2], kk[2], k2[2], G[2];
        {
            const f32x4 cw0[2] = {*(const f32x4*)(CONST + 192 + 8 * cs), *(const f32x4*)(CONST + 196 + 8 * cs)};
            const f32x4 ca0[2] = {*(const f32x4*)(CONST + 256 + 8 * cs), *(const f32x4*)(CONST + 260 + 8 * cs)};
            const f32x4 ckk[2] = {*(const f32x4*)(CONST + 320 + 8 * cs), *(const f32x4*)(CONST + 324 + 8 * cs)};
            const f32x4 cka[2] = {*(const f32x4*)(CONST + 384 + 8 * cs), *(const f32x4*)(CONST + 388 + 8 * cs)};
            const f32x4 crk[2] = {*(const f32x4*)(CONST + 448 + 8 * cs), *(const f32x4*)(CONST + 452 + 8 * cs)};
            const f32x4 dwv[2] = {*(const f32x4*)(DW + t * 68 + 8 * cs), *(const f32x4*)(DW + t * 68 + 8 * cs + 4)};
            const f32x4 dav[2] = {*(const f32x4*)(DA + t * 68 + 8 * cs), *(const f32x4*)(DA + t * 68 + 8 * cs + 4)};
            const f32x4 kin[2] = {k0, k1}, rin[2] = {r0, r1};
            float n2 = 0.f, rk = 0.f;
#pragma unroll
            for (int hf = 0; hf < 2; ++hf)
#pragma unroll
                for (int j = 0; j < 4; ++j) {
                    const float z = -(cw0[hf][j] + dwv[hf][j]);
                    const float sp = fmaxf(z, 0.f) + flog(1.f + fexp(-fabsf(z)));
                    lw[hf][j] = -fexp(-sp - 0.5f);
                    av[hf][j] = fast_rcp(1.f + fexp(-(ca0[hf][j] + dav[hf][j])));
                    kk[hf][j] = kin[hf][j] * ckk[hf][j];
                    k2[hf][j] = kin[hf][j] * (1.f + (av[hf][j] - 1.f) * cka[hf][j]);
                    n2 += kk[hf][j] * kk[hf][j]; rk += rin[hf][j] * k2[hf][j] * crk[hf][j];
                }
            n2 += __shfl_xor(n2, 1); rk += __shfl_xor(rk, 1); n2 += __shfl_xor(n2, 2); rk += __shfl_xor(rk, 2); n2 += __shfl_xor(n2, 4); rk += __shfl_xor(rk, 4);
            const float inv = 1.0f / fmaxf(sqrtf(n2), 1e-12f);
            kk[0] *= inv; kk[1] *= inv;
            if (cs == 0) RK[(R0 + t) * 16 + h] = rk;
            G[0] = lw[0]; G[1] = lw[1];
#pragma unroll
            for (int d = 1; d < 8; d <<= 1)
#pragma unroll
                for (int hf = 0; hf < 2; ++hf)
#pragma unroll
                    for (int j = 0; j < 4; ++j) { const float y = __shfl_up(G[hf][j], 8 * d); if (tl >= d) G[hf][j] += y; }
            if (tl == 7) { *(f32x4*)(CS + w * 64 + 8 * cs) = G[0]; *(f32x4*)(CS + w * 64 + 8 * cs + 4) = G[1]; }
        }
        LDS_BARRIER();
        {
            f32x4 off[2] = {(f32x4){0.f, 0.f, 0.f, 0.f}, (f32x4){0.f, 0.f, 0.f, 0.f}}, gc[2] = {off[0], off[0]};
#pragma unroll
            for (int q = 0; q < 8; ++q) {
                const f32x4 c0 = *(const f32x4*)(CS + q * 64 + 8 * cs), c1 = *(const f32x4*)(CS + q * 64 + 8 * cs + 4);
                const float mk = (q < w) ? 1.f : 0.f;
                gc[0] += c0; gc[1] += c1; off[0] += c0 * mk; off[1] += c1 * mk;
            }
            f32x4 al[2], bh[2], kh[2], rb[2];
            const f32x4 rin[2] = {r0, r1};
#pragma unroll
            for (int hf = 0; hf < 2; ++hf)
#pragma unroll
                for (int j = 0; j < 4; ++j) {
                    const float Gi = G[hf][j] + off[hf][j];
                    const float eG = fexp(Gi), eGm = fexp(Gi - lw[hf][j]), enG = fast_rcp(eG);
                    const float be = kk[hf][j] * av[hf][j];
                    al[hf][j] = -kk[hf][j] * eGm; bh[hf][j] = be * enG; kh[hf][j] = k2[hf][j] * enG; rb[hf][j] = rin[hf][j] * eG;
                }
            const int o = t * 72 + 8 * cs;
            *(u32x4*)(ALB + o) = pk8(al[0], al[1]); *(u32x4*)(BH + o) = pk8(bh[0], bh[1]); *(u32x4*)(KH + o) = pk8(kh[0], kh[1]); *(u32x4*)(RB + o) = pk8(rb[0], rb[1]);
            const u32x4 vpk = pk8(v0, v1);
            *(u32x4*)(VI + o) = vpk;
            *(u32x4*)(Ybuf + (R0 + t) * DM + h * 64 + 8 * cs) = vpk;
            if (w == 0 && tl == 0) { f32x4 e0, e1;
#pragma unroll
                for (int j = 0; j < 4; ++j) { e0[j] = fexp(gc[0][j]); e1[j] = fexp(gc[1][j]); }
                *(f32x4*)(GCs + 8 * cs) = e0; *(f32x4*)(GCs + 8 * cs + 4) = e1; }
        }
        LDS_BARRIER();
        {
            int ntile = 1, tta = 0, sta = 0, ttb = 0, stb = 0;
            if (w == 0) { tta = 0; sta = 0; } else if (w == 2) { tta = 1; sta = 1; } else if (w == 5) { tta = 2; sta = 2; } else if (w == 7) { tta = 3; sta = 3; }
            else if (w == 1) { ntile = 2; tta = 1; sta = 0; ttb = 2; stb = 0; } else if (w == 3) { ntile = 2; tta = 2; sta = 1; ttb = 3; stb = 0; }
            else if (w == 4) { tta = 3; sta = 1; } else { tta = 3; sta = 2; }
            for (int it = 0; it < ntile; ++it) {
                const int tt = it ? ttb : tta, st = it ? stb : sta;
                f32x4 cab = (f32x4){0.f, 0.f, 0.f, 0.f}, cak = cab, crb = cab, crk = cab, nab = cab;
#pragma unroll
                for (int kq = 0; kq < 2; ++kq) {
                    const bf16x8 fb = ldfrag(BH, 16 * st + l15, 32 * kq + 8 * g), fk = ldfrag(KH, 16 * st + l15, 32 * kq + 8 * g);
                    const bf16x8 fa = ldfrag(ALB, 16 * tt + l15, 32 * kq + 8 * g), fr = ldfrag(RB, 16 * tt + l15, 32 * kq + 8 * g);
                    cab = mfma16(fb, fa, cab); cak = mfma16(fk, fa, cak); crb = mfma16(fb, fr, crb); crk = mfma16(fk, fr, crk);
                    if (tt == st) nab = mfma16(fa, fb, nab);
                }
                if (tt == st) {
#pragma unroll
                    for (int r = 0; r < 4; ++r) {
                        const int s = 4 * g + r, tq = l15;
                        if (s >= tq) { cab[r] = 0.f; cak[r] = 0.f; }
                        if (s > tq) { crb[r] = 0.f; crk[r] = 0.f; }
                        if (l15 >= 4 * g + r) nab[r] = 0.f;
                    }
                }
                const int o = (16 * tt + l15) * 72 + 16 * st + 4 * g;
                *(u32x2*)(AAB + o) = pk4(cab); *(u32x2*)(AAK + o) = pk4(cak); *(u32x2*)(ARB + o) = pk4(crb); *(u32x2*)(ARK + o) = pk4(crk);
                if (tt == st) {
                    const f32x4 z = (f32x4){0.f, 0.f, 0.f, 0.f};
                    const f32x4 Q1 = cab, N1 = nab;
                    const f32x4 Q2 = mm16(N1, Q1, z), N2 = mm16(Q1, N1, z);
                    f32x4 Pm = Q1;
#pragma unroll
                    for (int r = 0; r < 4; ++r) if (4 * g + r == l15) Pm[r] += 1.f;
                    Pm = mm16(N2, Pm, Pm);
                    const f32x4 Q4 = mm16(N2, Q2, z), N4 = mm16(Q2, N2, z);
                    Pm = mm16(N4, Pm, Pm);
                    const f32x4 N8 = mm16(Q4, N4, z);
                    Pm = mm16(N8, Pm, Pm);
                    TDF[tt * 64 + lane] = pk4(Pm);
                }
            }
            if (w == 4 || w == 6) {
                const int tt = (w == 4) ? 0 : 2, st = tt + 1;
                const int o = (16 * tt + l15) * 72 + 16 * st + 4 * g;
                const u32x2 zz = (u32x2){0u, 0u};
                *(u32x2*)(AAK + o) = zz; *(u32x2*)(ARB + o) = zz; *(u32x2*)(ARK + o) = zz;
            }
        }
        LDS_BARRIER();
        {
            u32x2 xb[4];
            const int col = 16 * w + l15;
            bf16x8 vfr[2];
            if (w >= 4) { vfr[0] = trfrag(VI, 0, 16 * (w - 4), g, q4, p4); vfr[1] = trfrag(VI, 32, 16 * (w - 4), g, q4, p4); }
#pragma unroll
            for (int i = 0; i < 4; ++i) {
                f32x4 z;
                if (w < 4) z = unpk4(trread(ALB + (16 * i + 4 * g + q4) * 72 + 16 * w + 4 * p4));
                else {
                    z = mfma16(ldfrag(AAK, 16 * i + l15, 8 * g), vfr[0], (f32x4){0.f, 0.f, 0.f, 0.f});
                    if (i >= 2) z = mfma16(ldfrag(AAK, 16 * i + l15, 32 + 8 * g), vfr[1], z);
                }
                if (i >= 1) {
                    const bf16_t* ar = AAB + (16 * i + l15) * 72 + 4 * g;
                    const u32x2 a0 = *(const u32x2*)ar;
                    u32x2 a1 = (u32x2){0u, 0u}, b1 = (u32x2){0u, 0u};
                    if (i >= 2) { a1 = *(const u32x2*)(ar + 16); b1 = xb[1]; }
                    z = mfma16(as_bf16x8((u32x4){a0.x, a0.y, a1.x, a1.y}), as_bf16x8((u32x4){xb[0].x, xb[0].y, b1.x, b1.y}), z);
                    if (i == 3) {
                        const u32x2 a2 = *(const u32x2*)(ar + 32);
                        z = mfma16(as_bf16x8((u32x4){a2.x, a2.y, 0u, 0u}), as_bf16x8((u32x4){xb[2].x, xb[2].y, 0u, 0u}), z);
                    }
                }
                const u32x2 tq = TDF[i * 64 + lane];
                const u32x2 zq = pk4(z);
                const f32x4 x = mfma16(as_bf16x8((u32x4){tq.x, tq.y, 0u, 0u}), as_bf16x8((u32x4){zq.x, zq.y, 0u, 0u}), (f32x4){0.f, 0.f, 0.f, 0.f});
                xb[i] = pk4(x);
                *(u32x2*)(XT + col * 72 + 16 * i + 4 * g) = xb[i];
            }
        }
        LDS_BARRIER();
        {
            const int rt_ = w & 3, c0 = 2 * (w >> 2);
            bf16x8 xw[2], xu[2], fbt[2], fkt[2], fvr[2];
#pragma unroll
            for (int kq = 0; kq < 2; ++kq) {
                xw[kq] = ldfrag(XT, 16 * rt_ + l15, 32 * kq + 8 * g);
                xu[kq] = ldfrag(XT, 64 + 16 * rt_ + l15, 32 * kq + 8 * g);
                fbt[kq] = trfrag(BH, 32 * kq, 16 * rt_, g, q4, p4);
                fkt[kq] = trfrag(KH, 32 * kq, 16 * rt_, g, q4, p4);
                fvr[kq] = trfrag(VI, 32 * kq, 16 * rt_, g, q4, p4);
            }
            const float gcd0 = GCs[16 * c0 + l15], gcd1 = GCs[16 * c0 + 16 + l15];
            const f32x4 gcr = *(const f32x4*)(GCs + 16 * rt_ + 4 * g);
#pragma unroll
            for (int q = 0; q < 2; ++q) {
                bf16x8 gbt[2], garb[2], gxu[2], gvi[2], gark[2];
#pragma unroll
                for (int kq = 0; kq < 2; ++kq) {
                    gbt[kq] = trfrag(BH, 32 * kq, 16 * (c0 + q), g, q4, p4);
                    garb[kq] = ldfrag(ARB, 16 * (c0 + q) + l15, 32 * kq + 8 * g);
                    gxu[kq] = ldfrag(XT, 64 + 16 * (c0 + q) + l15, 32 * kq + 8 * g);
                    gvi[kq] = trfrag(VI, 32 * kq, 16 * (c0 + q), g, q4, p4);
                    gark[kq] = ldfrag(ARK, 16 * (c0 + q) + l15, 32 * kq + 8 * g);
                }
                const u32x2 rbi = *(const u32x2*)(RB + (16 * (c0 + q) + l15) * 72 + 16 * rt_ + 4 * g);
                __builtin_amdgcn_sched_barrier(0);
                const int ctile = c0 + q;
                {
                    f32x4 acc = (f32x4){0.f, 0.f, 0.f, 0.f};
#pragma unroll
                    for (int kq = 0; kq < 2; ++kq) acc = mfma16(xw[kq], gbt[kq], acc);
                    const int dcol = 16 * ctile + l15;
                    if (rt_ == ctile) {
#pragma unroll
                        for (int r = 0; r < 4; ++r) if (4 * g + r == l15) acc[r] += 1.f;
                    }
                    acc *= (q ? gcd1 : gcd0);
                    *(u32x2*)(ALB + dcol * 72 + 32 * (rt_ >> 1) + 8 * g + 4 * (rt_ & 1)) = pk4(acc);
                }
                {
                    f32x4 acc = unpk4(rbi);
#pragma unroll
                    for (int kq = 0; kq < 2; ++kq) {
                        if (32 * kq <= 16 * ctile + 15) acc = mfma16(xw[kq], garb[kq], acc);
                    }
                    *(u32x2*)(BTL + (16 * ctile + l15) * 72 + 16 * rt_ + 4 * g) = pk4(acc);
                }
                {
                    f32x4 acc = (f32x4){0.f, 0.f, 0.f, 0.f};
#pragma unroll
                    for (int kq = 0; kq < 2; ++kq) { acc = mfma16(fbt[kq], gxu[kq], acc); acc = mfma16(fkt[kq], gvi[kq], acc); }
                    *(u32x2*)(KTL + (16 * ctile + l15) * 72 + 16 * rt_ + 4 * g) = pk4(acc * gcr);
                }
                {
                    f32x4 acc = (f32x4){0.f, 0.f, 0.f, 0.f};
#pragma unroll
                    for (int kq = 0; kq < 2; ++kq) {
                        if (32 * kq <= 16 * ctile + 15) { acc = mfma16(xu[kq], garb[kq], acc); acc = mfma16(fvr[kq], gark[kq], acc); }
                    }
                    *(u32x2*)(AAB + (16 * ctile + l15) * 72 + 16 * rt_ + 4 * g) = pk4(acc);
                }
            }
        }
        LDS_BARRIER();
        {
            const int o = t * 72 + 8 * cs;
            *(u32x4*)(P + (R0 + t) * PP + h * 64 + 8 * cs) = *(const u32x4*)(ALB + o);
            *(u32x4*)(P + (R0 + t) * PP + 1024 + h * 64 + 8 * cs) = *(const u32x4*)(BTL + o);
            *(u32x4*)(P + (R0 + t) * PP + 2048 + h * 64 + 8 * cs) = *(const u32x4*)(KTL + o);
            *(u32x4*)(Abuf + (R0 + t) * DM + h * 64 + 8 * cs) = *(const u32x4*)(AAB + o);
        }
    }
}

constexpr int SC_SLOT = 2 * IMG;
constexpr size_t WS_MG = (WS_BND + (size_t)513 * PP * 2 + 255) & ~(size_t)255;
constexpr size_t WS_NG = WS_MG + (size_t)1024 * 4096 * 2;
static_assert(WS_NG + (size_t)1024 * 4096 * 2 <= WS_GD, "scan buffers must fit the GLA state region");

template <int MODE>
__device__ void rwkv_scan2(const Params& p, unsigned char* lds) {
    constexpr int GSZ = 32, NGRP = 256 / GSZ, LG = 3;
    constexpr int SPU = (MODE == 2) ? NGRP : GSZ;
    constexpr int NU = (MODE == 2) ? 32 : 32 * NGRP;
    const int tid = threadIdx.x, lane = tid & 63, w = __builtin_amdgcn_readfirstlane(tid >> 6), l15 = lane & 15, g = lane >> 4;
    bf16_t* P = (bf16_t*)(p.ws + WS_P);
    bf16_t* MG = (bf16_t*)(p.ws + WS_MG); bf16_t* NG = (bf16_t*)(p.ws + WS_NG); bf16_t* HG = NG;
    const int G = gridDim.x;
    const int nun = ((int)blockIdx.x < NU) ? (NU - 1 - (int)blockIdx.x) / G + 1 : 0;
    const int T = nun * SPU;
    if (T == 0) return;
#define SC_SRC(s, p0, p1, pitchb) \
    const int u_ = (int)blockIdx.x + G * ((s) / SPU), j_ = (s) % SPU; \
    const char* p0; const char* p1; unsigned pitchb; \
    if (MODE == 2) { p0 = (const char*)(MG + (size_t)(u_ * NGRP + j_) * 4096); p1 = (const char*)(NG + (size_t)(u_ * NGRP + j_) * 4096); pitchb = 128u; } \
    else { const int bh_ = u_ >> LG, n_ = GSZ * (u_ & (NGRP - 1)) + j_; p0 = (const char*)(P + ((size_t)(bh_ >> 4) * SEQ + (size_t)n_ * 64) * PP + (bh_ & 15) * 64); p1 = p0 + 4096; pitchb = (unsigned)(PP * 2); }
    if (w >= 4) {
        const int lj = w - 4;
        const unsigned loff = (unsigned)((lane >> 3) * 144 + (lane & 7) * 16);
        u32x4 ld0[16], ld1[16];
#define SC_ISSUE(dst, s) do { const int sc_ = ((s) < T) ? (s) : T - 1; SC_SRC(sc_, q0_, q1_, pb_) const unsigned go_ = (unsigned)(lane >> 3) * pb_ + (unsigned)(lane & 7) * 16u; \
        _Pragma("unroll") for (int q = 0; q < 16; ++q) dst[q] = *(const u32x4*)(((q >> 3) ? q1_ : q0_) + (size_t)((q & 7) * 8) * pb_ + go_); } while (0)
#define SC_RETIRE(src, s) do { unsigned char* sb = lds + ((s) & 1) * SC_SLOT + loff; _Pragma("unroll") for (int q = 0; q < 16; ++q) \
        *(u32x4*)(sb + (q >> 3) * IMG + (q & 7) * 8 * 144) = src[q]; } while (0)
        SC_ISSUE(ld0, lj); SC_ISSUE(ld1, lj + 4);
        for (int it = 0; it < T / 8; ++it) {
            const int c0 = lj + 8 * it;
            for (int k = 0; k < lj; ++k) LDS_BARRIER();
            SC_RETIRE(ld0, c0); SC_ISSUE(ld0, c0 + 8);
            for (int k = 0; k < 4; ++k) LDS_BARRIER();
            SC_RETIRE(ld1, c0 + 4); SC_ISSUE(ld1, c0 + 12);
            for (int k = 0; k < 4 - lj; ++k) LDS_BARRIER();
        }
        LDS_BARRIER();
#undef SC_ISSUE
#undef SC_RETIRE
    } else {
        f32x4 H[4], Mg[4];
        for (int i = 0; i <= T; ++i) {
            if (i >= 1) {
                const int s = i - 1, u = (int)blockIdx.x + G * (s / SPU), j = s % SPU;
                const unsigned char* sb = lds + (s & 1) * SC_SLOT;
                const bf16_t* MT = (const bf16_t*)sb; const bf16_t* NT = (const bf16_t*)(sb + IMG);
                if (j == 0) {
                    if (MODE == 3) {
#pragma unroll
                        for (int mt = 0; mt < 4; ++mt) H[mt] = unpk4(*(const u32x2*)(HG + (size_t)u * 4096 + (16 * w + l15) * 64 + 16 * mt + 4 * g));
                    } else {
#pragma unroll
                        for (int mt = 0; mt < 4; ++mt) H[mt] = (f32x4){0.f, 0.f, 0.f, 0.f};
                    }
                    if (MODE == 1) {
#pragma unroll
                        for (int mt = 0; mt < 4; ++mt)
#pragma unroll
                            for (int r = 0; r < 4; ++r) Mg[mt][r] = (16 * mt + 4 * g + r == 16 * w + l15) ? 1.f : 0.f;
                    }
                }
                u32x2 hp[4];
#pragma unroll
                for (int mt = 0; mt < 4; ++mt) hp[mt] = pk4(H[mt]);
                if (MODE == 2) {
#pragma unroll
                    for (int mt = 0; mt < 4; ++mt) *(u32x2*)(HG + (size_t)(u * NGRP + j) * 4096 + (16 * w + l15) * 64 + 16 * mt + 4 * g) = hp[mt];
                }
                if (MODE == 3) {
                    const int bh = u >> LG, n = GSZ * (u & (NGRP - 1)) + j;
#pragma unroll
                    for (int mt = 0; mt < 4; ++mt) *(u32x2*)(P + ((size_t)(bh >> 4) * SEQ + (size_t)n * 64 + 16 * w + l15) * PP + 2048 + (bh & 15) * 64 + 16 * mt + 4 * g) = hp[mt];
                }
                bf16x8 hb[2], mb[2];
                hb[0] = as_bf16x8((u32x4){hp[0].x, hp[0].y, hp[1].x, hp[1].y});
                hb[1] = as_bf16x8((u32x4){hp[2].x, hp[2].y, hp[3].x, hp[3].y});
                if (MODE == 1) {
                    const u32x2 m0 = pk4(Mg[0]), m1 = pk4(Mg[1]), m2 = pk4(Mg[2]), m3 = pk4(Mg[3]);
                    mb[0] = as_bf16x8((u32x4){m0.x, m0.y, m1.x, m1.y}); mb[1] = as_bf16x8((u32x4){m2.x, m2.y, m3.x, m3.y});
                }
#pragma unroll
                for (int mt = 0; mt < 4; ++mt) {
                    const bf16x8 a0 = ldfrag(MT, 16 * mt + l15, 8 * g), a1 = ldfrag(MT, 16 * mt + l15, 32 + 8 * g);
                    f32x4 acc = unpk4(*(const u32x2*)(NT + (16 * w + l15) * 72 + 16 * mt + 4 * g));
                    acc = mfma16(a0, hb[0], acc); acc = mfma16(a1, hb[1], acc);
                    H[mt] = acc;
                    if (MODE == 1) { f32x4 am = mfma16(a0, mb[0], (f32x4){0.f, 0.f, 0.f, 0.f}); am = mfma16(a1, mb[1], am); Mg[mt] = am; }
                }
                if (MODE == 1 && j == SPU - 1) {
                    const int pc = 32 * (w >> 1) + 8 * (l15 >> 2) + 4 * (w & 1) + (l15 & 3);
#pragma unroll
                    for (int mt = 0; mt < 4; ++mt) {
                        *(u32x2*)(NG + (size_t)u * 4096 + (16 * w + l15) * 64 + 16 * mt + 4 * g) = pk4(H[mt]);
#pragma unroll
                        for (int r = 0; r < 4; ++r) MG[(size_t)u * 4096 + (16 * mt + 4 * g + r) * 64 + pc] = f2bf(Mg[mt][r]);
                    }
                }
            }
            LDS_BARRIER();
        }
    }
#undef SC_SRC
}

__device__ void rwkv_post(const Params& p, unsigned char* lds) {
    const int tid = threadIdx.x, lane = tid & 63, w = __builtin_amdgcn_readfirstlane(tid >> 6), l15 = lane & 15, g = lane >> 4;
    const bf16_t* P = (const bf16_t*)(p.ws + WS_P);
    bf16_t* Abuf = (bf16_t*)(p.ws + WS_A);
    const bf16_t* Ybuf = (const bf16_t*)(p.ws + WS_Y);
    const float* RK = (const float*)(p.ws + WS_RK);
    const bf16_t* BND = (const bf16_t*)(p.ws + WS_BND);
    float* L = (float*)(lds + w * 8704);
    const int tr = lane >> 3, seg = lane & 7;
    for (int hu = blockIdx.x * 8 + w; hu < 16384; hu += gridDim.x * 8) {
        const int unit = hu >> 1, t0 = (hu & 1) * 32;
        const int bn = unit >> 4, h = unit & 15, n = bn & 255;
        const size_t R0 = (size_t)bn * 64;
        bf16x8 fh[4][2], fr[2][2];
#pragma unroll
        for (int kk = 0; kk < 2; ++kk) {
#pragma unroll
            for (int q = 0; q < 4; ++q) fh[q][kk] = *(const bf16x8*)(P + (R0 + 16 * q + l15) * PP + 2048 + h * 64 + 32 * kk + 8 * g);
#pragma unroll
            for (int q = 0; q < 2; ++q) fr[q][kk] = *(const bf16x8*)(P + (R0 + t0 + 16 * q + l15) * PP + 1024 + h * 64 + 32 * kk + 8 * g);
        }
        u32x4 y0r[4], g1r[4], g0r[4], vpr[4];
        float rkv[4];
#pragma unroll
        for (int i = 0; i < 4; ++i) {
            const int t = t0 + tr + 8 * i;
            y0r[i] = *(const u32x4*)(Abuf + (R0 + t) * DM + h * 64 + 8 * seg);
            const bf16_t* grow = P + (R0 + t) * PP + 3072 + h * 64 + 8 * seg;
            g1r[i] = *(const u32x4*)grow;
            g0r[i] = *(const u32x4*)((t > 0) ? (grow - PP) : (BND + (size_t)(n == 0 ? 0 : bn) * PP + 3072 + h * 64 + 8 * seg));
            vpr[i] = *(const u32x4*)(Ybuf + (R0 + t) * DM + h * 64 + 8 * seg);
            rkv[i] = RK[(R0 + t) * 16 + h];
        }
#pragma unroll
        for (int i = 0; i < 4; ++i) { *(f32x4*)(L + (tr + 8 * i) * 68 + 8 * seg) = lo4(y0r[i]); *(f32x4*)(L + (tr + 8 * i) * 68 + 8 * seg + 4) = hi4(y0r[i]); }
        f32x4 y[4][2];
#pragma unroll
        for (int vt = 0; vt < 4; ++vt)
#pragma unroll
            for (int tt = 0; tt < 2; ++tt) y[vt][tt] = *(const f32x4*)(L + (16 * tt + l15) * 68 + 16 * vt + 4 * g);
#pragma unroll
        for (int vt = 0; vt < 4; ++vt)
#pragma unroll
            for (int tt = 0; tt < 2; ++tt)
#pragma unroll
                for (int kk = 0; kk < 2; ++kk) y[vt][tt] = mfma16(fh[vt][kk], fr[tt][kk], y[vt][tt]);
#pragma unroll
        for (int tt = 0; tt < 2; ++tt) {
            float s1 = 0.f, s2 = 0.f;
#pragma unroll
            for (int vt = 0; vt < 4; ++vt)
#pragma unroll
                for (int r = 0; r < 4; ++r) { s1 += y[vt][tt][r]; s2 += y[vt][tt][r] * y[vt][tt][r]; }
            s1 += __shfl_xor(s1, 16); s2 += __shfl_xor(s2, 16); s1 += __shfl_xor(s1, 32); s2 += __shfl_xor(s2, 32);
            const float mean = s1 * (1.0f / 64.0f);
            const float rstd = rsqrtf(fmaxf(s2 * (1.0f / 64.0f) - mean * mean, 0.f) + 64e-5f);
#pragma unroll
            for (int vt = 0; vt < 4; ++vt) *(f32x4*)(L + (16 * tt + l15) * 68 + 16 * vt + 4 * g) = (y[vt][tt] - mean) * rstd;
        }
        const int ch = h * 64 + 8 * seg;
        const f32x4 lw0 = *(const f32x4*)(p.in[18] + ch), lw1 = *(const f32x4*)(p.in[18] + ch + 4), lb0 = *(const f32x4*)(p.in[19] + ch), lb1 = *(const f32x4*)(p.in[19] + ch + 4);
        const f32x4 mg0 = *(const f32x4*)(p.in[10] + 3072 + ch), mg1 = *(const f32x4*)(p.in[10] + 3072 + ch + 4);
#pragma unroll
        for (int i = 0; i < 4; ++i) {
            const int t = t0 + tr + 8 * i;
            const f32x4 n0 = *(const f32x4*)(L + (tr + 8 * i) * 68 + 8 * seg), n1 = *(const f32x4*)(L + (tr + 8 * i) * 68 + 8 * seg + 4);
            const f32x4 ga0 = lo4(g1r[i]), ga1 = hi4(g1r[i]);
            const f32x4 gb0 = lo4(g0r[i]), gb1 = hi4(g0r[i]);
            const f32x4 gt0 = ga0 + mg0 * (gb0 - ga0), gt1 = ga1 + mg1 * (gb1 - ga1);
            const f32x4 v0 = lo4(vpr[i]), v1 = hi4(vpr[i]);
            f32x4 o0 = n0 * lw0 + lb0 + rkv[i] * v0, o1 = n1 * lw1 + lb1 + rkv[i] * v1;
#pragma unroll
            for (int j = 0; j < 4; ++j) { o0[j] *= gt0[j] * __builtin_amdgcn_rcpf(1.0f + fexp(-gt0[j])); o1[j] *= gt1[j] * __builtin_amdgcn_rcpf(1.0f + fexp(-gt1[j])); }
            *(u32x4*)(Abuf + (R0 + t) * DM + h * 64 + 8 * seg) = pk8(o0, o1);
        }
    }
}
#define XB_TMO      128
#define XB_XCNT(j)  (256  + 64 * (j))
#define XB_XSUB(j)  (1280 + 64 * (j))
#define XB_XGEN(j)  (2304 + 64 * (j))
#define XB_TOP      3328
#define XB_TOPGEN   3392
#define XCD_BAR_WORDS 3456
#define XB_SPIN_CAP (1u << 18)
#define LAS __attribute__((address_space(3)))

__device__ __forceinline__ unsigned xb_ld(unsigned* p)              { return __hip_atomic_load(p, __ATOMIC_RELAXED, __HIP_MEMORY_SCOPE_AGENT); }
__device__ __forceinline__ unsigned xb_add(unsigned* p, unsigned v) { return __hip_atomic_fetch_add(p, v, __ATOMIC_RELAXED, __HIP_MEMORY_SCOPE_AGENT); }
__device__ __forceinline__ unsigned xb_xcc_id() { return (unsigned)__builtin_amdgcn_s_getreg((3 << 11) | 20) & 0xFu; }
#define XB_SPIN(cond, bar) do { unsigned _sp = 0; while (cond) { __builtin_amdgcn_s_sleep(1); \
    if ((++_sp & 255u) == 0u) { if (xb_ld(&(bar)[XB_TMO])) break; if (_sp > XB_SPIN_CAP) { atomicAdd(&(bar)[XB_TMO], 1u); break; } } } } while (0)

struct XcdBarrier {
    unsigned* bar; unsigned x;
    volatile LAS unsigned* st;
};

__device__ __forceinline__ XcdBarrier xcd_barrier_post(unsigned* bar, volatile LAS unsigned* st) {
    XcdBarrier b; b.bar = bar; b.x = xb_xcc_id(); b.st = st;
    if (threadIdx.x == 0) (void)xb_add(&bar[XB_XCNT(b.x)], 1u);
    return b;
}
__device__ __forceinline__ void xcd_barrier_complete(unsigned* bar, unsigned x, unsigned& nloc, unsigned& nx) {
    const unsigned G = gridDim.x * gridDim.y * gridDim.z;
    unsigned sum, cnt, mine, sp = 0u;
    for (;;) {
        sum = 0u; cnt = 0u; mine = 0u;
#pragma unroll
        for (unsigned j = 0; j < 16; ++j) { const unsigned c = xb_ld(&bar[XB_XCNT(j)]); sum += c; cnt += (c > 0u) ? 1u : 0u; mine = (j == x) ? c : mine; }
        if (sum == G) break;
        __builtin_amdgcn_s_sleep(1);
        if ((++sp & 255u) == 0u) { if (xb_ld(&bar[XB_TMO])) break; if (sp > XB_SPIN_CAP) { atomicAdd(&bar[XB_TMO], 1u); break; } }
    }
    nloc = mine > 0u ? mine : 1u; nx = cnt > 0u ? cnt : 1u;
}

__device__ __forceinline__ void xcd_barrier(const XcdBarrier& b) {
    asm volatile("s_waitcnt vmcnt(0)" ::: "memory");
    __syncthreads();
    if (threadIdx.x == 0) {
        unsigned* bar = b.bar;
        __builtin_amdgcn_s_waitcnt(0);
        unsigned nloc = b.st[0], nx = b.st[1];
        if (nloc == 0u) { xcd_barrier_complete(bar, b.x, nloc, nx); b.st[0] = nloc; b.st[1] = nx; }
        const unsigned old = xb_add(&bar[XB_XSUB(b.x)], 1u);
        const unsigned gen = old / nloc;
        if (old + 1u == (gen + 1u) * nloc) {
            __builtin_amdgcn_fence(__ATOMIC_RELEASE, "agent");
            asm volatile("s_waitcnt vmcnt(0)" ::: "memory");
            const unsigned og = xb_add(&bar[XB_TOP], 1u);
            const unsigned tg = og / nx;
            if (og + 1u == (tg + 1u) * nx) xb_add(&bar[XB_TOPGEN], 1u);
            else XB_SPIN(xb_ld(&bar[XB_TOPGEN]) == tg, bar);
            __builtin_amdgcn_fence(__ATOMIC_ACQUIRE, "agent");
            xb_add(&bar[XB_XGEN(b.x)], 1u);
            asm volatile("s_waitcnt vmcnt(0)" ::: "memory");
        } else {
            XB_SPIN(xb_ld(&bar[XB_XGEN(b.x)]) == gen, bar);
            __builtin_amdgcn_fence(__ATOMIC_ACQUIRE, "agent");
            asm volatile("s_waitcnt vmcnt(0)" ::: "memory");
        }
    }
    __syncthreads();
}


#ifndef PROBE_ID
#define PROBE_ID 0
#endif
#ifndef N_LAUNCH_MODE
#define N_LAUNCH_MODE 1
#endif
constexpr int N_PHASES = 15;

__global__ void __launch_bounds__(NTH, 2) fwd_kernel(Params p) {
    extern __shared__ __attribute__((aligned(16))) unsigned char lds[];
    const int lo = p.ph_lo, hi = p.ph_hi;
    volatile LAS unsigned* xst = (volatile LAS unsigned*)(lds + LDS_BYTES);
    if (threadIdx.x < 4) xst[threadIdx.x] = 0u;
    __syncthreads();
    const XcdBarrier xbar = xcd_barrier_post((unsigned*)(p.ws + WS_BAR), xst);
    unsigned char* ws = p.ws;
#define IN(k) (lo <= (k) && (k) < hi)
#define SEAM(k) do { if ((k) + 1 < hi) xcd_barrier(xbar); } while (0)
    if (IN(0)) {
        prep_weight(p.in[2], GIN, p.in[1], (bf16_t*)(ws + WS_WGIN), GIN_P, (float*)lds);
        prep_weight(p.in[6], DM, nullptr, (bf16_t*)(ws + WS_WGOUT), DM, (float*)lds);
        prep_wup(p.in[3], (bf16_t*)(ws + WS_WUPT));
        __syncthreads();
        phase_norm0(p, lds);
        SEAM(0);
    }
    if (IN(1)) {
        pg8::Gemm g{(const bf16_t*)(ws + WS_A), (const bf16_t*)(ws + WS_WGIN), MTOK, GIN_P, DM}; pg8::StaticOrder S; S.init(MTOK, GIN_P, gridDim.x, blockIdx.x);
        EpiBf16GateSilu E{(bf16_t*)(ws + WS_P), GIN_P};
        pg8::gemm_phase<EpiBf16GateSilu, pg8::StaticOrder>((PG8_LAS unsigned char*)lds, g, S, E);
        SEAM(1);
    }
    if (IN(2)) { gla_pass<false>(p, lds); SEAM(2); }
    if (IN(3)) {
        gla_scan(p);
        prep_weight(p.in[9], RIN, p.in[8], (bf16_t*)(ws + WS_WRIN), RIN_P, (float*)lds);
        prep_weight(p.in[20], DM, nullptr, (bf16_t*)(ws + WS_WROUT), DM, (float*)lds);
        prep_lowrank(p.in[12], (bf16_t*)(ws + WS_WDUT));
        prep_lowrank(p.in[14], (bf16_t*)(ws + WS_WIUT));
        SEAM(3);
    }
    if (IN(4)) { gla_pass<true>(p, lds); SEAM(4); }
    if (IN(5)) {
        pg8::Gemm g{(const bf16_t*)(ws + WS_A), (const bf16_t*)(ws + WS_WGOUT), MTOK, DM, DM}; pg8::StaticOrder S; S.init(MTOK, DM, gridDim.x, blockIdx.x);
        pg8::EpiBf16<0> E{(bf16_t*)(ws + WS_Y), DM, nullptr, 0, 0};
        pg8::gemm_phase<pg8::EpiBf16<0>, pg8::StaticOrder>((PG8_LAS unsigned char*)lds, g, S, E);
        SEAM(5);
    }
    if (IN(6)) { phase_norm1(p); zero_bnd_row((bf16_t*)(ws + WS_BND)); SEAM(6); }
    if (IN(7)) {
        pg8::Gemm g{(const bf16_t*)(ws + WS_A), (const bf16_t*)(ws + WS_WRIN), MTOK, RIN_P, DM}; pg8::StaticOrder S; S.init(MTOK, RIN_P, gridDim.x, blockIdx.x);
        EpiBf16Bnd E{(bf16_t*)(ws + WS_P), RIN_P, (bf16_t*)(ws + WS_BND)};
        pg8::gemm_phase<EpiBf16Bnd, pg8::StaticOrder>((PG8_LAS unsigned char*)lds, g, S, E);
        SEAM(7);
    }
    if (IN(8)) { rwkv_r1(p, lds); SEAM(8); }
    if (IN(9)) { rwkv_scan2<1>(p, lds); SEAM(9); }
    if (IN(10)) { rwkv_scan2<2>(p, lds); SEAM(10); }
    if (IN(11)) { rwkv_scan2<3>(p, lds); SEAM(11); }
    if (IN(12)) { rwkv_post(p, lds); SEAM(12); }
    if (IN(13)) {
        pg8::Gemm g{(const bf16_t*)(ws + WS_A), (const bf16_t*)(ws + WS_WROUT), MTOK, DM, DM}; pg8::StaticOrder S; S.init(MTOK, DM, gridDim.x, blockIdx.x);
        pg8::EpiBf16<0> E{(bf16_t*)(ws + WS_Y), DM, nullptr, 0, 0};
        pg8::gemm_phase<pg8::EpiBf16<0>, pg8::StaticOrder>((PG8_LAS unsigned char*)lds, g, S, E);
        SEAM(13);
    }
    if (IN(14)) { phase_final(p); }
#undef IN
#undef SEAM
}

extern "C" void kernel_launch(void* const* d_in, const int* in_sizes, int n_in, void* d_out, int out_size, void* d_ws, size_t ws_size, hipStream_t stream) {
    static int grid = 0;
    if (grid == 0) {
        int dev = 0, cus = 0, per_cu = 0;
        hipGetDevice(&dev);
        hipDeviceGetAttribute(&cus, hipDeviceAttributeMultiprocessorCount, dev);
        hipFuncSetAttribute((const void*)fwd_kernel, hipFuncAttributeMaxDynamicSharedMemorySize, LDS_BYTES + 16);
        hipOccupancyMaxActiveBlocksPerMultiprocessor(&per_cu, (const void*)fwd_kernel, NTH, LDS_BYTES + 16);
        if (per_cu < 1) { fprintf(stderr, "kernel_launch: occupancy query says %d blocks per CU\n", per_cu); per_cu = 1; }
        grid = cus;
        if (n_in != 22 || ws_size < WS_END) fprintf(stderr, "kernel_launch: unexpected n_in %d or workspace %zu < %zu\n", n_in, ws_size, (size_t)WS_END);
        (void)hipGetLastError();
    }
    if (hipMemsetAsync((char*)d_ws + WS_BAR, 0, XCD_BAR_WORDS * 4, stream) != hipSuccess) fprintf(stderr, "kernel_launch: memset of the barrier words failed\n");
    Params p{};
    for (int i = 0; i < 22; ++i) p.in[i] = (const float*)d_in[i];
    p.out = (float*)d_out; p.ws = (unsigned char*)d_ws;
#if N_LAUNCH_MODE == 1
    void* args[] = {&p};
#if PROBE_ID > 0
    p.ph_lo = 0; p.ph_hi = PROBE_ID;
    (void)hipLaunchCooperativeKernel((const void*)fwd_kernel, dim3(grid), dim3(NTH), args, LDS_BYTES + 16, stream);
    (void)hipMemsetAsync((char*)d_ws + WS_BAR, 0, XCD_BAR_WORDS * 4, stream);
#endif
    p.ph_lo = 0; p.ph_hi = N_PHASES;
    hipError_t e = hipLaunchCooperativeKernel((const void*)fwd_kernel, dim3(grid), dim3(NTH), args, LDS_BYTES + 16, stream);
    if (e != hipSuccess) fprintf(stderr, "cooperative launch failed: %s (grid %d)\n", hipGetErrorString(e), grid);
#else
    for (int k = 0; k < N_PHASES; ++k) {
        p.ph_lo = k; p.ph_hi = k + 1;
        hipLaunchKernelGGL(fwd_kernel, dim3(grid), dim3(NTH), LDS_BYTES + 16, stream, p);
    }
#endif
}
```

```cpp
#include <hip/hip_runtime.h>
#include <hip/hip_cooperative_groups.h>
#include <cstdio>
namespace cg = cooperative_groups;
#define PROBE_ID 0
#define N_LAUNCH_MODE 1
namespace pg8 {
#define PG8_LAS __attribute__((address_space(3)))
typedef unsigned short bf16_t;
typedef short bf16x8 __attribute__((ext_vector_type(8)));
typedef float f32x4 __attribute__((ext_vector_type(4)));
typedef unsigned u32x4 __attribute__((ext_vector_type(4)));
constexpr int BM = 256, BK = 64, HALF = 128, HTB = HALF * BK * 2  , STAGE_BYTES = 8 * HTB, NXCD = 8, WGM = 8;

__host__ __device__ __forceinline__ int lds_byte(int r, int c) { const int st = (r >> 4) * 2 + (c >> 5), rr = r & 15, cc = c & 31, ob = rr * 64 + cc * 2; return st * 1024 + (ob ^ (((ob >> 9) & 1) << 5)); }
__host__ __device__ __forceinline__ void stage_rc(int b, int& R, int& C) { const int st = b / 1024, sb = b % 1024, swz = sb ^ (((sb >> 9) & 1) << 5); R = (st >> 1) * 16 + swz / 64; C = (st & 1) * 32 + (swz % 64) / 2; }
__host__ __device__ __forceinline__ int perm32(int rho) { const int n = rho >> 4, i = rho & 15; return 8 * (i >> 2) + 4 * n + (i & 3); }

struct Unit { int pm, pn; };
struct Gemm { const bf16_t* A; const bf16_t* Bt; int M, N, K; };

struct StaticOrder {
    int nM, nN, nwg, G, c;
    __host__ __device__ void init(int M, int N, int G_, int c_) { nM = M / BM; nN = N / BM; nwg = nM * nN; G = G_; c = c_; }
    __host__ __device__ bool next(int i, Unit& u) const {
        const long L = (long)i * G + c; if (L >= nwg) return false;
        int wgid = (int)L; { const int q = nwg / NXCD, r = nwg % NXCD, xcd = wgid % NXCD, off = wgid / NXCD; wgid = (xcd < r ? xcd * (q + 1) : r * (q + 1) + (xcd - r) * q) + off; }
        const int nig = WGM * nN, gid = wgid / nig, fm = gid * WGM, gsz = (nM - fm) < WGM ? (nM - fm) : WGM;
        u.pm = fm + ((wgid % nig) % gsz); u.pn = (wgid % nig) / gsz; return true;
    }
    __device__ __forceinline__ void a_ready(const Unit&) const {}
    __device__ __forceinline__ void done(const Unit&) const {}
};

typedef float cvt_f32x2 __attribute__((ext_vector_type(2)));
typedef __bf16 cvt_bf16x2 __attribute__((ext_vector_type(2)));
__device__ __forceinline__ unsigned cvt_pk_bf16(float lo, float hi) { const cvt_f32x2 v = {lo, hi}; union { cvt_bf16x2 b; unsigned u; } x; x.b = __builtin_convertvector(v, cvt_bf16x2); return x.u; }
typedef float f32x2 __attribute__((ext_vector_type(2)));
struct EpiF32 {
    static constexpr bool PERM = false, AFTER_DRAIN = false;
    float* C; int ldc; const float* bias;
    __device__ __forceinline__ void operator()(const f32x4 (&acc)[2][2][4][2], const Unit& u, int wr, int wc, int fr, int fq) const {
        const int row0 = u.pm * BM + wr * 64 + fr, col0 = u.pn * BM + wc * 32 + 4 * fq;
        f32x4 bv[2][2];
#pragma unroll
        for (int bj = 0; bj < 2; ++bj)
#pragma unroll
            for (int n = 0; n < 2; ++n) bv[bj][n] = bias ? *(const f32x4*)(bias + col0 + bj * HALF + n * 16) : (f32x4){0.f, 0.f, 0.f, 0.f};
#pragma unroll
        for (int ai = 0; ai < 2; ++ai)
#pragma unroll
            for (int m = 0; m < 4; ++m) { float* rowp = C + (size_t)(row0 + ai * HALF + m * 16) * ldc + col0;
#pragma unroll
                for (int bj = 0; bj < 2; ++bj)
#pragma unroll
                    for (int n = 0; n < 2; ++n) *(f32x4*)(rowp + bj * HALF + n * 16) = acc[ai][bj][m][n] + bv[bj][n]; }
    }
};
template <int ACT  > struct EpiBf16 {
    static constexpr bool PERM = true, AFTER_DRAIN = false;
    bf16_t* O; int ldc; const float* bias; int split_cols; size_t split_stride;
    __device__ __forceinline__ void operator()(const f32x4 (&acc)[2][2][4][2], const Unit& u, int wr, int wc, int fr, int fq) const {
        const int row0 = u.pm * BM + wr * 64 + fr; int colt = u.pn * BM; bf16_t* base = O;
        if (split_cols) { const int t = colt / split_cols; base += (size_t)t * split_stride; colt -= t * split_cols; }
        const int col0 = colt + wc * 32 + 8 * fq, bcol0 = u.pn * BM + wc * 32 + 8 * fq;
        f32x4 bv[2][2];
#pragma unroll
        for (int bj = 0; bj < 2; ++bj)
#pragma unroll
            for (int n = 0; n < 2; ++n) bv[bj][n] = bias ? *(const f32x4*)(bias + bcol0 + bj * HALF + 4 * n) : (f32x4){0.f, 0.f, 0.f, 0.f};
#pragma unroll
        for (int ai = 0; ai < 2; ++ai)
#pragma unroll
            for (int m = 0; m < 4; ++m) { bf16_t* rowp = base + (size_t)(row0 + ai * HALF + m * 16) * ldc + col0;
#pragma unroll
                for (int bj = 0; bj < 2; ++bj) { f32x4 v0 = acc[ai][bj][m][0] + bv[bj][0], v1 = acc[ai][bj][m][1] + bv[bj][1];
                    u32x4 w; w.x = cvt_pk_bf16(v0[0], v0[1]); w.y = cvt_pk_bf16(v0[2], v0[3]); w.z = cvt_pk_bf16(v1[0], v1[1]); w.w = cvt_pk_bf16(v1[2], v1[3]);
                    *(u32x4*)(rowp + bj * HALF) = w; } }
    }
};

template <class Epi, class Sched>
__device__ __forceinline__ void gemm_phase(PG8_LAS unsigned char* lds, const Gemm g, const Sched& S, const Epi& E) {
    const int tid = threadIdx.x, wid = __builtin_amdgcn_readfirstlane(tid >> 6), lane = tid & 63, wr = wid >> 2, wc = wid & 3, fr = lane & 15, fq = lane >> 4;
    const int K = g.K, nt = K / BK;
    unsigned voffA[2], voffB[2];
#pragma unroll
    for (int i = 0; i < 2; ++i) { int R, C; stage_rc(tid * 16 + i * 8192, R, C); const int Rb = Epi::PERM ? ((R & ~31) + perm32(R & 31)) : R;
        voffA[i] = (unsigned)(R * K + C) * 2u; voffB[i] = (unsigned)(Rb * K + C) * 2u; }
    const size_t kstep = (size_t)(BK * 2);
    const size_t hstep = (size_t)HALF * K * 2;
    const size_t tstep = 2 * hstep;
    const unsigned ldsw = (unsigned)wid * 1024u;
    const int aoff = lds_byte(wr * 64 + fr, fq * 8), boff = lds_byte(wc * 32 + fr, fq * 8);
#define PG8_SA(b, h) (((b) * 2 + (h)) * HTB)
#define PG8_SB(b, h) ((4 + (b) * 2 + (h)) * HTB)
#define PG8_STAGE(bufoff, gbase, voff) do { _Pragma("unroll") for (int _i = 0; _i < 2; ++_i) \
        __builtin_amdgcn_global_load_lds((const unsigned*)((const char*)(gbase) + (voff)[_i]), (PG8_LAS unsigned*)(lds + (bufoff) + ldsw + _i * 8192), 16, 0, 0); } while (0)
#define PG8_LDA(dst, b, h) do { _Pragma("unroll") for (int m = 0; m < 4; ++m) _Pragma("unroll") for (int k = 0; k < 2; ++k) dst[m][k] = *(const PG8_LAS bf16x8*)(lds + PG8_SA(b, h) + aoff + m * 2048 + k * 1024); } while (0)
#define PG8_LDB(dst, b, h) do { _Pragma("unroll") for (int n = 0; n < 2; ++n) _Pragma("unroll") for (int k = 0; k < 2; ++k) dst[n][k] = *(const PG8_LAS bf16x8*)(lds + PG8_SB(b, h) + boff + n * 2048 + k * 1024); } while (0)
#define PG8_MMA(ai, bj, At, Bt) do { __builtin_amdgcn_s_setprio(1); _Pragma("unroll") for (int m = 0; m < 4; ++m) _Pragma("unroll") for (int n = 0; n < 2; ++n) _Pragma("unroll") for (int k = 0; k < 2; ++k) \
        acc[ai][bj][m][n] = __builtin_amdgcn_mfma_f32_16x16x32_bf16(Bt[n][k], At[m][k], acc[ai][bj][m][n], 0, 0, 0); __builtin_amdgcn_s_setprio(0); } while (0)
#define PG8_WAIT_V(n) asm volatile("s_waitcnt vmcnt(" #n ")" ::: "memory")
#define PG8_WAIT_L(n) asm volatile("s_waitcnt lgkmcnt(" #n ")" ::: "memory")
#define PG8_BAR __builtin_amdgcn_s_barrier()
#define PG8_SCHED __builtin_amdgcn_sched_barrier(0)
    Unit cur, nxt; int ui = 0;
    if (!S.next(0, cur)) return;
    f32x4 acc[2][2][4][2];
#pragma unroll
    for (int a = 0; a < 2; ++a)
#pragma unroll
        for (int b = 0; b < 2; ++b)
#pragma unroll
            for (int m = 0; m < 4; ++m)
#pragma unroll
                for (int n = 0; n < 2; ++n) acc[a][b][m][n] = (f32x4){0.f, 0.f, 0.f, 0.f};
    bf16x8 At[4][2], B0[2][2], B1[2][2];
    const char* cA = (const char*)g.A + (size_t)cur.pm * tstep; const char* cB = (const char*)g.Bt + (size_t)cur.pn * tstep;
    S.a_ready(cur);
    PG8_STAGE(PG8_SB(0, 0), cB, voffB); PG8_STAGE(PG8_SA(0, 0), cA, voffA); PG8_STAGE(PG8_SB(0, 1), cB + hstep, voffB); PG8_STAGE(PG8_SA(0, 1), cA + hstep, voffA);
    if (wr == 1) PG8_BAR;
    PG8_WAIT_V(4); PG8_BAR;
    PG8_STAGE(PG8_SB(1, 0), cB + kstep, voffB); PG8_STAGE(PG8_SA(1, 0), cA + kstep, voffA); PG8_STAGE(PG8_SB(1, 1), cB + hstep + kstep, voffB);
    PG8_WAIT_V(6); PG8_BAR;
    for (;;) {
        const bool has_next = S.next(ui + 1, nxt);
        const char* nA = has_next ? (const char*)g.A + (size_t)nxt.pm * tstep : cA; const char* nB = has_next ? (const char*)g.Bt + (size_t)nxt.pn * tstep : cB;
        for (int t = 0; t < nt; t += 2) {
            const bool last = (t == nt - 2);
            const char* a1 = cA + (size_t)(t + 1) * kstep;
            const char* a2 = last ? nA : cA + (size_t)(t + 2) * kstep; const char* b2 = last ? nB : cB + (size_t)(t + 2) * kstep;
            const char* a3 = a2 + kstep; const char* b3 = b2 + kstep;
            if (last && has_next) S.a_ready(nxt);
            PG8_LDB(B0, 0, 0); PG8_SCHED; PG8_LDA(At, 0, 0); PG8_STAGE(PG8_SA(1, 1), a1 + hstep, voffA);
            PG8_WAIT_L(8); PG8_BAR; PG8_WAIT_L(0); PG8_MMA(0, 0, At, B0); PG8_BAR; PG8_SCHED;
            PG8_LDB(B1, 0, 1); PG8_STAGE(PG8_SB(0, 0), b2, voffB);
            PG8_BAR; PG8_WAIT_L(0); PG8_MMA(0, 1, At, B1); PG8_BAR;
            PG8_LDA(At, 0, 1); PG8_STAGE(PG8_SA(0, 0), a2, voffA);
            PG8_BAR; PG8_WAIT_L(0); PG8_MMA(1, 0, At, B0); PG8_BAR; PG8_SCHED;
            PG8_STAGE(PG8_SB(0, 1), b2 + hstep, voffB);
            PG8_WAIT_V(6); PG8_BAR; PG8_MMA(1, 1, At, B1); PG8_BAR;
            PG8_LDB(B0, 1, 0); PG8_SCHED; PG8_LDA(At, 1, 0); PG8_STAGE(PG8_SA(0, 1), a2 + hstep, voffA);
            PG8_WAIT_L(8); PG8_BAR; PG8_WAIT_L(0); PG8_MMA(0, 0, At, B0); PG8_BAR; PG8_SCHED;
            PG8_LDB(B1, 1, 1); PG8_STAGE(PG8_SB(1, 0), b3, voffB);
            PG8_BAR; PG8_WAIT_L(0); PG8_MMA(0, 1, At, B1); PG8_BAR;
            PG8_LDA(At, 1, 1); PG8_STAGE(PG8_SA(1, 0), a3, voffA);
            PG8_BAR; PG8_WAIT_L(0); PG8_MMA(1, 0, At, B0); PG8_BAR; PG8_SCHED;
            PG8_STAGE(PG8_SB(1, 1), b3 + hstep, voffB);
            PG8_WAIT_V(6); PG8_BAR; PG8_MMA(1, 1, At, B1); PG8_BAR;
        }
        if constexpr (!Epi::AFTER_DRAIN) { E(acc, cur, wr, wc, fr, fq); S.done(cur); }
        if (!has_next) break;
#pragma unroll
        for (int a = 0; a < 2; ++a)
#pragma unroll
            for (int b = 0; b < 2; ++b)
#pragma unroll
                for (int m = 0; m < 4; ++m)
#pragma unroll
                    for (int n = 0; n < 2; ++n) acc[a][b][m][n] = (f32x4){0.f, 0.f, 0.f, 0.f};
        cur = nxt; cA = nA; cB = nB; ++ui;
    }
    PG8_WAIT_V(0);
    if (wr == 0) PG8_BAR;
    PG8_BAR;
    if constexpr (Epi::AFTER_DRAIN) { E.fused(acc, cur, wr, wc, fr, fq, lds, wid, lane); S.done(cur); }
#undef PG8_SA
#undef PG8_SB
#undef PG8_STAGE
#undef PG8_LDA
#undef PG8_LDB
#undef PG8_MMA
#undef PG8_WAIT_V
#undef PG8_WAIT_L
#undef PG8_BAR
#undef PG8_SCHED
}
}


typedef unsigned short bf16_t;
typedef short bf16x8 __attribute__((ext_vector_type(8)));
typedef float f32x4 __attribute__((ext_vector_type(4)));
typedef unsigned u32x4 __attribute__((ext_vector_type(4)));
typedef unsigned u32x2 __attribute__((ext_vector_type(2)));

constexpr int MTOK = 32768, DM = 1024, SEQ = 16384, NTH = 512;
constexpr int GIN = 3088, GIN_P = 3072, RIN = 4224, RIN_P = 4352;
constexpr int LDS_BYTES = 147456;

constexpr size_t WS_WGIN  = 0;
constexpr size_t WS_WGOUT = WS_WGIN  + (size_t)GIN_P * DM * 2;
constexpr size_t WS_WRIN  = WS_WGOUT + (size_t)DM * DM * 2;
constexpr size_t WS_WROUT = WS_WRIN  + (size_t)RIN_P * DM * 2;
constexpr size_t WS_WDUT  = WS_WROUT + (size_t)DM * DM * 2;
constexpr size_t WS_WIUT  = WS_WDUT  + (size_t)DM * 64 * 2;
constexpr size_t WS_WUPT  = WS_WIUT  + (size_t)DM * 64 * 2;
constexpr size_t WS_A     = WS_WUPT  + (size_t)512 * 16 * 2;
constexpr size_t WS_Y     = WS_A     + (size_t)MTOK * DM * 2;
constexpr size_t WS_GS    = WS_Y     + (size_t)MTOK * DM * 2;
constexpr size_t WS_GD    = WS_GS    + (size_t)24 * 1024 * 1024;
constexpr size_t WS_P     = WS_GD    + (size_t)8 * 32 * 128 * 4;
constexpr size_t WS_BAR   = WS_P     + (size_t)MTOK * RIN_P * 2;
constexpr size_t WS_AD    = WS_BAR   + 16384;
constexpr size_t WS_X1    = WS_AD    + (size_t)MTOK * 16 * 2;
constexpr size_t WS_END   = WS_X1    + (size_t)MTOK * DM * 2;
static_assert(WS_END <= (size_t)512 * 1024 * 1024, "workspace budget (4 x the largest tensor)");

struct Params { const float* in[22]; float* out; unsigned char* ws; int ph_lo, ph_hi; };

__device__ __forceinline__ float bf2f(unsigned b) { return __uint_as_float(b << 16); }
__device__ __forceinline__ bf16_t f2bf(float f) { unsigned u = __float_as_uint(f); u += 0x7FFFu + ((u >> 16) & 1u); return (bf16_t)(u >> 16); }
__device__ __forceinline__ unsigned pk2(float lo, float hi) { return pg8::cvt_pk_bf16(lo, hi); }
__device__ __forceinline__ float wave_sum(float x) {
#pragma unroll
    for (int off = 32; off >= 1; off >>= 1) x += __shfl_xor(x, off);
    return x;
}
__device__ __forceinline__ float bperm(int byte_addr, float x) { return __int_as_float(__builtin_amdgcn_ds_bpermute(byte_addr, __float_as_int(x))); }
template <int CTRL> __device__ __forceinline__ float dpp_mov(float x) { return __int_as_float(__builtin_amdgcn_update_dpp(0, __float_as_int(x), CTRL, 0xF, 0xF, true)); }
__device__ __forceinline__ float sum8(float x) { x += dpp_mov<0xB1>(x); x += dpp_mov<0x4E>(x); x += dpp_mov<0x141>(x); return x; }
__device__ __forceinline__ f32x4 mfma16(bf16x8 a, bf16x8 b, f32x4 c) { return __builtin_amdgcn_mfma_f32_16x16x32_bf16(a, b, c, 0, 0, 0); }
__device__ __forceinline__ bf16x8 as_bf16x8(u32x4 v) { union { u32x4 u; bf16x8 b; } x; x.u = v; return x.b; }
__device__ __forceinline__ float fexp(float x) { return __builtin_amdgcn_exp2f(x * 1.4426950408889634f); }
__device__ __forceinline__ float flog(float x) { return __builtin_amdgcn_logf(x) * 0.6931471805599453f; }
__device__ __forceinline__ float log_sigmoid(float z) { return fminf(z, 0.f) - log1pf(fexp(-fabsf(z))); }
__device__ __forceinline__ float softplus(float z) { return fmaxf(z, 0.f) + log1pf(fexp(-fabsf(z))); }

__device__ void prep_weight(const float* __restrict__ W, int N, const float* __restrict__ gain, bf16_t* __restrict__ Wt, int NP, float* tile) {
    const int tid = threadIdx.x;
    const int nu = (NP / 64) * 16;
    const int lk = tid >> 4, lq = tid & 15;
    const int sn = tid >> 3, ss = tid & 7;
    float4 v[2];
#define PW_LOAD(u_) do { const int n0_ = ((u_) >> 4) * 64, k0_ = ((u_) & 15) * 64; _Pragma("unroll") for (int r = 0; r < 2; ++r) { const int k = k0_ + lk + 32 * r, n = n0_ + 4 * lq; \
        float4 x_ = make_float4(0.f, 0.f, 0.f, 0.f); if (n < N) { x_ = *(const float4*)(W + (size_t)k * N + n); if (gain) { const float g_ = gain[k]; x_.x *= g_; x_.y *= g_; x_.z *= g_; x_.w *= g_; } } v[r] = x_; } } while (0)
    int u = blockIdx.x;
    if (u < nu) PW_LOAD(u);
    for (; u < nu; u += gridDim.x) {
        const int n0 = (u >> 4) * 64, k0 = (u & 15) * 64;
#pragma unroll
        for (int r = 0; r < 2; ++r) *(float4*)(tile + (lk + 32 * r) * 68 + 4 * lq) = v[r];
        if (u + (int)gridDim.x < nu) PW_LOAD(u + gridDim.x);
        __syncthreads();
        {
            float e[8];
#pragma unroll
            for (int q = 0; q < 8; ++q) e[q] = tile[(8 * ss + q) * 68 + sn];
            *(u32x4*)(Wt + (size_t)(n0 + sn) * DM + k0 + 8 * ss) = (u32x4){pk2(e[0], e[1]), pk2(e[2], e[3]), pk2(e[4], e[5]), pk2(e[6], e[7])};
        }
        __syncthreads();
    }
#undef PW_LOAD
}

__device__ void prep_lowrank(const float* __restrict__ src, bf16_t* __restrict__ dst) {
    for (int idx = blockIdx.x * NTH + threadIdx.x; idx < 65536; idx += gridDim.x * NTH) dst[idx] = f2bf(src[(idx & 63) * 1024 + (idx >> 6)]);
}

__device__ void zero_bnd_row(bf16_t* bnd) {
    if (blockIdx.x == 0) for (int i = threadIdx.x; i < RIN_P / 2; i += NTH) ((unsigned*)bnd)[i] = 0u;
}

__device__ void prep_wup(const float* __restrict__ src, bf16_t* __restrict__ dst) {
    for (int idx = blockIdx.x * NTH + threadIdx.x; idx < 8192; idx += gridDim.x * NTH) dst[idx] = f2bf(src[(idx & 15) * 512 + (idx >> 4)]);
}

struct EpiBf16GateSilu {
    static constexpr bool PERM = true, AFTER_DRAIN = false;
    bf16_t* O; int ldc;
    __device__ __forceinline__ void operator()(const f32x4 (&acc)[2][2][4][2], const pg8::Unit& u, int wr, int wc, int fr, int fq) const {
        const int row0 = u.pm * pg8::BM + wr * 64 + fr, col0 = u.pn * pg8::BM + wc * 32 + 8 * fq;
        const bool act = u.pn >= 8;
#pragma unroll
        for (int ai = 0; ai < 2; ++ai)
#pragma unroll
            for (int m = 0; m < 4; ++m) {
                bf16_t* rowp = O + (size_t)(row0 + ai * pg8::HALF + m * 16) * ldc + col0;
#pragma unroll
                for (int bj = 0; bj < 2; ++bj) {
                    f32x4 v0 = acc[ai][bj][m][0], v1 = acc[ai][bj][m][1];
                    if (act) {
#pragma unroll
                        for (int j = 0; j < 4; ++j) { v0[j] *= __builtin_amdgcn_rcpf(1.0f + fexp(-v0[j])); v1[j] *= __builtin_amdgcn_rcpf(1.0f + fexp(-v1[j])); }
                    }
                    u32x4 wv; wv.x = pk2(v0[0], v0[1]); wv.y = pk2(v0[2], v0[3]); wv.z = pk2(v1[0], v1[1]); wv.w = pk2(v1[2], v1[3]);
                    *(u32x4*)(rowp + bj * pg8::HALF) = wv;
                }
            }
    }
};

struct EpiBf16Bnd {
    static constexpr bool PERM = true, AFTER_DRAIN = false;
    bf16_t* O; int ldc; bf16_t* bnd;
    __device__ __forceinline__ void operator()(const f32x4 (&acc)[2][2][4][2], const pg8::Unit& u, int wr, int wc, int fr, int fq) const {
        const int row0 = u.pm * pg8::BM + wr * 64 + fr, col0 = u.pn * pg8::BM + wc * 32 + 8 * fq;
#pragma unroll
        for (int ai = 0; ai < 2; ++ai)
#pragma unroll
            for (int m = 0; m < 4; ++m) {
                const int row = row0 + ai * pg8::HALF + m * 16;
                bf16_t* rowp = O + (size_t)row * ldc + col0;
#pragma unroll
                for (int bj = 0; bj < 2; ++bj) {
                    const f32x4 v0 = acc[ai][bj][m][0], v1 = acc[ai][bj][m][1];
                    u32x4 wv; wv.x = pk2(v0[0], v0[1]); wv.y = pk2(v0[2], v0[3]); wv.z = pk2(v1[0], v1[1]); wv.w = pk2(v1[2], v1[3]);
                    *(u32x4*)(rowp + bj * pg8::HALF) = wv;
                    if (m == 3 && fr == 15) *(u32x4*)(bnd + (size_t)((row >> 6) + 1) * ldc + col0 + bj * pg8::HALF) = wv;
                }
            }
    }
};

__device__ void phase_norm0(const Params& p, unsigned char* lds) {
    const int tid = threadIdx.x, lane = tid & 63, w = tid >> 6, l15 = lane & 15, g = lane >> 4;
    const float* x = p.in[0];
    bf16_t* A = (bf16_t*)(p.ws + WS_A);
    bf16_t* AD = (bf16_t*)(p.ws + WS_AD);
    bf16_t* WAD = (bf16_t*)lds;
    float* PSS = (float*)(lds + 33024);
    float* PAD = (float*)(lds + 33024 + 512);
    for (int e = tid; e < 16384; e += NTH) { const int k = e >> 4, j = e & 15; WAD[j * 1032 + k] = f2bf(p.in[2][(size_t)k * GIN + 3072 + j] * p.in[1][k]); }
    __syncthreads();
    bf16x8 wf[4];
#pragma unroll
    for (int kk = 0; kk < 4; ++kk) wf[kk] = *(const bf16x8*)(WAD + l15 * 1032 + 128 * w + 32 * kk + 8 * g);
    float4 xa[4][2];
    int tile = blockIdx.x;
    if (tile < MTOK / 16) {
#pragma unroll
        for (int kk = 0; kk < 4; ++kk) { const float4* s = (const float4*)(x + (size_t)(16 * tile + l15) * DM + 128 * w + 32 * kk + 8 * g); xa[kk][0] = s[0]; xa[kk][1] = s[1]; }
    }
    for (; tile < MTOK / 16; tile += gridDim.x) {
        float4 xv[4][2];
#pragma unroll
        for (int kk = 0; kk < 4; ++kk) { xv[kk][0] = xa[kk][0]; xv[kk][1] = xa[kk][1]; }
        if (tile + (int)gridDim.x < MTOK / 16) {
#pragma unroll
            for (int kk = 0; kk < 4; ++kk) { const float4* s = (const float4*)(x + (size_t)(16 * (tile + gridDim.x) + l15) * DM + 128 * w + 32 * kk + 8 * g); xa[kk][0] = s[0]; xa[kk][1] = s[1]; }
        }
        float ss = 0.f;
        f32x4 acc = (f32x4){0.f, 0.f, 0.f, 0.f};
#pragma unroll
        for (int kk = 0; kk < 4; ++kk) {
            const float4 a = xv[kk][0], b = xv[kk][1];
            ss += a.x * a.x + a.y * a.y + a.z * a.z + a.w * a.w + b.x * b.x + b.y * b.y + b.z * b.z + b.w * b.w;
            acc = mfma16(as_bf16x8((u32x4){pk2(a.x, a.y), pk2(a.z, a.w), pk2(b.x, b.y), pk2(b.z, b.w)}), wf[kk], acc);
        }
        ss += __shfl_xor(ss, 16); ss += __shfl_xor(ss, 32);
        if (g == 0) PSS[w * 16 + l15] = ss;
        *(f32x4*)(PAD + (w * 64 + lane) * 4) = acc;
        __syncthreads();
        float tot = 0.f;
#pragma unroll
        for (int q = 0; q < 8; ++q) tot += PSS[q * 16 + l15];
        const float rstd = rsqrtf(tot * (1.0f / DM) + 1e-6f);
#pragma unroll
        for (int kk = 0; kk < 4; ++kk) {
            const float4 a = xv[kk][0], b = xv[kk][1];
            *(u32x4*)(A + (size_t)(16 * tile + l15) * DM + 128 * w + 32 * kk + 8 * g) = (u32x4){pk2(a.x * rstd, a.y * rstd), pk2(a.z * rstd, a.w * rstd), pk2(b.x * rstd, b.y * rstd), pk2(b.z * rstd, b.w * rstd)};
        }
        if (w == 0) {
            f32x4 s = (f32x4){0.f, 0.f, 0.f, 0.f};
#pragma unroll
            for (int q = 0; q < 8; ++q) s += *(const f32x4*)(PAD + (q * 64 + lane) * 4);
#pragma unroll
            for (int r = 0; r < 4; ++r) AD[(size_t)(16 * tile + 4 * g + r) * 16 + l15] = f2bf(s[r] * __shfl(rstd, 4 * g + r));
        }
        __syncthreads();
    }
}

__device__ void phase_norm1(const Params& p) {
    const int tid = threadIdx.x, lane = tid & 63, w = tid >> 6;
    const float* x = p.in[0];
    const float* gpost = p.in[7];
    const bf16_t* Y = (const bf16_t*)(p.ws + WS_Y);
    bf16_t* A = (bf16_t*)(p.ws + WS_A);
    bf16_t* X1 = (bf16_t*)(p.ws + WS_X1);
    float4 gp[4];
#pragma unroll
    for (int i = 0; i < 4; ++i) gp[i] = ((const float4*)gpost)[lane + 64 * i];
    const int stride = gridDim.x * 8;
    float4 vn[4]; u32x2 yn[4];
    {
        const int row = blockIdx.x * 8 + w;
#pragma unroll
        for (int i = 0; i < 4; ++i) { vn[i] = ((const float4*)(x + (size_t)row * DM))[lane + 64 * i]; yn[i] = *(const u32x2*)(Y + (size_t)row * DM + 4 * (lane + 64 * i)); }
    }
    for (int row = blockIdx.x * 8 + w; row < MTOK; row += stride) {
        float4 v[4]; u32x2 yv[4];
#pragma unroll
        for (int i = 0; i < 4; ++i) { v[i] = vn[i]; yv[i] = yn[i]; }
        if (row + stride < MTOK) {
#pragma unroll
            for (int i = 0; i < 4; ++i) { vn[i] = ((const float4*)(x + (size_t)(row + stride) * DM))[lane + 64 * i]; yn[i] = *(const u32x2*)(Y + (size_t)(row + stride) * DM + 4 * (lane + 64 * i)); }
        }
        float4 y[4];
        float ss = 0.f;
#pragma unroll
        for (int i = 0; i < 4; ++i) {
            y[i].x = bf2f(yv[i].x & 0xffffu); y[i].y = bf2f(yv[i].x >> 16); y[i].z = bf2f(yv[i].y & 0xffffu); y[i].w = bf2f(yv[i].y >> 16);
            ss += y[i].x * y[i].x + y[i].y * y[i].y + y[i].z * y[i].z + y[i].w * y[i].w;
        }
        ss = wave_sum(ss);
        const float rstdy = rsqrtf(ss * (1.0f / DM) + 1e-6f);
        float s1 = 0.f;
#pragma unroll
        for (int i = 0; i < 4; ++i) {
            v[i].x += y[i].x * rstdy * gp[i].x; v[i].y += y[i].y * rstdy * gp[i].y; v[i].z += y[i].z * rstdy * gp[i].z; v[i].w += y[i].w * rstdy * gp[i].w;
            s1 += v[i].x * v[i].x + v[i].y * v[i].y + v[i].z * v[i].z + v[i].w * v[i].w;
            u32x2 xo; xo.x = pk2(v[i].x, v[i].y); xo.y = pk2(v[i].z, v[i].w);
            *(u32x2*)(X1 + (size_t)row * DM + 4 * (lane + 64 * i)) = xo;
        }
        s1 = wave_sum(s1);
        const float rstd = rsqrtf(s1 * (1.0f / DM) + 1e-6f);
#pragma unroll
        for (int i = 0; i < 4; ++i) {
            u32x2 o; o.x = pk2(v[i].x * rstd, v[i].y * rstd); o.y = pk2(v[i].z * rstd, v[i].w * rstd);
            *(u32x2*)(A + (size_t)row * DM + 4 * (lane + 64 * i)) = o;
        }
    }
}

__device__ void phase_final(const Params& p) {
    const int tid = threadIdx.x, lane = tid & 63, w = tid >> 6;
    const float* gpost = p.in[21];
    const bf16_t* Y = (const bf16_t*)(p.ws + WS_Y);
    const bf16_t* X1 = (const bf16_t*)(p.ws + WS_X1);
    float4 gp[4];
#pragma unroll
    for (int i = 0; i < 4; ++i) gp[i] = ((const float4*)gpost)[lane + 64 * i];
    const int stride = gridDim.x * 8;
    u32x2 xn[4], yn[4];
    {
        const int row = blockIdx.x * 8 + w;
#pragma unroll
        for (int i = 0; i < 4; ++i) { xn[i] = *(const u32x2*)(X1 + (size_t)row * DM + 4 * (lane + 64 * i)); yn[i] = *(const u32x2*)(Y + (size_t)row * DM + 4 * (lane + 64 * i)); }
    }
    for (int row = blockIdx.x * 8 + w; row < MTOK; row += stride) {
        u32x2 xv[4], yv[4];
#pragma unroll
        for (int i = 0; i < 4; ++i) { xv[i] = xn[i]; yv[i] = yn[i]; }
        if (row + stride < MTOK) {
#pragma unroll
            for (int i = 0; i < 4; ++i) { xn[i] = *(const u32x2*)(X1 + (size_t)(row + stride) * DM + 4 * (lane + 64 * i)); yn[i] = *(const u32x2*)(Y + (size_t)(row + stride) * DM + 4 * (lane + 64 * i)); }
        }
        float4 y[4];
        float ss = 0.f;
#pragma unroll
        for (int i = 0; i < 4; ++i) {
            y[i].x = bf2f(yv[i].x & 0xffffu); y[i].y = bf2f(yv[i].x >> 16); y[i].z = bf2f(yv[i].y & 0xffffu); y[i].w = bf2f(yv[i].y >> 16);
            ss += y[i].x * y[i].x + y[i].y * y[i].y + y[i].z * y[i].z + y[i].w * y[i].w;
        }
        ss = wave_sum(ss);
        const float rstdy = rsqrtf(ss * (1.0f / DM) + 1e-6f);
#pragma unroll
        for (int i = 0; i < 4; ++i) {
            float4 v;
            v.x = bf2f(xv[i].x & 0xffffu) + y[i].x * rstdy * gp[i].x; v.y = bf2f(xv[i].x >> 16) + y[i].y * rstdy * gp[i].y;
            v.z = bf2f(xv[i].y & 0xffffu) + y[i].z * rstdy * gp[i].z; v.w = bf2f(xv[i].y >> 16) + y[i].w * rstdy * gp[i].w;
            ((float4*)(p.out + (size_t)row * DM))[lane + 64 * i] = v;
        }
    }
}

constexpr int L_BC = 0, L_ATT = 0, L_QD = 33792, L_KD = L_QD + 64 * 136 * 2, L_KTE = L_KD + 64 * 136 * 2, L_VI = L_KTE + 64 * 152 * 2, L_SSQ = L_VI + 64 * 280 * 2, L_BL = L_SSQ + 2048, L_DEC = L_BL + 512, L_ADL = L_DEC + 512,
              L_GLA_END = L_ADL + 2048;
static_assert(L_GLA_END <= LDS_BYTES, "GLA LDS");
#define GLA_BARRIER() do { asm volatile("s_waitcnt lgkmcnt(0)" ::: "memory"); __builtin_amdgcn_s_barrier(); asm volatile("" ::: "memory"); } while (0)
typedef short gs16x4 __attribute__((ext_vector_type(4)));
__device__ __forceinline__ u32x2 g_trread(const bf16_t* p) { union { gs16x4 s; u32x2 u; } x; x.s = __builtin_amdgcn_ds_read_tr16_b64_v4i16((__attribute__((address_space(3))) gs16x4*)p); return x.u; }
template <int PITCH> __device__ __forceinline__ bf16x8 g_trfrag(const bf16_t* img, int k0, int c0, int g, int q, int pq) {
    const bf16_t* a = img + (k0 + 8 * g + q) * PITCH + c0 + 4 * pq;
    const u32x2 lo = g_trread(a), hi = g_trread(a + 4 * PITCH);
    return as_bf16x8((u32x4){lo.x, lo.y, hi.x, hi.y});
}
__device__ __forceinline__ f32x4 g_lo4(u32x4 v) { return (f32x4){bf2f(v.x & 0xffffu), bf2f(v.x >> 16), bf2f(v.y & 0xffffu), bf2f(v.y >> 16)}; }
__device__ __forceinline__ f32x4 g_hi4(u32x4 v) { return (f32x4){bf2f(v.z & 0xffffu), bf2f(v.z >> 16), bf2f(v.w & 0xffffu), bf2f(v.w >> 16)}; }
__device__ __forceinline__ u32x2 g_pk4(f32x4 v) { u32x2 r; r.x = pk2(v[0], v[1]); r.y = pk2(v[2], v[3]); return r; }
__device__ __forceinline__ f32x4 g_unpk4(u32x2 v) { return (f32x4){bf2f(v.x & 0xffffu), bf2f(v.x >> 16), bf2f(v.y & 0xffffu), bf2f(v.y >> 16)}; }

template <bool OUT> struct GlaRaw { u32x4 q[2], k[2], v[4]; };
template <bool OUT> __device__ __forceinline__ void gla_issue(GlaRaw<OUT>& x, const char* cb  , unsigned offQ, unsigned offV) {
    if (OUT) { x.q[0] = *(const u32x4*)(cb + offQ); x.q[1] = *(const u32x4*)(cb + offQ + 16); }
    x.k[0] = *(const u32x4*)(cb + offQ + 1024); x.k[1] = *(const u32x4*)(cb + offQ + 1040);
#pragma unroll
    for (int i = 0; i < 4; ++i) x.v[i] = *(const u32x4*)(cb + offV + 16 * i);
}

template <bool OUT>
__device__ void gla_pass(const Params& p, unsigned char* lds) {
    const int tid = threadIdx.x, w = __builtin_amdgcn_readfirstlane(tid >> 6);
    const bf16_t* P = (const bf16_t*)(p.ws + WS_P);
    bf16_t* GS = (bf16_t*)(p.ws + WS_GS);
    float* GD = (float*)(p.ws + WS_GD);
    bf16_t* Aout = (bf16_t*)(p.ws + WS_A);
    const bf16_t* WupT = (const bf16_t*)(p.ws + WS_WUPT);
    const bf16_t* ADG = (const bf16_t*)(p.ws + WS_AD);
    float* BC = (float*)(lds + L_BC); bf16_t* ATT = (bf16_t*)(lds + L_ATT); bf16_t* QD = (bf16_t*)(lds + L_QD); bf16_t* KD = (bf16_t*)(lds + L_KD); bf16_t* KTE = (bf16_t*)(lds + L_KTE);
    bf16_t* VI = (bf16_t*)(lds + L_VI); float* SSQ = (float*)(lds + L_SSQ); float* BL = (float*)(lds + L_BL); float* DEC = (float*)(lds + L_DEC); bf16_t* ADL = (bf16_t*)(lds + L_ADL);
    const float* b_al = p.in[4]; const float* g_head = p.in[5];

    for (int unit = blockIdx.x; unit < 256; unit += gridDim.x) {
        const int bh = unit >> 5, m = unit & 31, b = bh >> 2, h = bh & 3;
        int tidv = tid; asm volatile("" : "+v"(tidv));
        const int lane = tidv & 63, l15 = lane & 15, g = lane >> 4, q4 = l15 >> 2, p4 = l15 & 3;
        const int c = tidv >> 3, seg = tidv & 7;
        const int tokbase = b * SEQ + m * 512;
        u32x4 wupq = *(const u32x4*)(WupT + (size_t)(h * 128 + 16 * w + l15) * 16 + 8 * (g & 1));
        if (g >= 2) wupq = (u32x4){0u, 0u, 0u, 0u};
        const bf16x8 wupf = as_bf16x8(wupq);
        const float bA = b_al[h * 128 + 16 * w + l15];
        f32x4 gh[2];
#pragma unroll
        for (int vt = 0; vt < 2; ++vt) gh[vt] = *(const f32x4*)(g_head + 32 * w + 16 * vt + 4 * g);
        float logD = 0.f;
        f32x4 S[8][2];
#pragma unroll
        for (int mt = 0; mt < 8; ++mt)
#pragma unroll
            for (int vt = 0; vt < 2; ++vt) {
                if (OUT) S[mt][vt] = g_unpk4(*(const u32x2*)(GS + ((size_t)(bh * 32 + m) * 256 + 32 * w + 16 * vt + l15) * 128 + 16 * mt + 4 * g));
                else S[mt][vt] = (f32x4){0.f, 0.f, 0.f, 0.f};
            }
        const unsigned offQ = (unsigned)((c * GIN_P + h * 128 + 16 * seg) * 2), offV = (unsigned)((c * GIN_P + 1024 + h * 256 + 32 * seg) * 2), offAD = (unsigned)(tid * 16);
        const unsigned offG = (unsigned)((l15 * GIN_P + 2048 + h * 256 + 32 * w + 4 * g) * 2), offO = (unsigned)((l15 * DM + h * 256 + 32 * w + 4 * g) * 2);
        GlaRaw<OUT> raw;
        gla_issue<OUT>(raw, (const char*)P + (size_t)tokbase * GIN_P * 2, offQ, offV);
        if (tid < 128) *(u32x4*)(ADL + tid * 8) = *(const u32x4*)((const char*)ADG + (size_t)tokbase * 32 + offAD);
        GLA_BARRIER();

        for (int ch = 0; ch < 8; ++ch) {
            const int tok0 = tokbase + ch * 64;
            u32x4 adn = (u32x4){0u, 0u, 0u, 0u};
            {
                if (ch < 7 && tid < 128) adn = *(const u32x4*)((const char*)ADG + (size_t)(tok0 + 64) * 32 + offAD);
                f32x4 sc[4]; float xinc[4], tot[4];
#pragma unroll
                for (int ct = 0; ct < 4; ++ct) {
                    u32x4 aq = *(const u32x4*)(ADL + (16 * ct + l15) * 16 + 8 * (g & 1));
                    if (g >= 2) aq = (u32x4){0u, 0u, 0u, 0u};
                    const f32x4 z = mfma16(as_bf16x8(aq), wupf, (f32x4){bA, bA, bA, bA});
                    float acc = 0.f;
#pragma unroll
                    for (int r = 0; r < 4; ++r) { acc += (fminf(z[r], 0.f) - flog(1.f + fexp(-fabsf(z[r])))) * (1.0f / 16.0f); sc[ct][r] = acc; }
                    xinc[ct] = acc;
                }
#pragma unroll
                for (int ct = 0; ct < 4; ++ct) xinc[ct] += (g >= 1 ? 1.f : 0.f) * bperm(((lane - 16) & 63) * 4, xinc[ct]);
#pragma unroll
                for (int ct = 0; ct < 4; ++ct) xinc[ct] += (g >= 2 ? 1.f : 0.f) * bperm(((lane - 32) & 63) * 4, xinc[ct]);
#pragma unroll
                for (int ct = 0; ct < 4; ++ct) tot[ct] = bperm((48 + l15) * 4, xinc[ct]);
                float run = 0.f;
#pragma unroll
                for (int ct = 0; ct < 4; ++ct) {
                    const float base = run + (xinc[ct] - sc[ct][3]);
                    run += tot[ct];
#pragma unroll
                    for (int r = 0; r < 4; ++r) BC[(16 * ct + 4 * g + r) * 132 + 16 * w + l15] = base + sc[ct][r];
                }
                if (g == 0) { BL[16 * w + l15] = run; DEC[16 * w + l15] = fexp(run); }
                if (!OUT) logD += run;
            }
            GLA_BARRIER();
            u32x2 gate[2][4];
            {
#pragma unroll
                for (int hh = 0; hh < 2; ++hh) {
                    const int o8 = 16 * seg + 8 * hh;
                    const f32x4 bb[2] = {*(const f32x4*)(BC + c * 132 + o8), *(const f32x4*)(BC + c * 132 + o8 + 4)};
                    const f32x4 dc[2] = {*(const f32x4*)(DEC + o8), *(const f32x4*)(DEC + o8 + 4)};
                    const f32x4 kx[2] = {g_lo4(raw.k[hh]), g_hi4(raw.k[hh])};
                    f32x4 qx[2];
                    if (OUT) { qx[0] = g_lo4(raw.q[hh]); qx[1] = g_hi4(raw.q[hh]); }
                    f32x4 kd[2], kt[2], qd[2];
#pragma unroll
                    for (int i = 0; i < 2; ++i)
#pragma unroll
                        for (int j = 0; j < 4; ++j) {
                            const float eB = fexp(bb[i][j]), enB = __builtin_amdgcn_rcpf(eB);
                            kd[i][j] = kx[i][j] * enB; kt[i][j] = kd[i][j] * dc[i][j];
                            if (OUT) qd[i][j] = qx[i][j] * 0.08838834764831845f * eB;
                        }
                    *(u32x4*)(KTE + c * 152 + o8) = (u32x4){pk2(kt[0][0], kt[0][1]), pk2(kt[0][2], kt[0][3]), pk2(kt[1][0], kt[1][1]), pk2(kt[1][2], kt[1][3])};
                    if (OUT) {
                        *(u32x4*)(KD + c * 136 + o8) = (u32x4){pk2(kd[0][0], kd[0][1]), pk2(kd[0][2], kd[0][3]), pk2(kd[1][0], kd[1][1]), pk2(kd[1][2], kd[1][3])};
                        *(u32x4*)(QD + c * 136 + o8) = (u32x4){pk2(qd[0][0], qd[0][1]), pk2(qd[0][2], qd[0][3]), pk2(qd[1][0], qd[1][1]), pk2(qd[1][2], qd[1][3])};
                    }
                }
#pragma unroll
                for (int i = 0; i < 4; ++i) *(u32x4*)(VI + c * 280 + 32 * seg + 8 * i) = raw.v[i];
                if (OUT) {
#pragma unroll
                    for (int vt = 0; vt < 2; ++vt)
#pragma unroll
                        for (int ct = 0; ct < 4; ++ct) gate[vt][ct] = *(const u32x2*)((const char*)P + (size_t)(tok0 + 16 * ct) * GIN_P * 2 + offG + 32 * vt);
                }
                if (ch < 7) gla_issue<OUT>(raw, (const char*)P + (size_t)(tok0 + 64) * GIN_P * 2, offQ, offV);
                if (ch < 7 && tid < 128) *(u32x4*)(ADL + tid * 8) = adn;
            }
            GLA_BARRIER();
            f32x4 o[2][4];
            if (OUT) {
#pragma unroll
                for (int t2 = 0; t2 < 2; ++t2) {
                    const int tl = 2 * w + t2, ct = tl >> 2, st = tl & 3;
                    f32x4 acc = (f32x4){0.f, 0.f, 0.f, 0.f};
                    if (st <= ct) {
#pragma unroll
                        for (int kk = 0; kk < 4; ++kk) {
                            const bf16x8 a = *(const bf16x8*)(KD + (16 * st + l15) * 136 + 32 * kk + 8 * g);
                            const bf16x8 bq = *(const bf16x8*)(QD + (16 * ct + l15) * 136 + 32 * kk + 8 * g);
                            acc = mfma16(a, bq, acc);
                        }
#pragma unroll
                        for (int r = 0; r < 4; ++r) if (16 * st + 4 * g + r > 16 * ct + l15) acc[r] = 0.f;
                    }
                    *(u32x2*)(ATT + (16 * ct + l15) * 72 + 16 * st + 4 * g) = g_pk4(acc);
                }
                GLA_BARRIER();
#pragma unroll
                for (int vt = 0; vt < 2; ++vt)
#pragma unroll
                    for (int ct = 0; ct < 4; ++ct) o[vt][ct] = (f32x4){0.f, 0.f, 0.f, 0.f};
#pragma unroll
                for (int kk = 0; kk < 4; ++kk) {
                    bf16x8 sa[2];
#pragma unroll
                    for (int vt = 0; vt < 2; ++vt) { const u32x2 s0 = g_pk4(S[2 * kk][vt]), s1 = g_pk4(S[2 * kk + 1][vt]); sa[vt] = as_bf16x8((u32x4){s0.x, s0.y, s1.x, s1.y}); }
#pragma unroll
                    for (int ct = 0; ct < 4; ++ct) {
                        const bf16_t* qr = QD + (16 * ct + l15) * 136 + 32 * kk + 4 * g;
                        const u32x2 lo = *(const u32x2*)qr, hi = *(const u32x2*)(qr + 16);
                        const bf16x8 bq = as_bf16x8((u32x4){lo.x, lo.y, hi.x, hi.y});
#pragma unroll
                        for (int vt = 0; vt < 2; ++vt) o[vt][ct] = mfma16(sa[vt], bq, o[vt][ct]);
                    }
                }
            }
            bf16x8 bv[2][2];
#pragma unroll
            for (int vt = 0; vt < 2; ++vt)
#pragma unroll
                for (int kk = 0; kk < 2; ++kk) bv[vt][kk] = g_trfrag<280>(VI, 32 * kk, 32 * w + 16 * vt, g, q4, p4);
            if (OUT) {
#pragma unroll
                for (int ct = 0; ct < 4; ++ct)
#pragma unroll
                    for (int kk = 0; kk < 2; ++kk) {
                        if (32 * kk <= 16 * ct + 15) {
                            const bf16x8 bq = *(const bf16x8*)(ATT + (16 * ct + l15) * 72 + 32 * kk + 8 * g);
#pragma unroll
                            for (int vt = 0; vt < 2; ++vt) o[vt][ct] = mfma16(bv[vt][kk], bq, o[vt][ct]);
                        }
                    }
            }
#pragma unroll
            for (int mt = 0; mt < 8; ++mt) {
                const f32x4 dv = *(const f32x4*)(DEC + 16 * mt + 4 * g);
#pragma unroll
                for (int vt = 0; vt < 2; ++vt) S[mt][vt] *= dv;
#pragma unroll
                for (int kk = 0; kk < 2; ++kk) {
                    const bf16x8 a = g_trfrag<152>(KTE, 32 * kk, 16 * mt, g, q4, p4);
#pragma unroll
                    for (int vt = 0; vt < 2; ++vt) S[mt][vt] = mfma16(a, bv[vt][kk], S[mt][vt]);
                }
            }
            if (OUT) {
                float ss[4];
#pragma unroll
                for (int ct = 0; ct < 4; ++ct) {
                    float s = 0.f;
#pragma unroll
                    for (int vt = 0; vt < 2; ++vt)
#pragma unroll
                        for (int r = 0; r < 4; ++r) s += o[vt][ct][r] * o[vt][ct][r];
                    s += bperm((lane ^ 16) * 4, s); s += bperm((lane ^ 32) * 4, s);
                    ss[ct] = s;
                }
                if (g == 0) {
#pragma unroll
                    for (int ct = 0; ct < 4; ++ct) SSQ[(16 * ct + l15) * 8 + w] = ss[ct];
                }
                GLA_BARRIER();
#pragma unroll
                for (int ct = 0; ct < 4; ++ct) {
                    const int cc = 16 * ct + l15;
                    const float4 s0 = *(const float4*)(SSQ + cc * 8), s1 = *(const float4*)(SSQ + cc * 8 + 4);
                    const float tot = (s0.x + s0.y) + (s0.z + s0.w) + (s1.x + s1.y) + (s1.z + s1.w);
                    const float rstd = rsqrtf(tot * (1.0f / 256.0f) + 1e-6f);
#pragma unroll
                    for (int vt = 0; vt < 2; ++vt) {
                        const f32x4 gt = g_unpk4(gate[vt][ct]);
                        f32x4 val;
#pragma unroll
                        for (int r = 0; r < 4; ++r) val[r] = o[vt][ct][r] * rstd * gh[vt][r] * gt[r];
                        *(u32x2*)((char*)Aout + (size_t)(tok0 + 16 * ct) * DM * 2 + offO + 32 * vt) = g_pk4(val);
                    }
                }
            } else {
                GLA_BARRIER();
            }
        }
        if (!OUT) {
#pragma unroll
            for (int mt = 0; mt < 8; ++mt)
#pragma unroll
                for (int vt = 0; vt < 2; ++vt) *(u32x2*)(GS + ((size_t)(bh * 32 + m) * 256 + 32 * w + 16 * vt + l15) * 128 + 16 * mt + 4 * g) = g_pk4(S[mt][vt]);
            if (g == 0) GD[(bh * 32 + m) * 128 + 16 * w + l15] = fexp(logD);
        }
        GLA_BARRIER();
    }
}

__device__ void gla_scan(const Params& p) {
    bf16_t* GS = (bf16_t*)(p.ws + WS_GS);
    const float* GD = (const float*)(p.ws + WS_GD);
    for (int idx = blockIdx.x * NTH + threadIdx.x; idx < 8 * 8192; idx += gridDim.x * NTH) {
        const int bh = idx >> 13, e = (idx & 8191) * 4, d = e & 127;
        f32x4 S = (f32x4){0.f, 0.f, 0.f, 0.f};
        for (int m0 = 0; m0 < 32; m0 += 8) {
            u32x2 t[8]; f32x4 dd[8];
#pragma unroll
            for (int m = 0; m < 8; ++m) { t[m] = *(const u32x2*)(GS + (size_t)(bh * 32 + m0 + m) * 32768 + e); dd[m] = *(const f32x4*)(GD + (bh * 32 + m0 + m) * 128 + d); }
#pragma unroll
            for (int m = 0; m < 8; ++m) { *(u32x2*)(GS + (size_t)(bh * 32 + m0 + m) * 32768 + e) = g_pk4(S); S = S * dd[m] + g_unpk4(t[m]); }
        }
    }
}

constexpr int PP = RIN_P;
constexpr size_t WS_RK  = WS_GS;
constexpr size_t WS_BND = WS_GS + (size_t)MTOK * 16 * 4;
static_assert(WS_BND + (size_t)513 * PP * 2 <= WS_GD, "RWKV side buffers must fit the GLA state region");
constexpr int IMG = 64 * 72 * 2;
constexpr int R_ALB = 0, R_BH = IMG, R_KH = 2 * IMG, R_RB = 3 * IMG, R_BTL = 4 * IMG, R_KTL = 5 * IMG, R_VI = 6 * IMG, R_AAB = 7 * IMG, R_AAK = 8 * IMG, R_ARB = 9 * IMG, R_ARK = 10 * IMG,
              R_DW = R_AAB, R_DA = R_AAB + 64 * 68 * 4, R_XT = 11 * IMG, R_TW = R_XT, R_ADI = R_XT + IMG, R_TDF = R_XT + 2 * IMG, R_CS = R_TDF + 2048, R_GC = R_CS + 2048, R_CONST = R_GC + 256, R_WDL = R_CONST + 2560, R_WIL = R_WDL + IMG,
              R_END = R_WIL + IMG;
static_assert(R_DA + 64 * 68 * 4 <= R_XT && R_END <= LDS_BYTES, "R1 LDS");
#define LDS_BARRIER() do { asm volatile("s_waitcnt lgkmcnt(0)" ::: "memory"); __builtin_amdgcn_s_barrier(); asm volatile("" ::: "memory"); } while (0)

typedef short s16x4 __attribute__((ext_vector_type(4)));
__device__ __forceinline__ bf16x8 ldfrag(const bf16_t* img, int row, int koff) { return *(const bf16x8*)(img + row * 72 + koff); }
__device__ __forceinline__ u32x2 pk4(f32x4 v) { u32x2 r; r.x = pk2(v[0], v[1]); r.y = pk2(v[2], v[3]); return r; }
__device__ __forceinline__ f32x4 unpk4(u32x2 v) { return (f32x4){bf2f(v.x & 0xffffu), bf2f(v.x >> 16), bf2f(v.y & 0xffffu), bf2f(v.y >> 16)}; }
__device__ __forceinline__ u32x2 trread(const bf16_t* p) {
    union { s16x4 s; u32x2 u; } x; x.s = __builtin_amdgcn_ds_read_tr16_b64_v4i16((__attribute__((address_space(3))) s16x4*)p); return x.u;
}
__device__ __forceinline__ bf16x8 trfrag(const bf16_t* img, int k0, int c0, int g, int q, int pq) {
    const bf16_t* a = img + (k0 + 8 * g + q) * 72 + c0 + 4 * pq;
    const u32x2 lo = trread(a), hi = trread(a + 4 * 72);
    return as_bf16x8((u32x4){lo.x, lo.y, hi.x, hi.y});
}
__device__ __forceinline__ f32x4 lo4(u32x4 v) { return (f32x4){bf2f(v.x & 0xffffu), bf2f(v.x >> 16), bf2f(v.y & 0xffffu), bf2f(v.y >> 16)}; }
__device__ __forceinline__ f32x4 hi4(u32x4 v) { return (f32x4){bf2f(v.z & 0xffffu), bf2f(v.z >> 16), bf2f(v.w & 0xffffu), bf2f(v.w >> 16)}; }
__device__ __forceinline__ u32x4 pk8(f32x4 a, f32x4 b) { return (u32x4){pk2(a[0], a[1]), pk2(a[2], a[3]), pk2(b[0], b[1]), pk2(b[2], b[3])}; }
__device__ __forceinline__ float fast_rcp(float x) { return __builtin_amdgcn_rcpf(x); }
__device__ __forceinline__ f32x4 mm16(f32x4 xa, f32x4 yb, f32x4 c) {
    const u32x2 a = pk4(xa), b = pk4(yb);
    return mfma16(as_bf16x8((u32x4){a.x, a.y, 0u, 0u}), as_bf16x8((u32x4){b.x, b.y, 0u, 0u}), c);
}

struct R1Raw { u32x4 r0, r1, k0, k1, v0, v1, w0, w1, a0, a1; };
__device__ __forceinline__ void r1_issue(R1Raw& x, const bf16_t* P, const bf16_t* BND, int unit, int t, int cs) {
    const int bn = unit >> 4, h = unit & 15, n = bn & 255;
    const bf16_t* cur = P + ((size_t)bn * 64 + t) * PP;
    const bf16_t* prv = (t > 0) ? (cur - PP) : (BND + (size_t)(n == 0 ? 0 : bn) * PP);
    const int ch = h * 64 + 8 * cs;
    x.r0 = *(const u32x4*)(cur + ch); x.k0 = *(const u32x4*)(cur + 1024 + ch); x.v0 = *(const u32x4*)(cur + 2048 + ch); x.w0 = *(const u32x4*)(cur + 4096 + 8 * cs); x.a0 = *(const u32x4*)(cur + 4160 + 8 * cs);
    x.r1 = *(const u32x4*)(prv + ch); x.k1 = *(const u32x4*)(prv + 1024 + ch); x.v1 = *(const u32x4*)(prv + 2048 + ch); x.w1 = *(const u32x4*)(prv + 4096 + 8 * cs); x.a1 = *(const u32x4*)(prv + 4160 + 8 * cs);
}
__device__ __forceinline__ void lerp8(u32x4 c, u32x4 pv, const float* mu8, f32x4& o0, f32x4& o1) {
    const f32x4 c0 = lo4(c), c1 = hi4(c), p0 = lo4(pv), p1 = hi4(pv);
    const f32x4 m0 = *(const f32x4*)mu8, m1 = *(const f32x4*)(mu8 + 4);
    o0 = c0 + m0 * (p0 - c0); o1 = c1 + m1 * (p1 - c1);
}

__device__ void rwkv_r1(const Params& p, unsigned char* lds) {
    const int tid = threadIdx.x, w = __builtin_amdgcn_readfirstlane(tid >> 6);
    bf16_t* P = (bf16_t*)(p.ws + WS_P);
    bf16_t* Abuf = (bf16_t*)(p.ws + WS_A);
    bf16_t* Ybuf = (bf16_t*)(p.ws + WS_Y);
    float* RK = (float*)(p.ws + WS_RK);
    const bf16_t* BND = (const bf16_t*)(p.ws + WS_BND);
    const bf16_t* WduT = (const bf16_t*)(p.ws + WS_WDUT);
    const bf16_t* WiuT = (const bf16_t*)(p.ws + WS_WIUT);
    bf16_t* ALB = (bf16_t*)(lds + R_ALB); bf16_t* BH = (bf16_t*)(lds + R_BH); bf16_t* KH = (bf16_t*)(lds + R_KH); bf16_t* RB = (bf16_t*)(lds + R_RB);
    bf16_t* BTL = (bf16_t*)(lds + R_BTL); bf16_t* KTL = (bf16_t*)(lds + R_KTL); bf16_t* VI = (bf16_t*)(lds + R_VI);
    bf16_t* AAB = (bf16_t*)(lds + R_AAB); bf16_t* AAK = (bf16_t*)(lds + R_AAK); bf16_t* ARB = (bf16_t*)(lds + R_ARB); bf16_t* ARK = (bf16_t*)(lds + R_ARK);
    float* DW = (float*)(lds + R_DW); float* DA = (float*)(lds + R_DA);
    bf16_t* XT = (bf16_t*)(lds + R_XT); bf16_t* TW = (bf16_t*)(lds + R_TW); bf16_t* ADI = (bf16_t*)(lds + R_ADI);
    u32x2* TDF = (u32x2*)(lds + R_TDF); float* CS = (float*)(lds + R_CS); float* GCs = (float*)(lds + R_GC); float* CONST = (float*)(lds + R_CONST); bf16_t* WDL = (bf16_t*)(lds + R_WDL); bf16_t* WIL = (bf16_t*)(lds + R_WIL);
    const int t0_ = tid >> 3, cs0_ = tid & 7;
    int hprev = -1;
    R1Raw raw;
    if (blockIdx.x < 8192) r1_issue(raw, P, BND, blockIdx.x, t0_, cs0_);

    for (int unit = blockIdx.x; unit < 8192; unit += gridDim.x) {
        const int bn = unit >> 4, h = unit & 15, n = bn & 255;
        const size_t R0 = (size_t)bn * 64;
        int tidv = tid; asm volatile("" : "+v"(tidv));
        const int lane = tidv & 63, l15 = lane & 15, g = lane >> 4, q4 = l15 >> 2, p4 = l15 & 3, t = tidv >> 3, cs = tidv & 7, tl = lane >> 3;
        if (h != hprev) {
            LDS_BARRIER();
            if (tid < 64) {
                const int ch = h * 64 + tid;
                CONST[tid] = p.in[10][ch]; CONST[64 + tid] = p.in[10][1024 + ch]; CONST[128 + tid] = p.in[10][2048 + ch];
                CONST[192 + tid] = p.in[11][ch]; CONST[256 + tid] = p.in[13][ch]; CONST[320 + tid] = p.in[15][ch]; CONST[384 + tid] = p.in[16][ch]; CONST[448 + tid] = p.in[17][ch];
                CONST[512 + tid] = p.in[10][4096 + tid]; CONST[576 + tid] = p.in[10][4160 + tid];
            }
            {
                const int rr = tid >> 3, sg = tid & 7;
                *(u32x4*)(WDL + rr * 72 + 8 * sg) = *(const u32x4*)(WduT + (size_t)(h * 64 + rr) * 64 + 8 * sg);
                *(u32x4*)(WIL + rr * 72 + 8 * sg) = *(const u32x4*)(WiuT + (size_t)(h * 64 + rr) * 64 + 8 * sg);
            }
            hprev = h;
            LDS_BARRIER();
        }
        f32x4 r0, r1, k0, k1, v0, v1;
        {
            f32x4 wd0, wd1, ad0, ad1;
            lerp8(raw.r0, raw.r1, CONST + 8 * cs, r0, r1);
            lerp8(raw.k0, raw.k1, CONST + 64 + 8 * cs, k0, k1);
            lerp8(raw.v0, raw.v1, CONST + 128 + 8 * cs, v0, v1);
            lerp8(raw.w0, raw.w1, CONST + 512 + 8 * cs, wd0, wd1);
            lerp8(raw.a0, raw.a1, CONST + 576 + 8 * cs, ad0, ad1);
#pragma unroll
            for (int j = 0; j < 4; ++j) {
                const float e0 = fexp(-2.f * fabsf(wd0[j])), e1 = fexp(-2.f * fabsf(wd1[j]));
                wd0[j] = copysignf((1.f - e0) * fast_rcp(1.f + e0), wd0[j]); wd1[j] = copysignf((1.f - e1) * fast_rcp(1.f + e1), wd1[j]);
            }
            *(u32x4*)(TW + t * 72 + 8 * cs) = pk8(wd0, wd1);
            *(u32x4*)(ADI + t * 72 + 8 * cs) = pk8(ad0, ad1);
        }
        if (unit + (int)gridDim.x < 8192) r1_issue(raw, P, BND, unit + gridDim.x, t, cs);
        LDS_BARRIER();
        {
            const int tt = w & 3;
            bf16x8 ft[2], fa[2];
#pragma unroll
            for (int kk = 0; kk < 2; ++kk) { ft[kk] = ldfrag(TW, 16 * tt + l15, 32 * kk + 8 * g); fa[kk] = ldfrag(ADI, 16 * tt + l15, 32 * kk + 8 * g); }
#pragma unroll
            for (int q = 0; q < 2; ++q) {
                const int ct = 2 * (w >> 2) + q;
                f32x4 aw = (f32x4){0.f, 0.f, 0.f, 0.f}, aa = aw;
#pragma unroll
                for (int kk = 0; kk < 2; ++kk) { aw = mfma16(ldfrag(WDL, 16 * ct + l15, 32 * kk + 8 * g), ft[kk], aw); aa = mfma16(ldfrag(WIL, 16 * ct + l15, 32 * kk + 8 * g), fa[kk], aa); }
                *(f32x4*)(DW + (16 * tt + l15) * 68 + 16 * ct + 4 * g) = aw;
                *(f32x4*)(DA + (16 * tt + l15) * 68 + 16 * ct + 4 * g) = aa;
            }
        }
        LDS_BARRIER();
        f32x4 lw[2], av[2], kk[2], k2[2], G[2];
        {
            const f32x4 cw0[2] = {*(const f32x4*)(CONST + 192 + 8 * cs), *(const f32x4*)(CONST + 196 + 8 * cs)};
            const f32x4 ca0[2] = {*(const f32x4*)(CONST + 256 + 8 * cs), *(const f32x4*)(CONST + 260 + 8 * cs)};
            const f32x4 ckk[2] = {*(const f32x4*)(CONST + 320 + 8 * cs), *(const f32x4*)(CONST + 324 + 8 * cs)};
            const f32x4 cka[2] = {*(const f32x4*)(CONST + 384 + 8 * cs), *(const f32x4*)(CONST + 388 + 8 * cs)};
            const f32x4 crk[2] = {*(const f32x4*)(CONST + 448 + 8 * cs), *(const f32x4*)(CONST + 452 + 8 * cs)};
            const f32x4 dwv[2] = {*(const f32x4*)(DW + t * 68 + 8 * cs), *(const f32x4*)(DW + t * 68 + 8 * cs + 4)};
            const f32x4 dav[2] = {*(const f32x4*)(DA + t * 68 + 8 * cs), *(const f32x4*)(DA + t * 68 + 8 * cs + 4)};
            const f32x4 kin[2] = {k0, k1}, rin[2] = {r0, r1};
            float n2 = 0.f, rk = 0.f;
#pragma unroll
            for (int hf = 0; hf < 2; ++hf)
#pragma unroll
                for (int j = 0; j < 4; ++j) {
                    const float z = -(cw0[hf][j] + dwv[hf][j]);
                    const float sp = fmaxf(z, 0.f) + flog(1.f + fexp(-fabsf(z)));
                    lw[hf][j] = -fexp(-sp - 0.5f);
                    av[hf][j] = fast_rcp(1.f + fexp(-(ca0[hf][j] + dav[hf][j])));
                    kk[hf][j] = kin[hf][j] * ckk[hf][j];
                    k2[hf][j] = kin[hf][j] * (1.f + (av[hf][j] - 1.f) * cka[hf][j]);
                    n2 += kk[hf][j] * kk[hf][j]; rk += rin[hf][j] * k2[hf][j] * crk[hf][j];
                }
            n2 = sum8(n2); rk = sum8(rk);
            const float inv = 1.0f / fmaxf(sqrtf(n2), 1e-12f);
            kk[0] *= inv; kk[1] *= inv;
            if (cs == 0) RK[(R0 + t) * 16 + h] = rk;
            G[0] = lw[0]; G[1] = lw[1];
#pragma unroll
            for (int d = 1; d < 8; d <<= 1) {
                const int src = ((lane - 8 * d) & 63) * 4;
                const float keep = (tl >= d) ? 1.f : 0.f;
#pragma unroll
                for (int hf = 0; hf < 2; ++hf)
#pragma unroll
                    for (int j = 0; j < 4; ++j) G[hf][j] += keep * bperm(src, G[hf][j]);
            }
            if (tl == 7) { *(f32x4*)(CS + w * 64 + 8 * cs) = G[0]; *(f32x4*)(CS + w * 64 + 8 * cs + 4) = G[1]; }
        }
        LDS_BARRIER();
        {
            f32x4 off[2] = {(f32x4){0.f, 0.f, 0.f, 0.f}, (f32x4){0.f, 0.f, 0.f, 0.f}}, gc[2] = {off[0], off[0]};
#pragma unroll
            for (int q = 0; q < 8; ++q) {
                const f32x4 c0 = *(const f32x4*)(CS + q * 64 + 8 * cs), c1 = *(const f32x4*)(CS + q * 64 + 8 * cs + 4);
                const float mk = (q < w) ? 1.f : 0.f;
                gc[0] += c0; gc[1] += c1; off[0] += c0 * mk; off[1] += c1 * mk;
            }
            f32x4 al[2], bh[2], kh[2], rb[2];
            const f32x4 rin[2] = {r0, r1};
#pragma unroll
            for (int hf = 0; hf < 2; ++hf)
#pragma unroll
                for (int j = 0; j < 4; ++j) {
                    const float Gi = G[hf][j] + off[hf][j];
                    const float eG = fexp(Gi), eGm = fexp(Gi - lw[hf][j]), enG = fast_rcp(eG);
                    const float be = kk[hf][j] * av[hf][j];
                    al[hf][j] = -kk[hf][j] * eGm; bh[hf][j] = be * enG; kh[hf][j] = k2[hf][j] * enG; rb[hf][j] = rin[hf][j] * eG;
                }
            const int o = t * 72 + 8 * cs;
            *(u32x4*)(ALB + o) = pk8(al[0], al[1]); *(u32x4*)(BH + o) = pk8(bh[0], bh[1]); *(u32x4*)(KH + o) = pk8(kh[0], kh[1]); *(u32x4*)(RB + o) = pk8(rb[0], rb[1]);
            const u32x4 vpk = pk8(v0, v1);
            *(u32x4*)(VI + o) = vpk;
            *(u32x4*)(Ybuf + (R0 + t) * DM + h * 64 + 8 * cs) = vpk;
            if (w == 0 && tl == 0) { f32x4 e0, e1;
#pragma unroll
                for (int j = 0; j < 4; ++j) { e0[j] = fexp(gc[0][j]); e1[j] = fexp(gc[1][j]); }
                *(f32x4*)(GCs + 8 * cs) = e0; *(f32x4*)(GCs + 8 * cs + 4) = e1; }
        }
        LDS_BARRIER();
        {
            int ntile = 1, tta = 0, sta = 0, ttb = 0, stb = 0;
            if (w == 0) { tta = 0; sta = 0; } else if (w == 2) { tta = 1; sta = 1; } else if (w == 5) { tta = 2; sta = 2; } else if (w == 7) { tta = 3; sta = 3; }
            else if (w == 1) { ntile = 2; tta = 1; sta = 0; ttb = 2; stb = 0; } else if (w == 3) { ntile = 2; tta = 2; sta = 1; ttb = 3; stb = 0; }
            else if (w == 4) { tta = 3; sta = 1; } else { tta = 3; sta = 2; }
            for (int it = 0; it < ntile; ++it) {
                const int tt = it ? ttb : tta, st = it ? stb : sta;
                f32x4 cab = (f32x4){0.f, 0.f, 0.f, 0.f}, cak = cab, crb = cab, crk = cab, nab = cab;
#pragma unroll
                for (int kq = 0; kq < 2; ++kq) {
                    const bf16x8 fb = ldfrag(BH, 16 * st + l15, 32 * kq + 8 * g), fk = ldfrag(KH, 16 * st + l15, 32 * kq + 8 * g);
                    const bf16x8 fa = ldfrag(ALB, 16 * tt + l15, 32 * kq + 8 * g), fr = ldfrag(RB, 16 * tt + l15, 32 * kq + 8 * g);
                    cab = mfma16(fb, fa, cab); cak = mfma16(fk, fa, cak); crb = mfma16(fb, fr, crb); crk = mfma16(fk, fr, crk);
                    if (tt == st) nab = mfma16(fa, fb, nab);
                }
                if (tt == st) {
#pragma unroll
                    for (int r = 0; r < 4; ++r) {
                        const int s = 4 * g + r, tq = l15;
                        if (s >= tq) { cab[r] = 0.f; cak[r] = 0.f; }
                        if (s > tq) { crb[r] = 0.f; crk[r] = 0.f; }
                        if (l15 >= 4 * g + r) nab[r] = 0.f;
                    }
                }
                const int o = (16 * tt + l15) * 72 + 16 * st + 4 * g;
                *(u32x2*)(AAB + o) = pk4(cab); *(u32x2*)(AAK + o) = pk4(cak); *(u32x2*)(ARB + o) = pk4(crb); *(u32x2*)(ARK + o) = pk4(crk);
                if (tt == st) {
                    const f32x4 z = (f32x4){0.f, 0.f, 0.f, 0.f};
                    const f32x4 Q1 = cab, N1 = nab;
                    const f32x4 Q2 = mm16(N1, Q1, z), N2 = mm16(Q1, N1, z);
                    f32x4 Pm = Q1;
#pragma unroll
                    for (int r = 0; r < 4; ++r) if (4 * g + r == l15) Pm[r] += 1.f;
                    Pm = mm16(N2, Pm, Pm);
                    const f32x4 Q4 = mm16(N2, Q2, z), N4 = mm16(Q2, N2, z);
                    Pm = mm16(N4, Pm, Pm);
                    const f32x4 N8 = mm16(Q4, N4, z);
                    Pm = mm16(N8, Pm, Pm);
                    TDF[tt * 64 + lane] = pk4(Pm);
                }
            }
            if (w == 4 || w == 6) {
                const int tt = (w == 4) ? 0 : 2, st = tt + 1;
                const int o = (16 * tt + l15) * 72 + 16 * st + 4 * g;
                const u32x2 zz = (u32x2){0u, 0u};
                *(u32x2*)(AAK + o) = zz; *(u32x2*)(ARB + o) = zz; *(u32x2*)(ARK + o) = zz;
            }
        }
        LDS_BARRIER();
        {
            u32x2 xb[4];
            const int col = 16 * w + l15;
            bf16x8 vfr[2];
            if (w >= 4) { vfr[0] = trfrag(VI, 0, 16 * (w - 4), g, q4, p4); vfr[1] = trfrag(VI, 32, 16 * (w - 4), g, q4, p4); }
#pragma unroll
            for (int i = 0; i < 4; ++i) {
                f32x4 z;
                if (w < 4) z = unpk4(trread(ALB + (16 * i + 4 * g + q4) * 72 + 16 * w + 4 * p4));
                else {
                    z = mfma16(ldfrag(AAK, 16 * i + l15, 8 * g), vfr[0], (f32x4){0.f, 0.f, 0.f, 0.f});
                    if (i >= 2) z = mfma16(ldfrag(AAK, 16 * i + l15, 32 + 8 * g), vfr[1], z);
                }
                if (i >= 1) {
                    const bf16_t* ar = AAB + (16 * i + l15) * 72 + 4 * g;
                    const u32x2 a0 = *(const u32x2*)ar;
                    u32x2 a1 = (u32x2){0u, 0u}, b1 = (u32x2){0u, 0u};
                    if (i >= 2) { a1 = *(const u32x2*)(ar + 16); b1 = xb[1]; }
                    z = mfma16(as_bf16x8((u32x4){a0.x, a0.y, a1.x, a1.y}), as_bf16x8((u32x4){xb[0].x, xb[0].y, b1.x, b1.y}), z);
                    if (i == 3) {
                        const u32x2 a2 = *(const u32x2*)(ar + 32);
                        z = mfma16(as_bf16x8((u32x4){a2.x, a2.y, 0u, 0u}), as_bf16x8((u32x4){xb[2].x, xb[2].y, 0u, 0u}), z);
                    }
                }
                const u32x2 tq = TDF[i * 64 + lane];
                const u32x2 zq = pk4(z);
                const f32x4 x = mfma16(as_bf16x8((u32x4){tq.x, tq.y, 0u, 0u}), as_bf16x8((u32x4){zq.x, zq.y, 0u, 0u}), (f32x4){0.f, 0.f, 0.f, 0.f});
                xb[i] = pk4(x);
                *(u32x2*)(XT + col * 72 + 16 * i + 4 * g) = xb[i];
            }
        }
        LDS_BARRIER();
        {
            const int rt_ = w & 3, c0 = 2 * (w >> 2);
            bf16x8 xw[2], xu[2], fbt[2], fkt[2], fvr[2];
#pragma unroll
            for (int kq = 0; kq < 2; ++kq) {
                xw[kq] = ldfrag(XT, 16 * rt_ + l15, 32 * kq + 8 * g);
                xu[kq] = ldfrag(XT, 64 + 16 * rt_ + l15, 32 * kq + 8 * g);
                fbt[kq] = trfrag(BH, 32 * kq, 16 * rt_, g, q4, p4);
                fkt[kq] = trfrag(KH, 32 * kq, 16 * rt_, g, q4, p4);
                fvr[kq] = trfrag(VI, 32 * kq, 16 * rt_, g, q4, p4);
            }
            const float gcd0 = GCs[16 * c0 + l15], gcd1 = GCs[16 * c0 + 16 + l15];
            const f32x4 gcr = *(const f32x4*)(GCs + 16 * rt_ + 4 * g);
#pragma unroll
            for (int q = 0; q < 2; ++q) {
                bf16x8 gbt[2], garb[2], gxu[2], gvi[2], gark[2];
#pragma unroll
                for (int kq = 0; kq < 2; ++kq) {
                    gbt[kq] = trfrag(BH, 32 * kq, 16 * (c0 + q), g, q4, p4);
                    garb[kq] = ldfrag(ARB, 16 * (c0 + q) + l15, 32 * kq + 8 * g);
                    gxu[kq] = ldfrag(XT, 64 + 16 * (c0 + q) + l15, 32 * kq + 8 * g);
                    gvi[kq] = trfrag(VI, 32 * kq, 16 * (c0 + q), g, q4, p4);
                    gark[kq] = ldfrag(ARK, 16 * (c0 + q) + l15, 32 * kq + 8 * g);
                }
                const u32x2 rbi = *(const u32x2*)(RB + (16 * (c0 + q) + l15) * 72 + 16 * rt_ + 4 * g);
                __builtin_amdgcn_sched_barrier(0);
                const int ctile = c0 + q;
                {
                    f32x4 acc = (f32x4){0.f, 0.f, 0.f, 0.f};
#pragma unroll
                    for (int kq = 0; kq < 2; ++kq) acc = mfma16(xw[kq], gbt[kq], acc);
                    const int dcol = 16 * ctile + l15;
                    if (rt_ == ctile) {
#pragma unroll
                        for (int r = 0; r < 4; ++r) if (4 * g + r == l15) acc[r] += 1.f;
                    }
                    acc *= (q ? gcd1 : gcd0);
                    *(u32x2*)(ALB + dcol * 72 + 32 * (rt_ >> 1) + 8 * g + 4 * (rt_ & 1)) = pk4(acc);
                }
                {
                    f32x4 acc = unpk4(rbi);
#pragma unroll
                    for (int kq = 0; kq < 2; ++kq) {
                        if (32 * kq <= 16 * ctile + 15) acc = mfma16(xw[kq], garb[kq], acc);
                    }
                    *(u32x2*)(BTL + (16 * ctile + l15) * 72 + 16 * rt_ + 4 * g) = pk4(acc);
                }
                {
                    f32x4 acc = (f32x4){0.f, 0.f, 0.f, 0.f};
#pragma unroll
                    for (int kq = 0; kq < 2; ++kq) { acc = mfma16(fbt[kq], gxu[kq], acc); acc = mfma16(fkt[kq], gvi[kq], acc); }
                    *(u32x2*)(KTL + (16 * ctile + l15) * 72 + 16 * rt_ + 4 * g) = pk4(acc * gcr);
                }
                {
                    f32x4 acc = (f32x4){0.f, 0.f, 0.f, 0.f};
#pragma unroll
                    for (int kq = 0; kq < 2; ++kq) {
                        if (32 * kq <= 16 * ctile + 15) { acc = mfma16(xu[kq], garb[kq], acc); acc = mfma16(fvr[kq], gark[kq], acc); }
                    }
                    *(u32x2*)(AAB + (16 * ctile + l15) * 72 + 16 * rt_ + 4 * g) = pk4(acc);
                }
            }
        }
        LDS_BARRIER();
        {
            const int o = t * 72 + 8 * cs;
            *(u32x4*)(P + (R0 + t) * PP + h * 64 + 8 * cs) = *(const u32x4*)(ALB + o);
            *(u32x4*)(P + (R0 + t) * PP + 1024 + h * 64 + 8 * cs) = *(const u32x4*)(BTL + o);
            *(u32x4*)(P + (R0 + t) * PP + 2048 + h * 64 + 8 * cs) = *(const u32x4*)(KTL + o);
            *(u32x4*)(Abuf + (R0 + t) * DM + h * 64 + 8 * cs) = *(const u32x4*)(AAB + o);
        }
    }
}

constexpr int SC_SLOT = 2 * IMG;
constexpr size_t WS_MG = (WS_BND + (size_t)513 * PP * 2 + 255) & ~(size_t)255;
constexpr size_t WS_NG = WS_MG + (size_t)1024 * 4096 * 2;
static_assert(WS_NG + (size_t)1024 * 4096 * 2 <= WS_GD, "scan buffers must fit the GLA state region");

template <int MODE>
__device__ void rwkv_scan2(const Params& p, unsigned char* lds) {
    constexpr int GSZ = 32, NGRP = 256 / GSZ, LG = 3;
    constexpr int SPU = (MODE == 2) ? NGRP : GSZ;
    constexpr int NU = (MODE == 2) ? 32 : 32 * NGRP;
    const int tid = threadIdx.x, lane = tid & 63, w = __builtin_amdgcn_readfirstlane(tid >> 6), l15 = lane & 15, g = lane >> 4;
    bf16_t* P = (bf16_t*)(p.ws + WS_P);
    bf16_t* MG = (bf16_t*)(p.ws + WS_MG); bf16_t* NG = (bf16_t*)(p.ws + WS_NG); bf16_t* HG = NG;
    const int G = gridDim.x;
    const int nun = ((int)blockIdx.x < NU) ? (NU - 1 - (int)blockIdx.x) / G + 1 : 0;
    const int T = nun * SPU;
    if (T == 0) return;
#define SC_SRC(s, p0, p1, pitchb) \
    const int u_ = (int)blockIdx.x + G * ((s) / SPU), j_ = (s) % SPU; \
    const char* p0; const char* p1; unsigned pitchb; \
    if (MODE == 2) { p0 = (const char*)(MG + (size_t)(u_ * NGRP + j_) * 4096); p1 = (const char*)(NG + (size_t)(u_ * NGRP + j_) * 4096); pitchb = 128u; } \
    else { const int bh_ = u_ >> LG, n_ = GSZ * (u_ & (NGRP - 1)) + j_; p0 = (const char*)(P + ((size_t)(bh_ >> 4) * SEQ + (size_t)n_ * 64) * PP + (bh_ & 15) * 64); p1 = p0 + 4096; pitchb = (unsigned)(PP * 2); }
    if (w >= 4) {
        const int lj = w - 4;
        const unsigned loff = (unsigned)((lane >> 3) * 144 + (lane & 7) * 16);
        u32x4 ld0[16], ld1[16];
#define SC_ISSUE(dst, s) do { const int sc_ = ((s) < T) ? (s) : T - 1; SC_SRC(sc_, q0_, q1_, pb_) const unsigned go_ = (unsigned)(lane >> 3) * pb_ + (unsigned)(lane & 7) * 16u; \
        _Pragma("unroll") for (int q = 0; q < 16; ++q) dst[q] = *(const u32x4*)(((q >> 3) ? q1_ : q0_) + (size_t)((q & 7) * 8) * pb_ + go_); } while (0)
#define SC_RETIRE(src, s) do { unsigned char* sb = lds + ((s) & 1) * SC_SLOT + loff; _Pragma("unroll") for (int q = 0; q < 16; ++q) \
        *(u32x4*)(sb + (q >> 3) * IMG + (q & 7) * 8 * 144) = src[q]; } while (0)
        SC_ISSUE(ld0, lj); SC_ISSUE(ld1, lj + 4);
        for (int it = 0; it < T / 8; ++it) {
            const int c0 = lj + 8 * it;
            for (int k = 0; k < lj; ++k) LDS_BARRIER();
            SC_RETIRE(ld0, c0); SC_ISSUE(ld0, c0 + 8);
            for (int k = 0; k < 4; ++k) LDS_BARRIER();
            SC_RETIRE(ld1, c0 + 4); SC_ISSUE(ld1, c0 + 12);
            for (int k = 0; k < 4 - lj; ++k) LDS_BARRIER();
        }
        LDS_BARRIER();
#undef SC_ISSUE
#undef SC_RETIRE
    } else {
        f32x4 H[4], Mg[4];
        for (int i = 0; i <= T; ++i) {
            if (i >= 1) {
                const int s = i - 1, u = (int)blockIdx.x + G * (s / SPU), j = s % SPU;
                const unsigned char* sb = lds + (s & 1) * SC_SLOT;
                const bf16_t* MT = (const bf16_t*)sb; const bf16_t* NT = (const bf16_t*)(sb + IMG);
                if (j == 0) {
                    if (MODE == 3) {
#pragma unroll
                        for (int mt = 0; mt < 4; ++mt) H[mt] = unpk4(*(const u32x2*)(HG + (size_t)u * 4096 + (16 * w + l15) * 64 + 16 * mt + 4 * g));
                    } else {
#pragma unroll
                        for (int mt = 0; mt < 4; ++mt) H[mt] = (f32x4){0.f, 0.f, 0.f, 0.f};
                    }
                    if (MODE == 1) {
#pragma unroll
                        for (int mt = 0; mt < 4; ++mt)
#pragma unroll
                            for (int r = 0; r < 4; ++r) Mg[mt][r] = (16 * mt + 4 * g + r == 16 * w + l15) ? 1.f : 0.f;
                    }
                }
                u32x2 hp[4];
#pragma unroll
                for (int mt = 0; mt < 4; ++mt) hp[mt] = pk4(H[mt]);
                if (MODE == 2) {
#pragma unroll
                    for (int mt = 0; mt < 4; ++mt) *(u32x2*)(HG + (size_t)(u * NGRP + j) * 4096 + (16 * w + l15) * 64 + 16 * mt + 4 * g) = hp[mt];
                }
                if (MODE == 3) {
                    const int bh = u >> LG, n = GSZ * (u & (NGRP - 1)) + j;
#pragma unroll
                    for (int mt = 0; mt < 4; ++mt) *(u32x2*)(P + ((size_t)(bh >> 4) * SEQ + (size_t)n * 64 + 16 * w + l15) * PP + 2048 + (bh & 15) * 64 + 16 * mt + 4 * g) = hp[mt];
                }
                bf16x8 hb[2], mb[2];
                hb[0] = as_bf16x8((u32x4){hp[0].x, hp[0].y, hp[1].x, hp[1].y});
                hb[1] = as_bf16x8((u32x4){hp[2].x, hp[2].y, hp[3].x, hp[3].y});
                if (MODE == 1) {
                    const u32x2 m0 = pk4(Mg[0]), m1 = pk4(Mg[1]), m2 = pk4(Mg[2]), m3 = pk4(Mg[3]);
                    mb[0] = as_bf16x8((u32x4){m0.x, m0.y, m1.x, m1.y}); mb[1] = as_bf16x8((u32x4){m2.x, m2.y, m3.x, m3.y});
                }
#pragma unroll
                for (int mt = 0; mt < 4; ++mt) {
                    const bf16x8 a0 = ldfrag(MT, 16 * mt + l15, 8 * g), a1 = ldfrag(MT, 16 * mt + l15, 32 + 8 * g);
                    f32x4 acc = unpk4(*(const u32x2*)(NT + (16 * w + l15) * 72 + 16 * mt + 4 * g));
                    acc = mfma16(a0, hb[0], acc); acc = mfma16(a1, hb[1], acc);
                    H[mt] = acc;
                    if (MODE == 1) { f32x4 am = mfma16(a0, mb[0], (f32x4){0.f, 0.f, 0.f, 0.f}); am = mfma16(a1, mb[1], am); Mg[mt] = am; }
                }
                if (MODE == 1 && j == SPU - 1) {
                    const int pc = 32 * (w >> 1) + 8 * (l15 >> 2) + 4 * (w & 1) + (l15 & 3);
#pragma unroll
                    for (int mt = 0; mt < 4; ++mt) {
                        *(u32x2*)(NG + (size_t)u * 4096 + (16 * w + l15) * 64 + 16 * mt + 4 * g) = pk4(H[mt]);
#pragma unroll
                        for (int r = 0; r < 4; ++r) MG[(size_t)u * 4096 + (16 * mt + 4 * g + r) * 64 + pc] = f2bf(Mg[mt][r]);
                    }
                }
            }
            LDS_BARRIER();
        }
    }
#undef SC_SRC
}

__device__ void rwkv_post(const Params& p, unsigned char* lds) {
    const int tid = threadIdx.x, lane = tid & 63, w = __builtin_amdgcn_readfirstlane(tid >> 6), l15 = lane & 15, g = lane >> 4;
    const bf16_t* P = (const bf16_t*)(p.ws + WS_P);
    bf16_t* Abuf = (bf16_t*)(p.ws + WS_A);
    const bf16_t* Ybuf = (const bf16_t*)(p.ws + WS_Y);
    const float* RK = (const float*)(p.ws + WS_RK);
    const bf16_t* BND = (const bf16_t*)(p.ws + WS_BND);
    float* L = (float*)(lds + w * 8704);
    const int tr = lane >> 3, seg = lane & 7;
    for (int hu = blockIdx.x * 8 + w; hu < 16384; hu += gridDim.x * 8) {
        const int unit = hu >> 1, t0 = (hu & 1) * 32;
        const int bn = unit >> 4, h = unit & 15, n = bn & 255;
        const size_t R0 = (size_t)bn * 64;
        bf16x8 fh[4][2], fr[2][2];
#pragma unroll
        for (int kk = 0; kk < 2; ++kk) {
#pragma unroll
            for (int q = 0; q < 4; ++q) fh[q][kk] = *(const bf16x8*)(P + (R0 + 16 * q + l15) * PP + 2048 + h * 64 + 32 * kk + 8 * g);
#pragma unroll
            for (int q = 0; q < 2; ++q) fr[q][kk] = *(const bf16x8*)(P + (R0 + t0 + 16 * q + l15) * PP + 1024 + h * 64 + 32 * kk + 8 * g);
        }
        u32x4 y0r[4], g1r[4], g0r[4], vpr[4];
        float rkv[4];
#pragma unroll
        for (int i = 0; i < 4; ++i) {
            const int t = t0 + tr + 8 * i;
            y0r[i] = *(const u32x4*)(Abuf + (R0 + t) * DM + h * 64 + 8 * seg);
            const bf16_t* grow = P + (R0 + t) * PP + 3072 + h * 64 + 8 * seg;
            g1r[i] = *(const u32x4*)grow;
            g0r[i] = *(const u32x4*)((t > 0) ? (grow - PP) : (BND + (size_t)(n == 0 ? 0 : bn) * PP + 3072 + h * 64 + 8 * seg));
            vpr[i] = *(const u32x4*)(Ybuf + (R0 + t) * DM + h * 64 + 8 * seg);
            rkv[i] = RK[(R0 + t) * 16 + h];
        }
#pragma unroll
        for (int i = 0; i < 4; ++i) { *(f32x4*)(L + (tr + 8 * i) * 68 + 8 * seg) = lo4(y0r[i]); *(f32x4*)(L + (tr + 8 * i) * 68 + 8 * seg + 4) = hi4(y0r[i]); }
        f32x4 y[4][2];
#pragma unroll
        for (int vt = 0; vt < 4; ++vt)
#pragma unroll
            for (int tt = 0; tt < 2; ++tt) y[vt][tt] = *(const f32x4*)(L + (16 * tt + l15) * 68 + 16 * vt + 4 * g);
#pragma unroll
        for (int vt = 0; vt < 4; ++vt)
#pragma unroll
            for (int tt = 0; tt < 2; ++tt)
#pragma unroll
                for (int kk = 0; kk < 2; ++kk) y[vt][tt] = mfma16(fh[vt][kk], fr[tt][kk], y[vt][tt]);
#pragma unroll
        for (int tt = 0; tt < 2; ++tt) {
            float s1 = 0.f, s2 = 0.f;
#pragma unroll
            for (int vt = 0; vt < 4; ++vt)
#pragma unroll
                for (int r = 0; r < 4; ++r) { s1 += y[vt][tt][r]; s2 += y[vt][tt][r] * y[vt][tt][r]; }
            { const int a16 = (lane ^ 16) * 4, a32 = (lane ^ 32) * 4; s1 += bperm(a16, s1); s2 += bperm(a16, s2); s1 += bperm(a32, s1); s2 += bperm(a32, s2); }
            const float mean = s1 * (1.0f / 64.0f);
            const float rstd = rsqrtf(fmaxf(s2 * (1.0f / 64.0f) - mean * mean, 0.f) + 64e-5f);
#pragma unroll
            for (int vt = 0; vt < 4; ++vt) *(f32x4*)(L + (16 * tt + l15) * 68 + 16 * vt + 4 * g) = (y[vt][tt] - mean) * rstd;
        }
        const int ch = h * 64 + 8 * seg;
        const f32x4 lw0 = *(const f32x4*)(p.in[18] + ch), lw1 = *(const f32x4*)(p.in[18] + ch + 4), lb0 = *(const f32x4*)(p.in[19] + ch), lb1 = *(const f32x4*)(p.in[19] + ch + 4);
        const f32x4 mg0 = *(const f32x4*)(p.in[10] + 3072 + ch), mg1 = *(const f32x4*)(p.in[10] + 3072 + ch + 4);
#pragma unroll
        for (int i = 0; i < 4; ++i) {
            const int t = t0 + tr + 8 * i;
            const f32x4 n0 = *(const f32x4*)(L + (tr + 8 * i) * 68 + 8 * seg), n1 = *(const f32x4*)(L + (tr + 8 * i) * 68 + 8 * seg + 4);
            const f32x4 ga0 = lo4(g1r[i]), ga1 = hi4(g1r[i]);
            const f32x4 gb0 = lo4(g0r[i]), gb1 = hi4(g0r[i]);
            const f32x4 gt0 = ga0 + mg0 * (gb0 - ga0), gt1 = ga1 + mg1 * (gb1 - ga1);
            const f32x4 v0 = lo4(vpr[i]), v1 = hi4(vpr[i]);
            f32x4 o0 = n0 * lw0 + lb0 + rkv[i] * v0, o1 = n1 * lw1 + lb1 + rkv[i] * v1;
#pragma unroll
            for (int j = 0; j < 4; ++j) { o0[j] *= gt0[j] * __builtin_amdgcn_rcpf(1.0f + fexp(-gt0[j])); o1[j] *= gt1[j] * __builtin_amdgcn_rcpf(1.0f + fexp(-gt1[j])); }
            *(u32x4*)(Abuf + (R0 + t) * DM + h * 64 + 8 * seg) = pk8(o0, o1);
        }
    }
}
#define XB_TMO      128
#define XB_XCNT(j)  (256  + 64 * (j))
#define XB_XSUB(j)  (1280 + 64 * (j))
#define XB_XGEN(j)  (2304 + 64 * (j))
#define XB_TOP      3328
#define XB_TOPGEN   3392
#define XCD_BAR_WORDS 3456
#define XB_SPIN_CAP (1u << 18)
#define LAS __attribute__((address_space(3)))

__device__ __forceinline__ unsigned xb_ld(unsigned* p)              { return __hip_atomic_load(p, __ATOMIC_RELAXED, __HIP_MEMORY_SCOPE_AGENT); }
__device__ __forceinline__ unsigned xb_add(unsigned* p, unsigned v) { return __hip_atomic_fetch_add(p, v, __ATOMIC_RELAXED, __HIP_MEMORY_SCOPE_AGENT); }
__device__ __forceinline__ unsigned xb_xcc_id() { return (unsigned)__builtin_amdgcn_s_getreg((3 << 11) | 20) & 0xFu; }
#define XB_SPIN(cond, bar) do { unsigned _sp = 0; while (cond) { __builtin_amdgcn_s_sleep(1); \
    if ((++_sp & 255u) == 0u) { if (xb_ld(&(bar)[XB_TMO])) break; if (_sp > XB_SPIN_CAP) { atomicAdd(&(bar)[XB_TMO], 1u); break; } } } } while (0)

struct XcdBarrier {
    unsigned* bar; unsigned x;
    volatile LAS unsigned* st;
};

__device__ __forceinline__ XcdBarrier xcd_barrier_post(unsigned* bar, volatile LAS unsigned* st) {
    XcdBarrier b; b.bar = bar; b.x = xb_xcc_id(); b.st = st;
    if (threadIdx.x == 0) (void)xb_add(&bar[XB_XCNT(b.x)], 1u);
    return b;
}
__device__ __forceinline__ void xcd_barrier_complete(unsigned* bar, unsigned x, unsigned& nloc, unsigned& nx) {
    const unsigned G = gridDim.x * gridDim.y * gridDim.z;
    unsigned sum, cnt, mine, sp = 0u;
    for (;;) {
        sum = 0u; cnt = 0u; mine = 0u;
#pragma unroll
        for (unsigned j = 0; j < 16; ++j) { const unsigned c = xb_ld(&bar[XB_XCNT(j)]); sum += c; cnt += (c > 0u) ? 1u : 0u; mine = (j == x) ? c : mine; }
        if (sum == G) break;
        __builtin_amdgcn_s_sleep(1);
        if ((++sp & 255u) == 0u) { if (xb_ld(&bar[XB_TMO])) break; if (sp > XB_SPIN_CAP) { atomicAdd(&bar[XB_TMO], 1u); break; } }
    }
    nloc = mine > 0u ? mine : 1u; nx = cnt > 0u ? cnt : 1u;
}

__device__ __forceinline__ void xcd_barrier(const XcdBarrier& b) {
    asm volatile("s_waitcnt vmcnt(0)" ::: "memory");
    __syncthreads();
    if (threadIdx.x == 0) {
        unsigned* bar = b.bar;
        __builtin_amdgcn_s_waitcnt(0);
        unsigned nloc = b.st[0], nx = b.st[1];
        if (nloc == 0u) { xcd_barrier_complete(bar, b.x, nloc, nx); b.st[0] = nloc; b.st[1] = nx; }
        const unsigned old = xb_add(&bar[XB_XSUB(b.x)], 1u);
        const unsigned gen = old / nloc;
        if (old + 1u == (gen + 1u) * nloc) {
            __builtin_amdgcn_fence(__ATOMIC_RELEASE, "agent");
            asm volatile("s_waitcnt vmcnt(0)" ::: "memory");
            const unsigned og = xb_add(&bar[XB_TOP], 1u);
            const unsigned tg = og / nx;
            if (og + 1u == (tg + 1u) * nx) xb_add(&bar[XB_TOPGEN], 1u);
            else XB_SPIN(xb_ld(&bar[XB_TOPGEN]) == tg, bar);
            __builtin_amdgcn_fence(__ATOMIC_ACQUIRE, "agent");
            xb_add(&bar[XB_XGEN(b.x)], 1u);
            asm volatile("s_waitcnt vmcnt(0)" ::: "memory");
        } else {
            XB_SPIN(xb_ld(&bar[XB_XGEN(b.x)]) == gen, bar);
            __builtin_amdgcn_fence(__ATOMIC_ACQUIRE, "agent");
            asm volatile("s_waitcnt vmcnt(0)" ::: "memory");
        }
    }
    __syncthreads();
}


#ifndef PROBE_ID
#define PROBE_ID 0
#endif
#ifndef N_LAUNCH_MODE
#define N_LAUNCH_MODE 1
#endif
constexpr int N_PHASES = 15;

__global__ void __launch_bounds__(NTH, 2) fwd_kernel(Params p) {
    extern __shared__ __attribute__((aligned(16))) unsigned char lds[];
    const int lo = p.ph_lo, hi = p.ph_hi;
    volatile LAS unsigned* xst = (volatile LAS unsigned*)(lds + LDS_BYTES);
    if (threadIdx.x < 4) xst[threadIdx.x] = 0u;
    __syncthreads();
    const XcdBarrier xbar = xcd_barrier_post((unsigned*)(p.ws + WS_BAR), xst);
    unsigned char* ws = p.ws;
#define IN(k) (lo <= (k) && (k) < hi)
#define SEAM(k) do { if ((k) + 1 < hi) xcd_barrier(xbar); } while (0)
    if (IN(0)) {
        prep_weight(p.in[2], GIN, p.in[1], (bf16_t*)(ws + WS_WGIN), GIN_P, (float*)lds);
        prep_weight(p.in[6], DM, nullptr, (bf16_t*)(ws + WS_WGOUT), DM, (float*)lds);
        prep_wup(p.in[3], (bf16_t*)(ws + WS_WUPT));
        __syncthreads();
        phase_norm0(p, lds);
        SEAM(0);
    }
    if (IN(1)) {
        pg8::Gemm g{(const bf16_t*)(ws + WS_A), (const bf16_t*)(ws + WS_WGIN), MTOK, GIN_P, DM}; pg8::StaticOrder S; S.init(MTOK, GIN_P, gridDim.x, blockIdx.x);
        EpiBf16GateSilu E{(bf16_t*)(ws + WS_P), GIN_P};
        pg8::gemm_phase<EpiBf16GateSilu, pg8::StaticOrder>((PG8_LAS unsigned char*)lds, g, S, E);
        SEAM(1);
    }
    if (IN(2)) { gla_pass<false>(p, lds); SEAM(2); }
    if (IN(3)) {
        gla_scan(p);
        prep_weight(p.in[9], RIN, p.in[8], (bf16_t*)(ws + WS_WRIN), RIN_P, (float*)lds);
        prep_weight(p.in[20], DM, nullptr, (bf16_t*)(ws + WS_WROUT), DM, (float*)lds);
        prep_lowrank(p.in[12], (bf16_t*)(ws + WS_WDUT));
        prep_lowrank(p.in[14], (bf16_t*)(ws + WS_WIUT));
        SEAM(3);
    }
    if (IN(4)) { gla_pass<true>(p, lds); SEAM(4); }
    if (IN(5)) {
        pg8::Gemm g{(const bf16_t*)(ws + WS_A), (const bf16_t*)(ws + WS_WGOUT), MTOK, DM, DM}; pg8::StaticOrder S; S.init(MTOK, DM, gridDim.x, blockIdx.x);
        pg8::EpiBf16<0> E{(bf16_t*)(ws + WS_Y), DM, nullptr, 0, 0};
        pg8::gemm_phase<pg8::EpiBf16<0>, pg8::StaticOrder>((PG8_LAS unsigned char*)lds, g, S, E);
        SEAM(5);
    }
    if (IN(6)) { phase_norm1(p); zero_bnd_row((bf16_t*)(ws + WS_BND)); SEAM(6); }
    if (IN(7)) {
        pg8::Gemm g{(const bf16_t*)(ws + WS_A), (const bf16_t*)(ws + WS_WRIN), MTOK, RIN_P, DM}; pg8::StaticOrder S; S.init(MTOK, RIN_P, gridDim.x, blockIdx.x);
        EpiBf16Bnd E{(bf16_t*)(ws + WS_P), RIN_P, (bf16_t*)(ws + WS_BND)};
        pg8::gemm_phase<EpiBf16Bnd, pg8::StaticOrder>((PG8_LAS unsigned char*)lds, g, S, E);
        SEAM(7);
    }
    if (IN(8)) { rwkv_r1(p, lds); SEAM(8); }
    if (IN(9)) { rwkv_scan2<1>(p, lds); SEAM(9); }
    if (IN(10)) { rwkv_scan2<2>(p, lds); SEAM(10); }
    if (IN(11)) { rwkv_scan2<3>(p, lds); SEAM(11); }
    if (IN(12)) { rwkv_post(p, lds); SEAM(12); }
    if (IN(13)) {
        pg8::Gemm g{(const bf16_t*)(ws + WS_A), (const bf16_t*)(ws + WS_WROUT), MTOK, DM, DM}; pg8::StaticOrder S; S.init(MTOK, DM, gridDim.x, blockIdx.x);
        pg8::EpiBf16<0> E{(bf16_t*)(ws + WS_Y), DM, nullptr, 0, 0};
        pg8::gemm_phase<pg8::EpiBf16<0>, pg8::StaticOrder>((PG8_LAS unsigned char*)lds, g, S, E);
        SEAM(13);
    }
    if (IN(14)) { phase_final(p); }
#undef IN
#undef SEAM
}

extern "C" void kernel_launch(void* const* d_in, const int* in_sizes, int n_in, void* d_out, int out_size, void* d_ws, size_t ws_size, hipStream_t stream) {
    static int grid = 0;
    if (grid == 0) {
        int dev = 0, cus = 0, per_cu = 0;
        hipGetDevice(&dev);
        hipDeviceGetAttribute(&cus, hipDeviceAttributeMultiprocessorCount, dev);
        hipFuncSetAttribute((const void*)fwd_kernel, hipFuncAttributeMaxDynamicSharedMemorySize, LDS_BYTES + 16);
        hipOccupancyMaxActiveBlocksPerMultiprocessor(&per_cu, (const void*)fwd_kernel, NTH, LDS_BYTES + 16);
        if (per_cu < 1) { fprintf(stderr, "kernel_launch: occupancy query says %d blocks per CU\n", per_cu); per_cu = 1; }
        grid = cus;
        if (n_in != 22 || ws_size < WS_END) fprintf(stderr, "kernel_launch: unexpected n_in %d or workspace %zu < %zu\n", n_in, ws_size, (size_t)WS_END);
        (void)hipGetLastError();
    }
    if (hipMemsetAsync((char*)d_ws + WS_BAR, 0, XCD_BAR_WORDS * 4, stream) != hipSuccess) fprintf(stderr, "kernel_launch: memset of the barrier words failed\n");
    Params p{};
    for (int i = 0; i < 22; ++i) p.in[i] = (const float*)d_in[i];
    p.out = (float*)d_out; p.ws = (unsigned char*)d_ws;
#if N_LAUNCH_MODE == 1
    void* args[] = {&p};
#if PROBE_ID > 0
    p.ph_lo = 0; p.ph_hi = PROBE_ID;
    (void)hipLaunchCooperativeKernel((const void*)fwd_kernel, dim3(grid), dim3(NTH), args, LDS_BYTES + 16, stream);
    (void)hipMemsetAsync((char*)d_ws + WS_BAR, 0, XCD_BAR_WORDS * 4, stream);
#endif
    p.ph_lo = 0; p.ph_hi = N_PHASES;
    hipError_t e = hipLaunchCooperativeKernel((const void*)fwd_kernel, dim3(grid), dim3(NTH), args, LDS_BYTES + 16, stream);
    if (e != hipSuccess) fprintf(stderr, "cooperative launch failed: %s (grid %d)\n", hipGetErrorString(e), grid);
#else
    for (int k = 0; k < N_PHASES; ++k) {
        p.ph_lo = k; p.ph_hi = k + 1;
        hipLaunchKernelGGL(fwd_kernel, dim3(grid), dim3(NTH), LDS_BYTES + 16, stream, p);
    }
#endif
}
```

```cpp
#include <hip/hip_runtime.h>
#include <hip/hip_cooperative_groups.h>
#include <cstdio>
namespace cg = cooperative_groups;
#define PROBE_ID 0
#define N_LAUNCH_MODE 1
namespace pg8 {
#define PG8_LAS __attribute__((address_space(3)))
typedef unsigned short bf16_t;
typedef short bf16x8 __attribute__((ext_vector_type(8)));
typedef float f32x4 __attribute__((ext_vector_type(4)));
typedef unsigned u32x4 __attribute__((ext_vector_type(4)));
constexpr int BM = 256, BK = 64, HALF = 128, HTB = HALF * BK * 2  , STAGE_BYTES = 8 * HTB, NXCD = 8, WGM = 8;

__host__ __device__ __forceinline__ int lds_byte(int r, int c) { const int st = (r >> 4) * 2 + (c >> 5), rr = r & 15, cc = c & 31, ob = rr * 64 + cc * 2; return st * 1024 + (ob ^ (((ob >> 9) & 1) << 5)); }
__host__ __device__ __forceinline__ void stage_rc(int b, int& R, int& C) { const int st = b / 1024, sb = b % 1024, swz = sb ^ (((sb >> 9) & 1) << 5); R = (st >> 1) * 16 + swz / 64; C = (st & 1) * 32 + (swz % 64) / 2; }
__host__ __device__ __forceinline__ int perm32(int rho) { const int n = rho >> 4, i = rho & 15; return 8 * (i >> 2) + 4 * n + (i & 3); }

struct Unit { int pm, pn; };
struct Gemm { const bf16_t* A; const bf16_t* Bt; int M, N, K; };

struct StaticOrder {
    int nM, nN, nwg, G, c;
    __host__ __device__ void init(int M, int N, int G_, int c_) { nM = M / BM; nN = N / BM; nwg = nM * nN; G = G_; c = c_; }
    __host__ __device__ bool next(int i, Unit& u) const {
        const long L = (long)i * G + c; if (L >= nwg) return false;
        int wgid = (int)L; { const int q = nwg / NXCD, r = nwg % NXCD, xcd = wgid % NXCD, off = wgid / NXCD; wgid = (xcd < r ? xcd * (q + 1) : r * (q + 1) + (xcd - r) * q) + off; }
        const int nig = WGM * nN, gid = wgid / nig, fm = gid * WGM, gsz = (nM - fm) < WGM ? (nM - fm) : WGM;
        u.pm = fm + ((wgid % nig) % gsz); u.pn = (wgid % nig) / gsz; return true;
    }
    __device__ __forceinline__ void a_ready(const Unit&) const {}
    __device__ __forceinline__ void done(const Unit&) const {}
};

typedef float cvt_f32x2 __attribute__((ext_vector_type(2)));
typedef __bf16 cvt_bf16x2 __attribute__((ext_vector_type(2)));
__device__ __forceinline__ unsigned cvt_pk_bf16(float lo, float hi) { const cvt_f32x2 v = {lo, hi}; union { cvt_bf16x2 b; unsigned u; } x; x.b = __builtin_convertvector(v, cvt_bf16x2); return x.u; }
typedef float f32x2 __attribute__((ext_vector_type(2)));
struct EpiF32 {
    static constexpr bool PERM = false, AFTER_DRAIN = false;
    float* C; int ldc; const float* bias;
    __device__ __forceinline__ void operator()(const f32x4 (&acc)[2][2][4][2], const Unit& u, int wr, int wc, int fr, int fq) const {
        const int row0 = u.pm * BM + wr * 64 + fr, col0 = u.pn * BM + wc * 32 + 4 * fq;
        f32x4 bv[2][2];
#pragma unroll
        for (int bj = 0; bj < 2; ++bj)
#pragma unroll
            for (int n = 0; n < 2; ++n) bv[bj][n] = bias ? *(const f32x4*)(bias + col0 + bj * HALF + n * 16) : (f32x4){0.f, 0.f, 0.f, 0.f};
#pragma unroll
        for (int ai = 0; ai < 2; ++ai)
#pragma unroll
            for (int m = 0; m < 4; ++m) { float* rowp = C + (size_t)(row0 + ai * HALF + m * 16) * ldc + col0;
#pragma unroll
                for (int bj = 0; bj < 2; ++bj)
#pragma unroll
                    for (int n = 0; n < 2; ++n) *(f32x4*)(rowp + bj * HALF + n * 16) = acc[ai][bj][m][n] + bv[bj][n]; }
    }
};
template <int ACT  > struct EpiBf16 {
    static constexpr bool PERM = true, AFTER_DRAIN = false;
    bf16_t* O; int ldc; const float* bias; int split_cols; size_t split_stride;
    __device__ __forceinline__ void operator()(const f32x4 (&acc)[2][2][4][2], const Unit& u, int wr, int wc, int fr, int fq) const {
        const int row0 = u.pm * BM + wr * 64 + fr; int colt = u.pn * BM; bf16_t* base = O;
        if (split_cols) { const int t = colt / split_cols; base += (size_t)t * split_stride; colt -= t * split_cols; }
        const int col0 = colt + wc * 32 + 8 * fq, bcol0 = u.pn * BM + wc * 32 + 8 * fq;
        f32x4 bv[2][2];
#pragma unroll
        for (int bj = 0; bj < 2; ++bj)
#pragma unroll
            for (int n = 0; n < 2; ++n) bv[bj][n] = bias ? *(const f32x4*)(bias + bcol0 + bj * HALF + 4 * n) : (f32x4){0.f, 0.f, 0.f, 0.f};
#pragma unroll
        for (int ai = 0; ai < 2; ++ai)
#pragma unroll
            for (int m = 0; m < 4; ++m) { bf16_t* rowp = base + (size_t)(row0 + ai * HALF + m * 16) * ldc + col0;
#pragma unroll
                for (int bj = 0; bj < 2; ++bj) { f32x4 v0 = acc[ai][bj][m][0] + bv[bj][0], v1 = acc[ai][bj][m][1] + bv[bj][1];
                    u32x4 w; w.x = cvt_pk_bf16(v0[0], v0[1]); w.y = cvt_pk_bf16(v0[2], v0[3]); w.z = cvt_pk_bf16(v1[0], v1[1]); w.w = cvt_pk_bf16(v1[2], v1[3]);
                    *(u32x4*)(rowp + bj * HALF) = w; } }
    }
};

template <class Epi, class Sched>
__device__ __forceinline__ void gemm_phase(PG8_LAS unsigned char* lds, const Gemm g, const Sched& S, const Epi& E) {
    const int tid = threadIdx.x, wid = __builtin_amdgcn_readfirstlane(tid >> 6), lane = tid & 63, wr = wid >> 2, wc = wid & 3, fr = lane & 15, fq = lane >> 4;
    const int K = g.K, nt = K / BK;
    unsigned voffA[2], voffB[2];
#pragma unroll
    for (int i = 0; i < 2; ++i) { int R, C; stage_rc(tid * 16 + i * 8192, R, C); const int Rb = Epi::PERM ? ((R & ~31) + perm32(R & 31)) : R;
        voffA[i] = (unsigned)(R * K + C) * 2u; voffB[i] = (unsigned)(Rb * K + C) * 2u; }
    const size_t kstep = (size_t)(BK * 2);
    const size_t hstep = (size_t)HALF * K * 2;
    const size_t tstep = 2 * hstep;
    const unsigned ldsw = (unsigned)wid * 1024u;
    const int aoff = lds_byte(wr * 64 + fr, fq * 8), boff = lds_byte(wc * 32 + fr, fq * 8);
#define PG8_SA(b, h) (((b) * 2 + (h)) * HTB)
#define PG8_SB(b, h) ((4 + (b) * 2 + (h)) * HTB)
#define PG8_STAGE(bufoff, gbase, voff) do { _Pragma("unroll") for (int _i = 0; _i < 2; ++_i) \
        __builtin_amdgcn_global_load_lds((const unsigned*)((const char*)(gbase) + (voff)[_i]), (PG8_LAS unsigned*)(lds + (bufoff) + ldsw + _i * 8192), 16, 0, 0); } while (0)
#define PG8_LDA(dst, b, h) do { _Pragma("unroll") for (int m = 0; m < 4; ++m) _Pragma("unroll") for (int k = 0; k < 2; ++k) dst[m][k] = *(const PG8_LAS bf16x8*)(lds + PG8_SA(b, h) + aoff + m * 2048 + k * 1024); } while (0)
#define PG8_LDB(dst, b, h) do { _Pragma("unroll") for (int n = 0; n < 2; ++n) _Pragma("unroll") for (int k = 0; k < 2; ++k) dst[n][k] = *(const PG8_LAS bf16x8*)(lds + PG8_SB(b, h) + boff + n * 2048 + k * 1024); } while (0)
#define PG8_MMA(ai, bj, At, Bt) do { __builtin_amdgcn_s_setprio(1); _Pragma("unroll") for (int m = 0; m < 4; ++m) _Pragma("unroll") for (int n = 0; n < 2; ++n) _Pragma("unroll") for (int k = 0; k < 2; ++k) \
        acc[ai][bj][m][n] = __builtin_amdgcn_mfma_f32_16x16x32_bf16(Bt[n][k], At[m][k], acc[ai][bj][m][n], 0, 0, 0); __builtin_amdgcn_s_setprio(0); } while (0)
#define PG8_WAIT_V(n) asm volatile("s_waitcnt vmcnt(" #n ")" ::: "memory")
#define PG8_WAIT_L(n) asm volatile("s_waitcnt lgkmcnt(" #n ")" ::: "memory")
#define PG8_BAR __builtin_amdgcn_s_barrier()
#define PG8_SCHED __builtin_amdgcn_sched_barrier(0)
    Unit cur, nxt; int ui = 0;
    if (!S.next(0, cur)) return;
    f32x4 acc[2][2][4][2];
#pragma unroll
    for (int a = 0; a < 2; ++a)
#pragma unroll
        for (int b = 0; b < 2; ++b)
#pragma unroll
            for (int m = 0; m < 4; ++m)
#pragma unroll
                for (int n = 0; n < 2; ++n) acc[a][b][m][n] = (f32x4){0.f, 0.f, 0.f, 0.f};
    bf16x8 At[4][2], B0[2][2], B1[2][2];
    const char* cA = (const char*)g.A + (size_t)cur.pm * tstep; const char* cB = (const char*)g.Bt + (size_t)cur.pn * tstep;
    S.a_ready(cur);
    PG8_STAGE(PG8_SB(0, 0), cB, voffB); PG8_STAGE(PG8_SA(0, 0), cA, voffA); PG8_STAGE(PG8_SB(0, 1), cB + hstep, voffB); PG8_STAGE(PG8_SA(0, 1), cA + hstep, voffA);
    if (wr == 1) PG8_BAR;
    PG8_WAIT_V(4); PG8_BAR;
    PG8_STAGE(PG8_SB(1, 0), cB + kstep, voffB); PG8_STAGE(PG8_SA(1, 0), cA + kstep, voffA); PG8_STAGE(PG8_SB(1, 1), cB + hstep + kstep, voffB);
    PG8_WAIT_V(6); PG8_BAR;
    for (;;) {
        const bool has_next = S.next(ui + 1, nxt);
        const char* nA = has_next ? (const char*)g.A + (size_t)nxt.pm * tstep : cA; const char* nB = has_next ? (const char*)g.Bt + (size_t)nxt.pn * tstep : cB;
        for (int t = 0; t < nt; t += 2) {
            const bool last = (t == nt - 2);
            const char* a1 = cA + (size_t)(t + 1) * kstep;
            const char* a2 = last ? nA : cA + (size_t)(t + 2) * kstep; const char* b2 = last ? nB : cB + (size_t)(t + 2) * kstep;
            const char* a3 = a2 + kstep; const char* b3 = b2 + kstep;
            if (last && has_next) S.a_ready(nxt);
            PG8_LDB(B0, 0, 0); PG8_SCHED; PG8_LDA(At, 0, 0); PG8_STAGE(PG8_SA(1, 1), a1 + hstep, voffA);
            PG8_WAIT_L(8); PG8_BAR; PG8_WAIT_L(0); PG8_MMA(0, 0, At, B0); PG8_BAR; PG8_SCHED;
            PG8_LDB(B1, 0, 1); PG8_STAGE(PG8_SB(0, 0), b2, voffB);
            PG8_BAR; PG8_WAIT_L(0); PG8_MMA(0, 1, At, B1); PG8_BAR;
            PG8_LDA(At, 0, 1); PG8_STAGE(PG8_SA(0, 0), a2, voffA);
            PG8_BAR; PG8_WAIT_L(0); PG8_MMA(1, 0, At, B0); PG8_BAR; PG8_SCHED;
            PG8_STAGE(PG8_SB(0, 1), b2 + hstep, voffB);
            PG8_WAIT_V(6); PG8_BAR; PG8_MMA(1, 1, At, B1); PG8_BAR;
            PG8_LDB(B0, 1, 0); PG8_SCHED; PG8_LDA(At, 1, 0); PG8_STAGE(PG8_SA(0, 1), a2 + hstep, voffA);
            PG8_WAIT_L(8); PG8_BAR; PG8_WAIT_L(0); PG8_MMA(0, 0, At, B0); PG8_BAR; PG8_SCHED;
            PG8_LDB(B1, 1, 1); PG8_STAGE(PG8_SB(1, 0), b3, voffB);
            PG8_BAR; PG8_WAIT_L(0); PG8_MMA(0, 1, At, B1); PG8_BAR;
            PG8_LDA(At, 1, 1); PG8_STAGE(PG8_SA(1, 0), a3, voffA);
            PG8_BAR; PG8_WAIT_L(0); PG8_MMA(1, 0, At, B0); PG8_BAR; PG8_SCHED;
            PG8_STAGE(PG8_SB(1, 1), b3 + hstep, voffB);
            PG8_WAIT_V(6); PG8_BAR; PG8_MMA(1, 1, At, B1); PG8_BAR;
        }
        if constexpr (!Epi::AFTER_DRAIN) { E(acc, cur, wr, wc, fr, fq); S.done(cur); }
        if (!has_next) break;
#pragma unroll
        for (int a = 0; a < 2; ++a)
#pragma unroll
            for (int b = 0; b < 2; ++b)
#pragma unroll
                for (int m = 0; m < 4; ++m)
#pragma unroll
                    for (int n = 0; n < 2; ++n) acc[a][b][m][n] = (f32x4){0.f, 0.f, 0.f, 0.f};
        cur = nxt; cA = nA; cB = nB; ++ui;
    }
    PG8_WAIT_V(0);
    if (wr == 0) PG8_BAR;
    PG8_BAR;
    if constexpr (Epi::AFTER_DRAIN) { E.fused(acc, cur, wr, wc, fr, fq, lds, wid, lane); S.done(cur); }
#undef PG8_SA
#undef PG8_SB
#undef PG8_STAGE
#undef PG8_LDA
#undef PG8_LDB
#undef PG8_MMA
#undef PG8_WAIT_V
#undef PG8_WAIT_L
#undef PG8_BAR
#undef PG8_SCHED
}
}


typedef unsigned short bf16_t;
typedef short bf16x8 __attribute__((ext_vector_type(8)));
typedef float f32x4 __attribute__((ext_vector_type(4)));
typedef unsigned u32x4 __attribute__((ext_vector_type(4)));
typedef unsigned u32x2 __attribute__((ext_vector_type(2)));

constexpr int MTOK = 32768, DM = 1024, SEQ = 16384, NTH = 512;
constexpr int GIN = 3088, GIN_P = 3072, RIN = 4224, RIN_P = 4352;
constexpr int LDS_BYTES = 147456;

constexpr size_t WS_WGIN  = 0;
constexpr size_t WS_WGOUT = WS_WGIN  + (size_t)GIN_P * DM * 2;
constexpr size_t WS_WRIN  = WS_WGOUT + (size_t)DM * DM * 2;
constexpr size_t WS_WROUT = WS_WRIN  + (size_t)RIN_P * DM * 2;
constexpr size_t WS_WDUT  = WS_WROUT + (size_t)DM * DM * 2;
constexpr size_t WS_WIUT  = WS_WDUT  + (size_t)DM * 64 * 2;
constexpr size_t WS_WUPT  = WS_WIUT  + (size_t)DM * 64 * 2;
constexpr size_t WS_A     = WS_WUPT  + (size_t)512 * 16 * 2;
constexpr size_t WS_Y     = WS_A     + (size_t)MTOK * DM * 2;
constexpr size_t WS_GS    = WS_Y     + (size_t)MTOK * DM * 2;
constexpr size_t WS_GD    = WS_GS    + (size_t)24 * 1024 * 1024;
constexpr size_t WS_P     = WS_GD    + (size_t)8 * 32 * 128 * 4;
constexpr size_t WS_BAR   = WS_P     + (size_t)MTOK * RIN_P * 2;
constexpr size_t WS_AD    = WS_BAR   + 16384;
constexpr size_t WS_X1    = WS_AD    + (size_t)MTOK * 16 * 2;
constexpr size_t WS_DUMMY = WS_X1    + (size_t)MTOK * DM * 2;
constexpr size_t WS_END   = WS_DUMMY + 65536;
static_assert(WS_END <= (size_t)512 * 1024 * 1024, "workspace budget (4 x the largest tensor)");

struct Params { const float* in[22]; float* out; unsigned char* ws; int ph_lo, ph_hi; };

__device__ __forceinline__ float bf2f(unsigned b) { return __uint_as_float(b << 16); }
__device__ __forceinline__ bf16_t f2bf(float f) { unsigned u = __float_as_uint(f); u += 0x7FFFu + ((u >> 16) & 1u); return (bf16_t)(u >> 16); }
__device__ __forceinline__ unsigned pk2(float lo, float hi) { return pg8::cvt_pk_bf16(lo, hi); }
__device__ __forceinline__ float wave_sum(float x) {
#pragma unroll
    for (int off = 32; off >= 1; off >>= 1) x += __shfl_xor(x, off);
    return x;
}
__device__ __forceinline__ float bperm(int byte_addr, float x) { return __int_as_float(__builtin_amdgcn_ds_bpermute(byte_addr, __float_as_int(x))); }
template <int CTRL> __device__ __forceinline__ float dpp_mov(float x) { return __int_as_float(__builtin_amdgcn_update_dpp(0, __float_as_int(x), CTRL, 0xF, 0xF, true)); }
__device__ __forceinline__ float sum8(float x) { x += dpp_mov<0xB1>(x); x += dpp_mov<0x4E>(x); x += dpp_mov<0x141>(x); return x; }
__device__ __forceinline__ f32x4 mfma16(bf16x8 a, bf16x8 b, f32x4 c) { return __builtin_amdgcn_mfma_f32_16x16x32_bf16(a, b, c, 0, 0, 0); }
__device__ __forceinline__ bf16x8 as_bf16x8(u32x4 v) { union { u32x4 u; bf16x8 b; } x; x.u = v; return x.b; }
__device__ __forceinline__ float fexp(float x) { return __builtin_amdgcn_exp2f(x * 1.4426950408889634f); }
__device__ __forceinline__ float flog(float x) { return __builtin_amdgcn_logf(x) * 0.6931471805599453f; }
__device__ __forceinline__ float log_sigmoid(float z) { return fminf(z, 0.f) - log1pf(fexp(-fabsf(z))); }
__device__ __forceinline__ float softplus(float z) { return fmaxf(z, 0.f) + log1pf(fexp(-fabsf(z))); }

__device__ void prep_weight(const float* __restrict__ W, int N, const float* __restrict__ gain, bf16_t* __restrict__ Wt, int NP, float* tile) {
    const int tid = threadIdx.x;
    const int nu = (NP / 64) * 16;
    const int lk = tid >> 4, lq = tid & 15;
    const int sn = tid >> 3, ss = tid & 7;
    float4 v[2];
#define PW_LOAD(u_) do { const int n0_ = ((u_) >> 4) * 64, k0_ = ((u_) & 15) * 64; _Pragma("unroll") for (int r = 0; r < 2; ++r) { const int k = k0_ + lk + 32 * r, n = n0_ + 4 * lq; \
        float4 x_ = make_float4(0.f, 0.f, 0.f, 0.f); if (n < N) { x_ = *(const float4*)(W + (size_t)k * N + n); if (gain) { const float g_ = gain[k]; x_.x *= g_; x_.y *= g_; x_.z *= g_; x_.w *= g_; } } v[r] = x_; } } while (0)
    int u = blockIdx.x;
    if (u < nu) PW_LOAD(u);
    for (; u < nu; u += gridDim.x) {
        const int n0 = (u >> 4) * 64, k0 = (u & 15) * 64;
#pragma unroll
        for (int r = 0; r < 2; ++r) *(float4*)(tile + (lk + 32 * r) * 68 + 4 * lq) = v[r];
        if (u + (int)gridDim.x < nu) PW_LOAD(u + gridDim.x);
        __syncthreads();
        {
            float e[8];
#pragma unroll
            for (int q = 0; q < 8; ++q) e[q] = tile[(8 * ss + q) * 68 + sn];
            *(u32x4*)(Wt + (size_t)(n0 + sn) * DM + k0 + 8 * ss) = (u32x4){pk2(e[0], e[1]), pk2(e[2], e[3]), pk2(e[4], e[5]), pk2(e[6], e[7])};
        }
        __syncthreads();
    }
#undef PW_LOAD
}

__device__ void prep_lowrank(const float* __restrict__ src, bf16_t* __restrict__ dst) {
    for (int idx = blockIdx.x * NTH + threadIdx.x; idx < 65536; idx += gridDim.x * NTH) dst[idx] = f2bf(src[(idx & 63) * 1024 + (idx >> 6)]);
}

__device__ void zero_bnd_row(bf16_t* bnd) {
    if (blockIdx.x == 0) for (int i = threadIdx.x; i < RIN_P / 2; i += NTH) ((unsigned*)bnd)[i] = 0u;
}

__device__ void prep_wup(const float* __restrict__ src, bf16_t* __restrict__ dst) {
    for (int idx = blockIdx.x * NTH + threadIdx.x; idx < 8192; idx += gridDim.x * NTH) dst[idx] = f2bf(src[(idx & 15) * 512 + (idx >> 4)]);
}

struct EpiBf16GateSilu {
    static constexpr bool PERM = true, AFTER_DRAIN = false;
    bf16_t* O; int ldc;
    __device__ __forceinline__ void operator()(const f32x4 (&acc)[2][2][4][2], const pg8::Unit& u, int wr, int wc, int fr, int fq) const {
        const int row0 = u.pm * pg8::BM + wr * 64 + fr, col0 = u.pn * pg8::BM + wc * 32 + 8 * fq;
        const bool act = u.pn >= 8;
#pragma unroll
        for (int ai = 0; ai < 2; ++ai)
#pragma unroll
            for (int m = 0; m < 4; ++m) {
                bf16_t* rowp = O + (size_t)(row0 + ai * pg8::HALF + m * 16) * ldc + col0;
#pragma unroll
                for (int bj = 0; bj < 2; ++bj) {
                    f32x4 v0 = acc[ai][bj][m][0], v1 = acc[ai][bj][m][1];
                    if (act) {
#pragma unroll
                        for (int j = 0; j < 4; ++j) { v0[j] *= __builtin_amdgcn_rcpf(1.0f + fexp(-v0[j])); v1[j] *= __builtin_amdgcn_rcpf(1.0f + fexp(-v1[j])); }
                    }
                    u32x4 wv; wv.x = pk2(v0[0], v0[1]); wv.y = pk2(v0[2], v0[3]); wv.z = pk2(v1[0], v1[1]); wv.w = pk2(v1[2], v1[3]);
                    *(u32x4*)(rowp + bj * pg8::HALF) = wv;
                }
            }
    }
};

struct EpiBf16Bnd {
    static constexpr bool PERM = true, AFTER_DRAIN = false;
    bf16_t* O; int ldc; bf16_t* bnd;
    __device__ __forceinline__ void operator()(const f32x4 (&acc)[2][2][4][2], const pg8::Unit& u, int wr, int wc, int fr, int fq) const {
        const int row0 = u.pm * pg8::BM + wr * 64 + fr, col0 = u.pn * pg8::BM + wc * 32 + 8 * fq;
#pragma unroll
        for (int ai = 0; ai < 2; ++ai)
#pragma unroll
            for (int m = 0; m < 4; ++m) {
                const int row = row0 + ai * pg8::HALF + m * 16;
                bf16_t* rowp = O + (size_t)row * ldc + col0;
#pragma unroll
                for (int bj = 0; bj < 2; ++bj) {
                    const f32x4 v0 = acc[ai][bj][m][0], v1 = acc[ai][bj][m][1];
                    u32x4 wv; wv.x = pk2(v0[0], v0[1]); wv.y = pk2(v0[2], v0[3]); wv.z = pk2(v1[0], v1[1]); wv.w = pk2(v1[2], v1[3]);
                    *(u32x4*)(rowp + bj * pg8::HALF) = wv;
                    if (m == 3 && fr == 15) *(u32x4*)(bnd + (size_t)((row >> 6) + 1) * ldc + col0 + bj * pg8::HALF) = wv;
                }
            }
    }
};

__device__ void phase_norm0(const Params& p, unsigned char* lds) {
    const int tid = threadIdx.x, lane = tid & 63, w = tid >> 6, l15 = lane & 15, g = lane >> 4;
    const float* x = p.in[0];
    bf16_t* A = (bf16_t*)(p.ws + WS_A);
    bf16_t* AD = (bf16_t*)(p.ws + WS_AD);
    bf16_t* WAD = (bf16_t*)lds;
    float* PSS = (float*)(lds + 33024);
    float* PAD = (float*)(lds + 33024 + 512);
    for (int e = tid; e < 16384; e += NTH) { const int k = e >> 4, j = e & 15; WAD[j * 1032 + k] = f2bf(p.in[2][(size_t)k * GIN + 3072 + j] * p.in[1][k]); }
    __syncthreads();
    bf16x8 wf[4];
#pragma unroll
    for (int kk = 0; kk < 4; ++kk) wf[kk] = *(const bf16x8*)(WAD + l15 * 1032 + 128 * w + 32 * kk + 8 * g);
    float4 xa[4][2];
    int tile = blockIdx.x;
    if (tile < MTOK / 16) {
#pragma unroll
        for (int kk = 0; kk < 4; ++kk) { const float4* s = (const float4*)(x + (size_t)(16 * tile + l15) * DM + 128 * w + 32 * kk + 8 * g); xa[kk][0] = s[0]; xa[kk][1] = s[1]; }
    }
    for (; tile < MTOK / 16; tile += gridDim.x) {
        float4 xv[4][2];
#pragma unroll
        for (int kk = 0; kk < 4; ++kk) { xv[kk][0] = xa[kk][0]; xv[kk][1] = xa[kk][1]; }
        if (tile + (int)gridDim.x < MTOK / 16) {
#pragma unroll
            for (int kk = 0; kk < 4; ++kk) { const float4* s = (const float4*)(x + (size_t)(16 * (tile + gridDim.x) + l15) * DM + 128 * w + 32 * kk + 8 * g); xa[kk][0] = s[0]; xa[kk][1] = s[1]; }
        }
        float ss = 0.f;
        f32x4 acc = (f32x4){0.f, 0.f, 0.f, 0.f};
#pragma unroll
        for (int kk = 0; kk < 4; ++kk) {
            const float4 a = xv[kk][0], b = xv[kk][1];
            ss += a.x * a.x + a.y * a.y + a.z * a.z + a.w * a.w + b.x * b.x + b.y * b.y + b.z * b.z + b.w * b.w;
            acc = mfma16(as_bf16x8((u32x4){pk2(a.x, a.y), pk2(a.z, a.w), pk2(b.x, b.y), pk2(b.z, b.w)}), wf[kk], acc);
        }
        ss += __shfl_xor(ss, 16); ss += __shfl_xor(ss, 32);
        if (g == 0) PSS[w * 16 + l15] = ss;
        *(f32x4*)(PAD + (w * 64 + lane) * 4) = acc;
        __syncthreads();
        float tot = 0.f;
#pragma unroll
        for (int q = 0; q < 8; ++q) tot += PSS[q * 16 + l15];
        const float rstd = rsqrtf(tot * (1.0f / DM) + 1e-6f);
#pragma unroll
        for (int kk = 0; kk < 4; ++kk) {
            const float4 a = xv[kk][0], b = xv[kk][1];
            *(u32x4*)(A + (size_t)(16 * tile + l15) * DM + 128 * w + 32 * kk + 8 * g) = (u32x4){pk2(a.x * rstd, a.y * rstd), pk2(a.z * rstd, a.w * rstd), pk2(b.x * rstd, b.y * rstd), pk2(b.z * rstd, b.w * rstd)};
        }
        if (w == 0) {
            f32x4 s = (f32x4){0.f, 0.f, 0.f, 0.f};
#pragma unroll
            for (int q = 0; q < 8; ++q) s += *(const f32x4*)(PAD + (q * 64 + lane) * 4);
#pragma unroll
            for (int r = 0; r < 4; ++r) AD[(size_t)(16 * tile + 4 * g + r) * 16 + l15] = f2bf(s[r] * __shfl(rstd, 4 * g + r));
        }
        __syncthreads();
    }
}

__device__ void phase_norm1(const Params& p) {
    const int tid = threadIdx.x, lane = tid & 63, w = tid >> 6;
    const float* x = p.in[0];
    const float* gpost = p.in[7];
    const bf16_t* Y = (const bf16_t*)(p.ws + WS_Y);
    bf16_t* A = (bf16_t*)(p.ws + WS_A);
    bf16_t* X1 = (bf16_t*)(p.ws + WS_X1);
    float4 gp[4];
#pragma unroll
    for (int i = 0; i < 4; ++i) gp[i] = ((const float4*)gpost)[lane + 64 * i];
    const int stride = gridDim.x * 8;
    float4 vn[4]; u32x2 yn[4];
    {
        const int row = blockIdx.x * 8 + w;
#pragma unroll
        for (int i = 0; i < 4; ++i) { vn[i] = ((const float4*)(x + (size_t)row * DM))[lane + 64 * i]; yn[i] = *(const u32x2*)(Y + (size_t)row * DM + 4 * (lane + 64 * i)); }
    }
    for (int row = blockIdx.x * 8 + w; row < MTOK; row += stride) {
        float4 v[4]; u32x2 yv[4];
#pragma unroll
        for (int i = 0; i < 4; ++i) { v[i] = vn[i]; yv[i] = yn[i]; }
        if (row + stride < MTOK) {
#pragma unroll
            for (int i = 0; i < 4; ++i) { vn[i] = ((const float4*)(x + (size_t)(row + stride) * DM))[lane + 64 * i]; yn[i] = *(const u32x2*)(Y + (size_t)(row + stride) * DM + 4 * (lane + 64 * i)); }
        }
        float4 y[4];
        float ss = 0.f;
#pragma unroll
        for (int i = 0; i < 4; ++i) {
            y[i].x = bf2f(yv[i].x & 0xffffu); y[i].y = bf2f(yv[i].x >> 16); y[i].z = bf2f(yv[i].y & 0xffffu); y[i].w = bf2f(yv[i].y >> 16);
            ss += y[i].x * y[i].x + y[i].y * y[i].y + y[i].z * y[i].z + y[i].w * y[i].w;
        }
        ss = wave_sum(ss);
        const float rstdy = rsqrtf(ss * (1.0f / DM) + 1e-6f);
        float s1 = 0.f;
#pragma unroll
        for (int i = 0; i < 4; ++i) {
            v[i].x += y[i].x * rstdy * gp[i].x; v[i].y += y[i].y * rstdy * gp[i].y; v[i].z += y[i].z * rstdy * gp[i].z; v[i].w += y[i].w * rstdy * gp[i].w;
            s1 += v[i].x * v[i].x + v[i].y * v[i].y + v[i].z * v[i].z + v[i].w * v[i].w;
            u32x2 xo; xo.x = pk2(v[i].x, v[i].y); xo.y = pk2(v[i].z, v[i].w);
            *(u32x2*)(X1 + (size_t)row * DM + 4 * (lane + 64 * i)) = xo;
        }
        s1 = wave_sum(s1);
        const float rstd = rsqrtf(s1 * (1.0f / DM) + 1e-6f);
#pragma unroll
        for (int i = 0; i < 4; ++i) {
            u32x2 o; o.x = pk2(v[i].x * rstd, v[i].y * rstd); o.y = pk2(v[i].z * rstd, v[i].w * rstd);
            *(u32x2*)(A + (size_t)row * DM + 4 * (lane + 64 * i)) = o;
        }
    }
}

__device__ void phase_final(const Params& p) {
    const int tid = threadIdx.x, lane = tid & 63, w = tid >> 6;
    const float* gpost = p.in[21];
    const bf16_t* Y = (const bf16_t*)(p.ws + WS_Y);
    const bf16_t* X1 = (const bf16_t*)(p.ws + WS_X1);
    float4 gp[4];
#pragma unroll
    for (int i = 0; i < 4; ++i) gp[i] = ((const float4*)gpost)[lane + 64 * i];
    const int stride = gridDim.x * 8;
    u32x2 xn[4], yn[4];
    {
        const int row = blockIdx.x * 8 + w;
#pragma unroll
        for (int i = 0; i < 4; ++i) { xn[i] = *(const u32x2*)(X1 + (size_t)row * DM + 4 * (lane + 64 * i)); yn[i] = *(const u32x2*)(Y + (size_t)row * DM + 4 * (lane + 64 * i)); }
    }
    for (int row = blockIdx.x * 8 + w; row < MTOK; row += stride) {
        u32x2 xv[4], yv[4];
#pragma unroll
        for (int i = 0; i < 4; ++i) { xv[i] = xn[i]; yv[i] = yn[i]; }
        if (row + stride < MTOK) {
#pragma unroll
            for (int i = 0; i < 4; ++i) { xn[i] = *(const u32x2*)(X1 + (size_t)(row + stride) * DM + 4 * (lane + 64 * i)); yn[i] = *(const u32x2*)(Y + (size_t)(row + stride) * DM + 4 * (lane + 64 * i)); }
        }
        float4 y[4];
        float ss = 0.f;
#pragma unroll
        for (int i = 0; i < 4; ++i) {
            y[i].x = bf2f(yv[i].x & 0xffffu); y[i].y = bf2f(yv[i].x >> 16); y[i].z = bf2f(yv[i].y & 0xffffu); y[i].w = bf2f(yv[i].y >> 16);
            ss += y[i].x * y[i].x + y[i].y * y[i].y + y[i].z * y[i].z + y[i].w * y[i].w;
        }
        ss = wave_sum(ss);
        const float rstdy = rsqrtf(ss * (1.0f / DM) + 1e-6f);
#pragma unroll
        for (int i = 0; i < 4; ++i) {
            float4 v;
            v.x = bf2f(xv[i].x & 0xffffu) + y[i].x * rstdy * gp[i].x; v.y = bf2f(xv[i].x >> 16) + y[i].y * rstdy * gp[i].y;
            v.z = bf2f(xv[i].y & 0xffffu) + y[i].z * rstdy * gp[i].z; v.w = bf2f(xv[i].y >> 16) + y[i].w * rstdy * gp[i].w;
            ((float4*)(p.out + (size_t)row * DM))[lane + 64 * i] = v;
        }
    }
}

constexpr int L_BC = 0, L_ATT = 0, L_QD = 33792, L_KD = L_QD + 64 * 136 * 2, L_KTE = L_KD + 64 * 136 * 2, L_VI = L_KTE + 64 * 152 * 2, L_SSQ = L_VI + 64 * 280 * 2, L_BL = L_SSQ + 2048, L_DEC = L_BL + 512, L_ADL = L_DEC + 512,
              L_GLA_END = L_ADL + 2048;
static_assert(L_GLA_END <= LDS_BYTES, "GLA LDS");
#define GLA_BARRIER() do { asm volatile("s_waitcnt lgkmcnt(0)" ::: "memory"); __builtin_amdgcn_s_barrier(); asm volatile("" ::: "memory"); } while (0)
typedef short gs16x4 __attribute__((ext_vector_type(4)));
__device__ __forceinline__ u32x2 g_trread(const bf16_t* p) { union { gs16x4 s; u32x2 u; } x; x.s = __builtin_amdgcn_ds_read_tr16_b64_v4i16((__attribute__((address_space(3))) gs16x4*)p); return x.u; }
template <int PITCH> __device__ __forceinline__ bf16x8 g_trfrag(const bf16_t* img, int k0, int c0, int g, int q, int pq) {
    const bf16_t* a = img + (k0 + 8 * g + q) * PITCH + c0 + 4 * pq;
    const u32x2 lo = g_trread(a), hi = g_trread(a + 4 * PITCH);
    return as_bf16x8((u32x4){lo.x, lo.y, hi.x, hi.y});
}
__device__ __forceinline__ f32x4 g_lo4(u32x4 v) { return (f32x4){bf2f(v.x & 0xffffu), bf2f(v.x >> 16), bf2f(v.y & 0xffffu), bf2f(v.y >> 16)}; }
__device__ __forceinline__ f32x4 g_hi4(u32x4 v) { return (f32x4){bf2f(v.z & 0xffffu), bf2f(v.z >> 16), bf2f(v.w & 0xffffu), bf2f(v.w >> 16)}; }
__device__ __forceinline__ u32x2 g_pk4(f32x4 v) { u32x2 r; r.x = pk2(v[0], v[1]); r.y = pk2(v[2], v[3]); return r; }
__device__ __forceinline__ f32x4 g_unpk4(u32x2 v) { return (f32x4){bf2f(v.x & 0xffffu), bf2f(v.x >> 16), bf2f(v.y & 0xffffu), bf2f(v.y >> 16)}; }

template <bool OUT> struct GlaRaw { u32x4 q[2], k[2], v[4]; };
template <bool OUT> __device__ __forceinline__ void gla_issue(GlaRaw<OUT>& x, const char* cb  , unsigned offQ, unsigned offV) {
    if (OUT) { x.q[0] = *(const u32x4*)(cb + offQ); x.q[1] = *(const u32x4*)(cb + offQ + 16); }
    x.k[0] = *(const u32x4*)(cb + offQ + 1024); x.k[1] = *(const u32x4*)(cb + offQ + 1040);
#pragma unroll
    for (int i = 0; i < 4; ++i) x.v[i] = *(const u32x4*)(cb + offV + 16 * i);
}

template <bool OUT>
__device__ void gla_pass(const Params& p, unsigned char* lds) {
    const int tid = threadIdx.x, w = __builtin_amdgcn_readfirstlane(tid >> 6);
    const bf16_t* P = (const bf16_t*)(p.ws + WS_P);
    bf16_t* GS = (bf16_t*)(p.ws + WS_GS);
    float* GD = (float*)(p.ws + WS_GD);
    bf16_t* Aout = (bf16_t*)(p.ws + WS_A);
    const bf16_t* WupT = (const bf16_t*)(p.ws + WS_WUPT);
    const bf16_t* ADG = (const bf16_t*)(p.ws + WS_AD);
    float* BC = (float*)(lds + L_BC); bf16_t* ATT = (bf16_t*)(lds + L_ATT); bf16_t* QD = (bf16_t*)(lds + L_QD); bf16_t* KD = (bf16_t*)(lds + L_KD); bf16_t* KTE = (bf16_t*)(lds + L_KTE);
    bf16_t* VI = (bf16_t*)(lds + L_VI); float* SSQ = (float*)(lds + L_SSQ); float* BL = (float*)(lds + L_BL); float* DEC = (float*)(lds + L_DEC); bf16_t* ADL = (bf16_t*)(lds + L_ADL);
    const float* b_al = p.in[4]; const float* g_head = p.in[5];

    for (int unit = blockIdx.x; unit < 256; unit += gridDim.x) {
        const int bh = unit >> 5, m = unit & 31, b = bh >> 2, h = bh & 3;
        int tidv = tid; asm volatile("" : "+v"(tidv));
        const int lane = tidv & 63, l15 = lane & 15, g = lane >> 4, q4 = l15 >> 2, p4 = l15 & 3;
        const int c = tidv >> 3, seg = tidv & 7;
        const int tokbase = b * SEQ + m * 512;
        u32x4 wupq = *(const u32x4*)(WupT + (size_t)(h * 128 + 16 * w + l15) * 16 + 8 * (g & 1));
        if (g >= 2) wupq = (u32x4){0u, 0u, 0u, 0u};
        const bf16x8 wupf = as_bf16x8(wupq);
        const float bA = b_al[h * 128 + 16 * w + l15];
        f32x4 gh[2];
#pragma unroll
        for (int vt = 0; vt < 2; ++vt) gh[vt] = *(const f32x4*)(g_head + 32 * w + 16 * vt + 4 * g);
        float logD = 0.f;
        f32x4 S[8][2];
#pragma unroll
        for (int mt = 0; mt < 8; ++mt)
#pragma unroll
            for (int vt = 0; vt < 2; ++vt) {
                if (OUT) S[mt][vt] = g_unpk4(*(const u32x2*)(GS + ((size_t)(bh * 32 + m) * 256 + 32 * w + 16 * vt + l15) * 128 + 16 * mt + 4 * g));
                else S[mt][vt] = (f32x4){0.f, 0.f, 0.f, 0.f};
            }
        const unsigned offQ = (unsigned)((c * GIN_P + h * 128 + 16 * seg) * 2), offV = (unsigned)((c * GIN_P + 1024 + h * 256 + 32 * seg) * 2), offAD = (unsigned)(tid * 16);
        const unsigned offG = (unsigned)((l15 * GIN_P + 2048 + h * 256 + 32 * w + 4 * g) * 2), offO = (unsigned)((l15 * DM + h * 256 + 32 * w + 4 * g) * 2);
        GlaRaw<OUT> raw;
        gla_issue<OUT>(raw, (const char*)P + (size_t)tokbase * GIN_P * 2, offQ, offV);
        if (tid < 128) *(u32x4*)(ADL + tid * 8) = *(const u32x4*)((const char*)ADG + (size_t)tokbase * 32 + offAD);
        GLA_BARRIER();

        for (int ch = 0; ch < 8; ++ch) {
            const int tok0 = tokbase + ch * 64;
            u32x4 adn = (u32x4){0u, 0u, 0u, 0u};
            {
                if (ch < 7 && tid < 128) adn = *(const u32x4*)((const char*)ADG + (size_t)(tok0 + 64) * 32 + offAD);
                f32x4 sc[4]; float xinc[4], tot[4];
#pragma unroll
                for (int ct = 0; ct < 4; ++ct) {
                    u32x4 aq = *(const u32x4*)(ADL + (16 * ct + l15) * 16 + 8 * (g & 1));
                    if (g >= 2) aq = (u32x4){0u, 0u, 0u, 0u};
                    const f32x4 z = mfma16(as_bf16x8(aq), wupf, (f32x4){bA, bA, bA, bA});
                    float acc = 0.f;
#pragma unroll
                    for (int r = 0; r < 4; ++r) { acc += (fminf(z[r], 0.f) - flog(1.f + fexp(-fabsf(z[r])))) * (1.0f / 16.0f); sc[ct][r] = acc; }
                    xinc[ct] = acc;
                }
#pragma unroll
                for (int ct = 0; ct < 4; ++ct) xinc[ct] += (g >= 1 ? 1.f : 0.f) * bperm(((lane - 16) & 63) * 4, xinc[ct]);
#pragma unroll
                for (int ct = 0; ct < 4; ++ct) xinc[ct] += (g >= 2 ? 1.f : 0.f) * bperm(((lane - 32) & 63) * 4, xinc[ct]);
#pragma unroll
                for (int ct = 0; ct < 4; ++ct) tot[ct] = bperm((48 + l15) * 4, xinc[ct]);
                float run = 0.f;
#pragma unroll
                for (int ct = 0; ct < 4; ++ct) {
                    const float base = run + (xinc[ct] - sc[ct][3]);
                    run += tot[ct];
#pragma unroll
                    for (int r = 0; r < 4; ++r) BC[(16 * ct + 4 * g + r) * 132 + 16 * w + l15] = base + sc[ct][r];
                }
                if (g == 0) { BL[16 * w + l15] = run; DEC[16 * w + l15] = fexp(run); }
                if (!OUT) logD += run;
            }
            GLA_BARRIER();
            u32x2 gate[2][4];
            {
#pragma unroll
                for (int hh = 0; hh < 2; ++hh) {
                    const int o8 = 16 * seg + 8 * hh;
                    const f32x4 bb[2] = {*(const f32x4*)(BC + c * 132 + o8), *(const f32x4*)(BC + c * 132 + o8 + 4)};
                    const f32x4 dc[2] = {*(const f32x4*)(DEC + o8), *(const f32x4*)(DEC + o8 + 4)};
                    const f32x4 kx[2] = {g_lo4(raw.k[hh]), g_hi4(raw.k[hh])};
                    f32x4 qx[2];
                    if (OUT) { qx[0] = g_lo4(raw.q[hh]); qx[1] = g_hi4(raw.q[hh]); }
                    f32x4 kd[2], kt[2], qd[2];
#pragma unroll
                    for (int i = 0; i < 2; ++i)
#pragma unroll
                        for (int j = 0; j < 4; ++j) {
                            const float eB = fexp(bb[i][j]), enB = __builtin_amdgcn_rcpf(eB);
                            kd[i][j] = kx[i][j] * enB; kt[i][j] = kd[i][j] * dc[i][j];
                            if (OUT) qd[i][j] = qx[i][j] * 0.08838834764831845f * eB;
                        }
                    *(u32x4*)(KTE + c * 152 + o8) = (u32x4){pk2(kt[0][0], kt[0][1]), pk2(kt[0][2], kt[0][3]), pk2(kt[1][0], kt[1][1]), pk2(kt[1][2], kt[1][3])};
                    if (OUT) {
                        *(u32x4*)(KD + c * 136 + o8) = (u32x4){pk2(kd[0][0], kd[0][1]), pk2(kd[0][2], kd[0][3]), pk2(kd[1][0], kd[1][1]), pk2(kd[1][2], kd[1][3])};
                        *(u32x4*)(QD + c * 136 + o8) = (u32x4){pk2(qd[0][0], qd[0][1]), pk2(qd[0][2], qd[0][3]), pk2(qd[1][0], qd[1][1]), pk2(qd[1][2], qd[1][3])};
                    }
                }
#pragma unroll
                for (int i = 0; i < 4; ++i) *(u32x4*)(VI + c * 280 + 32 * seg + 8 * i) = raw.v[i];
                if (OUT) {
#pragma unroll
                    for (int vt = 0; vt < 2; ++vt)
#pragma unroll
                        for (int ct = 0; ct < 4; ++ct) gate[vt][ct] = *(const u32x2*)((const char*)P + (size_t)(tok0 + 16 * ct) * GIN_P * 2 + offG + 32 * vt);
                }
                if (ch < 7) gla_issue<OUT>(raw, (const char*)P + (size_t)(tok0 + 64) * GIN_P * 2, offQ, offV);
                if (ch < 7 && tid < 128) *(u32x4*)(ADL + tid * 8) = adn;
            }
            GLA_BARRIER();
            f32x4 o[2][4];
            if (OUT) {
#pragma unroll
                for (int t2 = 0; t2 < 2; ++t2) {
                    const int tl = 2 * w + t2, ct = tl >> 2, st = tl & 3;
                    f32x4 acc = (f32x4){0.f, 0.f, 0.f, 0.f};
                    if (st <= ct) {
#pragma unroll
                        for (int kk = 0; kk < 4; ++kk) {
                            const bf16x8 a = *(const bf16x8*)(KD + (16 * st + l15) * 136 + 32 * kk + 8 * g);
                            const bf16x8 bq = *(const bf16x8*)(QD + (16 * ct + l15) * 136 + 32 * kk + 8 * g);
                            acc = mfma16(a, bq, acc);
                        }
#pragma unroll
                        for (int r = 0; r < 4; ++r) if (16 * st + 4 * g + r > 16 * ct + l15) acc[r] = 0.f;
                    }
                    *(u32x2*)(ATT + (16 * ct + l15) * 72 + 16 * st + 4 * g) = g_pk4(acc);
                }
                GLA_BARRIER();
#pragma unroll
                for (int vt = 0; vt < 2; ++vt)
#pragma unroll
                    for (int ct = 0; ct < 4; ++ct) o[vt][ct] = (f32x4){0.f, 0.f, 0.f, 0.f};
#pragma unroll
                for (int kk = 0; kk < 4; ++kk) {
                    bf16x8 sa[2];
#pragma unroll
                    for (int vt = 0; vt < 2; ++vt) { const u32x2 s0 = g_pk4(S[2 * kk][vt]), s1 = g_pk4(S[2 * kk + 1][vt]); sa[vt] = as_bf16x8((u32x4){s0.x, s0.y, s1.x, s1.y}); }
#pragma unroll
                    for (int ct = 0; ct < 4; ++ct) {
                        const bf16_t* qr = QD + (16 * ct + l15) * 136 + 32 * kk + 4 * g;
                        const u32x2 lo = *(const u32x2*)qr, hi = *(const u32x2*)(qr + 16);
                        const bf16x8 bq = as_bf16x8((u32x4){lo.x, lo.y, hi.x, hi.y});
#pragma unroll
                        for (int vt = 0; vt < 2; ++vt) o[vt][ct] = mfma16(sa[vt], bq, o[vt][ct]);
                    }
                }
            }
            bf16x8 bv[2][2];
#pragma unroll
            for (int vt = 0; vt < 2; ++vt)
#pragma unroll
                for (int kk = 0; kk < 2; ++kk) bv[vt][kk] = g_trfrag<280>(VI, 32 * kk, 32 * w + 16 * vt, g, q4, p4);
            if (OUT) {
#pragma unroll
                for (int ct = 0; ct < 4; ++ct)
#pragma unroll
                    for (int kk = 0; kk < 2; ++kk) {
                        if (32 * kk <= 16 * ct + 15) {
                            const bf16x8 bq = *(const bf16x8*)(ATT + (16 * ct + l15) * 72 + 32 * kk + 8 * g);
#pragma unroll
                            for (int vt = 0; vt < 2; ++vt) o[vt][ct] = mfma16(bv[vt][kk], bq, o[vt][ct]);
                        }
                    }
            }
#pragma unroll
            for (int mt = 0; mt < 8; ++mt) {
                const f32x4 dv = *(const f32x4*)(DEC + 16 * mt + 4 * g);
#pragma unroll
                for (int vt = 0; vt < 2; ++vt) S[mt][vt] *= dv;
#pragma unroll
                for (int kk = 0; kk < 2; ++kk) {
                    const bf16x8 a = g_trfrag<152>(KTE, 32 * kk, 16 * mt, g, q4, p4);
#pragma unroll
                    for (int vt = 0; vt < 2; ++vt) S[mt][vt] = mfma16(a, bv[vt][kk], S[mt][vt]);
                }
            }
            if (OUT) {
                float ss[4];
#pragma unroll
                for (int ct = 0; ct < 4; ++ct) {
                    float s = 0.f;
#pragma unroll
                    for (int vt = 0; vt < 2; ++vt)
#pragma unroll
                        for (int r = 0; r < 4; ++r) s += o[vt][ct][r] * o[vt][ct][r];
                    s += bperm((lane ^ 16) * 4, s); s += bperm((lane ^ 32) * 4, s);
                    ss[ct] = s;
                }
                if (g == 0) {
#pragma unroll
                    for (int ct = 0; ct < 4; ++ct) SSQ[(16 * ct + l15) * 8 + w] = ss[ct];
                }
                GLA_BARRIER();
#pragma unroll
                for (int ct = 0; ct < 4; ++ct) {
                    const int cc = 16 * ct + l15;
                    const float4 s0 = *(const float4*)(SSQ + cc * 8), s1 = *(const float4*)(SSQ + cc * 8 + 4);
                    const float tot = (s0.x + s0.y) + (s0.z + s0.w) + (s1.x + s1.y) + (s1.z + s1.w);
                    const float rstd = rsqrtf(tot * (1.0f / 256.0f) + 1e-6f);
#pragma unroll
                    for (int vt = 0; vt < 2; ++vt) {
                        const f32x4 gt = g_unpk4(gate[vt][ct]);
                        f32x4 val;
#pragma unroll
                        for (int r = 0; r < 4; ++r) val[r] = o[vt][ct][r] * rstd * gh[vt][r] * gt[r];
                        *(u32x2*)((char*)Aout + (size_t)(tok0 + 16 * ct) * DM * 2 + offO + 32 * vt) = g_pk4(val);
                    }
                }
            } else {
                GLA_BARRIER();
            }
        }
        if (!OUT) {
#pragma unroll
            for (int mt = 0; mt < 8; ++mt)
#pragma unroll
                for (int vt = 0; vt < 2; ++vt) *(u32x2*)(GS + ((size_t)(bh * 32 + m) * 256 + 32 * w + 16 * vt + l15) * 128 + 16 * mt + 4 * g) = g_pk4(S[mt][vt]);
            if (g == 0) GD[(bh * 32 + m) * 128 + 16 * w + l15] = fexp(logD);
        }
        GLA_BARRIER();
    }
}

__device__ void gla_scan(const Params& p) {
    bf16_t* GS = (bf16_t*)(p.ws + WS_GS);
    const float* GD = (const float*)(p.ws + WS_GD);
    for (int idx = blockIdx.x * NTH + threadIdx.x; idx < 8 * 8192; idx += gridDim.x * NTH) {
        const int bh = idx >> 13, e = (idx & 8191) * 4, d = e & 127;
        f32x4 S = (f32x4){0.f, 0.f, 0.f, 0.f};
        for (int m0 = 0; m0 < 32; m0 += 8) {
            u32x2 t[8]; f32x4 dd[8];
#pragma unroll
            for (int m = 0; m < 8; ++m) { t[m] = *(const u32x2*)(GS + (size_t)(bh * 32 + m0 + m) * 32768 + e); dd[m] = *(const f32x4*)(GD + (bh * 32 + m0 + m) * 128 + d); }
#pragma unroll
            for (int m = 0; m < 8; ++m) { *(u32x2*)(GS + (size_t)(bh * 32 + m0 + m) * 32768 + e) = g_pk4(S); S = S * dd[m] + g_unpk4(t[m]); }
        }
    }
}

constexpr int PP = RIN_P;
constexpr size_t WS_RK  = WS_GS;
constexpr size_t WS_BND = WS_GS + (size_t)MTOK * 16 * 4;
static_assert(WS_BND + (size_t)513 * PP * 2 <= WS_GD, "RWKV side buffers must fit the GLA state region");
constexpr int IMG = 64 * 72 * 2;
constexpr int R_ALB = 0, R_BH = IMG, R_KH = 2 * IMG, R_RB = 3 * IMG, R_BTL = 4 * IMG, R_KTL = 5 * IMG, R_VI = 6 * IMG, R_AAB = 7 * IMG, R_AAK = 8 * IMG, R_ARB = 9 * IMG, R_ARK = 10 * IMG,
              R_DW = R_AAK, R_DA = R_BH, R_XT = 11 * IMG, R_TW = R_XT, R_ADI = R_XT + IMG, R_TDF = R_XT + 2 * IMG, R_CS = R_TDF + 2048, R_GC = R_CS + 2048, R_CONST = R_GC + 256, R_WDL = R_CONST + 2560, R_WIL = R_WDL + IMG,
              R_END = R_WIL + IMG;
static_assert(R_DW + 64 * 68 * 4 <= R_XT && R_DA + 64 * 68 * 4 <= R_RB && R_END <= LDS_BYTES, "R1 LDS");
#define LDS_BARRIER() do { asm volatile("s_waitcnt lgkmcnt(0)" ::: "memory"); __builtin_amdgcn_s_barrier(); asm volatile("" ::: "memory"); } while (0)

typedef short s16x4 __attribute__((ext_vector_type(4)));
__device__ __forceinline__ bf16x8 ldfrag(const bf16_t* img, int row, int koff) { return *(const bf16x8*)(img + row * 72 + koff); }
__device__ __forceinline__ u32x2 pk4(f32x4 v) { u32x2 r; r.x = pk2(v[0], v[1]); r.y = pk2(v[2], v[3]); return r; }
__device__ __forceinline__ f32x4 unpk4(u32x2 v) { return (f32x4){bf2f(v.x & 0xffffu), bf2f(v.x >> 16), bf2f(v.y & 0xffffu), bf2f(v.y >> 16)}; }
__device__ __forceinline__ u32x2 trread(const bf16_t* p) {
    union { s16x4 s; u32x2 u; } x; x.s = __builtin_amdgcn_ds_read_tr16_b64_v4i16((__attribute__((address_space(3))) s16x4*)p); return x.u;
}
__device__ __forceinline__ bf16x8 trfrag(const bf16_t* img, int k0, int c0, int g, int q, int pq) {
    const bf16_t* a = img + (k0 + 8 * g + q) * 72 + c0 + 4 * pq;
    const u32x2 lo = trread(a), hi = trread(a + 4 * 72);
    return as_bf16x8((u32x4){lo.x, lo.y, hi.x, hi.y});
}
__device__ __forceinline__ f32x4 lo4(u32x4 v) { return (f32x4){bf2f(v.x & 0xffffu), bf2f(v.x >> 16), bf2f(v.y & 0xffffu), bf2f(v.y >> 16)}; }
__device__ __forceinline__ f32x4 hi4(u32x4 v) { return (f32x4){bf2f(v.z & 0xffffu), bf2f(v.z >> 16), bf2f(v.w & 0xffffu), bf2f(v.w >> 16)}; }
__device__ __forceinline__ u32x4 pk8(f32x4 a, f32x4 b) { return (u32x4){pk2(a[0], a[1]), pk2(a[2], a[3]), pk2(b[0], b[1]), pk2(b[2], b[3])}; }
__device__ __forceinline__ float fast_rcp(float x) { return __builtin_amdgcn_rcpf(x); }
__device__ __forceinline__ f32x4 mm16(f32x4 xa, f32x4 yb, f32x4 c) {
    const u32x2 a = pk4(xa), b = pk4(yb);
    return mfma16(as_bf16x8((u32x4){a.x, a.y, 0u, 0u}), as_bf16x8((u32x4){b.x, b.y, 0u, 0u}), c);
}

struct R1Raw { u32x4 r0, r1, k0, k1, v0, v1, w0, w1, a0, a1; };
__device__ __forceinline__ void r1_issue(R1Raw& x, const bf16_t* P, const bf16_t* BND, int unit, int t, int cs) {
    const int bn = unit >> 4, h = unit & 15, n = bn & 255;
    const bf16_t* cur = P + ((size_t)bn * 64 + t) * PP;
    const bf16_t* prv = (t > 0) ? (cur - PP) : (BND + (size_t)(n == 0 ? 0 : bn) * PP);
    const int ch = h * 64 + 8 * cs;
    x.r0 = *(const u32x4*)(cur + ch); x.k0 = *(const u32x4*)(cur + 1024 + ch); x.v0 = *(const u32x4*)(cur + 2048 + ch); x.w0 = *(const u32x4*)(cur + 4096 + 8 * cs); x.a0 = *(const u32x4*)(cur + 4160 + 8 * cs);
    x.r1 = *(const u32x4*)(prv + ch); x.k1 = *(const u32x4*)(prv + 1024 + ch); x.v1 = *(const u32x4*)(prv + 2048 + ch); x.w1 = *(const u32x4*)(prv + 4096 + 8 * cs); x.a1 = *(const u32x4*)(prv + 4160 + 8 * cs);
}
__device__ __forceinline__ void lerp8(u32x4 c, u32x4 pv, const float* mu8, f32x4& o0, f32x4& o1) {
    const f32x4 c0 = lo4(c), c1 = hi4(c), p0 = lo4(pv), p1 = hi4(pv);
    const f32x4 m0 = *(const f32x4*)mu8, m1 = *(const f32x4*)(mu8 + 4);
    o0 = c0 + m0 * (p0 - c0); o1 = c1 + m1 * (p1 - c1);
}

__device__ void rwkv_r1(const Params& p, unsigned char* lds) {
    const int tid = threadIdx.x, w = __builtin_amdgcn_readfirstlane(tid >> 6);
    bf16_t* P = (bf16_t*)(p.ws + WS_P);
    bf16_t* Abuf = (bf16_t*)(p.ws + WS_A);
    bf16_t* Ybuf = (bf16_t*)(p.ws + WS_Y);
    float* RK = (float*)(p.ws + WS_RK);
    const bf16_t* BND = (const bf16_t*)(p.ws + WS_BND);
    const bf16_t* WduT = (const bf16_t*)(p.ws + WS_WDUT);
    const bf16_t* WiuT = (const bf16_t*)(p.ws + WS_WIUT);
    bf16_t* ALB = (bf16_t*)(lds + R_ALB); bf16_t* BH = (bf16_t*)(lds + R_BH); bf16_t* KH = (bf16_t*)(lds + R_KH); bf16_t* RB = (bf16_t*)(lds + R_RB);
    bf16_t* BTL = (bf16_t*)(lds + R_BTL); bf16_t* KTL = (bf16_t*)(lds + R_KTL); bf16_t* VI = (bf16_t*)(lds + R_VI);
    bf16_t* AAB = (bf16_t*)(lds + R_AAB); bf16_t* AAK = (bf16_t*)(lds + R_AAK); bf16_t* ARB = (bf16_t*)(lds + R_ARB); bf16_t* ARK = (bf16_t*)(lds + R_ARK);
    float* DW = (float*)(lds + R_DW); float* DA = (float*)(lds + R_DA);
    bf16_t* XT = (bf16_t*)(lds + R_XT); bf16_t* TW = (bf16_t*)(lds + R_TW); bf16_t* ADI = (bf16_t*)(lds + R_ADI);
    u32x2* TDF = (u32x2*)(lds + R_TDF); float* CS = (float*)(lds + R_CS); float* GCs = (float*)(lds + R_GC); float* CONST = (float*)(lds + R_CONST); bf16_t* WDL = (bf16_t*)(lds + R_WDL); bf16_t* WIL = (bf16_t*)(lds + R_WIL);
    const int t0_ = tid >> 3, cs0_ = tid & 7;
    int hprev = -1;
    R1Raw raw;
    if (blockIdx.x < 8192) r1_issue(raw, P, BND, blockIdx.x, t0_, cs0_);
    {
        u32x4* dmy = (u32x4*)(p.ws + WS_DUMMY) + tid;
#pragma unroll
        for (int k = 0; k < 6; ++k) dmy[k * NTH] = (u32x4){0u, 0u, 0u, 0u};
    }

    for (int unit = blockIdx.x; unit < 8192; unit += gridDim.x) {
        const int bn = unit >> 4, h = unit & 15, n = bn & 255;
        const size_t R0 = (size_t)bn * 64;
        int tidv = tid; asm volatile("" : "+v"(tidv));
        const int lane = tidv & 63, l15 = lane & 15, g = lane >> 4, q4 = l15 >> 2, p4 = l15 & 3, t = tidv >> 3, cs = tidv & 7, tl = lane >> 3;
        if (h != hprev) {
            LDS_BARRIER();
            if (tid < 64) {
                const int ch = h * 64 + tid;
                CONST[tid] = p.in[10][ch]; CONST[64 + tid] = p.in[10][1024 + ch]; CONST[128 + tid] = p.in[10][2048 + ch];
                CONST[192 + tid] = p.in[11][ch]; CONST[256 + tid] = p.in[13][ch]; CONST[320 + tid] = p.in[15][ch]; CONST[384 + tid] = p.in[16][ch]; CONST[448 + tid] = p.in[17][ch];
                CONST[512 + tid] = p.in[10][4096 + tid]; CONST[576 + tid] = p.in[10][4160 + tid];
            }
            {
                const int rr = tid >> 3, sg = tid & 7;
                *(u32x4*)(WDL + rr * 72 + 8 * sg) = *(const u32x4*)(WduT + (size_t)(h * 64 + rr) * 64 + 8 * sg);
                *(u32x4*)(WIL + rr * 72 + 8 * sg) = *(const u32x4*)(WiuT + (size_t)(h * 64 + rr) * 64 + 8 * sg);
            }
            hprev = h;
            LDS_BARRIER();
        }
        f32x4 r0, r1, k0, k1, v0, v1;
        {
            f32x4 wd0, wd1, ad0, ad1;
            lerp8(raw.r0, raw.r1, CONST + 8 * cs, r0, r1);
            lerp8(raw.k0, raw.k1, CONST + 64 + 8 * cs, k0, k1);
            lerp8(raw.v0, raw.v1, CONST + 128 + 8 * cs, v0, v1);
            lerp8(raw.w0, raw.w1, CONST + 512 + 8 * cs, wd0, wd1);
            lerp8(raw.a0, raw.a1, CONST + 576 + 8 * cs, ad0, ad1);
#pragma unroll
            for (int j = 0; j < 4; ++j) {
                const float e0 = fexp(-2.f * fabsf(wd0[j])), e1 = fexp(-2.f * fabsf(wd1[j]));
                wd0[j] = copysignf((1.f - e0) * fast_rcp(1.f + e0), wd0[j]); wd1[j] = copysignf((1.f - e1) * fast_rcp(1.f + e1), wd1[j]);
            }
            *(u32x4*)(TW + t * 72 + 8 * cs) = pk8(wd0, wd1);
            *(u32x4*)(ADI + t * 72 + 8 * cs) = pk8(ad0, ad1);
        }
        if (unit + (int)gridDim.x < 8192) r1_issue(raw, P, BND, unit + gridDim.x, t, cs);
        {
            const int trow = 8 * w + (l15 & 7);
            const bool lo8 = l15 < 8;
            bf16x8 ft[2], fa[2];
#pragma unroll
            for (int kk = 0; kk < 2; ++kk) { ft[kk] = ldfrag(TW, trow, 32 * kk + 8 * g); fa[kk] = ldfrag(ADI, trow, 32 * kk + 8 * g); }
            float* dst = (lo8 ? DW : DA) + trow * 68 + 4 * g;
#pragma unroll
            for (int ct = 0; ct < 4; ++ct) {
                f32x4 aw = (f32x4){0.f, 0.f, 0.f, 0.f}, aa = aw;
#pragma unroll
                for (int kk = 0; kk < 2; ++kk) { aw = mfma16(ldfrag(WDL, 16 * ct + l15, 32 * kk + 8 * g), ft[kk], aw); aa = mfma16(ldfrag(WIL, 16 * ct + l15, 32 * kk + 8 * g), fa[kk], aa); }
                f32x4 o;
#pragma unroll
                for (int j = 0; j < 4; ++j) o[j] = lo8 ? aw[j] : aa[j];
                *(f32x4*)(dst + 16 * ct) = o;
            }
        }
        f32x4 lw[2], av[2], kk[2], k2[2], G[2];
        {
            const f32x4 cw0[2] = {*(const f32x4*)(CONST + 192 + 8 * cs), *(const f32x4*)(CONST + 196 + 8 * cs)};
            const f32x4 ca0[2] = {*(const f32x4*)(CONST + 256 + 8 * cs), *(const f32x4*)(CONST + 260 + 8 * cs)};
            const f32x4 ckk[2] = {*(const f32x4*)(CONST + 320 + 8 * cs), *(const f32x4*)(CONST + 324 + 8 * cs)};
            const f32x4 cka[2] = {*(const f32x4*)(CONST + 384 + 8 * cs), *(const f32x4*)(CONST + 388 + 8 * cs)};
            const f32x4 crk[2] = {*(const f32x4*)(CONST + 448 + 8 * cs), *(const f32x4*)(CONST + 452 + 8 * cs)};
            const f32x4 dwv[2] = {*(const f32x4*)(DW + t * 68 + 8 * cs), *(const f32x4*)(DW + t * 68 + 8 * cs + 4)};
            const f32x4 dav[2] = {*(const f32x4*)(DA + t * 68 + 8 * cs), *(const f32x4*)(DA + t * 68 + 8 * cs + 4)};
            const f32x4 kin[2] = {k0, k1}, rin[2] = {r0, r1};
            float n2 = 0.f, rk = 0.f;
#pragma unroll
            for (int hf = 0; hf < 2; ++hf)
#pragma unroll
                for (int j = 0; j < 4; ++j) {
                    const float z = -(cw0[hf][j] + dwv[hf][j]);
                    const float sp = fmaxf(z, 0.f) + flog(1.f + fexp(-fabsf(z)));
                    lw[hf][j] = -fexp(-sp - 0.5f);
                    av[hf][j] = fast_rcp(1.f + fexp(-(ca0[hf][j] + dav[hf][j])));
                    kk[hf][j] = kin[hf][j] * ckk[hf][j];
                    k2[hf][j] = kin[hf][j] * (1.f + (av[hf][j] - 1.f) * cka[hf][j]);
                    n2 += kk[hf][j] * kk[hf][j]; rk += rin[hf][j] * k2[hf][j] * crk[hf][j];
                }
            n2 = sum8(n2); rk = sum8(rk);
            const float inv = 1.0f / fmaxf(sqrtf(n2), 1e-12f);
            kk[0] *= inv; kk[1] *= inv;
            if (cs == 0) RK[(R0 + t) * 16 + h] = rk;
            G[0] = lw[0]; G[1] = lw[1];
#pragma unroll
            for (int d = 1; d < 8; d <<= 1) {
                const int src = ((lane - 8 * d) & 63) * 4;
                const float keep = (tl >= d) ? 1.f : 0.f;
#pragma unroll
                for (int hf = 0; hf < 2; ++hf)
#pragma unroll
                    for (int j = 0; j < 4; ++j) G[hf][j] += keep * bperm(src, G[hf][j]);
            }
            if (tl == 7) { *(f32x4*)(CS + w * 64 + 8 * cs) = G[0]; *(f32x4*)(CS + w * 64 + 8 * cs + 4) = G[1]; }
        }
        LDS_BARRIER();
        {
            f32x4 off[2] = {(f32x4){0.f, 0.f, 0.f, 0.f}, (f32x4){0.f, 0.f, 0.f, 0.f}}, gc[2] = {off[0], off[0]};
#pragma unroll
            for (int q = 0; q < 8; ++q) {
                const f32x4 c0 = *(const f32x4*)(CS + q * 64 + 8 * cs), c1 = *(const f32x4*)(CS + q * 64 + 8 * cs + 4);
                const float mk = (q < w) ? 1.f : 0.f;
                gc[0] += c0; gc[1] += c1; off[0] += c0 * mk; off[1] += c1 * mk;
            }
            f32x4 al[2], bh[2], kh[2], rb[2];
            const f32x4 rin[2] = {r0, r1};
#pragma unroll
            for (int hf = 0; hf < 2; ++hf)
#pragma unroll
                for (int j = 0; j < 4; ++j) {
                    const float Gi = G[hf][j] + off[hf][j];
                    const float eG = fexp(Gi), eGm = fexp(Gi - lw[hf][j]), enG = fast_rcp(eG);
                    const float be = kk[hf][j] * av[hf][j];
                    al[hf][j] = -kk[hf][j] * eGm; bh[hf][j] = be * enG; kh[hf][j] = k2[hf][j] * enG; rb[hf][j] = rin[hf][j] * eG;
                }
            const int o = t * 72 + 8 * cs;
            *(u32x4*)(ALB + o) = pk8(al[0], al[1]); *(u32x4*)(BH + o) = pk8(bh[0], bh[1]); *(u32x4*)(KH + o) = pk8(kh[0], kh[1]); *(u32x4*)(RB + o) = pk8(rb[0], rb[1]);
            const u32x4 vpk = pk8(v0, v1);
            *(u32x4*)(VI + o) = vpk;
            *(u32x4*)(Ybuf + (R0 + t) * DM + h * 64 + 8 * cs) = vpk;
            if (w == 0 && tl == 0) { f32x4 e0, e1;
#pragma unroll
                for (int j = 0; j < 4; ++j) { e0[j] = fexp(gc[0][j]); e1[j] = fexp(gc[1][j]); }
                *(f32x4*)(GCs + 8 * cs) = e0; *(f32x4*)(GCs + 8 * cs + 4) = e1; }
        }
        LDS_BARRIER();
        {
            int ntile = 1, tta = 0, sta = 0, ttb = 0, stb = 0;
            if (w == 0) { tta = 0; sta = 0; } else if (w == 2) { tta = 1; sta = 1; } else if (w == 5) { tta = 2; sta = 2; } else if (w == 7) { tta = 3; sta = 3; }
            else if (w == 1) { ntile = 2; tta = 1; sta = 0; ttb = 2; stb = 0; } else if (w == 3) { ntile = 2; tta = 2; sta = 1; ttb = 3; stb = 0; }
            else if (w == 4) { tta = 3; sta = 1; } else { tta = 3; sta = 2; }
            for (int it = 0; it < ntile; ++it) {
                const int tt = it ? ttb : tta, st = it ? stb : sta;
                f32x4 cab = (f32x4){0.f, 0.f, 0.f, 0.f}, cak = cab, crb = cab, crk = cab, nab = cab;
#pragma unroll
                for (int kq = 0; kq < 2; ++kq) {
                    const bf16x8 fb = ldfrag(BH, 16 * st + l15, 32 * kq + 8 * g), fk = ldfrag(KH, 16 * st + l15, 32 * kq + 8 * g);
                    const bf16x8 fa = ldfrag(ALB, 16 * tt + l15, 32 * kq + 8 * g), fr = ldfrag(RB, 16 * tt + l15, 32 * kq + 8 * g);
                    cab = mfma16(fb, fa, cab); cak = mfma16(fk, fa, cak); crb = mfma16(fb, fr, crb); crk = mfma16(fk, fr, crk);
                    if (tt == st) nab = mfma16(fa, fb, nab);
                }
                if (tt == st) {
#pragma unroll
                    for (int r = 0; r < 4; ++r) {
                        const int s = 4 * g + r, tq = l15;
                        if (s >= tq) { cab[r] = 0.f; cak[r] = 0.f; }
                        if (s > tq) { crb[r] = 0.f; crk[r] = 0.f; }
                        if (l15 >= 4 * g + r) nab[r] = 0.f;
                    }
                }
                const int o = (16 * tt + l15) * 72 + 16 * st + 4 * g;
                *(u32x2*)(AAB + o) = pk4(cab); *(u32x2*)(AAK + o) = pk4(cak); *(u32x2*)(ARB + o) = pk4(crb); *(u32x2*)(ARK + o) = pk4(crk);
                if (tt == st) {
                    const f32x4 z = (f32x4){0.f, 0.f, 0.f, 0.f};
                    const f32x4 Q1 = cab, N1 = nab;
                    const f32x4 Q2 = mm16(N1, Q1, z), N2 = mm16(Q1, N1, z);
                    f32x4 Pm = Q1;
#pragma unroll
                    for (int r = 0; r < 4; ++r) if (4 * g + r == l15) Pm[r] += 1.f;
                    Pm = mm16(N2, Pm, Pm);
                    const f32x4 Q4 = mm16(N2, Q2, z), N4 = mm16(Q2, N2, z);
                    Pm = mm16(N4, Pm, Pm);
                    const f32x4 N8 = mm16(Q4, N4, z);
                    Pm = mm16(N8, Pm, Pm);
                    TDF[tt * 64 + lane] = pk4(Pm);
                }
            }
            if (w == 4 || w == 6) {
                const int tt = (w == 4) ? 0 : 2, st = tt + 1;
                const int o = (16 * tt + l15) * 72 + 16 * st + 4 * g;
                const u32x2 zz = (u32x2){0u, 0u};
                *(u32x2*)(AAK + o) = zz; *(u32x2*)(ARB + o) = zz; *(u32x2*)(ARK + o) = zz;
            }
        }
        LDS_BARRIER();
        {
            u32x2 xb[4];
            const int col = 16 * w + l15;
            bf16x8 vfr[2];
            if (w >= 4) { vfr[0] = trfrag(VI, 0, 16 * (w - 4), g, q4, p4); vfr[1] = trfrag(VI, 32, 16 * (w - 4), g, q4, p4); }
#pragma unroll
            for (int i = 0; i < 4; ++i) {
                f32x4 z;
                if (w < 4) z = unpk4(trread(ALB + (16 * i + 4 * g + q4) * 72 + 16 * w + 4 * p4));
                else {
                    z = mfma16(ldfrag(AAK, 16 * i + l15, 8 * g), vfr[0], (f32x4){0.f, 0.f, 0.f, 0.f});
                    if (i >= 2) z = mfma16(ldfrag(AAK, 16 * i + l15, 32 + 8 * g), vfr[1], z);
                }
                if (i >= 1) {
                    const bf16_t* ar = AAB + (16 * i + l15) * 72 + 4 * g;
                    const u32x2 a0 = *(const u32x2*)ar;
                    u32x2 a1 = (u32x2){0u, 0u}, b1 = (u32x2){0u, 0u};
                    if (i >= 2) { a1 = *(const u32x2*)(ar + 16); b1 = xb[1]; }
                    z = mfma16(as_bf16x8((u32x4){a0.x, a0.y, a1.x, a1.y}), as_bf16x8((u32x4){xb[0].x, xb[0].y, b1.x, b1.y}), z);
                    if (i == 3) {
                        const u32x2 a2 = *(const u32x2*)(ar + 32);
                        z = mfma16(as_bf16x8((u32x4){a2.x, a2.y, 0u, 0u}), as_bf16x8((u32x4){xb[2].x, xb[2].y, 0u, 0u}), z);
                    }
                }
                const u32x2 tq = TDF[i * 64 + lane];
                const u32x2 zq = pk4(z);
                const f32x4 x = mfma16(as_bf16x8((u32x4){tq.x, tq.y, 0u, 0u}), as_bf16x8((u32x4){zq.x, zq.y, 0u, 0u}), (f32x4){0.f, 0.f, 0.f, 0.f});
                xb[i] = pk4(x);
                *(u32x2*)(XT + col * 72 + 16 * i + 4 * g) = xb[i];
            }
        }
        LDS_BARRIER();
        {
            const int rt_ = w & 3, c0 = 2 * (w >> 2);
            bf16x8 xw[2], xu[2], fbt[2], fkt[2], fvr[2];
#pragma unroll
            for (int kq = 0; kq < 2; ++kq) {
                xw[kq] = ldfrag(XT, 16 * rt_ + l15, 32 * kq + 8 * g);
                xu[kq] = ldfrag(XT, 64 + 16 * rt_ + l15, 32 * kq + 8 * g);
                fbt[kq] = trfrag(BH, 32 * kq, 16 * rt_, g, q4, p4);
                fkt[kq] = trfrag(KH, 32 * kq, 16 * rt_, g, q4, p4);
                fvr[kq] = trfrag(VI, 32 * kq, 16 * rt_, g, q4, p4);
            }
            const float gcd0 = GCs[16 * c0 + l15], gcd1 = GCs[16 * c0 + 16 + l15];
            const f32x4 gcr = *(const f32x4*)(GCs + 16 * rt_ + 4 * g);
#pragma unroll
            for (int q = 0; q < 2; ++q) {
                bf16x8 gbt[2], garb[2], gxu[2], gvi[2], gark[2];
#pragma unroll
                for (int kq = 0; kq < 2; ++kq) {
                    gbt[kq] = trfrag(BH, 32 * kq, 16 * (c0 + q), g, q4, p4);
                    garb[kq] = ldfrag(ARB, 16 * (c0 + q) + l15, 32 * kq + 8 * g);
                    gxu[kq] = ldfrag(XT, 64 + 16 * (c0 + q) + l15, 32 * kq + 8 * g);
                    gvi[kq] = trfrag(VI, 32 * kq, 16 * (c0 + q), g, q4, p4);
                    gark[kq] = ldfrag(ARK, 16 * (c0 + q) + l15, 32 * kq + 8 * g);
                }
                const u32x2 rbi = *(const u32x2*)(RB + (16 * (c0 + q) + l15) * 72 + 16 * rt_ + 4 * g);
                __builtin_amdgcn_sched_barrier(0);
                const int ctile = c0 + q;
                {
                    f32x4 acc = (f32x4){0.f, 0.f, 0.f, 0.f};
#pragma unroll
                    for (int kq = 0; kq < 2; ++kq) acc = mfma16(xw[kq], gbt[kq], acc);
                    const int dcol = 16 * ctile + l15;
                    if (rt_ == ctile) {
#pragma unroll
                        for (int r = 0; r < 4; ++r) if (4 * g + r == l15) acc[r] += 1.f;
                    }
                    acc *= (q ? gcd1 : gcd0);
                    *(u32x2*)(ALB + dcol * 72 + 32 * (rt_ >> 1) + 8 * g + 4 * (rt_ & 1)) = pk4(acc);
                }
                {
                    f32x4 acc = unpk4(rbi);
#pragma unroll
                    for (int kq = 0; kq < 2; ++kq) {
                        if (32 * kq <= 16 * ctile + 15) acc = mfma16(xw[kq], garb[kq], acc);
                    }
                    *(u32x2*)(BTL + (16 * ctile + l15) * 72 + 16 * rt_ + 4 * g) = pk4(acc);
                }
                {
                    f32x4 acc = (f32x4){0.f, 0.f, 0.f, 0.f};
#pragma unroll
                    for (int kq = 0; kq < 2; ++kq) { acc = mfma16(fbt[kq], gxu[kq], acc); acc = mfma16(fkt[kq], gvi[kq], acc); }
                    *(u32x2*)(KTL + (16 * ctile + l15) * 72 + 16 * rt_ + 4 * g) = pk4(acc * gcr);
                }
                {
                    f32x4 acc = (f32x4){0.f, 0.f, 0.f, 0.f};
#pragma unroll
                    for (int kq = 0; kq < 2; ++kq) {
                        if (32 * kq <= 16 * ctile + 15) { acc = mfma16(xu[kq], garb[kq], acc); acc = mfma16(fvr[kq], gark[kq], acc); }
                    }
                    *(u32x2*)(AAB + (16 * ctile + l15) * 72 + 16 * rt_ + 4 * g) = pk4(acc);
                }
            }
        }
        LDS_BARRIER();
        {
            const int o = t * 72 + 8 * cs;
            *(u32x4*)(P + (R0 + t) * PP + h * 64 + 8 * cs) = *(const u32x4*)(ALB + o);
            *(u32x4*)(P + (R0 + t) * PP + 1024 + h * 64 + 8 * cs) = *(const u32x4*)(BTL + o);
            *(u32x4*)(P + (R0 + t) * PP + 2048 + h * 64 + 8 * cs) = *(const u32x4*)(KTL + o);
            *(u32x4*)(Abuf + (R0 + t) * DM + h * 64 + 8 * cs) = *(const u32x4*)(AAB + o);
        }
    }
}

constexpr int SC_SLOT = 2 * IMG;
constexpr size_t WS_MG = (WS_BND + (size_t)513 * PP * 2 + 255) & ~(size_t)255;
constexpr size_t WS_NG = WS_MG + (size_t)1024 * 4096 * 2;
static_assert(WS_NG + (size_t)1024 * 4096 * 2 <= WS_GD, "scan buffers must fit the GLA state region");

template <int MODE>
__device__ void rwkv_scan2(const Params& p, unsigned char* lds) {
    constexpr int GSZ = 32, NGRP = 256 / GSZ, LG = 3;
    constexpr int SPU = (MODE == 2) ? NGRP : GSZ;
    constexpr int NU = (MODE == 2) ? 32 : 32 * NGRP;
    const int tid = threadIdx.x, lane = tid & 63, w = __builtin_amdgcn_readfirstlane(tid >> 6), l15 = lane & 15, g = lane >> 4;
    bf16_t* P = (bf16_t*)(p.ws + WS_P);
    bf16_t* MG = (bf16_t*)(p.ws + WS_MG); bf16_t* NG = (bf16_t*)(p.ws + WS_NG); bf16_t* HG = NG;
    const int G = gridDim.x;
    const int nun = ((int)blockIdx.x < NU) ? (NU - 1 - (int)blockIdx.x) / G + 1 : 0;
    const int T = nun * SPU;
    if (T == 0) return;
#define SC_SRC(s, p0, p1, pitchb) \
    const int u_ = (int)blockIdx.x + G * ((s) / SPU), j_ = (s) % SPU; \
    const char* p0; const char* p1; unsigned pitchb; \
    if (MODE == 2) { p0 = (const char*)(MG + (size_t)(u_ * NGRP + j_) * 4096); p1 = (const char*)(NG + (size_t)(u_ * NGRP + j_) * 4096); pitchb = 128u; } \
    else { const int bh_ = u_ >> LG, n_ = GSZ * (u_ & (NGRP - 1)) + j_; p0 = (const char*)(P + ((size_t)(bh_ >> 4) * SEQ + (size_t)n_ * 64) * PP + (bh_ & 15) * 64); p1 = p0 + 4096; pitchb = (unsigned)(PP * 2); }
    if (w >= 4) {
        const int lj = w - 4;
        const unsigned loff = (unsigned)((lane >> 3) * 144 + (lane & 7) * 16);
        u32x4 ld0[16], ld1[16];
#define SC_ISSUE(dst, s) do { const int sc_ = ((s) < T) ? (s) : T - 1; SC_SRC(sc_, q0_, q1_, pb_) const unsigned go_ = (unsigned)(lane >> 3) * pb_ + (unsigned)(lane & 7) * 16u; \
        _Pragma("unroll") for (int q = 0; q < 16; ++q) dst[q] = *(const u32x4*)(((q >> 3) ? q1_ : q0_) + (size_t)((q & 7) * 8) * pb_ + go_); } while (0)
#define SC_RETIRE(src, s) do { unsigned char* sb = lds + ((s) & 1) * SC_SLOT + loff; _Pragma("unroll") for (int q = 0; q < 16; ++q) \
        *(u32x4*)(sb + (q >> 3) * IMG + (q & 7) * 8 * 144) = src[q]; } while (0)
        SC_ISSUE(ld0, lj); SC_ISSUE(ld1, lj + 4);
        for (int it = 0; it < T / 8; ++it) {
            const int c0 = lj + 8 * it;
            for (int k = 0; k < lj; ++k) LDS_BARRIER();
            SC_RETIRE(ld0, c0); SC_ISSUE(ld0, c0 + 8);
            for (int k = 0; k < 4; ++k) LDS_BARRIER();
            SC_RETIRE(ld1, c0 + 4); SC_ISSUE(ld1, c0 + 12);
            for (int k = 0; k < 4 - lj; ++k) LDS_BARRIER();
        }
        LDS_BARRIER();
#undef SC_ISSUE
#undef SC_RETIRE
    } else {
        f32x4 H[4], Mg[4];
        for (int i = 0; i <= T; ++i) {
            if (i >= 1) {
                const int s = i - 1, u = (int)blockIdx.x + G * (s / SPU), j = s % SPU;
                const unsigned char* sb = lds + (s & 1) * SC_SLOT;
                const bf16_t* MT = (const bf16_t*)sb; const bf16_t* NT = (const bf16_t*)(sb + IMG);
                if (j == 0) {
                    if (MODE == 3) {
#pragma unroll
                        for (int mt = 0; mt < 4; ++mt) H[mt] = unpk4(*(const u32x2*)(HG + (size_t)u * 4096 + (16 * w + l15) * 64 + 16 * mt + 4 * g));
                    } else {
#pragma unroll
                        for (int mt = 0; mt < 4; ++mt) H[mt] = (f32x4){0.f, 0.f, 0.f, 0.f};
                    }
                    if (MODE == 1) {
#pragma unroll
                        for (int mt = 0; mt < 4; ++mt)
#pragma unroll
                            for (int r = 0; r < 4; ++r) Mg[mt][r] = (16 * mt + 4 * g + r == 16 * w + l15) ? 1.f : 0.f;
                    }
                }
                u32x2 hp[4];
#pragma unroll
                for (int mt = 0; mt < 4; ++mt) hp[mt] = pk4(H[mt]);
                if (MODE == 2) {
#pragma unroll
                    for (int mt = 0; mt < 4; ++mt) *(u32x2*)(HG + (size_t)(u * NGRP + j) * 4096 + (16 * w + l15) * 64 + 16 * mt + 4 * g) = hp[mt];
                }
                if (MODE == 3) {
                    const int bh = u >> LG, n = GSZ * (u & (NGRP - 1)) + j;
#pragma unroll
                    for (int mt = 0; mt < 4; ++mt) *(u32x2*)(P + ((size_t)(bh >> 4) * SEQ + (size_t)n * 64 + 16 * w + l15) * PP + 2048 + (bh & 15) * 64 + 16 * mt + 4 * g) = hp[mt];
                }
                bf16x8 hb[2], mb[2];
                hb[0] = as_bf16x8((u32x4){hp[0].x, hp[0].y, hp[1].x, hp[1].y});
                hb[1] = as_bf16x8((u32x4){hp[2].x, hp[2].y, hp[3].x, hp[3].y});
                if (MODE == 1) {
                    const u32x2 m0 = pk4(Mg[0]), m1 = pk4(Mg[1]), m2 = pk4(Mg[2]), m3 = pk4(Mg[3]);
                    mb[0] = as_bf16x8((u32x4){m0.x, m0.y, m1.x, m1.y}); mb[1] = as_bf16x8((u32x4){m2.x, m2.y, m3.x, m3.y});
                }
#pragma unroll
                for (int mt = 0; mt < 4; ++mt) {
                    const bf16x8 a0 = ldfrag(MT, 16 * mt + l15, 8 * g), a1 = ldfrag(MT, 16 * mt + l15, 32 + 8 * g);
                    f32x4 acc = unpk4(*(const u32x2*)(NT + (16 * w + l15) * 72 + 16 * mt + 4 * g));
                    acc = mfma16(a0, hb[0], acc); acc = mfma16(a1, hb[1], acc);
                    H[mt] = acc;
                    if (MODE == 1) { f32x4 am = mfma16(a0, mb[0], (f32x4){0.f, 0.f, 0.f, 0.f}); am = mfma16(a1, mb[1], am); Mg[mt] = am; }
                }
                if (MODE == 1 && j == SPU - 1) {
                    const int pc = 32 * (w >> 1) + 8 * (l15 >> 2) + 4 * (w & 1) + (l15 & 3);
#pragma unroll
                    for (int mt = 0; mt < 4; ++mt) {
                        *(u32x2*)(NG + (size_t)u * 4096 + (16 * w + l15) * 64 + 16 * mt + 4 * g) = pk4(H[mt]);
#pragma unroll
                        for (int r = 0; r < 4; ++r) MG[(size_t)u * 4096 + (16 * mt + 4 * g + r) * 64 + pc] = f2bf(Mg[mt][r]);
                    }
                }
            }
            LDS_BARRIER();
        }
    }
#undef SC_SRC
}

__device__ void rwkv_post(const Params& p, unsigned char* lds) {
    const int tid = threadIdx.x, lane = tid & 63, w = __builtin_amdgcn_readfirstlane(tid >> 6), l15 = lane & 15, g = lane >> 4;
    const bf16_t* P = (const bf16_t*)(p.ws + WS_P);
    bf16_t* Abuf = (bf16_t*)(p.ws + WS_A);
    const bf16_t* Ybuf = (const bf16_t*)(p.ws + WS_Y);
    const float* RK = (const float*)(p.ws + WS_RK);
    const bf16_t* BND = (const bf16_t*)(p.ws + WS_BND);
    float* L = (float*)(lds + w * 8704);
    const int tr = lane >> 3, seg = lane & 7;
    for (int hu = blockIdx.x * 8 + w; hu < 16384; hu += gridDim.x * 8) {
        const int unit = hu >> 1, t0 = (hu & 1) * 32;
        const int bn = unit >> 4, h = unit & 15, n = bn & 255;
        const size_t R0 = (size_t)bn * 64;
        bf16x8 fh[4][2], fr[2][2];
#pragma unroll
        for (int kk = 0; kk < 2; ++kk) {
#pragma unroll
            for (int q = 0; q < 4; ++q) fh[q][kk] = *(const bf16x8*)(P + (R0 + 16 * q + l15) * PP + 2048 + h * 64 + 32 * kk + 8 * g);
#pragma unroll
            for (int q = 0; q < 2; ++q) fr[q][kk] = *(const bf16x8*)(P + (R0 + t0 + 16 * q + l15) * PP + 1024 + h * 64 + 32 * kk + 8 * g);
        }
        u32x4 y0r[4], g1r[4], g0r[4], vpr[4];
        float rkv[4];
#pragma unroll
        for (int i = 0; i < 4; ++i) {
            const int t = t0 + tr + 8 * i;
            y0r[i] = *(const u32x4*)(Abuf + (R0 + t) * DM + h * 64 + 8 * seg);
            const bf16_t* grow = P + (R0 + t) * PP + 3072 + h * 64 + 8 * seg;
            g1r[i] = *(const u32x4*)grow;
            g0r[i] = *(const u32x4*)((t > 0) ? (grow - PP) : (BND + (size_t)(n == 0 ? 0 : bn) * PP + 3072 + h * 64 + 8 * seg));
            vpr[i] = *(const u32x4*)(Ybuf + (R0 + t) * DM + h * 64 + 8 * seg);
            rkv[i] = RK[(R0 + t) * 16 + h];
        }
#pragma unroll
        for (int i = 0; i < 4; ++i) { *(f32x4*)(L + (tr + 8 * i) * 68 + 8 * seg) = lo4(y0r[i]); *(f32x4*)(L + (tr + 8 * i) * 68 + 8 * seg + 4) = hi4(y0r[i]); }
        f32x4 y[4][2];
#pragma unroll
        for (int vt = 0; vt < 4; ++vt)
#pragma unroll
            for (int tt = 0; tt < 2; ++tt) y[vt][tt] = *(const f32x4*)(L + (16 * tt + l15) * 68 + 16 * vt + 4 * g);
#pragma unroll
        for (int vt = 0; vt < 4; ++vt)
#pragma unroll
            for (int tt = 0; tt < 2; ++tt)
#pragma unroll
                for (int kk = 0; kk < 2; ++kk) y[vt][tt] = mfma16(fh[vt][kk], fr[tt][kk], y[vt][tt]);
#pragma unroll
        for (int tt = 0; tt < 2; ++tt) {
            float s1 = 0.f, s2 = 0.f;
#pragma unroll
            for (int vt = 0; vt < 4; ++vt)
#pragma unroll
                for (int r = 0; r < 4; ++r) { s1 += y[vt][tt][r]; s2 += y[vt][tt][r] * y[vt][tt][r]; }
            { const int a16 = (lane ^ 16) * 4, a32 = (lane ^ 32) * 4; s1 += bperm(a16, s1); s2 += bperm(a16, s2); s1 += bperm(a32, s1); s2 += bperm(a32, s2); }
            const float mean = s1 * (1.0f / 64.0f);
            const float rstd = rsqrtf(fmaxf(s2 * (1.0f / 64.0f) - mean * mean, 0.f) + 64e-5f);
#pragma unroll
            for (int vt = 0; vt < 4; ++vt) *(f32x4*)(L + (16 * tt + l15) * 68 + 16 * vt + 4 * g) = (y[vt][tt] - mean) * rstd;
        }
        const int ch = h * 64 + 8 * seg;
        const f32x4 lw0 = *(const f32x4*)(p.in[18] + ch), lw1 = *(const f32x4*)(p.in[18] + ch + 4), lb0 = *(const f32x4*)(p.in[19] + ch), lb1 = *(const f32x4*)(p.in[19] + ch + 4);
        const f32x4 mg0 = *(const f32x4*)(p.in[10] + 3072 + ch), mg1 = *(const f32x4*)(p.in[10] + 3072 + ch + 4);
#pragma unroll
        for (int i = 0; i < 4; ++i) {
            const int t = t0 + tr + 8 * i;
            const f32x4 n0 = *(const f32x4*)(L + (tr + 8 * i) * 68 + 8 * seg), n1 = *(const f32x4*)(L + (tr + 8 * i) * 68 + 8 * seg + 4);
            const f32x4 ga0 = lo4(g1r[i]), ga1 = hi4(g1r[i]);
            const f32x4 gb0 = lo4(g0r[i]), gb1 = hi4(g0r[i]);
            const f32x4 gt0 = ga0 + mg0 * (gb0 - ga0), gt1 = ga1 + mg1 * (gb1 - ga1);
            const f32x4 v0 = lo4(vpr[i]), v1 = hi4(vpr[i]);
            f32x4 o0 = n0 * lw0 + lb0 + rkv[i] * v0, o1 = n1 * lw1 + lb1 + rkv[i] * v1;
#pragma unroll
            for (int j = 0; j < 4; ++j) { o0[j] *= gt0[j] * __builtin_amdgcn_rcpf(1.0f + fexp(-gt0[j])); o1[j] *= gt1[j] * __builtin_amdgcn_rcpf(1.0f + fexp(-gt1[j])); }
            *(u32x4*)(Abuf + (R0 + t) * DM + h * 64 + 8 * seg) = pk8(o0, o1);
        }
    }
}
#define XB_TMO      128
#define XB_XCNT(j)  (256  + 64 * (j))
#define XB_XSUB(j)  (1280 + 64 * (j))
#define XB_XGEN(j)  (2304 + 64 * (j))
#define XB_TOP      3328
#define XB_TOPGEN   3392
#define XCD_BAR_WORDS 3456
#define XB_SPIN_CAP (1u << 18)
#define LAS __attribute__((address_space(3)))

__device__ __forceinline__ unsigned xb_ld(unsigned* p)              { return __hip_atomic_load(p, __ATOMIC_RELAXED, __HIP_MEMORY_SCOPE_AGENT); }
__device__ __forceinline__ unsigned xb_add(unsigned* p, unsigned v) { return __hip_atomic_fetch_add(p, v, __ATOMIC_RELAXED, __HIP_MEMORY_SCOPE_AGENT); }
__device__ __forceinline__ unsigned xb_xcc_id() { return (unsigned)__builtin_amdgcn_s_getreg((3 << 11) | 20) & 0xFu; }
#define XB_SPIN(cond, bar) do { unsigned _sp = 0; while (cond) { __builtin_amdgcn_s_sleep(1); \
    if ((++_sp & 255u) == 0u) { if (xb_ld(&(bar)[XB_TMO])) break; if (_sp > XB_SPIN_CAP) { atomicAdd(&(bar)[XB_TMO], 1u); break; } } } } while (0)

struct XcdBarrier {
    unsigned* bar; unsigned x;
    volatile LAS unsigned* st;
};

__device__ __forceinline__ XcdBarrier xcd_barrier_post(unsigned* bar, volatile LAS unsigned* st) {
    XcdBarrier b; b.bar = bar; b.x = xb_xcc_id(); b.st = st;
    if (threadIdx.x == 0) (void)xb_add(&bar[XB_XCNT(b.x)], 1u);
    return b;
}
__device__ __forceinline__ void xcd_barrier_complete(unsigned* bar, unsigned x, unsigned& nloc, unsigned& nx) {
    const unsigned G = gridDim.x * gridDim.y * gridDim.z;
    unsigned sum, cnt, mine, sp = 0u;
    for (;;) {
        sum = 0u; cnt = 0u; mine = 0u;
#pragma unroll
        for (unsigned j = 0; j < 16; ++j) { const unsigned c = xb_ld(&bar[XB_XCNT(j)]); sum += c; cnt += (c > 0u) ? 1u : 0u; mine = (j == x) ? c : mine; }
        if (sum == G) break;
        __builtin_amdgcn_s_sleep(1);
        if ((++sp & 255u) == 0u) { if (xb_ld(&bar[XB_TMO])) break; if (sp > XB_SPIN_CAP) { atomicAdd(&bar[XB_TMO], 1u); break; } }
    }
    nloc = mine > 0u ? mine : 1u; nx = cnt > 0u ? cnt : 1u;
}

__device__ __forceinline__ void xcd_barrier(const XcdBarrier& b) {
    asm volatile("s_waitcnt vmcnt(0)" ::: "memory");
    __syncthreads();
    if (threadIdx.x == 0) {
        unsigned* bar = b.bar;
        __builtin_amdgcn_s_waitcnt(0);
        unsigned nloc = b.st[0], nx = b.st[1];
        if (nloc == 0u) { xcd_barrier_complete(bar, b.x, nloc, nx); b.st[0] = nloc; b.st[1] = nx; }
        const unsigned old = xb_add(&bar[XB_XSUB(b.x)], 1u);
        const unsigned gen = old / nloc;
        if (old + 1u == (gen + 1u) * nloc) {
            __builtin_amdgcn_fence(__ATOMIC_RELEASE, "agent");
            asm volatile("s_waitcnt vmcnt(0)" ::: "memory");
            const unsigned og = xb_add(&bar[XB_TOP], 1u);
            const unsigned tg = og / nx;
            if (og + 1u == (tg + 1u) * nx) xb_add(&bar[XB_TOPGEN], 1u);
            else XB_SPIN(xb_ld(&bar[XB_TOPGEN]) == tg, bar);
            __builtin_amdgcn_fence(__ATOMIC_ACQUIRE, "agent");
            xb_add(&bar[XB_XGEN(b.x)], 1u);
            asm volatile("s_waitcnt vmcnt(0)" ::: "memory");
        } else {
            XB_SPIN(xb_ld(&bar[XB_XGEN(b.x)]) == gen, bar);
            __builtin_amdgcn_fence(__ATOMIC_ACQUIRE, "agent");
            asm volatile("s_waitcnt vmcnt(0)" ::: "memory");
        }
    }
    __syncthreads();
}


#ifndef PROBE_ID
#define PROBE_ID 0
#endif
#ifndef N_LAUNCH_MODE
#define N_LAUNCH_MODE 1
#endif
constexpr int N_PHASES = 15;

__global__ void __launch_bounds__(NTH, 2) fwd_kernel(Params p) {
    extern __shared__ __attribute__((aligned(16))) unsigned char lds[];
    const int lo = p.ph_lo, hi = p.ph_hi;
    volatile LAS unsigned* xst = (volatile LAS unsigned*)(lds + LDS_BYTES);
    if (threadIdx.x < 4) xst[threadIdx.x] = 0u;
    __syncthreads();
    const XcdBarrier xbar = xcd_barrier_post((unsigned*)(p.ws + WS_BAR), xst);
    unsigned char* ws = p.ws;
#define IN(k) (lo <= (k) && (k) < hi)
#define SEAM(k) do { if ((k) + 1 < hi) xcd_barrier(xbar); } while (0)
    if (IN(0)) {
        prep_weight(p.in[2], GIN, p.in[1], (bf16_t*)(ws + WS_WGIN), GIN_P, (float*)lds);
        prep_weight(p.in[6], DM, nullptr, (bf16_t*)(ws + WS_WGOUT), DM, (float*)lds);
        prep_wup(p.in[3], (bf16_t*)(ws + WS_WUPT));
        __syncthreads();
        phase_norm0(p, lds);
        SEAM(0);
    }
    if (IN(1)) {
        pg8::Gemm g{(const bf16_t*)(ws + WS_A), (const bf16_t*)(ws + WS_WGIN), MTOK, GIN_P, DM}; pg8::StaticOrder S; S.init(MTOK, GIN_P, gridDim.x, blockIdx.x);
        EpiBf16GateSilu E{(bf16_t*)(ws + WS_P), GIN_P};
        pg8::gemm_phase<EpiBf16GateSilu, pg8::StaticOrder>((PG8_LAS unsigned char*)lds, g, S, E);
        SEAM(1);
    }
    if (IN(2)) { gla_pass<false>(p, lds); SEAM(2); }
    if (IN(3)) {
        gla_scan(p);
        prep_weight(p.in[9], RIN, p.in[8], (bf16_t*)(ws + WS_WRIN), RIN_P, (float*)lds);
        prep_weight(p.in[20], DM, nullptr, (bf16_t*)(ws + WS_WROUT), DM, (float*)lds);
        prep_lowrank(p.in[12], (bf16_t*)(ws + WS_WDUT));
        prep_lowrank(p.in[14], (bf16_t*)(ws + WS_WIUT));
        SEAM(3);
    }
    if (IN(4)) { gla_pass<true>(p, lds); SEAM(4); }
    if (IN(5)) {
        pg8::Gemm g{(const bf16_t*)(ws + WS_A), (const bf16_t*)(ws + WS_WGOUT), MTOK, DM, DM}; pg8::StaticOrder S; S.init(MTOK, DM, gridDim.x, blockIdx.x);
        pg8::EpiBf16<0> E{(bf16_t*)(ws + WS_Y), DM, nullptr, 0, 0};
        pg8::gemm_phase<pg8::EpiBf16<0>, pg8::StaticOrder>((PG8_LAS unsigned char*)lds, g, S, E);
        SEAM(5);
    }
    if (IN(6)) { phase_norm1(p); zero_bnd_row((bf16_t*)(ws + WS_BND)); SEAM(6); }
    if (IN(7)) {
        pg8::Gemm g{(const bf16_t*)(ws + WS_A), (const bf16_t*)(ws + WS_WRIN), MTOK, RIN_P, DM}; pg8::StaticOrder S; S.init(MTOK, RIN_P, gridDim.x, blockIdx.x);
        EpiBf16Bnd E{(bf16_t*)(ws + WS_P), RIN_P, (bf16_t*)(ws + WS_BND)};
        pg8::gemm_phase<EpiBf16Bnd, pg8::StaticOrder>((PG8_LAS unsigned char*)lds, g, S, E);
        SEAM(7);
    }
    if (IN(8)) { rwkv_r1(p, lds); SEAM(8); }
    if (IN(9)) { rwkv_scan2<1>(p, lds); SEAM(9); }
    if (IN(10)) { rwkv_scan2<2>(p, lds); SEAM(10); }
    if (IN(11)) { rwkv_scan2<3>(p, lds); SEAM(11); }
    if (IN(12)) { rwkv_post(p, lds); SEAM(12); }
    if (IN(13)) {
        pg8::Gemm g{(const bf16_t*)(ws + WS_A), (const bf16_t*)(ws + WS_WROUT), MTOK, DM, DM}; pg8::StaticOrder S; S.init(MTOK, DM, gridDim.x, blockIdx.x);
        pg8::EpiBf16<0> E{(bf16_t*)(ws + WS_Y), DM, nullptr, 0, 0};
        pg8::gemm_phase<pg8::EpiBf16<0>, pg8::StaticOrder>((PG8_LAS unsigned char*)lds, g, S, E);
        SEAM(13);
    }
    if (IN(14)) { phase_final(p); }
#undef IN
#undef SEAM
}

extern "C" void kernel_launch(void* const* d_in, const int* in_sizes, int n_in, void* d_out, int out_size, void* d_ws, size_t ws_size, hipStream_t stream) {
    static int grid = 0;
    if (grid == 0) {
        int dev = 0, cus = 0, per_cu = 0;
        hipGetDevice(&dev);
        hipDeviceGetAttribute(&cus, hipDeviceAttributeMultiprocessorCount, dev);
        hipFuncSetAttribute((const void*)fwd_kernel, hipFuncAttributeMaxDynamicSharedMemorySize, LDS_BYTES + 16);
        hipOccupancyMaxActiveBlocksPerMultiprocessor(&per_cu, (const void*)fwd_kernel, NTH, LDS_BYTES + 16);
        if (per_cu < 1) { fprintf(stderr, "kernel_launch: occupancy query says %d blocks per CU\n", per_cu); per_cu = 1; }
        grid = cus;
        if (n_in != 22 || ws_size < WS_END) fprintf(stderr, "kernel_launch: unexpected n_in %d or workspace %zu < %zu\n", n_in, ws_size, (size_t)WS_END);
        (void)hipGetLastError();
    }
    if (hipMemsetAsync((char*)d_ws + WS_BAR, 0, XCD_BAR_WORDS * 4, stream) != hipSuccess) fprintf(stderr, "kernel_launch: memset of the barrier words failed\n");
    Params p{};
    for (int i = 0; i < 22; ++i) p.in[i] = (const float*)d_in[i];
    p.out = (float*)d_out; p.ws = (unsigned char*)d_ws;
#if N_LAUNCH_MODE == 1
    void* args[] = {&p};
#if PROBE_ID > 0
    p.ph_lo = 0; p.ph_hi = PROBE_ID;
    (void)hipLaunchCooperativeKernel((const void*)fwd_kernel, dim3(grid), dim3(NTH), args, LDS_BYTES + 16, stream);
    (void)hipMemsetAsync((char*)d_ws + WS_BAR, 0, XCD_BAR_WORDS * 4, stream);
#endif
    p.ph_lo = 0; p.ph_hi = N_PHASES;
    hipError_t e = hipLaunchCooperativeKernel((const void*)fwd_kernel, dim3(grid), dim3(NTH), args, LDS_BYTES + 16, stream);
    if (e != hipSuccess) fprintf(stderr, "cooperative launch failed: %s (grid %d)\n", hipGetErrorString(e), grid);
#else
    for (int k = 0; k < N_PHASES; ++k) {
        p.ph_lo = k; p.ph_hi = k + 1;
        hipLaunchKernelGGL(fwd_kernel, dim3(grid), dim3(NTH), LDS_BYTES + 16, stream, p);
    }
#endif
}
```

```cpp
#include <hip/hip_runtime.h>
#include <hip/hip_cooperative_groups.h>
#include <cstdio>
namespace cg = cooperative_groups;
#define PROBE_ID 0
#define N_LAUNCH_MODE 1
namespace pg8 {
#define PG8_LAS __attribute__((address_space(3)))
typedef unsigned short bf16_t;
typedef short bf16x8 __attribute__((ext_vector_type(8)));
typedef float f32x4 __attribute__((ext_vector_type(4)));
typedef unsigned u32x4 __attribute__((ext_vector_type(4)));
constexpr int BM = 256, BK = 64, HALF = 128, HTB = HALF * BK * 2  , STAGE_BYTES = 8 * HTB, NXCD = 8, WGM = 8;

__host__ __device__ __forceinline__ int lds_byte(int r, int c) { const int st = (r >> 4) * 2 + (c >> 5), rr = r & 15, cc = c & 31, ob = rr * 64 + cc * 2; return st * 1024 + (ob ^ (((ob >> 9) & 1) << 5)); }
__host__ __device__ __forceinline__ void stage_rc(int b, int& R, int& C) { const int st = b / 1024, sb = b % 1024, swz = sb ^ (((sb >> 9) & 1) << 5); R = (st >> 1) * 16 + swz / 64; C = (st & 1) * 32 + (swz % 64) / 2; }
__host__ __device__ __forceinline__ int perm32(int rho) { const int n = rho >> 4, i = rho & 15; return 8 * (i >> 2) + 4 * n + (i & 3); }

struct Unit { int pm, pn; };
struct Gemm { const bf16_t* A; const bf16_t* Bt; int M, N, K; };

struct StaticOrder {
    int nM, nN, nwg, G, c;
    __host__ __device__ void init(int M, int N, int G_, int c_) { nM = M / BM; nN = N / BM; nwg = nM * nN; G = G_; c = c_; }
    __host__ __device__ bool next(int i, Unit& u) const {
        const long L = (long)i * G + c; if (L >= nwg) return false;
        int wgid = (int)L; { const int q = nwg / NXCD, r = nwg % NXCD, xcd = wgid % NXCD, off = wgid / NXCD; wgid = (xcd < r ? xcd * (q + 1) : r * (q + 1) + (xcd - r) * q) + off; }
        const int nig = WGM * nN, gid = wgid / nig, fm = gid * WGM, gsz = (nM - fm) < WGM ? (nM - fm) : WGM;
        u.pm = fm + ((wgid % nig) % gsz); u.pn = (wgid % nig) / gsz; return true;
    }
    __device__ __forceinline__ void a_ready(const Unit&) const {}
    __device__ __forceinline__ void done(const Unit&) const {}
};

typedef float cvt_f32x2 __attribute__((ext_vector_type(2)));
typedef __bf16 cvt_bf16x2 __attribute__((ext_vector_type(2)));
__device__ __forceinline__ unsigned cvt_pk_bf16(float lo, float hi) { const cvt_f32x2 v = {lo, hi}; union { cvt_bf16x2 b; unsigned u; } x; x.b = __builtin_convertvector(v, cvt_bf16x2); return x.u; }
typedef float f32x2 __attribute__((ext_vector_type(2)));
struct EpiF32 {
    static constexpr bool PERM = false, AFTER_DRAIN = false;
    float* C; int ldc; const float* bias;
    __device__ __forceinline__ void operator()(const f32x4 (&acc)[2][2][4][2], const Unit& u, int wr, int wc, int fr, int fq) const {
        const int row0 = u.pm * BM + wr * 64 + fr, col0 = u.pn * BM + wc * 32 + 4 * fq;
        f32x4 bv[2][2];
#pragma unroll
        for (int bj = 0; bj < 2; ++bj)
#pragma unroll
            for (int n = 0; n < 2; ++n) bv[bj][n] = bias ? *(const f32x4*)(bias + col0 + bj * HALF + n * 16) : (f32x4){0.f, 0.f, 0.f, 0.f};
#pragma unroll
        for (int ai = 0; ai < 2; ++ai)
#pragma unroll
            for (int m = 0; m < 4; ++m) { float* rowp = C + (size_t)(row0 + ai * HALF + m * 16) * ldc + col0;
#pragma unroll
                for (int bj = 0; bj < 2; ++bj)
#pragma unroll
                    for (int n = 0; n < 2; ++n) *(f32x4*)(rowp + bj * HALF + n * 16) = acc[ai][bj][m][n] + bv[bj][n]; }
    }
};
template <int ACT  > struct EpiBf16 {
    static constexpr bool PERM = true, AFTER_DRAIN = false;
    bf16_t* O; int ldc; const float* bias; int split_cols; size_t split_stride;
    __device__ __forceinline__ void operator()(const f32x4 (&acc)[2][2][4][2], const Unit& u, int wr, int wc, int fr, int fq) const {
        const int row0 = u.pm * BM + wr * 64 + fr; int colt = u.pn * BM; bf16_t* base = O;
        if (split_cols) { const int t = colt / split_cols; base += (size_t)t * split_stride; colt -= t * split_cols; }
        const int col0 = colt + wc * 32 + 8 * fq, bcol0 = u.pn * BM + wc * 32 + 8 * fq;
        f32x4 bv[2][2];
#pragma unroll
        for (int bj = 0; bj < 2; ++bj)
#pragma unroll
            for (int n = 0; n < 2; ++n) bv[bj][n] = bias ? *(const f32x4*)(bias + bcol0 + bj * HALF + 4 * n) : (f32x4){0.f, 0.f, 0.f, 0.f};
#pragma unroll
        for (int ai = 0; ai < 2; ++ai)
#pragma unroll
            for (int m = 0; m < 4; ++m) { bf16_t* rowp = base + (size_t)(row0 + ai * HALF + m * 16) * ldc + col0;
#pragma unroll
                for (int bj = 0; bj < 2; ++bj) { f32x4 v0 = acc[ai][bj][m][0] + bv[bj][0], v1 = acc[ai][bj][m][1] + bv[bj][1];
                    u32x4 w; w.x = cvt_pk_bf16(v0[0], v0[1]); w.y = cvt_pk_bf16(v0[2], v0[3]); w.z = cvt_pk_bf16(v1[0], v1[1]); w.w = cvt_pk_bf16(v1[2], v1[3]);
                    *(u32x4*)(rowp + bj * HALF) = w; } }
    }
};

template <class Epi, class Sched>
__device__ __forceinline__ void gemm_phase(PG8_LAS unsigned char* lds, const Gemm g, const Sched& S, const Epi& E) {
    const int tid = threadIdx.x, wid = __builtin_amdgcn_readfirstlane(tid >> 6), lane = tid & 63, wr = wid >> 2, wc = wid & 3, fr = lane & 15, fq = lane >> 4;
    const int K = g.K, nt = K / BK;
    unsigned voffA[2], voffB[2];
#pragma unroll
    for (int i = 0; i < 2; ++i) { int R, C; stage_rc(tid * 16 + i * 8192, R, C); const int Rb = Epi::PERM ? ((R & ~31) + perm32(R & 31)) : R;
        voffA[i] = (unsigned)(R * K + C) * 2u; voffB[i] = (unsigned)(Rb * K + C) * 2u; }
    const size_t kstep = (size_t)(BK * 2);
    const size_t hstep = (size_t)HALF * K * 2;
    const size_t tstep = 2 * hstep;
    const unsigned ldsw = (unsigned)wid * 1024u;
    const int aoff = lds_byte(wr * 64 + fr, fq * 8), boff = lds_byte(wc * 32 + fr, fq * 8);
#define PG8_SA(b, h) (((b) * 2 + (h)) * HTB)
#define PG8_SB(b, h) ((4 + (b) * 2 + (h)) * HTB)
#define PG8_STAGE(bufoff, gbase, voff) do { _Pragma("unroll") for (int _i = 0; _i < 2; ++_i) \
        __builtin_amdgcn_global_load_lds((const unsigned*)((const char*)(gbase) + (voff)[_i]), (PG8_LAS unsigned*)(lds + (bufoff) + ldsw + _i * 8192), 16, 0, 0); } while (0)
#define PG8_LDA(dst, b, h) do { _Pragma("unroll") for (int m = 0; m < 4; ++m) _Pragma("unroll") for (int k = 0; k < 2; ++k) dst[m][k] = *(const PG8_LAS bf16x8*)(lds + PG8_SA(b, h) + aoff + m * 2048 + k * 1024); } while (0)
#define PG8_LDB(dst, b, h) do { _Pragma("unroll") for (int n = 0; n < 2; ++n) _Pragma("unroll") for (int k = 0; k < 2; ++k) dst[n][k] = *(const PG8_LAS bf16x8*)(lds + PG8_SB(b, h) + boff + n * 2048 + k * 1024); } while (0)
#define PG8_MMA(ai, bj, At, Bt) do { __builtin_amdgcn_s_setprio(1); _Pragma("unroll") for (int m = 0; m < 4; ++m) _Pragma("unroll") for (int n = 0; n < 2; ++n) _Pragma("unroll") for (int k = 0; k < 2; ++k) \
        acc[ai][bj][m][n] = __builtin_amdgcn_mfma_f32_16x16x32_bf16(Bt[n][k], At[m][k], acc[ai][bj][m][n], 0, 0, 0); __builtin_amdgcn_s_setprio(0); } while (0)
#define PG8_WAIT_V(n) asm volatile("s_waitcnt vmcnt(" #n ")" ::: "memory")
#define PG8_WAIT_L(n) asm volatile("s_waitcnt lgkmcnt(" #n ")" ::: "memory")
#define PG8_BAR __builtin_amdgcn_s_barrier()
#define PG8_SCHED __builtin_amdgcn_sched_barrier(0)
    Unit cur, nxt; int ui = 0;
    if (!S.next(0, cur)) return;
    f32x4 acc[2][2][4][2];
#pragma unroll
    for (int a = 0; a < 2; ++a)
#pragma unroll
        for (int b = 0; b < 2; ++b)
#pragma unroll
            for (int m = 0; m < 4; ++m)
#pragma unroll
                for (int n = 0; n < 2; ++n) acc[a][b][m][n] = (f32x4){0.f, 0.f, 0.f, 0.f};
    bf16x8 At[4][2], B0[2][2], B1[2][2];
    const char* cA = (const char*)g.A + (size_t)cur.pm * tstep; const char* cB = (const char*)g.Bt + (size_t)cur.pn * tstep;
    S.a_ready(cur);
    PG8_STAGE(PG8_SB(0, 0), cB, voffB); PG8_STAGE(PG8_SA(0, 0), cA, voffA); PG8_STAGE(PG8_SB(0, 1), cB + hstep, voffB); PG8_STAGE(PG8_SA(0, 1), cA + hstep, voffA);
    if (wr == 1) PG8_BAR;
    PG8_WAIT_V(4); PG8_BAR;
    PG8_STAGE(PG8_SB(1, 0), cB + kstep, voffB); PG8_STAGE(PG8_SA(1, 0), cA + kstep, voffA); PG8_STAGE(PG8_SB(1, 1), cB + hstep + kstep, voffB);
    PG8_WAIT_V(6); PG8_BAR;
    for (;;) {
        const bool has_next = S.next(ui + 1, nxt);
        const char* nA = has_next ? (const char*)g.A + (size_t)nxt.pm * tstep : cA; const char* nB = has_next ? (const char*)g.Bt + (size_t)nxt.pn * tstep : cB;
        for (int t = 0; t < nt; t += 2) {
            const bool last = (t == nt - 2);
            const char* a1 = cA + (size_t)(t + 1) * kstep;
            const char* a2 = last ? nA : cA + (size_t)(t + 2) * kstep; const char* b2 = last ? nB : cB + (size_t)(t + 2) * kstep;
            const char* a3 = a2 + kstep; const char* b3 = b2 + kstep;
            if (last && has_next) S.a_ready(nxt);
            PG8_LDB(B0, 0, 0); PG8_SCHED; PG8_LDA(At, 0, 0); PG8_STAGE(PG8_SA(1, 1), a1 + hstep, voffA);
            PG8_WAIT_L(8); PG8_BAR; PG8_WAIT_L(0); PG8_MMA(0, 0, At, B0); PG8_BAR; PG8_SCHED;
            PG8_LDB(B1, 0, 1); PG8_STAGE(PG8_SB(0, 0), b2, voffB);
            PG8_BAR; PG8_WAIT_L(0); PG8_MMA(0, 1, At, B1); PG8_BAR;
            PG8_LDA(At, 0, 1); PG8_STAGE(PG8_SA(0, 0), a2, voffA);
            PG8_BAR; PG8_WAIT_L(0); PG8_MMA(1, 0, At, B0); PG8_BAR; PG8_SCHED;
            PG8_STAGE(PG8_SB(0, 1), b2 + hstep, voffB);
            PG8_WAIT_V(6); PG8_BAR; PG8_MMA(1, 1, At, B1); PG8_BAR;
            PG8_LDB(B0, 1, 0); PG8_SCHED; PG8_LDA(At, 1, 0); PG8_STAGE(PG8_SA(0, 1), a2 + hstep, voffA);
            PG8_WAIT_L(8); PG8_BAR; PG8_WAIT_L(0); PG8_MMA(0, 0, At, B0); PG8_BAR; PG8_SCHED;
            PG8_LDB(B1, 1, 1); PG8_STAGE(PG8_SB(1, 0), b3, voffB);
            PG8_BAR; PG8_WAIT_L(0); PG8_MMA(0, 1, At, B1); PG8_BAR;
            PG8_LDA(At, 1, 1); PG8_STAGE(PG8_SA(1, 0), a3, voffA);
            PG8_BAR; PG8_WAIT_L(0); PG8_MMA(1, 0, At, B0); PG8_BAR; PG8_SCHED;
            PG8_STAGE(PG8_SB(1, 1), b3 + hstep, voffB);
            PG8_WAIT_V(6); PG8_BAR; PG8_MMA(1, 1, At, B1); PG8_BAR;
        }
        if constexpr (!Epi::AFTER_DRAIN) { E(acc, cur, wr, wc, fr, fq); S.done(cur); }
        if (!has_next) break;
#pragma unroll
        for (int a = 0; a < 2; ++a)
#pragma unroll
            for (int b = 0; b < 2; ++b)
#pragma unroll
                for (int m = 0; m < 4; ++m)
#pragma unroll
                    for (int n = 0; n < 2; ++n) acc[a][b][m][n] = (f32x4){0.f, 0.f, 0.f, 0.f};
        cur = nxt; cA = nA; cB = nB; ++ui;
    }
    PG8_WAIT_V(0);
    if (wr == 0) PG8_BAR;
    PG8_BAR;
    if constexpr (Epi::AFTER_DRAIN) { E.fused(acc, cur, wr, wc, fr, fq, lds, wid, lane); S.done(cur); }
#undef PG8_SA
#undef PG8_SB
#undef PG8_STAGE
#undef PG8_LDA
#undef PG8_LDB
#undef PG8_MMA
#undef PG8_WAIT_V
#undef PG8_WAIT_L
#undef PG8_BAR
#undef PG8_SCHED
}
}


typedef unsigned short bf16_t;
typedef short bf16x8 __attribute__((ext_vector_type(8)));
typedef float f32x4 __attribute__((ext_vector_type(4)));
typedef unsigned u32x4 __attribute__((ext_vector_type(4)));
typedef unsigned u32x2 __attribute__((ext_vector_type(2)));

constexpr int MTOK = 32768, DM = 1024, SEQ = 16384, NTH = 512;
constexpr int GIN = 3088, GIN_P = 3072, RIN = 4224, RIN_P = 4352;
constexpr int LDS_BYTES = 147456;

constexpr size_t WS_WGIN  = 0;
constexpr size_t WS_WGOUT = WS_WGIN  + (size_t)GIN_P * DM * 2;
constexpr size_t WS_WRIN  = WS_WGOUT + (size_t)DM * DM * 2;
constexpr size_t WS_WROUT = WS_WRIN  + (size_t)RIN_P * DM * 2;
constexpr size_t WS_WDUT  = WS_WROUT + (size_t)DM * DM * 2;
constexpr size_t WS_WIUT  = WS_WDUT  + (size_t)DM * 64 * 2;
constexpr size_t WS_WUPT  = WS_WIUT  + (size_t)DM * 64 * 2;
constexpr size_t WS_A     = WS_WUPT  + (size_t)512 * 16 * 2;
constexpr size_t WS_Y     = WS_A     + (size_t)MTOK * DM * 2;
constexpr size_t WS_GS    = WS_Y     + (size_t)MTOK * DM * 2;
constexpr size_t WS_GD    = WS_GS    + (size_t)24 * 1024 * 1024;
constexpr size_t WS_P     = WS_GD    + (size_t)8 * 32 * 128 * 4;
constexpr size_t WS_BAR   = WS_P     + (size_t)MTOK * RIN_P * 2;
constexpr size_t WS_AD    = WS_BAR   + 16384;
constexpr size_t WS_X1    = WS_AD    + (size_t)MTOK * 16 * 2;
constexpr size_t WS_DUMMY = WS_X1    + (size_t)MTOK * DM * 2;
constexpr size_t WS_END   = WS_DUMMY + 65536;
static_assert(WS_END <= (size_t)512 * 1024 * 1024, "workspace budget (4 x the largest tensor)");

struct Params { const float* in[22]; float* out; unsigned char* ws; int ph_lo, ph_hi; };

__device__ __forceinline__ float bf2f(unsigned b) { return __uint_as_float(b << 16); }
__device__ __forceinline__ bf16_t f2bf(float f) { unsigned u = __float_as_uint(f); u += 0x7FFFu + ((u >> 16) & 1u); return (bf16_t)(u >> 16); }
__device__ __forceinline__ unsigned pk2(float lo, float hi) { return pg8::cvt_pk_bf16(lo, hi); }
__device__ __forceinline__ float wave_sum(float x) {
#pragma unroll
    for (int off = 32; off >= 1; off >>= 1) x += __shfl_xor(x, off);
    return x;
}
__device__ __forceinline__ float bperm(int byte_addr, float x) { return __int_as_float(__builtin_amdgcn_ds_bpermute(byte_addr, __float_as_int(x))); }
template <int CTRL> __device__ __forceinline__ float dpp_mov(float x) { return __int_as_float(__builtin_amdgcn_update_dpp(0, __float_as_int(x), CTRL, 0xF, 0xF, true)); }
__device__ __forceinline__ float sum8(float x) { x += dpp_mov<0xB1>(x); x += dpp_mov<0x4E>(x); x += dpp_mov<0x141>(x); return x; }
__device__ __forceinline__ f32x4 mfma16(bf16x8 a, bf16x8 b, f32x4 c) { return __builtin_amdgcn_mfma_f32_16x16x32_bf16(a, b, c, 0, 0, 0); }
__device__ __forceinline__ bf16x8 as_bf16x8(u32x4 v) { union { u32x4 u; bf16x8 b; } x; x.u = v; return x.b; }
__device__ __forceinline__ float fexp(float x) { return __builtin_amdgcn_exp2f(x * 1.4426950408889634f); }
__device__ __forceinline__ float flog(float x) { return __builtin_amdgcn_logf(x) * 0.6931471805599453f; }
__device__ __forceinline__ float log_sigmoid(float z) { return fminf(z, 0.f) - log1pf(fexp(-fabsf(z))); }
__device__ __forceinline__ float softplus(float z) { return fmaxf(z, 0.f) + log1pf(fexp(-fabsf(z))); }

__device__ void prep_weight(const float* __restrict__ W, int N, const float* __restrict__ gain, bf16_t* __restrict__ Wt, int NP, float* tile) {
    const int tid = threadIdx.x;
    const int nu = (NP / 64) * 16;
    const int lk = tid >> 4, lq = tid & 15;
    const int sn = tid >> 3, ss = tid & 7;
    float4 v[2];
#define PW_LOAD(u_) do { const int n0_ = ((u_) >> 4) * 64, k0_ = ((u_) & 15) * 64; _Pragma("unroll") for (int r = 0; r < 2; ++r) { const int k = k0_ + lk + 32 * r, n = n0_ + 4 * lq; \
        float4 x_ = make_float4(0.f, 0.f, 0.f, 0.f); if (n < N) { x_ = *(const float4*)(W + (size_t)k * N + n); if (gain) { const float g_ = gain[k]; x_.x *= g_; x_.y *= g_; x_.z *= g_; x_.w *= g_; } } v[r] = x_; } } while (0)
    int u = blockIdx.x;
    if (u < nu) PW_LOAD(u);
    for (; u < nu; u += gridDim.x) {
        const int n0 = (u >> 4) * 64, k0 = (u & 15) * 64;
#pragma unroll
        for (int r = 0; r < 2; ++r) *(float4*)(tile + (lk + 32 * r) * 68 + 4 * lq) = v[r];
        if (u + (int)gridDim.x < nu) PW_LOAD(u + gridDim.x);
        __syncthreads();
        {
            float e[8];
#pragma unroll
            for (int q = 0; q < 8; ++q) e[q] = tile[(8 * ss + q) * 68 + sn];
            *(u32x4*)(Wt + (size_t)(n0 + sn) * DM + k0 + 8 * ss) = (u32x4){pk2(e[0], e[1]), pk2(e[2], e[3]), pk2(e[4], e[5]), pk2(e[6], e[7])};
        }
        __syncthreads();
    }
#undef PW_LOAD
}

__device__ void prep_lowrank(const float* __restrict__ src, bf16_t* __restrict__ dst) {
    for (int idx = blockIdx.x * NTH + threadIdx.x; idx < 65536; idx += gridDim.x * NTH) dst[idx] = f2bf(src[(idx & 63) * 1024 + (idx >> 6)]);
}

__device__ void zero_bnd_row(bf16_t* bnd) {
    if (blockIdx.x == 0) for (int i = threadIdx.x; i < RIN_P / 2; i += NTH) ((unsigned*)bnd)[i] = 0u;
}

__device__ void prep_wup(const float* __restrict__ src, bf16_t* __restrict__ dst) {
    for (int idx = blockIdx.x * NTH + threadIdx.x; idx < 8192; idx += gridDim.x * NTH) dst[idx] = f2bf(src[(idx & 15) * 512 + (idx >> 4)]);
}

struct EpiBf16GateSilu {
    static constexpr bool PERM = true, AFTER_DRAIN = false;
    bf16_t* O; int ldc;
    __device__ __forceinline__ void operator()(const f32x4 (&acc)[2][2][4][2], const pg8::Unit& u, int wr, int wc, int fr, int fq) const {
        const int row0 = u.pm * pg8::BM + wr * 64 + fr, col0 = u.pn * pg8::BM + wc * 32 + 8 * fq;
        const bool act = u.pn >= 8;
#pragma unroll
        for (int ai = 0; ai < 2; ++ai)
#pragma unroll
            for (int m = 0; m < 4; ++m) {
                bf16_t* rowp = O + (size_t)(row0 + ai * pg8::HALF + m * 16) * ldc + col0;
#pragma unroll
                for (int bj = 0; bj < 2; ++bj) {
                    f32x4 v0 = acc[ai][bj][m][0], v1 = acc[ai][bj][m][1];
                    if (act) {
#pragma unroll
                        for (int j = 0; j < 4; ++j) { v0[j] *= __builtin_amdgcn_rcpf(1.0f + fexp(-v0[j])); v1[j] *= __builtin_amdgcn_rcpf(1.0f + fexp(-v1[j])); }
                    }
                    u32x4 wv; wv.x = pk2(v0[0], v0[1]); wv.y = pk2(v0[2], v0[3]); wv.z = pk2(v1[0], v1[1]); wv.w = pk2(v1[2], v1[3]);
                    *(u32x4*)(rowp + bj * pg8::HALF) = wv;
                }
            }
    }
};

struct EpiBf16Bnd {
    static constexpr bool PERM = true, AFTER_DRAIN = false;
    bf16_t* O; int ldc; bf16_t* bnd;
    __device__ __forceinline__ void operator()(const f32x4 (&acc)[2][2][4][2], const pg8::Unit& u, int wr, int wc, int fr, int fq) const {
        const int row0 = u.pm * pg8::BM + wr * 64 + fr, col0 = u.pn * pg8::BM + wc * 32 + 8 * fq;
#pragma unroll
        for (int ai = 0; ai < 2; ++ai)
#pragma unroll
            for (int m = 0; m < 4; ++m) {
                const int row = row0 + ai * pg8::HALF + m * 16;
                bf16_t* rowp = O + (size_t)row * ldc + col0;
#pragma unroll
                for (int bj = 0; bj < 2; ++bj) {
                    const f32x4 v0 = acc[ai][bj][m][0], v1 = acc[ai][bj][m][1];
                    u32x4 wv; wv.x = pk2(v0[0], v0[1]); wv.y = pk2(v0[2], v0[3]); wv.z = pk2(v1[0], v1[1]); wv.w = pk2(v1[2], v1[3]);
                    *(u32x4*)(rowp + bj * pg8::HALF) = wv;
                    if (m == 3 && fr == 15) *(u32x4*)(bnd + (size_t)((row >> 6) + 1) * ldc + col0 + bj * pg8::HALF) = wv;
                }
            }
    }
};

__device__ void phase_norm0(const Params& p, unsigned char* lds) {
    const int tid = threadIdx.x, lane = tid & 63, w = tid >> 6, l15 = lane & 15, g = lane >> 4;
    const float* x = p.in[0];
    bf16_t* A = (bf16_t*)(p.ws + WS_A);
    bf16_t* AD = (bf16_t*)(p.ws + WS_AD);
    bf16_t* WAD = (bf16_t*)lds;
    float* PSS = (float*)(lds + 33024);
    float* PAD = (float*)(lds + 33024 + 512);
    for (int e = tid; e < 16384; e += NTH) { const int k = e >> 4, j = e & 15; WAD[j * 1032 + k] = f2bf(p.in[2][(size_t)k * GIN + 3072 + j] * p.in[1][k]); }
    __syncthreads();
    bf16x8 wf[4];
#pragma unroll
    for (int kk = 0; kk < 4; ++kk) wf[kk] = *(const bf16x8*)(WAD + l15 * 1032 + 128 * w + 32 * kk + 8 * g);
    float4 xa[4][2];
    int tile = blockIdx.x;
    if (tile < MTOK / 16) {
#pragma unroll
        for (int kk = 0; kk < 4; ++kk) { const float4* s = (const float4*)(x + (size_t)(16 * tile + l15) * DM + 128 * w + 32 * kk + 8 * g); xa[kk][0] = s[0]; xa[kk][1] = s[1]; }
    }
    for (; tile < MTOK / 16; tile += gridDim.x) {
        float4 xv[4][2];
#pragma unroll
        for (int kk = 0; kk < 4; ++kk) { xv[kk][0] = xa[kk][0]; xv[kk][1] = xa[kk][1]; }
        if (tile + (int)gridDim.x < MTOK / 16) {
#pragma unroll
            for (int kk = 0; kk < 4; ++kk) { const float4* s = (const float4*)(x + (size_t)(16 * (tile + gridDim.x) + l15) * DM + 128 * w + 32 * kk + 8 * g); xa[kk][0] = s[0]; xa[kk][1] = s[1]; }
        }
        float ss = 0.f;
        f32x4 acc = (f32x4){0.f, 0.f, 0.f, 0.f};
#pragma unroll
        for (int kk = 0; kk < 4; ++kk) {
            const float4 a = xv[kk][0], b = xv[kk][1];
            ss += a.x * a.x + a.y * a.y + a.z * a.z + a.w * a.w + b.x * b.x + b.y * b.y + b.z * b.z + b.w * b.w;
            acc = mfma16(as_bf16x8((u32x4){pk2(a.x, a.y), pk2(a.z, a.w), pk2(b.x, b.y), pk2(b.z, b.w)}), wf[kk], acc);
        }
        ss += __shfl_xor(ss, 16); ss += __shfl_xor(ss, 32);
        if (g == 0) PSS[w * 16 + l15] = ss;
        *(f32x4*)(PAD + (w * 64 + lane) * 4) = acc;
        __syncthreads();
        float tot = 0.f;
#pragma unroll
        for (int q = 0; q < 8; ++q) tot += PSS[q * 16 + l15];
        const float rstd = rsqrtf(tot * (1.0f / DM) + 1e-6f);
#pragma unroll
        for (int kk = 0; kk < 4; ++kk) {
            const float4 a = xv[kk][0], b = xv[kk][1];
            *(u32x4*)(A + (size_t)(16 * tile + l15) * DM + 128 * w + 32 * kk + 8 * g) = (u32x4){pk2(a.x * rstd, a.y * rstd), pk2(a.z * rstd, a.w * rstd), pk2(b.x * rstd, b.y * rstd), pk2(b.z * rstd, b.w * rstd)};
        }
        if (w == 0) {
            f32x4 s = (f32x4){0.f, 0.f, 0.f, 0.f};
#pragma unroll
            for (int q = 0; q < 8; ++q) s += *(const f32x4*)(PAD + (q * 64 + lane) * 4);
#pragma unroll
            for (int r = 0; r < 4; ++r) AD[(size_t)(16 * tile + 4 * g + r) * 16 + l15] = f2bf(s[r] * __shfl(rstd, 4 * g + r));
        }
        __syncthreads();
    }
}

__device__ void phase_norm1(const Params& p) {
    const int tid = threadIdx.x, lane = tid & 63, w = tid >> 6;
    const float* x = p.in[0];
    const float* gpost = p.in[7];
    const bf16_t* Y = (const bf16_t*)(p.ws + WS_Y);
    bf16_t* A = (bf16_t*)(p.ws + WS_A);
    bf16_t* X1 = (bf16_t*)(p.ws + WS_X1);
    float4 gp[4];
#pragma unroll
    for (int i = 0; i < 4; ++i) gp[i] = ((const float4*)gpost)[lane + 64 * i];
    const int stride = gridDim.x * 8;
    float4 vn[4]; u32x2 yn[4];
    {
        const int row = blockIdx.x * 8 + w;
#pragma unroll
        for (int i = 0; i < 4; ++i) { vn[i] = ((const float4*)(x + (size_t)row * DM))[lane + 64 * i]; yn[i] = *(const u32x2*)(Y + (size_t)row * DM + 4 * (lane + 64 * i)); }
    }
    for (int row = blockIdx.x * 8 + w; row < MTOK; row += stride) {
        float4 v[4]; u32x2 yv[4];
#pragma unroll
        for (int i = 0; i < 4; ++i) { v[i] = vn[i]; yv[i] = yn[i]; }
        if (row + stride < MTOK) {
#pragma unroll
            for (int i = 0; i < 4; ++i) { vn[i] = ((const float4*)(x + (size_t)(row + stride) * DM))[lane + 64 * i]; yn[i] = *(const u32x2*)(Y + (size_t)(row + stride) * DM + 4 * (lane + 64 * i)); }
        }
        float4 y[4];
        float ss = 0.f;
#pragma unroll
        for (int i = 0; i < 4; ++i) {
            y[i].x = bf2f(yv[i].x & 0xffffu); y[i].y = bf2f(yv[i].x >> 16); y[i].z = bf2f(yv[i].y & 0xffffu); y[i].w = bf2f(yv[i].y >> 16);
            ss += y[i].x * y[i].x + y[i].y * y[i].y + y[i].z * y[i].z + y[i].w * y[i].w;
        }
        ss = wave_sum(ss);
        const float rstdy = rsqrtf(ss * (1.0f / DM) + 1e-6f);
        float s1 = 0.f;
#pragma unroll
        for (int i = 0; i < 4; ++i) {
            v[i].x += y[i].x * rstdy * gp[i].x; v[i].y += y[i].y * rstdy * gp[i].y; v[i].z += y[i].z * rstdy * gp[i].z; v[i].w += y[i].w * rstdy * gp[i].w;
            s1 += v[i].x * v[i].x + v[i].y * v[i].y + v[i].z * v[i].z + v[i].w * v[i].w;
            u32x2 xo; xo.x = pk2(v[i].x, v[i].y); xo.y = pk2(v[i].z, v[i].w);
            *(u32x2*)(X1 + (size_t)row * DM + 4 * (lane + 64 * i)) = xo;
        }
        s1 = wave_sum(s1);
        const float rstd = rsqrtf(s1 * (1.0f / DM) + 1e-6f);
#pragma unroll
        for (int i = 0; i < 4; ++i) {
            u32x2 o; o.x = pk2(v[i].x * rstd, v[i].y * rstd); o.y = pk2(v[i].z * rstd, v[i].w * rstd);
            *(u32x2*)(A + (size_t)row * DM + 4 * (lane + 64 * i)) = o;
        }
    }
}

__device__ void phase_final(const Params& p) {
    const int tid = threadIdx.x, lane = tid & 63, w = tid >> 6;
    const float* gpost = p.in[21];
    const bf16_t* Y = (const bf16_t*)(p.ws + WS_Y);
    const bf16_t* X1 = (const bf16_t*)(p.ws + WS_X1);
    float4 gp[4];
#pragma unroll
    for (int i = 0; i < 4; ++i) gp[i] = ((const float4*)gpost)[lane + 64 * i];
    const int stride = gridDim.x * 8;
    u32x2 xn[4], yn[4];
    {
        const int row = blockIdx.x * 8 + w;
#pragma unroll
        for (int i = 0; i < 4; ++i) { xn[i] = *(const u32x2*)(X1 + (size_t)row * DM + 4 * (lane + 64 * i)); yn[i] = *(const u32x2*)(Y + (size_t)row * DM + 4 * (lane + 64 * i)); }
    }
    for (int row = blockIdx.x * 8 + w; row < MTOK; row += stride) {
        u32x2 xv[4], yv[4];
#pragma unroll
        for (int i = 0; i < 4; ++i) { xv[i] = xn[i]; yv[i] = yn[i]; }
        if (row + stride < MTOK) {
#pragma unroll
            for (int i = 0; i < 4; ++i) { xn[i] = *(const u32x2*)(X1 + (size_t)(row + stride) * DM + 4 * (lane + 64 * i)); yn[i] = *(const u32x2*)(Y + (size_t)(row + stride) * DM + 4 * (lane + 64 * i)); }
        }
        float4 y[4];
        float ss = 0.f;
#pragma unroll
        for (int i = 0; i < 4; ++i) {
            y[i].x = bf2f(yv[i].x & 0xffffu); y[i].y = bf2f(yv[i].x >> 16); y[i].z = bf2f(yv[i].y & 0xffffu); y[i].w = bf2f(yv[i].y >> 16);
            ss += y[i].x * y[i].x + y[i].y * y[i].y + y[i].z * y[i].z + y[i].w * y[i].w;
        }
        ss = wave_sum(ss);
        const float rstdy = rsqrtf(ss * (1.0f / DM) + 1e-6f);
#pragma unroll
        for (int i = 0; i < 4; ++i) {
            float4 v;
            v.x = bf2f(xv[i].x & 0xffffu) + y[i].x * rstdy * gp[i].x; v.y = bf2f(xv[i].x >> 16) + y[i].y * rstdy * gp[i].y;
            v.z = bf2f(xv[i].y & 0xffffu) + y[i].z * rstdy * gp[i].z; v.w = bf2f(xv[i].y >> 16) + y[i].w * rstdy * gp[i].w;
            ((float4*)(p.out + (size_t)row * DM))[lane + 64 * i] = v;
        }
    }
}

constexpr int L_BC = 0, L_ATT = 0, L_QD = 33792, L_KD = L_QD + 64 * 136 * 2, L_KTE = L_KD + 64 * 136 * 2, L_VI = L_KTE + 64 * 152 * 2, L_SSQ = L_VI + 64 * 280 * 2, L_BL = L_SSQ + 2048, L_DEC = L_BL + 512, L_ADL = L_DEC + 512,
              L_GLA_END = L_ADL + 2048;
static_assert(L_GLA_END <= LDS_BYTES, "GLA LDS");
#define GLA_BARRIER() do { asm volatile("s_waitcnt lgkmcnt(0)" ::: "memory"); __builtin_amdgcn_s_barrier(); asm volatile("" ::: "memory"); } while (0)
typedef short gs16x4 __attribute__((ext_vector_type(4)));
__device__ __forceinline__ u32x2 g_trread(const bf16_t* p) { union { gs16x4 s; u32x2 u; } x; x.s = __builtin_amdgcn_ds_read_tr16_b64_v4i16((__attribute__((address_space(3))) gs16x4*)p); return x.u; }
template <int PITCH> __device__ __forceinline__ bf16x8 g_trfrag(const bf16_t* img, int k0, int c0, int g, int q, int pq) {
    const bf16_t* a = img + (k0 + 8 * g + q) * PITCH + c0 + 4 * pq;
    const u32x2 lo = g_trread(a), hi = g_trread(a + 4 * PITCH);
    return as_bf16x8((u32x4){lo.x, lo.y, hi.x, hi.y});
}
__device__ __forceinline__ f32x4 g_lo4(u32x4 v) { return (f32x4){bf2f(v.x & 0xffffu), bf2f(v.x >> 16), bf2f(v.y & 0xffffu), bf2f(v.y >> 16)}; }
__device__ __forceinline__ f32x4 g_hi4(u32x4 v) { return (f32x4){bf2f(v.z & 0xffffu), bf2f(v.z >> 16), bf2f(v.w & 0xffffu), bf2f(v.w >> 16)}; }
__device__ __forceinline__ u32x2 g_pk4(f32x4 v) { u32x2 r; r.x = pk2(v[0], v[1]); r.y = pk2(v[2], v[3]); return r; }
__device__ __forceinline__ f32x4 g_unpk4(u32x2 v) { return (f32x4){bf2f(v.x & 0xffffu), bf2f(v.x >> 16), bf2f(v.y & 0xffffu), bf2f(v.y >> 16)}; }

template <bool OUT> struct GlaRaw { u32x4 q[2], k[2], v[4]; };
template <bool OUT> __device__ __forceinline__ void gla_issue(GlaRaw<OUT>& x, const char* cb  , unsigned offQ, unsigned offV) {
    if (OUT) { x.q[0] = *(const u32x4*)(cb + offQ); x.q[1] = *(const u32x4*)(cb + offQ + 16); }
    x.k[0] = *(const u32x4*)(cb + offQ + 1024); x.k[1] = *(const u32x4*)(cb + offQ + 1040);
#pragma unroll
    for (int i = 0; i < 4; ++i) x.v[i] = *(const u32x4*)(cb + offV + 16 * i);
}

template <bool OUT>
__device__ void gla_pass(const Params& p, unsigned char* lds) {
    const int tid = threadIdx.x, w = __builtin_amdgcn_readfirstlane(tid >> 6);
    const bf16_t* P = (const bf16_t*)(p.ws + WS_P);
    bf16_t* GS = (bf16_t*)(p.ws + WS_GS);
    float* GD = (float*)(p.ws + WS_GD);
    bf16_t* Aout = (bf16_t*)(p.ws + WS_A);
    const bf16_t* WupT = (const bf16_t*)(p.ws + WS_WUPT);
    const bf16_t* ADG = (const bf16_t*)(p.ws + WS_AD);
    float* BC = (float*)(lds + L_BC); bf16_t* ATT = (bf16_t*)(lds + L_ATT); bf16_t* QD = (bf16_t*)(lds + L_QD); bf16_t* KD = (bf16_t*)(lds + L_KD); bf16_t* KTE = (bf16_t*)(lds + L_KTE);
    bf16_t* VI = (bf16_t*)(lds + L_VI); float* SSQ = (float*)(lds + L_SSQ); float* BL = (float*)(lds + L_BL); float* DEC = (float*)(lds + L_DEC); bf16_t* ADL = (bf16_t*)(lds + L_ADL);
    const float* b_al = p.in[4]; const float* g_head = p.in[5];

    for (int unit = blockIdx.x; unit < 256; unit += gridDim.x) {
        const int bh = unit >> 5, m = unit & 31, b = bh >> 2, h = bh & 3;
        int tidv = tid; asm volatile("" : "+v"(tidv));
        const int lane = tidv & 63, l15 = lane & 15, g = lane >> 4, q4 = l15 >> 2, p4 = l15 & 3;
        const int c = tidv >> 3, seg = tidv & 7;
        const int tokbase = b * SEQ + m * 512;
        u32x4 wupq = *(const u32x4*)(WupT + (size_t)(h * 128 + 16 * w + l15) * 16 + 8 * (g & 1));
        if (g >= 2) wupq = (u32x4){0u, 0u, 0u, 0u};
        const bf16x8 wupf = as_bf16x8(wupq);
        const float bA = b_al[h * 128 + 16 * w + l15];
        f32x4 gh[2];
#pragma unroll
        for (int vt = 0; vt < 2; ++vt) gh[vt] = *(const f32x4*)(g_head + 32 * w + 16 * vt + 4 * g);
        float logD = 0.f;
        f32x4 S[8][2];
#pragma unroll
        for (int mt = 0; mt < 8; ++mt)
#pragma unroll
            for (int vt = 0; vt < 2; ++vt) {
                if (OUT) S[mt][vt] = g_unpk4(*(const u32x2*)(GS + ((size_t)(bh * 32 + m) * 256 + 32 * w + 16 * vt + l15) * 128 + 16 * mt + 4 * g));
                else S[mt][vt] = (f32x4){0.f, 0.f, 0.f, 0.f};
            }
        const unsigned offQ = (unsigned)((c * GIN_P + h * 128 + 16 * seg) * 2), offV = (unsigned)((c * GIN_P + 1024 + h * 256 + 32 * seg) * 2), offAD = (unsigned)(tid * 16);
        const unsigned offG = (unsigned)((l15 * GIN_P + 2048 + h * 256 + 32 * w + 4 * g) * 2), offO = (unsigned)((l15 * DM + h * 256 + 32 * w + 4 * g) * 2);
        GlaRaw<OUT> raw;
        gla_issue<OUT>(raw, (const char*)P + (size_t)tokbase * GIN_P * 2, offQ, offV);
        if (tid < 128) *(u32x4*)(ADL + tid * 8) = *(const u32x4*)((const char*)ADG + (size_t)tokbase * 32 + offAD);
        GLA_BARRIER();

        for (int ch = 0; ch < 8; ++ch) {
            const int tok0 = tokbase + ch * 64;
            u32x4 adn = (u32x4){0u, 0u, 0u, 0u};
            {
                if (ch < 7 && tid < 128) adn = *(const u32x4*)((const char*)ADG + (size_t)(tok0 + 64) * 32 + offAD);
                f32x4 sc[4]; float xinc[4], tot[4];
#pragma unroll
                for (int ct = 0; ct < 4; ++ct) {
                    u32x4 aq = *(const u32x4*)(ADL + (16 * ct + l15) * 16 + 8 * (g & 1));
                    if (g >= 2) aq = (u32x4){0u, 0u, 0u, 0u};
                    const f32x4 z = mfma16(as_bf16x8(aq), wupf, (f32x4){bA, bA, bA, bA});
                    float acc = 0.f;
#pragma unroll
                    for (int r = 0; r < 4; ++r) { acc += (fminf(z[r], 0.f) - flog(1.f + fexp(-fabsf(z[r])))) * (1.0f / 16.0f); sc[ct][r] = acc; }
                    xinc[ct] = acc;
                }
#pragma unroll
                for (int ct = 0; ct < 4; ++ct) xinc[ct] += (g >= 1 ? 1.f : 0.f) * bperm(((lane - 16) & 63) * 4, xinc[ct]);
#pragma unroll
                for (int ct = 0; ct < 4; ++ct) xinc[ct] += (g >= 2 ? 1.f : 0.f) * bperm(((lane - 32) & 63) * 4, xinc[ct]);
#pragma unroll
                for (int ct = 0; ct < 4; ++ct) tot[ct] = bperm((48 + l15) * 4, xinc[ct]);
                float run = 0.f;
#pragma unroll
                for (int ct = 0; ct < 4; ++ct) {
                    const float base = run + (xinc[ct] - sc[ct][3]);
                    run += tot[ct];
#pragma unroll
                    for (int r = 0; r < 4; ++r) BC[(16 * ct + 4 * g + r) * 132 + 16 * w + l15] = base + sc[ct][r];
                }
                if (g == 0) { BL[16 * w + l15] = run; DEC[16 * w + l15] = fexp(run); }
                if (!OUT) logD += run;
            }
            GLA_BARRIER();
            u32x2 gate[2][4];
            {
#pragma unroll
                for (int hh = 0; hh < 2; ++hh) {
                    const int o8 = 16 * seg + 8 * hh;
                    const f32x4 bb[2] = {*(const f32x4*)(BC + c * 132 + o8), *(const f32x4*)(BC + c * 132 + o8 + 4)};
                    const f32x4 dc[2] = {*(const f32x4*)(DEC + o8), *(const f32x4*)(DEC + o8 + 4)};
                    const f32x4 kx[2] = {g_lo4(raw.k[hh]), g_hi4(raw.k[hh])};
                    f32x4 qx[2];
                    if (OUT) { qx[0] = g_lo4(raw.q[hh]); qx[1] = g_hi4(raw.q[hh]); }
                    f32x4 kd[2], kt[2], qd[2];
#pragma unroll
                    for (int i = 0; i < 2; ++i)
#pragma unroll
                        for (int j = 0; j < 4; ++j) {
                            const float eB = fexp(bb[i][j]), enB = __builtin_amdgcn_rcpf(eB);
                            kd[i][j] = kx[i][j] * enB; kt[i][j] = kd[i][j] * dc[i][j];
                            if (OUT) qd[i][j] = qx[i][j] * 0.08838834764831845f * eB;
                        }
                    *(u32x4*)(KTE + c * 152 + o8) = (u32x4){pk2(kt[0][0], kt[0][1]), pk2(kt[0][2], kt[0][3]), pk2(kt[1][0], kt[1][1]), pk2(kt[1][2], kt[1][3])};
                    if (OUT) {
                        *(u32x4*)(KD + c * 136 + o8) = (u32x4){pk2(kd[0][0], kd[0][1]), pk2(kd[0][2], kd[0][3]), pk2(kd[1][0], kd[1][1]), pk2(kd[1][2], kd[1][3])};
                        *(u32x4*)(QD + c * 136 + o8) = (u32x4){pk2(qd[0][0], qd[0][1]), pk2(qd[0][2], qd[0][3]), pk2(qd[1][0], qd[1][1]), pk2(qd[1][2], qd[1][3])};
                    }
                }
#pragma unroll
                for (int i = 0; i < 4; ++i) *(u32x4*)(VI + c * 280 + 32 * seg + 8 * i) = raw.v[i];
                if (OUT) {
#pragma unroll
                    for (int vt = 0; vt < 2; ++vt)
#pragma unroll
                        for (int ct = 0; ct < 4; ++ct) gate[vt][ct] = *(const u32x2*)((const char*)P + (size_t)(tok0 + 16 * ct) * GIN_P * 2 + offG + 32 * vt);
                }
                if (ch < 7) gla_issue<OUT>(raw, (const char*)P + (size_t)(tok0 + 64) * GIN_P * 2, offQ, offV);
                if (ch < 7 && tid < 128) *(u32x4*)(ADL + tid * 8) = adn;
            }
            GLA_BARRIER();
            f32x4 o[2][4];
            if (OUT) {
#pragma unroll
                for (int t2 = 0; t2 < 2; ++t2) {
                    const int tl = 2 * w + t2, ct = tl >> 2, st = tl & 3;
                    f32x4 acc = (f32x4){0.f, 0.f, 0.f, 0.f};
                    if (st <= ct) {
#pragma unroll
                        for (int kk = 0; kk < 4; ++kk) {
                            const bf16x8 a = *(const bf16x8*)(KD + (16 * st + l15) * 136 + 32 * kk + 8 * g);
                            const bf16x8 bq = *(const bf16x8*)(QD + (16 * ct + l15) * 136 + 32 * kk + 8 * g);
                            acc = mfma16(a, bq, acc);
                        }
#pragma unroll
                        for (int r = 0; r < 4; ++r) if (16 * st + 4 * g + r > 16 * ct + l15) acc[r] = 0.f;
                    }
                    *(u32x2*)(ATT + (16 * ct + l15) * 72 + 16 * st + 4 * g) = g_pk4(acc);
                }
                GLA_BARRIER();
#pragma unroll
                for (int vt = 0; vt < 2; ++vt)
#pragma unroll
                    for (int ct = 0; ct < 4; ++ct) o[vt][ct] = (f32x4){0.f, 0.f, 0.f, 0.f};
#pragma unroll
                for (int kk = 0; kk < 4; ++kk) {
                    bf16x8 sa[2];
#pragma unroll
                    for (int vt = 0; vt < 2; ++vt) { const u32x2 s0 = g_pk4(S[2 * kk][vt]), s1 = g_pk4(S[2 * kk + 1][vt]); sa[vt] = as_bf16x8((u32x4){s0.x, s0.y, s1.x, s1.y}); }
#pragma unroll
                    for (int ct = 0; ct < 4; ++ct) {
                        const bf16_t* qr = QD + (16 * ct + l15) * 136 + 32 * kk + 4 * g;
                        const u32x2 lo = *(const u32x2*)qr, hi = *(const u32x2*)(qr + 16);
                        const bf16x8 bq = as_bf16x8((u32x4){lo.x, lo.y, hi.x, hi.y});
#pragma unroll
                        for (int vt = 0; vt < 2; ++vt) o[vt][ct] = mfma16(sa[vt], bq, o[vt][ct]);
                    }
                }
            }
            bf16x8 bv[2][2];
#pragma unroll
            for (int vt = 0; vt < 2; ++vt)
#pragma unroll
                for (int kk = 0; kk < 2; ++kk) bv[vt][kk] = g_trfrag<280>(VI, 32 * kk, 32 * w + 16 * vt, g, q4, p4);
            if (OUT) {
#pragma unroll
                for (int ct = 0; ct < 4; ++ct)
#pragma unroll
                    for (int kk = 0; kk < 2; ++kk) {
                        if (32 * kk <= 16 * ct + 15) {
                            const bf16x8 bq = *(const bf16x8*)(ATT + (16 * ct + l15) * 72 + 32 * kk + 8 * g);
#pragma unroll
                            for (int vt = 0; vt < 2; ++vt) o[vt][ct] = mfma16(bv[vt][kk], bq, o[vt][ct]);
                        }
                    }
            }
#pragma unroll
            for (int mt = 0; mt < 8; ++mt) {
                const f32x4 dv = *(const f32x4*)(DEC + 16 * mt + 4 * g);
#pragma unroll
                for (int vt = 0; vt < 2; ++vt) S[mt][vt] *= dv;
#pragma unroll
                for (int kk = 0; kk < 2; ++kk) {
                    const bf16x8 a = g_trfrag<152>(KTE, 32 * kk, 16 * mt, g, q4, p4);
#pragma unroll
                    for (int vt = 0; vt < 2; ++vt) S[mt][vt] = mfma16(a, bv[vt][kk], S[mt][vt]);
                }
            }
            if (OUT) {
                float ss[4];
#pragma unroll
                for (int ct = 0; ct < 4; ++ct) {
                    float s = 0.f;
#pragma unroll
                    for (int vt = 0; vt < 2; ++vt)
#pragma unroll
                        for (int r = 0; r < 4; ++r) s += o[vt][ct][r] * o[vt][ct][r];
                    s += bperm((lane ^ 16) * 4, s); s += bperm((lane ^ 32) * 4, s);
                    ss[ct] = s;
                }
                if (g == 0) {
#pragma unroll
                    for (int ct = 0; ct < 4; ++ct) SSQ[(16 * ct + l15) * 8 + w] = ss[ct];
                }
                GLA_BARRIER();
#pragma unroll
                for (int ct = 0; ct < 4; ++ct) {
                    const int cc = 16 * ct + l15;
                    const float4 s0 = *(const float4*)(SSQ + cc * 8), s1 = *(const float4*)(SSQ + cc * 8 + 4);
                    const float tot = (s0.x + s0.y) + (s0.z + s0.w) + (s1.x + s1.y) + (s1.z + s1.w);
                    const float rstd = rsqrtf(tot * (1.0f / 256.0f) + 1e-6f);
#pragma unroll
                    for (int vt = 0; vt < 2; ++vt) {
                        const f32x4 gt = g_unpk4(gate[vt][ct]);
                        f32x4 val;
#pragma unroll
                        for (int r = 0; r < 4; ++r) val[r] = o[vt][ct][r] * rstd * gh[vt][r] * gt[r];
                        *(u32x2*)((char*)Aout + (size_t)(tok0 + 16 * ct) * DM * 2 + offO + 32 * vt) = g_pk4(val);
                    }
                }
            } else {
                GLA_BARRIER();
            }
        }
        if (!OUT) {
#pragma unroll
            for (int mt = 0; mt < 8; ++mt)
#pragma unroll
                for (int vt = 0; vt < 2; ++vt) *(u32x2*)(GS + ((size_t)(bh * 32 + m) * 256 + 32 * w + 16 * vt + l15) * 128 + 16 * mt + 4 * g) = g_pk4(S[mt][vt]);
            if (g == 0) GD[(bh * 32 + m) * 128 + 16 * w + l15] = fexp(logD);
        }
        GLA_BARRIER();
    }
}

__device__ void gla_scan(const Params& p) {
    bf16_t* GS = (bf16_t*)(p.ws + WS_GS);
    const float* GD = (const float*)(p.ws + WS_GD);
    for (int idx = blockIdx.x * NTH + threadIdx.x; idx < 8 * 8192; idx += gridDim.x * NTH) {
        const int bh = idx >> 13, e = (idx & 8191) * 4, d = e & 127;
        f32x4 S = (f32x4){0.f, 0.f, 0.f, 0.f};
        for (int m0 = 0; m0 < 32; m0 += 8) {
            u32x2 t[8]; f32x4 dd[8];
#pragma unroll
            for (int m = 0; m < 8; ++m) { t[m] = *(const u32x2*)(GS + (size_t)(bh * 32 + m0 + m) * 32768 + e); dd[m] = *(const f32x4*)(GD + (bh * 32 + m0 + m) * 128 + d); }
#pragma unroll
            for (int m = 0; m < 8; ++m) { *(u32x2*)(GS + (size_t)(bh * 32 + m0 + m) * 32768 + e) = g_pk4(S); S = S * dd[m] + g_unpk4(t[m]); }
        }
    }
}

constexpr int PP = RIN_P;
constexpr size_t WS_RK  = WS_GS;
constexpr size_t WS_BND = WS_GS + (size_t)MTOK * 16 * 4;
static_assert(WS_BND + (size_t)513 * PP * 2 <= WS_GD, "RWKV side buffers must fit the GLA state region");
constexpr int IMG = 64 * 72 * 2;
constexpr int R_ALB = 0, R_BH = IMG, R_KH = 2 * IMG, R_RB = 3 * IMG, R_BTL = 4 * IMG, R_KTL = 5 * IMG, R_VI = 6 * IMG, R_AAB = 7 * IMG, R_AAK = 8 * IMG, R_ARB = 9 * IMG, R_ARK = 10 * IMG,
              R_DW = R_AAK, R_DA = R_BH, R_XT = 11 * IMG, R_TW = R_XT, R_ADI = R_XT + IMG, R_TDF = R_XT + 2 * IMG, R_CS = R_TDF + 2048, R_GC = R_CS + 2048, R_CONST = R_GC + 256, R_WDL = R_CONST + 2560, R_WIL = R_WDL + IMG,
              R_END = R_WIL + IMG;
static_assert(R_DW + 64 * 68 * 4 <= R_XT && R_DA + 64 * 68 * 4 <= R_RB && R_END <= LDS_BYTES, "R1 LDS");
#define LDS_BARRIER() do { asm volatile("s_waitcnt lgkmcnt(0)" ::: "memory"); __builtin_amdgcn_s_barrier(); asm volatile("" ::: "memory"); } while (0)

typedef short s16x4 __attribute__((ext_vector_type(4)));
__device__ __forceinline__ bf16x8 ldfrag(const bf16_t* img, int row, int koff) { return *(const bf16x8*)(img + row * 72 + koff); }
__device__ __forceinline__ u32x2 pk4(f32x4 v) { u32x2 r; r.x = pk2(v[0], v[1]); r.y = pk2(v[2], v[3]); return r; }
__device__ __forceinline__ f32x4 unpk4(u32x2 v) { return (f32x4){bf2f(v.x & 0xffffu), bf2f(v.x >> 16), bf2f(v.y & 0xffffu), bf2f(v.y >> 16)}; }
__device__ __forceinline__ u32x2 trread(const bf16_t* p) {
    union { s16x4 s; u32x2 u; } x; x.s = __builtin_amdgcn_ds_read_tr16_b64_v4i16((__attribute__((address_space(3))) s16x4*)p); return x.u;
}
__device__ __forceinline__ bf16x8 trfrag(const bf16_t* img, int k0, int c0, int g, int q, int pq) {
    const bf16_t* a = img + (k0 + 8 * g + q) * 72 + c0 + 4 * pq;
    const u32x2 lo = trread(a), hi = trread(a + 4 * 72);
    return as_bf16x8((u32x4){lo.x, lo.y, hi.x, hi.y});
}
__device__ __forceinline__ f32x4 lo4(u32x4 v) { return (f32x4){bf2f(v.x & 0xffffu), bf2f(v.x >> 16), bf2f(v.y & 0xffffu), bf2f(v.y >> 16)}; }
__device__ __forceinline__ f32x4 hi4(u32x4 v) { return (f32x4){bf2f(v.z & 0xffffu), bf2f(v.z >> 16), bf2f(v.w & 0xffffu), bf2f(v.w >> 16)}; }
__device__ __forceinline__ u32x4 pk8(f32x4 a, f32x4 b) { return (u32x4){pk2(a[0], a[1]), pk2(a[2], a[3]), pk2(b[0], b[1]), pk2(b[2], b[3])}; }
__device__ __forceinline__ float fast_rcp(float x) { return __builtin_amdgcn_rcpf(x); }
__device__ __forceinline__ f32x4 mm16(f32x4 xa, f32x4 yb, f32x4 c) {
    const u32x2 a = pk4(xa), b = pk4(yb);
    return mfma16(as_bf16x8((u32x4){a.x, a.y, 0u, 0u}), as_bf16x8((u32x4){b.x, b.y, 0u, 0u}), c);
}

struct R1Raw { u32x4 r0, r1, k0, k1, v0, v1, w0, w1, a0, a1; };
__device__ __forceinline__ void r1_issue(R1Raw& x, const bf16_t* P, const bf16_t* BND, int unit, int t, int cs) {
    const int bn = unit >> 4, h = unit & 15, n = bn & 255;
    const bf16_t* cur = P + ((size_t)bn * 64 + t) * PP;
    const bf16_t* prv = (t > 0) ? (cur - PP) : (BND + (size_t)(n == 0 ? 0 : bn) * PP);
    const int ch = h * 64 + 8 * cs;
    x.r0 = *(const u32x4*)(cur + ch); x.k0 = *(const u32x4*)(cur + 1024 + ch); x.v0 = *(const u32x4*)(cur + 2048 + ch); x.w0 = *(const u32x4*)(cur + 4096 + 8 * cs); x.a0 = *(const u32x4*)(cur + 4160 + 8 * cs);
    x.r1 = *(const u32x4*)(prv + ch); x.k1 = *(const u32x4*)(prv + 1024 + ch); x.v1 = *(const u32x4*)(prv + 2048 + ch); x.w1 = *(const u32x4*)(prv + 4096 + 8 * cs); x.a1 = *(const u32x4*)(prv + 4160 + 8 * cs);
}
__device__ __forceinline__ void lerp8(u32x4 c, u32x4 pv, const float* mu8, f32x4& o0, f32x4& o1) {
    const f32x4 c0 = lo4(c), c1 = hi4(c), p0 = lo4(pv), p1 = hi4(pv);
    const f32x4 m0 = *(const f32x4*)mu8, m1 = *(const f32x4*)(mu8 + 4);
    o0 = c0 + m0 * (p0 - c0); o1 = c1 + m1 * (p1 - c1);
}

__device__ void rwkv_r1(const Params& p, unsigned char* lds) {
    const int tid = threadIdx.x, w = __builtin_amdgcn_readfirstlane(tid >> 6);
    bf16_t* P = (bf16_t*)(p.ws + WS_P);
    bf16_t* Abuf = (bf16_t*)(p.ws + WS_A);
    bf16_t* Ybuf = (bf16_t*)(p.ws + WS_Y);
    float* RK = (float*)(p.ws + WS_RK);
    const bf16_t* BND = (const bf16_t*)(p.ws + WS_BND);
    const bf16_t* WduT = (const bf16_t*)(p.ws + WS_WDUT);
    const bf16_t* WiuT = (const bf16_t*)(p.ws + WS_WIUT);
    bf16_t* ALB = (bf16_t*)(lds + R_ALB); bf16_t* BH = (bf16_t*)(lds + R_BH); bf16_t* KH = (bf16_t*)(lds + R_KH); bf16_t* RB = (bf16_t*)(lds + R_RB);
    bf16_t* BTL = (bf16_t*)(lds + R_BTL); bf16_t* KTL = (bf16_t*)(lds + R_KTL); bf16_t* VI = (bf16_t*)(lds + R_VI);
    bf16_t* AAB = (bf16_t*)(lds + R_AAB); bf16_t* AAK = (bf16_t*)(lds + R_AAK); bf16_t* ARB = (bf16_t*)(lds + R_ARB); bf16_t* ARK = (bf16_t*)(lds + R_ARK);
    float* DW = (float*)(lds + R_DW); float* DA = (float*)(lds + R_DA);
    bf16_t* XT = (bf16_t*)(lds + R_XT); bf16_t* TW = (bf16_t*)(lds + R_TW); bf16_t* ADI = (bf16_t*)(lds + R_ADI);
    u32x2* TDF = (u32x2*)(lds + R_TDF); float* CS = (float*)(lds + R_CS); float* GCs = (float*)(lds + R_GC); float* CONST = (float*)(lds + R_CONST); bf16_t* WDL = (bf16_t*)(lds + R_WDL); bf16_t* WIL = (bf16_t*)(lds + R_WIL);
    const int t0_ = tid >> 3, cs0_ = tid & 7;
    int hprev = -1;
    R1Raw raw;
    if (blockIdx.x < 8192) r1_issue(raw, P, BND, blockIdx.x, t0_, cs0_);
    {
        u32x4* dmy = (u32x4*)(p.ws + WS_DUMMY) + tid;
#pragma unroll
        for (int k = 0; k < 6; ++k) dmy[k * NTH] = (u32x4){0u, 0u, 0u, 0u};
    }

    for (int unit = blockIdx.x; unit < 8192; unit += gridDim.x) {
        const int bn = unit >> 4, h = unit & 15, n = bn & 255;
        const size_t R0 = (size_t)bn * 64;
        int tidv = tid; asm volatile("" : "+v"(tidv));
        const int lane = tidv & 63, l15 = lane & 15, g = lane >> 4, q4 = l15 >> 2, p4 = l15 & 3, t = tidv >> 3, cs = tidv & 7, tl = lane >> 3;
        if (h != hprev) {
            LDS_BARRIER();
            if (tid < 64) {
                const int ch = h * 64 + tid;
                CONST[tid] = p.in[10][ch]; CONST[64 + tid] = p.in[10][1024 + ch]; CONST[128 + tid] = p.in[10][2048 + ch];
                CONST[192 + tid] = p.in[11][ch]; CONST[256 + tid] = p.in[13][ch]; CONST[320 + tid] = p.in[15][ch]; CONST[384 + tid] = p.in[16][ch]; CONST[448 + tid] = p.in[17][ch];
                CONST[512 + tid] = p.in[10][4096 + tid]; CONST[576 + tid] = p.in[10][4160 + tid];
            }
            {
                const int rr = tid >> 3, sg = tid & 7;
                *(u32x4*)(WDL + rr * 72 + 8 * sg) = *(const u32x4*)(WduT + (size_t)(h * 64 + rr) * 64 + 8 * sg);
                *(u32x4*)(WIL + rr * 72 + 8 * sg) = *(const u32x4*)(WiuT + (size_t)(h * 64 + rr) * 64 + 8 * sg);
            }
            hprev = h;
            LDS_BARRIER();
        }
        f32x4 r0, r1, k0, k1, v0, v1;
        {
            f32x4 wd0, wd1, ad0, ad1;
            lerp8(raw.r0, raw.r1, CONST + 8 * cs, r0, r1);
            lerp8(raw.k0, raw.k1, CONST + 64 + 8 * cs, k0, k1);
            lerp8(raw.v0, raw.v1, CONST + 128 + 8 * cs, v0, v1);
            lerp8(raw.w0, raw.w1, CONST + 512 + 8 * cs, wd0, wd1);
            lerp8(raw.a0, raw.a1, CONST + 576 + 8 * cs, ad0, ad1);
#pragma unroll
            for (int j = 0; j < 4; ++j) {
                const float e0 = fexp(-2.f * fabsf(wd0[j])), e1 = fexp(-2.f * fabsf(wd1[j]));
                wd0[j] = copysignf((1.f - e0) * fast_rcp(1.f + e0), wd0[j]); wd1[j] = copysignf((1.f - e1) * fast_rcp(1.f + e1), wd1[j]);
            }
            *(u32x4*)(TW + t * 72 + 8 * cs) = pk8(wd0, wd1);
            *(u32x4*)(ADI + t * 72 + 8 * cs) = pk8(ad0, ad1);
        }
        if (unit + (int)gridDim.x < 8192) r1_issue(raw, P, BND, unit + gridDim.x, t, cs);
        {
            const int trow = 8 * w + (l15 & 7);
            const bool lo8 = l15 < 8;
            bf16x8 ft[2], fa[2];
#pragma unroll
            for (int kk = 0; kk < 2; ++kk) { ft[kk] = ldfrag(TW, trow, 32 * kk + 8 * g); fa[kk] = ldfrag(ADI, trow, 32 * kk + 8 * g); }
            float* dst = (lo8 ? DW : DA) + trow * 68 + 4 * g;
#pragma unroll
            for (int ct = 0; ct < 4; ++ct) {
                f32x4 aw = (f32x4){0.f, 0.f, 0.f, 0.f}, aa = aw;
#pragma unroll
                for (int kk = 0; kk < 2; ++kk) { aw = mfma16(ldfrag(WDL, 16 * ct + l15, 32 * kk + 8 * g), ft[kk], aw); aa = mfma16(ldfrag(WIL, 16 * ct + l15, 32 * kk + 8 * g), fa[kk], aa); }
                f32x4 o;
#pragma unroll
                for (int j = 0; j < 4; ++j) o[j] = lo8 ? aw[j] : aa[j];
                *(f32x4*)(dst + 16 * ct) = o;
            }
        }
        f32x4 lw[2], av[2], kk[2], k2[2], G[2];
        {
            const f32x4 cw0[2] = {*(const f32x4*)(CONST + 192 + 8 * cs), *(const f32x4*)(CONST + 196 + 8 * cs)};
            const f32x4 ca0[2] = {*(const f32x4*)(CONST + 256 + 8 * cs), *(const f32x4*)(CONST + 260 + 8 * cs)};
            const f32x4 ckk[2] = {*(const f32x4*)(CONST + 320 + 8 * cs), *(const f32x4*)(CONST + 324 + 8 * cs)};
            const f32x4 cka[2] = {*(const f32x4*)(CONST + 384 + 8 * cs), *(const f32x4*)(CONST + 388 + 8 * cs)};
            const f32x4 crk[2] = {*(const f32x4*)(CONST + 448 + 8 * cs), *(const f32x4*)(CONST + 452 + 8 * cs)};
            const f32x4 dwv[2] = {*(const f32x4*)(DW + t * 68 + 8 * cs), *(const f32x4*)(DW + t * 68 + 8 * cs + 4)};
            const f32x4 dav[2] = {*(const f32x4*)(DA + t * 68 + 8 * cs), *(const f32x4*)(DA + t * 68 + 8 * cs + 4)};
            const f32x4 kin[2] = {k0, k1}, rin[2] = {r0, r1};
            float n2 = 0.f, rk = 0.f;
#pragma unroll
            for (int hf = 0; hf < 2; ++hf)
#pragma unroll
                for (int j = 0; j < 4; ++j) {
                    const float z = -(cw0[hf][j] + dwv[hf][j]);
                    lw[hf][j] = -0.60653066f * fast_rcp(1.f + fexp(z));
                    av[hf][j] = fast_rcp(1.f + fexp(-(ca0[hf][j] + dav[hf][j])));
                    kk[hf][j] = kin[hf][j] * ckk[hf][j];
                    k2[hf][j] = kin[hf][j] * (1.f + (av[hf][j] - 1.f) * cka[hf][j]);
                    n2 += kk[hf][j] * kk[hf][j]; rk += rin[hf][j] * k2[hf][j] * crk[hf][j];
                }
            n2 = sum8(n2); rk = sum8(rk);
            const float inv = __builtin_amdgcn_rsqf(fmaxf(n2, 1e-24f));
            kk[0] *= inv; kk[1] *= inv;
            if (cs == 0) RK[(R0 + t) * 16 + h] = rk;
            G[0] = lw[0]; G[1] = lw[1];
#pragma unroll
            for (int d = 1; d < 8; d <<= 1) {
                const int src = ((lane - 8 * d) & 63) * 4;
                const float keep = (tl >= d) ? 1.f : 0.f;
#pragma unroll
                for (int hf = 0; hf < 2; ++hf)
#pragma unroll
                    for (int j = 0; j < 4; ++j) G[hf][j] += keep * bperm(src, G[hf][j]);
            }
            if (tl == 7) { *(f32x4*)(CS + w * 64 + 8 * cs) = G[0]; *(f32x4*)(CS + w * 64 + 8 * cs + 4) = G[1]; }
        }
        LDS_BARRIER();
        {
            f32x4 off[2] = {(f32x4){0.f, 0.f, 0.f, 0.f}, (f32x4){0.f, 0.f, 0.f, 0.f}}, gc[2] = {off[0], off[0]};
#pragma unroll
            for (int q = 0; q < 8; ++q) {
                const f32x4 c0 = *(const f32x4*)(CS + q * 64 + 8 * cs), c1 = *(const f32x4*)(CS + q * 64 + 8 * cs + 4);
                const float mk = (q < w) ? 1.f : 0.f;
                gc[0] += c0; gc[1] += c1; off[0] += c0 * mk; off[1] += c1 * mk;
            }
            f32x4 al[2], bh[2], kh[2], rb[2];
            const f32x4 rin[2] = {r0, r1};
#pragma unroll
            for (int hf = 0; hf < 2; ++hf)
#pragma unroll
                for (int j = 0; j < 4; ++j) {
                    const float Gi = G[hf][j] + off[hf][j];
                    const float eG = fexp(Gi), eGm = fexp(Gi - lw[hf][j]), enG = fast_rcp(eG);
                    const float be = kk[hf][j] * av[hf][j];
                    al[hf][j] = -kk[hf][j] * eGm; bh[hf][j] = be * enG; kh[hf][j] = k2[hf][j] * enG; rb[hf][j] = rin[hf][j] * eG;
                }
            const int o = t * 72 + 8 * cs;
            *(u32x4*)(ALB + o) = pk8(al[0], al[1]); *(u32x4*)(BH + o) = pk8(bh[0], bh[1]); *(u32x4*)(KH + o) = pk8(kh[0], kh[1]); *(u32x4*)(RB + o) = pk8(rb[0], rb[1]);
            const u32x4 vpk = pk8(v0, v1);
            *(u32x4*)(VI + o) = vpk;
            *(u32x4*)(Ybuf + (R0 + t) * DM + h * 64 + 8 * cs) = vpk;
            if (w == 0 && tl == 0) { f32x4 e0, e1;
#pragma unroll
                for (int j = 0; j < 4; ++j) { e0[j] = fexp(gc[0][j]); e1[j] = fexp(gc[1][j]); }
                *(f32x4*)(GCs + 8 * cs) = e0; *(f32x4*)(GCs + 8 * cs + 4) = e1; }
        }
        LDS_BARRIER();
        {
            int ntile = 1, tta = 0, sta = 0, ttb = 0, stb = 0;
            if (w == 0) { tta = 0; sta = 0; } else if (w == 2) { tta = 1; sta = 1; } else if (w == 5) { tta = 2; sta = 2; } else if (w == 7) { tta = 3; sta = 3; }
            else if (w == 1) { ntile = 2; tta = 1; sta = 0; ttb = 2; stb = 0; } else if (w == 3) { ntile = 2; tta = 2; sta = 1; ttb = 3; stb = 0; }
            else if (w == 4) { tta = 3; sta = 1; } else { tta = 3; sta = 2; }
            for (int it = 0; it < ntile; ++it) {
                const int tt = it ? ttb : tta, st = it ? stb : sta;
                f32x4 cab = (f32x4){0.f, 0.f, 0.f, 0.f}, cak = cab, crb = cab, crk = cab, nab = cab;
#pragma unroll
                for (int kq = 0; kq < 2; ++kq) {
                    const bf16x8 fb = ldfrag(BH, 16 * st + l15, 32 * kq + 8 * g), fk = ldfrag(KH, 16 * st + l15, 32 * kq + 8 * g);
                    const bf16x8 fa = ldfrag(ALB, 16 * tt + l15, 32 * kq + 8 * g), fr = ldfrag(RB, 16 * tt + l15, 32 * kq + 8 * g);
                    cab = mfma16(fb, fa, cab); cak = mfma16(fk, fa, cak); crb = mfma16(fb, fr, crb); crk = mfma16(fk, fr, crk);
                    if (tt == st) nab = mfma16(fa, fb, nab);
                }
                if (tt == st) {
#pragma unroll
                    for (int r = 0; r < 4; ++r) {
                        const int s = 4 * g + r, tq = l15;
                        if (s >= tq) { cab[r] = 0.f; cak[r] = 0.f; }
                        if (s > tq) { crb[r] = 0.f; crk[r] = 0.f; }
                        if (l15 >= 4 * g + r) nab[r] = 0.f;
                    }
                }
                const int o = (16 * tt + l15) * 72 + 16 * st + 4 * g;
                *(u32x2*)(AAB + o) = pk4(cab); *(u32x2*)(AAK + o) = pk4(cak); *(u32x2*)(ARB + o) = pk4(crb); *(u32x2*)(ARK + o) = pk4(crk);
                if (tt == st) {
                    const f32x4 z = (f32x4){0.f, 0.f, 0.f, 0.f};
                    const f32x4 Q1 = cab, N1 = nab;
                    const f32x4 Q2 = mm16(N1, Q1, z), N2 = mm16(Q1, N1, z);
                    f32x4 Pm = Q1;
#pragma unroll
                    for (int r = 0; r < 4; ++r) if (4 * g + r == l15) Pm[r] += 1.f;
                    Pm = mm16(N2, Pm, Pm);
                    const f32x4 Q4 = mm16(N2, Q2, z), N4 = mm16(Q2, N2, z);
                    Pm = mm16(N4, Pm, Pm);
                    const f32x4 N8 = mm16(Q4, N4, z);
                    Pm = mm16(N8, Pm, Pm);
                    TDF[tt * 64 + lane] = pk4(Pm);
                }
            }
            if (w == 4 || w == 6) {
                const int tt = (w == 4) ? 0 : 2, st = tt + 1;
                const int o = (16 * tt + l15) * 72 + 16 * st + 4 * g;
                const u32x2 zz = (u32x2){0u, 0u};
                *(u32x2*)(AAK + o) = zz; *(u32x2*)(ARB + o) = zz; *(u32x2*)(ARK + o) = zz;
            }
        }
        LDS_BARRIER();
        {
            u32x2 xb[4];
            const int col = 16 * w + l15;
            bf16x8 vfr[2];
            if (w >= 4) { vfr[0] = trfrag(VI, 0, 16 * (w - 4), g, q4, p4); vfr[1] = trfrag(VI, 32, 16 * (w - 4), g, q4, p4); }
#pragma unroll
            for (int i = 0; i < 4; ++i) {
                f32x4 z;
                if (w < 4) z = unpk4(trread(ALB + (16 * i + 4 * g + q4) * 72 + 16 * w + 4 * p4));
                else {
                    z = mfma16(ldfrag(AAK, 16 * i + l15, 8 * g), vfr[0], (f32x4){0.f, 0.f, 0.f, 0.f});
                    if (i >= 2) z = mfma16(ldfrag(AAK, 16 * i + l15, 32 + 8 * g), vfr[1], z);
                }
                if (i >= 1) {
                    const bf16_t* ar = AAB + (16 * i + l15) * 72 + 4 * g;
                    const u32x2 a0 = *(const u32x2*)ar;
                    u32x2 a1 = (u32x2){0u, 0u}, b1 = (u32x2){0u, 0u};
                    if (i >= 2) { a1 = *(const u32x2*)(ar + 16); b1 = xb[1]; }
                    z = mfma16(as_bf16x8((u32x4){a0.x, a0.y, a1.x, a1.y}), as_bf16x8((u32x4){xb[0].x, xb[0].y, b1.x, b1.y}), z);
                    if (i == 3) {
                        const u32x2 a2 = *(const u32x2*)(ar + 32);
                        z = mfma16(as_bf16x8((u32x4){a2.x, a2.y, 0u, 0u}), as_bf16x8((u32x4){xb[2].x, xb[2].y, 0u, 0u}), z);
                    }
                }
                const u32x2 tq = TDF[i * 64 + lane];
                const u32x2 zq = pk4(z);
                const f32x4 x = mfma16(as_bf16x8((u32x4){tq.x, tq.y, 0u, 0u}), as_bf16x8((u32x4){zq.x, zq.y, 0u, 0u}), (f32x4){0.f, 0.f, 0.f, 0.f});
                xb[i] = pk4(x);
                *(u32x2*)(XT + col * 72 + 16 * i + 4 * g) = xb[i];
            }
        }
        LDS_BARRIER();
        {
            const int rt_ = w & 3, c0 = 2 * (w >> 2);
            bf16x8 xw[2], xu[2], fbt[2], fkt[2], fvr[2];
#pragma unroll
            for (int kq = 0; kq < 2; ++kq) {
                xw[kq] = ldfrag(XT, 16 * rt_ + l15, 32 * kq + 8 * g);
                xu[kq] = ldfrag(XT, 64 + 16 * rt_ + l15, 32 * kq + 8 * g);
                fbt[kq] = trfrag(BH, 32 * kq, 16 * rt_, g, q4, p4);
                fkt[kq] = trfrag(KH, 32 * kq, 16 * rt_, g, q4, p4);
                fvr[kq] = trfrag(VI, 32 * kq, 16 * rt_, g, q4, p4);
            }
            const float gcd0 = GCs[16 * c0 + l15], gcd1 = GCs[16 * c0 + 16 + l15];
            const f32x4 gcr = *(const f32x4*)(GCs + 16 * rt_ + 4 * g);
#pragma unroll
            for (int q = 0; q < 2; ++q) {
                bf16x8 gbt[2], garb[2], gxu[2], gvi[2], gark[2];
#pragma unroll
                for (int kq = 0; kq < 2; ++kq) {
                    gbt[kq] = trfrag(BH, 32 * kq, 16 * (c0 + q), g, q4, p4);
                    garb[kq] = ldfrag(ARB, 16 * (c0 + q) + l15, 32 * kq + 8 * g);
                    gxu[kq] = ldfrag(XT, 64 + 16 * (c0 + q) + l15, 32 * kq + 8 * g);
                    gvi[kq] = trfrag(VI, 32 * kq, 16 * (c0 + q), g, q4, p4);
                    gark[kq] = ldfrag(ARK, 16 * (c0 + q) + l15, 32 * kq + 8 * g);
                }
                const u32x2 rbi = *(const u32x2*)(RB + (16 * (c0 + q) + l15) * 72 + 16 * rt_ + 4 * g);
                __builtin_amdgcn_sched_barrier(0);
                const int ctile = c0 + q;
                {
                    f32x4 acc = (f32x4){0.f, 0.f, 0.f, 0.f};
#pragma unroll
                    for (int kq = 0; kq < 2; ++kq) acc = mfma16(xw[kq], gbt[kq], acc);
                    const int dcol = 16 * ctile + l15;
                    if (rt_ == ctile) {
#pragma unroll
                        for (int r = 0; r < 4; ++r) if (4 * g + r == l15) acc[r] += 1.f;
                    }
                    acc *= (q ? gcd1 : gcd0);
                    *(u32x2*)(ALB + dcol * 72 + 32 * (rt_ >> 1) + 8 * g + 4 * (rt_ & 1)) = pk4(acc);
                }
                {
                    f32x4 acc = unpk4(rbi);
#pragma unroll
                    for (int kq = 0; kq < 2; ++kq) {
                        if (32 * kq <= 16 * ctile + 15) acc = mfma16(xw[kq], garb[kq], acc);
                    }
                    *(u32x2*)(BTL + (16 * ctile + l15) * 72 + 16 * rt_ + 4 * g) = pk4(acc);
                }
                {
                    f32x4 acc = (f32x4){0.f, 0.f, 0.f, 0.f};
#pragma unroll
                    for (int kq = 0; kq < 2; ++kq) { acc = mfma16(fbt[kq], gxu[kq], acc); acc = mfma16(fkt[kq], gvi[kq], acc); }
                    *(u32x2*)(KTL + (16 * ctile + l15) * 72 + 16 * rt_ + 4 * g) = pk4(acc * gcr);
                }
                {
                    f32x4 acc = (f32x4){0.f, 0.f, 0.f, 0.f};
#pragma unroll
                    for (int kq = 0; kq < 2; ++kq) {
                        if (32 * kq <= 16 * ctile + 15) { acc = mfma16(xu[kq], garb[kq], acc); acc = mfma16(fvr[kq], gark[kq], acc); }
                    }
                    *(u32x2*)(AAB + (16 * ctile + l15) * 72 + 16 * rt_ + 4 * g) = pk4(acc);
                }
            }
        }
        LDS_BARRIER();
        {
            const int o = t * 72 + 8 * cs;
            *(u32x4*)(P + (R0 + t) * PP + h * 64 + 8 * cs) = *(const u32x4*)(ALB + o);
            *(u32x4*)(P + (R0 + t) * PP + 1024 + h * 64 + 8 * cs) = *(const u32x4*)(BTL + o);
            *(u32x4*)(P + (R0 + t) * PP + 2048 + h * 64 + 8 * cs) = *(const u32x4*)(KTL + o);
            *(u32x4*)(Abuf + (R0 + t) * DM + h * 64 + 8 * cs) = *(const u32x4*)(AAB + o);
        }
    }
}

constexpr int SC_SLOT = 2 * IMG;
constexpr size_t WS_MG = (WS_BND + (size_t)513 * PP * 2 + 255) & ~(size_t)255;
constexpr size_t WS_NG = WS_MG + (size_t)1024 * 4096 * 2;
static_assert(WS_NG + (size_t)1024 * 4096 * 2 <= WS_GD, "scan buffers must fit the GLA state region");

template <int MODE>
__device__ void rwkv_scan2(const Params& p, unsigned char* lds) {
    constexpr int GSZ = 32, NGRP = 256 / GSZ, LG = 3;
    constexpr int SPU = (MODE == 2) ? NGRP : GSZ;
    constexpr int NU = (MODE == 2) ? 32 : 32 * NGRP;
    const int tid = threadIdx.x, lane = tid & 63, w = __builtin_amdgcn_readfirstlane(tid >> 6), l15 = lane & 15, g = lane >> 4;
    bf16_t* P = (bf16_t*)(p.ws + WS_P);
    bf16_t* MG = (bf16_t*)(p.ws + WS_MG); bf16_t* NG = (bf16_t*)(p.ws + WS_NG); bf16_t* HG = NG;
    const int G = gridDim.x;
    const int nun = ((int)blockIdx.x < NU) ? (NU - 1 - (int)blockIdx.x) / G + 1 : 0;
    const int T = nun * SPU;
    if (T == 0) return;
#define SC_SRC(s, p0, p1, pitchb) \
    const int u_ = (int)blockIdx.x + G * ((s) / SPU), j_ = (s) % SPU; \
    const char* p0; const char* p1; unsigned pitchb; \
    if (MODE == 2) { p0 = (const char*)(MG + (size_t)(u_ * NGRP + j_) * 4096); p1 = (const char*)(NG + (size_t)(u_ * NGRP + j_) * 4096); pitchb = 128u; } \
    else { const int bh_ = u_ >> LG, n_ = GSZ * (u_ & (NGRP - 1)) + j_; p0 = (const char*)(P + ((size_t)(bh_ >> 4) * SEQ + (size_t)n_ * 64) * PP + (bh_ & 15) * 64); p1 = p0 + 4096; pitchb = (unsigned)(PP * 2); }
    if (w >= 4) {
        const int lj = w - 4;
        const unsigned loff = (unsigned)((lane >> 3) * 144 + (lane & 7) * 16);
        u32x4 ld0[16], ld1[16];
#define SC_ISSUE(dst, s) do { const int sc_ = ((s) < T) ? (s) : T - 1; SC_SRC(sc_, q0_, q1_, pb_) const unsigned go_ = (unsigned)(lane >> 3) * pb_ + (unsigned)(lane & 7) * 16u; \
        _Pragma("unroll") for (int q = 0; q < 16; ++q) dst[q] = *(const u32x4*)(((q >> 3) ? q1_ : q0_) + (size_t)((q & 7) * 8) * pb_ + go_); } while (0)
#define SC_RETIRE(src, s) do { unsigned char* sb = lds + ((s) & 1) * SC_SLOT + loff; _Pragma("unroll") for (int q = 0; q < 16; ++q) \
        *(u32x4*)(sb + (q >> 3) * IMG + (q & 7) * 8 * 144) = src[q]; } while (0)
        SC_ISSUE(ld0, lj); SC_ISSUE(ld1, lj + 4);
        for (int it = 0; it < T / 8; ++it) {
            const int c0 = lj + 8 * it;
            for (int k = 0; k < lj; ++k) LDS_BARRIER();
            SC_RETIRE(ld0, c0); SC_ISSUE(ld0, c0 + 8);
            for (int k = 0; k < 4; ++k) LDS_BARRIER();
            SC_RETIRE(ld1, c0 + 4); SC_ISSUE(ld1, c0 + 12);
            for (int k = 0; k < 4 - lj; ++k) LDS_BARRIER();
        }
        LDS_BARRIER();
#undef SC_ISSUE
#undef SC_RETIRE
    } else {
        f32x4 H[4], Mg[4];
        for (int i = 0; i <= T; ++i) {
            if (i >= 1) {
                const int s = i - 1, u = (int)blockIdx.x + G * (s / SPU), j = s % SPU;
                const unsigned char* sb = lds + (s & 1) * SC_SLOT;
                const bf16_t* MT = (const bf16_t*)sb; const bf16_t* NT = (const bf16_t*)(sb + IMG);
                if (j == 0) {
                    if (MODE == 3) {
#pragma unroll
                        for (int mt = 0; mt < 4; ++mt) H[mt] = unpk4(*(const u32x2*)(HG + (size_t)u * 4096 + (16 * w + l15) * 64 + 16 * mt + 4 * g));
                    } else {
#pragma unroll
                        for (int mt = 0; mt < 4; ++mt) H[mt] = (f32x4){0.f, 0.f, 0.f, 0.f};
                    }
                    if (MODE == 1) {
#pragma unroll
                        for (int mt = 0; mt < 4; ++mt)
#pragma unroll
                            for (int r = 0; r < 4; ++r) Mg[mt][r] = (16 * mt + 4 * g + r == 16 * w + l15) ? 1.f : 0.f;
                    }
                }
                u32x2 hp[4];
#pragma unroll
                for (int mt = 0; mt < 4; ++mt) hp[mt] = pk4(H[mt]);
                if (MODE == 2) {
#pragma unroll
                    for (int mt = 0; mt < 4; ++mt) *(u32x2*)(HG + (size_t)(u * NGRP + j) * 4096 + (16 * w + l15) * 64 + 16 * mt + 4 * g) = hp[mt];
                }
                if (MODE == 3) {
                    const int bh = u >> LG, n = GSZ * (u & (NGRP - 1)) + j;
#pragma unroll
                    for (int mt = 0; mt < 4; ++mt) *(u32x2*)(P + ((size_t)(bh >> 4) * SEQ + (size_t)n * 64 + 16 * w + l15) * PP + 2048 + (bh & 15) * 64 + 16 * mt + 4 * g) = hp[mt];
                }
                bf16x8 hb[2], mb[2];
                hb[0] = as_bf16x8((u32x4){hp[0].x, hp[0].y, hp[1].x, hp[1].y});
                hb[1] = as_bf16x8((u32x4){hp[2].x, hp[2].y, hp[3].x, hp[3].y});
                if (MODE == 1) {
                    const u32x2 m0 = pk4(Mg[0]), m1 = pk4(Mg[1]), m2 = pk4(Mg[2]), m3 = pk4(Mg[3]);
                    mb[0] = as_bf16x8((u32x4){m0.x, m0.y, m1.x, m1.y}); mb[1] = as_bf16x8((u32x4){m2.x, m2.y, m3.x, m3.y});
                }
#pragma unroll
                for (int mt = 0; mt < 4; ++mt) {
                    const bf16x8 a0 = ldfrag(MT, 16 * mt + l15, 8 * g), a1 = ldfrag(MT, 16 * mt + l15, 32 + 8 * g);
                    f32x4 acc = unpk4(*(const u32x2*)(NT + (16 * w + l15) * 72 + 16 * mt + 4 * g));
                    acc = mfma16(a0, hb[0], acc); acc = mfma16(a1, hb[1], acc);
                    H[mt] = acc;
                    if (MODE == 1) { f32x4 am = mfma16(a0, mb[0], (f32x4){0.f, 0.f, 0.f, 0.f}); am = mfma16(a1, mb[1], am); Mg[mt] = am; }
                }
                if (MODE == 1 && j == SPU - 1) {
                    const int pc = 32 * (w >> 1) + 8 * (l15 >> 2) + 4 * (w & 1) + (l15 & 3);
#pragma unroll
                    for (int mt = 0; mt < 4; ++mt) {
                        *(u32x2*)(NG + (size_t)u * 4096 + (16 * w + l15) * 64 + 16 * mt + 4 * g) = pk4(H[mt]);
#pragma unroll
                        for (int r = 0; r < 4; ++r) MG[(size_t)u * 4096 + (16 * mt + 4 * g + r) * 64 + pc] = f2bf(Mg[mt][r]);
                    }
                }
            }
            LDS_BARRIER();
        }
    }
#undef SC_SRC
}

__device__ void rwkv_post(const Params& p, unsigned char* lds) {
    const int tid = threadIdx.x, lane = tid & 63, w = __builtin_amdgcn_readfirstlane(tid >> 6), l15 = lane & 15, g = lane >> 4;
    const bf16_t* P = (const bf16_t*)(p.ws + WS_P);
    bf16_t* Abuf = (bf16_t*)(p.ws + WS_A);
    const bf16_t* Ybuf = (const bf16_t*)(p.ws + WS_Y);
    const float* RK = (const float*)(p.ws + WS_RK);
    const bf16_t* BND = (const bf16_t*)(p.ws + WS_BND);
    float* L = (float*)(lds + w * 8704);
    const int tr = lane >> 3, seg = lane & 7;
    for (int hu = blockIdx.x * 8 + w; hu < 16384; hu += gridDim.x * 8) {
        const int unit = hu >> 1, t0 = (hu & 1) * 32;
        const int bn = unit >> 4, h = unit & 15, n = bn & 255;
        const size_t R0 = (size_t)bn * 64;
        bf16x8 fh[4][2], fr[2][2];
#pragma unroll
        for (int kk = 0; kk < 2; ++kk) {
#pragma unroll
            for (int q = 0; q < 4; ++q) fh[q][kk] = *(const bf16x8*)(P + (R0 + 16 * q + l15) * PP + 2048 + h * 64 + 32 * kk + 8 * g);
#pragma unroll
            for (int q = 0; q < 2; ++q) fr[q][kk] = *(const bf16x8*)(P + (R0 + t0 + 16 * q + l15) * PP + 1024 + h * 64 + 32 * kk + 8 * g);
        }
        u32x4 y0r[4], g1r[4], g0r[4], vpr[4];
        float rkv[4];
#pragma unroll
        for (int i = 0; i < 4; ++i) {
            const int t = t0 + tr + 8 * i;
            y0r[i] = *(const u32x4*)(Abuf + (R0 + t) * DM + h * 64 + 8 * seg);
            const bf16_t* grow = P + (R0 + t) * PP + 3072 + h * 64 + 8 * seg;
            g1r[i] = *(const u32x4*)grow;
            g0r[i] = *(const u32x4*)((t > 0) ? (grow - PP) : (BND + (size_t)(n == 0 ? 0 : bn) * PP + 3072 + h * 64 + 8 * seg));
            vpr[i] = *(const u32x4*)(Ybuf + (R0 + t) * DM + h * 64 + 8 * seg);
            rkv[i] = RK[(R0 + t) * 16 + h];
        }
#pragma unroll
        for (int i = 0; i < 4; ++i) { *(f32x4*)(L + (tr + 8 * i) * 68 + 8 * seg) = lo4(y0r[i]); *(f32x4*)(L + (tr + 8 * i) * 68 + 8 * seg + 4) = hi4(y0r[i]); }
        f32x4 y[4][2];
#pragma unroll
        for (int vt = 0; vt < 4; ++vt)
#pragma unroll
            for (int tt = 0; tt < 2; ++tt) y[vt][tt] = *(const f32x4*)(L + (16 * tt + l15) * 68 + 16 * vt + 4 * g);
#pragma unroll
        for (int vt = 0; vt < 4; ++vt)
#pragma unroll
            for (int tt = 0; tt < 2; ++tt)
#pragma unroll
                for (int kk = 0; kk < 2; ++kk) y[vt][tt] = mfma16(fh[vt][kk], fr[tt][kk], y[vt][tt]);
#pragma unroll
        for (int tt = 0; tt < 2; ++tt) {
            float s1 = 0.f, s2 = 0.f;
#pragma unroll
            for (int vt = 0; vt < 4; ++vt)
#pragma unroll
                for (int r = 0; r < 4; ++r) { s1 += y[vt][tt][r]; s2 += y[vt][tt][r] * y[vt][tt][r]; }
            { const int a16 = (lane ^ 16) * 4, a32 = (lane ^ 32) * 4; s1 += bperm(a16, s1); s2 += bperm(a16, s2); s1 += bperm(a32, s1); s2 += bperm(a32, s2); }
            const float mean = s1 * (1.0f / 64.0f);
            const float rstd = rsqrtf(fmaxf(s2 * (1.0f / 64.0f) - mean * mean, 0.f) + 64e-5f);
#pragma unroll
            for (int vt = 0; vt < 4; ++vt) *(f32x4*)(L + (16 * tt + l15) * 68 + 16 * vt + 4 * g) = (y[vt][tt] - mean) * rstd;
        }
        const int ch = h * 64 + 8 * seg;
        const f32x4 lw0 = *(const f32x4*)(p.in[18] + ch), lw1 = *(const f32x4*)(p.in[18] + ch + 4), lb0 = *(const f32x4*)(p.in[19] + ch), lb1 = *(const f32x4*)(p.in[19] + ch + 4);
        const f32x4 mg0 = *(const f32x4*)(p.in[10] + 3072 + ch), mg1 = *(const f32x4*)(p.in[10] + 3072 + ch + 4);
#pragma unroll
        for (int i = 0; i < 4; ++i) {
            const int t = t0 + tr + 8 * i;
            const f32x4 n0 = *(const f32x4*)(L + (tr + 8 * i) * 68 + 8 * seg), n1 = *(const f32x4*)(L + (tr + 8 * i) * 68 + 8 * seg + 4);
            const f32x4 ga0 = lo4(g1r[i]), ga1 = hi4(g1r[i]);
            const f32x4 gb0 = lo4(g0r[i]), gb1 = hi4(g0r[i]);
            const f32x4 gt0 = ga0 + mg0 * (gb0 - ga0), gt1 = ga1 + mg1 * (gb1 - ga1);
            const f32x4 v0 = lo4(vpr[i]), v1 = hi4(vpr[i]);
            f32x4 o0 = n0 * lw0 + lb0 + rkv[i] * v0, o1 = n1 * lw1 + lb1 + rkv[i] * v1;
#pragma unroll
            for (int j = 0; j < 4; ++j) { o0[j] *= gt0[j] * __builtin_amdgcn_rcpf(1.0f + fexp(-gt0[j])); o1[j] *= gt1[j] * __builtin_amdgcn_rcpf(1.0f + fexp(-gt1[j])); }
            *(u32x4*)(Abuf + (R0 + t) * DM + h * 64 + 8 * seg) = pk8(o0, o1);
        }
    }
}
#define XB_TMO      128
#define XB_XCNT(j)  (256  + 64 * (j))
#define XB_XSUB(j)  (1280 + 64 * (j))
#define XB_XGEN(j)  (2304 + 64 * (j))
#define XB_TOP      3328
#define XB_TOPGEN   3392
#define XCD_BAR_WORDS 3456
#define XB_SPIN_CAP (1u << 18)
#define LAS __attribute__((address_space(3)))

__device__ __forceinline__ unsigned xb_ld(unsigned* p)              { return __hip_atomic_load(p, __ATOMIC_RELAXED, __HIP_MEMORY_SCOPE_AGENT); }
__device__ __forceinline__ unsigned xb_add(unsigned* p, unsigned v) { return __hip_atomic_fetch_add(p, v, __ATOMIC_RELAXED, __HIP_MEMORY_SCOPE_AGENT); }
__device__ __forceinline__ unsigned xb_xcc_id() { return (unsigned)__builtin_amdgcn_s_getreg((3 << 11) | 20) & 0xFu; }
#define XB_SPIN(cond, bar) do { unsigned _sp = 0; while (cond) { __builtin_amdgcn_s_sleep(1); \
    if ((++_sp & 255u) == 0u) { if (xb_ld(&(bar)[XB_TMO])) break; if (_sp > XB_SPIN_CAP) { atomicAdd(&(bar)[XB_TMO], 1u); break; } } } } while (0)

struct XcdBarrier {
    unsigned* bar; unsigned x;
    volatile LAS unsigned* st;
};

__device__ __forceinline__ XcdBarrier xcd_barrier_post(unsigned* bar, volatile LAS unsigned* st) {
    XcdBarrier b; b.bar = bar; b.x = xb_xcc_id(); b.st = st;
    if (threadIdx.x == 0) (void)xb_add(&bar[XB_XCNT(b.x)], 1u);
    return b;
}
__device__ __forceinline__ void xcd_barrier_complete(unsigned* bar, unsigned x, unsigned& nloc, unsigned& nx) {
    const unsigned G = gridDim.x * gridDim.y * gridDim.z;
    unsigned sum, cnt, mine, sp = 0u;
    for (;;) {
        sum = 0u; cnt = 0u; mine = 0u;
#pragma unroll
        for (unsigned j = 0; j < 16; ++j) { const unsigned c = xb_ld(&bar[XB_XCNT(j)]); sum += c; cnt += (c > 0u) ? 1u : 0u; mine = (j == x) ? c : mine; }
        if (sum == G) break;
        __builtin_amdgcn_s_sleep(1);
        if ((++sp & 255u) == 0u) { if (xb_ld(&bar[XB_TMO])) break; if (sp > XB_SPIN_CAP) { atomicAdd(&bar[XB_TMO], 1u); break; } }
    }
    nloc = mine > 0u ? mine : 1u; nx = cnt > 0u ? cnt : 1u;
}

__device__ __forceinline__ void xcd_barrier(const XcdBarrier& b) {
    asm volatile("s_waitcnt vmcnt(0)" ::: "memory");
    __syncthreads();
    if (threadIdx.x == 0) {
        unsigned* bar = b.bar;
        __builtin_amdgcn_s_waitcnt(0);
        unsigned nloc = b.st[0], nx = b.st[1];
        if (nloc == 0u) { xcd_barrier_complete(bar, b.x, nloc, nx); b.st[0] = nloc; b.st[1] = nx; }
        const unsigned old = xb_add(&bar[XB_XSUB(b.x)], 1u);
        const unsigned gen = old / nloc;
        if (old + 1u == (gen + 1u) * nloc) {
            __builtin_amdgcn_fence(__ATOMIC_RELEASE, "agent");
            asm volatile("s_waitcnt vmcnt(0)" ::: "memory");
            const unsigned og = xb_add(&bar[XB_TOP], 1u);
            const unsigned tg = og / nx;
            if (og + 1u == (tg + 1u) * nx) xb_add(&bar[XB_TOPGEN], 1u);
            else XB_SPIN(xb_ld(&bar[XB_TOPGEN]) == tg, bar);
            __builtin_amdgcn_fence(__ATOMIC_ACQUIRE, "agent");
            xb_add(&bar[XB_XGEN(b.x)], 1u);
            asm volatile("s_waitcnt vmcnt(0)" ::: "memory");
        } else {
            XB_SPIN(xb_ld(&bar[XB_XGEN(b.x)]) == gen, bar);
            __builtin_amdgcn_fence(__ATOMIC_ACQUIRE, "agent");
            asm volatile("s_waitcnt vmcnt(0)" ::: "memory");
        }
    }
    __syncthreads();
}


#ifndef PROBE_ID
#define PROBE_ID 0
#endif
#ifndef N_LAUNCH_MODE
#define N_LAUNCH_MODE 1
#endif
constexpr int N_PHASES = 15;

__global__ void __launch_bounds__(NTH, 2) fwd_kernel(Params p) {
    extern __shared__ __attribute__((aligned(16))) unsigned char lds[];
    const int lo = p.ph_lo, hi = p.ph_hi;
    volatile LAS unsigned* xst = (volatile LAS unsigned*)(lds + LDS_BYTES);
    if (threadIdx.x < 4) xst[threadIdx.x] = 0u;
    __syncthreads();
    const XcdBarrier xbar = xcd_barrier_post((unsigned*)(p.ws + WS_BAR), xst);
    unsigned char* ws = p.ws;
#define IN(k) (lo <= (k) && (k) < hi)
#define SEAM(k) do { if ((k) + 1 < hi) xcd_barrier(xbar); } while (0)
    if (IN(0)) {
        prep_weight(p.in[2], GIN, p.in[1], (bf16_t*)(ws + WS_WGIN), GIN_P, (float*)lds);
        prep_weight(p.in[6], DM, nullptr, (bf16_t*)(ws + WS_WGOUT), DM, (float*)lds);
        prep_wup(p.in[3], (bf16_t*)(ws + WS_WUPT));
        __syncthreads();
        phase_norm0(p, lds);
        SEAM(0);
    }
    if (IN(1)) {
        pg8::Gemm g{(const bf16_t*)(ws + WS_A), (const bf16_t*)(ws + WS_WGIN), MTOK, GIN_P, DM}; pg8::StaticOrder S; S.init(MTOK, GIN_P, gridDim.x, blockIdx.x);
        EpiBf16GateSilu E{(bf16_t*)(ws + WS_P), GIN_P};
        pg8::gemm_phase<EpiBf16GateSilu, pg8::StaticOrder>((PG8_LAS unsigned char*)lds, g, S, E);
        SEAM(1);
    }
    if (IN(2)) { gla_pass<false>(p, lds); SEAM(2); }
    if (IN(3)) {
        gla_scan(p);
        prep_weight(p.in[9], RIN, p.in[8], (bf16_t*)(ws + WS_WRIN), RIN_P, (float*)lds);
        prep_weight(p.in[20], DM, nullptr, (bf16_t*)(ws + WS_WROUT), DM, (float*)lds);
        prep_lowrank(p.in[12], (bf16_t*)(ws + WS_WDUT));
        prep_lowrank(p.in[14], (bf16_t*)(ws + WS_WIUT));
        SEAM(3);
    }
    if (IN(4)) { gla_pass<true>(p, lds); SEAM(4); }
    if (IN(5)) {
        pg8::Gemm g{(const bf16_t*)(ws + WS_A), (const bf16_t*)(ws + WS_WGOUT), MTOK, DM, DM}; pg8::StaticOrder S; S.init(MTOK, DM, gridDim.x, blockIdx.x);
        pg8::EpiBf16<0> E{(bf16_t*)(ws + WS_Y), DM, nullptr, 0, 0};
        pg8::gemm_phase<pg8::EpiBf16<0>, pg8::StaticOrder>((PG8_LAS unsigned char*)lds, g, S, E);
        SEAM(5);
    }
    if (IN(6)) { phase_norm1(p); zero_bnd_row((bf16_t*)(ws + WS_BND)); SEAM(6); }
    if (IN(7)) {
        pg8::Gemm g{(const bf16_t*)(ws + WS_A), (const bf16_t*)(ws + WS_WRIN), MTOK, RIN_P, DM}; pg8::StaticOrder S; S.init(MTOK, RIN_P, gridDim.x, blockIdx.x);
        EpiBf16Bnd E{(bf16_t*)(ws + WS_P), RIN_P, (bf16_t*)(ws + WS_BND)};
        pg8::gemm_phase<EpiBf16Bnd, pg8::StaticOrder>((PG8_LAS unsigned char*)lds, g, S, E);
        SEAM(7);
    }
    if (IN(8)) { rwkv_r1(p, lds); SEAM(8); }
    if (IN(9)) { rwkv_scan2<1>(p, lds); SEAM(9); }
    if (IN(10)) { rwkv_scan2<2>(p, lds); SEAM(10); }
    if (IN(11)) { rwkv_scan2<3>(p, lds); SEAM(11); }
    if (IN(12)) { rwkv_post(p, lds); SEAM(12); }
    if (IN(13)) {
        pg8::Gemm g{(const bf16_t*)(ws + WS_A), (const bf16_t*)(ws + WS_WROUT), MTOK, DM, DM}; pg8::StaticOrder S; S.init(MTOK, DM, gridDim.x, blockIdx.x);
        pg8::EpiBf16<0> E{(bf16_t*)(ws + WS_Y), DM, nullptr, 0, 0};
        pg8::gemm_phase<pg8::EpiBf16<0>, pg8::StaticOrder>((PG8_LAS unsigned char*)lds, g, S, E);
        SEAM(13);
    }
    if (IN(14)) { phase_final(p); }
#undef IN
#undef SEAM
}

extern "C" void kernel_launch(void* const* d_in, const int* in_sizes, int n_in, void* d_out, int out_size, void* d_ws, size_t ws_size, hipStream_t stream) {
    static int grid = 0;
    if (grid == 0) {
        int dev = 0, cus = 0, per_cu = 0;
        hipGetDevice(&dev);
        hipDeviceGetAttribute(&cus, hipDeviceAttributeMultiprocessorCount, dev);
        hipFuncSetAttribute((const void*)fwd_kernel, hipFuncAttributeMaxDynamicSharedMemorySize, LDS_BYTES + 16);
        hipOccupancyMaxActiveBlocksPerMultiprocessor(&per_cu, (const void*)fwd_kernel, NTH, LDS_BYTES + 16);
        if (per_cu < 1) { fprintf(stderr, "kernel_launch: occupancy query says %d blocks per CU\n", per_cu); per_cu = 1; }
        grid = cus;
        if (n_in != 22 || ws_size < WS_END) fprintf(stderr, "kernel_launch: unexpected n_in %d or workspace %zu < %zu\n", n_in, ws_size, (size_t)WS_END);
        (void)hipGetLastError();
    }
    if (hipMemsetAsync((char*)d_ws + WS_BAR, 0, XCD_BAR_WORDS * 4, stream) != hipSuccess) fprintf(stderr, "kernel_launch: memset of the barrier words failed\n");
    Params p{};
    for (int i = 0; i < 22; ++i) p.in[i] = (const float*)d_in[i];
    p.out = (float*)d_out; p.ws = (unsigned char*)d_ws;
#if N_LAUNCH_MODE == 1
    void* args[] = {&p};
#if PROBE_ID > 0
    p.ph_lo = 0; p.ph_hi = PROBE_ID;
    (void)hipLaunchCooperativeKernel((const void*)fwd_kernel, dim3(grid), dim3(NTH), args, LDS_BYTES + 16, stream);
    (void)hipMemsetAsync((char*)d_ws + WS_BAR, 0, XCD_BAR_WORDS * 4, stream);
#endif
    p.ph_lo = 0; p.ph_hi = N_PHASES;
    hipError_t e = hipLaunchCooperativeKernel((const void*)fwd_kernel, dim3(grid), dim3(NTH), args, LDS_BYTES + 16, stream);
    if (e != hipSuccess) fprintf(stderr, "cooperative launch failed: %s (grid %d)\n", hipGetErrorString(e), grid);
#else
    for (int k = 0; k < N_PHASES; ++k) {
        p.ph_lo = k; p.ph_hi = k + 1;
        hipLaunchKernelGGL(fwd_kernel, dim3(grid), dim3(NTH), LDS_BYTES + 16, stream, p);
    }
#endif
}
```

```cpp
#include <hip/hip_runtime.h>
#include <hip/hip_cooperative_groups.h>
#include <cstdio>
namespace cg = cooperative_groups;
#define PROBE_ID 0
#define N_LAUNCH_MODE 1
namespace pg8 {
#define PG8_LAS __attribute__((address_space(3)))
typedef unsigned short bf16_t;
typedef short bf16x8 __attribute__((ext_vector_type(8)));
typedef float f32x4 __attribute__((ext_vector_type(4)));
typedef unsigned u32x4 __attribute__((ext_vector_type(4)));
constexpr int BM = 256, BK = 64, HALF = 128, HTB = HALF * BK * 2  , STAGE_BYTES = 8 * HTB, NXCD = 8, WGM = 8;

__host__ __device__ __forceinline__ int lds_byte(int r, int c) { const int st = (r >> 4) * 2 + (c >> 5), rr = r & 15, cc = c & 31, ob = rr * 64 + cc * 2; return st * 1024 + (ob ^ (((ob >> 9) & 1) << 5)); }
__host__ __device__ __forceinline__ void stage_rc(int b, int& R, int& C) { const int st = b / 1024, sb = b % 1024, swz = sb ^ (((sb >> 9) & 1) << 5); R = (st >> 1) * 16 + swz / 64; C = (st & 1) * 32 + (swz % 64) / 2; }
__host__ __device__ __forceinline__ int perm32(int rho) { const int n = rho >> 4, i = rho & 15; return 8 * (i >> 2) + 4 * n + (i & 3); }

struct Unit { int pm, pn; };
struct Gemm { const bf16_t* A; const bf16_t* Bt; int M, N, K; };

struct StaticOrder {
    int nM, nN, nwg, G, c;
    __host__ __device__ void init(int M, int N, int G_, int c_) { nM = M / BM; nN = N / BM; nwg = nM * nN; G = G_; c = c_; }
    __host__ __device__ bool next(int i, Unit& u) const {
        const long L = (long)i * G + c; if (L >= nwg) return false;
        int wgid = (int)L; { const int q = nwg / NXCD, r = nwg % NXCD, xcd = wgid % NXCD, off = wgid / NXCD; wgid = (xcd < r ? xcd * (q + 1) : r * (q + 1) + (xcd - r) * q) + off; }
        const int nig = WGM * nN, gid = wgid / nig, fm = gid * WGM, gsz = (nM - fm) < WGM ? (nM - fm) : WGM;
        u.pm = fm + ((wgid % nig) % gsz); u.pn = (wgid % nig) / gsz; return true;
    }
    __device__ __forceinline__ void a_ready(const Unit&) const {}
    __device__ __forceinline__ void done(const Unit&) const {}
};

typedef float cvt_f32x2 __attribute__((ext_vector_type(2)));
typedef __bf16 cvt_bf16x2 __attribute__((ext_vector_type(2)));
__device__ __forceinline__ unsigned cvt_pk_bf16(float lo, float hi) { const cvt_f32x2 v = {lo, hi}; union { cvt_bf16x2 b; unsigned u; } x; x.b = __builtin_convertvector(v, cvt_bf16x2); return x.u; }
typedef float f32x2 __attribute__((ext_vector_type(2)));
struct EpiF32 {
    static constexpr bool PERM = false, AFTER_DRAIN = false;
    float* C; int ldc; const float* bias;
    __device__ __forceinline__ void operator()(const f32x4 (&acc)[2][2][4][2], const Unit& u, int wr, int wc, int fr, int fq) const {
        const int row0 = u.pm * BM + wr * 64 + fr, col0 = u.pn * BM + wc * 32 + 4 * fq;
        f32x4 bv[2][2];
#pragma unroll
        for (int bj = 0; bj < 2; ++bj)
#pragma unroll
            for (int n = 0; n < 2; ++n) bv[bj][n] = bias ? *(const f32x4*)(bias + col0 + bj * HALF + n * 16) : (f32x4){0.f, 0.f, 0.f, 0.f};
#pragma unroll
        for (int ai = 0; ai < 2; ++ai)
#pragma unroll
            for (int m = 0; m < 4; ++m) { float* rowp = C + (size_t)(row0 + ai * HALF + m * 16) * ldc + col0;
#pragma unroll
                for (int bj = 0; bj < 2; ++bj)
#pragma unroll
                    for (int n = 0; n < 2; ++n) *(f32x4*)(rowp + bj * HALF + n * 16) = acc[ai][bj][m][n] + bv[bj][n]; }
    }
};
template <int ACT  > struct EpiBf16 {
    static constexpr bool PERM = true, AFTER_DRAIN = false;
    bf16_t* O; int ldc; const float* bias; int split_cols; size_t split_stride;
    __device__ __forceinline__ void operator()(const f32x4 (&acc)[2][2][4][2], const Unit& u, int wr, int wc, int fr, int fq) const {
        const int row0 = u.pm * BM + wr * 64 + fr; int colt = u.pn * BM; bf16_t* base = O;
        if (split_cols) { const int t = colt / split_cols; base += (size_t)t * split_stride; colt -= t * split_cols; }
        const int col0 = colt + wc * 32 + 8 * fq, bcol0 = u.pn * BM + wc * 32 + 8 * fq;
        f32x4 bv[2][2];
#pragma unroll
        for (int bj = 0; bj < 2; ++bj)
#pragma unroll
            for (int n = 0; n < 2; ++n) bv[bj][n] = bias ? *(const f32x4*)(bias + bcol0 + bj * HALF + 4 * n) : (f32x4){0.f, 0.f, 0.f, 0.f};
#pragma unroll
        for (int ai = 0; ai < 2; ++ai)
#pragma unroll
            for (int m = 0; m < 4; ++m) { bf16_t* rowp = base + (size_t)(row0 + ai * HALF + m * 16) * ldc + col0;
#pragma unroll
                for (int bj = 0; bj < 2; ++bj) { f32x4 v0 = acc[ai][bj][m][0] + bv[bj][0], v1 = acc[ai][bj][m][1] + bv[bj][1];
                    u32x4 w; w.x = cvt_pk_bf16(v0[0], v0[1]); w.y = cvt_pk_bf16(v0[2], v0[3]); w.z = cvt_pk_bf16(v1[0], v1[1]); w.w = cvt_pk_bf16(v1[2], v1[3]);
                    *(u32x4*)(rowp + bj * HALF) = w; } }
    }
};

template <class Epi, class Sched>
__device__ __forceinline__ void gemm_phase(PG8_LAS unsigned char* lds, const Gemm g, const Sched& S, const Epi& E) {
    const int tid = threadIdx.x, wid = __builtin_amdgcn_readfirstlane(tid >> 6), lane = tid & 63, wr = wid >> 2, wc = wid & 3, fr = lane & 15, fq = lane >> 4;
    const int K = g.K, nt = K / BK;
    unsigned voffA[2], voffB[2];
#pragma unroll
    for (int i = 0; i < 2; ++i) { int R, C; stage_rc(tid * 16 + i * 8192, R, C); const int Rb = Epi::PERM ? ((R & ~31) + perm32(R & 31)) : R;
        voffA[i] = (unsigned)(R * K + C) * 2u; voffB[i] = (unsigned)(Rb * K + C) * 2u; }
    const size_t kstep = (size_t)(BK * 2);
    const size_t hstep = (size_t)HALF * K * 2;
    const size_t tstep = 2 * hstep;
    const unsigned ldsw = (unsigned)wid * 1024u;
    const int aoff = lds_byte(wr * 64 + fr, fq * 8), boff = lds_byte(wc * 32 + fr, fq * 8);
#define PG8_SA(b, h) (((b) * 2 + (h)) * HTB)
#define PG8_SB(b, h) ((4 + (b) * 2 + (h)) * HTB)
#define PG8_STAGE(bufoff, gbase, voff) do { _Pragma("unroll") for (int _i = 0; _i < 2; ++_i) \
        __builtin_amdgcn_global_load_lds((const unsigned*)((const char*)(gbase) + (voff)[_i]), (PG8_LAS unsigned*)(lds + (bufoff) + ldsw + _i * 8192), 16, 0, 0); } while (0)
#define PG8_LDA(dst, b, h) do { _Pragma("unroll") for (int m = 0; m < 4; ++m) _Pragma("unroll") for (int k = 0; k < 2; ++k) dst[m][k] = *(const PG8_LAS bf16x8*)(lds + PG8_SA(b, h) + aoff + m * 2048 + k * 1024); } while (0)
#define PG8_LDB(dst, b, h) do { _Pragma("unroll") for (int n = 0; n < 2; ++n) _Pragma("unroll") for (int k = 0; k < 2; ++k) dst[n][k] = *(const PG8_LAS bf16x8*)(lds + PG8_SB(b, h) + boff + n * 2048 + k * 1024); } while (0)
#define PG8_MMA(ai, bj, At, Bt) do { __builtin_amdgcn_s_setprio(1); _Pragma("unroll") for (int m = 0; m < 4; ++m) _Pragma("unroll") for (int n = 0; n < 2; ++n) _Pragma("unroll") for (int k = 0; k < 2; ++k) \
        acc[ai][bj][m][n] = __builtin_amdgcn_mfma_f32_16x16x32_bf16(Bt[n][k], At[m][k], acc[ai][bj][m][n], 0, 0, 0); __builtin_amdgcn_s_setprio(0); } while (0)
#define PG8_WAIT_V(n) asm volatile("s_waitcnt vmcnt(" #n ")" ::: "memory")
#define PG8_WAIT_L(n) asm volatile("s_waitcnt lgkmcnt(" #n ")" ::: "memory")
#define PG8_BAR __builtin_amdgcn_s_barrier()
#define PG8_SCHED __builtin_amdgcn_sched_barrier(0)
    Unit cur, nxt; int ui = 0;
    if (!S.next(0, cur)) return;
    f32x4 acc[2][2][4][2];
#pragma unroll
    for (int a = 0; a < 2; ++a)
#pragma unroll
        for (int b = 0; b < 2; ++b)
#pragma unroll
            for (int m = 0; m < 4; ++m)
#pragma unroll
                for (int n = 0; n < 2; ++n) acc[a][b][m][n] = (f32x4){0.f, 0.f, 0.f, 0.f};
    bf16x8 At[4][2], B0[2][2], B1[2][2];
    const char* cA = (const char*)g.A + (size_t)cur.pm * tstep; const char* cB = (const char*)g.Bt + (size_t)cur.pn * tstep;
    S.a_ready(cur);
    PG8_STAGE(PG8_SB(0, 0), cB, voffB); PG8_STAGE(PG8_SA(0, 0), cA, voffA); PG8_STAGE(PG8_SB(0, 1), cB + hstep, voffB); PG8_STAGE(PG8_SA(0, 1), cA + hstep, voffA);
    if (wr == 1) PG8_BAR;
    PG8_WAIT_V(4); PG8_BAR;
    PG8_STAGE(PG8_SB(1, 0), cB + kstep, voffB); PG8_STAGE(PG8_SA(1, 0), cA + kstep, voffA); PG8_STAGE(PG8_SB(1, 1), cB + hstep + kstep, voffB);
    PG8_WAIT_V(6); PG8_BAR;
    for (;;) {
        const bool has_next = S.next(ui + 1, nxt);
        const char* nA = has_next ? (const char*)g.A + (size_t)nxt.pm * tstep : cA; const char* nB = has_next ? (const char*)g.Bt + (size_t)nxt.pn * tstep : cB;
        for (int t = 0; t < nt; t += 2) {
            const bool last = (t == nt - 2);
            const char* a1 = cA + (size_t)(t + 1) * kstep;
            const char* a2 = last ? nA : cA + (size_t)(t + 2) * kstep; const char* b2 = last ? nB : cB + (size_t)(t + 2) * kstep;
            const char* a3 = a2 + kstep; const char* b3 = b2 + kstep;
            if (last && has_next) S.a_ready(nxt);
            PG8_LDB(B0, 0, 0); PG8_SCHED; PG8_LDA(At, 0, 0); PG8_STAGE(PG8_SA(1, 1), a1 + hstep, voffA);
            PG8_WAIT_L(8); PG8_BAR; PG8_WAIT_L(0); PG8_MMA(0, 0, At, B0); PG8_BAR; PG8_SCHED;
            PG8_LDB(B1, 0, 1); PG8_STAGE(PG8_SB(0, 0), b2, voffB);
            PG8_BAR; PG8_WAIT_L(0); PG8_MMA(0, 1, At, B1); PG8_BAR;
            PG8_LDA(At, 0, 1); PG8_STAGE(PG8_SA(0, 0), a2, voffA);
            PG8_BAR; PG8_WAIT_L(0); PG8_MMA(1, 0, At, B0); PG8_BAR; PG8_SCHED;
            PG8_STAGE(PG8_SB(0, 1), b2 + hstep, voffB);
            PG8_WAIT_V(6); PG8_BAR; PG8_MMA(1, 1, At, B1); PG8_BAR;
            PG8_LDB(B0, 1, 0); PG8_SCHED; PG8_LDA(At, 1, 0); PG8_STAGE(PG8_SA(0, 1), a2 + hstep, voffA);
            PG8_WAIT_L(8); PG8_BAR; PG8_WAIT_L(0); PG8_MMA(0, 0, At, B0); PG8_BAR; PG8_SCHED;
            PG8_LDB(B1, 1, 1); PG8_STAGE(PG8_SB(1, 0), b3, voffB);
            PG8_BAR; PG8_WAIT_L(0); PG8_MMA(0, 1, At, B1); PG8_BAR;
            PG8_LDA(At, 1, 1); PG8_STAGE(PG8_SA(1, 0), a3, voffA);
            PG8_BAR; PG8_WAIT_L(0); PG8_MMA(1, 0, At, B0); PG8_BAR; PG8_SCHED;
            PG8_STAGE(PG8_SB(1, 1), b3 + hstep, voffB);
            PG8_WAIT_V(6); PG8_BAR; PG8_MMA(1, 1, At, B1); PG8_BAR;
        }
        if constexpr (!Epi::AFTER_DRAIN) { E(acc, cur, wr, wc, fr, fq); S.done(cur); }
        if (!has_next) break;
#pragma unroll
        for (int a = 0; a < 2; ++a)
#pragma unroll
            for (int b = 0; b < 2; ++b)
#pragma unroll
                for (int m = 0; m < 4; ++m)
#pragma unroll
                    for (int n = 0; n < 2; ++n) acc[a][b][m][n] = (f32x4){0.f, 0.f, 0.f, 0.f};
        cur = nxt; cA = nA; cB = nB; ++ui;
    }
    PG8_WAIT_V(0);
    if (wr == 0) PG8_BAR;
    PG8_BAR;
    if constexpr (Epi::AFTER_DRAIN) { E.fused(acc, cur, wr, wc, fr, fq, lds, wid, lane); S.done(cur); }
#undef PG8_SA
#undef PG8_SB
#undef PG8_STAGE
#undef PG8_LDA
#undef PG8_LDB
#undef PG8_MMA
#undef PG8_WAIT_V
#undef PG8_WAIT_L
#undef PG8_BAR
#undef PG8_SCHED
}
}


typedef unsigned short bf16_t;
typedef short bf16x8 __attribute__((ext_vector_type(8)));
typedef float f32x4 __attribute__((ext_vector_type(4)));
typedef unsigned u32x4 __attribute__((ext_vector_type(4)));
typedef unsigned u32x2 __attribute__((ext_vector_type(2)));

constexpr int MTOK = 32768, DM = 1024, SEQ = 16384, NTH = 512;
constexpr int GIN = 3088, GIN_P = 3072, RIN = 4224, RIN_P = 4352;
constexpr int LDS_BYTES = 147456;

constexpr size_t WS_WGIN  = 0;
constexpr size_t WS_WGOUT = WS_WGIN  + (size_t)GIN_P * DM * 2;
constexpr size_t WS_WRIN  = WS_WGOUT + (size_t)DM * DM * 2;
constexpr size_t WS_WROUT = WS_WRIN  + (size_t)RIN_P * DM * 2;
constexpr size_t WS_WDUT  = WS_WROUT + (size_t)DM * DM * 2;
constexpr size_t WS_WIUT  = WS_WDUT  + (size_t)DM * 64 * 2;
constexpr size_t WS_WUPT  = WS_WIUT  + (size_t)DM * 64 * 2;
constexpr size_t WS_A     = WS_WUPT  + (size_t)512 * 16 * 2;
constexpr size_t WS_Y     = WS_A     + (size_t)MTOK * DM * 2;
constexpr size_t WS_GS    = WS_Y     + (size_t)MTOK * DM * 2;
constexpr size_t WS_GD    = WS_GS    + (size_t)24 * 1024 * 1024;
constexpr size_t WS_P     = WS_GD    + (size_t)8 * 32 * 128 * 4;
constexpr size_t WS_BAR   = WS_P     + (size_t)MTOK * RIN_P * 2;
constexpr size_t WS_AD    = WS_BAR   + 16384;
constexpr size_t WS_X1    = WS_AD    + (size_t)MTOK * 16 * 2;
constexpr size_t WS_DUMMY = WS_X1    + (size_t)MTOK * DM * 2;
constexpr size_t WS_END   = WS_DUMMY + 65536;
static_assert(WS_END <= (size_t)512 * 1024 * 1024, "workspace budget (4 x the largest tensor)");

struct Params { const float* in[22]; float* out; unsigned char* ws; int ph_lo, ph_hi; };

__device__ __forceinline__ float bf2f(unsigned b) { return __uint_as_float(b << 16); }
__device__ __forceinline__ bf16_t f2bf(float f) { unsigned u = __float_as_uint(f); u += 0x7FFFu + ((u >> 16) & 1u); return (bf16_t)(u >> 16); }
__device__ __forceinline__ unsigned pk2(float lo, float hi) { return pg8::cvt_pk_bf16(lo, hi); }
__device__ __forceinline__ float wave_sum(float x) {
#pragma unroll
    for (int off = 32; off >= 1; off >>= 1) x += __shfl_xor(x, off);
    return x;
}
__device__ __forceinline__ float bperm(int byte_addr, float x) { return __int_as_float(__builtin_amdgcn_ds_bpermute(byte_addr, __float_as_int(x))); }
template <int CTRL> __device__ __forceinline__ float dpp_mov(float x) { return __int_as_float(__builtin_amdgcn_update_dpp(0, __float_as_int(x), CTRL, 0xF, 0xF, true)); }
__device__ __forceinline__ float sum8(float x) { x += dpp_mov<0xB1>(x); x += dpp_mov<0x4E>(x); x += dpp_mov<0x141>(x); return x; }
__device__ __forceinline__ f32x4 mfma16(bf16x8 a, bf16x8 b, f32x4 c) { return __builtin_amdgcn_mfma_f32_16x16x32_bf16(a, b, c, 0, 0, 0); }
__device__ __forceinline__ bf16x8 as_bf16x8(u32x4 v) { union { u32x4 u; bf16x8 b; } x; x.u = v; return x.b; }
__device__ __forceinline__ float fexp(float x) { return __builtin_amdgcn_exp2f(x * 1.4426950408889634f); }
__device__ __forceinline__ float flog(float x) { return __builtin_amdgcn_logf(x) * 0.6931471805599453f; }
__device__ __forceinline__ float log_sigmoid(float z) { return fminf(z, 0.f) - log1pf(fexp(-fabsf(z))); }
__device__ __forceinline__ float softplus(float z) { return fmaxf(z, 0.f) + log1pf(fexp(-fabsf(z))); }

__device__ void prep_weight(const float* __restrict__ W, int N, const float* __restrict__ gain, bf16_t* __restrict__ Wt, int NP, float* tile) {
    const int tid = threadIdx.x;
    const int nu = (NP / 64) * 16;
    const int lk = tid >> 4, lq = tid & 15;
    const int sn = tid >> 3, ss = tid & 7;
    float4 v[2];
#define PW_LOAD(u_) do { const int n0_ = ((u_) >> 4) * 64, k0_ = ((u_) & 15) * 64; _Pragma("unroll") for (int r = 0; r < 2; ++r) { const int k = k0_ + lk + 32 * r, n = n0_ + 4 * lq; \
        float4 x_ = make_float4(0.f, 0.f, 0.f, 0.f); if (n < N) { x_ = *(const float4*)(W + (size_t)k * N + n); if (gain) { const float g_ = gain[k]; x_.x *= g_; x_.y *= g_; x_.z *= g_; x_.w *= g_; } } v[r] = x_; } } while (0)
    int u = blockIdx.x;
    if (u < nu) PW_LOAD(u);
    for (; u < nu; u += gridDim.x) {
        const int n0 = (u >> 4) * 64, k0 = (u & 15) * 64;
#pragma unroll
        for (int r = 0; r < 2; ++r) *(float4*)(tile + (lk + 32 * r) * 68 + 4 * lq) = v[r];
        if (u + (int)gridDim.x < nu) PW_LOAD(u + gridDim.x);
        __syncthreads();
        {
            float e[8];
#pragma unroll
            for (int q = 0; q < 8; ++q) e[q] = tile[(8 * ss + q) * 68 + sn];
            *(u32x4*)(Wt + (size_t)(n0 + sn) * DM + k0 + 8 * ss) = (u32x4){pk2(e[0], e[1]), pk2(e[2], e[3]), pk2(e[4], e[5]), pk2(e[6], e[7])};
        }
        __syncthreads();
    }
#undef PW_LOAD
}

__device__ void prep_lowrank(const float* __restrict__ src, bf16_t* __restrict__ dst) {
    for (int idx = blockIdx.x * NTH + threadIdx.x; idx < 65536; idx += gridDim.x * NTH) dst[idx] = f2bf(src[(idx & 63) * 1024 + (idx >> 6)]);
}

__device__ void zero_bnd_row(bf16_t* bnd) {
    if (blockIdx.x == 0) for (int i = threadIdx.x; i < RIN_P / 2; i += NTH) ((unsigned*)bnd)[i] = 0u;
}

__device__ void prep_wup(const float* __restrict__ src, bf16_t* __restrict__ dst) {
    for (int idx = blockIdx.x * NTH + threadIdx.x; idx < 8192; idx += gridDim.x * NTH) dst[idx] = f2bf(src[(idx & 15) * 512 + (idx >> 4)]);
}

struct EpiBf16GateSilu {
    static constexpr bool PERM = true, AFTER_DRAIN = false;
    bf16_t* O; int ldc;
    __device__ __forceinline__ void operator()(const f32x4 (&acc)[2][2][4][2], const pg8::Unit& u, int wr, int wc, int fr, int fq) const {
        const int row0 = u.pm * pg8::BM + wr * 64 + fr, col0 = u.pn * pg8::BM + wc * 32 + 8 * fq;
        const bool act = u.pn >= 8;
#pragma unroll
        for (int ai = 0; ai < 2; ++ai)
#pragma unroll
            for (int m = 0; m < 4; ++m) {
                bf16_t* rowp = O + (size_t)(row0 + ai * pg8::HALF + m * 16) * ldc + col0;
#pragma unroll
                for (int bj = 0; bj < 2; ++bj) {
                    f32x4 v0 = acc[ai][bj][m][0], v1 = acc[ai][bj][m][1];
                    if (act) {
#pragma unroll
                        for (int j = 0; j < 4; ++j) { v0[j] *= __builtin_amdgcn_rcpf(1.0f + fexp(-v0[j])); v1[j] *= __builtin_amdgcn_rcpf(1.0f + fexp(-v1[j])); }
                    }
                    u32x4 wv; wv.x = pk2(v0[0], v0[1]); wv.y = pk2(v0[2], v0[3]); wv.z = pk2(v1[0], v1[1]); wv.w = pk2(v1[2], v1[3]);
                    *(u32x4*)(rowp + bj * pg8::HALF) = wv;
                }
            }
    }
};

struct EpiBf16Bnd {
    static constexpr bool PERM = true, AFTER_DRAIN = false;
    bf16_t* O; int ldc; bf16_t* bnd;
    __device__ __forceinline__ void operator()(const f32x4 (&acc)[2][2][4][2], const pg8::Unit& u, int wr, int wc, int fr, int fq) const {
        const int row0 = u.pm * pg8::BM + wr * 64 + fr, col0 = u.pn * pg8::BM + wc * 32 + 8 * fq;
#pragma unroll
        for (int ai = 0; ai < 2; ++ai)
#pragma unroll
            for (int m = 0; m < 4; ++m) {
                const int row = row0 + ai * pg8::HALF + m * 16;
                bf16_t* rowp = O + (size_t)row * ldc + col0;
#pragma unroll
                for (int bj = 0; bj < 2; ++bj) {
                    const f32x4 v0 = acc[ai][bj][m][0], v1 = acc[ai][bj][m][1];
                    u32x4 wv; wv.x = pk2(v0[0], v0[1]); wv.y = pk2(v0[2], v0[3]); wv.z = pk2(v1[0], v1[1]); wv.w = pk2(v1[2], v1[3]);
                    *(u32x4*)(rowp + bj * pg8::HALF) = wv;
                    if (m == 3 && fr == 15) *(u32x4*)(bnd + (size_t)((row >> 6) + 1) * ldc + col0 + bj * pg8::HALF) = wv;
                }
            }
    }
};

__device__ void phase_norm0(const Params& p, unsigned char* lds) {
    const int tid = threadIdx.x, lane = tid & 63, w = tid >> 6, l15 = lane & 15, g = lane >> 4;
    const float* x = p.in[0];
    bf16_t* A = (bf16_t*)(p.ws + WS_A);
    bf16_t* AD = (bf16_t*)(p.ws + WS_AD);
    bf16_t* WAD = (bf16_t*)lds;
    float* PSS = (float*)(lds + 33024);
    float* PAD = (float*)(lds + 33024 + 512);
    for (int e = tid; e < 16384; e += NTH) { const int k = e >> 4, j = e & 15; WAD[j * 1032 + k] = f2bf(p.in[2][(size_t)k * GIN + 3072 + j] * p.in[1][k]); }
    __syncthreads();
    bf16x8 wf[4];
#pragma unroll
    for (int kk = 0; kk < 4; ++kk) wf[kk] = *(const bf16x8*)(WAD + l15 * 1032 + 128 * w + 32 * kk + 8 * g);
    float4 xa[4][2];
    int tile = blockIdx.x;
    if (tile < MTOK / 16) {
#pragma unroll
        for (int kk = 0; kk < 4; ++kk) { const float4* s = (const float4*)(x + (size_t)(16 * tile + l15) * DM + 128 * w + 32 * kk + 8 * g); xa[kk][0] = s[0]; xa[kk][1] = s[1]; }
    }
    for (; tile < MTOK / 16; tile += gridDim.x) {
        float4 xv[4][2];
#pragma unroll
        for (int kk = 0; kk < 4; ++kk) { xv[kk][0] = xa[kk][0]; xv[kk][1] = xa[kk][1]; }
        if (tile + (int)gridDim.x < MTOK / 16) {
#pragma unroll
            for (int kk = 0; kk < 4; ++kk) { const float4* s = (const float4*)(x + (size_t)(16 * (tile + gridDim.x) + l15) * DM + 128 * w + 32 * kk + 8 * g); xa[kk][0] = s[0]; xa[kk][1] = s[1]; }
        }
        float ss = 0.f;
        f32x4 acc = (f32x4){0.f, 0.f, 0.f, 0.f};
#pragma unroll
        for (int kk = 0; kk < 4; ++kk) {
            const float4 a = xv[kk][0], b = xv[kk][1];
            ss += a.x * a.x + a.y * a.y + a.z * a.z + a.w * a.w + b.x * b.x + b.y * b.y + b.z * b.z + b.w * b.w;
            acc = mfma16(as_bf16x8((u32x4){pk2(a.x, a.y), pk2(a.z, a.w), pk2(b.x, b.y), pk2(b.z, b.w)}), wf[kk], acc);
        }
        ss += __shfl_xor(ss, 16); ss += __shfl_xor(ss, 32);
        if (g == 0) PSS[w * 16 + l15] = ss;
        *(f32x4*)(PAD + (w * 64 + lane) * 4) = acc;
        __syncthreads();
        float tot = 0.f;
#pragma unroll
        for (int q = 0; q < 8; ++q) tot += PSS[q * 16 + l15];
        const float rstd = rsqrtf(tot * (1.0f / DM) + 1e-6f);
#pragma unroll
        for (int kk = 0; kk < 4; ++kk) {
            const float4 a = xv[kk][0], b = xv[kk][1];
            *(u32x4*)(A + (size_t)(16 * tile + l15) * DM + 128 * w + 32 * kk + 8 * g) = (u32x4){pk2(a.x * rstd, a.y * rstd), pk2(a.z * rstd, a.w * rstd), pk2(b.x * rstd, b.y * rstd), pk2(b.z * rstd, b.w * rstd)};
        }
        if (w == 0) {
            f32x4 s = (f32x4){0.f, 0.f, 0.f, 0.f};
#pragma unroll
            for (int q = 0; q < 8; ++q) s += *(const f32x4*)(PAD + (q * 64 + lane) * 4);
#pragma unroll
            for (int r = 0; r < 4; ++r) AD[(size_t)(16 * tile + 4 * g + r) * 16 + l15] = f2bf(s[r] * __shfl(rstd, 4 * g + r));
        }
        __syncthreads();
    }
}

__device__ void phase_norm1(const Params& p) {
    const int tid = threadIdx.x, lane = tid & 63, w = tid >> 6;
    const float* x = p.in[0];
    const float* gpost = p.in[7];
    const bf16_t* Y = (const bf16_t*)(p.ws + WS_Y);
    bf16_t* A = (bf16_t*)(p.ws + WS_A);
    bf16_t* X1 = (bf16_t*)(p.ws + WS_X1);
    float4 gp[4];
#pragma unroll
    for (int i = 0; i < 4; ++i) gp[i] = ((const float4*)gpost)[lane + 64 * i];
    const int stride = gridDim.x * 8;
    float4 vn[4]; u32x2 yn[4];
    {
        const int row = blockIdx.x * 8 + w;
#pragma unroll
        for (int i = 0; i < 4; ++i) { vn[i] = ((const float4*)(x + (size_t)row * DM))[lane + 64 * i]; yn[i] = *(const u32x2*)(Y + (size_t)row * DM + 4 * (lane + 64 * i)); }
    }
    for (int row = blockIdx.x * 8 + w; row < MTOK; row += stride) {
        float4 v[4]; u32x2 yv[4];
#pragma unroll
        for (int i = 0; i < 4; ++i) { v[i] = vn[i]; yv[i] = yn[i]; }
        if (row + stride < MTOK) {
#pragma unroll
            for (int i = 0; i < 4; ++i) { vn[i] = ((const float4*)(x + (size_t)(row + stride) * DM))[lane + 64 * i]; yn[i] = *(const u32x2*)(Y + (size_t)(row + stride) * DM + 4 * (lane + 64 * i)); }
        }
        float4 y[4];
        float ss = 0.f;
#pragma unroll
        for (int i = 0; i < 4; ++i) {
            y[i].x = bf2f(yv[i].x & 0xffffu); y[i].y = bf2f(yv[i].x >> 16); y[i].z = bf2f(yv[i].y & 0xffffu); y[i].w = bf2f(yv[i].y >> 16);
            ss += y[i].x * y[i].x + y[i].y * y[i].y + y[i].z * y[i].z + y[i].w * y[i].w;
        }
        ss = wave_sum(ss);
        const float rstdy = rsqrtf(ss * (1.0f / DM) + 1e-6f);
        float s1 = 0.f;
#pragma unroll
        for (int i = 0; i < 4; ++i) {
            v[i].x += y[i].x * rstdy * gp[i].x; v[i].y += y[i].y * rstdy * gp[i].y; v[i].z += y[i].z * rstdy * gp[i].z; v[i].w += y[i].w * rstdy * gp[i].w;
            s1 += v[i].x * v[i].x + v[i].y * v[i].y + v[i].z * v[i].z + v[i].w * v[i].w;
            u32x2 xo; xo.x = pk2(v[i].x, v[i].y); xo.y = pk2(v[i].z, v[i].w);
            *(u32x2*)(X1 + (size_t)row * DM + 4 * (lane + 64 * i)) = xo;
        }
        s1 = wave_sum(s1);
        const float rstd = rsqrtf(s1 * (1.0f / DM) + 1e-6f);
#pragma unroll
        for (int i = 0; i < 4; ++i) {
            u32x2 o; o.x = pk2(v[i].x * rstd, v[i].y * rstd); o.y = pk2(v[i].z * rstd, v[i].w * rstd);
            *(u32x2*)(A + (size_t)row * DM + 4 * (lane + 64 * i)) = o;
        }
    }
}

__device__ void phase_final(const Params& p) {
    const int tid = threadIdx.x, lane = tid & 63, w = tid >> 6;
    const float* gpost = p.in[21];
    const bf16_t* Y = (const bf16_t*)(p.ws + WS_Y);
    const bf16_t* X1 = (const bf16_t*)(p.ws + WS_X1);
    float4 gp[4];
#pragma unroll
    for (int i = 0; i < 4; ++i) gp[i] = ((const float4*)gpost)[lane + 64 * i];
    const int stride = gridDim.x * 8;
    u32x2 xn[4], yn[4];
    {
        const int row = blockIdx.x * 8 + w;
#pragma unroll
        for (int i = 0; i < 4; ++i) { xn[i] = *(const u32x2*)(X1 + (size_t)row * DM + 4 * (lane + 64 * i)); yn[i] = *(const u32x2*)(Y + (size_t)row * DM + 4 * (lane + 64 * i)); }
    }
    for (int row = blockIdx.x * 8 + w; row < MTOK; row += stride) {
        u32x2 xv[4], yv[4];
#pragma unroll
        for (int i = 0; i < 4; ++i) { xv[i] = xn[i]; yv[i] = yn[i]; }
        if (row + stride < MTOK) {
#pragma unroll
            for (int i = 0; i < 4; ++i) { xn[i] = *(const u32x2*)(X1 + (size_t)(row + stride) * DM + 4 * (lane + 64 * i)); yn[i] = *(const u32x2*)(Y + (size_t)(row + stride) * DM + 4 * (lane + 64 * i)); }
        }
        float4 y[4];
        float ss = 0.f;
#pragma unroll
        for (int i = 0; i < 4; ++i) {
            y[i].x = bf2f(yv[i].x & 0xffffu); y[i].y = bf2f(yv[i].x >> 16); y[i].z = bf2f(yv[i].y & 0xffffu); y[i].w = bf2f(yv[i].y >> 16);
            ss += y[i].x * y[i].x + y[i].y * y[i].y + y[i].z * y[i].z + y[i].w * y[i].w;
        }
        ss = wave_sum(ss);
        const float rstdy = rsqrtf(ss * (1.0f / DM) + 1e-6f);
#pragma unroll
        for (int i = 0; i < 4; ++i) {
            float4 v;
            v.x = bf2f(xv[i].x & 0xffffu) + y[i].x * rstdy * gp[i].x; v.y = bf2f(xv[i].x >> 16) + y[i].y * rstdy * gp[i].y;
            v.z = bf2f(xv[i].y & 0xffffu) + y[i].z * rstdy * gp[i].z; v.w = bf2f(xv[i].y >> 16) + y[i].w * rstdy * gp[i].w;
            ((float4*)(p.out + (size_t)row * DM))[lane + 64 * i] = v;
        }
    }
}

constexpr int L_BC = 0, L_ATT = 0, L_QD = 33792, L_KD = L_QD + 64 * 136 * 2, L_KTE = L_KD + 64 * 136 * 2, L_VI = L_KTE + 64 * 152 * 2, L_SSQ = L_VI + 64 * 280 * 2, L_BL = L_SSQ + 2048, L_DEC = L_BL + 512, L_ADL = L_DEC + 512,
              L_GLA_END = L_ADL + 2048;
static_assert(L_GLA_END <= LDS_BYTES, "GLA LDS");
#define GLA_BARRIER() do { asm volatile("s_waitcnt lgkmcnt(0)" ::: "memory"); __builtin_amdgcn_s_barrier(); asm volatile("" ::: "memory"); } while (0)
typedef short gs16x4 __attribute__((ext_vector_type(4)));
__device__ __forceinline__ u32x2 g_trread(const bf16_t* p) { union { gs16x4 s; u32x2 u; } x; x.s = __builtin_amdgcn_ds_read_tr16_b64_v4i16((__attribute__((address_space(3))) gs16x4*)p); return x.u; }
template <int PITCH> __device__ __forceinline__ bf16x8 g_trfrag(const bf16_t* img, int k0, int c0, int g, int q, int pq) {
    const bf16_t* a = img + (k0 + 8 * g + q) * PITCH + c0 + 4 * pq;
    const u32x2 lo = g_trread(a), hi = g_trread(a + 4 * PITCH);
    return as_bf16x8((u32x4){lo.x, lo.y, hi.x, hi.y});
}
__device__ __forceinline__ f32x4 g_lo4(u32x4 v) { return (f32x4){bf2f(v.x & 0xffffu), bf2f(v.x >> 16), bf2f(v.y & 0xffffu), bf2f(v.y >> 16)}; }
__device__ __forceinline__ f32x4 g_hi4(u32x4 v) { return (f32x4){bf2f(v.z & 0xffffu), bf2f(v.z >> 16), bf2f(v.w & 0xffffu), bf2f(v.w >> 16)}; }
__device__ __forceinline__ u32x2 g_pk4(f32x4 v) { u32x2 r; r.x = pk2(v[0], v[1]); r.y = pk2(v[2], v[3]); return r; }
__device__ __forceinline__ f32x4 g_unpk4(u32x2 v) { return (f32x4){bf2f(v.x & 0xffffu), bf2f(v.x >> 16), bf2f(v.y & 0xffffu), bf2f(v.y >> 16)}; }

template <bool OUT> struct GlaRaw { u32x4 q[2], k[2], v[4]; };
template <bool OUT> __device__ __forceinline__ void gla_issue(GlaRaw<OUT>& x, const char* cb  , unsigned offQ, unsigned offV) {
    if (OUT) { x.q[0] = *(const u32x4*)(cb + offQ); x.q[1] = *(const u32x4*)(cb + offQ + 16); }
    x.k[0] = *(const u32x4*)(cb + offQ + 1024); x.k[1] = *(const u32x4*)(cb + offQ + 1040);
#pragma unroll
    for (int i = 0; i < 4; ++i) x.v[i] = *(const u32x4*)(cb + offV + 16 * i);
}

template <bool OUT>
__device__ void gla_pass(const Params& p, unsigned char* lds) {
    const int tid = threadIdx.x, w = __builtin_amdgcn_readfirstlane(tid >> 6);
    const bf16_t* P = (const bf16_t*)(p.ws + WS_P);
    bf16_t* GS = (bf16_t*)(p.ws + WS_GS);
    float* GD = (float*)(p.ws + WS_GD);
    bf16_t* Aout = (bf16_t*)(p.ws + WS_A);
    const bf16_t* WupT = (const bf16_t*)(p.ws + WS_WUPT);
    const bf16_t* ADG = (const bf16_t*)(p.ws + WS_AD);
    float* BC = (float*)(lds + L_BC); bf16_t* ATT = (bf16_t*)(lds + L_ATT); bf16_t* QD = (bf16_t*)(lds + L_QD); bf16_t* KD = (bf16_t*)(lds + L_KD); bf16_t* KTE = (bf16_t*)(lds + L_KTE);
    bf16_t* VI = (bf16_t*)(lds + L_VI); float* SSQ = (float*)(lds + L_SSQ); float* BL = (float*)(lds + L_BL); float* DEC = (float*)(lds + L_DEC); bf16_t* ADL = (bf16_t*)(lds + L_ADL);
    const float* b_al = p.in[4]; const float* g_head = p.in[5];

    for (int unit = blockIdx.x; unit < 256; unit += gridDim.x) {
        const int bh = unit >> 5, m = unit & 31, b = bh >> 2, h = bh & 3;
        int tidv = tid; asm volatile("" : "+v"(tidv));
        const int lane = tidv & 63, l15 = lane & 15, g = lane >> 4, q4 = l15 >> 2, p4 = l15 & 3;
        const int c = tidv >> 3, seg = tidv & 7;
        const int tokbase = b * SEQ + m * 512;
        u32x4 wupq = *(const u32x4*)(WupT + (size_t)(h * 128 + 16 * w + l15) * 16 + 8 * (g & 1));
        if (g >= 2) wupq = (u32x4){0u, 0u, 0u, 0u};
        const bf16x8 wupf = as_bf16x8(wupq);
        const float bA = b_al[h * 128 + 16 * w + l15];
        f32x4 gh[2];
#pragma unroll
        for (int vt = 0; vt < 2; ++vt) gh[vt] = *(const f32x4*)(g_head + 32 * w + 16 * vt + 4 * g);
        float logD = 0.f;
        f32x4 S[8][2];
#pragma unroll
        for (int mt = 0; mt < 8; ++mt)
#pragma unroll
            for (int vt = 0; vt < 2; ++vt) {
                if (OUT) S[mt][vt] = g_unpk4(*(const u32x2*)(GS + ((size_t)(bh * 32 + m) * 256 + 32 * w + 16 * vt + l15) * 128 + 16 * mt + 4 * g));
                else S[mt][vt] = (f32x4){0.f, 0.f, 0.f, 0.f};
            }
        const unsigned offQ = (unsigned)((c * GIN_P + h * 128 + 16 * seg) * 2), offV = (unsigned)((c * GIN_P + 1024 + h * 256 + 32 * seg) * 2), offAD = (unsigned)(tid * 16);
        const unsigned offG = (unsigned)((l15 * GIN_P + 2048 + h * 256 + 32 * w + 4 * g) * 2), offO = (unsigned)((l15 * DM + h * 256 + 32 * w + 4 * g) * 2);
        GlaRaw<OUT> raw;
        gla_issue<OUT>(raw, (const char*)P + (size_t)tokbase * GIN_P * 2, offQ, offV);
        if (tid < 128) *(u32x4*)(ADL + tid * 8) = *(const u32x4*)((const char*)ADG + (size_t)tokbase * 32 + offAD);
        GLA_BARRIER();

        for (int ch = 0; ch < 8; ++ch) {
            const int tok0 = tokbase + ch * 64;
            u32x4 adn = (u32x4){0u, 0u, 0u, 0u};
            {
                if (ch < 7 && tid < 128) adn = *(const u32x4*)((const char*)ADG + (size_t)(tok0 + 64) * 32 + offAD);
                f32x4 sc[4]; float xinc[4], tot[4];
#pragma unroll
                for (int ct = 0; ct < 4; ++ct) {
                    u32x4 aq = *(const u32x4*)(ADL + (16 * ct + l15) * 16 + 8 * (g & 1));
                    if (g >= 2) aq = (u32x4){0u, 0u, 0u, 0u};
                    const f32x4 z = mfma16(as_bf16x8(aq), wupf, (f32x4){bA, bA, bA, bA});
                    float acc = 0.f;
#pragma unroll
                    for (int r = 0; r < 4; ++r) { acc += (fminf(z[r], 0.f) - flog(1.f + fexp(-fabsf(z[r])))) * (1.0f / 16.0f); sc[ct][r] = acc; }
                    xinc[ct] = acc;
                }
#pragma unroll
                for (int ct = 0; ct < 4; ++ct) xinc[ct] += (g >= 1 ? 1.f : 0.f) * bperm(((lane - 16) & 63) * 4, xinc[ct]);
#pragma unroll
                for (int ct = 0; ct < 4; ++ct) xinc[ct] += (g >= 2 ? 1.f : 0.f) * bperm(((lane - 32) & 63) * 4, xinc[ct]);
#pragma unroll
                for (int ct = 0; ct < 4; ++ct) tot[ct] = bperm((48 + l15) * 4, xinc[ct]);
                float run = 0.f;
#pragma unroll
                for (int ct = 0; ct < 4; ++ct) {
                    const float base = run + (xinc[ct] - sc[ct][3]);
                    run += tot[ct];
#pragma unroll
                    for (int r = 0; r < 4; ++r) BC[(16 * ct + 4 * g + r) * 132 + 16 * w + l15] = base + sc[ct][r];
                }
                if (g == 0) { BL[16 * w + l15] = run; DEC[16 * w + l15] = fexp(run); }
                if (!OUT) logD += run;
            }
            GLA_BARRIER();
            u32x2 gate[2][4];
            {
#pragma unroll
                for (int hh = 0; hh < 2; ++hh) {
                    const int o8 = 16 * seg + 8 * hh;
                    const f32x4 bb[2] = {*(const f32x4*)(BC + c * 132 + o8), *(const f32x4*)(BC + c * 132 + o8 + 4)};
                    const f32x4 dc[2] = {*(const f32x4*)(DEC + o8), *(const f32x4*)(DEC + o8 + 4)};
                    const f32x4 kx[2] = {g_lo4(raw.k[hh]), g_hi4(raw.k[hh])};
                    f32x4 qx[2];
                    if (OUT) { qx[0] = g_lo4(raw.q[hh]); qx[1] = g_hi4(raw.q[hh]); }
                    f32x4 kd[2], kt[2], qd[2];
#pragma unroll
                    for (int i = 0; i < 2; ++i)
#pragma unroll
                        for (int j = 0; j < 4; ++j) {
                            const float eB = fexp(bb[i][j]), enB = __builtin_amdgcn_rcpf(eB);
                            kd[i][j] = kx[i][j] * enB; kt[i][j] = kd[i][j] * dc[i][j];
                            if (OUT) qd[i][j] = qx[i][j] * 0.08838834764831845f * eB;
                        }
                    *(u32x4*)(KTE + c * 152 + o8) = (u32x4){pk2(kt[0][0], kt[0][1]), pk2(kt[0][2], kt[0][3]), pk2(kt[1][0], kt[1][1]), pk2(kt[1][2], kt[1][3])};
                    if (OUT) {
                        *(u32x4*)(KD + c * 136 + o8) = (u32x4){pk2(kd[0][0], kd[0][1]), pk2(kd[0][2], kd[0][3]), pk2(kd[1][0], kd[1][1]), pk2(kd[1][2], kd[1][3])};
                        *(u32x4*)(QD + c * 136 + o8) = (u32x4){pk2(qd[0][0], qd[0][1]), pk2(qd[0][2], qd[0][3]), pk2(qd[1][0], qd[1][1]), pk2(qd[1][2], qd[1][3])};
                    }
                }
#pragma unroll
                for (int i = 0; i < 4; ++i) *(u32x4*)(VI + c * 280 + 32 * seg + 8 * i) = raw.v[i];
                if (OUT) {
#pragma unroll
                    for (int vt = 0; vt < 2; ++vt)
#pragma unroll
                        for (int ct = 0; ct < 4; ++ct) gate[vt][ct] = *(const u32x2*)((const char*)P + (size_t)(tok0 + 16 * ct) * GIN_P * 2 + offG + 32 * vt);
                }
                if (ch < 7) gla_issue<OUT>(raw, (const char*)P + (size_t)(tok0 + 64) * GIN_P * 2, offQ, offV);
                if (ch < 7 && tid < 128) *(u32x4*)(ADL + tid * 8) = adn;
            }
            GLA_BARRIER();
            f32x4 o[2][4];
            if (OUT) {
#pragma unroll
                for (int t2 = 0; t2 < 2; ++t2) {
                    const int tl = 2 * w + t2, ct = tl >> 2, st = tl & 3;
                    f32x4 acc = (f32x4){0.f, 0.f, 0.f, 0.f};
                    if (st <= ct) {
#pragma unroll
                        for (int kk = 0; kk < 4; ++kk) {
                            const bf16x8 a = *(const bf16x8*)(KD + (16 * st + l15) * 136 + 32 * kk + 8 * g);
                            const bf16x8 bq = *(const bf16x8*)(QD + (16 * ct + l15) * 136 + 32 * kk + 8 * g);
                            acc = mfma16(a, bq, acc);
                        }
#pragma unroll
                        for (int r = 0; r < 4; ++r) if (16 * st + 4 * g + r > 16 * ct + l15) acc[r] = 0.f;
                    }
                    *(u32x2*)(ATT + (16 * ct + l15) * 72 + 16 * st + 4 * g) = g_pk4(acc);
                }
                GLA_BARRIER();
#pragma unroll
                for (int vt = 0; vt < 2; ++vt)
#pragma unroll
                    for (int ct = 0; ct < 4; ++ct) o[vt][ct] = (f32x4){0.f, 0.f, 0.f, 0.f};
#pragma unroll
                for (int kk = 0; kk < 4; ++kk) {
                    bf16x8 sa[2];
#pragma unroll
                    for (int vt = 0; vt < 2; ++vt) { const u32x2 s0 = g_pk4(S[2 * kk][vt]), s1 = g_pk4(S[2 * kk + 1][vt]); sa[vt] = as_bf16x8((u32x4){s0.x, s0.y, s1.x, s1.y}); }
#pragma unroll
                    for (int ct = 0; ct < 4; ++ct) {
                        const bf16_t* qr = QD + (16 * ct + l15) * 136 + 32 * kk + 4 * g;
                        const u32x2 lo = *(const u32x2*)qr, hi = *(const u32x2*)(qr + 16);
                        const bf16x8 bq = as_bf16x8((u32x4){lo.x, lo.y, hi.x, hi.y});
#pragma unroll
                        for (int vt = 0; vt < 2; ++vt) o[vt][ct] = mfma16(sa[vt], bq, o[vt][ct]);
                    }
                }
            }
            bf16x8 bv[2][2];
#pragma unroll
            for (int vt = 0; vt < 2; ++vt)
#pragma unroll
                for (int kk = 0; kk < 2; ++kk) bv[vt][kk] = g_trfrag<280>(VI, 32 * kk, 32 * w + 16 * vt, g, q4, p4);
            if (OUT) {
#pragma unroll
                for (int ct = 0; ct < 4; ++ct)
#pragma unroll
                    for (int kk = 0; kk < 2; ++kk) {
                        if (32 * kk <= 16 * ct + 15) {
                            const bf16x8 bq = *(const bf16x8*)(ATT + (16 * ct + l15) * 72 + 32 * kk + 8 * g);
#pragma unroll
                            for (int vt = 0; vt < 2; ++vt) o[vt][ct] = mfma16(bv[vt][kk], bq, o[vt][ct]);
                        }
                    }
            }
#pragma unroll
            for (int mt = 0; mt < 8; ++mt) {
                const f32x4 dv = *(const f32x4*)(DEC + 16 * mt + 4 * g);
#pragma unroll
                for (int vt = 0; vt < 2; ++vt) S[mt][vt] *= dv;
#pragma unroll
                for (int kk = 0; kk < 2; ++kk) {
                    const bf16x8 a = g_trfrag<152>(KTE, 32 * kk, 16 * mt, g, q4, p4);
#pragma unroll
                    for (int vt = 0; vt < 2; ++vt) S[mt][vt] = mfma16(a, bv[vt][kk], S[mt][vt]);
                }
            }
            if (OUT) {
                float ss[4];
#pragma unroll
                for (int ct = 0; ct < 4; ++ct) {
                    float s = 0.f;
#pragma unroll
                    for (int vt = 0; vt < 2; ++vt)
#pragma unroll
                        for (int r = 0; r < 4; ++r) s += o[vt][ct][r] * o[vt][ct][r];
                    s += bperm((lane ^ 16) * 4, s); s += bperm((lane ^ 32) * 4, s);
                    ss[ct] = s;
                }
                if (g == 0) {
#pragma unroll
                    for (int ct = 0; ct < 4; ++ct) SSQ[(16 * ct + l15) * 8 + w] = ss[ct];
                }
                GLA_BARRIER();
#pragma unroll
                for (int ct = 0; ct < 4; ++ct) {
                    const int cc = 16 * ct + l15;
                    const float4 s0 = *(const float4*)(SSQ + cc * 8), s1 = *(const float4*)(SSQ + cc * 8 + 4);
                    const float tot = (s0.x + s0.y) + (s0.z + s0.w) + (s1.x + s1.y) + (s1.z + s1.w);
                    const float rstd = rsqrtf(tot * (1.0f / 256.0f) + 1e-6f);
#pragma unroll
                    for (int vt = 0; vt < 2; ++vt) {
                        const f32x4 gt = g_unpk4(gate[vt][ct]);
                        f32x4 val;
#pragma unroll
                        for (int r = 0; r < 4; ++r) val[r] = o[vt][ct][r] * rstd * gh[vt][r] * gt[r];
                        *(u32x2*)((char*)Aout + (size_t)(tok0 + 16 * ct) * DM * 2 + offO + 32 * vt) = g_pk4(val);
                    }
                }
            } else {
                GLA_BARRIER();
            }
        }
        if (!OUT) {
#pragma unroll
            for (int mt = 0; mt < 8; ++mt)
#pragma unroll
                for (int vt = 0; vt < 2; ++vt) *(u32x2*)(GS + ((size_t)(bh * 32 + m) * 256 + 32 * w + 16 * vt + l15) * 128 + 16 * mt + 4 * g) = g_pk4(S[mt][vt]);
            if (g == 0) GD[(bh * 32 + m) * 128 + 16 * w + l15] = fexp(logD);
        }
        GLA_BARRIER();
    }
}

__device__ void gla_scan(const Params& p) {
    bf16_t* GS = (bf16_t*)(p.ws + WS_GS);
    const float* GD = (const float*)(p.ws + WS_GD);
    for (int idx = blockIdx.x * NTH + threadIdx.x; idx < 8 * 8192; idx += gridDim.x * NTH) {
        const int bh = idx >> 13, e = (idx & 8191) * 4, d = e & 127;
        f32x4 S = (f32x4){0.f, 0.f, 0.f, 0.f};
        for (int m0 = 0; m0 < 32; m0 += 8) {
            u32x2 t[8]; f32x4 dd[8];
#pragma unroll
            for (int m = 0; m < 8; ++m) { t[m] = *(const u32x2*)(GS + (size_t)(bh * 32 + m0 + m) * 32768 + e); dd[m] = *(const f32x4*)(GD + (bh * 32 + m0 + m) * 128 + d); }
#pragma unroll
            for (int m = 0; m < 8; ++m) { *(u32x2*)(GS + (size_t)(bh * 32 + m0 + m) * 32768 + e) = g_pk4(S); S = S * dd[m] + g_unpk4(t[m]); }
        }
    }
}

constexpr int PP = RIN_P;
constexpr size_t WS_RK  = WS_GS;
constexpr size_t WS_BND = WS_GS + (size_t)MTOK * 16 * 4;
static_assert(WS_BND + (size_t)513 * PP * 2 <= WS_GD, "RWKV side buffers must fit the GLA state region");
constexpr int IMG = 64 * 72 * 2;
constexpr int R_ALB = 0, R_BH = IMG, R_KH = 2 * IMG, R_RB = 3 * IMG, R_BTL = 4 * IMG, R_KTL = 5 * IMG, R_VI = 6 * IMG, R_AAB = 7 * IMG, R_AAK = 8 * IMG, R_ARB = 9 * IMG, R_ARK = 10 * IMG,
              R_DW = R_AAK, R_DA = R_BH, R_XT = 11 * IMG, R_TW = R_XT, R_ADI = R_XT + IMG, R_TDF = R_XT + 2 * IMG, R_CS = R_TDF + 2048, R_GC = R_CS + 2048, R_CONST = R_GC + 256, R_WDL = R_CONST + 2560, R_WIL = R_WDL + IMG,
              R_END = R_WIL + IMG;
static_assert(R_DW + 64 * 68 * 4 <= R_XT && R_DA + 64 * 68 * 4 <= R_RB && R_END <= LDS_BYTES, "R1 LDS");
#define LDS_BARRIER() do { asm volatile("s_waitcnt lgkmcnt(0)" ::: "memory"); __builtin_amdgcn_s_barrier(); asm volatile("" ::: "memory"); } while (0)

typedef short s16x4 __attribute__((ext_vector_type(4)));
__device__ __forceinline__ bf16x8 ldfrag(const bf16_t* img, int row, int koff) { return *(const bf16x8*)(img + row * 72 + koff); }
__device__ __forceinline__ u32x2 pk4(f32x4 v) { u32x2 r; r.x = pk2(v[0], v[1]); r.y = pk2(v[2], v[3]); return r; }
__device__ __forceinline__ f32x4 unpk4(u32x2 v) { return (f32x4){bf2f(v.x & 0xffffu), bf2f(v.x >> 16), bf2f(v.y & 0xffffu), bf2f(v.y >> 16)}; }
__device__ __forceinline__ u32x2 trread(const bf16_t* p) {
    union { s16x4 s; u32x2 u; } x; x.s = __builtin_amdgcn_ds_read_tr16_b64_v4i16((__attribute__((address_space(3))) s16x4*)p); return x.u;
}
__device__ __forceinline__ bf16x8 trfrag(const bf16_t* img, int k0, int c0, int g, int q, int pq) {
    const bf16_t* a = img + (k0 + 8 * g + q) * 72 + c0 + 4 * pq;
    const u32x2 lo = trread(a), hi = trread(a + 4 * 72);
    return as_bf16x8((u32x4){lo.x, lo.y, hi.x, hi.y});
}
__device__ __forceinline__ f32x4 lo4(u32x4 v) { return (f32x4){bf2f(v.x & 0xffffu), bf2f(v.x >> 16), bf2f(v.y & 0xffffu), bf2f(v.y >> 16)}; }
__device__ __forceinline__ f32x4 hi4(u32x4 v) { return (f32x4){bf2f(v.z & 0xffffu), bf2f(v.z >> 16), bf2f(v.w & 0xffffu), bf2f(v.w >> 16)}; }
__device__ __forceinline__ u32x4 pk8(f32x4 a, f32x4 b) { return (u32x4){pk2(a[0], a[1]), pk2(a[2], a[3]), pk2(b[0], b[1]), pk2(b[2], b[3])}; }
__device__ __forceinline__ float fast_rcp(float x) { return __builtin_amdgcn_rcpf(x); }
__device__ __forceinline__ f32x4 mm16(f32x4 xa, f32x4 yb, f32x4 c) {
    const u32x2 a = pk4(xa), b = pk4(yb);
    return mfma16(as_bf16x8((u32x4){a.x, a.y, 0u, 0u}), as_bf16x8((u32x4){b.x, b.y, 0u, 0u}), c);
}

struct R1Raw { u32x4 r0, r1, k0, k1, v0, v1, w0, w1, a0, a1; };
__device__ __forceinline__ void r1_issue(R1Raw& x, const bf16_t* P, const bf16_t* BND, int unit, int t, int cs) {
    const int bn = unit >> 4, h = unit & 15, n = bn & 255;
    const bf16_t* cur = P + ((size_t)bn * 64 + t) * PP;
    const bf16_t* prv = (t > 0) ? (cur - PP) : (BND + (size_t)(n == 0 ? 0 : bn) * PP);
    const int ch = h * 64 + 8 * cs;
    x.r0 = *(const u32x4*)(cur + ch); x.k0 = *(const u32x4*)(cur + 1024 + ch); x.v0 = *(const u32x4*)(cur + 2048 + ch); x.w0 = *(const u32x4*)(cur + 4096 + 8 * cs); x.a0 = *(const u32x4*)(cur + 4160 + 8 * cs);
    x.r1 = *(const u32x4*)(prv + ch); x.k1 = *(const u32x4*)(prv + 1024 + ch); x.v1 = *(const u32x4*)(prv + 2048 + ch); x.w1 = *(const u32x4*)(prv + 4096 + 8 * cs); x.a1 = *(const u32x4*)(prv + 4160 + 8 * cs);
}
__device__ __forceinline__ void lerp8(u32x4 c, u32x4 pv, const float* mu8, f32x4& o0, f32x4& o1) {
    const f32x4 c0 = lo4(c), c1 = hi4(c), p0 = lo4(pv), p1 = hi4(pv);
    const f32x4 m0 = *(const f32x4*)mu8, m1 = *(const f32x4*)(mu8 + 4);
    o0 = c0 + m0 * (p0 - c0); o1 = c1 + m1 * (p1 - c1);
}

__device__ void rwkv_r1(const Params& p, unsigned char* lds) {
    const int tid = threadIdx.x, w = __builtin_amdgcn_readfirstlane(tid >> 6);
    bf16_t* P = (bf16_t*)(p.ws + WS_P);
    bf16_t* Abuf = (bf16_t*)(p.ws + WS_A);
    bf16_t* Ybuf = (bf16_t*)(p.ws + WS_Y);
    float* RK = (float*)(p.ws + WS_RK);
    const bf16_t* BND = (const bf16_t*)(p.ws + WS_BND);
    const bf16_t* WduT = (const bf16_t*)(p.ws + WS_WDUT);
    const bf16_t* WiuT = (const bf16_t*)(p.ws + WS_WIUT);
    bf16_t* ALB = (bf16_t*)(lds + R_ALB); bf16_t* BH = (bf16_t*)(lds + R_BH); bf16_t* KH = (bf16_t*)(lds + R_KH); bf16_t* RB = (bf16_t*)(lds + R_RB);
    bf16_t* BTL = (bf16_t*)(lds + R_BTL); bf16_t* KTL = (bf16_t*)(lds + R_KTL); bf16_t* VI = (bf16_t*)(lds + R_VI);
    bf16_t* AAB = (bf16_t*)(lds + R_AAB); bf16_t* AAK = (bf16_t*)(lds + R_AAK); bf16_t* ARB = (bf16_t*)(lds + R_ARB); bf16_t* ARK = (bf16_t*)(lds + R_ARK);
    float* DW = (float*)(lds + R_DW); float* DA = (float*)(lds + R_DA);
    bf16_t* XT = (bf16_t*)(lds + R_XT); bf16_t* TW = (bf16_t*)(lds + R_TW); bf16_t* ADI = (bf16_t*)(lds + R_ADI);
    u32x2* TDF = (u32x2*)(lds + R_TDF); float* CS = (float*)(lds + R_CS); float* GCs = (float*)(lds + R_GC); float* CONST = (float*)(lds + R_CONST); bf16_t* WDL = (bf16_t*)(lds + R_WDL); bf16_t* WIL = (bf16_t*)(lds + R_WIL);
    const int t0_ = tid >> 3, cs0_ = tid & 7;
    int hprev = -1;
    R1Raw raw;
    if (blockIdx.x < 8192) r1_issue(raw, P, BND, blockIdx.x, t0_, cs0_);
    {
        u32x4* dmy = (u32x4*)(p.ws + WS_DUMMY) + tid;
#pragma unroll
        for (int k = 0; k < 6; ++k) dmy[k * NTH] = (u32x4){0u, 0u, 0u, 0u};
    }

    for (int unit = blockIdx.x; unit < 8192; unit += gridDim.x) {
        const int bn = unit >> 4, h = unit & 15, n = bn & 255;
        const size_t R0 = (size_t)bn * 64;
        int tidv = tid; asm volatile("" : "+v"(tidv));
        const int lane = tidv & 63, l15 = lane & 15, g = lane >> 4, q4 = l15 >> 2, p4 = l15 & 3, t = tidv >> 3, cs = tidv & 7, tl = lane >> 3;
        if (h != hprev) {
            LDS_BARRIER();
            if (tid < 64) {
                const int ch = h * 64 + tid;
                CONST[tid] = p.in[10][ch]; CONST[64 + tid] = p.in[10][1024 + ch]; CONST[128 + tid] = p.in[10][2048 + ch];
                CONST[192 + tid] = p.in[11][ch]; CONST[256 + tid] = p.in[13][ch]; CONST[320 + tid] = p.in[15][ch]; CONST[384 + tid] = p.in[16][ch]; CONST[448 + tid] = p.in[17][ch];
                CONST[512 + tid] = p.in[10][4096 + tid]; CONST[576 + tid] = p.in[10][4160 + tid];
            }
            {
                const int rr = tid >> 3, sg = tid & 7;
                *(u32x4*)(WDL + rr * 72 + 8 * sg) = *(const u32x4*)(WduT + (size_t)(h * 64 + rr) * 64 + 8 * sg);
                *(u32x4*)(WIL + rr * 72 + 8 * sg) = *(const u32x4*)(WiuT + (size_t)(h * 64 + rr) * 64 + 8 * sg);
            }
            hprev = h;
            LDS_BARRIER();
        }
        f32x4 r0, r1, k0, k1, v0, v1;
        {
            f32x4 wd0, wd1, ad0, ad1;
            lerp8(raw.r0, raw.r1, CONST + 8 * cs, r0, r1);
            lerp8(raw.k0, raw.k1, CONST + 64 + 8 * cs, k0, k1);
            lerp8(raw.v0, raw.v1, CONST + 128 + 8 * cs, v0, v1);
            lerp8(raw.w0, raw.w1, CONST + 512 + 8 * cs, wd0, wd1);
            lerp8(raw.a0, raw.a1, CONST + 576 + 8 * cs, ad0, ad1);
#pragma unroll
            for (int j = 0; j < 4; ++j) {
                const float e0 = __builtin_amdgcn_exp2f(2.8853900817779268f * wd0[j]), e1 = __builtin_amdgcn_exp2f(2.8853900817779268f * wd1[j]);
                wd0[j] = 1.f - 2.f * fast_rcp(1.f + e0); wd1[j] = 1.f - 2.f * fast_rcp(1.f + e1);
            }
            *(u32x4*)(TW + t * 72 + 8 * cs) = pk8(wd0, wd1);
            *(u32x4*)(ADI + t * 72 + 8 * cs) = pk8(ad0, ad1);
        }
        if (unit + (int)gridDim.x < 8192) r1_issue(raw, P, BND, unit + gridDim.x, t, cs);
        {
            const int trow = 8 * w + (l15 & 7);
            const bool lo8 = l15 < 8;
            bf16x8 ft[2], fa[2];
#pragma unroll
            for (int kk = 0; kk < 2; ++kk) { ft[kk] = ldfrag(TW, trow, 32 * kk + 8 * g); fa[kk] = ldfrag(ADI, trow, 32 * kk + 8 * g); }
            float* dst = (lo8 ? DW : DA) + trow * 68 + 4 * g;
#pragma unroll
            for (int ct = 0; ct < 4; ++ct) {
                f32x4 aw = (f32x4){0.f, 0.f, 0.f, 0.f}, aa = aw;
#pragma unroll
                for (int kk = 0; kk < 2; ++kk) { aw = mfma16(ldfrag(WDL, 16 * ct + l15, 32 * kk + 8 * g), ft[kk], aw); aa = mfma16(ldfrag(WIL, 16 * ct + l15, 32 * kk + 8 * g), fa[kk], aa); }
                f32x4 o;
#pragma unroll
                for (int j = 0; j < 4; ++j) o[j] = lo8 ? aw[j] : aa[j];
                *(f32x4*)(dst + 16 * ct) = o;
            }
        }
        f32x4 lw[2], av[2], kk[2], k2[2], G[2];
        {
            const f32x4 cw0[2] = {*(const f32x4*)(CONST + 192 + 8 * cs), *(const f32x4*)(CONST + 196 + 8 * cs)};
            const f32x4 ca0[2] = {*(const f32x4*)(CONST + 256 + 8 * cs), *(const f32x4*)(CONST + 260 + 8 * cs)};
            const f32x4 ckk[2] = {*(const f32x4*)(CONST + 320 + 8 * cs), *(const f32x4*)(CONST + 324 + 8 * cs)};
            const f32x4 cka[2] = {*(const f32x4*)(CONST + 384 + 8 * cs), *(const f32x4*)(CONST + 388 + 8 * cs)};
            const f32x4 crk[2] = {*(const f32x4*)(CONST + 448 + 8 * cs), *(const f32x4*)(CONST + 452 + 8 * cs)};
            const f32x4 dwv[2] = {*(const f32x4*)(DW + t * 68 + 8 * cs), *(const f32x4*)(DW + t * 68 + 8 * cs + 4)};
            const f32x4 dav[2] = {*(const f32x4*)(DA + t * 68 + 8 * cs), *(const f32x4*)(DA + t * 68 + 8 * cs + 4)};
            const f32x4 kin[2] = {k0, k1}, rin[2] = {r0, r1};
            float n2 = 0.f, rk = 0.f;
#pragma unroll
            for (int hf = 0; hf < 2; ++hf)
#pragma unroll
                for (int j = 0; j < 4; ++j) {
                    const float z = -(cw0[hf][j] + dwv[hf][j]);
                    lw[hf][j] = -0.8750387749f * fast_rcp(1.f + __builtin_amdgcn_exp2f(1.4426950408889634f * z));
                    av[hf][j] = fast_rcp(1.f + __builtin_amdgcn_exp2f(-1.4426950408889634f * (ca0[hf][j] + dav[hf][j])));
                    kk[hf][j] = kin[hf][j] * ckk[hf][j];
                    k2[hf][j] = kin[hf][j] * (1.f + (av[hf][j] - 1.f) * cka[hf][j]);
                    n2 += kk[hf][j] * kk[hf][j]; rk += rin[hf][j] * k2[hf][j] * crk[hf][j];
                }
            n2 = sum8(n2); rk = sum8(rk);
            const float inv = __builtin_amdgcn_rsqf(fmaxf(n2, 1e-24f));
            kk[0] *= inv; kk[1] *= inv;
            if (cs == 0) RK[(R0 + t) * 16 + h] = rk;
            G[0] = lw[0]; G[1] = lw[1];
#pragma unroll
            for (int d = 1; d < 8; d <<= 1) {
                const int src = ((lane - 8 * d) & 63) * 4;
                const float keep = (tl >= d) ? 1.f : 0.f;
#pragma unroll
                for (int hf = 0; hf < 2; ++hf)
#pragma unroll
                    for (int j = 0; j < 4; ++j) G[hf][j] += keep * bperm(src, G[hf][j]);
            }
            if (tl == 7) { *(f32x4*)(CS + w * 64 + 8 * cs) = G[0]; *(f32x4*)(CS + w * 64 + 8 * cs + 4) = G[1]; }
        }
        LDS_BARRIER();
        {
            f32x4 off[2] = {(f32x4){0.f, 0.f, 0.f, 0.f}, (f32x4){0.f, 0.f, 0.f, 0.f}}, gc[2] = {off[0], off[0]};
#pragma unroll
            for (int q = 0; q < 8; ++q) {
                const f32x4 c0 = *(const f32x4*)(CS + q * 64 + 8 * cs), c1 = *(const f32x4*)(CS + q * 64 + 8 * cs + 4);
                const float mk = (q < w) ? 1.f : 0.f;
                gc[0] += c0; gc[1] += c1; off[0] += c0 * mk; off[1] += c1 * mk;
            }
            f32x4 al[2], bh[2], kh[2], rb[2];
            const f32x4 rin[2] = {r0, r1};
#pragma unroll
            for (int hf = 0; hf < 2; ++hf)
#pragma unroll
                for (int j = 0; j < 4; ++j) {
                    const float Gi = G[hf][j] + off[hf][j];
                    const float eG = __builtin_amdgcn_exp2f(Gi), eGm = __builtin_amdgcn_exp2f(Gi - lw[hf][j]), enG = fast_rcp(eG);
                    const float be = kk[hf][j] * av[hf][j];
                    al[hf][j] = -kk[hf][j] * eGm; bh[hf][j] = be * enG; kh[hf][j] = k2[hf][j] * enG; rb[hf][j] = rin[hf][j] * eG;
                }
            const int o = t * 72 + 8 * cs;
            *(u32x4*)(ALB + o) = pk8(al[0], al[1]); *(u32x4*)(BH + o) = pk8(bh[0], bh[1]); *(u32x4*)(KH + o) = pk8(kh[0], kh[1]); *(u32x4*)(RB + o) = pk8(rb[0], rb[1]);
            const u32x4 vpk = pk8(v0, v1);
            *(u32x4*)(VI + o) = vpk;
            *(u32x4*)(Ybuf + (R0 + t) * DM + h * 64 + 8 * cs) = vpk;
            if (w == 0 && tl == 0) { f32x4 e0, e1;
#pragma unroll
                for (int j = 0; j < 4; ++j) { e0[j] = __builtin_amdgcn_exp2f(gc[0][j]); e1[j] = __builtin_amdgcn_exp2f(gc[1][j]); }
                *(f32x4*)(GCs + 8 * cs) = e0; *(f32x4*)(GCs + 8 * cs + 4) = e1; }
        }
        LDS_BARRIER();
        {
            int ntile = 1, tta = 0, sta = 0, ttb = 0, stb = 0;
            if (w == 0) { tta = 0; sta = 0; } else if (w == 2) { tta = 1; sta = 1; } else if (w == 5) { tta = 2; sta = 2; } else if (w == 7) { tta = 3; sta = 3; }
            else if (w == 1) { ntile = 2; tta = 1; sta = 0; ttb = 2; stb = 0; } else if (w == 3) { ntile = 2; tta = 2; sta = 1; ttb = 3; stb = 0; }
            else if (w == 4) { tta = 3; sta = 1; } else { tta = 3; sta = 2; }
            for (int it = 0; it < ntile; ++it) {
                const int tt = it ? ttb : tta, st = it ? stb : sta;
                f32x4 cab = (f32x4){0.f, 0.f, 0.f, 0.f}, cak = cab, crb = cab, crk = cab, nab = cab;
#pragma unroll
                for (int kq = 0; kq < 2; ++kq) {
                    const bf16x8 fb = ldfrag(BH, 16 * st + l15, 32 * kq + 8 * g), fk = ldfrag(KH, 16 * st + l15, 32 * kq + 8 * g);
                    const bf16x8 fa = ldfrag(ALB, 16 * tt + l15, 32 * kq + 8 * g), fr = ldfrag(RB, 16 * tt + l15, 32 * kq + 8 * g);
                    cab = mfma16(fb, fa, cab); cak = mfma16(fk, fa, cak); crb = mfma16(fb, fr, crb); crk = mfma16(fk, fr, crk);
                    if (tt == st) nab = mfma16(fa, fb, nab);
                }
                if (tt == st) {
#pragma unroll
                    for (int r = 0; r < 4; ++r) {
                        const int s = 4 * g + r, tq = l15;
                        if (s >= tq) { cab[r] = 0.f; cak[r] = 0.f; }
                        if (s > tq) { crb[r] = 0.f; crk[r] = 0.f; }
                        if (l15 >= 4 * g + r) nab[r] = 0.f;
                    }
                }
                const int o = (16 * tt + l15) * 72 + 16 * st + 4 * g;
                *(u32x2*)(AAB + o) = pk4(cab); *(u32x2*)(AAK + o) = pk4(cak); *(u32x2*)(ARB + o) = pk4(crb); *(u32x2*)(ARK + o) = pk4(crk);
                if (tt == st) {
                    const f32x4 z = (f32x4){0.f, 0.f, 0.f, 0.f};
                    const f32x4 Q1 = cab, N1 = nab;
                    const f32x4 Q2 = mm16(N1, Q1, z), N2 = mm16(Q1, N1, z);
                    f32x4 Pm = Q1;
#pragma unroll
                    for (int r = 0; r < 4; ++r) if (4 * g + r == l15) Pm[r] += 1.f;
                    Pm = mm16(N2, Pm, Pm);
                    const f32x4 Q4 = mm16(N2, Q2, z), N4 = mm16(Q2, N2, z);
                    Pm = mm16(N4, Pm, Pm);
                    const f32x4 N8 = mm16(Q4, N4, z);
                    Pm = mm16(N8, Pm, Pm);
                    TDF[tt * 64 + lane] = pk4(Pm);
                }
            }
            if (w == 4 || w == 6) {
                const int tt = (w == 4) ? 0 : 2, st = tt + 1;
                const int o = (16 * tt + l15) * 72 + 16 * st + 4 * g;
                const u32x2 zz = (u32x2){0u, 0u};
                *(u32x2*)(AAK + o) = zz; *(u32x2*)(ARB + o) = zz; *(u32x2*)(ARK + o) = zz;
            }
        }
        LDS_BARRIER();
        {
            u32x2 xb[4];
            const int col = 16 * w + l15;
            bf16x8 vfr[2];
            if (w >= 4) { vfr[0] = trfrag(VI, 0, 16 * (w - 4), g, q4, p4); vfr[1] = trfrag(VI, 32, 16 * (w - 4), g, q4, p4); }
#pragma unroll
            for (int i = 0; i < 4; ++i) {
                f32x4 z;
                if (w < 4) z = unpk4(trread(ALB + (16 * i + 4 * g + q4) * 72 + 16 * w + 4 * p4));
                else {
                    z = mfma16(ldfrag(AAK, 16 * i + l15, 8 * g), vfr[0], (f32x4){0.f, 0.f, 0.f, 0.f});
                    if (i >= 2) z = mfma16(ldfrag(AAK, 16 * i + l15, 32 + 8 * g), vfr[1], z);
                }
                if (i >= 1) {
                    const bf16_t* ar = AAB + (16 * i + l15) * 72 + 4 * g;
                    const u32x2 a0 = *(const u32x2*)ar;
                    u32x2 a1 = (u32x2){0u, 0u}, b1 = (u32x2){0u, 0u};
                    if (i >= 2) { a1 = *(const u32x2*)(ar + 16); b1 = xb[1]; }
                    z = mfma16(as_bf16x8((u32x4){a0.x, a0.y, a1.x, a1.y}), as_bf16x8((u32x4){xb[0].x, xb[0].y, b1.x, b1.y}), z);
                    if (i == 3) {
                        const u32x2 a2 = *(const u32x2*)(ar + 32);
                        z = mfma16(as_bf16x8((u32x4){a2.x, a2.y, 0u, 0u}), as_bf16x8((u32x4){xb[2].x, xb[2].y, 0u, 0u}), z);
                    }
                }
                const u32x2 tq = TDF[i * 64 + lane];
                const u32x2 zq = pk4(z);
                const f32x4 x = mfma16(as_bf16x8((u32x4){tq.x, tq.y, 0u, 0u}), as_bf16x8((u32x4){zq.x, zq.y, 0u, 0u}), (f32x4){0.f, 0.f, 0.f, 0.f});
                xb[i] = pk4(x);
                *(u32x2*)(XT + col * 72 + 16 * i + 4 * g) = xb[i];
            }
        }
        LDS_BARRIER();
        {
            const int rt_ = w & 3, c0 = 2 * (w >> 2);
            bf16x8 xw[2], xu[2], fbt[2], fkt[2], fvr[2];
#pragma unroll
            for (int kq = 0; kq < 2; ++kq) {
                xw[kq] = ldfrag(XT, 16 * rt_ + l15, 32 * kq + 8 * g);
                xu[kq] = ldfrag(XT, 64 + 16 * rt_ + l15, 32 * kq + 8 * g);
                fbt[kq] = trfrag(BH, 32 * kq, 16 * rt_, g, q4, p4);
                fkt[kq] = trfrag(KH, 32 * kq, 16 * rt_, g, q4, p4);
                fvr[kq] = trfrag(VI, 32 * kq, 16 * rt_, g, q4, p4);
            }
            const float gcd0 = GCs[16 * c0 + l15], gcd1 = GCs[16 * c0 + 16 + l15];
            const f32x4 gcr = *(const f32x4*)(GCs + 16 * rt_ + 4 * g);
#pragma unroll
            for (int q = 0; q < 2; ++q) {
                bf16x8 gbt[2], garb[2], gxu[2], gvi[2], gark[2];
#pragma unroll
                for (int kq = 0; kq < 2; ++kq) {
                    gbt[kq] = trfrag(BH, 32 * kq, 16 * (c0 + q), g, q4, p4);
                    garb[kq] = ldfrag(ARB, 16 * (c0 + q) + l15, 32 * kq + 8 * g);
                    gxu[kq] = ldfrag(XT, 64 + 16 * (c0 + q) + l15, 32 * kq + 8 * g);
                    gvi[kq] = trfrag(VI, 32 * kq, 16 * (c0 + q), g, q4, p4);
                    gark[kq] = ldfrag(ARK, 16 * (c0 + q) + l15, 32 * kq + 8 * g);
                }
                const u32x2 rbi = *(const u32x2*)(RB + (16 * (c0 + q) + l15) * 72 + 16 * rt_ + 4 * g);
                __builtin_amdgcn_sched_barrier(0);
                const int ctile = c0 + q;
                {
                    f32x4 acc = (f32x4){0.f, 0.f, 0.f, 0.f};
#pragma unroll
                    for (int kq = 0; kq < 2; ++kq) acc = mfma16(xw[kq], gbt[kq], acc);
                    const int dcol = 16 * ctile + l15;
                    if (rt_ == ctile) {
#pragma unroll
                        for (int r = 0; r < 4; ++r) if (4 * g + r == l15) acc[r] += 1.f;
                    }
                    acc *= (q ? gcd1 : gcd0);
                    *(u32x2*)(ALB + dcol * 72 + 32 * (rt_ >> 1) + 8 * g + 4 * (rt_ & 1)) = pk4(acc);
                }
                {
                    f32x4 acc = unpk4(rbi);
#pragma unroll
                    for (int kq = 0; kq < 2; ++kq) {
                        if (32 * kq <= 16 * ctile + 15) acc = mfma16(xw[kq], garb[kq], acc);
                    }
                    *(u32x2*)(BTL + (16 * ctile + l15) * 72 + 16 * rt_ + 4 * g) = pk4(acc);
                }
                {
                    f32x4 acc = (f32x4){0.f, 0.f, 0.f, 0.f};
#pragma unroll
                    for (int kq = 0; kq < 2; ++kq) { acc = mfma16(fbt[kq], gxu[kq], acc); acc = mfma16(fkt[kq], gvi[kq], acc); }
                    *(u32x2*)(KTL + (16 * ctile + l15) * 72 + 16 * rt_ + 4 * g) = pk4(acc * gcr);
                }
                {
                    f32x4 acc = (f32x4){0.f, 0.f, 0.f, 0.f};
#pragma unroll
                    for (int kq = 0; kq < 2; ++kq) {
                        if (32 * kq <= 16 * ctile + 15) { acc = mfma16(xu[kq], garb[kq], acc); acc = mfma16(fvr[kq], gark[kq], acc); }
                    }
                    *(u32x2*)(AAB + (16 * ctile + l15) * 72 + 16 * rt_ + 4 * g) = pk4(acc);
                }
            }
        }
        LDS_BARRIER();
        {
            const int o = t * 72 + 8 * cs;
            *(u32x4*)(P + (R0 + t) * PP + h * 64 + 8 * cs) = *(const u32x4*)(ALB + o);
            *(u32x4*)(P + (R0 + t) * PP + 1024 + h * 64 + 8 * cs) = *(const u32x4*)(BTL + o);
            *(u32x4*)(P + (R0 + t) * PP + 2048 + h * 64 + 8 * cs) = *(const u32x4*)(KTL + o);
            *(u32x4*)(Abuf + (R0 + t) * DM + h * 64 + 8 * cs) = *(const u32x4*)(AAB + o);
        }
    }
}

constexpr int SC_SLOT = 2 * IMG;
constexpr size_t WS_MG = (WS_BND + (size_t)513 * PP * 2 + 255) & ~(size_t)255;
constexpr size_t WS_NG = WS_MG + (size_t)1024 * 4096 * 2;
static_assert(WS_NG + (size_t)1024 * 4096 * 2 <= WS_GD, "scan buffers must fit the GLA state region");

template <int MODE>
__device__ void rwkv_scan2(const Params& p, unsigned char* lds) {
    constexpr int GSZ = 32, NGRP = 256 / GSZ, LG = 3;
    constexpr int SPU = (MODE == 2) ? NGRP : GSZ;
    constexpr int NU = (MODE == 2) ? 32 : 32 * NGRP;
    const int tid = threadIdx.x, lane = tid & 63, w = __builtin_amdgcn_readfirstlane(tid >> 6), l15 = lane & 15, g = lane >> 4;
    bf16_t* P = (bf16_t*)(p.ws + WS_P);
    bf16_t* MG = (bf16_t*)(p.ws + WS_MG); bf16_t* NG = (bf16_t*)(p.ws + WS_NG); bf16_t* HG = NG;
    const int G = gridDim.x;
    const int nun = ((int)blockIdx.x < NU) ? (NU - 1 - (int)blockIdx.x) / G + 1 : 0;
    const int T = nun * SPU;
    if (T == 0) return;
#define SC_SRC(s, p0, p1, pitchb) \
    const int u_ = (int)blockIdx.x + G * ((s) / SPU), j_ = (s) % SPU; \
    const char* p0; const char* p1; unsigned pitchb; \
    if (MODE == 2) { p0 = (const char*)(MG + (size_t)(u_ * NGRP + j_) * 4096); p1 = (const char*)(NG + (size_t)(u_ * NGRP + j_) * 4096); pitchb = 128u; } \
    else { const int bh_ = u_ >> LG, n_ = GSZ * (u_ & (NGRP - 1)) + j_; p0 = (const char*)(P + ((size_t)(bh_ >> 4) * SEQ + (size_t)n_ * 64) * PP + (bh_ & 15) * 64); p1 = p0 + 4096; pitchb = (unsigned)(PP * 2); }
    if (w >= 4) {
        const int lj = w - 4;
        const unsigned loff = (unsigned)((lane >> 3) * 144 + (lane & 7) * 16);
        u32x4 ld0[16], ld1[16];
#define SC_ISSUE(dst, s) do { const int sc_ = ((s) < T) ? (s) : T - 1; SC_SRC(sc_, q0_, q1_, pb_) const unsigned go_ = (unsigned)(lane >> 3) * pb_ + (unsigned)(lane & 7) * 16u; \
        _Pragma("unroll") for (int q = 0; q < 16; ++q) dst[q] = *(const u32x4*)(((q >> 3) ? q1_ : q0_) + (size_t)((q & 7) * 8) * pb_ + go_); } while (0)
#define SC_RETIRE(src, s) do { unsigned char* sb = lds + ((s) & 1) * SC_SLOT + loff; _Pragma("unroll") for (int q = 0; q < 16; ++q) \
        *(u32x4*)(sb + (q >> 3) * IMG + (q & 7) * 8 * 144) = src[q]; } while (0)
        SC_ISSUE(ld0, lj); SC_ISSUE(ld1, lj + 4);
        for (int it = 0; it < T / 8; ++it) {
            const int c0 = lj + 8 * it;
            for (int k = 0; k < lj; ++k) LDS_BARRIER();
            SC_RETIRE(ld0, c0); SC_ISSUE(ld0, c0 + 8);
            for (int k = 0; k < 4; ++k) LDS_BARRIER();
            SC_RETIRE(ld1, c0 + 4); SC_ISSUE(ld1, c0 + 12);
            for (int k = 0; k < 4 - lj; ++k) LDS_BARRIER();
        }
        LDS_BARRIER();
#undef SC_ISSUE
#undef SC_RETIRE
    } else {
        f32x4 H[4], Mg[4];
        for (int i = 0; i <= T; ++i) {
            if (i >= 1) {
                const int s = i - 1, u = (int)blockIdx.x + G * (s / SPU), j = s % SPU;
                const unsigned char* sb = lds + (s & 1) * SC_SLOT;
                const bf16_t* MT = (const bf16_t*)sb; const bf16_t* NT = (const bf16_t*)(sb + IMG);
                if (j == 0) {
                    if (MODE == 3) {
#pragma unroll
                        for (int mt = 0; mt < 4; ++mt) H[mt] = unpk4(*(const u32x2*)(HG + (size_t)u * 4096 + (16 * w + l15) * 64 + 16 * mt + 4 * g));
                    } else {
#pragma unroll
                        for (int mt = 0; mt < 4; ++mt) H[mt] = (f32x4){0.f, 0.f, 0.f, 0.f};
                    }
                    if (MODE == 1) {
#pragma unroll
                        for (int mt = 0; mt < 4; ++mt)
#pragma unroll
                            for (int r = 0; r < 4; ++r) Mg[mt][r] = (16 * mt + 4 * g + r == 16 * w + l15) ? 1.f : 0.f;
                    }
                }
                u32x2 hp[4];
#pragma unroll
                for (int mt = 0; mt < 4; ++mt) hp[mt] = pk4(H[mt]);
                if (MODE == 2) {
#pragma unroll
                    for (int mt = 0; mt < 4; ++mt) *(u32x2*)(HG + (size_t)(u * NGRP + j) * 4096 + (16 * w + l15) * 64 + 16 * mt + 4 * g) = hp[mt];
                }
                if (MODE == 3) {
                    const int bh = u >> LG, n = GSZ * (u & (NGRP - 1)) + j;
#pragma unroll
                    for (int mt = 0; mt < 4; ++mt) *(u32x2*)(P + ((size_t)(bh >> 4) * SEQ + (size_t)n * 64 + 16 * w + l15) * PP + 2048 + (bh & 15) * 64 + 16 * mt + 4 * g) = hp[mt];
                }
                bf16x8 hb[2], mb[2];
                hb[0] = as_bf16x8((u32x4){hp[0].x, hp[0].y, hp[1].x, hp[1].y});
                hb[1] = as_bf16x8((u32x4){hp[2].x, hp[2].y, hp[3].x, hp[3].y});
                if (MODE == 1) {
                    const u32x2 m0 = pk4(Mg[0]), m1 = pk4(Mg[1]), m2 = pk4(Mg[2]), m3 = pk4(Mg[3]);
                    mb[0] = as_bf16x8((u32x4){m0.x, m0.y, m1.x, m1.y}); mb[1] = as_bf16x8((u32x4){m2.x, m2.y, m3.x, m3.y});
                }
#pragma unroll
                for (int mt = 0; mt < 4; ++mt) {
                    const bf16x8 a0 = ldfrag(MT, 16 * mt + l15, 8 * g), a1 = ldfrag(MT, 16 * mt + l15, 32 + 8 * g);
                    f32x4 acc = unpk4(*(const u32x2*)(NT + (16 * w + l15) * 72 + 16 * mt + 4 * g));
                    acc = mfma16(a0, hb[0], acc); acc = mfma16(a1, hb[1], acc);
                    H[mt] = acc;
                    if (MODE == 1) { f32x4 am = mfma16(a0, mb[0], (f32x4){0.f, 0.f, 0.f, 0.f}); am = mfma16(a1, mb[1], am); Mg[mt] = am; }
                }
                if (MODE == 1 && j == SPU - 1) {
                    const int pc = 32 * (w >> 1) + 8 * (l15 >> 2) + 4 * (w & 1) + (l15 & 3);
#pragma unroll
                    for (int mt = 0; mt < 4; ++mt) {
                        *(u32x2*)(NG + (size_t)u * 4096 + (16 * w + l15) * 64 + 16 * mt + 4 * g) = pk4(H[mt]);
#pragma unroll
                        for (int r = 0; r < 4; ++r) MG[(size_t)u * 4096 + (16 * mt + 4 * g + r) * 64 + pc] = f2bf(Mg[mt][r]);
                    }
                }
            }
            LDS_BARRIER();
        }
    }
#undef SC_SRC
}

__device__ void rwkv_post(const Params& p, unsigned char* lds) {
    const int tid = threadIdx.x, lane = tid & 63, w = __builtin_amdgcn_readfirstlane(tid >> 6), l15 = lane & 15, g = lane >> 4;
    const bf16_t* P = (const bf16_t*)(p.ws + WS_P);
    bf16_t* Abuf = (bf16_t*)(p.ws + WS_A);
    const bf16_t* Ybuf = (const bf16_t*)(p.ws + WS_Y);
    const float* RK = (const float*)(p.ws + WS_RK);
    const bf16_t* BND = (const bf16_t*)(p.ws + WS_BND);
    float* L = (float*)(lds + w * 8704);
    const int tr = lane >> 3, seg = lane & 7;
    for (int hu = blockIdx.x * 8 + w; hu < 16384; hu += gridDim.x * 8) {
        const int unit = hu >> 1, t0 = (hu & 1) * 32;
        const int bn = unit >> 4, h = unit & 15, n = bn & 255;
        const size_t R0 = (size_t)bn * 64;
        bf16x8 fh[4][2], fr[2][2];
#pragma unroll
        for (int kk = 0; kk < 2; ++kk) {
#pragma unroll
            for (int q = 0; q < 4; ++q) fh[q][kk] = *(const bf16x8*)(P + (R0 + 16 * q + l15) * PP + 2048 + h * 64 + 32 * kk + 8 * g);
#pragma unroll
            for (int q = 0; q < 2; ++q) fr[q][kk] = *(const bf16x8*)(P + (R0 + t0 + 16 * q + l15) * PP + 1024 + h * 64 + 32 * kk + 8 * g);
        }
        u32x4 y0r[4], g1r[4], g0r[4], vpr[4];
        float rkv[4];
#pragma unroll
        for (int i = 0; i < 4; ++i) {
            const int t = t0 + tr + 8 * i;
            y0r[i] = *(const u32x4*)(Abuf + (R0 + t) * DM + h * 64 + 8 * seg);
            const bf16_t* grow = P + (R0 + t) * PP + 3072 + h * 64 + 8 * seg;
            g1r[i] = *(const u32x4*)grow;
            g0r[i] = *(const u32x4*)((t > 0) ? (grow - PP) : (BND + (size_t)(n == 0 ? 0 : bn) * PP + 3072 + h * 64 + 8 * seg));
            vpr[i] = *(const u32x4*)(Ybuf + (R0 + t) * DM + h * 64 + 8 * seg);
            rkv[i] = RK[(R0 + t) * 16 + h];
        }
#pragma unroll
        for (int i = 0; i < 4; ++i) { *(f32x4*)(L + (tr + 8 * i) * 68 + 8 * seg) = lo4(y0r[i]); *(f32x4*)(L + (tr + 8 * i) * 68 + 8 * seg + 4) = hi4(y0r[i]); }
        f32x4 y[4][2];
#pragma unroll
        for (int vt = 0; vt < 4; ++vt)
#pragma unroll
            for (int tt = 0; tt < 2; ++tt) y[vt][tt] = *(const f32x4*)(L + (16 * tt + l15) * 68 + 16 * vt + 4 * g);
#pragma unroll
        for (int vt = 0; vt < 4; ++vt)
#pragma unroll
            for (int tt = 0; tt < 2; ++tt)
#pragma unroll
                for (int kk = 0; kk < 2; ++kk) y[vt][tt] = mfma16(fh[vt][kk], fr[tt][kk], y[vt][tt]);
#pragma unroll
        for (int tt = 0; tt < 2; ++tt) {
            float s1 = 0.f, s2 = 0.f;
#pragma unroll
            for (int vt = 0; vt < 4; ++vt)
#pragma unroll
                for (int r = 0; r < 4; ++r) { s1 += y[vt][tt][r]; s2 += y[vt][tt][r] * y[vt][tt][r]; }
            { const int a16 = (lane ^ 16) * 4, a32 = (lane ^ 32) * 4; s1 += bperm(a16, s1); s2 += bperm(a16, s2); s1 += bperm(a32, s1); s2 += bperm(a32, s2); }
            const float mean = s1 * (1.0f / 64.0f);
            const float rstd = rsqrtf(fmaxf(s2 * (1.0f / 64.0f) - mean * mean, 0.f) + 64e-5f);
#pragma unroll
            for (int vt = 0; vt < 4; ++vt) *(f32x4*)(L + (16 * tt + l15) * 68 + 16 * vt + 4 * g) = (y[vt][tt] - mean) * rstd;
        }
        const int ch = h * 64 + 8 * seg;
        const f32x4 lw0 = *(const f32x4*)(p.in[18] + ch), lw1 = *(const f32x4*)(p.in[18] + ch + 4), lb0 = *(const f32x4*)(p.in[19] + ch), lb1 = *(const f32x4*)(p.in[19] + ch + 4);
        const f32x4 mg0 = *(const f32x4*)(p.in[10] + 3072 + ch), mg1 = *(const f32x4*)(p.in[10] + 3072 + ch + 4);
#pragma unroll
        for (int i = 0; i < 4; ++i) {
            const int t = t0 + tr + 8 * i;
            const f32x4 n0 = *(const f32x4*)(L + (tr + 8 * i) * 68 + 8 * seg), n1 = *(const f32x4*)(L + (tr + 8 * i) * 68 + 8 * seg + 4);
            const f32x4 ga0 = lo4(g1r[i]), ga1 = hi4(g1r[i]);
            const f32x4 gb0 = lo4(g0r[i]), gb1 = hi4(g0r[i]);
            const f32x4 gt0 = ga0 + mg0 * (gb0 - ga0), gt1 = ga1 + mg1 * (gb1 - ga1);
            const f32x4 v0 = lo4(vpr[i]), v1 = hi4(vpr[i]);
            f32x4 o0 = n0 * lw0 + lb0 + rkv[i] * v0, o1 = n1 * lw1 + lb1 + rkv[i] * v1;
#pragma unroll
            for (int j = 0; j < 4; ++j) { o0[j] *= gt0[j] * __builtin_amdgcn_rcpf(1.0f + fexp(-gt0[j])); o1[j] *= gt1[j] * __builtin_amdgcn_rcpf(1.0f + fexp(-gt1[j])); }
            *(u32x4*)(Abuf + (R0 + t) * DM + h * 64 + 8 * seg) = pk8(o0, o1);
        }
    }
}
#define XB_TMO      128
#define XB_XCNT(j)  (256  + 64 * (j))
#define XB_XSUB(j)  (1280 + 64 * (j))
#define XB_XGEN(j)  (2304 + 64 * (j))
#define XB_TOP      3328
#define XB_TOPGEN   3392
#define XCD_BAR_WORDS 3456
#define XB_SPIN_CAP (1u << 18)
#define LAS __attribute__((address_space(3)))

__device__ __forceinline__ unsigned xb_ld(unsigned* p)              { return __hip_atomic_load(p, __ATOMIC_RELAXED, __HIP_MEMORY_SCOPE_AGENT); }
__device__ __forceinline__ unsigned xb_add(unsigned* p, unsigned v) { return __hip_atomic_fetch_add(p, v, __ATOMIC_RELAXED, __HIP_MEMORY_SCOPE_AGENT); }
__device__ __forceinline__ unsigned xb_xcc_id() { return (unsigned)__builtin_amdgcn_s_getreg((3 << 11) | 20) & 0xFu; }
#define XB_SPIN(cond, bar) do { unsigned _sp = 0; while (cond) { __builtin_amdgcn_s_sleep(1); \
    if ((++_sp & 255u) == 0u) { if (xb_ld(&(bar)[XB_TMO])) break; if (_sp > XB_SPIN_CAP) { atomicAdd(&(bar)[XB_TMO], 1u); break; } } } } while (0)

struct XcdBarrier {
    unsigned* bar; unsigned x;
    volatile LAS unsigned* st;
};

__device__ __forceinline__ XcdBarrier xcd_barrier_post(unsigned* bar, volatile LAS unsigned* st) {
    XcdBarrier b; b.bar = bar; b.x = xb_xcc_id(); b.st = st;
    if (threadIdx.x == 0) (void)xb_add(&bar[XB_XCNT(b.x)], 1u);
    return b;
}
__device__ __forceinline__ void xcd_barrier_complete(unsigned* bar, unsigned x, unsigned& nloc, unsigned& nx) {
    const unsigned G = gridDim.x * gridDim.y * gridDim.z;
    unsigned sum, cnt, mine, sp = 0u;
    for (;;) {
        sum = 0u; cnt = 0u; mine = 0u;
#pragma unroll
        for (unsigned j = 0; j < 16; ++j) { const unsigned c = xb_ld(&bar[XB_XCNT(j)]); sum += c; cnt += (c > 0u) ? 1u : 0u; mine = (j == x) ? c : mine; }
        if (sum == G) break;
        __builtin_amdgcn_s_sleep(1);
        if ((++sp & 255u) == 0u) { if (xb_ld(&bar[XB_TMO])) break; if (sp > XB_SPIN_CAP) { atomicAdd(&bar[XB_TMO], 1u); break; } }
    }
    nloc = mine > 0u ? mine : 1u; nx = cnt > 0u ? cnt : 1u;
}

__device__ __forceinline__ void xcd_barrier(const XcdBarrier& b) {
    asm volatile("s_waitcnt vmcnt(0)" ::: "memory");
    __syncthreads();
    if (threadIdx.x == 0) {
        unsigned* bar = b.bar;
        __builtin_amdgcn_s_waitcnt(0);
        unsigned nloc = b.st[0], nx = b.st[1];
        if (nloc == 0u) { xcd_barrier_complete(bar, b.x, nloc, nx); b.st[0] = nloc; b.st[1] = nx; }
        const unsigned old = xb_add(&bar[XB_XSUB(b.x)], 1u);
        const unsigned gen = old / nloc;
        if (old + 1u == (gen + 1u) * nloc) {
            __builtin_amdgcn_fence(__ATOMIC_RELEASE, "agent");
            asm volatile("s_waitcnt vmcnt(0)" ::: "memory");
            const unsigned og = xb_add(&bar[XB_TOP], 1u);
            const unsigned tg = og / nx;
            if (og + 1u == (tg + 1u) * nx) xb_add(&bar[XB_TOPGEN], 1u);
            else XB_SPIN(xb_ld(&bar[XB_TOPGEN]) == tg, bar);
            __builtin_amdgcn_fence(__ATOMIC_ACQUIRE, "agent");
            xb_add(&bar[XB_XGEN(b.x)], 1u);
            asm volatile("s_waitcnt vmcnt(0)" ::: "memory");
        } else {
            XB_SPIN(xb_ld(&bar[XB_XGEN(b.x)]) == gen, bar);
            __builtin_amdgcn_fence(__ATOMIC_ACQUIRE, "agent");
            asm volatile("s_waitcnt vmcnt(0)" ::: "memory");
        }
    }
    __syncthreads();
}


#ifndef PROBE_ID
#define PROBE_ID 0
#endif
#ifndef N_LAUNCH_MODE
#define N_LAUNCH_MODE 1
#endif
constexpr int N_PHASES = 15;

__global__ void __launch_bounds__(NTH, 2) fwd_kernel(Params p) {
    extern __shared__ __attribute__((aligned(16))) unsigned char lds[];
    const int lo = p.ph_lo, hi = p.ph_hi;
    volatile LAS unsigned* xst = (volatile LAS unsigned*)(lds + LDS_BYTES);
    if (threadIdx.x < 4) xst[threadIdx.x] = 0u;
    __syncthreads();
    const XcdBarrier xbar = xcd_barrier_post((unsigned*)(p.ws + WS_BAR), xst);
    unsigned char* ws = p.ws;
#define IN(k) (lo <= (k) && (k) < hi)
#define SEAM(k) do { if ((k) + 1 < hi) xcd_barrier(xbar); } while (0)
    if (IN(0)) {
        prep_weight(p.in[2], GIN, p.in[1], (bf16_t*)(ws + WS_WGIN), GIN_P, (float*)lds);
        prep_weight(p.in[6], DM, nullptr, (bf16_t*)(ws + WS_WGOUT), DM, (float*)lds);
        prep_wup(p.in[3], (bf16_t*)(ws + WS_WUPT));
        __syncthreads();
        phase_norm0(p, lds);
        SEAM(0);
    }
    if (IN(1)) {
        pg8::Gemm g{(const bf16_t*)(ws + WS_A), (const bf16_t*)(ws + WS_WGIN), MTOK, GIN_P, DM}; pg8::StaticOrder S; S.init(MTOK, GIN_P, gridDim.x, blockIdx.x);
        EpiBf16GateSilu E{(bf16_t*)(ws + WS_P), GIN_P};
        pg8::gemm_phase<EpiBf16GateSilu, pg8::StaticOrder>((PG8_LAS unsigned char*)lds, g, S, E);
        SEAM(1);
    }
    if (IN(2)) { gla_pass<false>(p, lds); SEAM(2); }
    if (IN(3)) {
        gla_scan(p);
        prep_weight(p.in[9], RIN, p.in[8], (bf16_t*)(ws + WS_WRIN), RIN_P, (float*)lds);
        prep_weight(p.in[20], DM, nullptr, (bf16_t*)(ws + WS_WROUT), DM, (float*)lds);
        prep_lowrank(p.in[12], (bf16_t*)(ws + WS_WDUT));
        prep_lowrank(p.in[14], (bf16_t*)(ws + WS_WIUT));
        SEAM(3);
    }
    if (IN(4)) { gla_pass<true>(p, lds); SEAM(4); }
    if (IN(5)) {
        pg8::Gemm g{(const bf16_t*)(ws + WS_A), (const bf16_t*)(ws + WS_WGOUT), MTOK, DM, DM}; pg8::StaticOrder S; S.init(MTOK, DM, gridDim.x, blockIdx.x);
        pg8::EpiBf16<0> E{(bf16_t*)(ws + WS_Y), DM, nullptr, 0, 0};
        pg8::gemm_phase<pg8::EpiBf16<0>, pg8::StaticOrder>((PG8_LAS unsigned char*)lds, g, S, E);
        SEAM(5);
    }
    if (IN(6)) { phase_norm1(p); zero_bnd_row((bf16_t*)(ws + WS_BND)); SEAM(6); }
    if (IN(7)) {
        pg8::Gemm g{(const bf16_t*)(ws + WS_A), (const bf16_t*)(ws + WS_WRIN), MTOK, RIN_P, DM}; pg8::StaticOrder S; S.init(MTOK, RIN_P, gridDim.x, blockIdx.x);
        EpiBf16Bnd E{(bf16_t*)(ws + WS_P), RIN_P, (bf16_t*)(ws + WS_BND)};
        pg8::gemm_phase<EpiBf16Bnd, pg8::StaticOrder>((PG8_LAS unsigned char*)lds, g, S, E);
        SEAM(7);
    }
    if (IN(8)) { rwkv_r1(p, lds); SEAM(8); }
    if (IN(9)) { rwkv_scan2<1>(p, lds); SEAM(9); }
    if (IN(10)) { rwkv_scan2<2>(p, lds); SEAM(10); }
    if (IN(11)) { rwkv_scan2<3>(p, lds); SEAM(11); }
    if (IN(12)) { rwkv_post(p, lds); SEAM(12); }
    if (IN(13)) {
        pg8::Gemm g{(const bf16_t*)(ws + WS_A), (const bf16_t*)(ws + WS_WROUT), MTOK, DM, DM}; pg8::StaticOrder S; S.init(MTOK, DM, gridDim.x, blockIdx.x);
        pg8::EpiBf16<0> E{(bf16_t*)(ws + WS_Y), DM, nullptr, 0, 0};
        pg8::gemm_phase<pg8::EpiBf16<0>, pg8::StaticOrder>((PG8_LAS unsigned char*)lds, g, S, E);
        SEAM(13);
    }
    if (IN(14)) { phase_final(p); }
#undef IN
#undef SEAM
}

extern "C" void kernel_launch(void* const* d_in, const int* in_sizes, int n_in, void* d_out, int out_size, void* d_ws, size_t ws_size, hipStream_t stream) {
    static int grid = 0;
    if (grid == 0) {
        int dev = 0, cus = 0, per_cu = 0;
        hipGetDevice(&dev);
        hipDeviceGetAttribute(&cus, hipDeviceAttributeMultiprocessorCount, dev);
        hipFuncSetAttribute((const void*)fwd_kernel, hipFuncAttributeMaxDynamicSharedMemorySize, LDS_BYTES + 16);
        hipOccupancyMaxActiveBlocksPerMultiprocessor(&per_cu, (const void*)fwd_kernel, NTH, LDS_BYTES + 16);
        if (per_cu < 1) { fprintf(stderr, "kernel_launch: occupancy query says %d blocks per CU\n", per_cu); per_cu = 1; }
        grid = cus;
        if (n_in != 22 || ws_size < WS_END) fprintf(stderr, "kernel_launch: unexpected n_in %d or workspace %zu < %zu\n", n_in, ws_size, (size_t)WS_END);
        (void)hipGetLastError();
    }
    if (hipMemsetAsync((char*)d_ws + WS_BAR, 0, XCD_BAR_WORDS * 4, stream) != hipSuccess) fprintf(stderr, "kernel_launch: memset of the barrier words failed\n");
    Params p{};
    for (int i = 0; i < 22; ++i) p.in[i] = (const float*)d_in[i];
    p.out = (float*)d_out; p.ws = (unsigned char*)d_ws;
#if N_LAUNCH_MODE == 1
    void* args[] = {&p};
#if PROBE_ID > 0
    p.ph_lo = 0; p.ph_hi = PROBE_ID;
    (void)hipLaunchCooperativeKernel((const void*)fwd_kernel, dim3(grid), dim3(NTH), args, LDS_BYTES + 16, stream);
    (void)hipMemsetAsync((char*)d_ws + WS_BAR, 0, XCD_BAR_WORDS * 4, stream);
#endif
    p.ph_lo = 0; p.ph_hi = N_PHASES;
    hipError_t e = hipLaunchCooperativeKernel((const void*)fwd_kernel, dim3(grid), dim3(NTH), args, LDS_BYTES + 16, stream);
    if (e != hipSuccess) fprintf(stderr, "cooperative launch failed: %s (grid %d)\n", hipGetErrorString(e), grid);
#else
    for (int k = 0; k < N_PHASES; ++k) {
        p.ph_lo = k; p.ph_hi = k + 1;
        hipLaunchKernelGGL(fwd_kernel, dim3(grid), dim3(NTH), LDS_BYTES + 16, stream, p);
    }
#endif
}
```

```cpp
#include <hip/hip_runtime.h>
#include <hip/hip_cooperative_groups.h>
#include <cstdio>
namespace cg = cooperative_groups;
#define PROBE_ID 0
#define N_LAUNCH_MODE 1
namespace pg8 {
#define PG8_LAS __attribute__((address_space(3)))
typedef unsigned short bf16_t;
typedef short bf16x8 __attribute__((ext_vector_type(8)));
typedef float f32x4 __attribute__((ext_vector_type(4)));
typedef unsigned u32x4 __attribute__((ext_vector_type(4)));
constexpr int BM = 256, BK = 64, HALF = 128, HTB = HALF * BK * 2  , STAGE_BYTES = 8 * HTB, NXCD = 8, WGM = 8;

__host__ __device__ __forceinline__ int lds_byte(int r, int c) { const int st = (r >> 4) * 2 + (c >> 5), rr = r & 15, cc = c & 31, ob = rr * 64 + cc * 2; return st * 1024 + (ob ^ (((ob >> 9) & 1) << 5)); }
__host__ __device__ __forceinline__ void stage_rc(int b, int& R, int& C) { const int st = b / 1024, sb = b % 1024, swz = sb ^ (((sb >> 9) & 1) << 5); R = (st >> 1) * 16 + swz / 64; C = (st & 1) * 32 + (swz % 64) / 2; }
__host__ __device__ __forceinline__ int perm32(int rho) { const int n = rho >> 4, i = rho & 15; return 8 * (i >> 2) + 4 * n + (i & 3); }

struct Unit { int pm, pn; };
struct Gemm { const bf16_t* A; const bf16_t* Bt; int M, N, K; };

struct StaticOrder {
    int nM, nN, nwg, G, c;
    __host__ __device__ void init(int M, int N, int G_, int c_) { nM = M / BM; nN = N / BM; nwg = nM * nN; G = G_; c = c_; }
    __host__ __device__ bool next(int i, Unit& u) const {
        const long L = (long)i * G + c; if (L >= nwg) return false;
        int wgid = (int)L; { const int q = nwg / NXCD, r = nwg % NXCD, xcd = wgid % NXCD, off = wgid / NXCD; wgid = (xcd < r ? xcd * (q + 1) : r * (q + 1) + (xcd - r) * q) + off; }
        const int nig = WGM * nN, gid = wgid / nig, fm = gid * WGM, gsz = (nM - fm) < WGM ? (nM - fm) : WGM;
        u.pm = fm + ((wgid % nig) % gsz); u.pn = (wgid % nig) / gsz; return true;
    }
    __device__ __forceinline__ void a_ready(const Unit&) const {}
    __device__ __forceinline__ void done(const Unit&) const {}
};

typedef float cvt_f32x2 __attribute__((ext_vector_type(2)));
typedef __bf16 cvt_bf16x2 __attribute__((ext_vector_type(2)));
__device__ __forceinline__ unsigned cvt_pk_bf16(float lo, float hi) { const cvt_f32x2 v = {lo, hi}; union { cvt_bf16x2 b; unsigned u; } x; x.b = __builtin_convertvector(v, cvt_bf16x2); return x.u; }
typedef float f32x2 __attribute__((ext_vector_type(2)));
struct EpiF32 {
    static constexpr bool PERM = false, AFTER_DRAIN = false;
    float* C; int ldc; const float* bias;
    __device__ __forceinline__ void operator()(const f32x4 (&acc)[2][2][4][2], const Unit& u, int wr, int wc, int fr, int fq) const {
        const int row0 = u.pm * BM + wr * 64 + fr, col0 = u.pn * BM + wc * 32 + 4 * fq;
        f32x4 bv[2][2];
#pragma unroll
        for (int bj = 0; bj < 2; ++bj)
#pragma unroll
            for (int n = 0; n < 2; ++n) bv[bj][n] = bias ? *(const f32x4*)(bias + col0 + bj * HALF + n * 16) : (f32x4){0.f, 0.f, 0.f, 0.f};
#pragma unroll
        for (int ai = 0; ai < 2; ++ai)
#pragma unroll
            for (int m = 0; m < 4; ++m) { float* rowp = C + (size_t)(row0 + ai * HALF + m * 16) * ldc + col0;
#pragma unroll
                for (int bj = 0; bj < 2; ++bj)
#pragma unroll
                    for (int n = 0; n < 2; ++n) *(f32x4*)(rowp + bj * HALF + n * 16) = acc[ai][bj][m][n] + bv[bj][n]; }
    }
};
template <int ACT  > struct EpiBf16 {
    static constexpr bool PERM = true, AFTER_DRAIN = false;
    bf16_t* O; int ldc; const float* bias; int split_cols; size_t split_stride;
    __device__ __forceinline__ void operator()(const f32x4 (&acc)[2][2][4][2], const Unit& u, int wr, int wc, int fr, int fq) const {
        const int row0 = u.pm * BM + wr * 64 + fr; int colt = u.pn * BM; bf16_t* base = O;
        if (split_cols) { const int t = colt / split_cols; base += (size_t)t * split_stride; colt -= t * split_cols; }
        const int col0 = colt + wc * 32 + 8 * fq, bcol0 = u.pn * BM + wc * 32 + 8 * fq;
        f32x4 bv[2][2];
#pragma unroll
        for (int bj = 0; bj < 2; ++bj)
#pragma unroll
            for (int n = 0; n < 2; ++n) bv[bj][n] = bias ? *(const f32x4*)(bias + bcol0 + bj * HALF + 4 * n) : (f32x4){0.f, 0.f, 0.f, 0.f};
#pragma unroll
        for (int ai = 0; ai < 2; ++ai)
#pragma unroll
            for (int m = 0; m < 4; ++m) { bf16_t* rowp = base + (size_t)(row0 + ai * HALF + m * 16) * ldc + col0;
#pragma unroll
                for (int bj = 0; bj < 2; ++bj) { f32x4 v0 = acc[ai][bj][m][0] + bv[bj][0], v1 = acc[ai][bj][m][1] + bv[bj][1];
                    u32x4 w; w.x = cvt_pk_bf16(v0[0], v0[1]); w.y = cvt_pk_bf16(v0[2], v0[3]); w.z = cvt_pk_bf16(v1[0], v1[1]); w.w = cvt_pk_bf16(v1[2], v1[3]);
                    *(u32x4*)(rowp + bj * HALF) = w; } }
    }
};

template <class Epi, class Sched>
__device__ __forceinline__ void gemm_phase(PG8_LAS unsigned char* lds, const Gemm g, const Sched& S, const Epi& E) {
    const int tid = threadIdx.x, wid = __builtin_amdgcn_readfirstlane(tid >> 6), lane = tid & 63, wr = wid >> 2, wc = wid & 3, fr = lane & 15, fq = lane >> 4;
    const int K = g.K, nt = K / BK;
    unsigned voffA[2], voffB[2];
#pragma unroll
    for (int i = 0; i < 2; ++i) { int R, C; stage_rc(tid * 16 + i * 8192, R, C); const int Rb = Epi::PERM ? ((R & ~31) + perm32(R & 31)) : R;
        voffA[i] = (unsigned)(R * K + C) * 2u; voffB[i] = (unsigned)(Rb * K + C) * 2u; }
    const size_t kstep = (size_t)(BK * 2);
    const size_t hstep = (size_t)HALF * K * 2;
    const size_t tstep = 2 * hstep;
    const unsigned ldsw = (unsigned)wid * 1024u;
    const int aoff = lds_byte(wr * 64 + fr, fq * 8), boff = lds_byte(wc * 32 + fr, fq * 8);
#define PG8_SA(b, h) (((b) * 2 + (h)) * HTB)
#define PG8_SB(b, h) ((4 + (b) * 2 + (h)) * HTB)
#define PG8_STAGE(bufoff, gbase, voff) do { _Pragma("unroll") for (int _i = 0; _i < 2; ++_i) \
        __builtin_amdgcn_global_load_lds((const unsigned*)((const char*)(gbase) + (voff)[_i]), (PG8_LAS unsigned*)(lds + (bufoff) + ldsw + _i * 8192), 16, 0, 0); } while (0)
#define PG8_LDA(dst, b, h) do { _Pragma("unroll") for (int m = 0; m < 4; ++m) _Pragma("unroll") for (int k = 0; k < 2; ++k) dst[m][k] = *(const PG8_LAS bf16x8*)(lds + PG8_SA(b, h) + aoff + m * 2048 + k * 1024); } while (0)
#define PG8_LDB(dst, b, h) do { _Pragma("unroll") for (int n = 0; n < 2; ++n) _Pragma("unroll") for (int k = 0; k < 2; ++k) dst[n][k] = *(const PG8_LAS bf16x8*)(lds + PG8_SB(b, h) + boff + n * 2048 + k * 1024); } while (0)
#define PG8_MMA(ai, bj, At, Bt) do { __builtin_amdgcn_s_setprio(1); _Pragma("unroll") for (int m = 0; m < 4; ++m) _Pragma("unroll") for (int n = 0; n < 2; ++n) _Pragma("unroll") for (int k = 0; k < 2; ++k) \
        acc[ai][bj][m][n] = __builtin_amdgcn_mfma_f32_16x16x32_bf16(Bt[n][k], At[m][k], acc[ai][bj][m][n], 0, 0, 0); __builtin_amdgcn_s_setprio(0); } while (0)
#define PG8_WAIT_V(n) asm volatile("s_waitcnt vmcnt(" #n ")" ::: "memory")
#define PG8_WAIT_L(n) asm volatile("s_waitcnt lgkmcnt(" #n ")" ::: "memory")
#define PG8_BAR __builtin_amdgcn_s_barrier()
#define PG8_SCHED __builtin_amdgcn_sched_barrier(0)
    Unit cur, nxt; int ui = 0;
    if (!S.next(0, cur)) return;
    f32x4 acc[2][2][4][2];
#pragma unroll
    for (int a = 0; a < 2; ++a)
#pragma unroll
        for (int b = 0; b < 2; ++b)
#pragma unroll
            for (int m = 0; m < 4; ++m)
#pragma unroll
                for (int n = 0; n < 2; ++n) acc[a][b][m][n] = (f32x4){0.f, 0.f, 0.f, 0.f};
    bf16x8 At[4][2], B0[2][2], B1[2][2];
    const char* cA = (const char*)g.A + (size_t)cur.pm * tstep; const char* cB = (const char*)g.Bt + (size_t)cur.pn * tstep;
    S.a_ready(cur);
    PG8_STAGE(PG8_SB(0, 0), cB, voffB); PG8_STAGE(PG8_SA(0, 0), cA, voffA); PG8_STAGE(PG8_SB(0, 1), cB + hstep, voffB); PG8_STAGE(PG8_SA(0, 1), cA + hstep, voffA);
    if (wr == 1) PG8_BAR;
    PG8_WAIT_V(4); PG8_BAR;
    PG8_STAGE(PG8_SB(1, 0), cB + kstep, voffB); PG8_STAGE(PG8_SA(1, 0), cA + kstep, voffA); PG8_STAGE(PG8_SB(1, 1), cB + hstep + kstep, voffB);
    PG8_WAIT_V(6); PG8_BAR;
    for (;;) {
        const bool has_next = S.next(ui + 1, nxt);
        const char* nA = has_next ? (const char*)g.A + (size_t)nxt.pm * tstep : cA; const char* nB = has_next ? (const char*)g.Bt + (size_t)nxt.pn * tstep : cB;
        for (int t = 0; t < nt; t += 2) {
            const bool last = (t == nt - 2);
            const char* a1 = cA + (size_t)(t + 1) * kstep;
            const char* a2 = last ? nA : cA + (size_t)(t + 2) * kstep; const char* b2 = last ? nB : cB + (size_t)(t + 2) * kstep;
            const char* a3 = a2 + kstep; const char* b3 = b2 + kstep;
            if (last && has_next) S.a_ready(nxt);
            PG8_LDB(B0, 0, 0); PG8_SCHED; PG8_LDA(At, 0, 0); PG8_STAGE(PG8_SA(1, 1), a1 + hstep, voffA);
            PG8_WAIT_L(8); PG8_BAR; PG8_WAIT_L(0); PG8_MMA(0, 0, At, B0); PG8_BAR; PG8_SCHED;
            PG8_LDB(B1, 0, 1); PG8_STAGE(PG8_SB(0, 0), b2, voffB);
            PG8_BAR; PG8_WAIT_L(0); PG8_MMA(0, 1, At, B1); PG8_BAR;
            PG8_LDA(At, 0, 1); PG8_STAGE(PG8_SA(0, 0), a2, voffA);
            PG8_BAR; PG8_WAIT_L(0); PG8_MMA(1, 0, At, B0); PG8_BAR; PG8_SCHED;
            PG8_STAGE(PG8_SB(0, 1), b2 + hstep, voffB);
            PG8_WAIT_V(6); PG8_BAR; PG8_MMA(1, 1, At, B1); PG8_BAR;
            PG8_LDB(B0, 1, 0); PG8_SCHED; PG8_LDA(At, 1, 0); PG8_STAGE(PG8_SA(0, 1), a2 + hstep, voffA);
            PG8_WAIT_L(8); PG8_BAR; PG8_WAIT_L(0); PG8_MMA(0, 0, At, B0); PG8_BAR; PG8_SCHED;
            PG8_LDB(B1, 1, 1); PG8_STAGE(PG8_SB(1, 0), b3, voffB);
            PG8_BAR; PG8_WAIT_L(0); PG8_MMA(0, 1, At, B1); PG8_BAR;
            PG8_LDA(At, 1, 1); PG8_STAGE(PG8_SA(1, 0), a3, voffA);
            PG8_BAR; PG8_WAIT_L(0); PG8_MMA(1, 0, At, B0); PG8_BAR; PG8_SCHED;
            PG8_STAGE(PG8_SB(1, 1), b3 + hstep, voffB);
            PG8_WAIT_V(6); PG8_BAR; PG8_MMA(1, 1, At, B1); PG8_BAR;
        }
        if constexpr (!Epi::AFTER_DRAIN) { E(acc, cur, wr, wc, fr, fq); S.done(cur); }
        if (!has_next) break;
#pragma unroll
        for (int a = 0; a < 2; ++a)
#pragma unroll
            for (int b = 0; b < 2; ++b)
#pragma unroll
                for (int m = 0; m < 4; ++m)
#pragma unroll
                    for (int n = 0; n < 2; ++n) acc[a][b][m][n] = (f32x4){0.f, 0.f, 0.f, 0.f};
        cur = nxt; cA = nA; cB = nB; ++ui;
    }
    PG8_WAIT_V(0);
    if (wr == 0) PG8_BAR;
    PG8_BAR;
    if constexpr (Epi::AFTER_DRAIN) { E.fused(acc, cur, wr, wc, fr, fq, lds, wid, lane); S.done(cur); }
#undef PG8_SA
#undef PG8_SB
#undef PG8_STAGE
#undef PG8_LDA
#undef PG8_LDB
#undef PG8_MMA
#undef PG8_WAIT_V
#undef PG8_WAIT_L
#undef PG8_BAR
#undef PG8_SCHED
}
}


typedef unsigned short bf16_t;
typedef short bf16x8 __attribute__((ext_vector_type(8)));
typedef float f32x4 __attribute__((ext_vector_type(4)));
typedef unsigned u32x4 __attribute__((ext_vector_type(4)));
typedef unsigned u32x2 __attribute__((ext_vector_type(2)));

constexpr int MTOK = 32768, DM = 1024, SEQ = 16384, NTH = 512;
constexpr int GIN = 3088, GIN_P = 3072, RIN = 4224, RIN_P = 4352;
constexpr int LDS_BYTES = 147456;

constexpr size_t WS_WGIN  = 0;
constexpr size_t WS_WGOUT = WS_WGIN  + (size_t)GIN_P * DM * 2;
constexpr size_t WS_WRIN  = WS_WGOUT + (size_t)DM * DM * 2;
constexpr size_t WS_WROUT = WS_WRIN  + (size_t)RIN_P * DM * 2;
constexpr size_t WS_WDUT  = WS_WROUT + (size_t)DM * DM * 2;
constexpr size_t WS_WIUT  = WS_WDUT  + (size_t)DM * 64 * 2;
constexpr size_t WS_WUPT  = WS_WIUT  + (size_t)DM * 64 * 2;
constexpr size_t WS_A     = WS_WUPT  + (size_t)512 * 16 * 2;
constexpr size_t WS_Y     = WS_A     + (size_t)MTOK * DM * 2;
constexpr size_t WS_GS    = WS_Y     + (size_t)MTOK * DM * 2;
constexpr size_t WS_GD    = WS_GS    + (size_t)24 * 1024 * 1024;
constexpr size_t WS_P     = WS_GD    + (size_t)8 * 32 * 128 * 4;
constexpr size_t WS_BAR   = WS_P     + (size_t)MTOK * RIN_P * 2;
constexpr size_t WS_AD    = WS_BAR   + 16384;
constexpr size_t WS_X1    = WS_AD    + (size_t)MTOK * 16 * 2;
constexpr size_t WS_DUMMY = WS_X1    + (size_t)MTOK * DM * 2;
constexpr size_t WS_END   = WS_DUMMY + 65536;
static_assert(WS_END <= (size_t)512 * 1024 * 1024, "workspace budget (4 x the largest tensor)");

struct Params { const float* in[22]; float* out; unsigned char* ws; int ph_lo, ph_hi; };

__device__ __forceinline__ float bf2f(unsigned b) { return __uint_as_float(b << 16); }
__device__ __forceinline__ bf16_t f2bf(float f) { unsigned u = __float_as_uint(f); u += 0x7FFFu + ((u >> 16) & 1u); return (bf16_t)(u >> 16); }
__device__ __forceinline__ unsigned pk2(float lo, float hi) { return pg8::cvt_pk_bf16(lo, hi); }
__device__ __forceinline__ float wave_sum(float x) {
#pragma unroll
    for (int off = 32; off >= 1; off >>= 1) x += __shfl_xor(x, off);
    return x;
}
__device__ __forceinline__ float bperm(int byte_addr, float x) { return __int_as_float(__builtin_amdgcn_ds_bpermute(byte_addr, __float_as_int(x))); }
template <int CTRL> __device__ __forceinline__ float dpp_mov(float x) { return __int_as_float(__builtin_amdgcn_update_dpp(0, __float_as_int(x), CTRL, 0xF, 0xF, true)); }
__device__ __forceinline__ float sum8(float x) { x += dpp_mov<0xB1>(x); x += dpp_mov<0x4E>(x); x += dpp_mov<0x141>(x); return x; }
__device__ __forceinline__ f32x4 mfma16(bf16x8 a, bf16x8 b, f32x4 c) { return __builtin_amdgcn_mfma_f32_16x16x32_bf16(a, b, c, 0, 0, 0); }
__device__ __forceinline__ bf16x8 as_bf16x8(u32x4 v) { union { u32x4 u; bf16x8 b; } x; x.u = v; return x.b; }
__device__ __forceinline__ float fexp(float x) { return __builtin_amdgcn_exp2f(x * 1.4426950408889634f); }
__device__ __forceinline__ float flog(float x) { return __builtin_amdgcn_logf(x) * 0.6931471805599453f; }
__device__ __forceinline__ float log_sigmoid(float z) { return fminf(z, 0.f) - log1pf(fexp(-fabsf(z))); }
__device__ __forceinline__ float softplus(float z) { return fmaxf(z, 0.f) + log1pf(fexp(-fabsf(z))); }

__device__ void prep_weight(const float* __restrict__ W, int N, const float* __restrict__ gain, bf16_t* __restrict__ Wt, int NP, float* tile) {
    const int tid = threadIdx.x;
    const int nu = (NP / 64) * 16;
    const int lk = tid >> 4, lq = tid & 15;
    const int sn = tid >> 3, ss = tid & 7;
    float4 v[2];
#define PW_LOAD(u_) do { const int n0_ = ((u_) >> 4) * 64, k0_ = ((u_) & 15) * 64; _Pragma("unroll") for (int r = 0; r < 2; ++r) { const int k = k0_ + lk + 32 * r, n = n0_ + 4 * lq; \
        float4 x_ = make_float4(0.f, 0.f, 0.f, 0.f); if (n < N) { x_ = *(const float4*)(W + (size_t)k * N + n); if (gain) { const float g_ = gain[k]; x_.x *= g_; x_.y *= g_; x_.z *= g_; x_.w *= g_; } } v[r] = x_; } } while (0)
    int u = blockIdx.x;
    if (u < nu) PW_LOAD(u);
    for (; u < nu; u += gridDim.x) {
        const int n0 = (u >> 4) * 64, k0 = (u & 15) * 64;
#pragma unroll
        for (int r = 0; r < 2; ++r) *(float4*)(tile + (lk + 32 * r) * 68 + 4 * lq) = v[r];
        if (u + (int)gridDim.x < nu) PW_LOAD(u + gridDim.x);
        __syncthreads();
        {
            float e[8];
#pragma unroll
            for (int q = 0; q < 8; ++q) e[q] = tile[(8 * ss + q) * 68 + sn];
            *(u32x4*)(Wt + (size_t)(n0 + sn) * DM + k0 + 8 * ss) = (u32x4){pk2(e[0], e[1]), pk2(e[2], e[3]), pk2(e[4], e[5]), pk2(e[6], e[7])};
        }
        __syncthreads();
    }
#undef PW_LOAD
}

__device__ void prep_lowrank(const float* __restrict__ src, bf16_t* __restrict__ dst) {
    for (int idx = blockIdx.x * NTH + threadIdx.x; idx < 65536; idx += gridDim.x * NTH) dst[idx] = f2bf(src[(idx & 63) * 1024 + (idx >> 6)]);
}

__device__ void zero_bnd_row(bf16_t* bnd) {
    if (blockIdx.x == 0) for (int i = threadIdx.x; i < RIN_P / 2; i += NTH) ((unsigned*)bnd)[i] = 0u;
}

__device__ void prep_wup(const float* __restrict__ src, bf16_t* __restrict__ dst) {
    for (int idx = blockIdx.x * NTH + threadIdx.x; idx < 8192; idx += gridDim.x * NTH) dst[idx] = f2bf(src[(idx & 15) * 512 + (idx >> 4)]);
}

struct EpiBf16GateSilu {
    static constexpr bool PERM = true, AFTER_DRAIN = false;
    bf16_t* O; int ldc;
    __device__ __forceinline__ void operator()(const f32x4 (&acc)[2][2][4][2], const pg8::Unit& u, int wr, int wc, int fr, int fq) const {
        const int row0 = u.pm * pg8::BM + wr * 64 + fr, col0 = u.pn * pg8::BM + wc * 32 + 8 * fq;
        const bool act = u.pn >= 8;
#pragma unroll
        for (int ai = 0; ai < 2; ++ai)
#pragma unroll
            for (int m = 0; m < 4; ++m) {
                bf16_t* rowp = O + (size_t)(row0 + ai * pg8::HALF + m * 16) * ldc + col0;
#pragma unroll
                for (int bj = 0; bj < 2; ++bj) {
                    f32x4 v0 = acc[ai][bj][m][0], v1 = acc[ai][bj][m][1];
                    if (act) {
#pragma unroll
                        for (int j = 0; j < 4; ++j) { v0[j] *= __builtin_amdgcn_rcpf(1.0f + fexp(-v0[j])); v1[j] *= __builtin_amdgcn_rcpf(1.0f + fexp(-v1[j])); }
                    }
                    u32x4 wv; wv.x = pk2(v0[0], v0[1]); wv.y = pk2(v0[2], v0[3]); wv.z = pk2(v1[0], v1[1]); wv.w = pk2(v1[2], v1[3]);
                    *(u32x4*)(rowp + bj * pg8::HALF) = wv;
                }
            }
    }
};

struct EpiBf16Bnd {
    static constexpr bool PERM = true, AFTER_DRAIN = false;
    bf16_t* O; int ldc; bf16_t* bnd;
    __device__ __forceinline__ void operator()(const f32x4 (&acc)[2][2][4][2], const pg8::Unit& u, int wr, int wc, int fr, int fq) const {
        const int row0 = u.pm * pg8::BM + wr * 64 + fr, col0 = u.pn * pg8::BM + wc * 32 + 8 * fq;
#pragma unroll
        for (int ai = 0; ai < 2; ++ai)
#pragma unroll
            for (int m = 0; m < 4; ++m) {
                const int row = row0 + ai * pg8::HALF + m * 16;
                bf16_t* rowp = O + (size_t)row * ldc + col0;
#pragma unroll
                for (int bj = 0; bj < 2; ++bj) {
                    const f32x4 v0 = acc[ai][bj][m][0], v1 = acc[ai][bj][m][1];
                    u32x4 wv; wv.x = pk2(v0[0], v0[1]); wv.y = pk2(v0[2], v0[3]); wv.z = pk2(v1[0], v1[1]); wv.w = pk2(v1[2], v1[3]);
                    *(u32x4*)(rowp + bj * pg8::HALF) = wv;
                    if (m == 3 && fr == 15) *(u32x4*)(bnd + (size_t)((row >> 6) + 1) * ldc + col0 + bj * pg8::HALF) = wv;
                }
            }
    }
};

__device__ void phase_norm0(const Params& p, unsigned char* lds) {
    const int tid = threadIdx.x, lane = tid & 63, w = tid >> 6, l15 = lane & 15, g = lane >> 4;
    const float* x = p.in[0];
    bf16_t* A = (bf16_t*)(p.ws + WS_A);
    bf16_t* AD = (bf16_t*)(p.ws + WS_AD);
    bf16_t* WAD = (bf16_t*)lds;
    float* PSS = (float*)(lds + 33024);
    float* PAD = (float*)(lds + 33024 + 512);
    for (int e = tid; e < 16384; e += NTH) { const int k = e >> 4, j = e & 15; WAD[j * 1032 + k] = f2bf(p.in[2][(size_t)k * GIN + 3072 + j] * p.in[1][k]); }
    __syncthreads();
    bf16x8 wf[4];
#pragma unroll
    for (int kk = 0; kk < 4; ++kk) wf[kk] = *(const bf16x8*)(WAD + l15 * 1032 + 128 * w + 32 * kk + 8 * g);
    float4 xa[4][2];
    int tile = blockIdx.x;
    if (tile < MTOK / 16) {
#pragma unroll
        for (int kk = 0; kk < 4; ++kk) { const float4* s = (const float4*)(x + (size_t)(16 * tile + l15) * DM + 128 * w + 32 * kk + 8 * g); xa[kk][0] = s[0]; xa[kk][1] = s[1]; }
    }
    for (; tile < MTOK / 16; tile += gridDim.x) {
        float4 xv[4][2];
#pragma unroll
        for (int kk = 0; kk < 4; ++kk) { xv[kk][0] = xa[kk][0]; xv[kk][1] = xa[kk][1]; }
        if (tile + (int)gridDim.x < MTOK / 16) {
#pragma unroll
            for (int kk = 0; kk < 4; ++kk) { const float4* s = (const float4*)(x + (size_t)(16 * (tile + gridDim.x) + l15) * DM + 128 * w + 32 * kk + 8 * g); xa[kk][0] = s[0]; xa[kk][1] = s[1]; }
        }
        float ss = 0.f;
        f32x4 acc = (f32x4){0.f, 0.f, 0.f, 0.f};
#pragma unroll
        for (int kk = 0; kk < 4; ++kk) {
            const float4 a = xv[kk][0], b = xv[kk][1];
            ss += a.x * a.x + a.y * a.y + a.z * a.z + a.w * a.w + b.x * b.x + b.y * b.y + b.z * b.z + b.w * b.w;
            acc = mfma16(as_bf16x8((u32x4){pk2(a.x, a.y), pk2(a.z, a.w), pk2(b.x, b.y), pk2(b.z, b.w)}), wf[kk], acc);
        }
        ss += __shfl_xor(ss, 16); ss += __shfl_xor(ss, 32);
        if (g == 0) PSS[w * 16 + l15] = ss;
        *(f32x4*)(PAD + (w * 64 + lane) * 4) = acc;
        __syncthreads();
        float tot = 0.f;
#pragma unroll
        for (int q = 0; q < 8; ++q) tot += PSS[q * 16 + l15];
        const float rstd = rsqrtf(tot * (1.0f / DM) + 1e-6f);
#pragma unroll
        for (int kk = 0; kk < 4; ++kk) {
            const float4 a = xv[kk][0], b = xv[kk][1];
            *(u32x4*)(A + (size_t)(16 * tile + l15) * DM + 128 * w + 32 * kk + 8 * g) = (u32x4){pk2(a.x * rstd, a.y * rstd), pk2(a.z * rstd, a.w * rstd), pk2(b.x * rstd, b.y * rstd), pk2(b.z * rstd, b.w * rstd)};
        }
        if (w == 0) {
            f32x4 s = (f32x4){0.f, 0.f, 0.f, 0.f};
#pragma unroll
            for (int q = 0; q < 8; ++q) s += *(const f32x4*)(PAD + (q * 64 + lane) * 4);
#pragma unroll
            for (int r = 0; r < 4; ++r) AD[(size_t)(16 * tile + 4 * g + r) * 16 + l15] = f2bf(s[r] * __shfl(rstd, 4 * g + r));
        }
        __syncthreads();
    }
}

__device__ void phase_norm1(const Params& p) {
    const int tid = threadIdx.x, lane = tid & 63, w = tid >> 6;
    const float* x = p.in[0];
    const float* gpost = p.in[7];
    const bf16_t* Y = (const bf16_t*)(p.ws + WS_Y);
    bf16_t* A = (bf16_t*)(p.ws + WS_A);
    bf16_t* X1 = (bf16_t*)(p.ws + WS_X1);
    float4 gp[4];
#pragma unroll
    for (int i = 0; i < 4; ++i) gp[i] = ((const float4*)gpost)[lane + 64 * i];
    const int stride = gridDim.x * 8;
    float4 vn[4]; u32x2 yn[4];
    {
        const int row = blockIdx.x * 8 + w;
#pragma unroll
        for (int i = 0; i < 4; ++i) { vn[i] = ((const float4*)(x + (size_t)row * DM))[lane + 64 * i]; yn[i] = *(const u32x2*)(Y + (size_t)row * DM + 4 * (lane + 64 * i)); }
    }
    for (int row = blockIdx.x * 8 + w; row < MTOK; row += stride) {
        float4 v[4]; u32x2 yv[4];
#pragma unroll
        for (int i = 0; i < 4; ++i) { v[i] = vn[i]; yv[i] = yn[i]; }
        if (row + stride < MTOK) {
#pragma unroll
            for (int i = 0; i < 4; ++i) { vn[i] = ((const float4*)(x + (size_t)(row + stride) * DM))[lane + 64 * i]; yn[i] = *(const u32x2*)(Y + (size_t)(row + stride) * DM + 4 * (lane + 64 * i)); }
        }
        float4 y[4];
        float ss = 0.f;
#pragma unroll
        for (int i = 0; i < 4; ++i) {
            y[i].x = bf2f(yv[i].x & 0xffffu); y[i].y = bf2f(yv[i].x >> 16); y[i].z = bf2f(yv[i].y & 0xffffu); y[i].w = bf2f(yv[i].y >> 16);
            ss += y[i].x * y[i].x + y[i].y * y[i].y + y[i].z * y[i].z + y[i].w * y[i].w;
        }
        ss = wave_sum(ss);
        const float rstdy = rsqrtf(ss * (1.0f / DM) + 1e-6f);
        float s1 = 0.f;
#pragma unroll
        for (int i = 0; i < 4; ++i) {
            v[i].x += y[i].x * rstdy * gp[i].x; v[i].y += y[i].y * rstdy * gp[i].y; v[i].z += y[i].z * rstdy * gp[i].z; v[i].w += y[i].w * rstdy * gp[i].w;
            s1 += v[i].x * v[i].x + v[i].y * v[i].y + v[i].z * v[i].z + v[i].w * v[i].w;
            u32x2 xo; xo.x = pk2(v[i].x, v[i].y); xo.y = pk2(v[i].z, v[i].w);
            *(u32x2*)(X1 + (size_t)row * DM + 4 * (lane + 64 * i)) = xo;
        }
        s1 = wave_sum(s1);
        const float rstd = rsqrtf(s1 * (1.0f / DM) + 1e-6f);
#pragma unroll
        for (int i = 0; i < 4; ++i) {
            u32x2 o; o.x = pk2(v[i].x * rstd, v[i].y * rstd); o.y = pk2(v[i].z * rstd, v[i].w * rstd);
            *(u32x2*)(A + (size_t)row * DM + 4 * (lane + 64 * i)) = o;
        }
    }
}

__device__ void phase_final(const Params& p) {
    const int tid = threadIdx.x, lane = tid & 63, w = tid >> 6;
    const float* gpost = p.in[21];
    const bf16_t* Y = (const bf16_t*)(p.ws + WS_Y);
    const bf16_t* X1 = (const bf16_t*)(p.ws + WS_X1);
    float4 gp[4];
#pragma unroll
    for (int i = 0; i < 4; ++i) gp[i] = ((const float4*)gpost)[lane + 64 * i];
    const int stride = gridDim.x * 8;
    u32x2 xn[4], yn[4];
    {
        const int row = blockIdx.x * 8 + w;
#pragma unroll
        for (int i = 0; i < 4; ++i) { xn[i] = *(const u32x2*)(X1 + (size_t)row * DM + 4 * (lane + 64 * i)); yn[i] = *(const u32x2*)(Y + (size_t)row * DM + 4 * (lane + 64 * i)); }
    }
    for (int row = blockIdx.x * 8 + w; row < MTOK; row += stride) {
        u32x2 xv[4], yv[4];
#pragma unroll
        for (int i = 0; i < 4; ++i) { xv[i] = xn[i]; yv[i] = yn[i]; }
        if (row + stride < MTOK) {
#pragma unroll
            for (int i = 0; i < 4; ++i) { xn[i] = *(const u32x2*)(X1 + (size_t)(row + stride) * DM + 4 * (lane + 64 * i)); yn[i] = *(const u32x2*)(Y + (size_t)(row + stride) * DM + 4 * (lane + 64 * i)); }
        }
        float4 y[4];
        float ss = 0.f;
#pragma unroll
        for (int i = 0; i < 4; ++i) {
            y[i].x = bf2f(yv[i].x & 0xffffu); y[i].y = bf2f(yv[i].x >> 16); y[i].z = bf2f(yv[i].y & 0xffffu); y[i].w = bf2f(yv[i].y >> 16);
            ss += y[i].x * y[i].x + y[i].y * y[i].y + y[i].z * y[i].z + y[i].w * y[i].w;
        }
        ss = wave_sum(ss);
        const float rstdy = rsqrtf(ss * (1.0f / DM) + 1e-6f);
#pragma unroll
        for (int i = 0; i < 4; ++i) {
            float4 v;
            v.x = bf2f(xv[i].x & 0xffffu) + y[i].x * rstdy * gp[i].x; v.y = bf2f(xv[i].x >> 16) + y[i].y * rstdy * gp[i].y;
            v.z = bf2f(xv[i].y & 0xffffu) + y[i].z * rstdy * gp[i].z; v.w = bf2f(xv[i].y >> 16) + y[i].w * rstdy * gp[i].w;
            ((float4*)(p.out + (size_t)row * DM))[lane + 64 * i] = v;
        }
    }
}

constexpr int L_BC = 0, L_ATT = 0, L_QD = 33792, L_KD = L_QD + 64 * 136 * 2, L_KTE = L_KD + 64 * 136 * 2, L_VI = L_KTE + 64 * 152 * 2, L_SSQ = L_VI + 64 * 280 * 2, L_BL = L_SSQ + 2048, L_DEC = L_BL + 512, L_ADL = L_DEC + 512,
              L_GLA_END = L_ADL + 2048;
static_assert(L_GLA_END <= LDS_BYTES, "GLA LDS");
#define GLA_BARRIER() do { asm volatile("s_waitcnt lgkmcnt(0)" ::: "memory"); __builtin_amdgcn_s_barrier(); asm volatile("" ::: "memory"); } while (0)
typedef short gs16x4 __attribute__((ext_vector_type(4)));
__device__ __forceinline__ u32x2 g_trread(const bf16_t* p) { union { gs16x4 s; u32x2 u; } x; x.s = __builtin_amdgcn_ds_read_tr16_b64_v4i16((__attribute__((address_space(3))) gs16x4*)p); return x.u; }
template <int PITCH> __device__ __forceinline__ bf16x8 g_trfrag(const bf16_t* img, int k0, int c0, int g, int q, int pq) {
    const bf16_t* a = img + (k0 + 8 * g + q) * PITCH + c0 + 4 * pq;
    const u32x2 lo = g_trread(a), hi = g_trread(a + 4 * PITCH);
    return as_bf16x8((u32x4){lo.x, lo.y, hi.x, hi.y});
}
__device__ __forceinline__ f32x4 g_lo4(u32x4 v) { return (f32x4){bf2f(v.x & 0xffffu), bf2f(v.x >> 16), bf2f(v.y & 0xffffu), bf2f(v.y >> 16)}; }
__device__ __forceinline__ f32x4 g_hi4(u32x4 v) { return (f32x4){bf2f(v.z & 0xffffu), bf2f(v.z >> 16), bf2f(v.w & 0xffffu), bf2f(v.w >> 16)}; }
__device__ __forceinline__ u32x2 g_pk4(f32x4 v) { u32x2 r; r.x = pk2(v[0], v[1]); r.y = pk2(v[2], v[3]); return r; }
__device__ __forceinline__ f32x4 g_unpk4(u32x2 v) { return (f32x4){bf2f(v.x & 0xffffu), bf2f(v.x >> 16), bf2f(v.y & 0xffffu), bf2f(v.y >> 16)}; }

template <bool OUT> struct GlaRaw { u32x4 q[2], k[2], v[4]; };
template <bool OUT> __device__ __forceinline__ void gla_issue(GlaRaw<OUT>& x, const char* cb  , unsigned offQ, unsigned offV) {
    if (OUT) { x.q[0] = *(const u32x4*)(cb + offQ); x.q[1] = *(const u32x4*)(cb + offQ + 16); }
    x.k[0] = *(const u32x4*)(cb + offQ + 1024); x.k[1] = *(const u32x4*)(cb + offQ + 1040);
#pragma unroll
    for (int i = 0; i < 4; ++i) x.v[i] = *(const u32x4*)(cb + offV + 16 * i);
}

template <bool OUT>
__device__ void gla_pass(const Params& p, unsigned char* lds) {
    const int tid = threadIdx.x, w = __builtin_amdgcn_readfirstlane(tid >> 6);
    const bf16_t* P = (const bf16_t*)(p.ws + WS_P);
    bf16_t* GS = (bf16_t*)(p.ws + WS_GS);
    float* GD = (float*)(p.ws + WS_GD);
    bf16_t* Aout = (bf16_t*)(p.ws + WS_A);
    const bf16_t* WupT = (const bf16_t*)(p.ws + WS_WUPT);
    const bf16_t* ADG = (const bf16_t*)(p.ws + WS_AD);
    float* BC = (float*)(lds + L_BC); bf16_t* ATT = (bf16_t*)(lds + L_ATT); bf16_t* QD = (bf16_t*)(lds + L_QD); bf16_t* KD = (bf16_t*)(lds + L_KD); bf16_t* KTE = (bf16_t*)(lds + L_KTE);
    bf16_t* VI = (bf16_t*)(lds + L_VI); float* SSQ = (float*)(lds + L_SSQ); float* BL = (float*)(lds + L_BL); float* DEC = (float*)(lds + L_DEC); bf16_t* ADL = (bf16_t*)(lds + L_ADL);
    const float* b_al = p.in[4]; const float* g_head = p.in[5];

    for (int unit = blockIdx.x; unit < 256; unit += gridDim.x) {
        const int bh = unit >> 5, m = unit & 31, b = bh >> 2, h = bh & 3;
        int tidv = tid; asm volatile("" : "+v"(tidv));
        const int lane = tidv & 63, l15 = lane & 15, g = lane >> 4, q4 = l15 >> 2, p4 = l15 & 3;
        const int c = tidv >> 3, seg = tidv & 7;
        const int tokbase = b * SEQ + m * 512;
        u32x4 wupq = *(const u32x4*)(WupT + (size_t)(h * 128 + 16 * w + l15) * 16 + 8 * (g & 1));
        if (g >= 2) wupq = (u32x4){0u, 0u, 0u, 0u};
        const bf16x8 wupf = as_bf16x8(wupq);
        const float bA = b_al[h * 128 + 16 * w + l15];
        f32x4 gh[2];
#pragma unroll
        for (int vt = 0; vt < 2; ++vt) gh[vt] = *(const f32x4*)(g_head + 32 * w + 16 * vt + 4 * g);
        float logD = 0.f;
        f32x4 S[8][2];
#pragma unroll
        for (int mt = 0; mt < 8; ++mt)
#pragma unroll
            for (int vt = 0; vt < 2; ++vt) {
                if (OUT) S[mt][vt] = g_unpk4(*(const u32x2*)(GS + ((size_t)(bh * 32 + m) * 256 + 32 * w + 16 * vt + l15) * 128 + 16 * mt + 4 * g));
                else S[mt][vt] = (f32x4){0.f, 0.f, 0.f, 0.f};
            }
        const unsigned offQ = (unsigned)((c * GIN_P + h * 128 + 16 * seg) * 2), offV = (unsigned)((c * GIN_P + 1024 + h * 256 + 32 * seg) * 2), offAD = (unsigned)(tid * 16);
        const unsigned offG = (unsigned)((l15 * GIN_P + 2048 + h * 256 + 32 * w + 4 * g) * 2), offO = (unsigned)((l15 * DM + h * 256 + 32 * w + 4 * g) * 2);
        GlaRaw<OUT> raw;
        gla_issue<OUT>(raw, (const char*)P + (size_t)tokbase * GIN_P * 2, offQ, offV);
        if (tid < 128) *(u32x4*)(ADL + tid * 8) = *(const u32x4*)((const char*)ADG + (size_t)tokbase * 32 + offAD);
        GLA_BARRIER();

        for (int ch = 0; ch < 8; ++ch) {
            const int tok0 = tokbase + ch * 64;
            u32x4 adn = (u32x4){0u, 0u, 0u, 0u};
            {
                if (ch < 7 && tid < 128) adn = *(const u32x4*)((const char*)ADG + (size_t)(tok0 + 64) * 32 + offAD);
                f32x4 sc[4]; float xinc[4], tot[4];
#pragma unroll
                for (int ct = 0; ct < 4; ++ct) {
                    u32x4 aq = *(const u32x4*)(ADL + (16 * ct + l15) * 16 + 8 * (g & 1));
                    if (g >= 2) aq = (u32x4){0u, 0u, 0u, 0u};
                    const f32x4 z = mfma16(as_bf16x8(aq), wupf, (f32x4){bA, bA, bA, bA});
                    float acc = 0.f;
#pragma unroll
                    for (int r = 0; r < 4; ++r) { acc += (fminf(z[r], 0.f) - flog(1.f + fexp(-fabsf(z[r])))) * (1.0f / 16.0f); sc[ct][r] = acc; }
                    xinc[ct] = acc;
                }
#pragma unroll
                for (int ct = 0; ct < 4; ++ct) xinc[ct] += (g >= 1 ? 1.f : 0.f) * bperm(((lane - 16) & 63) * 4, xinc[ct]);
#pragma unroll
                for (int ct = 0; ct < 4; ++ct) xinc[ct] += (g >= 2 ? 1.f : 0.f) * bperm(((lane - 32) & 63) * 4, xinc[ct]);
#pragma unroll
                for (int ct = 0; ct < 4; ++ct) tot[ct] = bperm((48 + l15) * 4, xinc[ct]);
                float run = 0.f;
#pragma unroll
                for (int ct = 0; ct < 4; ++ct) {
                    const float base = run + (xinc[ct] - sc[ct][3]);
                    run += tot[ct];
#pragma unroll
                    for (int r = 0; r < 4; ++r) BC[(16 * ct + 4 * g + r) * 132 + 16 * w + l15] = base + sc[ct][r];
                }
                if (g == 0) { BL[16 * w + l15] = run; DEC[16 * w + l15] = fexp(run); }
                if (!OUT) logD += run;
            }
            GLA_BARRIER();
            u32x2 gate[2][4];
            {
#pragma unroll
                for (int hh = 0; hh < 2; ++hh) {
                    const int o8 = 16 * seg + 8 * hh;
                    const f32x4 bb[2] = {*(const f32x4*)(BC + c * 132 + o8), *(const f32x4*)(BC + c * 132 + o8 + 4)};
                    const f32x4 dc[2] = {*(const f32x4*)((OUT ? DEC : BL) + o8), *(const f32x4*)((OUT ? DEC : BL) + o8 + 4)};
                    const f32x4 kx[2] = {g_lo4(raw.k[hh]), g_hi4(raw.k[hh])};
                    f32x4 qx[2];
                    if (OUT) { qx[0] = g_lo4(raw.q[hh]); qx[1] = g_hi4(raw.q[hh]); }
                    f32x4 kd[2], kt[2], qd[2];
#pragma unroll
                    for (int i = 0; i < 2; ++i)
#pragma unroll
                        for (int j = 0; j < 4; ++j) {
                            if (OUT) {
                                const float eB = fexp(bb[i][j]), enB = __builtin_amdgcn_rcpf(eB);
                                kd[i][j] = kx[i][j] * enB; kt[i][j] = kd[i][j] * dc[i][j];
                                qd[i][j] = qx[i][j] * 0.08838834764831845f * eB;
                            } else kt[i][j] = kx[i][j] * fexp(dc[i][j] - bb[i][j]);
                        }
                    *(u32x4*)(KTE + c * 152 + o8) = (u32x4){pk2(kt[0][0], kt[0][1]), pk2(kt[0][2], kt[0][3]), pk2(kt[1][0], kt[1][1]), pk2(kt[1][2], kt[1][3])};
                    if (OUT) {
                        *(u32x4*)(KD + c * 136 + o8) = (u32x4){pk2(kd[0][0], kd[0][1]), pk2(kd[0][2], kd[0][3]), pk2(kd[1][0], kd[1][1]), pk2(kd[1][2], kd[1][3])};
                        *(u32x4*)(QD + c * 136 + o8) = (u32x4){pk2(qd[0][0], qd[0][1]), pk2(qd[0][2], qd[0][3]), pk2(qd[1][0], qd[1][1]), pk2(qd[1][2], qd[1][3])};
                    }
                }
#pragma unroll
                for (int i = 0; i < 4; ++i) *(u32x4*)(VI + c * 280 + 32 * seg + 8 * i) = raw.v[i];
                if (OUT) {
#pragma unroll
                    for (int vt = 0; vt < 2; ++vt)
#pragma unroll
                        for (int ct = 0; ct < 4; ++ct) gate[vt][ct] = *(const u32x2*)((const char*)P + (size_t)(tok0 + 16 * ct) * GIN_P * 2 + offG + 32 * vt);
                }
                if (ch < 7) gla_issue<OUT>(raw, (const char*)P + (size_t)(tok0 + 64) * GIN_P * 2, offQ, offV);
                if (ch < 7 && tid < 128) *(u32x4*)(ADL + tid * 8) = adn;
            }
            GLA_BARRIER();
            f32x4 o[2][4];
            if (OUT) {
#pragma unroll
                for (int t2 = 0; t2 < 2; ++t2) {
                    const int tl = 2 * w + t2, ct = tl >> 2, st = tl & 3;
                    f32x4 acc = (f32x4){0.f, 0.f, 0.f, 0.f};
                    if (st <= ct) {
#pragma unroll
                        for (int kk = 0; kk < 4; ++kk) {
                            const bf16x8 a = *(const bf16x8*)(KD + (16 * st + l15) * 136 + 32 * kk + 8 * g);
                            const bf16x8 bq = *(const bf16x8*)(QD + (16 * ct + l15) * 136 + 32 * kk + 8 * g);
                            acc = mfma16(a, bq, acc);
                        }
#pragma unroll
                        for (int r = 0; r < 4; ++r) if (16 * st + 4 * g + r > 16 * ct + l15) acc[r] = 0.f;
                    }
                    *(u32x2*)(ATT + (16 * ct + l15) * 72 + 16 * st + 4 * g) = g_pk4(acc);
                }
                GLA_BARRIER();
#pragma unroll
                for (int vt = 0; vt < 2; ++vt)
#pragma unroll
                    for (int ct = 0; ct < 4; ++ct) o[vt][ct] = (f32x4){0.f, 0.f, 0.f, 0.f};
#pragma unroll
                for (int kk = 0; kk < 4; ++kk) {
                    bf16x8 sa[2];
#pragma unroll
                    for (int vt = 0; vt < 2; ++vt) { const u32x2 s0 = g_pk4(S[2 * kk][vt]), s1 = g_pk4(S[2 * kk + 1][vt]); sa[vt] = as_bf16x8((u32x4){s0.x, s0.y, s1.x, s1.y}); }
#pragma unroll
                    for (int ct = 0; ct < 4; ++ct) {
                        const bf16_t* qr = QD + (16 * ct + l15) * 136 + 32 * kk + 4 * g;
                        const u32x2 lo = *(const u32x2*)qr, hi = *(const u32x2*)(qr + 16);
                        const bf16x8 bq = as_bf16x8((u32x4){lo.x, lo.y, hi.x, hi.y});
#pragma unroll
                        for (int vt = 0; vt < 2; ++vt) o[vt][ct] = mfma16(sa[vt], bq, o[vt][ct]);
                    }
                }
            }
            bf16x8 bv[2][2];
#pragma unroll
            for (int vt = 0; vt < 2; ++vt)
#pragma unroll
                for (int kk = 0; kk < 2; ++kk) bv[vt][kk] = g_trfrag<280>(VI, 32 * kk, 32 * w + 16 * vt, g, q4, p4);
            if (OUT) {
#pragma unroll
                for (int ct = 0; ct < 4; ++ct)
#pragma unroll
                    for (int kk = 0; kk < 2; ++kk) {
                        if (32 * kk <= 16 * ct + 15) {
                            const bf16x8 bq = *(const bf16x8*)(ATT + (16 * ct + l15) * 72 + 32 * kk + 8 * g);
#pragma unroll
                            for (int vt = 0; vt < 2; ++vt) o[vt][ct] = mfma16(bv[vt][kk], bq, o[vt][ct]);
                        }
                    }
            }
#pragma unroll
            for (int mt = 0; mt < 8; ++mt) {
                const f32x4 dv = *(const f32x4*)(DEC + 16 * mt + 4 * g);
#pragma unroll
                for (int vt = 0; vt < 2; ++vt) S[mt][vt] *= dv;
#pragma unroll
                for (int kk = 0; kk < 2; ++kk) {
                    const bf16x8 a = g_trfrag<152>(KTE, 32 * kk, 16 * mt, g, q4, p4);
#pragma unroll
                    for (int vt = 0; vt < 2; ++vt) S[mt][vt] = mfma16(a, bv[vt][kk], S[mt][vt]);
                }
            }
            if (OUT) {
                float ss[4];
#pragma unroll
                for (int ct = 0; ct < 4; ++ct) {
                    float s = 0.f;
#pragma unroll
                    for (int vt = 0; vt < 2; ++vt)
#pragma unroll
                        for (int r = 0; r < 4; ++r) s += o[vt][ct][r] * o[vt][ct][r];
                    s += bperm((lane ^ 16) * 4, s); s += bperm((lane ^ 32) * 4, s);
                    ss[ct] = s;
                }
                if (g == 0) {
#pragma unroll
                    for (int ct = 0; ct < 4; ++ct) SSQ[(16 * ct + l15) * 8 + w] = ss[ct];
                }
                GLA_BARRIER();
#pragma unroll
                for (int ct = 0; ct < 4; ++ct) {
                    const int cc = 16 * ct + l15;
                    const float4 s0 = *(const float4*)(SSQ + cc * 8), s1 = *(const float4*)(SSQ + cc * 8 + 4);
                    const float tot = (s0.x + s0.y) + (s0.z + s0.w) + (s1.x + s1.y) + (s1.z + s1.w);
                    const float rstd = rsqrtf(tot * (1.0f / 256.0f) + 1e-6f);
#pragma unroll
                    for (int vt = 0; vt < 2; ++vt) {
                        const f32x4 gt = g_unpk4(gate[vt][ct]);
                        f32x4 val;
#pragma unroll
                        for (int r = 0; r < 4; ++r) val[r] = o[vt][ct][r] * rstd * gh[vt][r] * gt[r];
                        *(u32x2*)((char*)Aout + (size_t)(tok0 + 16 * ct) * DM * 2 + offO + 32 * vt) = g_pk4(val);
                    }
                }
            } else {
                GLA_BARRIER();
            }
        }
        if (!OUT) {
#pragma unroll
            for (int mt = 0; mt < 8; ++mt)
#pragma unroll
                for (int vt = 0; vt < 2; ++vt) *(u32x2*)(GS + ((size_t)(bh * 32 + m) * 256 + 32 * w + 16 * vt + l15) * 128 + 16 * mt + 4 * g) = g_pk4(S[mt][vt]);
            if (g == 0) GD[(bh * 32 + m) * 128 + 16 * w + l15] = fexp(logD);
        }
        GLA_BARRIER();
    }
}

__device__ void gla_scan(const Params& p) {
    bf16_t* GS = (bf16_t*)(p.ws + WS_GS);
    const float* GD = (const float*)(p.ws + WS_GD);
    for (int idx = blockIdx.x * NTH + threadIdx.x; idx < 8 * 8192; idx += gridDim.x * NTH) {
        const int bh = idx >> 13, e = (idx & 8191) * 4, d = e & 127;
        f32x4 S = (f32x4){0.f, 0.f, 0.f, 0.f};
        for (int m0 = 0; m0 < 32; m0 += 8) {
            u32x2 t[8]; f32x4 dd[8];
#pragma unroll
            for (int m = 0; m < 8; ++m) { t[m] = *(const u32x2*)(GS + (size_t)(bh * 32 + m0 + m) * 32768 + e); dd[m] = *(const f32x4*)(GD + (bh * 32 + m0 + m) * 128 + d); }
#pragma unroll
            for (int m = 0; m < 8; ++m) { *(u32x2*)(GS + (size_t)(bh * 32 + m0 + m) * 32768 + e) = g_pk4(S); S = S * dd[m] + g_unpk4(t[m]); }
        }
    }
}

constexpr int PP = RIN_P;
constexpr size_t WS_RK  = WS_GS;
constexpr size_t WS_BND = WS_GS + (size_t)MTOK * 16 * 4;
static_assert(WS_BND + (size_t)513 * PP * 2 <= WS_GD, "RWKV side buffers must fit the GLA state region");
constexpr int IMG = 64 * 72 * 2;
constexpr int R_ALB = 0, R_BH = IMG, R_KH = 2 * IMG, R_RB = 3 * IMG, R_BTL = 4 * IMG, R_KTL = 5 * IMG, R_VI = 6 * IMG, R_AAB = 7 * IMG, R_AAK = 8 * IMG, R_ARB = 9 * IMG, R_ARK = 10 * IMG,
              R_DW = R_AAK, R_DA = R_BH, R_XT = 11 * IMG, R_TW = R_XT, R_ADI = R_XT + IMG, R_TDF = R_XT + 2 * IMG, R_CS = R_TDF + 2048, R_GC = R_CS + 2048, R_CONST = R_GC + 256, R_WDL = R_CONST + 2560, R_WIL = R_WDL + IMG,
              R_END = R_WIL + IMG;
static_assert(R_DW + 64 * 68 * 4 <= R_XT && R_DA + 64 * 68 * 4 <= R_RB && R_END <= LDS_BYTES, "R1 LDS");
#define LDS_BARRIER() do { asm volatile("s_waitcnt lgkmcnt(0)" ::: "memory"); __builtin_amdgcn_s_barrier(); asm volatile("" ::: "memory"); } while (0)

typedef short s16x4 __attribute__((ext_vector_type(4)));
__device__ __forceinline__ bf16x8 ldfrag(const bf16_t* img, int row, int koff) { return *(const bf16x8*)(img + row * 72 + koff); }
__device__ __forceinline__ u32x2 pk4(f32x4 v) { u32x2 r; r.x = pk2(v[0], v[1]); r.y = pk2(v[2], v[3]); return r; }
__device__ __forceinline__ f32x4 unpk4(u32x2 v) { return (f32x4){bf2f(v.x & 0xffffu), bf2f(v.x >> 16), bf2f(v.y & 0xffffu), bf2f(v.y >> 16)}; }
__device__ __forceinline__ u32x2 trread(const bf16_t* p) {
    union { s16x4 s; u32x2 u; } x; x.s = __builtin_amdgcn_ds_read_tr16_b64_v4i16((__attribute__((address_space(3))) s16x4*)p); return x.u;
}
__device__ __forceinline__ bf16x8 trfrag(const bf16_t* img, int k0, int c0, int g, int q, int pq) {
    const bf16_t* a = img + (k0 + 8 * g + q) * 72 + c0 + 4 * pq;
    const u32x2 lo = trread(a), hi = trread(a + 4 * 72);
    return as_bf16x8((u32x4){lo.x, lo.y, hi.x, hi.y});
}
__device__ __forceinline__ f32x4 lo4(u32x4 v) { return (f32x4){bf2f(v.x & 0xffffu), bf2f(v.x >> 16), bf2f(v.y & 0xffffu), bf2f(v.y >> 16)}; }
__device__ __forceinline__ f32x4 hi4(u32x4 v) { return (f32x4){bf2f(v.z & 0xffffu), bf2f(v.z >> 16), bf2f(v.w & 0xffffu), bf2f(v.w >> 16)}; }
__device__ __forceinline__ u32x4 pk8(f32x4 a, f32x4 b) { return (u32x4){pk2(a[0], a[1]), pk2(a[2], a[3]), pk2(b[0], b[1]), pk2(b[2], b[3])}; }
__device__ __forceinline__ float fast_rcp(float x) { return __builtin_amdgcn_rcpf(x); }
__device__ __forceinline__ f32x4 mm16(f32x4 xa, f32x4 yb, f32x4 c) {
    const u32x2 a = pk4(xa), b = pk4(yb);
    return mfma16(as_bf16x8((u32x4){a.x, a.y, 0u, 0u}), as_bf16x8((u32x4){b.x, b.y, 0u, 0u}), c);
}

struct R1Raw { u32x4 r0, r1, k0, k1, v0, v1, w0, w1, a0, a1; };
__device__ __forceinline__ void r1_issue(R1Raw& x, const bf16_t* P, const bf16_t* BND, int unit, int t, int cs) {
    const int bn = unit >> 4, h = unit & 15, n = bn & 255;
    const bf16_t* cur = P + ((size_t)bn * 64 + t) * PP;
    const bf16_t* prv = (t > 0) ? (cur - PP) : (BND + (size_t)(n == 0 ? 0 : bn) * PP);
    const int ch = h * 64 + 8 * cs;
    x.r0 = *(const u32x4*)(cur + ch); x.k0 = *(const u32x4*)(cur + 1024 + ch); x.v0 = *(const u32x4*)(cur + 2048 + ch); x.w0 = *(const u32x4*)(cur + 4096 + 8 * cs); x.a0 = *(const u32x4*)(cur + 4160 + 8 * cs);
    x.r1 = *(const u32x4*)(prv + ch); x.k1 = *(const u32x4*)(prv + 1024 + ch); x.v1 = *(const u32x4*)(prv + 2048 + ch); x.w1 = *(const u32x4*)(prv + 4096 + 8 * cs); x.a1 = *(const u32x4*)(prv + 4160 + 8 * cs);
}
__device__ __forceinline__ void lerp8(u32x4 c, u32x4 pv, const float* mu8, f32x4& o0, f32x4& o1) {
    const f32x4 c0 = lo4(c), c1 = hi4(c), p0 = lo4(pv), p1 = hi4(pv);
    const f32x4 m0 = *(const f32x4*)mu8, m1 = *(const f32x4*)(mu8 + 4);
    o0 = c0 + m0 * (p0 - c0); o1 = c1 + m1 * (p1 - c1);
}

__device__ void rwkv_r1(const Params& p, unsigned char* lds) {
    const int tid = threadIdx.x, w = __builtin_amdgcn_readfirstlane(tid >> 6);
    bf16_t* P = (bf16_t*)(p.ws + WS_P);
    bf16_t* Abuf = (bf16_t*)(p.ws + WS_A);
    bf16_t* Ybuf = (bf16_t*)(p.ws + WS_Y);
    float* RK = (float*)(p.ws + WS_RK);
    const bf16_t* BND = (const bf16_t*)(p.ws + WS_BND);
    const bf16_t* WduT = (const bf16_t*)(p.ws + WS_WDUT);
    const bf16_t* WiuT = (const bf16_t*)(p.ws + WS_WIUT);
    bf16_t* ALB = (bf16_t*)(lds + R_ALB); bf16_t* BH = (bf16_t*)(lds + R_BH); bf16_t* KH = (bf16_t*)(lds + R_KH); bf16_t* RB = (bf16_t*)(lds + R_RB);
    bf16_t* BTL = (bf16_t*)(lds + R_BTL); bf16_t* KTL = (bf16_t*)(lds + R_KTL); bf16_t* VI = (bf16_t*)(lds + R_VI);
    bf16_t* AAB = (bf16_t*)(lds + R_AAB); bf16_t* AAK = (bf16_t*)(lds + R_AAK); bf16_t* ARB = (bf16_t*)(lds + R_ARB); bf16_t* ARK = (bf16_t*)(lds + R_ARK);
    float* DW = (float*)(lds + R_DW); float* DA = (float*)(lds + R_DA);
    bf16_t* XT = (bf16_t*)(lds + R_XT); bf16_t* TW = (bf16_t*)(lds + R_TW); bf16_t* ADI = (bf16_t*)(lds + R_ADI);
    u32x2* TDF = (u32x2*)(lds + R_TDF); float* CS = (float*)(lds + R_CS); float* GCs = (float*)(lds + R_GC); float* CONST = (float*)(lds + R_CONST); bf16_t* WDL = (bf16_t*)(lds + R_WDL); bf16_t* WIL = (bf16_t*)(lds + R_WIL);
    const int t0_ = tid >> 3, cs0_ = tid & 7;
    int hprev = -1;
    R1Raw raw;
    if (blockIdx.x < 8192) r1_issue(raw, P, BND, blockIdx.x, t0_, cs0_);
    {
        u32x4* dmy = (u32x4*)(p.ws + WS_DUMMY) + tid;
#pragma unroll
        for (int k = 0; k < 6; ++k) dmy[k * NTH] = (u32x4){0u, 0u, 0u, 0u};
    }

    for (int unit = blockIdx.x; unit < 8192; unit += gridDim.x) {
        const int bn = unit >> 4, h = unit & 15, n = bn & 255;
        const size_t R0 = (size_t)bn * 64;
        int tidv = tid; asm volatile("" : "+v"(tidv));
        const int lane = tidv & 63, l15 = lane & 15, g = lane >> 4, q4 = l15 >> 2, p4 = l15 & 3, t = tidv >> 3, cs = tidv & 7, tl = lane >> 3;
        if (h != hprev) {
            LDS_BARRIER();
            if (tid < 64) {
                const int ch = h * 64 + tid;
                CONST[tid] = p.in[10][ch]; CONST[64 + tid] = p.in[10][1024 + ch]; CONST[128 + tid] = p.in[10][2048 + ch];
                CONST[192 + tid] = p.in[11][ch]; CONST[256 + tid] = p.in[13][ch]; CONST[320 + tid] = p.in[15][ch]; CONST[384 + tid] = p.in[16][ch]; CONST[448 + tid] = p.in[17][ch];
                CONST[512 + tid] = p.in[10][4096 + tid]; CONST[576 + tid] = p.in[10][4160 + tid];
            }
            {
                const int rr = tid >> 3, sg = tid & 7;
                *(u32x4*)(WDL + rr * 72 + 8 * sg) = *(const u32x4*)(WduT + (size_t)(h * 64 + rr) * 64 + 8 * sg);
                *(u32x4*)(WIL + rr * 72 + 8 * sg) = *(const u32x4*)(WiuT + (size_t)(h * 64 + rr) * 64 + 8 * sg);
            }
            hprev = h;
            LDS_BARRIER();
        }
        f32x4 r0, r1, k0, k1, v0, v1;
        {
            f32x4 wd0, wd1, ad0, ad1;
            lerp8(raw.r0, raw.r1, CONST + 8 * cs, r0, r1);
            lerp8(raw.k0, raw.k1, CONST + 64 + 8 * cs, k0, k1);
            lerp8(raw.v0, raw.v1, CONST + 128 + 8 * cs, v0, v1);
            lerp8(raw.w0, raw.w1, CONST + 512 + 8 * cs, wd0, wd1);
            lerp8(raw.a0, raw.a1, CONST + 576 + 8 * cs, ad0, ad1);
#pragma unroll
            for (int j = 0; j < 4; ++j) {
                const float e0 = __builtin_amdgcn_exp2f(2.8853900817779268f * wd0[j]), e1 = __builtin_amdgcn_exp2f(2.8853900817779268f * wd1[j]);
                wd0[j] = 1.f - 2.f * fast_rcp(1.f + e0); wd1[j] = 1.f - 2.f * fast_rcp(1.f + e1);
            }
            *(u32x4*)(TW + t * 72 + 8 * cs) = pk8(wd0, wd1);
            *(u32x4*)(ADI + t * 72 + 8 * cs) = pk8(ad0, ad1);
        }
        if (unit + (int)gridDim.x < 8192) r1_issue(raw, P, BND, unit + gridDim.x, t, cs);
        {
            const int trow = 8 * w + (l15 & 7);
            const bool lo8 = l15 < 8;
            bf16x8 ft[2], fa[2];
#pragma unroll
            for (int kk = 0; kk < 2; ++kk) { ft[kk] = ldfrag(TW, trow, 32 * kk + 8 * g); fa[kk] = ldfrag(ADI, trow, 32 * kk + 8 * g); }
            float* dst = (lo8 ? DW : DA) + trow * 68 + 4 * g;
#pragma unroll
            for (int ct = 0; ct < 4; ++ct) {
                f32x4 aw = (f32x4){0.f, 0.f, 0.f, 0.f}, aa = aw;
#pragma unroll
                for (int kk = 0; kk < 2; ++kk) { aw = mfma16(ldfrag(WDL, 16 * ct + l15, 32 * kk + 8 * g), ft[kk], aw); aa = mfma16(ldfrag(WIL, 16 * ct + l15, 32 * kk + 8 * g), fa[kk], aa); }
                f32x4 o;
#pragma unroll
                for (int j = 0; j < 4; ++j) o[j] = lo8 ? aw[j] : aa[j];
                *(f32x4*)(dst + 16 * ct) = o;
            }
        }
        f32x4 lw[2], av[2], kk[2], k2[2], G[2];
        {
            const f32x4 cw0[2] = {*(const f32x4*)(CONST + 192 + 8 * cs), *(const f32x4*)(CONST + 196 + 8 * cs)};
            const f32x4 ca0[2] = {*(const f32x4*)(CONST + 256 + 8 * cs), *(const f32x4*)(CONST + 260 + 8 * cs)};
            const f32x4 ckk[2] = {*(const f32x4*)(CONST + 320 + 8 * cs), *(const f32x4*)(CONST + 324 + 8 * cs)};
            const f32x4 cka[2] = {*(const f32x4*)(CONST + 384 + 8 * cs), *(const f32x4*)(CONST + 388 + 8 * cs)};
            const f32x4 crk[2] = {*(const f32x4*)(CONST + 448 + 8 * cs), *(const f32x4*)(CONST + 452 + 8 * cs)};
            const f32x4 dwv[2] = {*(const f32x4*)(DW + t * 68 + 8 * cs), *(const f32x4*)(DW + t * 68 + 8 * cs + 4)};
            const f32x4 dav[2] = {*(const f32x4*)(DA + t * 68 + 8 * cs), *(const f32x4*)(DA + t * 68 + 8 * cs + 4)};
            const f32x4 kin[2] = {k0, k1}, rin[2] = {r0, r1};
            float n2 = 0.f, rk = 0.f;
#pragma unroll
            for (int hf = 0; hf < 2; ++hf)
#pragma unroll
                for (int j = 0; j < 4; ++j) {
                    const float z = -(cw0[hf][j] + dwv[hf][j]);
                    lw[hf][j] = -0.8750387749f * fast_rcp(1.f + __builtin_amdgcn_exp2f(1.4426950408889634f * z));
                    av[hf][j] = fast_rcp(1.f + __builtin_amdgcn_exp2f(-1.4426950408889634f * (ca0[hf][j] + dav[hf][j])));
                    kk[hf][j] = kin[hf][j] * ckk[hf][j];
                    k2[hf][j] = kin[hf][j] * (1.f + (av[hf][j] - 1.f) * cka[hf][j]);
                    n2 += kk[hf][j] * kk[hf][j]; rk += rin[hf][j] * k2[hf][j] * crk[hf][j];
                }
            n2 = sum8(n2); rk = sum8(rk);
            const float inv = __builtin_amdgcn_rsqf(fmaxf(n2, 1e-24f));
            kk[0] *= inv; kk[1] *= inv;
            if (cs == 0) RK[(R0 + t) * 16 + h] = rk;
            G[0] = lw[0]; G[1] = lw[1];
#pragma unroll
            for (int d = 1; d < 8; d <<= 1) {
                const int src = ((lane - 8 * d) & 63) * 4;
                const float keep = (tl >= d) ? 1.f : 0.f;
#pragma unroll
                for (int hf = 0; hf < 2; ++hf)
#pragma unroll
                    for (int j = 0; j < 4; ++j) G[hf][j] += keep * bperm(src, G[hf][j]);
            }
            if (tl == 7) { *(f32x4*)(CS + w * 64 + 8 * cs) = G[0]; *(f32x4*)(CS + w * 64 + 8 * cs + 4) = G[1]; }
        }
        LDS_BARRIER();
        {
            f32x4 off[2] = {(f32x4){0.f, 0.f, 0.f, 0.f}, (f32x4){0.f, 0.f, 0.f, 0.f}}, gc[2] = {off[0], off[0]};
#pragma unroll
            for (int q = 0; q < 8; ++q) {
                const f32x4 c0 = *(const f32x4*)(CS + q * 64 + 8 * cs), c1 = *(const f32x4*)(CS + q * 64 + 8 * cs + 4);
                const float mk = (q < w) ? 1.f : 0.f;
                gc[0] += c0; gc[1] += c1; off[0] += c0 * mk; off[1] += c1 * mk;
            }
            f32x4 al[2], bh[2], kh[2], rb[2];
            const f32x4 rin[2] = {r0, r1};
#pragma unroll
            for (int hf = 0; hf < 2; ++hf)
#pragma unroll
                for (int j = 0; j < 4; ++j) {
                    const float Gi = G[hf][j] + off[hf][j];
                    const float eG = __builtin_amdgcn_exp2f(Gi), eGm = __builtin_amdgcn_exp2f(Gi - lw[hf][j]), enG = fast_rcp(eG);
                    const float be = kk[hf][j] * av[hf][j];
                    al[hf][j] = -kk[hf][j] * eGm; bh[hf][j] = be * enG; kh[hf][j] = k2[hf][j] * enG; rb[hf][j] = rin[hf][j] * eG;
                }
            const int o = t * 72 + 8 * cs;
            *(u32x4*)(ALB + o) = pk8(al[0], al[1]); *(u32x4*)(BH + o) = pk8(bh[0], bh[1]); *(u32x4*)(KH + o) = pk8(kh[0], kh[1]); *(u32x4*)(RB + o) = pk8(rb[0], rb[1]);
            const u32x4 vpk = pk8(v0, v1);
            *(u32x4*)(VI + o) = vpk;
            *(u32x4*)(Ybuf + (R0 + t) * DM + h * 64 + 8 * cs) = vpk;
            if (w == 0 && tl == 0) { f32x4 e0, e1;
#pragma unroll
                for (int j = 0; j < 4; ++j) { e0[j] = __builtin_amdgcn_exp2f(gc[0][j]); e1[j] = __builtin_amdgcn_exp2f(gc[1][j]); }
                *(f32x4*)(GCs + 8 * cs) = e0; *(f32x4*)(GCs + 8 * cs + 4) = e1; }
        }
        LDS_BARRIER();
        {
            int ntile = 1, tta = 0, sta = 0, ttb = 0, stb = 0;
            if (w == 0) { tta = 0; sta = 0; } else if (w == 2) { tta = 1; sta = 1; } else if (w == 5) { tta = 2; sta = 2; } else if (w == 7) { tta = 3; sta = 3; }
            else if (w == 1) { ntile = 2; tta = 1; sta = 0; ttb = 2; stb = 0; } else if (w == 3) { ntile = 2; tta = 2; sta = 1; ttb = 3; stb = 0; }
            else if (w == 4) { tta = 3; sta = 1; } else { tta = 3; sta = 2; }
            for (int it = 0; it < ntile; ++it) {
                const int tt = it ? ttb : tta, st = it ? stb : sta;
                f32x4 cab = (f32x4){0.f, 0.f, 0.f, 0.f}, cak = cab, crb = cab, crk = cab, nab = cab;
#pragma unroll
                for (int kq = 0; kq < 2; ++kq) {
                    const bf16x8 fb = ldfrag(BH, 16 * st + l15, 32 * kq + 8 * g), fk = ldfrag(KH, 16 * st + l15, 32 * kq + 8 * g);
                    const bf16x8 fa = ldfrag(ALB, 16 * tt + l15, 32 * kq + 8 * g), fr = ldfrag(RB, 16 * tt + l15, 32 * kq + 8 * g);
                    cab = mfma16(fb, fa, cab); cak = mfma16(fk, fa, cak); crb = mfma16(fb, fr, crb); crk = mfma16(fk, fr, crk);
                    if (tt == st) nab = mfma16(fa, fb, nab);
                }
                if (tt == st) {
#pragma unroll
                    for (int r = 0; r < 4; ++r) {
                        const int s = 4 * g + r, tq = l15;
                        if (s >= tq) { cab[r] = 0.f; cak[r] = 0.f; }
                        if (s > tq) { crb[r] = 0.f; crk[r] = 0.f; }
                        if (l15 >= 4 * g + r) nab[r] = 0.f;
                    }
                }
                const int o = (16 * tt + l15) * 72 + 16 * st + 4 * g;
                *(u32x2*)(AAB + o) = pk4(cab); *(u32x2*)(AAK + o) = pk4(cak); *(u32x2*)(ARB + o) = pk4(crb); *(u32x2*)(ARK + o) = pk4(crk);
                if (tt == st) {
                    const f32x4 z = (f32x4){0.f, 0.f, 0.f, 0.f};
                    const f32x4 Q1 = cab, N1 = nab;
                    const f32x4 Q2 = mm16(N1, Q1, z), N2 = mm16(Q1, N1, z);
                    f32x4 Pm = Q1;
#pragma unroll
                    for (int r = 0; r < 4; ++r) if (4 * g + r == l15) Pm[r] += 1.f;
                    Pm = mm16(N2, Pm, Pm);
                    const f32x4 Q4 = mm16(N2, Q2, z), N4 = mm16(Q2, N2, z);
                    Pm = mm16(N4, Pm, Pm);
                    const f32x4 N8 = mm16(Q4, N4, z);
                    Pm = mm16(N8, Pm, Pm);
                    TDF[tt * 64 + lane] = pk4(Pm);
                }
            }
            if (w == 4 || w == 6) {
                const int tt = (w == 4) ? 0 : 2, st = tt + 1;
                const int o = (16 * tt + l15) * 72 + 16 * st + 4 * g;
                const u32x2 zz = (u32x2){0u, 0u};
                *(u32x2*)(AAK + o) = zz; *(u32x2*)(ARB + o) = zz; *(u32x2*)(ARK + o) = zz;
            }
        }
        LDS_BARRIER();
        {
            u32x2 xb[4];
            const int col = 16 * w + l15;
            bf16x8 vfr[2];
            if (w >= 4) { vfr[0] = trfrag(VI, 0, 16 * (w - 4), g, q4, p4); vfr[1] = trfrag(VI, 32, 16 * (w - 4), g, q4, p4); }
#pragma unroll
            for (int i = 0; i < 4; ++i) {
                f32x4 z;
                if (w < 4) z = unpk4(trread(ALB + (16 * i + 4 * g + q4) * 72 + 16 * w + 4 * p4));
                else {
                    z = mfma16(ldfrag(AAK, 16 * i + l15, 8 * g), vfr[0], (f32x4){0.f, 0.f, 0.f, 0.f});
                    if (i >= 2) z = mfma16(ldfrag(AAK, 16 * i + l15, 32 + 8 * g), vfr[1], z);
                }
                if (i >= 1) {
                    const bf16_t* ar = AAB + (16 * i + l15) * 72 + 4 * g;
                    const u32x2 a0 = *(const u32x2*)ar;
                    u32x2 a1 = (u32x2){0u, 0u}, b1 = (u32x2){0u, 0u};
                    if (i >= 2) { a1 = *(const u32x2*)(ar + 16); b1 = xb[1]; }
                    z = mfma16(as_bf16x8((u32x4){a0.x, a0.y, a1.x, a1.y}), as_bf16x8((u32x4){xb[0].x, xb[0].y, b1.x, b1.y}), z);
                    if (i == 3) {
                        const u32x2 a2 = *(const u32x2*)(ar + 32);
                        z = mfma16(as_bf16x8((u32x4){a2.x, a2.y, 0u, 0u}), as_bf16x8((u32x4){xb[2].x, xb[2].y, 0u, 0u}), z);
                    }
                }
                const u32x2 tq = TDF[i * 64 + lane];
                const u32x2 zq = pk4(z);
                const f32x4 x = mfma16(as_bf16x8((u32x4){tq.x, tq.y, 0u, 0u}), as_bf16x8((u32x4){zq.x, zq.y, 0u, 0u}), (f32x4){0.f, 0.f, 0.f, 0.f});
                xb[i] = pk4(x);
                *(u32x2*)(XT + col * 72 + 16 * i + 4 * g) = xb[i];
            }
        }
        LDS_BARRIER();
        {
            const int rt_ = w & 3, c0 = 2 * (w >> 2);
            bf16x8 xw[2], xu[2], fbt[2], fkt[2], fvr[2];
#pragma unroll
            for (int kq = 0; kq < 2; ++kq) {
                xw[kq] = ldfrag(XT, 16 * rt_ + l15, 32 * kq + 8 * g);
                xu[kq] = ldfrag(XT, 64 + 16 * rt_ + l15, 32 * kq + 8 * g);
                fbt[kq] = trfrag(BH, 32 * kq, 16 * rt_, g, q4, p4);
                fkt[kq] = trfrag(KH, 32 * kq, 16 * rt_, g, q4, p4);
                fvr[kq] = trfrag(VI, 32 * kq, 16 * rt_, g, q4, p4);
            }
            const float gcd0 = GCs[16 * c0 + l15], gcd1 = GCs[16 * c0 + 16 + l15];
            const f32x4 gcr = *(const f32x4*)(GCs + 16 * rt_ + 4 * g);
#pragma unroll
            for (int q = 0; q < 2; ++q) {
                bf16x8 gbt[2], garb[2], gxu[2], gvi[2], gark[2];
#pragma unroll
                for (int kq = 0; kq < 2; ++kq) {
                    gbt[kq] = trfrag(BH, 32 * kq, 16 * (c0 + q), g, q4, p4);
                    garb[kq] = ldfrag(ARB, 16 * (c0 + q) + l15, 32 * kq + 8 * g);
                    gxu[kq] = ldfrag(XT, 64 + 16 * (c0 + q) + l15, 32 * kq + 8 * g);
                    gvi[kq] = trfrag(VI, 32 * kq, 16 * (c0 + q), g, q4, p4);
                    gark[kq] = ldfrag(ARK, 16 * (c0 + q) + l15, 32 * kq + 8 * g);
                }
                const u32x2 rbi = *(const u32x2*)(RB + (16 * (c0 + q) + l15) * 72 + 16 * rt_ + 4 * g);
                __builtin_amdgcn_sched_barrier(0);
                const int ctile = c0 + q;
                {
                    f32x4 acc = (f32x4){0.f, 0.f, 0.f, 0.f};
#pragma unroll
                    for (int kq = 0; kq < 2; ++kq) acc = mfma16(xw[kq], gbt[kq], acc);
                    const int dcol = 16 * ctile + l15;
                    if (rt_ == ctile) {
#pragma unroll
                        for (int r = 0; r < 4; ++r) if (4 * g + r == l15) acc[r] += 1.f;
                    }
                    acc *= (q ? gcd1 : gcd0);
                    *(u32x2*)(ALB + dcol * 72 + 32 * (rt_ >> 1) + 8 * g + 4 * (rt_ & 1)) = pk4(acc);
                }
                {
                    f32x4 acc = unpk4(rbi);
#pragma unroll
                    for (int kq = 0; kq < 2; ++kq) {
                        if (32 * kq <= 16 * ctile + 15) acc = mfma16(xw[kq], garb[kq], acc);
                    }
                    *(u32x2*)(BTL + (16 * ctile + l15) * 72 + 16 * rt_ + 4 * g) = pk4(acc);
                }
                {
                    f32x4 acc = (f32x4){0.f, 0.f, 0.f, 0.f};
#pragma unroll
                    for (int kq = 0; kq < 2; ++kq) { acc = mfma16(fbt[kq], gxu[kq], acc); acc = mfma16(fkt[kq], gvi[kq], acc); }
                    *(u32x2*)(KTL + (16 * ctile + l15) * 72 + 16 * rt_ + 4 * g) = pk4(acc * gcr);
                }
                {
                    f32x4 acc = (f32x4){0.f, 0.f, 0.f, 0.f};
#pragma unroll
                    for (int kq = 0; kq < 2; ++kq) {
                        if (32 * kq <= 16 * ctile + 15) { acc = mfma16(xu[kq], garb[kq], acc); acc = mfma16(fvr[kq], gark[kq], acc); }
                    }
                    *(u32x2*)(AAB + (16 * ctile + l15) * 72 + 16 * rt_ + 4 * g) = pk4(acc);
                }
            }
        }
        LDS_BARRIER();
        {
            const int o = t * 72 + 8 * cs;
            *(u32x4*)(P + (R0 + t) * PP + h * 64 + 8 * cs) = *(const u32x4*)(ALB + o);
            *(u32x4*)(P + (R0 + t) * PP + 1024 + h * 64 + 8 * cs) = *(const u32x4*)(BTL + o);
            *(u32x4*)(P + (R0 + t) * PP + 2048 + h * 64 + 8 * cs) = *(const u32x4*)(KTL + o);
            *(u32x4*)(Abuf + (R0 + t) * DM + h * 64 + 8 * cs) = *(const u32x4*)(AAB + o);
        }
    }
}

constexpr int SC_SLOT = 2 * IMG;
constexpr size_t WS_MG = (WS_BND + (size_t)513 * PP * 2 + 255) & ~(size_t)255;
constexpr size_t WS_NG = WS_MG + (size_t)1024 * 4096 * 2;
static_assert(WS_NG + (size_t)1024 * 4096 * 2 <= WS_GD, "scan buffers must fit the GLA state region");

template <int MODE>
__device__ void rwkv_scan2(const Params& p, unsigned char* lds) {
    constexpr int GSZ = 32, NGRP = 256 / GSZ, LG = 3;
    constexpr int SPU = (MODE == 2) ? NGRP : GSZ;
    constexpr int NU = (MODE == 2) ? 32 : 32 * NGRP;
    const int tid = threadIdx.x, lane = tid & 63, w = __builtin_amdgcn_readfirstlane(tid >> 6), l15 = lane & 15, g = lane >> 4;
    bf16_t* P = (bf16_t*)(p.ws + WS_P);
    bf16_t* MG = (bf16_t*)(p.ws + WS_MG); bf16_t* NG = (bf16_t*)(p.ws + WS_NG); bf16_t* HG = NG;
    const int G = gridDim.x;
    const int nun = ((int)blockIdx.x < NU) ? (NU - 1 - (int)blockIdx.x) / G + 1 : 0;
    const int T = nun * SPU;
    if (T == 0) return;
#define SC_SRC(s, p0, p1, pitchb) \
    const int u_ = (int)blockIdx.x + G * ((s) / SPU), j_ = (s) % SPU; \
    const char* p0; const char* p1; unsigned pitchb; \
    if (MODE == 2) { p0 = (const char*)(MG + (size_t)(u_ * NGRP + j_) * 4096); p1 = (const char*)(NG + (size_t)(u_ * NGRP + j_) * 4096); pitchb = 128u; } \
    else { const int bh_ = u_ >> LG, n_ = GSZ * (u_ & (NGRP - 1)) + j_; p0 = (const char*)(P + ((size_t)(bh_ >> 4) * SEQ + (size_t)n_ * 64) * PP + (bh_ & 15) * 64); p1 = p0 + 4096; pitchb = (unsigned)(PP * 2); }
    if (w >= 4) {
        const int lj = w - 4;
        const unsigned loff = (unsigned)((lane >> 3) * 144 + (lane & 7) * 16);
        u32x4 ld0[16], ld1[16];
#define SC_ISSUE(dst, s) do { const int sc_ = ((s) < T) ? (s) : T - 1; SC_SRC(sc_, q0_, q1_, pb_) const unsigned go_ = (unsigned)(lane >> 3) * pb_ + (unsigned)(lane & 7) * 16u; \
        _Pragma("unroll") for (int q = 0; q < 16; ++q) dst[q] = *(const u32x4*)(((q >> 3) ? q1_ : q0_) + (size_t)((q & 7) * 8) * pb_ + go_); } while (0)
#define SC_RETIRE(src, s) do { unsigned char* sb = lds + ((s) & 1) * SC_SLOT + loff; _Pragma("unroll") for (int q = 0; q < 16; ++q) \
        *(u32x4*)(sb + (q >> 3) * IMG + (q & 7) * 8 * 144) = src[q]; } while (0)
        SC_ISSUE(ld0, lj); SC_ISSUE(ld1, lj + 4);
        for (int it = 0; it < T / 8; ++it) {
            const int c0 = lj + 8 * it;
            for (int k = 0; k < lj; ++k) LDS_BARRIER();
            SC_RETIRE(ld0, c0); SC_ISSUE(ld0, c0 + 8);
            for (int k = 0; k < 4; ++k) LDS_BARRIER();
            SC_RETIRE(ld1, c0 + 4); SC_ISSUE(ld1, c0 + 12);
            for (int k = 0; k < 4 - lj; ++k) LDS_BARRIER();
        }
        LDS_BARRIER();
#undef SC_ISSUE
#undef SC_RETIRE
    } else {
        f32x4 H[4], Mg[4];
        for (int i = 0; i <= T; ++i) {
            if (i >= 1) {
                const int s = i - 1, u = (int)blockIdx.x + G * (s / SPU), j = s % SPU;
                const unsigned char* sb = lds + (s & 1) * SC_SLOT;
                const bf16_t* MT = (const bf16_t*)sb; const bf16_t* NT = (const bf16_t*)(sb + IMG);
                if (j == 0) {
                    if (MODE == 3) {
#pragma unroll
                        for (int mt = 0; mt < 4; ++mt) H[mt] = unpk4(*(const u32x2*)(HG + (size_t)u * 4096 + (16 * w + l15) * 64 + 16 * mt + 4 * g));
                    } else {
#pragma unroll
                        for (int mt = 0; mt < 4; ++mt) H[mt] = (f32x4){0.f, 0.f, 0.f, 0.f};
                    }
                    if (MODE == 1) {
#pragma unroll
                        for (int mt = 0; mt < 4; ++mt)
#pragma unroll
                            for (int r = 0; r < 4; ++r) Mg[mt][r] = (16 * mt + 4 * g + r == 16 * w + l15) ? 1.f : 0.f;
                    }
                }
                u32x2 hp[4];
#pragma unroll
                for (int mt = 0; mt < 4; ++mt) hp[mt] = pk4(H[mt]);
                if (MODE == 2) {
#pragma unroll
                    for (int mt = 0; mt < 4; ++mt) *(u32x2*)(HG + (size_t)(u * NGRP + j) * 4096 + (16 * w + l15) * 64 + 16 * mt + 4 * g) = hp[mt];
                }
                if (MODE == 3) {
                    const int bh = u >> LG, n = GSZ * (u & (NGRP - 1)) + j;
#pragma unroll
                    for (int mt = 0; mt < 4; ++mt) *(u32x2*)(P + ((size_t)(bh >> 4) * SEQ + (size_t)n * 64 + 16 * w + l15) * PP + 2048 + (bh & 15) * 64 + 16 * mt + 4 * g) = hp[mt];
                }
                bf16x8 hb[2], mb[2];
                hb[0] = as_bf16x8((u32x4){hp[0].x, hp[0].y, hp[1].x, hp[1].y});
                hb[1] = as_bf16x8((u32x4){hp[2].x, hp[2].y, hp[3].x, hp[3].y});
                if (MODE == 1) {
                    const u32x2 m0 = pk4(Mg[0]), m1 = pk4(Mg[1]), m2 = pk4(Mg[2]), m3 = pk4(Mg[3]);
                    mb[0] = as_bf16x8((u32x4){m0.x, m0.y, m1.x, m1.y}); mb[1] = as_bf16x8((u32x4){m2.x, m2.y, m3.x, m3.y});
                }
#pragma unroll
                for (int mt = 0; mt < 4; ++mt) {
                    const bf16x8 a0 = ldfrag(MT, 16 * mt + l15, 8 * g), a1 = ldfrag(MT, 16 * mt + l15, 32 + 8 * g);
                    f32x4 acc = unpk4(*(const u32x2*)(NT + (16 * w + l15) * 72 + 16 * mt + 4 * g));
                    acc = mfma16(a0, hb[0], acc); acc = mfma16(a1, hb[1], acc);
                    H[mt] = acc;
                    if (MODE == 1) { f32x4 am = mfma16(a0, mb[0], (f32x4){0.f, 0.f, 0.f, 0.f}); am = mfma16(a1, mb[1], am); Mg[mt] = am; }
                }
                if (MODE == 1 && j == SPU - 1) {
                    const int pc = 32 * (w >> 1) + 8 * (l15 >> 2) + 4 * (w & 1) + (l15 & 3);
#pragma unroll
                    for (int mt = 0; mt < 4; ++mt) {
                        *(u32x2*)(NG + (size_t)u * 4096 + (16 * w + l15) * 64 + 16 * mt + 4 * g) = pk4(H[mt]);
#pragma unroll
                        for (int r = 0; r < 4; ++r) MG[(size_t)u * 4096 + (16 * mt + 4 * g + r) * 64 + pc] = f2bf(Mg[mt][r]);
                    }
                }
            }
            LDS_BARRIER();
        }
    }
#undef SC_SRC
}

__device__ void rwkv_post(const Params& p, unsigned char* lds) {
    const int tid = threadIdx.x, lane = tid & 63, w = __builtin_amdgcn_readfirstlane(tid >> 6), l15 = lane & 15, g = lane >> 4;
    const bf16_t* P = (const bf16_t*)(p.ws + WS_P);
    bf16_t* Abuf = (bf16_t*)(p.ws + WS_A);
    const bf16_t* Ybuf = (const bf16_t*)(p.ws + WS_Y);
    const float* RK = (const float*)(p.ws + WS_RK);
    const bf16_t* BND = (const bf16_t*)(p.ws + WS_BND);
    float* L = (float*)(lds + w * 8704);
    const int tr = lane >> 3, seg = lane & 7;
    for (int hu = blockIdx.x * 8 + w; hu < 16384; hu += gridDim.x * 8) {
        const int unit = hu >> 1, t0 = (hu & 1) * 32;
        const int bn = unit >> 4, h = unit & 15, n = bn & 255;
        const size_t R0 = (size_t)bn * 64;
        bf16x8 fh[4][2], fr[2][2];
#pragma unroll
        for (int kk = 0; kk < 2; ++kk) {
#pragma unroll
            for (int q = 0; q < 4; ++q) fh[q][kk] = *(const bf16x8*)(P + (R0 + 16 * q + l15) * PP + 2048 + h * 64 + 32 * kk + 8 * g);
#pragma unroll
            for (int q = 0; q < 2; ++q) fr[q][kk] = *(const bf16x8*)(P + (R0 + t0 + 16 * q + l15) * PP + 1024 + h * 64 + 32 * kk + 8 * g);
        }
        u32x4 y0r[4], g1r[4], g0r[4], vpr[4];
        float rkv[4];
#pragma unroll
        for (int i = 0; i < 4; ++i) {
            const int t = t0 + tr + 8 * i;
            y0r[i] = *(const u32x4*)(Abuf + (R0 + t) * DM + h * 64 + 8 * seg);
            const bf16_t* grow = P + (R0 + t) * PP + 3072 + h * 64 + 8 * seg;
            g1r[i] = *(const u32x4*)grow;
            g0r[i] = *(const u32x4*)((t > 0) ? (grow - PP) : (BND + (size_t)(n == 0 ? 0 : bn) * PP + 3072 + h * 64 + 8 * seg));
            vpr[i] = *(const u32x4*)(Ybuf + (R0 + t) * DM + h * 64 + 8 * seg);
            rkv[i] = RK[(R0 + t) * 16 + h];
        }
#pragma unroll
        for (int i = 0; i < 4; ++i) { *(f32x4*)(L + (tr + 8 * i) * 68 + 8 * seg) = lo4(y0r[i]); *(f32x4*)(L + (tr + 8 * i) * 68 + 8 * seg + 4) = hi4(y0r[i]); }
        f32x4 y[4][2];
#pragma unroll
        for (int vt = 0; vt < 4; ++vt)
#pragma unroll
            for (int tt = 0; tt < 2; ++tt) y[vt][tt] = *(const f32x4*)(L + (16 * tt + l15) * 68 + 16 * vt + 4 * g);
#pragma unroll
        for (int vt = 0; vt < 4; ++vt)
#pragma unroll
            for (int tt = 0; tt < 2; ++tt)
#pragma unroll
                for (int kk = 0; kk < 2; ++kk) y[vt][tt] = mfma16(fh[vt][kk], fr[tt][kk], y[vt][tt]);
#pragma unroll
        for (int tt = 0; tt < 2; ++tt) {
            float s1 = 0.f, s2 = 0.f;
#pragma unroll
            for (int vt = 0; vt < 4; ++vt)
#pragma unroll
                for (int r = 0; r < 4; ++r) { s1 += y[vt][tt][r]; s2 += y[vt][tt][r] * y[vt][tt][r]; }
            { const int a16 = (lane ^ 16) * 4, a32 = (lane ^ 32) * 4; s1 += bperm(a16, s1); s2 += bperm(a16, s2); s1 += bperm(a32, s1); s2 += bperm(a32, s2); }
            const float mean = s1 * (1.0f / 64.0f);
            const float rstd = rsqrtf(fmaxf(s2 * (1.0f / 64.0f) - mean * mean, 0.f) + 64e-5f);
#pragma unroll
            for (int vt = 0; vt < 4; ++vt) *(f32x4*)(L + (16 * tt + l15) * 68 + 16 * vt + 4 * g) = (y[vt][tt] - mean) * rstd;
        }
        const int ch = h * 64 + 8 * seg;
        const f32x4 lw0 = *(const f32x4*)(p.in[18] + ch), lw1 = *(const f32x4*)(p.in[18] + ch + 4), lb0 = *(const f32x4*)(p.in[19] + ch), lb1 = *(const f32x4*)(p.in[19] + ch + 4);
        const f32x4 mg0 = *(const f32x4*)(p.in[10] + 3072 + ch), mg1 = *(const f32x4*)(p.in[10] + 3072 + ch + 4);
#pragma unroll
        for (int i = 0; i < 4; ++i) {
            const int t = t0 + tr + 8 * i;
            const f32x4 n0 = *(const f32x4*)(L + (tr + 8 * i) * 68 + 8 * seg), n1 = *(const f32x4*)(L + (tr + 8 * i) * 68 + 8 * seg + 4);
            const f32x4 ga0 = lo4(g1r[i]), ga1 = hi4(g1r[i]);
            const f32x4 gb0 = lo4(g0r[i]), gb1 = hi4(g0r[i]);
            const f32x4 gt0 = ga0 + mg0 * (gb0 - ga0), gt1 = ga1 + mg1 * (gb1 - ga1);
            const f32x4 v0 = lo4(vpr[i]), v1 = hi4(vpr[i]);
            f32x4 o0 = n0 * lw0 + lb0 + rkv[i] * v0, o1 = n1 * lw1 + lb1 + rkv[i] * v1;
#pragma unroll
            for (int j = 0; j < 4; ++j) { o0[j] *= gt0[j] * __builtin_amdgcn_rcpf(1.0f + fexp(-gt0[j])); o1[j] *= gt1[j] * __builtin_amdgcn_rcpf(1.0f + fexp(-gt1[j])); }
            *(u32x4*)(Abuf + (R0 + t) * DM + h * 64 + 8 * seg) = pk8(o0, o1);
        }
    }
}
#define XB_TMO      128
#define XB_XCNT(j)  (256  + 64 * (j))
#define XB_XSUB(j)  (1280 + 64 * (j))
#define XB_XGEN(j)  (2304 + 64 * (j))
#define XB_TOP      3328
#define XB_TOPGEN   3392
#define XCD_BAR_WORDS 3456
#define XB_SPIN_CAP (1u << 18)
#define LAS __attribute__((address_space(3)))

__device__ __forceinline__ unsigned xb_ld(unsigned* p)              { return __hip_atomic_load(p, __ATOMIC_RELAXED, __HIP_MEMORY_SCOPE_AGENT); }
__device__ __forceinline__ unsigned xb_add(unsigned* p, unsigned v) { return __hip_atomic_fetch_add(p, v, __ATOMIC_RELAXED, __HIP_MEMORY_SCOPE_AGENT); }
__device__ __forceinline__ unsigned xb_xcc_id() { return (unsigned)__builtin_amdgcn_s_getreg((3 << 11) | 20) & 0xFu; }
#define XB_SPIN(cond, bar) do { unsigned _sp = 0; while (cond) { __builtin_amdgcn_s_sleep(1); \
    if ((++_sp & 255u) == 0u) { if (xb_ld(&(bar)[XB_TMO])) break; if (_sp > XB_SPIN_CAP) { atomicAdd(&(bar)[XB_TMO], 1u); break; } } } } while (0)

struct XcdBarrier {
    unsigned* bar; unsigned x;
    volatile LAS unsigned* st;
};

__device__ __forceinline__ XcdBarrier xcd_barrier_post(unsigned* bar, volatile LAS unsigned* st) {
    XcdBarrier b; b.bar = bar; b.x = xb_xcc_id(); b.st = st;
    if (threadIdx.x == 0) (void)xb_add(&bar[XB_XCNT(b.x)], 1u);
    return b;
}
__device__ __forceinline__ void xcd_barrier_complete(unsigned* bar, unsigned x, unsigned& nloc, unsigned& nx) {
    const unsigned G = gridDim.x * gridDim.y * gridDim.z;
    unsigned sum, cnt, mine, sp = 0u;
    for (;;) {
        sum = 0u; cnt = 0u; mine = 0u;
#pragma unroll
        for (unsigned j = 0; j < 16; ++j) { const unsigned c = xb_ld(&bar[XB_XCNT(j)]); sum += c; cnt += (c > 0u) ? 1u : 0u; mine = (j == x) ? c : mine; }
        if (sum == G) break;
        __builtin_amdgcn_s_sleep(1);
        if ((++sp & 255u) == 0u) { if (xb_ld(&bar[XB_TMO])) break; if (sp > XB_SPIN_CAP) { atomicAdd(&bar[XB_TMO], 1u); break; } }
    }
    nloc = mine > 0u ? mine : 1u; nx = cnt > 0u ? cnt : 1u;
}

__device__ __forceinline__ void xcd_barrier(const XcdBarrier& b) {
    asm volatile("s_waitcnt vmcnt(0)" ::: "memory");
    __syncthreads();
    if (threadIdx.x == 0) {
        unsigned* bar = b.bar;
        __builtin_amdgcn_s_waitcnt(0);
        unsigned nloc = b.st[0], nx = b.st[1];
        if (nloc == 0u) { xcd_barrier_complete(bar, b.x, nloc, nx); b.st[0] = nloc; b.st[1] = nx; }
        const unsigned old = xb_add(&bar[XB_XSUB(b.x)], 1u);
        const unsigned gen = old / nloc;
        if (old + 1u == (gen + 1u) * nloc) {
            __builtin_amdgcn_fence(__ATOMIC_RELEASE, "agent");
            asm volatile("s_waitcnt vmcnt(0)" ::: "memory");
            const unsigned og = xb_add(&bar[XB_TOP], 1u);
            const unsigned tg = og / nx;
            if (og + 1u == (tg + 1u) * nx) xb_add(&bar[XB_TOPGEN], 1u);
            else XB_SPIN(xb_ld(&bar[XB_TOPGEN]) == tg, bar);
            __builtin_amdgcn_fence(__ATOMIC_ACQUIRE, "agent");
            xb_add(&bar[XB_XGEN(b.x)], 1u);
            asm volatile("s_waitcnt vmcnt(0)" ::: "memory");
        } else {
            XB_SPIN(xb_ld(&bar[XB_XGEN(b.x)]) == gen, bar);
            __builtin_amdgcn_fence(__ATOMIC_ACQUIRE, "agent");
            asm volatile("s_waitcnt vmcnt(0)" ::: "memory");
        }
    }
    __syncthreads();
}


#ifndef PROBE_ID
#define PROBE_ID 0
#endif
#ifndef N_LAUNCH_MODE
#define N_LAUNCH_MODE 1
#endif
constexpr int N_PHASES = 15;

__global__ void __launch_bounds__(NTH, 2) fwd_kernel(Params p) {
    extern __shared__ __attribute__((aligned(16))) unsigned char lds[];
    const int lo = p.ph_lo, hi = p.ph_hi;
    volatile LAS unsigned* xst = (volatile LAS unsigned*)(lds + LDS_BYTES);
    if (threadIdx.x < 4) xst[threadIdx.x] = 0u;
    __syncthreads();
    const XcdBarrier xbar = xcd_barrier_post((unsigned*)(p.ws + WS_BAR), xst);
    unsigned char* ws = p.ws;
#define IN(k) (lo <= (k) && (k) < hi)
#define SEAM(k) do { if ((k) + 1 < hi) xcd_barrier(xbar); } while (0)
    if (IN(0)) {
        prep_weight(p.in[2], GIN, p.in[1], (bf16_t*)(ws + WS_WGIN), GIN_P, (float*)lds);
        prep_weight(p.in[6], DM, nullptr, (bf16_t*)(ws + WS_WGOUT), DM, (float*)lds);
        prep_wup(p.in[3], (bf16_t*)(ws + WS_WUPT));
        __syncthreads();
        phase_norm0(p, lds);
        SEAM(0);
    }
    if (IN(1)) {
        pg8::Gemm g{(const bf16_t*)(ws + WS_A), (const bf16_t*)(ws + WS_WGIN), MTOK, GIN_P, DM}; pg8::StaticOrder S; S.init(MTOK, GIN_P, gridDim.x, blockIdx.x);
        EpiBf16GateSilu E{(bf16_t*)(ws + WS_P), GIN_P};
        pg8::gemm_phase<EpiBf16GateSilu, pg8::StaticOrder>((PG8_LAS unsigned char*)lds, g, S, E);
        SEAM(1);
    }
    if (IN(2)) { gla_pass<false>(p, lds); SEAM(2); }
    if (IN(3)) {
        gla_scan(p);
        prep_weight(p.in[9], RIN, p.in[8], (bf16_t*)(ws + WS_WRIN), RIN_P, (float*)lds);
        prep_weight(p.in[20], DM, nullptr, (bf16_t*)(ws + WS_WROUT), DM, (float*)lds);
        prep_lowrank(p.in[12], (bf16_t*)(ws + WS_WDUT));
        prep_lowrank(p.in[14], (bf16_t*)(ws + WS_WIUT));
        SEAM(3);
    }
    if (IN(4)) { gla_pass<true>(p, lds); SEAM(4); }
    if (IN(5)) {
        pg8::Gemm g{(const bf16_t*)(ws + WS_A), (const bf16_t*)(ws + WS_WGOUT), MTOK, DM, DM}; pg8::StaticOrder S; S.init(MTOK, DM, gridDim.x, blockIdx.x);
        pg8::EpiBf16<0> E{(bf16_t*)(ws + WS_Y), DM, nullptr, 0, 0};
        pg8::gemm_phase<pg8::EpiBf16<0>, pg8::StaticOrder>((PG8_LAS unsigned char*)lds, g, S, E);
        SEAM(5);
    }
    if (IN(6)) { phase_norm1(p); zero_bnd_row((bf16_t*)(ws + WS_BND)); SEAM(6); }
    if (IN(7)) {
        pg8::Gemm g{(const bf16_t*)(ws + WS_A), (const bf16_t*)(ws + WS_WRIN), MTOK, RIN_P, DM}; pg8::StaticOrder S; S.init(MTOK, RIN_P, gridDim.x, blockIdx.x);
        EpiBf16Bnd E{(bf16_t*)(ws + WS_P), RIN_P, (bf16_t*)(ws + WS_BND)};
        pg8::gemm_phase<EpiBf16Bnd, pg8::StaticOrder>((PG8_LAS unsigned char*)lds, g, S, E);
        SEAM(7);
    }
    if (IN(8)) { rwkv_r1(p, lds); SEAM(8); }
    if (IN(9)) { rwkv_scan2<1>(p, lds); SEAM(9); }
    if (IN(10)) { rwkv_scan2<2>(p, lds); SEAM(10); }
    if (IN(11)) { rwkv_scan2<3>(p, lds); SEAM(11); }
    if (IN(12)) { rwkv_post(p, lds); SEAM(12); }
    if (IN(13)) {
        pg8::Gemm g{(const bf16_t*)(ws + WS_A), (const bf16_t*)(ws + WS_WROUT), MTOK, DM, DM}; pg8::StaticOrder S; S.init(MTOK, DM, gridDim.x, blockIdx.x);
        pg8::EpiBf16<0> E{(bf16_t*)(ws + WS_Y), DM, nullptr, 0, 0};
        pg8::gemm_phase<pg8::EpiBf16<0>, pg8::StaticOrder>((PG8_LAS unsigned char*)lds, g, S, E);
        SEAM(13);
    }
    if (IN(14)) { phase_final(p); }
#undef IN
#undef SEAM
}

extern "C" void kernel_launch(void* const* d_in, const int* in_sizes, int n_in, void* d_out, int out_size, void* d_ws, size_t ws_size, hipStream_t stream) {
    static int grid = 0;
    if (grid == 0) {
        int dev = 0, cus = 0, per_cu = 0;
        hipGetDevice(&dev);
        hipDeviceGetAttribute(&cus, hipDeviceAttributeMultiprocessorCount, dev);
        hipFuncSetAttribute((const void*)fwd_kernel, hipFuncAttributeMaxDynamicSharedMemorySize, LDS_BYTES + 16);
        hipOccupancyMaxActiveBlocksPerMultiprocessor(&per_cu, (const void*)fwd_kernel, NTH, LDS_BYTES + 16);
        if (per_cu < 1) { fprintf(stderr, "kernel_launch: occupancy query says %d blocks per CU\n", per_cu); per_cu = 1; }
        grid = cus;
        if (n_in != 22 || ws_size < WS_END) fprintf(stderr, "kernel_launch: unexpected n_in %d or workspace %zu < %zu\n", n_in, ws_size, (size_t)WS_END);
        (void)hipGetLastError();
    }
    if (hipMemsetAsync((char*)d_ws + WS_BAR, 0, XCD_BAR_WORDS * 4, stream) != hipSuccess) fprintf(stderr, "kernel_launch: memset of the barrier words failed\n");
    Params p{};
    for (int i = 0; i < 22; ++i) p.in[i] = (const float*)d_in[i];
    p.out = (float*)d_out; p.ws = (unsigned char*)d_ws;
#if N_LAUNCH_MODE == 1
    void* args[] = {&p};
#if PROBE_ID > 0
    p.ph_lo = 0; p.ph_hi = PROBE_ID;
    (void)hipLaunchCooperativeKernel((const void*)fwd_kernel, dim3(grid), dim3(NTH), args, LDS_BYTES + 16, stream);
    (void)hipMemsetAsync((char*)d_ws + WS_BAR, 0, XCD_BAR_WORDS * 4, stream);
#endif
    p.ph_lo = 0; p.ph_hi = N_PHASES;
    hipError_t e = hipLaunchCooperativeKernel((const void*)fwd_kernel, dim3(grid), dim3(NTH), args, LDS_BYTES + 16, stream);
    if (e != hipSuccess) fprintf(stderr, "cooperative launch failed: %s (grid %d)\n", hipGetErrorString(e), grid);
#else
    for (int k = 0; k < N_PHASES; ++k) {
        p.ph_lo = k; p.ph_hi = k + 1;
        hipLaunchKernelGGL(fwd_kernel, dim3(grid), dim3(NTH), LDS_BYTES + 16, stream, p);
    }
#endif
}
```

```cpp
#include <hip/hip_runtime.h>
#include <hip/hip_cooperative_groups.h>
#include <cstdio>
namespace cg = cooperative_groups;
#define PROBE_ID 0
#define N_LAUNCH_MODE 1
namespace pg8 {
#define PG8_LAS __attribute__((address_space(3)))
typedef unsigned short bf16_t;
typedef short bf16x8 __attribute__((ext_vector_type(8)));
typedef float f32x4 __attribute__((ext_vector_type(4)));
typedef unsigned u32x4 __attribute__((ext_vector_type(4)));
constexpr int BM = 256, BK = 64, HALF = 128, HTB = HALF * BK * 2  , STAGE_BYTES = 8 * HTB, NXCD = 8, WGM = 8;

__host__ __device__ __forceinline__ int lds_byte(int r, int c) { const int st = (r >> 4) * 2 + (c >> 5), rr = r & 15, cc = c & 31, ob = rr * 64 + cc * 2; return st * 1024 + (ob ^ (((ob >> 9) & 1) << 5)); }
__host__ __device__ __forceinline__ void stage_rc(int b, int& R, int& C) { const int st = b / 1024, sb = b % 1024, swz = sb ^ (((sb >> 9) & 1) << 5); R = (st >> 1) * 16 + swz / 64; C = (st & 1) * 32 + (swz % 64) / 2; }
__host__ __device__ __forceinline__ int perm32(int rho) { const int n = rho >> 4, i = rho & 15; return 8 * (i >> 2) + 4 * n + (i & 3); }

struct Unit { int pm, pn; };
struct Gemm { const bf16_t* A; const bf16_t* Bt; int M, N, K; };

struct StaticOrder {
    int nM, nN, nwg, G, c;
    __host__ __device__ void init(int M, int N, int G_, int c_) { nM = M / BM; nN = N / BM; nwg = nM * nN; G = G_; c = c_; }
    __host__ __device__ bool next(int i, Unit& u) const {
        const long L = (long)i * G + c; if (L >= nwg) return false;
        int wgid = (int)L; { const int q = nwg / NXCD, r = nwg % NXCD, xcd = wgid % NXCD, off = wgid / NXCD; wgid = (xcd < r ? xcd * (q + 1) : r * (q + 1) + (xcd - r) * q) + off; }
        const int nig = WGM * nN, gid = wgid / nig, fm = gid * WGM, gsz = (nM - fm) < WGM ? (nM - fm) : WGM;
        u.pm = fm + ((wgid % nig) % gsz); u.pn = (wgid % nig) / gsz; return true;
    }
    __device__ __forceinline__ void a_ready(const Unit&) const {}
    __device__ __forceinline__ void done(const Unit&) const {}
};

typedef float cvt_f32x2 __attribute__((ext_vector_type(2)));
typedef __bf16 cvt_bf16x2 __attribute__((ext_vector_type(2)));
__device__ __forceinline__ unsigned cvt_pk_bf16(float lo, float hi) { const cvt_f32x2 v = {lo, hi}; union { cvt_bf16x2 b; unsigned u; } x; x.b = __builtin_convertvector(v, cvt_bf16x2); return x.u; }
typedef float f32x2 __attribute__((ext_vector_type(2)));
struct EpiF32 {
    static constexpr bool PERM = false, AFTER_DRAIN = false;
    float* C; int ldc; const float* bias;
    __device__ __forceinline__ void operator()(const f32x4 (&acc)[2][2][4][2], const Unit& u, int wr, int wc, int fr, int fq) const {
        const int row0 = u.pm * BM + wr * 64 + fr, col0 = u.pn * BM + wc * 32 + 4 * fq;
        f32x4 bv[2][2];
#pragma unroll
        for (int bj = 0; bj < 2; ++bj)
#pragma unroll
            for (int n = 0; n < 2; ++n) bv[bj][n] = bias ? *(const f32x4*)(bias + col0 + bj * HALF + n * 16) : (f32x4){0.f, 0.f, 0.f, 0.f};
#pragma unroll
        for (int ai = 0; ai < 2; ++ai)
#pragma unroll
            for (int m = 0; m < 4; ++m) { float* rowp = C + (size_t)(row0 + ai * HALF + m * 16) * ldc + col0;
#pragma unroll
                for (int bj = 0; bj < 2; ++bj)
#pragma unroll
                    for (int n = 0; n < 2; ++n) *(f32x4*)(rowp + bj * HALF + n * 16) = acc[ai][bj][m][n] + bv[bj][n]; }
    }
};
template <int ACT  > struct EpiBf16 {
    static constexpr bool PERM = true, AFTER_DRAIN = false;
    bf16_t* O; int ldc; const float* bias; int split_cols; size_t split_stride;
    __device__ __forceinline__ void operator()(const f32x4 (&acc)[2][2][4][2], const Unit& u, int wr, int wc, int fr, int fq) const {
        const int row0 = u.pm * BM + wr * 64 + fr; int colt = u.pn * BM; bf16_t* base = O;
        if (split_cols) { const int t = colt / split_cols; base += (size_t)t * split_stride; colt -= t * split_cols; }
        const int col0 = colt + wc * 32 + 8 * fq, bcol0 = u.pn * BM + wc * 32 + 8 * fq;
        f32x4 bv[2][2];
#pragma unroll
        for (int bj = 0; bj < 2; ++bj)
#pragma unroll
            for (int n = 0; n < 2; ++n) bv[bj][n] = bias ? *(const f32x4*)(bias + bcol0 + bj * HALF + 4 * n) : (f32x4){0.f, 0.f, 0.f, 0.f};
#pragma unroll
        for (int ai = 0; ai < 2; ++ai)
#pragma unroll
            for (int m = 0; m < 4; ++m) { bf16_t* rowp = base + (size_t)(row0 + ai * HALF + m * 16) * ldc + col0;
#pragma unroll
                for (int bj = 0; bj < 2; ++bj) { f32x4 v0 = acc[ai][bj][m][0] + bv[bj][0], v1 = acc[ai][bj][m][1] + bv[bj][1];
                    u32x4 w; w.x = cvt_pk_bf16(v0[0], v0[1]); w.y = cvt_pk_bf16(v0[2], v0[3]); w.z = cvt_pk_bf16(v1[0], v1[1]); w.w = cvt_pk_bf16(v1[2], v1[3]);
                    *(u32x4*)(rowp + bj * HALF) = w; } }
    }
};

template <class Epi, class Sched>
__device__ __forceinline__ void gemm_phase(PG8_LAS unsigned char* lds, const Gemm g, const Sched& S, const Epi& E) {
    const int tid = threadIdx.x, wid = __builtin_amdgcn_readfirstlane(tid >> 6), lane = tid & 63, wr = wid >> 2, wc = wid & 3, fr = lane & 15, fq = lane >> 4;
    const int K = g.K, nt = K / BK;
    unsigned voffA[2], voffB[2];
#pragma unroll
    for (int i = 0; i < 2; ++i) { int R, C; stage_rc(tid * 16 + i * 8192, R, C); const int Rb = Epi::PERM ? ((R & ~31) + perm32(R & 31)) : R;
        voffA[i] = (unsigned)(R * K + C) * 2u; voffB[i] = (unsigned)(Rb * K + C) * 2u; }
    const size_t kstep = (size_t)(BK * 2);
    const size_t hstep = (size_t)HALF * K * 2;
    const size_t tstep = 2 * hstep;
    const unsigned ldsw = (unsigned)wid * 1024u;
    const int aoff = lds_byte(wr * 64 + fr, fq * 8), boff = lds_byte(wc * 32 + fr, fq * 8);
#define PG8_SA(b, h) (((b) * 2 + (h)) * HTB)
#define PG8_SB(b, h) ((4 + (b) * 2 + (h)) * HTB)
#define PG8_STAGE(bufoff, gbase, voff) do { _Pragma("unroll") for (int _i = 0; _i < 2; ++_i) \
        __builtin_amdgcn_global_load_lds((const unsigned*)((const char*)(gbase) + (voff)[_i]), (PG8_LAS unsigned*)(lds + (bufoff) + ldsw + _i * 8192), 16, 0, 0); } while (0)
#define PG8_LDA(dst, b, h) do { _Pragma("unroll") for (int m = 0; m < 4; ++m) _Pragma("unroll") for (int k = 0; k < 2; ++k) dst[m][k] = *(const PG8_LAS bf16x8*)(lds + PG8_SA(b, h) + aoff + m * 2048 + k * 1024); } while (0)
#define PG8_LDB(dst, b, h) do { _Pragma("unroll") for (int n = 0; n < 2; ++n) _Pragma("unroll") for (int k = 0; k < 2; ++k) dst[n][k] = *(const PG8_LAS bf16x8*)(lds + PG8_SB(b, h) + boff + n * 2048 + k * 1024); } while (0)
#define PG8_MMA(ai, bj, At, Bt) do { __builtin_amdgcn_s_setprio(1); _Pragma("unroll") for (int m = 0; m < 4; ++m) _Pragma("unroll") for (int n = 0; n < 2; ++n) _Pragma("unroll") for (int k = 0; k < 2; ++k) \
        acc[ai][bj][m][n] = __builtin_amdgcn_mfma_f32_16x16x32_bf16(Bt[n][k], At[m][k], acc[ai][bj][m][n], 0, 0, 0); __builtin_amdgcn_s_setprio(0); } while (0)
#define PG8_WAIT_V(n) asm volatile("s_waitcnt vmcnt(" #n ")" ::: "memory")
#define PG8_WAIT_L(n) asm volatile("s_waitcnt lgkmcnt(" #n ")" ::: "memory")
#define PG8_BAR __builtin_amdgcn_s_barrier()
#define PG8_SCHED __builtin_amdgcn_sched_barrier(0)
    Unit cur, nxt; int ui = 0;
    if (!S.next(0, cur)) return;
    f32x4 acc[2][2][4][2];
#pragma unroll
    for (int a = 0; a < 2; ++a)
#pragma unroll
        for (int b = 0; b < 2; ++b)
#pragma unroll
            for (int m = 0; m < 4; ++m)
#pragma unroll
                for (int n = 0; n < 2; ++n) acc[a][b][m][n] = (f32x4){0.f, 0.f, 0.f, 0.f};
    bf16x8 At[4][2], B0[2][2], B1[2][2];
    const char* cA = (const char*)g.A + (size_t)cur.pm * tstep; const char* cB = (const char*)g.Bt + (size_t)cur.pn * tstep;
    S.a_ready(cur);
    PG8_STAGE(PG8_SB(0, 0), cB, voffB); PG8_STAGE(PG8_SA(0, 0), cA, voffA); PG8_STAGE(PG8_SB(0, 1), cB + hstep, voffB); PG8_STAGE(PG8_SA(0, 1), cA + hstep, voffA);
    if (wr == 1) PG8_BAR;
    PG8_WAIT_V(4); PG8_BAR;
    PG8_STAGE(PG8_SB(1, 0), cB + kstep, voffB); PG8_STAGE(PG8_SA(1, 0), cA + kstep, voffA); PG8_STAGE(PG8_SB(1, 1), cB + hstep + kstep, voffB);
    PG8_WAIT_V(6); PG8_BAR;
    for (;;) {
        const bool has_next = S.next(ui + 1, nxt);
        const char* nA = has_next ? (const char*)g.A + (size_t)nxt.pm * tstep : cA; const char* nB = has_next ? (const char*)g.Bt + (size_t)nxt.pn * tstep : cB;
        for (int t = 0; t < nt; t += 2) {
            const bool last = (t == nt - 2);
            const char* a1 = cA + (size_t)(t + 1) * kstep;
            const char* a2 = last ? nA : cA + (size_t)(t + 2) * kstep; const char* b2 = last ? nB : cB + (size_t)(t + 2) * kstep;
            const char* a3 = a2 + kstep; const char* b3 = b2 + kstep;
            if (last && has_next) S.a_ready(nxt);
            PG8_LDB(B0, 0, 0); PG8_SCHED; PG8_LDA(At, 0, 0); PG8_STAGE(PG8_SA(1, 1), a1 + hstep, voffA);
            PG8_WAIT_L(8); PG8_BAR; PG8_WAIT_L(0); PG8_MMA(0, 0, At, B0); PG8_BAR; PG8_SCHED;
            PG8_LDB(B1, 0, 1); PG8_STAGE(PG8_SB(0, 0), b2, voffB);
            PG8_BAR; PG8_WAIT_L(0); PG8_MMA(0, 1, At, B1); PG8_BAR;
            PG8_LDA(At, 0, 1); PG8_STAGE(PG8_SA(0, 0), a2, voffA);
            PG8_BAR; PG8_WAIT_L(0); PG8_MMA(1, 0, At, B0); PG8_BAR; PG8_SCHED;
            PG8_STAGE(PG8_SB(0, 1), b2 + hstep, voffB);
            PG8_WAIT_V(6); PG8_BAR; PG8_MMA(1, 1, At, B1); PG8_BAR;
            PG8_LDB(B0, 1, 0); PG8_SCHED; PG8_LDA(At, 1, 0); PG8_STAGE(PG8_SA(0, 1), a2 + hstep, voffA);
            PG8_WAIT_L(8); PG8_BAR; PG8_WAIT_L(0); PG8_MMA(0, 0, At, B0); PG8_BAR; PG8_SCHED;
            PG8_LDB(B1, 1, 1); PG8_STAGE(PG8_SB(1, 0), b3, voffB);
            PG8_BAR; PG8_WAIT_L(0); PG8_MMA(0, 1, At, B1); PG8_BAR;
            PG8_LDA(At, 1, 1); PG8_STAGE(PG8_SA(1, 0), a3, voffA);
            PG8_BAR; PG8_WAIT_L(0); PG8_MMA(1, 0, At, B0); PG8_BAR; PG8_SCHED;
            PG8_STAGE(PG8_SB(1, 1), b3 + hstep, voffB);
            PG8_WAIT_V(6); PG8_BAR; PG8_MMA(1, 1, At, B1); PG8_BAR;
        }
        if constexpr (!Epi::AFTER_DRAIN) { E(acc, cur, wr, wc, fr, fq); S.done(cur); }
        if (!has_next) break;
#pragma unroll
        for (int a = 0; a < 2; ++a)
#pragma unroll
            for (int b = 0; b < 2; ++b)
#pragma unroll
                for (int m = 0; m < 4; ++m)
#pragma unroll
                    for (int n = 0; n < 2; ++n) acc[a][b][m][n] = (f32x4){0.f, 0.f, 0.f, 0.f};
        cur = nxt; cA = nA; cB = nB; ++ui;
    }
    PG8_WAIT_V(0);
    if (wr == 0) PG8_BAR;
    PG8_BAR;
    if constexpr (Epi::AFTER_DRAIN) { E.fused(acc, cur, wr, wc, fr, fq, lds, wid, lane); S.done(cur); }
#undef PG8_SA
#undef PG8_SB
#undef PG8_STAGE
#undef PG8_LDA
#undef PG8_LDB
#undef PG8_MMA
#undef PG8_WAIT_V
#undef PG8_WAIT_L
#undef PG8_BAR
#undef PG8_SCHED
}
}


typedef unsigned short bf16_t;
typedef short bf16x8 __attribute__((ext_vector_type(8)));
typedef float f32x4 __attribute__((ext_vector_type(4)));
typedef unsigned u32x4 __attribute__((ext_vector_type(4)));
typedef unsigned u32x2 __attribute__((ext_vector_type(2)));

constexpr int MTOK = 32768, DM = 1024, SEQ = 16384, NTH = 512;
constexpr int GIN = 3088, GIN_P = 3072, RIN = 4224, RIN_P = 4352;
constexpr int LDS_BYTES = 147456;

constexpr size_t WS_WGIN  = 0;
constexpr size_t WS_WGOUT = WS_WGIN  + (size_t)GIN_P * DM * 2;
constexpr size_t WS_WRIN  = WS_WGOUT + (size_t)DM * DM * 2;
constexpr size_t WS_WROUT = WS_WRIN  + (size_t)RIN_P * DM * 2;
constexpr size_t WS_WDUT  = WS_WROUT + (size_t)DM * DM * 2;
constexpr size_t WS_WIUT  = WS_WDUT  + (size_t)DM * 64 * 2;
constexpr size_t WS_WUPT  = WS_WIUT  + (size_t)DM * 64 * 2;
constexpr size_t WS_A     = WS_WUPT  + (size_t)512 * 16 * 2;
constexpr size_t WS_Y     = WS_A     + (size_t)MTOK * DM * 2;
constexpr size_t WS_GS    = WS_Y     + (size_t)MTOK * DM * 2;
constexpr size_t WS_GD    = WS_GS    + (size_t)24 * 1024 * 1024;
constexpr size_t WS_P     = WS_GD    + (size_t)8 * 32 * 128 * 4;
constexpr size_t WS_BAR   = WS_P     + (size_t)MTOK * RIN_P * 2;
constexpr size_t WS_AD    = WS_BAR   + 16384;
constexpr size_t WS_X1    = WS_AD    + (size_t)MTOK * 16 * 2;
constexpr size_t WS_DUMMY = WS_X1    + (size_t)MTOK * DM * 2;
constexpr size_t WS_END   = WS_DUMMY + 65536;
static_assert(WS_END <= (size_t)512 * 1024 * 1024, "workspace budget (4 x the largest tensor)");
constexpr int PB_BLK = 4096, PB_WDAD = 4 * 16 * PB_BLK, PB_CHUNK = PB_WDAD + 64 * 128;
static_assert((size_t)(MTOK / 64) * PB_CHUNK <= (size_t)MTOK * RIN_P, "blocked projection buffer must fit WS_P");

struct Params { const float* in[22]; float* out; unsigned char* ws; int ph_lo, ph_hi; };

__device__ __forceinline__ float bf2f(unsigned b) { return __uint_as_float(b << 16); }
__device__ __forceinline__ bf16_t f2bf(float f) { unsigned u = __float_as_uint(f); u += 0x7FFFu + ((u >> 16) & 1u); return (bf16_t)(u >> 16); }
__device__ __forceinline__ unsigned pk2(float lo, float hi) { return pg8::cvt_pk_bf16(lo, hi); }
__device__ __forceinline__ float wave_sum(float x) {
#pragma unroll
    for (int off = 32; off >= 1; off >>= 1) x += __shfl_xor(x, off);
    return x;
}
__device__ __forceinline__ float bperm(int byte_addr, float x) { return __int_as_float(__builtin_amdgcn_ds_bpermute(byte_addr, __float_as_int(x))); }
template <int CTRL> __device__ __forceinline__ float dpp_mov(float x) { return __int_as_float(__builtin_amdgcn_update_dpp(0, __float_as_int(x), CTRL, 0xF, 0xF, true)); }
__device__ __forceinline__ float sum8(float x) { x += dpp_mov<0xB1>(x); x += dpp_mov<0x4E>(x); x += dpp_mov<0x141>(x); return x; }
__device__ __forceinline__ f32x4 mfma16(bf16x8 a, bf16x8 b, f32x4 c) { return __builtin_amdgcn_mfma_f32_16x16x32_bf16(a, b, c, 0, 0, 0); }
__device__ __forceinline__ bf16x8 as_bf16x8(u32x4 v) { union { u32x4 u; bf16x8 b; } x; x.u = v; return x.b; }
__device__ __forceinline__ float fexp(float x) { return __builtin_amdgcn_exp2f(x * 1.4426950408889634f); }
__device__ __forceinline__ float flog(float x) { return __builtin_amdgcn_logf(x) * 0.6931471805599453f; }
__device__ __forceinline__ float log_sigmoid(float z) { return fminf(z, 0.f) - log1pf(fexp(-fabsf(z))); }
__device__ __forceinline__ float softplus(float z) { return fmaxf(z, 0.f) + log1pf(fexp(-fabsf(z))); }

__device__ void prep_weight(const float* __restrict__ W, int N, const float* __restrict__ gain, bf16_t* __restrict__ Wt, int NP, float* tile) {
    const int tid = threadIdx.x;
    const int nu = (NP / 64) * 16;
    const int lk = tid >> 4, lq = tid & 15;
    const int sn = tid >> 3, ss = tid & 7;
    float4 v[2];
#define PW_LOAD(u_) do { const int n0_ = ((u_) >> 4) * 64, k0_ = ((u_) & 15) * 64; _Pragma("unroll") for (int r = 0; r < 2; ++r) { const int k = k0_ + lk + 32 * r, n = n0_ + 4 * lq; \
        float4 x_ = make_float4(0.f, 0.f, 0.f, 0.f); if (n < N) { x_ = *(const float4*)(W + (size_t)k * N + n); if (gain) { const float g_ = gain[k]; x_.x *= g_; x_.y *= g_; x_.z *= g_; x_.w *= g_; } } v[r] = x_; } } while (0)
    int u = blockIdx.x;
    if (u < nu) PW_LOAD(u);
    for (; u < nu; u += gridDim.x) {
        const int n0 = (u >> 4) * 64, k0 = (u & 15) * 64;
#pragma unroll
        for (int r = 0; r < 2; ++r) *(float4*)(tile + (lk + 32 * r) * 68 + 4 * lq) = v[r];
        if (u + (int)gridDim.x < nu) PW_LOAD(u + gridDim.x);
        __syncthreads();
        {
            float e[8];
#pragma unroll
            for (int q = 0; q < 8; ++q) e[q] = tile[(8 * ss + q) * 68 + sn];
            *(u32x4*)(Wt + (size_t)(n0 + sn) * DM + k0 + 8 * ss) = (u32x4){pk2(e[0], e[1]), pk2(e[2], e[3]), pk2(e[4], e[5]), pk2(e[6], e[7])};
        }
        __syncthreads();
    }
#undef PW_LOAD
}

__device__ void prep_lowrank(const float* __restrict__ src, bf16_t* __restrict__ dst) {
    for (int idx = blockIdx.x * NTH + threadIdx.x; idx < 65536; idx += gridDim.x * NTH) dst[idx] = f2bf(src[(idx & 63) * 1024 + (idx >> 6)]);
}

__device__ void zero_bnd_row(bf16_t* bnd) {
    if (blockIdx.x == 0) for (int i = threadIdx.x; i < RIN_P / 2; i += NTH) ((unsigned*)bnd)[i] = 0u;
}

__device__ void prep_wup(const float* __restrict__ src, bf16_t* __restrict__ dst) {
    for (int idx = blockIdx.x * NTH + threadIdx.x; idx < 8192; idx += gridDim.x * NTH) dst[idx] = f2bf(src[(idx & 15) * 512 + (idx >> 4)]);
}

struct EpiBf16GateSilu {
    static constexpr bool PERM = true, AFTER_DRAIN = false;
    bf16_t* O; int ldc;
    __device__ __forceinline__ void operator()(const f32x4 (&acc)[2][2][4][2], const pg8::Unit& u, int wr, int wc, int fr, int fq) const {
        const int row0 = u.pm * pg8::BM + wr * 64 + fr, col0 = u.pn * pg8::BM + wc * 32 + 8 * fq;
        const bool act = u.pn >= 8;
#pragma unroll
        for (int ai = 0; ai < 2; ++ai)
#pragma unroll
            for (int m = 0; m < 4; ++m) {
                bf16_t* rowp = O + (size_t)(row0 + ai * pg8::HALF + m * 16) * ldc + col0;
#pragma unroll
                for (int bj = 0; bj < 2; ++bj) {
                    f32x4 v0 = acc[ai][bj][m][0], v1 = acc[ai][bj][m][1];
                    if (act) {
#pragma unroll
                        for (int j = 0; j < 4; ++j) { v0[j] *= __builtin_amdgcn_rcpf(1.0f + fexp(-v0[j])); v1[j] *= __builtin_amdgcn_rcpf(1.0f + fexp(-v1[j])); }
                    }
                    u32x4 wv; wv.x = pk2(v0[0], v0[1]); wv.y = pk2(v0[2], v0[3]); wv.z = pk2(v1[0], v1[1]); wv.w = pk2(v1[2], v1[3]);
                    *(u32x4*)(rowp + bj * pg8::HALF) = wv;
                }
            }
    }
};

struct EpiBf16Bnd {
    static constexpr bool PERM = true, AFTER_DRAIN = false;
    bf16_t* O; int ldc; bf16_t* bnd;
    __device__ __forceinline__ void operator()(const f32x4 (&acc)[2][2][4][2], const pg8::Unit& u, int wr, int wc, int fr, int fq) const {
        const int row0 = u.pm * pg8::BM + wr * 64 + fr, col0 = u.pn * pg8::BM + wc * 32 + 8 * fq;
#pragma unroll
        for (int ai = 0; ai < 2; ++ai)
#pragma unroll
            for (int m = 0; m < 4; ++m) {
                const int row = row0 + ai * pg8::HALF + m * 16;
                bf16_t* cb = O + (size_t)(row >> 6) * PB_CHUNK;
#pragma unroll
                for (int bj = 0; bj < 2; ++bj) {
                    const f32x4 v0 = acc[ai][bj][m][0], v1 = acc[ai][bj][m][1];
                    u32x4 wv; wv.x = pk2(v0[0], v0[1]); wv.y = pk2(v0[2], v0[3]); wv.z = pk2(v1[0], v1[1]); wv.w = pk2(v1[2], v1[3]);
                    if (u.pn < 16) *(u32x4*)(cb + (u.pn * 4 + bj * 2 + (wc >> 1)) * PB_BLK + (row & 63) * 64 + (wc & 1) * 32 + 8 * fq) = wv;
                    else if (bj == 0) *(u32x4*)(cb + PB_WDAD + (row & 63) * 128 + wc * 32 + 8 * fq) = wv;
                    if (m == 3 && fr == 15) *(u32x4*)(bnd + (size_t)((row >> 6) + 1) * ldc + col0 + bj * pg8::HALF) = wv;
                }
            }
    }
};

__device__ void phase_norm0(const Params& p, unsigned char* lds) {
    const int tid = threadIdx.x, lane = tid & 63, w = tid >> 6, l15 = lane & 15, g = lane >> 4;
    const float* x = p.in[0];
    bf16_t* A = (bf16_t*)(p.ws + WS_A);
    bf16_t* AD = (bf16_t*)(p.ws + WS_AD);
    bf16_t* WAD = (bf16_t*)lds;
    float* PSS = (float*)(lds + 33024);
    float* PAD = (float*)(lds + 33024 + 512);
    for (int e = tid; e < 16384; e += NTH) { const int k = e >> 4, j = e & 15; WAD[j * 1032 + k] = f2bf(p.in[2][(size_t)k * GIN + 3072 + j] * p.in[1][k]); }
    __syncthreads();
    bf16x8 wf[4];
#pragma unroll
    for (int kk = 0; kk < 4; ++kk) wf[kk] = *(const bf16x8*)(WAD + l15 * 1032 + 128 * w + 32 * kk + 8 * g);
    float4 xa[4][2];
    int tile = blockIdx.x;
    if (tile < MTOK / 16) {
#pragma unroll
        for (int kk = 0; kk < 4; ++kk) { const float4* s = (const float4*)(x + (size_t)(16 * tile + l15) * DM + 128 * w + 32 * kk + 8 * g); xa[kk][0] = s[0]; xa[kk][1] = s[1]; }
    }
    for (; tile < MTOK / 16; tile += gridDim.x) {
        float4 xv[4][2];
#pragma unroll
        for (int kk = 0; kk < 4; ++kk) { xv[kk][0] = xa[kk][0]; xv[kk][1] = xa[kk][1]; }
        if (tile + (int)gridDim.x < MTOK / 16) {
#pragma unroll
            for (int kk = 0; kk < 4; ++kk) { const float4* s = (const float4*)(x + (size_t)(16 * (tile + gridDim.x) + l15) * DM + 128 * w + 32 * kk + 8 * g); xa[kk][0] = s[0]; xa[kk][1] = s[1]; }
        }
        float ss = 0.f;
        f32x4 acc = (f32x4){0.f, 0.f, 0.f, 0.f};
#pragma unroll
        for (int kk = 0; kk < 4; ++kk) {
            const float4 a = xv[kk][0], b = xv[kk][1];
            ss += a.x * a.x + a.y * a.y + a.z * a.z + a.w * a.w + b.x * b.x + b.y * b.y + b.z * b.z + b.w * b.w;
            acc = mfma16(as_bf16x8((u32x4){pk2(a.x, a.y), pk2(a.z, a.w), pk2(b.x, b.y), pk2(b.z, b.w)}), wf[kk], acc);
        }
        ss += __shfl_xor(ss, 16); ss += __shfl_xor(ss, 32);
        if (g == 0) PSS[w * 16 + l15] = ss;
        *(f32x4*)(PAD + (w * 64 + lane) * 4) = acc;
        __syncthreads();
        float tot = 0.f;
#pragma unroll
        for (int q = 0; q < 8; ++q) tot += PSS[q * 16 + l15];
        const float rstd = rsqrtf(tot * (1.0f / DM) + 1e-6f);
#pragma unroll
        for (int kk = 0; kk < 4; ++kk) {
            const float4 a = xv[kk][0], b = xv[kk][1];
            *(u32x4*)(A + (size_t)(16 * tile + l15) * DM + 128 * w + 32 * kk + 8 * g) = (u32x4){pk2(a.x * rstd, a.y * rstd), pk2(a.z * rstd, a.w * rstd), pk2(b.x * rstd, b.y * rstd), pk2(b.z * rstd, b.w * rstd)};
        }
        if (w == 0) {
            f32x4 s = (f32x4){0.f, 0.f, 0.f, 0.f};
#pragma unroll
            for (int q = 0; q < 8; ++q) s += *(const f32x4*)(PAD + (q * 64 + lane) * 4);
#pragma unroll
            for (int r = 0; r < 4; ++r) AD[(size_t)(16 * tile + 4 * g + r) * 16 + l15] = f2bf(s[r] * __shfl(rstd, 4 * g + r));
        }
        __syncthreads();
    }
}

__device__ void phase_norm1(const Params& p) {
    const int tid = threadIdx.x, lane = tid & 63, w = tid >> 6;
    const float* x = p.in[0];
    const float* gpost = p.in[7];
    const bf16_t* Y = (const bf16_t*)(p.ws + WS_Y);
    bf16_t* A = (bf16_t*)(p.ws + WS_A);
    bf16_t* X1 = (bf16_t*)(p.ws + WS_X1);
    float4 gp[4];
#pragma unroll
    for (int i = 0; i < 4; ++i) gp[i] = ((const float4*)gpost)[lane + 64 * i];
    const int stride = gridDim.x * 8;
    float4 vn[4]; u32x2 yn[4];
    {
        const int row = blockIdx.x * 8 + w;
#pragma unroll
        for (int i = 0; i < 4; ++i) { vn[i] = ((const float4*)(x + (size_t)row * DM))[lane + 64 * i]; yn[i] = *(const u32x2*)(Y + (size_t)row * DM + 4 * (lane + 64 * i)); }
    }
    for (int row = blockIdx.x * 8 + w; row < MTOK; row += stride) {
        float4 v[4]; u32x2 yv[4];
#pragma unroll
        for (int i = 0; i < 4; ++i) { v[i] = vn[i]; yv[i] = yn[i]; }
        if (row + stride < MTOK) {
#pragma unroll
            for (int i = 0; i < 4; ++i) { vn[i] = ((const float4*)(x + (size_t)(row + stride) * DM))[lane + 64 * i]; yn[i] = *(const u32x2*)(Y + (size_t)(row + stride) * DM + 4 * (lane + 64 * i)); }
        }
        float4 y[4];
        float ss = 0.f;
#pragma unroll
        for (int i = 0; i < 4; ++i) {
            y[i].x = bf2f(yv[i].x & 0xffffu); y[i].y = bf2f(yv[i].x >> 16); y[i].z = bf2f(yv[i].y & 0xffffu); y[i].w = bf2f(yv[i].y >> 16);
            ss += y[i].x * y[i].x + y[i].y * y[i].y + y[i].z * y[i].z + y[i].w * y[i].w;
        }
        ss = wave_sum(ss);
        const float rstdy = rsqrtf(ss * (1.0f / DM) + 1e-6f);
        float s1 = 0.f;
#pragma unroll
        for (int i = 0; i < 4; ++i) {
            v[i].x += y[i].x * rstdy * gp[i].x; v[i].y += y[i].y * rstdy * gp[i].y; v[i].z += y[i].z * rstdy * gp[i].z; v[i].w += y[i].w * rstdy * gp[i].w;
            s1 += v[i].x * v[i].x + v[i].y * v[i].y + v[i].z * v[i].z + v[i].w * v[i].w;
            u32x2 xo; xo.x = pk2(v[i].x, v[i].y); xo.y = pk2(v[i].z, v[i].w);
            *(u32x2*)(X1 + (size_t)row * DM + 4 * (lane + 64 * i)) = xo;
        }
        s1 = wave_sum(s1);
        const float rstd = rsqrtf(s1 * (1.0f / DM) + 1e-6f);
#pragma unroll
        for (int i = 0; i < 4; ++i) {
            u32x2 o; o.x = pk2(v[i].x * rstd, v[i].y * rstd); o.y = pk2(v[i].z * rstd, v[i].w * rstd);
            *(u32x2*)(A + (size_t)row * DM + 4 * (lane + 64 * i)) = o;
        }
    }
}

__device__ void phase_final(const Params& p) {
    const int tid = threadIdx.x, lane = tid & 63, w = tid >> 6;
    const float* gpost = p.in[21];
    const bf16_t* Y = (const bf16_t*)(p.ws + WS_Y);
    const bf16_t* X1 = (const bf16_t*)(p.ws + WS_X1);
    float4 gp[4];
#pragma unroll
    for (int i = 0; i < 4; ++i) gp[i] = ((const float4*)gpost)[lane + 64 * i];
    const int stride = gridDim.x * 8;
    u32x2 xn[4], yn[4];
    {
        const int row = blockIdx.x * 8 + w;
#pragma unroll
        for (int i = 0; i < 4; ++i) { xn[i] = *(const u32x2*)(X1 + (size_t)row * DM + 4 * (lane + 64 * i)); yn[i] = *(const u32x2*)(Y + (size_t)row * DM + 4 * (lane + 64 * i)); }
    }
    for (int row = blockIdx.x * 8 + w; row < MTOK; row += stride) {
        u32x2 xv[4], yv[4];
#pragma unroll
        for (int i = 0; i < 4; ++i) { xv[i] = xn[i]; yv[i] = yn[i]; }
        if (row + stride < MTOK) {
#pragma unroll
            for (int i = 0; i < 4; ++i) { xn[i] = *(const u32x2*)(X1 + (size_t)(row + stride) * DM + 4 * (lane + 64 * i)); yn[i] = *(const u32x2*)(Y + (size_t)(row + stride) * DM + 4 * (lane + 64 * i)); }
        }
        float4 y[4];
        float ss = 0.f;
#pragma unroll
        for (int i = 0; i < 4; ++i) {
            y[i].x = bf2f(yv[i].x & 0xffffu); y[i].y = bf2f(yv[i].x >> 16); y[i].z = bf2f(yv[i].y & 0xffffu); y[i].w = bf2f(yv[i].y >> 16);
            ss += y[i].x * y[i].x + y[i].y * y[i].y + y[i].z * y[i].z + y[i].w * y[i].w;
        }
        ss = wave_sum(ss);
        const float rstdy = rsqrtf(ss * (1.0f / DM) + 1e-6f);
#pragma unroll
        for (int i = 0; i < 4; ++i) {
            float4 v;
            v.x = bf2f(xv[i].x & 0xffffu) + y[i].x * rstdy * gp[i].x; v.y = bf2f(xv[i].x >> 16) + y[i].y * rstdy * gp[i].y;
            v.z = bf2f(xv[i].y & 0xffffu) + y[i].z * rstdy * gp[i].z; v.w = bf2f(xv[i].y >> 16) + y[i].w * rstdy * gp[i].w;
            ((float4*)(p.out + (size_t)row * DM))[lane + 64 * i] = v;
        }
    }
}

constexpr int L_BC = 0, L_ATT = 0, L_QD = 33792, L_KD = L_QD + 64 * 136 * 2, L_KTE = L_KD + 64 * 136 * 2, L_VI = L_KTE + 64 * 152 * 2, L_SSQ = L_VI + 64 * 280 * 2, L_BL = L_SSQ + 2048, L_DEC = L_BL + 512, L_ADL = L_DEC + 512,
              L_GLA_END = L_ADL + 2048;
static_assert(L_GLA_END <= LDS_BYTES, "GLA LDS");
#define GLA_BARRIER() do { asm volatile("s_waitcnt lgkmcnt(0)" ::: "memory"); __builtin_amdgcn_s_barrier(); asm volatile("" ::: "memory"); } while (0)
typedef short gs16x4 __attribute__((ext_vector_type(4)));
__device__ __forceinline__ u32x2 g_trread(const bf16_t* p) { union { gs16x4 s; u32x2 u; } x; x.s = __builtin_amdgcn_ds_read_tr16_b64_v4i16((__attribute__((address_space(3))) gs16x4*)p); return x.u; }
template <int PITCH> __device__ __forceinline__ bf16x8 g_trfrag(const bf16_t* img, int k0, int c0, int g, int q, int pq) {
    const bf16_t* a = img + (k0 + 8 * g + q) * PITCH + c0 + 4 * pq;
    const u32x2 lo = g_trread(a), hi = g_trread(a + 4 * PITCH);
    return as_bf16x8((u32x4){lo.x, lo.y, hi.x, hi.y});
}
__device__ __forceinline__ f32x4 g_lo4(u32x4 v) { return (f32x4){bf2f(v.x & 0xffffu), bf2f(v.x >> 16), bf2f(v.y & 0xffffu), bf2f(v.y >> 16)}; }
__device__ __forceinline__ f32x4 g_hi4(u32x4 v) { return (f32x4){bf2f(v.z & 0xffffu), bf2f(v.z >> 16), bf2f(v.w & 0xffffu), bf2f(v.w >> 16)}; }
__device__ __forceinline__ u32x2 g_pk4(f32x4 v) { u32x2 r; r.x = pk2(v[0], v[1]); r.y = pk2(v[2], v[3]); return r; }
__device__ __forceinline__ f32x4 g_unpk4(u32x2 v) { return (f32x4){bf2f(v.x & 0xffffu), bf2f(v.x >> 16), bf2f(v.y & 0xffffu), bf2f(v.y >> 16)}; }

template <bool OUT> struct GlaRaw { u32x4 q[2], k[2], v[4]; };
template <bool OUT> __device__ __forceinline__ void gla_issue(GlaRaw<OUT>& x, const char* cb  , unsigned offQ, unsigned offV) {
    if (OUT) { x.q[0] = *(const u32x4*)(cb + offQ); x.q[1] = *(const u32x4*)(cb + offQ + 16); }
    x.k[0] = *(const u32x4*)(cb + offQ + 1024); x.k[1] = *(const u32x4*)(cb + offQ + 1040);
#pragma unroll
    for (int i = 0; i < 4; ++i) x.v[i] = *(const u32x4*)(cb + offV + 16 * i);
}

template <bool OUT>
__device__ void gla_pass(const Params& p, unsigned char* lds) {
    const int tid = threadIdx.x, w = __builtin_amdgcn_readfirstlane(tid >> 6);
    const bf16_t* P = (const bf16_t*)(p.ws + WS_P);
    bf16_t* GS = (bf16_t*)(p.ws + WS_GS);
    float* GD = (float*)(p.ws + WS_GD);
    bf16_t* Aout = (bf16_t*)(p.ws + WS_A);
    const bf16_t* WupT = (const bf16_t*)(p.ws + WS_WUPT);
    const bf16_t* ADG = (const bf16_t*)(p.ws + WS_AD);
    float* BC = (float*)(lds + L_BC); bf16_t* ATT = (bf16_t*)(lds + L_ATT); bf16_t* QD = (bf16_t*)(lds + L_QD); bf16_t* KD = (bf16_t*)(lds + L_KD); bf16_t* KTE = (bf16_t*)(lds + L_KTE);
    bf16_t* VI = (bf16_t*)(lds + L_VI); float* SSQ = (float*)(lds + L_SSQ); float* BL = (float*)(lds + L_BL); float* DEC = (float*)(lds + L_DEC); bf16_t* ADL = (bf16_t*)(lds + L_ADL);
    const float* b_al = p.in[4]; const float* g_head = p.in[5];

    for (int unit = blockIdx.x; unit < 256; unit += gridDim.x) {
        const int bh = unit >> 5, m = unit & 31, b = bh >> 2, h = bh & 3;
        int tidv = tid; asm volatile("" : "+v"(tidv));
        const int lane = tidv & 63, l15 = lane & 15, g = lane >> 4, q4 = l15 >> 2, p4 = l15 & 3;
        const int c = tidv >> 3, seg = tidv & 7;
        const int tokbase = b * SEQ + m * 512;
        u32x4 wupq = *(const u32x4*)(WupT + (size_t)(h * 128 + 16 * w + l15) * 16 + 8 * (g & 1));
        if (g >= 2) wupq = (u32x4){0u, 0u, 0u, 0u};
        const bf16x8 wupf = as_bf16x8(wupq);
        const float bA = b_al[h * 128 + 16 * w + l15];
        f32x4 gh[2];
#pragma unroll
        for (int vt = 0; vt < 2; ++vt) gh[vt] = *(const f32x4*)(g_head + 32 * w + 16 * vt + 4 * g);
        float logD = 0.f;
        f32x4 S[8][2];
#pragma unroll
        for (int mt = 0; mt < 8; ++mt)
#pragma unroll
            for (int vt = 0; vt < 2; ++vt) {
                if (OUT) S[mt][vt] = g_unpk4(*(const u32x2*)(GS + ((size_t)(bh * 32 + m) * 256 + 32 * w + 16 * vt + l15) * 128 + 16 * mt + 4 * g));
                else S[mt][vt] = (f32x4){0.f, 0.f, 0.f, 0.f};
            }
        const unsigned offQ = (unsigned)((c * GIN_P + h * 128 + 16 * seg) * 2), offV = (unsigned)((c * GIN_P + 1024 + h * 256 + 32 * seg) * 2), offAD = (unsigned)(tid * 16);
        const unsigned offG = (unsigned)((l15 * GIN_P + 2048 + h * 256 + 32 * w + 4 * g) * 2), offO = (unsigned)((l15 * DM + h * 256 + 32 * w + 4 * g) * 2);
        GlaRaw<OUT> raw;
        gla_issue<OUT>(raw, (const char*)P + (size_t)tokbase * GIN_P * 2, offQ, offV);
        if (tid < 128) *(u32x4*)(ADL + tid * 8) = *(const u32x4*)((const char*)ADG + (size_t)tokbase * 32 + offAD);
        GLA_BARRIER();

        for (int ch = 0; ch < 8; ++ch) {
            const int tok0 = tokbase + ch * 64;
            u32x4 adn = (u32x4){0u, 0u, 0u, 0u};
            {
                if (ch < 7 && tid < 128) adn = *(const u32x4*)((const char*)ADG + (size_t)(tok0 + 64) * 32 + offAD);
                f32x4 sc[4]; float xinc[4], tot[4];
#pragma unroll
                for (int ct = 0; ct < 4; ++ct) {
                    u32x4 aq = *(const u32x4*)(ADL + (16 * ct + l15) * 16 + 8 * (g & 1));
                    if (g >= 2) aq = (u32x4){0u, 0u, 0u, 0u};
                    const f32x4 z = mfma16(as_bf16x8(aq), wupf, (f32x4){bA, bA, bA, bA});
                    float acc = 0.f;
#pragma unroll
                    for (int r = 0; r < 4; ++r) { acc += (fminf(z[r], 0.f) - flog(1.f + fexp(-fabsf(z[r])))) * (1.0f / 16.0f); sc[ct][r] = acc; }
                    xinc[ct] = acc;
                }
#pragma unroll
                for (int ct = 0; ct < 4; ++ct) xinc[ct] += (g >= 1 ? 1.f : 0.f) * bperm(((lane - 16) & 63) * 4, xinc[ct]);
#pragma unroll
                for (int ct = 0; ct < 4; ++ct) xinc[ct] += (g >= 2 ? 1.f : 0.f) * bperm(((lane - 32) & 63) * 4, xinc[ct]);
#pragma unroll
                for (int ct = 0; ct < 4; ++ct) tot[ct] = bperm((48 + l15) * 4, xinc[ct]);
                float run = 0.f;
#pragma unroll
                for (int ct = 0; ct < 4; ++ct) {
                    const float base = run + (xinc[ct] - sc[ct][3]);
                    run += tot[ct];
#pragma unroll
                    for (int r = 0; r < 4; ++r) BC[(16 * ct + 4 * g + r) * 132 + 16 * w + l15] = base + sc[ct][r];
                }
                if (g == 0) { BL[16 * w + l15] = run; DEC[16 * w + l15] = fexp(run); }
                if (!OUT) logD += run;
            }
            GLA_BARRIER();
            u32x2 gate[2][4];
            {
#pragma unroll
                for (int hh = 0; hh < 2; ++hh) {
                    const int o8 = 16 * seg + 8 * hh;
                    const f32x4 bb[2] = {*(const f32x4*)(BC + c * 132 + o8), *(const f32x4*)(BC + c * 132 + o8 + 4)};
                    const f32x4 dc[2] = {*(const f32x4*)((OUT ? DEC : BL) + o8), *(const f32x4*)((OUT ? DEC : BL) + o8 + 4)};
                    const f32x4 kx[2] = {g_lo4(raw.k[hh]), g_hi4(raw.k[hh])};
                    f32x4 qx[2];
                    if (OUT) { qx[0] = g_lo4(raw.q[hh]); qx[1] = g_hi4(raw.q[hh]); }
                    f32x4 kd[2], kt[2], qd[2];
#pragma unroll
                    for (int i = 0; i < 2; ++i)
#pragma unroll
                        for (int j = 0; j < 4; ++j) {
                            if (OUT) {
                                const float eB = fexp(bb[i][j]), enB = __builtin_amdgcn_rcpf(eB);
                                kd[i][j] = kx[i][j] * enB; kt[i][j] = kd[i][j] * dc[i][j];
                                qd[i][j] = qx[i][j] * 0.08838834764831845f * eB;
                            } else kt[i][j] = kx[i][j] * fexp(dc[i][j] - bb[i][j]);
                        }
                    *(u32x4*)(KTE + c * 152 + o8) = (u32x4){pk2(kt[0][0], kt[0][1]), pk2(kt[0][2], kt[0][3]), pk2(kt[1][0], kt[1][1]), pk2(kt[1][2], kt[1][3])};
                    if (OUT) {
                        *(u32x4*)(KD + c * 136 + o8) = (u32x4){pk2(kd[0][0], kd[0][1]), pk2(kd[0][2], kd[0][3]), pk2(kd[1][0], kd[1][1]), pk2(kd[1][2], kd[1][3])};
                        *(u32x4*)(QD + c * 136 + o8) = (u32x4){pk2(qd[0][0], qd[0][1]), pk2(qd[0][2], qd[0][3]), pk2(qd[1][0], qd[1][1]), pk2(qd[1][2], qd[1][3])};
                    }
                }
#pragma unroll
                for (int i = 0; i < 4; ++i) *(u32x4*)(VI + c * 280 + 32 * seg + 8 * i) = raw.v[i];
                if (OUT) {
#pragma unroll
                    for (int vt = 0; vt < 2; ++vt)
#pragma unroll
                        for (int ct = 0; ct < 4; ++ct) gate[vt][ct] = *(const u32x2*)((const char*)P + (size_t)(tok0 + 16 * ct) * GIN_P * 2 + offG + 32 * vt);
                }
                if (ch < 7) gla_issue<OUT>(raw, (const char*)P + (size_t)(tok0 + 64) * GIN_P * 2, offQ, offV);
                if (ch < 7 && tid < 128) *(u32x4*)(ADL + tid * 8) = adn;
            }
            GLA_BARRIER();
            f32x4 o[2][4];
            if (OUT) {
#pragma unroll
                for (int t2 = 0; t2 < 2; ++t2) {
                    const int tl = 2 * w + t2, ct = tl >> 2, st = tl & 3;
                    f32x4 acc = (f32x4){0.f, 0.f, 0.f, 0.f};
                    if (st <= ct) {
#pragma unroll
                        for (int kk = 0; kk < 4; ++kk) {
                            const bf16x8 a = *(const bf16x8*)(KD + (16 * st + l15) * 136 + 32 * kk + 8 * g);
                            const bf16x8 bq = *(const bf16x8*)(QD + (16 * ct + l15) * 136 + 32 * kk + 8 * g);
                            acc = mfma16(a, bq, acc);
                        }
#pragma unroll
                        for (int r = 0; r < 4; ++r) if (16 * st + 4 * g + r > 16 * ct + l15) acc[r] = 0.f;
                    }
                    *(u32x2*)(ATT + (16 * ct + l15) * 72 + 16 * st + 4 * g) = g_pk4(acc);
                }
                GLA_BARRIER();
#pragma unroll
                for (int vt = 0; vt < 2; ++vt)
#pragma unroll
                    for (int ct = 0; ct < 4; ++ct) o[vt][ct] = (f32x4){0.f, 0.f, 0.f, 0.f};
#pragma unroll
                for (int kk = 0; kk < 4; ++kk) {
                    bf16x8 sa[2];
#pragma unroll
                    for (int vt = 0; vt < 2; ++vt) { const u32x2 s0 = g_pk4(S[2 * kk][vt]), s1 = g_pk4(S[2 * kk + 1][vt]); sa[vt] = as_bf16x8((u32x4){s0.x, s0.y, s1.x, s1.y}); }
#pragma unroll
                    for (int ct = 0; ct < 4; ++ct) {
                        const bf16_t* qr = QD + (16 * ct + l15) * 136 + 32 * kk + 4 * g;
                        const u32x2 lo = *(const u32x2*)qr, hi = *(const u32x2*)(qr + 16);
                        const bf16x8 bq = as_bf16x8((u32x4){lo.x, lo.y, hi.x, hi.y});
#pragma unroll
                        for (int vt = 0; vt < 2; ++vt) o[vt][ct] = mfma16(sa[vt], bq, o[vt][ct]);
                    }
                }
            }
            bf16x8 bv[2][2];
#pragma unroll
            for (int vt = 0; vt < 2; ++vt)
#pragma unroll
                for (int kk = 0; kk < 2; ++kk) bv[vt][kk] = g_trfrag<280>(VI, 32 * kk, 32 * w + 16 * vt, g, q4, p4);
            if (OUT) {
#pragma unroll
                for (int ct = 0; ct < 4; ++ct)
#pragma unroll
                    for (int kk = 0; kk < 2; ++kk) {
                        if (32 * kk <= 16 * ct + 15) {
                            const bf16x8 bq = *(const bf16x8*)(ATT + (16 * ct + l15) * 72 + 32 * kk + 8 * g);
#pragma unroll
                            for (int vt = 0; vt < 2; ++vt) o[vt][ct] = mfma16(bv[vt][kk], bq, o[vt][ct]);
                        }
                    }
            }
#pragma unroll
            for (int mt = 0; mt < 8; ++mt) {
                const f32x4 dv = *(const f32x4*)(DEC + 16 * mt + 4 * g);
#pragma unroll
                for (int vt = 0; vt < 2; ++vt) S[mt][vt] *= dv;
#pragma unroll
                for (int kk = 0; kk < 2; ++kk) {
                    const bf16x8 a = g_trfrag<152>(KTE, 32 * kk, 16 * mt, g, q4, p4);
#pragma unroll
                    for (int vt = 0; vt < 2; ++vt) S[mt][vt] = mfma16(a, bv[vt][kk], S[mt][vt]);
                }
            }
            if (OUT) {
                float ss[4];
#pragma unroll
                for (int ct = 0; ct < 4; ++ct) {
                    float s = 0.f;
#pragma unroll
                    for (int vt = 0; vt < 2; ++vt)
#pragma unroll
                        for (int r = 0; r < 4; ++r) s += o[vt][ct][r] * o[vt][ct][r];
                    s += bperm((lane ^ 16) * 4, s); s += bperm((lane ^ 32) * 4, s);
                    ss[ct] = s;
                }
                if (g == 0) {
#pragma unroll
                    for (int ct = 0; ct < 4; ++ct) SSQ[(16 * ct + l15) * 8 + w] = ss[ct];
                }
                GLA_BARRIER();
#pragma unroll
                for (int ct = 0; ct < 4; ++ct) {
                    const int cc = 16 * ct + l15;
                    const float4 s0 = *(const float4*)(SSQ + cc * 8), s1 = *(const float4*)(SSQ + cc * 8 + 4);
                    const float tot = (s0.x + s0.y) + (s0.z + s0.w) + (s1.x + s1.y) + (s1.z + s1.w);
                    const float rstd = rsqrtf(tot * (1.0f / 256.0f) + 1e-6f);
#pragma unroll
                    for (int vt = 0; vt < 2; ++vt) {
                        const f32x4 gt = g_unpk4(gate[vt][ct]);
                        f32x4 val;
#pragma unroll
                        for (int r = 0; r < 4; ++r) val[r] = o[vt][ct][r] * rstd * gh[vt][r] * gt[r];
                        *(u32x2*)((char*)Aout + (size_t)(tok0 + 16 * ct) * DM * 2 + offO + 32 * vt) = g_pk4(val);
                    }
                }
            } else {
                GLA_BARRIER();
            }
        }
        if (!OUT) {
#pragma unroll
            for (int mt = 0; mt < 8; ++mt)
#pragma unroll
                for (int vt = 0; vt < 2; ++vt) *(u32x2*)(GS + ((size_t)(bh * 32 + m) * 256 + 32 * w + 16 * vt + l15) * 128 + 16 * mt + 4 * g) = g_pk4(S[mt][vt]);
            if (g == 0) GD[(bh * 32 + m) * 128 + 16 * w + l15] = fexp(logD);
        }
        GLA_BARRIER();
    }
}

__device__ void gla_scan(const Params& p) {
    bf16_t* GS = (bf16_t*)(p.ws + WS_GS);
    const float* GD = (const float*)(p.ws + WS_GD);
    for (int idx = blockIdx.x * NTH + threadIdx.x; idx < 8 * 8192; idx += gridDim.x * NTH) {
        const int bh = idx >> 13, e = (idx & 8191) * 4, d = e & 127;
        f32x4 S = (f32x4){0.f, 0.f, 0.f, 0.f};
        for (int m0 = 0; m0 < 32; m0 += 8) {
            u32x2 t[8]; f32x4 dd[8];
#pragma unroll
            for (int m = 0; m < 8; ++m) { t[m] = *(const u32x2*)(GS + (size_t)(bh * 32 + m0 + m) * 32768 + e); dd[m] = *(const f32x4*)(GD + (bh * 32 + m0 + m) * 128 + d); }
#pragma unroll
            for (int m = 0; m < 8; ++m) { *(u32x2*)(GS + (size_t)(bh * 32 + m0 + m) * 32768 + e) = g_pk4(S); S = S * dd[m] + g_unpk4(t[m]); }
        }
    }
}

constexpr int PP = RIN_P;
constexpr size_t WS_RK  = WS_GS;
constexpr size_t WS_BND = WS_GS + (size_t)MTOK * 16 * 4;
static_assert(WS_BND + (size_t)513 * PP * 2 <= WS_GD, "RWKV side buffers must fit the GLA state region");
constexpr int IMG = 64 * 72 * 2;
constexpr int R_ALB = 0, R_BH = IMG, R_KH = 2 * IMG, R_RB = 3 * IMG, R_BTL = 4 * IMG, R_KTL = 5 * IMG, R_VI = 6 * IMG, R_AAB = 7 * IMG, R_AAK = 8 * IMG, R_ARB = 9 * IMG, R_ARK = 10 * IMG,
              R_DW = R_AAK, R_DA = R_BH, R_XT = 11 * IMG, R_TW = R_XT, R_ADI = R_XT + IMG, R_TDF = R_XT + 2 * IMG, R_CS = R_TDF + 2048, R_GC = R_CS + 2048, R_CONST = R_GC + 256, R_WDL = R_CONST + 2560, R_WIL = R_WDL + IMG,
              R_END = R_WIL + IMG;
static_assert(R_DW + 64 * 68 * 4 <= R_XT && R_DA + 64 * 68 * 4 <= R_RB && R_END <= LDS_BYTES, "R1 LDS");
#define LDS_BARRIER() do { asm volatile("s_waitcnt lgkmcnt(0)" ::: "memory"); __builtin_amdgcn_s_barrier(); asm volatile("" ::: "memory"); } while (0)

typedef short s16x4 __attribute__((ext_vector_type(4)));
__device__ __forceinline__ bf16x8 ldfrag(const bf16_t* img, int row, int koff) { return *(const bf16x8*)(img + row * 72 + koff); }
__device__ __forceinline__ u32x2 pk4(f32x4 v) { u32x2 r; r.x = pk2(v[0], v[1]); r.y = pk2(v[2], v[3]); return r; }
__device__ __forceinline__ f32x4 unpk4(u32x2 v) { return (f32x4){bf2f(v.x & 0xffffu), bf2f(v.x >> 16), bf2f(v.y & 0xffffu), bf2f(v.y >> 16)}; }
__device__ __forceinline__ u32x2 trread(const bf16_t* p) {
    union { s16x4 s; u32x2 u; } x; x.s = __builtin_amdgcn_ds_read_tr16_b64_v4i16((__attribute__((address_space(3))) s16x4*)p); return x.u;
}
__device__ __forceinline__ bf16x8 trfrag(const bf16_t* img, int k0, int c0, int g, int q, int pq) {
    const bf16_t* a = img + (k0 + 8 * g + q) * 72 + c0 + 4 * pq;
    const u32x2 lo = trread(a), hi = trread(a + 4 * 72);
    return as_bf16x8((u32x4){lo.x, lo.y, hi.x, hi.y});
}
__device__ __forceinline__ f32x4 lo4(u32x4 v) { return (f32x4){bf2f(v.x & 0xffffu), bf2f(v.x >> 16), bf2f(v.y & 0xffffu), bf2f(v.y >> 16)}; }
__device__ __forceinline__ f32x4 hi4(u32x4 v) { return (f32x4){bf2f(v.z & 0xffffu), bf2f(v.z >> 16), bf2f(v.w & 0xffffu), bf2f(v.w >> 16)}; }
__device__ __forceinline__ u32x4 pk8(f32x4 a, f32x4 b) { return (u32x4){pk2(a[0], a[1]), pk2(a[2], a[3]), pk2(b[0], b[1]), pk2(b[2], b[3])}; }
__device__ __forceinline__ float fast_rcp(float x) { return __builtin_amdgcn_rcpf(x); }
__device__ __forceinline__ f32x4 mm16(f32x4 xa, f32x4 yb, f32x4 c) {
    const u32x2 a = pk4(xa), b = pk4(yb);
    return mfma16(as_bf16x8((u32x4){a.x, a.y, 0u, 0u}), as_bf16x8((u32x4){b.x, b.y, 0u, 0u}), c);
}

struct R1Raw { u32x4 r0, r1, k0, k1, v0, v1, w0, w1, a0, a1; };
__device__ __forceinline__ void r1_issue(R1Raw& x, const bf16_t* P, const bf16_t* BND, int unit, int t, int cs) {
    const int bn = unit >> 4, h = unit & 15, n = bn & 255;
    const bf16_t* cr = P + (size_t)bn * PB_CHUNK + h * PB_BLK + t * 64 + 8 * cs;
    const bf16_t* cw = P + (size_t)bn * PB_CHUNK + PB_WDAD + t * 128 + 8 * cs;
    const bf16_t* bp = BND + (size_t)(n == 0 ? 0 : bn) * PP;
    const int ch = h * 64 + 8 * cs;
    x.r0 = *(const u32x4*)cr; x.k0 = *(const u32x4*)(cr + 16 * PB_BLK); x.v0 = *(const u32x4*)(cr + 32 * PB_BLK); x.w0 = *(const u32x4*)cw; x.a0 = *(const u32x4*)(cw + 64);
    const bool in = t > 0;
    x.r1 = *(const u32x4*)(in ? cr - 64 : bp + ch); x.k1 = *(const u32x4*)(in ? cr + 16 * PB_BLK - 64 : bp + 1024 + ch); x.v1 = *(const u32x4*)(in ? cr + 32 * PB_BLK - 64 : bp + 2048 + ch);
    x.w1 = *(const u32x4*)(in ? cw - 128 : bp + 4096 + 8 * cs); x.a1 = *(const u32x4*)(in ? cw - 64 : bp + 4160 + 8 * cs);
}
__device__ __forceinline__ void lerp8(u32x4 c, u32x4 pv, const float* mu8, f32x4& o0, f32x4& o1) {
    const f32x4 c0 = lo4(c), c1 = hi4(c), p0 = lo4(pv), p1 = hi4(pv);
    const f32x4 m0 = *(const f32x4*)mu8, m1 = *(const f32x4*)(mu8 + 4);
    o0 = c0 + m0 * (p0 - c0); o1 = c1 + m1 * (p1 - c1);
}

__device__ void rwkv_r1(const Params& p, unsigned char* lds) {
    const int tid = threadIdx.x, w = __builtin_amdgcn_readfirstlane(tid >> 6);
    bf16_t* P = (bf16_t*)(p.ws + WS_P);
    bf16_t* Abuf = (bf16_t*)(p.ws + WS_A);
    bf16_t* Ybuf = (bf16_t*)(p.ws + WS_Y);
    float* RK = (float*)(p.ws + WS_RK);
    const bf16_t* BND = (const bf16_t*)(p.ws + WS_BND);
    const bf16_t* WduT = (const bf16_t*)(p.ws + WS_WDUT);
    const bf16_t* WiuT = (const bf16_t*)(p.ws + WS_WIUT);
    bf16_t* ALB = (bf16_t*)(lds + R_ALB); bf16_t* BH = (bf16_t*)(lds + R_BH); bf16_t* KH = (bf16_t*)(lds + R_KH); bf16_t* RB = (bf16_t*)(lds + R_RB);
    bf16_t* BTL = (bf16_t*)(lds + R_BTL); bf16_t* KTL = (bf16_t*)(lds + R_KTL); bf16_t* VI = (bf16_t*)(lds + R_VI);
    bf16_t* AAB = (bf16_t*)(lds + R_AAB); bf16_t* AAK = (bf16_t*)(lds + R_AAK); bf16_t* ARB = (bf16_t*)(lds + R_ARB); bf16_t* ARK = (bf16_t*)(lds + R_ARK);
    float* DW = (float*)(lds + R_DW); float* DA = (float*)(lds + R_DA);
    bf16_t* XT = (bf16_t*)(lds + R_XT); bf16_t* TW = (bf16_t*)(lds + R_TW); bf16_t* ADI = (bf16_t*)(lds + R_ADI);
    u32x2* TDF = (u32x2*)(lds + R_TDF); float* CS = (float*)(lds + R_CS); float* GCs = (float*)(lds + R_GC); float* CONST = (float*)(lds + R_CONST); bf16_t* WDL = (bf16_t*)(lds + R_WDL); bf16_t* WIL = (bf16_t*)(lds + R_WIL);
    const int t0_ = tid >> 3, cs0_ = tid & 7;
    int hprev = -1;
    R1Raw raw;
    if (blockIdx.x < 8192) r1_issue(raw, P, BND, blockIdx.x, t0_, cs0_);
    {
        u32x4* dmy = (u32x4*)(p.ws + WS_DUMMY) + tid;
#pragma unroll
        for (int k = 0; k < 6; ++k) dmy[k * NTH] = (u32x4){0u, 0u, 0u, 0u};
    }

    for (int unit = blockIdx.x; unit < 8192; unit += gridDim.x) {
        const int bn = unit >> 4, h = unit & 15, n = bn & 255;
        const size_t R0 = (size_t)bn * 64;
        int tidv = tid; asm volatile("" : "+v"(tidv));
        const int lane = tidv & 63, l15 = lane & 15, g = lane >> 4, q4 = l15 >> 2, p4 = l15 & 3, t = tidv >> 3, cs = tidv & 7, tl = lane >> 3;
        if (h != hprev) {
            LDS_BARRIER();
            if (tid < 64) {
                const int ch = h * 64 + tid;
                CONST[tid] = p.in[10][ch]; CONST[64 + tid] = p.in[10][1024 + ch]; CONST[128 + tid] = p.in[10][2048 + ch];
                CONST[192 + tid] = p.in[11][ch]; CONST[256 + tid] = p.in[13][ch]; CONST[320 + tid] = p.in[15][ch]; CONST[384 + tid] = p.in[16][ch]; CONST[448 + tid] = p.in[17][ch];
                CONST[512 + tid] = p.in[10][4096 + tid]; CONST[576 + tid] = p.in[10][4160 + tid];
            }
            {
                const int rr = tid >> 3, sg = tid & 7;
                *(u32x4*)(WDL + rr * 72 + 8 * sg) = *(const u32x4*)(WduT + (size_t)(h * 64 + rr) * 64 + 8 * sg);
                *(u32x4*)(WIL + rr * 72 + 8 * sg) = *(const u32x4*)(WiuT + (size_t)(h * 64 + rr) * 64 + 8 * sg);
            }
            hprev = h;
            LDS_BARRIER();
        }
        f32x4 r0, r1, k0, k1, v0, v1;
        {
            f32x4 wd0, wd1, ad0, ad1;
            lerp8(raw.r0, raw.r1, CONST + 8 * cs, r0, r1);
            lerp8(raw.k0, raw.k1, CONST + 64 + 8 * cs, k0, k1);
            lerp8(raw.v0, raw.v1, CONST + 128 + 8 * cs, v0, v1);
            lerp8(raw.w0, raw.w1, CONST + 512 + 8 * cs, wd0, wd1);
            lerp8(raw.a0, raw.a1, CONST + 576 + 8 * cs, ad0, ad1);
#pragma unroll
            for (int j = 0; j < 4; ++j) {
                const float e0 = __builtin_amdgcn_exp2f(2.8853900817779268f * wd0[j]), e1 = __builtin_amdgcn_exp2f(2.8853900817779268f * wd1[j]);
                wd0[j] = 1.f - 2.f * fast_rcp(1.f + e0); wd1[j] = 1.f - 2.f * fast_rcp(1.f + e1);
            }
            *(u32x4*)(TW + t * 72 + 8 * cs) = pk8(wd0, wd1);
            *(u32x4*)(ADI + t * 72 + 8 * cs) = pk8(ad0, ad1);
        }
        if (unit + (int)gridDim.x < 8192) r1_issue(raw, P, BND, unit + gridDim.x, t, cs);
        {
            const int trow = 8 * w + (l15 & 7);
            const bool lo8 = l15 < 8;
            bf16x8 ft[2], fa[2];
#pragma unroll
            for (int kk = 0; kk < 2; ++kk) { ft[kk] = ldfrag(TW, trow, 32 * kk + 8 * g); fa[kk] = ldfrag(ADI, trow, 32 * kk + 8 * g); }
            float* dst = (lo8 ? DW : DA) + trow * 68 + 4 * g;
#pragma unroll
            for (int ct = 0; ct < 4; ++ct) {
                f32x4 aw = (f32x4){0.f, 0.f, 0.f, 0.f}, aa = aw;
#pragma unroll
                for (int kk = 0; kk < 2; ++kk) { aw = mfma16(ldfrag(WDL, 16 * ct + l15, 32 * kk + 8 * g), ft[kk], aw); aa = mfma16(ldfrag(WIL, 16 * ct + l15, 32 * kk + 8 * g), fa[kk], aa); }
                f32x4 o;
#pragma unroll
                for (int j = 0; j < 4; ++j) o[j] = lo8 ? aw[j] : aa[j];
                *(f32x4*)(dst + 16 * ct) = o;
            }
        }
        f32x4 lw[2], av[2], kk[2], k2[2], G[2];
        {
            const f32x4 cw0[2] = {*(const f32x4*)(CONST + 192 + 8 * cs), *(const f32x4*)(CONST + 196 + 8 * cs)};
            const f32x4 ca0[2] = {*(const f32x4*)(CONST + 256 + 8 * cs), *(const f32x4*)(CONST + 260 + 8 * cs)};
            const f32x4 ckk[2] = {*(const f32x4*)(CONST + 320 + 8 * cs), *(const f32x4*)(CONST + 324 + 8 * cs)};
            const f32x4 cka[2] = {*(const f32x4*)(CONST + 384 + 8 * cs), *(const f32x4*)(CONST + 388 + 8 * cs)};
            const f32x4 crk[2] = {*(const f32x4*)(CONST + 448 + 8 * cs), *(const f32x4*)(CONST + 452 + 8 * cs)};
            const f32x4 dwv[2] = {*(const f32x4*)(DW + t * 68 + 8 * cs), *(const f32x4*)(DW + t * 68 + 8 * cs + 4)};
            const f32x4 dav[2] = {*(const f32x4*)(DA + t * 68 + 8 * cs), *(const f32x4*)(DA + t * 68 + 8 * cs + 4)};
            const f32x4 kin[2] = {k0, k1}, rin[2] = {r0, r1};
            float n2 = 0.f, rk = 0.f;
#pragma unroll
            for (int hf = 0; hf < 2; ++hf)
#pragma unroll
                for (int j = 0; j < 4; ++j) {
                    const float z = -(cw0[hf][j] + dwv[hf][j]);
                    lw[hf][j] = -0.8750387749f * fast_rcp(1.f + __builtin_amdgcn_exp2f(1.4426950408889634f * z));
                    av[hf][j] = fast_rcp(1.f + __builtin_amdgcn_exp2f(-1.4426950408889634f * (ca0[hf][j] + dav[hf][j])));
                    kk[hf][j] = kin[hf][j] * ckk[hf][j];
                    k2[hf][j] = kin[hf][j] * (1.f + (av[hf][j] - 1.f) * cka[hf][j]);
                    n2 += kk[hf][j] * kk[hf][j]; rk += rin[hf][j] * k2[hf][j] * crk[hf][j];
                }
            n2 = sum8(n2); rk = sum8(rk);
            const float inv = __builtin_amdgcn_rsqf(fmaxf(n2, 1e-24f));
            kk[0] *= inv; kk[1] *= inv;
            if (cs == 0) RK[(R0 + t) * 16 + h] = rk;
            G[0] = lw[0]; G[1] = lw[1];
#pragma unroll
            for (int d = 1; d < 8; d <<= 1) {
                const int src = ((lane - 8 * d) & 63) * 4;
                const float keep = (tl >= d) ? 1.f : 0.f;
#pragma unroll
                for (int hf = 0; hf < 2; ++hf)
#pragma unroll
                    for (int j = 0; j < 4; ++j) G[hf][j] += keep * bperm(src, G[hf][j]);
            }
            if (tl == 7) { *(f32x4*)(CS + w * 64 + 8 * cs) = G[0]; *(f32x4*)(CS + w * 64 + 8 * cs + 4) = G[1]; }
        }
        LDS_BARRIER();
        {
            f32x4 off[2] = {(f32x4){0.f, 0.f, 0.f, 0.f}, (f32x4){0.f, 0.f, 0.f, 0.f}}, gc[2] = {off[0], off[0]};
#pragma unroll
            for (int q = 0; q < 8; ++q) {
                const f32x4 c0 = *(const f32x4*)(CS + q * 64 + 8 * cs), c1 = *(const f32x4*)(CS + q * 64 + 8 * cs + 4);
                const float mk = (q < w) ? 1.f : 0.f;
                gc[0] += c0; gc[1] += c1; off[0] += c0 * mk; off[1] += c1 * mk;
            }
            f32x4 al[2], bh[2], kh[2], rb[2];
            const f32x4 rin[2] = {r0, r1};
#pragma unroll
            for (int hf = 0; hf < 2; ++hf)
#pragma unroll
                for (int j = 0; j < 4; ++j) {
                    const float Gi = G[hf][j] + off[hf][j];
                    const float eG = __builtin_amdgcn_exp2f(Gi), eGm = __builtin_amdgcn_exp2f(Gi - lw[hf][j]), enG = fast_rcp(eG);
                    const float be = kk[hf][j] * av[hf][j];
                    al[hf][j] = -kk[hf][j] * eGm; bh[hf][j] = be * enG; kh[hf][j] = k2[hf][j] * enG; rb[hf][j] = rin[hf][j] * eG;
                }
            const int o = t * 72 + 8 * cs;
            *(u32x4*)(ALB + o) = pk8(al[0], al[1]); *(u32x4*)(BH + o) = pk8(bh[0], bh[1]); *(u32x4*)(KH + o) = pk8(kh[0], kh[1]); *(u32x4*)(RB + o) = pk8(rb[0], rb[1]);
            const u32x4 vpk = pk8(v0, v1);
            *(u32x4*)(VI + o) = vpk;
            *(u32x4*)(Ybuf + (R0 + t) * DM + h * 64 + 8 * cs) = vpk;
            if (w == 0 && tl == 0) { f32x4 e0, e1;
#pragma unroll
                for (int j = 0; j < 4; ++j) { e0[j] = __builtin_amdgcn_exp2f(gc[0][j]); e1[j] = __builtin_amdgcn_exp2f(gc[1][j]); }
                *(f32x4*)(GCs + 8 * cs) = e0; *(f32x4*)(GCs + 8 * cs + 4) = e1; }
        }
        LDS_BARRIER();
        {
            int ntile = 1, tta = 0, sta = 0, ttb = 0, stb = 0;
            if (w == 0) { tta = 0; sta = 0; } else if (w == 2) { tta = 1; sta = 1; } else if (w == 5) { tta = 2; sta = 2; } else if (w == 7) { tta = 3; sta = 3; }
            else if (w == 1) { ntile = 2; tta = 1; sta = 0; ttb = 2; stb = 0; } else if (w == 3) { ntile = 2; tta = 2; sta = 1; ttb = 3; stb = 0; }
            else if (w == 4) { tta = 3; sta = 1; } else { tta = 3; sta = 2; }
            for (int it = 0; it < ntile; ++it) {
                const int tt = it ? ttb : tta, st = it ? stb : sta;
                f32x4 cab = (f32x4){0.f, 0.f, 0.f, 0.f}, cak = cab, crb = cab, crk = cab, nab = cab;
#pragma unroll
                for (int kq = 0; kq < 2; ++kq) {
                    const bf16x8 fb = ldfrag(BH, 16 * st + l15, 32 * kq + 8 * g), fk = ldfrag(KH, 16 * st + l15, 32 * kq + 8 * g);
                    const bf16x8 fa = ldfrag(ALB, 16 * tt + l15, 32 * kq + 8 * g), fr = ldfrag(RB, 16 * tt + l15, 32 * kq + 8 * g);
                    cab = mfma16(fb, fa, cab); cak = mfma16(fk, fa, cak); crb = mfma16(fb, fr, crb); crk = mfma16(fk, fr, crk);
                    if (tt == st) nab = mfma16(fa, fb, nab);
                }
                if (tt == st) {
#pragma unroll
                    for (int r = 0; r < 4; ++r) {
                        const int s = 4 * g + r, tq = l15;
                        if (s >= tq) { cab[r] = 0.f; cak[r] = 0.f; }
                        if (s > tq) { crb[r] = 0.f; crk[r] = 0.f; }
                        if (l15 >= 4 * g + r) nab[r] = 0.f;
                    }
                }
                const int o = (16 * tt + l15) * 72 + 16 * st + 4 * g;
                *(u32x2*)(AAB + o) = pk4(cab); *(u32x2*)(AAK + o) = pk4(cak); *(u32x2*)(ARB + o) = pk4(crb); *(u32x2*)(ARK + o) = pk4(crk);
                if (tt == st) {
                    const f32x4 z = (f32x4){0.f, 0.f, 0.f, 0.f};
                    const f32x4 Q1 = cab, N1 = nab;
                    const f32x4 Q2 = mm16(N1, Q1, z), N2 = mm16(Q1, N1, z);
                    f32x4 Pm = Q1;
#pragma unroll
                    for (int r = 0; r < 4; ++r) if (4 * g + r == l15) Pm[r] += 1.f;
                    Pm = mm16(N2, Pm, Pm);
                    const f32x4 Q4 = mm16(N2, Q2, z), N4 = mm16(Q2, N2, z);
                    Pm = mm16(N4, Pm, Pm);
                    const f32x4 N8 = mm16(Q4, N4, z);
                    Pm = mm16(N8, Pm, Pm);
                    TDF[tt * 64 + lane] = pk4(Pm);
                }
            }
            if (w == 4 || w == 6) {
                const int tt = (w == 4) ? 0 : 2, st = tt + 1;
                const int o = (16 * tt + l15) * 72 + 16 * st + 4 * g;
                const u32x2 zz = (u32x2){0u, 0u};
                *(u32x2*)(AAK + o) = zz; *(u32x2*)(ARB + o) = zz; *(u32x2*)(ARK + o) = zz;
            }
        }
        LDS_BARRIER();
        {
            u32x2 xb[4];
            const int col = 16 * w + l15;
            bf16x8 vfr[2];
            if (w >= 4) { vfr[0] = trfrag(VI, 0, 16 * (w - 4), g, q4, p4); vfr[1] = trfrag(VI, 32, 16 * (w - 4), g, q4, p4); }
#pragma unroll
            for (int i = 0; i < 4; ++i) {
                f32x4 z;
                if (w < 4) z = unpk4(trread(ALB + (16 * i + 4 * g + q4) * 72 + 16 * w + 4 * p4));
                else {
                    z = mfma16(ldfrag(AAK, 16 * i + l15, 8 * g), vfr[0], (f32x4){0.f, 0.f, 0.f, 0.f});
                    if (i >= 2) z = mfma16(ldfrag(AAK, 16 * i + l15, 32 + 8 * g), vfr[1], z);
                }
                if (i >= 1) {
                    const bf16_t* ar = AAB + (16 * i + l15) * 72 + 4 * g;
                    const u32x2 a0 = *(const u32x2*)ar;
                    u32x2 a1 = (u32x2){0u, 0u}, b1 = (u32x2){0u, 0u};
                    if (i >= 2) { a1 = *(const u32x2*)(ar + 16); b1 = xb[1]; }
                    z = mfma16(as_bf16x8((u32x4){a0.x, a0.y, a1.x, a1.y}), as_bf16x8((u32x4){xb[0].x, xb[0].y, b1.x, b1.y}), z);
                    if (i == 3) {
                        const u32x2 a2 = *(const u32x2*)(ar + 32);
                        z = mfma16(as_bf16x8((u32x4){a2.x, a2.y, 0u, 0u}), as_bf16x8((u32x4){xb[2].x, xb[2].y, 0u, 0u}), z);
                    }
                }
                const u32x2 tq = TDF[i * 64 + lane];
                const u32x2 zq = pk4(z);
                const f32x4 x = mfma16(as_bf16x8((u32x4){tq.x, tq.y, 0u, 0u}), as_bf16x8((u32x4){zq.x, zq.y, 0u, 0u}), (f32x4){0.f, 0.f, 0.f, 0.f});
                xb[i] = pk4(x);
                *(u32x2*)(XT + col * 72 + 16 * i + 4 * g) = xb[i];
            }
        }
        LDS_BARRIER();
        {
            const int rt_ = w & 3, c0 = 2 * (w >> 2);
            bf16x8 xw[2], xu[2], fbt[2], fkt[2], fvr[2];
#pragma unroll
            for (int kq = 0; kq < 2; ++kq) {
                xw[kq] = ldfrag(XT, 16 * rt_ + l15, 32 * kq + 8 * g);
                xu[kq] = ldfrag(XT, 64 + 16 * rt_ + l15, 32 * kq + 8 * g);
                fbt[kq] = trfrag(BH, 32 * kq, 16 * rt_, g, q4, p4);
                fkt[kq] = trfrag(KH, 32 * kq, 16 * rt_, g, q4, p4);
                fvr[kq] = trfrag(VI, 32 * kq, 16 * rt_, g, q4, p4);
            }
            const float gcd0 = GCs[16 * c0 + l15], gcd1 = GCs[16 * c0 + 16 + l15];
            const f32x4 gcr = *(const f32x4*)(GCs + 16 * rt_ + 4 * g);
#pragma unroll
            for (int q = 0; q < 2; ++q) {
                bf16x8 gbt[2], garb[2], gxu[2], gvi[2], gark[2];
#pragma unroll
                for (int kq = 0; kq < 2; ++kq) {
                    gbt[kq] = trfrag(BH, 32 * kq, 16 * (c0 + q), g, q4, p4);
                    garb[kq] = ldfrag(ARB, 16 * (c0 + q) + l15, 32 * kq + 8 * g);
                    gxu[kq] = ldfrag(XT, 64 + 16 * (c0 + q) + l15, 32 * kq + 8 * g);
                    gvi[kq] = trfrag(VI, 32 * kq, 16 * (c0 + q), g, q4, p4);
                    gark[kq] = ldfrag(ARK, 16 * (c0 + q) + l15, 32 * kq + 8 * g);
                }
                const u32x2 rbi = *(const u32x2*)(RB + (16 * (c0 + q) + l15) * 72 + 16 * rt_ + 4 * g);
                __builtin_amdgcn_sched_barrier(0);
                const int ctile = c0 + q;
                {
                    f32x4 acc = (f32x4){0.f, 0.f, 0.f, 0.f};
#pragma unroll
                    for (int kq = 0; kq < 2; ++kq) acc = mfma16(xw[kq], gbt[kq], acc);
                    const int dcol = 16 * ctile + l15;
                    if (rt_ == ctile) {
#pragma unroll
                        for (int r = 0; r < 4; ++r) if (4 * g + r == l15) acc[r] += 1.f;
                    }
                    acc *= (q ? gcd1 : gcd0);
                    *(u32x2*)(ALB + dcol * 72 + 32 * (rt_ >> 1) + 8 * g + 4 * (rt_ & 1)) = pk4(acc);
                }
                {
                    f32x4 acc = unpk4(rbi);
#pragma unroll
                    for (int kq = 0; kq < 2; ++kq) {
                        if (32 * kq <= 16 * ctile + 15) acc = mfma16(xw[kq], garb[kq], acc);
                    }
                    *(u32x2*)(BTL + (16 * ctile + l15) * 72 + 16 * rt_ + 4 * g) = pk4(acc);
                }
                {
                    f32x4 acc = (f32x4){0.f, 0.f, 0.f, 0.f};
#pragma unroll
                    for (int kq = 0; kq < 2; ++kq) { acc = mfma16(fbt[kq], gxu[kq], acc); acc = mfma16(fkt[kq], gvi[kq], acc); }
                    *(u32x2*)(KTL + (16 * ctile + l15) * 72 + 16 * rt_ + 4 * g) = pk4(acc * gcr);
                }
                {
                    f32x4 acc = (f32x4){0.f, 0.f, 0.f, 0.f};
#pragma unroll
                    for (int kq = 0; kq < 2; ++kq) {
                        if (32 * kq <= 16 * ctile + 15) { acc = mfma16(xu[kq], garb[kq], acc); acc = mfma16(fvr[kq], gark[kq], acc); }
                    }
                    *(u32x2*)(AAB + (16 * ctile + l15) * 72 + 16 * rt_ + 4 * g) = pk4(acc);
                }
            }
        }
        LDS_BARRIER();
        {
            const int o = t * 72 + 8 * cs;
            bf16_t* cb = P + (size_t)bn * PB_CHUNK + h * PB_BLK + t * 64 + 8 * cs;
            *(u32x4*)cb = *(const u32x4*)(ALB + o);
            *(u32x4*)(cb + 16 * PB_BLK) = *(const u32x4*)(BTL + o);
            *(u32x4*)(cb + 32 * PB_BLK) = *(const u32x4*)(KTL + o);
            *(u32x4*)(Abuf + (R0 + t) * DM + h * 64 + 8 * cs) = *(const u32x4*)(AAB + o);
        }
    }
}

constexpr int SC_SLOT = 2 * IMG;
constexpr size_t WS_MG = (WS_BND + (size_t)513 * PP * 2 + 255) & ~(size_t)255;
constexpr size_t WS_NG = WS_MG + (size_t)1024 * 4096 * 2;
static_assert(WS_NG + (size_t)1024 * 4096 * 2 <= WS_GD, "scan buffers must fit the GLA state region");

template <int MODE>
__device__ void rwkv_scan2(const Params& p, unsigned char* lds) {
    constexpr int GSZ = 32, NGRP = 256 / GSZ, LG = 3;
    constexpr int SPU = (MODE == 2) ? NGRP : GSZ;
    constexpr int NU = (MODE == 2) ? 32 : 32 * NGRP;
    const int tid = threadIdx.x, lane = tid & 63, w = __builtin_amdgcn_readfirstlane(tid >> 6), l15 = lane & 15, g = lane >> 4;
    bf16_t* P = (bf16_t*)(p.ws + WS_P);
    bf16_t* MG = (bf16_t*)(p.ws + WS_MG); bf16_t* NG = (bf16_t*)(p.ws + WS_NG); bf16_t* HG = NG;
    const int G = gridDim.x;
    const int nun = ((int)blockIdx.x < NU) ? (NU - 1 - (int)blockIdx.x) / G + 1 : 0;
    const int T = nun * SPU;
    if (T == 0) return;
#define SC_SRC(s, p0, p1, pitchb) \
    const int u_ = (int)blockIdx.x + G * ((s) / SPU), j_ = (s) % SPU; \
    const char* p0; const char* p1; unsigned pitchb; \
    if (MODE == 2) { p0 = (const char*)(MG + (size_t)(u_ * NGRP + j_) * 4096); p1 = (const char*)(NG + (size_t)(u_ * NGRP + j_) * 4096); pitchb = 128u; } \
    else { const int bh_ = u_ >> LG, n_ = GSZ * (u_ & (NGRP - 1)) + j_; p0 = (const char*)(P + (size_t)((bh_ >> 4) * 256 + n_) * PB_CHUNK + (bh_ & 15) * PB_BLK); p1 = p0 + 32 * PB_BLK * 2; pitchb = 128u; }
    if (w >= 4) {
        const int lj = w - 4;
        const unsigned loff = (unsigned)((lane >> 3) * 144 + (lane & 7) * 16);
        u32x4 ld0[16], ld1[16];
#define SC_ISSUE(dst, s) do { const int sc_ = ((s) < T) ? (s) : T - 1; SC_SRC(sc_, q0_, q1_, pb_) const unsigned go_ = (unsigned)(lane >> 3) * pb_ + (unsigned)(lane & 7) * 16u; \
        _Pragma("unroll") for (int q = 0; q < 16; ++q) dst[q] = *(const u32x4*)(((q >> 3) ? q1_ : q0_) + (size_t)((q & 7) * 8) * pb_ + go_); } while (0)
#define SC_RETIRE(src, s) do { unsigned char* sb = lds + ((s) & 1) * SC_SLOT + loff; _Pragma("unroll") for (int q = 0; q < 16; ++q) \
        *(u32x4*)(sb + (q >> 3) * IMG + (q & 7) * 8 * 144) = src[q]; } while (0)
        SC_ISSUE(ld0, lj); SC_ISSUE(ld1, lj + 4);
        for (int it = 0; it < T / 8; ++it) {
            const int c0 = lj + 8 * it;
            for (int k = 0; k < lj; ++k) LDS_BARRIER();
            SC_RETIRE(ld0, c0); SC_ISSUE(ld0, c0 + 8);
            for (int k = 0; k < 4; ++k) LDS_BARRIER();
            SC_RETIRE(ld1, c0 + 4); SC_ISSUE(ld1, c0 + 12);
            for (int k = 0; k < 4 - lj; ++k) LDS_BARRIER();
        }
        LDS_BARRIER();
#undef SC_ISSUE
#undef SC_RETIRE
    } else {
        f32x4 H[4], Mg[4];
        for (int i = 0; i <= T; ++i) {
            if (i >= 1) {
                const int s = i - 1, u = (int)blockIdx.x + G * (s / SPU), j = s % SPU;
                const unsigned char* sb = lds + (s & 1) * SC_SLOT;
                const bf16_t* MT = (const bf16_t*)sb; const bf16_t* NT = (const bf16_t*)(sb + IMG);
                if (j == 0) {
                    if (MODE == 3) {
#pragma unroll
                        for (int mt = 0; mt < 4; ++mt) H[mt] = unpk4(*(const u32x2*)(HG + (size_t)u * 4096 + (16 * w + l15) * 64 + 16 * mt + 4 * g));
                    } else {
#pragma unroll
                        for (int mt = 0; mt < 4; ++mt) H[mt] = (f32x4){0.f, 0.f, 0.f, 0.f};
                    }
                    if (MODE == 1) {
#pragma unroll
                        for (int mt = 0; mt < 4; ++mt)
#pragma unroll
                            for (int r = 0; r < 4; ++r) Mg[mt][r] = (16 * mt + 4 * g + r == 16 * w + l15) ? 1.f : 0.f;
                    }
                }
                u32x2 hp[4];
#pragma unroll
                for (int mt = 0; mt < 4; ++mt) hp[mt] = pk4(H[mt]);
                if (MODE == 2) {
#pragma unroll
                    for (int mt = 0; mt < 4; ++mt) *(u32x2*)(HG + (size_t)(u * NGRP + j) * 4096 + (16 * w + l15) * 64 + 16 * mt + 4 * g) = hp[mt];
                }
                if (MODE == 3) {
                    const int bh = u >> LG, n = GSZ * (u & (NGRP - 1)) + j;
#pragma unroll
                    for (int mt = 0; mt < 4; ++mt) *(u32x2*)(P + (size_t)((bh >> 4) * 256 + n) * PB_CHUNK + (32 + (bh & 15)) * PB_BLK + (16 * w + l15) * 64 + 16 * mt + 4 * g) = hp[mt];
                }
                bf16x8 hb[2], mb[2];
                hb[0] = as_bf16x8((u32x4){hp[0].x, hp[0].y, hp[1].x, hp[1].y});
                hb[1] = as_bf16x8((u32x4){hp[2].x, hp[2].y, hp[3].x, hp[3].y});
                if (MODE == 1) {
                    const u32x2 m0 = pk4(Mg[0]), m1 = pk4(Mg[1]), m2 = pk4(Mg[2]), m3 = pk4(Mg[3]);
                    mb[0] = as_bf16x8((u32x4){m0.x, m0.y, m1.x, m1.y}); mb[1] = as_bf16x8((u32x4){m2.x, m2.y, m3.x, m3.y});
                }
#pragma unroll
                for (int mt = 0; mt < 4; ++mt) {
                    const bf16x8 a0 = ldfrag(MT, 16 * mt + l15, 8 * g), a1 = ldfrag(MT, 16 * mt + l15, 32 + 8 * g);
                    f32x4 acc = unpk4(*(const u32x2*)(NT + (16 * w + l15) * 72 + 16 * mt + 4 * g));
                    acc = mfma16(a0, hb[0], acc); acc = mfma16(a1, hb[1], acc);
                    H[mt] = acc;
                    if (MODE == 1) { f32x4 am = mfma16(a0, mb[0], (f32x4){0.f, 0.f, 0.f, 0.f}); am = mfma16(a1, mb[1], am); Mg[mt] = am; }
                }
                if (MODE == 1 && j == SPU - 1) {
                    const int pc = 32 * (w >> 1) + 8 * (l15 >> 2) + 4 * (w & 1) + (l15 & 3);
#pragma unroll
                    for (int mt = 0; mt < 4; ++mt) {
                        *(u32x2*)(NG + (size_t)u * 4096 + (16 * w + l15) * 64 + 16 * mt + 4 * g) = pk4(H[mt]);
#pragma unroll
                        for (int r = 0; r < 4; ++r) MG[(size_t)u * 4096 + (16 * mt + 4 * g + r) * 64 + pc] = f2bf(Mg[mt][r]);
                    }
                }
            }
            LDS_BARRIER();
        }
    }
#undef SC_SRC
}

__device__ void rwkv_post(const Params& p, unsigned char* lds) {
    const int tid = threadIdx.x, lane = tid & 63, w = __builtin_amdgcn_readfirstlane(tid >> 6), l15 = lane & 15, g = lane >> 4;
    const bf16_t* P = (const bf16_t*)(p.ws + WS_P);
    bf16_t* Abuf = (bf16_t*)(p.ws + WS_A);
    const bf16_t* Ybuf = (const bf16_t*)(p.ws + WS_Y);
    const float* RK = (const float*)(p.ws + WS_RK);
    const bf16_t* BND = (const bf16_t*)(p.ws + WS_BND);
    float* L = (float*)(lds + w * 8704);
    const int tr = lane >> 3, seg = lane & 7;
    for (int hu = blockIdx.x * 8 + w; hu < 16384; hu += gridDim.x * 8) {
        const int unit = hu >> 1, t0 = (hu & 1) * 32;
        const int bn = unit >> 4, h = unit & 15, n = bn & 255;
        const size_t R0 = (size_t)bn * 64;
        bf16x8 fh[4][2], fr[2][2];
#pragma unroll
        for (int kk = 0; kk < 2; ++kk) {
#pragma unroll
            for (int q = 0; q < 4; ++q) fh[q][kk] = *(const bf16x8*)(P + (size_t)bn * PB_CHUNK + (32 + h) * PB_BLK + (16 * q + l15) * 64 + 32 * kk + 8 * g);
#pragma unroll
            for (int q = 0; q < 2; ++q) fr[q][kk] = *(const bf16x8*)(P + (size_t)bn * PB_CHUNK + (16 + h) * PB_BLK + (t0 + 16 * q + l15) * 64 + 32 * kk + 8 * g);
        }
        u32x4 y0r[4], g1r[4], g0r[4], vpr[4];
        float rkv[4];
#pragma unroll
        for (int i = 0; i < 4; ++i) {
            const int t = t0 + tr + 8 * i;
            y0r[i] = *(const u32x4*)(Abuf + (R0 + t) * DM + h * 64 + 8 * seg);
            const bf16_t* grow = P + (size_t)bn * PB_CHUNK + (48 + h) * PB_BLK + t * 64 + 8 * seg;
            g1r[i] = *(const u32x4*)grow;
            g0r[i] = *(const u32x4*)((t > 0) ? (grow - 64) : (BND + (size_t)(n == 0 ? 0 : bn) * PP + 3072 + h * 64 + 8 * seg));
            vpr[i] = *(const u32x4*)(Ybuf + (R0 + t) * DM + h * 64 + 8 * seg);
            rkv[i] = RK[(R0 + t) * 16 + h];
        }
#pragma unroll
        for (int i = 0; i < 4; ++i) { *(f32x4*)(L + (tr + 8 * i) * 68 + 8 * seg) = lo4(y0r[i]); *(f32x4*)(L + (tr + 8 * i) * 68 + 8 * seg + 4) = hi4(y0r[i]); }
        f32x4 y[4][2];
#pragma unroll
        for (int vt = 0; vt < 4; ++vt)
#pragma unroll
            for (int tt = 0; tt < 2; ++tt) y[vt][tt] = *(const f32x4*)(L + (16 * tt + l15) * 68 + 16 * vt + 4 * g);
#pragma unroll
        for (int vt = 0; vt < 4; ++vt)
#pragma unroll
            for (int tt = 0; tt < 2; ++tt)
#pragma unroll
                for (int kk = 0; kk < 2; ++kk) y[vt][tt] = mfma16(fh[vt][kk], fr[tt][kk], y[vt][tt]);
#pragma unroll
        for (int tt = 0; tt < 2; ++tt) {
            float s1 = 0.f, s2 = 0.f;
#pragma unroll
            for (int vt = 0; vt < 4; ++vt)
#pragma unroll
                for (int r = 0; r < 4; ++r) { s1 += y[vt][tt][r]; s2 += y[vt][tt][r] * y[vt][tt][r]; }
            { const int a16 = (lane ^ 16) * 4, a32 = (lane ^ 32) * 4; s1 += bperm(a16, s1); s2 += bperm(a16, s2); s1 += bperm(a32, s1); s2 += bperm(a32, s2); }
            const float mean = s1 * (1.0f / 64.0f);
            const float rstd = rsqrtf(fmaxf(s2 * (1.0f / 64.0f) - mean * mean, 0.f) + 64e-5f);
#pragma unroll
            for (int vt = 0; vt < 4; ++vt) *(f32x4*)(L + (16 * tt + l15) * 68 + 16 * vt + 4 * g) = (y[vt][tt] - mean) * rstd;
        }
        const int ch = h * 64 + 8 * seg;
        const f32x4 lw0 = *(const f32x4*)(p.in[18] + ch), lw1 = *(const f32x4*)(p.in[18] + ch + 4), lb0 = *(const f32x4*)(p.in[19] + ch), lb1 = *(const f32x4*)(p.in[19] + ch + 4);
        const f32x4 mg0 = *(const f32x4*)(p.in[10] + 3072 + ch), mg1 = *(const f32x4*)(p.in[10] + 3072 + ch + 4);
#pragma unroll
        for (int i = 0; i < 4; ++i) {
            const int t = t0 + tr + 8 * i;
            const f32x4 n0 = *(const f32x4*)(L + (tr + 8 * i) * 68 + 8 * seg), n1 = *(const f32x4*)(L + (tr + 8 * i) * 68 + 8 * seg + 4);
            const f32x4 ga0 = lo4(g1r[i]), ga1 = hi4(g1r[i]);
            const f32x4 gb0 = lo4(g0r[i]), gb1 = hi4(g0r[i]);
            const f32x4 gt0 = ga0 + mg0 * (gb0 - ga0), gt1 = ga1 + mg1 * (gb1 - ga1);
            const f32x4 v0 = lo4(vpr[i]), v1 = hi4(vpr[i]);
            f32x4 o0 = n0 * lw0 + lb0 + rkv[i] * v0, o1 = n1 * lw1 + lb1 + rkv[i] * v1;
#pragma unroll
            for (int j = 0; j < 4; ++j) { o0[j] *= gt0[j] * __builtin_amdgcn_rcpf(1.0f + fexp(-gt0[j])); o1[j] *= gt1[j] * __builtin_amdgcn_rcpf(1.0f + fexp(-gt1[j])); }
            *(u32x4*)(Abuf + (R0 + t) * DM + h * 64 + 8 * seg) = pk8(o0, o1);
        }
    }
}
#define XB_TMO      128
#define XB_XCNT(j)  (256  + 64 * (j))
#define XB_XSUB(j)  (1280 + 64 * (j))
#define XB_XGEN(j)  (2304 + 64 * (j))
#define XB_TOP      3328
#define XB_TOPGEN   3392
#define XCD_BAR_WORDS 3456
#define XB_SPIN_CAP (1u << 18)
#define LAS __attribute__((address_space(3)))

__device__ __forceinline__ unsigned xb_ld(unsigned* p)              { return __hip_atomic_load(p, __ATOMIC_RELAXED, __HIP_MEMORY_SCOPE_AGENT); }
__device__ __forceinline__ unsigned xb_add(unsigned* p, unsigned v) { return __hip_atomic_fetch_add(p, v, __ATOMIC_RELAXED, __HIP_MEMORY_SCOPE_AGENT); }
__device__ __forceinline__ unsigned xb_xcc_id() { return (unsigned)__builtin_amdgcn_s_getreg((3 << 11) | 20) & 0xFu; }
#define XB_SPIN(cond, bar) do { unsigned _sp = 0; while (cond) { __builtin_amdgcn_s_sleep(1); \
    if ((++_sp & 255u) == 0u) { if (xb_ld(&(bar)[XB_TMO])) break; if (_sp > XB_SPIN_CAP) { atomicAdd(&(bar)[XB_TMO], 1u); break; } } } } while (0)

struct XcdBarrier {
    unsigned* bar; unsigned x;
    volatile LAS unsigned* st;
};

__device__ __forceinline__ XcdBarrier xcd_barrier_post(unsigned* bar, volatile LAS unsigned* st) {
    XcdBarrier b; b.bar = bar; b.x = xb_xcc_id(); b.st = st;
    if (threadIdx.x == 0) (void)xb_add(&bar[XB_XCNT(b.x)], 1u);
    return b;
}
__device__ __forceinline__ void xcd_barrier_complete(unsigned* bar, unsigned x, unsigned& nloc, unsigned& nx) {
    const unsigned G = gridDim.x * gridDim.y * gridDim.z;
    unsigned sum, cnt, mine, sp = 0u;
    for (;;) {
        sum = 0u; cnt = 0u; mine = 0u;
#pragma unroll
        for (unsigned j = 0; j < 16; ++j) { const unsigned c = xb_ld(&bar[XB_XCNT(j)]); sum += c; cnt += (c > 0u) ? 1u : 0u; mine = (j == x) ? c : mine; }
        if (sum == G) break;
        __builtin_amdgcn_s_sleep(1);
        if ((++sp & 255u) == 0u) { if (xb_ld(&bar[XB_TMO])) break; if (sp > XB_SPIN_CAP) { atomicAdd(&bar[XB_TMO], 1u); break; } }
    }
    nloc = mine > 0u ? mine : 1u; nx = cnt > 0u ? cnt : 1u;
}

__device__ __forceinline__ void xcd_barrier(const XcdBarrier& b) {
    asm volatile("s_waitcnt vmcnt(0)" ::: "memory");
    __syncthreads();
    if (threadIdx.x == 0) {
        unsigned* bar = b.bar;
        __builtin_amdgcn_s_waitcnt(0);
        unsigned nloc = b.st[0], nx = b.st[1];
        if (nloc == 0u) { xcd_barrier_complete(bar, b.x, nloc, nx); b.st[0] = nloc; b.st[1] = nx; }
        const unsigned old = xb_add(&bar[XB_XSUB(b.x)], 1u);
        const unsigned gen = old / nloc;
        if (old + 1u == (gen + 1u) * nloc) {
            __builtin_amdgcn_fence(__ATOMIC_RELEASE, "agent");
            asm volatile("s_waitcnt vmcnt(0)" ::: "memory");
            const unsigned og = xb_add(&bar[XB_TOP], 1u);
            const unsigned tg = og / nx;
            if (og + 1u == (tg + 1u) * nx) xb_add(&bar[XB_TOPGEN], 1u);
            else XB_SPIN(xb_ld(&bar[XB_TOPGEN]) == tg, bar);
            __builtin_amdgcn_fence(__ATOMIC_ACQUIRE, "agent");
            xb_add(&bar[XB_XGEN(b.x)], 1u);
            asm volatile("s_waitcnt vmcnt(0)" ::: "memory");
        } else {
            XB_SPIN(xb_ld(&bar[XB_XGEN(b.x)]) == gen, bar);
            __builtin_amdgcn_fence(__ATOMIC_ACQUIRE, "agent");
            asm volatile("s_waitcnt vmcnt(0)" ::: "memory");
        }
    }
    __syncthreads();
}


#ifndef PROBE_ID
#define PROBE_ID 0
#endif
#ifndef N_LAUNCH_MODE
#define N_LAUNCH_MODE 1
#endif
constexpr int N_PHASES = 15;

__global__ void __launch_bounds__(NTH, 2) fwd_kernel(Params p) {
    extern __shared__ __attribute__((aligned(16))) unsigned char lds[];
    const int lo = p.ph_lo, hi = p.ph_hi;
    volatile LAS unsigned* xst = (volatile LAS unsigned*)(lds + LDS_BYTES);
    if (threadIdx.x < 4) xst[threadIdx.x] = 0u;
    __syncthreads();
    const XcdBarrier xbar = xcd_barrier_post((unsigned*)(p.ws + WS_BAR), xst);
    unsigned char* ws = p.ws;
#define IN(k) (lo <= (k) && (k) < hi)
#define SEAM(k) do { if ((k) + 1 < hi) xcd_barrier(xbar); } while (0)
    if (IN(0)) {
        prep_weight(p.in[2], GIN, p.in[1], (bf16_t*)(ws + WS_WGIN), GIN_P, (float*)lds);
        prep_weight(p.in[6], DM, nullptr, (bf16_t*)(ws + WS_WGOUT), DM, (float*)lds);
        prep_wup(p.in[3], (bf16_t*)(ws + WS_WUPT));
        __syncthreads();
        phase_norm0(p, lds);
        SEAM(0);
    }
    if (IN(1)) {
        pg8::Gemm g{(const bf16_t*)(ws + WS_A), (const bf16_t*)(ws + WS_WGIN), MTOK, GIN_P, DM}; pg8::StaticOrder S; S.init(MTOK, GIN_P, gridDim.x, blockIdx.x);
        EpiBf16GateSilu E{(bf16_t*)(ws + WS_P), GIN_P};
        pg8::gemm_phase<EpiBf16GateSilu, pg8::StaticOrder>((PG8_LAS unsigned char*)lds, g, S, E);
        SEAM(1);
    }
    if (IN(2)) { gla_pass<false>(p, lds); SEAM(2); }
    if (IN(3)) {
        gla_scan(p);
        prep_weight(p.in[9], RIN, p.in[8], (bf16_t*)(ws + WS_WRIN), RIN_P, (float*)lds);
        prep_weight(p.in[20], DM, nullptr, (bf16_t*)(ws + WS_WROUT), DM, (float*)lds);
        prep_lowrank(p.in[12], (bf16_t*)(ws + WS_WDUT));
        prep_lowrank(p.in[14], (bf16_t*)(ws + WS_WIUT));
        SEAM(3);
    }
    if (IN(4)) { gla_pass<true>(p, lds); SEAM(4); }
    if (IN(5)) {
        pg8::Gemm g{(const bf16_t*)(ws + WS_A), (const bf16_t*)(ws + WS_WGOUT), MTOK, DM, DM}; pg8::StaticOrder S; S.init(MTOK, DM, gridDim.x, blockIdx.x);
        pg8::EpiBf16<0> E{(bf16_t*)(ws + WS_Y), DM, nullptr, 0, 0};
        pg8::gemm_phase<pg8::EpiBf16<0>, pg8::StaticOrder>((PG8_LAS unsigned char*)lds, g, S, E);
        SEAM(5);
    }
    if (IN(6)) { phase_norm1(p); zero_bnd_row((bf16_t*)(ws + WS_BND)); SEAM(6); }
    if (IN(7)) {
        pg8::Gemm g{(const bf16_t*)(ws + WS_A), (const bf16_t*)(ws + WS_WRIN), MTOK, RIN_P, DM}; pg8::StaticOrder S; S.init(MTOK, RIN_P, gridDim.x, blockIdx.x);
        EpiBf16Bnd E{(bf16_t*)(ws + WS_P), RIN_P, (bf16_t*)(ws + WS_BND)};
        pg8::gemm_phase<EpiBf16Bnd, pg8::StaticOrder>((PG8_LAS unsigned char*)lds, g, S, E);
        SEAM(7);
    }
    if (IN(8)) { rwkv_r1(p, lds); SEAM(8); }
    if (IN(9)) { rwkv_scan2<1>(p, lds); SEAM(9); }
    if (IN(10)) { rwkv_scan2<2>(p, lds); SEAM(10); }
    if (IN(11)) { rwkv_scan2<3>(p, lds); SEAM(11); }
    if (IN(12)) { rwkv_post(p, lds); SEAM(12); }
    if (IN(13)) {
        pg8::Gemm g{(const bf16_t*)(ws + WS_A), (const bf16_t*)(ws + WS_WROUT), MTOK, DM, DM}; pg8::StaticOrder S; S.init(MTOK, DM, gridDim.x, blockIdx.x);
        pg8::EpiBf16<0> E{(bf16_t*)(ws + WS_Y), DM, nullptr, 0, 0};
        pg8::gemm_phase<pg8::EpiBf16<0>, pg8::StaticOrder>((PG8_LAS unsigned char*)lds, g, S, E);
        SEAM(13);
    }
    if (IN(14)) { phase_final(p); }
#undef IN
#undef SEAM
}

extern "C" void kernel_launch(void* const* d_in, const int* in_sizes, int n_in, void* d_out, int out_size, void* d_ws, size_t ws_size, hipStream_t stream) {
    static int grid = 0;
    if (grid == 0) {
        int dev = 0, cus = 0, per_cu = 0;
        hipGetDevice(&dev);
        hipDeviceGetAttribute(&cus, hipDeviceAttributeMultiprocessorCount, dev);
        hipFuncSetAttribute((const void*)fwd_kernel, hipFuncAttributeMaxDynamicSharedMemorySize, LDS_BYTES + 16);
        hipOccupancyMaxActiveBlocksPerMultiprocessor(&per_cu, (const void*)fwd_kernel, NTH, LDS_BYTES + 16);
        if (per_cu < 1) { fprintf(stderr, "kernel_launch: occupancy query says %d blocks per CU\n", per_cu); per_cu = 1; }
        grid = cus;
        if (n_in != 22 || ws_size < WS_END) fprintf(stderr, "kernel_launch: unexpected n_in %d or workspace %zu < %zu\n", n_in, ws_size, (size_t)WS_END);
        (void)hipGetLastError();
    }
    if (hipMemsetAsync((char*)d_ws + WS_BAR, 0, XCD_BAR_WORDS * 4, stream) != hipSuccess) fprintf(stderr, "kernel_launch: memset of the barrier words failed\n");
    Params p{};
    for (int i = 0; i < 22; ++i) p.in[i] = (const float*)d_in[i];
    p.out = (float*)d_out; p.ws = (unsigned char*)d_ws;
#if N_LAUNCH_MODE == 1
    void* args[] = {&p};
#if PROBE_ID > 0
    p.ph_lo = 0; p.ph_hi = PROBE_ID;
    (void)hipLaunchCooperativeKernel((const void*)fwd_kernel, dim3(grid), dim3(NTH), args, LDS_BYTES + 16, stream);
    (void)hipMemsetAsync((char*)d_ws + WS_BAR, 0, XCD_BAR_WORDS * 4, stream);
#endif
    p.ph_lo = 0; p.ph_hi = N_PHASES;
    hipError_t e = hipLaunchCooperativeKernel((const void*)fwd_kernel, dim3(grid), dim3(NTH), args, LDS_BYTES + 16, stream);
    if (e != hipSuccess) fprintf(stderr, "cooperative launch failed: %s (grid %d)\n", hipGetErrorString(e), grid);
#else
    for (int k = 0; k < N_PHASES; ++k) {
        p.ph_lo = k; p.ph_hi = k + 1;
        hipLaunchKernelGGL(fwd_kernel, dim3(grid), dim3(NTH), LDS_BYTES + 16, stream, p);
    }
#endif
}
```

```cpp
#include <hip/hip_runtime.h>
#include <hip/hip_cooperative_groups.h>
#include <cstdio>
namespace cg = cooperative_groups;
#define PROBE_ID 0
#define N_LAUNCH_MODE 1
namespace pg8 {
#define PG8_LAS __attribute__((address_space(3)))
typedef unsigned short bf16_t;
typedef short bf16x8 __attribute__((ext_vector_type(8)));
typedef float f32x4 __attribute__((ext_vector_type(4)));
typedef unsigned u32x4 __attribute__((ext_vector_type(4)));
constexpr int BM = 256, BK = 64, HALF = 128, HTB = HALF * BK * 2  , STAGE_BYTES = 8 * HTB, NXCD = 8, WGM = 8;

__host__ __device__ __forceinline__ int lds_byte(int r, int c) { const int st = (r >> 4) * 2 + (c >> 5), rr = r & 15, cc = c & 31, ob = rr * 64 + cc * 2; return st * 1024 + (ob ^ (((ob >> 9) & 1) << 5)); }
__host__ __device__ __forceinline__ void stage_rc(int b, int& R, int& C) { const int st = b / 1024, sb = b % 1024, swz = sb ^ (((sb >> 9) & 1) << 5); R = (st >> 1) * 16 + swz / 64; C = (st & 1) * 32 + (swz % 64) / 2; }
__host__ __device__ __forceinline__ int perm32(int rho) { const int n = rho >> 4, i = rho & 15; return 8 * (i >> 2) + 4 * n + (i & 3); }

struct Unit { int pm, pn; };
struct Gemm { const bf16_t* A; const bf16_t* Bt; int M, N, K; };

struct StaticOrder {
    int nM, nN, nwg, G, c;
    __host__ __device__ void init(int M, int N, int G_, int c_) { nM = M / BM; nN = N / BM; nwg = nM * nN; G = G_; c = c_; }
    __host__ __device__ bool next(int i, Unit& u) const {
        const long L = (long)i * G + c; if (L >= nwg) return false;
        int wgid = (int)L; { const int q = nwg / NXCD, r = nwg % NXCD, xcd = wgid % NXCD, off = wgid / NXCD; wgid = (xcd < r ? xcd * (q + 1) : r * (q + 1) + (xcd - r) * q) + off; }
        const int nig = WGM * nN, gid = wgid / nig, fm = gid * WGM, gsz = (nM - fm) < WGM ? (nM - fm) : WGM;
        u.pm = fm + ((wgid % nig) % gsz); u.pn = (wgid % nig) / gsz; return true;
    }
    __device__ __forceinline__ void a_ready(const Unit&) const {}
    __device__ __forceinline__ void done(const Unit&) const {}
};

typedef float cvt_f32x2 __attribute__((ext_vector_type(2)));
typedef __bf16 cvt_bf16x2 __attribute__((ext_vector_type(2)));
__device__ __forceinline__ unsigned cvt_pk_bf16(float lo, float hi) { const cvt_f32x2 v = {lo, hi}; union { cvt_bf16x2 b; unsigned u; } x; x.b = __builtin_convertvector(v, cvt_bf16x2); return x.u; }
typedef float f32x2 __attribute__((ext_vector_type(2)));
struct EpiF32 {
    static constexpr bool PERM = false, AFTER_DRAIN = false, HALF_TAIL = false, ROW_SCALE = false;
    float* C; int ldc; const float* bias;
    __device__ __forceinline__ void operator()(const f32x4 (&acc)[2][2][4][2], const Unit& u, int wr, int wc, int fr, int fq) const {
        const int row0 = u.pm * BM + wr * 64 + fr, col0 = u.pn * BM + wc * 32 + 4 * fq;
        f32x4 bv[2][2];
#pragma unroll
        for (int bj = 0; bj < 2; ++bj)
#pragma unroll
            for (int n = 0; n < 2; ++n) bv[bj][n] = bias ? *(const f32x4*)(bias + col0 + bj * HALF + n * 16) : (f32x4){0.f, 0.f, 0.f, 0.f};
#pragma unroll
        for (int ai = 0; ai < 2; ++ai)
#pragma unroll
            for (int m = 0; m < 4; ++m) { float* rowp = C + (size_t)(row0 + ai * HALF + m * 16) * ldc + col0;
#pragma unroll
                for (int bj = 0; bj < 2; ++bj)
#pragma unroll
                    for (int n = 0; n < 2; ++n) *(f32x4*)(rowp + bj * HALF + n * 16) = acc[ai][bj][m][n] + bv[bj][n]; }
    }
};
template <int ACT  > struct EpiBf16 {
    static constexpr bool PERM = true, AFTER_DRAIN = false, HALF_TAIL = false, ROW_SCALE = false;
    bf16_t* O; int ldc; const float* bias; int split_cols; size_t split_stride;
    __device__ __forceinline__ void operator()(const f32x4 (&acc)[2][2][4][2], const Unit& u, int wr, int wc, int fr, int fq) const {
        const int row0 = u.pm * BM + wr * 64 + fr; int colt = u.pn * BM; bf16_t* base = O;
        if (split_cols) { const int t = colt / split_cols; base += (size_t)t * split_stride; colt -= t * split_cols; }
        const int col0 = colt + wc * 32 + 8 * fq, bcol0 = u.pn * BM + wc * 32 + 8 * fq;
        f32x4 bv[2][2];
#pragma unroll
        for (int bj = 0; bj < 2; ++bj)
#pragma unroll
            for (int n = 0; n < 2; ++n) bv[bj][n] = bias ? *(const f32x4*)(bias + bcol0 + bj * HALF + 4 * n) : (f32x4){0.f, 0.f, 0.f, 0.f};
#pragma unroll
        for (int ai = 0; ai < 2; ++ai)
#pragma unroll
            for (int m = 0; m < 4; ++m) { bf16_t* rowp = base + (size_t)(row0 + ai * HALF + m * 16) * ldc + col0;
#pragma unroll
                for (int bj = 0; bj < 2; ++bj) { f32x4 v0 = acc[ai][bj][m][0] + bv[bj][0], v1 = acc[ai][bj][m][1] + bv[bj][1];
                    u32x4 w; w.x = cvt_pk_bf16(v0[0], v0[1]); w.y = cvt_pk_bf16(v0[2], v0[3]); w.z = cvt_pk_bf16(v1[0], v1[1]); w.w = cvt_pk_bf16(v1[2], v1[3]);
                    *(u32x4*)(rowp + bj * HALF) = w; } }
    }
};

template <class Epi, class Sched>
__device__ __forceinline__ void gemm_phase(PG8_LAS unsigned char* lds, const Gemm g, const Sched& S, const Epi& E) {
    const int tid = threadIdx.x, wid = __builtin_amdgcn_readfirstlane(tid >> 6), lane = tid & 63, wr = wid >> 2, wc = wid & 3, fr = lane & 15, fq = lane >> 4;
    const int K = g.K, nt = K / BK;
    unsigned voffA[2], voffB[2];
#pragma unroll
    for (int i = 0; i < 2; ++i) { int R, C; stage_rc(tid * 16 + i * 8192, R, C); const int Rb = Epi::PERM ? ((R & ~31) + perm32(R & 31)) : R;
        voffA[i] = (unsigned)(R * K + C) * 2u; voffB[i] = (unsigned)(Rb * K + C) * 2u; }
    const size_t kstep = (size_t)(BK * 2);
    const size_t hstep = (size_t)HALF * K * 2;
    const size_t tstep = 2 * hstep;
    const unsigned ldsw = (unsigned)wid * 1024u;
    const int aoff = lds_byte(wr * 64 + fr, fq * 8), boff = lds_byte(wc * 32 + fr, fq * 8);
#define PG8_SA(b, h) (((b) * 2 + (h)) * HTB)
#define PG8_SB(b, h) ((4 + (b) * 2 + (h)) * HTB)
#define PG8_STAGE(bufoff, gbase, voff) do { _Pragma("unroll") for (int _i = 0; _i < 2; ++_i) \
        __builtin_amdgcn_global_load_lds((const unsigned*)((const char*)(gbase) + (voff)[_i]), (PG8_LAS unsigned*)(lds + (bufoff) + ldsw + _i * 8192), 16, 0, 0); } while (0)
#define PG8_LDA(dst, b, h) do { _Pragma("unroll") for (int m = 0; m < 4; ++m) _Pragma("unroll") for (int k = 0; k < 2; ++k) dst[m][k] = *(const PG8_LAS bf16x8*)(lds + PG8_SA(b, h) + aoff + m * 2048 + k * 1024); } while (0)
#define PG8_LDB(dst, b, h) do { _Pragma("unroll") for (int n = 0; n < 2; ++n) _Pragma("unroll") for (int k = 0; k < 2; ++k) dst[n][k] = *(const PG8_LAS bf16x8*)(lds + PG8_SB(b, h) + boff + n * 2048 + k * 1024); } while (0)
#define PG8_MMA(ai, bj, At, Bt) do { __builtin_amdgcn_s_setprio(1); _Pragma("unroll") for (int m = 0; m < 4; ++m) _Pragma("unroll") for (int n = 0; n < 2; ++n) _Pragma("unroll") for (int k = 0; k < 2; ++k) \
        acc[ai][bj][m][n] = __builtin_amdgcn_mfma_f32_16x16x32_bf16(Bt[n][k], At[m][k], acc[ai][bj][m][n], 0, 0, 0); __builtin_amdgcn_s_setprio(0); } while (0)
#define PG8_WAIT_V(n) asm volatile("s_waitcnt vmcnt(" #n ")" ::: "memory")
#define PG8_WAIT_L(n) asm volatile("s_waitcnt lgkmcnt(" #n ")" ::: "memory")
#define PG8_BAR __builtin_amdgcn_s_barrier()
#define PG8_SCHED __builtin_amdgcn_sched_barrier(0)
    Unit cur, nxt; int ui = 0;
    if (!S.next(0, cur)) return;
    f32x4 acc[2][2][4][2];
#pragma unroll
    for (int a = 0; a < 2; ++a)
#pragma unroll
        for (int b = 0; b < 2; ++b)
#pragma unroll
            for (int m = 0; m < 4; ++m)
#pragma unroll
                for (int n = 0; n < 2; ++n) acc[a][b][m][n] = (f32x4){0.f, 0.f, 0.f, 0.f};
    bf16x8 At[4][2], B0[2][2], B1[2][2];
    float rsc[2][4];
#pragma unroll
    for (int a = 0; a < 2; ++a)
#pragma unroll
        for (int m = 0; m < 4; ++m) rsc[a][m] = 1.f;
    const char* cA = (const char*)g.A + (size_t)cur.pm * tstep; const char* cB = (const char*)g.Bt + (size_t)cur.pn * tstep;
    S.a_ready(cur);
    PG8_STAGE(PG8_SB(0, 0), cB, voffB); PG8_STAGE(PG8_SA(0, 0), cA, voffA); PG8_STAGE(PG8_SB(0, 1), cB + hstep, voffB); PG8_STAGE(PG8_SA(0, 1), cA + hstep, voffA);
    if (wr == 1) PG8_BAR;
    PG8_WAIT_V(4); PG8_BAR;
    PG8_STAGE(PG8_SB(1, 0), cB + kstep, voffB); PG8_STAGE(PG8_SA(1, 0), cA + kstep, voffA); PG8_STAGE(PG8_SB(1, 1), cB + hstep + kstep, voffB);
    PG8_WAIT_V(6); PG8_BAR;
    for (;;) {
        const bool has_next = S.next(ui + 1, nxt);
        bool fulln = true; if constexpr (Epi::HALF_TAIL) fulln = (cur.pn != Epi::TAIL_PN);
        const char* nA = has_next ? (const char*)g.A + (size_t)nxt.pm * tstep : cA; const char* nB = has_next ? (const char*)g.Bt + (size_t)nxt.pn * tstep : cB;
        for (int t = 0; t < nt; t += 2) {
            const bool last = (t == nt - 2);
            const char* a1 = cA + (size_t)(t + 1) * kstep;
            const char* a2 = last ? nA : cA + (size_t)(t + 2) * kstep; const char* b2 = last ? nB : cB + (size_t)(t + 2) * kstep;
            const char* a3 = a2 + kstep; const char* b3 = b2 + kstep;
            if (last && has_next) S.a_ready(nxt);
            if constexpr (Epi::ROW_SCALE) { if (last) { E.load_scale(cur, wr, fr, rsc); PG8_SCHED; } }
            PG8_LDB(B0, 0, 0); PG8_SCHED; PG8_LDA(At, 0, 0); PG8_STAGE(PG8_SA(1, 1), a1 + hstep, voffA);
            PG8_WAIT_L(8); PG8_BAR; PG8_WAIT_L(0); PG8_MMA(0, 0, At, B0); PG8_BAR; PG8_SCHED;
            if (fulln) PG8_LDB(B1, 0, 1); PG8_STAGE(PG8_SB(0, 0), b2, voffB);
            PG8_BAR; PG8_WAIT_L(0); if (fulln) PG8_MMA(0, 1, At, B1); PG8_BAR;
            PG8_LDA(At, 0, 1); PG8_STAGE(PG8_SA(0, 0), a2, voffA);
            PG8_BAR; PG8_WAIT_L(0); PG8_MMA(1, 0, At, B0); PG8_BAR; PG8_SCHED;
            PG8_STAGE(PG8_SB(0, 1), b2 + hstep, voffB);
            PG8_WAIT_V(6); PG8_BAR; if (fulln) PG8_MMA(1, 1, At, B1); PG8_BAR;
            PG8_LDB(B0, 1, 0); PG8_SCHED; PG8_LDA(At, 1, 0); PG8_STAGE(PG8_SA(0, 1), a2 + hstep, voffA);
            PG8_WAIT_L(8); PG8_BAR; PG8_WAIT_L(0); PG8_MMA(0, 0, At, B0); PG8_BAR; PG8_SCHED;
            if (fulln) PG8_LDB(B1, 1, 1); PG8_STAGE(PG8_SB(1, 0), b3, voffB);
            PG8_BAR; PG8_WAIT_L(0); if (fulln) PG8_MMA(0, 1, At, B1); PG8_BAR;
            PG8_LDA(At, 1, 1); PG8_STAGE(PG8_SA(1, 0), a3, voffA);
            PG8_BAR; PG8_WAIT_L(0); PG8_MMA(1, 0, At, B0); PG8_BAR; PG8_SCHED;
            PG8_STAGE(PG8_SB(1, 1), b3 + hstep, voffB);
            PG8_WAIT_V(6); PG8_BAR; if (fulln) PG8_MMA(1, 1, At, B1); PG8_BAR;
        }
        if constexpr (!Epi::AFTER_DRAIN) { if constexpr (Epi::ROW_SCALE) E(acc, cur, wr, wc, fr, fq, rsc); else E(acc, cur, wr, wc, fr, fq); S.done(cur); }
        if (!has_next) break;
#pragma unroll
        for (int a = 0; a < 2; ++a)
#pragma unroll
            for (int b = 0; b < 2; ++b)
#pragma unroll
                for (int m = 0; m < 4; ++m)
#pragma unroll
                    for (int n = 0; n < 2; ++n) acc[a][b][m][n] = (f32x4){0.f, 0.f, 0.f, 0.f};
        cur = nxt; cA = nA; cB = nB; ++ui;
    }
    PG8_WAIT_V(0);
    if (wr == 0) PG8_BAR;
    PG8_BAR;
    if constexpr (Epi::AFTER_DRAIN) { E.fused(acc, cur, wr, wc, fr, fq, lds, wid, lane); S.done(cur); }
#undef PG8_SA
#undef PG8_SB
#undef PG8_STAGE
#undef PG8_LDA
#undef PG8_LDB
#undef PG8_MMA
#undef PG8_WAIT_V
#undef PG8_WAIT_L
#undef PG8_BAR
#undef PG8_SCHED
}
}


typedef unsigned short bf16_t;
typedef short bf16x8 __attribute__((ext_vector_type(8)));
typedef float f32x4 __attribute__((ext_vector_type(4)));
typedef unsigned u32x4 __attribute__((ext_vector_type(4)));
typedef unsigned u32x2 __attribute__((ext_vector_type(2)));

constexpr int MTOK = 32768, DM = 1024, SEQ = 16384, NTH = 512;
constexpr int GIN = 3088, GIN_P = 3072, RIN = 4224, RIN_P = 4352;
constexpr int LDS_BYTES = 147456;

constexpr size_t WS_WGIN  = 0;
constexpr size_t WS_WGOUT = WS_WGIN  + (size_t)GIN_P * DM * 2;
constexpr size_t WS_WRIN  = WS_WGOUT + (size_t)DM * DM * 2;
constexpr size_t WS_WROUT = WS_WRIN  + (size_t)RIN_P * DM * 2;
constexpr size_t WS_WDUT  = WS_WROUT + (size_t)DM * DM * 2;
constexpr size_t WS_WIUT  = WS_WDUT  + (size_t)DM * 64 * 2;
constexpr size_t WS_WUPT  = WS_WIUT  + (size_t)DM * 64 * 2;
constexpr size_t WS_A     = WS_WUPT  + (size_t)512 * 16 * 2;
constexpr size_t WS_Y     = WS_A     + (size_t)MTOK * DM * 2;
constexpr size_t WS_GS    = WS_Y     + (size_t)MTOK * DM * 2;
constexpr size_t WS_GD    = WS_GS    + (size_t)24 * 1024 * 1024;
constexpr size_t WS_P     = WS_GD    + (size_t)8 * 32 * 128 * 4;
constexpr size_t WS_BAR   = WS_P     + (size_t)MTOK * RIN_P * 2;
constexpr size_t WS_AD    = WS_BAR   + 16384;
constexpr size_t WS_X1    = WS_AD    + (size_t)MTOK * 16 * 2;
constexpr size_t WS_DUMMY = WS_X1    + (size_t)MTOK * DM * 2;
constexpr size_t WS_RS    = WS_DUMMY + 65536;
constexpr size_t WS_RS0   = WS_RS + (size_t)MTOK * 4;
constexpr size_t WS_END   = WS_RS0 + (size_t)MTOK * 4;
static_assert(WS_END <= (size_t)512 * 1024 * 1024, "workspace budget (4 x the largest tensor)");
constexpr int PB_BLK = 4096, PB_WDAD = 4 * 16 * PB_BLK, PB_CHUNK = PB_WDAD + 64 * 128;
#ifndef PB_MASK
#define PB_MASK 0xA
#endif
static_assert(((PB_MASK >> 0) & 1) == ((PB_MASK >> 2) & 1), "the scans stream arrays 0 and 2 with one row pitch");
__host__ __device__ __forceinline__ constexpr int pb_pitch(int X) { return ((PB_MASK >> X) & 1) ? 1024 : 64; }
__host__ __device__ __forceinline__ constexpr int pb_sub(int X, int h) { return X * 16 * PB_BLK + (((PB_MASK >> X) & 1) ? h * 64 : h * PB_BLK); }
static_assert((size_t)(MTOK / 64) * PB_CHUNK <= (size_t)MTOK * RIN_P, "blocked projection buffer must fit WS_P");

struct Params { const float* in[22]; float* out; unsigned char* ws; int ph_lo, ph_hi; };

__device__ __forceinline__ float bf2f(unsigned b) { return __uint_as_float(b << 16); }
__device__ __forceinline__ bf16_t f2bf(float f) { unsigned u = __float_as_uint(f); u += 0x7FFFu + ((u >> 16) & 1u); return (bf16_t)(u >> 16); }
__device__ __forceinline__ unsigned pk2(float lo, float hi) { return pg8::cvt_pk_bf16(lo, hi); }
__device__ __forceinline__ float wave_sum(float x) {
#pragma unroll
    for (int off = 32; off >= 1; off >>= 1) x += __shfl_xor(x, off);
    return x;
}
__device__ __forceinline__ float bperm(int byte_addr, float x) { return __int_as_float(__builtin_amdgcn_ds_bpermute(byte_addr, __float_as_int(x))); }
template <int CTRL> __device__ __forceinline__ float dpp_mov(float x) { return __int_as_float(__builtin_amdgcn_update_dpp(0, __float_as_int(x), CTRL, 0xF, 0xF, true)); }
__device__ __forceinline__ float sum8(float x) { x += dpp_mov<0xB1>(x); x += dpp_mov<0x4E>(x); x += dpp_mov<0x141>(x); return x; }
__device__ __forceinline__ f32x4 mfma16(bf16x8 a, bf16x8 b, f32x4 c) { return __builtin_amdgcn_mfma_f32_16x16x32_bf16(a, b, c, 0, 0, 0); }
__device__ __forceinline__ bf16x8 as_bf16x8(u32x4 v) { union { u32x4 u; bf16x8 b; } x; x.u = v; return x.b; }
__device__ __forceinline__ float fexp(float x) { return __builtin_amdgcn_exp2f(x * 1.4426950408889634f); }
__device__ __forceinline__ float flog(float x) { return __builtin_amdgcn_logf(x) * 0.6931471805599453f; }
__device__ __forceinline__ float log_sigmoid(float z) { return fminf(z, 0.f) - log1pf(fexp(-fabsf(z))); }
__device__ __forceinline__ float softplus(float z) { return fmaxf(z, 0.f) + log1pf(fexp(-fabsf(z))); }

__device__ void prep_weight(const float* __restrict__ W, int N, const float* __restrict__ gain, bf16_t* __restrict__ Wt, int NP, float* tile) {
    const int tid = threadIdx.x;
    const int nu = (NP / 64) * 16;
    const int lk = tid >> 4, lq = tid & 15;
    const int sn = tid >> 3, ss = tid & 7;
    float4 v[2];
#define PW_LOAD(u_) do { const int n0_ = ((u_) >> 4) * 64, k0_ = ((u_) & 15) * 64; _Pragma("unroll") for (int r = 0; r < 2; ++r) { const int k = k0_ + lk + 32 * r, n = n0_ + 4 * lq; \
        float4 x_ = make_float4(0.f, 0.f, 0.f, 0.f); if (n < N) { x_ = *(const float4*)(W + (size_t)k * N + n); if (gain) { const float g_ = gain[k]; x_.x *= g_; x_.y *= g_; x_.z *= g_; x_.w *= g_; } } v[r] = x_; } } while (0)
    int u = blockIdx.x;
    if (u < nu) PW_LOAD(u);
    for (; u < nu; u += gridDim.x) {
        const int n0 = (u >> 4) * 64, k0 = (u & 15) * 64;
#pragma unroll
        for (int r = 0; r < 2; ++r) *(float4*)(tile + (lk + 32 * r) * 68 + 4 * lq) = v[r];
        if (u + (int)gridDim.x < nu) PW_LOAD(u + gridDim.x);
        __syncthreads();
        {
            float e[8];
#pragma unroll
            for (int q = 0; q < 8; ++q) e[q] = tile[(8 * ss + q) * 68 + sn];
            *(u32x4*)(Wt + (size_t)(n0 + sn) * DM + k0 + 8 * ss) = (u32x4){pk2(e[0], e[1]), pk2(e[2], e[3]), pk2(e[4], e[5]), pk2(e[6], e[7])};
        }
        __syncthreads();
    }
#undef PW_LOAD
}

__device__ void prep_lowrank(const float* __restrict__ src, bf16_t* __restrict__ dst) {
    for (int idx = blockIdx.x * NTH + threadIdx.x; idx < 65536; idx += gridDim.x * NTH) dst[idx] = f2bf(src[(idx & 63) * 1024 + (idx >> 6)]);
}

__device__ void zero_bnd_row(bf16_t* bnd) {
    if (blockIdx.x == 0) for (int i = threadIdx.x; i < RIN_P / 2; i += NTH) ((unsigned*)bnd)[i] = 0u;
}

__device__ void prep_wup(const float* __restrict__ src, bf16_t* __restrict__ dst) {
    for (int idx = blockIdx.x * NTH + threadIdx.x; idx < 8192; idx += gridDim.x * NTH) dst[idx] = f2bf(src[(idx & 15) * 512 + (idx >> 4)]);
}

struct EpiBf16GateSilu {
    static constexpr bool PERM = true, AFTER_DRAIN = false, HALF_TAIL = false, ROW_SCALE = false;
    bf16_t* O; int ldc;
    __device__ __forceinline__ void operator()(const f32x4 (&acc)[2][2][4][2], const pg8::Unit& u, int wr, int wc, int fr, int fq) const {
        const int row0 = u.pm * pg8::BM + wr * 64 + fr, col0 = u.pn * pg8::BM + wc * 32 + 8 * fq;
        const bool act = u.pn >= 8;
#pragma unroll
        for (int ai = 0; ai < 2; ++ai)
#pragma unroll
            for (int m = 0; m < 4; ++m) {
                bf16_t* rowp = O + (size_t)(row0 + ai * pg8::HALF + m * 16) * ldc + col0;
#pragma unroll
                for (int bj = 0; bj < 2; ++bj) {
                    f32x4 v0 = acc[ai][bj][m][0], v1 = acc[ai][bj][m][1];
                    if (act) {
#pragma unroll
                        for (int j = 0; j < 4; ++j) { v0[j] *= __builtin_amdgcn_rcpf(1.0f + fexp(-v0[j])); v1[j] *= __builtin_amdgcn_rcpf(1.0f + fexp(-v1[j])); }
                    }
                    u32x4 wv; wv.x = pk2(v0[0], v0[1]); wv.y = pk2(v0[2], v0[3]); wv.z = pk2(v1[0], v1[1]); wv.w = pk2(v1[2], v1[3]);
                    *(u32x4*)(rowp + bj * pg8::HALF) = wv;
                }
            }
    }
};

struct EpiBf16Bnd {
    static constexpr bool PERM = true, AFTER_DRAIN = false, HALF_TAIL = true, ROW_SCALE = true; static constexpr int TAIL_PN = 16;
    bf16_t* O; int ldc; bf16_t* bnd; const float* rs;
    __device__ __forceinline__ void load_scale(const pg8::Unit& u, int wr, int fr, float (&sc)[2][4]) const {
#pragma unroll
        for (int ai = 0; ai < 2; ++ai)
#pragma unroll
            for (int m = 0; m < 4; ++m) sc[ai][m] = rs[u.pm * pg8::BM + wr * 64 + fr + ai * pg8::HALF + m * 16];
    }
    __device__ __forceinline__ void operator()(const f32x4 (&acc)[2][2][4][2], const pg8::Unit& u, int wr, int wc, int fr, int fq, const float (&sc)[2][4]) const {
        const int row0 = u.pm * pg8::BM + wr * 64 + fr, col0 = u.pn * pg8::BM + wc * 32 + 8 * fq;
#pragma unroll
        for (int ai = 0; ai < 2; ++ai)
#pragma unroll
            for (int m = 0; m < 4; ++m) {
                const int row = row0 + ai * pg8::HALF + m * 16;
                bf16_t* cb = O + (size_t)(row >> 6) * PB_CHUNK;
#pragma unroll
                for (int bj = 0; bj < 2; ++bj) {
                    const f32x4 v0 = acc[ai][bj][m][0] * sc[ai][m], v1 = acc[ai][bj][m][1] * sc[ai][m];
                    u32x4 wv; wv.x = pk2(v0[0], v0[1]); wv.y = pk2(v0[2], v0[3]); wv.z = pk2(v1[0], v1[1]); wv.w = pk2(v1[2], v1[3]);
                    if (u.pn < 16) *(u32x4*)(cb + pb_sub(u.pn >> 2, (u.pn & 3) * 4 + bj * 2 + (wc >> 1)) + (row & 63) * pb_pitch(u.pn >> 2) + (wc & 1) * 32 + 8 * fq) = wv;
                    else if (bj == 0) *(u32x4*)(cb + PB_WDAD + (row & 63) * 128 + wc * 32 + 8 * fq) = wv;
                    if (m == 3 && fr == 15) *(u32x4*)(bnd + (size_t)((row >> 6) + 1) * ldc + col0 + bj * pg8::HALF) = wv;
                }
            }
    }
};

struct TailOrder : pg8::StaticOrder {
    __device__ bool next(int i, pg8::Unit& u) const {
        const long L = (long)i * G + c;
        if (L < nwg) return pg8::StaticOrder::next(i, u);
        if (L - nwg < nM) { u.pm = (int)(L - nwg); u.pn = nN; return true; }
        return false;
    }
};

__device__ void phase_norm0(const Params& p, unsigned char* lds) {
    const int tid = threadIdx.x, lane = tid & 63, w = tid >> 6, l15 = lane & 15, g = lane >> 4;
    const float* x = p.in[0];
    bf16_t* A = (bf16_t*)(p.ws + WS_A);
    bf16_t* AD = (bf16_t*)(p.ws + WS_AD);
    bf16_t* WAD = (bf16_t*)lds;
    float* PSS = (float*)(lds + 33024);
    float* PAD = (float*)(lds + 33024 + 512);
    for (int e = tid; e < 16384; e += NTH) { const int k = e >> 4, j = e & 15; WAD[j * 1032 + k] = f2bf(p.in[2][(size_t)k * GIN + 3072 + j] * p.in[1][k]); }
    __syncthreads();
    bf16x8 wf[4];
#pragma unroll
    for (int kk = 0; kk < 4; ++kk) wf[kk] = *(const bf16x8*)(WAD + l15 * 1032 + 128 * w + 32 * kk + 8 * g);
    float4 xa[4][2];
    int tile = blockIdx.x;
    if (tile < MTOK / 16) {
#pragma unroll
        for (int kk = 0; kk < 4; ++kk) { const float4* s = (const float4*)(x + (size_t)(16 * tile + l15) * DM + 128 * w + 32 * kk + 8 * g); xa[kk][0] = s[0]; xa[kk][1] = s[1]; }
    }
    for (; tile < MTOK / 16; tile += gridDim.x) {
        float4 xv[4][2];
#pragma unroll
        for (int kk = 0; kk < 4; ++kk) { xv[kk][0] = xa[kk][0]; xv[kk][1] = xa[kk][1]; }
        if (tile + (int)gridDim.x < MTOK / 16) {
#pragma unroll
            for (int kk = 0; kk < 4; ++kk) { const float4* s = (const float4*)(x + (size_t)(16 * (tile + gridDim.x) + l15) * DM + 128 * w + 32 * kk + 8 * g); xa[kk][0] = s[0]; xa[kk][1] = s[1]; }
        }
        float ss = 0.f;
        f32x4 acc = (f32x4){0.f, 0.f, 0.f, 0.f};
#pragma unroll
        for (int kk = 0; kk < 4; ++kk) {
            const float4 a = xv[kk][0], b = xv[kk][1];
            ss += a.x * a.x + a.y * a.y + a.z * a.z + a.w * a.w + b.x * b.x + b.y * b.y + b.z * b.z + b.w * b.w;
            acc = mfma16(as_bf16x8((u32x4){pk2(a.x, a.y), pk2(a.z, a.w), pk2(b.x, b.y), pk2(b.z, b.w)}), wf[kk], acc);
        }
        ss += __shfl_xor(ss, 16); ss += __shfl_xor(ss, 32);
        if (g == 0) PSS[w * 16 + l15] = ss;
        *(f32x4*)(PAD + (w * 64 + lane) * 4) = acc;
        __syncthreads();
        float tot = 0.f;
#pragma unroll
        for (int q = 0; q < 8; ++q) tot += PSS[q * 16 + l15];
        const float rstd = rsqrtf(tot * (1.0f / DM) + 1e-6f);
        if (w == 0 && g == 0) ((float*)(p.ws + WS_RS0))[16 * tile + l15] = sqrtf(tot * (1.0f / DM) + 1e-6f);
#pragma unroll
        for (int kk = 0; kk < 4; ++kk) {
            const float4 a = xv[kk][0], b = xv[kk][1];
            *(u32x4*)(A + (size_t)(16 * tile + l15) * DM + 128 * w + 32 * kk + 8 * g) = (u32x4){pk2(a.x * rstd, a.y * rstd), pk2(a.z * rstd, a.w * rstd), pk2(b.x * rstd, b.y * rstd), pk2(b.z * rstd, b.w * rstd)};
        }
        if (w == 0) {
            f32x4 s = (f32x4){0.f, 0.f, 0.f, 0.f};
#pragma unroll
            for (int q = 0; q < 8; ++q) s += *(const f32x4*)(PAD + (q * 64 + lane) * 4);
#pragma unroll
            for (int r = 0; r < 4; ++r) AD[(size_t)(16 * tile + 4 * g + r) * 16 + l15] = f2bf(s[r] * __shfl(rstd, 4 * g + r));
        }
        __syncthreads();
    }
}

__device__ void phase_norm1(const Params& p) {
    const int tid = threadIdx.x, lane = tid & 63, w = tid >> 6;
    const bf16_t* H0 = (const bf16_t*)(p.ws + WS_A);
    const float* RS0 = (const float*)(p.ws + WS_RS0);
    const float* gpost = p.in[7];
    const bf16_t* Y = (const bf16_t*)(p.ws + WS_Y);
    bf16_t* X1 = (bf16_t*)(p.ws + WS_X1);
    f32x4 gp[2][2];
#pragma unroll
    for (int i = 0; i < 2; ++i) { gp[i][0] = *(const f32x4*)(gpost + 8 * (lane + 64 * i)); gp[i][1] = *(const f32x4*)(gpost + 8 * (lane + 64 * i) + 4); }
    const int stride = gridDim.x * 8;
    u32x4 hn[2], yn[2]; float sn;
    {
        const int row = blockIdx.x * 8 + w;
        sn = RS0[row];
#pragma unroll
        for (int i = 0; i < 2; ++i) { hn[i] = *(const u32x4*)(H0 + (size_t)row * DM + 8 * (lane + 64 * i)); yn[i] = *(const u32x4*)(Y + (size_t)row * DM + 8 * (lane + 64 * i)); }
    }
    for (int row = blockIdx.x * 8 + w; row < MTOK; row += stride) {
        f32x4 v[2][2], y[2][2];
        const float s0 = sn;
#pragma unroll
        for (int i = 0; i < 2; ++i) {
            v[i][0] = (f32x4){bf2f(hn[i].x & 0xffffu), bf2f(hn[i].x >> 16), bf2f(hn[i].y & 0xffffu), bf2f(hn[i].y >> 16)} * s0;
            v[i][1] = (f32x4){bf2f(hn[i].z & 0xffffu), bf2f(hn[i].z >> 16), bf2f(hn[i].w & 0xffffu), bf2f(hn[i].w >> 16)} * s0;
            y[i][0] = (f32x4){bf2f(yn[i].x & 0xffffu), bf2f(yn[i].x >> 16), bf2f(yn[i].y & 0xffffu), bf2f(yn[i].y >> 16)};
            y[i][1] = (f32x4){bf2f(yn[i].z & 0xffffu), bf2f(yn[i].z >> 16), bf2f(yn[i].w & 0xffffu), bf2f(yn[i].w >> 16)};
        }
        if (row + stride < MTOK) {
            sn = RS0[row + stride];
#pragma unroll
            for (int i = 0; i < 2; ++i) { hn[i] = *(const u32x4*)(H0 + (size_t)(row + stride) * DM + 8 * (lane + 64 * i)); yn[i] = *(const u32x4*)(Y + (size_t)(row + stride) * DM + 8 * (lane + 64 * i)); }
        }
        float ss = 0.f;
#pragma unroll
        for (int i = 0; i < 2; ++i)
#pragma unroll
            for (int q = 0; q < 2; ++q)
#pragma unroll
                for (int j = 0; j < 4; ++j) ss += y[i][q][j] * y[i][q][j];
        ss = wave_sum(ss);
        const float rstdy = rsqrtf(ss * (1.0f / DM) + 1e-6f);
        float s1 = 0.f;
#pragma unroll
        for (int i = 0; i < 2; ++i) {
#pragma unroll
            for (int q = 0; q < 2; ++q) {
                v[i][q] += y[i][q] * rstdy * gp[i][q];
#pragma unroll
                for (int j = 0; j < 4; ++j) s1 += v[i][q][j] * v[i][q][j];
            }
            u32x4 xo; xo.x = pk2(v[i][0][0], v[i][0][1]); xo.y = pk2(v[i][0][2], v[i][0][3]); xo.z = pk2(v[i][1][0], v[i][1][1]); xo.w = pk2(v[i][1][2], v[i][1][3]);
            *(u32x4*)(X1 + (size_t)row * DM + 8 * (lane + 64 * i)) = xo;
        }
        s1 = wave_sum(s1);
        if (lane == 0) ((float*)(p.ws + WS_RS))[row] = rsqrtf(s1 * (1.0f / DM) + 1e-6f);
    }
}

__device__ void phase_final(const Params& p) {
    const int tid = threadIdx.x, lane = tid & 63, w = tid >> 6;
    const float* gpost = p.in[21];
    const bf16_t* Y = (const bf16_t*)(p.ws + WS_Y);
    const bf16_t* X1 = (const bf16_t*)(p.ws + WS_X1);
    f32x4 gp[2][2];
#pragma unroll
    for (int i = 0; i < 2; ++i) { gp[i][0] = *(const f32x4*)(gpost + 8 * (lane + 64 * i)); gp[i][1] = *(const f32x4*)(gpost + 8 * (lane + 64 * i) + 4); }
    const int stride = gridDim.x * 8;
    u32x4 xn[2], yn[2];
    {
        const int row = blockIdx.x * 8 + w;
#pragma unroll
        for (int i = 0; i < 2; ++i) { xn[i] = *(const u32x4*)(X1 + (size_t)row * DM + 8 * (lane + 64 * i)); yn[i] = *(const u32x4*)(Y + (size_t)row * DM + 8 * (lane + 64 * i)); }
    }
    for (int row = blockIdx.x * 8 + w; row < MTOK; row += stride) {
        f32x4 xv[2][2], y[2][2];
#pragma unroll
        for (int i = 0; i < 2; ++i) {
            xv[i][0] = (f32x4){bf2f(xn[i].x & 0xffffu), bf2f(xn[i].x >> 16), bf2f(xn[i].y & 0xffffu), bf2f(xn[i].y >> 16)};
            xv[i][1] = (f32x4){bf2f(xn[i].z & 0xffffu), bf2f(xn[i].z >> 16), bf2f(xn[i].w & 0xffffu), bf2f(xn[i].w >> 16)};
            y[i][0] = (f32x4){bf2f(yn[i].x & 0xffffu), bf2f(yn[i].x >> 16), bf2f(yn[i].y & 0xffffu), bf2f(yn[i].y >> 16)};
            y[i][1] = (f32x4){bf2f(yn[i].z & 0xffffu), bf2f(yn[i].z >> 16), bf2f(yn[i].w & 0xffffu), bf2f(yn[i].w >> 16)};
        }
        if (row + stride < MTOK) {
#pragma unroll
            for (int i = 0; i < 2; ++i) { xn[i] = *(const u32x4*)(X1 + (size_t)(row + stride) * DM + 8 * (lane + 64 * i)); yn[i] = *(const u32x4*)(Y + (size_t)(row + stride) * DM + 8 * (lane + 64 * i)); }
        }
        float ss = 0.f;
#pragma unroll
        for (int i = 0; i < 2; ++i)
#pragma unroll
            for (int q = 0; q < 2; ++q)
#pragma unroll
                for (int j = 0; j < 4; ++j) ss += y[i][q][j] * y[i][q][j];
        ss = wave_sum(ss);
        const float rstdy = rsqrtf(ss * (1.0f / DM) + 1e-6f);
#pragma unroll
        for (int i = 0; i < 2; ++i)
#pragma unroll
            for (int q = 0; q < 2; ++q) *(f32x4*)(p.out + (size_t)row * DM + 8 * (lane + 64 * i) + 4 * q) = xv[i][q] + y[i][q] * rstdy * gp[i][q];
    }
}

constexpr int L_BC = 0, L_ATT = 0, L_QD = 33792, L_KD = L_QD + 64 * 136 * 2, L_KTE = L_KD + 64 * 136 * 2, L_VI = L_KTE + 64 * 152 * 2, L_SSQ = L_VI + 64 * 280 * 2, L_BL = L_SSQ + 2048, L_DEC = L_BL + 512, L_ADL = L_DEC + 512,
              L_GLA_END = L_ADL + 2048;
static_assert(L_GLA_END <= LDS_BYTES, "GLA LDS");
#define GLA_BARRIER() do { asm volatile("s_waitcnt lgkmcnt(0)" ::: "memory"); __builtin_amdgcn_s_barrier(); asm volatile("" ::: "memory"); } while (0)
typedef short gs16x4 __attribute__((ext_vector_type(4)));
__device__ __forceinline__ u32x2 g_trread(const bf16_t* p) { union { gs16x4 s; u32x2 u; } x; x.s = __builtin_amdgcn_ds_read_tr16_b64_v4i16((__attribute__((address_space(3))) gs16x4*)p); return x.u; }
template <int PITCH> __device__ __forceinline__ bf16x8 g_trfrag(const bf16_t* img, int k0, int c0, int g, int q, int pq) {
    const bf16_t* a = img + (k0 + 8 * g + q) * PITCH + c0 + 4 * pq;
    const u32x2 lo = g_trread(a), hi = g_trread(a + 4 * PITCH);
    return as_bf16x8((u32x4){lo.x, lo.y, hi.x, hi.y});
}
__device__ __forceinline__ f32x4 g_lo4(u32x4 v) { return (f32x4){bf2f(v.x & 0xffffu), bf2f(v.x >> 16), bf2f(v.y & 0xffffu), bf2f(v.y >> 16)}; }
__device__ __forceinline__ f32x4 g_hi4(u32x4 v) { return (f32x4){bf2f(v.z & 0xffffu), bf2f(v.z >> 16), bf2f(v.w & 0xffffu), bf2f(v.w >> 16)}; }
__device__ __forceinline__ u32x2 g_pk4(f32x4 v) { u32x2 r; r.x = pk2(v[0], v[1]); r.y = pk2(v[2], v[3]); return r; }
__device__ __forceinline__ f32x4 g_unpk4(u32x2 v) { return (f32x4){bf2f(v.x & 0xffffu), bf2f(v.x >> 16), bf2f(v.y & 0xffffu), bf2f(v.y >> 16)}; }

template <bool OUT> struct GlaRaw { u32x4 q[2], k[2], v[4]; };
template <bool OUT> __device__ __forceinline__ void gla_issue(GlaRaw<OUT>& x, const char* cb  , unsigned offQ, unsigned offV) {
    if (OUT) { x.q[0] = *(const u32x4*)(cb + offQ); x.q[1] = *(const u32x4*)(cb + offQ + 16); }
    x.k[0] = *(const u32x4*)(cb + offQ + 1024); x.k[1] = *(const u32x4*)(cb + offQ + 1040);
#pragma unroll
    for (int i = 0; i < 4; ++i) x.v[i] = *(const u32x4*)(cb + offV + 16 * i);
}

template <bool OUT>
__device__ void gla_pass(const Params& p, unsigned char* lds) {
    const int tid = threadIdx.x, w = __builtin_amdgcn_readfirstlane(tid >> 6);
    const bf16_t* P = (const bf16_t*)(p.ws + WS_P);
    bf16_t* GS = (bf16_t*)(p.ws + WS_GS);
    float* GD = (float*)(p.ws + WS_GD);
    bf16_t* Aout = (bf16_t*)(p.ws + WS_X1);
    const bf16_t* WupT = (const bf16_t*)(p.ws + WS_WUPT);
    const bf16_t* ADG = (const bf16_t*)(p.ws + WS_AD);
    float* BC = (float*)(lds + L_BC); bf16_t* ATT = (bf16_t*)(lds + L_ATT); bf16_t* QD = (bf16_t*)(lds + L_QD); bf16_t* KD = (bf16_t*)(lds + L_KD); bf16_t* KTE = (bf16_t*)(lds + L_KTE);
    bf16_t* VI = (bf16_t*)(lds + L_VI); float* SSQ = (float*)(lds + L_SSQ); float* BL = (float*)(lds + L_BL); float* DEC = (float*)(lds + L_DEC); bf16_t* ADL = (bf16_t*)(lds + L_ADL);
    const float* b_al = p.in[4]; const float* g_head = p.in[5];

    for (int unit = blockIdx.x; unit < 256; unit += gridDim.x) {
        const int bh = unit >> 5, m = unit & 31, b = bh >> 2, h = bh & 3;
        int tidv = tid; asm volatile("" : "+v"(tidv));
        const int lane = tidv & 63, l15 = lane & 15, g = lane >> 4, q4 = l15 >> 2, p4 = l15 & 3;
        const int c = tidv >> 3, seg = tidv & 7;
        const int tokbase = b * SEQ + m * 512;
        u32x4 wupq = *(const u32x4*)(WupT + (size_t)(h * 128 + 16 * w + l15) * 16 + 8 * (g & 1));
        if (g >= 2) wupq = (u32x4){0u, 0u, 0u, 0u};
        const bf16x8 wupf = as_bf16x8(wupq);
        const float bA = b_al[h * 128 + 16 * w + l15];
        f32x4 gh[2];
#pragma unroll
        for (int vt = 0; vt < 2; ++vt) gh[vt] = *(const f32x4*)(g_head + 32 * w + 16 * vt + 4 * g);
        float logD = 0.f;
        f32x4 S[8][2];
#pragma unroll
        for (int mt = 0; mt < 8; ++mt)
#pragma unroll
            for (int vt = 0; vt < 2; ++vt) {
                if (OUT) S[mt][vt] = g_unpk4(*(const u32x2*)(GS + ((size_t)(bh * 32 + m) * 256 + 32 * w + 16 * vt + l15) * 128 + 16 * mt + 4 * g));
                else S[mt][vt] = (f32x4){0.f, 0.f, 0.f, 0.f};
            }
        const unsigned offQ = (unsigned)((c * GIN_P + h * 128 + 16 * seg) * 2), offV = (unsigned)((c * GIN_P + 1024 + h * 256 + 32 * seg) * 2), offAD = (unsigned)(tid * 16);
        const unsigned offG = (unsigned)((l15 * GIN_P + 2048 + h * 256 + 32 * w + 4 * g) * 2), offO = (unsigned)((l15 * DM + h * 256 + 32 * w + 4 * g) * 2);
        GlaRaw<OUT> raw;
        gla_issue<OUT>(raw, (const char*)P + (size_t)tokbase * GIN_P * 2, offQ, offV);
        if (tid < 128) *(u32x4*)(ADL + tid * 8) = *(const u32x4*)((const char*)ADG + (size_t)tokbase * 32 + offAD);
        GLA_BARRIER();

        for (int ch = 0; ch < 8; ++ch) {
            const int tok0 = tokbase + ch * 64;
            u32x4 adn = (u32x4){0u, 0u, 0u, 0u};
            {
                if (ch < 7 && tid < 128) adn = *(const u32x4*)((const char*)ADG + (size_t)(tok0 + 64) * 32 + offAD);
                f32x4 sc[4]; float xinc[4], tot[4];
#pragma unroll
                for (int ct = 0; ct < 4; ++ct) {
                    u32x4 aq = *(const u32x4*)(ADL + (16 * ct + l15) * 16 + 8 * (g & 1));
                    if (g >= 2) aq = (u32x4){0u, 0u, 0u, 0u};
                    const f32x4 z = mfma16(as_bf16x8(aq), wupf, (f32x4){bA, bA, bA, bA});
                    float acc = 0.f;
#pragma unroll
                    for (int r = 0; r < 4; ++r) { acc += (fminf(z[r], 0.f) - flog(1.f + fexp(-fabsf(z[r])))) * (1.0f / 16.0f); sc[ct][r] = acc; }
                    xinc[ct] = acc;
                }
#pragma unroll
                for (int ct = 0; ct < 4; ++ct) xinc[ct] += (g >= 1 ? 1.f : 0.f) * bperm(((lane - 16) & 63) * 4, xinc[ct]);
#pragma unroll
                for (int ct = 0; ct < 4; ++ct) xinc[ct] += (g >= 2 ? 1.f : 0.f) * bperm(((lane - 32) & 63) * 4, xinc[ct]);
#pragma unroll
                for (int ct = 0; ct < 4; ++ct) tot[ct] = bperm((48 + l15) * 4, xinc[ct]);
                float run = 0.f;
#pragma unroll
                for (int ct = 0; ct < 4; ++ct) {
                    const float base = run + (xinc[ct] - sc[ct][3]);
                    run += tot[ct];
#pragma unroll
                    for (int r = 0; r < 4; ++r) BC[(16 * ct + 4 * g + r) * 132 + 16 * w + l15] = base + sc[ct][r];
                }
                if (g == 0) { BL[16 * w + l15] = run; DEC[16 * w + l15] = fexp(run); }
                if (!OUT) logD += run;
            }
            GLA_BARRIER();
            u32x2 gate[2][4];
            {
#pragma unroll
                for (int hh = 0; hh < 2; ++hh) {
                    const int o8 = 16 * seg + 8 * hh;
                    const f32x4 bb[2] = {*(const f32x4*)(BC + c * 132 + o8), *(const f32x4*)(BC + c * 132 + o8 + 4)};
                    const f32x4 dc[2] = {*(const f32x4*)((OUT ? DEC : BL) + o8), *(const f32x4*)((OUT ? DEC : BL) + o8 + 4)};
                    const f32x4 kx[2] = {g_lo4(raw.k[hh]), g_hi4(raw.k[hh])};
                    f32x4 qx[2];
                    if (OUT) { qx[0] = g_lo4(raw.q[hh]); qx[1] = g_hi4(raw.q[hh]); }
                    f32x4 kd[2], kt[2], qd[2];
#pragma unroll
                    for (int i = 0; i < 2; ++i)
#pragma unroll
                        for (int j = 0; j < 4; ++j) {
                            if (OUT) {
                                const float eB = fexp(bb[i][j]), enB = __builtin_amdgcn_rcpf(eB);
                                kd[i][j] = kx[i][j] * enB; kt[i][j] = kd[i][j] * dc[i][j];
                                qd[i][j] = qx[i][j] * 0.08838834764831845f * eB;
                            } else kt[i][j] = kx[i][j] * fexp(dc[i][j] - bb[i][j]);
                        }
                    *(u32x4*)(KTE + c * 152 + o8) = (u32x4){pk2(kt[0][0], kt[0][1]), pk2(kt[0][2], kt[0][3]), pk2(kt[1][0], kt[1][1]), pk2(kt[1][2], kt[1][3])};
                    if (OUT) {
                        *(u32x4*)(KD + c * 136 + o8) = (u32x4){pk2(kd[0][0], kd[0][1]), pk2(kd[0][2], kd[0][3]), pk2(kd[1][0], kd[1][1]), pk2(kd[1][2], kd[1][3])};
                        *(u32x4*)(QD + c * 136 + o8) = (u32x4){pk2(qd[0][0], qd[0][1]), pk2(qd[0][2], qd[0][3]), pk2(qd[1][0], qd[1][1]), pk2(qd[1][2], qd[1][3])};
                    }
                }
#pragma unroll
                for (int i = 0; i < 4; ++i) *(u32x4*)(VI + c * 280 + 32 * seg + 8 * i) = raw.v[i];
                if (OUT) {
#pragma unroll
                    for (int vt = 0; vt < 2; ++vt)
#pragma unroll
                        for (int ct = 0; ct < 4; ++ct) gate[vt][ct] = *(const u32x2*)((const char*)P + (size_t)(tok0 + 16 * ct) * GIN_P * 2 + offG + 32 * vt);
                }
                if (ch < 7) gla_issue<OUT>(raw, (const char*)P + (size_t)(tok0 + 64) * GIN_P * 2, offQ, offV);
                if (ch < 7 && tid < 128) *(u32x4*)(ADL + tid * 8) = adn;
            }
            GLA_BARRIER();
            f32x4 o[2][4];
            if (OUT) {
#pragma unroll
                for (int t2 = 0; t2 < 2; ++t2) {
                    const int tl = 2 * w + t2, ct = tl >> 2, st = tl & 3;
                    f32x4 acc = (f32x4){0.f, 0.f, 0.f, 0.f};
                    if (st <= ct) {
#pragma unroll
                        for (int kk = 0; kk < 4; ++kk) {
                            const bf16x8 a = *(const bf16x8*)(KD + (16 * st + l15) * 136 + 32 * kk + 8 * g);
                            const bf16x8 bq = *(const bf16x8*)(QD + (16 * ct + l15) * 136 + 32 * kk + 8 * g);
                            acc = mfma16(a, bq, acc);
                        }
#pragma unroll
                        for (int r = 0; r < 4; ++r) if (16 * st + 4 * g + r > 16 * ct + l15) acc[r] = 0.f;
                    }
                    *(u32x2*)(ATT + (16 * ct + l15) * 72 + 16 * st + 4 * g) = g_pk4(acc);
                }
                GLA_BARRIER();
#pragma unroll
                for (int vt = 0; vt < 2; ++vt)
#pragma unroll
                    for (int ct = 0; ct < 4; ++ct) o[vt][ct] = (f32x4){0.f, 0.f, 0.f, 0.f};
#pragma unroll
                for (int kk = 0; kk < 4; ++kk) {
                    bf16x8 sa[2];
#pragma unroll
                    for (int vt = 0; vt < 2; ++vt) { const u32x2 s0 = g_pk4(S[2 * kk][vt]), s1 = g_pk4(S[2 * kk + 1][vt]); sa[vt] = as_bf16x8((u32x4){s0.x, s0.y, s1.x, s1.y}); }
#pragma unroll
                    for (int ct = 0; ct < 4; ++ct) {
                        const bf16_t* qr = QD + (16 * ct + l15) * 136 + 32 * kk + 4 * g;
                        const u32x2 lo = *(const u32x2*)qr, hi = *(const u32x2*)(qr + 16);
                        const bf16x8 bq = as_bf16x8((u32x4){lo.x, lo.y, hi.x, hi.y});
#pragma unroll
                        for (int vt = 0; vt < 2; ++vt) o[vt][ct] = mfma16(sa[vt], bq, o[vt][ct]);
                    }
                }
            }
            bf16x8 bv[2][2];
#pragma unroll
            for (int vt = 0; vt < 2; ++vt)
#pragma unroll
                for (int kk = 0; kk < 2; ++kk) bv[vt][kk] = g_trfrag<280>(VI, 32 * kk, 32 * w + 16 * vt, g, q4, p4);
            if (OUT) {
#pragma unroll
                for (int ct = 0; ct < 4; ++ct)
#pragma unroll
                    for (int kk = 0; kk < 2; ++kk) {
                        if (32 * kk <= 16 * ct + 15) {
                            const bf16x8 bq = *(const bf16x8*)(ATT + (16 * ct + l15) * 72 + 32 * kk + 8 * g);
#pragma unroll
                            for (int vt = 0; vt < 2; ++vt) o[vt][ct] = mfma16(bv[vt][kk], bq, o[vt][ct]);
                        }
                    }
            }
#pragma unroll
            for (int mt = 0; mt < 8; ++mt) {
                const f32x4 dv = *(const f32x4*)(DEC + 16 * mt + 4 * g);
#pragma unroll
                for (int vt = 0; vt < 2; ++vt) S[mt][vt] *= dv;
#pragma unroll
                for (int kk = 0; kk < 2; ++kk) {
                    const bf16x8 a = g_trfrag<152>(KTE, 32 * kk, 16 * mt, g, q4, p4);
#pragma unroll
                    for (int vt = 0; vt < 2; ++vt) S[mt][vt] = mfma16(a, bv[vt][kk], S[mt][vt]);
                }
            }
            if (OUT) {
                float ss[4];
#pragma unroll
                for (int ct = 0; ct < 4; ++ct) {
                    float s = 0.f;
#pragma unroll
                    for (int vt = 0; vt < 2; ++vt)
#pragma unroll
                        for (int r = 0; r < 4; ++r) s += o[vt][ct][r] * o[vt][ct][r];
                    s += bperm((lane ^ 16) * 4, s); s += bperm((lane ^ 32) * 4, s);
                    ss[ct] = s;
                }
                if (g == 0) {
#pragma unroll
                    for (int ct = 0; ct < 4; ++ct) SSQ[(16 * ct + l15) * 8 + w] = ss[ct];
                }
                GLA_BARRIER();
#pragma unroll
                for (int ct = 0; ct < 4; ++ct) {
                    const int cc = 16 * ct + l15;
                    const float4 s0 = *(const float4*)(SSQ + cc * 8), s1 = *(const float4*)(SSQ + cc * 8 + 4);
                    const float tot = (s0.x + s0.y) + (s0.z + s0.w) + (s1.x + s1.y) + (s1.z + s1.w);
                    const float rstd = rsqrtf(tot * (1.0f / 256.0f) + 1e-6f);
#pragma unroll
                    for (int vt = 0; vt < 2; ++vt) {
                        const f32x4 gt = g_unpk4(gate[vt][ct]);
                        f32x4 val;
#pragma unroll
                        for (int r = 0; r < 4; ++r) val[r] = o[vt][ct][r] * rstd * gh[vt][r] * gt[r];
                        *(u32x2*)((char*)Aout + (size_t)(tok0 + 16 * ct) * DM * 2 + offO + 32 * vt) = g_pk4(val);
                    }
                }
            } else {
                GLA_BARRIER();
            }
        }
        if (!OUT) {
#pragma unroll
            for (int mt = 0; mt < 8; ++mt)
#pragma unroll
                for (int vt = 0; vt < 2; ++vt) *(u32x2*)(GS + ((size_t)(bh * 32 + m) * 256 + 32 * w + 16 * vt + l15) * 128 + 16 * mt + 4 * g) = g_pk4(S[mt][vt]);
            if (g == 0) GD[(bh * 32 + m) * 128 + 16 * w + l15] = fexp(logD);
        }
        GLA_BARRIER();
    }
}

__device__ void gla_scan(const Params& p) {
    bf16_t* GS = (bf16_t*)(p.ws + WS_GS);
    const float* GD = (const float*)(p.ws + WS_GD);
    typedef float f32x2s __attribute__((ext_vector_type(2)));
    for (int idx = blockIdx.x * NTH + threadIdx.x; idx < 8 * 16384; idx += gridDim.x * NTH) {
        const int bh = idx >> 14, e = (idx & 16383) * 2, d = e & 127;
        f32x2s S = (f32x2s){0.f, 0.f};
        for (int m0 = 0; m0 < 32; m0 += 16) {
            unsigned t[16]; f32x2s dd[16];
#pragma unroll
            for (int m = 0; m < 16; ++m) { t[m] = *(const unsigned*)(GS + (size_t)(bh * 32 + m0 + m) * 32768 + e); dd[m] = *(const f32x2s*)(GD + (bh * 32 + m0 + m) * 128 + d); }
#pragma unroll
            for (int m = 0; m < 16; ++m) { *(unsigned*)(GS + (size_t)(bh * 32 + m0 + m) * 32768 + e) = pk2(S.x, S.y); S = S * dd[m] + (f32x2s){bf2f(t[m] & 0xffffu), bf2f(t[m] >> 16)}; }
        }
    }
}

constexpr int PP = RIN_P;
constexpr size_t WS_RK  = WS_GS;
constexpr size_t WS_BND = WS_GS + (size_t)MTOK * 16 * 4;
static_assert(WS_BND + (size_t)513 * PP * 2 <= WS_GD, "RWKV side buffers must fit the GLA state region");
constexpr int IMG = 64 * 72 * 2;
constexpr int R_ALB = 0, R_BH = IMG, R_KH = 2 * IMG, R_RB = 3 * IMG, R_BTL = 4 * IMG, R_KTL = 5 * IMG, R_VI = 6 * IMG, R_AAB = 7 * IMG, R_AAK = 8 * IMG, R_ARB = 9 * IMG, R_ARK = 10 * IMG,
              R_DW = R_AAK, R_DA = R_BH, R_XT = 11 * IMG, R_TW = R_XT, R_ADI = R_XT + IMG, R_TDF = R_XT + 2 * IMG, R_CS = R_TDF + 2048, R_GC = R_CS + 2048, R_CONST = R_GC + 256, R_WDL = R_CONST + 2560, R_WIL = R_WDL + IMG,
              R_END = R_WIL + IMG;
static_assert(R_DW + 64 * 68 * 4 <= R_XT && R_DA + 64 * 68 * 4 <= R_RB && R_END <= LDS_BYTES, "R1 LDS");
#define LDS_BARRIER() do { asm volatile("s_waitcnt lgkmcnt(0)" ::: "memory"); __builtin_amdgcn_s_barrier(); asm volatile("" ::: "memory"); } while (0)

typedef short s16x4 __attribute__((ext_vector_type(4)));
__device__ __forceinline__ bf16x8 ldfrag(const bf16_t* img, int row, int koff) { return *(const bf16x8*)(img + row * 72 + koff); }
__device__ __forceinline__ u32x2 pk4(f32x4 v) { u32x2 r; r.x = pk2(v[0], v[1]); r.y = pk2(v[2], v[3]); return r; }
__device__ __forceinline__ f32x4 unpk4(u32x2 v) { return (f32x4){bf2f(v.x & 0xffffu), bf2f(v.x >> 16), bf2f(v.y & 0xffffu), bf2f(v.y >> 16)}; }
__device__ __forceinline__ u32x2 trread(const bf16_t* p) {
    union { s16x4 s; u32x2 u; } x; x.s = __builtin_amdgcn_ds_read_tr16_b64_v4i16((__attribute__((address_space(3))) s16x4*)p); return x.u;
}
__device__ __forceinline__ bf16x8 trfrag(const bf16_t* img, int k0, int c0, int g, int q, int pq) {
    const bf16_t* a = img + (k0 + 8 * g + q) * 72 + c0 + 4 * pq;
    const u32x2 lo = trread(a), hi = trread(a + 4 * 72);
    return as_bf16x8((u32x4){lo.x, lo.y, hi.x, hi.y});
}
__device__ __forceinline__ f32x4 lo4(u32x4 v) { return (f32x4){bf2f(v.x & 0xffffu), bf2f(v.x >> 16), bf2f(v.y & 0xffffu), bf2f(v.y >> 16)}; }
__device__ __forceinline__ f32x4 hi4(u32x4 v) { return (f32x4){bf2f(v.z & 0xffffu), bf2f(v.z >> 16), bf2f(v.w & 0xffffu), bf2f(v.w >> 16)}; }
__device__ __forceinline__ u32x4 pk8(f32x4 a, f32x4 b) { return (u32x4){pk2(a[0], a[1]), pk2(a[2], a[3]), pk2(b[0], b[1]), pk2(b[2], b[3])}; }
__device__ __forceinline__ float fast_rcp(float x) { return __builtin_amdgcn_rcpf(x); }
__device__ __forceinline__ f32x4 mm16(f32x4 xa, f32x4 yb, f32x4 c) {
    const u32x2 a = pk4(xa), b = pk4(yb);
    return mfma16(as_bf16x8((u32x4){a.x, a.y, 0u, 0u}), as_bf16x8((u32x4){b.x, b.y, 0u, 0u}), c);
}

struct R1Raw { u32x4 r0, r1, k0, k1, v0, v1, w0, w1, a0, a1; };
__device__ __forceinline__ void r1_issue(R1Raw& x, const char* ws, int unit, int t, int cs) {
    const int bn = unit >> 4, h = unit & 15, n = bn & 255;
    const unsigned cbo = (unsigned)WS_P + (unsigned)bn * (unsigned)(PB_CHUNK * 2);
    const unsigned bpo = (unsigned)WS_BND + (unsigned)(n == 0 ? 0 : bn) * (unsigned)(PP * 2);
    const unsigned l16 = 16u * (unsigned)cs, ut = (unsigned)t;
    const unsigned oR = cbo + (unsigned)(pb_sub(0, h) * 2) + ut * (unsigned)(pb_pitch(0) * 2) + l16, oK = cbo + (unsigned)(pb_sub(1, h) * 2) + ut * (unsigned)(pb_pitch(1) * 2) + l16;
    const unsigned oV = cbo + (unsigned)(pb_sub(2, h) * 2) + ut * (unsigned)(pb_pitch(2) * 2) + l16, oW = cbo + (unsigned)(PB_WDAD * 2) + ut * 256u + l16;
    x.r0 = *(const u32x4*)(ws + oR); x.k0 = *(const u32x4*)(ws + oK); x.v0 = *(const u32x4*)(ws + oV); x.w0 = *(const u32x4*)(ws + oW); x.a0 = *(const u32x4*)(ws + oW + 128u);
    const bool in = t > 0;
    const unsigned bh = bpo + (unsigned)(h * 128) + l16;
    const unsigned pR = in ? oR - (unsigned)(pb_pitch(0) * 2) : bh, pK = in ? oK - (unsigned)(pb_pitch(1) * 2) : bh + 2048u, pV = in ? oV - (unsigned)(pb_pitch(2) * 2) : bh + 4096u;
    const unsigned pW = in ? oW - 256u : bpo + 8192u + l16;
    x.r1 = *(const u32x4*)(ws + pR); x.k1 = *(const u32x4*)(ws + pK); x.v1 = *(const u32x4*)(ws + pV); x.w1 = *(const u32x4*)(ws + pW); x.a1 = *(const u32x4*)(ws + pW + 128u);
}
__device__ __forceinline__ void lerp8(u32x4 c, u32x4 pv, const float* mu8, f32x4& o0, f32x4& o1) {
    const f32x4 c0 = lo4(c), c1 = hi4(c), p0 = lo4(pv), p1 = hi4(pv);
    const f32x4 m0 = *(const f32x4*)mu8, m1 = *(const f32x4*)(mu8 + 4);
    o0 = c0 + m0 * (p0 - c0); o1 = c1 + m1 * (p1 - c1);
}

__device__ void rwkv_r1(const Params& p, unsigned char* lds) {
    const int tid = threadIdx.x, w = __builtin_amdgcn_readfirstlane(tid >> 6);
    bf16_t* P = (bf16_t*)(p.ws + WS_P);
    bf16_t* Abuf = (bf16_t*)(p.ws + WS_A);
    bf16_t* Ybuf = (bf16_t*)(p.ws + WS_Y);
    float* RK = (float*)(p.ws + WS_RK);
    const bf16_t* BND = (const bf16_t*)(p.ws + WS_BND);
    const bf16_t* WduT = (const bf16_t*)(p.ws + WS_WDUT);
    const bf16_t* WiuT = (const bf16_t*)(p.ws + WS_WIUT);
    bf16_t* ALB = (bf16_t*)(lds + R_ALB); bf16_t* BH = (bf16_t*)(lds + R_BH); bf16_t* KH = (bf16_t*)(lds + R_KH); bf16_t* RB = (bf16_t*)(lds + R_RB);
    bf16_t* BTL = (bf16_t*)(lds + R_BTL); bf16_t* KTL = (bf16_t*)(lds + R_KTL); bf16_t* VI = (bf16_t*)(lds + R_VI);
    bf16_t* AAB = (bf16_t*)(lds + R_AAB); bf16_t* AAK = (bf16_t*)(lds + R_AAK); bf16_t* ARB = (bf16_t*)(lds + R_ARB); bf16_t* ARK = (bf16_t*)(lds + R_ARK);
    float* DW = (float*)(lds + R_DW); float* DA = (float*)(lds + R_DA);
    bf16_t* XT = (bf16_t*)(lds + R_XT); bf16_t* TW = (bf16_t*)(lds + R_TW); bf16_t* ADI = (bf16_t*)(lds + R_ADI);
    u32x2* TDF = (u32x2*)(lds + R_TDF); float* CS = (float*)(lds + R_CS); float* GCs = (float*)(lds + R_GC); float* CONST = (float*)(lds + R_CONST); bf16_t* WDL = (bf16_t*)(lds + R_WDL); bf16_t* WIL = (bf16_t*)(lds + R_WIL);
    const int t0_ = tid >> 3, cs0_ = tid & 7;
    int hprev = -1;
    R1Raw raw;
    if (blockIdx.x < 8192) r1_issue(raw, (const char*)p.ws, blockIdx.x, t0_, cs0_);
    {
        u32x4* dmy = (u32x4*)(p.ws + WS_DUMMY) + tid;
#pragma unroll
        for (int k = 0; k < 6; ++k) dmy[k * NTH] = (u32x4){0u, 0u, 0u, 0u};
    }

    for (int unit = blockIdx.x; unit < 8192; unit += gridDim.x) {
        const int bn = unit >> 4, h = unit & 15, n = bn & 255;
        const size_t R0 = (size_t)bn * 64;
        int tidv = tid; asm volatile("" : "+v"(tidv));
        const int lane = tidv & 63, l15 = lane & 15, g = lane >> 4, q4 = l15 >> 2, p4 = l15 & 3, t = tidv >> 3, cs = tidv & 7, tl = lane >> 3;
        if (h != hprev) {
            LDS_BARRIER();
            if (tid < 64) {
                const int ch = h * 64 + tid;
                CONST[tid] = p.in[10][ch]; CONST[64 + tid] = p.in[10][1024 + ch]; CONST[128 + tid] = p.in[10][2048 + ch];
                CONST[192 + tid] = p.in[11][ch]; CONST[256 + tid] = p.in[13][ch]; CONST[320 + tid] = p.in[15][ch]; CONST[384 + tid] = p.in[16][ch]; CONST[448 + tid] = p.in[17][ch];
                CONST[512 + tid] = p.in[10][4096 + tid]; CONST[576 + tid] = p.in[10][4160 + tid];
            }
            {
                const int rr = tid >> 3, sg = tid & 7;
                *(u32x4*)(WDL + rr * 72 + 8 * sg) = *(const u32x4*)(WduT + (size_t)(h * 64 + rr) * 64 + 8 * sg);
                *(u32x4*)(WIL + rr * 72 + 8 * sg) = *(const u32x4*)(WiuT + (size_t)(h * 64 + rr) * 64 + 8 * sg);
            }
            hprev = h;
            LDS_BARRIER();
        }
        f32x4 r0, r1, k0, k1, v0, v1;
        {
            f32x4 wd0, wd1, ad0, ad1;
            lerp8(raw.r0, raw.r1, CONST + 8 * cs, r0, r1);
            lerp8(raw.k0, raw.k1, CONST + 64 + 8 * cs, k0, k1);
            lerp8(raw.v0, raw.v1, CONST + 128 + 8 * cs, v0, v1);
            lerp8(raw.w0, raw.w1, CONST + 512 + 8 * cs, wd0, wd1);
            lerp8(raw.a0, raw.a1, CONST + 576 + 8 * cs, ad0, ad1);
#pragma unroll
            for (int j = 0; j < 4; ++j) {
                const float e0 = __builtin_amdgcn_exp2f(2.8853900817779268f * wd0[j]), e1 = __builtin_amdgcn_exp2f(2.8853900817779268f * wd1[j]);
                wd0[j] = 1.f - 2.f * fast_rcp(1.f + e0); wd1[j] = 1.f - 2.f * fast_rcp(1.f + e1);
            }
            *(u32x4*)(TW + t * 72 + 8 * cs) = pk8(wd0, wd1);
            *(u32x4*)(ADI + t * 72 + 8 * cs) = pk8(ad0, ad1);
        }
        if (unit + (int)gridDim.x < 8192) r1_issue(raw, (const char*)p.ws, unit + gridDim.x, t, cs);
        {
            const int trow = 8 * w + (l15 & 7);
            const bool lo8 = l15 < 8;
            bf16x8 ft[2], fa[2];
#pragma unroll
            for (int kk = 0; kk < 2; ++kk) { ft[kk] = ldfrag(TW, trow, 32 * kk + 8 * g); fa[kk] = ldfrag(ADI, trow, 32 * kk + 8 * g); }
            float* dst = (lo8 ? DW : DA) + trow * 68 + 4 * g;
#pragma unroll
            for (int ct = 0; ct < 4; ++ct) {
                f32x4 aw = (f32x4){0.f, 0.f, 0.f, 0.f}, aa = aw;
#pragma unroll
                for (int kk = 0; kk < 2; ++kk) { aw = mfma16(ldfrag(WDL, 16 * ct + l15, 32 * kk + 8 * g), ft[kk], aw); aa = mfma16(ldfrag(WIL, 16 * ct + l15, 32 * kk + 8 * g), fa[kk], aa); }
                f32x4 o;
#pragma unroll
                for (int j = 0; j < 4; ++j) o[j] = lo8 ? aw[j] : aa[j];
                *(f32x4*)(dst + 16 * ct) = o;
            }
        }
        f32x4 lw[2], av[2], kk[2], k2[2], G[2];
        {
            const f32x4 cw0[2] = {*(const f32x4*)(CONST + 192 + 8 * cs), *(const f32x4*)(CONST + 196 + 8 * cs)};
            const f32x4 ca0[2] = {*(const f32x4*)(CONST + 256 + 8 * cs), *(const f32x4*)(CONST + 260 + 8 * cs)};
            const f32x4 ckk[2] = {*(const f32x4*)(CONST + 320 + 8 * cs), *(const f32x4*)(CONST + 324 + 8 * cs)};
            const f32x4 cka[2] = {*(const f32x4*)(CONST + 384 + 8 * cs), *(const f32x4*)(CONST + 388 + 8 * cs)};
            const f32x4 crk[2] = {*(const f32x4*)(CONST + 448 + 8 * cs), *(const f32x4*)(CONST + 452 + 8 * cs)};
            const f32x4 dwv[2] = {*(const f32x4*)(DW + t * 68 + 8 * cs), *(const f32x4*)(DW + t * 68 + 8 * cs + 4)};
            const f32x4 dav[2] = {*(const f32x4*)(DA + t * 68 + 8 * cs), *(const f32x4*)(DA + t * 68 + 8 * cs + 4)};
            const f32x4 kin[2] = {k0, k1}, rin[2] = {r0, r1};
            float n2 = 0.f, rk = 0.f;
#pragma unroll
            for (int hf = 0; hf < 2; ++hf)
#pragma unroll
                for (int j = 0; j < 4; ++j) {
                    const float z = -(cw0[hf][j] + dwv[hf][j]);
                    lw[hf][j] = -0.8750387749f * fast_rcp(1.f + __builtin_amdgcn_exp2f(1.4426950408889634f * z));
                    av[hf][j] = fast_rcp(1.f + __builtin_amdgcn_exp2f(-1.4426950408889634f * (ca0[hf][j] + dav[hf][j])));
                    kk[hf][j] = kin[hf][j] * ckk[hf][j];
                    k2[hf][j] = kin[hf][j] * (1.f + (av[hf][j] - 1.f) * cka[hf][j]);
                    n2 += kk[hf][j] * kk[hf][j]; rk += rin[hf][j] * k2[hf][j] * crk[hf][j];
                }
            n2 = sum8(n2); rk = sum8(rk);
            const float inv = __builtin_amdgcn_rsqf(fmaxf(n2, 1e-24f));
            kk[0] *= inv; kk[1] *= inv;
            if (cs == 0) RK[(R0 + t) * 16 + h] = rk;
            G[0] = lw[0]; G[1] = lw[1];
#pragma unroll
            for (int d = 1; d < 8; d <<= 1) {
                const int src = ((lane - 8 * d) & 63) * 4;
                const float keep = (tl >= d) ? 1.f : 0.f;
#pragma unroll
                for (int hf = 0; hf < 2; ++hf)
#pragma unroll
                    for (int j = 0; j < 4; ++j) G[hf][j] += keep * bperm(src, G[hf][j]);
            }
            if (tl == 7) { *(f32x4*)(CS + w * 64 + 8 * cs) = G[0]; *(f32x4*)(CS + w * 64 + 8 * cs + 4) = G[1]; }
        }
        LDS_BARRIER();
        {
            f32x4 off[2] = {(f32x4){0.f, 0.f, 0.f, 0.f}, (f32x4){0.f, 0.f, 0.f, 0.f}}, gc[2] = {off[0], off[0]};
#pragma unroll
            for (int q = 0; q < 8; ++q) {
                const f32x4 c0 = *(const f32x4*)(CS + q * 64 + 8 * cs), c1 = *(const f32x4*)(CS + q * 64 + 8 * cs + 4);
                const float mk = (q < w) ? 1.f : 0.f;
                gc[0] += c0; gc[1] += c1; off[0] += c0 * mk; off[1] += c1 * mk;
            }
            f32x4 al[2], bh[2], kh[2], rb[2];
            const f32x4 rin[2] = {r0, r1};
#pragma unroll
            for (int hf = 0; hf < 2; ++hf)
#pragma unroll
                for (int j = 0; j < 4; ++j) {
                    const float Gi = G[hf][j] + off[hf][j];
                    const float eG = __builtin_amdgcn_exp2f(Gi), eGm = __builtin_amdgcn_exp2f(Gi - lw[hf][j]), enG = fast_rcp(eG);
                    const float be = kk[hf][j] * av[hf][j];
                    al[hf][j] = -kk[hf][j] * eGm; bh[hf][j] = be * enG; kh[hf][j] = k2[hf][j] * enG; rb[hf][j] = rin[hf][j] * eG;
                }
            const int o = t * 72 + 8 * cs;
            *(u32x4*)(ALB + o) = pk8(al[0], al[1]); *(u32x4*)(BH + o) = pk8(bh[0], bh[1]); *(u32x4*)(KH + o) = pk8(kh[0], kh[1]); *(u32x4*)(RB + o) = pk8(rb[0], rb[1]);
            const u32x4 vpk = pk8(v0, v1);
            *(u32x4*)(VI + o) = vpk;
            *(u32x4*)(Ybuf + (R0 + t) * DM + h * 64 + 8 * cs) = vpk;
            if (w == 0 && tl == 0) { f32x4 e0, e1;
#pragma unroll
                for (int j = 0; j < 4; ++j) { e0[j] = __builtin_amdgcn_exp2f(gc[0][j]); e1[j] = __builtin_amdgcn_exp2f(gc[1][j]); }
                *(f32x4*)(GCs + 8 * cs) = e0; *(f32x4*)(GCs + 8 * cs + 4) = e1; }
        }
        LDS_BARRIER();
        {
            int ntile = 1, tta = 0, sta = 0, ttb = 0, stb = 0;
            if (w == 0) { tta = 0; sta = 0; } else if (w == 2) { tta = 1; sta = 1; } else if (w == 5) { tta = 2; sta = 2; } else if (w == 7) { tta = 3; sta = 3; }
            else if (w == 1) { ntile = 2; tta = 1; sta = 0; ttb = 2; stb = 0; } else if (w == 3) { ntile = 2; tta = 2; sta = 1; ttb = 3; stb = 0; }
            else if (w == 4) { tta = 3; sta = 1; } else { tta = 3; sta = 2; }
            for (int it = 0; it < ntile; ++it) {
                const int tt = it ? ttb : tta, st = it ? stb : sta;
                f32x4 cab = (f32x4){0.f, 0.f, 0.f, 0.f}, cak = cab, crb = cab, crk = cab, nab = cab;
#pragma unroll
                for (int kq = 0; kq < 2; ++kq) {
                    const bf16x8 fb = ldfrag(BH, 16 * st + l15, 32 * kq + 8 * g), fk = ldfrag(KH, 16 * st + l15, 32 * kq + 8 * g);
                    const bf16x8 fa = ldfrag(ALB, 16 * tt + l15, 32 * kq + 8 * g), fr = ldfrag(RB, 16 * tt + l15, 32 * kq + 8 * g);
                    cab = mfma16(fb, fa, cab); cak = mfma16(fk, fa, cak); crb = mfma16(fb, fr, crb); crk = mfma16(fk, fr, crk);
                    if (tt == st) nab = mfma16(fa, fb, nab);
                }
                if (tt == st) {
#pragma unroll
                    for (int r = 0; r < 4; ++r) {
                        const int s = 4 * g + r, tq = l15;
                        if (s >= tq) { cab[r] = 0.f; cak[r] = 0.f; }
                        if (s > tq) { crb[r] = 0.f; crk[r] = 0.f; }
                        if (l15 >= 4 * g + r) nab[r] = 0.f;
                    }
                }
                const int o = (16 * tt + l15) * 72 + 16 * st + 4 * g;
                *(u32x2*)(AAB + o) = pk4(cab); *(u32x2*)(AAK + o) = pk4(cak); *(u32x2*)(ARB + o) = pk4(crb); *(u32x2*)(ARK + o) = pk4(crk);
                if (tt == st) {
                    const f32x4 z = (f32x4){0.f, 0.f, 0.f, 0.f};
                    const f32x4 Q1 = cab, N1 = nab;
                    const f32x4 Q2 = mm16(N1, Q1, z), N2 = mm16(Q1, N1, z);
                    f32x4 Pm = Q1;
#pragma unroll
                    for (int r = 0; r < 4; ++r) if (4 * g + r == l15) Pm[r] += 1.f;
                    Pm = mm16(N2, Pm, Pm);
                    const f32x4 Q4 = mm16(N2, Q2, z), N4 = mm16(Q2, N2, z);
                    Pm = mm16(N4, Pm, Pm);
                    const f32x4 N8 = mm16(Q4, N4, z);
                    Pm = mm16(N8, Pm, Pm);
                    TDF[tt * 64 + lane] = pk4(Pm);
                }
            }
            if (w == 4 || w == 6) {
                const int tt = (w == 4) ? 0 : 2, st = tt + 1;
                const int o = (16 * tt + l15) * 72 + 16 * st + 4 * g;
                const u32x2 zz = (u32x2){0u, 0u};
                *(u32x2*)(AAK + o) = zz; *(u32x2*)(ARB + o) = zz; *(u32x2*)(ARK + o) = zz;
            }
        }
        LDS_BARRIER();
        {
            u32x2 xb[4];
            const int col = 16 * w + l15;
            bf16x8 vfr[2];
            if (w >= 4) { vfr[0] = trfrag(VI, 0, 16 * (w - 4), g, q4, p4); vfr[1] = trfrag(VI, 32, 16 * (w - 4), g, q4, p4); }
#pragma unroll
            for (int i = 0; i < 4; ++i) {
                f32x4 z;
                if (w < 4) z = unpk4(trread(ALB + (16 * i + 4 * g + q4) * 72 + 16 * w + 4 * p4));
                else {
                    z = mfma16(ldfrag(AAK, 16 * i + l15, 8 * g), vfr[0], (f32x4){0.f, 0.f, 0.f, 0.f});
                    if (i >= 2) z = mfma16(ldfrag(AAK, 16 * i + l15, 32 + 8 * g), vfr[1], z);
                }
                if (i >= 1) {
                    const bf16_t* ar = AAB + (16 * i + l15) * 72 + 4 * g;
                    const u32x2 a0 = *(const u32x2*)ar;
                    u32x2 a1 = (u32x2){0u, 0u}, b1 = (u32x2){0u, 0u};
                    if (i >= 2) { a1 = *(const u32x2*)(ar + 16); b1 = xb[1]; }
                    z = mfma16(as_bf16x8((u32x4){a0.x, a0.y, a1.x, a1.y}), as_bf16x8((u32x4){xb[0].x, xb[0].y, b1.x, b1.y}), z);
                    if (i == 3) {
                        const u32x2 a2 = *(const u32x2*)(ar + 32);
                        z = mfma16(as_bf16x8((u32x4){a2.x, a2.y, 0u, 0u}), as_bf16x8((u32x4){xb[2].x, xb[2].y, 0u, 0u}), z);
                    }
                }
                const u32x2 tq = TDF[i * 64 + lane];
                const u32x2 zq = pk4(z);
                const f32x4 x = mfma16(as_bf16x8((u32x4){tq.x, tq.y, 0u, 0u}), as_bf16x8((u32x4){zq.x, zq.y, 0u, 0u}), (f32x4){0.f, 0.f, 0.f, 0.f});
                xb[i] = pk4(x);
                *(u32x2*)(XT + col * 72 + 16 * i + 4 * g) = xb[i];
            }
        }
        LDS_BARRIER();
        {
            const int rt_ = w & 3, c0 = 2 * (w >> 2);
            bf16x8 xw[2], xu[2], fbt[2], fkt[2], fvr[2];
#pragma unroll
            for (int kq = 0; kq < 2; ++kq) {
                xw[kq] = ldfrag(XT, 16 * rt_ + l15, 32 * kq + 8 * g);
                xu[kq] = ldfrag(XT, 64 + 16 * rt_ + l15, 32 * kq + 8 * g);
                fbt[kq] = trfrag(BH, 32 * kq, 16 * rt_, g, q4, p4);
                fkt[kq] = trfrag(KH, 32 * kq, 16 * rt_, g, q4, p4);
                fvr[kq] = trfrag(VI, 32 * kq, 16 * rt_, g, q4, p4);
            }
            const float gcd0 = GCs[16 * c0 + l15], gcd1 = GCs[16 * c0 + 16 + l15];
            const f32x4 gcr = *(const f32x4*)(GCs + 16 * rt_ + 4 * g);
#pragma unroll
            for (int q = 0; q < 2; ++q) {
                bf16x8 gbt[2], garb[2], gxu[2], gvi[2], gark[2];
#pragma unroll
                for (int kq = 0; kq < 2; ++kq) {
                    gbt[kq] = trfrag(BH, 32 * kq, 16 * (c0 + q), g, q4, p4);
                    garb[kq] = ldfrag(ARB, 16 * (c0 + q) + l15, 32 * kq + 8 * g);
                    gxu[kq] = ldfrag(XT, 64 + 16 * (c0 + q) + l15, 32 * kq + 8 * g);
                    gvi[kq] = trfrag(VI, 32 * kq, 16 * (c0 + q), g, q4, p4);
                    gark[kq] = ldfrag(ARK, 16 * (c0 + q) + l15, 32 * kq + 8 * g);
                }
                const u32x2 rbi = *(const u32x2*)(RB + (16 * (c0 + q) + l15) * 72 + 16 * rt_ + 4 * g);
                __builtin_amdgcn_sched_barrier(0);
                const int ctile = c0 + q;
                {
                    f32x4 acc = (f32x4){0.f, 0.f, 0.f, 0.f};
#pragma unroll
                    for (int kq = 0; kq < 2; ++kq) acc = mfma16(xw[kq], gbt[kq], acc);
                    const int dcol = 16 * ctile + l15;
                    if (rt_ == ctile) {
#pragma unroll
                        for (int r = 0; r < 4; ++r) if (4 * g + r == l15) acc[r] += 1.f;
                    }
                    acc *= (q ? gcd1 : gcd0);
                    *(u32x2*)(ALB + dcol * 72 + 32 * (rt_ >> 1) + 8 * g + 4 * (rt_ & 1)) = pk4(acc);
                }
                {
                    f32x4 acc = unpk4(rbi);
#pragma unroll
                    for (int kq = 0; kq < 2; ++kq) {
                        if (32 * kq <= 16 * ctile + 15) acc = mfma16(xw[kq], garb[kq], acc);
                    }
                    *(u32x2*)(BTL + (16 * ctile + l15) * 72 + 16 * rt_ + 4 * g) = pk4(acc);
                }
                {
                    f32x4 acc = (f32x4){0.f, 0.f, 0.f, 0.f};
#pragma unroll
                    for (int kq = 0; kq < 2; ++kq) { acc = mfma16(fbt[kq], gxu[kq], acc); acc = mfma16(fkt[kq], gvi[kq], acc); }
                    *(u32x2*)(KTL + (16 * ctile + l15) * 72 + 16 * rt_ + 4 * g) = pk4(acc * gcr);
                }
                {
                    f32x4 acc = (f32x4){0.f, 0.f, 0.f, 0.f};
#pragma unroll
                    for (int kq = 0; kq < 2; ++kq) {
                        if (32 * kq <= 16 * ctile + 15) { acc = mfma16(xu[kq], garb[kq], acc); acc = mfma16(fvr[kq], gark[kq], acc); }
                    }
                    *(u32x2*)(AAB + (16 * ctile + l15) * 72 + 16 * rt_ + 4 * g) = pk4(acc);
                }
            }
        }
        LDS_BARRIER();
        {
            const int o = t * 72 + 8 * cs;
            bf16_t* cb = P + (size_t)bn * PB_CHUNK + 8 * cs;
            *(u32x4*)(cb + pb_sub(0, h) + t * pb_pitch(0)) = *(const u32x4*)(ALB + o);
            *(u32x4*)(cb + pb_sub(1, h) + t * pb_pitch(1)) = *(const u32x4*)(BTL + o);
            *(u32x4*)(cb + pb_sub(2, h) + t * pb_pitch(2)) = *(const u32x4*)(KTL + o);
            *(u32x4*)(Abuf + (R0 + t) * DM + h * 64 + 8 * cs) = *(const u32x4*)(AAB + o);
        }
    }
}

constexpr int SC_SLOT = 2 * IMG;
constexpr size_t WS_MG = (WS_BND + (size_t)513 * PP * 2 + 255) & ~(size_t)255;
constexpr size_t WS_NG = WS_MG + (size_t)1024 * 4096 * 2;
static_assert(WS_NG + (size_t)1024 * 4096 * 2 <= WS_GD, "scan buffers must fit the GLA state region");

template <int MODE>
__device__ void rwkv_scan2(const Params& p, unsigned char* lds) {
    constexpr int GSZ = 32, NGRP = 256 / GSZ, LG = 3;
    constexpr int PRE = (MODE == 3) ? NGRP : 0;
    constexpr int SPU = (MODE == 2) ? NGRP : GSZ + PRE;
    constexpr int NU = (MODE == 2) ? 32 : 32 * NGRP;
    const int tid = threadIdx.x, lane = tid & 63, w = __builtin_amdgcn_readfirstlane(tid >> 6), l15 = lane & 15, g = lane >> 4;
    bf16_t* P = (bf16_t*)(p.ws + WS_P);
    bf16_t* MG = (bf16_t*)(p.ws + WS_MG); bf16_t* NG = (bf16_t*)(p.ws + WS_NG); bf16_t* HG = NG;
    const int G = gridDim.x;
    const int nun = ((int)blockIdx.x < NU) ? (NU - 1 - (int)blockIdx.x) / G + 1 : 0;
    const int T = nun * SPU;
    if (T == 0) return;
#define SC_SRC(s, p0, p1, pitchb) \
    const int u_ = (int)blockIdx.x + G * ((s) / SPU), j_ = (s) % SPU; \
    const char* p0; const char* p1; unsigned pitchb; \
    if (MODE == 2) { p0 = (const char*)(MG + (size_t)(u_ * NGRP + j_) * 4096); p1 = (const char*)(NG + (size_t)(u_ * NGRP + j_) * 4096); pitchb = 128u; } \
    else { const int bh_ = u_ >> LG, g_ = u_ & (NGRP - 1), jp_ = j_ - (PRE - g_), n_ = GSZ * g_ + ((j_ >= PRE) ? j_ - PRE : 0); pitchb = (unsigned)(pb_pitch(0) * 2); \
        p0 = (const char*)(P + (size_t)((bh_ >> 4) * 256 + n_) * PB_CHUNK + pb_sub(0, bh_ & 15)); p1 = (const char*)(P + (size_t)((bh_ >> 4) * 256 + n_) * PB_CHUNK + pb_sub(2, bh_ & 15)); \
        if (j_ < PRE) { if (jp_ >= 0) { p0 = (const char*)(MG + (size_t)(bh_ * NGRP + jp_) * 4096); p1 = (const char*)(NG + (size_t)(bh_ * NGRP + jp_) * 4096); } else p1 = (const char*)(p.ws + WS_BND); } }
    if (w >= 4) {
        const int lj = w - 4;
        const unsigned loff = (unsigned)((lane >> 3) * 144 + (lane & 7) * 16);
        u32x4 ld0[16], ld1[16];
#define SC_ISSUE(dst, s) do { const int sc_ = ((s) < T) ? (s) : T - 1; SC_SRC(sc_, q0_, q1_, pb_) const unsigned go_ = (unsigned)(lane >> 3) * pb_ + (unsigned)(lane & 7) * 16u; \
        _Pragma("unroll") for (int q = 0; q < 16; ++q) dst[q] = *(const u32x4*)(((q >> 3) ? q1_ : q0_) + (size_t)((q & 7) * 8) * pb_ + go_); } while (0)
#define SC_RETIRE(src, s) do { unsigned char* sb = lds + ((s) & 1) * SC_SLOT + loff; _Pragma("unroll") for (int q = 0; q < 16; ++q) \
        *(u32x4*)(sb + (q >> 3) * IMG + (q & 7) * 8 * 144) = src[q]; } while (0)
        SC_ISSUE(ld0, lj); SC_ISSUE(ld1, lj + 4);
        for (int it = 0; it < T / 8; ++it) {
            const int c0 = lj + 8 * it;
            for (int k = 0; k < lj; ++k) LDS_BARRIER();
            SC_RETIRE(ld0, c0); SC_ISSUE(ld0, c0 + 8);
            for (int k = 0; k < 4; ++k) LDS_BARRIER();
            SC_RETIRE(ld1, c0 + 4); SC_ISSUE(ld1, c0 + 12);
            for (int k = 0; k < 4 - lj; ++k) LDS_BARRIER();
        }
        LDS_BARRIER();
#undef SC_ISSUE
#undef SC_RETIRE
    } else {
        f32x4 H[4], Mg[4];
        for (int i = 0; i <= T; ++i) {
            if (i >= 1) {
                const int s = i - 1, u = (int)blockIdx.x + G * (s / SPU), j = s % SPU;
                const unsigned char* sb = lds + (s & 1) * SC_SLOT;
                const bf16_t* MT = (const bf16_t*)sb; const bf16_t* NT = (const bf16_t*)(sb + IMG);
                if (j == 0) {
#pragma unroll
                    for (int mt = 0; mt < 4; ++mt) H[mt] = (f32x4){0.f, 0.f, 0.f, 0.f};
                    if (MODE == 1) {
#pragma unroll
                        for (int mt = 0; mt < 4; ++mt)
#pragma unroll
                            for (int r = 0; r < 4; ++r) Mg[mt][r] = (16 * mt + 4 * g + r == 16 * w + l15) ? 1.f : 0.f;
                    }
                }
                u32x2 hp[4];
#pragma unroll
                for (int mt = 0; mt < 4; ++mt) hp[mt] = pk4(H[mt]);
                if (MODE == 2) {
#pragma unroll
                    for (int mt = 0; mt < 4; ++mt) *(u32x2*)(HG + (size_t)(u * NGRP + j) * 4096 + (16 * w + l15) * 64 + 16 * mt + 4 * g) = hp[mt];
                }
                if (MODE == 3 && j >= PRE) {
                    const int bh = u >> LG, n = GSZ * (u & (NGRP - 1)) + (j - PRE);
#pragma unroll
                    for (int mt = 0; mt < 4; ++mt) *(u32x2*)(P + (size_t)((bh >> 4) * 256 + n) * PB_CHUNK + pb_sub(2, bh & 15) + (16 * w + l15) * pb_pitch(2) + 16 * mt + 4 * g) = hp[mt];
                }
                bf16x8 hb[2], mb[2];
                hb[0] = as_bf16x8((u32x4){hp[0].x, hp[0].y, hp[1].x, hp[1].y});
                hb[1] = as_bf16x8((u32x4){hp[2].x, hp[2].y, hp[3].x, hp[3].y});
                if (MODE == 1) {
                    const u32x2 m0 = pk4(Mg[0]), m1 = pk4(Mg[1]), m2 = pk4(Mg[2]), m3 = pk4(Mg[3]);
                    mb[0] = as_bf16x8((u32x4){m0.x, m0.y, m1.x, m1.y}); mb[1] = as_bf16x8((u32x4){m2.x, m2.y, m3.x, m3.y});
                }
#pragma unroll
                for (int mt = 0; mt < 4; ++mt) {
                    const bf16x8 a0 = ldfrag(MT, 16 * mt + l15, 8 * g), a1 = ldfrag(MT, 16 * mt + l15, 32 + 8 * g);
                    f32x4 acc = unpk4(*(const u32x2*)(NT + (16 * w + l15) * 72 + 16 * mt + 4 * g));
                    acc = mfma16(a0, hb[0], acc); acc = mfma16(a1, hb[1], acc);
                    H[mt] = acc;
                    if (MODE == 1) { f32x4 am = mfma16(a0, mb[0], (f32x4){0.f, 0.f, 0.f, 0.f}); am = mfma16(a1, mb[1], am); Mg[mt] = am; }
                }
                if (MODE == 1 && j == SPU - 1) {
                    const int pc = 32 * (w >> 1) + 8 * (l15 >> 2) + 4 * (w & 1) + (l15 & 3);
#pragma unroll
                    for (int mt = 0; mt < 4; ++mt) {
                        *(u32x2*)(NG + (size_t)u * 4096 + (16 * w + l15) * 64 + 16 * mt + 4 * g) = pk4(H[mt]);
#pragma unroll
                        for (int r = 0; r < 4; ++r) MG[(size_t)u * 4096 + (16 * mt + 4 * g + r) * 64 + pc] = f2bf(Mg[mt][r]);
                    }
                }
            }
            LDS_BARRIER();
        }
    }
#undef SC_SRC
}

__device__ void rwkv_post(const Params& p, unsigned char* lds) {
    const int tid = threadIdx.x, lane = tid & 63, w = __builtin_amdgcn_readfirstlane(tid >> 6), l15 = lane & 15, g = lane >> 4;
    const bf16_t* P = (const bf16_t*)(p.ws + WS_P);
    bf16_t* Abuf = (bf16_t*)(p.ws + WS_A);
    const bf16_t* Ybuf = (const bf16_t*)(p.ws + WS_Y);
    const float* RK = (const float*)(p.ws + WS_RK);
    const bf16_t* BND = (const bf16_t*)(p.ws + WS_BND);
    float* L = (float*)(lds + w * 8704);
    const int tr = lane >> 3, seg = lane & 7;
    for (int hu = blockIdx.x * 8 + w; hu < 16384; hu += gridDim.x * 8) {
        const int unit = hu >> 1, t0 = (hu & 1) * 32;
        const int bn = unit >> 4, h = unit & 15, n = bn & 255;
        const size_t R0 = (size_t)bn * 64;
        bf16x8 fh[4][2], fr[2][2];
#pragma unroll
        for (int kk = 0; kk < 2; ++kk) {
#pragma unroll
            for (int q = 0; q < 4; ++q) fh[q][kk] = *(const bf16x8*)(P + (size_t)bn * PB_CHUNK + pb_sub(2, h) + (16 * q + l15) * pb_pitch(2) + 32 * kk + 8 * g);
#pragma unroll
            for (int q = 0; q < 2; ++q) fr[q][kk] = *(const bf16x8*)(P + (size_t)bn * PB_CHUNK + pb_sub(1, h) + (t0 + 16 * q + l15) * pb_pitch(1) + 32 * kk + 8 * g);
        }
        u32x4 y0r[4], g1r[4], g0r[4], vpr[4];
        float rkv[4];
#pragma unroll
        for (int i = 0; i < 4; ++i) {
            const int t = t0 + tr + 8 * i;
            y0r[i] = *(const u32x4*)(Abuf + (R0 + t) * DM + h * 64 + 8 * seg);
            const bf16_t* grow = P + (size_t)bn * PB_CHUNK + pb_sub(3, h) + t * pb_pitch(3) + 8 * seg;
            g1r[i] = *(const u32x4*)grow;
            g0r[i] = *(const u32x4*)((t > 0) ? (grow - pb_pitch(3)) : (BND + (size_t)(n == 0 ? 0 : bn) * PP + 3072 + h * 64 + 8 * seg));
            vpr[i] = *(const u32x4*)(Ybuf + (R0 + t) * DM + h * 64 + 8 * seg);
            rkv[i] = RK[(R0 + t) * 16 + h];
        }
#pragma unroll
        for (int i = 0; i < 4; ++i) { *(f32x4*)(L + (tr + 8 * i) * 68 + 8 * seg) = lo4(y0r[i]); *(f32x4*)(L + (tr + 8 * i) * 68 + 8 * seg + 4) = hi4(y0r[i]); }
        f32x4 y[4][2];
#pragma unroll
        for (int vt = 0; vt < 4; ++vt)
#pragma unroll
            for (int tt = 0; tt < 2; ++tt) y[vt][tt] = *(const f32x4*)(L + (16 * tt + l15) * 68 + 16 * vt + 4 * g);
#pragma unroll
        for (int vt = 0; vt < 4; ++vt)
#pragma unroll
            for (int tt = 0; tt < 2; ++tt)
#pragma unroll
                for (int kk = 0; kk < 2; ++kk) y[vt][tt] = mfma16(fh[vt][kk], fr[tt][kk], y[vt][tt]);
#pragma unroll
        for (int tt = 0; tt < 2; ++tt) {
            float s1 = 0.f, s2 = 0.f;
#pragma unroll
            for (int vt = 0; vt < 4; ++vt)
#pragma unroll
                for (int r = 0; r < 4; ++r) { s1 += y[vt][tt][r]; s2 += y[vt][tt][r] * y[vt][tt][r]; }
            { const int a16 = (lane ^ 16) * 4, a32 = (lane ^ 32) * 4; s1 += bperm(a16, s1); s2 += bperm(a16, s2); s1 += bperm(a32, s1); s2 += bperm(a32, s2); }
            const float mean = s1 * (1.0f / 64.0f);
            const float rstd = rsqrtf(fmaxf(s2 * (1.0f / 64.0f) - mean * mean, 0.f) + 64e-5f);
#pragma unroll
            for (int vt = 0; vt < 4; ++vt) *(f32x4*)(L + (16 * tt + l15) * 68 + 16 * vt + 4 * g) = (y[vt][tt] - mean) * rstd;
        }
        const int ch = h * 64 + 8 * seg;
        const f32x4 lw0 = *(const f32x4*)(p.in[18] + ch), lw1 = *(const f32x4*)(p.in[18] + ch + 4), lb0 = *(const f32x4*)(p.in[19] + ch), lb1 = *(const f32x4*)(p.in[19] + ch + 4);
        const f32x4 mg0 = *(const f32x4*)(p.in[10] + 3072 + ch), mg1 = *(const f32x4*)(p.in[10] + 3072 + ch + 4);
#pragma unroll
        for (int i = 0; i < 4; ++i) {
            const int t = t0 + tr + 8 * i;
            const f32x4 n0 = *(const f32x4*)(L + (tr + 8 * i) * 68 + 8 * seg), n1 = *(const f32x4*)(L + (tr + 8 * i) * 68 + 8 * seg + 4);
            const f32x4 ga0 = lo4(g1r[i]), ga1 = hi4(g1r[i]);
            const f32x4 gb0 = lo4(g0r[i]), gb1 = hi4(g0r[i]);
            const f32x4 gt0 = ga0 + mg0 * (gb0 - ga0), gt1 = ga1 + mg1 * (gb1 - ga1);
            const f32x4 v0 = lo4(vpr[i]), v1 = hi4(vpr[i]);
            f32x4 o0 = n0 * lw0 + lb0 + rkv[i] * v0, o1 = n1 * lw1 + lb1 + rkv[i] * v1;
#pragma unroll
            for (int j = 0; j < 4; ++j) { o0[j] *= gt0[j] * __builtin_amdgcn_rcpf(1.0f + fexp(-gt0[j])); o1[j] *= gt1[j] * __builtin_amdgcn_rcpf(1.0f + fexp(-gt1[j])); }
            *(u32x4*)(Abuf + (R0 + t) * DM + h * 64 + 8 * seg) = pk8(o0, o1);
        }
    }
}
#define XB_TMO      128
#define XB_XCNT(j)  (256  + 64 * (j))
#define XB_XSUB(j)  (1280 + 64 * (j))
#define XB_XGEN(j)  (2304 + 64 * (j))
#define XB_TOP      3328
#define XB_TOPGEN   3392
#define XCD_BAR_WORDS 3456
#define XB_SPIN_CAP (1u << 18)
#define LAS __attribute__((address_space(3)))

__device__ __forceinline__ unsigned xb_ld(unsigned* p)              { return __hip_atomic_load(p, __ATOMIC_RELAXED, __HIP_MEMORY_SCOPE_AGENT); }
__device__ __forceinline__ unsigned xb_add(unsigned* p, unsigned v) { return __hip_atomic_fetch_add(p, v, __ATOMIC_RELAXED, __HIP_MEMORY_SCOPE_AGENT); }
__device__ __forceinline__ unsigned xb_xcc_id() { return (unsigned)__builtin_amdgcn_s_getreg((3 << 11) | 20) & 0xFu; }
#define XB_SPIN(cond, bar) do { unsigned _sp = 0; while (cond) { __builtin_amdgcn_s_sleep(1); \
    if ((++_sp & 255u) == 0u) { if (xb_ld(&(bar)[XB_TMO])) break; if (_sp > XB_SPIN_CAP) { atomicAdd(&(bar)[XB_TMO], 1u); break; } } } } while (0)

struct XcdBarrier {
    unsigned* bar; unsigned x;
    volatile LAS unsigned* st;
};

__device__ __forceinline__ XcdBarrier xcd_barrier_post(unsigned* bar, volatile LAS unsigned* st) {
    XcdBarrier b; b.bar = bar; b.x = xb_xcc_id(); b.st = st;
    if (threadIdx.x == 0) (void)xb_add(&bar[XB_XCNT(b.x)], 1u);
    return b;
}
__device__ __forceinline__ void xcd_barrier_complete(unsigned* bar, unsigned x, unsigned& nloc, unsigned& nx) {
    const unsigned G = gridDim.x * gridDim.y * gridDim.z;
    unsigned sum, cnt, mine, sp = 0u;
    for (;;) {
        sum = 0u; cnt = 0u; mine = 0u;
#pragma unroll
        for (unsigned j = 0; j < 16; ++j) { const unsigned c = xb_ld(&bar[XB_XCNT(j)]); sum += c; cnt += (c > 0u) ? 1u : 0u; mine = (j == x) ? c : mine; }
        if (sum == G) break;
        __builtin_amdgcn_s_sleep(1);
        if ((++sp & 255u) == 0u) { if (xb_ld(&bar[XB_TMO])) break; if (sp > XB_SPIN_CAP) { atomicAdd(&bar[XB_TMO], 1u); break; } }
    }
    nloc = mine > 0u ? mine : 1u; nx = cnt > 0u ? cnt : 1u;
}

__device__ __forceinline__ void xcd_barrier(const XcdBarrier& b) {
    asm volatile("s_waitcnt vmcnt(0)" ::: "memory");
    __syncthreads();
    if (threadIdx.x == 0) {
        unsigned* bar = b.bar;
        __builtin_amdgcn_s_waitcnt(0);
        unsigned nloc = b.st[0], nx = b.st[1];
        if (nloc == 0u) { xcd_barrier_complete(bar, b.x, nloc, nx); b.st[0] = nloc; b.st[1] = nx; }
        const unsigned old = xb_add(&bar[XB_XSUB(b.x)], 1u);
        const unsigned gen = old / nloc;
        if (old + 1u == (gen + 1u) * nloc) {
            __builtin_amdgcn_fence(__ATOMIC_RELEASE, "agent");
            asm volatile("s_waitcnt vmcnt(0)" ::: "memory");
            const unsigned og = xb_add(&bar[XB_TOP], 1u);
            const unsigned tg = og / nx;
            if (og + 1u == (tg + 1u) * nx) xb_add(&bar[XB_TOPGEN], 1u);
            else XB_SPIN(xb_ld(&bar[XB_TOPGEN]) == tg, bar);
            __builtin_amdgcn_fence(__ATOMIC_ACQUIRE, "agent");
            xb_add(&bar[XB_XGEN(b.x)], 1u);
            asm volatile("s_waitcnt vmcnt(0)" ::: "memory");
        } else {
            XB_SPIN(xb_ld(&bar[XB_XGEN(b.x)]) == gen, bar);
            __builtin_amdgcn_fence(__ATOMIC_ACQUIRE, "agent");
            asm volatile("s_waitcnt vmcnt(0)" ::: "memory");
        }
    }
    __syncthreads();
}


#ifndef PROBE_ID
#define PROBE_ID 0
#endif
#ifndef N_LAUNCH_MODE
#define N_LAUNCH_MODE 1
#endif
constexpr int N_PHASES = 14;

__global__ void __launch_bounds__(NTH, 2) fwd_kernel(Params p) {
    extern __shared__ __attribute__((aligned(16))) unsigned char lds[];
    const int lo = p.ph_lo, hi = p.ph_hi;
    volatile LAS unsigned* xst = (volatile LAS unsigned*)(lds + LDS_BYTES);
    if (threadIdx.x < 4) xst[threadIdx.x] = 0u;
    __syncthreads();
    const XcdBarrier xbar = xcd_barrier_post((unsigned*)(p.ws + WS_BAR), xst);
    unsigned char* ws = p.ws;
#define IN(k) (lo <= (k) && (k) < hi)
#define SEAM(k) do { if ((k) + 1 < hi) xcd_barrier(xbar); } while (0)
    if (IN(0)) {
        prep_weight(p.in[2], GIN, p.in[1], (bf16_t*)(ws + WS_WGIN), GIN_P, (float*)lds);
        prep_weight(p.in[6], DM, nullptr, (bf16_t*)(ws + WS_WGOUT), DM, (float*)lds);
        prep_wup(p.in[3], (bf16_t*)(ws + WS_WUPT));
        __syncthreads();
        phase_norm0(p, lds);
        SEAM(0);
    }
    if (IN(1)) {
        pg8::Gemm g{(const bf16_t*)(ws + WS_A), (const bf16_t*)(ws + WS_WGIN), MTOK, GIN_P, DM}; pg8::StaticOrder S; S.init(MTOK, GIN_P, gridDim.x, blockIdx.x);
        EpiBf16GateSilu E{(bf16_t*)(ws + WS_P), GIN_P};
        pg8::gemm_phase<EpiBf16GateSilu, pg8::StaticOrder>((PG8_LAS unsigned char*)lds, g, S, E);
        SEAM(1);
    }
    if (IN(2)) { gla_pass<false>(p, lds); SEAM(2); }
    if (IN(3)) {
        gla_scan(p);
        prep_weight(p.in[9], RIN, p.in[8], (bf16_t*)(ws + WS_WRIN), RIN_P, (float*)lds);
        prep_weight(p.in[20], DM, nullptr, (bf16_t*)(ws + WS_WROUT), DM, (float*)lds);
        prep_lowrank(p.in[12], (bf16_t*)(ws + WS_WDUT));
        prep_lowrank(p.in[14], (bf16_t*)(ws + WS_WIUT));
        SEAM(3);
    }
    if (IN(4)) { gla_pass<true>(p, lds); SEAM(4); }
    if (IN(5)) {
        pg8::Gemm g{(const bf16_t*)(ws + WS_X1), (const bf16_t*)(ws + WS_WGOUT), MTOK, DM, DM}; pg8::StaticOrder S; S.init(MTOK, DM, gridDim.x, blockIdx.x);
        pg8::EpiBf16<0> E{(bf16_t*)(ws + WS_Y), DM, nullptr, 0, 0};
        pg8::gemm_phase<pg8::EpiBf16<0>, pg8::StaticOrder>((PG8_LAS unsigned char*)lds, g, S, E);
        SEAM(5);
    }
    if (IN(6)) { phase_norm1(p); zero_bnd_row((bf16_t*)(ws + WS_BND)); SEAM(6); }
    if (IN(7)) {
        pg8::Gemm g{(const bf16_t*)(ws + WS_X1), (const bf16_t*)(ws + WS_WRIN), MTOK, RIN_P, DM}; TailOrder S; S.init(MTOK, RIN_P - 256, gridDim.x, blockIdx.x);
        EpiBf16Bnd E{(bf16_t*)(ws + WS_P), RIN_P, (bf16_t*)(ws + WS_BND), (const float*)(ws + WS_RS)};
        pg8::gemm_phase<EpiBf16Bnd, TailOrder>((PG8_LAS unsigned char*)lds, g, S, E);
        SEAM(7);
    }
    if (IN(8)) { rwkv_r1(p, lds); SEAM(8); }
    if (IN(9)) { rwkv_scan2<1>(p, lds); SEAM(9); }
    if (IN(10)) { rwkv_scan2<3>(p, lds); SEAM(10); }
    if (IN(11)) { rwkv_post(p, lds); SEAM(11); }
    if (IN(12)) {
        pg8::Gemm g{(const bf16_t*)(ws + WS_A), (const bf16_t*)(ws + WS_WROUT), MTOK, DM, DM}; pg8::StaticOrder S; S.init(MTOK, DM, gridDim.x, blockIdx.x);
        pg8::EpiBf16<0> E{(bf16_t*)(ws + WS_Y), DM, nullptr, 0, 0};
        pg8::gemm_phase<pg8::EpiBf16<0>, pg8::StaticOrder>((PG8_LAS unsigned char*)lds, g, S, E);
        SEAM(12);
    }
    if (IN(13)) { phase_final(p); }
#undef IN
#undef SEAM
}

extern "C" void kernel_launch(void* const* d_in, const int* in_sizes, int n_in, void* d_out, int out_size, void* d_ws, size_t ws_size, hipStream_t stream) {
    static int grid = 0;
    if (grid == 0) {
        int dev = 0, cus = 0, per_cu = 0;
        hipGetDevice(&dev);
        hipDeviceGetAttribute(&cus, hipDeviceAttributeMultiprocessorCount, dev);
        hipFuncSetAttribute((const void*)fwd_kernel, hipFuncAttributeMaxDynamicSharedMemorySize, LDS_BYTES + 16);
        hipOccupancyMaxActiveBlocksPerMultiprocessor(&per_cu, (const void*)fwd_kernel, NTH, LDS_BYTES + 16);
        if (per_cu < 1) { fprintf(stderr, "kernel_launch: occupancy query says %d blocks per CU\n", per_cu); per_cu = 1; }
        grid = cus;
        if (n_in != 22 || ws_size < WS_END) fprintf(stderr, "kernel_launch: unexpected n_in %d or workspace %zu < %zu\n", n_in, ws_size, (size_t)WS_END);
        (void)hipGetLastError();
    }
    if (hipMemsetAsync((char*)d_ws + WS_BAR, 0, XCD_BAR_WORDS * 4, stream) != hipSuccess) fprintf(stderr, "kernel_launch: memset of the barrier words failed\n");
    Params p{};
    for (int i = 0; i < 22; ++i) p.in[i] = (const float*)d_in[i];
    p.out = (float*)d_out; p.ws = (unsigned char*)d_ws;
#if N_LAUNCH_MODE == 1
    void* args[] = {&p};
#if PROBE_ID > 0
    p.ph_lo = 0; p.ph_hi = PROBE_ID;
    (void)hipLaunchCooperativeKernel((const void*)fwd_kernel, dim3(grid), dim3(NTH), args, LDS_BYTES + 16, stream);
    (void)hipMemsetAsync((char*)d_ws + WS_BAR, 0, XCD_BAR_WORDS * 4, stream);
#endif
    p.ph_lo = 0; p.ph_hi = N_PHASES;
    hipError_t e = hipLaunchCooperativeKernel((const void*)fwd_kernel, dim3(grid), dim3(NTH), args, LDS_BYTES + 16, stream);
    if (e != hipSuccess) fprintf(stderr, "cooperative launch failed: %s (grid %d)\n", hipGetErrorString(e), grid);
#else
    for (int k = 0; k < N_PHASES; ++k) {
        p.ph_lo = k; p.ph_hi = k + 1;
        hipLaunchKernelGGL(fwd_kernel, dim3(grid), dim3(NTH), LDS_BYTES + 16, stream, p);
    }
#endif
}
```
